# Optimizing an MI355X kernel written in HIP

```python
import jax, jax.numpy as jnp
from jax import lax
import numpy as np

D_MODEL = 1024
BATCH = 4
SEQ = 4096
DEPTH = 1

N_MEM = 256
EPS = 1e-6
NEG = -1e30
ML_HEADS = 4
ML_DH = 128
ML_WIDTH = ML_HEADS * ML_DH
ML_CHUNK = 64
ML_CONV = 4
NSA_HEADS = 8
NSA_KV = 2
NSA_DH = 64
NSA_WIDTH = NSA_HEADS * NSA_DH
NSA_KV_WIDTH = NSA_KV * NSA_DH
CMP_LEN = 32
CMP_STRIDE = 16
CMP_HIDDEN = 256
SEL_LEN = 64
SEL_TOP = 16
WINDOW = 512
Q_BLOCK = 128
FORCE_BONUS = 1e3
XA_HEADS = 4
XA_DH = 128
XA_WIDTH = XA_HEADS * XA_DH
N_BRANCH = 3
BRANCH_WIDTH = 512
D_FF = 4 * D_MODEL
IN_SPLITS = (ML_WIDTH, ML_WIDTH, ML_WIDTH, ML_WIDTH, ML_HEADS, ML_HEADS,
             NSA_WIDTH, NSA_KV_WIDTH, NSA_KV_WIDTH, NSA_KV_WIDTH, NSA_KV_WIDTH, NSA_KV_WIDTH, NSA_KV_WIDTH,
             3 * NSA_HEADS, XA_WIDTH, N_BRANCH * D_MODEL)
D_IN = 4 * ML_WIDTH + 2 * ML_HEADS + NSA_WIDTH + 6 * NSA_KV_WIDTH + 3 * NSA_HEADS + XA_WIDTH + N_BRANCH * D_MODEL
ML_F_OFF = 4 * ML_WIDTH + ML_HEADS

kernel_name = 'hybrid_mlstm_nsa_memory_block'


def rmsnorm(x, g):
    xf = x.astype(jnp.float32)
    y = xf * lax.rsqrt(jnp.mean(xf * xf, axis=-1, keepdims=True) + EPS)
    return (y * g.astype(jnp.float32)).astype(x.dtype)


def alibi_slopes(n):
    return jnp.asarray(2.0 ** (-8.0 * np.arange(1, n + 1) / n), dtype=jnp.float32)


def causal_dwconv(x, w):
    K = w.shape[0]
    T = x.shape[1]
    xp = jnp.pad(x, ((0, 0), (K - 1, 0), (0, 0)))
    y = xp[:, K - 1:K - 1 + T] * w[0]
    for j in range(1, K):
        y = y + xp[:, K - 1 - j:K - 1 - j + T] * w[j]
    return y


def mlstm_chunkwise(q, k, v, i_pre, f_pre):
    f32 = jnp.float32
    B, T, H, Dh = q.shape
    L = ML_CHUNK
    NC = T // L
    def chunks(a):
        return a.astype(f32).reshape(B, NC, L, H, Dh).transpose(0, 3, 1, 2, 4)
    qc, kc, vc = chunks(q), chunks(k) * (Dh ** -0.5), chunks(v)
    li = i_pre.astype(f32).reshape(B, NC, L, H).transpose(0, 3, 1, 2)
    lf = jax.nn.log_sigmoid(f_pre.astype(f32)).reshape(B, NC, L, H).transpose(0, 3, 1, 2)
    b = jnp.cumsum(lf, axis=-1)
    g = b[..., -1]
    causal = np.tril(np.ones((L, L), dtype=bool))
    logD = jnp.where(causal, b[..., :, None] - b[..., None, :] + li[..., None, :], -jnp.inf)
    w_end = g[..., None] - b + li
    m_loc = jnp.max(w_end, axis=-1)
    e = jnp.exp(w_end - m_loc[..., None])
    A = jnp.einsum('bhcs,bhcsk,bhcsv->bhckv', e, kc, vc)
    nA = jnp.einsum('bhcs,bhcsk->bhck', e, kc)

    def step(carry, xs):
        C, n, m = carry
        g_c, m_c, A_c, nA_c = xs
        m_new = jnp.maximum(g_c + m, m_c)
        a = jnp.exp(g_c + m - m_new)
        bb = jnp.exp(m_c - m_new)
        C_new = a[..., None, None] * C + bb[..., None, None] * A_c
        n_new = a[..., None] * n + bb[..., None] * nA_c
        return (C_new, n_new, m_new), (C, n, m)

    init = (jnp.zeros((B, H, Dh, Dh), f32), jnp.zeros((B, H, Dh), f32), jnp.zeros((B, H), f32))
    xs = (jnp.moveaxis(g, 2, 0), jnp.moveaxis(m_loc, 2, 0), jnp.moveaxis(A, 2, 0), jnp.moveaxis(nA, 2, 0))
    _, (C_prev, n_prev, m_prev) = lax.scan(step, init, xs)
    C_prev = jnp.moveaxis(C_prev, 0, 2)
    n_prev = jnp.moveaxis(n_prev, 0, 2)
    m_prev = jnp.moveaxis(m_prev, 0, 2)
    inter_log = b + m_prev[..., None]
    m_t = jnp.maximum(inter_log, jnp.max(logD, axis=-1))
    S = jnp.einsum('bhctd,bhcsd->bhcts', qc, kc) * jnp.exp(logD - m_t[..., None])
    sc = jnp.exp(inter_log - m_t)
    num = jnp.einsum('bhcts,bhcsv->bhctv', S, vc) + sc[..., None] * jnp.einsum('bhctk,bhckv->bhctv', qc, C_prev)
    den = jnp.sum(S, axis=-1) + sc * jnp.einsum('bhctk,bhck->bhct', qc, n_prev)
    h = num / jnp.maximum(jnp.abs(den), jnp.exp(-m_t))[..., None]
    return h.transpose(0, 2, 3, 1, 4).reshape(B, T, H, Dh)


def compress_blocks(kv, pe, w1, w2):
    B, T, G, dh = kv.shape
    nb = (T - CMP_LEN) // CMP_STRIDE + 1
    idx = np.arange(nb)[:, None] * CMP_STRIDE + np.arange(CMP_LEN)[None, :]
    blk = kv[:, idx] + pe[:, None, :]
    blk = blk.transpose(0, 1, 3, 2, 4).reshape(B, nb, G, CMP_LEN * dh)
    return jax.nn.gelu(blk @ w1) @ w2


def nsa_attention(q, kc, vc, ks, vs, kw, vw, gates):
    f32 = jnp.float32
    B, T, H, dh = q.shape
    G = kc.shape[2]
    R = H // G
    nbc = kc.shape[1]
    nbs = T // SEL_LEN
    topn = min(SEL_TOP, nbs)
    scale = dh ** -0.5
    slopes = alibi_slopes(H).reshape(G, R)
    cmp_end = jnp.asarray(np.arange(nbc) * CMP_STRIDE + CMP_LEN - 1, jnp.int32)
    cs = np.arange(nbc) * CMP_STRIDE
    js = np.arange(nbs) * SEL_LEN
    overlap = jnp.asarray(((cs[:, None] < js[None, :] + SEL_LEN) & (cs[:, None] + CMP_LEN > js[None, :])).astype(np.float32))
    qg = q.astype(f32).reshape(B, T, G, R, dh)
    gg = gates.astype(f32).reshape(B, T, G, R, 3)
    kc = kc.astype(f32)
    vc = vc.astype(f32)
    ks_blk = ks.astype(f32).reshape(B, nbs, SEL_LEN, G, dh).transpose(0, 3, 1, 2, 4)
    vs_blk = vs.astype(f32).reshape(B, nbs, SEL_LEN, G, dh).transpose(0, 3, 1, 2, 4)
    kw_pad = jnp.pad(kw.astype(f32), ((0, 0), (WINDOW, 0), (0, 0), (0, 0)))
    vw_pad = jnp.pad(vw.astype(f32), ((0, 0), (WINDOW, 0), (0, 0), (0, 0)))
    b_ix = jnp.arange(B)[:, None, None, None]
    g_ix = jnp.arange(G)[None, None, :, None]
    blk_ids = jnp.arange(nbs)

    def one_block(c):
        t0 = c * Q_BLOCK
        qb = lax.dynamic_slice_in_dim(qg, t0, Q_BLOCK, axis=1) * scale
        gb = lax.dynamic_slice_in_dim(gg, t0, Q_BLOCK, axis=1)
        tpos = t0 + jnp.arange(Q_BLOCK)
        dist_c = tpos[:, None] - cmp_end[None, :]
        s_c = jnp.einsum('bqgrd,bngd->bqgrn', qb, kc) - slopes[:, :, None] * dist_c[:, None, None, :]
        ok_c = (dist_c >= 0)[:, None, None, :]
        p_c = jax.nn.softmax(jnp.where(ok_c, s_c, NEG), axis=-1) * ok_c
        o_c = jnp.einsum('bqgrn,bngd->bqgrd', p_c, vc)
        imp = jnp.einsum('bqgrn,nj->bqgj', p_c, overlap)
        cur = tpos // SEL_LEN
        sel_ok = (blk_ids[None, :] <= cur[:, None])[:, None, :]
        forced = ((blk_ids[None, :] == 0) | (blk_ids[None, :] == cur[:, None]) | (blk_ids[None, :] == cur[:, None] - 1))[:, None, :]
        score = jnp.where(sel_ok, imp + jnp.where(forced, FORCE_BONUS, 0.0), NEG)
        _, idx = lax.top_k(score, topn)
        k_sel = ks_blk[b_ix, g_ix, idx].reshape(B, Q_BLOCK, G, topn * SEL_LEN, dh)
        v_sel = vs_blk[b_ix, g_ix, idx].reshape(B, Q_BLOCK, G, topn * SEL_LEN, dh)
        kpos = (idx[..., None] * SEL_LEN + jnp.arange(SEL_LEN)).reshape(B, Q_BLOCK, G, topn * SEL_LEN)
        dist_s = tpos[None, :, None, None] - kpos
        s_s = jnp.einsum('bqgrd,bqgkd->bqgrk', qb, k_sel) - slopes[None, None, :, :, None] * dist_s[:, :, :, None, :]
        ok_s = (dist_s >= 0)[:, :, :, None, :]
        p_s = jax.nn.softmax(jnp.where(ok_s, s_s, NEG), axis=-1)
        o_s = jnp.einsum('bqgrk,bqgkd->bqgrd', p_s, v_sel)
        k_win = lax.dynamic_slice_in_dim(kw_pad, t0, Q_BLOCK + WINDOW, axis=1)
        v_win = lax.dynamic_slice_in_dim(vw_pad, t0, Q_BLOCK + WINDOW, axis=1)
        wpos = t0 - WINDOW + jnp.arange(Q_BLOCK + WINDOW)
        dist_w = tpos[:, None] - wpos[None, :]
        ok_w = ((dist_w >= 0) & (dist_w < WINDOW) & (wpos[None, :] >= 0))[:, None, None, :]
        s_w = jnp.einsum('bqgrd,bkgd->bqgrk', qb, k_win) - slopes[:, :, None] * dist_w[:, None, None, :]
        p_w = jax.nn.softmax(jnp.where(ok_w, s_w, NEG), axis=-1)
        o_w = jnp.einsum('bqgrk,bkgd->bqgrd', p_w, v_win)
        return gb[..., 0:1] * o_c + gb[..., 1:2] * o_s + gb[..., 2:3] * o_w

    out = lax.map(one_block, jnp.arange(T // Q_BLOCK))
    return jnp.moveaxis(out, 0, 1).reshape(B, T, H * dh)


def memory_cross_attention(q, mem_n, w_mem_kv):
    f32 = jnp.float32
    B, T, _ = q.shape
    M = mem_n.shape[1]
    kv = mem_n @ w_mem_kv
    mk, mv = jnp.split(kv, 2, axis=-1)
    qh = q.astype(f32).reshape(B, T, XA_HEADS, XA_DH) * (XA_DH ** -0.5)
    mk = mk.astype(f32).reshape(B, M, XA_HEADS, XA_DH)
    mv = mv.astype(f32).reshape(B, M, XA_HEADS, XA_DH)
    p = jax.nn.softmax(jnp.einsum('bthd,bmhd->bhtm', qh, mk), axis=-1)
    return jnp.einsum('bhtm,bmhd->bthd', p, mv).reshape(B, T, XA_WIDTH)


def hybrid_layer(h, mem, g_mix, w_in, b_in, ml_conv, ml_norm_g, cmp_pe, cmp_w1, cmp_w2,
                 g_mem, w_mem_kv, w_branch, w_out, g_ffn, w_ff1, w_ff2):
    f32 = jnp.float32
    B, T, _ = h.shape
    dt = h.dtype
    u = rmsnorm(h, g_mix)
    proj = u @ w_in + b_in
    splits = [int(s) for s in np.cumsum(IN_SPLITS)[:-1]]
    (ml_q, ml_k, ml_v, ml_o, ml_i, ml_f, ns_q, ns_kc, ns_vc, ns_ks, ns_vs, ns_kw, ns_vw,
     ns_g, xa_q, mg) = jnp.split(proj, splits, axis=-1)
    qk = jax.nn.silu(causal_dwconv(jnp.concatenate([ml_q, ml_k], axis=-1), ml_conv))
    mq, mk = jnp.split(qk, 2, axis=-1)
    hml = mlstm_chunkwise(mq.reshape(B, T, ML_HEADS, ML_DH), mk.reshape(B, T, ML_HEADS, ML_DH),
                          ml_v.reshape(B, T, ML_HEADS, ML_DH), ml_i, ml_f)
    hml = (hml * lax.rsqrt(jnp.mean(hml * hml, axis=-1, keepdims=True) + EPS)).reshape(B, T, ML_WIDTH)
    y_ml = (jax.nn.sigmoid(ml_o.astype(f32)) * hml * ml_norm_g.astype(f32)).astype(dt)
    kc = compress_blocks(ns_kc.reshape(B, T, NSA_KV, NSA_DH), cmp_pe[0], cmp_w1[0], cmp_w2[0])
    vc = compress_blocks(ns_vc.reshape(B, T, NSA_KV, NSA_DH), cmp_pe[1], cmp_w1[1], cmp_w2[1])
    y_nsa = nsa_attention(ns_q.reshape(B, T, NSA_HEADS, NSA_DH), kc, vc,
                          ns_ks.reshape(B, T, NSA_KV, NSA_DH), ns_vs.reshape(B, T, NSA_KV, NSA_DH),
                          ns_kw.reshape(B, T, NSA_KV, NSA_DH), ns_vw.reshape(B, T, NSA_KV, NSA_DH),
                          jax.nn.sigmoid(ns_g)).astype(dt)
    y_xa = memory_cross_attention(xa_q, rmsnorm(mem, g_mem), w_mem_kv).astype(dt)
    ys = jnp.stack([y_ml, y_nsa, y_xa], axis=2)
    ups = jnp.einsum('btjc,jcd->btjd', ys, w_branch)
    gates = jax.nn.sigmoid(mg.reshape(B, T, N_BRANCH, D_MODEL))
    merged = jnp.sum(gates * ups, axis=2)
    h = h + merged @ w_out
    a = rmsnorm(h, g_ffn) @ w_ff1
    return h + jnp.square(jax.nn.relu(a)) @ w_ff2


def setup_inputs(seed: int = 0) -> dict:
    key = jax.random.key(seed)
    ks = jax.random.split(key, 20)
    f32 = jnp.float32

    def nrm(k, shape, scale):
        return jax.random.normal(k, shape, f32) * scale

    def gain(k, n):
        return 1.0 + 0.02 * jax.random.normal(k, (DEPTH, n), f32)

    b_in = nrm(ks[4], (DEPTH, D_IN), 0.01)
    b_in = b_in.at[:, ML_F_OFF:ML_F_OFF + ML_HEADS].add(jnp.linspace(3.0, 6.0, ML_HEADS, dtype=f32))
    return {
        'x': nrm(ks[0], (BATCH, SEQ, D_MODEL), 1.0),
        'mem': nrm(ks[1], (BATCH, N_MEM, D_MODEL), 1.0),
        'g_mix': gain(ks[2], D_MODEL),
        'w_in': nrm(ks[3], (DEPTH, D_MODEL, D_IN), D_MODEL ** -0.5),
        'b_in': b_in,
        'ml_conv': nrm(ks[5], (DEPTH, ML_CONV, 2 * ML_WIDTH), ML_CONV ** -0.5),
        'ml_norm_g': gain(ks[6], ML_WIDTH),
        'cmp_pe': nrm(ks[7], (DEPTH, 2, CMP_LEN, NSA_DH), 0.1),
        'cmp_w1': nrm(ks[8], (DEPTH, 2, CMP_LEN * NSA_DH, CMP_HIDDEN), (CMP_LEN * NSA_DH) ** -0.5),
        'cmp_w2': nrm(ks[9], (DEPTH, 2, CMP_HIDDEN, NSA_DH), CMP_HIDDEN ** -0.5),
        'g_mem': gain(ks[10], D_MODEL),
        'w_mem_kv': nrm(ks[11], (DEPTH, D_MODEL, 2 * XA_WIDTH), D_MODEL ** -0.5),
        'w_branch': nrm(ks[12], (DEPTH, N_BRANCH, BRANCH_WIDTH, D_MODEL), BRANCH_WIDTH ** -0.5),
        'w_out': nrm(ks[13], (DEPTH, D_MODEL, D_MODEL), D_MODEL ** -0.5),
        'g_ffn': gain(ks[14], D_MODEL),
        'w_ff1': nrm(ks[15], (DEPTH, D_MODEL, D_FF), D_MODEL ** -0.5),
        'w_ff2': nrm(ks[16], (DEPTH, D_FF, D_MODEL), D_FF ** -0.5),
        'g_final': 1.0 + 0.02 * jax.random.normal(ks[17], (D_MODEL,), f32),
    }


def reference(x, mem, g_mix, w_in, b_in, ml_conv, ml_norm_g, cmp_pe, cmp_w1, cmp_w2,
              g_mem, w_mem_kv, w_branch, w_out, g_ffn, w_ff1, w_ff2, g_final):
    h = x
    for l in range(DEPTH):
        h = hybrid_layer(h, mem, g_mix[l], w_in[l], b_in[l], ml_conv[l], ml_norm_g[l], cmp_pe[l],
                         cmp_w1[l], cmp_w2[l], g_mem[l], w_mem_kv[l], w_branch[l], w_out[l],
                         g_ffn[l], w_ff1[l], w_ff2[l])
    return rmsnorm(h, g_final)
```

```cpp
#include <hip/hip_runtime.h>
#include <stdint.h>

typedef unsigned short bf16_t;
__device__ __forceinline__ float bf2f(bf16_t v) { return __uint_as_float(((unsigned)v) << 16); }
__device__ __forceinline__ bf16_t f2bf(float f) { unsigned u = __float_as_uint(f); return (bf16_t)((u + 0x7fffu + ((u >> 16) & 1u)) >> 16); }

constexpr int NB = 4, T = 4096, M = NB * T, D = 1024, DIN = 6944, FF = 4096;
constexpr float EPS = 1e-6f;
constexpr int C_MLI = 2048, C_NSG = 3336, C_MG = 3872;
constexpr int P_MLQ = 0, P_MLK = 512, P_MLV = 1024, P_MLO = 1536, P_NSQ = 2048, P_KC = 2560, P_VC = 2688, P_KS = 2816, P_VS = 2944, P_KW = 3072, P_VW = 3200, P_XAQ = 3328, PW = 3840;
constexpr size_t MiB = 1u << 20;
constexpr size_t WS_QKC = 1 * MiB;
constexpr size_t WS_U = 40 * MiB;
constexpr size_t WS_P = 72 * MiB;
constexpr size_t WS_Y = 192 * MiB;
constexpr size_t WS_AFFN = 200 * MiB;
constexpr size_t WS_S32 = 240 * MiB;
constexpr size_t WS_MEMN = 242 * MiB;
constexpr size_t WS_MEMKV = 244 * MiB;
constexpr size_t WS_KC = 246 * MiB;
constexpr size_t WS_VC = 246 * MiB + 512 * 1024;
constexpr size_t WS_NA = 247 * MiB;
constexpr size_t WS_G = 248 * MiB;
constexpr size_t WS_MLOC = 248 * MiB + 4096;
constexpr size_t WS_MPREV = 248 * MiB + 8192;

__device__ __forceinline__ float wave_sum(float v) {
#pragma unroll
    for (int o = 1; o < 64; o <<= 1) v += __shfl_xor(v, o);
    return v;
}
__device__ __forceinline__ float wave_max(float v) {
#pragma unroll
    for (int o = 1; o < 64; o <<= 1) v = fmaxf(v, __shfl_xor(v, o));
    return v;
}

template <bool OUT_BF16>
__global__ void __launch_bounds__(256) rms_rows(const float* x, const float* g, void* out) {
    __shared__ float red[4];
    const int row = blockIdx.x, tid = threadIdx.x;
    const float4 v = ((const float4*)(x + (size_t)row * D))[tid];
    float s = v.x * v.x + v.y * v.y + v.z * v.z + v.w * v.w;
    s = wave_sum(s);
    if ((tid & 63) == 0) red[tid >> 6] = s;
    __syncthreads();
    const float tot = red[0] + red[1] + red[2] + red[3];
    const float r = rsqrtf(tot * (1.0f / D) + EPS);
    const float4 gg = ((const float4*)g)[tid];
    float4 o; o.x = v.x * r * gg.x; o.y = v.y * r * gg.y; o.z = v.z * r * gg.z; o.w = v.w * r * gg.w;
    if (OUT_BF16) { bf16_t* ob = (bf16_t*)out + (size_t)row * D + tid * 4; ob[0] = f2bf(o.x); ob[1] = f2bf(o.y); ob[2] = f2bf(o.z); ob[3] = f2bf(o.w); }
    else ((float4*)((float*)out + (size_t)row * D))[tid] = o;
}

struct GArgs { const bf16_t* A; const float* W; int lda, ldw, N, K; };
template <class Epi>
__global__ void __launch_bounds__(256) ngemm(GArgs ga, Epi epi) {
    const bf16_t* A = ga.A; const float* W = ga.W; const int lda = ga.lda, ldw = ga.ldw, N = ga.N, K = ga.K;
    __shared__ float As[16][65], Bs[16][65];
    const int tid = threadIdx.x, tx = tid & 15, ty = tid >> 4;
    const int m0 = blockIdx.y * 64, n0 = blockIdx.x * 64;
    float acc[4][4];
#pragma unroll
    for (int i = 0; i < 4; ++i)
#pragma unroll
        for (int j = 0; j < 4; ++j) acc[i][j] = 0.f;
    for (int k0 = 0; k0 < K; k0 += 16) {
#pragma unroll
        for (int i = 0; i < 4; ++i) { const int idx = tid + i * 256, r = idx >> 4, kk = idx & 15; As[kk][r] = bf2f(A[(size_t)(m0 + r) * lda + k0 + kk]); }
#pragma unroll
        for (int i = 0; i < 4; ++i) { const int idx = tid + i * 256, kk = idx >> 6, n = idx & 63; Bs[kk][n] = (n0 + n < N) ? W[(size_t)(k0 + kk) * ldw + n0 + n] : 0.f; }
        __syncthreads();
#pragma unroll
        for (int kk = 0; kk < 16; ++kk) {
            float a[4], b[4];
#pragma unroll
            for (int i = 0; i < 4; ++i) { a[i] = As[kk][ty * 4 + i]; b[i] = Bs[kk][tx * 4 + i]; }
#pragma unroll
            for (int i = 0; i < 4; ++i)
#pragma unroll
                for (int j = 0; j < 4; ++j) acc[i][j] += a[i] * b[j];
        }
        __syncthreads();
    }
#pragma unroll
    for (int i = 0; i < 4; ++i)
#pragma unroll
        for (int j = 0; j < 4; ++j) { const int n = n0 + tx * 4 + j; if (n < N) epi(m0 + ty * 4 + i, n, acc[i][j]); }
}
struct EpiBiasBf16 { bf16_t* O; const float* bias; int ldo, pad; __device__ void operator()(int m, int n, float a) const { O[(size_t)m * ldo + n] = f2bf(a + (bias ? bias[n] : 0.f)); } };
struct EpiBiasF32 { float* O; const float* bias; int ldo, pad; __device__ void operator()(int m, int n, float a) const { O[(size_t)m * ldo + n] = a + bias[n]; } };
struct EpiSigBf16 { bf16_t* O; const float* bias; int ldo, pad; __device__ void operator()(int m, int n, float a) const { const float v = a + bias[n]; O[(size_t)m * ldo + n] = f2bf(1.f / (1.f + __expf(-v))); } };
struct EpiMerge { const bf16_t* G; float* Mf; bf16_t* Mb; int j, pad; __device__ void operator()(int m, int n, float a) const {
    const float g = bf2f(G[(size_t)m * 3072 + j * 1024 + n]); float v = g * a; if (j > 0) v += Mf[(size_t)m * D + n];
    if (j < 2) Mf[(size_t)m * D + n] = v; else Mb[(size_t)m * D + n] = f2bf(v); } };
struct EpiResid { const float* X; float* O; __device__ void operator()(int m, int n, float a) const { O[(size_t)m * D + n] = X[(size_t)m * D + n] + a; } };
struct EpiRelu2 { bf16_t* O; __device__ void operator()(int m, int n, float a) const { const float r = fmaxf(a, 0.f); O[(size_t)m * FF + n] = f2bf(r * r); } };

__global__ void __launch_bounds__(256) conv_qk(const bf16_t* P, const float* w  , bf16_t* QKc) {
    const size_t i = (size_t)blockIdx.x * 256 + threadIdx.x;
    const int m = (int)(i >> 10), ch = (int)(i & 1023), t = m % T;
    float y = 0.f;
#pragma unroll
    for (int j = 0; j < 4; ++j) if (t - j >= 0) y += w[j * 1024 + ch] * bf2f(P[(size_t)(m - j) * PW + ch]);
    QKc[i] = f2bf(y / (1.f + __expf(-y)));
}
__device__ __forceinline__ float logsig(float x) { return fminf(x, 0.f) - log1pf(__expf(-fabsf(x))); }
__global__ void __launch_bounds__(256) m1_naive(const bf16_t* P, const bf16_t* QKc, const float* S32, float* Abuf, float* NA, float* Gc, float* Mloc) {
    __shared__ float kk[64][128]; __shared__ float e[64]; __shared__ float bc[64];
    const int ci = blockIdx.x, c = ci & 63, bh = ci >> 6, h = bh & 3, b = bh >> 2, tid = threadIdx.x;
    const int m0 = b * T + c * 64;
    if (tid == 0) {
        float run = 0.f;
        for (int s = 0; s < 64; ++s) { run += logsig(S32[(size_t)(m0 + s) * 32 + 4 + h]); bc[s] = run; }
        const float g = run; float mx = -INFINITY;
        for (int s = 0; s < 64; ++s) { const float w = g - bc[s] + S32[(size_t)(m0 + s) * 32 + h]; e[s] = w; mx = fmaxf(mx, w); }
        for (int s = 0; s < 64; ++s) e[s] = __expf(e[s] - mx);
        Gc[ci] = g; Mloc[ci] = mx;
    }
    for (int i = tid; i < 64 * 128; i += 256) { const int s = i >> 7, k = i & 127; kk[s][k] = bf2f(QKc[(size_t)(m0 + s) * 1024 + 512 + h * 128 + k]) * 0.08838834764831845f; }
    __syncthreads();
    const int v = tid & 127, kh = tid >> 7;
    float acc[64];
#pragma unroll
    for (int i = 0; i < 64; ++i) acc[i] = 0.f;
    for (int s = 0; s < 64; ++s) {
        const float ev = e[s] * bf2f(P[(size_t)(m0 + s) * PW + P_MLV + h * 128 + v]);
#pragma unroll
        for (int i = 0; i < 64; ++i) acc[i] += kk[s][kh * 64 + i] * ev;
    }
#pragma unroll
    for (int i = 0; i < 64; ++i) Abuf[((size_t)ci * 128 + kh * 64 + i) * 128 + v] = acc[i];
    if (tid < 128) { float n = 0.f; for (int s = 0; s < 64; ++s) n += e[s] * kk[s][tid]; NA[(size_t)ci * 128 + tid] = n; }
}
__global__ void __launch_bounds__(256) m2_naive(float* Abuf, float* NA, const float* Gc, const float* Mloc, float* Mprev) {
    const int i = blockIdx.x * 256 + threadIdx.x;
    const int bh = i >> 14, kv = i & 16383, k = kv >> 7, v = kv & 127;
    float C = 0.f, n = 0.f, m = 0.f;
    for (int c = 0; c < 64; ++c) {
        const int ci = bh * 64 + c;
        const float g = Gc[ci], ml = Mloc[ci];
        const float mn = fmaxf(g + m, ml), a = __expf(g + m - mn), bb = __expf(ml - mn);
        const size_t idx = ((size_t)ci * 128 + k) * 128 + v;
        const float A = Abuf[idx]; Abuf[idx] = C; C = a * C + bb * A;
        if (v == 0) { const float nA = NA[(size_t)ci * 128 + k]; NA[(size_t)ci * 128 + k] = n; n = a * n + bb * nA; }
        if (kv == 0) Mprev[ci] = m;
        m = mn;
    }
}
__global__ void __launch_bounds__(128) m3_naive(const bf16_t* P, const bf16_t* QKc, const float* S32, const float* Cprev, const float* Nprev, const float* Mprev,
                                                const float* normg, bf16_t* Yml) {
    __shared__ float q[128], Srow[64], bc[64], li[64], sh[8];
    const int ci = blockIdx.x >> 6, tt = blockIdx.x & 63, c = ci & 63, bh = ci >> 6, h = bh & 3, b = bh >> 2, tid = threadIdx.x;
    const int m0 = b * T + c * 64, m = m0 + tt;
    q[tid] = bf2f(QKc[(size_t)m * 1024 + h * 128 + tid]);
    if (tid == 0) { float run = 0.f; for (int s = 0; s <= tt; ++s) { run += logsig(S32[(size_t)(m0 + s) * 32 + 4 + h]); bc[s] = run; li[s] = S32[(size_t)(m0 + s) * 32 + h]; } }
    __syncthreads();
    const float mprev = Mprev[ci], inter = bc[tt] + mprev;
    float mt = inter;
    for (int s = 0; s <= tt; ++s) mt = fmaxf(mt, bc[tt] - bc[s] + li[s]);
    if (tid < 64) {
        float sv = 0.f;
        if (tid <= tt) { float dot = 0.f; const bf16_t* kr = QKc + (size_t)(m0 + tid) * 1024 + 512 + h * 128; for (int k = 0; k < 128; ++k) dot += q[k] * bf2f(kr[k]);
            sv = dot * 0.08838834764831845f * __expf(bc[tt] - bc[tid] + li[tid] - mt); }
        Srow[tid] = sv;
    }
    __syncthreads();
    const float sc = __expf(inter - mt);
    float num = 0.f, den = 0.f;
    for (int s = 0; s <= tt; ++s) { num += Srow[s] * bf2f(P[(size_t)(m0 + s) * PW + P_MLV + h * 128 + tid]); den += Srow[s]; }
    float qc = 0.f, qn = 0.f;
    for (int k = 0; k < 128; ++k) { qc += q[k] * Cprev[((size_t)ci * 128 + k) * 128 + tid]; qn += q[k] * Nprev[(size_t)ci * 128 + k]; }
    num += sc * qc; den += sc * qn;
    const float hv = num / fmaxf(fabsf(den), __expf(-mt));
    float ss = wave_sum(hv * hv);
    if ((tid & 63) == 0) sh[tid >> 6] = ss;
    __syncthreads();
    const float r = rsqrtf((sh[0] + sh[1]) * (1.f / 128.f) + EPS);
    const float o = bf2f(P[(size_t)m * PW + P_MLO + h * 128 + tid]);
    Yml[(size_t)m * 512 + h * 128 + tid] = f2bf(1.f / (1.f + __expf(-o)) * hv * r * normg[h * 128 + tid]);
}

__device__ __forceinline__ float gelu_tanh(float x) { const float u = 0.7978845608028654f * (x + 0.044715f * x * x * x); return 0.5f * x * (1.f + tanhf(u)); }
__global__ void __launch_bounds__(256) n1_naive(const bf16_t* P, const float* pe  , const float* w1  , const float* w2  , bf16_t* KC, bf16_t* VC) {
    __shared__ float xin[2048]; __shared__ float hid[256];
    int idx = blockIdx.x; const int g = idx & 1; idx >>= 1; const int n = idx % 255; idx /= 255; const int b = idx & 3, kv = idx >> 2, tid = threadIdx.x;
    const int pcol = (kv ? P_VC : P_KC) + g * 64;
    for (int i = tid; i < 2048; i += 256) { const int l = i >> 6, d = i & 63; xin[i] = bf2f(P[(size_t)(b * T + n * 16 + l) * PW + pcol + d]) + pe[kv * 2048 + i]; }
    __syncthreads();
    float a = 0.f; const float* w = w1 + (size_t)kv * 2048 * 256 + tid;
    for (int i = 0; i < 2048; ++i) a += xin[i] * w[(size_t)i * 256];
    hid[tid] = gelu_tanh(a);
    __syncthreads();
    if (tid < 64) { float o = 0.f; const float* ww = w2 + (size_t)kv * 256 * 64 + tid; for (int j = 0; j < 256; ++j) o += hid[j] * ww[j * 64];
        (kv ? VC : KC)[((size_t)(b * 256 + n) * 2 + g) * 64 + tid] = f2bf(o); }
}
__global__ void __launch_bounds__(256) n2_naive(const bf16_t* P, const float* S32, const bf16_t* KC, const bf16_t* VC, bf16_t* Ynsa) {
    __shared__ float q_s[4][64]; __shared__ float sc[4][1024]; __shared__ float pc[4][256]; __shared__ float imp_s[64]; __shared__ unsigned long long selmask;
    const int g = blockIdx.x & 1, m = blockIdx.x >> 1, b = m / T, t = m % T, tid = threadIdx.x, r = tid >> 6, lane = tid & 63, h = g * 4 + r;
    const float slope = exp2f(-(float)(h + 1));
    q_s[r][lane] = bf2f(P[(size_t)m * PW + P_NSQ + h * 64 + lane]) * 0.125f;
    __syncthreads();
    float sv[4]; float mx = -INFINITY;
#pragma unroll
    for (int i = 0; i < 4; ++i) { const int n = lane + 64 * i; sv[i] = -INFINITY;
        if (n < 255) { const int dist = t - (16 * n + 31); if (dist >= 0) { const bf16_t* kr = KC + ((size_t)(b * 256 + n) * 2 + g) * 64; float dot = 0.f; for (int d = 0; d < 64; ++d) dot += q_s[r][d] * bf2f(kr[d]);
            sv[i] = dot - slope * (float)dist; mx = fmaxf(mx, sv[i]); } } }
    mx = wave_max(mx);
    float sum = 0.f;
#pragma unroll
    for (int i = 0; i < 4; ++i) { sv[i] = (sv[i] == -INFINITY) ? 0.f : __expf(sv[i] - mx); sum += sv[i]; }
    sum = wave_sum(sum);
    const float inv = sum > 0.f ? 1.f / sum : 0.f;
#pragma unroll
    for (int i = 0; i < 4; ++i) pc[r][lane + 64 * i] = sv[i] * inv;
    __syncthreads();
    float oc = 0.f;
    { const int nmax = (t >= 31) ? ((t - 31) / 16) : -1; for (int n = 0; n <= nmax && n < 255; ++n) oc += pc[r][n] * bf2f(VC[((size_t)(b * 256 + n) * 2 + g) * 64 + lane]); }
    if (tid < 64) { const int j = tid; float im = 0.f;
        for (int n = 4 * j - 1; n <= 4 * j + 3; ++n) if (n >= 0 && n < 255) im += (pc[0][n] + pc[1][n]) + (pc[2][n] + pc[3][n]);
        const int cur = t >> 6; const bool valid = j <= cur, forced = (j == 0) || (j == cur) || (j == cur - 1);
        const float s = valid ? im + (forced ? 1000.f : 0.f) : -1e30f;
        imp_s[j] = s; }
    __syncthreads();
    if (tid < 64) { const int j = tid; const float s = imp_s[j]; int rank = 0;
        for (int jj = 0; jj < 64; ++jj) { const float o = imp_s[jj]; rank += (o > s || (o == s && jj < j)) ? 1 : 0; }
        const unsigned long long mk = __ballot(rank < 16 && j <= (t >> 6)); if (tid == 0) selmask = mk; }
    __syncthreads();
    float osel = 0.f;
    { unsigned long long mk = selmask; int slot = 0; float mxs = -INFINITY;
      while (mk) { const int jb = __ffsll((long long)mk) - 1; mk &= mk - 1; const int pos = jb * 64 + lane; float s = -INFINITY;
          if (pos <= t) { const bf16_t* kr = P + (size_t)(b * T + pos) * PW + P_KS + g * 64; float dot = 0.f; for (int d = 0; d < 64; ++d) dot += q_s[r][d] * bf2f(kr[d]); s = dot - slope * (float)(t - pos); }
          sc[r][slot * 64 + lane] = s; mxs = fmaxf(mxs, s); ++slot; }
      mxs = wave_max(mxs); float sm = 0.f;
      for (int i = 0; i < slot; ++i) { const float s = sc[r][i * 64 + lane]; const float p = (s == -INFINITY) ? 0.f : __expf(s - mxs); sc[r][i * 64 + lane] = p; sm += p; }
      sm = wave_sum(sm);
      mk = selmask; slot = 0;
      while (mk) { const int jb = __ffsll((long long)mk) - 1; mk &= mk - 1;
          for (int i = 0; i < 64; ++i) { const int pos = jb * 64 + i; if (pos > t) break; osel += sc[r][slot * 64 + i] * bf2f(P[(size_t)(b * T + pos) * PW + P_VS + g * 64 + lane]); }
          ++slot; }
      osel /= sm; }
    __syncthreads();
    float owin = 0.f;
    { float mxs = -INFINITY;
      for (int i = 0; i < 8; ++i) { const int pos = t - 511 + i * 64 + lane; float s = -INFINITY;
          if (pos >= 0) { const bf16_t* kr = P + (size_t)(b * T + pos) * PW + P_KW + g * 64; float dot = 0.f; for (int d = 0; d < 64; ++d) dot += q_s[r][d] * bf2f(kr[d]); s = dot - slope * (float)(t - pos); }
          sc[r][i * 64 + lane] = s; mxs = fmaxf(mxs, s); }
      mxs = wave_max(mxs); float sm = 0.f;
      for (int i = 0; i < 8; ++i) { const float s = sc[r][i * 64 + lane]; const float p = (s == -INFINITY) ? 0.f : __expf(s - mxs); sc[r][i * 64 + lane] = p; sm += p; }
      sm = wave_sum(sm);
      for (int i = 0; i < 512; ++i) { const int pos = t - 511 + i; if (pos < 0) continue; owin += sc[r][i] * bf2f(P[(size_t)(b * T + pos) * PW + P_VW + g * 64 + lane]); }
      owin /= sm; }
    const float* gp = S32 + (size_t)m * 32 + 8 + h * 3;
    const float g0 = 1.f / (1.f + __expf(-gp[0])), g1 = 1.f / (1.f + __expf(-gp[1])), g2 = 1.f / (1.f + __expf(-gp[2]));
    Ynsa[(size_t)m * 512 + h * 64 + lane] = f2bf(g0 * oc + g1 * osel + g2 * owin);
}
__global__ void __launch_bounds__(256) x1_naive(const bf16_t* P, const bf16_t* MEMKV, bf16_t* Yxa) {
    __shared__ float q_s[4][128]; __shared__ float p_s[4][256];
    const int m = blockIdx.x, b = m / T, tid = threadIdx.x, h = tid >> 6, lane = tid & 63;
    q_s[h][lane] = bf2f(P[(size_t)m * PW + P_XAQ + h * 128 + lane]) * 0.08838834764831845f;
    q_s[h][lane + 64] = bf2f(P[(size_t)m * PW + P_XAQ + h * 128 + lane + 64]) * 0.08838834764831845f;
    __syncthreads();
    float sv[4]; float mx = -INFINITY;
#pragma unroll
    for (int i = 0; i < 4; ++i) { const int j = lane + 64 * i; const bf16_t* kr = MEMKV + (size_t)(b * 256 + j) * 1024 + h * 128; float dot = 0.f; for (int d = 0; d < 128; ++d) dot += q_s[h][d] * bf2f(kr[d]); sv[i] = dot; mx = fmaxf(mx, dot); }
    mx = wave_max(mx); float sm = 0.f;
#pragma unroll
    for (int i = 0; i < 4; ++i) { sv[i] = __expf(sv[i] - mx); sm += sv[i]; }
    sm = wave_sum(sm);
#pragma unroll
    for (int i = 0; i < 4; ++i) p_s[h][lane + 64 * i] = sv[i] / sm;
    __syncthreads();
    float o0 = 0.f, o1 = 0.f;
    for (int j = 0; j < 256; ++j) { const bf16_t* vr = MEMKV + (size_t)(b * 256 + j) * 1024 + 512 + h * 128; const float p = p_s[h][j]; o0 += p * bf2f(vr[lane]); o1 += p * bf2f(vr[lane + 64]); }
    Yxa[(size_t)m * 512 + h * 128 + lane] = f2bf(o0); Yxa[(size_t)m * 512 + h * 128 + lane + 64] = f2bf(o1);
}

extern "C" void kernel_launch(void* const* d_in, const int* in_sizes, int n_in, void* d_out, int out_size, void* d_ws, size_t ws_size, hipStream_t stream) {
    const float* x = (const float*)d_in[0]; const float* mem = (const float*)d_in[1]; const float* g_mix = (const float*)d_in[2]; const float* w_in = (const float*)d_in[3];
    const float* b_in = (const float*)d_in[4]; const float* ml_conv = (const float*)d_in[5]; const float* ml_norm_g = (const float*)d_in[6]; const float* cmp_pe = (const float*)d_in[7];
    const float* cmp_w1 = (const float*)d_in[8]; const float* cmp_w2 = (const float*)d_in[9]; const float* g_mem = (const float*)d_in[10]; const float* w_mem_kv = (const float*)d_in[11];
    const float* w_branch = (const float*)d_in[12]; const float* w_out = (const float*)d_in[13]; const float* g_ffn = (const float*)d_in[14]; const float* w_ff1 = (const float*)d_in[15];
    const float* w_ff2 = (const float*)d_in[16]; const float* g_final = (const float*)d_in[17];
    char* ws = (char*)d_ws; float* out = (float*)d_out;
    bf16_t* U = (bf16_t*)(ws + WS_U); bf16_t* P = (bf16_t*)(ws + WS_P); bf16_t* QKc = (bf16_t*)(ws + WS_QKC);
    bf16_t* Yml = (bf16_t*)(ws + WS_Y); bf16_t* Ynsa = Yml + (size_t)M * 512; bf16_t* Yxa = Ynsa + (size_t)M * 512;
    float* S32 = (float*)(ws + WS_S32); bf16_t* MEMN = (bf16_t*)(ws + WS_MEMN); bf16_t* MEMKV = (bf16_t*)(ws + WS_MEMKV);
    bf16_t* KC = (bf16_t*)(ws + WS_KC); bf16_t* VC = (bf16_t*)(ws + WS_VC);
    float* NA = (float*)(ws + WS_NA); float* Gc = (float*)(ws + WS_G); float* Mloc = (float*)(ws + WS_MLOC); float* Mprev = (float*)(ws + WS_MPREV);
    float* Abuf = out;
    bf16_t* GATES = P; bf16_t* MERGED = U; bf16_t* AFFN = (bf16_t*)(ws + WS_AFFN); bf16_t* HBUF = P;

    rms_rows<true><<<M, 256, 0, stream>>>(x, g_mix, U);
    rms_rows<true><<<1024, 256, 0, stream>>>(mem, g_mem, MEMN);
    ngemm<<<dim3(2048 / 64, M / 64), 256, 0, stream>>>(GArgs{U, w_in + 0, D, DIN, 2048, D}, EpiBiasBf16{P + 0, b_in + 0, PW, 0});
    ngemm<<<dim3(1280 / 64, M / 64), 256, 0, stream>>>(GArgs{U, w_in + 2056, D, DIN, 1280, D}, EpiBiasBf16{P + 2048, b_in + 2056, PW, 0});
    ngemm<<<dim3(512 / 64, M / 64), 256, 0, stream>>>(GArgs{U, w_in + 3360, D, DIN, 512, D}, EpiBiasBf16{P + 3328, b_in + 3360, PW, 0});
    ngemm<<<dim3(1, M / 64), 256, 0, stream>>>(GArgs{U, w_in + C_MLI, D, DIN, 8, D}, EpiBiasF32{S32, b_in + C_MLI, 32, 0});
    ngemm<<<dim3(1, M / 64), 256, 0, stream>>>(GArgs{U, w_in + C_NSG, D, DIN, 24, D}, EpiBiasF32{S32 + 8, b_in + C_NSG, 32, 0});
    ngemm<<<dim3(1024 / 64, 1024 / 64), 256, 0, stream>>>(GArgs{MEMN, w_mem_kv, D, 1024, 1024, D}, EpiBiasBf16{MEMKV, nullptr, 1024, 0});
    conv_qk<<<(unsigned)((size_t)M * 1024 / 256), 256, 0, stream>>>(P, ml_conv, QKc);
    m1_naive<<<1024, 256, 0, stream>>>(P, QKc, S32, Abuf, NA, Gc, Mloc);
    m2_naive<<<16 * 128 * 128 / 256, 256, 0, stream>>>(Abuf, NA, Gc, Mloc, Mprev);
    m3_naive<<<1024 * 64, 128, 0, stream>>>(P, QKc, S32, Abuf, NA, Mprev, ml_norm_g, Yml);
    n1_naive<<<2 * 4 * 255 * 2, 256, 0, stream>>>(P, cmp_pe, cmp_w1, cmp_w2, KC, VC);
    n2_naive<<<M * 2, 256, 0, stream>>>(P, S32, KC, VC, Ynsa);
    x1_naive<<<M, 256, 0, stream>>>(P, MEMKV, Yxa);
    ngemm<<<dim3(3072 / 64, M / 64), 256, 0, stream>>>(GArgs{U, w_in + C_MG, D, DIN, 3072, D}, EpiSigBf16{GATES, b_in + C_MG, 3072, 0});
    for (int j = 0; j < 3; ++j)
        ngemm<<<dim3(1024 / 64, M / 64), 256, 0, stream>>>(GArgs{Yml + (size_t)j * M * 512, w_branch + (size_t)j * 512 * 1024, 512, 1024, 1024, 512}, EpiMerge{GATES, out, MERGED, j, 0});
    ngemm<<<dim3(1024 / 64, M / 64), 256, 0, stream>>>(GArgs{MERGED, w_out, D, 1024, 1024, D}, EpiResid{x, out});
    rms_rows<true><<<M, 256, 0, stream>>>(out, g_ffn, AFFN);
    ngemm<<<dim3(FF / 64, M / 64), 256, 0, stream>>>(GArgs{AFFN, w_ff1, D, FF, FF, D}, EpiRelu2{HBUF});
    ngemm<<<dim3(1024 / 64, M / 64), 256, 0, stream>>>(GArgs{HBUF, w_ff2, FF, 1024, 1024, FF}, EpiResid{out, out});
    rms_rows<false><<<M, 256, 0, stream>>>(out, g_final, out);
}
```

```cpp
#include <hip/hip_runtime.h>
#include <hip/hip_cooperative_groups.h>
#include <cstdio>
namespace cg = cooperative_groups;
#include <stdint.h>

typedef unsigned short bf16_t;
struct VB { int id; int tid; char* sm; };
__device__ __forceinline__ float bf2f(bf16_t v) { return __uint_as_float(((unsigned)v) << 16); }
__device__ __forceinline__ bf16_t f2bf(float f) { unsigned u = __float_as_uint(f); return (bf16_t)((u + 0x7fffu + ((u >> 16) & 1u)) >> 16); }

constexpr int NB = 4, T = 4096, M = NB * T, D = 1024, DIN = 6944, FF = 4096;
constexpr float EPS = 1e-6f;
constexpr int C_MLI = 2048, C_NSG = 3336, C_MG = 3872;
constexpr int P_MLQ = 0, P_MLK = 512, P_MLV = 1024, P_MLO = 1536, P_NSQ = 2048, P_KC = 2560, P_VC = 2688, P_KS = 2816, P_VS = 2944, P_KW = 3072, P_VW = 3200, P_XAQ = 3328, PW = 3840;
constexpr size_t MiB = 1u << 20;
constexpr size_t WS_U = 40 * MiB;
constexpr size_t WS_P = 72 * MiB;
constexpr size_t WS_Y = 192 * MiB;
constexpr size_t WS_AFFN = 200 * MiB;
constexpr size_t WS_S32 = 240 * MiB;
constexpr size_t WS_MEMN = 242 * MiB;
constexpr size_t WS_MEMKV = 244 * MiB;
constexpr size_t WS_KC = 246 * MiB;
constexpr size_t WS_VC = 246 * MiB + 512 * 1024;
constexpr size_t WS_NA = 247 * MiB;
constexpr size_t WS_G = 248 * MiB;
constexpr size_t WS_MLOC = 248 * MiB + 4096;
constexpr size_t WS_MPREV = 248 * MiB + 8192;

__device__ __forceinline__ float wave_sum(float v) {
#pragma unroll
    for (int o = 1; o < 64; o <<= 1) v += __shfl_xor(v, o);
    return v;
}
__device__ __forceinline__ float wave_max(float v) {
#pragma unroll
    for (int o = 1; o < 64; o <<= 1) v = fmaxf(v, __shfl_xor(v, o));
    return v;
}

template <bool OUT_BF16>
__device__ __forceinline__ void rms_rows(VB vb, const float* x, const float* g, void* out) {
    float* red = (float*)vb.sm;
    const int row = vb.id, tid = vb.tid;
    const float4 v = ((const float4*)(x + (size_t)row * D))[tid];
    float s = v.x * v.x + v.y * v.y + v.z * v.z + v.w * v.w;
    s = wave_sum(s);
    if ((tid & 63) == 0) red[tid >> 6] = s;
    __syncthreads();
    const float tot = red[0] + red[1] + red[2] + red[3];
    const float r = rsqrtf(tot * (1.0f / D) + EPS);
    const float4 gg = ((const float4*)g)[tid];
    float4 o; o.x = v.x * r * gg.x; o.y = v.y * r * gg.y; o.z = v.z * r * gg.z; o.w = v.w * r * gg.w;
    if (OUT_BF16) { bf16_t* ob = (bf16_t*)out + (size_t)row * D + tid * 4; ob[0] = f2bf(o.x); ob[1] = f2bf(o.y); ob[2] = f2bf(o.z); ob[3] = f2bf(o.w); }
    else ((float4*)((float*)out + (size_t)row * D))[tid] = o;
}

struct GArgs { const bf16_t* A; const float* W; int lda, ldw, N, K; };
template <class Epi>
__device__ __forceinline__ void ngemm(VB vb, GArgs ga, Epi epi) {
    const bf16_t* A = ga.A; const float* W = ga.W; const int lda = ga.lda, ldw = ga.ldw, N = ga.N, K = ga.K;
    float (*As)[65] = (float (*)[65])vb.sm; float (*Bs)[65] = (float (*)[65])(vb.sm + 16 * 65 * 4);
    const int tid = vb.tid, tx = tid & 15, ty = tid >> 4;
    const int nx = (N + 63) / 64; const int m0 = (vb.id / nx) * 64, n0 = (vb.id % nx) * 64;
    float acc[4][4];
#pragma unroll
    for (int i = 0; i < 4; ++i)
#pragma unroll
        for (int j = 0; j < 4; ++j) acc[i][j] = 0.f;
    for (int k0 = 0; k0 < K; k0 += 16) {
#pragma unroll
        for (int i = 0; i < 4; ++i) { const int idx = tid + i * 256, r = idx >> 4, kk = idx & 15; As[kk][r] = bf2f(A[(size_t)(m0 + r) * lda + k0 + kk]); }
#pragma unroll
        for (int i = 0; i < 4; ++i) { const int idx = tid + i * 256, kk = idx >> 6, n = idx & 63; Bs[kk][n] = (n0 + n < N) ? W[(size_t)(k0 + kk) * ldw + n0 + n] : 0.f; }
        __syncthreads();
#pragma unroll
        for (int kk = 0; kk < 16; ++kk) {
            float a[4], b[4];
#pragma unroll
            for (int i = 0; i < 4; ++i) { a[i] = As[kk][ty * 4 + i]; b[i] = Bs[kk][tx * 4 + i]; }
#pragma unroll
            for (int i = 0; i < 4; ++i)
#pragma unroll
                for (int j = 0; j < 4; ++j) acc[i][j] += a[i] * b[j];
        }
        __syncthreads();
    }
#pragma unroll
    for (int i = 0; i < 4; ++i)
#pragma unroll
        for (int j = 0; j < 4; ++j) { const int n = n0 + tx * 4 + j; if (n < N) epi(m0 + ty * 4 + i, n, acc[i][j]); }
}
struct EpiBiasBf16 { bf16_t* O; const float* bias; int ldo, pad; __device__ void operator()(int m, int n, float a) const { O[(size_t)m * ldo + n] = f2bf(a + (bias ? bias[n] : 0.f)); } };
struct EpiBiasF32 { float* O; const float* bias; int ldo, pad; __device__ void operator()(int m, int n, float a) const { O[(size_t)m * ldo + n] = a + bias[n]; } };
struct EpiSigBf16 { bf16_t* O; const float* bias; int ldo, pad; __device__ void operator()(int m, int n, float a) const { const float v = a + bias[n]; O[(size_t)m * ldo + n] = f2bf(1.f / (1.f + __expf(-v))); } };
struct EpiMerge { const bf16_t* G; float* Mf; bf16_t* Mb; int j, pad; __device__ void operator()(int m, int n, float a) const {
    const float g = bf2f(G[(size_t)m * 3072 + j * 1024 + n]); float v = g * a; if (j > 0) v += Mf[(size_t)m * D + n];
    if (j < 2) Mf[(size_t)m * D + n] = v; else Mb[(size_t)m * D + n] = f2bf(v); } };
struct EpiResid { const float* X; float* O; __device__ void operator()(int m, int n, float a) const { O[(size_t)m * D + n] = X[(size_t)m * D + n] + a; } };
struct EpiRelu2 { bf16_t* O; __device__ void operator()(int m, int n, float a) const { const float r = fmaxf(a, 0.f); O[(size_t)m * FF + n] = f2bf(r * r); } };

__device__ __forceinline__ float convqk(const bf16_t* P, const float* w  , int m, int t, int ch) {
    float y = 0.f;
#pragma unroll
    for (int j = 0; j < 4; ++j) if (t - j >= 0) y += w[j * 1024 + ch] * bf2f(P[(size_t)(m - j) * PW + ch]);
    return bf2f(f2bf(y / (1.f + __expf(-y))));
}
__device__ __forceinline__ float logsig(float x) { return fminf(x, 0.f) - log1pf(__expf(-fabsf(x))); }
__device__ __forceinline__ void m1_naive(VB vb, const bf16_t* P, const float* cw, const float* S32, float* Abuf, float* NA, float* Gc, float* Mloc) {
    float (*kk)[128] = (float (*)[128])vb.sm; float* e = (float*)(vb.sm + 32768); float* bc = e + 64;
    const int ci = vb.id, c = ci & 63, bh = ci >> 6, h = bh & 3, b = bh >> 2, tid = vb.tid;
    const int m0 = b * T + c * 64;
    if (tid == 0) {
        float run = 0.f;
        for (int s = 0; s < 64; ++s) { run += logsig(S32[(size_t)(m0 + s) * 32 + 4 + h]); bc[s] = run; }
        const float g = run; float mx = -INFINITY;
        for (int s = 0; s < 64; ++s) { const float w = g - bc[s] + S32[(size_t)(m0 + s) * 32 + h]; e[s] = w; mx = fmaxf(mx, w); }
        for (int s = 0; s < 64; ++s) e[s] = __expf(e[s] - mx);
        Gc[ci] = g; Mloc[ci] = mx;
    }
    for (int i = tid; i < 64 * 128; i += 256) { const int s = i >> 7, k = i & 127; kk[s][k] = convqk(P, cw, m0 + s, c * 64 + s, 512 + h * 128 + k) * 0.08838834764831845f; }
    __syncthreads();
    const int v = tid & 127, kh = tid >> 7;
    float acc[64];
#pragma unroll
    for (int i = 0; i < 64; ++i) acc[i] = 0.f;
    for (int s = 0; s < 64; ++s) {
        const float ev = e[s] * bf2f(P[(size_t)(m0 + s) * PW + P_MLV + h * 128 + v]);
#pragma unroll
        for (int i = 0; i < 64; ++i) acc[i] += kk[s][kh * 64 + i] * ev;
    }
#pragma unroll
    for (int i = 0; i < 64; ++i) Abuf[((size_t)ci * 128 + kh * 64 + i) * 128 + v] = acc[i];
    if (tid < 128) { float n = 0.f; for (int s = 0; s < 64; ++s) n += e[s] * kk[s][tid]; NA[(size_t)ci * 128 + tid] = n; }
}
__device__ __forceinline__ void m2_naive(VB vb, float* Abuf, float* NA, const float* Gc, const float* Mloc, float* Mprev) {
    const int i = vb.id * 256 + vb.tid;
    const int bh = i >> 14, kv = i & 16383, k = kv >> 7, v = kv & 127;
    float C = 0.f, n = 0.f, m = 0.f;
    for (int c = 0; c < 64; ++c) {
        const int ci = bh * 64 + c;
        const float g = Gc[ci], ml = Mloc[ci];
        const float mn = fmaxf(g + m, ml), a = __expf(g + m - mn), bb = __expf(ml - mn);
        const size_t idx = ((size_t)ci * 128 + k) * 128 + v;
        const float A = Abuf[idx]; Abuf[idx] = C; C = a * C + bb * A;
        if (v == 0) { const float nA = NA[(size_t)ci * 128 + k]; NA[(size_t)ci * 128 + k] = n; n = a * n + bb * nA; }
        if (kv == 0) Mprev[ci] = m;
        m = mn;
    }
}
__device__ __forceinline__ void m3_naive(VB vb, const bf16_t* P, const float* cw, const float* S32, const float* Cprev, const float* Nprev, const float* Mprev,
                                                const float* normg, bf16_t* Yml) {
    float* q = (float*)vb.sm; float* Srow = q + 128; float* bc = Srow + 64; float* li = bc + 64; float* sh = li + 64;
    const int ci = vb.id >> 6, tt = vb.id & 63, c = ci & 63, bh = ci >> 6, h = bh & 3, b = bh >> 2, tid = vb.tid;
    const int m0 = b * T + c * 64, m = m0 + tt;
    q[tid] = convqk(P, cw, m, c * 64 + tt, h * 128 + tid);
    if (tid == 0) { float run = 0.f; for (int s = 0; s <= tt; ++s) { run += logsig(S32[(size_t)(m0 + s) * 32 + 4 + h]); bc[s] = run; li[s] = S32[(size_t)(m0 + s) * 32 + h]; } }
    __syncthreads();
    const float mprev = Mprev[ci], inter = bc[tt] + mprev;
    float mt = inter;
    for (int s = 0; s <= tt; ++s) mt = fmaxf(mt, bc[tt] - bc[s] + li[s]);
    if (tid < 64) {
        float sv = 0.f;
        if (tid <= tt) { float dot = 0.f; for (int k = 0; k < 128; ++k) dot += q[k] * convqk(P, cw, m0 + tid, c * 64 + tid, 512 + h * 128 + k);
            sv = dot * 0.08838834764831845f * __expf(bc[tt] - bc[tid] + li[tid] - mt); }
        Srow[tid] = sv;
    }
    __syncthreads();
    const float sc = __expf(inter - mt);
    float num = 0.f, den = 0.f;
    for (int s = 0; s <= tt; ++s) { num += Srow[s] * bf2f(P[(size_t)(m0 + s) * PW + P_MLV + h * 128 + tid]); den += Srow[s]; }
    float qc = 0.f, qn = 0.f;
    for (int k = 0; k < 128; ++k) { qc += q[k] * Cprev[((size_t)ci * 128 + k) * 128 + tid]; qn += q[k] * Nprev[(size_t)ci * 128 + k]; }
    num += sc * qc; den += sc * qn;
    const float hv = num / fmaxf(fabsf(den), __expf(-mt));
    float ss = wave_sum(hv * hv);
    if ((tid & 63) == 0) sh[tid >> 6] = ss;
    __syncthreads();
    const float r = rsqrtf((sh[0] + sh[1]) * (1.f / 128.f) + EPS);
    const float o = bf2f(P[(size_t)m * PW + P_MLO + h * 128 + tid]);
    Yml[(size_t)m * 512 + h * 128 + tid] = f2bf(1.f / (1.f + __expf(-o)) * hv * r * normg[h * 128 + tid]);
}

__device__ __forceinline__ float gelu_tanh(float x) { const float u = 0.7978845608028654f * (x + 0.044715f * x * x * x); return 0.5f * x * (1.f + tanhf(u)); }
__device__ __forceinline__ void n1_naive(VB vb, const bf16_t* P, const float* pe  , const float* w1  , const float* w2  , bf16_t* KC, bf16_t* VC) {
    float* xin = (float*)vb.sm; float* hid = xin + 2048;
    int idx = vb.id; const int g = idx & 1; idx >>= 1; const int n = idx % 255; idx /= 255; const int b = idx & 3, kv = idx >> 2, tid = vb.tid;
    const int pcol = (kv ? P_VC : P_KC) + g * 64;
    for (int i = tid; i < 2048; i += 256) { const int l = i >> 6, d = i & 63; xin[i] = bf2f(P[(size_t)(b * T + n * 16 + l) * PW + pcol + d]) + pe[kv * 2048 + i]; }
    __syncthreads();
    float a = 0.f; const float* w = w1 + (size_t)kv * 2048 * 256 + tid;
    for (int i = 0; i < 2048; ++i) a += xin[i] * w[(size_t)i * 256];
    hid[tid] = gelu_tanh(a);
    __syncthreads();
    if (tid < 64) { float o = 0.f; const float* ww = w2 + (size_t)kv * 256 * 64 + tid; for (int j = 0; j < 256; ++j) o += hid[j] * ww[j * 64];
        (kv ? VC : KC)[((size_t)(b * 256 + n) * 2 + g) * 64 + tid] = f2bf(o); }
}
__device__ __forceinline__ void n2_naive(VB vb, const bf16_t* P, const float* S32, const bf16_t* KC, const bf16_t* VC, bf16_t* Ynsa) {
    float (*q_s)[64] = (float (*)[64])vb.sm; float (*sc)[1024] = (float (*)[1024])(vb.sm + 1024); float (*pc)[256] = (float (*)[256])(vb.sm + 1024 + 16384); float* imp_s = (float*)(vb.sm + 1024 + 16384 + 4096);
    unsigned long long& selmask = *(unsigned long long*)(vb.sm + 1024 + 16384 + 4096 + 256);
    const int g = vb.id & 1, m = vb.id >> 1, b = m / T, t = m % T, tid = vb.tid, r = tid >> 6, lane = tid & 63, h = g * 4 + r;
    const float slope = exp2f(-(float)(h + 1));
    q_s[r][lane] = bf2f(P[(size_t)m * PW + P_NSQ + h * 64 + lane]) * 0.125f;
    __syncthreads();
    float sv[4]; float mx = -INFINITY;
#pragma unroll
    for (int i = 0; i < 4; ++i) { const int n = lane + 64 * i; sv[i] = -INFINITY;
        if (n < 255) { const int dist = t - (16 * n + 31); if (dist >= 0) { const bf16_t* kr = KC + ((size_t)(b * 256 + n) * 2 + g) * 64; float dot = 0.f; for (int d = 0; d < 64; ++d) dot += q_s[r][d] * bf2f(kr[d]);
            sv[i] = dot - slope * (float)dist; mx = fmaxf(mx, sv[i]); } } }
    mx = wave_max(mx);
    float sum = 0.f;
#pragma unroll
    for (int i = 0; i < 4; ++i) { sv[i] = (sv[i] == -INFINITY) ? 0.f : __expf(sv[i] - mx); sum += sv[i]; }
    sum = wave_sum(sum);
    const float inv = sum > 0.f ? 1.f / sum : 0.f;
#pragma unroll
    for (int i = 0; i < 4; ++i) pc[r][lane + 64 * i] = sv[i] * inv;
    __syncthreads();
    float oc = 0.f;
    { const int nmax = (t >= 31) ? ((t - 31) / 16) : -1; for (int n = 0; n <= nmax && n < 255; ++n) oc += pc[r][n] * bf2f(VC[((size_t)(b * 256 + n) * 2 + g) * 64 + lane]); }
    if (tid < 64) { const int j = tid; float im = 0.f;
        for (int n = 4 * j - 1; n <= 4 * j + 3; ++n) if (n >= 0 && n < 255) im += (pc[0][n] + pc[1][n]) + (pc[2][n] + pc[3][n]);
        const int cur = t >> 6; const bool valid = j <= cur, forced = (j == 0) || (j == cur) || (j == cur - 1);
        const float s = valid ? im + (forced ? 1000.f : 0.f) : -1e30f;
        imp_s[j] = s; }
    __syncthreads();
    if (tid < 64) { const int j = tid; const float s = imp_s[j]; int rank = 0;
        for (int jj = 0; jj < 64; ++jj) { const float o = imp_s[jj]; rank += (o > s || (o == s && jj < j)) ? 1 : 0; }
        const unsigned long long mk = __ballot(rank < 16 && j <= (t >> 6)); if (tid == 0) selmask = mk; }
    __syncthreads();
    float osel = 0.f;
    { unsigned long long mk = selmask; int slot = 0; float mxs = -INFINITY;
      while (mk) { const int jb = __ffsll((long long)mk) - 1; mk &= mk - 1; const int pos = jb * 64 + lane; float s = -INFINITY;
          if (pos <= t) { const bf16_t* kr = P + (size_t)(b * T + pos) * PW + P_KS + g * 64; float dot = 0.f; for (int d = 0; d < 64; ++d) dot += q_s[r][d] * bf2f(kr[d]); s = dot - slope * (float)(t - pos); }
          sc[r][slot * 64 + lane] = s; mxs = fmaxf(mxs, s); ++slot; }
      mxs = wave_max(mxs); float sm = 0.f;
      for (int i = 0; i < slot; ++i) { const float s = sc[r][i * 64 + lane]; const float p = (s == -INFINITY) ? 0.f : __expf(s - mxs); sc[r][i * 64 + lane] = p; sm += p; }
      sm = wave_sum(sm);
      mk = selmask; slot = 0;
      while (mk) { const int jb = __ffsll((long long)mk) - 1; mk &= mk - 1;
          for (int i = 0; i < 64; ++i) { const int pos = jb * 64 + i; if (pos > t) break; osel += sc[r][slot * 64 + i] * bf2f(P[(size_t)(b * T + pos) * PW + P_VS + g * 64 + lane]); }
          ++slot; }
      osel /= sm; }
    __syncthreads();
    float owin = 0.f;
    { float mxs = -INFINITY;
      for (int i = 0; i < 8; ++i) { const int pos = t - 511 + i * 64 + lane; float s = -INFINITY;
          if (pos >= 0) { const bf16_t* kr = P + (size_t)(b * T + pos) * PW + P_KW + g * 64; float dot = 0.f; for (int d = 0; d < 64; ++d) dot += q_s[r][d] * bf2f(kr[d]); s = dot - slope * (float)(t - pos); }
          sc[r][i * 64 + lane] = s; mxs = fmaxf(mxs, s); }
      mxs = wave_max(mxs); float sm = 0.f;
      for (int i = 0; i < 8; ++i) { const float s = sc[r][i * 64 + lane]; const float p = (s == -INFINITY) ? 0.f : __expf(s - mxs); sc[r][i * 64 + lane] = p; sm += p; }
      sm = wave_sum(sm);
      for (int i = 0; i < 512; ++i) { const int pos = t - 511 + i; if (pos < 0) continue; owin += sc[r][i] * bf2f(P[(size_t)(b * T + pos) * PW + P_VW + g * 64 + lane]); }
      owin /= sm; }
    const float* gp = S32 + (size_t)m * 32 + 8 + h * 3;
    const float g0 = 1.f / (1.f + __expf(-gp[0])), g1 = 1.f / (1.f + __expf(-gp[1])), g2 = 1.f / (1.f + __expf(-gp[2]));
    Ynsa[(size_t)m * 512 + h * 64 + lane] = f2bf(g0 * oc + g1 * osel + g2 * owin);
}
__device__ __forceinline__ void x1_naive(VB vb, const bf16_t* P, const bf16_t* MEMKV, bf16_t* Yxa) {
    float (*q_s)[128] = (float (*)[128])vb.sm; float (*p_s)[256] = (float (*)[256])(vb.sm + 2048);
    const int m = vb.id, b = m / T, tid = vb.tid, h = tid >> 6, lane = tid & 63;
    q_s[h][lane] = bf2f(P[(size_t)m * PW + P_XAQ + h * 128 + lane]) * 0.08838834764831845f;
    q_s[h][lane + 64] = bf2f(P[(size_t)m * PW + P_XAQ + h * 128 + lane + 64]) * 0.08838834764831845f;
    __syncthreads();
    float sv[4]; float mx = -INFINITY;
#pragma unroll
    for (int i = 0; i < 4; ++i) { const int j = lane + 64 * i; const bf16_t* kr = MEMKV + (size_t)(b * 256 + j) * 1024 + h * 128; float dot = 0.f; for (int d = 0; d < 128; ++d) dot += q_s[h][d] * bf2f(kr[d]); sv[i] = dot; mx = fmaxf(mx, dot); }
    mx = wave_max(mx); float sm = 0.f;
#pragma unroll
    for (int i = 0; i < 4; ++i) { sv[i] = __expf(sv[i] - mx); sm += sv[i]; }
    sm = wave_sum(sm);
#pragma unroll
    for (int i = 0; i < 4; ++i) p_s[h][lane + 64 * i] = sv[i] / sm;
    __syncthreads();
    float o0 = 0.f, o1 = 0.f;
    for (int j = 0; j < 256; ++j) { const bf16_t* vr = MEMKV + (size_t)(b * 256 + j) * 1024 + 512 + h * 128; const float p = p_s[h][j]; o0 += p * bf2f(vr[lane]); o1 += p * bf2f(vr[lane + 64]); }
    Yxa[(size_t)m * 512 + h * 128 + lane] = f2bf(o0); Yxa[(size_t)m * 512 + h * 128 + lane + 64] = f2bf(o1);
}


constexpr int NTHREADS = 512, LDS_BYTES = 147456;
struct Args { const float* in[18]; float* out; unsigned char* ws; int ph_lo, ph_hi; };
template <int VT, class F> __device__ __forceinline__ void run_vb(int nvb, char* lds, F f) {
    constexpr int PER = NTHREADS / VT; const int sub = threadIdx.x / VT, tid = threadIdx.x % VT;
    for (int it = blockIdx.x; it * PER < nvb; it += gridDim.x) { VB vb{it * PER + sub, tid, lds + sub * (LDS_BYTES / PER)}; f(vb); __syncthreads(); }
}
__global__ void __launch_bounds__(NTHREADS) mega(Args a) {
    extern __shared__ __attribute__((aligned(16))) unsigned char lds_raw[];
    char* lds = (char*)lds_raw;
    cg::grid_group grid = cg::this_grid();
    const float* x = a.in[0]; const float* mem = a.in[1]; const float* g_mix = a.in[2]; const float* w_in = a.in[3];
    const float* b_in = a.in[4]; const float* ml_conv = a.in[5]; const float* ml_norm_g = a.in[6]; const float* cmp_pe = a.in[7];
    const float* cmp_w1 = a.in[8]; const float* cmp_w2 = a.in[9]; const float* g_mem = a.in[10]; const float* w_mem_kv = a.in[11];
    const float* w_branch = a.in[12]; const float* w_out = a.in[13]; const float* g_ffn = a.in[14]; const float* w_ff1 = a.in[15];
    const float* w_ff2 = a.in[16]; const float* g_final = a.in[17];
    char* ws = (char*)a.ws; float* out = a.out;
    bf16_t* U = (bf16_t*)(ws + WS_U); bf16_t* P = (bf16_t*)(ws + WS_P);
    bf16_t* Yml = (bf16_t*)(ws + WS_Y); bf16_t* Ynsa = Yml + (size_t)M * 512; bf16_t* Yxa = Ynsa + (size_t)M * 512;
    float* S32 = (float*)(ws + WS_S32); bf16_t* MEMN = (bf16_t*)(ws + WS_MEMN); bf16_t* MEMKV = (bf16_t*)(ws + WS_MEMKV);
    bf16_t* KC = (bf16_t*)(ws + WS_KC); bf16_t* VC = (bf16_t*)(ws + WS_VC);
    float* NA = (float*)(ws + WS_NA); float* Gc = (float*)(ws + WS_G); float* Mloc = (float*)(ws + WS_MLOC); float* Mprev = (float*)(ws + WS_MPREV);
    float* Abuf = out;
    bf16_t* GATES = P; bf16_t* MERGED = U; bf16_t* AFFN = (bf16_t*)(ws + WS_AFFN); bf16_t* HBUF = P;
    const int lo = a.ph_lo, hi = a.ph_hi;
#define PHASE(k) if (lo <= (k) && (k) < hi)
#define SEAM(k) if (lo <= (k) && (k) + 1 < hi) grid.sync()
    PHASE(0) { run_vb<256>(M, lds, [=](VB vb) { rms_rows<true>(vb, x, g_mix, U); }); run_vb<256>(1024, lds, [=](VB vb) { rms_rows<true>(vb, mem, g_mem, MEMN); }); }
    SEAM(0);
    PHASE(1) {
        run_vb<256>((2048 / 64) * (M / 64), lds, [=](VB vb) { ngemm(vb, GArgs{U, w_in + 0, D, DIN, 2048, D}, EpiBiasBf16{P + 0, b_in + 0, PW, 0}); });
        run_vb<256>((1280 / 64) * (M / 64), lds, [=](VB vb) { ngemm(vb, GArgs{U, w_in + 2056, D, DIN, 1280, D}, EpiBiasBf16{P + 2048, b_in + 2056, PW, 0}); });
        run_vb<256>((512 / 64) * (M / 64), lds, [=](VB vb) { ngemm(vb, GArgs{U, w_in + 3360, D, DIN, 512, D}, EpiBiasBf16{P + 3328, b_in + 3360, PW, 0}); });
        run_vb<256>(M / 64, lds, [=](VB vb) { ngemm(vb, GArgs{U, w_in + C_MLI, D, DIN, 8, D}, EpiBiasF32{S32, b_in + C_MLI, 32, 0}); });
        run_vb<256>(M / 64, lds, [=](VB vb) { ngemm(vb, GArgs{U, w_in + C_NSG, D, DIN, 24, D}, EpiBiasF32{S32 + 8, b_in + C_NSG, 32, 0}); });
        run_vb<256>((1024 / 64) * (1024 / 64), lds, [=](VB vb) { ngemm(vb, GArgs{MEMN, w_mem_kv, D, 1024, 1024, D}, EpiBiasBf16{MEMKV, nullptr, 1024, 0}); });
    }
    SEAM(1);
    PHASE(2) { run_vb<256>(1024, lds, [=](VB vb) { m1_naive(vb, P, ml_conv, S32, Abuf, NA, Gc, Mloc); });
               run_vb<256>(2 * 4 * 255 * 2, lds, [=](VB vb) { n1_naive(vb, P, cmp_pe, cmp_w1, cmp_w2, KC, VC); });
               run_vb<256>(M, lds, [=](VB vb) { x1_naive(vb, P, MEMKV, Yxa); }); }
    SEAM(2);
    PHASE(3) { run_vb<256>(16 * 128 * 128 / 256, lds, [=](VB vb) { m2_naive(vb, Abuf, NA, Gc, Mloc, Mprev); });
               run_vb<256>(M * 2, lds, [=](VB vb) { n2_naive(vb, P, S32, KC, VC, Ynsa); }); }
    SEAM(3);
    PHASE(4) { run_vb<128>(1024 * 64, lds, [=](VB vb) { m3_naive(vb, P, ml_conv, S32, Abuf, NA, Mprev, ml_norm_g, Yml); }); }
    SEAM(4);
    PHASE(5) { run_vb<256>((3072 / 64) * (M / 64), lds, [=](VB vb) { ngemm(vb, GArgs{U, w_in + C_MG, D, DIN, 3072, D}, EpiSigBf16{GATES, b_in + C_MG, 3072, 0}); }); }
    SEAM(5);
    PHASE(6) { for (int j = 0; j < 3; ++j)
        run_vb<256>((1024 / 64) * (M / 64), lds, [=](VB vb) { ngemm(vb, GArgs{Yml + (size_t)j * M * 512, w_branch + (size_t)j * 512 * 1024, 512, 1024, 1024, 512}, EpiMerge{GATES, out, MERGED, j, 0}); }); }
    SEAM(6);
    PHASE(7) { run_vb<256>((1024 / 64) * (M / 64), lds, [=](VB vb) { ngemm(vb, GArgs{MERGED, w_out, D, 1024, 1024, D}, EpiResid{x, out}); }); }
    SEAM(7);
    PHASE(8) { run_vb<256>(M, lds, [=](VB vb) { rms_rows<true>(vb, out, g_ffn, AFFN); }); }
    SEAM(8);
    PHASE(9) { run_vb<256>((FF / 64) * (M / 64), lds, [=](VB vb) { ngemm(vb, GArgs{AFFN, w_ff1, D, FF, FF, D}, EpiRelu2{HBUF}); }); }
    SEAM(9);
    PHASE(10) { run_vb<256>((1024 / 64) * (M / 64), lds, [=](VB vb) { ngemm(vb, GArgs{HBUF, w_ff2, FF, 1024, 1024, FF}, EpiResid{out, out}); }); }
    SEAM(10);
    PHASE(11) { run_vb<256>(M, lds, [=](VB vb) { rms_rows<false>(vb, out, g_final, out); }); }
}
constexpr int N_PHASES = 12;
#ifndef MK_PER_PHASE
#define MK_PER_PHASE 0
#endif
extern "C" void kernel_launch(void* const* d_in, const int* in_sizes, int n_in, void* d_out, int out_size, void* d_ws, size_t ws_size, hipStream_t stream) {
    static int grid = 0;
    if (grid == 0) {
        int dev = 0, cus = 0, per_cu = 0;
        (void)hipGetDevice(&dev); (void)hipDeviceGetAttribute(&cus, hipDeviceAttributeMultiprocessorCount, dev);
        (void)hipFuncSetAttribute((const void*)mega, hipFuncAttributeMaxDynamicSharedMemorySize, LDS_BYTES);
        (void)hipOccupancyMaxActiveBlocksPerMultiprocessor(&per_cu, (const void*)mega, NTHREADS, LDS_BYTES);
        if (per_cu < 1) { fprintf(stderr, "occupancy query says %d blocks/CU\n", per_cu); per_cu = 1; }
        grid = cus * 1;
        (void)hipGetLastError();
    }
    Args a{};
    for (int i = 0; i < 18; ++i) a.in[i] = (const float*)d_in[i];
    a.out = (float*)d_out; a.ws = (unsigned char*)d_ws;
#if MK_PER_PHASE
    for (int p = 0; p < N_PHASES; ++p) { a.ph_lo = p; a.ph_hi = p + 1; void* args[] = {&a};
        (void)hipLaunchCooperativeKernel((const void*)mega, dim3(grid), dim3(NTHREADS), args, LDS_BYTES, stream); }
#else
    a.ph_lo = 0; a.ph_hi = N_PHASES; void* args[] = {&a};
    hipError_t e = hipLaunchCooperativeKernel((const void*)mega, dim3(grid), dim3(NTHREADS), args, LDS_BYTES, stream);
    if (e != hipSuccess) fprintf(stderr, "cooperative launch failed: %s (grid %d)\n", hipGetErrorString(e), grid);
#endif
}
```

```cpp
#include <hip/hip_runtime.h>
#include <hip/hip_cooperative_groups.h>
#include <cstdio>
namespace cg = cooperative_groups;
#include <stdint.h>

typedef unsigned short bf16_t;
struct VB { int id; int tid; char* sm; };
__device__ __forceinline__ float bf2f(bf16_t v) { return __uint_as_float(((unsigned)v) << 16); }
__device__ __forceinline__ bf16_t f2bf(float f) { unsigned u = __float_as_uint(f); return (bf16_t)((u + 0x7fffu + ((u >> 16) & 1u)) >> 16); }

constexpr int NB = 4, T = 4096, M = NB * T, D = 1024, DIN = 6944, FF = 4096;
constexpr float EPS = 1e-6f;
constexpr int C_MLI = 2048, C_NSG = 3336, C_MG = 3872;
constexpr int P_MLQ = 0, P_MLK = 512, P_MLV = 1024, P_MLO = 1536, P_NSQ = 2048, P_KC = 2560, P_VC = 2688, P_KS = 2816, P_VS = 2944, P_KW = 3072, P_VW = 3200, P_XAQ = 3328, PW = 3840;
constexpr size_t MiB = 1u << 20;
constexpr size_t WS_U = 40 * MiB;
constexpr size_t WS_P = 72 * MiB;
constexpr size_t WS_Y = 192 * MiB;
constexpr size_t WS_AFFN = 200 * MiB;
constexpr size_t WS_S32 = 240 * MiB;
constexpr size_t WS_MEMN = 242 * MiB;
constexpr size_t WS_MEMKV = 244 * MiB;
constexpr size_t WS_KC = 246 * MiB;
constexpr size_t WS_VC = 246 * MiB + 512 * 1024;
constexpr size_t WS_NA = 247 * MiB;
constexpr size_t WS_G = 248 * MiB;
constexpr size_t WS_MLOC = 248 * MiB + 4096;
constexpr size_t WS_MPREV = 248 * MiB + 8192;

__device__ __forceinline__ float wave_sum(float v) {
#pragma unroll
    for (int o = 1; o < 64; o <<= 1) v += __shfl_xor(v, o);
    return v;
}
__device__ __forceinline__ float wave_max(float v) {
#pragma unroll
    for (int o = 1; o < 64; o <<= 1) v = fmaxf(v, __shfl_xor(v, o));
    return v;
}

template <bool OUT_BF16>
__device__ __forceinline__ void rms_rows(VB vb, const float* x, const float* g, void* out) {
    float* red = (float*)vb.sm;
    const int row = vb.id, tid = vb.tid;
    const float4 v = ((const float4*)(x + (size_t)row * D))[tid];
    float s = v.x * v.x + v.y * v.y + v.z * v.z + v.w * v.w;
    s = wave_sum(s);
    if ((tid & 63) == 0) red[tid >> 6] = s;
    __syncthreads();
    const float tot = red[0] + red[1] + red[2] + red[3];
    const float r = rsqrtf(tot * (1.0f / D) + EPS);
    const float4 gg = ((const float4*)g)[tid];
    float4 o; o.x = v.x * r * gg.x; o.y = v.y * r * gg.y; o.z = v.z * r * gg.z; o.w = v.w * r * gg.w;
    if (OUT_BF16) { bf16_t* ob = (bf16_t*)out + (size_t)row * D + tid * 4; ob[0] = f2bf(o.x); ob[1] = f2bf(o.y); ob[2] = f2bf(o.z); ob[3] = f2bf(o.w); }
    else ((float4*)((float*)out + (size_t)row * D))[tid] = o;
}

struct GArgs { const bf16_t* A; const float* W; int lda, ldw, N, K; };
template <class Epi>
__device__ __forceinline__ void ngemm(VB vb, GArgs ga, Epi epi) {
    const bf16_t* A = ga.A; const float* W = ga.W; const int lda = ga.lda, ldw = ga.ldw, N = ga.N, K = ga.K;
    float (*As)[65] = (float (*)[65])vb.sm; float (*Bs)[65] = (float (*)[65])(vb.sm + 16 * 65 * 4);
    const int tid = vb.tid, tx = tid & 15, ty = tid >> 4;
    const int nx = (N + 63) / 64; const int m0 = (vb.id / nx) * 64, n0 = (vb.id % nx) * 64;
    float acc[4][4];
#pragma unroll
    for (int i = 0; i < 4; ++i)
#pragma unroll
        for (int j = 0; j < 4; ++j) acc[i][j] = 0.f;
    for (int k0 = 0; k0 < K; k0 += 16) {
#pragma unroll
        for (int i = 0; i < 4; ++i) { const int idx = tid + i * 256, r = idx >> 4, kk = idx & 15; As[kk][r] = bf2f(A[(size_t)(m0 + r) * lda + k0 + kk]); }
#pragma unroll
        for (int i = 0; i < 4; ++i) { const int idx = tid + i * 256, kk = idx >> 6, n = idx & 63; Bs[kk][n] = (n0 + n < N) ? W[(size_t)(k0 + kk) * ldw + n0 + n] : 0.f; }
        __syncthreads();
#pragma unroll
        for (int kk = 0; kk < 16; ++kk) {
            float a[4], b[4];
#pragma unroll
            for (int i = 0; i < 4; ++i) { a[i] = As[kk][ty * 4 + i]; b[i] = Bs[kk][tx * 4 + i]; }
#pragma unroll
            for (int i = 0; i < 4; ++i)
#pragma unroll
                for (int j = 0; j < 4; ++j) acc[i][j] += a[i] * b[j];
        }
        __syncthreads();
    }
#pragma unroll
    for (int i = 0; i < 4; ++i)
#pragma unroll
        for (int j = 0; j < 4; ++j) { const int n = n0 + tx * 4 + j; if (n < N) epi(m0 + ty * 4 + i, n, acc[i][j]); }
}
struct EpiBiasBf16 { bf16_t* O; const float* bias; int ldo, pad; __device__ void operator()(int m, int n, float a) const { O[(size_t)m * ldo + n] = f2bf(a + (bias ? bias[n] : 0.f)); } };
struct EpiBiasF32 { float* O; const float* bias; int ldo, pad; __device__ void operator()(int m, int n, float a) const { O[(size_t)m * ldo + n] = a + bias[n]; } };
struct EpiSigBf16 { bf16_t* O; const float* bias; int ldo, pad; __device__ void operator()(int m, int n, float a) const { const float v = a + bias[n]; O[(size_t)m * ldo + n] = f2bf(1.f / (1.f + __expf(-v))); } };
struct EpiMerge { const bf16_t* G; float* Mf; bf16_t* Mb; int j, pad; __device__ void operator()(int m, int n, float a) const {
    const float g = bf2f(G[(size_t)m * 3072 + j * 1024 + n]); float v = g * a; if (j > 0) v += Mf[(size_t)m * D + n];
    if (j < 2) Mf[(size_t)m * D + n] = v; else Mb[(size_t)m * D + n] = f2bf(v); } };
struct EpiResid { const float* X; float* O; __device__ void operator()(int m, int n, float a) const { O[(size_t)m * D + n] = X[(size_t)m * D + n] + a; } };
struct EpiRelu2 { bf16_t* O; __device__ void operator()(int m, int n, float a) const { const float r = fmaxf(a, 0.f); O[(size_t)m * FF + n] = f2bf(r * r); } };

__device__ __forceinline__ float convqk(const bf16_t* P, const float* w  , int m, int t, int ch) {
    float y = 0.f;
#pragma unroll
    for (int j = 0; j < 4; ++j) if (t - j >= 0) y += w[j * 1024 + ch] * bf2f(P[(size_t)(m - j) * PW + ch]);
    return bf2f(f2bf(y / (1.f + __expf(-y))));
}
__device__ __forceinline__ float logsig(float x) { return fminf(x, 0.f) - log1pf(__expf(-fabsf(x))); }
__device__ __forceinline__ void m1_naive(VB vb, const bf16_t* P, const float* cw, const float* S32, float* Abuf, float* NA, float* Gc, float* Mloc) {
    float (*kk)[128] = (float (*)[128])vb.sm; float* e = (float*)(vb.sm + 32768); float* bc = e + 64;
    const int ci = vb.id, c = ci & 63, bh = ci >> 6, h = bh & 3, b = bh >> 2, tid = vb.tid;
    const int m0 = b * T + c * 64;
    if (tid == 0) {
        float run = 0.f;
        for (int s = 0; s < 64; ++s) { run += logsig(S32[(size_t)(m0 + s) * 32 + 4 + h]); bc[s] = run; }
        const float g = run; float mx = -INFINITY;
        for (int s = 0; s < 64; ++s) { const float w = g - bc[s] + S32[(size_t)(m0 + s) * 32 + h]; e[s] = w; mx = fmaxf(mx, w); }
        for (int s = 0; s < 64; ++s) e[s] = __expf(e[s] - mx);
        Gc[ci] = g; Mloc[ci] = mx;
    }
    for (int i = tid; i < 64 * 128; i += 256) { const int s = i >> 7, k = i & 127; kk[s][k] = convqk(P, cw, m0 + s, c * 64 + s, 512 + h * 128 + k) * 0.08838834764831845f; }
    __syncthreads();
    const int v = tid & 127, kh = tid >> 7;
    float acc[64];
#pragma unroll
    for (int i = 0; i < 64; ++i) acc[i] = 0.f;
    for (int s = 0; s < 64; ++s) {
        const float ev = e[s] * bf2f(P[(size_t)(m0 + s) * PW + P_MLV + h * 128 + v]);
#pragma unroll
        for (int i = 0; i < 64; ++i) acc[i] += kk[s][kh * 64 + i] * ev;
    }
#pragma unroll
    for (int i = 0; i < 64; ++i) Abuf[((size_t)ci * 128 + kh * 64 + i) * 128 + v] = acc[i];
    if (tid < 128) { float n = 0.f; for (int s = 0; s < 64; ++s) n += e[s] * kk[s][tid]; NA[(size_t)ci * 128 + tid] = n; }
}
__device__ __forceinline__ void m2_naive(VB vb, float* Abuf, float* NA, const float* Gc, const float* Mloc, float* Mprev) {
    const int i = vb.id * 256 + vb.tid;
    const int bh = i >> 14, kv = i & 16383, k = kv >> 7, v = kv & 127;
    float C = 0.f, n = 0.f, m = 0.f;
    for (int c = 0; c < 64; ++c) {
        const int ci = bh * 64 + c;
        const float g = Gc[ci], ml = Mloc[ci];
        const float mn = fmaxf(g + m, ml), a = __expf(g + m - mn), bb = __expf(ml - mn);
        const size_t idx = ((size_t)ci * 128 + k) * 128 + v;
        const float A = Abuf[idx]; Abuf[idx] = C; C = a * C + bb * A;
        if (v == 0) { const float nA = NA[(size_t)ci * 128 + k]; NA[(size_t)ci * 128 + k] = n; n = a * n + bb * nA; }
        if (kv == 0) Mprev[ci] = m;
        m = mn;
    }
}
__device__ __forceinline__ void m3_naive(VB vb, const bf16_t* P, const float* cw, const float* S32, const float* Cprev, const float* Nprev, const float* Mprev,
                                                const float* normg, bf16_t* Yml) {
    float* q = (float*)vb.sm; float* Srow = q + 128; float* bc = Srow + 64; float* li = bc + 64; float* sh = li + 64;
    const int ci = vb.id >> 6, tt = vb.id & 63, c = ci & 63, bh = ci >> 6, h = bh & 3, b = bh >> 2, tid = vb.tid;
    const int m0 = b * T + c * 64, m = m0 + tt;
    q[tid] = convqk(P, cw, m, c * 64 + tt, h * 128 + tid);
    if (tid == 0) { float run = 0.f; for (int s = 0; s <= tt; ++s) { run += logsig(S32[(size_t)(m0 + s) * 32 + 4 + h]); bc[s] = run; li[s] = S32[(size_t)(m0 + s) * 32 + h]; } }
    __syncthreads();
    const float mprev = Mprev[ci], inter = bc[tt] + mprev;
    float mt = inter;
    for (int s = 0; s <= tt; ++s) mt = fmaxf(mt, bc[tt] - bc[s] + li[s]);
    if (tid < 64) {
        float sv = 0.f;
        if (tid <= tt) { float dot = 0.f; for (int k = 0; k < 128; ++k) dot += q[k] * convqk(P, cw, m0 + tid, c * 64 + tid, 512 + h * 128 + k);
            sv = dot * 0.08838834764831845f * __expf(bc[tt] - bc[tid] + li[tid] - mt); }
        Srow[tid] = sv;
    }
    __syncthreads();
    const float sc = __expf(inter - mt);
    float num = 0.f, den = 0.f;
    for (int s = 0; s <= tt; ++s) { num += Srow[s] * bf2f(P[(size_t)(m0 + s) * PW + P_MLV + h * 128 + tid]); den += Srow[s]; }
    float qc = 0.f, qn = 0.f;
    for (int k = 0; k < 128; ++k) { qc += q[k] * Cprev[((size_t)ci * 128 + k) * 128 + tid]; qn += q[k] * Nprev[(size_t)ci * 128 + k]; }
    num += sc * qc; den += sc * qn;
    const float hv = num / fmaxf(fabsf(den), __expf(-mt));
    float ss = wave_sum(hv * hv);
    if ((tid & 63) == 0) sh[tid >> 6] = ss;
    __syncthreads();
    const float r = rsqrtf((sh[0] + sh[1]) * (1.f / 128.f) + EPS);
    const float o = bf2f(P[(size_t)m * PW + P_MLO + h * 128 + tid]);
    Yml[(size_t)m * 512 + h * 128 + tid] = f2bf(1.f / (1.f + __expf(-o)) * hv * r * normg[h * 128 + tid]);
}

__device__ __forceinline__ float gelu_tanh(float x) { const float u = 0.7978845608028654f * (x + 0.044715f * x * x * x); return 0.5f * x * (1.f + tanhf(u)); }
__device__ __forceinline__ void n1_naive(VB vb, const bf16_t* P, const float* pe  , const float* w1  , const float* w2  , bf16_t* KC, bf16_t* VC) {
    float* xin = (float*)vb.sm; float* hid = xin + 2048;
    int idx = vb.id; const int g = idx & 1; idx >>= 1; const int n = idx % 255; idx /= 255; const int b = idx & 3, kv = idx >> 2, tid = vb.tid;
    const int pcol = (kv ? P_VC : P_KC) + g * 64;
    for (int i = tid; i < 2048; i += 256) { const int l = i >> 6, d = i & 63; xin[i] = bf2f(P[(size_t)(b * T + n * 16 + l) * PW + pcol + d]) + pe[kv * 2048 + i]; }
    __syncthreads();
    float a = 0.f; const float* w = w1 + (size_t)kv * 2048 * 256 + tid;
    for (int i = 0; i < 2048; ++i) a += xin[i] * w[(size_t)i * 256];
    hid[tid] = gelu_tanh(a);
    __syncthreads();
    if (tid < 64) { float o = 0.f; const float* ww = w2 + (size_t)kv * 256 * 64 + tid; for (int j = 0; j < 256; ++j) o += hid[j] * ww[j * 64];
        (kv ? VC : KC)[((size_t)(b * 256 + n) * 2 + g) * 64 + tid] = f2bf(o); }
}
__device__ __forceinline__ void n2_naive(VB vb, const bf16_t* P, const float* S32, const bf16_t* KC, const bf16_t* VC, bf16_t* Ynsa) {
    float (*q_s)[64] = (float (*)[64])vb.sm; float (*sc)[1024] = (float (*)[1024])(vb.sm + 1024); float (*pc)[256] = (float (*)[256])(vb.sm + 1024 + 16384); float* imp_s = (float*)(vb.sm + 1024 + 16384 + 4096);
    unsigned long long& selmask = *(unsigned long long*)(vb.sm + 1024 + 16384 + 4096 + 256);
    const int g = vb.id & 1, m = vb.id >> 1, b = m / T, t = m % T, tid = vb.tid, r = tid >> 6, lane = tid & 63, h = g * 4 + r;
    const float slope = exp2f(-(float)(h + 1));
    q_s[r][lane] = bf2f(P[(size_t)m * PW + P_NSQ + h * 64 + lane]) * 0.125f;
    __syncthreads();
    float sv[4]; float mx = -INFINITY;
#pragma unroll
    for (int i = 0; i < 4; ++i) { const int n = lane + 64 * i; sv[i] = -INFINITY;
        if (n < 255) { const int dist = t - (16 * n + 31); if (dist >= 0) { const bf16_t* kr = KC + ((size_t)(b * 256 + n) * 2 + g) * 64; float dot = 0.f; for (int d = 0; d < 64; ++d) dot += q_s[r][d] * bf2f(kr[d]);
            sv[i] = dot - slope * (float)dist; mx = fmaxf(mx, sv[i]); } } }
    mx = wave_max(mx);
    float sum = 0.f;
#pragma unroll
    for (int i = 0; i < 4; ++i) { sv[i] = (sv[i] == -INFINITY) ? 0.f : __expf(sv[i] - mx); sum += sv[i]; }
    sum = wave_sum(sum);
    const float inv = sum > 0.f ? 1.f / sum : 0.f;
#pragma unroll
    for (int i = 0; i < 4; ++i) pc[r][lane + 64 * i] = sv[i] * inv;
    __syncthreads();
    float oc = 0.f;
    { const int nmax = (t >= 31) ? ((t - 31) / 16) : -1; for (int n = 0; n <= nmax && n < 255; ++n) oc += pc[r][n] * bf2f(VC[((size_t)(b * 256 + n) * 2 + g) * 64 + lane]); }
    if (tid < 64) { const int j = tid; float im = 0.f;
        for (int n = 4 * j - 1; n <= 4 * j + 3; ++n) if (n >= 0 && n < 255) im += (pc[0][n] + pc[1][n]) + (pc[2][n] + pc[3][n]);
        const int cur = t >> 6; const bool valid = j <= cur, forced = (j == 0) || (j == cur) || (j == cur - 1);
        const float s = valid ? im + (forced ? 1000.f : 0.f) : -1e30f;
        imp_s[j] = s; }
    __syncthreads();
    if (tid < 64) { const int j = tid; const float s = imp_s[j]; int rank = 0;
        for (int jj = 0; jj < 64; ++jj) { const float o = imp_s[jj]; rank += (o > s || (o == s && jj < j)) ? 1 : 0; }
        const unsigned long long mk = __ballot(rank < 16 && j <= (t >> 6)); if (tid == 0) selmask = mk; }
    __syncthreads();
    float osel = 0.f;
    { unsigned long long mk = selmask; int slot = 0; float mxs = -INFINITY;
      while (mk) { const int jb = __ffsll((long long)mk) - 1; mk &= mk - 1; const int pos = jb * 64 + lane; float s = -INFINITY;
          if (pos <= t) { const bf16_t* kr = P + (size_t)(b * T + pos) * PW + P_KS + g * 64; float dot = 0.f; for (int d = 0; d < 64; ++d) dot += q_s[r][d] * bf2f(kr[d]); s = dot - slope * (float)(t - pos); }
          sc[r][slot * 64 + lane] = s; mxs = fmaxf(mxs, s); ++slot; }
      mxs = wave_max(mxs); float sm = 0.f;
      for (int i = 0; i < slot; ++i) { const float s = sc[r][i * 64 + lane]; const float p = (s == -INFINITY) ? 0.f : __expf(s - mxs); sc[r][i * 64 + lane] = p; sm += p; }
      sm = wave_sum(sm);
      mk = selmask; slot = 0;
      while (mk) { const int jb = __ffsll((long long)mk) - 1; mk &= mk - 1;
          for (int i = 0; i < 64; ++i) { const int pos = jb * 64 + i; if (pos > t) break; osel += sc[r][slot * 64 + i] * bf2f(P[(size_t)(b * T + pos) * PW + P_VS + g * 64 + lane]); }
          ++slot; }
      osel /= sm; }
    __syncthreads();
    float owin = 0.f;
    { float mxs = -INFINITY;
      for (int i = 0; i < 8; ++i) { const int pos = t - 511 + i * 64 + lane; float s = -INFINITY;
          if (pos >= 0) { const bf16_t* kr = P + (size_t)(b * T + pos) * PW + P_KW + g * 64; float dot = 0.f; for (int d = 0; d < 64; ++d) dot += q_s[r][d] * bf2f(kr[d]); s = dot - slope * (float)(t - pos); }
          sc[r][i * 64 + lane] = s; mxs = fmaxf(mxs, s); }
      mxs = wave_max(mxs); float sm = 0.f;
      for (int i = 0; i < 8; ++i) { const float s = sc[r][i * 64 + lane]; const float p = (s == -INFINITY) ? 0.f : __expf(s - mxs); sc[r][i * 64 + lane] = p; sm += p; }
      sm = wave_sum(sm);
      for (int i = 0; i < 512; ++i) { const int pos = t - 511 + i; if (pos < 0) continue; owin += sc[r][i] * bf2f(P[(size_t)(b * T + pos) * PW + P_VW + g * 64 + lane]); }
      owin /= sm; }
    const float* gp = S32 + (size_t)m * 32 + 8 + h * 3;
    const float g0 = 1.f / (1.f + __expf(-gp[0])), g1 = 1.f / (1.f + __expf(-gp[1])), g2 = 1.f / (1.f + __expf(-gp[2]));
    Ynsa[(size_t)m * 512 + h * 64 + lane] = f2bf(g0 * oc + g1 * osel + g2 * owin);
}
__device__ __forceinline__ void x1_naive(VB vb, const bf16_t* P, const bf16_t* MEMKV, bf16_t* Yxa) {
    float (*q_s)[128] = (float (*)[128])vb.sm; float (*p_s)[256] = (float (*)[256])(vb.sm + 2048);
    const int m = vb.id, b = m / T, tid = vb.tid, h = tid >> 6, lane = tid & 63;
    q_s[h][lane] = bf2f(P[(size_t)m * PW + P_XAQ + h * 128 + lane]) * 0.08838834764831845f;
    q_s[h][lane + 64] = bf2f(P[(size_t)m * PW + P_XAQ + h * 128 + lane + 64]) * 0.08838834764831845f;
    __syncthreads();
    float sv[4]; float mx = -INFINITY;
#pragma unroll
    for (int i = 0; i < 4; ++i) { const int j = lane + 64 * i; const bf16_t* kr = MEMKV + (size_t)(b * 256 + j) * 1024 + h * 128; float dot = 0.f; for (int d = 0; d < 128; ++d) dot += q_s[h][d] * bf2f(kr[d]); sv[i] = dot; mx = fmaxf(mx, dot); }
    mx = wave_max(mx); float sm = 0.f;
#pragma unroll
    for (int i = 0; i < 4; ++i) { sv[i] = __expf(sv[i] - mx); sm += sv[i]; }
    sm = wave_sum(sm);
#pragma unroll
    for (int i = 0; i < 4; ++i) p_s[h][lane + 64 * i] = sv[i] / sm;
    __syncthreads();
    float o0 = 0.f, o1 = 0.f;
    for (int j = 0; j < 256; ++j) { const bf16_t* vr = MEMKV + (size_t)(b * 256 + j) * 1024 + 512 + h * 128; const float p = p_s[h][j]; o0 += p * bf2f(vr[lane]); o1 += p * bf2f(vr[lane + 64]); }
    Yxa[(size_t)m * 512 + h * 128 + lane] = f2bf(o0); Yxa[(size_t)m * 512 + h * 128 + lane + 64] = f2bf(o1);
}


namespace pg8 {
#define PG8_LAS __attribute__((address_space(3)))
typedef unsigned short bf16_t;
typedef short bf16x8 __attribute__((ext_vector_type(8)));
typedef float f32x4 __attribute__((ext_vector_type(4)));
typedef unsigned u32x4 __attribute__((ext_vector_type(4)));
constexpr int BM = 256, BK = 64, HALF = 128, HTB = HALF * BK * 2  , STAGE_BYTES = 8 * HTB, NXCD = 8, WGM = 8;

__host__ __device__ __forceinline__ int lds_byte(int r, int c) { const int st = (r >> 4) * 2 + (c >> 5), rr = r & 15, cc = c & 31, ob = rr * 64 + cc * 2; return st * 1024 + (ob ^ (((ob >> 9) & 1) << 5)); }
__host__ __device__ __forceinline__ void stage_rc(int b, int& R, int& C) { const int st = b / 1024, sb = b % 1024, swz = sb ^ (((sb >> 9) & 1) << 5); R = (st >> 1) * 16 + swz / 64; C = (st & 1) * 32 + (swz % 64) / 2; }
__host__ __device__ __forceinline__ int perm32(int rho) { const int n = rho >> 4, i = rho & 15; return 8 * (i >> 2) + 4 * n + (i & 3); }

struct Unit { int pm, pn; };
struct Gemm { const bf16_t* A; const bf16_t* Bt; int M, N, K; };

struct StaticOrder {
    int nM, nN, nwg, G, c;
    __host__ __device__ void init(int M, int N, int G_, int c_) { nM = M / BM; nN = N / BM; nwg = nM * nN; G = G_; c = c_; }
    __host__ __device__ bool next(int i, Unit& u) const {
        const long L = (long)i * G + c; if (L >= nwg) return false;
        int wgid = (int)L; { const int q = nwg / NXCD, r = nwg % NXCD, xcd = wgid % NXCD, off = wgid / NXCD; wgid = (xcd < r ? xcd * (q + 1) : r * (q + 1) + (xcd - r) * q) + off; }
        const int nig = WGM * nN, gid = wgid / nig, fm = gid * WGM, gsz = (nM - fm) < WGM ? (nM - fm) : WGM;
        u.pm = fm + ((wgid % nig) % gsz); u.pn = (wgid % nig) / gsz; return true;
    }
    __device__ __forceinline__ void a_ready(const Unit&) const {}
    __device__ __forceinline__ void done(const Unit&) const {}
};

typedef float f32x2_t __attribute__((ext_vector_type(2))); typedef __bf16 bf16x2_t __attribute__((ext_vector_type(2)));
__device__ __forceinline__ unsigned cvt_pk_bf16(float lo, float hi) { f32x2_t v = {lo, hi}; bf16x2_t b = __builtin_convertvector(v, bf16x2_t); return __builtin_bit_cast(unsigned, b); }
typedef float f32x2 __attribute__((ext_vector_type(2)));

typedef unsigned u32x2 __attribute__((ext_vector_type(2)));
__device__ __forceinline__ float bflo(unsigned w) { return __uint_as_float(w << 16); }
__device__ __forceinline__ float bfhi(unsigned w) { return __uint_as_float(w & 0xffff0000u); }
template <int ACT> __device__ __forceinline__ f32x4 act4(f32x4 v) {
    if (ACT == 1) { f32x4 o; for (int e = 0; e < 4; ++e) o[e] = __builtin_amdgcn_rcpf(1.f + __expf(-v[e])); return o; }
    if (ACT == 2) { f32x4 o; for (int e = 0; e < 4; ++e) { const float r = fmaxf(v[e], 0.f); o[e] = r * r; } return o; }
    return v;
}
template <int ACT> struct EpiStore {
    static constexpr bool PERM = true, AFTER_DRAIN = false;
    bf16_t* O; const float* bias; float* S32; int ldc, small_pn;
    __device__ __forceinline__ void operator()(const f32x4 (&acc)[2][2][4][2], const Unit& u, int wr, int wc, int fr, int fq) const {
        asm volatile("s_waitcnt vmcnt(0)" ::: "memory");
        const int row0 = u.pm * BM + wr * 64 + fr, col0 = u.pn * BM + wc * 32 + 8 * fq;
        if (u.pn == small_pn) {
            if (wc == 0) {
                const f32x4 b0 = *(const f32x4*)(bias + col0), b1 = *(const f32x4*)(bias + col0 + 4);
#pragma unroll
                for (int ai = 0; ai < 2; ++ai)
#pragma unroll
                    for (int m = 0; m < 4; ++m) { float* rp = S32 + (size_t)(row0 + ai * HALF + m * 16) * 32 + 8 * fq;
                        *(f32x4*)rp = acc[ai][0][m][0] + acc[ai][1][m][0] + b0; *(f32x4*)(rp + 4) = acc[ai][0][m][1] + acc[ai][1][m][1] + b1; }
            }
            return;
        }
        f32x4 bv[2][2];
#pragma unroll
        for (int bj = 0; bj < 2; ++bj)
#pragma unroll
            for (int n = 0; n < 2; ++n) bv[bj][n] = bias ? *(const f32x4*)(bias + col0 + bj * HALF + 4 * n) : (f32x4){0.f, 0.f, 0.f, 0.f};
#pragma unroll
        for (int ai = 0; ai < 2; ++ai)
#pragma unroll
            for (int m = 0; m < 4; ++m) { bf16_t* rowp = O + (size_t)(row0 + ai * HALF + m * 16) * ldc + col0;
#pragma unroll
                for (int bj = 0; bj < 2; ++bj) { const f32x4 v0 = act4<ACT>(acc[ai][bj][m][0] + bv[bj][0]), v1 = act4<ACT>(acc[ai][bj][m][1] + bv[bj][1]);
                    u32x4 w; w.x = cvt_pk_bf16(v0[0], v0[1]); w.y = cvt_pk_bf16(v0[2], v0[3]); w.z = cvt_pk_bf16(v1[0], v1[1]); w.w = cvt_pk_bf16(v1[2], v1[3]);
                    *(u32x4*)(rowp + bj * HALF) = w; } }
    }
};
struct EpiMergeG {
    static constexpr bool PERM = true, AFTER_DRAIN = false;
    const bf16_t* G; float* Mf; bf16_t* Mb; int j, pad;
    __device__ __forceinline__ void operator()(const f32x4 (&acc)[2][2][4][2], const Unit& u, int wr, int wc, int fr, int fq) const {
        asm volatile("s_waitcnt vmcnt(0)" ::: "memory");
        const int row0 = u.pm * BM + wr * 64 + fr, col0 = u.pn * BM + wc * 32 + 8 * fq;
#pragma unroll
        for (int ai = 0; ai < 2; ++ai)
#pragma unroll
            for (int m = 0; m < 4; ++m) { const size_t row = (size_t)(row0 + ai * HALF + m * 16);
#pragma unroll
                for (int bj = 0; bj < 2; ++bj) { const int col = col0 + bj * HALF;
                    const u32x4 gw = *(const u32x4*)(G + row * 3072 + j * 1024 + col);
                    f32x4 v0 = (f32x4){bflo(gw.x), bfhi(gw.x), bflo(gw.y), bfhi(gw.y)} * acc[ai][bj][m][0], v1 = (f32x4){bflo(gw.z), bfhi(gw.z), bflo(gw.w), bfhi(gw.w)} * acc[ai][bj][m][1];
                    float* mp = Mf + row * 1024 + col;
                    if (j > 0) { v0 += *(const f32x4*)mp; v1 += *(const f32x4*)(mp + 4); }
                    if (j < 2) { *(f32x4*)mp = v0; *(f32x4*)(mp + 4) = v1; }
                    else { u32x4 w; w.x = cvt_pk_bf16(v0[0], v0[1]); w.y = cvt_pk_bf16(v0[2], v0[3]); w.z = cvt_pk_bf16(v1[0], v1[1]); w.w = cvt_pk_bf16(v1[2], v1[3]); *(u32x4*)(Mb + row * 1024 + col) = w; } } }
    }
};
struct EpiResidF {
    static constexpr bool PERM = true, AFTER_DRAIN = false;
    const float* X; float* O;
    __device__ __forceinline__ void operator()(const f32x4 (&acc)[2][2][4][2], const Unit& u, int wr, int wc, int fr, int fq) const {
        asm volatile("s_waitcnt vmcnt(0)" ::: "memory");
        const int row0 = u.pm * BM + wr * 64 + fr, col0 = u.pn * BM + wc * 32 + 8 * fq;
#pragma unroll
        for (int ai = 0; ai < 2; ++ai)
#pragma unroll
            for (int m = 0; m < 4; ++m) { const size_t off = (size_t)(row0 + ai * HALF + m * 16) * 1024 + col0;
#pragma unroll
                for (int bj = 0; bj < 2; ++bj) { const f32x4 x0 = *(const f32x4*)(X + off + bj * HALF), x1 = *(const f32x4*)(X + off + bj * HALF + 4);
                    *(f32x4*)(O + off + bj * HALF) = x0 + acc[ai][bj][m][0]; *(f32x4*)(O + off + bj * HALF + 4) = x1 + acc[ai][bj][m][1]; } }
    }
};
template <class Epi, class Sched, bool ALIGN_EPI = false, bool SP2 = false>
__device__ __forceinline__ void gemm_phase(PG8_LAS unsigned char* lds, const Gemm g, const Sched& S, const Epi& E) {
    const int tid = threadIdx.x, wid = __builtin_amdgcn_readfirstlane(tid >> 6), lane = tid & 63, wr = wid >> 2, wc = wid & 3, fr = lane & 15, fq = lane >> 4;
    const int K = g.K, nt = K / BK;
    unsigned voffA[2], voffB[2];
#pragma unroll
    for (int i = 0; i < 2; ++i) { int R, C; stage_rc(tid * 16 + i * 8192, R, C); const int Rb = Epi::PERM ? ((R & ~31) + perm32(R & 31)) : R;
        voffA[i] = (unsigned)(R * K + C) * 2u; voffB[i] = (unsigned)(Rb * K + C) * 2u; }
    const size_t kstep = (size_t)(BK * 2);
    const size_t hstep = (size_t)HALF * K * 2;
    const size_t tstep = 2 * hstep;
    const unsigned ldsw = (unsigned)wid * 1024u;
    const int aoff = lds_byte(wr * 64 + fr, fq * 8), boff = lds_byte(wc * 32 + fr, fq * 8);
#define PG8_SA(b, h) (((b) * 2 + (h)) * HTB)
#define PG8_SB(b, h) ((4 + (b) * 2 + (h)) * HTB)
#define PG8_STAGE(bufoff, gbase, voff) do { _Pragma("unroll") for (int _i = 0; _i < 2; ++_i) \
        __builtin_amdgcn_global_load_lds((const unsigned*)((const char*)(gbase) + (voff)[_i]), (PG8_LAS unsigned*)(lds + (bufoff) + ldsw + _i * 8192), 16, 0, 0); } while (0)
#define PG8_LDA(dst, b, h) do { _Pragma("unroll") for (int m = 0; m < 4; ++m) _Pragma("unroll") for (int k = 0; k < 2; ++k) dst[m][k] = *(const PG8_LAS bf16x8*)(lds + PG8_SA(b, h) + aoff + m * 2048 + k * 1024); } while (0)
#define PG8_LDB(dst, b, h) do { _Pragma("unroll") for (int n = 0; n < 2; ++n) _Pragma("unroll") for (int k = 0; k < 2; ++k) dst[n][k] = *(const PG8_LAS bf16x8*)(lds + PG8_SB(b, h) + boff + n * 2048 + k * 1024); } while (0)
#define PG8_MMA(ai, bj, At, Bt) do { __builtin_amdgcn_s_setprio(1); _Pragma("unroll") for (int m = 0; m < 4; ++m) _Pragma("unroll") for (int n = 0; n < 2; ++n) _Pragma("unroll") for (int k = 0; k < 2; ++k) \
        acc[ai][bj][m][n] = __builtin_amdgcn_mfma_f32_16x16x32_bf16(Bt[n][k], At[m][k], acc[ai][bj][m][n], 0, 0, 0); __builtin_amdgcn_s_setprio(0); } while (0)
#define PG8_WAIT_V(n) asm volatile("s_waitcnt vmcnt(" #n ")" ::: "memory")
#define PG8_WAIT_L(n) asm volatile("s_waitcnt lgkmcnt(" #n ")" ::: "memory")
#define PG8_BAR __builtin_amdgcn_s_barrier()
#define PG8_SCHED __builtin_amdgcn_sched_barrier(0)
    Unit cur, nxt; int ui = 0;
    if (!S.next(0, cur)) return;
    f32x4 acc[2][2][4][2];
#pragma unroll
    for (int a = 0; a < 2; ++a)
#pragma unroll
        for (int b = 0; b < 2; ++b)
#pragma unroll
            for (int m = 0; m < 4; ++m)
#pragma unroll
                for (int n = 0; n < 2; ++n) acc[a][b][m][n] = (f32x4){0.f, 0.f, 0.f, 0.f};
    bf16x8 At[4][2], B0[2][2], B1[2][2];
    const char* cA = (const char*)g.A + (size_t)cur.pm * tstep; const char* cB = (const char*)g.Bt + (size_t)cur.pn * tstep;
    S.a_ready(cur);
    if constexpr (SP2) {
        PG8_STAGE(PG8_SB(0, 0), cB, voffB); PG8_STAGE(PG8_SB(0, 1), cB + hstep, voffB); PG8_STAGE(PG8_SA(0, 0), cA, voffA); PG8_STAGE(PG8_SA(0, 1), cA + hstep, voffA);
        if (wr == 1) PG8_BAR;
        PG8_WAIT_V(2); PG8_BAR;
        PG8_STAGE(PG8_SB(1, 0), cB + kstep, voffB); PG8_STAGE(PG8_SA(1, 0), cA + kstep, voffA); PG8_STAGE(PG8_SB(1, 1), cB + hstep + kstep, voffB);
        PG8_WAIT_V(6); PG8_BAR;
    } else {
        PG8_STAGE(PG8_SB(0, 0), cB, voffB); PG8_STAGE(PG8_SA(0, 0), cA, voffA); PG8_STAGE(PG8_SB(0, 1), cB + hstep, voffB); PG8_STAGE(PG8_SA(0, 1), cA + hstep, voffA);
        if (wr == 1) PG8_BAR;
        PG8_WAIT_V(4); PG8_BAR;
        PG8_STAGE(PG8_SB(1, 0), cB + kstep, voffB); PG8_STAGE(PG8_SA(1, 0), cA + kstep, voffA); PG8_STAGE(PG8_SB(1, 1), cB + hstep + kstep, voffB);
        PG8_WAIT_V(6); PG8_BAR;
    }
    for (;;) {
        const bool has_next = S.next(ui + 1, nxt);
        const char* nA = has_next ? (const char*)g.A + (size_t)nxt.pm * tstep : cA; const char* nB = has_next ? (const char*)g.Bt + (size_t)nxt.pn * tstep : cB;
        for (int t = 0; t < nt; t += 2) {
            const bool last = (t == nt - 2);
            const char* a1 = cA + (size_t)(t + 1) * kstep;
            const char* a2 = last ? nA : cA + (size_t)(t + 2) * kstep; const char* b2 = last ? nB : cB + (size_t)(t + 2) * kstep;
            const char* a3 = a2 + kstep; const char* b3 = b2 + kstep;
            if (last && has_next) S.a_ready(nxt);
            if constexpr (SP2) {
            PG8_LDB(B0, 0, 0); PG8_LDB(B1, 0, 1); PG8_SCHED; PG8_LDA(At, 0, 0); PG8_STAGE(PG8_SA(1, 1), a1 + hstep, voffA);
            PG8_WAIT_V(8); PG8_WAIT_L(0); PG8_BAR; PG8_MMA(0, 0, At, B0); PG8_MMA(0, 1, At, B1); PG8_BAR; PG8_SCHED;
            PG8_LDA(At, 0, 1); PG8_STAGE(PG8_SB(0, 0), b2, voffB); PG8_STAGE(PG8_SB(0, 1), b2 + hstep, voffB); PG8_STAGE(PG8_SA(0, 0), a2, voffA);
            PG8_WAIT_V(8); PG8_WAIT_L(0); PG8_BAR; PG8_MMA(1, 0, At, B0); PG8_MMA(1, 1, At, B1); PG8_BAR; PG8_SCHED;
            PG8_LDB(B0, 1, 0); PG8_LDB(B1, 1, 1); PG8_SCHED; PG8_LDA(At, 1, 0); PG8_STAGE(PG8_SA(0, 1), a2 + hstep, voffA);
            PG8_WAIT_V(8); PG8_WAIT_L(0); PG8_BAR; PG8_MMA(0, 0, At, B0); PG8_MMA(0, 1, At, B1); PG8_BAR; PG8_SCHED;
            PG8_LDA(At, 1, 1); PG8_STAGE(PG8_SB(1, 0), b3, voffB); PG8_STAGE(PG8_SB(1, 1), b3 + hstep, voffB); PG8_STAGE(PG8_SA(1, 0), a3, voffA);
            PG8_WAIT_V(8); PG8_WAIT_L(0); PG8_BAR; PG8_MMA(1, 0, At, B0); PG8_MMA(1, 1, At, B1); PG8_BAR; PG8_SCHED;
            } else {
            PG8_LDB(B0, 0, 0); PG8_SCHED; PG8_LDA(At, 0, 0); PG8_STAGE(PG8_SA(1, 1), a1 + hstep, voffA);
            PG8_WAIT_L(8); PG8_BAR; PG8_WAIT_L(0); PG8_MMA(0, 0, At, B0); PG8_BAR; PG8_SCHED;
            PG8_LDB(B1, 0, 1); PG8_STAGE(PG8_SB(0, 0), b2, voffB);
            PG8_BAR; PG8_WAIT_L(0); PG8_MMA(0, 1, At, B1); PG8_BAR;
            PG8_LDA(At, 0, 1); PG8_STAGE(PG8_SA(0, 0), a2, voffA);
            PG8_BAR; PG8_WAIT_L(0); PG8_MMA(1, 0, At, B0); PG8_BAR; PG8_SCHED;
            PG8_STAGE(PG8_SB(0, 1), b2 + hstep, voffB);
            PG8_WAIT_V(6); PG8_BAR; PG8_MMA(1, 1, At, B1); PG8_BAR;
            PG8_LDB(B0, 1, 0); PG8_SCHED; PG8_LDA(At, 1, 0); PG8_STAGE(PG8_SA(0, 1), a2 + hstep, voffA);
            PG8_WAIT_L(8); PG8_BAR; PG8_WAIT_L(0); PG8_MMA(0, 0, At, B0); PG8_BAR; PG8_SCHED;
            PG8_LDB(B1, 1, 1); PG8_STAGE(PG8_SB(1, 0), b3, voffB);
            PG8_BAR; PG8_WAIT_L(0); PG8_MMA(0, 1, At, B1); PG8_BAR;
            PG8_LDA(At, 1, 1); PG8_STAGE(PG8_SA(1, 0), a3, voffA);
            PG8_BAR; PG8_WAIT_L(0); PG8_MMA(1, 0, At, B0); PG8_BAR; PG8_SCHED;
            PG8_STAGE(PG8_SB(1, 1), b3 + hstep, voffB);
            PG8_WAIT_V(6); PG8_BAR; PG8_MMA(1, 1, At, B1); PG8_BAR;
            }
        }
        if constexpr (ALIGN_EPI) { if (wr == 0) PG8_BAR; }
        if constexpr (!Epi::AFTER_DRAIN) { E(acc, cur, wr, wc, fr, fq); S.done(cur); }
        if (!has_next) break;
#pragma unroll
        for (int a = 0; a < 2; ++a)
#pragma unroll
            for (int b = 0; b < 2; ++b)
#pragma unroll
                for (int m = 0; m < 4; ++m)
#pragma unroll
                    for (int n = 0; n < 2; ++n) acc[a][b][m][n] = (f32x4){0.f, 0.f, 0.f, 0.f};
        cur = nxt; cA = nA; cB = nB; ++ui;
        if constexpr (ALIGN_EPI) { if (wr == 1) PG8_BAR; }
    }
    PG8_WAIT_V(0);
    if constexpr (!ALIGN_EPI) { if (wr == 0) PG8_BAR; }
    PG8_BAR;
    if constexpr (Epi::AFTER_DRAIN) { E.fused(acc, cur, wr, wc, fr, fq, lds, wid, lane); S.done(cur); }
#undef PG8_SA
#undef PG8_SB
#undef PG8_STAGE
#undef PG8_LDA
#undef PG8_LDB
#undef PG8_MMA
#undef PG8_WAIT_V
#undef PG8_WAIT_L
#undef PG8_BAR
#undef PG8_SCHED
}
}

#define LAS __attribute__((address_space(3)))
constexpr int NTHREADS = 512, LDS_BYTES = 147456;
constexpr size_t WS_WIN = 1 * MiB, WS_WG = 9 * MiB, WS_WBR = 15 * MiB, WS_WOUT = 18 * MiB, WS_WFF1 = 20 * MiB, WS_WFF2 = 28 * MiB, WS_WMKV = 36 * MiB, WS_WC1 = 38 * MiB;
constexpr size_t WS_BIASP = 249 * MiB;
struct Args { const float* in[18]; float* out; unsigned char* ws; int ph_lo, ph_hi; };
template <int VT, class F> __device__ __forceinline__ void run_vb(int nvb, char* lds, F f) {
    constexpr int PER = NTHREADS / VT; const int sub = threadIdx.x / VT, tid = threadIdx.x % VT;
    for (int it = blockIdx.x; it * PER < nvb; it += gridDim.x) { VB vb{it * PER + sub, tid, lds + sub * (LDS_BYTES / PER)}; f(vb); __syncthreads(); }
}
__device__ __forceinline__ unsigned pk2(float lo, float hi) { return (unsigned)f2bf(lo) | ((unsigned)f2bf(hi) << 16); }
typedef unsigned v4u __attribute__((ext_vector_type(4)));
typedef float f32x4 __attribute__((ext_vector_type(4)));
__device__ __forceinline__ void tr_item(const float* W, int ld, int ncols, int K, bf16_t* WT, int row_off, LAS float* scr, int item, int lane) {
    const int nblk = ncols / 32, kb = item / nblk, nb = item % nblk, k0 = 64 * kb, n0 = 32 * nb;
#pragma unroll 8
    for (int i = 0; i < 32; ++i) { const int kk = 2 * i + (lane >> 5); scr[kk * 33 + (lane & 31)] = W[(size_t)(k0 + kk) * ld + n0 + (lane & 31)]; }
    asm volatile("s_waitcnt lgkmcnt(0)" ::: "memory");
    const int c = lane & 7;
#pragma unroll
    for (int j = 0; j < 4; ++j) { const int n = (lane >> 3) + 8 * j; const LAS float* s = scr + (8 * c) * 33 + n;
        v4u o; o.x = pk2(s[0 * 33], s[1 * 33]); o.y = pk2(s[2 * 33], s[3 * 33]); o.z = pk2(s[4 * 33], s[5 * 33]); o.w = pk2(s[6 * 33], s[7 * 33]);
        *(v4u*)(WT + (size_t)(row_off + n0 + n) * K + k0 + 8 * c) = o; }
    asm volatile("s_waitcnt lgkmcnt(0)" ::: "memory");
}
__device__ __forceinline__ void rms_row_wave(const float* xrow, const float* g, bf16_t* orow, int lane) {
    const f32x4* xr = (const f32x4*)xrow + lane; const f32x4* gr = (const f32x4*)g + lane;
    f32x4 v[4]; float s = 0.f;
#pragma unroll
    for (int j = 0; j < 4; ++j) { v[j] = xr[64 * j]; s += (v[j].x * v[j].x + v[j].y * v[j].y) + (v[j].z * v[j].z + v[j].w * v[j].w); }
    const float r = rsqrtf(wave_sum(s) * (1.f / D) + EPS);
    unsigned long long* o8 = (unsigned long long*)orow + lane;
#pragma unroll
    for (int j = 0; j < 4; ++j) { const f32x4 gg = gr[64 * j]; o8[64 * j] = (unsigned long long)pk2(v[j].x * r * gg.x, v[j].y * r * gg.y) | ((unsigned long long)pk2(v[j].z * r * gg.z, v[j].w * r * gg.w) << 32); }
}
__device__ __forceinline__ int small_src_col(int c) { return c < 8 ? C_MLI + c : C_NSG + (c - 8); }
__global__ void __launch_bounds__(NTHREADS, 2) mega(Args a) {
    extern __shared__ __attribute__((aligned(16))) unsigned char lds_raw[];
    char* lds = (char*)lds_raw;
    LAS unsigned char* lds3 = (LAS unsigned char*)lds_raw;
    cg::grid_group grid = cg::this_grid();
    const float* x = a.in[0]; const float* mem = a.in[1]; const float* g_mix = a.in[2]; const float* w_in = a.in[3];
    const float* b_in = a.in[4]; const float* ml_conv = a.in[5]; const float* ml_norm_g = a.in[6]; const float* cmp_pe = a.in[7];
    const float* cmp_w1 = a.in[8]; const float* cmp_w2 = a.in[9]; const float* g_mem = a.in[10]; const float* w_mem_kv = a.in[11];
    const float* w_branch = a.in[12]; const float* w_out = a.in[13]; const float* g_ffn = a.in[14]; const float* w_ff1 = a.in[15];
    const float* w_ff2 = a.in[16]; const float* g_final = a.in[17];
    char* ws = (char*)a.ws; float* out = a.out;
    bf16_t* U = (bf16_t*)(ws + WS_U); bf16_t* P = (bf16_t*)(ws + WS_P);
    bf16_t* Yml = (bf16_t*)(ws + WS_Y); bf16_t* Ynsa = Yml + (size_t)M * 512; bf16_t* Yxa = Ynsa + (size_t)M * 512;
    float* S32 = (float*)(ws + WS_S32); bf16_t* MEMN = (bf16_t*)(ws + WS_MEMN); bf16_t* MEMKV = (bf16_t*)(ws + WS_MEMKV);
    bf16_t* KC = (bf16_t*)(ws + WS_KC); bf16_t* VC = (bf16_t*)(ws + WS_VC);
    float* NA = (float*)(ws + WS_NA); float* Gc = (float*)(ws + WS_G); float* Mloc = (float*)(ws + WS_MLOC); float* Mprev = (float*)(ws + WS_MPREV);
    float* Abuf = out;
    bf16_t* GATES = P; bf16_t* MERGED = U; bf16_t* AFFN = (bf16_t*)(ws + WS_AFFN); bf16_t* HBUF = P;
    bf16_t* Wi = (bf16_t*)(ws + WS_WIN); bf16_t* Wg = (bf16_t*)(ws + WS_WG); bf16_t* Wbr = (bf16_t*)(ws + WS_WBR); bf16_t* Wo = (bf16_t*)(ws + WS_WOUT);
    bf16_t* Wf1 = (bf16_t*)(ws + WS_WFF1); bf16_t* Wf2 = (bf16_t*)(ws + WS_WFF2); bf16_t* Wmkv = (bf16_t*)(ws + WS_WMKV);
    float* biasP = (float*)(ws + WS_BIASP);
    const int tid = threadIdx.x, lane = tid & 63, wave = __builtin_amdgcn_readfirstlane(tid >> 6);
    const int G = gridDim.x, bid = blockIdx.x;
    const int lo = a.ph_lo, hi = a.ph_hi;
#define PHASE(k) if (lo <= (k) && (k) < hi)
#define SEAM(k) if (lo <= (k) && (k) + 1 < hi) grid.sync()
    PHASE(0) {
        LAS float* scr = (LAS float*)(lds3 + wave * 16384);
        const int gw = bid * 8 + wave, NGW = G * 8;
        constexpr int I0 = 16 * 64, I1 = 16 * 40, I2 = 16 * 16, I3 = 16 * 96, I4 = 8 * 32, I5 = 16 * 32, I6 = 16 * 128, I7 = 64 * 32, I8 = 16 * 32;
        constexpr int NITEMS = I0 + I1 + I2 + I3 + 3 * I4 + I5 + I6 + I7 + I8;
        for (int it = gw; it < NITEMS; it += NGW) {
            int r = it;
            if (r < I0) { tr_item(w_in, DIN, 2048, 1024, Wi, 0, scr, r, lane); continue; } r -= I0;
            if (r < I1) { tr_item(w_in + 2056, DIN, 1280, 1024, Wi, 2048, scr, r, lane); continue; } r -= I1;
            if (r < I2) { tr_item(w_in + 3360, DIN, 512, 1024, Wi, 3328, scr, r, lane); continue; } r -= I2;
            if (r < I3) { tr_item(w_in + C_MG, DIN, 3072, 1024, Wg, 0, scr, r, lane); continue; } r -= I3;
            if (r < 3 * I4) { const int j = r / I4; tr_item(w_branch + (size_t)j * 512 * 1024, 1024, 1024, 512, Wbr + (size_t)j * 1024 * 512, 0, scr, r % I4, lane); continue; } r -= 3 * I4;
            if (r < I5) { tr_item(w_out, 1024, 1024, 1024, Wo, 0, scr, r, lane); continue; } r -= I5;
            if (r < I6) { tr_item(w_ff1, FF, FF, 1024, Wf1, 0, scr, r, lane); continue; } r -= I6;
            if (r < I7) { tr_item(w_ff2, 1024, 1024, FF, Wf2, 0, scr, r, lane); continue; } r -= I7;
            tr_item(w_mem_kv, 1024, 1024, 1024, Wmkv, 0, scr, r, lane);
        }
        for (int i = bid * NTHREADS + tid; i < 256 * 1024; i += G * NTHREADS) { const int r = i >> 10, k = i & 1023; bf16_t v = 0;
            if (r < 32) v = f2bf(w_in[(size_t)k * DIN + small_src_col(r)]);
            else if (r >= 128 && r < 160) { const float w = w_in[(size_t)k * DIN + small_src_col(r - 128)]; v = f2bf(w - bf2f(f2bf(w))); }
            Wi[(size_t)(3840 + r) * 1024 + k] = v; }
        for (int c = bid * NTHREADS + tid; c < 4096; c += G * NTHREADS) { float v = 0.f;
            if (c < 2048) v = b_in[c]; else if (c < 3328) v = b_in[c + 8]; else if (c < 3840) v = b_in[c + 32]; else if (c < 3872) v = b_in[small_src_col(c - 3840)];
            biasP[c] = v; }
        for (int m = gw; m < M; m += NGW) rms_row_wave(x + (size_t)m * D, g_mix, U + (size_t)m * D, lane);
        for (int m = gw; m < 1024; m += NGW) rms_row_wave(mem + (size_t)m * D, g_mem, MEMN + (size_t)m * D, lane);
    }
    SEAM(0);
    PHASE(1) {
        { pg8::Gemm g{U, Wi, M, 4096, D}; pg8::StaticOrder S; S.init(M, 4096, G, bid);
          pg8::EpiStore<0> E{P, biasP, S32, PW, 15};
          pg8::gemm_phase<pg8::EpiStore<0>, pg8::StaticOrder, true, true>(lds3, g, S, E); }
        { pg8::Gemm g{MEMN, Wmkv, 1024, 1024, D}; pg8::StaticOrder S; S.init(1024, 1024, G, bid);
          pg8::EpiStore<0> E{MEMKV, nullptr, nullptr, 1024, -1};
          pg8::gemm_phase<pg8::EpiStore<0>, pg8::StaticOrder, true, true>(lds3, g, S, E); }
    }
    SEAM(1);
    PHASE(2) { run_vb<256>(1024, lds, [=](VB vb) { m1_naive(vb, P, ml_conv, S32, Abuf, NA, Gc, Mloc); });
               run_vb<256>(2 * 4 * 255 * 2, lds, [=](VB vb) { n1_naive(vb, P, cmp_pe, cmp_w1, cmp_w2, KC, VC); });
               run_vb<256>(M, lds, [=](VB vb) { x1_naive(vb, P, MEMKV, Yxa); }); }
    SEAM(2);
    PHASE(3) { run_vb<256>(16 * 128 * 128 / 256, lds, [=](VB vb) { m2_naive(vb, Abuf, NA, Gc, Mloc, Mprev); });
               run_vb<256>(M * 2, lds, [=](VB vb) { n2_naive(vb, P, S32, KC, VC, Ynsa); }); }
    SEAM(3);
    PHASE(4) { run_vb<128>(1024 * 64, lds, [=](VB vb) { m3_naive(vb, P, ml_conv, S32, Abuf, NA, Mprev, ml_norm_g, Yml); }); }
    SEAM(4);
    PHASE(5) { pg8::Gemm g{U, Wg, M, 3072, D}; pg8::StaticOrder S; S.init(M, 3072, G, bid);
               pg8::EpiStore<1> E{GATES, b_in + C_MG, nullptr, 3072, -1};
               pg8::gemm_phase<pg8::EpiStore<1>, pg8::StaticOrder, true, true>(lds3, g, S, E); }
    SEAM(5);
    PHASE(6) {
#pragma unroll 1
        for (int j = 0; j < 3; ++j) { pg8::Gemm g{Yml + (size_t)j * M * 512, Wbr + (size_t)j * 1024 * 512, M, 1024, 512}; pg8::StaticOrder S; S.init(M, 1024, G, bid);
            pg8::EpiMergeG E{GATES, out, MERGED, j, 0};
            pg8::gemm_phase<pg8::EpiMergeG, pg8::StaticOrder, true, true>(lds3, g, S, E); }
    }
    SEAM(6);
    PHASE(7) { pg8::Gemm g{MERGED, Wo, M, 1024, D}; pg8::StaticOrder S; S.init(M, 1024, G, bid);
               pg8::EpiResidF E{x, out};
               pg8::gemm_phase<pg8::EpiResidF, pg8::StaticOrder, true, true>(lds3, g, S, E); }
    SEAM(7);
    PHASE(8) { const int gw = bid * 8 + wave, NGW = G * 8; for (int m = gw; m < M; m += NGW) rms_row_wave(out + (size_t)m * D, g_ffn, AFFN + (size_t)m * D, lane); }
    SEAM(8);
    PHASE(9) { pg8::Gemm g{AFFN, Wf1, M, FF, D}; pg8::StaticOrder S; S.init(M, FF, G, bid);
               pg8::EpiStore<2> E{HBUF, nullptr, nullptr, FF, -1};
               pg8::gemm_phase<pg8::EpiStore<2>, pg8::StaticOrder, true, true>(lds3, g, S, E); }
    SEAM(9);
    PHASE(10) { pg8::Gemm g{HBUF, Wf2, M, 1024, FF}; pg8::StaticOrder S; S.init(M, 1024, G, bid);
                pg8::EpiResidF E{out, out};
                pg8::gemm_phase<pg8::EpiResidF, pg8::StaticOrder, true, true>(lds3, g, S, E); }
    SEAM(10);
    PHASE(11) { run_vb<256>(M, lds, [=](VB vb) { rms_rows<false>(vb, out, g_final, out); }); }
}
constexpr int N_PHASES = 12;
#ifndef MK_PER_PHASE
#define MK_PER_PHASE 0
#endif
extern "C" void kernel_launch(void* const* d_in, const int* in_sizes, int n_in, void* d_out, int out_size, void* d_ws, size_t ws_size, hipStream_t stream) {
    static int grid = 0;
    if (grid == 0) {
        int dev = 0, cus = 0, per_cu = 0;
        (void)hipGetDevice(&dev); (void)hipDeviceGetAttribute(&cus, hipDeviceAttributeMultiprocessorCount, dev);
        (void)hipFuncSetAttribute((const void*)mega, hipFuncAttributeMaxDynamicSharedMemorySize, LDS_BYTES);
        (void)hipOccupancyMaxActiveBlocksPerMultiprocessor(&per_cu, (const void*)mega, NTHREADS, LDS_BYTES);
        if (per_cu < 1) { fprintf(stderr, "occupancy query says %d blocks/CU\n", per_cu); per_cu = 1; }
        grid = cus * 1;
        (void)hipGetLastError();
    }
    Args a{};
    for (int i = 0; i < 18; ++i) a.in[i] = (const float*)d_in[i];
    a.out = (float*)d_out; a.ws = (unsigned char*)d_ws;
#if MK_PER_PHASE
    for (int p = 0; p < N_PHASES; ++p) { a.ph_lo = p; a.ph_hi = p + 1; void* args[] = {&a};
        (void)hipLaunchCooperativeKernel((const void*)mega, dim3(grid), dim3(NTHREADS), args, LDS_BYTES, stream); }
#else
    a.ph_lo = 0; a.ph_hi = N_PHASES; void* args[] = {&a};
    hipError_t e = hipLaunchCooperativeKernel((const void*)mega, dim3(grid), dim3(NTHREADS), args, LDS_BYTES, stream);
    if (e != hipSuccess) fprintf(stderr, "cooperative launch failed: %s (grid %d)\n", hipGetErrorString(e), grid);
#endif
}
```

```cpp
#include <hip/hip_runtime.h>
#include <hip/hip_cooperative_groups.h>
#include <cstdio>
namespace cg = cooperative_groups;
#include <stdint.h>

typedef unsigned short bf16_t;
struct VB { int id; int tid; char* sm; };
__device__ __forceinline__ float bf2f(bf16_t v) { return __uint_as_float(((unsigned)v) << 16); }
__device__ __forceinline__ bf16_t f2bf(float f) { unsigned u = __float_as_uint(f); return (bf16_t)((u + 0x7fffu + ((u >> 16) & 1u)) >> 16); }

constexpr int NB = 4, T = 4096, M = NB * T, D = 1024, DIN = 6944, FF = 4096;
constexpr float EPS = 1e-6f;
constexpr int C_MLI = 2048, C_NSG = 3336, C_MG = 3872;
constexpr int P_MLQ = 0, P_MLK = 512, P_MLV = 1024, P_MLO = 1536, P_NSQ = 2048, P_KC = 2560, P_VC = 2688, P_KS = 2816, P_VS = 2944, P_KW = 3072, P_VW = 3200, P_XAQ = 3328, PW = 3840;
constexpr size_t MiB = 1u << 20;
constexpr size_t WS_U = 40 * MiB;
constexpr size_t WS_P = 72 * MiB;
constexpr size_t WS_Y = 192 * MiB;
constexpr size_t WS_AFFN = 200 * MiB;
constexpr size_t WS_S32 = 240 * MiB;
constexpr size_t WS_MEMN = 242 * MiB;
constexpr size_t WS_MEMKV = 244 * MiB;
constexpr size_t WS_KC = 246 * MiB;
constexpr size_t WS_VC = 246 * MiB + 512 * 1024;
constexpr size_t WS_NA = 247 * MiB;
constexpr size_t WS_G = 248 * MiB;
constexpr size_t WS_MLOC = 248 * MiB + 4096;
constexpr size_t WS_MPREV = 248 * MiB + 8192;

__device__ __forceinline__ float wave_sum(float v) {
#pragma unroll
    for (int o = 1; o < 64; o <<= 1) v += __shfl_xor(v, o);
    return v;
}
__device__ __forceinline__ float wave_max(float v) {
#pragma unroll
    for (int o = 1; o < 64; o <<= 1) v = fmaxf(v, __shfl_xor(v, o));
    return v;
}

template <bool OUT_BF16>
__device__ __forceinline__ void rms_rows(VB vb, const float* x, const float* g, void* out) {
    float* red = (float*)vb.sm;
    const int row = vb.id, tid = vb.tid;
    const float4 v = ((const float4*)(x + (size_t)row * D))[tid];
    float s = v.x * v.x + v.y * v.y + v.z * v.z + v.w * v.w;
    s = wave_sum(s);
    if ((tid & 63) == 0) red[tid >> 6] = s;
    __syncthreads();
    const float tot = red[0] + red[1] + red[2] + red[3];
    const float r = rsqrtf(tot * (1.0f / D) + EPS);
    const float4 gg = ((const float4*)g)[tid];
    float4 o; o.x = v.x * r * gg.x; o.y = v.y * r * gg.y; o.z = v.z * r * gg.z; o.w = v.w * r * gg.w;
    if (OUT_BF16) { bf16_t* ob = (bf16_t*)out + (size_t)row * D + tid * 4; ob[0] = f2bf(o.x); ob[1] = f2bf(o.y); ob[2] = f2bf(o.z); ob[3] = f2bf(o.w); }
    else ((float4*)((float*)out + (size_t)row * D))[tid] = o;
}

struct GArgs { const bf16_t* A; const float* W; int lda, ldw, N, K; };
template <class Epi>
__device__ __forceinline__ void ngemm(VB vb, GArgs ga, Epi epi) {
    const bf16_t* A = ga.A; const float* W = ga.W; const int lda = ga.lda, ldw = ga.ldw, N = ga.N, K = ga.K;
    float (*As)[65] = (float (*)[65])vb.sm; float (*Bs)[65] = (float (*)[65])(vb.sm + 16 * 65 * 4);
    const int tid = vb.tid, tx = tid & 15, ty = tid >> 4;
    const int nx = (N + 63) / 64; const int m0 = (vb.id / nx) * 64, n0 = (vb.id % nx) * 64;
    float acc[4][4];
#pragma unroll
    for (int i = 0; i < 4; ++i)
#pragma unroll
        for (int j = 0; j < 4; ++j) acc[i][j] = 0.f;
    for (int k0 = 0; k0 < K; k0 += 16) {
#pragma unroll
        for (int i = 0; i < 4; ++i) { const int idx = tid + i * 256, r = idx >> 4, kk = idx & 15; As[kk][r] = bf2f(A[(size_t)(m0 + r) * lda + k0 + kk]); }
#pragma unroll
        for (int i = 0; i < 4; ++i) { const int idx = tid + i * 256, kk = idx >> 6, n = idx & 63; Bs[kk][n] = (n0 + n < N) ? W[(size_t)(k0 + kk) * ldw + n0 + n] : 0.f; }
        __syncthreads();
#pragma unroll
        for (int kk = 0; kk < 16; ++kk) {
            float a[4], b[4];
#pragma unroll
            for (int i = 0; i < 4; ++i) { a[i] = As[kk][ty * 4 + i]; b[i] = Bs[kk][tx * 4 + i]; }
#pragma unroll
            for (int i = 0; i < 4; ++i)
#pragma unroll
                for (int j = 0; j < 4; ++j) acc[i][j] += a[i] * b[j];
        }
        __syncthreads();
    }
#pragma unroll
    for (int i = 0; i < 4; ++i)
#pragma unroll
        for (int j = 0; j < 4; ++j) { const int n = n0 + tx * 4 + j; if (n < N) epi(m0 + ty * 4 + i, n, acc[i][j]); }
}
struct EpiBiasBf16 { bf16_t* O; const float* bias; int ldo, pad; __device__ void operator()(int m, int n, float a) const { O[(size_t)m * ldo + n] = f2bf(a + (bias ? bias[n] : 0.f)); } };
struct EpiBiasF32 { float* O; const float* bias; int ldo, pad; __device__ void operator()(int m, int n, float a) const { O[(size_t)m * ldo + n] = a + bias[n]; } };
struct EpiSigBf16 { bf16_t* O; const float* bias; int ldo, pad; __device__ void operator()(int m, int n, float a) const { const float v = a + bias[n]; O[(size_t)m * ldo + n] = f2bf(1.f / (1.f + __expf(-v))); } };
struct EpiMerge { const bf16_t* G; float* Mf; bf16_t* Mb; int j, pad; __device__ void operator()(int m, int n, float a) const {
    const float g = bf2f(G[(size_t)m * 3072 + j * 1024 + n]); float v = g * a; if (j > 0) v += Mf[(size_t)m * D + n];
    if (j < 2) Mf[(size_t)m * D + n] = v; else Mb[(size_t)m * D + n] = f2bf(v); } };
struct EpiResid { const float* X; float* O; __device__ void operator()(int m, int n, float a) const { O[(size_t)m * D + n] = X[(size_t)m * D + n] + a; } };
struct EpiRelu2 { bf16_t* O; __device__ void operator()(int m, int n, float a) const { const float r = fmaxf(a, 0.f); O[(size_t)m * FF + n] = f2bf(r * r); } };

__device__ __forceinline__ float convqk(const bf16_t* P, const float* w  , int m, int t, int ch) {
    float y = 0.f;
#pragma unroll
    for (int j = 0; j < 4; ++j) if (t - j >= 0) y += w[j * 1024 + ch] * bf2f(P[(size_t)(m - j) * PW + ch]);
    return bf2f(f2bf(y / (1.f + __expf(-y))));
}
__device__ __forceinline__ float logsig(float x) { return fminf(x, 0.f) - log1pf(__expf(-fabsf(x))); }
__device__ __forceinline__ void m1_naive(VB vb, const bf16_t* P, const float* cw, const float* S32, float* Abuf, float* NA, float* Gc, float* Mloc) {
    float (*kk)[128] = (float (*)[128])vb.sm; float* e = (float*)(vb.sm + 32768); float* bc = e + 64;
    const int ci = vb.id, c = ci & 63, bh = ci >> 6, h = bh & 3, b = bh >> 2, tid = vb.tid;
    const int m0 = b * T + c * 64;
    if (tid == 0) {
        float run = 0.f;
        for (int s = 0; s < 64; ++s) { run += logsig(S32[(size_t)(m0 + s) * 32 + 4 + h]); bc[s] = run; }
        const float g = run; float mx = -INFINITY;
        for (int s = 0; s < 64; ++s) { const float w = g - bc[s] + S32[(size_t)(m0 + s) * 32 + h]; e[s] = w; mx = fmaxf(mx, w); }
        for (int s = 0; s < 64; ++s) e[s] = __expf(e[s] - mx);
        Gc[ci] = g; Mloc[ci] = mx;
    }
    for (int i = tid; i < 64 * 128; i += 256) { const int s = i >> 7, k = i & 127; kk[s][k] = convqk(P, cw, m0 + s, c * 64 + s, 512 + h * 128 + k) * 0.08838834764831845f; }
    __syncthreads();
    const int v = tid & 127, kh = tid >> 7;
    float acc[64];
#pragma unroll
    for (int i = 0; i < 64; ++i) acc[i] = 0.f;
    for (int s = 0; s < 64; ++s) {
        const float ev = e[s] * bf2f(P[(size_t)(m0 + s) * PW + P_MLV + h * 128 + v]);
#pragma unroll
        for (int i = 0; i < 64; ++i) acc[i] += kk[s][kh * 64 + i] * ev;
    }
#pragma unroll
    for (int i = 0; i < 64; ++i) Abuf[((size_t)ci * 128 + kh * 64 + i) * 128 + v] = acc[i];
    if (tid < 128) { float n = 0.f; for (int s = 0; s < 64; ++s) n += e[s] * kk[s][tid]; NA[(size_t)ci * 128 + tid] = n; }
}
__device__ __forceinline__ void m2_naive(VB vb, float* Abuf, float* NA, const float* Gc, const float* Mloc, float* Mprev) {
    const int i = vb.id * 256 + vb.tid;
    const int bh = i >> 14, kv = i & 16383, k = kv >> 7, v = kv & 127;
    float C = 0.f, n = 0.f, m = 0.f;
    for (int c = 0; c < 64; ++c) {
        const int ci = bh * 64 + c;
        const float g = Gc[ci], ml = Mloc[ci];
        const float mn = fmaxf(g + m, ml), a = __expf(g + m - mn), bb = __expf(ml - mn);
        const size_t idx = ((size_t)ci * 128 + k) * 128 + v;
        const float A = Abuf[idx]; Abuf[idx] = C; C = a * C + bb * A;
        if (v == 0) { const float nA = NA[(size_t)ci * 128 + k]; NA[(size_t)ci * 128 + k] = n; n = a * n + bb * nA; }
        if (kv == 0) Mprev[ci] = m;
        m = mn;
    }
}
__device__ __forceinline__ void m3_naive(VB vb, const bf16_t* P, const float* cw, const float* S32, const float* Cprev, const float* Nprev, const float* Mprev,
                                                const float* normg, bf16_t* Yml) {
    float* q = (float*)vb.sm; float* Srow = q + 128; float* bc = Srow + 64; float* li = bc + 64; float* sh = li + 64;
    const int ci = vb.id >> 6, tt = vb.id & 63, c = ci & 63, bh = ci >> 6, h = bh & 3, b = bh >> 2, tid = vb.tid;
    const int m0 = b * T + c * 64, m = m0 + tt;
    q[tid] = convqk(P, cw, m, c * 64 + tt, h * 128 + tid);
    if (tid == 0) { float run = 0.f; for (int s = 0; s <= tt; ++s) { run += logsig(S32[(size_t)(m0 + s) * 32 + 4 + h]); bc[s] = run; li[s] = S32[(size_t)(m0 + s) * 32 + h]; } }
    __syncthreads();
    const float mprev = Mprev[ci], inter = bc[tt] + mprev;
    float mt = inter;
    for (int s = 0; s <= tt; ++s) mt = fmaxf(mt, bc[tt] - bc[s] + li[s]);
    if (tid < 64) {
        float sv = 0.f;
        if (tid <= tt) { float dot = 0.f; for (int k = 0; k < 128; ++k) dot += q[k] * convqk(P, cw, m0 + tid, c * 64 + tid, 512 + h * 128 + k);
            sv = dot * 0.08838834764831845f * __expf(bc[tt] - bc[tid] + li[tid] - mt); }
        Srow[tid] = sv;
    }
    __syncthreads();
    const float sc = __expf(inter - mt);
    float num = 0.f, den = 0.f;
    for (int s = 0; s <= tt; ++s) { num += Srow[s] * bf2f(P[(size_t)(m0 + s) * PW + P_MLV + h * 128 + tid]); den += Srow[s]; }
    float qc = 0.f, qn = 0.f;
    for (int k = 0; k < 128; ++k) { qc += q[k] * Cprev[((size_t)ci * 128 + k) * 128 + tid]; qn += q[k] * Nprev[(size_t)ci * 128 + k]; }
    num += sc * qc; den += sc * qn;
    const float hv = num / fmaxf(fabsf(den), __expf(-mt));
    float ss = wave_sum(hv * hv);
    if ((tid & 63) == 0) sh[tid >> 6] = ss;
    __syncthreads();
    const float r = rsqrtf((sh[0] + sh[1]) * (1.f / 128.f) + EPS);
    const float o = bf2f(P[(size_t)m * PW + P_MLO + h * 128 + tid]);
    Yml[(size_t)m * 512 + h * 128 + tid] = f2bf(1.f / (1.f + __expf(-o)) * hv * r * normg[h * 128 + tid]);
}

__device__ __forceinline__ float gelu_tanh(float x) { const float u = 0.7978845608028654f * (x + 0.044715f * x * x * x); return 0.5f * x * (1.f + tanhf(u)); }
__device__ __forceinline__ void n1_naive(VB vb, const bf16_t* P, const float* pe  , const float* w1  , const float* w2  , bf16_t* KC, bf16_t* VC) {
    float* xin = (float*)vb.sm; float* hid = xin + 2048;
    int idx = vb.id; const int g = idx & 1; idx >>= 1; const int n = idx % 255; idx /= 255; const int b = idx & 3, kv = idx >> 2, tid = vb.tid;
    const int pcol = (kv ? P_VC : P_KC) + g * 64;
    for (int i = tid; i < 2048; i += 256) { const int l = i >> 6, d = i & 63; xin[i] = bf2f(P[(size_t)(b * T + n * 16 + l) * PW + pcol + d]) + pe[kv * 2048 + i]; }
    __syncthreads();
    float a = 0.f; const float* w = w1 + (size_t)kv * 2048 * 256 + tid;
    for (int i = 0; i < 2048; ++i) a += xin[i] * w[(size_t)i * 256];
    hid[tid] = gelu_tanh(a);
    __syncthreads();
    if (tid < 64) { float o = 0.f; const float* ww = w2 + (size_t)kv * 256 * 64 + tid; for (int j = 0; j < 256; ++j) o += hid[j] * ww[j * 64];
        (kv ? VC : KC)[((size_t)(b * 256 + n) * 2 + g) * 64 + tid] = f2bf(o); }
}
__device__ __forceinline__ void n2_naive(VB vb, const bf16_t* P, const float* S32, const bf16_t* KC, const bf16_t* VC, bf16_t* Ynsa) {
    float (*q_s)[64] = (float (*)[64])vb.sm; float (*sc)[1024] = (float (*)[1024])(vb.sm + 1024); float (*pc)[256] = (float (*)[256])(vb.sm + 1024 + 16384); float* imp_s = (float*)(vb.sm + 1024 + 16384 + 4096);
    unsigned long long& selmask = *(unsigned long long*)(vb.sm + 1024 + 16384 + 4096 + 256);
    const int g = vb.id & 1, m = vb.id >> 1, b = m / T, t = m % T, tid = vb.tid, r = tid >> 6, lane = tid & 63, h = g * 4 + r;
    const float slope = exp2f(-(float)(h + 1));
    q_s[r][lane] = bf2f(P[(size_t)m * PW + P_NSQ + h * 64 + lane]) * 0.125f;
    __syncthreads();
    float sv[4]; float mx = -INFINITY;
#pragma unroll
    for (int i = 0; i < 4; ++i) { const int n = lane + 64 * i; sv[i] = -INFINITY;
        if (n < 255) { const int dist = t - (16 * n + 31); if (dist >= 0) { const bf16_t* kr = KC + ((size_t)(b * 256 + n) * 2 + g) * 64; float dot = 0.f; for (int d = 0; d < 64; ++d) dot += q_s[r][d] * bf2f(kr[d]);
            sv[i] = dot - slope * (float)dist; mx = fmaxf(mx, sv[i]); } } }
    mx = wave_max(mx);
    float sum = 0.f;
#pragma unroll
    for (int i = 0; i < 4; ++i) { sv[i] = (sv[i] == -INFINITY) ? 0.f : __expf(sv[i] - mx); sum += sv[i]; }
    sum = wave_sum(sum);
    const float inv = sum > 0.f ? 1.f / sum : 0.f;
#pragma unroll
    for (int i = 0; i < 4; ++i) pc[r][lane + 64 * i] = sv[i] * inv;
    __syncthreads();
    float oc = 0.f;
    { const int nmax = (t >= 31) ? ((t - 31) / 16) : -1; for (int n = 0; n <= nmax && n < 255; ++n) oc += pc[r][n] * bf2f(VC[((size_t)(b * 256 + n) * 2 + g) * 64 + lane]); }
    if (tid < 64) { const int j = tid; float im = 0.f;
        for (int n = 4 * j - 1; n <= 4 * j + 3; ++n) if (n >= 0 && n < 255) im += (pc[0][n] + pc[1][n]) + (pc[2][n] + pc[3][n]);
        const int cur = t >> 6; const bool valid = j <= cur, forced = (j == 0) || (j == cur) || (j == cur - 1);
        const float s = valid ? im + (forced ? 1000.f : 0.f) : -1e30f;
        imp_s[j] = s; }
    __syncthreads();
    if (tid < 64) { const int j = tid; const float s = imp_s[j]; int rank = 0;
        for (int jj = 0; jj < 64; ++jj) { const float o = imp_s[jj]; rank += (o > s || (o == s && jj < j)) ? 1 : 0; }
        const unsigned long long mk = __ballot(rank < 16 && j <= (t >> 6)); if (tid == 0) selmask = mk; }
    __syncthreads();
    float osel = 0.f;
    { unsigned long long mk = selmask; int slot = 0; float mxs = -INFINITY;
      while (mk) { const int jb = __ffsll((long long)mk) - 1; mk &= mk - 1; const int pos = jb * 64 + lane; float s = -INFINITY;
          if (pos <= t) { const bf16_t* kr = P + (size_t)(b * T + pos) * PW + P_KS + g * 64; float dot = 0.f; for (int d = 0; d < 64; ++d) dot += q_s[r][d] * bf2f(kr[d]); s = dot - slope * (float)(t - pos); }
          sc[r][slot * 64 + lane] = s; mxs = fmaxf(mxs, s); ++slot; }
      mxs = wave_max(mxs); float sm = 0.f;
      for (int i = 0; i < slot; ++i) { const float s = sc[r][i * 64 + lane]; const float p = (s == -INFINITY) ? 0.f : __expf(s - mxs); sc[r][i * 64 + lane] = p; sm += p; }
      sm = wave_sum(sm);
      mk = selmask; slot = 0;
      while (mk) { const int jb = __ffsll((long long)mk) - 1; mk &= mk - 1;
          for (int i = 0; i < 64; ++i) { const int pos = jb * 64 + i; if (pos > t) break; osel += sc[r][slot * 64 + i] * bf2f(P[(size_t)(b * T + pos) * PW + P_VS + g * 64 + lane]); }
          ++slot; }
      osel /= sm; }
    __syncthreads();
    float owin = 0.f;
    { float mxs = -INFINITY;
      for (int i = 0; i < 8; ++i) { const int pos = t - 511 + i * 64 + lane; float s = -INFINITY;
          if (pos >= 0) { const bf16_t* kr = P + (size_t)(b * T + pos) * PW + P_KW + g * 64; float dot = 0.f; for (int d = 0; d < 64; ++d) dot += q_s[r][d] * bf2f(kr[d]); s = dot - slope * (float)(t - pos); }
          sc[r][i * 64 + lane] = s; mxs = fmaxf(mxs, s); }
      mxs = wave_max(mxs); float sm = 0.f;
      for (int i = 0; i < 8; ++i) { const float s = sc[r][i * 64 + lane]; const float p = (s == -INFINITY) ? 0.f : __expf(s - mxs); sc[r][i * 64 + lane] = p; sm += p; }
      sm = wave_sum(sm);
      for (int i = 0; i < 512; ++i) { const int pos = t - 511 + i; if (pos < 0) continue; owin += sc[r][i] * bf2f(P[(size_t)(b * T + pos) * PW + P_VW + g * 64 + lane]); }
      owin /= sm; }
    const float* gp = S32 + (size_t)m * 32 + 8 + h * 3;
    const float g0 = 1.f / (1.f + __expf(-gp[0])), g1 = 1.f / (1.f + __expf(-gp[1])), g2 = 1.f / (1.f + __expf(-gp[2]));
    Ynsa[(size_t)m * 512 + h * 64 + lane] = f2bf(g0 * oc + g1 * osel + g2 * owin);
}
__device__ __forceinline__ void x1_naive(VB vb, const bf16_t* P, const bf16_t* MEMKV, bf16_t* Yxa) {
    float (*q_s)[128] = (float (*)[128])vb.sm; float (*p_s)[256] = (float (*)[256])(vb.sm + 2048);
    const int m = vb.id, b = m / T, tid = vb.tid, h = tid >> 6, lane = tid & 63;
    q_s[h][lane] = bf2f(P[(size_t)m * PW + P_XAQ + h * 128 + lane]) * 0.08838834764831845f;
    q_s[h][lane + 64] = bf2f(P[(size_t)m * PW + P_XAQ + h * 128 + lane + 64]) * 0.08838834764831845f;
    __syncthreads();
    float sv[4]; float mx = -INFINITY;
#pragma unroll
    for (int i = 0; i < 4; ++i) { const int j = lane + 64 * i; const bf16_t* kr = MEMKV + (size_t)(b * 256 + j) * 1024 + h * 128; float dot = 0.f; for (int d = 0; d < 128; ++d) dot += q_s[h][d] * bf2f(kr[d]); sv[i] = dot; mx = fmaxf(mx, dot); }
    mx = wave_max(mx); float sm = 0.f;
#pragma unroll
    for (int i = 0; i < 4; ++i) { sv[i] = __expf(sv[i] - mx); sm += sv[i]; }
    sm = wave_sum(sm);
#pragma unroll
    for (int i = 0; i < 4; ++i) p_s[h][lane + 64 * i] = sv[i] / sm;
    __syncthreads();
    float o0 = 0.f, o1 = 0.f;
    for (int j = 0; j < 256; ++j) { const bf16_t* vr = MEMKV + (size_t)(b * 256 + j) * 1024 + 512 + h * 128; const float p = p_s[h][j]; o0 += p * bf2f(vr[lane]); o1 += p * bf2f(vr[lane + 64]); }
    Yxa[(size_t)m * 512 + h * 128 + lane] = f2bf(o0); Yxa[(size_t)m * 512 + h * 128 + lane + 64] = f2bf(o1);
}


namespace pg8 {
#define PG8_LAS __attribute__((address_space(3)))
typedef unsigned short bf16_t;
typedef short bf16x8 __attribute__((ext_vector_type(8)));
typedef float f32x4 __attribute__((ext_vector_type(4)));
typedef unsigned u32x4 __attribute__((ext_vector_type(4)));
constexpr int BM = 256, BK = 64, HALF = 128, HTB = HALF * BK * 2  , STAGE_BYTES = 8 * HTB, NXCD = 8, WGM = 8;

__host__ __device__ __forceinline__ int lds_byte(int r, int c) { const int st = (r >> 4) * 2 + (c >> 5), rr = r & 15, cc = c & 31, ob = rr * 64 + cc * 2; return st * 1024 + (ob ^ (((ob >> 9) & 1) << 5)); }
__host__ __device__ __forceinline__ void stage_rc(int b, int& R, int& C) { const int st = b / 1024, sb = b % 1024, swz = sb ^ (((sb >> 9) & 1) << 5); R = (st >> 1) * 16 + swz / 64; C = (st & 1) * 32 + (swz % 64) / 2; }
__host__ __device__ __forceinline__ int perm32(int rho) { const int n = rho >> 4, i = rho & 15; return 8 * (i >> 2) + 4 * n + (i & 3); }

struct Unit { int pm, pn; };
struct Gemm { const bf16_t* A; const bf16_t* Bt; int M, N, K; };

struct StaticOrder {
    int nM, nN, nwg, G, c;
    __host__ __device__ void init(int M, int N, int G_, int c_) { nM = M / BM; nN = N / BM; nwg = nM * nN; G = G_; c = c_; }
    __host__ __device__ bool next(int i, Unit& u) const {
        const long L = (long)i * G + c; if (L >= nwg) return false;
        int wgid = (int)L; { const int q = nwg / NXCD, r = nwg % NXCD, xcd = wgid % NXCD, off = wgid / NXCD; wgid = (xcd < r ? xcd * (q + 1) : r * (q + 1) + (xcd - r) * q) + off; }
        const int nig = WGM * nN, gid = wgid / nig, fm = gid * WGM, gsz = (nM - fm) < WGM ? (nM - fm) : WGM;
        u.pm = fm + ((wgid % nig) % gsz); u.pn = (wgid % nig) / gsz; return true;
    }
    __device__ __forceinline__ void a_ready(const Unit&) const {}
    __device__ __forceinline__ void done(const Unit&) const {}
};

typedef float f32x2_t __attribute__((ext_vector_type(2))); typedef __bf16 bf16x2_t __attribute__((ext_vector_type(2)));
__device__ __forceinline__ unsigned cvt_pk_bf16(float lo, float hi) { f32x2_t v = {lo, hi}; bf16x2_t b = __builtin_convertvector(v, bf16x2_t); return __builtin_bit_cast(unsigned, b); }
typedef float f32x2 __attribute__((ext_vector_type(2)));

typedef unsigned u32x2 __attribute__((ext_vector_type(2)));
__device__ __forceinline__ float bflo(unsigned w) { return __uint_as_float(w << 16); }
__device__ __forceinline__ float bfhi(unsigned w) { return __uint_as_float(w & 0xffff0000u); }
template <int ACT> __device__ __forceinline__ f32x4 act4(f32x4 v) {
    if (ACT == 1) { f32x4 o; for (int e = 0; e < 4; ++e) o[e] = __builtin_amdgcn_rcpf(1.f + __expf(-v[e])); return o; }
    if (ACT == 2) { f32x4 o; for (int e = 0; e < 4; ++e) { const float r = fmaxf(v[e], 0.f); o[e] = r * r; } return o; }
    return v;
}
template <int ACT> struct EpiStore {
    static constexpr bool PERM = true, AFTER_DRAIN = false;
    bf16_t* O; const float* bias; float* S32; int ldc, small_pn;
    __device__ __forceinline__ void operator()(const f32x4 (&acc)[2][2][4][2], const Unit& u, int wr, int wc, int fr, int fq) const {
        asm volatile("s_waitcnt vmcnt(0)" ::: "memory");
        const int row0 = u.pm * BM + wr * 64 + fr, col0 = u.pn * BM + wc * 32 + 8 * fq;
        if (u.pn == small_pn) {
            if (wc == 0) {
                const f32x4 b0 = *(const f32x4*)(bias + col0), b1 = *(const f32x4*)(bias + col0 + 4);
#pragma unroll
                for (int ai = 0; ai < 2; ++ai)
#pragma unroll
                    for (int m = 0; m < 4; ++m) { float* rp = S32 + (size_t)(row0 + ai * HALF + m * 16) * 32 + 8 * fq;
                        *(f32x4*)rp = acc[ai][0][m][0] + acc[ai][1][m][0] + b0; *(f32x4*)(rp + 4) = acc[ai][0][m][1] + acc[ai][1][m][1] + b1; }
            }
            return;
        }
        f32x4 bv[2][2];
#pragma unroll
        for (int bj = 0; bj < 2; ++bj)
#pragma unroll
            for (int n = 0; n < 2; ++n) bv[bj][n] = bias ? *(const f32x4*)(bias + col0 + bj * HALF + 4 * n) : (f32x4){0.f, 0.f, 0.f, 0.f};
#pragma unroll
        for (int ai = 0; ai < 2; ++ai)
#pragma unroll
            for (int m = 0; m < 4; ++m) { bf16_t* rowp = O + (size_t)(row0 + ai * HALF + m * 16) * ldc + col0;
#pragma unroll
                for (int bj = 0; bj < 2; ++bj) { const f32x4 v0 = act4<ACT>(acc[ai][bj][m][0] + bv[bj][0]), v1 = act4<ACT>(acc[ai][bj][m][1] + bv[bj][1]);
                    u32x4 w; w.x = cvt_pk_bf16(v0[0], v0[1]); w.y = cvt_pk_bf16(v0[2], v0[3]); w.z = cvt_pk_bf16(v1[0], v1[1]); w.w = cvt_pk_bf16(v1[2], v1[3]);
                    *(u32x4*)(rowp + bj * HALF) = w; } }
    }
};
struct EpiMergeG {
    static constexpr bool PERM = true, AFTER_DRAIN = false;
    const bf16_t* G; float* Mf; bf16_t* Mb; int j, pad;
    __device__ __forceinline__ void operator()(const f32x4 (&acc)[2][2][4][2], const Unit& u, int wr, int wc, int fr, int fq) const {
        asm volatile("s_waitcnt vmcnt(0)" ::: "memory");
        const int row0 = u.pm * BM + wr * 64 + fr, col0 = u.pn * BM + wc * 32 + 8 * fq;
#pragma unroll
        for (int ai = 0; ai < 2; ++ai)
#pragma unroll
            for (int m = 0; m < 4; ++m) { const size_t row = (size_t)(row0 + ai * HALF + m * 16);
#pragma unroll
                for (int bj = 0; bj < 2; ++bj) { const int col = col0 + bj * HALF;
                    const u32x4 gw = *(const u32x4*)(G + row * 3072 + j * 1024 + col);
                    f32x4 v0 = (f32x4){bflo(gw.x), bfhi(gw.x), bflo(gw.y), bfhi(gw.y)} * acc[ai][bj][m][0], v1 = (f32x4){bflo(gw.z), bfhi(gw.z), bflo(gw.w), bfhi(gw.w)} * acc[ai][bj][m][1];
                    float* mp = Mf + row * 1024 + col;
                    if (j > 0) { v0 += *(const f32x4*)mp; v1 += *(const f32x4*)(mp + 4); }
                    if (j < 2) { *(f32x4*)mp = v0; *(f32x4*)(mp + 4) = v1; }
                    else { u32x4 w; w.x = cvt_pk_bf16(v0[0], v0[1]); w.y = cvt_pk_bf16(v0[2], v0[3]); w.z = cvt_pk_bf16(v1[0], v1[1]); w.w = cvt_pk_bf16(v1[2], v1[3]); *(u32x4*)(Mb + row * 1024 + col) = w; } } }
    }
};
struct EpiResidF {
    static constexpr bool PERM = true, AFTER_DRAIN = false;
    const float* X; float* O;
    __device__ __forceinline__ void operator()(const f32x4 (&acc)[2][2][4][2], const Unit& u, int wr, int wc, int fr, int fq) const {
        asm volatile("s_waitcnt vmcnt(0)" ::: "memory");
        const int row0 = u.pm * BM + wr * 64 + fr, col0 = u.pn * BM + wc * 32 + 8 * fq;
#pragma unroll
        for (int ai = 0; ai < 2; ++ai)
#pragma unroll
            for (int m = 0; m < 4; ++m) { const size_t off = (size_t)(row0 + ai * HALF + m * 16) * 1024 + col0;
#pragma unroll
                for (int bj = 0; bj < 2; ++bj) { const f32x4 x0 = *(const f32x4*)(X + off + bj * HALF), x1 = *(const f32x4*)(X + off + bj * HALF + 4);
                    *(f32x4*)(O + off + bj * HALF) = x0 + acc[ai][bj][m][0]; *(f32x4*)(O + off + bj * HALF + 4) = x1 + acc[ai][bj][m][1]; } }
    }
};
template <class Epi, class Sched, bool ALIGN_EPI = false, bool SP2 = false>
__device__ __forceinline__ void gemm_phase(PG8_LAS unsigned char* lds, const Gemm g, const Sched& S, const Epi& E) {
    const int tid = threadIdx.x, wid = __builtin_amdgcn_readfirstlane(tid >> 6), lane = tid & 63, wr = wid >> 2, wc = wid & 3, fr = lane & 15, fq = lane >> 4;
    const int K = g.K, nt = K / BK;
    unsigned voffA[2], voffB[2];
#pragma unroll
    for (int i = 0; i < 2; ++i) { int R, C; stage_rc(tid * 16 + i * 8192, R, C); const int Rb = Epi::PERM ? ((R & ~31) + perm32(R & 31)) : R;
        voffA[i] = (unsigned)(R * K + C) * 2u; voffB[i] = (unsigned)(Rb * K + C) * 2u; }
    const size_t kstep = (size_t)(BK * 2);
    const size_t hstep = (size_t)HALF * K * 2;
    const size_t tstep = 2 * hstep;
    const unsigned ldsw = (unsigned)wid * 1024u;
    const int aoff = lds_byte(wr * 64 + fr, fq * 8), boff = lds_byte(wc * 32 + fr, fq * 8);
#define PG8_SA(b, h) (((b) * 2 + (h)) * HTB)
#define PG8_SB(b, h) ((4 + (b) * 2 + (h)) * HTB)
#define PG8_STAGE(bufoff, gbase, voff) do { _Pragma("unroll") for (int _i = 0; _i < 2; ++_i) \
        __builtin_amdgcn_global_load_lds((const unsigned*)((const char*)(gbase) + (voff)[_i]), (PG8_LAS unsigned*)(lds + (bufoff) + ldsw + _i * 8192), 16, 0, 0); } while (0)
#define PG8_LDA(dst, b, h) do { _Pragma("unroll") for (int m = 0; m < 4; ++m) _Pragma("unroll") for (int k = 0; k < 2; ++k) dst[m][k] = *(const PG8_LAS bf16x8*)(lds + PG8_SA(b, h) + aoff + m * 2048 + k * 1024); } while (0)
#define PG8_LDB(dst, b, h) do { _Pragma("unroll") for (int n = 0; n < 2; ++n) _Pragma("unroll") for (int k = 0; k < 2; ++k) dst[n][k] = *(const PG8_LAS bf16x8*)(lds + PG8_SB(b, h) + boff + n * 2048 + k * 1024); } while (0)
#define PG8_MMA(ai, bj, At, Bt) do { __builtin_amdgcn_s_setprio(1); _Pragma("unroll") for (int m = 0; m < 4; ++m) _Pragma("unroll") for (int n = 0; n < 2; ++n) _Pragma("unroll") for (int k = 0; k < 2; ++k) \
        acc[ai][bj][m][n] = __builtin_amdgcn_mfma_f32_16x16x32_bf16(Bt[n][k], At[m][k], acc[ai][bj][m][n], 0, 0, 0); __builtin_amdgcn_s_setprio(0); } while (0)
#define PG8_WAIT_V(n) asm volatile("s_waitcnt vmcnt(" #n ")" ::: "memory")
#define PG8_WAIT_L(n) asm volatile("s_waitcnt lgkmcnt(" #n ")" ::: "memory")
#define PG8_BAR __builtin_amdgcn_s_barrier()
#define PG8_SCHED __builtin_amdgcn_sched_barrier(0)
    Unit cur, nxt; int ui = 0;
    if (!S.next(0, cur)) return;
    f32x4 acc[2][2][4][2];
#pragma unroll
    for (int a = 0; a < 2; ++a)
#pragma unroll
        for (int b = 0; b < 2; ++b)
#pragma unroll
            for (int m = 0; m < 4; ++m)
#pragma unroll
                for (int n = 0; n < 2; ++n) acc[a][b][m][n] = (f32x4){0.f, 0.f, 0.f, 0.f};
    bf16x8 At[4][2], B0[2][2], B1[2][2];
    const char* cA = (const char*)g.A + (size_t)cur.pm * tstep; const char* cB = (const char*)g.Bt + (size_t)cur.pn * tstep;
    S.a_ready(cur);
    if constexpr (SP2) {
        PG8_STAGE(PG8_SB(0, 0), cB, voffB); PG8_STAGE(PG8_SB(0, 1), cB + hstep, voffB); PG8_STAGE(PG8_SA(0, 0), cA, voffA); PG8_STAGE(PG8_SA(0, 1), cA + hstep, voffA);
        if (wr == 1) PG8_BAR;
        PG8_WAIT_V(2); PG8_BAR;
        PG8_STAGE(PG8_SB(1, 0), cB + kstep, voffB); PG8_STAGE(PG8_SA(1, 0), cA + kstep, voffA); PG8_STAGE(PG8_SB(1, 1), cB + hstep + kstep, voffB);
        PG8_WAIT_V(6); PG8_BAR;
    } else {
        PG8_STAGE(PG8_SB(0, 0), cB, voffB); PG8_STAGE(PG8_SA(0, 0), cA, voffA); PG8_STAGE(PG8_SB(0, 1), cB + hstep, voffB); PG8_STAGE(PG8_SA(0, 1), cA + hstep, voffA);
        if (wr == 1) PG8_BAR;
        PG8_WAIT_V(4); PG8_BAR;
        PG8_STAGE(PG8_SB(1, 0), cB + kstep, voffB); PG8_STAGE(PG8_SA(1, 0), cA + kstep, voffA); PG8_STAGE(PG8_SB(1, 1), cB + hstep + kstep, voffB);
        PG8_WAIT_V(6); PG8_BAR;
    }
    for (;;) {
        const bool has_next = S.next(ui + 1, nxt);
        const char* nA = has_next ? (const char*)g.A + (size_t)nxt.pm * tstep : cA; const char* nB = has_next ? (const char*)g.Bt + (size_t)nxt.pn * tstep : cB;
        for (int t = 0; t < nt; t += 2) {
            const bool last = (t == nt - 2);
            const char* a1 = cA + (size_t)(t + 1) * kstep;
            const char* a2 = last ? nA : cA + (size_t)(t + 2) * kstep; const char* b2 = last ? nB : cB + (size_t)(t + 2) * kstep;
            const char* a3 = a2 + kstep; const char* b3 = b2 + kstep;
            if (last && has_next) S.a_ready(nxt);
            if constexpr (SP2) {
            PG8_LDB(B0, 0, 0); PG8_LDB(B1, 0, 1); PG8_SCHED; PG8_LDA(At, 0, 0); PG8_STAGE(PG8_SA(1, 1), a1 + hstep, voffA);
            PG8_WAIT_V(8); PG8_WAIT_L(0); PG8_BAR; PG8_MMA(0, 0, At, B0); PG8_MMA(0, 1, At, B1); PG8_BAR; PG8_SCHED;
            PG8_LDA(At, 0, 1); PG8_STAGE(PG8_SB(0, 0), b2, voffB); PG8_STAGE(PG8_SB(0, 1), b2 + hstep, voffB); PG8_STAGE(PG8_SA(0, 0), a2, voffA);
            PG8_WAIT_V(8); PG8_WAIT_L(0); PG8_BAR; PG8_MMA(1, 0, At, B0); PG8_MMA(1, 1, At, B1); PG8_BAR; PG8_SCHED;
            PG8_LDB(B0, 1, 0); PG8_LDB(B1, 1, 1); PG8_SCHED; PG8_LDA(At, 1, 0); PG8_STAGE(PG8_SA(0, 1), a2 + hstep, voffA);
            PG8_WAIT_V(8); PG8_WAIT_L(0); PG8_BAR; PG8_MMA(0, 0, At, B0); PG8_MMA(0, 1, At, B1); PG8_BAR; PG8_SCHED;
            PG8_LDA(At, 1, 1); PG8_STAGE(PG8_SB(1, 0), b3, voffB); PG8_STAGE(PG8_SB(1, 1), b3 + hstep, voffB); PG8_STAGE(PG8_SA(1, 0), a3, voffA);
            PG8_WAIT_V(8); PG8_WAIT_L(0); PG8_BAR; PG8_MMA(1, 0, At, B0); PG8_MMA(1, 1, At, B1); PG8_BAR; PG8_SCHED;
            } else {
            PG8_LDB(B0, 0, 0); PG8_SCHED; PG8_LDA(At, 0, 0); PG8_STAGE(PG8_SA(1, 1), a1 + hstep, voffA);
            PG8_WAIT_L(8); PG8_BAR; PG8_WAIT_L(0); PG8_MMA(0, 0, At, B0); PG8_BAR; PG8_SCHED;
            PG8_LDB(B1, 0, 1); PG8_STAGE(PG8_SB(0, 0), b2, voffB);
            PG8_BAR; PG8_WAIT_L(0); PG8_MMA(0, 1, At, B1); PG8_BAR;
            PG8_LDA(At, 0, 1); PG8_STAGE(PG8_SA(0, 0), a2, voffA);
            PG8_BAR; PG8_WAIT_L(0); PG8_MMA(1, 0, At, B0); PG8_BAR; PG8_SCHED;
            PG8_STAGE(PG8_SB(0, 1), b2 + hstep, voffB);
            PG8_WAIT_V(6); PG8_BAR; PG8_MMA(1, 1, At, B1); PG8_BAR;
            PG8_LDB(B0, 1, 0); PG8_SCHED; PG8_LDA(At, 1, 0); PG8_STAGE(PG8_SA(0, 1), a2 + hstep, voffA);
            PG8_WAIT_L(8); PG8_BAR; PG8_WAIT_L(0); PG8_MMA(0, 0, At, B0); PG8_BAR; PG8_SCHED;
            PG8_LDB(B1, 1, 1); PG8_STAGE(PG8_SB(1, 0), b3, voffB);
            PG8_BAR; PG8_WAIT_L(0); PG8_MMA(0, 1, At, B1); PG8_BAR;
            PG8_LDA(At, 1, 1); PG8_STAGE(PG8_SA(1, 0), a3, voffA);
            PG8_BAR; PG8_WAIT_L(0); PG8_MMA(1, 0, At, B0); PG8_BAR; PG8_SCHED;
            PG8_STAGE(PG8_SB(1, 1), b3 + hstep, voffB);
            PG8_WAIT_V(6); PG8_BAR; PG8_MMA(1, 1, At, B1); PG8_BAR;
            }
        }
        if constexpr (ALIGN_EPI) { if (wr == 0) PG8_BAR; }
        if constexpr (!Epi::AFTER_DRAIN) { E(acc, cur, wr, wc, fr, fq); S.done(cur); }
        if (!has_next) break;
#pragma unroll
        for (int a = 0; a < 2; ++a)
#pragma unroll
            for (int b = 0; b < 2; ++b)
#pragma unroll
                for (int m = 0; m < 4; ++m)
#pragma unroll
                    for (int n = 0; n < 2; ++n) acc[a][b][m][n] = (f32x4){0.f, 0.f, 0.f, 0.f};
        cur = nxt; cA = nA; cB = nB; ++ui;
        if constexpr (ALIGN_EPI) { if (wr == 1) PG8_BAR; }
    }
    PG8_WAIT_V(0);
    if constexpr (!ALIGN_EPI) { if (wr == 0) PG8_BAR; }
    PG8_BAR;
    if constexpr (Epi::AFTER_DRAIN) { E.fused(acc, cur, wr, wc, fr, fq, lds, wid, lane); S.done(cur); }
#undef PG8_SA
#undef PG8_SB
#undef PG8_STAGE
#undef PG8_LDA
#undef PG8_LDB
#undef PG8_MMA
#undef PG8_WAIT_V
#undef PG8_WAIT_L
#undef PG8_BAR
#undef PG8_SCHED
}
}

namespace nsa {
#define NLAS __attribute__((address_space(3)))
typedef short bf16x8 __attribute__((ext_vector_type(8)));
typedef short s16x4 __attribute__((ext_vector_type(4)));
typedef short v4i16_t __attribute__((ext_vector_type(4)));
typedef float f32x4 __attribute__((ext_vector_type(4)));
typedef unsigned u32x4 __attribute__((ext_vector_type(4)));
typedef unsigned u32x2 __attribute__((ext_vector_type(2)));
typedef unsigned long long u64;
constexpr int RS = 144, TILE_B = 64 * RS;
constexpr float LOG2E = 1.4426950408889634f;
constexpr int L_KB0 = 0, L_VB0 = TILE_B, L_KB1 = 2 * TILE_B, L_VB1 = 3 * TILE_B, L_CK = 4 * TILE_B, L_CV = 8 * TILE_B, L_IMP = 12 * TILE_B, L_MSK = L_IMP + 8192, L_WU = L_MSK + 256, L_END = L_WU + 64;
static_assert(L_END <= 131072, "nsa LDS map");
__device__ __forceinline__ s16x4 vtr(const NLAS char* p) { return __builtin_bit_cast(s16x4, __builtin_amdgcn_ds_read_tr16_b64_v4i16((NLAS v4i16_t*)p)); }
__device__ __forceinline__ f32x4 mfma16(bf16x8 a, bf16x8 b, f32x4 c) { return __builtin_amdgcn_mfma_f32_16x16x32_bf16(a, b, c, 0, 0, 0); }
__device__ __forceinline__ unsigned pkbf(float lo, float hi) { return pg8::cvt_pk_bf16(lo, hi); }
__device__ __forceinline__ void qk_tile(f32x4 (&s)[4], const NLAS char* Kb, const bf16x8 (&qf)[2], int i, int g) {
#pragma unroll
    for (int kb = 0; kb < 4; ++kb) { const NLAS char* kp = Kb + (kb * 16 + i) * RS + 16 * g;
        const bf16x8 a0 = *(const NLAS bf16x8*)kp, a1 = *(const NLAS bf16x8*)(kp + 64);
        f32x4 acc = (f32x4){0.f, 0.f, 0.f, 0.f}; acc = mfma16(a0, qf[0], acc); acc = mfma16(a1, qf[1], acc); s[kb] = acc; }
}
__device__ __forceinline__ void pv_tile(f32x4 (&o)[4], const NLAS char* Vb, const f32x4 (&p)[4], int i, int g) {
    const NLAS char* vb = Vb + (4 * g + (i >> 2)) * RS + (i & 3) * 8;
#pragma unroll
    for (int kk = 0; kk < 2; ++kk) {
        u32x4 pw; pw.x = pkbf(p[2 * kk][0], p[2 * kk][1]); pw.y = pkbf(p[2 * kk][2], p[2 * kk][3]); pw.z = pkbf(p[2 * kk + 1][0], p[2 * kk + 1][1]); pw.w = pkbf(p[2 * kk + 1][2], p[2 * kk + 1][3]);
        const bf16x8 pf = __builtin_bit_cast(bf16x8, pw);
#pragma unroll
        for (int db = 0; db < 4; ++db) { const NLAS char* vp = vb + (2 * kk) * 16 * RS + db * 32;
            const s16x4 lo = vtr(vp), hi = vtr(vp + 16 * RS);
            const bf16x8 vf = (bf16x8){lo[0], lo[1], lo[2], lo[3], hi[0], hi[1], hi[2], hi[3]};
            o[db] = mfma16(vf, pf, o[db]); }
    }
}
__device__ __forceinline__ void online_tile(f32x4 (&s)[4], float& m, float& l, f32x4 (&o)[4], float kslope, float c, int base, int lo, int hi) {
    float mt = -INFINITY; const float bf = (float)base;
#pragma unroll
    for (int kb = 0; kb < 4; ++kb)
#pragma unroll
        for (int r = 0; r < 4; ++r) { const int pos = base + kb * 16 + r; float v = fmaf(s[kb][r], LOG2E, fmaf(kslope, bf + (float)(kb * 16 + r), c));
            v = (pos >= lo && pos <= hi) ? v : -INFINITY; s[kb][r] = v; mt = fmaxf(mt, v); }
    mt = fmaxf(mt, __shfl_xor(mt, 16)); mt = fmaxf(mt, __shfl_xor(mt, 32));
    const float mn = fmaxf(m, mt), ms = (mn == -INFINITY) ? 0.f : mn;
    const float alpha = __builtin_amdgcn_exp2f(m - ms);
    float sum = 0.f;
#pragma unroll
    for (int kb = 0; kb < 4; ++kb)
#pragma unroll
        for (int r = 0; r < 4; ++r) { const float p = __builtin_amdgcn_exp2f(s[kb][r] - ms); s[kb][r] = p; sum += p; }
    l = l * alpha + sum; m = mn;
#pragma unroll
    for (int db = 0; db < 4; ++db) o[db] = o[db] * alpha;
}
struct Stg { u32x4 k, v; };
__device__ __forceinline__ void stg_load(Stg& r, const bf16_t* kb, const bf16_t* vb, size_t pitch, int tid) { const size_t off = (size_t)(tid >> 3) * pitch + (tid & 7) * 8; r.k = *(const u32x4*)(kb + off); r.v = *(const u32x4*)(vb + off); }
__device__ __forceinline__ void stg_store(NLAS char* lds, int ko, int vo, const Stg& r, int tid) { const int off = (tid >> 3) * RS + (tid & 7) * 16; *(NLAS u32x4*)(lds + ko + off) = r.k; *(NLAS u32x4*)(lds + vo + off) = r.v; }
__device__ __forceinline__ float sigm(float v) { return __builtin_amdgcn_rcpf(1.f + __expf(-v)); }

__device__ __forceinline__ void unit(NLAS char* lds, const bf16_t* P, const float* S32, const bf16_t* KC, const bf16_t* VC, bf16_t* Ynsa, int b, int gq, int ti) {
    const int tid = threadIdx.x, lane = tid & 63, w = __builtin_amdgcn_readfirstlane(tid >> 6), i = lane & 15, g = lane >> 4;
    const int t0 = ti * 32, tl_mine = i >> 2, r = i & 3, h = gq * 4 + r, t = t0 + 4 * w + tl_mine; const size_t m = (size_t)b * T + t;
    const float slope2 = __builtin_amdgcn_exp2f(-(float)(h + 1)) * LOG2E;
    bf16x8 qf[2];
    { const bf16_t* qp = P + m * PW + P_NSQ + h * 64 + 8 * g;
#pragma unroll
      for (int ks = 0; ks < 2; ++ks) { const u32x4 raw = *(const u32x4*)(qp + 32 * ks); u32x4 sc;
          sc.x = pkbf(pg8::bflo(raw.x) * 0.125f, pg8::bfhi(raw.x) * 0.125f); sc.y = pkbf(pg8::bflo(raw.y) * 0.125f, pg8::bfhi(raw.y) * 0.125f);
          sc.z = pkbf(pg8::bflo(raw.z) * 0.125f, pg8::bfhi(raw.z) * 0.125f); sc.w = pkbf(pg8::bflo(raw.w) * 0.125f, pg8::bfhi(raw.w) * 0.125f);
          qf[ks] = __builtin_bit_cast(bf16x8, sc); } }
    const float* gp = S32 + m * 32 + 8 + h * 3;
    const float gate0 = sigm(gp[0]), gate1 = sigm(gp[1]), gate2 = sigm(gp[2]);
    f32x4 outacc[4];
#pragma unroll
    for (int db = 0; db < 4; ++db) outacc[db] = (f32x4){0.f, 0.f, 0.f, 0.f};
    const int ntc = (ti >> 5) + 1;
    for (int tile = 0; tile < ntc; ++tile) { Stg sr; const size_t row0 = ((size_t)(b * 256 + tile * 64) * 2 + gq) * 64; stg_load(sr, KC + row0, VC + row0, 128, tid); stg_store(lds, L_CK + tile * TILE_B, L_CV + tile * TILE_B, sr, tid); }
    __syncthreads();
    { const int nmax = (t - 31) >> 4; const float kslope = 16.f * slope2, c = -slope2 * (float)(t - 31);
      float mc = -INFINITY, lc = 0.f;
#pragma unroll 1
      for (int tile = 0; tile < ntc; ++tile) { f32x4 s[4]; qk_tile(s, lds + L_CK + tile * TILE_B, qf, i, g);
          float mt = -INFINITY;
#pragma unroll
          for (int kb = 0; kb < 4; ++kb)
#pragma unroll
              for (int rr = 0; rr < 4; ++rr) { const int n = tile * 64 + kb * 16 + 4 * g + rr; float v = fmaf(s[kb][rr], LOG2E, fmaf(kslope, (float)n, c)); v = (n <= nmax) ? v : -INFINITY; s[kb][rr] = v; mt = fmaxf(mt, v); }
          mt = fmaxf(mt, __shfl_xor(mt, 16)); mt = fmaxf(mt, __shfl_xor(mt, 32));
          const float mn = fmaxf(mc, mt), ms = (mn == -INFINITY) ? 0.f : mn; float sum = 0.f;
#pragma unroll
          for (int kb = 0; kb < 4; ++kb)
#pragma unroll
              for (int rr = 0; rr < 4; ++rr) sum += __builtin_amdgcn_exp2f(s[kb][rr] - ms);
          lc = lc * __builtin_amdgcn_exp2f(mc - ms) + sum; mc = mn; }
      lc += __shfl_xor(lc, 16); lc += __shfl_xor(lc, 32);
      const float ms = (mc == -INFINITY) ? 0.f : mc, inv = lc > 0.f ? 1.f / lc : 0.f;
      f32x4 oc[4];
#pragma unroll
      for (int db = 0; db < 4; ++db) oc[db] = (f32x4){0.f, 0.f, 0.f, 0.f};
      NLAS float* imp_s = (NLAS float*)(lds + L_IMP) + (w * 4 + tl_mine) * 64;
      float cprev = 0.f;
#pragma unroll 1
      for (int tile = 0; tile < 4; ++tile) {
          if (tile < ntc) { f32x4 s[4]; qk_tile(s, lds + L_CK + tile * TILE_B, qf, i, g);
#pragma unroll
              for (int kb = 0; kb < 4; ++kb)
#pragma unroll
                  for (int rr = 0; rr < 4; ++rr) { const int n = tile * 64 + kb * 16 + 4 * g + rr; float v = fmaf(s[kb][rr], LOG2E, fmaf(kslope, (float)n, c)); v = (n <= nmax) ? v : -INFINITY; s[kb][rr] = __builtin_amdgcn_exp2f(v - ms) * inv; }
              pv_tile(oc, lds + L_CV + tile * TILE_B, s, i, g);
#pragma unroll
              for (int kb = 0; kb < 4; ++kb) { const f32x4 pv = s[kb];
                  float a = (pv[0] + pv[1]) + (pv[2] + pv[3]), cc = pv[3];
                  a += __shfl_xor(a, 1); a += __shfl_xor(a, 2); cc += __shfl_xor(cc, 1); cc += __shfl_xor(cc, 2);
                  const float up = __shfl(cc, (lane + 48) & 63);
                  const float im = a + (g > 0 ? up : cprev); cprev = up;
                  if (r == 0) imp_s[4 * (tile * 4 + kb) + g] = im; }
          } else { if (r == 0) {
#pragma unroll
              for (int kb = 0; kb < 4; ++kb) imp_s[4 * (tile * 4 + kb) + g] = 0.f; } }
      }
#pragma unroll
      for (int db = 0; db < 4; ++db) outacc[db] = outacc[db] + oc[db] * gate0;
    }
    __syncthreads();
    NLAS float* impw = (NLAS float*)(lds + L_IMP) + w * 256;
    float myscore[4];
#pragma unroll
    for (int tl = 0; tl < 4; ++tl) { const int tt = t0 + 4 * w + tl, cur = tt >> 6, j = lane; const bool valid = j <= cur, forced = (j == 0) || (j == cur) || (j == cur - 1);
        const float s = valid ? impw[tl * 64 + j] + (forced ? 1000.f : 0.f) : -1e30f; myscore[tl] = s; }
    __syncthreads();
#pragma unroll
    for (int tl = 0; tl < 4; ++tl) impw[tl * 64 + lane] = myscore[tl];
    __syncthreads();
    u64 wmask[4], wun = 0ull;
#pragma unroll
    for (int tl = 0; tl < 4; ++tl) { const int tt = t0 + 4 * w + tl, cur = tt >> 6; const float s = myscore[tl]; int rank = 0;
        for (int jj = 0; jj < 64; ++jj) { const float o = impw[tl * 64 + jj]; rank += (o > s || (o == s && jj < lane)) ? 1 : 0; }
        wmask[tl] = __ballot(rank < 16 && lane <= cur); wun |= wmask[tl]; }
    if (lane == 0) { NLAS u64* mk = (NLAS u64*)(lds + L_MSK) + w * 4; mk[0] = wmask[0]; mk[1] = wmask[1]; mk[2] = wmask[2]; mk[3] = wmask[3]; ((NLAS u64*)(lds + L_WU))[w] = wun; }
    __syncthreads();
    const u64 mymask = ((const NLAS u64*)(lds + L_MSK))[w * 4 + tl_mine];
    u64 uall = 0ull;
#pragma unroll
    for (int ww = 0; ww < 8; ++ww) uall |= ((const NLAS u64*)(lds + L_WU))[ww];
    uall = ((u64)__builtin_amdgcn_readfirstlane((unsigned)(uall >> 32)) << 32) | (u64)__builtin_amdgcn_readfirstlane((unsigned)uall);
    const size_t rowb = (size_t)b * T;
    {
        float ms_ = -INFINITY, ls = 0.f; f32x4 os[4];
#pragma unroll
        for (int db = 0; db < 4; ++db) os[db] = (f32x4){0.f, 0.f, 0.f, 0.f};
        const bf16_t* kcol = P + rowb * PW + P_KS + gq * 64; const bf16_t* vcol = P + rowb * PW + P_VS + gq * 64;
        const float c = -slope2 * (float)t;
        u64 rem = uall; int j = __builtin_ctzll(rem); rem &= rem - 1; int cur = 0;
        { Stg sr; stg_load(sr, kcol + (size_t)j * 64 * PW, vcol + (size_t)j * 64 * PW, PW, tid); stg_store(lds, L_KB0, L_VB0, sr, tid); }
        __syncthreads();
        for (;;) {
            const int jn = rem ? __builtin_ctzll(rem) : -1; rem &= rem - 1;
            Stg sr; if (jn >= 0) stg_load(sr, kcol + (size_t)jn * 64 * PW, vcol + (size_t)jn * 64 * PW, PW, tid);
            if ((wun >> j) & 1ull) { f32x4 s[4]; qk_tile(s, lds + (cur ? L_KB1 : L_KB0), qf, i, g);
                online_tile(s, ms_, ls, os, slope2, c, j * 64 + 4 * g, 0, ((mymask >> j) & 1ull) ? t : -1);
                pv_tile(os, lds + (cur ? L_VB1 : L_VB0), s, i, g); }
            if (jn >= 0) stg_store(lds, cur ? L_KB0 : L_KB1, cur ? L_VB0 : L_VB1, sr, tid);
            __syncthreads();
            if (jn < 0) break;
            j = jn; cur ^= 1;
        }
        ls += __shfl_xor(ls, 16); ls += __shfl_xor(ls, 32);
        const float sc1 = gate1 / ls;
#pragma unroll
        for (int db = 0; db < 4; ++db) outacc[db] = outacc[db] + os[db] * sc1;
    }
    {
        float mw = -INFINITY, lw = 0.f; f32x4 ow[4];
#pragma unroll
        for (int db = 0; db < 4; ++db) ow[db] = (f32x4){0.f, 0.f, 0.f, 0.f};
        const bf16_t* kcol = P + rowb * PW + P_KW + gq * 64; const bf16_t* vcol = P + rowb * PW + P_VW + gq * 64;
        const float c = -slope2 * (float)t;
        const int j0 = (t0 - 511) > 0 ? ((t0 - 511) >> 6) : 0, j1 = t0 >> 6, tw0 = t0 + 4 * w;
        int j = j0, cur = 0;
        { Stg sr; stg_load(sr, kcol + (size_t)j * 64 * PW, vcol + (size_t)j * 64 * PW, PW, tid); stg_store(lds, L_KB0, L_VB0, sr, tid); }
        __syncthreads();
        for (;;) {
            const int jn = (j < j1) ? j + 1 : -1;
            Stg sr; if (jn >= 0) stg_load(sr, kcol + (size_t)jn * 64 * PW, vcol + (size_t)jn * 64 * PW, PW, tid);
            if (64 * j <= tw0 + 3 && 64 * j + 63 >= tw0 - 511) { f32x4 s[4]; qk_tile(s, lds + (cur ? L_KB1 : L_KB0), qf, i, g);
                online_tile(s, mw, lw, ow, slope2, c, j * 64 + 4 * g, t - 511, t);
                pv_tile(ow, lds + (cur ? L_VB1 : L_VB0), s, i, g); }
            if (jn >= 0) stg_store(lds, cur ? L_KB0 : L_KB1, cur ? L_VB0 : L_VB1, sr, tid);
            __syncthreads();
            if (jn < 0) break;
            j = jn; cur ^= 1;
        }
        lw += __shfl_xor(lw, 16); lw += __shfl_xor(lw, 32);
        const float sc2 = gate2 / lw;
#pragma unroll
        for (int db = 0; db < 4; ++db) outacc[db] = outacc[db] + ow[db] * sc2;
    }
    bf16_t* yo = Ynsa + m * 512 + h * 64 + 4 * g;
#pragma unroll
    for (int db = 0; db < 4; ++db) { u32x2 v; v.x = pkbf(outacc[db][0], outacc[db][1]); v.y = pkbf(outacc[db][2], outacc[db][3]); *(u32x2*)(yo + db * 16) = v; }
}
__device__ __forceinline__ void phase(NLAS char* lds, const bf16_t* P, const float* S32, const bf16_t* KC, const bf16_t* VC, bf16_t* Ynsa) {
    const int G = gridDim.x, bid = blockIdx.x;
    if (G == 256) { const int base = bid >> 3, bg = bid & 7;
#pragma unroll 1
        for (int k = 0; k < 4; ++k) { const int ti = (k == 0) ? 127 - base : (k == 1) ? 64 + base : (k == 2) ? 63 - base : base; unit(lds, P, S32, KC, VC, Ynsa, bg >> 1, bg & 1, ti); } }
    else {
#pragma unroll 1
        for (int u = bid; u < 1024; u += G) unit(lds, P, S32, KC, VC, Ynsa, (u & 7) >> 1, u & 1, 127 - (u >> 3)); }
}
}

namespace xa {
using nsa::bf16x8; using nsa::s16x4; using nsa::f32x4; using nsa::u32x4; using nsa::u32x2; using nsa::vtr; using nsa::mfma16; using nsa::pkbf;
constexpr int RS = 272, TILE_B = 64 * RS;
constexpr int L_K0 = 0, L_V0 = TILE_B, L_K1 = 2 * TILE_B, L_V1 = 3 * TILE_B;
struct Stg { u32x4 k0, k1, v0, v1; };
__device__ __forceinline__ void stg_load(Stg& r, const bf16_t* kb, int tid) { const bf16_t* p = kb + (size_t)(tid >> 3) * 1024 + (tid & 7) * 8;
    r.k0 = *(const u32x4*)p; r.k1 = *(const u32x4*)(p + 64); r.v0 = *(const u32x4*)(p + 512); r.v1 = *(const u32x4*)(p + 576); }
__device__ __forceinline__ void stg_store(NLAS char* lds, int ko, int vo, const Stg& r, int tid) { const int off = (tid >> 3) * RS + (tid & 7) * 16;
    *(NLAS u32x4*)(lds + ko + off) = r.k0; *(NLAS u32x4*)(lds + ko + off + 128) = r.k1; *(NLAS u32x4*)(lds + vo + off) = r.v0; *(NLAS u32x4*)(lds + vo + off + 128) = r.v1; }
__device__ __forceinline__ void unit(NLAS char* lds, const bf16_t* P, const bf16_t* MEMKV, bf16_t* Yxa, int b, int h, int tt) {
    const int tid = threadIdx.x, lane = tid & 63, w = __builtin_amdgcn_readfirstlane(tid >> 6), i = lane & 15, g = lane >> 4;
    const size_t m = (size_t)b * T + tt * 128 + 16 * w + i;
    bf16x8 qf[4];
    { const bf16_t* qp = P + m * PW + P_XAQ + h * 128 + 8 * g;
#pragma unroll
      for (int ks = 0; ks < 4; ++ks) qf[ks] = *(const bf16x8*)(qp + 32 * ks); }
    const float scale2 = 0.08838834764831845f * nsa::LOG2E;
    float mx = -INFINITY, l = 0.f; f32x4 o[8];
#pragma unroll
    for (int db = 0; db < 8; ++db) o[db] = (f32x4){0.f, 0.f, 0.f, 0.f};
    const bf16_t* kbase = MEMKV + (size_t)b * 256 * 1024 + h * 128;
    { Stg sr; stg_load(sr, kbase, tid); stg_store(lds, L_K0, L_V0, sr, tid); }
    __syncthreads();
#pragma unroll 1
    for (int tile = 0; tile < 4; ++tile) { const int cur = tile & 1;
        Stg sr; if (tile < 3) stg_load(sr, kbase + (size_t)(tile + 1) * 64 * 1024, tid);
        const NLAS char* Kb = lds + (cur ? L_K1 : L_K0); const NLAS char* Vb = lds + (cur ? L_V1 : L_V0);
        f32x4 s[4];
#pragma unroll
        for (int kb = 0; kb < 4; ++kb) { const NLAS char* kp = Kb + (kb * 16 + i) * RS + 16 * g; f32x4 acc = (f32x4){0.f, 0.f, 0.f, 0.f};
#pragma unroll
            for (int ks = 0; ks < 4; ++ks) acc = mfma16(*(const NLAS bf16x8*)(kp + 64 * ks), qf[ks], acc);
            s[kb] = acc; }
        float mt = -INFINITY;
#pragma unroll
        for (int kb = 0; kb < 4; ++kb)
#pragma unroll
            for (int r = 0; r < 4; ++r) { const float v = s[kb][r] * scale2; s[kb][r] = v; mt = fmaxf(mt, v); }
        mt = fmaxf(mt, __shfl_xor(mt, 16)); mt = fmaxf(mt, __shfl_xor(mt, 32));
        const float mn = fmaxf(mx, mt), alpha = __builtin_amdgcn_exp2f(mx - mn); float sum = 0.f;
#pragma unroll
        for (int kb = 0; kb < 4; ++kb)
#pragma unroll
            for (int r = 0; r < 4; ++r) { const float p = __builtin_amdgcn_exp2f(s[kb][r] - mn); s[kb][r] = p; sum += p; }
        l = l * alpha + sum; mx = mn;
#pragma unroll
        for (int db = 0; db < 8; ++db) o[db] = o[db] * alpha;
        const NLAS char* vb = Vb + (4 * g + (i >> 2)) * RS + (i & 3) * 8;
#pragma unroll
        for (int kk = 0; kk < 2; ++kk) {
            u32x4 pw; pw.x = pkbf(s[2 * kk][0], s[2 * kk][1]); pw.y = pkbf(s[2 * kk][2], s[2 * kk][3]); pw.z = pkbf(s[2 * kk + 1][0], s[2 * kk + 1][1]); pw.w = pkbf(s[2 * kk + 1][2], s[2 * kk + 1][3]);
            const bf16x8 pf = __builtin_bit_cast(bf16x8, pw);
#pragma unroll
            for (int db = 0; db < 8; ++db) { const NLAS char* vp = vb + (2 * kk) * 16 * RS + db * 32; const s16x4 lo = vtr(vp), hi = vtr(vp + 16 * RS);
                o[db] = mfma16((bf16x8){lo[0], lo[1], lo[2], lo[3], hi[0], hi[1], hi[2], hi[3]}, pf, o[db]); }
        }
        if (tile < 3) stg_store(lds, cur ? L_K0 : L_K1, cur ? L_V0 : L_V1, sr, tid);
        __syncthreads();
    }
    l += __shfl_xor(l, 16); l += __shfl_xor(l, 32);
    const float inv = 1.f / l;
    bf16_t* yo = Yxa + m * 512 + h * 128 + 4 * g;
#pragma unroll
    for (int db = 0; db < 8; ++db) { u32x2 v; v.x = pkbf(o[db][0] * inv, o[db][1] * inv); v.y = pkbf(o[db][2] * inv, o[db][3] * inv); *(u32x2*)(yo + db * 16) = v; }
}
__device__ __forceinline__ void phase(NLAS char* lds, const bf16_t* P, const bf16_t* MEMKV, bf16_t* Yxa) {
#pragma unroll 1
    for (int u = blockIdx.x; u < 512; u += gridDim.x) unit(lds, P, MEMKV, Yxa, u >> 7, (u >> 5) & 3, u & 31);
}
}

namespace ml {
using nsa::bf16x8; using nsa::s16x4; using nsa::f32x4; using nsa::u32x4; using nsa::u32x2; using nsa::vtr; using nsa::mfma16; using nsa::pkbf;
constexpr int RS = 272, TB = 64 * RS, RSS = 144;
constexpr float KSCALE = 0.08838834764831845f;
__device__ __forceinline__ float scan_add(float v, int lane) {
#pragma unroll
    for (int o = 1; o < 64; o <<= 1) { const float u = __shfl_up(v, o); if (lane >= o) v += u; }
    return v; }
__device__ __forceinline__ float scan_max(float v, int lane) {
#pragma unroll
    for (int o = 1; o < 64; o <<= 1) { const float u = __shfl_up(v, o); if (lane >= o) v = fmaxf(v, u); }
    return v; }
__device__ __forceinline__ bf16x8 trpair(const NLAS char* p, int hi_off) { const s16x4 lo = vtr(p), hi = vtr(p + hi_off); return (bf16x8){lo[0], lo[1], lo[2], lo[3], hi[0], hi[1], hi[2], hi[3]}; }
__device__ __forceinline__ void load_conv(NLAS char* dst, const bf16_t* P, const float* cw, int colP, int cwc, size_t m0, int tseq0, int tid) {
    const int s = tid >> 3, c16 = (tid & 7) * 16;
#pragma unroll
    for (int half = 0; half < 2; ++half) { const int c = c16 + half * 8; float acc[8];
#pragma unroll
        for (int e = 0; e < 8; ++e) acc[e] = 0.f;
#pragma unroll
        for (int j = 0; j < 4; ++j) { if (tseq0 + s - j >= 0) { const u32x4 raw = *(const u32x4*)(P + (m0 + s - j) * PW + colP + c);
            const f32x4 w0 = *(const f32x4*)(cw + j * 1024 + cwc + c), w1 = *(const f32x4*)(cw + j * 1024 + cwc + c + 4);
            acc[0] += w0[0] * pg8::bflo(raw.x); acc[1] += w0[1] * pg8::bfhi(raw.x); acc[2] += w0[2] * pg8::bflo(raw.y); acc[3] += w0[3] * pg8::bfhi(raw.y);
            acc[4] += w1[0] * pg8::bflo(raw.z); acc[5] += w1[1] * pg8::bfhi(raw.z); acc[6] += w1[2] * pg8::bflo(raw.w); acc[7] += w1[3] * pg8::bfhi(raw.w); } }
#pragma unroll
        for (int e = 0; e < 8; ++e) acc[e] = acc[e] * __builtin_amdgcn_rcpf(1.f + __expf(-acc[e]));
        u32x4 o; o.x = pkbf(acc[0], acc[1]); o.y = pkbf(acc[2], acc[3]); o.z = pkbf(acc[4], acc[5]); o.w = pkbf(acc[6], acc[7]);
        *(NLAS u32x4*)(dst + s * RS + c * 2) = o; }
}
__device__ __forceinline__ void m1_unit(NLAS char* lds, const bf16_t* P, const float* cw, const float* S32, float* Abuf, float* NA, float* Gc, float* Mloc, int ci) {
    constexpr int L_K = 0, L_EV = TB, L_E = 2 * TB;
    const int tid = threadIdx.x, lane = tid & 63, w = __builtin_amdgcn_readfirstlane(tid >> 6), i = lane & 15, g = lane >> 4;
    const int c = ci & 63, bh = ci >> 6, h = bh & 3, b = bh >> 2; const size_t m0 = (size_t)b * T + c * 64;
    NLAS float* eS = (NLAS float*)(lds + L_E);
    if (w == 0) { const float fpre = S32[(m0 + lane) * 32 + 4 + h], ipre = S32[(m0 + lane) * 32 + h];
        const float bcs = scan_add(logsig(fpre), lane), gtot = __shfl(bcs, 63), wend = gtot - bcs + ipre, mloc = wave_max(wend);
        eS[lane] = __expf(wend - mloc) * KSCALE; if (lane == 0) { Gc[ci] = gtot; Mloc[ci] = mloc; } }
    load_conv(lds + L_K, P, cw, P_MLK + h * 128, 512 + h * 128, m0, c * 64, tid);
    __syncthreads();
    { const int s = tid >> 3, c16 = (tid & 7) * 16; const float es = eS[s]; const bf16_t* vp = P + (m0 + s) * PW + P_MLV + h * 128 + c16;
#pragma unroll
      for (int half = 0; half < 2; ++half) { const u32x4 raw = *(const u32x4*)(vp + half * 8); u32x4 o;
          o.x = pkbf(pg8::bflo(raw.x) * es, pg8::bfhi(raw.x) * es); o.y = pkbf(pg8::bflo(raw.y) * es, pg8::bfhi(raw.y) * es);
          o.z = pkbf(pg8::bflo(raw.z) * es, pg8::bfhi(raw.z) * es); o.w = pkbf(pg8::bflo(raw.w) * es, pg8::bfhi(raw.w) * es);
          *(NLAS u32x4*)(lds + L_EV + s * RS + (c16 + half * 8) * 2) = o; } }
    __syncthreads();
    f32x4 acc[8];
#pragma unroll
    for (int vb = 0; vb < 8; ++vb) acc[vb] = (f32x4){0.f, 0.f, 0.f, 0.f};
    const int rowoff = (4 * g + (i >> 2)) * RS + (i & 3) * 8;
#pragma unroll
    for (int kk = 0; kk < 2; ++kk) { const bf16x8 kf = trpair(lds + L_K + kk * 32 * RS + rowoff + w * 32, 16 * RS);
#pragma unroll
        for (int vb = 0; vb < 8; ++vb) acc[vb] = mfma16(trpair(lds + L_EV + kk * 32 * RS + rowoff + vb * 32, 16 * RS), kf, acc[vb]); }
    float* ap = Abuf + ((size_t)ci * 128 + w * 16 + i) * 128 + 4 * g;
#pragma unroll
    for (int vb = 0; vb < 8; ++vb) *(f32x4*)(ap + vb * 16) = acc[vb];
    if (tid < 128) { float n = 0.f; for (int s = 0; s < 64; ++s) n += eS[s] * bf2f(*(const NLAS bf16_t*)(lds + L_K + s * RS + tid * 2)); NA[(size_t)ci * 128 + tid] = n; }
    __syncthreads();
}
__device__ __forceinline__ void m2_items(float* Abuf, float* NA, const float* Gc, const float* Mloc, float* Mprev) {
    typedef float f32x2 __attribute__((ext_vector_type(2)));
    for (int it = blockIdx.x * blockDim.x + threadIdx.x; it < 16 * 128 * 64; it += gridDim.x * blockDim.x) {
        const int bh = it >> 13, kv2 = it & 8191, k = kv2 >> 6, v2 = kv2 & 63;
        f32x2 C = (f32x2){0.f, 0.f}; float n = 0.f, m = 0.f;
#pragma unroll 1
        for (int c0 = 0; c0 < 64; c0 += 8) { f32x2 A[8];
#pragma unroll
            for (int u = 0; u < 8; ++u) A[u] = *(const f32x2*)(Abuf + ((size_t)(bh * 64 + c0 + u) * 128 + k) * 128 + v2 * 2);
#pragma unroll
            for (int u = 0; u < 8; ++u) { const int ci = bh * 64 + c0 + u; const float gg = Gc[ci], ml = Mloc[ci];
                const float mn = fmaxf(gg + m, ml), a = __expf(gg + m - mn), bb = __expf(ml - mn);
                *(f32x2*)(Abuf + ((size_t)ci * 128 + k) * 128 + v2 * 2) = C; C = C * a + A[u] * bb;
                if (v2 == 0) { const float nA = NA[(size_t)ci * 128 + k]; NA[(size_t)ci * 128 + k] = n; n = a * n + bb * nA; }
                if (kv2 == 0) Mprev[ci] = m;
                m = mn; } }
    }
}
__device__ __forceinline__ void m3_unit(NLAS char* lds, const bf16_t* P, const float* cw, const float* S32, const float* Cprev, const float* Nprev, const float* Mprev, const float* normg, bf16_t* Yml, int ci) {
    constexpr int L_Q = 0, L_K = TB, L_V = 2 * TB, L_C = 3 * TB, L_S = 5 * TB, L_F = L_S + 64 * RSS;
    const int tid = threadIdx.x, lane = tid & 63, w = __builtin_amdgcn_readfirstlane(tid >> 6), i = lane & 15, g = lane >> 4;
    const int c = ci & 63, bh = ci >> 6, h = bh & 3, b = bh >> 2; const size_t m0 = (size_t)b * T + c * 64;
    NLAS float* F = (NLAS float*)(lds + L_F);
    NLAS float* rowf = F; NLAS float* colf = F + 64; NLAS float* scv = F + 128; NLAS float* emt = F + 192; NLAS float* qn = F + 256; NLAS float* nprev = F + 320; NLAS float* denp = F + 448; NLAS float* ssq = F + 576;
    if (w == 0) { const float fpre = S32[(m0 + lane) * 32 + 4 + h], ipre = S32[(m0 + lane) * 32 + h], mprev = Mprev[ci];
        const float bcs = scan_add(logsig(fpre), lane), u = ipre - bcs, pm = scan_max(u, lane), mt = bcs + fmaxf(mprev, pm);
        rowf[lane] = bcs - mt; colf[lane] = u; scv[lane] = __expf(bcs + mprev - mt); emt[lane] = __expf(-mt); }
    else if (w <= 2) nprev[tid - 64] = Nprev[(size_t)ci * 128 + tid - 64];
    load_conv(lds + L_Q, P, cw, P_MLQ + h * 128, h * 128, m0, c * 64, tid);
    load_conv(lds + L_K, P, cw, P_MLK + h * 128, 512 + h * 128, m0, c * 64, tid);
    { const int s = tid >> 3, c16 = (tid & 7) * 16; const bf16_t* vp = P + (m0 + s) * PW + P_MLV + h * 128 + c16;
      *(NLAS u32x4*)(lds + L_V + s * RS + c16 * 2) = *(const u32x4*)vp; *(NLAS u32x4*)(lds + L_V + s * RS + c16 * 2 + 16) = *(const u32x4*)(vp + 8); }
    { const int k = tid >> 2, v0 = (tid & 3) * 32; const float* cp = Cprev + ((size_t)ci * 128 + k) * 128 + v0;
#pragma unroll
      for (int q8 = 0; q8 < 4; ++q8) { const f32x4 a = *(const f32x4*)(cp + q8 * 8), bq = *(const f32x4*)(cp + q8 * 8 + 4); u32x4 o;
          o.x = pkbf(a[0], a[1]); o.y = pkbf(a[2], a[3]); o.z = pkbf(bq[0], bq[1]); o.w = pkbf(bq[2], bq[3]); *(NLAS u32x4*)(lds + L_C + k * RS + (v0 + q8 * 8) * 2) = o; } }
    __syncthreads();
    if (tid < 64) { float a = 0.f; for (int k = 0; k < 128; ++k) a += bf2f(*(const NLAS bf16_t*)(lds + L_Q + tid * RS + k * 2)) * nprev[k]; qn[tid] = a; }
    const int tb = w >> 1;
    {
        float rs[4] = {0.f, 0.f, 0.f, 0.f};
#pragma unroll
        for (int sbi = 0; sbi < 2; ++sbi) { const int sb = 2 * (w & 1) + sbi; f32x4 acc = (f32x4){0.f, 0.f, 0.f, 0.f};
            if (sb <= tb) {
#pragma unroll
                for (int ks = 0; ks < 4; ++ks) acc = mfma16(*(const NLAS bf16x8*)(lds + L_Q + (tb * 16 + i) * RS + (32 * ks + 8 * g) * 2), *(const NLAS bf16x8*)(lds + L_K + (sb * 16 + i) * RS + (32 * ks + 8 * g) * 2), acc); }
            const int s = sb * 16 + i; const float cf = colf[s];
#pragma unroll
            for (int r = 0; r < 4; ++r) { const int t = tb * 16 + 4 * g + r; const float v = (s <= t) ? acc[r] * KSCALE * __expf(rowf[t] + cf) : 0.f; rs[r] += v;
                *(NLAS bf16_t*)(lds + L_S + t * RSS + s * 2) = f2bf(v); } }
#pragma unroll
        for (int r = 0; r < 4; ++r) { float x = rs[r]; x += __shfl_xor(x, 1); x += __shfl_xor(x, 2); x += __shfl_xor(x, 4); x += __shfl_xor(x, 8); if (i == 0) denp[(w & 1) * 64 + tb * 16 + 4 * g + r] = x; }
    }
    __syncthreads();
    f32x4 a1[4], a2[4];
#pragma unroll
    for (int vb = 0; vb < 4; ++vb) { a1[vb] = (f32x4){0.f, 0.f, 0.f, 0.f}; a2[vb] = (f32x4){0.f, 0.f, 0.f, 0.f}; }
    const int vb0 = (w & 1) * 4, troff = (8 * g + (i >> 2)) * RS + (i & 3) * 8;
#pragma unroll
    for (int kk = 0; kk < 2; ++kk) { if (32 * kk <= tb * 16 + 15) { const bf16x8 sf = *(const NLAS bf16x8*)(lds + L_S + (tb * 16 + i) * RSS + (32 * kk + 8 * g) * 2);
#pragma unroll
        for (int vb = 0; vb < 4; ++vb) a1[vb] = mfma16(sf, trpair(lds + L_V + kk * 32 * RS + troff + (vb0 + vb) * 32, 4 * RS), a1[vb]); } }
#pragma unroll
    for (int ks = 0; ks < 4; ++ks) { const bf16x8 qf = *(const NLAS bf16x8*)(lds + L_Q + (tb * 16 + i) * RS + (32 * ks + 8 * g) * 2);
#pragma unroll
        for (int vb = 0; vb < 4; ++vb) a2[vb] = mfma16(qf, trpair(lds + L_C + ks * 32 * RS + troff + (vb0 + vb) * 32, 4 * RS), a2[vb]); }
    float hv[4][4], sq[4] = {0.f, 0.f, 0.f, 0.f};
#pragma unroll
    for (int r = 0; r < 4; ++r) { const int t = tb * 16 + 4 * g + r; const float sc = scv[t]; const float den = denp[t] + denp[64 + t] + sc * qn[t]; const float hd = 1.f / fmaxf(fabsf(den), emt[t]);
#pragma unroll
        for (int vb = 0; vb < 4; ++vb) { const float x = (a1[vb][r] + sc * a2[vb][r]) * hd; hv[vb][r] = x; sq[r] += x * x; } }
#pragma unroll
    for (int r = 0; r < 4; ++r) { float x = sq[r]; x += __shfl_xor(x, 1); x += __shfl_xor(x, 2); x += __shfl_xor(x, 4); x += __shfl_xor(x, 8); if (i == 0) ssq[(w & 1) * 64 + tb * 16 + 4 * g + r] = x; }
    __syncthreads();
#pragma unroll
    for (int r = 0; r < 4; ++r) { const int t = tb * 16 + 4 * g + r; const float rinv = rsqrtf((ssq[t] + ssq[64 + t]) * (1.f / 128.f) + EPS);
#pragma unroll
        for (int vb = 0; vb < 4; ++vb) { const int v = (vb0 + vb) * 16 + i; const float o = bf2f(P[(m0 + t) * PW + P_MLO + h * 128 + v]);
            Yml[(m0 + t) * 512 + h * 128 + v] = f2bf(__builtin_amdgcn_rcpf(1.f + __expf(-o)) * hv[vb][r] * rinv * normg[h * 128 + v]); } }
    __syncthreads();
}
}

#define LAS __attribute__((address_space(3)))
constexpr int NTHREADS = 512, LDS_BYTES = 147456;
constexpr size_t WS_WIN = 1 * MiB, WS_WG = 9 * MiB, WS_WBR = 15 * MiB, WS_WOUT = 18 * MiB, WS_WFF1 = 20 * MiB, WS_WFF2 = 28 * MiB, WS_WMKV = 36 * MiB, WS_WC1 = 38 * MiB;
constexpr size_t WS_BIASP = 249 * MiB;
struct Args { const float* in[18]; float* out; unsigned char* ws; int ph_lo, ph_hi; };
template <int VT, class F> __device__ __forceinline__ void run_vb(int nvb, char* lds, F f) {
    constexpr int PER = NTHREADS / VT; const int sub = threadIdx.x / VT, tid = threadIdx.x % VT;
    for (int it = blockIdx.x; it * PER < nvb; it += gridDim.x) { VB vb{it * PER + sub, tid, lds + sub * (LDS_BYTES / PER)}; f(vb); __syncthreads(); }
}
__device__ __forceinline__ unsigned pk2(float lo, float hi) { return (unsigned)f2bf(lo) | ((unsigned)f2bf(hi) << 16); }
typedef unsigned v4u __attribute__((ext_vector_type(4)));
typedef float f32x4 __attribute__((ext_vector_type(4)));
__device__ __forceinline__ void tr_item(const float* W, int ld, int ncols, int K, bf16_t* WT, int row_off, LAS float* scr, int item, int lane) {
    const int nblk = ncols / 32, kb = item / nblk, nb = item % nblk, k0 = 64 * kb, n0 = 32 * nb;
#pragma unroll 8
    for (int i = 0; i < 32; ++i) { const int kk = 2 * i + (lane >> 5); scr[kk * 33 + (lane & 31)] = W[(size_t)(k0 + kk) * ld + n0 + (lane & 31)]; }
    asm volatile("s_waitcnt lgkmcnt(0)" ::: "memory");
    const int c = lane & 7;
#pragma unroll
    for (int j = 0; j < 4; ++j) { const int n = (lane >> 3) + 8 * j; const LAS float* s = scr + (8 * c) * 33 + n;
        v4u o; o.x = pk2(s[0 * 33], s[1 * 33]); o.y = pk2(s[2 * 33], s[3 * 33]); o.z = pk2(s[4 * 33], s[5 * 33]); o.w = pk2(s[6 * 33], s[7 * 33]);
        *(v4u*)(WT + (size_t)(row_off + n0 + n) * K + k0 + 8 * c) = o; }
    asm volatile("s_waitcnt lgkmcnt(0)" ::: "memory");
}
__device__ __forceinline__ void rms_row_wave(const float* xrow, const float* g, bf16_t* orow, int lane) {
    const f32x4* xr = (const f32x4*)xrow + lane; const f32x4* gr = (const f32x4*)g + lane;
    f32x4 v[4]; float s = 0.f;
#pragma unroll
    for (int j = 0; j < 4; ++j) { v[j] = xr[64 * j]; s += (v[j].x * v[j].x + v[j].y * v[j].y) + (v[j].z * v[j].z + v[j].w * v[j].w); }
    const float r = rsqrtf(wave_sum(s) * (1.f / D) + EPS);
    unsigned long long* o8 = (unsigned long long*)orow + lane;
#pragma unroll
    for (int j = 0; j < 4; ++j) { const f32x4 gg = gr[64 * j]; o8[64 * j] = (unsigned long long)pk2(v[j].x * r * gg.x, v[j].y * r * gg.y) | ((unsigned long long)pk2(v[j].z * r * gg.z, v[j].w * r * gg.w) << 32); }
}
__device__ __forceinline__ int small_src_col(int c) { return c < 8 ? C_MLI + c : C_NSG + (c - 8); }
__global__ void __launch_bounds__(NTHREADS, 2) mega(Args a) {
    extern __shared__ __attribute__((aligned(16))) unsigned char lds_raw[];
    char* lds = (char*)lds_raw;
    LAS unsigned char* lds3 = (LAS unsigned char*)lds_raw;
    cg::grid_group grid = cg::this_grid();
    const float* x = a.in[0]; const float* mem = a.in[1]; const float* g_mix = a.in[2]; const float* w_in = a.in[3];
    const float* b_in = a.in[4]; const float* ml_conv = a.in[5]; const float* ml_norm_g = a.in[6]; const float* cmp_pe = a.in[7];
    const float* cmp_w1 = a.in[8]; const float* cmp_w2 = a.in[9]; const float* g_mem = a.in[10]; const float* w_mem_kv = a.in[11];
    const float* w_branch = a.in[12]; const float* w_out = a.in[13]; const float* g_ffn = a.in[14]; const float* w_ff1 = a.in[15];
    const float* w_ff2 = a.in[16]; const float* g_final = a.in[17];
    char* ws = (char*)a.ws; float* out = a.out;
    bf16_t* U = (bf16_t*)(ws + WS_U); bf16_t* P = (bf16_t*)(ws + WS_P);
    bf16_t* Yml = (bf16_t*)(ws + WS_Y); bf16_t* Ynsa = Yml + (size_t)M * 512; bf16_t* Yxa = Ynsa + (size_t)M * 512;
    float* S32 = (float*)(ws + WS_S32); bf16_t* MEMN = (bf16_t*)(ws + WS_MEMN); bf16_t* MEMKV = (bf16_t*)(ws + WS_MEMKV);
    bf16_t* KC = (bf16_t*)(ws + WS_KC); bf16_t* VC = (bf16_t*)(ws + WS_VC);
    float* NA = (float*)(ws + WS_NA); float* Gc = (float*)(ws + WS_G); float* Mloc = (float*)(ws + WS_MLOC); float* Mprev = (float*)(ws + WS_MPREV);
    float* Abuf = out;
    bf16_t* GATES = P; bf16_t* MERGED = U; bf16_t* AFFN = (bf16_t*)(ws + WS_AFFN); bf16_t* HBUF = P;
    bf16_t* Wi = (bf16_t*)(ws + WS_WIN); bf16_t* Wg = (bf16_t*)(ws + WS_WG); bf16_t* Wbr = (bf16_t*)(ws + WS_WBR); bf16_t* Wo = (bf16_t*)(ws + WS_WOUT);
    bf16_t* Wf1 = (bf16_t*)(ws + WS_WFF1); bf16_t* Wf2 = (bf16_t*)(ws + WS_WFF2); bf16_t* Wmkv = (bf16_t*)(ws + WS_WMKV);
    float* biasP = (float*)(ws + WS_BIASP);
    const int tid = threadIdx.x, lane = tid & 63, wave = __builtin_amdgcn_readfirstlane(tid >> 6);
    const int G = gridDim.x, bid = blockIdx.x;
    const int lo = a.ph_lo, hi = a.ph_hi;
#define PHASE(k) if (lo <= (k) && (k) < hi)
#define SEAM(k) if (lo <= (k) && (k) + 1 < hi) grid.sync()
    PHASE(0) {
        LAS float* scr = (LAS float*)(lds3 + wave * 16384);
        const int gw = bid * 8 + wave, NGW = G * 8;
        constexpr int I0 = 16 * 64, I1 = 16 * 40, I2 = 16 * 16, I3 = 16 * 96, I4 = 8 * 32, I5 = 16 * 32, I6 = 16 * 128, I7 = 64 * 32, I8 = 16 * 32;
        constexpr int NITEMS = I0 + I1 + I2 + I3 + 3 * I4 + I5 + I6 + I7 + I8;
        for (int it = gw; it < NITEMS; it += NGW) {
            int r = it;
            if (r < I0) { tr_item(w_in, DIN, 2048, 1024, Wi, 0, scr, r, lane); continue; } r -= I0;
            if (r < I1) { tr_item(w_in + 2056, DIN, 1280, 1024, Wi, 2048, scr, r, lane); continue; } r -= I1;
            if (r < I2) { tr_item(w_in + 3360, DIN, 512, 1024, Wi, 3328, scr, r, lane); continue; } r -= I2;
            if (r < I3) { tr_item(w_in + C_MG, DIN, 3072, 1024, Wg, 0, scr, r, lane); continue; } r -= I3;
            if (r < 3 * I4) { const int j = r / I4; tr_item(w_branch + (size_t)j * 512 * 1024, 1024, 1024, 512, Wbr + (size_t)j * 1024 * 512, 0, scr, r % I4, lane); continue; } r -= 3 * I4;
            if (r < I5) { tr_item(w_out, 1024, 1024, 1024, Wo, 0, scr, r, lane); continue; } r -= I5;
            if (r < I6) { tr_item(w_ff1, FF, FF, 1024, Wf1, 0, scr, r, lane); continue; } r -= I6;
            if (r < I7) { tr_item(w_ff2, 1024, 1024, FF, Wf2, 0, scr, r, lane); continue; } r -= I7;
            tr_item(w_mem_kv, 1024, 1024, 1024, Wmkv, 0, scr, r, lane);
        }
        for (int i = bid * NTHREADS + tid; i < 256 * 1024; i += G * NTHREADS) { const int r = i >> 10, k = i & 1023; bf16_t v = 0;
            if (r < 32) v = f2bf(w_in[(size_t)k * DIN + small_src_col(r)]);
            else if (r >= 128 && r < 160) { const float w = w_in[(size_t)k * DIN + small_src_col(r - 128)]; v = f2bf(w - bf2f(f2bf(w))); }
            Wi[(size_t)(3840 + r) * 1024 + k] = v; }
        for (int c = bid * NTHREADS + tid; c < 4096; c += G * NTHREADS) { float v = 0.f;
            if (c < 2048) v = b_in[c]; else if (c < 3328) v = b_in[c + 8]; else if (c < 3840) v = b_in[c + 32]; else if (c < 3872) v = b_in[small_src_col(c - 3840)];
            biasP[c] = v; }
        for (int m = gw; m < M; m += NGW) rms_row_wave(x + (size_t)m * D, g_mix, U + (size_t)m * D, lane);
        for (int m = gw; m < 1024; m += NGW) rms_row_wave(mem + (size_t)m * D, g_mem, MEMN + (size_t)m * D, lane);
    }
    SEAM(0);
    PHASE(1) {
        { pg8::Gemm g{U, Wi, M, 4096, D}; pg8::StaticOrder S; S.init(M, 4096, G, bid);
          pg8::EpiStore<0> E{P, biasP, S32, PW, 15};
          pg8::gemm_phase<pg8::EpiStore<0>, pg8::StaticOrder, true, true>(lds3, g, S, E); }
        { pg8::Gemm g{MEMN, Wmkv, 1024, 1024, D}; pg8::StaticOrder S; S.init(1024, 1024, G, bid);
          pg8::EpiStore<0> E{MEMKV, nullptr, nullptr, 1024, -1};
          pg8::gemm_phase<pg8::EpiStore<0>, pg8::StaticOrder, true, true>(lds3, g, S, E); }
    }
    SEAM(1);
    PHASE(2) { for (int ci = bid; ci < 1024; ci += G) ml::m1_unit((NLAS char*)lds_raw, P, ml_conv, S32, Abuf, NA, Gc, Mloc, ci);
               run_vb<256>(2 * 4 * 255 * 2, lds, [=](VB vb) { n1_naive(vb, P, cmp_pe, cmp_w1, cmp_w2, KC, VC); });
               xa::phase((NLAS char*)lds_raw, P, MEMKV, Yxa); }
    SEAM(2);
    PHASE(3) { ml::m2_items(Abuf, NA, Gc, Mloc, Mprev);
               nsa::phase((NLAS char*)lds_raw, P, S32, KC, VC, Ynsa); }
    SEAM(3);
    PHASE(4) { for (int ci = bid; ci < 1024; ci += G) ml::m3_unit((NLAS char*)lds_raw, P, ml_conv, S32, Abuf, NA, Mprev, ml_norm_g, Yml, ci); }
    SEAM(4);
    PHASE(5) { pg8::Gemm g{U, Wg, M, 3072, D}; pg8::StaticOrder S; S.init(M, 3072, G, bid);
               pg8::EpiStore<1> E{GATES, b_in + C_MG, nullptr, 3072, -1};
               pg8::gemm_phase<pg8::EpiStore<1>, pg8::StaticOrder, true, true>(lds3, g, S, E); }
    SEAM(5);
    PHASE(6) {
#pragma unroll 1
        for (int j = 0; j < 3; ++j) { pg8::Gemm g{Yml + (size_t)j * M * 512, Wbr + (size_t)j * 1024 * 512, M, 1024, 512}; pg8::StaticOrder S; S.init(M, 1024, G, bid);
            pg8::EpiMergeG E{GATES, out, MERGED, j, 0};
            pg8::gemm_phase<pg8::EpiMergeG, pg8::StaticOrder, true, true>(lds3, g, S, E); }
    }
    SEAM(6);
    PHASE(7) { pg8::Gemm g{MERGED, Wo, M, 1024, D}; pg8::StaticOrder S; S.init(M, 1024, G, bid);
               pg8::EpiResidF E{x, out};
               pg8::gemm_phase<pg8::EpiResidF, pg8::StaticOrder, true, true>(lds3, g, S, E); }
    SEAM(7);
    PHASE(8) { const int gw = bid * 8 + wave, NGW = G * 8; for (int m = gw; m < M; m += NGW) rms_row_wave(out + (size_t)m * D, g_ffn, AFFN + (size_t)m * D, lane); }
    SEAM(8);
    PHASE(9) { pg8::Gemm g{AFFN, Wf1, M, FF, D}; pg8::StaticOrder S; S.init(M, FF, G, bid);
               pg8::EpiStore<2> E{HBUF, nullptr, nullptr, FF, -1};
               pg8::gemm_phase<pg8::EpiStore<2>, pg8::StaticOrder, true, true>(lds3, g, S, E); }
    SEAM(9);
    PHASE(10) { pg8::Gemm g{HBUF, Wf2, M, 1024, FF}; pg8::StaticOrder S; S.init(M, 1024, G, bid);
                pg8::EpiResidF E{out, out};
                pg8::gemm_phase<pg8::EpiResidF, pg8::StaticOrder, true, true>(lds3, g, S, E); }
    SEAM(10);
    PHASE(11) { run_vb<256>(M, lds, [=](VB vb) { rms_rows<false>(vb, out, g_final, out); }); }
}
constexpr int N_PHASES = 12;
#ifndef MK_PER_PHASE
#define MK_PER_PHASE 0
#endif
extern "C" void kernel_launch(void* const* d_in, const int* in_sizes, int n_in, void* d_out, int out_size, void* d_ws, size_t ws_size, hipStream_t stream) {
    static int grid = 0;
    if (grid == 0) {
        int dev = 0, cus = 0, per_cu = 0;
        (void)hipGetDevice(&dev); (void)hipDeviceGetAttribute(&cus, hipDeviceAttributeMultiprocessorCount, dev);
        (void)hipFuncSetAttribute((const void*)mega, hipFuncAttributeMaxDynamicSharedMemorySize, LDS_BYTES);
        (void)hipOccupancyMaxActiveBlocksPerMultiprocessor(&per_cu, (const void*)mega, NTHREADS, LDS_BYTES);
        if (per_cu < 1) { fprintf(stderr, "occupancy query says %d blocks/CU\n", per_cu); per_cu = 1; }
        grid = cus * 1;
        (void)hipGetLastError();
    }
    Args a{};
    for (int i = 0; i < 18; ++i) a.in[i] = (const float*)d_in[i];
    a.out = (float*)d_out; a.ws = (unsigned char*)d_ws;
#if MK_PER_PHASE
    for (int p = 0; p < N_PHASES; ++p) { a.ph_lo = p; a.ph_hi = p + 1; void* args[] = {&a};
        (void)hipLaunchCooperativeKernel((const void*)mega, dim3(grid), dim3(NTHREADS), args, LDS_BYTES, stream); }
#else
    a.ph_lo = 0; a.ph_hi = N_PHASES; void* args[] = {&a};
    hipError_t e = hipLaunchCooperativeKernel((const void*)mega, dim3(grid), dim3(NTHREADS), args, LDS_BYTES, stream);
    if (e != hipSuccess) fprintf(stderr, "cooperative launch failed: %s (grid %d)\n", hipGetErrorString(e), grid);
#endif
}
```

```cpp
#include <hip/hip_runtime.h>
#include <hip/hip_cooperative_groups.h>
#include <cstdio>
namespace cg = cooperative_groups;
#include <stdint.h>

typedef unsigned short bf16_t;
struct VB { int id; int tid; char* sm; };
__device__ __forceinline__ float bf2f(bf16_t v) { return __uint_as_float(((unsigned)v) << 16); }
__device__ __forceinline__ bf16_t f2bf(float f) { unsigned u = __float_as_uint(f); return (bf16_t)((u + 0x7fffu + ((u >> 16) & 1u)) >> 16); }

constexpr int NB = 4, T = 4096, M = NB * T, D = 1024, DIN = 6944, FF = 4096;
constexpr float EPS = 1e-6f;
constexpr int C_MLI = 2048, C_NSG = 3336, C_MG = 3872;
constexpr int P_MLQ = 0, P_MLK = 512, P_MLV = 1024, P_MLO = 1536, P_NSQ = 2048, P_KC = 2560, P_VC = 2688, P_KS = 2816, P_VS = 2944, P_KW = 3072, P_VW = 3200, P_XAQ = 3328, PW = 3840;
constexpr size_t MiB = 1u << 20;
constexpr size_t WS_U = 40 * MiB;
constexpr size_t WS_P = 72 * MiB;
constexpr size_t WS_Y = 192 * MiB;
constexpr size_t WS_AFFN = 200 * MiB;
constexpr size_t WS_S32 = 240 * MiB;
constexpr size_t WS_MEMN = 242 * MiB;
constexpr size_t WS_MEMKV = 244 * MiB;
constexpr size_t WS_KC = 246 * MiB;
constexpr size_t WS_VC = 246 * MiB + 512 * 1024;
constexpr size_t WS_NA = 247 * MiB;
constexpr size_t WS_G = 248 * MiB;
constexpr size_t WS_MLOC = 248 * MiB + 4096;
constexpr size_t WS_MPREV = 248 * MiB + 8192;

__device__ __forceinline__ float wave_sum(float v) {
#pragma unroll
    for (int o = 1; o < 64; o <<= 1) v += __shfl_xor(v, o);
    return v;
}
__device__ __forceinline__ float wave_max(float v) {
#pragma unroll
    for (int o = 1; o < 64; o <<= 1) v = fmaxf(v, __shfl_xor(v, o));
    return v;
}

template <bool OUT_BF16>
__device__ __forceinline__ void rms_rows(VB vb, const float* x, const float* g, void* out) {
    float* red = (float*)vb.sm;
    const int row = vb.id, tid = vb.tid;
    const float4 v = ((const float4*)(x + (size_t)row * D))[tid];
    float s = v.x * v.x + v.y * v.y + v.z * v.z + v.w * v.w;
    s = wave_sum(s);
    if ((tid & 63) == 0) red[tid >> 6] = s;
    __syncthreads();
    const float tot = red[0] + red[1] + red[2] + red[3];
    const float r = rsqrtf(tot * (1.0f / D) + EPS);
    const float4 gg = ((const float4*)g)[tid];
    float4 o; o.x = v.x * r * gg.x; o.y = v.y * r * gg.y; o.z = v.z * r * gg.z; o.w = v.w * r * gg.w;
    if (OUT_BF16) { bf16_t* ob = (bf16_t*)out + (size_t)row * D + tid * 4; ob[0] = f2bf(o.x); ob[1] = f2bf(o.y); ob[2] = f2bf(o.z); ob[3] = f2bf(o.w); }
    else ((float4*)((float*)out + (size_t)row * D))[tid] = o;
}

struct GArgs { const bf16_t* A; const float* W; int lda, ldw, N, K; };
template <class Epi>
__device__ __forceinline__ void ngemm(VB vb, GArgs ga, Epi epi) {
    const bf16_t* A = ga.A; const float* W = ga.W; const int lda = ga.lda, ldw = ga.ldw, N = ga.N, K = ga.K;
    float (*As)[65] = (float (*)[65])vb.sm; float (*Bs)[65] = (float (*)[65])(vb.sm + 16 * 65 * 4);
    const int tid = vb.tid, tx = tid & 15, ty = tid >> 4;
    const int nx = (N + 63) / 64; const int m0 = (vb.id / nx) * 64, n0 = (vb.id % nx) * 64;
    float acc[4][4];
#pragma unroll
    for (int i = 0; i < 4; ++i)
#pragma unroll
        for (int j = 0; j < 4; ++j) acc[i][j] = 0.f;
    for (int k0 = 0; k0 < K; k0 += 16) {
#pragma unroll
        for (int i = 0; i < 4; ++i) { const int idx = tid + i * 256, r = idx >> 4, kk = idx & 15; As[kk][r] = bf2f(A[(size_t)(m0 + r) * lda + k0 + kk]); }
#pragma unroll
        for (int i = 0; i < 4; ++i) { const int idx = tid + i * 256, kk = idx >> 6, n = idx & 63; Bs[kk][n] = (n0 + n < N) ? W[(size_t)(k0 + kk) * ldw + n0 + n] : 0.f; }
        __syncthreads();
#pragma unroll
        for (int kk = 0; kk < 16; ++kk) {
            float a[4], b[4];
#pragma unroll
            for (int i = 0; i < 4; ++i) { a[i] = As[kk][ty * 4 + i]; b[i] = Bs[kk][tx * 4 + i]; }
#pragma unroll
            for (int i = 0; i < 4; ++i)
#pragma unroll
                for (int j = 0; j < 4; ++j) acc[i][j] += a[i] * b[j];
        }
        __syncthreads();
    }
#pragma unroll
    for (int i = 0; i < 4; ++i)
#pragma unroll
        for (int j = 0; j < 4; ++j) { const int n = n0 + tx * 4 + j; if (n < N) epi(m0 + ty * 4 + i, n, acc[i][j]); }
}
struct EpiBiasBf16 { bf16_t* O; const float* bias; int ldo, pad; __device__ void operator()(int m, int n, float a) const { O[(size_t)m * ldo + n] = f2bf(a + (bias ? bias[n] : 0.f)); } };
struct EpiBiasF32 { float* O; const float* bias; int ldo, pad; __device__ void operator()(int m, int n, float a) const { O[(size_t)m * ldo + n] = a + bias[n]; } };
struct EpiSigBf16 { bf16_t* O; const float* bias; int ldo, pad; __device__ void operator()(int m, int n, float a) const { const float v = a + bias[n]; O[(size_t)m * ldo + n] = f2bf(1.f / (1.f + __expf(-v))); } };
struct EpiMerge { const bf16_t* G; float* Mf; bf16_t* Mb; int j, pad; __device__ void operator()(int m, int n, float a) const {
    const float g = bf2f(G[(size_t)m * 3072 + j * 1024 + n]); float v = g * a; if (j > 0) v += Mf[(size_t)m * D + n];
    if (j < 2) Mf[(size_t)m * D + n] = v; else Mb[(size_t)m * D + n] = f2bf(v); } };
struct EpiResid { const float* X; float* O; __device__ void operator()(int m, int n, float a) const { O[(size_t)m * D + n] = X[(size_t)m * D + n] + a; } };
struct EpiRelu2 { bf16_t* O; __device__ void operator()(int m, int n, float a) const { const float r = fmaxf(a, 0.f); O[(size_t)m * FF + n] = f2bf(r * r); } };

__device__ __forceinline__ float convqk(const bf16_t* P, const float* w  , int m, int t, int ch) {
    float y = 0.f;
#pragma unroll
    for (int j = 0; j < 4; ++j) if (t - j >= 0) y += w[j * 1024 + ch] * bf2f(P[(size_t)(m - j) * PW + ch]);
    return bf2f(f2bf(y / (1.f + __expf(-y))));
}
__device__ __forceinline__ float logsig(float x) { return fminf(x, 0.f) - log1pf(__expf(-fabsf(x))); }
__device__ __forceinline__ void m1_naive(VB vb, const bf16_t* P, const float* cw, const float* S32, float* Abuf, float* NA, float* Gc, float* Mloc) {
    float (*kk)[128] = (float (*)[128])vb.sm; float* e = (float*)(vb.sm + 32768); float* bc = e + 64;
    const int ci = vb.id, c = ci & 63, bh = ci >> 6, h = bh & 3, b = bh >> 2, tid = vb.tid;
    const int m0 = b * T + c * 64;
    if (tid == 0) {
        float run = 0.f;
        for (int s = 0; s < 64; ++s) { run += logsig(S32[(size_t)(m0 + s) * 32 + 4 + h]); bc[s] = run; }
        const float g = run; float mx = -INFINITY;
        for (int s = 0; s < 64; ++s) { const float w = g - bc[s] + S32[(size_t)(m0 + s) * 32 + h]; e[s] = w; mx = fmaxf(mx, w); }
        for (int s = 0; s < 64; ++s) e[s] = __expf(e[s] - mx);
        Gc[ci] = g; Mloc[ci] = mx;
    }
    for (int i = tid; i < 64 * 128; i += 256) { const int s = i >> 7, k = i & 127; kk[s][k] = convqk(P, cw, m0 + s, c * 64 + s, 512 + h * 128 + k) * 0.08838834764831845f; }
    __syncthreads();
    const int v = tid & 127, kh = tid >> 7;
    float acc[64];
#pragma unroll
    for (int i = 0; i < 64; ++i) acc[i] = 0.f;
    for (int s = 0; s < 64; ++s) {
        const float ev = e[s] * bf2f(P[(size_t)(m0 + s) * PW + P_MLV + h * 128 + v]);
#pragma unroll
        for (int i = 0; i < 64; ++i) acc[i] += kk[s][kh * 64 + i] * ev;
    }
#pragma unroll
    for (int i = 0; i < 64; ++i) Abuf[((size_t)ci * 128 + kh * 64 + i) * 128 + v] = acc[i];
    if (tid < 128) { float n = 0.f; for (int s = 0; s < 64; ++s) n += e[s] * kk[s][tid]; NA[(size_t)ci * 128 + tid] = n; }
}
__device__ __forceinline__ void m2_naive(VB vb, float* Abuf, float* NA, const float* Gc, const float* Mloc, float* Mprev) {
    const int i = vb.id * 256 + vb.tid;
    const int bh = i >> 14, kv = i & 16383, k = kv >> 7, v = kv & 127;
    float C = 0.f, n = 0.f, m = 0.f;
    for (int c = 0; c < 64; ++c) {
        const int ci = bh * 64 + c;
        const float g = Gc[ci], ml = Mloc[ci];
        const float mn = fmaxf(g + m, ml), a = __expf(g + m - mn), bb = __expf(ml - mn);
        const size_t idx = ((size_t)ci * 128 + k) * 128 + v;
        const float A = Abuf[idx]; Abuf[idx] = C; C = a * C + bb * A;
        if (v == 0) { const float nA = NA[(size_t)ci * 128 + k]; NA[(size_t)ci * 128 + k] = n; n = a * n + bb * nA; }
        if (kv == 0) Mprev[ci] = m;
        m = mn;
    }
}
__device__ __forceinline__ void m3_naive(VB vb, const bf16_t* P, const float* cw, const float* S32, const float* Cprev, const float* Nprev, const float* Mprev,
                                                const float* normg, bf16_t* Yml) {
    float* q = (float*)vb.sm; float* Srow = q + 128; float* bc = Srow + 64; float* li = bc + 64; float* sh = li + 64;
    const int ci = vb.id >> 6, tt = vb.id & 63, c = ci & 63, bh = ci >> 6, h = bh & 3, b = bh >> 2, tid = vb.tid;
    const int m0 = b * T + c * 64, m = m0 + tt;
    q[tid] = convqk(P, cw, m, c * 64 + tt, h * 128 + tid);
    if (tid == 0) { float run = 0.f; for (int s = 0; s <= tt; ++s) { run += logsig(S32[(size_t)(m0 + s) * 32 + 4 + h]); bc[s] = run; li[s] = S32[(size_t)(m0 + s) * 32 + h]; } }
    __syncthreads();
    const float mprev = Mprev[ci], inter = bc[tt] + mprev;
    float mt = inter;
    for (int s = 0; s <= tt; ++s) mt = fmaxf(mt, bc[tt] - bc[s] + li[s]);
    if (tid < 64) {
        float sv = 0.f;
        if (tid <= tt) { float dot = 0.f; for (int k = 0; k < 128; ++k) dot += q[k] * convqk(P, cw, m0 + tid, c * 64 + tid, 512 + h * 128 + k);
            sv = dot * 0.08838834764831845f * __expf(bc[tt] - bc[tid] + li[tid] - mt); }
        Srow[tid] = sv;
    }
    __syncthreads();
    const float sc = __expf(inter - mt);
    float num = 0.f, den = 0.f;
    for (int s = 0; s <= tt; ++s) { num += Srow[s] * bf2f(P[(size_t)(m0 + s) * PW + P_MLV + h * 128 + tid]); den += Srow[s]; }
    float qc = 0.f, qn = 0.f;
    for (int k = 0; k < 128; ++k) { qc += q[k] * Cprev[((size_t)ci * 128 + k) * 128 + tid]; qn += q[k] * Nprev[(size_t)ci * 128 + k]; }
    num += sc * qc; den += sc * qn;
    const float hv = num / fmaxf(fabsf(den), __expf(-mt));
    float ss = wave_sum(hv * hv);
    if ((tid & 63) == 0) sh[tid >> 6] = ss;
    __syncthreads();
    const float r = rsqrtf((sh[0] + sh[1]) * (1.f / 128.f) + EPS);
    const float o = bf2f(P[(size_t)m * PW + P_MLO + h * 128 + tid]);
    Yml[(size_t)m * 512 + h * 128 + tid] = f2bf(1.f / (1.f + __expf(-o)) * hv * r * normg[h * 128 + tid]);
}

__device__ __forceinline__ float gelu_tanh(float x) { const float u = 0.7978845608028654f * (x + 0.044715f * x * x * x); return 0.5f * x * (1.f + tanhf(u)); }
__device__ __forceinline__ void n1_naive(VB vb, const bf16_t* P, const float* pe  , const float* w1  , const float* w2  , bf16_t* KC, bf16_t* VC) {
    float* xin = (float*)vb.sm; float* hid = xin + 2048;
    int idx = vb.id; const int g = idx & 1; idx >>= 1; const int n = idx % 255; idx /= 255; const int b = idx & 3, kv = idx >> 2, tid = vb.tid;
    const int pcol = (kv ? P_VC : P_KC) + g * 64;
    for (int i = tid; i < 2048; i += 256) { const int l = i >> 6, d = i & 63; xin[i] = bf2f(P[(size_t)(b * T + n * 16 + l) * PW + pcol + d]) + pe[kv * 2048 + i]; }
    __syncthreads();
    float a = 0.f; const float* w = w1 + (size_t)kv * 2048 * 256 + tid;
    for (int i = 0; i < 2048; ++i) a += xin[i] * w[(size_t)i * 256];
    hid[tid] = gelu_tanh(a);
    __syncthreads();
    if (tid < 64) { float o = 0.f; const float* ww = w2 + (size_t)kv * 256 * 64 + tid; for (int j = 0; j < 256; ++j) o += hid[j] * ww[j * 64];
        (kv ? VC : KC)[((size_t)(b * 256 + n) * 2 + g) * 64 + tid] = f2bf(o); }
}
__device__ __forceinline__ void n2_naive(VB vb, const bf16_t* P, const float* S32, const bf16_t* KC, const bf16_t* VC, bf16_t* Ynsa) {
    float (*q_s)[64] = (float (*)[64])vb.sm; float (*sc)[1024] = (float (*)[1024])(vb.sm + 1024); float (*pc)[256] = (float (*)[256])(vb.sm + 1024 + 16384); float* imp_s = (float*)(vb.sm + 1024 + 16384 + 4096);
    unsigned long long& selmask = *(unsigned long long*)(vb.sm + 1024 + 16384 + 4096 + 256);
    const int g = vb.id & 1, m = vb.id >> 1, b = m / T, t = m % T, tid = vb.tid, r = tid >> 6, lane = tid & 63, h = g * 4 + r;
    const float slope = exp2f(-(float)(h + 1));
    q_s[r][lane] = bf2f(P[(size_t)m * PW + P_NSQ + h * 64 + lane]) * 0.125f;
    __syncthreads();
    float sv[4]; float mx = -INFINITY;
#pragma unroll
    for (int i = 0; i < 4; ++i) { const int n = lane + 64 * i; sv[i] = -INFINITY;
        if (n < 255) { const int dist = t - (16 * n + 31); if (dist >= 0) { const bf16_t* kr = KC + ((size_t)(b * 256 + n) * 2 + g) * 64; float dot = 0.f; for (int d = 0; d < 64; ++d) dot += q_s[r][d] * bf2f(kr[d]);
            sv[i] = dot - slope * (float)dist; mx = fmaxf(mx, sv[i]); } } }
    mx = wave_max(mx);
    float sum = 0.f;
#pragma unroll
    for (int i = 0; i < 4; ++i) { sv[i] = (sv[i] == -INFINITY) ? 0.f : __expf(sv[i] - mx); sum += sv[i]; }
    sum = wave_sum(sum);
    const float inv = sum > 0.f ? 1.f / sum : 0.f;
#pragma unroll
    for (int i = 0; i < 4; ++i) pc[r][lane + 64 * i] = sv[i] * inv;
    __syncthreads();
    float oc = 0.f;
    { const int nmax = (t >= 31) ? ((t - 31) / 16) : -1; for (int n = 0; n <= nmax && n < 255; ++n) oc += pc[r][n] * bf2f(VC[((size_t)(b * 256 + n) * 2 + g) * 64 + lane]); }
    if (tid < 64) { const int j = tid; float im = 0.f;
        for (int n = 4 * j - 1; n <= 4 * j + 3; ++n) if (n >= 0 && n < 255) im += (pc[0][n] + pc[1][n]) + (pc[2][n] + pc[3][n]);
        const int cur = t >> 6; const bool valid = j <= cur, forced = (j == 0) || (j == cur) || (j == cur - 1);
        const float s = valid ? im + (forced ? 1000.f : 0.f) : -1e30f;
        imp_s[j] = s; }
    __syncthreads();
    if (tid < 64) { const int j = tid; const float s = imp_s[j]; int rank = 0;
        for (int jj = 0; jj < 64; ++jj) { const float o = imp_s[jj]; rank += (o > s || (o == s && jj < j)) ? 1 : 0; }
        const unsigned long long mk = __ballot(rank < 16 && j <= (t >> 6)); if (tid == 0) selmask = mk; }
    __syncthreads();
    float osel = 0.f;
    { unsigned long long mk = selmask; int slot = 0; float mxs = -INFINITY;
      while (mk) { const int jb = __ffsll((long long)mk) - 1; mk &= mk - 1; const int pos = jb * 64 + lane; float s = -INFINITY;
          if (pos <= t) { const bf16_t* kr = P + (size_t)(b * T + pos) * PW + P_KS + g * 64; float dot = 0.f; for (int d = 0; d < 64; ++d) dot += q_s[r][d] * bf2f(kr[d]); s = dot - slope * (float)(t - pos); }
          sc[r][slot * 64 + lane] = s; mxs = fmaxf(mxs, s); ++slot; }
      mxs = wave_max(mxs); float sm = 0.f;
      for (int i = 0; i < slot; ++i) { const float s = sc[r][i * 64 + lane]; const float p = (s == -INFINITY) ? 0.f : __expf(s - mxs); sc[r][i * 64 + lane] = p; sm += p; }
      sm = wave_sum(sm);
      mk = selmask; slot = 0;
      while (mk) { const int jb = __ffsll((long long)mk) - 1; mk &= mk - 1;
          for (int i = 0; i < 64; ++i) { const int pos = jb * 64 + i; if (pos > t) break; osel += sc[r][slot * 64 + i] * bf2f(P[(size_t)(b * T + pos) * PW + P_VS + g * 64 + lane]); }
          ++slot; }
      osel /= sm; }
    __syncthreads();
    float owin = 0.f;
    { float mxs = -INFINITY;
      for (int i = 0; i < 8; ++i) { const int pos = t - 511 + i * 64 + lane; float s = -INFINITY;
          if (pos >= 0) { const bf16_t* kr = P + (size_t)(b * T + pos) * PW + P_KW + g * 64; float dot = 0.f; for (int d = 0; d < 64; ++d) dot += q_s[r][d] * bf2f(kr[d]); s = dot - slope * (float)(t - pos); }
          sc[r][i * 64 + lane] = s; mxs = fmaxf(mxs, s); }
      mxs = wave_max(mxs); float sm = 0.f;
      for (int i = 0; i < 8; ++i) { const float s = sc[r][i * 64 + lane]; const float p = (s == -INFINITY) ? 0.f : __expf(s - mxs); sc[r][i * 64 + lane] = p; sm += p; }
      sm = wave_sum(sm);
      for (int i = 0; i < 512; ++i) { const int pos = t - 511 + i; if (pos < 0) continue; owin += sc[r][i] * bf2f(P[(size_t)(b * T + pos) * PW + P_VW + g * 64 + lane]); }
      owin /= sm; }
    const float* gp = S32 + (size_t)m * 32 + 8 + h * 3;
    const float g0 = 1.f / (1.f + __expf(-gp[0])), g1 = 1.f / (1.f + __expf(-gp[1])), g2 = 1.f / (1.f + __expf(-gp[2]));
    Ynsa[(size_t)m * 512 + h * 64 + lane] = f2bf(g0 * oc + g1 * osel + g2 * owin);
}
__device__ __forceinline__ void x1_naive(VB vb, const bf16_t* P, const bf16_t* MEMKV, bf16_t* Yxa) {
    float (*q_s)[128] = (float (*)[128])vb.sm; float (*p_s)[256] = (float (*)[256])(vb.sm + 2048);
    const int m = vb.id, b = m / T, tid = vb.tid, h = tid >> 6, lane = tid & 63;
    q_s[h][lane] = bf2f(P[(size_t)m * PW + P_XAQ + h * 128 + lane]) * 0.08838834764831845f;
    q_s[h][lane + 64] = bf2f(P[(size_t)m * PW + P_XAQ + h * 128 + lane + 64]) * 0.08838834764831845f;
    __syncthreads();
    float sv[4]; float mx = -INFINITY;
#pragma unroll
    for (int i = 0; i < 4; ++i) { const int j = lane + 64 * i; const bf16_t* kr = MEMKV + (size_t)(b * 256 + j) * 1024 + h * 128; float dot = 0.f; for (int d = 0; d < 128; ++d) dot += q_s[h][d] * bf2f(kr[d]); sv[i] = dot; mx = fmaxf(mx, dot); }
    mx = wave_max(mx); float sm = 0.f;
#pragma unroll
    for (int i = 0; i < 4; ++i) { sv[i] = __expf(sv[i] - mx); sm += sv[i]; }
    sm = wave_sum(sm);
#pragma unroll
    for (int i = 0; i < 4; ++i) p_s[h][lane + 64 * i] = sv[i] / sm;
    __syncthreads();
    float o0 = 0.f, o1 = 0.f;
    for (int j = 0; j < 256; ++j) { const bf16_t* vr = MEMKV + (size_t)(b * 256 + j) * 1024 + 512 + h * 128; const float p = p_s[h][j]; o0 += p * bf2f(vr[lane]); o1 += p * bf2f(vr[lane + 64]); }
    Yxa[(size_t)m * 512 + h * 128 + lane] = f2bf(o0); Yxa[(size_t)m * 512 + h * 128 + lane + 64] = f2bf(o1);
}


namespace pg8 {
#define PG8_LAS __attribute__((address_space(3)))
typedef unsigned short bf16_t;
typedef short bf16x8 __attribute__((ext_vector_type(8)));
typedef float f32x4 __attribute__((ext_vector_type(4)));
typedef unsigned u32x4 __attribute__((ext_vector_type(4)));
constexpr int BM = 256, BK = 64, HALF = 128, HTB = HALF * BK * 2  , STAGE_BYTES = 8 * HTB, NXCD = 8, WGM = 8;

__host__ __device__ __forceinline__ int lds_byte(int r, int c) { const int st = (r >> 4) * 2 + (c >> 5), rr = r & 15, cc = c & 31, ob = rr * 64 + cc * 2; return st * 1024 + (ob ^ (((ob >> 9) & 1) << 5)); }
__host__ __device__ __forceinline__ void stage_rc(int b, int& R, int& C) { const int st = b / 1024, sb = b % 1024, swz = sb ^ (((sb >> 9) & 1) << 5); R = (st >> 1) * 16 + swz / 64; C = (st & 1) * 32 + (swz % 64) / 2; }
__host__ __device__ __forceinline__ int perm32(int rho) { const int n = rho >> 4, i = rho & 15; return 8 * (i >> 2) + 4 * n + (i & 3); }

struct Unit { int pm, pn; };
struct Gemm { const bf16_t* A; const bf16_t* Bt; int M, N, K; };

struct StaticOrder {
    int nM, nN, nwg, G, c;
    __host__ __device__ void init(int M, int N, int G_, int c_) { nM = M / BM; nN = N / BM; nwg = nM * nN; G = G_; c = c_; }
    __host__ __device__ bool next(int i, Unit& u) const {
        const long L = (long)i * G + c; if (L >= nwg) return false;
        int wgid = (int)L; { const int q = nwg / NXCD, r = nwg % NXCD, xcd = wgid % NXCD, off = wgid / NXCD; wgid = (xcd < r ? xcd * (q + 1) : r * (q + 1) + (xcd - r) * q) + off; }
        const int nig = WGM * nN, gid = wgid / nig, fm = gid * WGM, gsz = (nM - fm) < WGM ? (nM - fm) : WGM;
        u.pm = fm + ((wgid % nig) % gsz); u.pn = (wgid % nig) / gsz; return true;
    }
    __device__ __forceinline__ void a_ready(const Unit&) const {}
    __device__ __forceinline__ void done(const Unit&) const {}
};

typedef float f32x2_t __attribute__((ext_vector_type(2))); typedef __bf16 bf16x2_t __attribute__((ext_vector_type(2)));
__device__ __forceinline__ unsigned cvt_pk_bf16(float lo, float hi) { f32x2_t v = {lo, hi}; bf16x2_t b = __builtin_convertvector(v, bf16x2_t); return __builtin_bit_cast(unsigned, b); }
typedef float f32x2 __attribute__((ext_vector_type(2)));

typedef unsigned u32x2 __attribute__((ext_vector_type(2)));
__device__ __forceinline__ float bflo(unsigned w) { return __uint_as_float(w << 16); }
__device__ __forceinline__ float bfhi(unsigned w) { return __uint_as_float(w & 0xffff0000u); }
template <int ACT> __device__ __forceinline__ f32x4 act4(f32x4 v) {
    if (ACT == 1) { f32x4 o; for (int e = 0; e < 4; ++e) o[e] = __builtin_amdgcn_rcpf(1.f + __expf(-v[e])); return o; }
    if (ACT == 2) { f32x4 o; for (int e = 0; e < 4; ++e) { const float r = fmaxf(v[e], 0.f); o[e] = r * r; } return o; }
    return v;
}
template <int ACT> struct EpiStore {
    static constexpr bool PERM = true, AFTER_DRAIN = false;
    bf16_t* O; const float* bias; float* S32; int ldc, small_pn;
    __device__ __forceinline__ void operator()(const f32x4 (&acc)[2][2][4][2], const Unit& u, int wr, int wc, int fr, int fq) const {
        asm volatile("s_waitcnt vmcnt(0)" ::: "memory");
        const int row0 = u.pm * BM + wr * 64 + fr, col0 = u.pn * BM + wc * 32 + 8 * fq;
        if (u.pn == small_pn) {
            if (wc == 0) {
                const f32x4 b0 = *(const f32x4*)(bias + col0), b1 = *(const f32x4*)(bias + col0 + 4);
#pragma unroll
                for (int ai = 0; ai < 2; ++ai)
#pragma unroll
                    for (int m = 0; m < 4; ++m) { float* rp = S32 + (size_t)(row0 + ai * HALF + m * 16) * 32 + 8 * fq;
                        *(f32x4*)rp = acc[ai][0][m][0] + acc[ai][1][m][0] + b0; *(f32x4*)(rp + 4) = acc[ai][0][m][1] + acc[ai][1][m][1] + b1; }
            }
            return;
        }
        f32x4 bv[2][2];
#pragma unroll
        for (int bj = 0; bj < 2; ++bj)
#pragma unroll
            for (int n = 0; n < 2; ++n) bv[bj][n] = bias ? *(const f32x4*)(bias + col0 + bj * HALF + 4 * n) : (f32x4){0.f, 0.f, 0.f, 0.f};
#pragma unroll
        for (int ai = 0; ai < 2; ++ai)
#pragma unroll
            for (int m = 0; m < 4; ++m) { bf16_t* rowp = O + (size_t)(row0 + ai * HALF + m * 16) * ldc + col0;
#pragma unroll
                for (int bj = 0; bj < 2; ++bj) { const f32x4 v0 = act4<ACT>(acc[ai][bj][m][0] + bv[bj][0]), v1 = act4<ACT>(acc[ai][bj][m][1] + bv[bj][1]);
                    u32x4 w; w.x = cvt_pk_bf16(v0[0], v0[1]); w.y = cvt_pk_bf16(v0[2], v0[3]); w.z = cvt_pk_bf16(v1[0], v1[1]); w.w = cvt_pk_bf16(v1[2], v1[3]);
                    *(u32x4*)(rowp + bj * HALF) = w; } }
    }
};
struct EpiMergeG {
    static constexpr bool PERM = true, AFTER_DRAIN = false;
    const bf16_t* G; float* Mf; bf16_t* Mb; int j, pad;
    __device__ __forceinline__ void operator()(const f32x4 (&acc)[2][2][4][2], const Unit& u, int wr, int wc, int fr, int fq) const {
        asm volatile("s_waitcnt vmcnt(0)" ::: "memory");
        const int row0 = u.pm * BM + wr * 64 + fr, col0 = u.pn * BM + wc * 32 + 8 * fq;
#pragma unroll
        for (int ai = 0; ai < 2; ++ai)
#pragma unroll
            for (int m = 0; m < 4; ++m) { const size_t row = (size_t)(row0 + ai * HALF + m * 16);
#pragma unroll
                for (int bj = 0; bj < 2; ++bj) { const int col = col0 + bj * HALF;
                    const u32x4 gw = *(const u32x4*)(G + row * 3072 + j * 1024 + col);
                    f32x4 v0 = (f32x4){bflo(gw.x), bfhi(gw.x), bflo(gw.y), bfhi(gw.y)} * acc[ai][bj][m][0], v1 = (f32x4){bflo(gw.z), bfhi(gw.z), bflo(gw.w), bfhi(gw.w)} * acc[ai][bj][m][1];
                    float* mp = Mf + row * 1024 + col;
                    if (j > 0) { v0 += *(const f32x4*)mp; v1 += *(const f32x4*)(mp + 4); }
                    if (j < 2) { *(f32x4*)mp = v0; *(f32x4*)(mp + 4) = v1; }
                    else { u32x4 w; w.x = cvt_pk_bf16(v0[0], v0[1]); w.y = cvt_pk_bf16(v0[2], v0[3]); w.z = cvt_pk_bf16(v1[0], v1[1]); w.w = cvt_pk_bf16(v1[2], v1[3]); *(u32x4*)(Mb + row * 1024 + col) = w; } } }
    }
};
struct EpiResidF {
    static constexpr bool PERM = true, AFTER_DRAIN = false;
    const float* X; float* O;
    __device__ __forceinline__ void operator()(const f32x4 (&acc)[2][2][4][2], const Unit& u, int wr, int wc, int fr, int fq) const {
        asm volatile("s_waitcnt vmcnt(0)" ::: "memory");
        const int row0 = u.pm * BM + wr * 64 + fr, col0 = u.pn * BM + wc * 32 + 8 * fq;
#pragma unroll
        for (int ai = 0; ai < 2; ++ai)
#pragma unroll
            for (int m = 0; m < 4; ++m) { const size_t off = (size_t)(row0 + ai * HALF + m * 16) * 1024 + col0;
#pragma unroll
                for (int bj = 0; bj < 2; ++bj) { const f32x4 x0 = *(const f32x4*)(X + off + bj * HALF), x1 = *(const f32x4*)(X + off + bj * HALF + 4);
                    *(f32x4*)(O + off + bj * HALF) = x0 + acc[ai][bj][m][0]; *(f32x4*)(O + off + bj * HALF + 4) = x1 + acc[ai][bj][m][1]; } }
    }
};
template <class Epi, class Sched, bool ALIGN_EPI = false, bool SP2 = false>
__device__ __forceinline__ void gemm_phase(PG8_LAS unsigned char* lds, const Gemm g, const Sched& S, const Epi& E) {
    const int tid = threadIdx.x, wid = __builtin_amdgcn_readfirstlane(tid >> 6), lane = tid & 63, wr = wid >> 2, wc = wid & 3, fr = lane & 15, fq = lane >> 4;
    const int K = g.K, nt = K / BK;
    unsigned voffA[2], voffB[2];
#pragma unroll
    for (int i = 0; i < 2; ++i) { int R, C; stage_rc(tid * 16 + i * 8192, R, C); const int Rb = Epi::PERM ? ((R & ~31) + perm32(R & 31)) : R;
        voffA[i] = (unsigned)(R * K + C) * 2u; voffB[i] = (unsigned)(Rb * K + C) * 2u; }
    const size_t kstep = (size_t)(BK * 2);
    const size_t hstep = (size_t)HALF * K * 2;
    const size_t tstep = 2 * hstep;
    const unsigned ldsw = (unsigned)wid * 1024u;
    const int aoff = lds_byte(wr * 64 + fr, fq * 8), boff = lds_byte(wc * 32 + fr, fq * 8);
#define PG8_SA(b, h) (((b) * 2 + (h)) * HTB)
#define PG8_SB(b, h) ((4 + (b) * 2 + (h)) * HTB)
#define PG8_STAGE(bufoff, gbase, voff) do { _Pragma("unroll") for (int _i = 0; _i < 2; ++_i) \
        __builtin_amdgcn_global_load_lds((const unsigned*)((const char*)(gbase) + (voff)[_i]), (PG8_LAS unsigned*)(lds + (bufoff) + ldsw + _i * 8192), 16, 0, 0); } while (0)
#define PG8_LDA(dst, b, h) do { _Pragma("unroll") for (int m = 0; m < 4; ++m) _Pragma("unroll") for (int k = 0; k < 2; ++k) dst[m][k] = *(const PG8_LAS bf16x8*)(lds + PG8_SA(b, h) + aoff + m * 2048 + k * 1024); } while (0)
#define PG8_LDB(dst, b, h) do { _Pragma("unroll") for (int n = 0; n < 2; ++n) _Pragma("unroll") for (int k = 0; k < 2; ++k) dst[n][k] = *(const PG8_LAS bf16x8*)(lds + PG8_SB(b, h) + boff + n * 2048 + k * 1024); } while (0)
#define PG8_MMA(ai, bj, At, Bt) do { __builtin_amdgcn_s_setprio(1); _Pragma("unroll") for (int m = 0; m < 4; ++m) _Pragma("unroll") for (int n = 0; n < 2; ++n) _Pragma("unroll") for (int k = 0; k < 2; ++k) \
        acc[ai][bj][m][n] = __builtin_amdgcn_mfma_f32_16x16x32_bf16(Bt[n][k], At[m][k], acc[ai][bj][m][n], 0, 0, 0); __builtin_amdgcn_s_setprio(0); } while (0)
#define PG8_WAIT_V(n) asm volatile("s_waitcnt vmcnt(" #n ")" ::: "memory")
#define PG8_WAIT_L(n) asm volatile("s_waitcnt lgkmcnt(" #n ")" ::: "memory")
#define PG8_BAR __builtin_amdgcn_s_barrier()
#define PG8_SCHED __builtin_amdgcn_sched_barrier(0)
    Unit cur, nxt; int ui = 0;
    if (!S.next(0, cur)) return;
    f32x4 acc[2][2][4][2];
#pragma unroll
    for (int a = 0; a < 2; ++a)
#pragma unroll
        for (int b = 0; b < 2; ++b)
#pragma unroll
            for (int m = 0; m < 4; ++m)
#pragma unroll
                for (int n = 0; n < 2; ++n) acc[a][b][m][n] = (f32x4){0.f, 0.f, 0.f, 0.f};
    bf16x8 At[4][2], B0[2][2], B1[2][2];
    const char* cA = (const char*)g.A + (size_t)cur.pm * tstep; const char* cB = (const char*)g.Bt + (size_t)cur.pn * tstep;
    S.a_ready(cur);
    if constexpr (SP2) {
        PG8_STAGE(PG8_SB(0, 0), cB, voffB); PG8_STAGE(PG8_SB(0, 1), cB + hstep, voffB); PG8_STAGE(PG8_SA(0, 0), cA, voffA); PG8_STAGE(PG8_SA(0, 1), cA + hstep, voffA);
        if (wr == 1) PG8_BAR;
        PG8_WAIT_V(2); PG8_BAR;
        PG8_STAGE(PG8_SB(1, 0), cB + kstep, voffB); PG8_STAGE(PG8_SA(1, 0), cA + kstep, voffA); PG8_STAGE(PG8_SB(1, 1), cB + hstep + kstep, voffB);
        PG8_WAIT_V(6); PG8_BAR;
    } else {
        PG8_STAGE(PG8_SB(0, 0), cB, voffB); PG8_STAGE(PG8_SA(0, 0), cA, voffA); PG8_STAGE(PG8_SB(0, 1), cB + hstep, voffB); PG8_STAGE(PG8_SA(0, 1), cA + hstep, voffA);
        if (wr == 1) PG8_BAR;
        PG8_WAIT_V(4); PG8_BAR;
        PG8_STAGE(PG8_SB(1, 0), cB + kstep, voffB); PG8_STAGE(PG8_SA(1, 0), cA + kstep, voffA); PG8_STAGE(PG8_SB(1, 1), cB + hstep + kstep, voffB);
        PG8_WAIT_V(6); PG8_BAR;
    }
    for (;;) {
        const bool has_next = S.next(ui + 1, nxt);
        const char* nA = has_next ? (const char*)g.A + (size_t)nxt.pm * tstep : cA; const char* nB = has_next ? (const char*)g.Bt + (size_t)nxt.pn * tstep : cB;
        for (int t = 0; t < nt; t += 2) {
            const bool last = (t == nt - 2);
            const char* a1 = cA + (size_t)(t + 1) * kstep;
            const char* a2 = last ? nA : cA + (size_t)(t + 2) * kstep; const char* b2 = last ? nB : cB + (size_t)(t + 2) * kstep;
            const char* a3 = a2 + kstep; const char* b3 = b2 + kstep;
            if (last && has_next) S.a_ready(nxt);
            if constexpr (SP2) {
            PG8_LDB(B0, 0, 0); PG8_LDB(B1, 0, 1); PG8_SCHED; PG8_LDA(At, 0, 0); PG8_STAGE(PG8_SA(1, 1), a1 + hstep, voffA);
            PG8_WAIT_V(8); PG8_WAIT_L(0); PG8_BAR; PG8_MMA(0, 0, At, B0); PG8_MMA(0, 1, At, B1); PG8_BAR; PG8_SCHED;
            PG8_LDA(At, 0, 1); PG8_STAGE(PG8_SB(0, 0), b2, voffB); PG8_STAGE(PG8_SB(0, 1), b2 + hstep, voffB); PG8_STAGE(PG8_SA(0, 0), a2, voffA);
            PG8_WAIT_V(8); PG8_WAIT_L(0); PG8_BAR; PG8_MMA(1, 0, At, B0); PG8_MMA(1, 1, At, B1); PG8_BAR; PG8_SCHED;
            PG8_LDB(B0, 1, 0); PG8_LDB(B1, 1, 1); PG8_SCHED; PG8_LDA(At, 1, 0); PG8_STAGE(PG8_SA(0, 1), a2 + hstep, voffA);
            PG8_WAIT_V(8); PG8_WAIT_L(0); PG8_BAR; PG8_MMA(0, 0, At, B0); PG8_MMA(0, 1, At, B1); PG8_BAR; PG8_SCHED;
            PG8_LDA(At, 1, 1); PG8_STAGE(PG8_SB(1, 0), b3, voffB); PG8_STAGE(PG8_SB(1, 1), b3 + hstep, voffB); PG8_STAGE(PG8_SA(1, 0), a3, voffA);
            PG8_WAIT_V(8); PG8_WAIT_L(0); PG8_BAR; PG8_MMA(1, 0, At, B0); PG8_MMA(1, 1, At, B1); PG8_BAR; PG8_SCHED;
            } else {
            PG8_LDB(B0, 0, 0); PG8_SCHED; PG8_LDA(At, 0, 0); PG8_STAGE(PG8_SA(1, 1), a1 + hstep, voffA);
            PG8_WAIT_L(8); PG8_BAR; PG8_WAIT_L(0); PG8_MMA(0, 0, At, B0); PG8_BAR; PG8_SCHED;
            PG8_LDB(B1, 0, 1); PG8_STAGE(PG8_SB(0, 0), b2, voffB);
            PG8_BAR; PG8_WAIT_L(0); PG8_MMA(0, 1, At, B1); PG8_BAR;
            PG8_LDA(At, 0, 1); PG8_STAGE(PG8_SA(0, 0), a2, voffA);
            PG8_BAR; PG8_WAIT_L(0); PG8_MMA(1, 0, At, B0); PG8_BAR; PG8_SCHED;
            PG8_STAGE(PG8_SB(0, 1), b2 + hstep, voffB);
            PG8_WAIT_V(6); PG8_BAR; PG8_MMA(1, 1, At, B1); PG8_BAR;
            PG8_LDB(B0, 1, 0); PG8_SCHED; PG8_LDA(At, 1, 0); PG8_STAGE(PG8_SA(0, 1), a2 + hstep, voffA);
            PG8_WAIT_L(8); PG8_BAR; PG8_WAIT_L(0); PG8_MMA(0, 0, At, B0); PG8_BAR; PG8_SCHED;
            PG8_LDB(B1, 1, 1); PG8_STAGE(PG8_SB(1, 0), b3, voffB);
            PG8_BAR; PG8_WAIT_L(0); PG8_MMA(0, 1, At, B1); PG8_BAR;
            PG8_LDA(At, 1, 1); PG8_STAGE(PG8_SA(1, 0), a3, voffA);
            PG8_BAR; PG8_WAIT_L(0); PG8_MMA(1, 0, At, B0); PG8_BAR; PG8_SCHED;
            PG8_STAGE(PG8_SB(1, 1), b3 + hstep, voffB);
            PG8_WAIT_V(6); PG8_BAR; PG8_MMA(1, 1, At, B1); PG8_BAR;
            }
        }
        if constexpr (ALIGN_EPI) { if (wr == 0) PG8_BAR; }
        if constexpr (!Epi::AFTER_DRAIN) { E(acc, cur, wr, wc, fr, fq); S.done(cur); }
        if (!has_next) break;
#pragma unroll
        for (int a = 0; a < 2; ++a)
#pragma unroll
            for (int b = 0; b < 2; ++b)
#pragma unroll
                for (int m = 0; m < 4; ++m)
#pragma unroll
                    for (int n = 0; n < 2; ++n) acc[a][b][m][n] = (f32x4){0.f, 0.f, 0.f, 0.f};
        cur = nxt; cA = nA; cB = nB; ++ui;
        if constexpr (ALIGN_EPI) { if (wr == 1) PG8_BAR; }
    }
    PG8_WAIT_V(0);
    if constexpr (!ALIGN_EPI) { if (wr == 0) PG8_BAR; }
    PG8_BAR;
    if constexpr (Epi::AFTER_DRAIN) { E.fused(acc, cur, wr, wc, fr, fq, lds, wid, lane); S.done(cur); }
#undef PG8_SA
#undef PG8_SB
#undef PG8_STAGE
#undef PG8_LDA
#undef PG8_LDB
#undef PG8_MMA
#undef PG8_WAIT_V
#undef PG8_WAIT_L
#undef PG8_BAR
#undef PG8_SCHED
}
}

namespace nsa {
#define NLAS __attribute__((address_space(3)))
typedef short bf16x8 __attribute__((ext_vector_type(8)));
typedef short s16x4 __attribute__((ext_vector_type(4)));
typedef short v4i16_t __attribute__((ext_vector_type(4)));
typedef float f32x4 __attribute__((ext_vector_type(4)));
typedef unsigned u32x4 __attribute__((ext_vector_type(4)));
typedef unsigned u32x2 __attribute__((ext_vector_type(2)));
typedef unsigned long long u64;
constexpr int RS = 144, TILE_B = 64 * RS;
constexpr float LOG2E = 1.4426950408889634f;
constexpr int L_KB0 = 0, L_VB0 = TILE_B, L_KB1 = 2 * TILE_B, L_VB1 = 3 * TILE_B, L_CK = 4 * TILE_B, L_CV = 8 * TILE_B, L_IMP = 12 * TILE_B, L_MSK = L_IMP + 8192, L_WU = L_MSK + 256, L_END = L_WU + 64;
static_assert(L_END <= 131072, "nsa LDS map");
__device__ __forceinline__ s16x4 vtr(const NLAS char* p) { return __builtin_bit_cast(s16x4, __builtin_amdgcn_ds_read_tr16_b64_v4i16((NLAS v4i16_t*)p)); }
__device__ __forceinline__ f32x4 mfma16(bf16x8 a, bf16x8 b, f32x4 c) { return __builtin_amdgcn_mfma_f32_16x16x32_bf16(a, b, c, 0, 0, 0); }
__device__ __forceinline__ unsigned pkbf(float lo, float hi) { return pg8::cvt_pk_bf16(lo, hi); }
__device__ __forceinline__ void qk_tile(f32x4 (&s)[4], const NLAS char* Kb, const bf16x8 (&qf)[2], int i, int g) {
#pragma unroll
    for (int kb = 0; kb < 4; ++kb) { const NLAS char* kp = Kb + (kb * 16 + i) * RS + 16 * g;
        const bf16x8 a0 = *(const NLAS bf16x8*)kp, a1 = *(const NLAS bf16x8*)(kp + 64);
        f32x4 acc = (f32x4){0.f, 0.f, 0.f, 0.f}; acc = mfma16(a0, qf[0], acc); acc = mfma16(a1, qf[1], acc); s[kb] = acc; }
}
__device__ __forceinline__ void pv_tile(f32x4 (&o)[4], const NLAS char* Vb, const f32x4 (&p)[4], int i, int g) {
    const NLAS char* vb = Vb + (4 * g + (i >> 2)) * RS + (i & 3) * 8;
#pragma unroll
    for (int kk = 0; kk < 2; ++kk) {
        u32x4 pw; pw.x = pkbf(p[2 * kk][0], p[2 * kk][1]); pw.y = pkbf(p[2 * kk][2], p[2 * kk][3]); pw.z = pkbf(p[2 * kk + 1][0], p[2 * kk + 1][1]); pw.w = pkbf(p[2 * kk + 1][2], p[2 * kk + 1][3]);
        const bf16x8 pf = __builtin_bit_cast(bf16x8, pw);
#pragma unroll
        for (int db = 0; db < 4; ++db) { const NLAS char* vp = vb + (2 * kk) * 16 * RS + db * 32;
            const s16x4 lo = vtr(vp), hi = vtr(vp + 16 * RS);
            const bf16x8 vf = (bf16x8){lo[0], lo[1], lo[2], lo[3], hi[0], hi[1], hi[2], hi[3]};
            o[db] = mfma16(vf, pf, o[db]); }
    }
}
__device__ __forceinline__ void online_tile(f32x4 (&s)[4], float& m, float& l, f32x4 (&o)[4], float kslope, float c, int base, int lo, int hi) {
    float mt = -INFINITY; const float bf = (float)base;
#pragma unroll
    for (int kb = 0; kb < 4; ++kb)
#pragma unroll
        for (int r = 0; r < 4; ++r) { const int pos = base + kb * 16 + r; float v = fmaf(s[kb][r], LOG2E, fmaf(kslope, bf + (float)(kb * 16 + r), c));
            v = (pos >= lo && pos <= hi) ? v : -INFINITY; s[kb][r] = v; mt = fmaxf(mt, v); }
    mt = fmaxf(mt, __shfl_xor(mt, 16)); mt = fmaxf(mt, __shfl_xor(mt, 32));
    const float mn = fmaxf(m, mt), ms = (mn == -INFINITY) ? 0.f : mn;
    const float alpha = __builtin_amdgcn_exp2f(m - ms);
    float sum = 0.f;
#pragma unroll
    for (int kb = 0; kb < 4; ++kb)
#pragma unroll
        for (int r = 0; r < 4; ++r) { const float p = __builtin_amdgcn_exp2f(s[kb][r] - ms); s[kb][r] = p; sum += p; }
    l = l * alpha + sum; m = mn;
#pragma unroll
    for (int db = 0; db < 4; ++db) o[db] = o[db] * alpha;
}
struct Stg { u32x4 k, v; };
__device__ __forceinline__ void stg_load(Stg& r, const bf16_t* kb, const bf16_t* vb, size_t pitch, int tid) { const size_t off = (size_t)(tid >> 3) * pitch + (tid & 7) * 8; r.k = *(const u32x4*)(kb + off); r.v = *(const u32x4*)(vb + off); }
__device__ __forceinline__ void stg_store(NLAS char* lds, int ko, int vo, const Stg& r, int tid) { const int off = (tid >> 3) * RS + (tid & 7) * 16; *(NLAS u32x4*)(lds + ko + off) = r.k; *(NLAS u32x4*)(lds + vo + off) = r.v; }
__device__ __forceinline__ float sigm(float v) { return __builtin_amdgcn_rcpf(1.f + __expf(-v)); }

__device__ __forceinline__ void unit(NLAS char* lds, const bf16_t* P, const float* S32, const bf16_t* KC, const bf16_t* VC, bf16_t* Ynsa, int b, int gq, int ti) {
    const int tid = threadIdx.x, lane = tid & 63, w = __builtin_amdgcn_readfirstlane(tid >> 6), i = lane & 15, g = lane >> 4;
    const int t0 = ti * 32, tl_mine = i >> 2, r = i & 3, h = gq * 4 + r, t = t0 + 4 * w + tl_mine; const size_t m = (size_t)b * T + t;
    const float slope2 = __builtin_amdgcn_exp2f(-(float)(h + 1)) * LOG2E;
    bf16x8 qf[2];
    { const bf16_t* qp = P + m * PW + P_NSQ + h * 64 + 8 * g;
#pragma unroll
      for (int ks = 0; ks < 2; ++ks) { const u32x4 raw = *(const u32x4*)(qp + 32 * ks); u32x4 sc;
          sc.x = pkbf(pg8::bflo(raw.x) * 0.125f, pg8::bfhi(raw.x) * 0.125f); sc.y = pkbf(pg8::bflo(raw.y) * 0.125f, pg8::bfhi(raw.y) * 0.125f);
          sc.z = pkbf(pg8::bflo(raw.z) * 0.125f, pg8::bfhi(raw.z) * 0.125f); sc.w = pkbf(pg8::bflo(raw.w) * 0.125f, pg8::bfhi(raw.w) * 0.125f);
          qf[ks] = __builtin_bit_cast(bf16x8, sc); } }
    const float* gp = S32 + m * 32 + 8 + h * 3;
    const float gate0 = sigm(gp[0]), gate1 = sigm(gp[1]), gate2 = sigm(gp[2]);
    f32x4 outacc[4];
#pragma unroll
    for (int db = 0; db < 4; ++db) outacc[db] = (f32x4){0.f, 0.f, 0.f, 0.f};
    const int ntc = (ti >> 5) + 1;
    for (int tile = 0; tile < ntc; ++tile) { Stg sr; const size_t row0 = ((size_t)(b * 256 + tile * 64) * 2 + gq) * 64; stg_load(sr, KC + row0, VC + row0, 128, tid); stg_store(lds, L_CK + tile * TILE_B, L_CV + tile * TILE_B, sr, tid); }
    __syncthreads();
    { const int nmax = (t - 31) >> 4; const float kslope = 16.f * slope2, c = -slope2 * (float)(t - 31);
      float mc = -INFINITY, lc = 0.f;
#pragma unroll 1
      for (int tile = 0; tile < ntc; ++tile) { f32x4 s[4]; qk_tile(s, lds + L_CK + tile * TILE_B, qf, i, g);
          float mt = -INFINITY;
#pragma unroll
          for (int kb = 0; kb < 4; ++kb)
#pragma unroll
              for (int rr = 0; rr < 4; ++rr) { const int n = tile * 64 + kb * 16 + 4 * g + rr; float v = fmaf(s[kb][rr], LOG2E, fmaf(kslope, (float)n, c)); v = (n <= nmax) ? v : -INFINITY; s[kb][rr] = v; mt = fmaxf(mt, v); }
          mt = fmaxf(mt, __shfl_xor(mt, 16)); mt = fmaxf(mt, __shfl_xor(mt, 32));
          const float mn = fmaxf(mc, mt), ms = (mn == -INFINITY) ? 0.f : mn; float sum = 0.f;
#pragma unroll
          for (int kb = 0; kb < 4; ++kb)
#pragma unroll
              for (int rr = 0; rr < 4; ++rr) sum += __builtin_amdgcn_exp2f(s[kb][rr] - ms);
          lc = lc * __builtin_amdgcn_exp2f(mc - ms) + sum; mc = mn; }
      lc += __shfl_xor(lc, 16); lc += __shfl_xor(lc, 32);
      const float ms = (mc == -INFINITY) ? 0.f : mc, inv = lc > 0.f ? 1.f / lc : 0.f;
      f32x4 oc[4];
#pragma unroll
      for (int db = 0; db < 4; ++db) oc[db] = (f32x4){0.f, 0.f, 0.f, 0.f};
      NLAS float* imp_s = (NLAS float*)(lds + L_IMP) + (w * 4 + tl_mine) * 64;
      float cprev = 0.f;
#pragma unroll 1
      for (int tile = 0; tile < 4; ++tile) {
          if (tile < ntc) { f32x4 s[4]; qk_tile(s, lds + L_CK + tile * TILE_B, qf, i, g);
#pragma unroll
              for (int kb = 0; kb < 4; ++kb)
#pragma unroll
                  for (int rr = 0; rr < 4; ++rr) { const int n = tile * 64 + kb * 16 + 4 * g + rr; float v = fmaf(s[kb][rr], LOG2E, fmaf(kslope, (float)n, c)); v = (n <= nmax) ? v : -INFINITY; s[kb][rr] = __builtin_amdgcn_exp2f(v - ms) * inv; }
              pv_tile(oc, lds + L_CV + tile * TILE_B, s, i, g);
#pragma unroll
              for (int kb = 0; kb < 4; ++kb) { const f32x4 pv = s[kb];
                  float a = (pv[0] + pv[1]) + (pv[2] + pv[3]), cc = pv[3];
                  a += __shfl_xor(a, 1); a += __shfl_xor(a, 2); cc += __shfl_xor(cc, 1); cc += __shfl_xor(cc, 2);
                  const float up = __shfl(cc, (lane + 48) & 63);
                  const float im = a + (g > 0 ? up : cprev); cprev = up;
                  if (r == 0) imp_s[4 * (tile * 4 + kb) + g] = im; }
          } else { if (r == 0) {
#pragma unroll
              for (int kb = 0; kb < 4; ++kb) imp_s[4 * (tile * 4 + kb) + g] = 0.f; } }
      }
#pragma unroll
      for (int db = 0; db < 4; ++db) outacc[db] = outacc[db] + oc[db] * gate0;
    }
    __syncthreads();
    NLAS float* impw = (NLAS float*)(lds + L_IMP) + w * 256;
    float myscore[4];
#pragma unroll
    for (int tl = 0; tl < 4; ++tl) { const int tt = t0 + 4 * w + tl, cur = tt >> 6, j = lane; const bool valid = j <= cur, forced = (j == 0) || (j == cur) || (j == cur - 1);
        const float s = valid ? impw[tl * 64 + j] + (forced ? 1000.f : 0.f) : -1e30f; myscore[tl] = s; }
    __syncthreads();
#pragma unroll
    for (int tl = 0; tl < 4; ++tl) impw[tl * 64 + lane] = myscore[tl];
    __syncthreads();
    u64 wmask[4], wun = 0ull;
#pragma unroll
    for (int tl = 0; tl < 4; ++tl) { const int tt = t0 + 4 * w + tl, cur = tt >> 6; const float s = myscore[tl]; int rank = 0;
        for (int jj = 0; jj < 64; ++jj) { const float o = impw[tl * 64 + jj]; rank += (o > s || (o == s && jj < lane)) ? 1 : 0; }
        wmask[tl] = __ballot(rank < 16 && lane <= cur); wun |= wmask[tl]; }
    if (lane == 0) { NLAS u64* mk = (NLAS u64*)(lds + L_MSK) + w * 4; mk[0] = wmask[0]; mk[1] = wmask[1]; mk[2] = wmask[2]; mk[3] = wmask[3]; ((NLAS u64*)(lds + L_WU))[w] = wun; }
    __syncthreads();
    const u64 mymask = ((const NLAS u64*)(lds + L_MSK))[w * 4 + tl_mine];
    u64 uall = 0ull;
#pragma unroll
    for (int ww = 0; ww < 8; ++ww) uall |= ((const NLAS u64*)(lds + L_WU))[ww];
    uall = ((u64)__builtin_amdgcn_readfirstlane((unsigned)(uall >> 32)) << 32) | (u64)__builtin_amdgcn_readfirstlane((unsigned)uall);
    const size_t rowb = (size_t)b * T;
    {
        float ms_ = -INFINITY, ls = 0.f; f32x4 os[4];
#pragma unroll
        for (int db = 0; db < 4; ++db) os[db] = (f32x4){0.f, 0.f, 0.f, 0.f};
        const bf16_t* kcol = P + rowb * PW + P_KS + gq * 64; const bf16_t* vcol = P + rowb * PW + P_VS + gq * 64;
        const float c = -slope2 * (float)t;
        u64 rem = uall; int j = __builtin_ctzll(rem); rem &= rem - 1; int cur = 0;
        { Stg sr; stg_load(sr, kcol + (size_t)j * 64 * PW, vcol + (size_t)j * 64 * PW, PW, tid); stg_store(lds, L_KB0, L_VB0, sr, tid); }
        __syncthreads();
        for (;;) {
            const int jn = rem ? __builtin_ctzll(rem) : -1; rem &= rem - 1;
            Stg sr; if (jn >= 0) stg_load(sr, kcol + (size_t)jn * 64 * PW, vcol + (size_t)jn * 64 * PW, PW, tid);
            if ((wun >> j) & 1ull) { f32x4 s[4]; qk_tile(s, lds + (cur ? L_KB1 : L_KB0), qf, i, g);
                online_tile(s, ms_, ls, os, slope2, c, j * 64 + 4 * g, 0, ((mymask >> j) & 1ull) ? t : -1);
                pv_tile(os, lds + (cur ? L_VB1 : L_VB0), s, i, g); }
            if (jn >= 0) stg_store(lds, cur ? L_KB0 : L_KB1, cur ? L_VB0 : L_VB1, sr, tid);
            __syncthreads();
            if (jn < 0) break;
            j = jn; cur ^= 1;
        }
        ls += __shfl_xor(ls, 16); ls += __shfl_xor(ls, 32);
        const float sc1 = gate1 / ls;
#pragma unroll
        for (int db = 0; db < 4; ++db) outacc[db] = outacc[db] + os[db] * sc1;
    }
    {
        float mw = -INFINITY, lw = 0.f; f32x4 ow[4];
#pragma unroll
        for (int db = 0; db < 4; ++db) ow[db] = (f32x4){0.f, 0.f, 0.f, 0.f};
        const bf16_t* kcol = P + rowb * PW + P_KW + gq * 64; const bf16_t* vcol = P + rowb * PW + P_VW + gq * 64;
        const float c = -slope2 * (float)t;
        const int j0 = (t0 - 511) > 0 ? ((t0 - 511) >> 6) : 0, j1 = t0 >> 6, tw0 = t0 + 4 * w;
        int j = j0, cur = 0;
        { Stg sr; stg_load(sr, kcol + (size_t)j * 64 * PW, vcol + (size_t)j * 64 * PW, PW, tid); stg_store(lds, L_KB0, L_VB0, sr, tid); }
        __syncthreads();
        for (;;) {
            const int jn = (j < j1) ? j + 1 : -1;
            Stg sr; if (jn >= 0) stg_load(sr, kcol + (size_t)jn * 64 * PW, vcol + (size_t)jn * 64 * PW, PW, tid);
            if (64 * j <= tw0 + 3 && 64 * j + 63 >= tw0 - 511) { f32x4 s[4]; qk_tile(s, lds + (cur ? L_KB1 : L_KB0), qf, i, g);
                online_tile(s, mw, lw, ow, slope2, c, j * 64 + 4 * g, t - 511, t);
                pv_tile(ow, lds + (cur ? L_VB1 : L_VB0), s, i, g); }
            if (jn >= 0) stg_store(lds, cur ? L_KB0 : L_KB1, cur ? L_VB0 : L_VB1, sr, tid);
            __syncthreads();
            if (jn < 0) break;
            j = jn; cur ^= 1;
        }
        lw += __shfl_xor(lw, 16); lw += __shfl_xor(lw, 32);
        const float sc2 = gate2 / lw;
#pragma unroll
        for (int db = 0; db < 4; ++db) outacc[db] = outacc[db] + ow[db] * sc2;
    }
    bf16_t* yo = Ynsa + m * 512 + h * 64 + 4 * g;
#pragma unroll
    for (int db = 0; db < 4; ++db) { u32x2 v; v.x = pkbf(outacc[db][0], outacc[db][1]); v.y = pkbf(outacc[db][2], outacc[db][3]); *(u32x2*)(yo + db * 16) = v; }
}
__device__ __forceinline__ void phase(NLAS char* lds, const bf16_t* P, const float* S32, const bf16_t* KC, const bf16_t* VC, bf16_t* Ynsa) {
    const int G = gridDim.x, bid = blockIdx.x;
    if (G == 256) { const int base = bid >> 3, bg = bid & 7;
#pragma unroll 1
        for (int k = 0; k < 4; ++k) { const int ti = (k == 0) ? 127 - base : (k == 1) ? 64 + base : (k == 2) ? 63 - base : base; unit(lds, P, S32, KC, VC, Ynsa, bg >> 1, bg & 1, ti); } }
    else {
#pragma unroll 1
        for (int u = bid; u < 1024; u += G) unit(lds, P, S32, KC, VC, Ynsa, (u & 7) >> 1, u & 1, 127 - (u >> 3)); }
}
}

namespace xa {
using nsa::bf16x8; using nsa::s16x4; using nsa::f32x4; using nsa::u32x4; using nsa::u32x2; using nsa::vtr; using nsa::mfma16; using nsa::pkbf;
constexpr int RS = 272, TILE_B = 64 * RS;
constexpr int L_K0 = 0, L_V0 = TILE_B, L_K1 = 2 * TILE_B, L_V1 = 3 * TILE_B;
struct Stg { u32x4 k0, k1, v0, v1; };
__device__ __forceinline__ void stg_load(Stg& r, const bf16_t* kb, int tid) { const bf16_t* p = kb + (size_t)(tid >> 3) * 1024 + (tid & 7) * 8;
    r.k0 = *(const u32x4*)p; r.k1 = *(const u32x4*)(p + 64); r.v0 = *(const u32x4*)(p + 512); r.v1 = *(const u32x4*)(p + 576); }
__device__ __forceinline__ void stg_store(NLAS char* lds, int ko, int vo, const Stg& r, int tid) { const int off = (tid >> 3) * RS + (tid & 7) * 16;
    *(NLAS u32x4*)(lds + ko + off) = r.k0; *(NLAS u32x4*)(lds + ko + off + 128) = r.k1; *(NLAS u32x4*)(lds + vo + off) = r.v0; *(NLAS u32x4*)(lds + vo + off + 128) = r.v1; }
__device__ __forceinline__ void unit(NLAS char* lds, const bf16_t* P, const bf16_t* MEMKV, bf16_t* Yxa, int b, int h, int tt) {
    const int tid = threadIdx.x, lane = tid & 63, w = __builtin_amdgcn_readfirstlane(tid >> 6), i = lane & 15, g = lane >> 4;
    const size_t m = (size_t)b * T + tt * 128 + 16 * w + i;
    bf16x8 qf[4];
    { const bf16_t* qp = P + m * PW + P_XAQ + h * 128 + 8 * g;
#pragma unroll
      for (int ks = 0; ks < 4; ++ks) qf[ks] = *(const bf16x8*)(qp + 32 * ks); }
    const float scale2 = 0.08838834764831845f * nsa::LOG2E;
    float mx = -INFINITY, l = 0.f; f32x4 o[8];
#pragma unroll
    for (int db = 0; db < 8; ++db) o[db] = (f32x4){0.f, 0.f, 0.f, 0.f};
    const bf16_t* kbase = MEMKV + (size_t)b * 256 * 1024 + h * 128;
    { Stg sr; stg_load(sr, kbase, tid); stg_store(lds, L_K0, L_V0, sr, tid); }
    __syncthreads();
#pragma unroll 1
    for (int tile = 0; tile < 4; ++tile) { const int cur = tile & 1;
        Stg sr; if (tile < 3) stg_load(sr, kbase + (size_t)(tile + 1) * 64 * 1024, tid);
        const NLAS char* Kb = lds + (cur ? L_K1 : L_K0); const NLAS char* Vb = lds + (cur ? L_V1 : L_V0);
        f32x4 s[4];
#pragma unroll
        for (int kb = 0; kb < 4; ++kb) { const NLAS char* kp = Kb + (kb * 16 + i) * RS + 16 * g; f32x4 acc = (f32x4){0.f, 0.f, 0.f, 0.f};
#pragma unroll
            for (int ks = 0; ks < 4; ++ks) acc = mfma16(*(const NLAS bf16x8*)(kp + 64 * ks), qf[ks], acc);
            s[kb] = acc; }
        float mt = -INFINITY;
#pragma unroll
        for (int kb = 0; kb < 4; ++kb)
#pragma unroll
            for (int r = 0; r < 4; ++r) { const float v = s[kb][r] * scale2; s[kb][r] = v; mt = fmaxf(mt, v); }
        mt = fmaxf(mt, __shfl_xor(mt, 16)); mt = fmaxf(mt, __shfl_xor(mt, 32));
        const float mn = fmaxf(mx, mt), alpha = __builtin_amdgcn_exp2f(mx - mn); float sum = 0.f;
#pragma unroll
        for (int kb = 0; kb < 4; ++kb)
#pragma unroll
            for (int r = 0; r < 4; ++r) { const float p = __builtin_amdgcn_exp2f(s[kb][r] - mn); s[kb][r] = p; sum += p; }
        l = l * alpha + sum; mx = mn;
#pragma unroll
        for (int db = 0; db < 8; ++db) o[db] = o[db] * alpha;
        const NLAS char* vb = Vb + (4 * g + (i >> 2)) * RS + (i & 3) * 8;
#pragma unroll
        for (int kk = 0; kk < 2; ++kk) {
            u32x4 pw; pw.x = pkbf(s[2 * kk][0], s[2 * kk][1]); pw.y = pkbf(s[2 * kk][2], s[2 * kk][3]); pw.z = pkbf(s[2 * kk + 1][0], s[2 * kk + 1][1]); pw.w = pkbf(s[2 * kk + 1][2], s[2 * kk + 1][3]);
            const bf16x8 pf = __builtin_bit_cast(bf16x8, pw);
#pragma unroll
            for (int db = 0; db < 8; ++db) { const NLAS char* vp = vb + (2 * kk) * 16 * RS + db * 32; const s16x4 lo = vtr(vp), hi = vtr(vp + 16 * RS);
                o[db] = mfma16((bf16x8){lo[0], lo[1], lo[2], lo[3], hi[0], hi[1], hi[2], hi[3]}, pf, o[db]); }
        }
        if (tile < 3) stg_store(lds, cur ? L_K0 : L_K1, cur ? L_V0 : L_V1, sr, tid);
        __syncthreads();
    }
    l += __shfl_xor(l, 16); l += __shfl_xor(l, 32);
    const float inv = 1.f / l;
    bf16_t* yo = Yxa + m * 512 + h * 128 + 4 * g;
#pragma unroll
    for (int db = 0; db < 8; ++db) { u32x2 v; v.x = pkbf(o[db][0] * inv, o[db][1] * inv); v.y = pkbf(o[db][2] * inv, o[db][3] * inv); *(u32x2*)(yo + db * 16) = v; }
}
__device__ __forceinline__ void phase(NLAS char* lds, const bf16_t* P, const bf16_t* MEMKV, bf16_t* Yxa) {
#pragma unroll 1
    for (int u = blockIdx.x; u < 512; u += gridDim.x) unit(lds, P, MEMKV, Yxa, u >> 7, (u >> 5) & 3, u & 31);
}
}

namespace ml {
using nsa::bf16x8; using nsa::s16x4; using nsa::f32x4; using nsa::u32x4; using nsa::u32x2; using nsa::vtr; using nsa::mfma16; using nsa::pkbf;
constexpr int RS = 272, TB = 64 * RS, RSS = 144;
constexpr float KSCALE = 0.08838834764831845f;
__device__ __forceinline__ float scan_add(float v, int lane) {
#pragma unroll
    for (int o = 1; o < 64; o <<= 1) { const float u = __shfl_up(v, o); if (lane >= o) v += u; }
    return v; }
__device__ __forceinline__ float scan_max(float v, int lane) {
#pragma unroll
    for (int o = 1; o < 64; o <<= 1) { const float u = __shfl_up(v, o); if (lane >= o) v = fmaxf(v, u); }
    return v; }
__device__ __forceinline__ bf16x8 trpair(const NLAS char* p, int hi_off) { const s16x4 lo = vtr(p), hi = vtr(p + hi_off); return (bf16x8){lo[0], lo[1], lo[2], lo[3], hi[0], hi[1], hi[2], hi[3]}; }
__device__ __forceinline__ void load_conv(NLAS char* dst, const bf16_t* P, const float* cw, int colP, int cwc, size_t m0, int tseq0, int tid) {
    const int s = tid >> 3, c16 = (tid & 7) * 16;
#pragma unroll
    for (int half = 0; half < 2; ++half) { const int c = c16 + half * 8; float acc[8];
#pragma unroll
        for (int e = 0; e < 8; ++e) acc[e] = 0.f;
#pragma unroll
        for (int j = 0; j < 4; ++j) { if (tseq0 + s - j >= 0) { const u32x4 raw = *(const u32x4*)(P + (m0 + s - j) * PW + colP + c);
            const f32x4 w0 = *(const f32x4*)(cw + j * 1024 + cwc + c), w1 = *(const f32x4*)(cw + j * 1024 + cwc + c + 4);
            acc[0] += w0[0] * pg8::bflo(raw.x); acc[1] += w0[1] * pg8::bfhi(raw.x); acc[2] += w0[2] * pg8::bflo(raw.y); acc[3] += w0[3] * pg8::bfhi(raw.y);
            acc[4] += w1[0] * pg8::bflo(raw.z); acc[5] += w1[1] * pg8::bfhi(raw.z); acc[6] += w1[2] * pg8::bflo(raw.w); acc[7] += w1[3] * pg8::bfhi(raw.w); } }
#pragma unroll
        for (int e = 0; e < 8; ++e) acc[e] = acc[e] * __builtin_amdgcn_rcpf(1.f + __expf(-acc[e]));
        u32x4 o; o.x = pkbf(acc[0], acc[1]); o.y = pkbf(acc[2], acc[3]); o.z = pkbf(acc[4], acc[5]); o.w = pkbf(acc[6], acc[7]);
        *(NLAS u32x4*)(dst + s * RS + c * 2) = o; }
}
__device__ __forceinline__ void m1_unit(NLAS char* lds, const bf16_t* P, const float* cw, const float* S32, float* Abuf, float* NA, float* Gc, float* Mloc, int ci) {
    constexpr int L_K = 0, L_EV = TB, L_E = 2 * TB;
    const int tid = threadIdx.x, lane = tid & 63, w = __builtin_amdgcn_readfirstlane(tid >> 6), i = lane & 15, g = lane >> 4;
    const int c = ci & 63, bh = ci >> 6, h = bh & 3, b = bh >> 2; const size_t m0 = (size_t)b * T + c * 64;
    NLAS float* eS = (NLAS float*)(lds + L_E);
    if (w == 0) { const float fpre = S32[(m0 + lane) * 32 + 4 + h], ipre = S32[(m0 + lane) * 32 + h];
        const float bcs = scan_add(logsig(fpre), lane), gtot = __shfl(bcs, 63), wend = gtot - bcs + ipre, mloc = wave_max(wend);
        eS[lane] = __expf(wend - mloc) * KSCALE; if (lane == 0) { Gc[ci] = gtot; Mloc[ci] = mloc; } }
    load_conv(lds + L_K, P, cw, P_MLK + h * 128, 512 + h * 128, m0, c * 64, tid);
    __syncthreads();
    { const int s = tid >> 3, c16 = (tid & 7) * 16; const float es = eS[s]; const bf16_t* vp = P + (m0 + s) * PW + P_MLV + h * 128 + c16;
#pragma unroll
      for (int half = 0; half < 2; ++half) { const u32x4 raw = *(const u32x4*)(vp + half * 8); u32x4 o;
          o.x = pkbf(pg8::bflo(raw.x) * es, pg8::bfhi(raw.x) * es); o.y = pkbf(pg8::bflo(raw.y) * es, pg8::bfhi(raw.y) * es);
          o.z = pkbf(pg8::bflo(raw.z) * es, pg8::bfhi(raw.z) * es); o.w = pkbf(pg8::bflo(raw.w) * es, pg8::bfhi(raw.w) * es);
          *(NLAS u32x4*)(lds + L_EV + s * RS + (c16 + half * 8) * 2) = o; } }
    __syncthreads();
    f32x4 acc[8];
#pragma unroll
    for (int vb = 0; vb < 8; ++vb) acc[vb] = (f32x4){0.f, 0.f, 0.f, 0.f};
    const int rowoff = (4 * g + (i >> 2)) * RS + (i & 3) * 8;
#pragma unroll
    for (int kk = 0; kk < 2; ++kk) { const bf16x8 kf = trpair(lds + L_K + kk * 32 * RS + rowoff + w * 32, 16 * RS);
#pragma unroll
        for (int vb = 0; vb < 8; ++vb) acc[vb] = mfma16(trpair(lds + L_EV + kk * 32 * RS + rowoff + vb * 32, 16 * RS), kf, acc[vb]); }
    float* ap = Abuf + ((size_t)ci * 128 + w * 16 + i) * 128 + 4 * g;
#pragma unroll
    for (int vb = 0; vb < 8; ++vb) *(f32x4*)(ap + vb * 16) = acc[vb];
    if (tid < 128) { float n = 0.f; for (int s = 0; s < 64; ++s) n += eS[s] * bf2f(*(const NLAS bf16_t*)(lds + L_K + s * RS + tid * 2)); NA[(size_t)ci * 128 + tid] = n; }
    __syncthreads();
}
__device__ __forceinline__ void m2_items(float* Abuf, float* NA, const float* Gc, const float* Mloc, float* Mprev) {
    typedef float f32x2 __attribute__((ext_vector_type(2)));
    for (int it = blockIdx.x * blockDim.x + threadIdx.x; it < 16 * 128 * 64; it += gridDim.x * blockDim.x) {
        const int bh = it >> 13, kv2 = it & 8191, k = kv2 >> 6, v2 = kv2 & 63;
        f32x2 C = (f32x2){0.f, 0.f}; float n = 0.f, m = 0.f;
#pragma unroll 1
        for (int c0 = 0; c0 < 64; c0 += 8) { f32x2 A[8];
#pragma unroll
            for (int u = 0; u < 8; ++u) A[u] = *(const f32x2*)(Abuf + ((size_t)(bh * 64 + c0 + u) * 128 + k) * 128 + v2 * 2);
#pragma unroll
            for (int u = 0; u < 8; ++u) { const int ci = bh * 64 + c0 + u; const float gg = Gc[ci], ml = Mloc[ci];
                const float mn = fmaxf(gg + m, ml), a = __expf(gg + m - mn), bb = __expf(ml - mn);
                *(f32x2*)(Abuf + ((size_t)ci * 128 + k) * 128 + v2 * 2) = C; C = C * a + A[u] * bb;
                if (v2 == 0) { const float nA = NA[(size_t)ci * 128 + k]; NA[(size_t)ci * 128 + k] = n; n = a * n + bb * nA; }
                if (kv2 == 0) Mprev[ci] = m;
                m = mn; } }
    }
}
__device__ __forceinline__ void m3_unit(NLAS char* lds, const bf16_t* P, const float* cw, const float* S32, const float* Cprev, const float* Nprev, const float* Mprev, const float* normg, bf16_t* Yml, int ci) {
    constexpr int L_Q = 0, L_K = TB, L_V = 2 * TB, L_C = 3 * TB, L_S = 5 * TB, L_F = L_S + 64 * RSS;
    const int tid = threadIdx.x, lane = tid & 63, w = __builtin_amdgcn_readfirstlane(tid >> 6), i = lane & 15, g = lane >> 4;
    const int c = ci & 63, bh = ci >> 6, h = bh & 3, b = bh >> 2; const size_t m0 = (size_t)b * T + c * 64;
    NLAS float* F = (NLAS float*)(lds + L_F);
    NLAS float* rowf = F; NLAS float* colf = F + 64; NLAS float* scv = F + 128; NLAS float* emt = F + 192; NLAS float* qn = F + 256; NLAS float* nprev = F + 320; NLAS float* denp = F + 448; NLAS float* ssq = F + 576;
    if (w == 0) { const float fpre = S32[(m0 + lane) * 32 + 4 + h], ipre = S32[(m0 + lane) * 32 + h], mprev = Mprev[ci];
        const float bcs = scan_add(logsig(fpre), lane), u = ipre - bcs, pm = scan_max(u, lane), mt = bcs + fmaxf(mprev, pm);
        rowf[lane] = bcs - mt; colf[lane] = u; scv[lane] = __expf(bcs + mprev - mt); emt[lane] = __expf(-mt); }
    else if (w <= 2) nprev[tid - 64] = Nprev[(size_t)ci * 128 + tid - 64];
    load_conv(lds + L_Q, P, cw, P_MLQ + h * 128, h * 128, m0, c * 64, tid);
    load_conv(lds + L_K, P, cw, P_MLK + h * 128, 512 + h * 128, m0, c * 64, tid);
    { const int s = tid >> 3, c16 = (tid & 7) * 16; const bf16_t* vp = P + (m0 + s) * PW + P_MLV + h * 128 + c16;
      *(NLAS u32x4*)(lds + L_V + s * RS + c16 * 2) = *(const u32x4*)vp; *(NLAS u32x4*)(lds + L_V + s * RS + c16 * 2 + 16) = *(const u32x4*)(vp + 8); }
    { const int k = tid >> 2, v0 = (tid & 3) * 32; const float* cp = Cprev + ((size_t)ci * 128 + k) * 128 + v0;
#pragma unroll
      for (int q8 = 0; q8 < 4; ++q8) { const f32x4 a = *(const f32x4*)(cp + q8 * 8), bq = *(const f32x4*)(cp + q8 * 8 + 4); u32x4 o;
          o.x = pkbf(a[0], a[1]); o.y = pkbf(a[2], a[3]); o.z = pkbf(bq[0], bq[1]); o.w = pkbf(bq[2], bq[3]); *(NLAS u32x4*)(lds + L_C + k * RS + (v0 + q8 * 8) * 2) = o; } }
    __syncthreads();
    if (tid < 64) { float a = 0.f; for (int k = 0; k < 128; ++k) a += bf2f(*(const NLAS bf16_t*)(lds + L_Q + tid * RS + k * 2)) * nprev[k]; qn[tid] = a; }
    const int tb = w >> 1;
    {
        float rs[4] = {0.f, 0.f, 0.f, 0.f};
#pragma unroll
        for (int sbi = 0; sbi < 2; ++sbi) { const int sb = 2 * (w & 1) + sbi; f32x4 acc = (f32x4){0.f, 0.f, 0.f, 0.f};
            if (sb <= tb) {
#pragma unroll
                for (int ks = 0; ks < 4; ++ks) acc = mfma16(*(const NLAS bf16x8*)(lds + L_Q + (tb * 16 + i) * RS + (32 * ks + 8 * g) * 2), *(const NLAS bf16x8*)(lds + L_K + (sb * 16 + i) * RS + (32 * ks + 8 * g) * 2), acc); }
            const int s = sb * 16 + i; const float cf = colf[s];
#pragma unroll
            for (int r = 0; r < 4; ++r) { const int t = tb * 16 + 4 * g + r; const float v = (s <= t) ? acc[r] * KSCALE * __expf(rowf[t] + cf) : 0.f; rs[r] += v;
                *(NLAS bf16_t*)(lds + L_S + t * RSS + s * 2) = f2bf(v); } }
#pragma unroll
        for (int r = 0; r < 4; ++r) { float x = rs[r]; x += __shfl_xor(x, 1); x += __shfl_xor(x, 2); x += __shfl_xor(x, 4); x += __shfl_xor(x, 8); if (i == 0) denp[(w & 1) * 64 + tb * 16 + 4 * g + r] = x; }
    }
    __syncthreads();
    f32x4 a1[4], a2[4];
#pragma unroll
    for (int vb = 0; vb < 4; ++vb) { a1[vb] = (f32x4){0.f, 0.f, 0.f, 0.f}; a2[vb] = (f32x4){0.f, 0.f, 0.f, 0.f}; }
    const int vb0 = (w & 1) * 4, troff = (8 * g + (i >> 2)) * RS + (i & 3) * 8;
#pragma unroll
    for (int kk = 0; kk < 2; ++kk) { if (32 * kk <= tb * 16 + 15) { const bf16x8 sf = *(const NLAS bf16x8*)(lds + L_S + (tb * 16 + i) * RSS + (32 * kk + 8 * g) * 2);
#pragma unroll
        for (int vb = 0; vb < 4; ++vb) a1[vb] = mfma16(sf, trpair(lds + L_V + kk * 32 * RS + troff + (vb0 + vb) * 32, 4 * RS), a1[vb]); } }
#pragma unroll
    for (int ks = 0; ks < 4; ++ks) { const bf16x8 qf = *(const NLAS bf16x8*)(lds + L_Q + (tb * 16 + i) * RS + (32 * ks + 8 * g) * 2);
#pragma unroll
        for (int vb = 0; vb < 4; ++vb) a2[vb] = mfma16(qf, trpair(lds + L_C + ks * 32 * RS + troff + (vb0 + vb) * 32, 4 * RS), a2[vb]); }
    float hv[4][4], sq[4] = {0.f, 0.f, 0.f, 0.f};
#pragma unroll
    for (int r = 0; r < 4; ++r) { const int t = tb * 16 + 4 * g + r; const float sc = scv[t]; const float den = denp[t] + denp[64 + t] + sc * qn[t]; const float hd = 1.f / fmaxf(fabsf(den), emt[t]);
#pragma unroll
        for (int vb = 0; vb < 4; ++vb) { const float x = (a1[vb][r] + sc * a2[vb][r]) * hd; hv[vb][r] = x; sq[r] += x * x; } }
#pragma unroll
    for (int r = 0; r < 4; ++r) { float x = sq[r]; x += __shfl_xor(x, 1); x += __shfl_xor(x, 2); x += __shfl_xor(x, 4); x += __shfl_xor(x, 8); if (i == 0) ssq[(w & 1) * 64 + tb * 16 + 4 * g + r] = x; }
    __syncthreads();
#pragma unroll
    for (int r = 0; r < 4; ++r) { const int t = tb * 16 + 4 * g + r; const float rinv = rsqrtf((ssq[t] + ssq[64 + t]) * (1.f / 128.f) + EPS);
#pragma unroll
        for (int vb = 0; vb < 4; ++vb) { const int v = (vb0 + vb) * 16 + i; const float o = bf2f(P[(m0 + t) * PW + P_MLO + h * 128 + v]);
            Yml[(m0 + t) * 512 + h * 128 + v] = f2bf(__builtin_amdgcn_rcpf(1.f + __expf(-o)) * hv[vb][r] * rinv * normg[h * 128 + v]); } }
    __syncthreads();
}
}

namespace cmpr {
using nsa::bf16x8; using nsa::f32x4; using nsa::u32x4; using nsa::mfma16; using nsa::pkbf;
constexpr int RSX = 144, L_X = 0, L_PE = 272 * RSX  , L_H = L_PE + 8192, RSH = 528;
__device__ __forceinline__ void unit(NLAS char* lds, const bf16_t* P, const float* pe, const bf16_t* W1t, const bf16_t* W2t, bf16_t* KC, bf16_t* VC, int u) {
    const int tid = threadIdx.x, lane = tid & 63, w = __builtin_amdgcn_readfirstlane(tid >> 6), i = lane & 15, g = lane >> 4;
    const int nt = u & 15, gq = (u >> 4) & 1, b = (u >> 5) & 3, kv = u >> 7;
    const int pcol = (kv ? P_VC : P_KC) + gq * 64, tok0 = 256 * nt;
    for (int ch = tid; ch < 272 * 8; ch += 512) { const int row = ch >> 3, c8 = (ch & 7) * 8, tok = tok0 + row;
        u32x4 v = (u32x4){0u, 0u, 0u, 0u}; if (tok < T) v = *(const u32x4*)(P + ((size_t)b * T + tok) * PW + pcol + c8);
        *(NLAS u32x4*)(lds + L_X + row * RSX + c8 * 2) = v; }
    for (int e = tid; e < 2048; e += 512) ((NLAS float*)(lds + L_PE))[e] = pe[kv * 2048 + e];
    __syncthreads();
    f32x4 acc[2]; acc[0] = (f32x4){0.f, 0.f, 0.f, 0.f}; acc[1] = acc[0];
    const bf16_t* wb = W1t + ((size_t)kv * 256 + 32 * w + i) * 2048 + 8 * g;
#pragma unroll 1
    for (int k0 = 0; k0 < 64; k0 += 8) { bf16x8 bq[8][2];
#pragma unroll
        for (int kk = 0; kk < 8; ++kk) { bq[kk][0] = *(const bf16x8*)(wb + 32 * (k0 + kk)); bq[kk][1] = *(const bf16x8*)(wb + 16 * 2048 + 32 * (k0 + kk)); }
#pragma unroll
        for (int kk = 0; kk < 8; ++kk) { const int ks = k0 + kk, l = ks >> 1, dh = ks & 1;
            const u32x4 raw = *(const NLAS u32x4*)(lds + L_X + (16 * i + l) * RSX + dh * 64 + 16 * g);
            const NLAS float* pp = (const NLAS float*)(lds + L_PE) + l * 64 + dh * 32 + 8 * g; const f32x4 p0 = *(const NLAS f32x4*)pp, p1 = *(const NLAS f32x4*)(pp + 4);
            u32x4 a; a.x = pkbf(pg8::bflo(raw.x) + p0[0], pg8::bfhi(raw.x) + p0[1]); a.y = pkbf(pg8::bflo(raw.y) + p0[2], pg8::bfhi(raw.y) + p0[3]);
            a.z = pkbf(pg8::bflo(raw.z) + p1[0], pg8::bfhi(raw.z) + p1[1]); a.w = pkbf(pg8::bflo(raw.w) + p1[2], pg8::bfhi(raw.w) + p1[3]);
            const bf16x8 af = __builtin_bit_cast(bf16x8, a);
            acc[0] = mfma16(af, bq[kk][0], acc[0]); acc[1] = mfma16(af, bq[kk][1], acc[1]); } }
#pragma unroll
    for (int cb = 0; cb < 2; ++cb)
#pragma unroll
        for (int r = 0; r < 4; ++r) { const float x = acc[cb][r], uu = 0.7978845608028654f * (x + 0.044715f * x * x * x); const float gl = x * __builtin_amdgcn_rcpf(1.f + __expf(-2.f * uu));
            *(NLAS bf16_t*)(lds + L_H + (4 * g + r) * RSH + (32 * w + cb * 16 + i) * 2) = f2bf(gl); }
    __syncthreads();
    if (w < 4) { f32x4 o = (f32x4){0.f, 0.f, 0.f, 0.f}; const bf16_t* w2 = W2t + ((size_t)kv * 64 + 16 * w + i) * 256 + 8 * g;
#pragma unroll
        for (int ks = 0; ks < 8; ++ks) o = mfma16(*(const NLAS bf16x8*)(lds + L_H + i * RSH + (32 * ks + 8 * g) * 2), *(const bf16x8*)(w2 + 32 * ks), o);
        bf16_t* dst = (kv ? VC : KC);
#pragma unroll
        for (int r = 0; r < 4; ++r) dst[((size_t)(b * 256 + 16 * nt + 4 * g + r) * 2 + gq) * 64 + 16 * w + i] = f2bf(o[r]); }
    __syncthreads();
}
}

#define LAS __attribute__((address_space(3)))
constexpr int NTHREADS = 512, LDS_BYTES = 147456;
constexpr size_t WS_WIN = 1 * MiB, WS_WG = 9 * MiB, WS_WBR = 15 * MiB, WS_WOUT = 18 * MiB, WS_WFF1 = 20 * MiB, WS_WFF2 = 28 * MiB, WS_WMKV = 36 * MiB, WS_WC1 = 38 * MiB;
constexpr size_t WS_BIASP = 249 * MiB;
struct Args { const float* in[18]; float* out; unsigned char* ws; int ph_lo, ph_hi; };
template <int VT, class F> __device__ __forceinline__ void run_vb(int nvb, char* lds, F f) {
    constexpr int PER = NTHREADS / VT; const int sub = threadIdx.x / VT, tid = threadIdx.x % VT;
    for (int it = blockIdx.x; it * PER < nvb; it += gridDim.x) { VB vb{it * PER + sub, tid, lds + sub * (LDS_BYTES / PER)}; f(vb); __syncthreads(); }
}
__device__ __forceinline__ unsigned pk2(float lo, float hi) { return (unsigned)f2bf(lo) | ((unsigned)f2bf(hi) << 16); }
typedef unsigned v4u __attribute__((ext_vector_type(4)));
typedef float f32x4 __attribute__((ext_vector_type(4)));
__device__ __forceinline__ void tr_item(const float* W, int ld, int ncols, int K, bf16_t* WT, int row_off, LAS float* scr, int item, int lane) {
    const int nblk = ncols / 32, kb = item / nblk, nb = item % nblk, k0 = 64 * kb, n0 = 32 * nb;
#pragma unroll 8
    for (int i = 0; i < 32; ++i) { const int kk = 2 * i + (lane >> 5); scr[kk * 33 + (lane & 31)] = W[(size_t)(k0 + kk) * ld + n0 + (lane & 31)]; }
    asm volatile("s_waitcnt lgkmcnt(0)" ::: "memory");
    const int c = lane & 7;
#pragma unroll
    for (int j = 0; j < 4; ++j) { const int n = (lane >> 3) + 8 * j; const LAS float* s = scr + (8 * c) * 33 + n;
        v4u o; o.x = pk2(s[0 * 33], s[1 * 33]); o.y = pk2(s[2 * 33], s[3 * 33]); o.z = pk2(s[4 * 33], s[5 * 33]); o.w = pk2(s[6 * 33], s[7 * 33]);
        *(v4u*)(WT + (size_t)(row_off + n0 + n) * K + k0 + 8 * c) = o; }
    asm volatile("s_waitcnt lgkmcnt(0)" ::: "memory");
}
__device__ __forceinline__ void rms_row_wave(const float* xrow, const float* g, bf16_t* orow, int lane) {
    const f32x4* xr = (const f32x4*)xrow + lane; const f32x4* gr = (const f32x4*)g + lane;
    f32x4 v[4]; float s = 0.f;
#pragma unroll
    for (int j = 0; j < 4; ++j) { v[j] = xr[64 * j]; s += (v[j].x * v[j].x + v[j].y * v[j].y) + (v[j].z * v[j].z + v[j].w * v[j].w); }
    const float r = rsqrtf(wave_sum(s) * (1.f / D) + EPS);
    unsigned long long* o8 = (unsigned long long*)orow + lane;
#pragma unroll
    for (int j = 0; j < 4; ++j) { const f32x4 gg = gr[64 * j]; o8[64 * j] = (unsigned long long)pk2(v[j].x * r * gg.x, v[j].y * r * gg.y) | ((unsigned long long)pk2(v[j].z * r * gg.z, v[j].w * r * gg.w) << 32); }
}
__device__ __forceinline__ int small_src_col(int c) { return c < 8 ? C_MLI + c : C_NSG + (c - 8); }
__global__ void __launch_bounds__(NTHREADS, 2) mega(Args a) {
    extern __shared__ __attribute__((aligned(16))) unsigned char lds_raw[];
    char* lds = (char*)lds_raw;
    LAS unsigned char* lds3 = (LAS unsigned char*)lds_raw;
    cg::grid_group grid = cg::this_grid();
    const float* x = a.in[0]; const float* mem = a.in[1]; const float* g_mix = a.in[2]; const float* w_in = a.in[3];
    const float* b_in = a.in[4]; const float* ml_conv = a.in[5]; const float* ml_norm_g = a.in[6]; const float* cmp_pe = a.in[7];
    const float* cmp_w1 = a.in[8]; const float* cmp_w2 = a.in[9]; const float* g_mem = a.in[10]; const float* w_mem_kv = a.in[11];
    const float* w_branch = a.in[12]; const float* w_out = a.in[13]; const float* g_ffn = a.in[14]; const float* w_ff1 = a.in[15];
    const float* w_ff2 = a.in[16]; const float* g_final = a.in[17];
    char* ws = (char*)a.ws; float* out = a.out;
    bf16_t* U = (bf16_t*)(ws + WS_U); bf16_t* P = (bf16_t*)(ws + WS_P);
    bf16_t* Yml = (bf16_t*)(ws + WS_Y); bf16_t* Ynsa = Yml + (size_t)M * 512; bf16_t* Yxa = Ynsa + (size_t)M * 512;
    float* S32 = (float*)(ws + WS_S32); bf16_t* MEMN = (bf16_t*)(ws + WS_MEMN); bf16_t* MEMKV = (bf16_t*)(ws + WS_MEMKV);
    bf16_t* KC = (bf16_t*)(ws + WS_KC); bf16_t* VC = (bf16_t*)(ws + WS_VC);
    float* NA = (float*)(ws + WS_NA); float* Gc = (float*)(ws + WS_G); float* Mloc = (float*)(ws + WS_MLOC); float* Mprev = (float*)(ws + WS_MPREV);
    float* Abuf = out;
    bf16_t* GATES = P; bf16_t* MERGED = U; bf16_t* AFFN = (bf16_t*)(ws + WS_AFFN); bf16_t* HBUF = P;
    bf16_t* Wi = (bf16_t*)(ws + WS_WIN); bf16_t* Wg = (bf16_t*)(ws + WS_WG); bf16_t* Wbr = (bf16_t*)(ws + WS_WBR); bf16_t* Wo = (bf16_t*)(ws + WS_WOUT);
    bf16_t* Wf1 = (bf16_t*)(ws + WS_WFF1); bf16_t* Wf2 = (bf16_t*)(ws + WS_WFF2); bf16_t* Wmkv = (bf16_t*)(ws + WS_WMKV);
    float* biasP = (float*)(ws + WS_BIASP); bf16_t* Wc1 = (bf16_t*)(ws + WS_WC1); bf16_t* Wc2 = (bf16_t*)(ws + WS_BIASP + 65536);
    const int tid = threadIdx.x, lane = tid & 63, wave = __builtin_amdgcn_readfirstlane(tid >> 6);
    const int G = gridDim.x, bid = blockIdx.x;
    const int lo = a.ph_lo, hi = a.ph_hi;
#define PHASE(k) if (lo <= (k) && (k) < hi)
#define SEAM(k) if (lo <= (k) && (k) + 1 < hi) grid.sync()
    PHASE(0) {
        LAS float* scr = (LAS float*)(lds3 + wave * 16384);
        const int gw = bid * 8 + wave, NGW = G * 8;
        constexpr int I0 = 16 * 64, I1 = 16 * 40, I2 = 16 * 16, I3 = 16 * 96, I4 = 8 * 32, I5 = 16 * 32, I6 = 16 * 128, I7 = 64 * 32, I8 = 16 * 32;
        constexpr int I9 = 32 * 8, I10 = 4 * 2;
        constexpr int NITEMS = I0 + I1 + I2 + I3 + 3 * I4 + I5 + I6 + I7 + I8 + 2 * I9 + 2 * I10;
        for (int it = gw; it < NITEMS; it += NGW) {
            int r = it;
            if (r < I0) { tr_item(w_in, DIN, 2048, 1024, Wi, 0, scr, r, lane); continue; } r -= I0;
            if (r < I1) { tr_item(w_in + 2056, DIN, 1280, 1024, Wi, 2048, scr, r, lane); continue; } r -= I1;
            if (r < I2) { tr_item(w_in + 3360, DIN, 512, 1024, Wi, 3328, scr, r, lane); continue; } r -= I2;
            if (r < I3) { tr_item(w_in + C_MG, DIN, 3072, 1024, Wg, 0, scr, r, lane); continue; } r -= I3;
            if (r < 3 * I4) { const int j = r / I4; tr_item(w_branch + (size_t)j * 512 * 1024, 1024, 1024, 512, Wbr + (size_t)j * 1024 * 512, 0, scr, r % I4, lane); continue; } r -= 3 * I4;
            if (r < I5) { tr_item(w_out, 1024, 1024, 1024, Wo, 0, scr, r, lane); continue; } r -= I5;
            if (r < I6) { tr_item(w_ff1, FF, FF, 1024, Wf1, 0, scr, r, lane); continue; } r -= I6;
            if (r < I7) { tr_item(w_ff2, 1024, 1024, FF, Wf2, 0, scr, r, lane); continue; } r -= I7;
            if (r < I8) { tr_item(w_mem_kv, 1024, 1024, 1024, Wmkv, 0, scr, r, lane); continue; } r -= I8;
            if (r < 2 * I9) { const int kv = r / I9; tr_item(cmp_w1 + (size_t)kv * 2048 * 256, 256, 256, 2048, Wc1 + (size_t)kv * 256 * 2048, 0, scr, r % I9, lane); continue; } r -= 2 * I9;
            { const int kv = r / I10; tr_item(cmp_w2 + (size_t)kv * 256 * 64, 64, 64, 256, Wc2 + (size_t)kv * 64 * 256, 0, scr, r % I10, lane); }
        }
        for (int i = bid * NTHREADS + tid; i < 256 * 1024; i += G * NTHREADS) { const int r = i >> 10, k = i & 1023; bf16_t v = 0;
            if (r < 32) v = f2bf(w_in[(size_t)k * DIN + small_src_col(r)]);
            else if (r >= 128 && r < 160) { const float w = w_in[(size_t)k * DIN + small_src_col(r - 128)]; v = f2bf(w - bf2f(f2bf(w))); }
            Wi[(size_t)(3840 + r) * 1024 + k] = v; }
        for (int c = bid * NTHREADS + tid; c < 4096; c += G * NTHREADS) { float v = 0.f;
            if (c < 2048) v = b_in[c]; else if (c < 3328) v = b_in[c + 8]; else if (c < 3840) v = b_in[c + 32]; else if (c < 3872) v = b_in[small_src_col(c - 3840)];
            biasP[c] = v; }
        for (int m = gw; m < M; m += NGW) rms_row_wave(x + (size_t)m * D, g_mix, U + (size_t)m * D, lane);
        for (int m = gw; m < 1024; m += NGW) rms_row_wave(mem + (size_t)m * D, g_mem, MEMN + (size_t)m * D, lane);
    }
    SEAM(0);
    PHASE(1) {
        { pg8::Gemm g{U, Wi, M, 4096, D}; pg8::StaticOrder S; S.init(M, 4096, G, bid);
          pg8::EpiStore<0> E{P, biasP, S32, PW, 15};
          pg8::gemm_phase<pg8::EpiStore<0>, pg8::StaticOrder, true, true>(lds3, g, S, E); }
        { pg8::Gemm g{MEMN, Wmkv, 1024, 1024, D}; pg8::StaticOrder S; S.init(1024, 1024, G, bid);
          pg8::EpiStore<0> E{MEMKV, nullptr, nullptr, 1024, -1};
          pg8::gemm_phase<pg8::EpiStore<0>, pg8::StaticOrder, true, true>(lds3, g, S, E); }
    }
    SEAM(1);
    PHASE(2) { for (int ci = bid; ci < 1024; ci += G) ml::m1_unit((NLAS char*)lds_raw, P, ml_conv, S32, Abuf, NA, Gc, Mloc, ci);
               for (int u = bid; u < 256; u += G) cmpr::unit((NLAS char*)lds_raw, P, cmp_pe, Wc1, Wc2, KC, VC, u);
               xa::phase((NLAS char*)lds_raw, P, MEMKV, Yxa); }
    SEAM(2);
    PHASE(3) { ml::m2_items(Abuf, NA, Gc, Mloc, Mprev);
               nsa::phase((NLAS char*)lds_raw, P, S32, KC, VC, Ynsa); }
    SEAM(3);
    PHASE(4) { for (int ci = bid; ci < 1024; ci += G) ml::m3_unit((NLAS char*)lds_raw, P, ml_conv, S32, Abuf, NA, Mprev, ml_norm_g, Yml, ci); }
    SEAM(4);
    PHASE(5) { pg8::Gemm g{U, Wg, M, 3072, D}; pg8::StaticOrder S; S.init(M, 3072, G, bid);
               pg8::EpiStore<1> E{GATES, b_in + C_MG, nullptr, 3072, -1};
               pg8::gemm_phase<pg8::EpiStore<1>, pg8::StaticOrder, true, true>(lds3, g, S, E); }
    SEAM(5);
    PHASE(6) {
#pragma unroll 1
        for (int j = 0; j < 3; ++j) { pg8::Gemm g{Yml + (size_t)j * M * 512, Wbr + (size_t)j * 1024 * 512, M, 1024, 512}; pg8::StaticOrder S; S.init(M, 1024, G, bid);
            pg8::EpiMergeG E{GATES, out, MERGED, j, 0};
            pg8::gemm_phase<pg8::EpiMergeG, pg8::StaticOrder, true, true>(lds3, g, S, E); }
    }
    SEAM(6);
    PHASE(7) { pg8::Gemm g{MERGED, Wo, M, 1024, D}; pg8::StaticOrder S; S.init(M, 1024, G, bid);
               pg8::EpiResidF E{x, out};
               pg8::gemm_phase<pg8::EpiResidF, pg8::StaticOrder, true, true>(lds3, g, S, E); }
    SEAM(7);
    PHASE(8) { const int gw = bid * 8 + wave, NGW = G * 8; for (int m = gw; m < M; m += NGW) rms_row_wave(out + (size_t)m * D, g_ffn, AFFN + (size_t)m * D, lane); }
    SEAM(8);
    PHASE(9) { pg8::Gemm g{AFFN, Wf1, M, FF, D}; pg8::StaticOrder S; S.init(M, FF, G, bid);
               pg8::EpiStore<2> E{HBUF, nullptr, nullptr, FF, -1};
               pg8::gemm_phase<pg8::EpiStore<2>, pg8::StaticOrder, true, true>(lds3, g, S, E); }
    SEAM(9);
    PHASE(10) { pg8::Gemm g{HBUF, Wf2, M, 1024, FF}; pg8::StaticOrder S; S.init(M, 1024, G, bid);
                pg8::EpiResidF E{out, out};
                pg8::gemm_phase<pg8::EpiResidF, pg8::StaticOrder, true, true>(lds3, g, S, E); }
    SEAM(10);
    PHASE(11) { run_vb<256>(M, lds, [=](VB vb) { rms_rows<false>(vb, out, g_final, out); }); }
}
constexpr int N_PHASES = 12;
#ifndef MK_PER_PHASE
#define MK_PER_PHASE 0
#endif
extern "C" void kernel_launch(void* const* d_in, const int* in_sizes, int n_in, void* d_out, int out_size, void* d_ws, size_t ws_size, hipStream_t stream) {
    static int grid = 0;
    if (grid == 0) {
        int dev = 0, cus = 0, per_cu = 0;
        (void)hipGetDevice(&dev); (void)hipDeviceGetAttribute(&cus, hipDeviceAttributeMultiprocessorCount, dev);
        (void)hipFuncSetAttribute((const void*)mega, hipFuncAttributeMaxDynamicSharedMemorySize, LDS_BYTES);
        (void)hipOccupancyMaxActiveBlocksPerMultiprocessor(&per_cu, (const void*)mega, NTHREADS, LDS_BYTES);
        if (per_cu < 1) { fprintf(stderr, "occupancy query says %d blocks/CU\n", per_cu); per_cu = 1; }
        grid = cus * 1;
        (void)hipGetLastError();
    }
    Args a{};
    for (int i = 0; i < 18; ++i) a.in[i] = (const float*)d_in[i];
    a.out = (float*)d_out; a.ws = (unsigned char*)d_ws;
#if MK_PER_PHASE
    for (int p = 0; p < N_PHASES; ++p) { a.ph_lo = p; a.ph_hi = p + 1; void* args[] = {&a};
        (void)hipLaunchCooperativeKernel((const void*)mega, dim3(grid), dim3(NTHREADS), args, LDS_BYTES, stream); }
#else
    a.ph_lo = 0; a.ph_hi = N_PHASES; void* args[] = {&a};
    hipError_t e = hipLaunchCooperativeKernel((const void*)mega, dim3(grid), dim3(NTHREADS), args, LDS_BYTES, stream);
    if (e != hipSuccess) fprintf(stderr, "cooperative launch failed: %s (grid %d)\n", hipGetErrorString(e), grid);
#endif
}
```

```cpp
#include <hip/hip_runtime.h>
#include <hip/hip_cooperative_groups.h>
#include <cstdio>
namespace cg = cooperative_groups;
#include <stdint.h>

typedef unsigned short bf16_t;
struct VB { int id; int tid; char* sm; };
__device__ __forceinline__ float bf2f(bf16_t v) { return __uint_as_float(((unsigned)v) << 16); }
__device__ __forceinline__ bf16_t f2bf(float f) { unsigned u = __float_as_uint(f); return (bf16_t)((u + 0x7fffu + ((u >> 16) & 1u)) >> 16); }

constexpr int NB = 4, T = 4096, M = NB * T, D = 1024, DIN = 6944, FF = 4096;
constexpr float EPS = 1e-6f;
constexpr int C_MLI = 2048, C_NSG = 3336, C_MG = 3872;
constexpr int P_MLQ = 0, P_MLK = 512, P_MLV = 1024, P_MLO = 1536, P_NSQ = 2048, P_KC = 2560, P_VC = 2688, P_KS = 2816, P_VS = 2944, P_KW = 3072, P_VW = 3200, P_XAQ = 3328, PW = 3840;
constexpr size_t MiB = 1u << 20;
constexpr size_t WS_U = 40 * MiB;
constexpr size_t WS_P = 72 * MiB;
constexpr size_t WS_Y = 192 * MiB;
constexpr size_t WS_AFFN = 200 * MiB;
constexpr size_t WS_S32 = 240 * MiB;
constexpr size_t WS_MEMN = 242 * MiB;
constexpr size_t WS_MEMKV = 244 * MiB;
constexpr size_t WS_KC = 246 * MiB;
constexpr size_t WS_VC = 246 * MiB + 512 * 1024;
constexpr size_t WS_NA = 247 * MiB;
constexpr size_t WS_G = 248 * MiB;
constexpr size_t WS_MLOC = 248 * MiB + 4096;
constexpr size_t WS_MPREV = 248 * MiB + 8192;

__device__ __forceinline__ float wave_sum(float v) {
#pragma unroll
    for (int o = 1; o < 64; o <<= 1) v += __shfl_xor(v, o);
    return v;
}
__device__ __forceinline__ float wave_max(float v) {
#pragma unroll
    for (int o = 1; o < 64; o <<= 1) v = fmaxf(v, __shfl_xor(v, o));
    return v;
}

template <bool OUT_BF16>
__device__ __forceinline__ void rms_rows(VB vb, const float* x, const float* g, void* out) {
    float* red = (float*)vb.sm;
    const int row = vb.id, tid = vb.tid;
    const float4 v = ((const float4*)(x + (size_t)row * D))[tid];
    float s = v.x * v.x + v.y * v.y + v.z * v.z + v.w * v.w;
    s = wave_sum(s);
    if ((tid & 63) == 0) red[tid >> 6] = s;
    __syncthreads();
    const float tot = red[0] + red[1] + red[2] + red[3];
    const float r = rsqrtf(tot * (1.0f / D) + EPS);
    const float4 gg = ((const float4*)g)[tid];
    float4 o; o.x = v.x * r * gg.x; o.y = v.y * r * gg.y; o.z = v.z * r * gg.z; o.w = v.w * r * gg.w;
    if (OUT_BF16) { bf16_t* ob = (bf16_t*)out + (size_t)row * D + tid * 4; ob[0] = f2bf(o.x); ob[1] = f2bf(o.y); ob[2] = f2bf(o.z); ob[3] = f2bf(o.w); }
    else ((float4*)((float*)out + (size_t)row * D))[tid] = o;
}

struct GArgs { const bf16_t* A; const float* W; int lda, ldw, N, K; };
template <class Epi>
__device__ __forceinline__ void ngemm(VB vb, GArgs ga, Epi epi) {
    const bf16_t* A = ga.A; const float* W = ga.W; const int lda = ga.lda, ldw = ga.ldw, N = ga.N, K = ga.K;
    float (*As)[65] = (float (*)[65])vb.sm; float (*Bs)[65] = (float (*)[65])(vb.sm + 16 * 65 * 4);
    const int tid = vb.tid, tx = tid & 15, ty = tid >> 4;
    const int nx = (N + 63) / 64; const int m0 = (vb.id / nx) * 64, n0 = (vb.id % nx) * 64;
    float acc[4][4];
#pragma unroll
    for (int i = 0; i < 4; ++i)
#pragma unroll
        for (int j = 0; j < 4; ++j) acc[i][j] = 0.f;
    for (int k0 = 0; k0 < K; k0 += 16) {
#pragma unroll
        for (int i = 0; i < 4; ++i) { const int idx = tid + i * 256, r = idx >> 4, kk = idx & 15; As[kk][r] = bf2f(A[(size_t)(m0 + r) * lda + k0 + kk]); }
#pragma unroll
        for (int i = 0; i < 4; ++i) { const int idx = tid + i * 256, kk = idx >> 6, n = idx & 63; Bs[kk][n] = (n0 + n < N) ? W[(size_t)(k0 + kk) * ldw + n0 + n] : 0.f; }
        __syncthreads();
#pragma unroll
        for (int kk = 0; kk < 16; ++kk) {
            float a[4], b[4];
#pragma unroll
            for (int i = 0; i < 4; ++i) { a[i] = As[kk][ty * 4 + i]; b[i] = Bs[kk][tx * 4 + i]; }
#pragma unroll
            for (int i = 0; i < 4; ++i)
#pragma unroll
                for (int j = 0; j < 4; ++j) acc[i][j] += a[i] * b[j];
        }
        __syncthreads();
    }
#pragma unroll
    for (int i = 0; i < 4; ++i)
#pragma unroll
        for (int j = 0; j < 4; ++j) { const int n = n0 + tx * 4 + j; if (n < N) epi(m0 + ty * 4 + i, n, acc[i][j]); }
}
struct EpiBiasBf16 { bf16_t* O; const float* bias; int ldo, pad; __device__ void operator()(int m, int n, float a) const { O[(size_t)m * ldo + n] = f2bf(a + (bias ? bias[n] : 0.f)); } };
struct EpiBiasF32 { float* O; const float* bias; int ldo, pad; __device__ void operator()(int m, int n, float a) const { O[(size_t)m * ldo + n] = a + bias[n]; } };
struct EpiSigBf16 { bf16_t* O; const float* bias; int ldo, pad; __device__ void operator()(int m, int n, float a) const { const float v = a + bias[n]; O[(size_t)m * ldo + n] = f2bf(1.f / (1.f + __expf(-v))); } };
struct EpiMerge { const bf16_t* G; float* Mf; bf16_t* Mb; int j, pad; __device__ void operator()(int m, int n, float a) const {
    const float g = bf2f(G[(size_t)m * 3072 + j * 1024 + n]); float v = g * a; if (j > 0) v += Mf[(size_t)m * D + n];
    if (j < 2) Mf[(size_t)m * D + n] = v; else Mb[(size_t)m * D + n] = f2bf(v); } };
struct EpiResid { const float* X; float* O; __device__ void operator()(int m, int n, float a) const { O[(size_t)m * D + n] = X[(size_t)m * D + n] + a; } };
struct EpiRelu2 { bf16_t* O; __device__ void operator()(int m, int n, float a) const { const float r = fmaxf(a, 0.f); O[(size_t)m * FF + n] = f2bf(r * r); } };

__device__ __forceinline__ float convqk(const bf16_t* P, const float* w  , int m, int t, int ch) {
    float y = 0.f;
#pragma unroll
    for (int j = 0; j < 4; ++j) if (t - j >= 0) y += w[j * 1024 + ch] * bf2f(P[(size_t)(m - j) * PW + ch]);
    return bf2f(f2bf(y / (1.f + __expf(-y))));
}
__device__ __forceinline__ float logsig(float x) { return fminf(x, 0.f) - log1pf(__expf(-fabsf(x))); }
__device__ __forceinline__ void m1_naive(VB vb, const bf16_t* P, const float* cw, const float* S32, float* Abuf, float* NA, float* Gc, float* Mloc) {
    float (*kk)[128] = (float (*)[128])vb.sm; float* e = (float*)(vb.sm + 32768); float* bc = e + 64;
    const int ci = vb.id, c = ci & 63, bh = ci >> 6, h = bh & 3, b = bh >> 2, tid = vb.tid;
    const int m0 = b * T + c * 64;
    if (tid == 0) {
        float run = 0.f;
        for (int s = 0; s < 64; ++s) { run += logsig(S32[(size_t)(m0 + s) * 32 + 4 + h]); bc[s] = run; }
        const float g = run; float mx = -INFINITY;
        for (int s = 0; s < 64; ++s) { const float w = g - bc[s] + S32[(size_t)(m0 + s) * 32 + h]; e[s] = w; mx = fmaxf(mx, w); }
        for (int s = 0; s < 64; ++s) e[s] = __expf(e[s] - mx);
        Gc[ci] = g; Mloc[ci] = mx;
    }
    for (int i = tid; i < 64 * 128; i += 256) { const int s = i >> 7, k = i & 127; kk[s][k] = convqk(P, cw, m0 + s, c * 64 + s, 512 + h * 128 + k) * 0.08838834764831845f; }
    __syncthreads();
    const int v = tid & 127, kh = tid >> 7;
    float acc[64];
#pragma unroll
    for (int i = 0; i < 64; ++i) acc[i] = 0.f;
    for (int s = 0; s < 64; ++s) {
        const float ev = e[s] * bf2f(P[(size_t)(m0 + s) * PW + P_MLV + h * 128 + v]);
#pragma unroll
        for (int i = 0; i < 64; ++i) acc[i] += kk[s][kh * 64 + i] * ev;
    }
#pragma unroll
    for (int i = 0; i < 64; ++i) Abuf[((size_t)ci * 128 + kh * 64 + i) * 128 + v] = acc[i];
    if (tid < 128) { float n = 0.f; for (int s = 0; s < 64; ++s) n += e[s] * kk[s][tid]; NA[(size_t)ci * 128 + tid] = n; }
}
__device__ __forceinline__ void m2_naive(VB vb, float* Abuf, float* NA, const float* Gc, const float* Mloc, float* Mprev) {
    const int i = vb.id * 256 + vb.tid;
    const int bh = i >> 14, kv = i & 16383, k = kv >> 7, v = kv & 127;
    float C = 0.f, n = 0.f, m = 0.f;
    for (int c = 0; c < 64; ++c) {
        const int ci = bh * 64 + c;
        const float g = Gc[ci], ml = Mloc[ci];
        const float mn = fmaxf(g + m, ml), a = __expf(g + m - mn), bb = __expf(ml - mn);
        const size_t idx = ((size_t)ci * 128 + k) * 128 + v;
        const float A = Abuf[idx]; Abuf[idx] = C; C = a * C + bb * A;
        if (v == 0) { const float nA = NA[(size_t)ci * 128 + k]; NA[(size_t)ci * 128 + k] = n; n = a * n + bb * nA; }
        if (kv == 0) Mprev[ci] = m;
        m = mn;
    }
}
__device__ __forceinline__ void m3_naive(VB vb, const bf16_t* P, const float* cw, const float* S32, const float* Cprev, const float* Nprev, const float* Mprev,
                                                const float* normg, bf16_t* Yml) {
    float* q = (float*)vb.sm; float* Srow = q + 128; float* bc = Srow + 64; float* li = bc + 64; float* sh = li + 64;
    const int ci = vb.id >> 6, tt = vb.id & 63, c = ci & 63, bh = ci >> 6, h = bh & 3, b = bh >> 2, tid = vb.tid;
    const int m0 = b * T + c * 64, m = m0 + tt;
    q[tid] = convqk(P, cw, m, c * 64 + tt, h * 128 + tid);
    if (tid == 0) { float run = 0.f; for (int s = 0; s <= tt; ++s) { run += logsig(S32[(size_t)(m0 + s) * 32 + 4 + h]); bc[s] = run; li[s] = S32[(size_t)(m0 + s) * 32 + h]; } }
    __syncthreads();
    const float mprev = Mprev[ci], inter = bc[tt] + mprev;
    float mt = inter;
    for (int s = 0; s <= tt; ++s) mt = fmaxf(mt, bc[tt] - bc[s] + li[s]);
    if (tid < 64) {
        float sv = 0.f;
        if (tid <= tt) { float dot = 0.f; for (int k = 0; k < 128; ++k) dot += q[k] * convqk(P, cw, m0 + tid, c * 64 + tid, 512 + h * 128 + k);
            sv = dot * 0.08838834764831845f * __expf(bc[tt] - bc[tid] + li[tid] - mt); }
        Srow[tid] = sv;
    }
    __syncthreads();
    const float sc = __expf(inter - mt);
    float num = 0.f, den = 0.f;
    for (int s = 0; s <= tt; ++s) { num += Srow[s] * bf2f(P[(size_t)(m0 + s) * PW + P_MLV + h * 128 + tid]); den += Srow[s]; }
    float qc = 0.f, qn = 0.f;
    for (int k = 0; k < 128; ++k) { qc += q[k] * Cprev[((size_t)ci * 128 + k) * 128 + tid]; qn += q[k] * Nprev[(size_t)ci * 128 + k]; }
    num += sc * qc; den += sc * qn;
    const float hv = num / fmaxf(fabsf(den), __expf(-mt));
    float ss = wave_sum(hv * hv);
    if ((tid & 63) == 0) sh[tid >> 6] = ss;
    __syncthreads();
    const float r = rsqrtf((sh[0] + sh[1]) * (1.f / 128.f) + EPS);
    const float o = bf2f(P[(size_t)m * PW + P_MLO + h * 128 + tid]);
    Yml[(size_t)m * 512 + h * 128 + tid] = f2bf(1.f / (1.f + __expf(-o)) * hv * r * normg[h * 128 + tid]);
}

__device__ __forceinline__ float gelu_tanh(float x) { const float u = 0.7978845608028654f * (x + 0.044715f * x * x * x); return 0.5f * x * (1.f + tanhf(u)); }
__device__ __forceinline__ void n1_naive(VB vb, const bf16_t* P, const float* pe  , const float* w1  , const float* w2  , bf16_t* KC, bf16_t* VC) {
    float* xin = (float*)vb.sm; float* hid = xin + 2048;
    int idx = vb.id; const int g = idx & 1; idx >>= 1; const int n = idx % 255; idx /= 255; const int b = idx & 3, kv = idx >> 2, tid = vb.tid;
    const int pcol = (kv ? P_VC : P_KC) + g * 64;
    for (int i = tid; i < 2048; i += 256) { const int l = i >> 6, d = i & 63; xin[i] = bf2f(P[(size_t)(b * T + n * 16 + l) * PW + pcol + d]) + pe[kv * 2048 + i]; }
    __syncthreads();
    float a = 0.f; const float* w = w1 + (size_t)kv * 2048 * 256 + tid;
    for (int i = 0; i < 2048; ++i) a += xin[i] * w[(size_t)i * 256];
    hid[tid] = gelu_tanh(a);
    __syncthreads();
    if (tid < 64) { float o = 0.f; const float* ww = w2 + (size_t)kv * 256 * 64 + tid; for (int j = 0; j < 256; ++j) o += hid[j] * ww[j * 64];
        (kv ? VC : KC)[((size_t)(b * 256 + n) * 2 + g) * 64 + tid] = f2bf(o); }
}
__device__ __forceinline__ void n2_naive(VB vb, const bf16_t* P, const float* S32, const bf16_t* KC, const bf16_t* VC, bf16_t* Ynsa) {
    float (*q_s)[64] = (float (*)[64])vb.sm; float (*sc)[1024] = (float (*)[1024])(vb.sm + 1024); float (*pc)[256] = (float (*)[256])(vb.sm + 1024 + 16384); float* imp_s = (float*)(vb.sm + 1024 + 16384 + 4096);
    unsigned long long& selmask = *(unsigned long long*)(vb.sm + 1024 + 16384 + 4096 + 256);
    const int g = vb.id & 1, m = vb.id >> 1, b = m / T, t = m % T, tid = vb.tid, r = tid >> 6, lane = tid & 63, h = g * 4 + r;
    const float slope = exp2f(-(float)(h + 1));
    q_s[r][lane] = bf2f(P[(size_t)m * PW + P_NSQ + h * 64 + lane]) * 0.125f;
    __syncthreads();
    float sv[4]; float mx = -INFINITY;
#pragma unroll
    for (int i = 0; i < 4; ++i) { const int n = lane + 64 * i; sv[i] = -INFINITY;
        if (n < 255) { const int dist = t - (16 * n + 31); if (dist >= 0) { const bf16_t* kr = KC + ((size_t)(b * 256 + n) * 2 + g) * 64; float dot = 0.f; for (int d = 0; d < 64; ++d) dot += q_s[r][d] * bf2f(kr[d]);
            sv[i] = dot - slope * (float)dist; mx = fmaxf(mx, sv[i]); } } }
    mx = wave_max(mx);
    float sum = 0.f;
#pragma unroll
    for (int i = 0; i < 4; ++i) { sv[i] = (sv[i] == -INFINITY) ? 0.f : __expf(sv[i] - mx); sum += sv[i]; }
    sum = wave_sum(sum);
    const float inv = sum > 0.f ? 1.f / sum : 0.f;
#pragma unroll
    for (int i = 0; i < 4; ++i) pc[r][lane + 64 * i] = sv[i] * inv;
    __syncthreads();
    float oc = 0.f;
    { const int nmax = (t >= 31) ? ((t - 31) / 16) : -1; for (int n = 0; n <= nmax && n < 255; ++n) oc += pc[r][n] * bf2f(VC[((size_t)(b * 256 + n) * 2 + g) * 64 + lane]); }
    if (tid < 64) { const int j = tid; float im = 0.f;
        for (int n = 4 * j - 1; n <= 4 * j + 3; ++n) if (n >= 0 && n < 255) im += (pc[0][n] + pc[1][n]) + (pc[2][n] + pc[3][n]);
        const int cur = t >> 6; const bool valid = j <= cur, forced = (j == 0) || (j == cur) || (j == cur - 1);
        const float s = valid ? im + (forced ? 1000.f : 0.f) : -1e30f;
        imp_s[j] = s; }
    __syncthreads();
    if (tid < 64) { const int j = tid; const float s = imp_s[j]; int rank = 0;
        for (int jj = 0; jj < 64; ++jj) { const float o = imp_s[jj]; rank += (o > s || (o == s && jj < j)) ? 1 : 0; }
        const unsigned long long mk = __ballot(rank < 16 && j <= (t >> 6)); if (tid == 0) selmask = mk; }
    __syncthreads();
    float osel = 0.f;
    { unsigned long long mk = selmask; int slot = 0; float mxs = -INFINITY;
      while (mk) { const int jb = __ffsll((long long)mk) - 1; mk &= mk - 1; const int pos = jb * 64 + lane; float s = -INFINITY;
          if (pos <= t) { const bf16_t* kr = P + (size_t)(b * T + pos) * PW + P_KS + g * 64; float dot = 0.f; for (int d = 0; d < 64; ++d) dot += q_s[r][d] * bf2f(kr[d]); s = dot - slope * (float)(t - pos); }
          sc[r][slot * 64 + lane] = s; mxs = fmaxf(mxs, s); ++slot; }
      mxs = wave_max(mxs); float sm = 0.f;
      for (int i = 0; i < slot; ++i) { const float s = sc[r][i * 64 + lane]; const float p = (s == -INFINITY) ? 0.f : __expf(s - mxs); sc[r][i * 64 + lane] = p; sm += p; }
      sm = wave_sum(sm);
      mk = selmask; slot = 0;
      while (mk) { const int jb = __ffsll((long long)mk) - 1; mk &= mk - 1;
          for (int i = 0; i < 64; ++i) { const int pos = jb * 64 + i; if (pos > t) break; osel += sc[r][slot * 64 + i] * bf2f(P[(size_t)(b * T + pos) * PW + P_VS + g * 64 + lane]); }
          ++slot; }
      osel /= sm; }
    __syncthreads();
    float owin = 0.f;
    { float mxs = -INFINITY;
      for (int i = 0; i < 8; ++i) { const int pos = t - 511 + i * 64 + lane; float s = -INFINITY;
          if (pos >= 0) { const bf16_t* kr = P + (size_t)(b * T + pos) * PW + P_KW + g * 64; float dot = 0.f; for (int d = 0; d < 64; ++d) dot += q_s[r][d] * bf2f(kr[d]); s = dot - slope * (float)(t - pos); }
          sc[r][i * 64 + lane] = s; mxs = fmaxf(mxs, s); }
      mxs = wave_max(mxs); float sm = 0.f;
      for (int i = 0; i < 8; ++i) { const float s = sc[r][i * 64 + lane]; const float p = (s == -INFINITY) ? 0.f : __expf(s - mxs); sc[r][i * 64 + lane] = p; sm += p; }
      sm = wave_sum(sm);
      for (int i = 0; i < 512; ++i) { const int pos = t - 511 + i; if (pos < 0) continue; owin += sc[r][i] * bf2f(P[(size_t)(b * T + pos) * PW + P_VW + g * 64 + lane]); }
      owin /= sm; }
    const float* gp = S32 + (size_t)m * 32 + 8 + h * 3;
    const float g0 = 1.f / (1.f + __expf(-gp[0])), g1 = 1.f / (1.f + __expf(-gp[1])), g2 = 1.f / (1.f + __expf(-gp[2]));
    Ynsa[(size_t)m * 512 + h * 64 + lane] = f2bf(g0 * oc + g1 * osel + g2 * owin);
}
__device__ __forceinline__ void x1_naive(VB vb, const bf16_t* P, const bf16_t* MEMKV, bf16_t* Yxa) {
    float (*q_s)[128] = (float (*)[128])vb.sm; float (*p_s)[256] = (float (*)[256])(vb.sm + 2048);
    const int m = vb.id, b = m / T, tid = vb.tid, h = tid >> 6, lane = tid & 63;
    q_s[h][lane] = bf2f(P[(size_t)m * PW + P_XAQ + h * 128 + lane]) * 0.08838834764831845f;
    q_s[h][lane + 64] = bf2f(P[(size_t)m * PW + P_XAQ + h * 128 + lane + 64]) * 0.08838834764831845f;
    __syncthreads();
    float sv[4]; float mx = -INFINITY;
#pragma unroll
    for (int i = 0; i < 4; ++i) { const int j = lane + 64 * i; const bf16_t* kr = MEMKV + (size_t)(b * 256 + j) * 1024 + h * 128; float dot = 0.f; for (int d = 0; d < 128; ++d) dot += q_s[h][d] * bf2f(kr[d]); sv[i] = dot; mx = fmaxf(mx, dot); }
    mx = wave_max(mx); float sm = 0.f;
#pragma unroll
    for (int i = 0; i < 4; ++i) { sv[i] = __expf(sv[i] - mx); sm += sv[i]; }
    sm = wave_sum(sm);
#pragma unroll
    for (int i = 0; i < 4; ++i) p_s[h][lane + 64 * i] = sv[i] / sm;
    __syncthreads();
    float o0 = 0.f, o1 = 0.f;
    for (int j = 0; j < 256; ++j) { const bf16_t* vr = MEMKV + (size_t)(b * 256 + j) * 1024 + 512 + h * 128; const float p = p_s[h][j]; o0 += p * bf2f(vr[lane]); o1 += p * bf2f(vr[lane + 64]); }
    Yxa[(size_t)m * 512 + h * 128 + lane] = f2bf(o0); Yxa[(size_t)m * 512 + h * 128 + lane + 64] = f2bf(o1);
}


namespace pg8 {
#define PG8_LAS __attribute__((address_space(3)))
typedef unsigned short bf16_t;
typedef short bf16x8 __attribute__((ext_vector_type(8)));
typedef float f32x4 __attribute__((ext_vector_type(4)));
typedef unsigned u32x4 __attribute__((ext_vector_type(4)));
constexpr int BM = 256, BK = 64, HALF = 128, HTB = HALF * BK * 2  , STAGE_BYTES = 8 * HTB, NXCD = 8, WGM = 8;

__host__ __device__ __forceinline__ int lds_byte(int r, int c) { const int st = (r >> 4) * 2 + (c >> 5), rr = r & 15, cc = c & 31, ob = rr * 64 + cc * 2; return st * 1024 + (ob ^ (((ob >> 9) & 1) << 5)); }
__host__ __device__ __forceinline__ void stage_rc(int b, int& R, int& C) { const int st = b / 1024, sb = b % 1024, swz = sb ^ (((sb >> 9) & 1) << 5); R = (st >> 1) * 16 + swz / 64; C = (st & 1) * 32 + (swz % 64) / 2; }
__host__ __device__ __forceinline__ int perm32(int rho) { const int n = rho >> 4, i = rho & 15; return 8 * (i >> 2) + 4 * n + (i & 3); }

struct Unit { int pm, pn; };
struct Gemm { const bf16_t* A; const bf16_t* Bt; int M, N, K; };

struct StaticOrder {
    int nM, nN, nwg, G, c;
    __host__ __device__ void init(int M, int N, int G_, int c_) { nM = M / BM; nN = N / BM; nwg = nM * nN; G = G_; c = c_; }
    __host__ __device__ bool next(int i, Unit& u) const {
        const long L = (long)i * G + c; if (L >= nwg) return false;
        int wgid = (int)L; { const int q = nwg / NXCD, r = nwg % NXCD, xcd = wgid % NXCD, off = wgid / NXCD; wgid = (xcd < r ? xcd * (q + 1) : r * (q + 1) + (xcd - r) * q) + off; }
        const int nig = WGM * nN, gid = wgid / nig, fm = gid * WGM, gsz = (nM - fm) < WGM ? (nM - fm) : WGM;
        u.pm = fm + ((wgid % nig) % gsz); u.pn = (wgid % nig) / gsz; return true;
    }
    __device__ __forceinline__ void a_ready(const Unit&) const {}
    __device__ __forceinline__ void done(const Unit&) const {}
};

typedef float f32x2_t __attribute__((ext_vector_type(2))); typedef __bf16 bf16x2_t __attribute__((ext_vector_type(2)));
__device__ __forceinline__ unsigned cvt_pk_bf16(float lo, float hi) { f32x2_t v = {lo, hi}; bf16x2_t b = __builtin_convertvector(v, bf16x2_t); return __builtin_bit_cast(unsigned, b); }
typedef float f32x2 __attribute__((ext_vector_type(2)));

typedef unsigned u32x2 __attribute__((ext_vector_type(2)));
__device__ __forceinline__ float bflo(unsigned w) { return __uint_as_float(w << 16); }
__device__ __forceinline__ float bfhi(unsigned w) { return __uint_as_float(w & 0xffff0000u); }
template <int ACT> __device__ __forceinline__ f32x4 act4(f32x4 v) {
    if (ACT == 1) { f32x4 o; for (int e = 0; e < 4; ++e) o[e] = __builtin_amdgcn_rcpf(1.f + __expf(-v[e])); return o; }
    if (ACT == 2) { f32x4 o; for (int e = 0; e < 4; ++e) { const float r = fmaxf(v[e], 0.f); o[e] = r * r; } return o; }
    return v;
}
template <int ACT> struct EpiStore {
    static constexpr bool PERM = true, AFTER_DRAIN = false;
    bf16_t* O; const float* bias; float* S32; int ldc, small_pn;
    __device__ __forceinline__ void operator()(const f32x4 (&acc)[2][2][4][2], const Unit& u, int wr, int wc, int fr, int fq) const {
        asm volatile("s_waitcnt vmcnt(0)" ::: "memory");
        const int row0 = u.pm * BM + wr * 64 + fr, col0 = u.pn * BM + wc * 32 + 8 * fq;
        if (u.pn == small_pn) {
            if (wc == 0) {
                const f32x4 b0 = *(const f32x4*)(bias + col0), b1 = *(const f32x4*)(bias + col0 + 4);
#pragma unroll
                for (int ai = 0; ai < 2; ++ai)
#pragma unroll
                    for (int m = 0; m < 4; ++m) { float* rp = S32 + (size_t)(row0 + ai * HALF + m * 16) * 32 + 8 * fq;
                        *(f32x4*)rp = acc[ai][0][m][0] + acc[ai][1][m][0] + b0; *(f32x4*)(rp + 4) = acc[ai][0][m][1] + acc[ai][1][m][1] + b1; }
            }
            return;
        }
        f32x4 bv[2][2];
#pragma unroll
        for (int bj = 0; bj < 2; ++bj)
#pragma unroll
            for (int n = 0; n < 2; ++n) bv[bj][n] = bias ? *(const f32x4*)(bias + col0 + bj * HALF + 4 * n) : (f32x4){0.f, 0.f, 0.f, 0.f};
#pragma unroll
        for (int ai = 0; ai < 2; ++ai)
#pragma unroll
            for (int m = 0; m < 4; ++m) { bf16_t* rowp = O + (size_t)(row0 + ai * HALF + m * 16) * ldc + col0;
#pragma unroll
                for (int bj = 0; bj < 2; ++bj) { const f32x4 v0 = act4<ACT>(acc[ai][bj][m][0] + bv[bj][0]), v1 = act4<ACT>(acc[ai][bj][m][1] + bv[bj][1]);
                    u32x4 w; w.x = cvt_pk_bf16(v0[0], v0[1]); w.y = cvt_pk_bf16(v0[2], v0[3]); w.z = cvt_pk_bf16(v1[0], v1[1]); w.w = cvt_pk_bf16(v1[2], v1[3]);
                    *(u32x4*)(rowp + bj * HALF) = w; } }
    }
};
struct EpiMergeG {
    static constexpr bool PERM = true, AFTER_DRAIN = false;
    const bf16_t* G; float* Mf; bf16_t* Mb; int j, pad;
    __device__ __forceinline__ void operator()(const f32x4 (&acc)[2][2][4][2], const Unit& u, int wr, int wc, int fr, int fq) const {
        asm volatile("s_waitcnt vmcnt(0)" ::: "memory");
        const int row0 = u.pm * BM + wr * 64 + fr, col0 = u.pn * BM + wc * 32 + 8 * fq;
#pragma unroll
        for (int ai = 0; ai < 2; ++ai)
#pragma unroll
            for (int m = 0; m < 4; ++m) { const size_t row = (size_t)(row0 + ai * HALF + m * 16);
#pragma unroll
                for (int bj = 0; bj < 2; ++bj) { const int col = col0 + bj * HALF;
                    const u32x4 gw = *(const u32x4*)(G + row * 3072 + j * 1024 + col);
                    f32x4 v0 = (f32x4){bflo(gw.x), bfhi(gw.x), bflo(gw.y), bfhi(gw.y)} * acc[ai][bj][m][0], v1 = (f32x4){bflo(gw.z), bfhi(gw.z), bflo(gw.w), bfhi(gw.w)} * acc[ai][bj][m][1];
                    float* mp = Mf + row * 1024 + col;
                    if (j > 0) { v0 += *(const f32x4*)mp; v1 += *(const f32x4*)(mp + 4); }
                    if (j < 2) { *(f32x4*)mp = v0; *(f32x4*)(mp + 4) = v1; }
                    else { u32x4 w; w.x = cvt_pk_bf16(v0[0], v0[1]); w.y = cvt_pk_bf16(v0[2], v0[3]); w.z = cvt_pk_bf16(v1[0], v1[1]); w.w = cvt_pk_bf16(v1[2], v1[3]); *(u32x4*)(Mb + row * 1024 + col) = w; } } }
    }
};
struct EpiResidF {
    static constexpr bool PERM = true, AFTER_DRAIN = false;
    const float* X; float* O;
    __device__ __forceinline__ void operator()(const f32x4 (&acc)[2][2][4][2], const Unit& u, int wr, int wc, int fr, int fq) const {
        asm volatile("s_waitcnt vmcnt(0)" ::: "memory");
        const int row0 = u.pm * BM + wr * 64 + fr, col0 = u.pn * BM + wc * 32 + 8 * fq;
#pragma unroll
        for (int ai = 0; ai < 2; ++ai)
#pragma unroll
            for (int m = 0; m < 4; ++m) { const size_t off = (size_t)(row0 + ai * HALF + m * 16) * 1024 + col0;
#pragma unroll
                for (int bj = 0; bj < 2; ++bj) { const f32x4 x0 = *(const f32x4*)(X + off + bj * HALF), x1 = *(const f32x4*)(X + off + bj * HALF + 4);
                    *(f32x4*)(O + off + bj * HALF) = x0 + acc[ai][bj][m][0]; *(f32x4*)(O + off + bj * HALF + 4) = x1 + acc[ai][bj][m][1]; } }
    }
};
template <class Epi, class Sched, bool ALIGN_EPI = false, bool SP2 = false>
__device__ __forceinline__ void gemm_phase(PG8_LAS unsigned char* lds, const Gemm g, const Sched& S, const Epi& E) {
    const int tid = threadIdx.x, wid = __builtin_amdgcn_readfirstlane(tid >> 6), lane = tid & 63, wr = wid >> 2, wc = wid & 3, fr = lane & 15, fq = lane >> 4;
    const int K = g.K, nt = K / BK;
    unsigned voffA[2], voffB[2];
#pragma unroll
    for (int i = 0; i < 2; ++i) { int R, C; stage_rc(tid * 16 + i * 8192, R, C); const int Rb = Epi::PERM ? ((R & ~31) + perm32(R & 31)) : R;
        voffA[i] = (unsigned)(R * K + C) * 2u; voffB[i] = (unsigned)(Rb * K + C) * 2u; }
    const size_t kstep = (size_t)(BK * 2);
    const size_t hstep = (size_t)HALF * K * 2;
    const size_t tstep = 2 * hstep;
    const unsigned ldsw = (unsigned)wid * 1024u;
    const int aoff = lds_byte(wr * 64 + fr, fq * 8), boff = lds_byte(wc * 32 + fr, fq * 8);
#define PG8_SA(b, h) (((b) * 2 + (h)) * HTB)
#define PG8_SB(b, h) ((4 + (b) * 2 + (h)) * HTB)
#define PG8_STAGE(bufoff, gbase, voff) do { _Pragma("unroll") for (int _i = 0; _i < 2; ++_i) \
        __builtin_amdgcn_global_load_lds((const unsigned*)((const char*)(gbase) + (voff)[_i]), (PG8_LAS unsigned*)(lds + (bufoff) + ldsw + _i * 8192), 16, 0, 0); } while (0)
#define PG8_LDA(dst, b, h) do { _Pragma("unroll") for (int m = 0; m < 4; ++m) _Pragma("unroll") for (int k = 0; k < 2; ++k) dst[m][k] = *(const PG8_LAS bf16x8*)(lds + PG8_SA(b, h) + aoff + m * 2048 + k * 1024); } while (0)
#define PG8_LDB(dst, b, h) do { _Pragma("unroll") for (int n = 0; n < 2; ++n) _Pragma("unroll") for (int k = 0; k < 2; ++k) dst[n][k] = *(const PG8_LAS bf16x8*)(lds + PG8_SB(b, h) + boff + n * 2048 + k * 1024); } while (0)
#define PG8_MMA(ai, bj, At, Bt) do { __builtin_amdgcn_s_setprio(1); _Pragma("unroll") for (int m = 0; m < 4; ++m) _Pragma("unroll") for (int n = 0; n < 2; ++n) _Pragma("unroll") for (int k = 0; k < 2; ++k) \
        acc[ai][bj][m][n] = __builtin_amdgcn_mfma_f32_16x16x32_bf16(Bt[n][k], At[m][k], acc[ai][bj][m][n], 0, 0, 0); __builtin_amdgcn_s_setprio(0); } while (0)
#define PG8_WAIT_V(n) asm volatile("s_waitcnt vmcnt(" #n ")" ::: "memory")
#define PG8_WAIT_L(n) asm volatile("s_waitcnt lgkmcnt(" #n ")" ::: "memory")
#define PG8_BAR __builtin_amdgcn_s_barrier()
#define PG8_SCHED __builtin_amdgcn_sched_barrier(0)
    Unit cur, nxt; int ui = 0;
    if (!S.next(0, cur)) return;
    f32x4 acc[2][2][4][2];
#pragma unroll
    for (int a = 0; a < 2; ++a)
#pragma unroll
        for (int b = 0; b < 2; ++b)
#pragma unroll
            for (int m = 0; m < 4; ++m)
#pragma unroll
                for (int n = 0; n < 2; ++n) acc[a][b][m][n] = (f32x4){0.f, 0.f, 0.f, 0.f};
    bf16x8 At[4][2], B0[2][2], B1[2][2];
    const char* cA = (const char*)g.A + (size_t)cur.pm * tstep; const char* cB = (const char*)g.Bt + (size_t)cur.pn * tstep;
    S.a_ready(cur);
    if constexpr (SP2) {
        PG8_STAGE(PG8_SB(0, 0), cB, voffB); PG8_STAGE(PG8_SB(0, 1), cB + hstep, voffB); PG8_STAGE(PG8_SA(0, 0), cA, voffA); PG8_STAGE(PG8_SA(0, 1), cA + hstep, voffA);
        if (wr == 1) PG8_BAR;
        PG8_WAIT_V(2); PG8_BAR;
        PG8_STAGE(PG8_SB(1, 0), cB + kstep, voffB); PG8_STAGE(PG8_SA(1, 0), cA + kstep, voffA); PG8_STAGE(PG8_SB(1, 1), cB + hstep + kstep, voffB);
        PG8_WAIT_V(6); PG8_BAR;
    } else {
        PG8_STAGE(PG8_SB(0, 0), cB, voffB); PG8_STAGE(PG8_SA(0, 0), cA, voffA); PG8_STAGE(PG8_SB(0, 1), cB + hstep, voffB); PG8_STAGE(PG8_SA(0, 1), cA + hstep, voffA);
        if (wr == 1) PG8_BAR;
        PG8_WAIT_V(4); PG8_BAR;
        PG8_STAGE(PG8_SB(1, 0), cB + kstep, voffB); PG8_STAGE(PG8_SA(1, 0), cA + kstep, voffA); PG8_STAGE(PG8_SB(1, 1), cB + hstep + kstep, voffB);
        PG8_WAIT_V(6); PG8_BAR;
    }
    for (;;) {
        const bool has_next = S.next(ui + 1, nxt);
        const char* nA = has_next ? (const char*)g.A + (size_t)nxt.pm * tstep : cA; const char* nB = has_next ? (const char*)g.Bt + (size_t)nxt.pn * tstep : cB;
        for (int t = 0; t < nt; t += 2) {
            const bool last = (t == nt - 2);
            const char* a1 = cA + (size_t)(t + 1) * kstep;
            const char* a2 = last ? nA : cA + (size_t)(t + 2) * kstep; const char* b2 = last ? nB : cB + (size_t)(t + 2) * kstep;
            const char* a3 = a2 + kstep; const char* b3 = b2 + kstep;
            if (last && has_next) S.a_ready(nxt);
            if constexpr (SP2) {
            PG8_LDB(B0, 0, 0); PG8_LDB(B1, 0, 1); PG8_SCHED; PG8_LDA(At, 0, 0); PG8_STAGE(PG8_SA(1, 1), a1 + hstep, voffA);
            PG8_WAIT_V(8); PG8_WAIT_L(0); PG8_BAR; PG8_MMA(0, 0, At, B0); PG8_MMA(0, 1, At, B1); PG8_BAR; PG8_SCHED;
            PG8_LDA(At, 0, 1); PG8_STAGE(PG8_SB(0, 0), b2, voffB); PG8_STAGE(PG8_SB(0, 1), b2 + hstep, voffB); PG8_STAGE(PG8_SA(0, 0), a2, voffA);
            PG8_WAIT_V(8); PG8_WAIT_L(0); PG8_BAR; PG8_MMA(1, 0, At, B0); PG8_MMA(1, 1, At, B1); PG8_BAR; PG8_SCHED;
            PG8_LDB(B0, 1, 0); PG8_LDB(B1, 1, 1); PG8_SCHED; PG8_LDA(At, 1, 0); PG8_STAGE(PG8_SA(0, 1), a2 + hstep, voffA);
            PG8_WAIT_V(8); PG8_WAIT_L(0); PG8_BAR; PG8_MMA(0, 0, At, B0); PG8_MMA(0, 1, At, B1); PG8_BAR; PG8_SCHED;
            PG8_LDA(At, 1, 1); PG8_STAGE(PG8_SB(1, 0), b3, voffB); PG8_STAGE(PG8_SB(1, 1), b3 + hstep, voffB); PG8_STAGE(PG8_SA(1, 0), a3, voffA);
            PG8_WAIT_V(8); PG8_WAIT_L(0); PG8_BAR; PG8_MMA(1, 0, At, B0); PG8_MMA(1, 1, At, B1); PG8_BAR; PG8_SCHED;
            } else {
            PG8_LDB(B0, 0, 0); PG8_SCHED; PG8_LDA(At, 0, 0); PG8_STAGE(PG8_SA(1, 1), a1 + hstep, voffA);
            PG8_WAIT_L(8); PG8_BAR; PG8_WAIT_L(0); PG8_MMA(0, 0, At, B0); PG8_BAR; PG8_SCHED;
            PG8_LDB(B1, 0, 1); PG8_STAGE(PG8_SB(0, 0), b2, voffB);
            PG8_BAR; PG8_WAIT_L(0); PG8_MMA(0, 1, At, B1); PG8_BAR;
            PG8_LDA(At, 0, 1); PG8_STAGE(PG8_SA(0, 0), a2, voffA);
            PG8_BAR; PG8_WAIT_L(0); PG8_MMA(1, 0, At, B0); PG8_BAR; PG8_SCHED;
            PG8_STAGE(PG8_SB(0, 1), b2 + hstep, voffB);
            PG8_WAIT_V(6); PG8_BAR; PG8_MMA(1, 1, At, B1); PG8_BAR;
            PG8_LDB(B0, 1, 0); PG8_SCHED; PG8_LDA(At, 1, 0); PG8_STAGE(PG8_SA(0, 1), a2 + hstep, voffA);
            PG8_WAIT_L(8); PG8_BAR; PG8_WAIT_L(0); PG8_MMA(0, 0, At, B0); PG8_BAR; PG8_SCHED;
            PG8_LDB(B1, 1, 1); PG8_STAGE(PG8_SB(1, 0), b3, voffB);
            PG8_BAR; PG8_WAIT_L(0); PG8_MMA(0, 1, At, B1); PG8_BAR;
            PG8_LDA(At, 1, 1); PG8_STAGE(PG8_SA(1, 0), a3, voffA);
            PG8_BAR; PG8_WAIT_L(0); PG8_MMA(1, 0, At, B0); PG8_BAR; PG8_SCHED;
            PG8_STAGE(PG8_SB(1, 1), b3 + hstep, voffB);
            PG8_WAIT_V(6); PG8_BAR; PG8_MMA(1, 1, At, B1); PG8_BAR;
            }
        }
        if constexpr (ALIGN_EPI) { if (wr == 0) PG8_BAR; }
        if constexpr (!Epi::AFTER_DRAIN) { E(acc, cur, wr, wc, fr, fq); S.done(cur); }
        if (!has_next) break;
#pragma unroll
        for (int a = 0; a < 2; ++a)
#pragma unroll
            for (int b = 0; b < 2; ++b)
#pragma unroll
                for (int m = 0; m < 4; ++m)
#pragma unroll
                    for (int n = 0; n < 2; ++n) acc[a][b][m][n] = (f32x4){0.f, 0.f, 0.f, 0.f};
        cur = nxt; cA = nA; cB = nB; ++ui;
        if constexpr (ALIGN_EPI) { if (wr == 1) PG8_BAR; }
    }
    PG8_WAIT_V(0);
    if constexpr (!ALIGN_EPI) { if (wr == 0) PG8_BAR; }
    PG8_BAR;
    if constexpr (Epi::AFTER_DRAIN) { E.fused(acc, cur, wr, wc, fr, fq, lds, wid, lane); S.done(cur); }
#undef PG8_SA
#undef PG8_SB
#undef PG8_STAGE
#undef PG8_LDA
#undef PG8_LDB
#undef PG8_MMA
#undef PG8_WAIT_V
#undef PG8_WAIT_L
#undef PG8_BAR
#undef PG8_SCHED
}
}

namespace nsa {
#define NLAS __attribute__((address_space(3)))
typedef short bf16x8 __attribute__((ext_vector_type(8)));
typedef short s16x4 __attribute__((ext_vector_type(4)));
typedef short v4i16_t __attribute__((ext_vector_type(4)));
typedef float f32x4 __attribute__((ext_vector_type(4)));
typedef unsigned u32x4 __attribute__((ext_vector_type(4)));
typedef unsigned u32x2 __attribute__((ext_vector_type(2)));
typedef unsigned long long u64;
constexpr int RS = 144, TILE_B = 64 * RS;
constexpr float LOG2E = 1.4426950408889634f;
constexpr int L_KB0 = 0, L_VB0 = TILE_B, L_KB1 = 2 * TILE_B, L_VB1 = 3 * TILE_B, L_CK = 4 * TILE_B, L_CV = 8 * TILE_B, L_IMP = 12 * TILE_B, L_MSK = L_IMP + 8192, L_WU = L_MSK + 256, L_END = L_WU + 64;
static_assert(L_END <= 131072, "nsa LDS map");
__device__ __forceinline__ s16x4 vtr(const NLAS char* p) { return __builtin_bit_cast(s16x4, __builtin_amdgcn_ds_read_tr16_b64_v4i16((NLAS v4i16_t*)p)); }
__device__ __forceinline__ f32x4 mfma16(bf16x8 a, bf16x8 b, f32x4 c) { return __builtin_amdgcn_mfma_f32_16x16x32_bf16(a, b, c, 0, 0, 0); }
__device__ __forceinline__ unsigned pkbf(float lo, float hi) { return pg8::cvt_pk_bf16(lo, hi); }
__device__ __forceinline__ void qk_tile(f32x4 (&s)[4], const NLAS char* Kb, const bf16x8 (&qf)[2], int i, int g) {
#pragma unroll
    for (int kb = 0; kb < 4; ++kb) { const NLAS char* kp = Kb + (kb * 16 + i) * RS + 16 * g;
        const bf16x8 a0 = *(const NLAS bf16x8*)kp, a1 = *(const NLAS bf16x8*)(kp + 64);
        f32x4 acc = (f32x4){0.f, 0.f, 0.f, 0.f}; acc = mfma16(a0, qf[0], acc); acc = mfma16(a1, qf[1], acc); s[kb] = acc; }
}
__device__ __forceinline__ void pv_tile(f32x4 (&o)[4], const NLAS char* Vb, const f32x4 (&p)[4], int i, int g) {
    const NLAS char* vb = Vb + (4 * g + (i >> 2)) * RS + (i & 3) * 8;
#pragma unroll
    for (int kk = 0; kk < 2; ++kk) {
        u32x4 pw; pw.x = pkbf(p[2 * kk][0], p[2 * kk][1]); pw.y = pkbf(p[2 * kk][2], p[2 * kk][3]); pw.z = pkbf(p[2 * kk + 1][0], p[2 * kk + 1][1]); pw.w = pkbf(p[2 * kk + 1][2], p[2 * kk + 1][3]);
        const bf16x8 pf = __builtin_bit_cast(bf16x8, pw);
#pragma unroll
        for (int db = 0; db < 4; ++db) { const NLAS char* vp = vb + (2 * kk) * 16 * RS + db * 32;
            const s16x4 lo = vtr(vp), hi = vtr(vp + 16 * RS);
            const bf16x8 vf = (bf16x8){lo[0], lo[1], lo[2], lo[3], hi[0], hi[1], hi[2], hi[3]};
            o[db] = mfma16(vf, pf, o[db]); }
    }
}
__device__ __forceinline__ void online_tile(f32x4 (&s)[4], float& m, float& l, f32x4 (&o)[4], float kslope, float c, int base, int lo, int hi) {
    float mt = -INFINITY; const float bf = (float)base;
#pragma unroll
    for (int kb = 0; kb < 4; ++kb)
#pragma unroll
        for (int r = 0; r < 4; ++r) { const int pos = base + kb * 16 + r; float v = fmaf(s[kb][r], LOG2E, fmaf(kslope, bf + (float)(kb * 16 + r), c));
            v = (pos >= lo && pos <= hi) ? v : -INFINITY; s[kb][r] = v; mt = fmaxf(mt, v); }
    mt = fmaxf(mt, __shfl_xor(mt, 16)); mt = fmaxf(mt, __shfl_xor(mt, 32));
    const float mn = fmaxf(m, mt), ms = (mn == -INFINITY) ? 0.f : mn;
    const float alpha = __builtin_amdgcn_exp2f(m - ms);
    float sum = 0.f;
#pragma unroll
    for (int kb = 0; kb < 4; ++kb)
#pragma unroll
        for (int r = 0; r < 4; ++r) { const float p = __builtin_amdgcn_exp2f(s[kb][r] - ms); s[kb][r] = p; sum += p; }
    l = l * alpha + sum; m = mn;
#pragma unroll
    for (int db = 0; db < 4; ++db) o[db] = o[db] * alpha;
}
struct Stg { u32x4 k, v; };
__device__ __forceinline__ void stg_load(Stg& r, const bf16_t* kb, const bf16_t* vb, size_t pitch, int tid) { const size_t off = (size_t)(tid >> 3) * pitch + (tid & 7) * 8; r.k = *(const u32x4*)(kb + off); r.v = *(const u32x4*)(vb + off); }
__device__ __forceinline__ void stg_store(NLAS char* lds, int ko, int vo, const Stg& r, int tid) { const int off = (tid >> 3) * RS + (tid & 7) * 16; *(NLAS u32x4*)(lds + ko + off) = r.k; *(NLAS u32x4*)(lds + vo + off) = r.v; }
__device__ __forceinline__ float sigm(float v) { return __builtin_amdgcn_rcpf(1.f + __expf(-v)); }

__device__ __forceinline__ void unit(NLAS char* lds, const bf16_t* P, const float* S32, const bf16_t* KC, const bf16_t* VC, bf16_t* Ynsa, int b, int gq, int ti) {
    const int tid = threadIdx.x, lane = tid & 63, w = __builtin_amdgcn_readfirstlane(tid >> 6), i = lane & 15, g = lane >> 4;
    const int t0 = ti * 32, tl_mine = i >> 2, r = i & 3, h = gq * 4 + r, t = t0 + 4 * w + tl_mine; const size_t m = (size_t)b * T + t;
    const float slope2 = __builtin_amdgcn_exp2f(-(float)(h + 1)) * LOG2E;
    bf16x8 qf[2];
    { const bf16_t* qp = P + m * PW + P_NSQ + h * 64 + 8 * g;
#pragma unroll
      for (int ks = 0; ks < 2; ++ks) { const u32x4 raw = *(const u32x4*)(qp + 32 * ks); u32x4 sc;
          sc.x = pkbf(pg8::bflo(raw.x) * 0.125f, pg8::bfhi(raw.x) * 0.125f); sc.y = pkbf(pg8::bflo(raw.y) * 0.125f, pg8::bfhi(raw.y) * 0.125f);
          sc.z = pkbf(pg8::bflo(raw.z) * 0.125f, pg8::bfhi(raw.z) * 0.125f); sc.w = pkbf(pg8::bflo(raw.w) * 0.125f, pg8::bfhi(raw.w) * 0.125f);
          qf[ks] = __builtin_bit_cast(bf16x8, sc); } }
    const float* gp = S32 + m * 32 + 8 + h * 3;
    const float gate0 = sigm(gp[0]), gate1 = sigm(gp[1]), gate2 = sigm(gp[2]);
    f32x4 outacc[4];
#pragma unroll
    for (int db = 0; db < 4; ++db) outacc[db] = (f32x4){0.f, 0.f, 0.f, 0.f};
    const int ntc = (ti >> 5) + 1;
    for (int tile = 0; tile < ntc; ++tile) { Stg sr; const size_t row0 = ((size_t)(b * 256 + tile * 64) * 2 + gq) * 64; stg_load(sr, KC + row0, VC + row0, 128, tid); stg_store(lds, L_CK + tile * TILE_B, L_CV + tile * TILE_B, sr, tid); }
    __syncthreads();
    { const int nmax = (t - 31) >> 4; const float kslope = 16.f * slope2, c = -slope2 * (float)(t - 31);
      float mc = -INFINITY, lc = 0.f;
#pragma unroll 1
      for (int tile = 0; tile < ntc; ++tile) { f32x4 s[4]; qk_tile(s, lds + L_CK + tile * TILE_B, qf, i, g);
          float mt = -INFINITY;
#pragma unroll
          for (int kb = 0; kb < 4; ++kb)
#pragma unroll
              for (int rr = 0; rr < 4; ++rr) { const int n = tile * 64 + kb * 16 + 4 * g + rr; float v = fmaf(s[kb][rr], LOG2E, fmaf(kslope, (float)n, c)); v = (n <= nmax) ? v : -INFINITY; s[kb][rr] = v; mt = fmaxf(mt, v); }
          mt = fmaxf(mt, __shfl_xor(mt, 16)); mt = fmaxf(mt, __shfl_xor(mt, 32));
          const float mn = fmaxf(mc, mt), ms = (mn == -INFINITY) ? 0.f : mn; float sum = 0.f;
#pragma unroll
          for (int kb = 0; kb < 4; ++kb)
#pragma unroll
              for (int rr = 0; rr < 4; ++rr) sum += __builtin_amdgcn_exp2f(s[kb][rr] - ms);
          lc = lc * __builtin_amdgcn_exp2f(mc - ms) + sum; mc = mn; }
      lc += __shfl_xor(lc, 16); lc += __shfl_xor(lc, 32);
      const float ms = (mc == -INFINITY) ? 0.f : mc, inv = lc > 0.f ? 1.f / lc : 0.f;
      f32x4 oc[4];
#pragma unroll
      for (int db = 0; db < 4; ++db) oc[db] = (f32x4){0.f, 0.f, 0.f, 0.f};
      NLAS float* imp_s = (NLAS float*)(lds + L_IMP) + (w * 4 + tl_mine) * 64;
      float cprev = 0.f;
#pragma unroll 1
      for (int tile = 0; tile < 4; ++tile) {
          if (tile < ntc) { f32x4 s[4]; qk_tile(s, lds + L_CK + tile * TILE_B, qf, i, g);
#pragma unroll
              for (int kb = 0; kb < 4; ++kb)
#pragma unroll
                  for (int rr = 0; rr < 4; ++rr) { const int n = tile * 64 + kb * 16 + 4 * g + rr; float v = fmaf(s[kb][rr], LOG2E, fmaf(kslope, (float)n, c)); v = (n <= nmax) ? v : -INFINITY; s[kb][rr] = __builtin_amdgcn_exp2f(v - ms) * inv; }
              pv_tile(oc, lds + L_CV + tile * TILE_B, s, i, g);
#pragma unroll
              for (int kb = 0; kb < 4; ++kb) { const f32x4 pv = s[kb];
                  float a = (pv[0] + pv[1]) + (pv[2] + pv[3]), cc = pv[3];
                  a += __shfl_xor(a, 1); a += __shfl_xor(a, 2); cc += __shfl_xor(cc, 1); cc += __shfl_xor(cc, 2);
                  const float up = __shfl(cc, (lane + 48) & 63);
                  const float im = a + (g > 0 ? up : cprev); cprev = up;
                  if (r == 0) imp_s[4 * (tile * 4 + kb) + g] = im; }
          } else { if (r == 0) {
#pragma unroll
              for (int kb = 0; kb < 4; ++kb) imp_s[4 * (tile * 4 + kb) + g] = 0.f; } }
      }
#pragma unroll
      for (int db = 0; db < 4; ++db) outacc[db] = outacc[db] + oc[db] * gate0;
    }
    __syncthreads();
    NLAS float* impw = (NLAS float*)(lds + L_IMP) + w * 256;
    float myscore[4];
#pragma unroll
    for (int tl = 0; tl < 4; ++tl) { const int tt = t0 + 4 * w + tl, cur = tt >> 6, j = lane; const bool valid = j <= cur, forced = (j == 0) || (j == cur) || (j == cur - 1);
        const float s = valid ? impw[tl * 64 + j] + (forced ? 1000.f : 0.f) : -1e30f; myscore[tl] = s; }
    __syncthreads();
#pragma unroll
    for (int tl = 0; tl < 4; ++tl) impw[tl * 64 + lane] = myscore[tl];
    __syncthreads();
    u64 wmask[4], wun = 0ull;
#pragma unroll
    for (int tl = 0; tl < 4; ++tl) { const int tt = t0 + 4 * w + tl, cur = tt >> 6; const float s = myscore[tl]; int rank = 0;
        for (int jj = 0; jj < 64; ++jj) { const float o = impw[tl * 64 + jj]; rank += (o > s || (o == s && jj < lane)) ? 1 : 0; }
        wmask[tl] = __ballot(rank < 16 && lane <= cur); wun |= wmask[tl]; }
    if (lane == 0) { NLAS u64* mk = (NLAS u64*)(lds + L_MSK) + w * 4; mk[0] = wmask[0]; mk[1] = wmask[1]; mk[2] = wmask[2]; mk[3] = wmask[3]; ((NLAS u64*)(lds + L_WU))[w] = wun; }
    __syncthreads();
    const u64 mymask = ((const NLAS u64*)(lds + L_MSK))[w * 4 + tl_mine];
    u64 uall = 0ull;
#pragma unroll
    for (int ww = 0; ww < 8; ++ww) uall |= ((const NLAS u64*)(lds + L_WU))[ww];
    uall = ((u64)__builtin_amdgcn_readfirstlane((unsigned)(uall >> 32)) << 32) | (u64)__builtin_amdgcn_readfirstlane((unsigned)uall);
    const size_t rowb = (size_t)b * T;
    {
        float ms_ = -INFINITY, ls = 0.f; f32x4 os[4];
#pragma unroll
        for (int db = 0; db < 4; ++db) os[db] = (f32x4){0.f, 0.f, 0.f, 0.f};
        const bf16_t* kcol = P + rowb * PW + P_KS + gq * 64; const bf16_t* vcol = P + rowb * PW + P_VS + gq * 64;
        const float c = -slope2 * (float)t;
        u64 rem = uall; int j = __builtin_ctzll(rem); rem &= rem - 1; int cur = 0;
        { Stg sr; stg_load(sr, kcol + (size_t)j * 64 * PW, vcol + (size_t)j * 64 * PW, PW, tid); stg_store(lds, L_KB0, L_VB0, sr, tid); }
        __syncthreads();
        for (;;) {
            const int jn = rem ? __builtin_ctzll(rem) : -1; rem &= rem - 1;
            Stg sr; if (jn >= 0) stg_load(sr, kcol + (size_t)jn * 64 * PW, vcol + (size_t)jn * 64 * PW, PW, tid);
            if ((wun >> j) & 1ull) { f32x4 s[4]; qk_tile(s, lds + (cur ? L_KB1 : L_KB0), qf, i, g);
                online_tile(s, ms_, ls, os, slope2, c, j * 64 + 4 * g, 0, ((mymask >> j) & 1ull) ? t : -1);
                pv_tile(os, lds + (cur ? L_VB1 : L_VB0), s, i, g); }
            if (jn >= 0) stg_store(lds, cur ? L_KB0 : L_KB1, cur ? L_VB0 : L_VB1, sr, tid);
            __syncthreads();
            if (jn < 0) break;
            j = jn; cur ^= 1;
        }
        ls += __shfl_xor(ls, 16); ls += __shfl_xor(ls, 32);
        const float sc1 = gate1 / ls;
#pragma unroll
        for (int db = 0; db < 4; ++db) outacc[db] = outacc[db] + os[db] * sc1;
    }
    {
        float mw = -INFINITY, lw = 0.f; f32x4 ow[4];
#pragma unroll
        for (int db = 0; db < 4; ++db) ow[db] = (f32x4){0.f, 0.f, 0.f, 0.f};
        const bf16_t* kcol = P + rowb * PW + P_KW + gq * 64; const bf16_t* vcol = P + rowb * PW + P_VW + gq * 64;
        const float c = -slope2 * (float)t;
        const int j0 = (t0 - 511) > 0 ? ((t0 - 511) >> 6) : 0, j1 = t0 >> 6, tw0 = t0 + 4 * w;
        int j = j0, cur = 0;
        { Stg sr; stg_load(sr, kcol + (size_t)j * 64 * PW, vcol + (size_t)j * 64 * PW, PW, tid); stg_store(lds, L_KB0, L_VB0, sr, tid); }
        __syncthreads();
        for (;;) {
            const int jn = (j < j1) ? j + 1 : -1;
            Stg sr; if (jn >= 0) stg_load(sr, kcol + (size_t)jn * 64 * PW, vcol + (size_t)jn * 64 * PW, PW, tid);
            if (64 * j <= tw0 + 3 && 64 * j + 63 >= tw0 - 511) { f32x4 s[4]; qk_tile(s, lds + (cur ? L_KB1 : L_KB0), qf, i, g);
                online_tile(s, mw, lw, ow, slope2, c, j * 64 + 4 * g, t - 511, t);
                pv_tile(ow, lds + (cur ? L_VB1 : L_VB0), s, i, g); }
            if (jn >= 0) stg_store(lds, cur ? L_KB0 : L_KB1, cur ? L_VB0 : L_VB1, sr, tid);
            __syncthreads();
            if (jn < 0) break;
            j = jn; cur ^= 1;
        }
        lw += __shfl_xor(lw, 16); lw += __shfl_xor(lw, 32);
        const float sc2 = gate2 / lw;
#pragma unroll
        for (int db = 0; db < 4; ++db) outacc[db] = outacc[db] + ow[db] * sc2;
    }
    bf16_t* yo = Ynsa + m * 512 + h * 64 + 4 * g;
#pragma unroll
    for (int db = 0; db < 4; ++db) { u32x2 v; v.x = pkbf(outacc[db][0], outacc[db][1]); v.y = pkbf(outacc[db][2], outacc[db][3]); *(u32x2*)(yo + db * 16) = v; }
}
__device__ __forceinline__ void phase(NLAS char* lds, const bf16_t* P, const float* S32, const bf16_t* KC, const bf16_t* VC, bf16_t* Ynsa) {
    const int G = gridDim.x, bid = blockIdx.x;
    if (G == 256) { const int base = bid >> 3, bg = bid & 7;
#pragma unroll 1
        for (int k = 0; k < 4; ++k) { const int ti = (k == 0) ? 127 - base : (k == 1) ? 64 + base : (k == 2) ? 63 - base : base; unit(lds, P, S32, KC, VC, Ynsa, bg >> 1, bg & 1, ti); } }
    else {
#pragma unroll 1
        for (int u = bid; u < 1024; u += G) unit(lds, P, S32, KC, VC, Ynsa, (u & 7) >> 1, u & 1, 127 - (u >> 3)); }
}
}

namespace xa {
using nsa::bf16x8; using nsa::s16x4; using nsa::f32x4; using nsa::u32x4; using nsa::u32x2; using nsa::vtr; using nsa::mfma16; using nsa::pkbf;
constexpr int RS = 272, TILE_B = 64 * RS;
constexpr int L_K0 = 0, L_V0 = TILE_B, L_K1 = 2 * TILE_B, L_V1 = 3 * TILE_B;
struct Stg { u32x4 k0, k1, v0, v1; };
__device__ __forceinline__ void stg_load(Stg& r, const bf16_t* kb, int tid) { const bf16_t* p = kb + (size_t)(tid >> 3) * 1024 + (tid & 7) * 8;
    r.k0 = *(const u32x4*)p; r.k1 = *(const u32x4*)(p + 64); r.v0 = *(const u32x4*)(p + 512); r.v1 = *(const u32x4*)(p + 576); }
__device__ __forceinline__ void stg_store(NLAS char* lds, int ko, int vo, const Stg& r, int tid) { const int off = (tid >> 3) * RS + (tid & 7) * 16;
    *(NLAS u32x4*)(lds + ko + off) = r.k0; *(NLAS u32x4*)(lds + ko + off + 128) = r.k1; *(NLAS u32x4*)(lds + vo + off) = r.v0; *(NLAS u32x4*)(lds + vo + off + 128) = r.v1; }
__device__ __forceinline__ void unit(NLAS char* lds, const bf16_t* P, const bf16_t* MEMKV, bf16_t* Yxa, int b, int h, int tt) {
    const int tid = threadIdx.x, lane = tid & 63, w = __builtin_amdgcn_readfirstlane(tid >> 6), i = lane & 15, g = lane >> 4;
    const size_t m = (size_t)b * T + tt * 128 + 16 * w + i;
    bf16x8 qf[4];
    { const bf16_t* qp = P + m * PW + P_XAQ + h * 128 + 8 * g;
#pragma unroll
      for (int ks = 0; ks < 4; ++ks) qf[ks] = *(const bf16x8*)(qp + 32 * ks); }
    const float scale2 = 0.08838834764831845f * nsa::LOG2E;
    float mx = -INFINITY, l = 0.f; f32x4 o[8];
#pragma unroll
    for (int db = 0; db < 8; ++db) o[db] = (f32x4){0.f, 0.f, 0.f, 0.f};
    const bf16_t* kbase = MEMKV + (size_t)b * 256 * 1024 + h * 128;
    { Stg sr; stg_load(sr, kbase, tid); stg_store(lds, L_K0, L_V0, sr, tid); }
    __syncthreads();
#pragma unroll 1
    for (int tile = 0; tile < 4; ++tile) { const int cur = tile & 1;
        Stg sr; if (tile < 3) stg_load(sr, kbase + (size_t)(tile + 1) * 64 * 1024, tid);
        const NLAS char* Kb = lds + (cur ? L_K1 : L_K0); const NLAS char* Vb = lds + (cur ? L_V1 : L_V0);
        f32x4 s[4];
#pragma unroll
        for (int kb = 0; kb < 4; ++kb) { const NLAS char* kp = Kb + (kb * 16 + i) * RS + 16 * g; f32x4 acc = (f32x4){0.f, 0.f, 0.f, 0.f};
#pragma unroll
            for (int ks = 0; ks < 4; ++ks) acc = mfma16(*(const NLAS bf16x8*)(kp + 64 * ks), qf[ks], acc);
            s[kb] = acc; }
        float mt = -INFINITY;
#pragma unroll
        for (int kb = 0; kb < 4; ++kb)
#pragma unroll
            for (int r = 0; r < 4; ++r) { const float v = s[kb][r] * scale2; s[kb][r] = v; mt = fmaxf(mt, v); }
        mt = fmaxf(mt, __shfl_xor(mt, 16)); mt = fmaxf(mt, __shfl_xor(mt, 32));
        const float mn = fmaxf(mx, mt), alpha = __builtin_amdgcn_exp2f(mx - mn); float sum = 0.f;
#pragma unroll
        for (int kb = 0; kb < 4; ++kb)
#pragma unroll
            for (int r = 0; r < 4; ++r) { const float p = __builtin_amdgcn_exp2f(s[kb][r] - mn); s[kb][r] = p; sum += p; }
        l = l * alpha + sum; mx = mn;
#pragma unroll
        for (int db = 0; db < 8; ++db) o[db] = o[db] * alpha;
        const NLAS char* vb = Vb + (4 * g + (i >> 2)) * RS + (i & 3) * 8;
#pragma unroll
        for (int kk = 0; kk < 2; ++kk) {
            u32x4 pw; pw.x = pkbf(s[2 * kk][0], s[2 * kk][1]); pw.y = pkbf(s[2 * kk][2], s[2 * kk][3]); pw.z = pkbf(s[2 * kk + 1][0], s[2 * kk + 1][1]); pw.w = pkbf(s[2 * kk + 1][2], s[2 * kk + 1][3]);
            const bf16x8 pf = __builtin_bit_cast(bf16x8, pw);
#pragma unroll
            for (int db = 0; db < 8; ++db) { const NLAS char* vp = vb + (2 * kk) * 16 * RS + db * 32; const s16x4 lo = vtr(vp), hi = vtr(vp + 16 * RS);
                o[db] = mfma16((bf16x8){lo[0], lo[1], lo[2], lo[3], hi[0], hi[1], hi[2], hi[3]}, pf, o[db]); }
        }
        if (tile < 3) stg_store(lds, cur ? L_K0 : L_K1, cur ? L_V0 : L_V1, sr, tid);
        __syncthreads();
    }
    l += __shfl_xor(l, 16); l += __shfl_xor(l, 32);
    const float inv = 1.f / l;
    bf16_t* yo = Yxa + m * 512 + h * 128 + 4 * g;
#pragma unroll
    for (int db = 0; db < 8; ++db) { u32x2 v; v.x = pkbf(o[db][0] * inv, o[db][1] * inv); v.y = pkbf(o[db][2] * inv, o[db][3] * inv); *(u32x2*)(yo + db * 16) = v; }
}
__device__ __forceinline__ void phase(NLAS char* lds, const bf16_t* P, const bf16_t* MEMKV, bf16_t* Yxa) {
#pragma unroll 1
    for (int u = blockIdx.x; u < 512; u += gridDim.x) unit(lds, P, MEMKV, Yxa, u >> 7, (u >> 5) & 3, u & 31);
}
}

namespace ml {
using nsa::bf16x8; using nsa::s16x4; using nsa::f32x4; using nsa::u32x4; using nsa::u32x2; using nsa::vtr; using nsa::mfma16; using nsa::pkbf;
constexpr int RS = 272, TB = 64 * RS, RSS = 144;
constexpr float KSCALE = 0.08838834764831845f;
__device__ __forceinline__ float scan_add(float v, int lane) {
#pragma unroll
    for (int o = 1; o < 64; o <<= 1) { const float u = __shfl_up(v, o); if (lane >= o) v += u; }
    return v; }
__device__ __forceinline__ float scan_max(float v, int lane) {
#pragma unroll
    for (int o = 1; o < 64; o <<= 1) { const float u = __shfl_up(v, o); if (lane >= o) v = fmaxf(v, u); }
    return v; }
__device__ __forceinline__ bf16x8 trpair(const NLAS char* p, int hi_off) { const s16x4 lo = vtr(p), hi = vtr(p + hi_off); return (bf16x8){lo[0], lo[1], lo[2], lo[3], hi[0], hi[1], hi[2], hi[3]}; }
__device__ __forceinline__ void load_conv(NLAS char* dst, const bf16_t* P, const float* cw, int colP, int cwc, size_t m0, int tseq0, int tid) {
    const int s = tid >> 3, c16 = (tid & 7) * 16;
#pragma unroll
    for (int half = 0; half < 2; ++half) { const int c = c16 + half * 8; float acc[8];
#pragma unroll
        for (int e = 0; e < 8; ++e) acc[e] = 0.f;
#pragma unroll
        for (int j = 0; j < 4; ++j) { if (tseq0 + s - j >= 0) { const u32x4 raw = *(const u32x4*)(P + (m0 + s - j) * PW + colP + c);
            const f32x4 w0 = *(const f32x4*)(cw + j * 1024 + cwc + c), w1 = *(const f32x4*)(cw + j * 1024 + cwc + c + 4);
            acc[0] += w0[0] * pg8::bflo(raw.x); acc[1] += w0[1] * pg8::bfhi(raw.x); acc[2] += w0[2] * pg8::bflo(raw.y); acc[3] += w0[3] * pg8::bfhi(raw.y);
            acc[4] += w1[0] * pg8::bflo(raw.z); acc[5] += w1[1] * pg8::bfhi(raw.z); acc[6] += w1[2] * pg8::bflo(raw.w); acc[7] += w1[3] * pg8::bfhi(raw.w); } }
#pragma unroll
        for (int e = 0; e < 8; ++e) acc[e] = acc[e] * __builtin_amdgcn_rcpf(1.f + __expf(-acc[e]));
        u32x4 o; o.x = pkbf(acc[0], acc[1]); o.y = pkbf(acc[2], acc[3]); o.z = pkbf(acc[4], acc[5]); o.w = pkbf(acc[6], acc[7]);
        *(NLAS u32x4*)(dst + s * RS + c * 2) = o; }
}
__device__ __forceinline__ void m1_unit(NLAS char* lds, const bf16_t* P, const float* cw, const float* S32, float* Abuf, float* NA, float* Gc, float* Mloc, int ci) {
    constexpr int L_K = 0, L_EV = TB, L_E = 2 * TB;
    const int tid = threadIdx.x, lane = tid & 63, w = __builtin_amdgcn_readfirstlane(tid >> 6), i = lane & 15, g = lane >> 4;
    const int c = ci & 63, bh = ci >> 6, h = bh & 3, b = bh >> 2; const size_t m0 = (size_t)b * T + c * 64;
    NLAS float* eS = (NLAS float*)(lds + L_E);
    if (w == 0) { const float fpre = S32[(m0 + lane) * 32 + 4 + h], ipre = S32[(m0 + lane) * 32 + h];
        const float bcs = scan_add(logsig(fpre), lane), gtot = __shfl(bcs, 63), wend = gtot - bcs + ipre, mloc = wave_max(wend);
        eS[lane] = __expf(wend - mloc) * KSCALE; if (lane == 0) { Gc[ci] = gtot; Mloc[ci] = mloc; } }
    load_conv(lds + L_K, P, cw, P_MLK + h * 128, 512 + h * 128, m0, c * 64, tid);
    __syncthreads();
    { const int s = tid >> 3, c16 = (tid & 7) * 16; const float es = eS[s]; const bf16_t* vp = P + (m0 + s) * PW + P_MLV + h * 128 + c16;
#pragma unroll
      for (int half = 0; half < 2; ++half) { const u32x4 raw = *(const u32x4*)(vp + half * 8); u32x4 o;
          o.x = pkbf(pg8::bflo(raw.x) * es, pg8::bfhi(raw.x) * es); o.y = pkbf(pg8::bflo(raw.y) * es, pg8::bfhi(raw.y) * es);
          o.z = pkbf(pg8::bflo(raw.z) * es, pg8::bfhi(raw.z) * es); o.w = pkbf(pg8::bflo(raw.w) * es, pg8::bfhi(raw.w) * es);
          *(NLAS u32x4*)(lds + L_EV + s * RS + (c16 + half * 8) * 2) = o; } }
    __syncthreads();
    f32x4 acc[8];
#pragma unroll
    for (int vb = 0; vb < 8; ++vb) acc[vb] = (f32x4){0.f, 0.f, 0.f, 0.f};
    const int rowoff = (4 * g + (i >> 2)) * RS + (i & 3) * 8;
#pragma unroll
    for (int kk = 0; kk < 2; ++kk) { const bf16x8 kf = trpair(lds + L_K + kk * 32 * RS + rowoff + w * 32, 16 * RS);
#pragma unroll
        for (int vb = 0; vb < 8; ++vb) acc[vb] = mfma16(trpair(lds + L_EV + kk * 32 * RS + rowoff + vb * 32, 16 * RS), kf, acc[vb]); }
    float* ap = Abuf + ((size_t)ci * 128 + w * 16 + i) * 128 + 4 * g;
#pragma unroll
    for (int vb = 0; vb < 8; ++vb) *(f32x4*)(ap + vb * 16) = acc[vb];
    if (tid < 128) { float n = 0.f; for (int s = 0; s < 64; ++s) n += eS[s] * bf2f(*(const NLAS bf16_t*)(lds + L_K + s * RS + tid * 2)); NA[(size_t)ci * 128 + tid] = n; }
    __syncthreads();
}
__device__ __forceinline__ void m2_items(float* Abuf, float* NA, const float* Gc, const float* Mloc, float* Mprev) {
    typedef float f32x2 __attribute__((ext_vector_type(2)));
    for (int it = blockIdx.x * blockDim.x + threadIdx.x; it < 16 * 128 * 64; it += gridDim.x * blockDim.x) {
        const int bh = it >> 13, kv2 = it & 8191, k = kv2 >> 6, v2 = kv2 & 63;
        f32x2 C = (f32x2){0.f, 0.f}; float n = 0.f, m = 0.f;
#pragma unroll 1
        for (int c0 = 0; c0 < 64; c0 += 8) { f32x2 A[8];
#pragma unroll
            for (int u = 0; u < 8; ++u) A[u] = *(const f32x2*)(Abuf + ((size_t)(bh * 64 + c0 + u) * 128 + k) * 128 + v2 * 2);
#pragma unroll
            for (int u = 0; u < 8; ++u) { const int ci = bh * 64 + c0 + u; const float gg = Gc[ci], ml = Mloc[ci];
                const float mn = fmaxf(gg + m, ml), a = __expf(gg + m - mn), bb = __expf(ml - mn);
                *(f32x2*)(Abuf + ((size_t)ci * 128 + k) * 128 + v2 * 2) = C; C = C * a + A[u] * bb;
                if (v2 == 0) { const float nA = NA[(size_t)ci * 128 + k]; NA[(size_t)ci * 128 + k] = n; n = a * n + bb * nA; }
                if (kv2 == 0) Mprev[ci] = m;
                m = mn; } }
    }
}
__device__ __forceinline__ void m3_unit(NLAS char* lds, const bf16_t* P, const float* cw, const float* S32, const float* Cprev, const float* Nprev, const float* Mprev, const float* normg, bf16_t* Yml, int ci) {
    constexpr int L_Q = 0, L_K = TB, L_V = 2 * TB, L_C = 3 * TB, L_S = 5 * TB, L_F = L_S + 64 * RSS;
    const int tid = threadIdx.x, lane = tid & 63, w = __builtin_amdgcn_readfirstlane(tid >> 6), i = lane & 15, g = lane >> 4;
    const int c = ci & 63, bh = ci >> 6, h = bh & 3, b = bh >> 2; const size_t m0 = (size_t)b * T + c * 64;
    NLAS float* F = (NLAS float*)(lds + L_F);
    NLAS float* rowf = F; NLAS float* colf = F + 64; NLAS float* scv = F + 128; NLAS float* emt = F + 192; NLAS float* qn = F + 256; NLAS float* nprev = F + 320; NLAS float* denp = F + 448; NLAS float* ssq = F + 576;
    if (w == 0) { const float fpre = S32[(m0 + lane) * 32 + 4 + h], ipre = S32[(m0 + lane) * 32 + h], mprev = Mprev[ci];
        const float bcs = scan_add(logsig(fpre), lane), u = ipre - bcs, pm = scan_max(u, lane), mt = bcs + fmaxf(mprev, pm);
        rowf[lane] = bcs - mt; colf[lane] = u; scv[lane] = __expf(bcs + mprev - mt); emt[lane] = __expf(-mt); }
    else if (w <= 2) nprev[tid - 64] = Nprev[(size_t)ci * 128 + tid - 64];
    load_conv(lds + L_Q, P, cw, P_MLQ + h * 128, h * 128, m0, c * 64, tid);
    load_conv(lds + L_K, P, cw, P_MLK + h * 128, 512 + h * 128, m0, c * 64, tid);
    { const int s = tid >> 3, c16 = (tid & 7) * 16; const bf16_t* vp = P + (m0 + s) * PW + P_MLV + h * 128 + c16;
      *(NLAS u32x4*)(lds + L_V + s * RS + c16 * 2) = *(const u32x4*)vp; *(NLAS u32x4*)(lds + L_V + s * RS + c16 * 2 + 16) = *(const u32x4*)(vp + 8); }
    { const int k = tid >> 2, v0 = (tid & 3) * 32; const float* cp = Cprev + ((size_t)ci * 128 + k) * 128 + v0;
#pragma unroll
      for (int q8 = 0; q8 < 4; ++q8) { const f32x4 a = *(const f32x4*)(cp + q8 * 8), bq = *(const f32x4*)(cp + q8 * 8 + 4); u32x4 o;
          o.x = pkbf(a[0], a[1]); o.y = pkbf(a[2], a[3]); o.z = pkbf(bq[0], bq[1]); o.w = pkbf(bq[2], bq[3]); *(NLAS u32x4*)(lds + L_C + k * RS + (v0 + q8 * 8) * 2) = o; } }
    __syncthreads();
    if (tid < 64) { float a = 0.f; for (int k = 0; k < 128; ++k) a += bf2f(*(const NLAS bf16_t*)(lds + L_Q + tid * RS + k * 2)) * nprev[k]; qn[tid] = a; }
    const int tb = w >> 1;
    {
        float rs[4] = {0.f, 0.f, 0.f, 0.f};
#pragma unroll
        for (int sbi = 0; sbi < 2; ++sbi) { const int sb = 2 * (w & 1) + sbi; f32x4 acc = (f32x4){0.f, 0.f, 0.f, 0.f};
            if (sb <= tb) {
#pragma unroll
                for (int ks = 0; ks < 4; ++ks) acc = mfma16(*(const NLAS bf16x8*)(lds + L_Q + (tb * 16 + i) * RS + (32 * ks + 8 * g) * 2), *(const NLAS bf16x8*)(lds + L_K + (sb * 16 + i) * RS + (32 * ks + 8 * g) * 2), acc); }
            const int s = sb * 16 + i; const float cf = colf[s];
#pragma unroll
            for (int r = 0; r < 4; ++r) { const int t = tb * 16 + 4 * g + r; const float v = (s <= t) ? acc[r] * KSCALE * __expf(rowf[t] + cf) : 0.f; rs[r] += v;
                *(NLAS bf16_t*)(lds + L_S + t * RSS + s * 2) = f2bf(v); } }
#pragma unroll
        for (int r = 0; r < 4; ++r) { float x = rs[r]; x += __shfl_xor(x, 1); x += __shfl_xor(x, 2); x += __shfl_xor(x, 4); x += __shfl_xor(x, 8); if (i == 0) denp[(w & 1) * 64 + tb * 16 + 4 * g + r] = x; }
    }
    __syncthreads();
    f32x4 a1[4], a2[4];
#pragma unroll
    for (int vb = 0; vb < 4; ++vb) { a1[vb] = (f32x4){0.f, 0.f, 0.f, 0.f}; a2[vb] = (f32x4){0.f, 0.f, 0.f, 0.f}; }
    const int vb0 = (w & 1) * 4, troff = (8 * g + (i >> 2)) * RS + (i & 3) * 8;
#pragma unroll
    for (int kk = 0; kk < 2; ++kk) { if (32 * kk <= tb * 16 + 15) { const bf16x8 sf = *(const NLAS bf16x8*)(lds + L_S + (tb * 16 + i) * RSS + (32 * kk + 8 * g) * 2);
#pragma unroll
        for (int vb = 0; vb < 4; ++vb) a1[vb] = mfma16(sf, trpair(lds + L_V + kk * 32 * RS + troff + (vb0 + vb) * 32, 4 * RS), a1[vb]); } }
#pragma unroll
    for (int ks = 0; ks < 4; ++ks) { const bf16x8 qf = *(const NLAS bf16x8*)(lds + L_Q + (tb * 16 + i) * RS + (32 * ks + 8 * g) * 2);
#pragma unroll
        for (int vb = 0; vb < 4; ++vb) a2[vb] = mfma16(qf, trpair(lds + L_C + ks * 32 * RS + troff + (vb0 + vb) * 32, 4 * RS), a2[vb]); }
    float hv[4][4], sq[4] = {0.f, 0.f, 0.f, 0.f};
#pragma unroll
    for (int r = 0; r < 4; ++r) { const int t = tb * 16 + 4 * g + r; const float sc = scv[t]; const float den = denp[t] + denp[64 + t] + sc * qn[t]; const float hd = 1.f / fmaxf(fabsf(den), emt[t]);
#pragma unroll
        for (int vb = 0; vb < 4; ++vb) { const float x = (a1[vb][r] + sc * a2[vb][r]) * hd; hv[vb][r] = x; sq[r] += x * x; } }
#pragma unroll
    for (int r = 0; r < 4; ++r) { float x = sq[r]; x += __shfl_xor(x, 1); x += __shfl_xor(x, 2); x += __shfl_xor(x, 4); x += __shfl_xor(x, 8); if (i == 0) ssq[(w & 1) * 64 + tb * 16 + 4 * g + r] = x; }
    __syncthreads();
#pragma unroll
    for (int r = 0; r < 4; ++r) { const int t = tb * 16 + 4 * g + r; const float rinv = rsqrtf((ssq[t] + ssq[64 + t]) * (1.f / 128.f) + EPS);
#pragma unroll
        for (int vb = 0; vb < 4; ++vb) { const int v = (vb0 + vb) * 16 + i; const float o = bf2f(P[(m0 + t) * PW + P_MLO + h * 128 + v]);
            Yml[(m0 + t) * 512 + h * 128 + v] = f2bf(__builtin_amdgcn_rcpf(1.f + __expf(-o)) * hv[vb][r] * rinv * normg[h * 128 + v]); } }
    __syncthreads();
}
}

namespace cmpr {
using nsa::bf16x8; using nsa::f32x4; using nsa::u32x4; using nsa::mfma16; using nsa::pkbf;
constexpr int RSX = 144, L_X = 0, L_PE = 272 * RSX  , L_H = L_PE + 8192, RSH = 528;
__device__ __forceinline__ void unit(NLAS char* lds, const bf16_t* P, const float* pe, const bf16_t* W1t, const bf16_t* W2t, bf16_t* KC, bf16_t* VC, int u) {
    const int tid = threadIdx.x, lane = tid & 63, w = __builtin_amdgcn_readfirstlane(tid >> 6), i = lane & 15, g = lane >> 4;
    const int nt = u & 15, gq = (u >> 4) & 1, b = (u >> 5) & 3, kv = u >> 7;
    const int pcol = (kv ? P_VC : P_KC) + gq * 64, tok0 = 256 * nt;
    for (int ch = tid; ch < 272 * 8; ch += 512) { const int row = ch >> 3, c8 = (ch & 7) * 8, tok = tok0 + row;
        u32x4 v = (u32x4){0u, 0u, 0u, 0u}; if (tok < T) v = *(const u32x4*)(P + ((size_t)b * T + tok) * PW + pcol + c8);
        *(NLAS u32x4*)(lds + L_X + row * RSX + c8 * 2) = v; }
    for (int e = tid; e < 2048; e += 512) ((NLAS float*)(lds + L_PE))[e] = pe[kv * 2048 + e];
    __syncthreads();
    f32x4 acc[2]; acc[0] = (f32x4){0.f, 0.f, 0.f, 0.f}; acc[1] = acc[0];
    const bf16_t* wb = W1t + ((size_t)kv * 256 + 32 * w + i) * 2048 + 8 * g;
#pragma unroll 1
    for (int k0 = 0; k0 < 64; k0 += 8) { bf16x8 bq[8][2];
#pragma unroll
        for (int kk = 0; kk < 8; ++kk) { bq[kk][0] = *(const bf16x8*)(wb + 32 * (k0 + kk)); bq[kk][1] = *(const bf16x8*)(wb + 16 * 2048 + 32 * (k0 + kk)); }
#pragma unroll
        for (int kk = 0; kk < 8; ++kk) { const int ks = k0 + kk, l = ks >> 1, dh = ks & 1;
            const u32x4 raw = *(const NLAS u32x4*)(lds + L_X + (16 * i + l) * RSX + dh * 64 + 16 * g);
            const NLAS float* pp = (const NLAS float*)(lds + L_PE) + l * 64 + dh * 32 + 8 * g; const f32x4 p0 = *(const NLAS f32x4*)pp, p1 = *(const NLAS f32x4*)(pp + 4);
            u32x4 a; a.x = pkbf(pg8::bflo(raw.x) + p0[0], pg8::bfhi(raw.x) + p0[1]); a.y = pkbf(pg8::bflo(raw.y) + p0[2], pg8::bfhi(raw.y) + p0[3]);
            a.z = pkbf(pg8::bflo(raw.z) + p1[0], pg8::bfhi(raw.z) + p1[1]); a.w = pkbf(pg8::bflo(raw.w) + p1[2], pg8::bfhi(raw.w) + p1[3]);
            const bf16x8 af = __builtin_bit_cast(bf16x8, a);
            acc[0] = mfma16(af, bq[kk][0], acc[0]); acc[1] = mfma16(af, bq[kk][1], acc[1]); } }
#pragma unroll
    for (int cb = 0; cb < 2; ++cb)
#pragma unroll
        for (int r = 0; r < 4; ++r) { const float x = acc[cb][r], uu = 0.7978845608028654f * (x + 0.044715f * x * x * x); const float gl = x * __builtin_amdgcn_rcpf(1.f + __expf(-2.f * uu));
            *(NLAS bf16_t*)(lds + L_H + (4 * g + r) * RSH + (32 * w + cb * 16 + i) * 2) = f2bf(gl); }
    __syncthreads();
    if (w < 4) { f32x4 o = (f32x4){0.f, 0.f, 0.f, 0.f}; const bf16_t* w2 = W2t + ((size_t)kv * 64 + 16 * w + i) * 256 + 8 * g;
#pragma unroll
        for (int ks = 0; ks < 8; ++ks) o = mfma16(*(const NLAS bf16x8*)(lds + L_H + i * RSH + (32 * ks + 8 * g) * 2), *(const bf16x8*)(w2 + 32 * ks), o);
        bf16_t* dst = (kv ? VC : KC);
#pragma unroll
        for (int r = 0; r < 4; ++r) dst[((size_t)(b * 256 + 16 * nt + 4 * g + r) * 2 + gq) * 64 + 16 * w + i] = f2bf(o[r]); }
    __syncthreads();
}
}

#define LAS __attribute__((address_space(3)))
constexpr int NTHREADS = 512, LDS_BYTES = 147456;
constexpr size_t WS_WIN = 1 * MiB, WS_WG = 9 * MiB, WS_WBR = 15 * MiB, WS_WOUT = 18 * MiB, WS_WFF1 = 20 * MiB, WS_WFF2 = 28 * MiB, WS_WMKV = 36 * MiB, WS_WC1 = 38 * MiB;
constexpr size_t WS_BIASP = 249 * MiB;
#define XB_TMO      128
#define XB_XCNT(j)  (256  + 64 * (j))
#define XB_XSUB(j)  (1280 + 64 * (j))
#define XB_XGEN(j)  (2304 + 64 * (j))
#define XB_TOP      3328
#define XB_TOPGEN   3392
#define XCD_BAR_WORDS 3456
#define XB_SPIN_CAP (1u << 18)

__device__ __forceinline__ unsigned xb_ld(unsigned* p)              { return __hip_atomic_load(p, __ATOMIC_RELAXED, __HIP_MEMORY_SCOPE_AGENT); }
__device__ __forceinline__ unsigned xb_add(unsigned* p, unsigned v) { return __hip_atomic_fetch_add(p, v, __ATOMIC_RELAXED, __HIP_MEMORY_SCOPE_AGENT); }
__device__ __forceinline__ unsigned xb_xcc_id() { return (unsigned)__builtin_amdgcn_s_getreg((3 << 11) | 20) & 0xFu; }
#define XB_SPIN(cond, bar) do { unsigned _sp = 0; while (cond) { __builtin_amdgcn_s_sleep(1); \
    if ((++_sp & 255u) == 0u) { if (xb_ld(&(bar)[XB_TMO])) break; if (_sp > XB_SPIN_CAP) { atomicAdd(&(bar)[XB_TMO], 1u); break; } } } } while (0)

struct XcdBarrier {
    unsigned* bar; unsigned x;
    volatile LAS unsigned* st;
};

__device__ __forceinline__ XcdBarrier xcd_barrier_post(unsigned* bar, volatile LAS unsigned* st) {
    XcdBarrier b; b.bar = bar; b.x = xb_xcc_id(); b.st = st;
    if (threadIdx.x == 0) (void)xb_add(&bar[XB_XCNT(b.x)], 1u);
    return b;
}
__device__ __forceinline__ void xcd_barrier_complete(unsigned* bar, unsigned x, unsigned& nloc, unsigned& nx) {
    const unsigned G = gridDim.x * gridDim.y * gridDim.z;
    unsigned sum, cnt, mine, sp = 0u;
    for (;;) {
        sum = 0u; cnt = 0u; mine = 0u;
#pragma unroll
        for (unsigned j = 0; j < 16; ++j) { const unsigned c = xb_ld(&bar[XB_XCNT(j)]); sum += c; cnt += (c > 0u) ? 1u : 0u; mine = (j == x) ? c : mine; }
        if (sum == G) break;
        __builtin_amdgcn_s_sleep(1);
        if ((++sp & 255u) == 0u) { if (xb_ld(&bar[XB_TMO])) break; if (sp > XB_SPIN_CAP) { atomicAdd(&bar[XB_TMO], 1u); break; } }
    }
    nloc = mine > 0u ? mine : 1u; nx = cnt > 0u ? cnt : 1u;
}

__device__ __forceinline__ void xcd_barrier(const XcdBarrier& b) {
    asm volatile("s_waitcnt vmcnt(0)" ::: "memory");
    __syncthreads();
    if (threadIdx.x == 0) {
        unsigned* bar = b.bar;
        __builtin_amdgcn_s_waitcnt(0);
        unsigned nloc = b.st[0], nx = b.st[1];
        if (nloc == 0u) { xcd_barrier_complete(bar, b.x, nloc, nx); b.st[0] = nloc; b.st[1] = nx; }
        const unsigned old = xb_add(&bar[XB_XSUB(b.x)], 1u);
        const unsigned gen = old / nloc;
        if (old + 1u == (gen + 1u) * nloc) {
            __builtin_amdgcn_fence(__ATOMIC_RELEASE, "agent");
            asm volatile("s_waitcnt vmcnt(0)" ::: "memory");
            const unsigned og = xb_add(&bar[XB_TOP], 1u);
            const unsigned tg = og / nx;
            if (og + 1u == (tg + 1u) * nx) xb_add(&bar[XB_TOPGEN], 1u);
            else XB_SPIN(xb_ld(&bar[XB_TOPGEN]) == tg, bar);
            __builtin_amdgcn_fence(__ATOMIC_ACQUIRE, "agent");
            xb_add(&bar[XB_XGEN(b.x)], 1u);
            asm volatile("s_waitcnt vmcnt(0)" ::: "memory");
        } else {
            XB_SPIN(xb_ld(&bar[XB_XGEN(b.x)]) == gen, bar);
            __builtin_amdgcn_fence(__ATOMIC_ACQUIRE, "agent");
            asm volatile("s_waitcnt vmcnt(0)" ::: "memory");
        }
    }
    __syncthreads();
}

struct Args { const float* in[18]; float* out; unsigned char* ws; int ph_lo, ph_hi; };
template <int VT, class F> __device__ __forceinline__ void run_vb(int nvb, char* lds, F f) {
    constexpr int PER = NTHREADS / VT; const int sub = threadIdx.x / VT, tid = threadIdx.x % VT;
    for (int it = blockIdx.x; it * PER < nvb; it += gridDim.x) { VB vb{it * PER + sub, tid, lds + sub * (LDS_BYTES / PER)}; f(vb); __syncthreads(); }
}
__device__ __forceinline__ unsigned pk2(float lo, float hi) { return (unsigned)f2bf(lo) | ((unsigned)f2bf(hi) << 16); }
typedef unsigned v4u __attribute__((ext_vector_type(4)));
typedef float f32x4 __attribute__((ext_vector_type(4)));
__device__ __forceinline__ void tr_item(const float* W, int ld, int ncols, int K, bf16_t* WT, int row_off, LAS float* scr, int item, int lane) {
    const int nblk = ncols / 32, kb = item / nblk, nb = item % nblk, k0 = 64 * kb, n0 = 32 * nb;
#pragma unroll 8
    for (int i = 0; i < 32; ++i) { const int kk = 2 * i + (lane >> 5); scr[kk * 33 + (lane & 31)] = W[(size_t)(k0 + kk) * ld + n0 + (lane & 31)]; }
    asm volatile("s_waitcnt lgkmcnt(0)" ::: "memory");
    const int c = lane & 7;
#pragma unroll
    for (int j = 0; j < 4; ++j) { const int n = (lane >> 3) + 8 * j; const LAS float* s = scr + (8 * c) * 33 + n;
        v4u o; o.x = pk2(s[0 * 33], s[1 * 33]); o.y = pk2(s[2 * 33], s[3 * 33]); o.z = pk2(s[4 * 33], s[5 * 33]); o.w = pk2(s[6 * 33], s[7 * 33]);
        *(v4u*)(WT + (size_t)(row_off + n0 + n) * K + k0 + 8 * c) = o; }
    asm volatile("s_waitcnt lgkmcnt(0)" ::: "memory");
}
__device__ __forceinline__ void rms_row_wave(const float* xrow, const float* g, bf16_t* orow, int lane) {
    const f32x4* xr = (const f32x4*)xrow + lane; const f32x4* gr = (const f32x4*)g + lane;
    f32x4 v[4]; float s = 0.f;
#pragma unroll
    for (int j = 0; j < 4; ++j) { v[j] = xr[64 * j]; s += (v[j].x * v[j].x + v[j].y * v[j].y) + (v[j].z * v[j].z + v[j].w * v[j].w); }
    const float r = rsqrtf(wave_sum(s) * (1.f / D) + EPS);
    unsigned long long* o8 = (unsigned long long*)orow + lane;
#pragma unroll
    for (int j = 0; j < 4; ++j) { const f32x4 gg = gr[64 * j]; o8[64 * j] = (unsigned long long)pk2(v[j].x * r * gg.x, v[j].y * r * gg.y) | ((unsigned long long)pk2(v[j].z * r * gg.z, v[j].w * r * gg.w) << 32); }
}
__device__ __forceinline__ int small_src_col(int c) { return c < 8 ? C_MLI + c : C_NSG + (c - 8); }
__global__ void __launch_bounds__(NTHREADS, 2) mega(Args a) {
    extern __shared__ __attribute__((aligned(16))) unsigned char lds_raw[];
    char* lds = (char*)lds_raw;
    LAS unsigned char* lds3 = (LAS unsigned char*)lds_raw;
    const float* x = a.in[0]; const float* mem = a.in[1]; const float* g_mix = a.in[2]; const float* w_in = a.in[3];
    const float* b_in = a.in[4]; const float* ml_conv = a.in[5]; const float* ml_norm_g = a.in[6]; const float* cmp_pe = a.in[7];
    const float* cmp_w1 = a.in[8]; const float* cmp_w2 = a.in[9]; const float* g_mem = a.in[10]; const float* w_mem_kv = a.in[11];
    const float* w_branch = a.in[12]; const float* w_out = a.in[13]; const float* g_ffn = a.in[14]; const float* w_ff1 = a.in[15];
    const float* w_ff2 = a.in[16]; const float* g_final = a.in[17];
    char* ws = (char*)a.ws; float* out = a.out;
    bf16_t* U = (bf16_t*)(ws + WS_U); bf16_t* P = (bf16_t*)(ws + WS_P);
    bf16_t* Yml = (bf16_t*)(ws + WS_Y); bf16_t* Ynsa = Yml + (size_t)M * 512; bf16_t* Yxa = Ynsa + (size_t)M * 512;
    float* S32 = (float*)(ws + WS_S32); bf16_t* MEMN = (bf16_t*)(ws + WS_MEMN); bf16_t* MEMKV = (bf16_t*)(ws + WS_MEMKV);
    bf16_t* KC = (bf16_t*)(ws + WS_KC); bf16_t* VC = (bf16_t*)(ws + WS_VC);
    float* NA = (float*)(ws + WS_NA); float* Gc = (float*)(ws + WS_G); float* Mloc = (float*)(ws + WS_MLOC); float* Mprev = (float*)(ws + WS_MPREV);
    float* Abuf = out;
    bf16_t* GATES = P; bf16_t* MERGED = U; bf16_t* AFFN = (bf16_t*)(ws + WS_AFFN); bf16_t* HBUF = P;
    bf16_t* Wi = (bf16_t*)(ws + WS_WIN); bf16_t* Wg = (bf16_t*)(ws + WS_WG); bf16_t* Wbr = (bf16_t*)(ws + WS_WBR); bf16_t* Wo = (bf16_t*)(ws + WS_WOUT);
    bf16_t* Wf1 = (bf16_t*)(ws + WS_WFF1); bf16_t* Wf2 = (bf16_t*)(ws + WS_WFF2); bf16_t* Wmkv = (bf16_t*)(ws + WS_WMKV);
    float* biasP = (float*)(ws + WS_BIASP); bf16_t* Wc1 = (bf16_t*)(ws + WS_WC1); bf16_t* Wc2 = (bf16_t*)(ws + WS_BIASP + 65536);
    const int tid = threadIdx.x, lane = tid & 63, wave = __builtin_amdgcn_readfirstlane(tid >> 6);
    const int G = gridDim.x, bid = blockIdx.x;
    const int lo = a.ph_lo, hi = a.ph_hi;
    volatile LAS unsigned* xbst = (volatile LAS unsigned*)(lds3 + 131072 + 1024);
    if (tid < 2) xbst[tid] = 0u;
    __syncthreads();
    const XcdBarrier bar = xcd_barrier_post((unsigned*)ws, xbst);
#define PHASE(k) if (lo <= (k) && (k) < hi)
#define SEAM(k) if (lo <= (k) && (k) + 1 < hi) xcd_barrier(bar)
    PHASE(0) {
        LAS float* scr = (LAS float*)(lds3 + wave * 16384);
        const int gw = bid * 8 + wave, NGW = G * 8;
        constexpr int I0 = 16 * 64, I1 = 16 * 40, I2 = 16 * 16, I3 = 16 * 96, I4 = 8 * 32, I5 = 16 * 32, I6 = 16 * 128, I7 = 64 * 32, I8 = 16 * 32;
        constexpr int I9 = 32 * 8, I10 = 4 * 2;
        constexpr int NITEMS = I0 + I1 + I2 + I3 + 3 * I4 + I5 + I6 + I7 + I8 + 2 * I9 + 2 * I10;
        for (int it = gw; it < NITEMS; it += NGW) {
            int r = it;
            if (r < I0) { tr_item(w_in, DIN, 2048, 1024, Wi, 0, scr, r, lane); continue; } r -= I0;
            if (r < I1) { tr_item(w_in + 2056, DIN, 1280, 1024, Wi, 2048, scr, r, lane); continue; } r -= I1;
            if (r < I2) { tr_item(w_in + 3360, DIN, 512, 1024, Wi, 3328, scr, r, lane); continue; } r -= I2;
            if (r < I3) { tr_item(w_in + C_MG, DIN, 3072, 1024, Wg, 0, scr, r, lane); continue; } r -= I3;
            if (r < 3 * I4) { const int j = r / I4; tr_item(w_branch + (size_t)j * 512 * 1024, 1024, 1024, 512, Wbr + (size_t)j * 1024 * 512, 0, scr, r % I4, lane); continue; } r -= 3 * I4;
            if (r < I5) { tr_item(w_out, 1024, 1024, 1024, Wo, 0, scr, r, lane); continue; } r -= I5;
            if (r < I6) { tr_item(w_ff1, FF, FF, 1024, Wf1, 0, scr, r, lane); continue; } r -= I6;
            if (r < I7) { tr_item(w_ff2, 1024, 1024, FF, Wf2, 0, scr, r, lane); continue; } r -= I7;
            if (r < I8) { tr_item(w_mem_kv, 1024, 1024, 1024, Wmkv, 0, scr, r, lane); continue; } r -= I8;
            if (r < 2 * I9) { const int kv = r / I9; tr_item(cmp_w1 + (size_t)kv * 2048 * 256, 256, 256, 2048, Wc1 + (size_t)kv * 256 * 2048, 0, scr, r % I9, lane); continue; } r -= 2 * I9;
            { const int kv = r / I10; tr_item(cmp_w2 + (size_t)kv * 256 * 64, 64, 64, 256, Wc2 + (size_t)kv * 64 * 256, 0, scr, r % I10, lane); }
        }
        for (int i = bid * NTHREADS + tid; i < 256 * 1024; i += G * NTHREADS) { const int r = i >> 10, k = i & 1023; bf16_t v = 0;
            if (r < 32) v = f2bf(w_in[(size_t)k * DIN + small_src_col(r)]);
            else if (r >= 128 && r < 160) { const float w = w_in[(size_t)k * DIN + small_src_col(r - 128)]; v = f2bf(w - bf2f(f2bf(w))); }
            Wi[(size_t)(3840 + r) * 1024 + k] = v; }
        for (int c = bid * NTHREADS + tid; c < 4096; c += G * NTHREADS) { float v = 0.f;
            if (c < 2048) v = b_in[c]; else if (c < 3328) v = b_in[c + 8]; else if (c < 3840) v = b_in[c + 32]; else if (c < 3872) v = b_in[small_src_col(c - 3840)];
            biasP[c] = v; }
        for (int m = gw; m < M; m += NGW) rms_row_wave(x + (size_t)m * D, g_mix, U + (size_t)m * D, lane);
        for (int m = gw; m < 1024; m += NGW) rms_row_wave(mem + (size_t)m * D, g_mem, MEMN + (size_t)m * D, lane);
    }
    SEAM(0);
    PHASE(1) {
        { pg8::Gemm g{U, Wi, M, 4096, D}; pg8::StaticOrder S; S.init(M, 4096, G, bid);
          pg8::EpiStore<0> E{P, biasP, S32, PW, 15};
          pg8::gemm_phase<pg8::EpiStore<0>, pg8::StaticOrder, true, true>(lds3, g, S, E); }
        { pg8::Gemm g{MEMN, Wmkv, 1024, 1024, D}; pg8::StaticOrder S; S.init(1024, 1024, G, bid);
          pg8::EpiStore<0> E{MEMKV, nullptr, nullptr, 1024, -1};
          pg8::gemm_phase<pg8::EpiStore<0>, pg8::StaticOrder, true, true>(lds3, g, S, E); }
    }
    SEAM(1);
    PHASE(2) { for (int ci = bid; ci < 1024; ci += G) ml::m1_unit((NLAS char*)lds_raw, P, ml_conv, S32, Abuf, NA, Gc, Mloc, ci);
               for (int u = bid; u < 256; u += G) cmpr::unit((NLAS char*)lds_raw, P, cmp_pe, Wc1, Wc2, KC, VC, u);
               xa::phase((NLAS char*)lds_raw, P, MEMKV, Yxa); }
    SEAM(2);
    PHASE(3) { ml::m2_items(Abuf, NA, Gc, Mloc, Mprev);
               nsa::phase((NLAS char*)lds_raw, P, S32, KC, VC, Ynsa); }
    SEAM(3);
    PHASE(4) { for (int ci = bid; ci < 1024; ci += G) ml::m3_unit((NLAS char*)lds_raw, P, ml_conv, S32, Abuf, NA, Mprev, ml_norm_g, Yml, ci); }
    SEAM(4);
    PHASE(5) { pg8::Gemm g{U, Wg, M, 3072, D}; pg8::StaticOrder S; S.init(M, 3072, G, bid);
               pg8::EpiStore<1> E{GATES, b_in + C_MG, nullptr, 3072, -1};
               pg8::gemm_phase<pg8::EpiStore<1>, pg8::StaticOrder, true, true>(lds3, g, S, E); }
    SEAM(5);
    PHASE(6) {
#pragma unroll 1
        for (int j = 0; j < 3; ++j) { pg8::Gemm g{Yml + (size_t)j * M * 512, Wbr + (size_t)j * 1024 * 512, M, 1024, 512}; pg8::StaticOrder S; S.init(M, 1024, G, bid);
            pg8::EpiMergeG E{GATES, out, MERGED, j, 0};
            pg8::gemm_phase<pg8::EpiMergeG, pg8::StaticOrder, true, true>(lds3, g, S, E); }
    }
    SEAM(6);
    PHASE(7) { pg8::Gemm g{MERGED, Wo, M, 1024, D}; pg8::StaticOrder S; S.init(M, 1024, G, bid);
               pg8::EpiResidF E{x, out};
               pg8::gemm_phase<pg8::EpiResidF, pg8::StaticOrder, true, true>(lds3, g, S, E); }
    SEAM(7);
    PHASE(8) { const int gw = bid * 8 + wave, NGW = G * 8; for (int m = gw; m < M; m += NGW) rms_row_wave(out + (size_t)m * D, g_ffn, AFFN + (size_t)m * D, lane); }
    SEAM(8);
    PHASE(9) { pg8::Gemm g{AFFN, Wf1, M, FF, D}; pg8::StaticOrder S; S.init(M, FF, G, bid);
               pg8::EpiStore<2> E{HBUF, nullptr, nullptr, FF, -1};
               pg8::gemm_phase<pg8::EpiStore<2>, pg8::StaticOrder, true, true>(lds3, g, S, E); }
    SEAM(9);
    PHASE(10) { pg8::Gemm g{HBUF, Wf2, M, 1024, FF}; pg8::StaticOrder S; S.init(M, 1024, G, bid);
                pg8::EpiResidF E{out, out};
                pg8::gemm_phase<pg8::EpiResidF, pg8::StaticOrder, true, true>(lds3, g, S, E); }
    SEAM(10);
    PHASE(11) { run_vb<256>(M, lds, [=](VB vb) { rms_rows<false>(vb, out, g_final, out); }); }
}
constexpr int N_PHASES = 12;
#ifndef MK_PER_PHASE
#define MK_PER_PHASE 0
#endif
extern "C" void kernel_launch(void* const* d_in, const int* in_sizes, int n_in, void* d_out, int out_size, void* d_ws, size_t ws_size, hipStream_t stream) {
    static int grid = 0;
    if (grid == 0) {
        int dev = 0, cus = 0, per_cu = 0;
        (void)hipGetDevice(&dev); (void)hipDeviceGetAttribute(&cus, hipDeviceAttributeMultiprocessorCount, dev);
        (void)hipFuncSetAttribute((const void*)mega, hipFuncAttributeMaxDynamicSharedMemorySize, LDS_BYTES);
        (void)hipOccupancyMaxActiveBlocksPerMultiprocessor(&per_cu, (const void*)mega, NTHREADS, LDS_BYTES);
        if (per_cu < 1) { fprintf(stderr, "occupancy query says %d blocks/CU\n", per_cu); per_cu = 1; }
        grid = cus * 1;
        (void)hipGetLastError();
    }
    (void)hipMemsetAsync(d_ws, 0, 16384, stream);
    Args a{};
    for (int i = 0; i < 18; ++i) a.in[i] = (const float*)d_in[i];
    a.out = (float*)d_out; a.ws = (unsigned char*)d_ws;
#if MK_PER_PHASE
    for (int p = 0; p < N_PHASES; ++p) { a.ph_lo = p; a.ph_hi = p + 1; void* args[] = {&a};
        (void)hipLaunchCooperativeKernel((const void*)mega, dim3(grid), dim3(NTHREADS), args, LDS_BYTES, stream); }
#else
    a.ph_lo = 0; a.ph_hi = N_PHASES; void* args[] = {&a};
    hipError_t e = hipLaunchCooperativeKernel((const void*)mega, dim3(grid), dim3(NTHREADS), args, LDS_BYTES, stream);
    if (e != hipSuccess) fprintf(stderr, "cooperative launch failed: %s (grid %d)\n", hipGetErrorString(e), grid);
#endif
}
```

```cpp
#include <hip/hip_runtime.h>
#include <hip/hip_cooperative_groups.h>
#include <cstdio>
namespace cg = cooperative_groups;
#include <stdint.h>

typedef unsigned short bf16_t;
struct VB { int id; int tid; char* sm; };
__device__ __forceinline__ float bf2f(bf16_t v) { return __uint_as_float(((unsigned)v) << 16); }
__device__ __forceinline__ bf16_t f2bf(float f) { unsigned u = __float_as_uint(f); return (bf16_t)((u + 0x7fffu + ((u >> 16) & 1u)) >> 16); }

constexpr int NB = 4, T = 4096, M = NB * T, D = 1024, DIN = 6944, FF = 4096;
constexpr float EPS = 1e-6f;
constexpr int C_MLI = 2048, C_NSG = 3336, C_MG = 3872;
constexpr int P_MLQ = 0, P_MLK = 512, P_MLV = 1024, P_MLO = 1536, P_NSQ = 2048, P_KC = 2560, P_VC = 2688, P_KS = 2816, P_VS = 2944, P_KW = 3072, P_VW = 3200, P_XAQ = 3328, PW = 3840;
constexpr size_t MiB = 1u << 20;
constexpr size_t WS_U = 40 * MiB;
constexpr size_t WS_P = 72 * MiB;
constexpr size_t WS_Y = 192 * MiB;
constexpr size_t WS_AFFN = 200 * MiB;
constexpr size_t WS_S32 = 240 * MiB;
constexpr size_t WS_MEMN = 242 * MiB;
constexpr size_t WS_MEMKV = 244 * MiB;
constexpr size_t WS_KC = 246 * MiB;
constexpr size_t WS_VC = 246 * MiB + 512 * 1024;
constexpr size_t WS_NA = 247 * MiB;
constexpr size_t WS_G = 248 * MiB;
constexpr size_t WS_MLOC = 248 * MiB + 4096;
constexpr size_t WS_MPREV = 248 * MiB + 8192;

__device__ __forceinline__ float wave_sum(float v) {
#pragma unroll
    for (int o = 1; o < 64; o <<= 1) v += __shfl_xor(v, o);
    return v;
}
__device__ __forceinline__ float wave_max(float v) {
#pragma unroll
    for (int o = 1; o < 64; o <<= 1) v = fmaxf(v, __shfl_xor(v, o));
    return v;
}

template <bool OUT_BF16>
__device__ __forceinline__ void rms_rows(VB vb, const float* x, const float* g, void* out) {
    float* red = (float*)vb.sm;
    const int row = vb.id, tid = vb.tid;
    const float4 v = ((const float4*)(x + (size_t)row * D))[tid];
    float s = v.x * v.x + v.y * v.y + v.z * v.z + v.w * v.w;
    s = wave_sum(s);
    if ((tid & 63) == 0) red[tid >> 6] = s;
    __syncthreads();
    const float tot = red[0] + red[1] + red[2] + red[3];
    const float r = rsqrtf(tot * (1.0f / D) + EPS);
    const float4 gg = ((const float4*)g)[tid];
    float4 o; o.x = v.x * r * gg.x; o.y = v.y * r * gg.y; o.z = v.z * r * gg.z; o.w = v.w * r * gg.w;
    if (OUT_BF16) { bf16_t* ob = (bf16_t*)out + (size_t)row * D + tid * 4; ob[0] = f2bf(o.x); ob[1] = f2bf(o.y); ob[2] = f2bf(o.z); ob[3] = f2bf(o.w); }
    else ((float4*)((float*)out + (size_t)row * D))[tid] = o;
}

struct GArgs { const bf16_t* A; const float* W; int lda, ldw, N, K; };
template <class Epi>
__device__ __forceinline__ void ngemm(VB vb, GArgs ga, Epi epi) {
    const bf16_t* A = ga.A; const float* W = ga.W; const int lda = ga.lda, ldw = ga.ldw, N = ga.N, K = ga.K;
    float (*As)[65] = (float (*)[65])vb.sm; float (*Bs)[65] = (float (*)[65])(vb.sm + 16 * 65 * 4);
    const int tid = vb.tid, tx = tid & 15, ty = tid >> 4;
    const int nx = (N + 63) / 64; const int m0 = (vb.id / nx) * 64, n0 = (vb.id % nx) * 64;
    float acc[4][4];
#pragma unroll
    for (int i = 0; i < 4; ++i)
#pragma unroll
        for (int j = 0; j < 4; ++j) acc[i][j] = 0.f;
    for (int k0 = 0; k0 < K; k0 += 16) {
#pragma unroll
        for (int i = 0; i < 4; ++i) { const int idx = tid + i * 256, r = idx >> 4, kk = idx & 15; As[kk][r] = bf2f(A[(size_t)(m0 + r) * lda + k0 + kk]); }
#pragma unroll
        for (int i = 0; i < 4; ++i) { const int idx = tid + i * 256, kk = idx >> 6, n = idx & 63; Bs[kk][n] = (n0 + n < N) ? W[(size_t)(k0 + kk) * ldw + n0 + n] : 0.f; }
        __syncthreads();
#pragma unroll
        for (int kk = 0; kk < 16; ++kk) {
            float a[4], b[4];
#pragma unroll
            for (int i = 0; i < 4; ++i) { a[i] = As[kk][ty * 4 + i]; b[i] = Bs[kk][tx * 4 + i]; }
#pragma unroll
            for (int i = 0; i < 4; ++i)
#pragma unroll
                for (int j = 0; j < 4; ++j) acc[i][j] += a[i] * b[j];
        }
        __syncthreads();
    }
#pragma unroll
    for (int i = 0; i < 4; ++i)
#pragma unroll
        for (int j = 0; j < 4; ++j) { const int n = n0 + tx * 4 + j; if (n < N) epi(m0 + ty * 4 + i, n, acc[i][j]); }
}
struct EpiBiasBf16 { bf16_t* O; const float* bias; int ldo, pad; __device__ void operator()(int m, int n, float a) const { O[(size_t)m * ldo + n] = f2bf(a + (bias ? bias[n] : 0.f)); } };
struct EpiBiasF32 { float* O; const float* bias; int ldo, pad; __device__ void operator()(int m, int n, float a) const { O[(size_t)m * ldo + n] = a + bias[n]; } };
struct EpiSigBf16 { bf16_t* O; const float* bias; int ldo, pad; __device__ void operator()(int m, int n, float a) const { const float v = a + bias[n]; O[(size_t)m * ldo + n] = f2bf(1.f / (1.f + __expf(-v))); } };
struct EpiMerge { const bf16_t* G; float* Mf; bf16_t* Mb; int j, pad; __device__ void operator()(int m, int n, float a) const {
    const float g = bf2f(G[(size_t)m * 3072 + j * 1024 + n]); float v = g * a; if (j > 0) v += Mf[(size_t)m * D + n];
    if (j < 2) Mf[(size_t)m * D + n] = v; else Mb[(size_t)m * D + n] = f2bf(v); } };
struct EpiResid { const float* X; float* O; __device__ void operator()(int m, int n, float a) const { O[(size_t)m * D + n] = X[(size_t)m * D + n] + a; } };
struct EpiRelu2 { bf16_t* O; __device__ void operator()(int m, int n, float a) const { const float r = fmaxf(a, 0.f); O[(size_t)m * FF + n] = f2bf(r * r); } };

__device__ __forceinline__ float convqk(const bf16_t* P, const float* w  , int m, int t, int ch) {
    float y = 0.f;
#pragma unroll
    for (int j = 0; j < 4; ++j) if (t - j >= 0) y += w[j * 1024 + ch] * bf2f(P[(size_t)(m - j) * PW + ch]);
    return bf2f(f2bf(y / (1.f + __expf(-y))));
}
__device__ __forceinline__ float logsig(float x) { return fminf(x, 0.f) - log1pf(__expf(-fabsf(x))); }
__device__ __forceinline__ void m1_naive(VB vb, const bf16_t* P, const float* cw, const float* S32, float* Abuf, float* NA, float* Gc, float* Mloc) {
    float (*kk)[128] = (float (*)[128])vb.sm; float* e = (float*)(vb.sm + 32768); float* bc = e + 64;
    const int ci = vb.id, c = ci & 63, bh = ci >> 6, h = bh & 3, b = bh >> 2, tid = vb.tid;
    const int m0 = b * T + c * 64;
    if (tid == 0) {
        float run = 0.f;
        for (int s = 0; s < 64; ++s) { run += logsig(S32[(size_t)(m0 + s) * 32 + 4 + h]); bc[s] = run; }
        const float g = run; float mx = -INFINITY;
        for (int s = 0; s < 64; ++s) { const float w = g - bc[s] + S32[(size_t)(m0 + s) * 32 + h]; e[s] = w; mx = fmaxf(mx, w); }
        for (int s = 0; s < 64; ++s) e[s] = __expf(e[s] - mx);
        Gc[ci] = g; Mloc[ci] = mx;
    }
    for (int i = tid; i < 64 * 128; i += 256) { const int s = i >> 7, k = i & 127; kk[s][k] = convqk(P, cw, m0 + s, c * 64 + s, 512 + h * 128 + k) * 0.08838834764831845f; }
    __syncthreads();
    const int v = tid & 127, kh = tid >> 7;
    float acc[64];
#pragma unroll
    for (int i = 0; i < 64; ++i) acc[i] = 0.f;
    for (int s = 0; s < 64; ++s) {
        const float ev = e[s] * bf2f(P[(size_t)(m0 + s) * PW + P_MLV + h * 128 + v]);
#pragma unroll
        for (int i = 0; i < 64; ++i) acc[i] += kk[s][kh * 64 + i] * ev;
    }
#pragma unroll
    for (int i = 0; i < 64; ++i) Abuf[((size_t)ci * 128 + kh * 64 + i) * 128 + v] = acc[i];
    if (tid < 128) { float n = 0.f; for (int s = 0; s < 64; ++s) n += e[s] * kk[s][tid]; NA[(size_t)ci * 128 + tid] = n; }
}
__device__ __forceinline__ void m2_naive(VB vb, float* Abuf, float* NA, const float* Gc, const float* Mloc, float* Mprev) {
    const int i = vb.id * 256 + vb.tid;
    const int bh = i >> 14, kv = i & 16383, k = kv >> 7, v = kv & 127;
    float C = 0.f, n = 0.f, m = 0.f;
    for (int c = 0; c < 64; ++c) {
        const int ci = bh * 64 + c;
        const float g = Gc[ci], ml = Mloc[ci];
        const float mn = fmaxf(g + m, ml), a = __expf(g + m - mn), bb = __expf(ml - mn);
        const size_t idx = ((size_t)ci * 128 + k) * 128 + v;
        const float A = Abuf[idx]; Abuf[idx] = C; C = a * C + bb * A;
        if (v == 0) { const float nA = NA[(size_t)ci * 128 + k]; NA[(size_t)ci * 128 + k] = n; n = a * n + bb * nA; }
        if (kv == 0) Mprev[ci] = m;
        m = mn;
    }
}
__device__ __forceinline__ void m3_naive(VB vb, const bf16_t* P, const float* cw, const float* S32, const float* Cprev, const float* Nprev, const float* Mprev,
                                                const float* normg, bf16_t* Yml) {
    float* q = (float*)vb.sm; float* Srow = q + 128; float* bc = Srow + 64; float* li = bc + 64; float* sh = li + 64;
    const int ci = vb.id >> 6, tt = vb.id & 63, c = ci & 63, bh = ci >> 6, h = bh & 3, b = bh >> 2, tid = vb.tid;
    const int m0 = b * T + c * 64, m = m0 + tt;
    q[tid] = convqk(P, cw, m, c * 64 + tt, h * 128 + tid);
    if (tid == 0) { float run = 0.f; for (int s = 0; s <= tt; ++s) { run += logsig(S32[(size_t)(m0 + s) * 32 + 4 + h]); bc[s] = run; li[s] = S32[(size_t)(m0 + s) * 32 + h]; } }
    __syncthreads();
    const float mprev = Mprev[ci], inter = bc[tt] + mprev;
    float mt = inter;
    for (int s = 0; s <= tt; ++s) mt = fmaxf(mt, bc[tt] - bc[s] + li[s]);
    if (tid < 64) {
        float sv = 0.f;
        if (tid <= tt) { float dot = 0.f; for (int k = 0; k < 128; ++k) dot += q[k] * convqk(P, cw, m0 + tid, c * 64 + tid, 512 + h * 128 + k);
            sv = dot * 0.08838834764831845f * __expf(bc[tt] - bc[tid] + li[tid] - mt); }
        Srow[tid] = sv;
    }
    __syncthreads();
    const float sc = __expf(inter - mt);
    float num = 0.f, den = 0.f;
    for (int s = 0; s <= tt; ++s) { num += Srow[s] * bf2f(P[(size_t)(m0 + s) * PW + P_MLV + h * 128 + tid]); den += Srow[s]; }
    float qc = 0.f, qn = 0.f;
    for (int k = 0; k < 128; ++k) { qc += q[k] * Cprev[((size_t)ci * 128 + k) * 128 + tid]; qn += q[k] * Nprev[(size_t)ci * 128 + k]; }
    num += sc * qc; den += sc * qn;
    const float hv = num / fmaxf(fabsf(den), __expf(-mt));
    float ss = wave_sum(hv * hv);
    if ((tid & 63) == 0) sh[tid >> 6] = ss;
    __syncthreads();
    const float r = rsqrtf((sh[0] + sh[1]) * (1.f / 128.f) + EPS);
    const float o = bf2f(P[(size_t)m * PW + P_MLO + h * 128 + tid]);
    Yml[(size_t)m * 512 + h * 128 + tid] = f2bf(1.f / (1.f + __expf(-o)) * hv * r * normg[h * 128 + tid]);
}

__device__ __forceinline__ float gelu_tanh(float x) { const float u = 0.7978845608028654f * (x + 0.044715f * x * x * x); return 0.5f * x * (1.f + tanhf(u)); }
__device__ __forceinline__ void n1_naive(VB vb, const bf16_t* P, const float* pe  , const float* w1  , const float* w2  , bf16_t* KC, bf16_t* VC) {
    float* xin = (float*)vb.sm; float* hid = xin + 2048;
    int idx = vb.id; const int g = idx & 1; idx >>= 1; const int n = idx % 255; idx /= 255; const int b = idx & 3, kv = idx >> 2, tid = vb.tid;
    const int pcol = (kv ? P_VC : P_KC) + g * 64;
    for (int i = tid; i < 2048; i += 256) { const int l = i >> 6, d = i & 63; xin[i] = bf2f(P[(size_t)(b * T + n * 16 + l) * PW + pcol + d]) + pe[kv * 2048 + i]; }
    __syncthreads();
    float a = 0.f; const float* w = w1 + (size_t)kv * 2048 * 256 + tid;
    for (int i = 0; i < 2048; ++i) a += xin[i] * w[(size_t)i * 256];
    hid[tid] = gelu_tanh(a);
    __syncthreads();
    if (tid < 64) { float o = 0.f; const float* ww = w2 + (size_t)kv * 256 * 64 + tid; for (int j = 0; j < 256; ++j) o += hid[j] * ww[j * 64];
        (kv ? VC : KC)[((size_t)(b * 256 + n) * 2 + g) * 64 + tid] = f2bf(o); }
}
__device__ __forceinline__ void n2_naive(VB vb, const bf16_t* P, const float* S32, const bf16_t* KC, const bf16_t* VC, bf16_t* Ynsa) {
    float (*q_s)[64] = (float (*)[64])vb.sm; float (*sc)[1024] = (float (*)[1024])(vb.sm + 1024); float (*pc)[256] = (float (*)[256])(vb.sm + 1024 + 16384); float* imp_s = (float*)(vb.sm + 1024 + 16384 + 4096);
    unsigned long long& selmask = *(unsigned long long*)(vb.sm + 1024 + 16384 + 4096 + 256);
    const int g = vb.id & 1, m = vb.id >> 1, b = m / T, t = m % T, tid = vb.tid, r = tid >> 6, lane = tid & 63, h = g * 4 + r;
    const float slope = exp2f(-(float)(h + 1));
    q_s[r][lane] = bf2f(P[(size_t)m * PW + P_NSQ + h * 64 + lane]) * 0.125f;
    __syncthreads();
    float sv[4]; float mx = -INFINITY;
#pragma unroll
    for (int i = 0; i < 4; ++i) { const int n = lane + 64 * i; sv[i] = -INFINITY;
        if (n < 255) { const int dist = t - (16 * n + 31); if (dist >= 0) { const bf16_t* kr = KC + ((size_t)(b * 256 + n) * 2 + g) * 64; float dot = 0.f; for (int d = 0; d < 64; ++d) dot += q_s[r][d] * bf2f(kr[d]);
            sv[i] = dot - slope * (float)dist; mx = fmaxf(mx, sv[i]); } } }
    mx = wave_max(mx);
    float sum = 0.f;
#pragma unroll
    for (int i = 0; i < 4; ++i) { sv[i] = (sv[i] == -INFINITY) ? 0.f : __expf(sv[i] - mx); sum += sv[i]; }
    sum = wave_sum(sum);
    const float inv = sum > 0.f ? 1.f / sum : 0.f;
#pragma unroll
    for (int i = 0; i < 4; ++i) pc[r][lane + 64 * i] = sv[i] * inv;
    __syncthreads();
    float oc = 0.f;
    { const int nmax = (t >= 31) ? ((t - 31) / 16) : -1; for (int n = 0; n <= nmax && n < 255; ++n) oc += pc[r][n] * bf2f(VC[((size_t)(b * 256 + n) * 2 + g) * 64 + lane]); }
    if (tid < 64) { const int j = tid; float im = 0.f;
        for (int n = 4 * j - 1; n <= 4 * j + 3; ++n) if (n >= 0 && n < 255) im += (pc[0][n] + pc[1][n]) + (pc[2][n] + pc[3][n]);
        const int cur = t >> 6; const bool valid = j <= cur, forced = (j == 0) || (j == cur) || (j == cur - 1);
        const float s = valid ? im + (forced ? 1000.f : 0.f) : -1e30f;
        imp_s[j] = s; }
    __syncthreads();
    if (tid < 64) { const int j = tid; const float s = imp_s[j]; int rank = 0;
        for (int jj = 0; jj < 64; ++jj) { const float o = imp_s[jj]; rank += (o > s || (o == s && jj < j)) ? 1 : 0; }
        const unsigned long long mk = __ballot(rank < 16 && j <= (t >> 6)); if (tid == 0) selmask = mk; }
    __syncthreads();
    float osel = 0.f;
    { unsigned long long mk = selmask; int slot = 0; float mxs = -INFINITY;
      while (mk) { const int jb = __ffsll((long long)mk) - 1; mk &= mk - 1; const int pos = jb * 64 + lane; float s = -INFINITY;
          if (pos <= t) { const bf16_t* kr = P + (size_t)(b * T + pos) * PW + P_KS + g * 64; float dot = 0.f; for (int d = 0; d < 64; ++d) dot += q_s[r][d] * bf2f(kr[d]); s = dot - slope * (float)(t - pos); }
          sc[r][slot * 64 + lane] = s; mxs = fmaxf(mxs, s); ++slot; }
      mxs = wave_max(mxs); float sm = 0.f;
      for (int i = 0; i < slot; ++i) { const float s = sc[r][i * 64 + lane]; const float p = (s == -INFINITY) ? 0.f : __expf(s - mxs); sc[r][i * 64 + lane] = p; sm += p; }
      sm = wave_sum(sm);
      mk = selmask; slot = 0;
      while (mk) { const int jb = __ffsll((long long)mk) - 1; mk &= mk - 1;
          for (int i = 0; i < 64; ++i) { const int pos = jb * 64 + i; if (pos > t) break; osel += sc[r][slot * 64 + i] * bf2f(P[(size_t)(b * T + pos) * PW + P_VS + g * 64 + lane]); }
          ++slot; }
      osel /= sm; }
    __syncthreads();
    float owin = 0.f;
    { float mxs = -INFINITY;
      for (int i = 0; i < 8; ++i) { const int pos = t - 511 + i * 64 + lane; float s = -INFINITY;
          if (pos >= 0) { const bf16_t* kr = P + (size_t)(b * T + pos) * PW + P_KW + g * 64; float dot = 0.f; for (int d = 0; d < 64; ++d) dot += q_s[r][d] * bf2f(kr[d]); s = dot - slope * (float)(t - pos); }
          sc[r][i * 64 + lane] = s; mxs = fmaxf(mxs, s); }
      mxs = wave_max(mxs); float sm = 0.f;
      for (int i = 0; i < 8; ++i) { const float s = sc[r][i * 64 + lane]; const float p = (s == -INFINITY) ? 0.f : __expf(s - mxs); sc[r][i * 64 + lane] = p; sm += p; }
      sm = wave_sum(sm);
      for (int i = 0; i < 512; ++i) { const int pos = t - 511 + i; if (pos < 0) continue; owin += sc[r][i] * bf2f(P[(size_t)(b * T + pos) * PW + P_VW + g * 64 + lane]); }
      owin /= sm; }
    const float* gp = S32 + (size_t)m * 32 + 8 + h * 3;
    const float g0 = 1.f / (1.f + __expf(-gp[0])), g1 = 1.f / (1.f + __expf(-gp[1])), g2 = 1.f / (1.f + __expf(-gp[2]));
    Ynsa[(size_t)m * 512 + h * 64 + lane] = f2bf(g0 * oc + g1 * osel + g2 * owin);
}
__device__ __forceinline__ void x1_naive(VB vb, const bf16_t* P, const bf16_t* MEMKV, bf16_t* Yxa) {
    float (*q_s)[128] = (float (*)[128])vb.sm; float (*p_s)[256] = (float (*)[256])(vb.sm + 2048);
    const int m = vb.id, b = m / T, tid = vb.tid, h = tid >> 6, lane = tid & 63;
    q_s[h][lane] = bf2f(P[(size_t)m * PW + P_XAQ + h * 128 + lane]) * 0.08838834764831845f;
    q_s[h][lane + 64] = bf2f(P[(size_t)m * PW + P_XAQ + h * 128 + lane + 64]) * 0.08838834764831845f;
    __syncthreads();
    float sv[4]; float mx = -INFINITY;
#pragma unroll
    for (int i = 0; i < 4; ++i) { const int j = lane + 64 * i; const bf16_t* kr = MEMKV + (size_t)(b * 256 + j) * 1024 + h * 128; float dot = 0.f; for (int d = 0; d < 128; ++d) dot += q_s[h][d] * bf2f(kr[d]); sv[i] = dot; mx = fmaxf(mx, dot); }
    mx = wave_max(mx); float sm = 0.f;
#pragma unroll
    for (int i = 0; i < 4; ++i) { sv[i] = __expf(sv[i] - mx); sm += sv[i]; }
    sm = wave_sum(sm);
#pragma unroll
    for (int i = 0; i < 4; ++i) p_s[h][lane + 64 * i] = sv[i] / sm;
    __syncthreads();
    float o0 = 0.f, o1 = 0.f;
    for (int j = 0; j < 256; ++j) { const bf16_t* vr = MEMKV + (size_t)(b * 256 + j) * 1024 + 512 + h * 128; const float p = p_s[h][j]; o0 += p * bf2f(vr[lane]); o1 += p * bf2f(vr[lane + 64]); }
    Yxa[(size_t)m * 512 + h * 128 + lane] = f2bf(o0); Yxa[(size_t)m * 512 + h * 128 + lane + 64] = f2bf(o1);
}


namespace pg8 {
#define PG8_LAS __attribute__((address_space(3)))
typedef unsigned short bf16_t;
typedef short bf16x8 __attribute__((ext_vector_type(8)));
typedef float f32x4 __attribute__((ext_vector_type(4)));
typedef unsigned u32x4 __attribute__((ext_vector_type(4)));
constexpr int BM = 256, BK = 64, HALF = 128, HTB = HALF * BK * 2  , STAGE_BYTES = 8 * HTB, NXCD = 8, WGM = 8;

__host__ __device__ __forceinline__ int lds_byte(int r, int c) { const int st = (r >> 4) * 2 + (c >> 5), rr = r & 15, cc = c & 31, ob = rr * 64 + cc * 2; return st * 1024 + (ob ^ (((ob >> 9) & 1) << 5)); }
__host__ __device__ __forceinline__ void stage_rc(int b, int& R, int& C) { const int st = b / 1024, sb = b % 1024, swz = sb ^ (((sb >> 9) & 1) << 5); R = (st >> 1) * 16 + swz / 64; C = (st & 1) * 32 + (swz % 64) / 2; }
__host__ __device__ __forceinline__ int perm32(int rho) { const int n = rho >> 4, i = rho & 15; return 8 * (i >> 2) + 4 * n + (i & 3); }

struct Unit { int pm, pn, j; };
struct Gemm { const bf16_t* A; const bf16_t* Bt; int M, N, K; };

struct StaticOrder {
    int nM, nN, nwg, G, c;
    __host__ __device__ void init(int M, int N, int G_, int c_) { nM = M / BM; nN = N / BM; nwg = nM * nN; G = G_; c = c_; }
    __host__ __device__ bool next(int i, Unit& u) const {
        const long L = (long)i * G + c; if (L >= nwg) return false;
        int wgid = (int)L; { const int q = nwg / NXCD, r = nwg % NXCD, xcd = wgid % NXCD, off = wgid / NXCD; wgid = (xcd < r ? xcd * (q + 1) : r * (q + 1) + (xcd - r) * q) + off; }
        const int nig = WGM * nN, gid = wgid / nig, fm = gid * WGM, gsz = (nM - fm) < WGM ? (nM - fm) : WGM;
        u.pm = fm + ((wgid % nig) % gsz); u.pn = (wgid % nig) / gsz; u.j = 0; return true;
    }
    __device__ __forceinline__ const char* pa(const Gemm& g, const Unit& u, size_t tstep) const { return (const char*)g.A + (size_t)u.pm * tstep; }
    __device__ __forceinline__ const char* pb(const Gemm& g, const Unit& u, size_t tstep) const { return (const char*)g.Bt + (size_t)u.pn * tstep; }
    __device__ __forceinline__ void a_ready(const Unit&) const {}
    __device__ __forceinline__ void done(const Unit&) const {}
};

struct MergeOrder {
    StaticOrder so; size_t sa, sb;
    __device__ __forceinline__ bool next(int i, Unit& u) const { if (i >= 3) return false; const bool ok = so.next(0, u); u.j = i; return ok; }
    __device__ __forceinline__ const char* pa(const Gemm& g, const Unit& u, size_t tstep) const { return (const char*)g.A + (size_t)u.j * sa + (size_t)u.pm * tstep; }
    __device__ __forceinline__ const char* pb(const Gemm& g, const Unit& u, size_t tstep) const { return (const char*)g.Bt + (size_t)u.j * sb + (size_t)u.pn * tstep; }
    __device__ __forceinline__ void a_ready(const Unit&) const {}
    __device__ __forceinline__ void done(const Unit&) const {}
};
typedef float f32x2_t __attribute__((ext_vector_type(2))); typedef __bf16 bf16x2_t __attribute__((ext_vector_type(2)));
__device__ __forceinline__ unsigned cvt_pk_bf16(float lo, float hi) { f32x2_t v = {lo, hi}; bf16x2_t b = __builtin_convertvector(v, bf16x2_t); return __builtin_bit_cast(unsigned, b); }
typedef float f32x2 __attribute__((ext_vector_type(2)));

typedef unsigned u32x2 __attribute__((ext_vector_type(2)));
__device__ __forceinline__ float bflo(unsigned w) { return __uint_as_float(w << 16); }
__device__ __forceinline__ float bfhi(unsigned w) { return __uint_as_float(w & 0xffff0000u); }
template <int ACT> __device__ __forceinline__ f32x4 act4(f32x4 v) {
    if (ACT == 1) { f32x4 o; for (int e = 0; e < 4; ++e) o[e] = __builtin_amdgcn_rcpf(1.f + __expf(-v[e])); return o; }
    if (ACT == 2) { f32x4 o; for (int e = 0; e < 4; ++e) { const float r = fmaxf(v[e], 0.f); o[e] = r * r; } return o; }
    return v;
}
template <int ACT> struct EpiStore {
    static constexpr bool PERM = true, AFTER_DRAIN = false;
    bf16_t* O; const float* bias; float* S32; int ldc, small_pn;
    __device__ __forceinline__ void operator()(const f32x4 (&acc)[2][2][4][2], const Unit& u, int wr, int wc, int fr, int fq) const {
        asm volatile("s_waitcnt vmcnt(0)" ::: "memory");
        const int row0 = u.pm * BM + wr * 64 + fr, col0 = u.pn * BM + wc * 32 + 8 * fq;
        if (u.pn == small_pn) {
            if (wc == 0) {
                const f32x4 b0 = *(const f32x4*)(bias + col0), b1 = *(const f32x4*)(bias + col0 + 4);
#pragma unroll
                for (int ai = 0; ai < 2; ++ai)
#pragma unroll
                    for (int m = 0; m < 4; ++m) { float* rp = S32 + (size_t)(row0 + ai * HALF + m * 16) * 32 + 8 * fq;
                        *(f32x4*)rp = acc[ai][0][m][0] + acc[ai][1][m][0] + b0; *(f32x4*)(rp + 4) = acc[ai][0][m][1] + acc[ai][1][m][1] + b1; }
            }
            return;
        }
        f32x4 bv[2][2];
#pragma unroll
        for (int bj = 0; bj < 2; ++bj)
#pragma unroll
            for (int n = 0; n < 2; ++n) bv[bj][n] = bias ? *(const f32x4*)(bias + col0 + bj * HALF + 4 * n) : (f32x4){0.f, 0.f, 0.f, 0.f};
#pragma unroll
        for (int ai = 0; ai < 2; ++ai)
#pragma unroll
            for (int m = 0; m < 4; ++m) { bf16_t* rowp = O + (size_t)(row0 + ai * HALF + m * 16) * ldc + col0;
#pragma unroll
                for (int bj = 0; bj < 2; ++bj) { const f32x4 v0 = act4<ACT>(acc[ai][bj][m][0] + bv[bj][0]), v1 = act4<ACT>(acc[ai][bj][m][1] + bv[bj][1]);
                    u32x4 w; w.x = cvt_pk_bf16(v0[0], v0[1]); w.y = cvt_pk_bf16(v0[2], v0[3]); w.z = cvt_pk_bf16(v1[0], v1[1]); w.w = cvt_pk_bf16(v1[2], v1[3]);
                    *(u32x4*)(rowp + bj * HALF) = w; } }
    }
};
struct EpiMergeG {
    static constexpr bool PERM = true, AFTER_DRAIN = false;
    const bf16_t* G; float* Mf; bf16_t* Mb;
    __device__ __forceinline__ void operator()(const f32x4 (&acc)[2][2][4][2], const Unit& u, int wr, int wc, int fr, int fq) const {
        const int j = u.j;
        asm volatile("s_waitcnt vmcnt(0)" ::: "memory");
        const int row0 = u.pm * BM + wr * 64 + fr, col0 = u.pn * BM + wc * 32 + 8 * fq;
#pragma unroll
        for (int ai = 0; ai < 2; ++ai)
#pragma unroll
            for (int m = 0; m < 4; ++m) { const size_t row = (size_t)(row0 + ai * HALF + m * 16);
#pragma unroll
                for (int bj = 0; bj < 2; ++bj) { const int col = col0 + bj * HALF;
                    const u32x4 gw = *(const u32x4*)(G + row * 3072 + j * 1024 + col);
                    f32x4 v0 = (f32x4){bflo(gw.x), bfhi(gw.x), bflo(gw.y), bfhi(gw.y)} * acc[ai][bj][m][0], v1 = (f32x4){bflo(gw.z), bfhi(gw.z), bflo(gw.w), bfhi(gw.w)} * acc[ai][bj][m][1];
                    float* mp = Mf + row * 1024 + col;
                    if (j > 0) { v0 += *(const f32x4*)mp; v1 += *(const f32x4*)(mp + 4); }
                    if (j < 2) { *(f32x4*)mp = v0; *(f32x4*)(mp + 4) = v1; }
                    else { u32x4 w; w.x = cvt_pk_bf16(v0[0], v0[1]); w.y = cvt_pk_bf16(v0[2], v0[3]); w.z = cvt_pk_bf16(v1[0], v1[1]); w.w = cvt_pk_bf16(v1[2], v1[3]); *(u32x4*)(Mb + row * 1024 + col) = w; } } }
    }
};
struct EpiResidF {
    static constexpr bool PERM = true, AFTER_DRAIN = false;
    const float* X; float* O;
    __device__ __forceinline__ void operator()(const f32x4 (&acc)[2][2][4][2], const Unit& u, int wr, int wc, int fr, int fq) const {
        asm volatile("s_waitcnt vmcnt(0)" ::: "memory");
        const int row0 = u.pm * BM + wr * 64 + fr, col0 = u.pn * BM + wc * 32 + 8 * fq;
#pragma unroll
        for (int ai = 0; ai < 2; ++ai)
#pragma unroll
            for (int m = 0; m < 4; ++m) { const size_t off = (size_t)(row0 + ai * HALF + m * 16) * 1024 + col0;
#pragma unroll
                for (int bj = 0; bj < 2; ++bj) { const f32x4 x0 = *(const f32x4*)(X + off + bj * HALF), x1 = *(const f32x4*)(X + off + bj * HALF + 4);
                    *(f32x4*)(O + off + bj * HALF) = x0 + acc[ai][bj][m][0]; *(f32x4*)(O + off + bj * HALF + 4) = x1 + acc[ai][bj][m][1]; } }
    }
};
struct EpiResRms {
    static constexpr bool PERM = false, AFTER_DRAIN = true;
    const float* R; float* Hout; float* Nf; bf16_t* Nb; const float* gain; float* xbuf; unsigned* cnt;
    __device__ __forceinline__ void fused(f32x4 (&acc)[2][2][4][2], const Unit& u, int wr, int wc, int fr, int fq, PG8_LAS unsigned char* lds, int wid, int lane) const {
        PG8_LAS float* Pp = (PG8_LAS float*)lds; PG8_LAS float* S = (PG8_LAS float*)(lds + 4096);
        const int col0 = u.pn * BM + wc * 32 + 4 * fq;
#pragma unroll
        for (int ai = 0; ai < 2; ++ai)
#pragma unroll
            for (int m = 0; m < 4; ++m) { const size_t off = (size_t)(u.pm * BM + ai * HALF + wr * 64 + m * 16 + fr) * 1024 + col0; float sq = 0.f;
#pragma unroll
                for (int bj = 0; bj < 2; ++bj)
#pragma unroll
                    for (int n = 0; n < 2; ++n) { const f32x4 v = acc[ai][bj][m][n] + *(const f32x4*)(R + off + bj * HALF + n * 16); acc[ai][bj][m][n] = v; sq += (v[0] * v[0] + v[1] * v[1]) + (v[2] * v[2] + v[3] * v[3]); }
                sq += __shfl_xor(sq, 16); sq += __shfl_xor(sq, 32);
                if (fq == 0) Pp[(ai * HALF + wr * 64 + m * 16 + fr) * 4 + wc] = sq; }
        asm volatile("s_waitcnt lgkmcnt(0)" ::: "memory"); __builtin_amdgcn_s_barrier(); asm volatile("" ::: "memory");
        const int row = wid * 32 + (lane & 31);
        if (lane < 32) { const float tot = (Pp[row * 4 + 0] + Pp[row * 4 + 1]) + (Pp[row * 4 + 2] + Pp[row * 4 + 3]);
            __hip_atomic_store(xbuf + ((size_t)(u.pm * BM + row) * 4 + u.pn), tot, __ATOMIC_RELAXED, __HIP_MEMORY_SCOPE_AGENT); }
        asm volatile("s_waitcnt vmcnt(0)" ::: "memory");
        if (lane == 0) __hip_atomic_fetch_add(cnt + 64 * u.pm, 1u, __ATOMIC_RELAXED, __HIP_MEMORY_SCOPE_AGENT);
        if (wid == 0) { unsigned sp = 0;
            while ((unsigned)__builtin_amdgcn_readfirstlane(__hip_atomic_load(cnt + 64 * u.pm, __ATOMIC_RELAXED, __HIP_MEMORY_SCOPE_AGENT)) < 32u) { __builtin_amdgcn_s_sleep(2); if (++sp > (1u << 22)) break; }
            __builtin_amdgcn_fence(__ATOMIC_ACQUIRE, "agent"); }
        asm volatile("s_waitcnt vmcnt(0) lgkmcnt(0)" ::: "memory"); __builtin_amdgcn_s_barrier(); asm volatile("" ::: "memory");
        if (lane < 32) { const float* slot = xbuf + (size_t)(u.pm * BM + row) * 4; float t = 0.f;
#pragma unroll
            for (int q = 0; q < 4; ++q) t += __hip_atomic_load(slot + q, __ATOMIC_RELAXED, __HIP_MEMORY_SCOPE_AGENT);
            S[row] = rsqrtf(t * (1.0f / 1024.0f) + 1e-6f); }
        asm volatile("s_waitcnt lgkmcnt(0)" ::: "memory"); __builtin_amdgcn_s_barrier(); asm volatile("" ::: "memory");
        f32x4 gv[2][2];
#pragma unroll
        for (int bj = 0; bj < 2; ++bj)
#pragma unroll
            for (int n = 0; n < 2; ++n) gv[bj][n] = *(const f32x4*)(gain + col0 + bj * HALF + n * 16);
#pragma unroll
        for (int ai = 0; ai < 2; ++ai)
#pragma unroll
            for (int m = 0; m < 4; ++m) { const int r = ai * HALF + wr * 64 + m * 16 + fr; const float rs = S[r]; const size_t off = (size_t)(u.pm * BM + r) * 1024 + col0;
#pragma unroll
                for (int bj = 0; bj < 2; ++bj)
#pragma unroll
                    for (int n = 0; n < 2; ++n) { const f32x4 v = acc[ai][bj][m][n]; const f32x4 o = v * rs * gv[bj][n];
                        if (Hout) *(f32x4*)(Hout + off + bj * HALF + n * 16) = v;
                        if (Nf) *(f32x4*)(Nf + off + bj * HALF + n * 16) = o;
                        if (Nb) { u32x2 w; w.x = cvt_pk_bf16(o[0], o[1]); w.y = cvt_pk_bf16(o[2], o[3]); *(u32x2*)(Nb + off + bj * HALF + n * 16) = w; } } }
    }
};

template <class Epi, class Sched, bool ALIGN_EPI = false, bool SP2 = false>
__device__ __forceinline__ void gemm_phase(PG8_LAS unsigned char* lds, const Gemm g, const Sched& S, const Epi& E) {
    const int tid = threadIdx.x, wid = __builtin_amdgcn_readfirstlane(tid >> 6), lane = tid & 63, wr = wid >> 2, wc = wid & 3, fr = lane & 15, fq = lane >> 4;
    const int K = g.K, nt = K / BK;
    unsigned voffA[2], voffB[2];
#pragma unroll
    for (int i = 0; i < 2; ++i) { int R, C; stage_rc(tid * 16 + i * 8192, R, C); const int Rb = Epi::PERM ? ((R & ~31) + perm32(R & 31)) : R;
        voffA[i] = (unsigned)(R * K + C) * 2u; voffB[i] = (unsigned)(Rb * K + C) * 2u; }
    const size_t kstep = (size_t)(BK * 2);
    const size_t hstep = (size_t)HALF * K * 2;
    const size_t tstep = 2 * hstep;
    const unsigned ldsw = (unsigned)wid * 1024u;
    const int aoff = lds_byte(wr * 64 + fr, fq * 8), boff = lds_byte(wc * 32 + fr, fq * 8);
#define PG8_SA(b, h) (((b) * 2 + (h)) * HTB)
#define PG8_SB(b, h) ((4 + (b) * 2 + (h)) * HTB)
#define PG8_STAGE(bufoff, gbase, voff) do { _Pragma("unroll") for (int _i = 0; _i < 2; ++_i) \
        __builtin_amdgcn_global_load_lds((const unsigned*)((const char*)(gbase) + (voff)[_i]), (PG8_LAS unsigned*)(lds + (bufoff) + ldsw + _i * 8192), 16, 0, 0); } while (0)
#define PG8_LDA(dst, b, h) do { _Pragma("unroll") for (int m = 0; m < 4; ++m) _Pragma("unroll") for (int k = 0; k < 2; ++k) dst[m][k] = *(const PG8_LAS bf16x8*)(lds + PG8_SA(b, h) + aoff + m * 2048 + k * 1024); } while (0)
#define PG8_LDB(dst, b, h) do { _Pragma("unroll") for (int n = 0; n < 2; ++n) _Pragma("unroll") for (int k = 0; k < 2; ++k) dst[n][k] = *(const PG8_LAS bf16x8*)(lds + PG8_SB(b, h) + boff + n * 2048 + k * 1024); } while (0)
#define PG8_MMA(ai, bj, At, Bt) do { __builtin_amdgcn_s_setprio(1); _Pragma("unroll") for (int m = 0; m < 4; ++m) _Pragma("unroll") for (int n = 0; n < 2; ++n) _Pragma("unroll") for (int k = 0; k < 2; ++k) \
        acc[ai][bj][m][n] = __builtin_amdgcn_mfma_f32_16x16x32_bf16(Bt[n][k], At[m][k], acc[ai][bj][m][n], 0, 0, 0); __builtin_amdgcn_s_setprio(0); } while (0)
#define PG8_WAIT_V(n) asm volatile("s_waitcnt vmcnt(" #n ")" ::: "memory")
#define PG8_WAIT_L(n) asm volatile("s_waitcnt lgkmcnt(" #n ")" ::: "memory")
#define PG8_BAR __builtin_amdgcn_s_barrier()
#define PG8_SCHED __builtin_amdgcn_sched_barrier(0)
    Unit cur, nxt; int ui = 0;
    if (!S.next(0, cur)) return;
    f32x4 acc[2][2][4][2];
#pragma unroll
    for (int a = 0; a < 2; ++a)
#pragma unroll
        for (int b = 0; b < 2; ++b)
#pragma unroll
            for (int m = 0; m < 4; ++m)
#pragma unroll
                for (int n = 0; n < 2; ++n) acc[a][b][m][n] = (f32x4){0.f, 0.f, 0.f, 0.f};
    bf16x8 At[4][2], B0[2][2], B1[2][2];
    const char* cA = S.pa(g, cur, tstep); const char* cB = S.pb(g, cur, tstep);
    S.a_ready(cur);
    if constexpr (SP2) {
        PG8_STAGE(PG8_SB(0, 0), cB, voffB); PG8_STAGE(PG8_SB(0, 1), cB + hstep, voffB); PG8_STAGE(PG8_SA(0, 0), cA, voffA); PG8_STAGE(PG8_SA(0, 1), cA + hstep, voffA);
        if (wr == 1) PG8_BAR;
        PG8_WAIT_V(2); PG8_BAR;
        PG8_STAGE(PG8_SB(1, 0), cB + kstep, voffB); PG8_STAGE(PG8_SA(1, 0), cA + kstep, voffA); PG8_STAGE(PG8_SB(1, 1), cB + hstep + kstep, voffB);
        PG8_WAIT_V(6); PG8_BAR;
    } else {
        PG8_STAGE(PG8_SB(0, 0), cB, voffB); PG8_STAGE(PG8_SA(0, 0), cA, voffA); PG8_STAGE(PG8_SB(0, 1), cB + hstep, voffB); PG8_STAGE(PG8_SA(0, 1), cA + hstep, voffA);
        if (wr == 1) PG8_BAR;
        PG8_WAIT_V(4); PG8_BAR;
        PG8_STAGE(PG8_SB(1, 0), cB + kstep, voffB); PG8_STAGE(PG8_SA(1, 0), cA + kstep, voffA); PG8_STAGE(PG8_SB(1, 1), cB + hstep + kstep, voffB);
        PG8_WAIT_V(6); PG8_BAR;
    }
    for (;;) {
        const bool has_next = S.next(ui + 1, nxt);
        const char* nA = has_next ? S.pa(g, nxt, tstep) : cA; const char* nB = has_next ? S.pb(g, nxt, tstep) : cB;
        for (int t = 0; t < nt; t += 2) {
            const bool last = (t == nt - 2);
            const char* a1 = cA + (size_t)(t + 1) * kstep;
            const char* a2 = last ? nA : cA + (size_t)(t + 2) * kstep; const char* b2 = last ? nB : cB + (size_t)(t + 2) * kstep;
            const char* a3 = a2 + kstep; const char* b3 = b2 + kstep;
            if (last && has_next) S.a_ready(nxt);
            if constexpr (SP2) {
            PG8_LDB(B0, 0, 0); PG8_LDB(B1, 0, 1); PG8_SCHED; PG8_LDA(At, 0, 0); PG8_STAGE(PG8_SA(1, 1), a1 + hstep, voffA);
            PG8_WAIT_V(8); PG8_WAIT_L(0); PG8_BAR; PG8_MMA(0, 0, At, B0); PG8_MMA(0, 1, At, B1); PG8_BAR; PG8_SCHED;
            PG8_LDA(At, 0, 1); PG8_STAGE(PG8_SB(0, 0), b2, voffB); PG8_STAGE(PG8_SB(0, 1), b2 + hstep, voffB); PG8_STAGE(PG8_SA(0, 0), a2, voffA);
            PG8_WAIT_V(8); PG8_WAIT_L(0); PG8_BAR; PG8_MMA(1, 0, At, B0); PG8_MMA(1, 1, At, B1); PG8_BAR; PG8_SCHED;
            PG8_LDB(B0, 1, 0); PG8_LDB(B1, 1, 1); PG8_SCHED; PG8_LDA(At, 1, 0); PG8_STAGE(PG8_SA(0, 1), a2 + hstep, voffA);
            PG8_WAIT_V(8); PG8_WAIT_L(0); PG8_BAR; PG8_MMA(0, 0, At, B0); PG8_MMA(0, 1, At, B1); PG8_BAR; PG8_SCHED;
            PG8_LDA(At, 1, 1); PG8_STAGE(PG8_SB(1, 0), b3, voffB); PG8_STAGE(PG8_SB(1, 1), b3 + hstep, voffB); PG8_STAGE(PG8_SA(1, 0), a3, voffA);
            PG8_WAIT_V(8); PG8_WAIT_L(0); PG8_BAR; PG8_MMA(1, 0, At, B0); PG8_MMA(1, 1, At, B1); PG8_BAR; PG8_SCHED;
            } else {
            PG8_LDB(B0, 0, 0); PG8_SCHED; PG8_LDA(At, 0, 0); PG8_STAGE(PG8_SA(1, 1), a1 + hstep, voffA);
            PG8_WAIT_L(8); PG8_BAR; PG8_WAIT_L(0); PG8_MMA(0, 0, At, B0); PG8_BAR; PG8_SCHED;
            PG8_LDB(B1, 0, 1); PG8_STAGE(PG8_SB(0, 0), b2, voffB);
            PG8_BAR; PG8_WAIT_L(0); PG8_MMA(0, 1, At, B1); PG8_BAR;
            PG8_LDA(At, 0, 1); PG8_STAGE(PG8_SA(0, 0), a2, voffA);
            PG8_BAR; PG8_WAIT_L(0); PG8_MMA(1, 0, At, B0); PG8_BAR; PG8_SCHED;
            PG8_STAGE(PG8_SB(0, 1), b2 + hstep, voffB);
            PG8_WAIT_V(6); PG8_BAR; PG8_MMA(1, 1, At, B1); PG8_BAR;
            PG8_LDB(B0, 1, 0); PG8_SCHED; PG8_LDA(At, 1, 0); PG8_STAGE(PG8_SA(0, 1), a2 + hstep, voffA);
            PG8_WAIT_L(8); PG8_BAR; PG8_WAIT_L(0); PG8_MMA(0, 0, At, B0); PG8_BAR; PG8_SCHED;
            PG8_LDB(B1, 1, 1); PG8_STAGE(PG8_SB(1, 0), b3, voffB);
            PG8_BAR; PG8_WAIT_L(0); PG8_MMA(0, 1, At, B1); PG8_BAR;
            PG8_LDA(At, 1, 1); PG8_STAGE(PG8_SA(1, 0), a3, voffA);
            PG8_BAR; PG8_WAIT_L(0); PG8_MMA(1, 0, At, B0); PG8_BAR; PG8_SCHED;
            PG8_STAGE(PG8_SB(1, 1), b3 + hstep, voffB);
            PG8_WAIT_V(6); PG8_BAR; PG8_MMA(1, 1, At, B1); PG8_BAR;
            }
        }
        if constexpr (ALIGN_EPI) { if (wr == 0) PG8_BAR; }
        if constexpr (!Epi::AFTER_DRAIN) { E(acc, cur, wr, wc, fr, fq); S.done(cur); }
        if (!has_next) break;
#pragma unroll
        for (int a = 0; a < 2; ++a)
#pragma unroll
            for (int b = 0; b < 2; ++b)
#pragma unroll
                for (int m = 0; m < 4; ++m)
#pragma unroll
                    for (int n = 0; n < 2; ++n) acc[a][b][m][n] = (f32x4){0.f, 0.f, 0.f, 0.f};
        cur = nxt; cA = nA; cB = nB; ++ui;
        if constexpr (ALIGN_EPI) { if (wr == 1) PG8_BAR; }
    }
    PG8_WAIT_V(0);
    if constexpr (!ALIGN_EPI) { if (wr == 0) PG8_BAR; }
    PG8_BAR;
    if constexpr (Epi::AFTER_DRAIN) { E.fused(acc, cur, wr, wc, fr, fq, lds, wid, lane); S.done(cur); }
#undef PG8_SA
#undef PG8_SB
#undef PG8_STAGE
#undef PG8_LDA
#undef PG8_LDB
#undef PG8_MMA
#undef PG8_WAIT_V
#undef PG8_WAIT_L
#undef PG8_BAR
#undef PG8_SCHED
}
}

namespace nsa {
#define NLAS __attribute__((address_space(3)))
typedef short bf16x8 __attribute__((ext_vector_type(8)));
typedef short s16x4 __attribute__((ext_vector_type(4)));
typedef short v4i16_t __attribute__((ext_vector_type(4)));
typedef float f32x4 __attribute__((ext_vector_type(4)));
typedef unsigned u32x4 __attribute__((ext_vector_type(4)));
typedef unsigned u32x2 __attribute__((ext_vector_type(2)));
typedef unsigned long long u64;
constexpr int RS = 144, TILE_B = 64 * RS;
constexpr float LOG2E = 1.4426950408889634f;
constexpr int L_KB0 = 0, L_VB0 = TILE_B, L_KB1 = 2 * TILE_B, L_VB1 = 3 * TILE_B, L_CK = 4 * TILE_B, L_CV = 8 * TILE_B, L_IMP = 12 * TILE_B, L_MSK = L_IMP + 8192, L_WU = L_MSK + 256, L_END = L_WU + 64;
static_assert(L_END <= 131072, "nsa LDS map");
__device__ __forceinline__ s16x4 vtr(const NLAS char* p) { return __builtin_bit_cast(s16x4, __builtin_amdgcn_ds_read_tr16_b64_v4i16((NLAS v4i16_t*)p)); }
__device__ __forceinline__ f32x4 mfma16(bf16x8 a, bf16x8 b, f32x4 c) { return __builtin_amdgcn_mfma_f32_16x16x32_bf16(a, b, c, 0, 0, 0); }
__device__ __forceinline__ unsigned pkbf(float lo, float hi) { return pg8::cvt_pk_bf16(lo, hi); }
__device__ __forceinline__ void qk_tile(f32x4 (&s)[4], const NLAS char* Kb, const bf16x8 (&qf)[2], int i, int g) {
    bf16x8 a[4][2]; const NLAS char* kp = Kb + i * RS + 16 * g;
#pragma unroll
    for (int kb = 0; kb < 4; ++kb) { a[kb][0] = *(const NLAS bf16x8*)(kp + kb * 16 * RS); a[kb][1] = *(const NLAS bf16x8*)(kp + kb * 16 * RS + 64); }
#pragma unroll
    for (int kb = 0; kb < 4; ++kb) s[kb] = mfma16(a[kb][0], qf[0], (f32x4){0.f, 0.f, 0.f, 0.f});
#pragma unroll
    for (int kb = 0; kb < 4; ++kb) s[kb] = mfma16(a[kb][1], qf[1], s[kb]);
}
__device__ __forceinline__ void pv_tile(f32x4 (&o)[4], const NLAS char* Vb, const f32x4 (&p)[4], int i, int g) {
    const NLAS char* vb = Vb + (4 * g + (i >> 2)) * RS + (i & 3) * 8;
    s16x4 lo[2][4], hi[2][4];
#pragma unroll
    for (int kk = 0; kk < 2; ++kk)
#pragma unroll
        for (int db = 0; db < 4; ++db) { const NLAS char* vp = vb + (2 * kk) * 16 * RS + db * 32; lo[kk][db] = vtr(vp); hi[kk][db] = vtr(vp + 16 * RS); }
    bf16x8 pf[2];
#pragma unroll
    for (int kk = 0; kk < 2; ++kk) { u32x4 pw; pw.x = pkbf(p[2 * kk][0], p[2 * kk][1]); pw.y = pkbf(p[2 * kk][2], p[2 * kk][3]); pw.z = pkbf(p[2 * kk + 1][0], p[2 * kk + 1][1]); pw.w = pkbf(p[2 * kk + 1][2], p[2 * kk + 1][3]);
        pf[kk] = __builtin_bit_cast(bf16x8, pw); }
#pragma unroll
    for (int kk = 0; kk < 2; ++kk)
#pragma unroll
        for (int db = 0; db < 4; ++db) o[db] = mfma16((bf16x8){lo[kk][db][0], lo[kk][db][1], lo[kk][db][2], lo[kk][db][3], hi[kk][db][0], hi[kk][db][1], hi[kk][db][2], hi[kk][db][3]}, pf[kk], o[db]);
}
__device__ __forceinline__ void online_tile(f32x4 (&s)[4], float& m, float& l, f32x4 (&o)[4], float kslope, float c, int base, int lo, int hi) {
    float mt = -INFINITY; const float bf = (float)base;
#pragma unroll
    for (int kb = 0; kb < 4; ++kb)
#pragma unroll
        for (int r = 0; r < 4; ++r) { const int pos = base + kb * 16 + r; float v = fmaf(s[kb][r], LOG2E, fmaf(kslope, bf + (float)(kb * 16 + r), c));
            v = (pos >= lo && pos <= hi) ? v : -INFINITY; s[kb][r] = v; mt = fmaxf(mt, v); }
    mt = fmaxf(mt, __shfl_xor(mt, 16)); mt = fmaxf(mt, __shfl_xor(mt, 32));
    const float mn = fmaxf(m, mt), ms = (mn == -INFINITY) ? 0.f : mn;
    const float alpha = __builtin_amdgcn_exp2f(m - ms);
    float sum = 0.f;
#pragma unroll
    for (int kb = 0; kb < 4; ++kb)
#pragma unroll
        for (int r = 0; r < 4; ++r) { const float p = __builtin_amdgcn_exp2f(s[kb][r] - ms); s[kb][r] = p; sum += p; }
    l = l * alpha + sum; m = mn;
#pragma unroll
    for (int db = 0; db < 4; ++db) o[db] = o[db] * alpha;
}
struct Stg { u32x4 k, v; };
__device__ __forceinline__ void stg_load(Stg& r, const bf16_t* kb, const bf16_t* vb, size_t pitch, int tid) { const size_t off = (size_t)(tid >> 3) * pitch + (tid & 7) * 8; r.k = *(const u32x4*)(kb + off); r.v = *(const u32x4*)(vb + off); }
__device__ __forceinline__ void stg_store(NLAS char* lds, int ko, int vo, const Stg& r, int tid) { const int off = (tid >> 3) * RS + (tid & 7) * 16; *(NLAS u32x4*)(lds + ko + off) = r.k; *(NLAS u32x4*)(lds + vo + off) = r.v; }
__device__ __forceinline__ float sigm(float v) { return __builtin_amdgcn_rcpf(1.f + __expf(-v)); }

__device__ __forceinline__ void unit(NLAS char* lds, const bf16_t* P, const float* S32, const bf16_t* KC, const bf16_t* VC, bf16_t* Ynsa, int b, int gq, int ti) {
    const int tid = threadIdx.x, lane = tid & 63, w = __builtin_amdgcn_readfirstlane(tid >> 6), i = lane & 15, g = lane >> 4;
    const int t0 = ti * 32, tl_mine = i >> 2, r = i & 3, h = gq * 4 + r, t = t0 + 4 * w + tl_mine; const size_t m = (size_t)b * T + t;
    const float slope2 = __builtin_amdgcn_exp2f(-(float)(h + 1)) * LOG2E;
    bf16x8 qf[2];
    { const bf16_t* qp = P + m * PW + P_NSQ + h * 64 + 8 * g;
#pragma unroll
      for (int ks = 0; ks < 2; ++ks) { const u32x4 raw = *(const u32x4*)(qp + 32 * ks); u32x4 sc;
          sc.x = pkbf(pg8::bflo(raw.x) * 0.125f, pg8::bfhi(raw.x) * 0.125f); sc.y = pkbf(pg8::bflo(raw.y) * 0.125f, pg8::bfhi(raw.y) * 0.125f);
          sc.z = pkbf(pg8::bflo(raw.z) * 0.125f, pg8::bfhi(raw.z) * 0.125f); sc.w = pkbf(pg8::bflo(raw.w) * 0.125f, pg8::bfhi(raw.w) * 0.125f);
          qf[ks] = __builtin_bit_cast(bf16x8, sc); } }
    const float* gp = S32 + m * 32 + 8 + h * 3;
    const float gate0 = sigm(gp[0]), gate1 = sigm(gp[1]), gate2 = sigm(gp[2]);
    f32x4 outacc[4];
#pragma unroll
    for (int db = 0; db < 4; ++db) outacc[db] = (f32x4){0.f, 0.f, 0.f, 0.f};
    const int ntc = (ti >> 5) + 1;
    for (int tile = 0; tile < ntc; ++tile) { Stg sr; const size_t row0 = ((size_t)(b * 256 + tile * 64) * 2 + gq) * 64; stg_load(sr, KC + row0, VC + row0, 128, tid); stg_store(lds, L_CK + tile * TILE_B, L_CV + tile * TILE_B, sr, tid); }
    __syncthreads();
    { const int nmax = (t - 31) >> 4; const float kslope = 16.f * slope2, c = -slope2 * (float)(t - 31);
      float mc = -INFINITY, lc = 0.f;
#pragma unroll 1
      for (int tile = 0; tile < ntc; ++tile) { f32x4 s[4]; qk_tile(s, lds + L_CK + tile * TILE_B, qf, i, g);
          float mt = -INFINITY;
#pragma unroll
          for (int kb = 0; kb < 4; ++kb)
#pragma unroll
              for (int rr = 0; rr < 4; ++rr) { const int n = tile * 64 + kb * 16 + 4 * g + rr; float v = fmaf(s[kb][rr], LOG2E, fmaf(kslope, (float)n, c)); v = (n <= nmax) ? v : -INFINITY; s[kb][rr] = v; mt = fmaxf(mt, v); }
          mt = fmaxf(mt, __shfl_xor(mt, 16)); mt = fmaxf(mt, __shfl_xor(mt, 32));
          const float mn = fmaxf(mc, mt), ms = (mn == -INFINITY) ? 0.f : mn; float sum = 0.f;
#pragma unroll
          for (int kb = 0; kb < 4; ++kb)
#pragma unroll
              for (int rr = 0; rr < 4; ++rr) sum += __builtin_amdgcn_exp2f(s[kb][rr] - ms);
          lc = lc * __builtin_amdgcn_exp2f(mc - ms) + sum; mc = mn; }
      lc += __shfl_xor(lc, 16); lc += __shfl_xor(lc, 32);
      const float ms = (mc == -INFINITY) ? 0.f : mc, inv = lc > 0.f ? 1.f / lc : 0.f;
      f32x4 oc[4];
#pragma unroll
      for (int db = 0; db < 4; ++db) oc[db] = (f32x4){0.f, 0.f, 0.f, 0.f};
      NLAS float* imp_s = (NLAS float*)(lds + L_IMP) + (w * 4 + tl_mine) * 64;
      float cprev = 0.f;
#pragma unroll 1
      for (int tile = 0; tile < 4; ++tile) {
          if (tile < ntc) { f32x4 s[4]; qk_tile(s, lds + L_CK + tile * TILE_B, qf, i, g);
#pragma unroll
              for (int kb = 0; kb < 4; ++kb)
#pragma unroll
                  for (int rr = 0; rr < 4; ++rr) { const int n = tile * 64 + kb * 16 + 4 * g + rr; float v = fmaf(s[kb][rr], LOG2E, fmaf(kslope, (float)n, c)); v = (n <= nmax) ? v : -INFINITY; s[kb][rr] = __builtin_amdgcn_exp2f(v - ms) * inv; }
              pv_tile(oc, lds + L_CV + tile * TILE_B, s, i, g);
#pragma unroll
              for (int kb = 0; kb < 4; ++kb) { const f32x4 pv = s[kb];
                  float a = (pv[0] + pv[1]) + (pv[2] + pv[3]), cc = pv[3];
                  a += __shfl_xor(a, 1); a += __shfl_xor(a, 2); cc += __shfl_xor(cc, 1); cc += __shfl_xor(cc, 2);
                  const float up = __shfl(cc, (lane + 48) & 63);
                  const float im = a + (g > 0 ? up : cprev); cprev = up;
                  if (r == 0) imp_s[4 * (tile * 4 + kb) + g] = im; }
          } else { if (r == 0) {
#pragma unroll
              for (int kb = 0; kb < 4; ++kb) imp_s[4 * (tile * 4 + kb) + g] = 0.f; } }
      }
#pragma unroll
      for (int db = 0; db < 4; ++db) outacc[db] = outacc[db] + oc[db] * gate0;
    }
    __syncthreads();
    NLAS float* impw = (NLAS float*)(lds + L_IMP) + w * 256;
    float myscore[4];
#pragma unroll
    for (int tl = 0; tl < 4; ++tl) { const int tt = t0 + 4 * w + tl, cur = tt >> 6, j = lane; const bool valid = j <= cur, forced = (j == 0) || (j == cur) || (j == cur - 1);
        const float s = valid ? impw[tl * 64 + j] + (forced ? 1000.f : 0.f) : -1e30f; myscore[tl] = s; }
    __syncthreads();
#pragma unroll
    for (int tl = 0; tl < 4; ++tl) impw[tl * 64 + lane] = myscore[tl];
    __syncthreads();
    u64 wmask[4], wun = 0ull;
#pragma unroll
    for (int tl = 0; tl < 4; ++tl) { const int tt = t0 + 4 * w + tl, cur = tt >> 6; const float s = myscore[tl]; int rank = 0;
        for (int jj = 0; jj < 64; ++jj) { const float o = impw[tl * 64 + jj]; rank += (o > s || (o == s && jj < lane)) ? 1 : 0; }
        wmask[tl] = __ballot(rank < 16 && lane <= cur); wun |= wmask[tl]; }
    if (lane == 0) { NLAS u64* mk = (NLAS u64*)(lds + L_MSK) + w * 4; mk[0] = wmask[0]; mk[1] = wmask[1]; mk[2] = wmask[2]; mk[3] = wmask[3]; ((NLAS u64*)(lds + L_WU))[w] = wun; }
    __syncthreads();
    const u64 mymask = ((const NLAS u64*)(lds + L_MSK))[w * 4 + tl_mine];
    u64 uall = 0ull;
#pragma unroll
    for (int ww = 0; ww < 8; ++ww) uall |= ((const NLAS u64*)(lds + L_WU))[ww];
    uall = ((u64)__builtin_amdgcn_readfirstlane((unsigned)(uall >> 32)) << 32) | (u64)__builtin_amdgcn_readfirstlane((unsigned)uall);
    const size_t rowb = (size_t)b * T;
    {
        float ms_ = -INFINITY, ls = 0.f; f32x4 os[4];
#pragma unroll
        for (int db = 0; db < 4; ++db) os[db] = (f32x4){0.f, 0.f, 0.f, 0.f};
        const bf16_t* kcol = P + rowb * PW + P_KS + gq * 64; const bf16_t* vcol = P + rowb * PW + P_VS + gq * 64;
        const float c = -slope2 * (float)t;
        u64 rem = uall; int j = __builtin_ctzll(rem); rem &= rem - 1; int cur = 0;
        Stg sr; stg_load(sr, kcol + (size_t)j * 64 * PW, vcol + (size_t)j * 64 * PW, PW, tid); stg_store(lds, L_KB0, L_VB0, sr, tid);
        int jn = rem ? __builtin_ctzll(rem) : -1; rem &= rem - 1;
        if (jn >= 0) stg_load(sr, kcol + (size_t)jn * 64 * PW, vcol + (size_t)jn * 64 * PW, PW, tid);
        __syncthreads();
        for (;;) {
            const int jnn = (jn >= 0 && rem) ? __builtin_ctzll(rem) : -1; rem &= rem - 1;
            if (jn >= 0) stg_store(lds, cur ? L_KB0 : L_KB1, cur ? L_VB0 : L_VB1, sr, tid);
            if (jnn >= 0) stg_load(sr, kcol + (size_t)jnn * 64 * PW, vcol + (size_t)jnn * 64 * PW, PW, tid);
            if ((wun >> j) & 1ull) { f32x4 s[4]; qk_tile(s, lds + (cur ? L_KB1 : L_KB0), qf, i, g);
                online_tile(s, ms_, ls, os, slope2, c, j * 64 + 4 * g, 0, ((mymask >> j) & 1ull) ? t : -1);
                pv_tile(os, lds + (cur ? L_VB1 : L_VB0), s, i, g); }
            __syncthreads();
            if (jn < 0) break;
            j = jn; jn = jnn; cur ^= 1;
        }
        ls += __shfl_xor(ls, 16); ls += __shfl_xor(ls, 32);
        const float sc1 = gate1 / ls;
#pragma unroll
        for (int db = 0; db < 4; ++db) outacc[db] = outacc[db] + os[db] * sc1;
    }
    {
        float mw = -INFINITY, lw = 0.f; f32x4 ow[4];
#pragma unroll
        for (int db = 0; db < 4; ++db) ow[db] = (f32x4){0.f, 0.f, 0.f, 0.f};
        const bf16_t* kcol = P + rowb * PW + P_KW + gq * 64; const bf16_t* vcol = P + rowb * PW + P_VW + gq * 64;
        const float c = -slope2 * (float)t;
        const int j0 = (t0 - 511) > 0 ? ((t0 - 511) >> 6) : 0, j1 = t0 >> 6, tw0 = t0 + 4 * w;
        int j = j0, cur = 0;
        Stg sr; stg_load(sr, kcol + (size_t)j * 64 * PW, vcol + (size_t)j * 64 * PW, PW, tid); stg_store(lds, L_KB0, L_VB0, sr, tid);
        if (j < j1) stg_load(sr, kcol + (size_t)(j + 1) * 64 * PW, vcol + (size_t)(j + 1) * 64 * PW, PW, tid);
        __syncthreads();
        for (;;) {
            if (j < j1) stg_store(lds, cur ? L_KB0 : L_KB1, cur ? L_VB0 : L_VB1, sr, tid);
            if (j + 1 < j1) stg_load(sr, kcol + (size_t)(j + 2) * 64 * PW, vcol + (size_t)(j + 2) * 64 * PW, PW, tid);
            if (64 * j <= tw0 + 3 && 64 * j + 63 >= tw0 - 511) { f32x4 s[4]; qk_tile(s, lds + (cur ? L_KB1 : L_KB0), qf, i, g);
                online_tile(s, mw, lw, ow, slope2, c, j * 64 + 4 * g, t - 511, t);
                pv_tile(ow, lds + (cur ? L_VB1 : L_VB0), s, i, g); }
            __syncthreads();
            if (j >= j1) break;
            ++j; cur ^= 1;
        }
        lw += __shfl_xor(lw, 16); lw += __shfl_xor(lw, 32);
        const float sc2 = gate2 / lw;
#pragma unroll
        for (int db = 0; db < 4; ++db) outacc[db] = outacc[db] + ow[db] * sc2;
    }
    bf16_t* yo = Ynsa + m * 512 + h * 64 + 4 * g;
#pragma unroll
    for (int db = 0; db < 4; ++db) { u32x2 v; v.x = pkbf(outacc[db][0], outacc[db][1]); v.y = pkbf(outacc[db][2], outacc[db][3]); *(u32x2*)(yo + db * 16) = v; }
}
__device__ __forceinline__ void phase(NLAS char* lds, const bf16_t* P, const float* S32, const bf16_t* KC, const bf16_t* VC, bf16_t* Ynsa) {
    const int G = gridDim.x, bid = blockIdx.x;
    if (G == 256) { const int base = bid >> 3, bg = bid & 7;
#pragma unroll 1
        for (int k = 0; k < 4; ++k) { const int ti = (k == 0) ? 127 - base : (k == 1) ? 64 + base : (k == 2) ? 63 - base : base; unit(lds, P, S32, KC, VC, Ynsa, bg >> 1, bg & 1, ti); } }
    else {
#pragma unroll 1
        for (int u = bid; u < 1024; u += G) unit(lds, P, S32, KC, VC, Ynsa, (u & 7) >> 1, u & 1, 127 - (u >> 3)); }
}
}

namespace xa {
using nsa::bf16x8; using nsa::s16x4; using nsa::f32x4; using nsa::u32x4; using nsa::u32x2; using nsa::vtr; using nsa::mfma16; using nsa::pkbf;
constexpr int RS = 272, TILE_B = 64 * RS;
constexpr int L_K0 = 0, L_V0 = TILE_B, L_K1 = 2 * TILE_B, L_V1 = 3 * TILE_B;
struct Stg { u32x4 k0, k1, v0, v1; };
__device__ __forceinline__ void stg_load(Stg& r, const bf16_t* kb, int tid) { const bf16_t* p = kb + (size_t)(tid >> 3) * 1024 + (tid & 7) * 8;
    r.k0 = *(const u32x4*)p; r.k1 = *(const u32x4*)(p + 64); r.v0 = *(const u32x4*)(p + 512); r.v1 = *(const u32x4*)(p + 576); }
__device__ __forceinline__ void stg_store(NLAS char* lds, int ko, int vo, const Stg& r, int tid) { const int off = (tid >> 3) * RS + (tid & 7) * 16;
    *(NLAS u32x4*)(lds + ko + off) = r.k0; *(NLAS u32x4*)(lds + ko + off + 128) = r.k1; *(NLAS u32x4*)(lds + vo + off) = r.v0; *(NLAS u32x4*)(lds + vo + off + 128) = r.v1; }
__device__ __forceinline__ void unit(NLAS char* lds, const bf16_t* P, const bf16_t* MEMKV, bf16_t* Yxa, int b, int h, int tt) {
    const int tid = threadIdx.x, lane = tid & 63, w = __builtin_amdgcn_readfirstlane(tid >> 6), i = lane & 15, g = lane >> 4;
    const size_t m = (size_t)b * T + tt * 128 + 16 * w + i;
    bf16x8 qf[4];
    { const bf16_t* qp = P + m * PW + P_XAQ + h * 128 + 8 * g;
#pragma unroll
      for (int ks = 0; ks < 4; ++ks) qf[ks] = *(const bf16x8*)(qp + 32 * ks); }
    const float scale2 = 0.08838834764831845f * nsa::LOG2E;
    float mx = -INFINITY, l = 0.f; f32x4 o[8];
#pragma unroll
    for (int db = 0; db < 8; ++db) o[db] = (f32x4){0.f, 0.f, 0.f, 0.f};
    const bf16_t* kbase = MEMKV + (size_t)b * 256 * 1024 + h * 128;
    { Stg sr; stg_load(sr, kbase, tid); stg_store(lds, L_K0, L_V0, sr, tid); }
    __syncthreads();
#pragma unroll 1
    for (int tile = 0; tile < 4; ++tile) { const int cur = tile & 1;
        Stg sr; if (tile < 3) stg_load(sr, kbase + (size_t)(tile + 1) * 64 * 1024, tid);
        const NLAS char* Kb = lds + (cur ? L_K1 : L_K0); const NLAS char* Vb = lds + (cur ? L_V1 : L_V0);
        f32x4 s[4];
#pragma unroll
        for (int kb = 0; kb < 4; ++kb) { const NLAS char* kp = Kb + (kb * 16 + i) * RS + 16 * g; f32x4 acc = (f32x4){0.f, 0.f, 0.f, 0.f};
#pragma unroll
            for (int ks = 0; ks < 4; ++ks) acc = mfma16(*(const NLAS bf16x8*)(kp + 64 * ks), qf[ks], acc);
            s[kb] = acc; }
        float mt = -INFINITY;
#pragma unroll
        for (int kb = 0; kb < 4; ++kb)
#pragma unroll
            for (int r = 0; r < 4; ++r) { const float v = s[kb][r] * scale2; s[kb][r] = v; mt = fmaxf(mt, v); }
        mt = fmaxf(mt, __shfl_xor(mt, 16)); mt = fmaxf(mt, __shfl_xor(mt, 32));
        const float mn = fmaxf(mx, mt), alpha = __builtin_amdgcn_exp2f(mx - mn); float sum = 0.f;
#pragma unroll
        for (int kb = 0; kb < 4; ++kb)
#pragma unroll
            for (int r = 0; r < 4; ++r) { const float p = __builtin_amdgcn_exp2f(s[kb][r] - mn); s[kb][r] = p; sum += p; }
        l = l * alpha + sum; mx = mn;
#pragma unroll
        for (int db = 0; db < 8; ++db) o[db] = o[db] * alpha;
        const NLAS char* vb = Vb + (4 * g + (i >> 2)) * RS + (i & 3) * 8;
#pragma unroll
        for (int kk = 0; kk < 2; ++kk) {
            u32x4 pw; pw.x = pkbf(s[2 * kk][0], s[2 * kk][1]); pw.y = pkbf(s[2 * kk][2], s[2 * kk][3]); pw.z = pkbf(s[2 * kk + 1][0], s[2 * kk + 1][1]); pw.w = pkbf(s[2 * kk + 1][2], s[2 * kk + 1][3]);
            const bf16x8 pf = __builtin_bit_cast(bf16x8, pw);
#pragma unroll
            for (int db = 0; db < 8; ++db) { const NLAS char* vp = vb + (2 * kk) * 16 * RS + db * 32; const s16x4 lo = vtr(vp), hi = vtr(vp + 16 * RS);
                o[db] = mfma16((bf16x8){lo[0], lo[1], lo[2], lo[3], hi[0], hi[1], hi[2], hi[3]}, pf, o[db]); }
        }
        if (tile < 3) stg_store(lds, cur ? L_K0 : L_K1, cur ? L_V0 : L_V1, sr, tid);
        __syncthreads();
    }
    l += __shfl_xor(l, 16); l += __shfl_xor(l, 32);
    const float inv = 1.f / l;
    bf16_t* yo = Yxa + m * 512 + h * 128 + 4 * g;
#pragma unroll
    for (int db = 0; db < 8; ++db) { u32x2 v; v.x = pkbf(o[db][0] * inv, o[db][1] * inv); v.y = pkbf(o[db][2] * inv, o[db][3] * inv); *(u32x2*)(yo + db * 16) = v; }
}
__device__ __forceinline__ void phase(NLAS char* lds, const bf16_t* P, const bf16_t* MEMKV, bf16_t* Yxa) {
#pragma unroll 1
    for (int u = blockIdx.x; u < 512; u += gridDim.x) unit(lds, P, MEMKV, Yxa, u >> 7, (u >> 5) & 3, u & 31);
}
}

namespace ml {
using nsa::bf16x8; using nsa::s16x4; using nsa::f32x4; using nsa::u32x4; using nsa::u32x2; using nsa::vtr; using nsa::mfma16; using nsa::pkbf;
constexpr int RS = 272, TB = 64 * RS, RSS = 144;
constexpr float KSCALE = 0.08838834764831845f;
__device__ __forceinline__ float scan_add(float v, int lane) {
#pragma unroll
    for (int o = 1; o < 64; o <<= 1) { const float u = __shfl_up(v, o); if (lane >= o) v += u; }
    return v; }
__device__ __forceinline__ float scan_max(float v, int lane) {
#pragma unroll
    for (int o = 1; o < 64; o <<= 1) { const float u = __shfl_up(v, o); if (lane >= o) v = fmaxf(v, u); }
    return v; }
__device__ __forceinline__ bf16x8 trpair(const NLAS char* p, int hi_off) { const s16x4 lo = vtr(p), hi = vtr(p + hi_off); return (bf16x8){lo[0], lo[1], lo[2], lo[3], hi[0], hi[1], hi[2], hi[3]}; }
__device__ __forceinline__ void load_conv(NLAS char* dst, const bf16_t* P, const float* cw, int colP, int cwc, size_t m0, int tseq0, int tid) {
    const int s = tid >> 3, c16 = (tid & 7) * 16;
#pragma unroll
    for (int half = 0; half < 2; ++half) { const int c = c16 + half * 8; float acc[8];
#pragma unroll
        for (int e = 0; e < 8; ++e) acc[e] = 0.f;
#pragma unroll
        for (int j = 0; j < 4; ++j) { if (tseq0 + s - j >= 0) { const u32x4 raw = *(const u32x4*)(P + (m0 + s - j) * PW + colP + c);
            const f32x4 w0 = *(const f32x4*)(cw + j * 1024 + cwc + c), w1 = *(const f32x4*)(cw + j * 1024 + cwc + c + 4);
            acc[0] += w0[0] * pg8::bflo(raw.x); acc[1] += w0[1] * pg8::bfhi(raw.x); acc[2] += w0[2] * pg8::bflo(raw.y); acc[3] += w0[3] * pg8::bfhi(raw.y);
            acc[4] += w1[0] * pg8::bflo(raw.z); acc[5] += w1[1] * pg8::bfhi(raw.z); acc[6] += w1[2] * pg8::bflo(raw.w); acc[7] += w1[3] * pg8::bfhi(raw.w); } }
#pragma unroll
        for (int e = 0; e < 8; ++e) acc[e] = acc[e] * __builtin_amdgcn_rcpf(1.f + __expf(-acc[e]));
        u32x4 o; o.x = pkbf(acc[0], acc[1]); o.y = pkbf(acc[2], acc[3]); o.z = pkbf(acc[4], acc[5]); o.w = pkbf(acc[6], acc[7]);
        *(NLAS u32x4*)(dst + s * RS + c * 2) = o; }
}
__device__ __forceinline__ void m1_unit(NLAS char* lds, const bf16_t* P, const float* cw, const float* S32, float* Abuf, float* NA, float* Gc, float* Mloc, int ci) {
    constexpr int L_K = 0, L_EV = TB, L_E = 2 * TB;
    const int tid = threadIdx.x, lane = tid & 63, w = __builtin_amdgcn_readfirstlane(tid >> 6), i = lane & 15, g = lane >> 4;
    const int c = ci & 63, bh = ci >> 6, h = bh & 3, b = bh >> 2; const size_t m0 = (size_t)b * T + c * 64;
    NLAS float* eS = (NLAS float*)(lds + L_E);
    if (w == 0) { const float fpre = S32[(m0 + lane) * 32 + 4 + h], ipre = S32[(m0 + lane) * 32 + h];
        const float bcs = scan_add(logsig(fpre), lane), gtot = __shfl(bcs, 63), wend = gtot - bcs + ipre, mloc = wave_max(wend);
        eS[lane] = __expf(wend - mloc) * KSCALE; if (lane == 0) { Gc[ci] = gtot; Mloc[ci] = mloc; } }
    load_conv(lds + L_K, P, cw, P_MLK + h * 128, 512 + h * 128, m0, c * 64, tid);
    __syncthreads();
    { const int s = tid >> 3, c16 = (tid & 7) * 16; const float es = eS[s]; const bf16_t* vp = P + (m0 + s) * PW + P_MLV + h * 128 + c16;
#pragma unroll
      for (int half = 0; half < 2; ++half) { const u32x4 raw = *(const u32x4*)(vp + half * 8); u32x4 o;
          o.x = pkbf(pg8::bflo(raw.x) * es, pg8::bfhi(raw.x) * es); o.y = pkbf(pg8::bflo(raw.y) * es, pg8::bfhi(raw.y) * es);
          o.z = pkbf(pg8::bflo(raw.z) * es, pg8::bfhi(raw.z) * es); o.w = pkbf(pg8::bflo(raw.w) * es, pg8::bfhi(raw.w) * es);
          *(NLAS u32x4*)(lds + L_EV + s * RS + (c16 + half * 8) * 2) = o; } }
    __syncthreads();
    f32x4 acc[8];
#pragma unroll
    for (int vb = 0; vb < 8; ++vb) acc[vb] = (f32x4){0.f, 0.f, 0.f, 0.f};
    const int rowoff = (4 * g + (i >> 2)) * RS + (i & 3) * 8;
#pragma unroll
    for (int kk = 0; kk < 2; ++kk) { const bf16x8 kf = trpair(lds + L_K + kk * 32 * RS + rowoff + w * 32, 16 * RS);
#pragma unroll
        for (int vb = 0; vb < 8; ++vb) acc[vb] = mfma16(trpair(lds + L_EV + kk * 32 * RS + rowoff + vb * 32, 16 * RS), kf, acc[vb]); }
    float* ap = Abuf + ((size_t)ci * 128 + w * 16 + i) * 128 + 4 * g;
#pragma unroll
    for (int vb = 0; vb < 8; ++vb) *(f32x4*)(ap + vb * 16) = acc[vb];
    if (tid < 128) { float n = 0.f; for (int s = 0; s < 64; ++s) n += eS[s] * bf2f(*(const NLAS bf16_t*)(lds + L_K + s * RS + tid * 2)); NA[(size_t)ci * 128 + tid] = n; }
    __syncthreads();
}
__device__ __forceinline__ void m2_items(float* Abuf, float* NA, const float* Gc, const float* Mloc, float* Mprev) {
    typedef float f32x2 __attribute__((ext_vector_type(2)));
    for (int it = blockIdx.x * blockDim.x + threadIdx.x; it < 16 * 128 * 64; it += gridDim.x * blockDim.x) {
        const int bh = it >> 13, kv2 = it & 8191, k = kv2 >> 6, v2 = kv2 & 63;
        f32x2 C = (f32x2){0.f, 0.f}; float n = 0.f, m = 0.f;
#pragma unroll 1
        for (int c0 = 0; c0 < 64; c0 += 8) { f32x2 A[8];
#pragma unroll
            for (int u = 0; u < 8; ++u) A[u] = *(const f32x2*)(Abuf + ((size_t)(bh * 64 + c0 + u) * 128 + k) * 128 + v2 * 2);
#pragma unroll
            for (int u = 0; u < 8; ++u) { const int ci = bh * 64 + c0 + u; const float gg = Gc[ci], ml = Mloc[ci];
                const float mn = fmaxf(gg + m, ml), a = __expf(gg + m - mn), bb = __expf(ml - mn);
                *(f32x2*)(Abuf + ((size_t)ci * 128 + k) * 128 + v2 * 2) = C; C = C * a + A[u] * bb;
                if (v2 == 0) { const float nA = NA[(size_t)ci * 128 + k]; NA[(size_t)ci * 128 + k] = n; n = a * n + bb * nA; }
                if (kv2 == 0) Mprev[ci] = m;
                m = mn; } }
    }
}
__device__ __forceinline__ void m3_unit(NLAS char* lds, const bf16_t* P, const float* cw, const float* S32, const float* Cprev, const float* Nprev, const float* Mprev, const float* normg, bf16_t* Yml, int ci) {
    constexpr int L_Q = 0, L_K = TB, L_V = 2 * TB, L_C = 3 * TB, L_S = 5 * TB, L_F = L_S + 64 * RSS;
    const int tid = threadIdx.x, lane = tid & 63, w = __builtin_amdgcn_readfirstlane(tid >> 6), i = lane & 15, g = lane >> 4;
    const int c = ci & 63, bh = ci >> 6, h = bh & 3, b = bh >> 2; const size_t m0 = (size_t)b * T + c * 64;
    NLAS float* F = (NLAS float*)(lds + L_F);
    NLAS float* rowf = F; NLAS float* colf = F + 64; NLAS float* scv = F + 128; NLAS float* emt = F + 192; NLAS float* qn = F + 256; NLAS float* nprev = F + 320; NLAS float* denp = F + 448; NLAS float* ssq = F + 576;
    if (w == 0) { const float fpre = S32[(m0 + lane) * 32 + 4 + h], ipre = S32[(m0 + lane) * 32 + h], mprev = Mprev[ci];
        const float bcs = scan_add(logsig(fpre), lane), u = ipre - bcs, pm = scan_max(u, lane), mt = bcs + fmaxf(mprev, pm);
        rowf[lane] = bcs - mt; colf[lane] = u; scv[lane] = __expf(bcs + mprev - mt); emt[lane] = __expf(-mt); }
    else if (w <= 2) nprev[tid - 64] = Nprev[(size_t)ci * 128 + tid - 64];
    load_conv(lds + L_Q, P, cw, P_MLQ + h * 128, h * 128, m0, c * 64, tid);
    load_conv(lds + L_K, P, cw, P_MLK + h * 128, 512 + h * 128, m0, c * 64, tid);
    { const int s = tid >> 3, c16 = (tid & 7) * 16; const bf16_t* vp = P + (m0 + s) * PW + P_MLV + h * 128 + c16;
      *(NLAS u32x4*)(lds + L_V + s * RS + c16 * 2) = *(const u32x4*)vp; *(NLAS u32x4*)(lds + L_V + s * RS + c16 * 2 + 16) = *(const u32x4*)(vp + 8); }
    { const int k = tid >> 2, v0 = (tid & 3) * 32; const float* cp = Cprev + ((size_t)ci * 128 + k) * 128 + v0;
#pragma unroll
      for (int q8 = 0; q8 < 4; ++q8) { const f32x4 a = *(const f32x4*)(cp + q8 * 8), bq = *(const f32x4*)(cp + q8 * 8 + 4); u32x4 o;
          o.x = pkbf(a[0], a[1]); o.y = pkbf(a[2], a[3]); o.z = pkbf(bq[0], bq[1]); o.w = pkbf(bq[2], bq[3]); *(NLAS u32x4*)(lds + L_C + k * RS + (v0 + q8 * 8) * 2) = o; } }
    __syncthreads();
    if (tid < 64) { float a = 0.f; for (int k = 0; k < 128; ++k) a += bf2f(*(const NLAS bf16_t*)(lds + L_Q + tid * RS + k * 2)) * nprev[k]; qn[tid] = a; }
    const int tb = w >> 1;
    {
        float rs[4] = {0.f, 0.f, 0.f, 0.f};
#pragma unroll
        for (int sbi = 0; sbi < 2; ++sbi) { const int sb = 2 * (w & 1) + sbi; f32x4 acc = (f32x4){0.f, 0.f, 0.f, 0.f};
            if (sb <= tb) {
#pragma unroll
                for (int ks = 0; ks < 4; ++ks) acc = mfma16(*(const NLAS bf16x8*)(lds + L_Q + (tb * 16 + i) * RS + (32 * ks + 8 * g) * 2), *(const NLAS bf16x8*)(lds + L_K + (sb * 16 + i) * RS + (32 * ks + 8 * g) * 2), acc); }
            const int s = sb * 16 + i; const float cf = colf[s];
#pragma unroll
            for (int r = 0; r < 4; ++r) { const int t = tb * 16 + 4 * g + r; const float v = (s <= t) ? acc[r] * KSCALE * __expf(rowf[t] + cf) : 0.f; rs[r] += v;
                *(NLAS bf16_t*)(lds + L_S + t * RSS + s * 2) = f2bf(v); } }
#pragma unroll
        for (int r = 0; r < 4; ++r) { float x = rs[r]; x += __shfl_xor(x, 1); x += __shfl_xor(x, 2); x += __shfl_xor(x, 4); x += __shfl_xor(x, 8); if (i == 0) denp[(w & 1) * 64 + tb * 16 + 4 * g + r] = x; }
    }
    __syncthreads();
    f32x4 a1[4], a2[4];
#pragma unroll
    for (int vb = 0; vb < 4; ++vb) { a1[vb] = (f32x4){0.f, 0.f, 0.f, 0.f}; a2[vb] = (f32x4){0.f, 0.f, 0.f, 0.f}; }
    const int vb0 = (w & 1) * 4, troff = (8 * g + (i >> 2)) * RS + (i & 3) * 8;
#pragma unroll
    for (int kk = 0; kk < 2; ++kk) { if (32 * kk <= tb * 16 + 15) { const bf16x8 sf = *(const NLAS bf16x8*)(lds + L_S + (tb * 16 + i) * RSS + (32 * kk + 8 * g) * 2);
#pragma unroll
        for (int vb = 0; vb < 4; ++vb) a1[vb] = mfma16(sf, trpair(lds + L_V + kk * 32 * RS + troff + (vb0 + vb) * 32, 4 * RS), a1[vb]); } }
#pragma unroll
    for (int ks = 0; ks < 4; ++ks) { const bf16x8 qf = *(const NLAS bf16x8*)(lds + L_Q + (tb * 16 + i) * RS + (32 * ks + 8 * g) * 2);
#pragma unroll
        for (int vb = 0; vb < 4; ++vb) a2[vb] = mfma16(qf, trpair(lds + L_C + ks * 32 * RS + troff + (vb0 + vb) * 32, 4 * RS), a2[vb]); }
    float hv[4][4], sq[4] = {0.f, 0.f, 0.f, 0.f};
#pragma unroll
    for (int r = 0; r < 4; ++r) { const int t = tb * 16 + 4 * g + r; const float sc = scv[t]; const float den = denp[t] + denp[64 + t] + sc * qn[t]; const float hd = 1.f / fmaxf(fabsf(den), emt[t]);
#pragma unroll
        for (int vb = 0; vb < 4; ++vb) { const float x = (a1[vb][r] + sc * a2[vb][r]) * hd; hv[vb][r] = x; sq[r] += x * x; } }
#pragma unroll
    for (int r = 0; r < 4; ++r) { float x = sq[r]; x += __shfl_xor(x, 1); x += __shfl_xor(x, 2); x += __shfl_xor(x, 4); x += __shfl_xor(x, 8); if (i == 0) ssq[(w & 1) * 64 + tb * 16 + 4 * g + r] = x; }
    __syncthreads();
#pragma unroll
    for (int r = 0; r < 4; ++r) { const int t = tb * 16 + 4 * g + r; const float rinv = rsqrtf((ssq[t] + ssq[64 + t]) * (1.f / 128.f) + EPS);
#pragma unroll
        for (int vb = 0; vb < 4; ++vb) { const int v = (vb0 + vb) * 16 + i; const float o = bf2f(P[(m0 + t) * PW + P_MLO + h * 128 + v]);
            Yml[(m0 + t) * 512 + h * 128 + v] = f2bf(__builtin_amdgcn_rcpf(1.f + __expf(-o)) * hv[vb][r] * rinv * normg[h * 128 + v]); } }
    __syncthreads();
}
}

namespace cmpr {
using nsa::bf16x8; using nsa::f32x4; using nsa::u32x4; using nsa::mfma16; using nsa::pkbf;
constexpr int RSX = 144, L_X = 0, L_PE = 272 * RSX  , L_H = L_PE + 8192, RSH = 528;
__device__ __forceinline__ void unit(NLAS char* lds, const bf16_t* P, const float* pe, const bf16_t* W1t, const bf16_t* W2t, bf16_t* KC, bf16_t* VC, int u) {
    const int tid = threadIdx.x, lane = tid & 63, w = __builtin_amdgcn_readfirstlane(tid >> 6), i = lane & 15, g = lane >> 4;
    const int nt = u & 15, gq = (u >> 4) & 1, b = (u >> 5) & 3, kv = u >> 7;
    const int pcol = (kv ? P_VC : P_KC) + gq * 64, tok0 = 256 * nt;
    for (int ch = tid; ch < 272 * 8; ch += 512) { const int row = ch >> 3, c8 = (ch & 7) * 8, tok = tok0 + row;
        u32x4 v = (u32x4){0u, 0u, 0u, 0u}; if (tok < T) v = *(const u32x4*)(P + ((size_t)b * T + tok) * PW + pcol + c8);
        *(NLAS u32x4*)(lds + L_X + row * RSX + c8 * 2) = v; }
    for (int e = tid; e < 2048; e += 512) ((NLAS float*)(lds + L_PE))[e] = pe[kv * 2048 + e];
    __syncthreads();
    f32x4 acc[2]; acc[0] = (f32x4){0.f, 0.f, 0.f, 0.f}; acc[1] = acc[0];
    const bf16_t* wb = W1t + ((size_t)kv * 256 + 32 * w + i) * 2048 + 8 * g;
#pragma unroll 1
    for (int k0 = 0; k0 < 64; k0 += 8) { bf16x8 bq[8][2];
#pragma unroll
        for (int kk = 0; kk < 8; ++kk) { bq[kk][0] = *(const bf16x8*)(wb + 32 * (k0 + kk)); bq[kk][1] = *(const bf16x8*)(wb + 16 * 2048 + 32 * (k0 + kk)); }
#pragma unroll
        for (int kk = 0; kk < 8; ++kk) { const int ks = k0 + kk, l = ks >> 1, dh = ks & 1;
            const u32x4 raw = *(const NLAS u32x4*)(lds + L_X + (16 * i + l) * RSX + dh * 64 + 16 * g);
            const NLAS float* pp = (const NLAS float*)(lds + L_PE) + l * 64 + dh * 32 + 8 * g; const f32x4 p0 = *(const NLAS f32x4*)pp, p1 = *(const NLAS f32x4*)(pp + 4);
            u32x4 a; a.x = pkbf(pg8::bflo(raw.x) + p0[0], pg8::bfhi(raw.x) + p0[1]); a.y = pkbf(pg8::bflo(raw.y) + p0[2], pg8::bfhi(raw.y) + p0[3]);
            a.z = pkbf(pg8::bflo(raw.z) + p1[0], pg8::bfhi(raw.z) + p1[1]); a.w = pkbf(pg8::bflo(raw.w) + p1[2], pg8::bfhi(raw.w) + p1[3]);
            const bf16x8 af = __builtin_bit_cast(bf16x8, a);
            acc[0] = mfma16(af, bq[kk][0], acc[0]); acc[1] = mfma16(af, bq[kk][1], acc[1]); } }
#pragma unroll
    for (int cb = 0; cb < 2; ++cb)
#pragma unroll
        for (int r = 0; r < 4; ++r) { const float x = acc[cb][r], uu = 0.7978845608028654f * (x + 0.044715f * x * x * x); const float gl = x * __builtin_amdgcn_rcpf(1.f + __expf(-2.f * uu));
            *(NLAS bf16_t*)(lds + L_H + (4 * g + r) * RSH + (32 * w + cb * 16 + i) * 2) = f2bf(gl); }
    __syncthreads();
    if (w < 4) { f32x4 o = (f32x4){0.f, 0.f, 0.f, 0.f}; const bf16_t* w2 = W2t + ((size_t)kv * 64 + 16 * w + i) * 256 + 8 * g;
#pragma unroll
        for (int ks = 0; ks < 8; ++ks) o = mfma16(*(const NLAS bf16x8*)(lds + L_H + i * RSH + (32 * ks + 8 * g) * 2), *(const bf16x8*)(w2 + 32 * ks), o);
        bf16_t* dst = (kv ? VC : KC);
#pragma unroll
        for (int r = 0; r < 4; ++r) dst[((size_t)(b * 256 + 16 * nt + 4 * g + r) * 2 + gq) * 64 + 16 * w + i] = f2bf(o[r]); }
    __syncthreads();
}
}

#define LAS __attribute__((address_space(3)))
constexpr int NTHREADS = 512, LDS_BYTES = 147456;
constexpr size_t WS_WIN = 1 * MiB, WS_WG = 9 * MiB, WS_WBR = 15 * MiB, WS_WOUT = 18 * MiB, WS_WFF1 = 20 * MiB, WS_WFF2 = 28 * MiB, WS_WMKV = 36 * MiB, WS_WC1 = 38 * MiB;
constexpr size_t WS_BIASP = 249 * MiB, WS_XCH = 250 * MiB;
#define XB_TMO      128
#define XB_XCNT(j)  (256  + 64 * (j))
#define XB_XSUB(j)  (1280 + 64 * (j))
#define XB_XGEN(j)  (2304 + 64 * (j))
#define XB_TOP      3328
#define XB_TOPGEN   3392
#define XCD_BAR_WORDS 3456
#define XB_SPIN_CAP (1u << 18)

__device__ __forceinline__ unsigned xb_ld(unsigned* p)              { return __hip_atomic_load(p, __ATOMIC_RELAXED, __HIP_MEMORY_SCOPE_AGENT); }
__device__ __forceinline__ unsigned xb_add(unsigned* p, unsigned v) { return __hip_atomic_fetch_add(p, v, __ATOMIC_RELAXED, __HIP_MEMORY_SCOPE_AGENT); }
__device__ __forceinline__ unsigned xb_xcc_id() { return (unsigned)__builtin_amdgcn_s_getreg((3 << 11) | 20) & 0xFu; }
#define XB_SPIN(cond, bar) do { unsigned _sp = 0; while (cond) { __builtin_amdgcn_s_sleep(1); \
    if ((++_sp & 255u) == 0u) { if (xb_ld(&(bar)[XB_TMO])) break; if (_sp > XB_SPIN_CAP) { atomicAdd(&(bar)[XB_TMO], 1u); break; } } } } while (0)

struct XcdBarrier {
    unsigned* bar; unsigned x;
    volatile LAS unsigned* st;
};

__device__ __forceinline__ XcdBarrier xcd_barrier_post(unsigned* bar, volatile LAS unsigned* st) {
    XcdBarrier b; b.bar = bar; b.x = xb_xcc_id(); b.st = st;
    if (threadIdx.x == 0) (void)xb_add(&bar[XB_XCNT(b.x)], 1u);
    return b;
}
__device__ __forceinline__ void xcd_barrier_complete(unsigned* bar, unsigned x, unsigned& nloc, unsigned& nx) {
    const unsigned G = gridDim.x * gridDim.y * gridDim.z;
    unsigned sum, cnt, mine, sp = 0u;
    for (;;) {
        sum = 0u; cnt = 0u; mine = 0u;
#pragma unroll
        for (unsigned j = 0; j < 16; ++j) { const unsigned c = xb_ld(&bar[XB_XCNT(j)]); sum += c; cnt += (c > 0u) ? 1u : 0u; mine = (j == x) ? c : mine; }
        if (sum == G) break;
        __builtin_amdgcn_s_sleep(1);
        if ((++sp & 255u) == 0u) { if (xb_ld(&bar[XB_TMO])) break; if (sp > XB_SPIN_CAP) { atomicAdd(&bar[XB_TMO], 1u); break; } }
    }
    nloc = mine > 0u ? mine : 1u; nx = cnt > 0u ? cnt : 1u;
}

__device__ __forceinline__ void xcd_barrier(const XcdBarrier& b) {
    asm volatile("s_waitcnt vmcnt(0)" ::: "memory");
    __syncthreads();
    if (threadIdx.x == 0) {
        unsigned* bar = b.bar;
        __builtin_amdgcn_s_waitcnt(0);
        unsigned nloc = b.st[0], nx = b.st[1];
        if (nloc == 0u) { xcd_barrier_complete(bar, b.x, nloc, nx); b.st[0] = nloc; b.st[1] = nx; }
        const unsigned old = xb_add(&bar[XB_XSUB(b.x)], 1u);
        const unsigned gen = old / nloc;
        if (old + 1u == (gen + 1u) * nloc) {
            __builtin_amdgcn_fence(__ATOMIC_RELEASE, "agent");
            asm volatile("s_waitcnt vmcnt(0)" ::: "memory");
            const unsigned og = xb_add(&bar[XB_TOP], 1u);
            const unsigned tg = og / nx;
            if (og + 1u == (tg + 1u) * nx) xb_add(&bar[XB_TOPGEN], 1u);
            else XB_SPIN(xb_ld(&bar[XB_TOPGEN]) == tg, bar);
            __builtin_amdgcn_fence(__ATOMIC_ACQUIRE, "agent");
            xb_add(&bar[XB_XGEN(b.x)], 1u);
            asm volatile("s_waitcnt vmcnt(0)" ::: "memory");
        } else {
            XB_SPIN(xb_ld(&bar[XB_XGEN(b.x)]) == gen, bar);
            __builtin_amdgcn_fence(__ATOMIC_ACQUIRE, "agent");
            asm volatile("s_waitcnt vmcnt(0)" ::: "memory");
        }
    }
    __syncthreads();
}

struct Args { const float* in[18]; float* out; unsigned char* ws; int ph_lo, ph_hi; };
template <int VT, class F> __device__ __forceinline__ void run_vb(int nvb, char* lds, F f) {
    constexpr int PER = NTHREADS / VT; const int sub = threadIdx.x / VT, tid = threadIdx.x % VT;
    for (int it = blockIdx.x; it * PER < nvb; it += gridDim.x) { VB vb{it * PER + sub, tid, lds + sub * (LDS_BYTES / PER)}; f(vb); __syncthreads(); }
}
__device__ __forceinline__ unsigned pk2(float lo, float hi) { return (unsigned)f2bf(lo) | ((unsigned)f2bf(hi) << 16); }
typedef unsigned v4u __attribute__((ext_vector_type(4)));
typedef float f32x4 __attribute__((ext_vector_type(4)));
__device__ __forceinline__ void tr_item(const float* W, int ld, int ncols, int K, bf16_t* WT, int row_off, LAS float* scr, int item, int lane) {
    const int nblk = ncols / 32, kb = item / nblk, nb = item % nblk, k0 = 64 * kb, n0 = 32 * nb;
#pragma unroll 8
    for (int i = 0; i < 32; ++i) { const int kk = 2 * i + (lane >> 5); scr[kk * 33 + (lane & 31)] = W[(size_t)(k0 + kk) * ld + n0 + (lane & 31)]; }
    asm volatile("s_waitcnt lgkmcnt(0)" ::: "memory");
    const int c = lane & 7;
#pragma unroll
    for (int j = 0; j < 4; ++j) { const int n = (lane >> 3) + 8 * j; const LAS float* s = scr + (8 * c) * 33 + n;
        v4u o; o.x = pk2(s[0 * 33], s[1 * 33]); o.y = pk2(s[2 * 33], s[3 * 33]); o.z = pk2(s[4 * 33], s[5 * 33]); o.w = pk2(s[6 * 33], s[7 * 33]);
        *(v4u*)(WT + (size_t)(row_off + n0 + n) * K + k0 + 8 * c) = o; }
    asm volatile("s_waitcnt lgkmcnt(0)" ::: "memory");
}
__device__ __forceinline__ void rms_row_wave(const float* xrow, const float* g, bf16_t* orow, int lane) {
    const f32x4* xr = (const f32x4*)xrow + lane; const f32x4* gr = (const f32x4*)g + lane;
    f32x4 v[4]; float s = 0.f;
#pragma unroll
    for (int j = 0; j < 4; ++j) { v[j] = xr[64 * j]; s += (v[j].x * v[j].x + v[j].y * v[j].y) + (v[j].z * v[j].z + v[j].w * v[j].w); }
    const float r = rsqrtf(wave_sum(s) * (1.f / D) + EPS);
    unsigned long long* o8 = (unsigned long long*)orow + lane;
#pragma unroll
    for (int j = 0; j < 4; ++j) { const f32x4 gg = gr[64 * j]; o8[64 * j] = (unsigned long long)pk2(v[j].x * r * gg.x, v[j].y * r * gg.y) | ((unsigned long long)pk2(v[j].z * r * gg.z, v[j].w * r * gg.w) << 32); }
}
__device__ __forceinline__ int small_src_col(int c) { return c < 8 ? C_MLI + c : C_NSG + (c - 8); }
__global__ void __launch_bounds__(NTHREADS, 2) mega(Args a) {
    extern __shared__ __attribute__((aligned(16))) unsigned char lds_raw[];
    char* lds = (char*)lds_raw;
    LAS unsigned char* lds3 = (LAS unsigned char*)lds_raw;
    const float* x = a.in[0]; const float* mem = a.in[1]; const float* g_mix = a.in[2]; const float* w_in = a.in[3];
    const float* b_in = a.in[4]; const float* ml_conv = a.in[5]; const float* ml_norm_g = a.in[6]; const float* cmp_pe = a.in[7];
    const float* cmp_w1 = a.in[8]; const float* cmp_w2 = a.in[9]; const float* g_mem = a.in[10]; const float* w_mem_kv = a.in[11];
    const float* w_branch = a.in[12]; const float* w_out = a.in[13]; const float* g_ffn = a.in[14]; const float* w_ff1 = a.in[15];
    const float* w_ff2 = a.in[16]; const float* g_final = a.in[17];
    char* ws = (char*)a.ws; float* out = a.out;
    bf16_t* U = (bf16_t*)(ws + WS_U); bf16_t* P = (bf16_t*)(ws + WS_P);
    bf16_t* Yml = (bf16_t*)(ws + WS_Y); bf16_t* Ynsa = Yml + (size_t)M * 512; bf16_t* Yxa = Ynsa + (size_t)M * 512;
    float* S32 = (float*)(ws + WS_S32); bf16_t* MEMN = (bf16_t*)(ws + WS_MEMN); bf16_t* MEMKV = (bf16_t*)(ws + WS_MEMKV);
    bf16_t* KC = (bf16_t*)(ws + WS_KC); bf16_t* VC = (bf16_t*)(ws + WS_VC);
    float* NA = (float*)(ws + WS_NA); float* Gc = (float*)(ws + WS_G); float* Mloc = (float*)(ws + WS_MLOC); float* Mprev = (float*)(ws + WS_MPREV);
    float* Abuf = out;
    bf16_t* GATES = P; bf16_t* MERGED = U; bf16_t* AFFN = (bf16_t*)(ws + WS_AFFN); bf16_t* HBUF = P;
    bf16_t* Wi = (bf16_t*)(ws + WS_WIN); bf16_t* Wg = (bf16_t*)(ws + WS_WG); bf16_t* Wbr = (bf16_t*)(ws + WS_WBR); bf16_t* Wo = (bf16_t*)(ws + WS_WOUT);
    bf16_t* Wf1 = (bf16_t*)(ws + WS_WFF1); bf16_t* Wf2 = (bf16_t*)(ws + WS_WFF2); bf16_t* Wmkv = (bf16_t*)(ws + WS_WMKV);
    float* biasP = (float*)(ws + WS_BIASP); bf16_t* Wc1 = (bf16_t*)(ws + WS_WC1); bf16_t* Wc2 = (bf16_t*)(ws + WS_BIASP + 65536);
    const int tid = threadIdx.x, lane = tid & 63, wave = __builtin_amdgcn_readfirstlane(tid >> 6);
    const int G = gridDim.x, bid = blockIdx.x;
    const int lo = a.ph_lo, hi = a.ph_hi;
    volatile LAS unsigned* xbst = (volatile LAS unsigned*)(lds3 + 131072 + 1024);
    if (tid < 2) xbst[tid] = 0u;
    __syncthreads();
    const XcdBarrier bar = xcd_barrier_post((unsigned*)ws, xbst);
#define PHASE(k) if (lo <= (k) && (k) < hi)
#define SEAM(k) if (lo <= (k) && (k) + 1 < hi) xcd_barrier(bar)
    PHASE(0) {
        LAS float* scr = (LAS float*)(lds3 + wave * 16384);
        const int gw = bid * 8 + wave, NGW = G * 8;
        constexpr int I0 = 16 * 64, I1 = 16 * 40, I2 = 16 * 16, I3 = 16 * 96, I4 = 8 * 32, I5 = 16 * 32, I6 = 16 * 128, I7 = 64 * 32, I8 = 16 * 32;
        constexpr int I9 = 32 * 8, I10 = 4 * 2;
        constexpr int NITEMS = I0 + I1 + I2 + I3 + 3 * I4 + I5 + I6 + I7 + I8 + 2 * I9 + 2 * I10;
        for (int it = gw; it < NITEMS; it += NGW) {
            int r = it;
            if (r < I0) { tr_item(w_in, DIN, 2048, 1024, Wi, 0, scr, r, lane); continue; } r -= I0;
            if (r < I1) { tr_item(w_in + 2056, DIN, 1280, 1024, Wi, 2048, scr, r, lane); continue; } r -= I1;
            if (r < I2) { tr_item(w_in + 3360, DIN, 512, 1024, Wi, 3328, scr, r, lane); continue; } r -= I2;
            if (r < I3) { tr_item(w_in + C_MG, DIN, 3072, 1024, Wg, 0, scr, r, lane); continue; } r -= I3;
            if (r < 3 * I4) { const int j = r / I4; tr_item(w_branch + (size_t)j * 512 * 1024, 1024, 1024, 512, Wbr + (size_t)j * 1024 * 512, 0, scr, r % I4, lane); continue; } r -= 3 * I4;
            if (r < I5) { tr_item(w_out, 1024, 1024, 1024, Wo, 0, scr, r, lane); continue; } r -= I5;
            if (r < I6) { tr_item(w_ff1, FF, FF, 1024, Wf1, 0, scr, r, lane); continue; } r -= I6;
            if (r < I7) { tr_item(w_ff2, 1024, 1024, FF, Wf2, 0, scr, r, lane); continue; } r -= I7;
            if (r < I8) { tr_item(w_mem_kv, 1024, 1024, 1024, Wmkv, 0, scr, r, lane); continue; } r -= I8;
            if (r < 2 * I9) { const int kv = r / I9; tr_item(cmp_w1 + (size_t)kv * 2048 * 256, 256, 256, 2048, Wc1 + (size_t)kv * 256 * 2048, 0, scr, r % I9, lane); continue; } r -= 2 * I9;
            { const int kv = r / I10; tr_item(cmp_w2 + (size_t)kv * 256 * 64, 64, 64, 256, Wc2 + (size_t)kv * 64 * 256, 0, scr, r % I10, lane); }
        }
        for (int i = bid * NTHREADS + tid; i < 256 * 1024; i += G * NTHREADS) { const int r = i >> 10, k = i & 1023; bf16_t v = 0;
            if (r < 32) v = f2bf(w_in[(size_t)k * DIN + small_src_col(r)]);
            else if (r >= 128 && r < 160) { const float w = w_in[(size_t)k * DIN + small_src_col(r - 128)]; v = f2bf(w - bf2f(f2bf(w))); }
            Wi[(size_t)(3840 + r) * 1024 + k] = v; }
        for (int c = bid * NTHREADS + tid; c < 4096; c += G * NTHREADS) { float v = 0.f;
            if (c < 2048) v = b_in[c]; else if (c < 3328) v = b_in[c + 8]; else if (c < 3840) v = b_in[c + 32]; else if (c < 3872) v = b_in[small_src_col(c - 3840)];
            biasP[c] = v; }
        for (int m = gw; m < M; m += NGW) rms_row_wave(x + (size_t)m * D, g_mix, U + (size_t)m * D, lane);
        for (int m = gw; m < 1024; m += NGW) rms_row_wave(mem + (size_t)m * D, g_mem, MEMN + (size_t)m * D, lane);
    }
    SEAM(0);
    PHASE(1) {
        { pg8::Gemm g{U, Wi, M, 4096, D}; pg8::StaticOrder S; S.init(M, 4096, G, bid);
          pg8::EpiStore<0> E{P, biasP, S32, PW, 15};
          pg8::gemm_phase<pg8::EpiStore<0>, pg8::StaticOrder, true, true>(lds3, g, S, E); }
        { pg8::Gemm g{MEMN, Wmkv, 1024, 1024, D}; pg8::StaticOrder S; S.init(1024, 1024, G, bid);
          pg8::EpiStore<0> E{MEMKV, nullptr, nullptr, 1024, -1};
          pg8::gemm_phase<pg8::EpiStore<0>, pg8::StaticOrder, true, true>(lds3, g, S, E); }
    }
    SEAM(1);
    PHASE(2) { for (int ci = bid; ci < 1024; ci += G) ml::m1_unit((NLAS char*)lds_raw, P, ml_conv, S32, Abuf, NA, Gc, Mloc, ci);
               for (int u = bid; u < 256; u += G) cmpr::unit((NLAS char*)lds_raw, P, cmp_pe, Wc1, Wc2, KC, VC, u);
               xa::phase((NLAS char*)lds_raw, P, MEMKV, Yxa); }
    SEAM(2);
    PHASE(3) { ml::m2_items(Abuf, NA, Gc, Mloc, Mprev);
               nsa::phase((NLAS char*)lds_raw, P, S32, KC, VC, Ynsa); }
    SEAM(3);
    PHASE(4) { for (int ci = bid; ci < 1024; ci += G) ml::m3_unit((NLAS char*)lds_raw, P, ml_conv, S32, Abuf, NA, Mprev, ml_norm_g, Yml, ci); }
    SEAM(4);
    PHASE(5) { pg8::Gemm g{U, Wg, M, 3072, D}; pg8::StaticOrder S; S.init(M, 3072, G, bid);
               pg8::EpiStore<1> E{GATES, b_in + C_MG, nullptr, 3072, -1};
               pg8::gemm_phase<pg8::EpiStore<1>, pg8::StaticOrder, true, true>(lds3, g, S, E); }
    SEAM(5);
    PHASE(6) { pg8::Gemm g{Yml, Wbr, M, 1024, 512}; pg8::MergeOrder S; S.so.init(M, 1024, G, bid); S.sa = (size_t)M * 512 * 2; S.sb = (size_t)1024 * 512 * 2;
               pg8::EpiMergeG E{GATES, out, MERGED};
               pg8::gemm_phase<pg8::EpiMergeG, pg8::MergeOrder, true, true>(lds3, g, S, E); }
    SEAM(6);
    PHASE(7) { pg8::Gemm g{MERGED, Wo, M, 1024, D}; pg8::StaticOrder S; S.init(M, 1024, G, bid);
               pg8::EpiResRms E{x, out, nullptr, AFFN, g_ffn, (float*)(ws + WS_XCH), (unsigned*)ws + 4096};
               pg8::gemm_phase<pg8::EpiResRms, pg8::StaticOrder, false, true>(lds3, g, S, E); }
    SEAM(7);
    PHASE(9) { pg8::Gemm g{AFFN, Wf1, M, FF, D}; pg8::StaticOrder S; S.init(M, FF, G, bid);
               pg8::EpiStore<2> E{HBUF, nullptr, nullptr, FF, -1};
               pg8::gemm_phase<pg8::EpiStore<2>, pg8::StaticOrder, true, true>(lds3, g, S, E); }
    SEAM(9);
    PHASE(10) { pg8::Gemm g{HBUF, Wf2, M, 1024, FF}; pg8::StaticOrder S; S.init(M, 1024, G, bid);
                pg8::EpiResRms E{out, nullptr, out, nullptr, g_final, (float*)(ws + WS_XCH + 262144), (unsigned*)ws + 4096 + 4096};
                pg8::gemm_phase<pg8::EpiResRms, pg8::StaticOrder, false, true>(lds3, g, S, E); }
}
constexpr int N_PHASES = 12;
#ifndef MK_PER_PHASE
#define MK_PER_PHASE 0
#endif
extern "C" void kernel_launch(void* const* d_in, const int* in_sizes, int n_in, void* d_out, int out_size, void* d_ws, size_t ws_size, hipStream_t stream) {
    static int grid = 0;
    if (grid == 0) {
        int dev = 0, cus = 0, per_cu = 0;
        (void)hipGetDevice(&dev); (void)hipDeviceGetAttribute(&cus, hipDeviceAttributeMultiprocessorCount, dev);
        (void)hipFuncSetAttribute((const void*)mega, hipFuncAttributeMaxDynamicSharedMemorySize, LDS_BYTES);
        (void)hipOccupancyMaxActiveBlocksPerMultiprocessor(&per_cu, (const void*)mega, NTHREADS, LDS_BYTES);
        if (per_cu < 1) { fprintf(stderr, "occupancy query says %d blocks/CU\n", per_cu); per_cu = 1; }
        grid = cus * 1;
        (void)hipGetLastError();
    }
    (void)hipMemsetAsync(d_ws, 0, 65536, stream);
    Args a{};
    for (int i = 0; i < 18; ++i) a.in[i] = (const float*)d_in[i];
    a.out = (float*)d_out; a.ws = (unsigned char*)d_ws;
#if MK_PER_PHASE
    for (int p = 0; p < N_PHASES; ++p) { a.ph_lo = p; a.ph_hi = p + 1; void* args[] = {&a};
        (void)hipLaunchCooperativeKernel((const void*)mega, dim3(grid), dim3(NTHREADS), args, LDS_BYTES, stream); }
#else
    a.ph_lo = 0; a.ph_hi = N_PHASES; void* args[] = {&a};
    hipError_t e = hipLaunchCooperativeKernel((const void*)mega, dim3(grid), dim3(NTHREADS), args, LDS_BYTES, stream);
    if (e != hipSuccess) fprintf(stderr, "cooperative launch failed: %s (grid %d)\n", hipGetErrorString(e), grid);
#endif
}
```

```cpp
#include <hip/hip_runtime.h>
#include <hip/hip_cooperative_groups.h>
#include <cstdio>
namespace cg = cooperative_groups;
#include <stdint.h>

typedef unsigned short bf16_t;
struct VB { int id; int tid; char* sm; };
__device__ __forceinline__ float bf2f(bf16_t v) { return __uint_as_float(((unsigned)v) << 16); }
__device__ __forceinline__ bf16_t f2bf(float f) { unsigned u = __float_as_uint(f); return (bf16_t)((u + 0x7fffu + ((u >> 16) & 1u)) >> 16); }

constexpr int NB = 4, T = 4096, M = NB * T, D = 1024, DIN = 6944, FF = 4096;
constexpr float EPS = 1e-6f;
constexpr int C_MLI = 2048, C_NSG = 3336, C_MG = 3872;
constexpr int P_MLQ = 0, P_MLK = 512, P_MLV = 1024, P_MLO = 1536, P_NSQ = 2048, P_KC = 2560, P_VC = 2688, P_KS = 2816, P_VS = 2944, P_KW = 3072, P_VW = 3200, P_XAQ = 3328, PW = 3840;
constexpr size_t MiB = 1u << 20;
constexpr size_t WS_U = 40 * MiB;
constexpr size_t WS_P = 72 * MiB;
constexpr size_t WS_Y = 192 * MiB;
constexpr size_t WS_AFFN = 200 * MiB;
constexpr size_t WS_S32 = 240 * MiB;
constexpr size_t WS_MEMN = 242 * MiB;
constexpr size_t WS_MEMKV = 244 * MiB;
constexpr size_t WS_KC = 246 * MiB;
constexpr size_t WS_VC = 246 * MiB + 512 * 1024;
constexpr size_t WS_NA = 247 * MiB;
constexpr size_t WS_G = 248 * MiB;
constexpr size_t WS_MLOC = 248 * MiB + 4096;
constexpr size_t WS_MPREV = 248 * MiB + 8192;

__device__ __forceinline__ float wave_sum(float v) {
#pragma unroll
    for (int o = 1; o < 64; o <<= 1) v += __shfl_xor(v, o);
    return v;
}
__device__ __forceinline__ float wave_max(float v) {
#pragma unroll
    for (int o = 1; o < 64; o <<= 1) v = fmaxf(v, __shfl_xor(v, o));
    return v;
}

template <bool OUT_BF16>
__device__ __forceinline__ void rms_rows(VB vb, const float* x, const float* g, void* out) {
    float* red = (float*)vb.sm;
    const int row = vb.id, tid = vb.tid;
    const float4 v = ((const float4*)(x + (size_t)row * D))[tid];
    float s = v.x * v.x + v.y * v.y + v.z * v.z + v.w * v.w;
    s = wave_sum(s);
    if ((tid & 63) == 0) red[tid >> 6] = s;
    __syncthreads();
    const float tot = red[0] + red[1] + red[2] + red[3];
    const float r = rsqrtf(tot * (1.0f / D) + EPS);
    const float4 gg = ((const float4*)g)[tid];
    float4 o; o.x = v.x * r * gg.x; o.y = v.y * r * gg.y; o.z = v.z * r * gg.z; o.w = v.w * r * gg.w;
    if (OUT_BF16) { bf16_t* ob = (bf16_t*)out + (size_t)row * D + tid * 4; ob[0] = f2bf(o.x); ob[1] = f2bf(o.y); ob[2] = f2bf(o.z); ob[3] = f2bf(o.w); }
    else ((float4*)((float*)out + (size_t)row * D))[tid] = o;
}

struct GArgs { const bf16_t* A; const float* W; int lda, ldw, N, K; };
template <class Epi>
__device__ __forceinline__ void ngemm(VB vb, GArgs ga, Epi epi) {
    const bf16_t* A = ga.A; const float* W = ga.W; const int lda = ga.lda, ldw = ga.ldw, N = ga.N, K = ga.K;
    float (*As)[65] = (float (*)[65])vb.sm; float (*Bs)[65] = (float (*)[65])(vb.sm + 16 * 65 * 4);
    const int tid = vb.tid, tx = tid & 15, ty = tid >> 4;
    const int nx = (N + 63) / 64; const int m0 = (vb.id / nx) * 64, n0 = (vb.id % nx) * 64;
    float acc[4][4];
#pragma unroll
    for (int i = 0; i < 4; ++i)
#pragma unroll
        for (int j = 0; j < 4; ++j) acc[i][j] = 0.f;
    for (int k0 = 0; k0 < K; k0 += 16) {
#pragma unroll
        for (int i = 0; i < 4; ++i) { const int idx = tid + i * 256, r = idx >> 4, kk = idx & 15; As[kk][r] = bf2f(A[(size_t)(m0 + r) * lda + k0 + kk]); }
#pragma unroll
        for (int i = 0; i < 4; ++i) { const int idx = tid + i * 256, kk = idx >> 6, n = idx & 63; Bs[kk][n] = (n0 + n < N) ? W[(size_t)(k0 + kk) * ldw + n0 + n] : 0.f; }
        __syncthreads();
#pragma unroll
        for (int kk = 0; kk < 16; ++kk) {
            float a[4], b[4];
#pragma unroll
            for (int i = 0; i < 4; ++i) { a[i] = As[kk][ty * 4 + i]; b[i] = Bs[kk][tx * 4 + i]; }
#pragma unroll
            for (int i = 0; i < 4; ++i)
#pragma unroll
                for (int j = 0; j < 4; ++j) acc[i][j] += a[i] * b[j];
        }
        __syncthreads();
    }
#pragma unroll
    for (int i = 0; i < 4; ++i)
#pragma unroll
        for (int j = 0; j < 4; ++j) { const int n = n0 + tx * 4 + j; if (n < N) epi(m0 + ty * 4 + i, n, acc[i][j]); }
}
struct EpiBiasBf16 { bf16_t* O; const float* bias; int ldo, pad; __device__ void operator()(int m, int n, float a) const { O[(size_t)m * ldo + n] = f2bf(a + (bias ? bias[n] : 0.f)); } };
struct EpiBiasF32 { float* O; const float* bias; int ldo, pad; __device__ void operator()(int m, int n, float a) const { O[(size_t)m * ldo + n] = a + bias[n]; } };
struct EpiSigBf16 { bf16_t* O; const float* bias; int ldo, pad; __device__ void operator()(int m, int n, float a) const { const float v = a + bias[n]; O[(size_t)m * ldo + n] = f2bf(1.f / (1.f + __expf(-v))); } };
struct EpiMerge { const bf16_t* G; float* Mf; bf16_t* Mb; int j, pad; __device__ void operator()(int m, int n, float a) const {
    const float g = bf2f(G[(size_t)m * 3072 + j * 1024 + n]); float v = g * a; if (j > 0) v += Mf[(size_t)m * D + n];
    if (j < 2) Mf[(size_t)m * D + n] = v; else Mb[(size_t)m * D + n] = f2bf(v); } };
struct EpiResid { const float* X; float* O; __device__ void operator()(int m, int n, float a) const { O[(size_t)m * D + n] = X[(size_t)m * D + n] + a; } };
struct EpiRelu2 { bf16_t* O; __device__ void operator()(int m, int n, float a) const { const float r = fmaxf(a, 0.f); O[(size_t)m * FF + n] = f2bf(r * r); } };

__device__ __forceinline__ float convqk(const bf16_t* P, const float* w  , int m, int t, int ch) {
    float y = 0.f;
#pragma unroll
    for (int j = 0; j < 4; ++j) if (t - j >= 0) y += w[j * 1024 + ch] * bf2f(P[(size_t)(m - j) * PW + ch]);
    return bf2f(f2bf(y / (1.f + __expf(-y))));
}
__device__ __forceinline__ float logsig(float x) { return fminf(x, 0.f) - log1pf(__expf(-fabsf(x))); }
__device__ __forceinline__ void m1_naive(VB vb, const bf16_t* P, const float* cw, const float* S32, float* Abuf, float* NA, float* Gc, float* Mloc) {
    float (*kk)[128] = (float (*)[128])vb.sm; float* e = (float*)(vb.sm + 32768); float* bc = e + 64;
    const int ci = vb.id, c = ci & 63, bh = ci >> 6, h = bh & 3, b = bh >> 2, tid = vb.tid;
    const int m0 = b * T + c * 64;
    if (tid == 0) {
        float run = 0.f;
        for (int s = 0; s < 64; ++s) { run += logsig(S32[(size_t)(m0 + s) * 32 + 4 + h]); bc[s] = run; }
        const float g = run; float mx = -INFINITY;
        for (int s = 0; s < 64; ++s) { const float w = g - bc[s] + S32[(size_t)(m0 + s) * 32 + h]; e[s] = w; mx = fmaxf(mx, w); }
        for (int s = 0; s < 64; ++s) e[s] = __expf(e[s] - mx);
        Gc[ci] = g; Mloc[ci] = mx;
    }
    for (int i = tid; i < 64 * 128; i += 256) { const int s = i >> 7, k = i & 127; kk[s][k] = convqk(P, cw, m0 + s, c * 64 + s, 512 + h * 128 + k) * 0.08838834764831845f; }
    __syncthreads();
    const int v = tid & 127, kh = tid >> 7;
    float acc[64];
#pragma unroll
    for (int i = 0; i < 64; ++i) acc[i] = 0.f;
    for (int s = 0; s < 64; ++s) {
        const float ev = e[s] * bf2f(P[(size_t)(m0 + s) * PW + P_MLV + h * 128 + v]);
#pragma unroll
        for (int i = 0; i < 64; ++i) acc[i] += kk[s][kh * 64 + i] * ev;
    }
#pragma unroll
    for (int i = 0; i < 64; ++i) Abuf[((size_t)ci * 128 + kh * 64 + i) * 128 + v] = acc[i];
    if (tid < 128) { float n = 0.f; for (int s = 0; s < 64; ++s) n += e[s] * kk[s][tid]; NA[(size_t)ci * 128 + tid] = n; }
}
__device__ __forceinline__ void m2_naive(VB vb, float* Abuf, float* NA, const float* Gc, const float* Mloc, float* Mprev) {
    const int i = vb.id * 256 + vb.tid;
    const int bh = i >> 14, kv = i & 16383, k = kv >> 7, v = kv & 127;
    float C = 0.f, n = 0.f, m = 0.f;
    for (int c = 0; c < 64; ++c) {
        const int ci = bh * 64 + c;
        const float g = Gc[ci], ml = Mloc[ci];
        const float mn = fmaxf(g + m, ml), a = __expf(g + m - mn), bb = __expf(ml - mn);
        const size_t idx = ((size_t)ci * 128 + k) * 128 + v;
        const float A = Abuf[idx]; Abuf[idx] = C; C = a * C + bb * A;
        if (v == 0) { const float nA = NA[(size_t)ci * 128 + k]; NA[(size_t)ci * 128 + k] = n; n = a * n + bb * nA; }
        if (kv == 0) Mprev[ci] = m;
        m = mn;
    }
}
__device__ __forceinline__ void m3_naive(VB vb, const bf16_t* P, const float* cw, const float* S32, const float* Cprev, const float* Nprev, const float* Mprev,
                                                const float* normg, bf16_t* Yml) {
    float* q = (float*)vb.sm; float* Srow = q + 128; float* bc = Srow + 64; float* li = bc + 64; float* sh = li + 64;
    const int ci = vb.id >> 6, tt = vb.id & 63, c = ci & 63, bh = ci >> 6, h = bh & 3, b = bh >> 2, tid = vb.tid;
    const int m0 = b * T + c * 64, m = m0 + tt;
    q[tid] = convqk(P, cw, m, c * 64 + tt, h * 128 + tid);
    if (tid == 0) { float run = 0.f; for (int s = 0; s <= tt; ++s) { run += logsig(S32[(size_t)(m0 + s) * 32 + 4 + h]); bc[s] = run; li[s] = S32[(size_t)(m0 + s) * 32 + h]; } }
    __syncthreads();
    const float mprev = Mprev[ci], inter = bc[tt] + mprev;
    float mt = inter;
    for (int s = 0; s <= tt; ++s) mt = fmaxf(mt, bc[tt] - bc[s] + li[s]);
    if (tid < 64) {
        float sv = 0.f;
        if (tid <= tt) { float dot = 0.f; for (int k = 0; k < 128; ++k) dot += q[k] * convqk(P, cw, m0 + tid, c * 64 + tid, 512 + h * 128 + k);
            sv = dot * 0.08838834764831845f * __expf(bc[tt] - bc[tid] + li[tid] - mt); }
        Srow[tid] = sv;
    }
    __syncthreads();
    const float sc = __expf(inter - mt);
    float num = 0.f, den = 0.f;
    for (int s = 0; s <= tt; ++s) { num += Srow[s] * bf2f(P[(size_t)(m0 + s) * PW + P_MLV + h * 128 + tid]); den += Srow[s]; }
    float qc = 0.f, qn = 0.f;
    for (int k = 0; k < 128; ++k) { qc += q[k] * Cprev[((size_t)ci * 128 + k) * 128 + tid]; qn += q[k] * Nprev[(size_t)ci * 128 + k]; }
    num += sc * qc; den += sc * qn;
    const float hv = num / fmaxf(fabsf(den), __expf(-mt));
    float ss = wave_sum(hv * hv);
    if ((tid & 63) == 0) sh[tid >> 6] = ss;
    __syncthreads();
    const float r = rsqrtf((sh[0] + sh[1]) * (1.f / 128.f) + EPS);
    const float o = bf2f(P[(size_t)m * PW + P_MLO + h * 128 + tid]);
    Yml[(size_t)m * 512 + h * 128 + tid] = f2bf(1.f / (1.f + __expf(-o)) * hv * r * normg[h * 128 + tid]);
}

__device__ __forceinline__ float gelu_tanh(float x) { const float u = 0.7978845608028654f * (x + 0.044715f * x * x * x); return 0.5f * x * (1.f + tanhf(u)); }
__device__ __forceinline__ void n1_naive(VB vb, const bf16_t* P, const float* pe  , const float* w1  , const float* w2  , bf16_t* KC, bf16_t* VC) {
    float* xin = (float*)vb.sm; float* hid = xin + 2048;
    int idx = vb.id; const int g = idx & 1; idx >>= 1; const int n = idx % 255; idx /= 255; const int b = idx & 3, kv = idx >> 2, tid = vb.tid;
    const int pcol = (kv ? P_VC : P_KC) + g * 64;
    for (int i = tid; i < 2048; i += 256) { const int l = i >> 6, d = i & 63; xin[i] = bf2f(P[(size_t)(b * T + n * 16 + l) * PW + pcol + d]) + pe[kv * 2048 + i]; }
    __syncthreads();
    float a = 0.f; const float* w = w1 + (size_t)kv * 2048 * 256 + tid;
    for (int i = 0; i < 2048; ++i) a += xin[i] * w[(size_t)i * 256];
    hid[tid] = gelu_tanh(a);
    __syncthreads();
    if (tid < 64) { float o = 0.f; const float* ww = w2 + (size_t)kv * 256 * 64 + tid; for (int j = 0; j < 256; ++j) o += hid[j] * ww[j * 64];
        (kv ? VC : KC)[((size_t)(b * 256 + n) * 2 + g) * 64 + tid] = f2bf(o); }
}
__device__ __forceinline__ void n2_naive(VB vb, const bf16_t* P, const float* S32, const bf16_t* KC, const bf16_t* VC, bf16_t* Ynsa) {
    float (*q_s)[64] = (float (*)[64])vb.sm; float (*sc)[1024] = (float (*)[1024])(vb.sm + 1024); float (*pc)[256] = (float (*)[256])(vb.sm + 1024 + 16384); float* imp_s = (float*)(vb.sm + 1024 + 16384 + 4096);
    unsigned long long& selmask = *(unsigned long long*)(vb.sm + 1024 + 16384 + 4096 + 256);
    const int g = vb.id & 1, m = vb.id >> 1, b = m / T, t = m % T, tid = vb.tid, r = tid >> 6, lane = tid & 63, h = g * 4 + r;
    const float slope = exp2f(-(float)(h + 1));
    q_s[r][lane] = bf2f(P[(size_t)m * PW + P_NSQ + h * 64 + lane]) * 0.125f;
    __syncthreads();
    float sv[4]; float mx = -INFINITY;
#pragma unroll
    for (int i = 0; i < 4; ++i) { const int n = lane + 64 * i; sv[i] = -INFINITY;
        if (n < 255) { const int dist = t - (16 * n + 31); if (dist >= 0) { const bf16_t* kr = KC + ((size_t)(b * 256 + n) * 2 + g) * 64; float dot = 0.f; for (int d = 0; d < 64; ++d) dot += q_s[r][d] * bf2f(kr[d]);
            sv[i] = dot - slope * (float)dist; mx = fmaxf(mx, sv[i]); } } }
    mx = wave_max(mx);
    float sum = 0.f;
#pragma unroll
    for (int i = 0; i < 4; ++i) { sv[i] = (sv[i] == -INFINITY) ? 0.f : __expf(sv[i] - mx); sum += sv[i]; }
    sum = wave_sum(sum);
    const float inv = sum > 0.f ? 1.f / sum : 0.f;
#pragma unroll
    for (int i = 0; i < 4; ++i) pc[r][lane + 64 * i] = sv[i] * inv;
    __syncthreads();
    float oc = 0.f;
    { const int nmax = (t >= 31) ? ((t - 31) / 16) : -1; for (int n = 0; n <= nmax && n < 255; ++n) oc += pc[r][n] * bf2f(VC[((size_t)(b * 256 + n) * 2 + g) * 64 + lane]); }
    if (tid < 64) { const int j = tid; float im = 0.f;
        for (int n = 4 * j - 1; n <= 4 * j + 3; ++n) if (n >= 0 && n < 255) im += (pc[0][n] + pc[1][n]) + (pc[2][n] + pc[3][n]);
        const int cur = t >> 6; const bool valid = j <= cur, forced = (j == 0) || (j == cur) || (j == cur - 1);
        const float s = valid ? im + (forced ? 1000.f : 0.f) : -1e30f;
        imp_s[j] = s; }
    __syncthreads();
    if (tid < 64) { const int j = tid; const float s = imp_s[j]; int rank = 0;
        for (int jj = 0; jj < 64; ++jj) { const float o = imp_s[jj]; rank += (o > s || (o == s && jj < j)) ? 1 : 0; }
        const unsigned long long mk = __ballot(rank < 16 && j <= (t >> 6)); if (tid == 0) selmask = mk; }
    __syncthreads();
    float osel = 0.f;
    { unsigned long long mk = selmask; int slot = 0; float mxs = -INFINITY;
      while (mk) { const int jb = __ffsll((long long)mk) - 1; mk &= mk - 1; const int pos = jb * 64 + lane; float s = -INFINITY;
          if (pos <= t) { const bf16_t* kr = P + (size_t)(b * T + pos) * PW + P_KS + g * 64; float dot = 0.f; for (int d = 0; d < 64; ++d) dot += q_s[r][d] * bf2f(kr[d]); s = dot - slope * (float)(t - pos); }
          sc[r][slot * 64 + lane] = s; mxs = fmaxf(mxs, s); ++slot; }
      mxs = wave_max(mxs); float sm = 0.f;
      for (int i = 0; i < slot; ++i) { const float s = sc[r][i * 64 + lane]; const float p = (s == -INFINITY) ? 0.f : __expf(s - mxs); sc[r][i * 64 + lane] = p; sm += p; }
      sm = wave_sum(sm);
      mk = selmask; slot = 0;
      while (mk) { const int jb = __ffsll((long long)mk) - 1; mk &= mk - 1;
          for (int i = 0; i < 64; ++i) { const int pos = jb * 64 + i; if (pos > t) break; osel += sc[r][slot * 64 + i] * bf2f(P[(size_t)(b * T + pos) * PW + P_VS + g * 64 + lane]); }
          ++slot; }
      osel /= sm; }
    __syncthreads();
    float owin = 0.f;
    { float mxs = -INFINITY;
      for (int i = 0; i < 8; ++i) { const int pos = t - 511 + i * 64 + lane; float s = -INFINITY;
          if (pos >= 0) { const bf16_t* kr = P + (size_t)(b * T + pos) * PW + P_KW + g * 64; float dot = 0.f; for (int d = 0; d < 64; ++d) dot += q_s[r][d] * bf2f(kr[d]); s = dot - slope * (float)(t - pos); }
          sc[r][i * 64 + lane] = s; mxs = fmaxf(mxs, s); }
      mxs = wave_max(mxs); float sm = 0.f;
      for (int i = 0; i < 8; ++i) { const float s = sc[r][i * 64 + lane]; const float p = (s == -INFINITY) ? 0.f : __expf(s - mxs); sc[r][i * 64 + lane] = p; sm += p; }
      sm = wave_sum(sm);
      for (int i = 0; i < 512; ++i) { const int pos = t - 511 + i; if (pos < 0) continue; owin += sc[r][i] * bf2f(P[(size_t)(b * T + pos) * PW + P_VW + g * 64 + lane]); }
      owin /= sm; }
    const float* gp = S32 + (size_t)m * 32 + 8 + h * 3;
    const float g0 = 1.f / (1.f + __expf(-gp[0])), g1 = 1.f / (1.f + __expf(-gp[1])), g2 = 1.f / (1.f + __expf(-gp[2]));
    Ynsa[(size_t)m * 512 + h * 64 + lane] = f2bf(g0 * oc + g1 * osel + g2 * owin);
}
__device__ __forceinline__ void x1_naive(VB vb, const bf16_t* P, const bf16_t* MEMKV, bf16_t* Yxa) {
    float (*q_s)[128] = (float (*)[128])vb.sm; float (*p_s)[256] = (float (*)[256])(vb.sm + 2048);
    const int m = vb.id, b = m / T, tid = vb.tid, h = tid >> 6, lane = tid & 63;
    q_s[h][lane] = bf2f(P[(size_t)m * PW + P_XAQ + h * 128 + lane]) * 0.08838834764831845f;
    q_s[h][lane + 64] = bf2f(P[(size_t)m * PW + P_XAQ + h * 128 + lane + 64]) * 0.08838834764831845f;
    __syncthreads();
    float sv[4]; float mx = -INFINITY;
#pragma unroll
    for (int i = 0; i < 4; ++i) { const int j = lane + 64 * i; const bf16_t* kr = MEMKV + (size_t)(b * 256 + j) * 1024 + h * 128; float dot = 0.f; for (int d = 0; d < 128; ++d) dot += q_s[h][d] * bf2f(kr[d]); sv[i] = dot; mx = fmaxf(mx, dot); }
    mx = wave_max(mx); float sm = 0.f;
#pragma unroll
    for (int i = 0; i < 4; ++i) { sv[i] = __expf(sv[i] - mx); sm += sv[i]; }
    sm = wave_sum(sm);
#pragma unroll
    for (int i = 0; i < 4; ++i) p_s[h][lane + 64 * i] = sv[i] / sm;
    __syncthreads();
    float o0 = 0.f, o1 = 0.f;
    for (int j = 0; j < 256; ++j) { const bf16_t* vr = MEMKV + (size_t)(b * 256 + j) * 1024 + 512 + h * 128; const float p = p_s[h][j]; o0 += p * bf2f(vr[lane]); o1 += p * bf2f(vr[lane + 64]); }
    Yxa[(size_t)m * 512 + h * 128 + lane] = f2bf(o0); Yxa[(size_t)m * 512 + h * 128 + lane + 64] = f2bf(o1);
}


namespace pg8 {
#define PG8_LAS __attribute__((address_space(3)))
typedef unsigned short bf16_t;
typedef short bf16x8 __attribute__((ext_vector_type(8)));
typedef float f32x4 __attribute__((ext_vector_type(4)));
typedef unsigned u32x4 __attribute__((ext_vector_type(4)));
constexpr int BM = 256, BK = 64, HALF = 128, HTB = HALF * BK * 2  , STAGE_BYTES = 8 * HTB, NXCD = 8, WGM = 8;

__host__ __device__ __forceinline__ int lds_byte(int r, int c) { const int st = (r >> 4) * 2 + (c >> 5), rr = r & 15, cc = c & 31, ob = rr * 64 + cc * 2; return st * 1024 + (ob ^ (((ob >> 9) & 1) << 5)); }
__host__ __device__ __forceinline__ void stage_rc(int b, int& R, int& C) { const int st = b / 1024, sb = b % 1024, swz = sb ^ (((sb >> 9) & 1) << 5); R = (st >> 1) * 16 + swz / 64; C = (st & 1) * 32 + (swz % 64) / 2; }
__host__ __device__ __forceinline__ int perm32(int rho) { const int n = rho >> 4, i = rho & 15; return 8 * (i >> 2) + 4 * n + (i & 3); }

struct Unit { int pm, pn, j; };
struct Gemm { const bf16_t* A; const bf16_t* Bt; int M, N, K; };

struct StaticOrder {
    int nM, nN, nwg, G, c;
    __host__ __device__ void init(int M, int N, int G_, int c_) { nM = M / BM; nN = N / BM; nwg = nM * nN; G = G_; c = c_; }
    __host__ __device__ bool next(int i, Unit& u) const {
        const long L = (long)i * G + c; if (L >= nwg) return false;
        int wgid = (int)L; { const int q = nwg / NXCD, r = nwg % NXCD, xcd = wgid % NXCD, off = wgid / NXCD; wgid = (xcd < r ? xcd * (q + 1) : r * (q + 1) + (xcd - r) * q) + off; }
        const int nig = WGM * nN, gid = wgid / nig, fm = gid * WGM, gsz = (nM - fm) < WGM ? (nM - fm) : WGM;
        u.pm = fm + ((wgid % nig) % gsz); u.pn = (wgid % nig) / gsz; u.j = 0; return true;
    }
    __device__ __forceinline__ const char* pa(const Gemm& g, const Unit& u, size_t tstep) const { return (const char*)g.A + (size_t)u.pm * tstep; }
    __device__ __forceinline__ const char* pb(const Gemm& g, const Unit& u, size_t tstep) const { return (const char*)g.Bt + (size_t)u.pn * tstep; }
    __device__ __forceinline__ void a_ready(const Unit&) const {}
    __device__ __forceinline__ void done(const Unit&) const {}
};

struct MergeOrder {
    StaticOrder so; size_t sa, sb;
    __device__ __forceinline__ bool next(int i, Unit& u) const { if (i >= 3) return false; const bool ok = so.next(0, u); u.j = i; return ok; }
    __device__ __forceinline__ const char* pa(const Gemm& g, const Unit& u, size_t tstep) const { return (const char*)g.A + (size_t)u.j * sa + (size_t)u.pm * tstep; }
    __device__ __forceinline__ const char* pb(const Gemm& g, const Unit& u, size_t tstep) const { return (const char*)g.Bt + (size_t)u.j * sb + (size_t)u.pn * tstep; }
    __device__ __forceinline__ void a_ready(const Unit&) const {}
    __device__ __forceinline__ void done(const Unit&) const {}
};
typedef float f32x2_t __attribute__((ext_vector_type(2))); typedef __bf16 bf16x2_t __attribute__((ext_vector_type(2)));
__device__ __forceinline__ unsigned cvt_pk_bf16(float lo, float hi) { f32x2_t v = {lo, hi}; bf16x2_t b = __builtin_convertvector(v, bf16x2_t); return __builtin_bit_cast(unsigned, b); }
typedef float f32x2 __attribute__((ext_vector_type(2)));

typedef unsigned u32x2 __attribute__((ext_vector_type(2)));
__device__ __forceinline__ float bflo(unsigned w) { return __uint_as_float(w << 16); }
__device__ __forceinline__ float bfhi(unsigned w) { return __uint_as_float(w & 0xffff0000u); }
template <int ACT> __device__ __forceinline__ f32x4 act4(f32x4 v) {
    if (ACT == 1) { f32x4 o; for (int e = 0; e < 4; ++e) o[e] = __builtin_amdgcn_rcpf(1.f + __expf(-v[e])); return o; }
    if (ACT == 2) { f32x4 o; for (int e = 0; e < 4; ++e) { const float r = fmaxf(v[e], 0.f); o[e] = r * r; } return o; }
    return v;
}
template <int ACT> struct EpiStore {
    static constexpr bool PERM = true, AFTER_DRAIN = false;
    bf16_t* O; const float* bias; float* S32; int ldc, small_pn;
    __device__ __forceinline__ void operator()(const f32x4 (&acc)[2][2][4][2], const Unit& u, int wr, int wc, int fr, int fq) const {
        asm volatile("s_waitcnt vmcnt(0)" ::: "memory");
        const int row0 = u.pm * BM + wr * 64 + fr, col0 = u.pn * BM + wc * 32 + 8 * fq;
        if (u.pn == small_pn) {
            if (wc == 0) {
                const f32x4 b0 = *(const f32x4*)(bias + col0), b1 = *(const f32x4*)(bias + col0 + 4);
#pragma unroll
                for (int ai = 0; ai < 2; ++ai)
#pragma unroll
                    for (int m = 0; m < 4; ++m) { float* rp = S32 + (size_t)(row0 + ai * HALF + m * 16) * 32 + 8 * fq;
                        *(f32x4*)rp = acc[ai][0][m][0] + acc[ai][1][m][0] + b0; *(f32x4*)(rp + 4) = acc[ai][0][m][1] + acc[ai][1][m][1] + b1; }
            }
            return;
        }
        f32x4 bv[2][2];
#pragma unroll
        for (int bj = 0; bj < 2; ++bj)
#pragma unroll
            for (int n = 0; n < 2; ++n) bv[bj][n] = bias ? *(const f32x4*)(bias + col0 + bj * HALF + 4 * n) : (f32x4){0.f, 0.f, 0.f, 0.f};
#pragma unroll
        for (int ai = 0; ai < 2; ++ai)
#pragma unroll
            for (int m = 0; m < 4; ++m) { bf16_t* rowp = O + (size_t)(row0 + ai * HALF + m * 16) * ldc + col0;
#pragma unroll
                for (int bj = 0; bj < 2; ++bj) { const f32x4 v0 = act4<ACT>(acc[ai][bj][m][0] + bv[bj][0]), v1 = act4<ACT>(acc[ai][bj][m][1] + bv[bj][1]);
                    u32x4 w; w.x = cvt_pk_bf16(v0[0], v0[1]); w.y = cvt_pk_bf16(v0[2], v0[3]); w.z = cvt_pk_bf16(v1[0], v1[1]); w.w = cvt_pk_bf16(v1[2], v1[3]);
                    *(u32x4*)(rowp + bj * HALF) = w; } }
    }
};
struct EpiMergeG {
    static constexpr bool PERM = true, AFTER_DRAIN = false;
    const bf16_t* G; float* Mf; bf16_t* Mb;
    __device__ __forceinline__ void operator()(const f32x4 (&acc)[2][2][4][2], const Unit& u, int wr, int wc, int fr, int fq) const {
        const int j = u.j;
        asm volatile("s_waitcnt vmcnt(0)" ::: "memory");
        const int row0 = u.pm * BM + wr * 64 + fr, col0 = u.pn * BM + wc * 32 + 8 * fq;
#pragma unroll
        for (int ai = 0; ai < 2; ++ai)
#pragma unroll
            for (int m = 0; m < 4; ++m) { const size_t row = (size_t)(row0 + ai * HALF + m * 16);
#pragma unroll
                for (int bj = 0; bj < 2; ++bj) { const int col = col0 + bj * HALF;
                    const u32x4 gw = *(const u32x4*)(G + row * 3072 + j * 1024 + col);
                    f32x4 v0 = (f32x4){bflo(gw.x), bfhi(gw.x), bflo(gw.y), bfhi(gw.y)} * acc[ai][bj][m][0], v1 = (f32x4){bflo(gw.z), bfhi(gw.z), bflo(gw.w), bfhi(gw.w)} * acc[ai][bj][m][1];
                    float* mp = Mf + row * 1024 + col;
                    if (j > 0) { v0 += *(const f32x4*)mp; v1 += *(const f32x4*)(mp + 4); }
                    if (j < 2) { *(f32x4*)mp = v0; *(f32x4*)(mp + 4) = v1; }
                    else { u32x4 w; w.x = cvt_pk_bf16(v0[0], v0[1]); w.y = cvt_pk_bf16(v0[2], v0[3]); w.z = cvt_pk_bf16(v1[0], v1[1]); w.w = cvt_pk_bf16(v1[2], v1[3]); *(u32x4*)(Mb + row * 1024 + col) = w; } } }
    }
};
struct EpiResidF {
    static constexpr bool PERM = true, AFTER_DRAIN = false;
    const float* X; float* O;
    __device__ __forceinline__ void operator()(const f32x4 (&acc)[2][2][4][2], const Unit& u, int wr, int wc, int fr, int fq) const {
        asm volatile("s_waitcnt vmcnt(0)" ::: "memory");
        const int row0 = u.pm * BM + wr * 64 + fr, col0 = u.pn * BM + wc * 32 + 8 * fq;
#pragma unroll
        for (int ai = 0; ai < 2; ++ai)
#pragma unroll
            for (int m = 0; m < 4; ++m) { const size_t off = (size_t)(row0 + ai * HALF + m * 16) * 1024 + col0;
#pragma unroll
                for (int bj = 0; bj < 2; ++bj) { const f32x4 x0 = *(const f32x4*)(X + off + bj * HALF), x1 = *(const f32x4*)(X + off + bj * HALF + 4);
                    *(f32x4*)(O + off + bj * HALF) = x0 + acc[ai][bj][m][0]; *(f32x4*)(O + off + bj * HALF + 4) = x1 + acc[ai][bj][m][1]; } }
    }
};
struct EpiResRms {
    static constexpr bool PERM = false, AFTER_DRAIN = true;
    const float* R; float* Hout; float* Nf; bf16_t* Nb; const float* gain; float* xbuf; unsigned* cnt;
    __device__ __forceinline__ void fused(f32x4 (&acc)[2][2][4][2], const Unit& u, int wr, int wc, int fr, int fq, PG8_LAS unsigned char* lds, int wid, int lane) const {
        PG8_LAS float* Pp = (PG8_LAS float*)lds; PG8_LAS float* S = (PG8_LAS float*)(lds + 4096);
        const int col0 = u.pn * BM + wc * 32 + 4 * fq;
#pragma unroll
        for (int ai = 0; ai < 2; ++ai)
#pragma unroll
            for (int m = 0; m < 4; ++m) { const size_t off = (size_t)(u.pm * BM + ai * HALF + wr * 64 + m * 16 + fr) * 1024 + col0; float sq = 0.f;
#pragma unroll
                for (int bj = 0; bj < 2; ++bj)
#pragma unroll
                    for (int n = 0; n < 2; ++n) { const f32x4 v = acc[ai][bj][m][n] + *(const f32x4*)(R + off + bj * HALF + n * 16); acc[ai][bj][m][n] = v; sq += (v[0] * v[0] + v[1] * v[1]) + (v[2] * v[2] + v[3] * v[3]); }
                sq += __shfl_xor(sq, 16); sq += __shfl_xor(sq, 32);
                if (fq == 0) Pp[(ai * HALF + wr * 64 + m * 16 + fr) * 4 + wc] = sq; }
        asm volatile("s_waitcnt lgkmcnt(0)" ::: "memory"); __builtin_amdgcn_s_barrier(); asm volatile("" ::: "memory");
        const int row = wid * 32 + (lane & 31);
        if (lane < 32) { const float tot = (Pp[row * 4 + 0] + Pp[row * 4 + 1]) + (Pp[row * 4 + 2] + Pp[row * 4 + 3]);
            __hip_atomic_store(xbuf + ((size_t)(u.pm * BM + row) * 4 + u.pn), tot, __ATOMIC_RELAXED, __HIP_MEMORY_SCOPE_AGENT); }
        asm volatile("s_waitcnt vmcnt(0)" ::: "memory");
        if (lane == 0) __hip_atomic_fetch_add(cnt + 64 * u.pm, 1u, __ATOMIC_RELAXED, __HIP_MEMORY_SCOPE_AGENT);
        if (wid == 0) { unsigned sp = 0;
            while ((unsigned)__builtin_amdgcn_readfirstlane(__hip_atomic_load(cnt + 64 * u.pm, __ATOMIC_RELAXED, __HIP_MEMORY_SCOPE_AGENT)) < 32u) { __builtin_amdgcn_s_sleep(2); if (++sp > (1u << 22)) break; }
            __builtin_amdgcn_fence(__ATOMIC_ACQUIRE, "agent"); }
        asm volatile("s_waitcnt vmcnt(0) lgkmcnt(0)" ::: "memory"); __builtin_amdgcn_s_barrier(); asm volatile("" ::: "memory");
        if (lane < 32) { const float* slot = xbuf + (size_t)(u.pm * BM + row) * 4; float t = 0.f;
#pragma unroll
            for (int q = 0; q < 4; ++q) t += __hip_atomic_load(slot + q, __ATOMIC_RELAXED, __HIP_MEMORY_SCOPE_AGENT);
            S[row] = rsqrtf(t * (1.0f / 1024.0f) + 1e-6f); }
        asm volatile("s_waitcnt lgkmcnt(0)" ::: "memory"); __builtin_amdgcn_s_barrier(); asm volatile("" ::: "memory");
        f32x4 gv[2][2];
#pragma unroll
        for (int bj = 0; bj < 2; ++bj)
#pragma unroll
            for (int n = 0; n < 2; ++n) gv[bj][n] = *(const f32x4*)(gain + col0 + bj * HALF + n * 16);
#pragma unroll
        for (int ai = 0; ai < 2; ++ai)
#pragma unroll
            for (int m = 0; m < 4; ++m) { const int r = ai * HALF + wr * 64 + m * 16 + fr; const float rs = S[r]; const size_t off = (size_t)(u.pm * BM + r) * 1024 + col0;
#pragma unroll
                for (int bj = 0; bj < 2; ++bj)
#pragma unroll
                    for (int n = 0; n < 2; ++n) { const f32x4 v = acc[ai][bj][m][n]; const f32x4 o = v * rs * gv[bj][n];
                        if (Hout) *(f32x4*)(Hout + off + bj * HALF + n * 16) = v;
                        if (Nf) *(f32x4*)(Nf + off + bj * HALF + n * 16) = o;
                        if (Nb) { u32x2 w; w.x = cvt_pk_bf16(o[0], o[1]); w.y = cvt_pk_bf16(o[2], o[3]); *(u32x2*)(Nb + off + bj * HALF + n * 16) = w; } } }
    }
};

template <class Epi, class Sched, bool ALIGN_EPI = false, bool SP2 = false>
__device__ __forceinline__ void gemm_phase(PG8_LAS unsigned char* lds, const Gemm g, const Sched& S, const Epi& E) {
    const int tid = threadIdx.x, wid = __builtin_amdgcn_readfirstlane(tid >> 6), lane = tid & 63, wr = wid >> 2, wc = wid & 3, fr = lane & 15, fq = lane >> 4;
    const int K = g.K, nt = K / BK;
    unsigned voffA[2], voffB[2];
#pragma unroll
    for (int i = 0; i < 2; ++i) { int R, C; stage_rc(tid * 16 + i * 8192, R, C); const int Rb = Epi::PERM ? ((R & ~31) + perm32(R & 31)) : R;
        voffA[i] = (unsigned)(R * K + C) * 2u; voffB[i] = (unsigned)(Rb * K + C) * 2u; }
    const size_t kstep = (size_t)(BK * 2);
    const size_t hstep = (size_t)HALF * K * 2;
    const size_t tstep = 2 * hstep;
    const unsigned ldsw = (unsigned)wid * 1024u;
    const int aoff = lds_byte(wr * 64 + fr, fq * 8), boff = lds_byte(wc * 32 + fr, fq * 8);
#define PG8_SA(b, h) (((b) * 2 + (h)) * HTB)
#define PG8_SB(b, h) ((4 + (b) * 2 + (h)) * HTB)
#define PG8_STAGE(bufoff, gbase, voff) do { _Pragma("unroll") for (int _i = 0; _i < 2; ++_i) \
        __builtin_amdgcn_global_load_lds((const unsigned*)((const char*)(gbase) + (voff)[_i]), (PG8_LAS unsigned*)(lds + (bufoff) + ldsw + _i * 8192), 16, 0, 0); } while (0)
#define PG8_LDA(dst, b, h) do { _Pragma("unroll") for (int m = 0; m < 4; ++m) _Pragma("unroll") for (int k = 0; k < 2; ++k) dst[m][k] = *(const PG8_LAS bf16x8*)(lds + PG8_SA(b, h) + aoff + m * 2048 + k * 1024); } while (0)
#define PG8_LDB(dst, b, h) do { _Pragma("unroll") for (int n = 0; n < 2; ++n) _Pragma("unroll") for (int k = 0; k < 2; ++k) dst[n][k] = *(const PG8_LAS bf16x8*)(lds + PG8_SB(b, h) + boff + n * 2048 + k * 1024); } while (0)
#define PG8_MMA(ai, bj, At, Bt) do { __builtin_amdgcn_s_setprio(1); _Pragma("unroll") for (int m = 0; m < 4; ++m) _Pragma("unroll") for (int n = 0; n < 2; ++n) _Pragma("unroll") for (int k = 0; k < 2; ++k) \
        acc[ai][bj][m][n] = __builtin_amdgcn_mfma_f32_16x16x32_bf16(Bt[n][k], At[m][k], acc[ai][bj][m][n], 0, 0, 0); __builtin_amdgcn_s_setprio(0); } while (0)
#define PG8_WAIT_V(n) asm volatile("s_waitcnt vmcnt(" #n ")" ::: "memory")
#define PG8_WAIT_L(n) asm volatile("s_waitcnt lgkmcnt(" #n ")" ::: "memory")
#define PG8_BAR __builtin_amdgcn_s_barrier()
#define PG8_SCHED __builtin_amdgcn_sched_barrier(0)
    Unit cur, nxt; int ui = 0;
    if (!S.next(0, cur)) return;
    f32x4 acc[2][2][4][2];
#pragma unroll
    for (int a = 0; a < 2; ++a)
#pragma unroll
        for (int b = 0; b < 2; ++b)
#pragma unroll
            for (int m = 0; m < 4; ++m)
#pragma unroll
                for (int n = 0; n < 2; ++n) acc[a][b][m][n] = (f32x4){0.f, 0.f, 0.f, 0.f};
    bf16x8 At[4][2], B0[2][2], B1[2][2];
    const char* cA = S.pa(g, cur, tstep); const char* cB = S.pb(g, cur, tstep);
    S.a_ready(cur);
    if constexpr (SP2) {
        PG8_STAGE(PG8_SB(0, 0), cB, voffB); PG8_STAGE(PG8_SB(0, 1), cB + hstep, voffB); PG8_STAGE(PG8_SA(0, 0), cA, voffA); PG8_STAGE(PG8_SA(0, 1), cA + hstep, voffA);
        if (wr == 1) PG8_BAR;
        PG8_WAIT_V(2); PG8_BAR;
        PG8_STAGE(PG8_SB(1, 0), cB + kstep, voffB); PG8_STAGE(PG8_SA(1, 0), cA + kstep, voffA); PG8_STAGE(PG8_SB(1, 1), cB + hstep + kstep, voffB);
        PG8_WAIT_V(6); PG8_BAR;
    } else {
        PG8_STAGE(PG8_SB(0, 0), cB, voffB); PG8_STAGE(PG8_SA(0, 0), cA, voffA); PG8_STAGE(PG8_SB(0, 1), cB + hstep, voffB); PG8_STAGE(PG8_SA(0, 1), cA + hstep, voffA);
        if (wr == 1) PG8_BAR;
        PG8_WAIT_V(4); PG8_BAR;
        PG8_STAGE(PG8_SB(1, 0), cB + kstep, voffB); PG8_STAGE(PG8_SA(1, 0), cA + kstep, voffA); PG8_STAGE(PG8_SB(1, 1), cB + hstep + kstep, voffB);
        PG8_WAIT_V(6); PG8_BAR;
    }
    for (;;) {
        const bool has_next = S.next(ui + 1, nxt);
        const char* nA = has_next ? S.pa(g, nxt, tstep) : cA; const char* nB = has_next ? S.pb(g, nxt, tstep) : cB;
        for (int t = 0; t < nt; t += 2) {
            const bool last = (t == nt - 2);
            const char* a1 = cA + (size_t)(t + 1) * kstep;
            const char* a2 = last ? nA : cA + (size_t)(t + 2) * kstep; const char* b2 = last ? nB : cB + (size_t)(t + 2) * kstep;
            const char* a3 = a2 + kstep; const char* b3 = b2 + kstep;
            if (last && has_next) S.a_ready(nxt);
            if constexpr (SP2) {
            PG8_LDB(B0, 0, 0); PG8_LDB(B1, 0, 1); PG8_SCHED; PG8_LDA(At, 0, 0); PG8_STAGE(PG8_SA(1, 1), a1 + hstep, voffA);
            PG8_WAIT_V(8); PG8_WAIT_L(0); PG8_BAR; PG8_MMA(0, 0, At, B0); PG8_MMA(0, 1, At, B1); PG8_BAR; PG8_SCHED;
            PG8_LDA(At, 0, 1); PG8_STAGE(PG8_SB(0, 0), b2, voffB); PG8_STAGE(PG8_SB(0, 1), b2 + hstep, voffB); PG8_STAGE(PG8_SA(0, 0), a2, voffA);
            PG8_WAIT_V(8); PG8_WAIT_L(0); PG8_BAR; PG8_MMA(1, 0, At, B0); PG8_MMA(1, 1, At, B1); PG8_BAR; PG8_SCHED;
            PG8_LDB(B0, 1, 0); PG8_LDB(B1, 1, 1); PG8_SCHED; PG8_LDA(At, 1, 0); PG8_STAGE(PG8_SA(0, 1), a2 + hstep, voffA);
            PG8_WAIT_V(8); PG8_WAIT_L(0); PG8_BAR; PG8_MMA(0, 0, At, B0); PG8_MMA(0, 1, At, B1); PG8_BAR; PG8_SCHED;
            PG8_LDA(At, 1, 1); PG8_STAGE(PG8_SB(1, 0), b3, voffB); PG8_STAGE(PG8_SB(1, 1), b3 + hstep, voffB); PG8_STAGE(PG8_SA(1, 0), a3, voffA);
            PG8_WAIT_V(8); PG8_WAIT_L(0); PG8_BAR; PG8_MMA(1, 0, At, B0); PG8_MMA(1, 1, At, B1); PG8_BAR; PG8_SCHED;
            } else {
            PG8_LDB(B0, 0, 0); PG8_SCHED; PG8_LDA(At, 0, 0); PG8_STAGE(PG8_SA(1, 1), a1 + hstep, voffA);
            PG8_WAIT_L(8); PG8_BAR; PG8_WAIT_L(0); PG8_MMA(0, 0, At, B0); PG8_BAR; PG8_SCHED;
            PG8_LDB(B1, 0, 1); PG8_STAGE(PG8_SB(0, 0), b2, voffB);
            PG8_BAR; PG8_WAIT_L(0); PG8_MMA(0, 1, At, B1); PG8_BAR;
            PG8_LDA(At, 0, 1); PG8_STAGE(PG8_SA(0, 0), a2, voffA);
            PG8_BAR; PG8_WAIT_L(0); PG8_MMA(1, 0, At, B0); PG8_BAR; PG8_SCHED;
            PG8_STAGE(PG8_SB(0, 1), b2 + hstep, voffB);
            PG8_WAIT_V(6); PG8_BAR; PG8_MMA(1, 1, At, B1); PG8_BAR;
            PG8_LDB(B0, 1, 0); PG8_SCHED; PG8_LDA(At, 1, 0); PG8_STAGE(PG8_SA(0, 1), a2 + hstep, voffA);
            PG8_WAIT_L(8); PG8_BAR; PG8_WAIT_L(0); PG8_MMA(0, 0, At, B0); PG8_BAR; PG8_SCHED;
            PG8_LDB(B1, 1, 1); PG8_STAGE(PG8_SB(1, 0), b3, voffB);
            PG8_BAR; PG8_WAIT_L(0); PG8_MMA(0, 1, At, B1); PG8_BAR;
            PG8_LDA(At, 1, 1); PG8_STAGE(PG8_SA(1, 0), a3, voffA);
            PG8_BAR; PG8_WAIT_L(0); PG8_MMA(1, 0, At, B0); PG8_BAR; PG8_SCHED;
            PG8_STAGE(PG8_SB(1, 1), b3 + hstep, voffB);
            PG8_WAIT_V(6); PG8_BAR; PG8_MMA(1, 1, At, B1); PG8_BAR;
            }
        }
        if constexpr (ALIGN_EPI) { if (wr == 0) PG8_BAR; }
        if constexpr (!Epi::AFTER_DRAIN) { E(acc, cur, wr, wc, fr, fq); S.done(cur); }
        if (!has_next) break;
#pragma unroll
        for (int a = 0; a < 2; ++a)
#pragma unroll
            for (int b = 0; b < 2; ++b)
#pragma unroll
                for (int m = 0; m < 4; ++m)
#pragma unroll
                    for (int n = 0; n < 2; ++n) acc[a][b][m][n] = (f32x4){0.f, 0.f, 0.f, 0.f};
        cur = nxt; cA = nA; cB = nB; ++ui;
        if constexpr (ALIGN_EPI) { if (wr == 1) PG8_BAR; }
    }
    PG8_WAIT_V(0);
    if constexpr (!ALIGN_EPI) { if (wr == 0) PG8_BAR; }
    PG8_BAR;
    if constexpr (Epi::AFTER_DRAIN) { E.fused(acc, cur, wr, wc, fr, fq, lds, wid, lane); S.done(cur); }
#undef PG8_SA
#undef PG8_SB
#undef PG8_STAGE
#undef PG8_LDA
#undef PG8_LDB
#undef PG8_MMA
#undef PG8_WAIT_V
#undef PG8_WAIT_L
#undef PG8_BAR
#undef PG8_SCHED
}
}

namespace nsa {
#define NLAS __attribute__((address_space(3)))
typedef short bf16x8 __attribute__((ext_vector_type(8)));
typedef short s16x4 __attribute__((ext_vector_type(4)));
typedef short v4i16_t __attribute__((ext_vector_type(4)));
typedef float f32x4 __attribute__((ext_vector_type(4)));
typedef unsigned u32x4 __attribute__((ext_vector_type(4)));
typedef unsigned u32x2 __attribute__((ext_vector_type(2)));
typedef unsigned long long u64;
constexpr int RS = 144, TILE_B = 64 * RS;
constexpr float LOG2E = 1.4426950408889634f;
constexpr int L_KB0 = 0, L_VB0 = TILE_B, L_KB1 = 2 * TILE_B, L_VB1 = 3 * TILE_B, L_CK = 4 * TILE_B, L_CV = 8 * TILE_B, L_IMP = 12 * TILE_B, L_MSK = L_IMP + 8192, L_WU = L_MSK + 256, L_END = L_WU + 64;
static_assert(L_END <= 131072, "nsa LDS map");
__device__ __forceinline__ s16x4 vtr(const NLAS char* p) { return __builtin_bit_cast(s16x4, __builtin_amdgcn_ds_read_tr16_b64_v4i16((NLAS v4i16_t*)p)); }
__device__ __forceinline__ f32x4 mfma16(bf16x8 a, bf16x8 b, f32x4 c) { return __builtin_amdgcn_mfma_f32_16x16x32_bf16(a, b, c, 0, 0, 0); }
__device__ __forceinline__ unsigned pkbf(float lo, float hi) { return pg8::cvt_pk_bf16(lo, hi); }
__device__ __forceinline__ void qk_tile(f32x4 (&s)[4], const NLAS char* Kb, const bf16x8 (&qf)[2], int i, int g, float kslope, float bt) {
    bf16x8 a[4][2]; const NLAS char* kp = Kb + i * RS + 16 * g;
#pragma unroll
    for (int kb = 0; kb < 4; ++kb) { a[kb][0] = *(const NLAS bf16x8*)(kp + kb * 16 * RS); a[kb][1] = *(const NLAS bf16x8*)(kp + kb * 16 * RS + 64); }
#pragma unroll
    for (int kb = 0; kb < 4; ++kb) { f32x4 ci; ci[0] = fmaf(kslope, (float)(kb * 16 + 0), bt); ci[1] = fmaf(kslope, (float)(kb * 16 + 1), bt); ci[2] = fmaf(kslope, (float)(kb * 16 + 2), bt); ci[3] = fmaf(kslope, (float)(kb * 16 + 3), bt);
        s[kb] = mfma16(a[kb][0], qf[0], ci); }
#pragma unroll
    for (int kb = 0; kb < 4; ++kb) s[kb] = mfma16(a[kb][1], qf[1], s[kb]);
}
__device__ __forceinline__ void pv_tile(f32x4 (&o)[4], const NLAS char* Vb, const f32x4 (&p)[4], int i, int g) {
    const NLAS char* vb = Vb + (4 * g + (i >> 2)) * RS + (i & 3) * 8;
    s16x4 lo[2][4], hi[2][4];
#pragma unroll
    for (int kk = 0; kk < 2; ++kk)
#pragma unroll
        for (int db = 0; db < 4; ++db) { const NLAS char* vp = vb + (2 * kk) * 16 * RS + db * 32; lo[kk][db] = vtr(vp); hi[kk][db] = vtr(vp + 16 * RS); }
    bf16x8 pf[2];
#pragma unroll
    for (int kk = 0; kk < 2; ++kk) { u32x4 pw; pw.x = pkbf(p[2 * kk][0], p[2 * kk][1]); pw.y = pkbf(p[2 * kk][2], p[2 * kk][3]); pw.z = pkbf(p[2 * kk + 1][0], p[2 * kk + 1][1]); pw.w = pkbf(p[2 * kk + 1][2], p[2 * kk + 1][3]);
        pf[kk] = __builtin_bit_cast(bf16x8, pw); }
#pragma unroll
    for (int kk = 0; kk < 2; ++kk)
#pragma unroll
        for (int db = 0; db < 4; ++db) o[db] = mfma16((bf16x8){lo[kk][db][0], lo[kk][db][1], lo[kk][db][2], lo[kk][db][3], hi[kk][db][0], hi[kk][db][1], hi[kk][db][2], hi[kk][db][3]}, pf[kk], o[db]);
}
constexpr float THR = 6.0f;
template <bool FIRST>
__device__ __forceinline__ void online_tile(f32x4 (&s)[4], float& m, float& l, f32x4 (&o)[4], bool needmask, int base, int lo, int hi) {
    if (needmask) {
#pragma unroll
        for (int kb = 0; kb < 4; ++kb)
#pragma unroll
            for (int r = 0; r < 4; ++r) { const int pos = base + kb * 16 + r; s[kb][r] = (pos >= lo && pos <= hi) ? s[kb][r] : -INFINITY; } }
    float mt = fmaxf(fmaxf(fmaxf(s[0][0], s[0][1]), fmaxf(s[0][2], s[0][3])), fmaxf(fmaxf(s[1][0], s[1][1]), fmaxf(s[1][2], s[1][3])));
    mt = fmaxf(mt, fmaxf(fmaxf(fmaxf(s[2][0], s[2][1]), fmaxf(s[2][2], s[2][3])), fmaxf(fmaxf(s[3][0], s[3][1]), fmaxf(s[3][2], s[3][3]))));
    mt = fmaxf(mt, __shfl_xor(mt, 16)); mt = fmaxf(mt, __shfl_xor(mt, 32));
    if (FIRST || __any(mt > THR)) { const float d = FIRST ? mt : fmaxf(mt, 0.f), f = __builtin_amdgcn_exp2f(-d); m += d; l *= f;
#pragma unroll
        for (int db = 0; db < 4; ++db) o[db] = o[db] * f;
#pragma unroll
        for (int kb = 0; kb < 4; ++kb) s[kb] = s[kb] - d; }
    float sum = 0.f;
#pragma unroll
    for (int kb = 0; kb < 4; ++kb)
#pragma unroll
        for (int r = 0; r < 4; ++r) { const float p = __builtin_amdgcn_exp2f(s[kb][r]); s[kb][r] = p; sum += p; }
    l += sum;
}
struct Stg { u32x4 k, v; };
__device__ __forceinline__ void stg_load(Stg& r, const bf16_t* kb, const bf16_t* vb, size_t pitch, int tid) { const size_t off = (size_t)(tid >> 3) * pitch + (tid & 7) * 8; r.k = *(const u32x4*)(kb + off); r.v = *(const u32x4*)(vb + off); }
__device__ __forceinline__ void stg_store(NLAS char* lds, int ko, int vo, const Stg& r, int tid) { const int off = (tid >> 3) * RS + (tid & 7) * 16; *(NLAS u32x4*)(lds + ko + off) = r.k; *(NLAS u32x4*)(lds + vo + off) = r.v; }
__device__ __forceinline__ float sigm(float v) { return __builtin_amdgcn_rcpf(1.f + __expf(-v)); }

__device__ __forceinline__ void unit(NLAS char* lds, const bf16_t* P, const float* S32, const bf16_t* KC, const bf16_t* VC, bf16_t* Ynsa, int b, int gq, int ti) {
    const int tid = threadIdx.x, lane = tid & 63, w = __builtin_amdgcn_readfirstlane(tid >> 6), i = lane & 15, g = lane >> 4;
    const int t0 = ti * 32, tl_mine = i >> 2, r = i & 3, h = gq * 4 + r, t = t0 + 4 * w + tl_mine; const size_t m = (size_t)b * T + t;
    const float slope2 = __builtin_amdgcn_exp2f(-(float)(h + 1)) * LOG2E;
    bf16x8 qf[2]; constexpr float QS = 0.125f * LOG2E;
    { const bf16_t* qp = P + m * PW + P_NSQ + h * 64 + 8 * g;
#pragma unroll
      for (int ks = 0; ks < 2; ++ks) { const u32x4 raw = *(const u32x4*)(qp + 32 * ks); u32x4 sc;
          sc.x = pkbf(pg8::bflo(raw.x) * QS, pg8::bfhi(raw.x) * QS); sc.y = pkbf(pg8::bflo(raw.y) * QS, pg8::bfhi(raw.y) * QS);
          sc.z = pkbf(pg8::bflo(raw.z) * QS, pg8::bfhi(raw.z) * QS); sc.w = pkbf(pg8::bflo(raw.w) * QS, pg8::bfhi(raw.w) * QS);
          qf[ks] = __builtin_bit_cast(bf16x8, sc); } }
    const float* gp = S32 + m * 32 + 8 + h * 3;
    const float gate0 = sigm(gp[0]), gate1 = sigm(gp[1]), gate2 = sigm(gp[2]);
    f32x4 outacc[4];
#pragma unroll
    for (int db = 0; db < 4; ++db) outacc[db] = (f32x4){0.f, 0.f, 0.f, 0.f};
    const int ntc = (ti >> 5) + 1;
    for (int tile = 0; tile < ntc; ++tile) { Stg sr; const size_t row0 = ((size_t)(b * 256 + tile * 64) * 2 + gq) * 64; stg_load(sr, KC + row0, VC + row0, 128, tid); stg_store(lds, L_CK + tile * TILE_B, L_CV + tile * TILE_B, sr, tid); }
    __syncthreads();
    { const int nmax = (t - 31) >> 4; const float kslope = 16.f * slope2, c = -slope2 * (float)(t - 31);
      float mc = -INFINITY, lc = 0.f;
#pragma unroll 1
      for (int tile = 0; tile < ntc; ++tile) { f32x4 s[4]; qk_tile(s, lds + L_CK + tile * TILE_B, qf, i, g, kslope, fmaf(kslope, (float)(tile * 64 + 4 * g), c));
          float mt = -INFINITY;
#pragma unroll
          for (int kb = 0; kb < 4; ++kb)
#pragma unroll
              for (int rr = 0; rr < 4; ++rr) { const int n = tile * 64 + kb * 16 + 4 * g + rr; const float v = (n <= nmax) ? s[kb][rr] : -INFINITY; s[kb][rr] = v; mt = fmaxf(mt, v); }
          mt = fmaxf(mt, __shfl_xor(mt, 16)); mt = fmaxf(mt, __shfl_xor(mt, 32));
          const float mn = fmaxf(mc, mt), ms = (mn == -INFINITY) ? 0.f : mn; float sum = 0.f;
#pragma unroll
          for (int kb = 0; kb < 4; ++kb)
#pragma unroll
              for (int rr = 0; rr < 4; ++rr) sum += __builtin_amdgcn_exp2f(s[kb][rr] - ms);
          lc = lc * __builtin_amdgcn_exp2f(mc - ms) + sum; mc = mn; }
      lc += __shfl_xor(lc, 16); lc += __shfl_xor(lc, 32);
      const float ms = (mc == -INFINITY) ? 0.f : mc, inv = lc > 0.f ? 1.f / lc : 0.f;
      f32x4 oc[4];
#pragma unroll
      for (int db = 0; db < 4; ++db) oc[db] = (f32x4){0.f, 0.f, 0.f, 0.f};
      NLAS float* imp_s = (NLAS float*)(lds + L_IMP) + (w * 4 + tl_mine) * 64;
      float cprev = 0.f;
#pragma unroll 1
      for (int tile = 0; tile < 4; ++tile) {
          if (tile < ntc) { f32x4 s[4]; qk_tile(s, lds + L_CK + tile * TILE_B, qf, i, g, kslope, fmaf(kslope, (float)(tile * 64 + 4 * g), c));
#pragma unroll
              for (int kb = 0; kb < 4; ++kb)
#pragma unroll
                  for (int rr = 0; rr < 4; ++rr) { const int n = tile * 64 + kb * 16 + 4 * g + rr; const float v = (n <= nmax) ? s[kb][rr] : -INFINITY; s[kb][rr] = __builtin_amdgcn_exp2f(v - ms) * inv; }
              pv_tile(oc, lds + L_CV + tile * TILE_B, s, i, g);
#pragma unroll
              for (int kb = 0; kb < 4; ++kb) { const f32x4 pv = s[kb];
                  float a = (pv[0] + pv[1]) + (pv[2] + pv[3]), cc = pv[3];
                  a += __shfl_xor(a, 1); a += __shfl_xor(a, 2); cc += __shfl_xor(cc, 1); cc += __shfl_xor(cc, 2);
                  const float up = __shfl(cc, (lane + 48) & 63);
                  const float im = a + (g > 0 ? up : cprev); cprev = up;
                  if (r == 0) imp_s[4 * (tile * 4 + kb) + g] = im; }
          } else { if (r == 0) {
#pragma unroll
              for (int kb = 0; kb < 4; ++kb) imp_s[4 * (tile * 4 + kb) + g] = 0.f; } }
      }
#pragma unroll
      for (int db = 0; db < 4; ++db) outacc[db] = outacc[db] + oc[db] * gate0;
    }
    __syncthreads();
    NLAS float* impw = (NLAS float*)(lds + L_IMP) + w * 256;
    float myscore[4];
#pragma unroll
    for (int tl = 0; tl < 4; ++tl) { const int tt = t0 + 4 * w + tl, cur = tt >> 6, j = lane; const bool valid = j <= cur, forced = (j == 0) || (j == cur) || (j == cur - 1);
        const float s = valid ? impw[tl * 64 + j] + (forced ? 1000.f : 0.f) : -1e30f; myscore[tl] = s; }
    __syncthreads();
#pragma unroll
    for (int tl = 0; tl < 4; ++tl) impw[tl * 64 + lane] = myscore[tl];
    __syncthreads();
    u64 wmask[4], wun = 0ull;
#pragma unroll
    for (int tl = 0; tl < 4; ++tl) { const int tt = t0 + 4 * w + tl, cur = tt >> 6; const float s = myscore[tl]; int rank = 0;
        for (int jj = 0; jj < 64; ++jj) { const float o = impw[tl * 64 + jj]; rank += (o > s || (o == s && jj < lane)) ? 1 : 0; }
        wmask[tl] = __ballot(rank < 16 && lane <= cur); wun |= wmask[tl]; }
    if (lane == 0) { NLAS u64* mk = (NLAS u64*)(lds + L_MSK) + w * 4; mk[0] = wmask[0]; mk[1] = wmask[1]; mk[2] = wmask[2]; mk[3] = wmask[3]; ((NLAS u64*)(lds + L_WU))[w] = wun; }
    __syncthreads();
    const u64 mymask = ((const NLAS u64*)(lds + L_MSK))[w * 4 + tl_mine];
    u64 uall = 0ull;
#pragma unroll
    for (int ww = 0; ww < 8; ++ww) uall |= ((const NLAS u64*)(lds + L_WU))[ww];
    uall = ((u64)__builtin_amdgcn_readfirstlane((unsigned)(uall >> 32)) << 32) | (u64)__builtin_amdgcn_readfirstlane((unsigned)uall);
    const size_t rowb = (size_t)b * T;
    {
        float ms_ = 0.f, ls = 0.f; f32x4 os[4];
#pragma unroll
        for (int db = 0; db < 4; ++db) os[db] = (f32x4){0.f, 0.f, 0.f, 0.f};
        const bf16_t* kcol = P + rowb * PW + P_KS + gq * 64; const bf16_t* vcol = P + rowb * PW + P_VS + gq * 64;
        const float c = -slope2 * (float)t;
        const int jcur = t0 >> 6;
        const u64 wall = ((const NLAS u64*)(lds + L_MSK))[w * 4 + 0] & ((const NLAS u64*)(lds + L_MSK))[w * 4 + 1] & ((const NLAS u64*)(lds + L_MSK))[w * 4 + 2] & ((const NLAS u64*)(lds + L_MSK))[w * 4 + 3];
        const u64 wallu = ((u64)__builtin_amdgcn_readfirstlane((unsigned)(wall >> 32)) << 32) | (u64)__builtin_amdgcn_readfirstlane((unsigned)wall);
        u64 rem = uall & ((1ull << jcur) - 1ull); int j = jcur; int cur = 0; bool first = true;
        Stg sr; stg_load(sr, kcol + (size_t)j * 64 * PW, vcol + (size_t)j * 64 * PW, PW, tid); stg_store(lds, L_KB0, L_VB0, sr, tid);
        int jn = rem ? 63 - __builtin_clzll(rem) : -1; if (jn >= 0) rem &= ~(1ull << jn);
        if (jn >= 0) stg_load(sr, kcol + (size_t)jn * 64 * PW, vcol + (size_t)jn * 64 * PW, PW, tid);
        __syncthreads();
        for (;;) {
            const int jnn = (jn >= 0 && rem) ? 63 - __builtin_clzll(rem) : -1; if (jnn >= 0) rem &= ~(1ull << jnn);
            if (jn >= 0) stg_store(lds, cur ? L_KB0 : L_KB1, cur ? L_VB0 : L_VB1, sr, tid);
            if (jnn >= 0) stg_load(sr, kcol + (size_t)jnn * 64 * PW, vcol + (size_t)jnn * 64 * PW, PW, tid);
            if ((wun >> j) & 1ull) { f32x4 s[4];
                const float bt = fmaf(slope2, (float)(j * 64 + 4 * g), c) - ms_ + (((mymask >> j) & 1ull) ? 0.f : -1e30f);
                qk_tile(s, lds + (cur ? L_KB1 : L_KB0), qf, i, g, slope2, bt);
                if (first) online_tile<true>(s, ms_, ls, os, true, j * 64 + 4 * g, 0, t); else online_tile<false>(s, ms_, ls, os, false, 0, 0, 0);
                pv_tile(os, lds + (cur ? L_VB1 : L_VB0), s, i, g); }
            first = false;
            __syncthreads();
            if (jn < 0) break;
            j = jn; jn = jnn; cur ^= 1;
        }
        ls += __shfl_xor(ls, 16); ls += __shfl_xor(ls, 32);
        const float sc1 = gate1 / ls;
#pragma unroll
        for (int db = 0; db < 4; ++db) outacc[db] = outacc[db] + os[db] * sc1;
    }
    {
        float mw = 0.f, lw = 0.f; f32x4 ow[4];
#pragma unroll
        for (int db = 0; db < 4; ++db) ow[db] = (f32x4){0.f, 0.f, 0.f, 0.f};
        const bf16_t* kcol = P + rowb * PW + P_KW + gq * 64; const bf16_t* vcol = P + rowb * PW + P_VW + gq * 64;
        const float c = -slope2 * (float)t;
        const int j0 = (t0 - 511) > 0 ? ((t0 - 511) >> 6) : 0, j1 = t0 >> 6, tw0 = t0 + 4 * w;
        int j = j1, cur = 0; bool first = true;
        Stg sr; stg_load(sr, kcol + (size_t)j * 64 * PW, vcol + (size_t)j * 64 * PW, PW, tid); stg_store(lds, L_KB0, L_VB0, sr, tid);
        if (j > j0) stg_load(sr, kcol + (size_t)(j - 1) * 64 * PW, vcol + (size_t)(j - 1) * 64 * PW, PW, tid);
        __syncthreads();
        for (;;) {
            if (j > j0) stg_store(lds, cur ? L_KB0 : L_KB1, cur ? L_VB0 : L_VB1, sr, tid);
            if (j - 1 > j0) stg_load(sr, kcol + (size_t)(j - 2) * 64 * PW, vcol + (size_t)(j - 2) * 64 * PW, PW, tid);
            if (64 * j <= tw0 + 3 && 64 * j + 63 >= tw0 - 511) { f32x4 s[4];
                qk_tile(s, lds + (cur ? L_KB1 : L_KB0), qf, i, g, slope2, fmaf(slope2, (float)(j * 64 + 4 * g), c) - mw);
                const bool needmask = first || (64 * j < tw0 + 3 - 511);
                if (first) online_tile<true>(s, mw, lw, ow, true, j * 64 + 4 * g, t - 511, t); else online_tile<false>(s, mw, lw, ow, needmask, j * 64 + 4 * g, t - 511, t);
                pv_tile(ow, lds + (cur ? L_VB1 : L_VB0), s, i, g); }
            first = false;
            __syncthreads();
            if (j <= j0) break;
            --j; cur ^= 1;
        }
        lw += __shfl_xor(lw, 16); lw += __shfl_xor(lw, 32);
        const float sc2 = gate2 / lw;
#pragma unroll
        for (int db = 0; db < 4; ++db) outacc[db] = outacc[db] + ow[db] * sc2;
    }
    bf16_t* yo = Ynsa + m * 512 + h * 64 + 4 * g;
#pragma unroll
    for (int db = 0; db < 4; ++db) { u32x2 v; v.x = pkbf(outacc[db][0], outacc[db][1]); v.y = pkbf(outacc[db][2], outacc[db][3]); *(u32x2*)(yo + db * 16) = v; }
}
__device__ __forceinline__ void phase(NLAS char* lds, const bf16_t* P, const float* S32, const bf16_t* KC, const bf16_t* VC, bf16_t* Ynsa) {
    const int G = gridDim.x, bid = blockIdx.x;
    if (G == 256) { const int base = bid >> 3, bg = bid & 7;
#pragma unroll 1
        for (int k = 0; k < 4; ++k) { const int ti = (k == 0) ? 127 - base : (k == 1) ? 64 + base : (k == 2) ? 63 - base : base; unit(lds, P, S32, KC, VC, Ynsa, bg >> 1, bg & 1, ti); } }
    else {
#pragma unroll 1
        for (int u = bid; u < 1024; u += G) unit(lds, P, S32, KC, VC, Ynsa, (u & 7) >> 1, u & 1, 127 - (u >> 3)); }
}
}

namespace xa {
using nsa::bf16x8; using nsa::s16x4; using nsa::f32x4; using nsa::u32x4; using nsa::u32x2; using nsa::vtr; using nsa::mfma16; using nsa::pkbf;
constexpr int RS = 272, TILE_B = 64 * RS;
constexpr int L_K0 = 0, L_V0 = TILE_B, L_K1 = 2 * TILE_B, L_V1 = 3 * TILE_B;
struct Stg { u32x4 k0, k1, v0, v1; };
__device__ __forceinline__ void stg_load(Stg& r, const bf16_t* kb, int tid) { const bf16_t* p = kb + (size_t)(tid >> 3) * 1024 + (tid & 7) * 8;
    r.k0 = *(const u32x4*)p; r.k1 = *(const u32x4*)(p + 64); r.v0 = *(const u32x4*)(p + 512); r.v1 = *(const u32x4*)(p + 576); }
__device__ __forceinline__ void stg_store(NLAS char* lds, int ko, int vo, const Stg& r, int tid) { const int off = (tid >> 3) * RS + (tid & 7) * 16;
    *(NLAS u32x4*)(lds + ko + off) = r.k0; *(NLAS u32x4*)(lds + ko + off + 128) = r.k1; *(NLAS u32x4*)(lds + vo + off) = r.v0; *(NLAS u32x4*)(lds + vo + off + 128) = r.v1; }
__device__ __forceinline__ void unit(NLAS char* lds, const bf16_t* P, const bf16_t* MEMKV, bf16_t* Yxa, int b, int h, int tt) {
    const int tid = threadIdx.x, lane = tid & 63, w = __builtin_amdgcn_readfirstlane(tid >> 6), i = lane & 15, g = lane >> 4;
    const size_t m = (size_t)b * T + tt * 128 + 16 * w + i;
    bf16x8 qf[4];
    { const bf16_t* qp = P + m * PW + P_XAQ + h * 128 + 8 * g;
#pragma unroll
      for (int ks = 0; ks < 4; ++ks) qf[ks] = *(const bf16x8*)(qp + 32 * ks); }
    const float scale2 = 0.08838834764831845f * nsa::LOG2E;
    float mx = -INFINITY, l = 0.f; f32x4 o[8];
#pragma unroll
    for (int db = 0; db < 8; ++db) o[db] = (f32x4){0.f, 0.f, 0.f, 0.f};
    const bf16_t* kbase = MEMKV + (size_t)b * 256 * 1024 + h * 128;
    { Stg sr; stg_load(sr, kbase, tid); stg_store(lds, L_K0, L_V0, sr, tid); }
    __syncthreads();
#pragma unroll 1
    for (int tile = 0; tile < 4; ++tile) { const int cur = tile & 1;
        Stg sr; if (tile < 3) stg_load(sr, kbase + (size_t)(tile + 1) * 64 * 1024, tid);
        const NLAS char* Kb = lds + (cur ? L_K1 : L_K0); const NLAS char* Vb = lds + (cur ? L_V1 : L_V0);
        f32x4 s[4];
#pragma unroll
        for (int kb = 0; kb < 4; ++kb) { const NLAS char* kp = Kb + (kb * 16 + i) * RS + 16 * g; f32x4 acc = (f32x4){0.f, 0.f, 0.f, 0.f};
#pragma unroll
            for (int ks = 0; ks < 4; ++ks) acc = mfma16(*(const NLAS bf16x8*)(kp + 64 * ks), qf[ks], acc);
            s[kb] = acc; }
        float mt = -INFINITY;
#pragma unroll
        for (int kb = 0; kb < 4; ++kb)
#pragma unroll
            for (int r = 0; r < 4; ++r) { const float v = s[kb][r] * scale2; s[kb][r] = v; mt = fmaxf(mt, v); }
        mt = fmaxf(mt, __shfl_xor(mt, 16)); mt = fmaxf(mt, __shfl_xor(mt, 32));
        const float mn = fmaxf(mx, mt), alpha = __builtin_amdgcn_exp2f(mx - mn); float sum = 0.f;
#pragma unroll
        for (int kb = 0; kb < 4; ++kb)
#pragma unroll
            for (int r = 0; r < 4; ++r) { const float p = __builtin_amdgcn_exp2f(s[kb][r] - mn); s[kb][r] = p; sum += p; }
        l = l * alpha + sum; mx = mn;
#pragma unroll
        for (int db = 0; db < 8; ++db) o[db] = o[db] * alpha;
        const NLAS char* vb = Vb + (4 * g + (i >> 2)) * RS + (i & 3) * 8;
#pragma unroll
        for (int kk = 0; kk < 2; ++kk) {
            u32x4 pw; pw.x = pkbf(s[2 * kk][0], s[2 * kk][1]); pw.y = pkbf(s[2 * kk][2], s[2 * kk][3]); pw.z = pkbf(s[2 * kk + 1][0], s[2 * kk + 1][1]); pw.w = pkbf(s[2 * kk + 1][2], s[2 * kk + 1][3]);
            const bf16x8 pf = __builtin_bit_cast(bf16x8, pw);
#pragma unroll
            for (int db = 0; db < 8; ++db) { const NLAS char* vp = vb + (2 * kk) * 16 * RS + db * 32; const s16x4 lo = vtr(vp), hi = vtr(vp + 16 * RS);
                o[db] = mfma16((bf16x8){lo[0], lo[1], lo[2], lo[3], hi[0], hi[1], hi[2], hi[3]}, pf, o[db]); }
        }
        if (tile < 3) stg_store(lds, cur ? L_K0 : L_K1, cur ? L_V0 : L_V1, sr, tid);
        __syncthreads();
    }
    l += __shfl_xor(l, 16); l += __shfl_xor(l, 32);
    const float inv = 1.f / l;
    bf16_t* yo = Yxa + m * 512 + h * 128 + 4 * g;
#pragma unroll
    for (int db = 0; db < 8; ++db) { u32x2 v; v.x = pkbf(o[db][0] * inv, o[db][1] * inv); v.y = pkbf(o[db][2] * inv, o[db][3] * inv); *(u32x2*)(yo + db * 16) = v; }
}
__device__ __forceinline__ void phase(NLAS char* lds, const bf16_t* P, const bf16_t* MEMKV, bf16_t* Yxa) {
#pragma unroll 1
    for (int u = blockIdx.x; u < 512; u += gridDim.x) unit(lds, P, MEMKV, Yxa, u >> 7, (u >> 5) & 3, u & 31);
}
}

namespace ml {
using nsa::bf16x8; using nsa::s16x4; using nsa::f32x4; using nsa::u32x4; using nsa::u32x2; using nsa::vtr; using nsa::mfma16; using nsa::pkbf;
constexpr int RS = 272, TB = 64 * RS, RSS = 144;
constexpr float KSCALE = 0.08838834764831845f;
__device__ __forceinline__ float scan_add(float v, int lane) {
#pragma unroll
    for (int o = 1; o < 64; o <<= 1) { const float u = __shfl_up(v, o); if (lane >= o) v += u; }
    return v; }
__device__ __forceinline__ float scan_max(float v, int lane) {
#pragma unroll
    for (int o = 1; o < 64; o <<= 1) { const float u = __shfl_up(v, o); if (lane >= o) v = fmaxf(v, u); }
    return v; }
__device__ __forceinline__ bf16x8 trpair(const NLAS char* p, int hi_off) { const s16x4 lo = vtr(p), hi = vtr(p + hi_off); return (bf16x8){lo[0], lo[1], lo[2], lo[3], hi[0], hi[1], hi[2], hi[3]}; }
__device__ __forceinline__ void load_conv(NLAS char* dst, const bf16_t* P, const float* cw, int colP, int cwc, size_t m0, int tseq0, int tid) {
    const int s = tid >> 3, c16 = (tid & 7) * 16;
#pragma unroll
    for (int half = 0; half < 2; ++half) { const int c = c16 + half * 8; float acc[8];
#pragma unroll
        for (int e = 0; e < 8; ++e) acc[e] = 0.f;
#pragma unroll
        for (int j = 0; j < 4; ++j) { if (tseq0 + s - j >= 0) { const u32x4 raw = *(const u32x4*)(P + (m0 + s - j) * PW + colP + c);
            const f32x4 w0 = *(const f32x4*)(cw + j * 1024 + cwc + c), w1 = *(const f32x4*)(cw + j * 1024 + cwc + c + 4);
            acc[0] += w0[0] * pg8::bflo(raw.x); acc[1] += w0[1] * pg8::bfhi(raw.x); acc[2] += w0[2] * pg8::bflo(raw.y); acc[3] += w0[3] * pg8::bfhi(raw.y);
            acc[4] += w1[0] * pg8::bflo(raw.z); acc[5] += w1[1] * pg8::bfhi(raw.z); acc[6] += w1[2] * pg8::bflo(raw.w); acc[7] += w1[3] * pg8::bfhi(raw.w); } }
#pragma unroll
        for (int e = 0; e < 8; ++e) acc[e] = acc[e] * __builtin_amdgcn_rcpf(1.f + __expf(-acc[e]));
        u32x4 o; o.x = pkbf(acc[0], acc[1]); o.y = pkbf(acc[2], acc[3]); o.z = pkbf(acc[4], acc[5]); o.w = pkbf(acc[6], acc[7]);
        *(NLAS u32x4*)(dst + s * RS + c * 2) = o; }
}
__device__ __forceinline__ void m1_unit(NLAS char* lds, const bf16_t* P, const float* cw, const float* S32, float* Abuf, float* NA, float* Gc, float* Mloc, int ci) {
    constexpr int L_K = 0, L_EV = TB, L_E = 2 * TB;
    const int tid = threadIdx.x, lane = tid & 63, w = __builtin_amdgcn_readfirstlane(tid >> 6), i = lane & 15, g = lane >> 4;
    const int c = ci & 63, bh = ci >> 6, h = bh & 3, b = bh >> 2; const size_t m0 = (size_t)b * T + c * 64;
    NLAS float* eS = (NLAS float*)(lds + L_E);
    if (w == 0) { const float fpre = S32[(m0 + lane) * 32 + 4 + h], ipre = S32[(m0 + lane) * 32 + h];
        const float bcs = scan_add(logsig(fpre), lane), gtot = __shfl(bcs, 63), wend = gtot - bcs + ipre, mloc = wave_max(wend);
        eS[lane] = __expf(wend - mloc) * KSCALE; if (lane == 0) { Gc[ci] = gtot; Mloc[ci] = mloc; } }
    load_conv(lds + L_K, P, cw, P_MLK + h * 128, 512 + h * 128, m0, c * 64, tid);
    __syncthreads();
    { const int s = tid >> 3, c16 = (tid & 7) * 16; const float es = eS[s]; const bf16_t* vp = P + (m0 + s) * PW + P_MLV + h * 128 + c16;
#pragma unroll
      for (int half = 0; half < 2; ++half) { const u32x4 raw = *(const u32x4*)(vp + half * 8); u32x4 o;
          o.x = pkbf(pg8::bflo(raw.x) * es, pg8::bfhi(raw.x) * es); o.y = pkbf(pg8::bflo(raw.y) * es, pg8::bfhi(raw.y) * es);
          o.z = pkbf(pg8::bflo(raw.z) * es, pg8::bfhi(raw.z) * es); o.w = pkbf(pg8::bflo(raw.w) * es, pg8::bfhi(raw.w) * es);
          *(NLAS u32x4*)(lds + L_EV + s * RS + (c16 + half * 8) * 2) = o; } }
    __syncthreads();
    f32x4 acc[8];
#pragma unroll
    for (int vb = 0; vb < 8; ++vb) acc[vb] = (f32x4){0.f, 0.f, 0.f, 0.f};
    const int rowoff = (4 * g + (i >> 2)) * RS + (i & 3) * 8;
#pragma unroll
    for (int kk = 0; kk < 2; ++kk) { const bf16x8 kf = trpair(lds + L_K + kk * 32 * RS + rowoff + w * 32, 16 * RS);
#pragma unroll
        for (int vb = 0; vb < 8; ++vb) acc[vb] = mfma16(trpair(lds + L_EV + kk * 32 * RS + rowoff + vb * 32, 16 * RS), kf, acc[vb]); }
    float* ap = Abuf + ((size_t)ci * 128 + w * 16 + i) * 128 + 4 * g;
#pragma unroll
    for (int vb = 0; vb < 8; ++vb) *(f32x4*)(ap + vb * 16) = acc[vb];
    if (tid < 128) { float n = 0.f; for (int s = 0; s < 64; ++s) n += eS[s] * bf2f(*(const NLAS bf16_t*)(lds + L_K + s * RS + tid * 2)); NA[(size_t)ci * 128 + tid] = n; }
    __syncthreads();
}
__device__ __forceinline__ void m2_items(float* Abuf, float* NA, const float* Gc, const float* Mloc, float* Mprev) {
    typedef float f32x2 __attribute__((ext_vector_type(2)));
    for (int it = blockIdx.x * blockDim.x + threadIdx.x; it < 16 * 128 * 64; it += gridDim.x * blockDim.x) {
        const int bh = it >> 13, kv2 = it & 8191, k = kv2 >> 6, v2 = kv2 & 63;
        f32x2 C = (f32x2){0.f, 0.f}; float n = 0.f, m = 0.f;
#pragma unroll 1
        for (int c0 = 0; c0 < 64; c0 += 8) { f32x2 A[8];
#pragma unroll
            for (int u = 0; u < 8; ++u) A[u] = *(const f32x2*)(Abuf + ((size_t)(bh * 64 + c0 + u) * 128 + k) * 128 + v2 * 2);
#pragma unroll
            for (int u = 0; u < 8; ++u) { const int ci = bh * 64 + c0 + u; const float gg = Gc[ci], ml = Mloc[ci];
                const float mn = fmaxf(gg + m, ml), a = __expf(gg + m - mn), bb = __expf(ml - mn);
                *(f32x2*)(Abuf + ((size_t)ci * 128 + k) * 128 + v2 * 2) = C; C = C * a + A[u] * bb;
                if (v2 == 0) { const float nA = NA[(size_t)ci * 128 + k]; NA[(size_t)ci * 128 + k] = n; n = a * n + bb * nA; }
                if (kv2 == 0) Mprev[ci] = m;
                m = mn; } }
    }
}
__device__ __forceinline__ void m3_unit(NLAS char* lds, const bf16_t* P, const float* cw, const float* S32, const float* Cprev, const float* Nprev, const float* Mprev, const float* normg, bf16_t* Yml, int ci) {
    constexpr int L_Q = 0, L_K = TB, L_V = 2 * TB, L_C = 3 * TB, L_S = 5 * TB, L_F = L_S + 64 * RSS;
    const int tid = threadIdx.x, lane = tid & 63, w = __builtin_amdgcn_readfirstlane(tid >> 6), i = lane & 15, g = lane >> 4;
    const int c = ci & 63, bh = ci >> 6, h = bh & 3, b = bh >> 2; const size_t m0 = (size_t)b * T + c * 64;
    NLAS float* F = (NLAS float*)(lds + L_F);
    NLAS float* rowf = F; NLAS float* colf = F + 64; NLAS float* scv = F + 128; NLAS float* emt = F + 192; NLAS float* qn = F + 256; NLAS float* nprev = F + 320; NLAS float* denp = F + 448; NLAS float* ssq = F + 576;
    if (w == 0) { const float fpre = S32[(m0 + lane) * 32 + 4 + h], ipre = S32[(m0 + lane) * 32 + h], mprev = Mprev[ci];
        const float bcs = scan_add(logsig(fpre), lane), u = ipre - bcs, pm = scan_max(u, lane), mt = bcs + fmaxf(mprev, pm);
        rowf[lane] = bcs - mt; colf[lane] = u; scv[lane] = __expf(bcs + mprev - mt); emt[lane] = __expf(-mt); }
    else if (w <= 2) nprev[tid - 64] = Nprev[(size_t)ci * 128 + tid - 64];
    load_conv(lds + L_Q, P, cw, P_MLQ + h * 128, h * 128, m0, c * 64, tid);
    load_conv(lds + L_K, P, cw, P_MLK + h * 128, 512 + h * 128, m0, c * 64, tid);
    { const int s = tid >> 3, c16 = (tid & 7) * 16; const bf16_t* vp = P + (m0 + s) * PW + P_MLV + h * 128 + c16;
      *(NLAS u32x4*)(lds + L_V + s * RS + c16 * 2) = *(const u32x4*)vp; *(NLAS u32x4*)(lds + L_V + s * RS + c16 * 2 + 16) = *(const u32x4*)(vp + 8); }
    { const int k = tid >> 2, v0 = (tid & 3) * 32; const float* cp = Cprev + ((size_t)ci * 128 + k) * 128 + v0;
#pragma unroll
      for (int q8 = 0; q8 < 4; ++q8) { const f32x4 a = *(const f32x4*)(cp + q8 * 8), bq = *(const f32x4*)(cp + q8 * 8 + 4); u32x4 o;
          o.x = pkbf(a[0], a[1]); o.y = pkbf(a[2], a[3]); o.z = pkbf(bq[0], bq[1]); o.w = pkbf(bq[2], bq[3]); *(NLAS u32x4*)(lds + L_C + k * RS + (v0 + q8 * 8) * 2) = o; } }
    __syncthreads();
    if (tid < 64) { float a = 0.f; for (int k = 0; k < 128; ++k) a += bf2f(*(const NLAS bf16_t*)(lds + L_Q + tid * RS + k * 2)) * nprev[k]; qn[tid] = a; }
    const int tb = w >> 1;
    {
        float rs[4] = {0.f, 0.f, 0.f, 0.f};
#pragma unroll
        for (int sbi = 0; sbi < 2; ++sbi) { const int sb = 2 * (w & 1) + sbi; f32x4 acc = (f32x4){0.f, 0.f, 0.f, 0.f};
            if (sb <= tb) {
#pragma unroll
                for (int ks = 0; ks < 4; ++ks) acc = mfma16(*(const NLAS bf16x8*)(lds + L_Q + (tb * 16 + i) * RS + (32 * ks + 8 * g) * 2), *(const NLAS bf16x8*)(lds + L_K + (sb * 16 + i) * RS + (32 * ks + 8 * g) * 2), acc); }
            const int s = sb * 16 + i; const float cf = colf[s];
#pragma unroll
            for (int r = 0; r < 4; ++r) { const int t = tb * 16 + 4 * g + r; const float v = (s <= t) ? acc[r] * KSCALE * __expf(rowf[t] + cf) : 0.f; rs[r] += v;
                *(NLAS bf16_t*)(lds + L_S + t * RSS + s * 2) = f2bf(v); } }
#pragma unroll
        for (int r = 0; r < 4; ++r) { float x = rs[r]; x += __shfl_xor(x, 1); x += __shfl_xor(x, 2); x += __shfl_xor(x, 4); x += __shfl_xor(x, 8); if (i == 0) denp[(w & 1) * 64 + tb * 16 + 4 * g + r] = x; }
    }
    __syncthreads();
    f32x4 a1[4], a2[4];
#pragma unroll
    for (int vb = 0; vb < 4; ++vb) { a1[vb] = (f32x4){0.f, 0.f, 0.f, 0.f}; a2[vb] = (f32x4){0.f, 0.f, 0.f, 0.f}; }
    const int vb0 = (w & 1) * 4, troff = (8 * g + (i >> 2)) * RS + (i & 3) * 8;
#pragma unroll
    for (int kk = 0; kk < 2; ++kk) { if (32 * kk <= tb * 16 + 15) { const bf16x8 sf = *(const NLAS bf16x8*)(lds + L_S + (tb * 16 + i) * RSS + (32 * kk + 8 * g) * 2);
#pragma unroll
        for (int vb = 0; vb < 4; ++vb) a1[vb] = mfma16(sf, trpair(lds + L_V + kk * 32 * RS + troff + (vb0 + vb) * 32, 4 * RS), a1[vb]); } }
#pragma unroll
    for (int ks = 0; ks < 4; ++ks) { const bf16x8 qf = *(const NLAS bf16x8*)(lds + L_Q + (tb * 16 + i) * RS + (32 * ks + 8 * g) * 2);
#pragma unroll
        for (int vb = 0; vb < 4; ++vb) a2[vb] = mfma16(qf, trpair(lds + L_C + ks * 32 * RS + troff + (vb0 + vb) * 32, 4 * RS), a2[vb]); }
    float hv[4][4], sq[4] = {0.f, 0.f, 0.f, 0.f};
#pragma unroll
    for (int r = 0; r < 4; ++r) { const int t = tb * 16 + 4 * g + r; const float sc = scv[t]; const float den = denp[t] + denp[64 + t] + sc * qn[t]; const float hd = 1.f / fmaxf(fabsf(den), emt[t]);
#pragma unroll
        for (int vb = 0; vb < 4; ++vb) { const float x = (a1[vb][r] + sc * a2[vb][r]) * hd; hv[vb][r] = x; sq[r] += x * x; } }
#pragma unroll
    for (int r = 0; r < 4; ++r) { float x = sq[r]; x += __shfl_xor(x, 1); x += __shfl_xor(x, 2); x += __shfl_xor(x, 4); x += __shfl_xor(x, 8); if (i == 0) ssq[(w & 1) * 64 + tb * 16 + 4 * g + r] = x; }
    __syncthreads();
#pragma unroll
    for (int r = 0; r < 4; ++r) { const int t = tb * 16 + 4 * g + r; const float rinv = rsqrtf((ssq[t] + ssq[64 + t]) * (1.f / 128.f) + EPS);
#pragma unroll
        for (int vb = 0; vb < 4; ++vb) { const int v = (vb0 + vb) * 16 + i; const float o = bf2f(P[(m0 + t) * PW + P_MLO + h * 128 + v]);
            Yml[(m0 + t) * 512 + h * 128 + v] = f2bf(__builtin_amdgcn_rcpf(1.f + __expf(-o)) * hv[vb][r] * rinv * normg[h * 128 + v]); } }
    __syncthreads();
}
}

namespace cmpr {
using nsa::bf16x8; using nsa::f32x4; using nsa::u32x4; using nsa::mfma16; using nsa::pkbf;
constexpr int RSX = 144, L_X = 0, L_PE = 272 * RSX  , L_H = L_PE + 8192, RSH = 528;
__device__ __forceinline__ void unit(NLAS char* lds, const bf16_t* P, const float* pe, const bf16_t* W1t, const bf16_t* W2t, bf16_t* KC, bf16_t* VC, int u) {
    const int tid = threadIdx.x, lane = tid & 63, w = __builtin_amdgcn_readfirstlane(tid >> 6), i = lane & 15, g = lane >> 4;
    const int nt = u & 15, gq = (u >> 4) & 1, b = (u >> 5) & 3, kv = u >> 7;
    const int pcol = (kv ? P_VC : P_KC) + gq * 64, tok0 = 256 * nt;
    for (int ch = tid; ch < 272 * 8; ch += 512) { const int row = ch >> 3, c8 = (ch & 7) * 8, tok = tok0 + row;
        u32x4 v = (u32x4){0u, 0u, 0u, 0u}; if (tok < T) v = *(const u32x4*)(P + ((size_t)b * T + tok) * PW + pcol + c8);
        *(NLAS u32x4*)(lds + L_X + row * RSX + c8 * 2) = v; }
    for (int e = tid; e < 2048; e += 512) ((NLAS float*)(lds + L_PE))[e] = pe[kv * 2048 + e];
    __syncthreads();
    f32x4 acc[2]; acc[0] = (f32x4){0.f, 0.f, 0.f, 0.f}; acc[1] = acc[0];
    const bf16_t* wb = W1t + ((size_t)kv * 256 + 32 * w + i) * 2048 + 8 * g;
#pragma unroll 1
    for (int k0 = 0; k0 < 64; k0 += 8) { bf16x8 bq[8][2];
#pragma unroll
        for (int kk = 0; kk < 8; ++kk) { bq[kk][0] = *(const bf16x8*)(wb + 32 * (k0 + kk)); bq[kk][1] = *(const bf16x8*)(wb + 16 * 2048 + 32 * (k0 + kk)); }
#pragma unroll
        for (int kk = 0; kk < 8; ++kk) { const int ks = k0 + kk, l = ks >> 1, dh = ks & 1;
            const u32x4 raw = *(const NLAS u32x4*)(lds + L_X + (16 * i + l) * RSX + dh * 64 + 16 * g);
            const NLAS float* pp = (const NLAS float*)(lds + L_PE) + l * 64 + dh * 32 + 8 * g; const f32x4 p0 = *(const NLAS f32x4*)pp, p1 = *(const NLAS f32x4*)(pp + 4);
            u32x4 a; a.x = pkbf(pg8::bflo(raw.x) + p0[0], pg8::bfhi(raw.x) + p0[1]); a.y = pkbf(pg8::bflo(raw.y) + p0[2], pg8::bfhi(raw.y) + p0[3]);
            a.z = pkbf(pg8::bflo(raw.z) + p1[0], pg8::bfhi(raw.z) + p1[1]); a.w = pkbf(pg8::bflo(raw.w) + p1[2], pg8::bfhi(raw.w) + p1[3]);
            const bf16x8 af = __builtin_bit_cast(bf16x8, a);
            acc[0] = mfma16(af, bq[kk][0], acc[0]); acc[1] = mfma16(af, bq[kk][1], acc[1]); } }
#pragma unroll
    for (int cb = 0; cb < 2; ++cb)
#pragma unroll
        for (int r = 0; r < 4; ++r) { const float x = acc[cb][r], uu = 0.7978845608028654f * (x + 0.044715f * x * x * x); const float gl = x * __builtin_amdgcn_rcpf(1.f + __expf(-2.f * uu));
            *(NLAS bf16_t*)(lds + L_H + (4 * g + r) * RSH + (32 * w + cb * 16 + i) * 2) = f2bf(gl); }
    __syncthreads();
    if (w < 4) { f32x4 o = (f32x4){0.f, 0.f, 0.f, 0.f}; const bf16_t* w2 = W2t + ((size_t)kv * 64 + 16 * w + i) * 256 + 8 * g;
#pragma unroll
        for (int ks = 0; ks < 8; ++ks) o = mfma16(*(const NLAS bf16x8*)(lds + L_H + i * RSH + (32 * ks + 8 * g) * 2), *(const bf16x8*)(w2 + 32 * ks), o);
        bf16_t* dst = (kv ? VC : KC);
#pragma unroll
        for (int r = 0; r < 4; ++r) dst[((size_t)(b * 256 + 16 * nt + 4 * g + r) * 2 + gq) * 64 + 16 * w + i] = f2bf(o[r]); }
    __syncthreads();
}
}

#define LAS __attribute__((address_space(3)))
constexpr int NTHREADS = 512, LDS_BYTES = 147456;
constexpr size_t WS_WIN = 1 * MiB, WS_WG = 9 * MiB, WS_WBR = 15 * MiB, WS_WOUT = 18 * MiB, WS_WFF1 = 20 * MiB, WS_WFF2 = 28 * MiB, WS_WMKV = 36 * MiB, WS_WC1 = 38 * MiB;
constexpr size_t WS_BIASP = 249 * MiB, WS_XCH = 250 * MiB;
#define XB_TMO      128
#define XB_XCNT(j)  (256  + 64 * (j))
#define XB_XSUB(j)  (1280 + 64 * (j))
#define XB_XGEN(j)  (2304 + 64 * (j))
#define XB_TOP      3328
#define XB_TOPGEN   3392
#define XCD_BAR_WORDS 3456
#define XB_SPIN_CAP (1u << 18)

__device__ __forceinline__ unsigned xb_ld(unsigned* p)              { return __hip_atomic_load(p, __ATOMIC_RELAXED, __HIP_MEMORY_SCOPE_AGENT); }
__device__ __forceinline__ unsigned xb_add(unsigned* p, unsigned v) { return __hip_atomic_fetch_add(p, v, __ATOMIC_RELAXED, __HIP_MEMORY_SCOPE_AGENT); }
__device__ __forceinline__ unsigned xb_xcc_id() { return (unsigned)__builtin_amdgcn_s_getreg((3 << 11) | 20) & 0xFu; }
#define XB_SPIN(cond, bar) do { unsigned _sp = 0; while (cond) { __builtin_amdgcn_s_sleep(1); \
    if ((++_sp & 255u) == 0u) { if (xb_ld(&(bar)[XB_TMO])) break; if (_sp > XB_SPIN_CAP) { atomicAdd(&(bar)[XB_TMO], 1u); break; } } } } while (0)

struct XcdBarrier {
    unsigned* bar; unsigned x;
    volatile LAS unsigned* st;
};

__device__ __forceinline__ XcdBarrier xcd_barrier_post(unsigned* bar, volatile LAS unsigned* st) {
    XcdBarrier b; b.bar = bar; b.x = xb_xcc_id(); b.st = st;
    if (threadIdx.x == 0) (void)xb_add(&bar[XB_XCNT(b.x)], 1u);
    return b;
}
__device__ __forceinline__ void xcd_barrier_complete(unsigned* bar, unsigned x, unsigned& nloc, unsigned& nx) {
    const unsigned G = gridDim.x * gridDim.y * gridDim.z;
    unsigned sum, cnt, mine, sp = 0u;
    for (;;) {
        sum = 0u; cnt = 0u; mine = 0u;
#pragma unroll
        for (unsigned j = 0; j < 16; ++j) { const unsigned c = xb_ld(&bar[XB_XCNT(j)]); sum += c; cnt += (c > 0u) ? 1u : 0u; mine = (j == x) ? c : mine; }
        if (sum == G) break;
        __builtin_amdgcn_s_sleep(1);
        if ((++sp & 255u) == 0u) { if (xb_ld(&bar[XB_TMO])) break; if (sp > XB_SPIN_CAP) { atomicAdd(&bar[XB_TMO], 1u); break; } }
    }
    nloc = mine > 0u ? mine : 1u; nx = cnt > 0u ? cnt : 1u;
}

__device__ __forceinline__ void xcd_barrier(const XcdBarrier& b) {
    asm volatile("s_waitcnt vmcnt(0)" ::: "memory");
    __syncthreads();
    if (threadIdx.x == 0) {
        unsigned* bar = b.bar;
        __builtin_amdgcn_s_waitcnt(0);
        unsigned nloc = b.st[0], nx = b.st[1];
        if (nloc == 0u) { xcd_barrier_complete(bar, b.x, nloc, nx); b.st[0] = nloc; b.st[1] = nx; }
        const unsigned old = xb_add(&bar[XB_XSUB(b.x)], 1u);
        const unsigned gen = old / nloc;
        if (old + 1u == (gen + 1u) * nloc) {
            __builtin_amdgcn_fence(__ATOMIC_RELEASE, "agent");
            asm volatile("s_waitcnt vmcnt(0)" ::: "memory");
            const unsigned og = xb_add(&bar[XB_TOP], 1u);
            const unsigned tg = og / nx;
            if (og + 1u == (tg + 1u) * nx) xb_add(&bar[XB_TOPGEN], 1u);
            else XB_SPIN(xb_ld(&bar[XB_TOPGEN]) == tg, bar);
            __builtin_amdgcn_fence(__ATOMIC_ACQUIRE, "agent");
            xb_add(&bar[XB_XGEN(b.x)], 1u);
            asm volatile("s_waitcnt vmcnt(0)" ::: "memory");
        } else {
            XB_SPIN(xb_ld(&bar[XB_XGEN(b.x)]) == gen, bar);
            __builtin_amdgcn_fence(__ATOMIC_ACQUIRE, "agent");
            asm volatile("s_waitcnt vmcnt(0)" ::: "memory");
        }
    }
    __syncthreads();
}

struct Args { const float* in[18]; float* out; unsigned char* ws; int ph_lo, ph_hi; };
template <int VT, class F> __device__ __forceinline__ void run_vb(int nvb, char* lds, F f) {
    constexpr int PER = NTHREADS / VT; const int sub = threadIdx.x / VT, tid = threadIdx.x % VT;
    for (int it = blockIdx.x; it * PER < nvb; it += gridDim.x) { VB vb{it * PER + sub, tid, lds + sub * (LDS_BYTES / PER)}; f(vb); __syncthreads(); }
}
__device__ __forceinline__ unsigned pk2(float lo, float hi) { return (unsigned)f2bf(lo) | ((unsigned)f2bf(hi) << 16); }
typedef unsigned v4u __attribute__((ext_vector_type(4)));
typedef float f32x4 __attribute__((ext_vector_type(4)));
__device__ __forceinline__ void tr_item(const float* W, int ld, int ncols, int K, bf16_t* WT, int row_off, LAS float* scr, int item, int lane) {
    const int nblk = ncols / 32, kb = item / nblk, nb = item % nblk, k0 = 64 * kb, n0 = 32 * nb;
#pragma unroll 8
    for (int i = 0; i < 32; ++i) { const int kk = 2 * i + (lane >> 5); scr[kk * 33 + (lane & 31)] = W[(size_t)(k0 + kk) * ld + n0 + (lane & 31)]; }
    asm volatile("s_waitcnt lgkmcnt(0)" ::: "memory");
    const int c = lane & 7;
#pragma unroll
    for (int j = 0; j < 4; ++j) { const int n = (lane >> 3) + 8 * j; const LAS float* s = scr + (8 * c) * 33 + n;
        v4u o; o.x = pk2(s[0 * 33], s[1 * 33]); o.y = pk2(s[2 * 33], s[3 * 33]); o.z = pk2(s[4 * 33], s[5 * 33]); o.w = pk2(s[6 * 33], s[7 * 33]);
        *(v4u*)(WT + (size_t)(row_off + n0 + n) * K + k0 + 8 * c) = o; }
    asm volatile("s_waitcnt lgkmcnt(0)" ::: "memory");
}
__device__ __forceinline__ void rms_row_wave(const float* xrow, const float* g, bf16_t* orow, int lane) {
    const f32x4* xr = (const f32x4*)xrow + lane; const f32x4* gr = (const f32x4*)g + lane;
    f32x4 v[4]; float s = 0.f;
#pragma unroll
    for (int j = 0; j < 4; ++j) { v[j] = xr[64 * j]; s += (v[j].x * v[j].x + v[j].y * v[j].y) + (v[j].z * v[j].z + v[j].w * v[j].w); }
    const float r = rsqrtf(wave_sum(s) * (1.f / D) + EPS);
    unsigned long long* o8 = (unsigned long long*)orow + lane;
#pragma unroll
    for (int j = 0; j < 4; ++j) { const f32x4 gg = gr[64 * j]; o8[64 * j] = (unsigned long long)pk2(v[j].x * r * gg.x, v[j].y * r * gg.y) | ((unsigned long long)pk2(v[j].z * r * gg.z, v[j].w * r * gg.w) << 32); }
}
__device__ __forceinline__ int small_src_col(int c) { return c < 8 ? C_MLI + c : C_NSG + (c - 8); }
__global__ void __launch_bounds__(NTHREADS, 2) mega(Args a) {
    extern __shared__ __attribute__((aligned(16))) unsigned char lds_raw[];
    char* lds = (char*)lds_raw;
    LAS unsigned char* lds3 = (LAS unsigned char*)lds_raw;
    const float* x = a.in[0]; const float* mem = a.in[1]; const float* g_mix = a.in[2]; const float* w_in = a.in[3];
    const float* b_in = a.in[4]; const float* ml_conv = a.in[5]; const float* ml_norm_g = a.in[6]; const float* cmp_pe = a.in[7];
    const float* cmp_w1 = a.in[8]; const float* cmp_w2 = a.in[9]; const float* g_mem = a.in[10]; const float* w_mem_kv = a.in[11];
    const float* w_branch = a.in[12]; const float* w_out = a.in[13]; const float* g_ffn = a.in[14]; const float* w_ff1 = a.in[15];
    const float* w_ff2 = a.in[16]; const float* g_final = a.in[17];
    char* ws = (char*)a.ws; float* out = a.out;
    bf16_t* U = (bf16_t*)(ws + WS_U); bf16_t* P = (bf16_t*)(ws + WS_P);
    bf16_t* Yml = (bf16_t*)(ws + WS_Y); bf16_t* Ynsa = Yml + (size_t)M * 512; bf16_t* Yxa = Ynsa + (size_t)M * 512;
    float* S32 = (float*)(ws + WS_S32); bf16_t* MEMN = (bf16_t*)(ws + WS_MEMN); bf16_t* MEMKV = (bf16_t*)(ws + WS_MEMKV);
    bf16_t* KC = (bf16_t*)(ws + WS_KC); bf16_t* VC = (bf16_t*)(ws + WS_VC);
    float* NA = (float*)(ws + WS_NA); float* Gc = (float*)(ws + WS_G); float* Mloc = (float*)(ws + WS_MLOC); float* Mprev = (float*)(ws + WS_MPREV);
    float* Abuf = out;
    bf16_t* GATES = P; bf16_t* MERGED = U; bf16_t* AFFN = (bf16_t*)(ws + WS_AFFN); bf16_t* HBUF = P;
    bf16_t* Wi = (bf16_t*)(ws + WS_WIN); bf16_t* Wg = (bf16_t*)(ws + WS_WG); bf16_t* Wbr = (bf16_t*)(ws + WS_WBR); bf16_t* Wo = (bf16_t*)(ws + WS_WOUT);
    bf16_t* Wf1 = (bf16_t*)(ws + WS_WFF1); bf16_t* Wf2 = (bf16_t*)(ws + WS_WFF2); bf16_t* Wmkv = (bf16_t*)(ws + WS_WMKV);
    float* biasP = (float*)(ws + WS_BIASP); bf16_t* Wc1 = (bf16_t*)(ws + WS_WC1); bf16_t* Wc2 = (bf16_t*)(ws + WS_BIASP + 65536);
    const int tid = threadIdx.x, lane = tid & 63, wave = __builtin_amdgcn_readfirstlane(tid >> 6);
    const int G = gridDim.x, bid = blockIdx.x;
    const int lo = a.ph_lo, hi = a.ph_hi;
    volatile LAS unsigned* xbst = (volatile LAS unsigned*)(lds3 + 131072 + 1024);
    if (tid < 2) xbst[tid] = 0u;
    __syncthreads();
    const XcdBarrier bar = xcd_barrier_post((unsigned*)ws, xbst);
#define PHASE(k) if (lo <= (k) && (k) < hi)
#define SEAM(k) if (lo <= (k) && (k) + 1 < hi) xcd_barrier(bar)
    PHASE(0) {
        LAS float* scr = (LAS float*)(lds3 + wave * 16384);
        const int gw = bid * 8 + wave, NGW = G * 8;
        constexpr int I0 = 16 * 64, I1 = 16 * 40, I2 = 16 * 16, I3 = 16 * 96, I4 = 8 * 32, I5 = 16 * 32, I6 = 16 * 128, I7 = 64 * 32, I8 = 16 * 32;
        constexpr int I9 = 32 * 8, I10 = 4 * 2;
        constexpr int NITEMS = I0 + I1 + I2 + I3 + 3 * I4 + I5 + I6 + I7 + I8 + 2 * I9 + 2 * I10;
        for (int it = gw; it < NITEMS; it += NGW) {
            int r = it;
            if (r < I0) { tr_item(w_in, DIN, 2048, 1024, Wi, 0, scr, r, lane); continue; } r -= I0;
            if (r < I1) { tr_item(w_in + 2056, DIN, 1280, 1024, Wi, 2048, scr, r, lane); continue; } r -= I1;
            if (r < I2) { tr_item(w_in + 3360, DIN, 512, 1024, Wi, 3328, scr, r, lane); continue; } r -= I2;
            if (r < I3) { tr_item(w_in + C_MG, DIN, 3072, 1024, Wg, 0, scr, r, lane); continue; } r -= I3;
            if (r < 3 * I4) { const int j = r / I4; tr_item(w_branch + (size_t)j * 512 * 1024, 1024, 1024, 512, Wbr + (size_t)j * 1024 * 512, 0, scr, r % I4, lane); continue; } r -= 3 * I4;
            if (r < I5) { tr_item(w_out, 1024, 1024, 1024, Wo, 0, scr, r, lane); continue; } r -= I5;
            if (r < I6) { tr_item(w_ff1, FF, FF, 1024, Wf1, 0, scr, r, lane); continue; } r -= I6;
            if (r < I7) { tr_item(w_ff2, 1024, 1024, FF, Wf2, 0, scr, r, lane); continue; } r -= I7;
            if (r < I8) { tr_item(w_mem_kv, 1024, 1024, 1024, Wmkv, 0, scr, r, lane); continue; } r -= I8;
            if (r < 2 * I9) { const int kv = r / I9; tr_item(cmp_w1 + (size_t)kv * 2048 * 256, 256, 256, 2048, Wc1 + (size_t)kv * 256 * 2048, 0, scr, r % I9, lane); continue; } r -= 2 * I9;
            { const int kv = r / I10; tr_item(cmp_w2 + (size_t)kv * 256 * 64, 64, 64, 256, Wc2 + (size_t)kv * 64 * 256, 0, scr, r % I10, lane); }
        }
        for (int i = bid * NTHREADS + tid; i < 256 * 1024; i += G * NTHREADS) { const int r = i >> 10, k = i & 1023; bf16_t v = 0;
            if (r < 32) v = f2bf(w_in[(size_t)k * DIN + small_src_col(r)]);
            else if (r >= 128 && r < 160) { const float w = w_in[(size_t)k * DIN + small_src_col(r - 128)]; v = f2bf(w - bf2f(f2bf(w))); }
            Wi[(size_t)(3840 + r) * 1024 + k] = v; }
        for (int c = bid * NTHREADS + tid; c < 4096; c += G * NTHREADS) { float v = 0.f;
            if (c < 2048) v = b_in[c]; else if (c < 3328) v = b_in[c + 8]; else if (c < 3840) v = b_in[c + 32]; else if (c < 3872) v = b_in[small_src_col(c - 3840)];
            biasP[c] = v; }
        for (int m = gw; m < M; m += NGW) rms_row_wave(x + (size_t)m * D, g_mix, U + (size_t)m * D, lane);
        for (int m = gw; m < 1024; m += NGW) rms_row_wave(mem + (size_t)m * D, g_mem, MEMN + (size_t)m * D, lane);
    }
    SEAM(0);
    PHASE(1) {
        { pg8::Gemm g{U, Wi, M, 4096, D}; pg8::StaticOrder S; S.init(M, 4096, G, bid);
          pg8::EpiStore<0> E{P, biasP, S32, PW, 15};
          pg8::gemm_phase<pg8::EpiStore<0>, pg8::StaticOrder, true, true>(lds3, g, S, E); }
        { pg8::Gemm g{MEMN, Wmkv, 1024, 1024, D}; pg8::StaticOrder S; S.init(1024, 1024, G, bid);
          pg8::EpiStore<0> E{MEMKV, nullptr, nullptr, 1024, -1};
          pg8::gemm_phase<pg8::EpiStore<0>, pg8::StaticOrder, true, true>(lds3, g, S, E); }
    }
    SEAM(1);
    PHASE(2) { for (int ci = bid; ci < 1024; ci += G) ml::m1_unit((NLAS char*)lds_raw, P, ml_conv, S32, Abuf, NA, Gc, Mloc, ci);
               for (int u = bid; u < 256; u += G) cmpr::unit((NLAS char*)lds_raw, P, cmp_pe, Wc1, Wc2, KC, VC, u);
               xa::phase((NLAS char*)lds_raw, P, MEMKV, Yxa); }
    SEAM(2);
    PHASE(3) { ml::m2_items(Abuf, NA, Gc, Mloc, Mprev);
               nsa::phase((NLAS char*)lds_raw, P, S32, KC, VC, Ynsa); }
    SEAM(3);
    PHASE(4) { for (int ci = bid; ci < 1024; ci += G) ml::m3_unit((NLAS char*)lds_raw, P, ml_conv, S32, Abuf, NA, Mprev, ml_norm_g, Yml, ci); }
    SEAM(4);
    PHASE(5) { pg8::Gemm g{U, Wg, M, 3072, D}; pg8::StaticOrder S; S.init(M, 3072, G, bid);
               pg8::EpiStore<1> E{GATES, b_in + C_MG, nullptr, 3072, -1};
               pg8::gemm_phase<pg8::EpiStore<1>, pg8::StaticOrder, true, true>(lds3, g, S, E); }
    SEAM(5);
    PHASE(6) { pg8::Gemm g{Yml, Wbr, M, 1024, 512}; pg8::MergeOrder S; S.so.init(M, 1024, G, bid); S.sa = (size_t)M * 512 * 2; S.sb = (size_t)1024 * 512 * 2;
               pg8::EpiMergeG E{GATES, out, MERGED};
               pg8::gemm_phase<pg8::EpiMergeG, pg8::MergeOrder, true, true>(lds3, g, S, E); }
    SEAM(6);
    PHASE(7) { pg8::Gemm g{MERGED, Wo, M, 1024, D}; pg8::StaticOrder S; S.init(M, 1024, G, bid);
               pg8::EpiResRms E{x, out, nullptr, AFFN, g_ffn, (float*)(ws + WS_XCH), (unsigned*)ws + 4096};
               pg8::gemm_phase<pg8::EpiResRms, pg8::StaticOrder, false, true>(lds3, g, S, E); }
    SEAM(7);
    PHASE(9) { pg8::Gemm g{AFFN, Wf1, M, FF, D}; pg8::StaticOrder S; S.init(M, FF, G, bid);
               pg8::EpiStore<2> E{HBUF, nullptr, nullptr, FF, -1};
               pg8::gemm_phase<pg8::EpiStore<2>, pg8::StaticOrder, true, true>(lds3, g, S, E); }
    SEAM(9);
    PHASE(10) { pg8::Gemm g{HBUF, Wf2, M, 1024, FF}; pg8::StaticOrder S; S.init(M, 1024, G, bid);
                pg8::EpiResRms E{out, nullptr, out, nullptr, g_final, (float*)(ws + WS_XCH + 262144), (unsigned*)ws + 4096 + 4096};
                pg8::gemm_phase<pg8::EpiResRms, pg8::StaticOrder, false, true>(lds3, g, S, E); }
}
constexpr int N_PHASES = 12;
#ifndef MK_PER_PHASE
#define MK_PER_PHASE 0
#endif
extern "C" void kernel_launch(void* const* d_in, const int* in_sizes, int n_in, void* d_out, int out_size, void* d_ws, size_t ws_size, hipStream_t stream) {
    static int grid = 0;
    if (grid == 0) {
        int dev = 0, cus = 0, per_cu = 0;
        (void)hipGetDevice(&dev); (void)hipDeviceGetAttribute(&cus, hipDeviceAttributeMultiprocessorCount, dev);
        (void)hipFuncSetAttribute((const void*)mega, hipFuncAttributeMaxDynamicSharedMemorySize, LDS_BYTES);
        (void)hipOccupancyMaxActiveBlocksPerMultiprocessor(&per_cu, (const void*)mega, NTHREADS, LDS_BYTES);
        if (per_cu < 1) { fprintf(stderr, "occupancy query says %d blocks/CU\n", per_cu); per_cu = 1; }
        grid = cus * 1;
        (void)hipGetLastError();
    }
    (void)hipMemsetAsync(d_ws, 0, 65536, stream);
    Args a{};
    for (int i = 0; i < 18; ++i) a.in[i] = (const float*)d_in[i];
    a.out = (float*)d_out; a.ws = (unsigned char*)d_ws;
#if MK_PER_PHASE
    for (int p = 0; p < N_PHASES; ++p) { a.ph_lo = p; a.ph_hi = p + 1; void* args[] = {&a};
        (void)hipLaunchCooperativeKernel((const void*)mega, dim3(grid), dim3(NTHREADS), args, LDS_BYTES, stream); }
#else
    a.ph_lo = 0; a.ph_hi = N_PHASES; void* args[] = {&a};
    hipError_t e = hipLaunchCooperativeKernel((const void*)mega, dim3(grid), dim3(NTHREADS), args, LDS_BYTES, stream);
    if (e != hipSuccess) fprintf(stderr, "cooperative launch failed: %s (grid %d)\n", hipGetErrorString(e), grid);
#endif
}
```

```cpp
#include <hip/hip_runtime.h>
#include <hip/hip_cooperative_groups.h>
#include <cstdio>
namespace cg = cooperative_groups;
#include <stdint.h>

typedef unsigned short bf16_t;
struct VB { int id; int tid; char* sm; };
__device__ __forceinline__ float bf2f(bf16_t v) { return __uint_as_float(((unsigned)v) << 16); }
__device__ __forceinline__ bf16_t f2bf(float f) { unsigned u = __float_as_uint(f); return (bf16_t)((u + 0x7fffu + ((u >> 16) & 1u)) >> 16); }

constexpr int NB = 4, T = 4096, M = NB * T, D = 1024, DIN = 6944, FF = 4096;
constexpr float EPS = 1e-6f;
constexpr int C_MLI = 2048, C_NSG = 3336, C_MG = 3872;
constexpr int P_MLQ = 0, P_MLK = 512, P_MLV = 1024, P_MLO = 1536, P_NSQ = 2048, P_KC = 2560, P_VC = 2688, P_KS = 2816, P_VS = 2944, P_KW = 3072, P_VW = 3200, P_XAQ = 3328, PW = 3840;
constexpr size_t MiB = 1u << 20;
constexpr size_t WS_U = 40 * MiB;
constexpr size_t WS_P = 72 * MiB;
constexpr size_t WS_Y = 192 * MiB;
constexpr size_t WS_AFFN = 200 * MiB;
constexpr size_t WS_S32 = 240 * MiB;
constexpr size_t WS_MEMN = 242 * MiB;
constexpr size_t WS_MEMKV = 244 * MiB;
constexpr size_t WS_KC = 246 * MiB;
constexpr size_t WS_VC = 246 * MiB + 512 * 1024;
constexpr size_t WS_NA = 247 * MiB;
constexpr size_t WS_G = 248 * MiB;
constexpr size_t WS_MLOC = 248 * MiB + 4096;
constexpr size_t WS_MPREV = 248 * MiB + 8192;

__device__ __forceinline__ float wave_sum(float v) {
#pragma unroll
    for (int o = 1; o < 64; o <<= 1) v += __shfl_xor(v, o);
    return v;
}
__device__ __forceinline__ float wave_max(float v) {
#pragma unroll
    for (int o = 1; o < 64; o <<= 1) v = fmaxf(v, __shfl_xor(v, o));
    return v;
}

template <bool OUT_BF16>
__device__ __forceinline__ void rms_rows(VB vb, const float* x, const float* g, void* out) {
    float* red = (float*)vb.sm;
    const int row = vb.id, tid = vb.tid;
    const float4 v = ((const float4*)(x + (size_t)row * D))[tid];
    float s = v.x * v.x + v.y * v.y + v.z * v.z + v.w * v.w;
    s = wave_sum(s);
    if ((tid & 63) == 0) red[tid >> 6] = s;
    __syncthreads();
    const float tot = red[0] + red[1] + red[2] + red[3];
    const float r = rsqrtf(tot * (1.0f / D) + EPS);
    const float4 gg = ((const float4*)g)[tid];
    float4 o; o.x = v.x * r * gg.x; o.y = v.y * r * gg.y; o.z = v.z * r * gg.z; o.w = v.w * r * gg.w;
    if (OUT_BF16) { bf16_t* ob = (bf16_t*)out + (size_t)row * D + tid * 4; ob[0] = f2bf(o.x); ob[1] = f2bf(o.y); ob[2] = f2bf(o.z); ob[3] = f2bf(o.w); }
    else ((float4*)((float*)out + (size_t)row * D))[tid] = o;
}

struct GArgs { const bf16_t* A; const float* W; int lda, ldw, N, K; };
template <class Epi>
__device__ __forceinline__ void ngemm(VB vb, GArgs ga, Epi epi) {
    const bf16_t* A = ga.A; const float* W = ga.W; const int lda = ga.lda, ldw = ga.ldw, N = ga.N, K = ga.K;
    float (*As)[65] = (float (*)[65])vb.sm; float (*Bs)[65] = (float (*)[65])(vb.sm + 16 * 65 * 4);
    const int tid = vb.tid, tx = tid & 15, ty = tid >> 4;
    const int nx = (N + 63) / 64; const int m0 = (vb.id / nx) * 64, n0 = (vb.id % nx) * 64;
    float acc[4][4];
#pragma unroll
    for (int i = 0; i < 4; ++i)
#pragma unroll
        for (int j = 0; j < 4; ++j) acc[i][j] = 0.f;
    for (int k0 = 0; k0 < K; k0 += 16) {
#pragma unroll
        for (int i = 0; i < 4; ++i) { const int idx = tid + i * 256, r = idx >> 4, kk = idx & 15; As[kk][r] = bf2f(A[(size_t)(m0 + r) * lda + k0 + kk]); }
#pragma unroll
        for (int i = 0; i < 4; ++i) { const int idx = tid + i * 256, kk = idx >> 6, n = idx & 63; Bs[kk][n] = (n0 + n < N) ? W[(size_t)(k0 + kk) * ldw + n0 + n] : 0.f; }
        __syncthreads();
#pragma unroll
        for (int kk = 0; kk < 16; ++kk) {
            float a[4], b[4];
#pragma unroll
            for (int i = 0; i < 4; ++i) { a[i] = As[kk][ty * 4 + i]; b[i] = Bs[kk][tx * 4 + i]; }
#pragma unroll
            for (int i = 0; i < 4; ++i)
#pragma unroll
                for (int j = 0; j < 4; ++j) acc[i][j] += a[i] * b[j];
        }
        __syncthreads();
    }
#pragma unroll
    for (int i = 0; i < 4; ++i)
#pragma unroll
        for (int j = 0; j < 4; ++j) { const int n = n0 + tx * 4 + j; if (n < N) epi(m0 + ty * 4 + i, n, acc[i][j]); }
}
struct EpiBiasBf16 { bf16_t* O; const float* bias; int ldo, pad; __device__ void operator()(int m, int n, float a) const { O[(size_t)m * ldo + n] = f2bf(a + (bias ? bias[n] : 0.f)); } };
struct EpiBiasF32 { float* O; const float* bias; int ldo, pad; __device__ void operator()(int m, int n, float a) const { O[(size_t)m * ldo + n] = a + bias[n]; } };
struct EpiSigBf16 { bf16_t* O; const float* bias; int ldo, pad; __device__ void operator()(int m, int n, float a) const { const float v = a + bias[n]; O[(size_t)m * ldo + n] = f2bf(1.f / (1.f + __expf(-v))); } };
struct EpiMerge { const bf16_t* G; float* Mf; bf16_t* Mb; int j, pad; __device__ void operator()(int m, int n, float a) const {
    const float g = bf2f(G[(size_t)m * 3072 + j * 1024 + n]); float v = g * a; if (j > 0) v += Mf[(size_t)m * D + n];
    if (j < 2) Mf[(size_t)m * D + n] = v; else Mb[(size_t)m * D + n] = f2bf(v); } };
struct EpiResid { const float* X; float* O; __device__ void operator()(int m, int n, float a) const { O[(size_t)m * D + n] = X[(size_t)m * D + n] + a; } };
struct EpiRelu2 { bf16_t* O; __device__ void operator()(int m, int n, float a) const { const float r = fmaxf(a, 0.f); O[(size_t)m * FF + n] = f2bf(r * r); } };

__device__ __forceinline__ float convqk(const bf16_t* P, const float* w  , int m, int t, int ch) {
    float y = 0.f;
#pragma unroll
    for (int j = 0; j < 4; ++j) if (t - j >= 0) y += w[j * 1024 + ch] * bf2f(P[(size_t)(m - j) * PW + ch]);
    return bf2f(f2bf(y / (1.f + __expf(-y))));
}
__device__ __forceinline__ float logsig(float x) { return fminf(x, 0.f) - log1pf(__expf(-fabsf(x))); }
__device__ __forceinline__ void m1_naive(VB vb, const bf16_t* P, const float* cw, const float* S32, float* Abuf, float* NA, float* Gc, float* Mloc) {
    float (*kk)[128] = (float (*)[128])vb.sm; float* e = (float*)(vb.sm + 32768); float* bc = e + 64;
    const int ci = vb.id, c = ci & 63, bh = ci >> 6, h = bh & 3, b = bh >> 2, tid = vb.tid;
    const int m0 = b * T + c * 64;
    if (tid == 0) {
        float run = 0.f;
        for (int s = 0; s < 64; ++s) { run += logsig(S32[(size_t)(m0 + s) * 32 + 4 + h]); bc[s] = run; }
        const float g = run; float mx = -INFINITY;
        for (int s = 0; s < 64; ++s) { const float w = g - bc[s] + S32[(size_t)(m0 + s) * 32 + h]; e[s] = w; mx = fmaxf(mx, w); }
        for (int s = 0; s < 64; ++s) e[s] = __expf(e[s] - mx);
        Gc[ci] = g; Mloc[ci] = mx;
    }
    for (int i = tid; i < 64 * 128; i += 256) { const int s = i >> 7, k = i & 127; kk[s][k] = convqk(P, cw, m0 + s, c * 64 + s, 512 + h * 128 + k) * 0.08838834764831845f; }
    __syncthreads();
    const int v = tid & 127, kh = tid >> 7;
    float acc[64];
#pragma unroll
    for (int i = 0; i < 64; ++i) acc[i] = 0.f;
    for (int s = 0; s < 64; ++s) {
        const float ev = e[s] * bf2f(P[(size_t)(m0 + s) * PW + P_MLV + h * 128 + v]);
#pragma unroll
        for (int i = 0; i < 64; ++i) acc[i] += kk[s][kh * 64 + i] * ev;
    }
#pragma unroll
    for (int i = 0; i < 64; ++i) Abuf[((size_t)ci * 128 + kh * 64 + i) * 128 + v] = acc[i];
    if (tid < 128) { float n = 0.f; for (int s = 0; s < 64; ++s) n += e[s] * kk[s][tid]; NA[(size_t)ci * 128 + tid] = n; }
}
__device__ __forceinline__ void m2_naive(VB vb, float* Abuf, float* NA, const float* Gc, const float* Mloc, float* Mprev) {
    const int i = vb.id * 256 + vb.tid;
    const int bh = i >> 14, kv = i & 16383, k = kv >> 7, v = kv & 127;
    float C = 0.f, n = 0.f, m = 0.f;
    for (int c = 0; c < 64; ++c) {
        const int ci = bh * 64 + c;
        const float g = Gc[ci], ml = Mloc[ci];
        const float mn = fmaxf(g + m, ml), a = __expf(g + m - mn), bb = __expf(ml - mn);
        const size_t idx = ((size_t)ci * 128 + k) * 128 + v;
        const float A = Abuf[idx]; Abuf[idx] = C; C = a * C + bb * A;
        if (v == 0) { const float nA = NA[(size_t)ci * 128 + k]; NA[(size_t)ci * 128 + k] = n; n = a * n + bb * nA; }
        if (kv == 0) Mprev[ci] = m;
        m = mn;
    }
}
__device__ __forceinline__ void m3_naive(VB vb, const bf16_t* P, const float* cw, const float* S32, const float* Cprev, const float* Nprev, const float* Mprev,
                                                const float* normg, bf16_t* Yml) {
    float* q = (float*)vb.sm; float* Srow = q + 128; float* bc = Srow + 64; float* li = bc + 64; float* sh = li + 64;
    const int ci = vb.id >> 6, tt = vb.id & 63, c = ci & 63, bh = ci >> 6, h = bh & 3, b = bh >> 2, tid = vb.tid;
    const int m0 = b * T + c * 64, m = m0 + tt;
    q[tid] = convqk(P, cw, m, c * 64 + tt, h * 128 + tid);
    if (tid == 0) { float run = 0.f; for (int s = 0; s <= tt; ++s) { run += logsig(S32[(size_t)(m0 + s) * 32 + 4 + h]); bc[s] = run; li[s] = S32[(size_t)(m0 + s) * 32 + h]; } }
    __syncthreads();
    const float mprev = Mprev[ci], inter = bc[tt] + mprev;
    float mt = inter;
    for (int s = 0; s <= tt; ++s) mt = fmaxf(mt, bc[tt] - bc[s] + li[s]);
    if (tid < 64) {
        float sv = 0.f;
        if (tid <= tt) { float dot = 0.f; for (int k = 0; k < 128; ++k) dot += q[k] * convqk(P, cw, m0 + tid, c * 64 + tid, 512 + h * 128 + k);
            sv = dot * 0.08838834764831845f * __expf(bc[tt] - bc[tid] + li[tid] - mt); }
        Srow[tid] = sv;
    }
    __syncthreads();
    const float sc = __expf(inter - mt);
    float num = 0.f, den = 0.f;
    for (int s = 0; s <= tt; ++s) { num += Srow[s] * bf2f(P[(size_t)(m0 + s) * PW + P_MLV + h * 128 + tid]); den += Srow[s]; }
    float qc = 0.f, qn = 0.f;
    for (int k = 0; k < 128; ++k) { qc += q[k] * Cprev[((size_t)ci * 128 + k) * 128 + tid]; qn += q[k] * Nprev[(size_t)ci * 128 + k]; }
    num += sc * qc; den += sc * qn;
    const float hv = num / fmaxf(fabsf(den), __expf(-mt));
    float ss = wave_sum(hv * hv);
    if ((tid & 63) == 0) sh[tid >> 6] = ss;
    __syncthreads();
    const float r = rsqrtf((sh[0] + sh[1]) * (1.f / 128.f) + EPS);
    const float o = bf2f(P[(size_t)m * PW + P_MLO + h * 128 + tid]);
    Yml[(size_t)m * 512 + h * 128 + tid] = f2bf(1.f / (1.f + __expf(-o)) * hv * r * normg[h * 128 + tid]);
}

__device__ __forceinline__ float gelu_tanh(float x) { const float u = 0.7978845608028654f * (x + 0.044715f * x * x * x); return 0.5f * x * (1.f + tanhf(u)); }
__device__ __forceinline__ void n1_naive(VB vb, const bf16_t* P, const float* pe  , const float* w1  , const float* w2  , bf16_t* KC, bf16_t* VC) {
    float* xin = (float*)vb.sm; float* hid = xin + 2048;
    int idx = vb.id; const int g = idx & 1; idx >>= 1; const int n = idx % 255; idx /= 255; const int b = idx & 3, kv = idx >> 2, tid = vb.tid;
    const int pcol = (kv ? P_VC : P_KC) + g * 64;
    for (int i = tid; i < 2048; i += 256) { const int l = i >> 6, d = i & 63; xin[i] = bf2f(P[(size_t)(b * T + n * 16 + l) * PW + pcol + d]) + pe[kv * 2048 + i]; }
    __syncthreads();
    float a = 0.f; const float* w = w1 + (size_t)kv * 2048 * 256 + tid;
    for (int i = 0; i < 2048; ++i) a += xin[i] * w[(size_t)i * 256];
    hid[tid] = gelu_tanh(a);
    __syncthreads();
    if (tid < 64) { float o = 0.f; const float* ww = w2 + (size_t)kv * 256 * 64 + tid; for (int j = 0; j < 256; ++j) o += hid[j] * ww[j * 64];
        (kv ? VC : KC)[((size_t)(b * 256 + n) * 2 + g) * 64 + tid] = f2bf(o); }
}
__device__ __forceinline__ void n2_naive(VB vb, const bf16_t* P, const float* S32, const bf16_t* KC, const bf16_t* VC, bf16_t* Ynsa) {
    float (*q_s)[64] = (float (*)[64])vb.sm; float (*sc)[1024] = (float (*)[1024])(vb.sm + 1024); float (*pc)[256] = (float (*)[256])(vb.sm + 1024 + 16384); float* imp_s = (float*)(vb.sm + 1024 + 16384 + 4096);
    unsigned long long& selmask = *(unsigned long long*)(vb.sm + 1024 + 16384 + 4096 + 256);
    const int g = vb.id & 1, m = vb.id >> 1, b = m / T, t = m % T, tid = vb.tid, r = tid >> 6, lane = tid & 63, h = g * 4 + r;
    const float slope = exp2f(-(float)(h + 1));
    q_s[r][lane] = bf2f(P[(size_t)m * PW + P_NSQ + h * 64 + lane]) * 0.125f;
    __syncthreads();
    float sv[4]; float mx = -INFINITY;
#pragma unroll
    for (int i = 0; i < 4; ++i) { const int n = lane + 64 * i; sv[i] = -INFINITY;
        if (n < 255) { const int dist = t - (16 * n + 31); if (dist >= 0) { const bf16_t* kr = KC + ((size_t)(b * 256 + n) * 2 + g) * 64; float dot = 0.f; for (int d = 0; d < 64; ++d) dot += q_s[r][d] * bf2f(kr[d]);
            sv[i] = dot - slope * (float)dist; mx = fmaxf(mx, sv[i]); } } }
    mx = wave_max(mx);
    float sum = 0.f;
#pragma unroll
    for (int i = 0; i < 4; ++i) { sv[i] = (sv[i] == -INFINITY) ? 0.f : __expf(sv[i] - mx); sum += sv[i]; }
    sum = wave_sum(sum);
    const float inv = sum > 0.f ? 1.f / sum : 0.f;
#pragma unroll
    for (int i = 0; i < 4; ++i) pc[r][lane + 64 * i] = sv[i] * inv;
    __syncthreads();
    float oc = 0.f;
    { const int nmax = (t >= 31) ? ((t - 31) / 16) : -1; for (int n = 0; n <= nmax && n < 255; ++n) oc += pc[r][n] * bf2f(VC[((size_t)(b * 256 + n) * 2 + g) * 64 + lane]); }
    if (tid < 64) { const int j = tid; float im = 0.f;
        for (int n = 4 * j - 1; n <= 4 * j + 3; ++n) if (n >= 0 && n < 255) im += (pc[0][n] + pc[1][n]) + (pc[2][n] + pc[3][n]);
        const int cur = t >> 6; const bool valid = j <= cur, forced = (j == 0) || (j == cur) || (j == cur - 1);
        const float s = valid ? im + (forced ? 1000.f : 0.f) : -1e30f;
        imp_s[j] = s; }
    __syncthreads();
    if (tid < 64) { const int j = tid; const float s = imp_s[j]; int rank = 0;
        for (int jj = 0; jj < 64; ++jj) { const float o = imp_s[jj]; rank += (o > s || (o == s && jj < j)) ? 1 : 0; }
        const unsigned long long mk = __ballot(rank < 16 && j <= (t >> 6)); if (tid == 0) selmask = mk; }
    __syncthreads();
    float osel = 0.f;
    { unsigned long long mk = selmask; int slot = 0; float mxs = -INFINITY;
      while (mk) { const int jb = __ffsll((long long)mk) - 1; mk &= mk - 1; const int pos = jb * 64 + lane; float s = -INFINITY;
          if (pos <= t) { const bf16_t* kr = P + (size_t)(b * T + pos) * PW + P_KS + g * 64; float dot = 0.f; for (int d = 0; d < 64; ++d) dot += q_s[r][d] * bf2f(kr[d]); s = dot - slope * (float)(t - pos); }
          sc[r][slot * 64 + lane] = s; mxs = fmaxf(mxs, s); ++slot; }
      mxs = wave_max(mxs); float sm = 0.f;
      for (int i = 0; i < slot; ++i) { const float s = sc[r][i * 64 + lane]; const float p = (s == -INFINITY) ? 0.f : __expf(s - mxs); sc[r][i * 64 + lane] = p; sm += p; }
      sm = wave_sum(sm);
      mk = selmask; slot = 0;
      while (mk) { const int jb = __ffsll((long long)mk) - 1; mk &= mk - 1;
          for (int i = 0; i < 64; ++i) { const int pos = jb * 64 + i; if (pos > t) break; osel += sc[r][slot * 64 + i] * bf2f(P[(size_t)(b * T + pos) * PW + P_VS + g * 64 + lane]); }
          ++slot; }
      osel /= sm; }
    __syncthreads();
    float owin = 0.f;
    { float mxs = -INFINITY;
      for (int i = 0; i < 8; ++i) { const int pos = t - 511 + i * 64 + lane; float s = -INFINITY;
          if (pos >= 0) { const bf16_t* kr = P + (size_t)(b * T + pos) * PW + P_KW + g * 64; float dot = 0.f; for (int d = 0; d < 64; ++d) dot += q_s[r][d] * bf2f(kr[d]); s = dot - slope * (float)(t - pos); }
          sc[r][i * 64 + lane] = s; mxs = fmaxf(mxs, s); }
      mxs = wave_max(mxs); float sm = 0.f;
      for (int i = 0; i < 8; ++i) { const float s = sc[r][i * 64 + lane]; const float p = (s == -INFINITY) ? 0.f : __expf(s - mxs); sc[r][i * 64 + lane] = p; sm += p; }
      sm = wave_sum(sm);
      for (int i = 0; i < 512; ++i) { const int pos = t - 511 + i; if (pos < 0) continue; owin += sc[r][i] * bf2f(P[(size_t)(b * T + pos) * PW + P_VW + g * 64 + lane]); }
      owin /= sm; }
    const float* gp = S32 + (size_t)m * 32 + 8 + h * 3;
    const float g0 = 1.f / (1.f + __expf(-gp[0])), g1 = 1.f / (1.f + __expf(-gp[1])), g2 = 1.f / (1.f + __expf(-gp[2]));
    Ynsa[(size_t)m * 512 + h * 64 + lane] = f2bf(g0 * oc + g1 * osel + g2 * owin);
}
__device__ __forceinline__ void x1_naive(VB vb, const bf16_t* P, const bf16_t* MEMKV, bf16_t* Yxa) {
    float (*q_s)[128] = (float (*)[128])vb.sm; float (*p_s)[256] = (float (*)[256])(vb.sm + 2048);
    const int m = vb.id, b = m / T, tid = vb.tid, h = tid >> 6, lane = tid & 63;
    q_s[h][lane] = bf2f(P[(size_t)m * PW + P_XAQ + h * 128 + lane]) * 0.08838834764831845f;
    q_s[h][lane + 64] = bf2f(P[(size_t)m * PW + P_XAQ + h * 128 + lane + 64]) * 0.08838834764831845f;
    __syncthreads();
    float sv[4]; float mx = -INFINITY;
#pragma unroll
    for (int i = 0; i < 4; ++i) { const int j = lane + 64 * i; const bf16_t* kr = MEMKV + (size_t)(b * 256 + j) * 1024 + h * 128; float dot = 0.f; for (int d = 0; d < 128; ++d) dot += q_s[h][d] * bf2f(kr[d]); sv[i] = dot; mx = fmaxf(mx, dot); }
    mx = wave_max(mx); float sm = 0.f;
#pragma unroll
    for (int i = 0; i < 4; ++i) { sv[i] = __expf(sv[i] - mx); sm += sv[i]; }
    sm = wave_sum(sm);
#pragma unroll
    for (int i = 0; i < 4; ++i) p_s[h][lane + 64 * i] = sv[i] / sm;
    __syncthreads();
    float o0 = 0.f, o1 = 0.f;
    for (int j = 0; j < 256; ++j) { const bf16_t* vr = MEMKV + (size_t)(b * 256 + j) * 1024 + 512 + h * 128; const float p = p_s[h][j]; o0 += p * bf2f(vr[lane]); o1 += p * bf2f(vr[lane + 64]); }
    Yxa[(size_t)m * 512 + h * 128 + lane] = f2bf(o0); Yxa[(size_t)m * 512 + h * 128 + lane + 64] = f2bf(o1);
}


namespace pg8 {
#define PG8_LAS __attribute__((address_space(3)))
typedef unsigned short bf16_t;
typedef short bf16x8 __attribute__((ext_vector_type(8)));
typedef float f32x4 __attribute__((ext_vector_type(4)));
typedef unsigned u32x4 __attribute__((ext_vector_type(4)));
constexpr int BM = 256, BK = 64, HALF = 128, HTB = HALF * BK * 2  , STAGE_BYTES = 8 * HTB, NXCD = 8, WGM = 8;

__host__ __device__ __forceinline__ int lds_byte(int r, int c) { const int st = (r >> 4) * 2 + (c >> 5), rr = r & 15, cc = c & 31, ob = rr * 64 + cc * 2; return st * 1024 + (ob ^ (((ob >> 9) & 1) << 5)); }
__host__ __device__ __forceinline__ void stage_rc(int b, int& R, int& C) { const int st = b / 1024, sb = b % 1024, swz = sb ^ (((sb >> 9) & 1) << 5); R = (st >> 1) * 16 + swz / 64; C = (st & 1) * 32 + (swz % 64) / 2; }
__host__ __device__ __forceinline__ int perm32(int rho) { const int n = rho >> 4, i = rho & 15; return 8 * (i >> 2) + 4 * n + (i & 3); }

struct Unit { int pm, pn, j; };
struct Gemm { const bf16_t* A; const bf16_t* Bt; int M, N, K; };

struct StaticOrder {
    int nM, nN, nwg, G, c;
    __host__ __device__ void init(int M, int N, int G_, int c_) { nM = M / BM; nN = N / BM; nwg = nM * nN; G = G_; c = c_; }
    __host__ __device__ bool next(int i, Unit& u) const {
        const long L = (long)i * G + c; if (L >= nwg) return false;
        int wgid = (int)L; { const int q = nwg / NXCD, r = nwg % NXCD, xcd = wgid % NXCD, off = wgid / NXCD; wgid = (xcd < r ? xcd * (q + 1) : r * (q + 1) + (xcd - r) * q) + off; }
        const int nig = WGM * nN, gid = wgid / nig, fm = gid * WGM, gsz = (nM - fm) < WGM ? (nM - fm) : WGM;
        u.pm = fm + ((wgid % nig) % gsz); u.pn = (wgid % nig) / gsz; u.j = 0; return true;
    }
    __device__ __forceinline__ const char* pa(const Gemm& g, const Unit& u, size_t tstep) const { return (const char*)g.A + (size_t)u.pm * tstep; }
    __device__ __forceinline__ const char* pb(const Gemm& g, const Unit& u, size_t tstep) const { return (const char*)g.Bt + (size_t)u.pn * tstep; }
    __device__ __forceinline__ void a_ready(const Unit&) const {}
    __device__ __forceinline__ void done(const Unit&) const {}
};

struct MergeOrder {
    StaticOrder so; size_t sa, sb;
    __device__ __forceinline__ bool next(int i, Unit& u) const { if (i >= 3) return false; const bool ok = so.next(0, u); u.j = i; return ok; }
    __device__ __forceinline__ const char* pa(const Gemm& g, const Unit& u, size_t tstep) const { return (const char*)g.A + (size_t)u.j * sa + (size_t)u.pm * tstep; }
    __device__ __forceinline__ const char* pb(const Gemm& g, const Unit& u, size_t tstep) const { return (const char*)g.Bt + (size_t)u.j * sb + (size_t)u.pn * tstep; }
    __device__ __forceinline__ void a_ready(const Unit&) const {}
    __device__ __forceinline__ void done(const Unit&) const {}
};
typedef float f32x2_t __attribute__((ext_vector_type(2))); typedef __bf16 bf16x2_t __attribute__((ext_vector_type(2)));
__device__ __forceinline__ unsigned cvt_pk_bf16(float lo, float hi) { f32x2_t v = {lo, hi}; bf16x2_t b = __builtin_convertvector(v, bf16x2_t); return __builtin_bit_cast(unsigned, b); }
typedef float f32x2 __attribute__((ext_vector_type(2)));

typedef unsigned u32x2 __attribute__((ext_vector_type(2)));
__device__ __forceinline__ float bflo(unsigned w) { return __uint_as_float(w << 16); }
__device__ __forceinline__ float bfhi(unsigned w) { return __uint_as_float(w & 0xffff0000u); }
template <int ACT> __device__ __forceinline__ f32x4 act4(f32x4 v) {
    if (ACT == 1) { f32x4 o; for (int e = 0; e < 4; ++e) o[e] = __builtin_amdgcn_rcpf(1.f + __expf(-v[e])); return o; }
    if (ACT == 2) { f32x4 o; for (int e = 0; e < 4; ++e) { const float r = fmaxf(v[e], 0.f); o[e] = r * r; } return o; }
    return v;
}
template <int ACT> struct EpiStore {
    static constexpr bool PERM = true, AFTER_DRAIN = false;
    bf16_t* O; const float* bias; float* S32; int ldc, small_pn;
    __device__ __forceinline__ void operator()(const f32x4 (&acc)[2][2][4][2], const Unit& u, int wr, int wc, int fr, int fq) const {
        asm volatile("s_waitcnt vmcnt(0)" ::: "memory");
        const int row0 = u.pm * BM + wr * 64 + fr, col0 = u.pn * BM + wc * 32 + 8 * fq;
        if (u.pn == small_pn) {
            if (wc == 0) {
                const f32x4 b0 = *(const f32x4*)(bias + col0), b1 = *(const f32x4*)(bias + col0 + 4);
#pragma unroll
                for (int ai = 0; ai < 2; ++ai)
#pragma unroll
                    for (int m = 0; m < 4; ++m) { float* rp = S32 + (size_t)(row0 + ai * HALF + m * 16) * 32 + 8 * fq;
                        *(f32x4*)rp = acc[ai][0][m][0] + acc[ai][1][m][0] + b0; *(f32x4*)(rp + 4) = acc[ai][0][m][1] + acc[ai][1][m][1] + b1; }
            }
            return;
        }
        f32x4 bv[2][2];
#pragma unroll
        for (int bj = 0; bj < 2; ++bj)
#pragma unroll
            for (int n = 0; n < 2; ++n) bv[bj][n] = bias ? *(const f32x4*)(bias + col0 + bj * HALF + 4 * n) : (f32x4){0.f, 0.f, 0.f, 0.f};
#pragma unroll
        for (int ai = 0; ai < 2; ++ai)
#pragma unroll
            for (int m = 0; m < 4; ++m) { bf16_t* rowp = O + (size_t)(row0 + ai * HALF + m * 16) * ldc + col0;
#pragma unroll
                for (int bj = 0; bj < 2; ++bj) { const f32x4 v0 = act4<ACT>(acc[ai][bj][m][0] + bv[bj][0]), v1 = act4<ACT>(acc[ai][bj][m][1] + bv[bj][1]);
                    u32x4 w; w.x = cvt_pk_bf16(v0[0], v0[1]); w.y = cvt_pk_bf16(v0[2], v0[3]); w.z = cvt_pk_bf16(v1[0], v1[1]); w.w = cvt_pk_bf16(v1[2], v1[3]);
                    *(u32x4*)(rowp + bj * HALF) = w; } }
    }
};
struct EpiMergeG {
    static constexpr bool PERM = true, AFTER_DRAIN = false;
    const bf16_t* G; float* Mf; bf16_t* Mb;
    __device__ __forceinline__ void operator()(const f32x4 (&acc)[2][2][4][2], const Unit& u, int wr, int wc, int fr, int fq) const {
        const int j = u.j;
        asm volatile("s_waitcnt vmcnt(0)" ::: "memory");
        const int row0 = u.pm * BM + wr * 64 + fr, col0 = u.pn * BM + wc * 32 + 8 * fq;
#pragma unroll
        for (int ai = 0; ai < 2; ++ai)
#pragma unroll
            for (int m = 0; m < 4; ++m) { const size_t row = (size_t)(row0 + ai * HALF + m * 16);
#pragma unroll
                for (int bj = 0; bj < 2; ++bj) { const int col = col0 + bj * HALF;
                    const u32x4 gw = *(const u32x4*)(G + row * 3072 + j * 1024 + col);
                    f32x4 v0 = (f32x4){bflo(gw.x), bfhi(gw.x), bflo(gw.y), bfhi(gw.y)} * acc[ai][bj][m][0], v1 = (f32x4){bflo(gw.z), bfhi(gw.z), bflo(gw.w), bfhi(gw.w)} * acc[ai][bj][m][1];
                    float* mp = Mf + row * 1024 + col;
                    if (j > 0) { v0 += *(const f32x4*)mp; v1 += *(const f32x4*)(mp + 4); }
                    if (j < 2) { *(f32x4*)mp = v0; *(f32x4*)(mp + 4) = v1; }
                    else { u32x4 w; w.x = cvt_pk_bf16(v0[0], v0[1]); w.y = cvt_pk_bf16(v0[2], v0[3]); w.z = cvt_pk_bf16(v1[0], v1[1]); w.w = cvt_pk_bf16(v1[2], v1[3]); *(u32x4*)(Mb + row * 1024 + col) = w; } } }
    }
};
struct EpiResidF {
    static constexpr bool PERM = true, AFTER_DRAIN = false;
    const float* X; float* O;
    __device__ __forceinline__ void operator()(const f32x4 (&acc)[2][2][4][2], const Unit& u, int wr, int wc, int fr, int fq) const {
        asm volatile("s_waitcnt vmcnt(0)" ::: "memory");
        const int row0 = u.pm * BM + wr * 64 + fr, col0 = u.pn * BM + wc * 32 + 8 * fq;
#pragma unroll
        for (int ai = 0; ai < 2; ++ai)
#pragma unroll
            for (int m = 0; m < 4; ++m) { const size_t off = (size_t)(row0 + ai * HALF + m * 16) * 1024 + col0;
#pragma unroll
                for (int bj = 0; bj < 2; ++bj) { const f32x4 x0 = *(const f32x4*)(X + off + bj * HALF), x1 = *(const f32x4*)(X + off + bj * HALF + 4);
                    *(f32x4*)(O + off + bj * HALF) = x0 + acc[ai][bj][m][0]; *(f32x4*)(O + off + bj * HALF + 4) = x1 + acc[ai][bj][m][1]; } }
    }
};
struct EpiResRms {
    static constexpr bool PERM = false, AFTER_DRAIN = true;
    const float* R; float* Hout; float* Nf; bf16_t* Nb; const float* gain; float* xbuf; unsigned* cnt;
    __device__ __forceinline__ void fused(f32x4 (&acc)[2][2][4][2], const Unit& u, int wr, int wc, int fr, int fq, PG8_LAS unsigned char* lds, int wid, int lane) const {
        PG8_LAS float* Pp = (PG8_LAS float*)lds; PG8_LAS float* S = (PG8_LAS float*)(lds + 4096);
        const int col0 = u.pn * BM + wc * 32 + 4 * fq;
#pragma unroll
        for (int ai = 0; ai < 2; ++ai)
#pragma unroll
            for (int m = 0; m < 4; ++m) { const size_t off = (size_t)(u.pm * BM + ai * HALF + wr * 64 + m * 16 + fr) * 1024 + col0; float sq = 0.f;
#pragma unroll
                for (int bj = 0; bj < 2; ++bj)
#pragma unroll
                    for (int n = 0; n < 2; ++n) { const f32x4 v = acc[ai][bj][m][n] + *(const f32x4*)(R + off + bj * HALF + n * 16); acc[ai][bj][m][n] = v; sq += (v[0] * v[0] + v[1] * v[1]) + (v[2] * v[2] + v[3] * v[3]); }
                sq += __shfl_xor(sq, 16); sq += __shfl_xor(sq, 32);
                if (fq == 0) Pp[(ai * HALF + wr * 64 + m * 16 + fr) * 4 + wc] = sq; }
        asm volatile("s_waitcnt lgkmcnt(0)" ::: "memory"); __builtin_amdgcn_s_barrier(); asm volatile("" ::: "memory");
        const int row = wid * 32 + (lane & 31);
        if (lane < 32) { const float tot = (Pp[row * 4 + 0] + Pp[row * 4 + 1]) + (Pp[row * 4 + 2] + Pp[row * 4 + 3]);
            __hip_atomic_store(xbuf + ((size_t)(u.pm * BM + row) * 4 + u.pn), tot, __ATOMIC_RELAXED, __HIP_MEMORY_SCOPE_AGENT); }
        asm volatile("s_waitcnt vmcnt(0)" ::: "memory");
        if (lane == 0) __hip_atomic_fetch_add(cnt + 64 * u.pm, 1u, __ATOMIC_RELAXED, __HIP_MEMORY_SCOPE_AGENT);
        if (wid == 0) { unsigned sp = 0;
            while ((unsigned)__builtin_amdgcn_readfirstlane(__hip_atomic_load(cnt + 64 * u.pm, __ATOMIC_RELAXED, __HIP_MEMORY_SCOPE_AGENT)) < 32u) { __builtin_amdgcn_s_sleep(2); if (++sp > (1u << 22)) break; }
            __builtin_amdgcn_fence(__ATOMIC_ACQUIRE, "agent"); }
        asm volatile("s_waitcnt vmcnt(0) lgkmcnt(0)" ::: "memory"); __builtin_amdgcn_s_barrier(); asm volatile("" ::: "memory");
        if (lane < 32) { const float* slot = xbuf + (size_t)(u.pm * BM + row) * 4; float t = 0.f;
#pragma unroll
            for (int q = 0; q < 4; ++q) t += __hip_atomic_load(slot + q, __ATOMIC_RELAXED, __HIP_MEMORY_SCOPE_AGENT);
            S[row] = rsqrtf(t * (1.0f / 1024.0f) + 1e-6f); }
        asm volatile("s_waitcnt lgkmcnt(0)" ::: "memory"); __builtin_amdgcn_s_barrier(); asm volatile("" ::: "memory");
        f32x4 gv[2][2];
#pragma unroll
        for (int bj = 0; bj < 2; ++bj)
#pragma unroll
            for (int n = 0; n < 2; ++n) gv[bj][n] = *(const f32x4*)(gain + col0 + bj * HALF + n * 16);
#pragma unroll
        for (int ai = 0; ai < 2; ++ai)
#pragma unroll
            for (int m = 0; m < 4; ++m) { const int r = ai * HALF + wr * 64 + m * 16 + fr; const float rs = S[r]; const size_t off = (size_t)(u.pm * BM + r) * 1024 + col0;
#pragma unroll
                for (int bj = 0; bj < 2; ++bj)
#pragma unroll
                    for (int n = 0; n < 2; ++n) { const f32x4 v = acc[ai][bj][m][n]; const f32x4 o = v * rs * gv[bj][n];
                        if (Hout) *(f32x4*)(Hout + off + bj * HALF + n * 16) = v;
                        if (Nf) *(f32x4*)(Nf + off + bj * HALF + n * 16) = o;
                        if (Nb) { u32x2 w; w.x = cvt_pk_bf16(o[0], o[1]); w.y = cvt_pk_bf16(o[2], o[3]); *(u32x2*)(Nb + off + bj * HALF + n * 16) = w; } } }
    }
};

template <class Epi, class Sched, bool ALIGN_EPI = false, bool SP2 = false>
__device__ __forceinline__ void gemm_phase(PG8_LAS unsigned char* lds, const Gemm g, const Sched& S, const Epi& E) {
    const int tid = threadIdx.x, wid = __builtin_amdgcn_readfirstlane(tid >> 6), lane = tid & 63, wr = wid >> 2, wc = wid & 3, fr = lane & 15, fq = lane >> 4;
    const int K = g.K, nt = K / BK;
    unsigned voffA[2], voffB[2];
#pragma unroll
    for (int i = 0; i < 2; ++i) { int R, C; stage_rc(tid * 16 + i * 8192, R, C); const int Rb = Epi::PERM ? ((R & ~31) + perm32(R & 31)) : R;
        voffA[i] = (unsigned)(R * K + C) * 2u; voffB[i] = (unsigned)(Rb * K + C) * 2u; }
    const size_t kstep = (size_t)(BK * 2);
    const size_t hstep = (size_t)HALF * K * 2;
    const size_t tstep = 2 * hstep;
    const unsigned ldsw = (unsigned)wid * 1024u;
    const int aoff = lds_byte(wr * 64 + fr, fq * 8), boff = lds_byte(wc * 32 + fr, fq * 8);
#define PG8_SA(b, h) (((b) * 2 + (h)) * HTB)
#define PG8_SB(b, h) ((4 + (b) * 2 + (h)) * HTB)
#define PG8_STAGE(bufoff, gbase, voff) do { _Pragma("unroll") for (int _i = 0; _i < 2; ++_i) \
        __builtin_amdgcn_global_load_lds((const unsigned*)((const char*)(gbase) + (voff)[_i]), (PG8_LAS unsigned*)(lds + (bufoff) + ldsw + _i * 8192), 16, 0, 0); } while (0)
#define PG8_LDA(dst, b, h) do { _Pragma("unroll") for (int m = 0; m < 4; ++m) _Pragma("unroll") for (int k = 0; k < 2; ++k) dst[m][k] = *(const PG8_LAS bf16x8*)(lds + PG8_SA(b, h) + aoff + m * 2048 + k * 1024); } while (0)
#define PG8_LDB(dst, b, h) do { _Pragma("unroll") for (int n = 0; n < 2; ++n) _Pragma("unroll") for (int k = 0; k < 2; ++k) dst[n][k] = *(const PG8_LAS bf16x8*)(lds + PG8_SB(b, h) + boff + n * 2048 + k * 1024); } while (0)
#define PG8_MMA(ai, bj, At, Bt) do { __builtin_amdgcn_s_setprio(1); _Pragma("unroll") for (int m = 0; m < 4; ++m) _Pragma("unroll") for (int n = 0; n < 2; ++n) _Pragma("unroll") for (int k = 0; k < 2; ++k) \
        acc[ai][bj][m][n] = __builtin_amdgcn_mfma_f32_16x16x32_bf16(Bt[n][k], At[m][k], acc[ai][bj][m][n], 0, 0, 0); __builtin_amdgcn_s_setprio(0); } while (0)
#define PG8_WAIT_V(n) asm volatile("s_waitcnt vmcnt(" #n ")" ::: "memory")
#define PG8_WAIT_L(n) asm volatile("s_waitcnt lgkmcnt(" #n ")" ::: "memory")
#define PG8_BAR __builtin_amdgcn_s_barrier()
#define PG8_SCHED __builtin_amdgcn_sched_barrier(0)
    Unit cur, nxt; int ui = 0;
    if (!S.next(0, cur)) return;
    f32x4 acc[2][2][4][2];
#pragma unroll
    for (int a = 0; a < 2; ++a)
#pragma unroll
        for (int b = 0; b < 2; ++b)
#pragma unroll
            for (int m = 0; m < 4; ++m)
#pragma unroll
                for (int n = 0; n < 2; ++n) acc[a][b][m][n] = (f32x4){0.f, 0.f, 0.f, 0.f};
    bf16x8 At[4][2], B0[2][2], B1[2][2];
    const char* cA = S.pa(g, cur, tstep); const char* cB = S.pb(g, cur, tstep);
    S.a_ready(cur);
    if constexpr (SP2) {
        PG8_STAGE(PG8_SB(0, 0), cB, voffB); PG8_STAGE(PG8_SB(0, 1), cB + hstep, voffB); PG8_STAGE(PG8_SA(0, 0), cA, voffA); PG8_STAGE(PG8_SA(0, 1), cA + hstep, voffA);
        if (wr == 1) PG8_BAR;
        PG8_WAIT_V(2); PG8_BAR;
        PG8_STAGE(PG8_SB(1, 0), cB + kstep, voffB); PG8_STAGE(PG8_SA(1, 0), cA + kstep, voffA); PG8_STAGE(PG8_SB(1, 1), cB + hstep + kstep, voffB);
        PG8_WAIT_V(6); PG8_BAR;
    } else {
        PG8_STAGE(PG8_SB(0, 0), cB, voffB); PG8_STAGE(PG8_SA(0, 0), cA, voffA); PG8_STAGE(PG8_SB(0, 1), cB + hstep, voffB); PG8_STAGE(PG8_SA(0, 1), cA + hstep, voffA);
        if (wr == 1) PG8_BAR;
        PG8_WAIT_V(4); PG8_BAR;
        PG8_STAGE(PG8_SB(1, 0), cB + kstep, voffB); PG8_STAGE(PG8_SA(1, 0), cA + kstep, voffA); PG8_STAGE(PG8_SB(1, 1), cB + hstep + kstep, voffB);
        PG8_WAIT_V(6); PG8_BAR;
    }
    for (;;) {
        const bool has_next = S.next(ui + 1, nxt);
        const char* nA = has_next ? S.pa(g, nxt, tstep) : cA; const char* nB = has_next ? S.pb(g, nxt, tstep) : cB;
        for (int t = 0; t < nt; t += 2) {
            const bool last = (t == nt - 2);
            const char* a1 = cA + (size_t)(t + 1) * kstep;
            const char* a2 = last ? nA : cA + (size_t)(t + 2) * kstep; const char* b2 = last ? nB : cB + (size_t)(t + 2) * kstep;
            const char* a3 = a2 + kstep; const char* b3 = b2 + kstep;
            if (last && has_next) S.a_ready(nxt);
            if constexpr (SP2) {
            PG8_LDB(B0, 0, 0); PG8_LDB(B1, 0, 1); PG8_SCHED; PG8_LDA(At, 0, 0); PG8_STAGE(PG8_SA(1, 1), a1 + hstep, voffA);
            PG8_WAIT_V(8); PG8_WAIT_L(0); PG8_BAR; PG8_MMA(0, 0, At, B0); PG8_MMA(0, 1, At, B1); PG8_BAR; PG8_SCHED;
            PG8_LDA(At, 0, 1); PG8_STAGE(PG8_SB(0, 0), b2, voffB); PG8_STAGE(PG8_SB(0, 1), b2 + hstep, voffB); PG8_STAGE(PG8_SA(0, 0), a2, voffA);
            PG8_WAIT_V(8); PG8_WAIT_L(0); PG8_BAR; PG8_MMA(1, 0, At, B0); PG8_MMA(1, 1, At, B1); PG8_BAR; PG8_SCHED;
            PG8_LDB(B0, 1, 0); PG8_LDB(B1, 1, 1); PG8_SCHED; PG8_LDA(At, 1, 0); PG8_STAGE(PG8_SA(0, 1), a2 + hstep, voffA);
            PG8_WAIT_V(8); PG8_WAIT_L(0); PG8_BAR; PG8_MMA(0, 0, At, B0); PG8_MMA(0, 1, At, B1); PG8_BAR; PG8_SCHED;
            PG8_LDA(At, 1, 1); PG8_STAGE(PG8_SB(1, 0), b3, voffB); PG8_STAGE(PG8_SB(1, 1), b3 + hstep, voffB); PG8_STAGE(PG8_SA(1, 0), a3, voffA);
            PG8_WAIT_V(8); PG8_WAIT_L(0); PG8_BAR; PG8_MMA(1, 0, At, B0); PG8_MMA(1, 1, At, B1); PG8_BAR; PG8_SCHED;
            } else {
            PG8_LDB(B0, 0, 0); PG8_SCHED; PG8_LDA(At, 0, 0); PG8_STAGE(PG8_SA(1, 1), a1 + hstep, voffA);
            PG8_WAIT_L(8); PG8_BAR; PG8_WAIT_L(0); PG8_MMA(0, 0, At, B0); PG8_BAR; PG8_SCHED;
            PG8_LDB(B1, 0, 1); PG8_STAGE(PG8_SB(0, 0), b2, voffB);
            PG8_BAR; PG8_WAIT_L(0); PG8_MMA(0, 1, At, B1); PG8_BAR;
            PG8_LDA(At, 0, 1); PG8_STAGE(PG8_SA(0, 0), a2, voffA);
            PG8_BAR; PG8_WAIT_L(0); PG8_MMA(1, 0, At, B0); PG8_BAR; PG8_SCHED;
            PG8_STAGE(PG8_SB(0, 1), b2 + hstep, voffB);
            PG8_WAIT_V(6); PG8_BAR; PG8_MMA(1, 1, At, B1); PG8_BAR;
            PG8_LDB(B0, 1, 0); PG8_SCHED; PG8_LDA(At, 1, 0); PG8_STAGE(PG8_SA(0, 1), a2 + hstep, voffA);
            PG8_WAIT_L(8); PG8_BAR; PG8_WAIT_L(0); PG8_MMA(0, 0, At, B0); PG8_BAR; PG8_SCHED;
            PG8_LDB(B1, 1, 1); PG8_STAGE(PG8_SB(1, 0), b3, voffB);
            PG8_BAR; PG8_WAIT_L(0); PG8_MMA(0, 1, At, B1); PG8_BAR;
            PG8_LDA(At, 1, 1); PG8_STAGE(PG8_SA(1, 0), a3, voffA);
            PG8_BAR; PG8_WAIT_L(0); PG8_MMA(1, 0, At, B0); PG8_BAR; PG8_SCHED;
            PG8_STAGE(PG8_SB(1, 1), b3 + hstep, voffB);
            PG8_WAIT_V(6); PG8_BAR; PG8_MMA(1, 1, At, B1); PG8_BAR;
            }
        }
        if constexpr (ALIGN_EPI) { if (wr == 0) PG8_BAR; }
        if constexpr (!Epi::AFTER_DRAIN) { E(acc, cur, wr, wc, fr, fq); S.done(cur); }
        if (!has_next) break;
#pragma unroll
        for (int a = 0; a < 2; ++a)
#pragma unroll
            for (int b = 0; b < 2; ++b)
#pragma unroll
                for (int m = 0; m < 4; ++m)
#pragma unroll
                    for (int n = 0; n < 2; ++n) acc[a][b][m][n] = (f32x4){0.f, 0.f, 0.f, 0.f};
        cur = nxt; cA = nA; cB = nB; ++ui;
        if constexpr (ALIGN_EPI) { if (wr == 1) PG8_BAR; }
    }
    PG8_WAIT_V(0);
    if constexpr (!ALIGN_EPI) { if (wr == 0) PG8_BAR; }
    PG8_BAR;
    if constexpr (Epi::AFTER_DRAIN) { E.fused(acc, cur, wr, wc, fr, fq, lds, wid, lane); S.done(cur); }
#undef PG8_SA
#undef PG8_SB
#undef PG8_STAGE
#undef PG8_LDA
#undef PG8_LDB
#undef PG8_MMA
#undef PG8_WAIT_V
#undef PG8_WAIT_L
#undef PG8_BAR
#undef PG8_SCHED
}
}

namespace nsa {
#define NLAS __attribute__((address_space(3)))
typedef short bf16x8 __attribute__((ext_vector_type(8)));
typedef short s16x4 __attribute__((ext_vector_type(4)));
typedef short v4i16_t __attribute__((ext_vector_type(4)));
typedef float f32x4 __attribute__((ext_vector_type(4)));
typedef unsigned u32x4 __attribute__((ext_vector_type(4)));
typedef unsigned u32x2 __attribute__((ext_vector_type(2)));
typedef unsigned long long u64;
constexpr int RS = 144, TILE_B = 64 * RS;
constexpr float LOG2E = 1.4426950408889634f;
constexpr int L_KB0 = 0, L_VB0 = TILE_B, L_KB1 = 2 * TILE_B, L_VB1 = 3 * TILE_B, L_CK = 4 * TILE_B, L_CV = 8 * TILE_B, L_IMP = 12 * TILE_B, L_MSK = L_IMP + 8192, L_WU = L_MSK + 256, L_END = L_WU + 64;
static_assert(L_END <= 131072, "nsa LDS map");
__device__ __forceinline__ s16x4 vtr(const NLAS char* p) { return __builtin_bit_cast(s16x4, __builtin_amdgcn_ds_read_tr16_b64_v4i16((NLAS v4i16_t*)p)); }
__device__ __forceinline__ f32x4 mfma16(bf16x8 a, bf16x8 b, f32x4 c) { return __builtin_amdgcn_mfma_f32_16x16x32_bf16(a, b, c, 0, 0, 0); }
__device__ __forceinline__ unsigned pkbf(float lo, float hi) { return pg8::cvt_pk_bf16(lo, hi); }
__device__ __forceinline__ void qk_tile(f32x4 (&s)[4], const NLAS char* Kb, const bf16x8 (&qf)[2], int i, int g, float kslope, float bt) {
    bf16x8 a[4][2]; const NLAS char* kp = Kb + i * RS + 16 * g;
#pragma unroll
    for (int kb = 0; kb < 4; ++kb) { a[kb][0] = *(const NLAS bf16x8*)(kp + kb * 16 * RS); a[kb][1] = *(const NLAS bf16x8*)(kp + kb * 16 * RS + 64); }
#pragma unroll
    for (int kb = 0; kb < 4; ++kb) { f32x4 ci; ci[0] = fmaf(kslope, (float)(kb * 16 + 0), bt); ci[1] = fmaf(kslope, (float)(kb * 16 + 1), bt); ci[2] = fmaf(kslope, (float)(kb * 16 + 2), bt); ci[3] = fmaf(kslope, (float)(kb * 16 + 3), bt);
        s[kb] = mfma16(a[kb][0], qf[0], ci); }
#pragma unroll
    for (int kb = 0; kb < 4; ++kb) s[kb] = mfma16(a[kb][1], qf[1], s[kb]);
}
__device__ __forceinline__ void pv_tile(f32x4 (&o)[4], const NLAS char* Vb, const f32x4 (&p)[4], int i, int g) {
    const NLAS char* vb = Vb + (4 * g + (i >> 2)) * RS + (i & 3) * 8;
    s16x4 lo[2][4], hi[2][4];
#pragma unroll
    for (int kk = 0; kk < 2; ++kk)
#pragma unroll
        for (int db = 0; db < 4; ++db) { const NLAS char* vp = vb + (2 * kk) * 16 * RS + db * 32; lo[kk][db] = vtr(vp); hi[kk][db] = vtr(vp + 16 * RS); }
    bf16x8 pf[2];
#pragma unroll
    for (int kk = 0; kk < 2; ++kk) { u32x4 pw; pw.x = pkbf(p[2 * kk][0], p[2 * kk][1]); pw.y = pkbf(p[2 * kk][2], p[2 * kk][3]); pw.z = pkbf(p[2 * kk + 1][0], p[2 * kk + 1][1]); pw.w = pkbf(p[2 * kk + 1][2], p[2 * kk + 1][3]);
        pf[kk] = __builtin_bit_cast(bf16x8, pw); }
#pragma unroll
    for (int kk = 0; kk < 2; ++kk)
#pragma unroll
        for (int db = 0; db < 4; ++db) o[db] = mfma16((bf16x8){lo[kk][db][0], lo[kk][db][1], lo[kk][db][2], lo[kk][db][3], hi[kk][db][0], hi[kk][db][1], hi[kk][db][2], hi[kk][db][3]}, pf[kk], o[db]);
}
constexpr float THR = 6.0f;
template <bool FIRST>
__device__ __forceinline__ void online_tile(f32x4 (&s)[4], float& m, float& l, f32x4 (&o)[4], bool needmask, int base, int lo, int hi) {
    if (needmask) {
#pragma unroll
        for (int kb = 0; kb < 4; ++kb)
#pragma unroll
            for (int r = 0; r < 4; ++r) { const int pos = base + kb * 16 + r; s[kb][r] = (pos >= lo && pos <= hi) ? s[kb][r] : -INFINITY; } }
    float mt = fmaxf(fmaxf(fmaxf(s[0][0], s[0][1]), fmaxf(s[0][2], s[0][3])), fmaxf(fmaxf(s[1][0], s[1][1]), fmaxf(s[1][2], s[1][3])));
    mt = fmaxf(mt, fmaxf(fmaxf(fmaxf(s[2][0], s[2][1]), fmaxf(s[2][2], s[2][3])), fmaxf(fmaxf(s[3][0], s[3][1]), fmaxf(s[3][2], s[3][3]))));
    if (FIRST || __any(mt > THR)) {
        mt = fmaxf(mt, __shfl_xor(mt, 16)); mt = fmaxf(mt, __shfl_xor(mt, 32));
        const float d = FIRST ? mt : fmaxf(mt, 0.f), f = __builtin_amdgcn_exp2f(-d); m += d; l *= f;
#pragma unroll
        for (int db = 0; db < 4; ++db) o[db] = o[db] * f;
#pragma unroll
        for (int kb = 0; kb < 4; ++kb) s[kb] = s[kb] - d; }
    float sum = 0.f;
#pragma unroll
    for (int kb = 0; kb < 4; ++kb)
#pragma unroll
        for (int r = 0; r < 4; ++r) { const float p = __builtin_amdgcn_exp2f(s[kb][r]); s[kb][r] = p; sum += p; }
    l += sum;
}
struct Stg { u32x4 k, v; };
__device__ __forceinline__ void stg_load(Stg& r, const bf16_t* kb, const bf16_t* vb, size_t pitch, int tid) { const size_t off = (size_t)(tid >> 3) * pitch + (tid & 7) * 8; r.k = *(const u32x4*)(kb + off); r.v = *(const u32x4*)(vb + off); }
__device__ __forceinline__ void stg_store(NLAS char* lds, int ko, int vo, const Stg& r, int tid) { const int off = (tid >> 3) * RS + (tid & 7) * 16; *(NLAS u32x4*)(lds + ko + off) = r.k; *(NLAS u32x4*)(lds + vo + off) = r.v; }
__device__ __forceinline__ float sigm(float v) { return __builtin_amdgcn_rcpf(1.f + __expf(-v)); }

__device__ __forceinline__ void unit(NLAS char* lds, const bf16_t* P, const float* S32, const bf16_t* KC, const bf16_t* VC, bf16_t* Ynsa, int b, int gq, int ti) {
    const int tid = threadIdx.x, lane = tid & 63, w = __builtin_amdgcn_readfirstlane(tid >> 6), i = lane & 15, g = lane >> 4;
    const int t0 = ti * 32, tl_mine = i >> 2, r = i & 3, h = gq * 4 + r, t = t0 + 4 * w + tl_mine; const size_t m = (size_t)b * T + t;
    const float slope2 = __builtin_amdgcn_exp2f(-(float)(h + 1)) * LOG2E;
    bf16x8 qf[2]; constexpr float QS = 0.125f * LOG2E;
    { const bf16_t* qp = P + m * PW + P_NSQ + h * 64 + 8 * g;
#pragma unroll
      for (int ks = 0; ks < 2; ++ks) { const u32x4 raw = *(const u32x4*)(qp + 32 * ks); u32x4 sc;
          sc.x = pkbf(pg8::bflo(raw.x) * QS, pg8::bfhi(raw.x) * QS); sc.y = pkbf(pg8::bflo(raw.y) * QS, pg8::bfhi(raw.y) * QS);
          sc.z = pkbf(pg8::bflo(raw.z) * QS, pg8::bfhi(raw.z) * QS); sc.w = pkbf(pg8::bflo(raw.w) * QS, pg8::bfhi(raw.w) * QS);
          qf[ks] = __builtin_bit_cast(bf16x8, sc); } }
    const float* gp = S32 + m * 32 + 8 + h * 3;
    const float gate0 = sigm(gp[0]), gate1 = sigm(gp[1]), gate2 = sigm(gp[2]);
    f32x4 outacc[4];
#pragma unroll
    for (int db = 0; db < 4; ++db) outacc[db] = (f32x4){0.f, 0.f, 0.f, 0.f};
    const int ntc = (ti >> 5) + 1;
    for (int tile = 0; tile < ntc; ++tile) { Stg sr; const size_t row0 = ((size_t)(b * 256 + tile * 64) * 2 + gq) * 64; stg_load(sr, KC + row0, VC + row0, 128, tid); stg_store(lds, L_CK + tile * TILE_B, L_CV + tile * TILE_B, sr, tid); }
    __syncthreads();
    { const int nmax = (t - 31) >> 4; const float kslope = 16.f * slope2, c = -slope2 * (float)(t - 31);
      float mc = -INFINITY, lc = 0.f;
#pragma unroll 1
      for (int tile = 0; tile < ntc; ++tile) { f32x4 s[4]; qk_tile(s, lds + L_CK + tile * TILE_B, qf, i, g, kslope, fmaf(kslope, (float)(tile * 64 + 4 * g), c));
          float mt = -INFINITY;
#pragma unroll
          for (int kb = 0; kb < 4; ++kb)
#pragma unroll
              for (int rr = 0; rr < 4; ++rr) { const int n = tile * 64 + kb * 16 + 4 * g + rr; const float v = (n <= nmax) ? s[kb][rr] : -INFINITY; s[kb][rr] = v; mt = fmaxf(mt, v); }
          mt = fmaxf(mt, __shfl_xor(mt, 16)); mt = fmaxf(mt, __shfl_xor(mt, 32));
          const float mn = fmaxf(mc, mt), ms = (mn == -INFINITY) ? 0.f : mn; float sum = 0.f;
#pragma unroll
          for (int kb = 0; kb < 4; ++kb)
#pragma unroll
              for (int rr = 0; rr < 4; ++rr) sum += __builtin_amdgcn_exp2f(s[kb][rr] - ms);
          lc = lc * __builtin_amdgcn_exp2f(mc - ms) + sum; mc = mn; }
      lc += __shfl_xor(lc, 16); lc += __shfl_xor(lc, 32);
      const float ms = (mc == -INFINITY) ? 0.f : mc, inv = lc > 0.f ? 1.f / lc : 0.f;
      f32x4 oc[4];
#pragma unroll
      for (int db = 0; db < 4; ++db) oc[db] = (f32x4){0.f, 0.f, 0.f, 0.f};
      NLAS float* imp_s = (NLAS float*)(lds + L_IMP) + (w * 4 + tl_mine) * 64;
      float cprev = 0.f;
#pragma unroll 1
      for (int tile = 0; tile < 4; ++tile) {
          if (tile < ntc) { f32x4 s[4]; qk_tile(s, lds + L_CK + tile * TILE_B, qf, i, g, kslope, fmaf(kslope, (float)(tile * 64 + 4 * g), c));
#pragma unroll
              for (int kb = 0; kb < 4; ++kb)
#pragma unroll
                  for (int rr = 0; rr < 4; ++rr) { const int n = tile * 64 + kb * 16 + 4 * g + rr; const float v = (n <= nmax) ? s[kb][rr] : -INFINITY; s[kb][rr] = __builtin_amdgcn_exp2f(v - ms) * inv; }
              pv_tile(oc, lds + L_CV + tile * TILE_B, s, i, g);
#pragma unroll
              for (int kb = 0; kb < 4; ++kb) { const f32x4 pv = s[kb];
                  float a = (pv[0] + pv[1]) + (pv[2] + pv[3]), cc = pv[3];
                  a += __shfl_xor(a, 1); a += __shfl_xor(a, 2); cc += __shfl_xor(cc, 1); cc += __shfl_xor(cc, 2);
                  const float up = __shfl(cc, (lane + 48) & 63);
                  const float im = a + (g > 0 ? up : cprev); cprev = up;
                  if (r == 0) imp_s[4 * (tile * 4 + kb) + g] = im; }
          } else { if (r == 0) {
#pragma unroll
              for (int kb = 0; kb < 4; ++kb) imp_s[4 * (tile * 4 + kb) + g] = 0.f; } }
      }
#pragma unroll
      for (int db = 0; db < 4; ++db) outacc[db] = outacc[db] + oc[db] * gate0;
    }
    __syncthreads();
    NLAS float* impw = (NLAS float*)(lds + L_IMP) + w * 256;
    float myscore[4];
#pragma unroll
    for (int tl = 0; tl < 4; ++tl) { const int tt = t0 + 4 * w + tl, cur = tt >> 6, j = lane; const bool valid = j <= cur, forced = (j == 0) || (j == cur) || (j == cur - 1);
        const float s = valid ? impw[tl * 64 + j] + (forced ? 1000.f : 0.f) : -1e30f; myscore[tl] = s; }
    __syncthreads();
#pragma unroll
    for (int tl = 0; tl < 4; ++tl) impw[tl * 64 + lane] = myscore[tl];
    __syncthreads();
    u64 wmask[4], wun = 0ull;
#pragma unroll
    for (int tl = 0; tl < 4; ++tl) { const int tt = t0 + 4 * w + tl, cur = tt >> 6; const float s = myscore[tl]; int rank = 0;
        for (int jj = 0; jj < 64; ++jj) { const float o = impw[tl * 64 + jj]; rank += (o > s || (o == s && jj < lane)) ? 1 : 0; }
        wmask[tl] = __ballot(rank < 16 && lane <= cur); wun |= wmask[tl]; }
    if (lane == 0) { NLAS u64* mk = (NLAS u64*)(lds + L_MSK) + w * 4; mk[0] = wmask[0]; mk[1] = wmask[1]; mk[2] = wmask[2]; mk[3] = wmask[3]; ((NLAS u64*)(lds + L_WU))[w] = wun; }
    __syncthreads();
    const u64 mymask = ((const NLAS u64*)(lds + L_MSK))[w * 4 + tl_mine];
    u64 uall = 0ull;
#pragma unroll
    for (int ww = 0; ww < 8; ++ww) uall |= ((const NLAS u64*)(lds + L_WU))[ww];
    uall = ((u64)__builtin_amdgcn_readfirstlane((unsigned)(uall >> 32)) << 32) | (u64)__builtin_amdgcn_readfirstlane((unsigned)uall);
    const size_t rowb = (size_t)b * T;
    {
        float ms_ = 0.f, ls = 0.f; f32x4 os[4];
#pragma unroll
        for (int db = 0; db < 4; ++db) os[db] = (f32x4){0.f, 0.f, 0.f, 0.f};
        const bf16_t* kcol = P + rowb * PW + P_KS + gq * 64; const bf16_t* vcol = P + rowb * PW + P_VS + gq * 64;
        const float c = -slope2 * (float)t;
        const int jcur = t0 >> 6;
        const u64 wall = ((const NLAS u64*)(lds + L_MSK))[w * 4 + 0] & ((const NLAS u64*)(lds + L_MSK))[w * 4 + 1] & ((const NLAS u64*)(lds + L_MSK))[w * 4 + 2] & ((const NLAS u64*)(lds + L_MSK))[w * 4 + 3];
        const u64 wallu = ((u64)__builtin_amdgcn_readfirstlane((unsigned)(wall >> 32)) << 32) | (u64)__builtin_amdgcn_readfirstlane((unsigned)wall);
        u64 rem = uall & ((1ull << jcur) - 1ull); int j = jcur; int cur = 0; bool first = true;
        Stg sr; stg_load(sr, kcol + (size_t)j * 64 * PW, vcol + (size_t)j * 64 * PW, PW, tid); stg_store(lds, L_KB0, L_VB0, sr, tid);
        int jn = rem ? 63 - __builtin_clzll(rem) : -1; if (jn >= 0) rem &= ~(1ull << jn);
        if (jn >= 0) stg_load(sr, kcol + (size_t)jn * 64 * PW, vcol + (size_t)jn * 64 * PW, PW, tid);
        __syncthreads();
        for (;;) {
            const int jnn = (jn >= 0 && rem) ? 63 - __builtin_clzll(rem) : -1; if (jnn >= 0) rem &= ~(1ull << jnn);
            if (jn >= 0) stg_store(lds, cur ? L_KB0 : L_KB1, cur ? L_VB0 : L_VB1, sr, tid);
            if (jnn >= 0) stg_load(sr, kcol + (size_t)jnn * 64 * PW, vcol + (size_t)jnn * 64 * PW, PW, tid);
            if ((wun >> j) & 1ull) { f32x4 s[4];
                const float bt = fmaf(slope2, (float)(j * 64 + 4 * g), c) - ms_ + (((mymask >> j) & 1ull) ? 0.f : -1e30f);
                qk_tile(s, lds + (cur ? L_KB1 : L_KB0), qf, i, g, slope2, bt);
                if (first) online_tile<true>(s, ms_, ls, os, true, j * 64 + 4 * g, 0, t); else online_tile<false>(s, ms_, ls, os, false, 0, 0, 0);
                pv_tile(os, lds + (cur ? L_VB1 : L_VB0), s, i, g); }
            first = false;
            __syncthreads();
            if (jn < 0) break;
            j = jn; jn = jnn; cur ^= 1;
        }
        ls += __shfl_xor(ls, 16); ls += __shfl_xor(ls, 32);
        const float sc1 = gate1 / ls;
#pragma unroll
        for (int db = 0; db < 4; ++db) outacc[db] = outacc[db] + os[db] * sc1;
    }
    {
        float mw = 0.f, lw = 0.f; f32x4 ow[4];
#pragma unroll
        for (int db = 0; db < 4; ++db) ow[db] = (f32x4){0.f, 0.f, 0.f, 0.f};
        const bf16_t* kcol = P + rowb * PW + P_KW + gq * 64; const bf16_t* vcol = P + rowb * PW + P_VW + gq * 64;
        const float c = -slope2 * (float)t;
        const int j0 = (t0 - 511) > 0 ? ((t0 - 511) >> 6) : 0, j1 = t0 >> 6, tw0 = t0 + 4 * w;
        int j = j1, cur = 0; bool first = true;
        Stg sr; stg_load(sr, kcol + (size_t)j * 64 * PW, vcol + (size_t)j * 64 * PW, PW, tid); stg_store(lds, L_KB0, L_VB0, sr, tid);
        if (j > j0) stg_load(sr, kcol + (size_t)(j - 1) * 64 * PW, vcol + (size_t)(j - 1) * 64 * PW, PW, tid);
        __syncthreads();
        for (;;) {
            if (j > j0) stg_store(lds, cur ? L_KB0 : L_KB1, cur ? L_VB0 : L_VB1, sr, tid);
            if (j - 1 > j0) stg_load(sr, kcol + (size_t)(j - 2) * 64 * PW, vcol + (size_t)(j - 2) * 64 * PW, PW, tid);
            if (64 * j <= tw0 + 3 && 64 * j + 63 >= tw0 - 511) { f32x4 s[4];
                qk_tile(s, lds + (cur ? L_KB1 : L_KB0), qf, i, g, slope2, fmaf(slope2, (float)(j * 64 + 4 * g), c) - mw);
                const bool needmask = first || (64 * j < tw0 + 3 - 511);
                if (first) online_tile<true>(s, mw, lw, ow, true, j * 64 + 4 * g, t - 511, t); else online_tile<false>(s, mw, lw, ow, needmask, j * 64 + 4 * g, t - 511, t);
                pv_tile(ow, lds + (cur ? L_VB1 : L_VB0), s, i, g); }
            first = false;
            __syncthreads();
            if (j <= j0) break;
            --j; cur ^= 1;
        }
        lw += __shfl_xor(lw, 16); lw += __shfl_xor(lw, 32);
        const float sc2 = gate2 / lw;
#pragma unroll
        for (int db = 0; db < 4; ++db) outacc[db] = outacc[db] + ow[db] * sc2;
    }
    bf16_t* yo = Ynsa + m * 512 + h * 64 + 4 * g;
#pragma unroll
    for (int db = 0; db < 4; ++db) { u32x2 v; v.x = pkbf(outacc[db][0], outacc[db][1]); v.y = pkbf(outacc[db][2], outacc[db][3]); *(u32x2*)(yo + db * 16) = v; }
}
__device__ __forceinline__ void phase(NLAS char* lds, const bf16_t* P, const float* S32, const bf16_t* KC, const bf16_t* VC, bf16_t* Ynsa) {
    const int G = gridDim.x, bid = blockIdx.x;
    if (G == 256) { const int base = bid >> 3, bg = bid & 7;
#pragma unroll 1
        for (int k = 0; k < 4; ++k) { const int ti = (k == 0) ? 127 - base : (k == 1) ? 64 + base : (k == 2) ? 63 - base : base; unit(lds, P, S32, KC, VC, Ynsa, bg >> 1, bg & 1, ti); } }
    else {
#pragma unroll 1
        for (int u = bid; u < 1024; u += G) unit(lds, P, S32, KC, VC, Ynsa, (u & 7) >> 1, u & 1, 127 - (u >> 3)); }
}
}

namespace xa {
using nsa::bf16x8; using nsa::s16x4; using nsa::f32x4; using nsa::u32x4; using nsa::u32x2; using nsa::vtr; using nsa::mfma16; using nsa::pkbf;
constexpr int RS = 272, TILE_B = 64 * RS;
constexpr int L_K0 = 0, L_V0 = TILE_B, L_K1 = 2 * TILE_B, L_V1 = 3 * TILE_B;
struct Stg { u32x4 k0, k1, v0, v1; };
__device__ __forceinline__ void stg_load(Stg& r, const bf16_t* kb, int tid) { const bf16_t* p = kb + (size_t)(tid >> 3) * 1024 + (tid & 7) * 8;
    r.k0 = *(const u32x4*)p; r.k1 = *(const u32x4*)(p + 64); r.v0 = *(const u32x4*)(p + 512); r.v1 = *(const u32x4*)(p + 576); }
__device__ __forceinline__ void stg_store(NLAS char* lds, int ko, int vo, const Stg& r, int tid) { const int off = (tid >> 3) * RS + (tid & 7) * 16;
    *(NLAS u32x4*)(lds + ko + off) = r.k0; *(NLAS u32x4*)(lds + ko + off + 128) = r.k1; *(NLAS u32x4*)(lds + vo + off) = r.v0; *(NLAS u32x4*)(lds + vo + off + 128) = r.v1; }
__device__ __forceinline__ void unit(NLAS char* lds, const bf16_t* P, const bf16_t* MEMKV, bf16_t* Yxa, int b, int h, int tt) {
    const int tid = threadIdx.x, lane = tid & 63, w = __builtin_amdgcn_readfirstlane(tid >> 6), i = lane & 15, g = lane >> 4;
    const size_t m = (size_t)b * T + tt * 128 + 16 * w + i;
    bf16x8 qf[4];
    { const bf16_t* qp = P + m * PW + P_XAQ + h * 128 + 8 * g;
#pragma unroll
      for (int ks = 0; ks < 4; ++ks) qf[ks] = *(const bf16x8*)(qp + 32 * ks); }
    const float scale2 = 0.08838834764831845f * nsa::LOG2E;
    float mx = -INFINITY, l = 0.f; f32x4 o[8];
#pragma unroll
    for (int db = 0; db < 8; ++db) o[db] = (f32x4){0.f, 0.f, 0.f, 0.f};
    const bf16_t* kbase = MEMKV + (size_t)b * 256 * 1024 + h * 128;
    { Stg sr; stg_load(sr, kbase, tid); stg_store(lds, L_K0, L_V0, sr, tid); }
    __syncthreads();
#pragma unroll 1
    for (int tile = 0; tile < 4; ++tile) { const int cur = tile & 1;
        Stg sr; if (tile < 3) stg_load(sr, kbase + (size_t)(tile + 1) * 64 * 1024, tid);
        const NLAS char* Kb = lds + (cur ? L_K1 : L_K0); const NLAS char* Vb = lds + (cur ? L_V1 : L_V0);
        f32x4 s[4];
#pragma unroll
        for (int kb = 0; kb < 4; ++kb) { const NLAS char* kp = Kb + (kb * 16 + i) * RS + 16 * g; f32x4 acc = (f32x4){0.f, 0.f, 0.f, 0.f};
#pragma unroll
            for (int ks = 0; ks < 4; ++ks) acc = mfma16(*(const NLAS bf16x8*)(kp + 64 * ks), qf[ks], acc);
            s[kb] = acc; }
        float mt = -INFINITY;
#pragma unroll
        for (int kb = 0; kb < 4; ++kb)
#pragma unroll
            for (int r = 0; r < 4; ++r) { const float v = s[kb][r] * scale2; s[kb][r] = v; mt = fmaxf(mt, v); }
        mt = fmaxf(mt, __shfl_xor(mt, 16)); mt = fmaxf(mt, __shfl_xor(mt, 32));
        const float mn = fmaxf(mx, mt), alpha = __builtin_amdgcn_exp2f(mx - mn); float sum = 0.f;
#pragma unroll
        for (int kb = 0; kb < 4; ++kb)
#pragma unroll
            for (int r = 0; r < 4; ++r) { const float p = __builtin_amdgcn_exp2f(s[kb][r] - mn); s[kb][r] = p; sum += p; }
        l = l * alpha + sum; mx = mn;
#pragma unroll
        for (int db = 0; db < 8; ++db) o[db] = o[db] * alpha;
        const NLAS char* vb = Vb + (4 * g + (i >> 2)) * RS + (i & 3) * 8;
#pragma unroll
        for (int kk = 0; kk < 2; ++kk) {
            u32x4 pw; pw.x = pkbf(s[2 * kk][0], s[2 * kk][1]); pw.y = pkbf(s[2 * kk][2], s[2 * kk][3]); pw.z = pkbf(s[2 * kk + 1][0], s[2 * kk + 1][1]); pw.w = pkbf(s[2 * kk + 1][2], s[2 * kk + 1][3]);
            const bf16x8 pf = __builtin_bit_cast(bf16x8, pw);
#pragma unroll
            for (int db = 0; db < 8; ++db) { const NLAS char* vp = vb + (2 * kk) * 16 * RS + db * 32; const s16x4 lo = vtr(vp), hi = vtr(vp + 16 * RS);
                o[db] = mfma16((bf16x8){lo[0], lo[1], lo[2], lo[3], hi[0], hi[1], hi[2], hi[3]}, pf, o[db]); }
        }
        if (tile < 3) stg_store(lds, cur ? L_K0 : L_K1, cur ? L_V0 : L_V1, sr, tid);
        __syncthreads();
    }
    l += __shfl_xor(l, 16); l += __shfl_xor(l, 32);
    const float inv = 1.f / l;
    bf16_t* yo = Yxa + m * 512 + h * 128 + 4 * g;
#pragma unroll
    for (int db = 0; db < 8; ++db) { u32x2 v; v.x = pkbf(o[db][0] * inv, o[db][1] * inv); v.y = pkbf(o[db][2] * inv, o[db][3] * inv); *(u32x2*)(yo + db * 16) = v; }
}
__device__ __forceinline__ void phase(NLAS char* lds, const bf16_t* P, const bf16_t* MEMKV, bf16_t* Yxa) {
#pragma unroll 1
    for (int u = blockIdx.x; u < 512; u += gridDim.x) unit(lds, P, MEMKV, Yxa, u >> 7, (u >> 5) & 3, u & 31);
}
}

namespace ml {
using nsa::bf16x8; using nsa::s16x4; using nsa::f32x4; using nsa::u32x4; using nsa::u32x2; using nsa::vtr; using nsa::mfma16; using nsa::pkbf;
constexpr int RS = 272, TB = 64 * RS, RSS = 144;
constexpr float KSCALE = 0.08838834764831845f;
__device__ __forceinline__ float scan_add(float v, int lane) {
#pragma unroll
    for (int o = 1; o < 64; o <<= 1) { const float u = __shfl_up(v, o); if (lane >= o) v += u; }
    return v; }
__device__ __forceinline__ float scan_max(float v, int lane) {
#pragma unroll
    for (int o = 1; o < 64; o <<= 1) { const float u = __shfl_up(v, o); if (lane >= o) v = fmaxf(v, u); }
    return v; }
__device__ __forceinline__ bf16x8 trpair(const NLAS char* p, int hi_off) { const s16x4 lo = vtr(p), hi = vtr(p + hi_off); return (bf16x8){lo[0], lo[1], lo[2], lo[3], hi[0], hi[1], hi[2], hi[3]}; }
__device__ __forceinline__ void load_conv(NLAS char* dst, const bf16_t* P, const float* cw, int colP, int cwc, size_t m0, int tseq0, int tid) {
    const int s = tid >> 3, c16 = (tid & 7) * 16;
#pragma unroll
    for (int half = 0; half < 2; ++half) { const int c = c16 + half * 8; float acc[8];
#pragma unroll
        for (int e = 0; e < 8; ++e) acc[e] = 0.f;
#pragma unroll
        for (int j = 0; j < 4; ++j) { if (tseq0 + s - j >= 0) { const u32x4 raw = *(const u32x4*)(P + (m0 + s - j) * PW + colP + c);
            const f32x4 w0 = *(const f32x4*)(cw + j * 1024 + cwc + c), w1 = *(const f32x4*)(cw + j * 1024 + cwc + c + 4);
            acc[0] += w0[0] * pg8::bflo(raw.x); acc[1] += w0[1] * pg8::bfhi(raw.x); acc[2] += w0[2] * pg8::bflo(raw.y); acc[3] += w0[3] * pg8::bfhi(raw.y);
            acc[4] += w1[0] * pg8::bflo(raw.z); acc[5] += w1[1] * pg8::bfhi(raw.z); acc[6] += w1[2] * pg8::bflo(raw.w); acc[7] += w1[3] * pg8::bfhi(raw.w); } }
#pragma unroll
        for (int e = 0; e < 8; ++e) acc[e] = acc[e] * __builtin_amdgcn_rcpf(1.f + __expf(-acc[e]));
        u32x4 o; o.x = pkbf(acc[0], acc[1]); o.y = pkbf(acc[2], acc[3]); o.z = pkbf(acc[4], acc[5]); o.w = pkbf(acc[6], acc[7]);
        *(NLAS u32x4*)(dst + s * RS + c * 2) = o; }
}
__device__ __forceinline__ void m1_unit(NLAS char* lds, const bf16_t* P, const float* cw, const float* S32, bf16_t* Abuf, float* NA, float* Gc, float* Mloc, int ci) {
    constexpr int L_K = 0, L_EV = TB, L_E = 2 * TB;
    const int tid = threadIdx.x, lane = tid & 63, w = __builtin_amdgcn_readfirstlane(tid >> 6), i = lane & 15, g = lane >> 4;
    const int c = ci & 63, bh = ci >> 6, h = bh & 3, b = bh >> 2; const size_t m0 = (size_t)b * T + c * 64;
    NLAS float* eS = (NLAS float*)(lds + L_E);
    if (w == 0) { const float fpre = S32[(m0 + lane) * 32 + 4 + h], ipre = S32[(m0 + lane) * 32 + h];
        const float bcs = scan_add(logsig(fpre), lane), gtot = __shfl(bcs, 63), wend = gtot - bcs + ipre, mloc = wave_max(wend);
        eS[lane] = __expf(wend - mloc) * KSCALE; if (lane == 0) { Gc[ci] = gtot; Mloc[ci] = mloc; } }
    load_conv(lds + L_K, P, cw, P_MLK + h * 128, 512 + h * 128, m0, c * 64, tid);
    __syncthreads();
    { const int s = tid >> 3, c16 = (tid & 7) * 16; const float es = eS[s]; const bf16_t* vp = P + (m0 + s) * PW + P_MLV + h * 128 + c16;
#pragma unroll
      for (int half = 0; half < 2; ++half) { const u32x4 raw = *(const u32x4*)(vp + half * 8); u32x4 o;
          o.x = pkbf(pg8::bflo(raw.x) * es, pg8::bfhi(raw.x) * es); o.y = pkbf(pg8::bflo(raw.y) * es, pg8::bfhi(raw.y) * es);
          o.z = pkbf(pg8::bflo(raw.z) * es, pg8::bfhi(raw.z) * es); o.w = pkbf(pg8::bflo(raw.w) * es, pg8::bfhi(raw.w) * es);
          *(NLAS u32x4*)(lds + L_EV + s * RS + (c16 + half * 8) * 2) = o; } }
    __syncthreads();
    f32x4 acc[8];
#pragma unroll
    for (int vb = 0; vb < 8; ++vb) acc[vb] = (f32x4){0.f, 0.f, 0.f, 0.f};
    const int rowoff = (4 * g + (i >> 2)) * RS + (i & 3) * 8;
#pragma unroll
    for (int kk = 0; kk < 2; ++kk) { const bf16x8 kf = trpair(lds + L_K + kk * 32 * RS + rowoff + w * 32, 16 * RS);
#pragma unroll
        for (int vb = 0; vb < 8; ++vb) acc[vb] = mfma16(trpair(lds + L_EV + kk * 32 * RS + rowoff + vb * 32, 16 * RS), kf, acc[vb]); }
    bf16_t* ap = Abuf + ((size_t)ci * 128 + w * 16 + i) * 128 + 4 * g;
#pragma unroll
    for (int vb = 0; vb < 8; ++vb) { u32x2 pk; pk.x = pkbf(acc[vb][0], acc[vb][1]); pk.y = pkbf(acc[vb][2], acc[vb][3]); *(u32x2*)(ap + vb * 16) = pk; }
    { const int k = tid >> 2, part = tid & 3; float n = 0.f;
#pragma unroll
      for (int s = 0; s < 16; ++s) n += eS[part * 16 + s] * bf2f(*(const NLAS bf16_t*)(lds + L_K + (part * 16 + s) * RS + k * 2));
      n += __shfl_xor(n, 1); n += __shfl_xor(n, 2); if (part == 0) NA[(size_t)ci * 128 + k] = n; }
    __syncthreads();
}
__device__ __forceinline__ void m2_items(bf16_t* Abuf, float* NA, const float* Gc, const float* Mloc, float* Mprev) {
    for (int it = blockIdx.x * blockDim.x + threadIdx.x; it < 16 * 128 * 64; it += gridDim.x * blockDim.x) {
        const int bh = it >> 13, kv2 = it & 8191, k = kv2 >> 6, v2 = kv2 & 63;
        float C0 = 0.f, C1 = 0.f, n = 0.f, m = 0.f;
        unsigned* base = (unsigned*)(Abuf + ((size_t)(bh * 64) * 128 + k) * 128 + v2 * 2);
#pragma unroll 1
        for (int c0 = 0; c0 < 64; c0 += 16) { unsigned A[16];
#pragma unroll
            for (int u = 0; u < 16; ++u) A[u] = base[(size_t)(c0 + u) * 8192];
#pragma unroll
            for (int u = 0; u < 16; ++u) { const int ci = bh * 64 + c0 + u; const float gg = Gc[ci], ml = Mloc[ci];
                const float mn = fmaxf(gg + m, ml), a = __expf(gg + m - mn), bb = __expf(ml - mn);
                base[(size_t)(c0 + u) * 8192] = pkbf(C0, C1); C0 = C0 * a + pg8::bflo(A[u]) * bb; C1 = C1 * a + pg8::bfhi(A[u]) * bb;
                if (v2 == 0) { const float nA = NA[(size_t)ci * 128 + k]; NA[(size_t)ci * 128 + k] = n; n = a * n + bb * nA; }
                if (kv2 == 0) Mprev[ci] = m;
                m = mn; } }
    }
}
__device__ __forceinline__ void m3_unit(NLAS char* lds, const bf16_t* P, const float* cw, const float* S32, const bf16_t* Cprev, const float* Nprev, const float* Mprev, const float* normg, bf16_t* Yml, int ci) {
    constexpr int L_Q = 0, L_K = TB, L_V = 2 * TB, L_C = 3 * TB, L_S = 5 * TB, L_F = L_S + 64 * RSS;
    const int tid = threadIdx.x, lane = tid & 63, w = __builtin_amdgcn_readfirstlane(tid >> 6), i = lane & 15, g = lane >> 4;
    const int c = ci & 63, bh = ci >> 6, h = bh & 3, b = bh >> 2; const size_t m0 = (size_t)b * T + c * 64;
    bf16_t ov[4][4]; float ng[4];
    { const int tb_ = w >> 1, vb0_ = (w & 1) * 4;
#pragma unroll
      for (int vb = 0; vb < 4; ++vb) { ng[vb] = normg[h * 128 + (vb0_ + vb) * 16 + i];
#pragma unroll
          for (int r = 0; r < 4; ++r) ov[vb][r] = P[(m0 + tb_ * 16 + 4 * g + r) * PW + P_MLO + h * 128 + (vb0_ + vb) * 16 + i]; } }
    NLAS float* F = (NLAS float*)(lds + L_F);
    NLAS float* rowf = F; NLAS float* colf = F + 64; NLAS float* scv = F + 128; NLAS float* emt = F + 192; NLAS float* qn = F + 256; NLAS float* nprev = F + 320; NLAS float* denp = F + 448; NLAS float* ssq = F + 576;
    if (w == 0) { const float fpre = S32[(m0 + lane) * 32 + 4 + h], ipre = S32[(m0 + lane) * 32 + h], mprev = Mprev[ci];
        const float bcs = scan_add(logsig(fpre), lane), u = ipre - bcs, pm = scan_max(u, lane), mt = bcs + fmaxf(mprev, pm);
        rowf[lane] = bcs - mt; colf[lane] = u; scv[lane] = __expf(bcs + mprev - mt); emt[lane] = __expf(-mt); }
    else if (w <= 2) nprev[tid - 64] = Nprev[(size_t)ci * 128 + tid - 64];
    load_conv(lds + L_Q, P, cw, P_MLQ + h * 128, h * 128, m0, c * 64, tid);
    load_conv(lds + L_K, P, cw, P_MLK + h * 128, 512 + h * 128, m0, c * 64, tid);
    { const int s = tid >> 3, c16 = (tid & 7) * 16; const bf16_t* vp = P + (m0 + s) * PW + P_MLV + h * 128 + c16;
      *(NLAS u32x4*)(lds + L_V + s * RS + c16 * 2) = *(const u32x4*)vp; *(NLAS u32x4*)(lds + L_V + s * RS + c16 * 2 + 16) = *(const u32x4*)(vp + 8); }
    { const int k = tid >> 2, v0 = (tid & 3) * 32; const bf16_t* cp = Cprev + ((size_t)ci * 128 + k) * 128 + v0;
#pragma unroll
      for (int q8 = 0; q8 < 4; ++q8) *(NLAS u32x4*)(lds + L_C + k * RS + (v0 + q8 * 8) * 2) = *(const u32x4*)(cp + q8 * 8); }
    __syncthreads();
    { const int tq = tid >> 3, part = tid & 7; const u32x4 q0 = *(const NLAS u32x4*)(lds + L_Q + tq * RS + part * 32), q1 = *(const NLAS u32x4*)(lds + L_Q + tq * RS + part * 32 + 16);
      const NLAS f32x4* np = (const NLAS f32x4*)(nprev + part * 16); const f32x4 n0 = np[0], n1 = np[1], n2 = np[2], n3 = np[3];
      float a = pg8::bflo(q0.x) * n0[0] + pg8::bfhi(q0.x) * n0[1] + pg8::bflo(q0.y) * n0[2] + pg8::bfhi(q0.y) * n0[3] + pg8::bflo(q0.z) * n1[0] + pg8::bfhi(q0.z) * n1[1] + pg8::bflo(q0.w) * n1[2] + pg8::bfhi(q0.w) * n1[3]
              + pg8::bflo(q1.x) * n2[0] + pg8::bfhi(q1.x) * n2[1] + pg8::bflo(q1.y) * n2[2] + pg8::bfhi(q1.y) * n2[3] + pg8::bflo(q1.z) * n3[0] + pg8::bfhi(q1.z) * n3[1] + pg8::bflo(q1.w) * n3[2] + pg8::bfhi(q1.w) * n3[3];
      a += __shfl_xor(a, 1); a += __shfl_xor(a, 2); a += __shfl_xor(a, 4); if (part == 0) qn[tq] = a; }
    const int tb = w >> 1;
    {
        float rs[4] = {0.f, 0.f, 0.f, 0.f};
#pragma unroll
        for (int sbi = 0; sbi < 2; ++sbi) { const int sb = 2 * (w & 1) + sbi; f32x4 acc = (f32x4){0.f, 0.f, 0.f, 0.f};
            if (sb <= tb) {
#pragma unroll
                for (int ks = 0; ks < 4; ++ks) acc = mfma16(*(const NLAS bf16x8*)(lds + L_Q + (tb * 16 + i) * RS + (32 * ks + 8 * g) * 2), *(const NLAS bf16x8*)(lds + L_K + (sb * 16 + i) * RS + (32 * ks + 8 * g) * 2), acc); }
            const int s = sb * 16 + i; const float cf = colf[s];
#pragma unroll
            for (int r = 0; r < 4; ++r) { const int t = tb * 16 + 4 * g + r; const float v = (s <= t) ? acc[r] * KSCALE * __expf(rowf[t] + cf) : 0.f; rs[r] += v;
                *(NLAS bf16_t*)(lds + L_S + t * RSS + s * 2) = f2bf(v); } }
#pragma unroll
        for (int r = 0; r < 4; ++r) { float x = rs[r]; x += __shfl_xor(x, 1); x += __shfl_xor(x, 2); x += __shfl_xor(x, 4); x += __shfl_xor(x, 8); if (i == 0) denp[(w & 1) * 64 + tb * 16 + 4 * g + r] = x; }
    }
    __syncthreads();
    f32x4 a1[4], a2[4];
#pragma unroll
    for (int vb = 0; vb < 4; ++vb) { a1[vb] = (f32x4){0.f, 0.f, 0.f, 0.f}; a2[vb] = (f32x4){0.f, 0.f, 0.f, 0.f}; }
    const int vb0 = (w & 1) * 4, troff = (8 * g + (i >> 2)) * RS + (i & 3) * 8;
#pragma unroll
    for (int kk = 0; kk < 2; ++kk) { if (32 * kk <= tb * 16 + 15) { const bf16x8 sf = *(const NLAS bf16x8*)(lds + L_S + (tb * 16 + i) * RSS + (32 * kk + 8 * g) * 2);
#pragma unroll
        for (int vb = 0; vb < 4; ++vb) a1[vb] = mfma16(sf, trpair(lds + L_V + kk * 32 * RS + troff + (vb0 + vb) * 32, 4 * RS), a1[vb]); } }
#pragma unroll
    for (int ks = 0; ks < 4; ++ks) { const bf16x8 qf = *(const NLAS bf16x8*)(lds + L_Q + (tb * 16 + i) * RS + (32 * ks + 8 * g) * 2);
#pragma unroll
        for (int vb = 0; vb < 4; ++vb) a2[vb] = mfma16(qf, trpair(lds + L_C + ks * 32 * RS + troff + (vb0 + vb) * 32, 4 * RS), a2[vb]); }
    float hv[4][4], sq[4] = {0.f, 0.f, 0.f, 0.f};
#pragma unroll
    for (int r = 0; r < 4; ++r) { const int t = tb * 16 + 4 * g + r; const float sc = scv[t]; const float den = denp[t] + denp[64 + t] + sc * qn[t]; const float hd = 1.f / fmaxf(fabsf(den), emt[t]);
#pragma unroll
        for (int vb = 0; vb < 4; ++vb) { const float x = (a1[vb][r] + sc * a2[vb][r]) * hd; hv[vb][r] = x; sq[r] += x * x; } }
#pragma unroll
    for (int r = 0; r < 4; ++r) { float x = sq[r]; x += __shfl_xor(x, 1); x += __shfl_xor(x, 2); x += __shfl_xor(x, 4); x += __shfl_xor(x, 8); if (i == 0) ssq[(w & 1) * 64 + tb * 16 + 4 * g + r] = x; }
    __syncthreads();
#pragma unroll
    for (int r = 0; r < 4; ++r) { const int t = tb * 16 + 4 * g + r; const float rinv = rsqrtf((ssq[t] + ssq[64 + t]) * (1.f / 128.f) + EPS);
#pragma unroll
        for (int vb = 0; vb < 4; ++vb) { const int v = (vb0 + vb) * 16 + i; const float o = bf2f(ov[vb][r]);
            Yml[(m0 + t) * 512 + h * 128 + v] = f2bf(__builtin_amdgcn_rcpf(1.f + __expf(-o)) * hv[vb][r] * rinv * ng[vb]); } }
    __syncthreads();
}
}

namespace cmpr {
using nsa::bf16x8; using nsa::f32x4; using nsa::u32x4; using nsa::mfma16; using nsa::pkbf;
constexpr int RSX = 144, L_X = 0, L_PE = 272 * RSX  , L_H = L_PE + 8192, RSH = 528;
__device__ __forceinline__ void unit(NLAS char* lds, const bf16_t* P, const float* pe, const bf16_t* W1t, const bf16_t* W2t, bf16_t* KC, bf16_t* VC, int u) {
    const int tid = threadIdx.x, lane = tid & 63, w = __builtin_amdgcn_readfirstlane(tid >> 6), i = lane & 15, g = lane >> 4;
    const int nt = u & 15, gq = (u >> 4) & 1, b = (u >> 5) & 3, kv = u >> 7;
    const int pcol = (kv ? P_VC : P_KC) + gq * 64, tok0 = 256 * nt;
    for (int ch = tid; ch < 272 * 8; ch += 512) { const int row = ch >> 3, c8 = (ch & 7) * 8, tok = tok0 + row;
        u32x4 v = (u32x4){0u, 0u, 0u, 0u}; if (tok < T) v = *(const u32x4*)(P + ((size_t)b * T + tok) * PW + pcol + c8);
        *(NLAS u32x4*)(lds + L_X + row * RSX + c8 * 2) = v; }
    for (int e = tid; e < 2048; e += 512) ((NLAS float*)(lds + L_PE))[e] = pe[kv * 2048 + e];
    __syncthreads();
    f32x4 acc[2]; acc[0] = (f32x4){0.f, 0.f, 0.f, 0.f}; acc[1] = acc[0];
    const bf16_t* wb = W1t + ((size_t)kv * 256 + 32 * w + i) * 2048 + 8 * g;
#pragma unroll 1
    for (int k0 = 0; k0 < 64; k0 += 16) { bf16x8 bq[16][2];
#pragma unroll
        for (int kk = 0; kk < 16; ++kk) { bq[kk][0] = *(const bf16x8*)(wb + 32 * (k0 + kk)); bq[kk][1] = *(const bf16x8*)(wb + 16 * 2048 + 32 * (k0 + kk)); }
#pragma unroll
        for (int kk = 0; kk < 16; ++kk) { const int ks = k0 + kk, l = ks >> 1, dh = ks & 1;
            const u32x4 raw = *(const NLAS u32x4*)(lds + L_X + (16 * i + l) * RSX + dh * 64 + 16 * g);
            const NLAS float* pp = (const NLAS float*)(lds + L_PE) + l * 64 + dh * 32 + 8 * g; const f32x4 p0 = *(const NLAS f32x4*)pp, p1 = *(const NLAS f32x4*)(pp + 4);
            u32x4 a; a.x = pkbf(pg8::bflo(raw.x) + p0[0], pg8::bfhi(raw.x) + p0[1]); a.y = pkbf(pg8::bflo(raw.y) + p0[2], pg8::bfhi(raw.y) + p0[3]);
            a.z = pkbf(pg8::bflo(raw.z) + p1[0], pg8::bfhi(raw.z) + p1[1]); a.w = pkbf(pg8::bflo(raw.w) + p1[2], pg8::bfhi(raw.w) + p1[3]);
            const bf16x8 af = __builtin_bit_cast(bf16x8, a);
            acc[0] = mfma16(af, bq[kk][0], acc[0]); acc[1] = mfma16(af, bq[kk][1], acc[1]); } }
#pragma unroll
    for (int cb = 0; cb < 2; ++cb)
#pragma unroll
        for (int r = 0; r < 4; ++r) { const float x = acc[cb][r], uu = 0.7978845608028654f * (x + 0.044715f * x * x * x); const float gl = x * __builtin_amdgcn_rcpf(1.f + __expf(-2.f * uu));
            *(NLAS bf16_t*)(lds + L_H + (4 * g + r) * RSH + (32 * w + cb * 16 + i) * 2) = f2bf(gl); }
    __syncthreads();
    if (w < 4) { f32x4 o = (f32x4){0.f, 0.f, 0.f, 0.f}; const bf16_t* w2 = W2t + ((size_t)kv * 64 + 16 * w + i) * 256 + 8 * g;
#pragma unroll
        for (int ks = 0; ks < 8; ++ks) o = mfma16(*(const NLAS bf16x8*)(lds + L_H + i * RSH + (32 * ks + 8 * g) * 2), *(const bf16x8*)(w2 + 32 * ks), o);
        bf16_t* dst = (kv ? VC : KC);
#pragma unroll
        for (int r = 0; r < 4; ++r) dst[((size_t)(b * 256 + 16 * nt + 4 * g + r) * 2 + gq) * 64 + 16 * w + i] = f2bf(o[r]); }
    __syncthreads();
}
}

#define LAS __attribute__((address_space(3)))
constexpr int NTHREADS = 512, LDS_BYTES = 147456;
constexpr size_t WS_WIN = 1 * MiB, WS_WG = 9 * MiB, WS_WBR = 15 * MiB, WS_WOUT = 18 * MiB, WS_WFF1 = 20 * MiB, WS_WFF2 = 28 * MiB, WS_WMKV = 36 * MiB, WS_WC1 = 38 * MiB;
constexpr size_t WS_BIASP = 249 * MiB, WS_XCH = 250 * MiB;
#define XB_TMO      128
#define XB_XCNT(j)  (256  + 64 * (j))
#define XB_XSUB(j)  (1280 + 64 * (j))
#define XB_XGEN(j)  (2304 + 64 * (j))
#define XB_TOP      3328
#define XB_TOPGEN   3392
#define XCD_BAR_WORDS 3456
#define XB_SPIN_CAP (1u << 18)

__device__ __forceinline__ unsigned xb_ld(unsigned* p)              { return __hip_atomic_load(p, __ATOMIC_RELAXED, __HIP_MEMORY_SCOPE_AGENT); }
__device__ __forceinline__ unsigned xb_add(unsigned* p, unsigned v) { return __hip_atomic_fetch_add(p, v, __ATOMIC_RELAXED, __HIP_MEMORY_SCOPE_AGENT); }
__device__ __forceinline__ unsigned xb_xcc_id() { return (unsigned)__builtin_amdgcn_s_getreg((3 << 11) | 20) & 0xFu; }
#define XB_SPIN(cond, bar) do { unsigned _sp = 0; while (cond) { __builtin_amdgcn_s_sleep(1); \
    if ((++_sp & 255u) == 0u) { if (xb_ld(&(bar)[XB_TMO])) break; if (_sp > XB_SPIN_CAP) { atomicAdd(&(bar)[XB_TMO], 1u); break; } } } } while (0)

struct XcdBarrier {
    unsigned* bar; unsigned x;
    volatile LAS unsigned* st;
};

__device__ __forceinline__ XcdBarrier xcd_barrier_post(unsigned* bar, volatile LAS unsigned* st) {
    XcdBarrier b; b.bar = bar; b.x = xb_xcc_id(); b.st = st;
    if (threadIdx.x == 0) (void)xb_add(&bar[XB_XCNT(b.x)], 1u);
    return b;
}
__device__ __forceinline__ void xcd_barrier_complete(unsigned* bar, unsigned x, unsigned& nloc, unsigned& nx) {
    const unsigned G = gridDim.x * gridDim.y * gridDim.z;
    unsigned sum, cnt, mine, sp = 0u;
    for (;;) {
        sum = 0u; cnt = 0u; mine = 0u;
#pragma unroll
        for (unsigned j = 0; j < 16; ++j) { const unsigned c = xb_ld(&bar[XB_XCNT(j)]); sum += c; cnt += (c > 0u) ? 1u : 0u; mine = (j == x) ? c : mine; }
        if (sum == G) break;
        __builtin_amdgcn_s_sleep(1);
        if ((++sp & 255u) == 0u) { if (xb_ld(&bar[XB_TMO])) break; if (sp > XB_SPIN_CAP) { atomicAdd(&bar[XB_TMO], 1u); break; } }
    }
    nloc = mine > 0u ? mine : 1u; nx = cnt > 0u ? cnt : 1u;
}

__device__ __forceinline__ void xcd_barrier(const XcdBarrier& b) {
    asm volatile("s_waitcnt vmcnt(0)" ::: "memory");
    __syncthreads();
    if (threadIdx.x == 0) {
        unsigned* bar = b.bar;
        __builtin_amdgcn_s_waitcnt(0);
        unsigned nloc = b.st[0], nx = b.st[1];
        if (nloc == 0u) { xcd_barrier_complete(bar, b.x, nloc, nx); b.st[0] = nloc; b.st[1] = nx; }
        const unsigned old = xb_add(&bar[XB_XSUB(b.x)], 1u);
        const unsigned gen = old / nloc;
        if (old + 1u == (gen + 1u) * nloc) {
            __builtin_amdgcn_fence(__ATOMIC_RELEASE, "agent");
            asm volatile("s_waitcnt vmcnt(0)" ::: "memory");
            const unsigned og = xb_add(&bar[XB_TOP], 1u);
            const unsigned tg = og / nx;
            if (og + 1u == (tg + 1u) * nx) xb_add(&bar[XB_TOPGEN], 1u);
            else XB_SPIN(xb_ld(&bar[XB_TOPGEN]) == tg, bar);
            __builtin_amdgcn_fence(__ATOMIC_ACQUIRE, "agent");
            xb_add(&bar[XB_XGEN(b.x)], 1u);
            asm volatile("s_waitcnt vmcnt(0)" ::: "memory");
        } else {
            XB_SPIN(xb_ld(&bar[XB_XGEN(b.x)]) == gen, bar);
            __builtin_amdgcn_fence(__ATOMIC_ACQUIRE, "agent");
            asm volatile("s_waitcnt vmcnt(0)" ::: "memory");
        }
    }
    __syncthreads();
}

struct Args { const float* in[18]; float* out; unsigned char* ws; int ph_lo, ph_hi; };
template <int VT, class F> __device__ __forceinline__ void run_vb(int nvb, char* lds, F f) {
    constexpr int PER = NTHREADS / VT; const int sub = threadIdx.x / VT, tid = threadIdx.x % VT;
    for (int it = blockIdx.x; it * PER < nvb; it += gridDim.x) { VB vb{it * PER + sub, tid, lds + sub * (LDS_BYTES / PER)}; f(vb); __syncthreads(); }
}
__device__ __forceinline__ unsigned pk2(float lo, float hi) { return (unsigned)f2bf(lo) | ((unsigned)f2bf(hi) << 16); }
typedef unsigned v4u __attribute__((ext_vector_type(4)));
typedef float f32x4 __attribute__((ext_vector_type(4)));
__device__ __forceinline__ void tr_item(const float* W, int ld, int ncols, int K, bf16_t* WT, int row_off, LAS float* scr, int item, int lane) {
    const int nblk = ncols / 32, kb = item / nblk, nb = item % nblk, k0 = 64 * kb, n0 = 32 * nb;
#pragma unroll 8
    for (int i = 0; i < 32; ++i) { const int kk = 2 * i + (lane >> 5); scr[kk * 33 + (lane & 31)] = W[(size_t)(k0 + kk) * ld + n0 + (lane & 31)]; }
    asm volatile("s_waitcnt lgkmcnt(0)" ::: "memory");
    const int c = lane & 7;
#pragma unroll
    for (int j = 0; j < 4; ++j) { const int n = (lane >> 3) + 8 * j; const LAS float* s = scr + (8 * c) * 33 + n;
        v4u o; o.x = pk2(s[0 * 33], s[1 * 33]); o.y = pk2(s[2 * 33], s[3 * 33]); o.z = pk2(s[4 * 33], s[5 * 33]); o.w = pk2(s[6 * 33], s[7 * 33]);
        *(v4u*)(WT + (size_t)(row_off + n0 + n) * K + k0 + 8 * c) = o; }
    asm volatile("s_waitcnt lgkmcnt(0)" ::: "memory");
}
__device__ __forceinline__ void rms_row_wave(const float* xrow, const float* g, bf16_t* orow, int lane) {
    const f32x4* xr = (const f32x4*)xrow + lane; const f32x4* gr = (const f32x4*)g + lane;
    f32x4 v[4]; float s = 0.f;
#pragma unroll
    for (int j = 0; j < 4; ++j) { v[j] = xr[64 * j]; s += (v[j].x * v[j].x + v[j].y * v[j].y) + (v[j].z * v[j].z + v[j].w * v[j].w); }
    const float r = rsqrtf(wave_sum(s) * (1.f / D) + EPS);
    unsigned long long* o8 = (unsigned long long*)orow + lane;
#pragma unroll
    for (int j = 0; j < 4; ++j) { const f32x4 gg = gr[64 * j]; o8[64 * j] = (unsigned long long)pk2(v[j].x * r * gg.x, v[j].y * r * gg.y) | ((unsigned long long)pk2(v[j].z * r * gg.z, v[j].w * r * gg.w) << 32); }
}
__device__ __forceinline__ int small_src_col(int c) { return c < 8 ? C_MLI + c : C_NSG + (c - 8); }
__global__ void __launch_bounds__(NTHREADS, 2) mega(Args a) {
    extern __shared__ __attribute__((aligned(16))) unsigned char lds_raw[];
    char* lds = (char*)lds_raw;
    LAS unsigned char* lds3 = (LAS unsigned char*)lds_raw;
    const float* x = a.in[0]; const float* mem = a.in[1]; const float* g_mix = a.in[2]; const float* w_in = a.in[3];
    const float* b_in = a.in[4]; const float* ml_conv = a.in[5]; const float* ml_norm_g = a.in[6]; const float* cmp_pe = a.in[7];
    const float* cmp_w1 = a.in[8]; const float* cmp_w2 = a.in[9]; const float* g_mem = a.in[10]; const float* w_mem_kv = a.in[11];
    const float* w_branch = a.in[12]; const float* w_out = a.in[13]; const float* g_ffn = a.in[14]; const float* w_ff1 = a.in[15];
    const float* w_ff2 = a.in[16]; const float* g_final = a.in[17];
    char* ws = (char*)a.ws; float* out = a.out;
    bf16_t* U = (bf16_t*)(ws + WS_U); bf16_t* P = (bf16_t*)(ws + WS_P);
    bf16_t* Yml = (bf16_t*)(ws + WS_Y); bf16_t* Ynsa = Yml + (size_t)M * 512; bf16_t* Yxa = Ynsa + (size_t)M * 512;
    float* S32 = (float*)(ws + WS_S32); bf16_t* MEMN = (bf16_t*)(ws + WS_MEMN); bf16_t* MEMKV = (bf16_t*)(ws + WS_MEMKV);
    bf16_t* KC = (bf16_t*)(ws + WS_KC); bf16_t* VC = (bf16_t*)(ws + WS_VC);
    float* NA = (float*)(ws + WS_NA); float* Gc = (float*)(ws + WS_G); float* Mloc = (float*)(ws + WS_MLOC); float* Mprev = (float*)(ws + WS_MPREV);
    bf16_t* Abuf = (bf16_t*)out;
    bf16_t* GATES = P; bf16_t* MERGED = U; bf16_t* AFFN = (bf16_t*)(ws + WS_AFFN); bf16_t* HBUF = P;
    bf16_t* Wi = (bf16_t*)(ws + WS_WIN); bf16_t* Wg = (bf16_t*)(ws + WS_WG); bf16_t* Wbr = (bf16_t*)(ws + WS_WBR); bf16_t* Wo = (bf16_t*)(ws + WS_WOUT);
    bf16_t* Wf1 = (bf16_t*)(ws + WS_WFF1); bf16_t* Wf2 = (bf16_t*)(ws + WS_WFF2); bf16_t* Wmkv = (bf16_t*)(ws + WS_WMKV);
    float* biasP = (float*)(ws + WS_BIASP); bf16_t* Wc1 = (bf16_t*)(ws + WS_WC1); bf16_t* Wc2 = (bf16_t*)(ws + WS_BIASP + 65536);
    const int tid = threadIdx.x, lane = tid & 63, wave = __builtin_amdgcn_readfirstlane(tid >> 6);
    const int G = gridDim.x, bid = blockIdx.x;
    const int lo = a.ph_lo, hi = a.ph_hi;
    volatile LAS unsigned* xbst = (volatile LAS unsigned*)(lds3 + 131072 + 1024);
    if (tid < 2) xbst[tid] = 0u;
    __syncthreads();
    const XcdBarrier bar = xcd_barrier_post((unsigned*)ws, xbst);
#define PHASE(k) if (lo <= (k) && (k) < hi)
#define SEAM(k) if (lo <= (k) && (k) + 1 < hi) xcd_barrier(bar)
    PHASE(0) {
        LAS float* scr = (LAS float*)(lds3 + wave * 16384);
        const int gw = bid * 8 + wave, NGW = G * 8;
        constexpr int I0 = 16 * 64, I1 = 16 * 40, I2 = 16 * 16, I3 = 16 * 96, I4 = 8 * 32, I5 = 16 * 32, I6 = 16 * 128, I7 = 64 * 32, I8 = 16 * 32;
        constexpr int I9 = 32 * 8, I10 = 4 * 2;
        constexpr int NITEMS = I0 + I1 + I2 + I3 + 3 * I4 + I5 + I6 + I7 + I8 + 2 * I9 + 2 * I10;
        for (int it = gw; it < NITEMS; it += NGW) {
            int r = it;
            if (r < I0) { tr_item(w_in, DIN, 2048, 1024, Wi, 0, scr, r, lane); continue; } r -= I0;
            if (r < I1) { tr_item(w_in + 2056, DIN, 1280, 1024, Wi, 2048, scr, r, lane); continue; } r -= I1;
            if (r < I2) { tr_item(w_in + 3360, DIN, 512, 1024, Wi, 3328, scr, r, lane); continue; } r -= I2;
            if (r < I3) { tr_item(w_in + C_MG, DIN, 3072, 1024, Wg, 0, scr, r, lane); continue; } r -= I3;
            if (r < 3 * I4) { const int j = r / I4; tr_item(w_branch + (size_t)j * 512 * 1024, 1024, 1024, 512, Wbr + (size_t)j * 1024 * 512, 0, scr, r % I4, lane); continue; } r -= 3 * I4;
            if (r < I5) { tr_item(w_out, 1024, 1024, 1024, Wo, 0, scr, r, lane); continue; } r -= I5;
            if (r < I6) { tr_item(w_ff1, FF, FF, 1024, Wf1, 0, scr, r, lane); continue; } r -= I6;
            if (r < I7) { tr_item(w_ff2, 1024, 1024, FF, Wf2, 0, scr, r, lane); continue; } r -= I7;
            if (r < I8) { tr_item(w_mem_kv, 1024, 1024, 1024, Wmkv, 0, scr, r, lane); continue; } r -= I8;
            if (r < 2 * I9) { const int kv = r / I9; tr_item(cmp_w1 + (size_t)kv * 2048 * 256, 256, 256, 2048, Wc1 + (size_t)kv * 256 * 2048, 0, scr, r % I9, lane); continue; } r -= 2 * I9;
            { const int kv = r / I10; tr_item(cmp_w2 + (size_t)kv * 256 * 64, 64, 64, 256, Wc2 + (size_t)kv * 64 * 256, 0, scr, r % I10, lane); }
        }
        for (int i = bid * NTHREADS + tid; i < 256 * 1024; i += G * NTHREADS) { const int r = i >> 10, k = i & 1023; bf16_t v = 0;
            if (r < 32) v = f2bf(w_in[(size_t)k * DIN + small_src_col(r)]);
            else if (r >= 128 && r < 160) { const float w = w_in[(size_t)k * DIN + small_src_col(r - 128)]; v = f2bf(w - bf2f(f2bf(w))); }
            Wi[(size_t)(3840 + r) * 1024 + k] = v; }
        for (int c = bid * NTHREADS + tid; c < 4096; c += G * NTHREADS) { float v = 0.f;
            if (c < 2048) v = b_in[c]; else if (c < 3328) v = b_in[c + 8]; else if (c < 3840) v = b_in[c + 32]; else if (c < 3872) v = b_in[small_src_col(c - 3840)];
            biasP[c] = v; }
        for (int m = gw; m < M; m += NGW) rms_row_wave(x + (size_t)m * D, g_mix, U + (size_t)m * D, lane);
        for (int m = gw; m < 1024; m += NGW) rms_row_wave(mem + (size_t)m * D, g_mem, MEMN + (size_t)m * D, lane);
    }
    SEAM(0);
    PHASE(1) {
        { pg8::Gemm g{U, Wi, M, 4096, D}; pg8::StaticOrder S; S.init(M, 4096, G, bid);
          pg8::EpiStore<0> E{P, biasP, S32, PW, 15};
          pg8::gemm_phase<pg8::EpiStore<0>, pg8::StaticOrder, true, true>(lds3, g, S, E); }
        { pg8::Gemm g{MEMN, Wmkv, 1024, 1024, D}; pg8::StaticOrder S; S.init(1024, 1024, G, bid);
          pg8::EpiStore<0> E{MEMKV, nullptr, nullptr, 1024, -1};
          pg8::gemm_phase<pg8::EpiStore<0>, pg8::StaticOrder, true, true>(lds3, g, S, E); }
    }
    SEAM(1);
    PHASE(2) { for (int ci = bid; ci < 1024; ci += G) ml::m1_unit((NLAS char*)lds_raw, P, ml_conv, S32, Abuf, NA, Gc, Mloc, ci);
               for (int u = bid; u < 256; u += G) cmpr::unit((NLAS char*)lds_raw, P, cmp_pe, Wc1, Wc2, KC, VC, u);
               xa::phase((NLAS char*)lds_raw, P, MEMKV, Yxa); }
    SEAM(2);
    PHASE(3) { ml::m2_items(Abuf, NA, Gc, Mloc, Mprev);
               nsa::phase((NLAS char*)lds_raw, P, S32, KC, VC, Ynsa); }
    SEAM(3);
    PHASE(4) { for (int ci = bid; ci < 1024; ci += G) ml::m3_unit((NLAS char*)lds_raw, P, ml_conv, S32, Abuf, NA, Mprev, ml_norm_g, Yml, ci); }
    SEAM(4);
    PHASE(5) { pg8::Gemm g{U, Wg, M, 3072, D}; pg8::StaticOrder S; S.init(M, 3072, G, bid);
               pg8::EpiStore<1> E{GATES, b_in + C_MG, nullptr, 3072, -1};
               pg8::gemm_phase<pg8::EpiStore<1>, pg8::StaticOrder, true, true>(lds3, g, S, E); }
    SEAM(5);
    PHASE(6) { pg8::Gemm g{Yml, Wbr, M, 1024, 512}; pg8::MergeOrder S; S.so.init(M, 1024, G, bid); S.sa = (size_t)M * 512 * 2; S.sb = (size_t)1024 * 512 * 2;
               pg8::EpiMergeG E{GATES, out, MERGED};
               pg8::gemm_phase<pg8::EpiMergeG, pg8::MergeOrder, true, true>(lds3, g, S, E); }
    SEAM(6);
    PHASE(7) { pg8::Gemm g{MERGED, Wo, M, 1024, D}; pg8::StaticOrder S; S.init(M, 1024, G, bid);
               pg8::EpiResRms E{x, out, nullptr, AFFN, g_ffn, (float*)(ws + WS_XCH), (unsigned*)ws + 4096};
               pg8::gemm_phase<pg8::EpiResRms, pg8::StaticOrder, false, true>(lds3, g, S, E); }
    SEAM(7);
    PHASE(9) { pg8::Gemm g{AFFN, Wf1, M, FF, D}; pg8::StaticOrder S; S.init(M, FF, G, bid);
               pg8::EpiStore<2> E{HBUF, nullptr, nullptr, FF, -1};
               pg8::gemm_phase<pg8::EpiStore<2>, pg8::StaticOrder, true, true>(lds3, g, S, E); }
    SEAM(9);
    PHASE(10) { pg8::Gemm g{HBUF, Wf2, M, 1024, FF}; pg8::StaticOrder S; S.init(M, 1024, G, bid);
                pg8::EpiResRms E{out, nullptr, out, nullptr, g_final, (float*)(ws + WS_XCH + 262144), (unsigned*)ws + 4096 + 4096};
                pg8::gemm_phase<pg8::EpiResRms, pg8::StaticOrder, false, true>(lds3, g, S, E); }
}
constexpr int N_PHASES = 12;
#ifndef MK_PER_PHASE
#define MK_PER_PHASE 0
#endif
extern "C" void kernel_launch(void* const* d_in, const int* in_sizes, int n_in, void* d_out, int out_size, void* d_ws, size_t ws_size, hipStream_t stream) {
    static int grid = 0;
    if (grid == 0) {
        int dev = 0, cus = 0, per_cu = 0;
        (void)hipGetDevice(&dev); (void)hipDeviceGetAttribute(&cus, hipDeviceAttributeMultiprocessorCount, dev);
        (void)hipFuncSetAttribute((const void*)mega, hipFuncAttributeMaxDynamicSharedMemorySize, LDS_BYTES);
        (void)hipOccupancyMaxActiveBlocksPerMultiprocessor(&per_cu, (const void*)mega, NTHREADS, LDS_BYTES);
        if (per_cu < 1) { fprintf(stderr, "occupancy query says %d blocks/CU\n", per_cu); per_cu = 1; }
        grid = cus * 1;
        (void)hipGetLastError();
    }
    (void)hipMemsetAsync(d_ws, 0, 65536, stream);
    Args a{};
    for (int i = 0; i < 18; ++i) a.in[i] = (const float*)d_in[i];
    a.out = (float*)d_out; a.ws = (unsigned char*)d_ws;
#if MK_PER_PHASE
    for (int p = 0; p < N_PHASES; ++p) { a.ph_lo = p; a.ph_hi = p + 1; void* args[] = {&a};
        (void)hipLaunchCooperativeKernel((const void*)mega, dim3(grid), dim3(NTHREADS), args, LDS_BYTES, stream); }
#else
    a.ph_lo = 0; a.ph_hi = N_PHASES; void* args[] = {&a};
    hipError_t e = hipLaunchCooperativeKernel((const void*)mega, dim3(grid), dim3(NTHREADS), args, LDS_BYTES, stream);
    if (e != hipSuccess) fprintf(stderr, "cooperative launch failed: %s (grid %d)\n", hipGetErrorString(e), grid);
#endif
}
```

```cpp
#include <hip/hip_runtime.h>
#include <hip/hip_cooperative_groups.h>
#include <cstdio>
namespace cg = cooperative_groups;
#include <stdint.h>

typedef unsigned short bf16_t;
struct VB { int id; int tid; char* sm; };
__device__ __forceinline__ float bf2f(bf16_t v) { return __uint_as_float(((unsigned)v) << 16); }
__device__ __forceinline__ bf16_t f2bf(float f) { unsigned u = __float_as_uint(f); return (bf16_t)((u + 0x7fffu + ((u >> 16) & 1u)) >> 16); }

constexpr int NB = 4, T = 4096, M = NB * T, D = 1024, DIN = 6944, FF = 4096;
constexpr float EPS = 1e-6f;
constexpr int C_MLI = 2048, C_NSG = 3336, C_MG = 3872;
constexpr int P_MLQ = 0, P_MLK = 512, P_MLV = 1024, P_MLO = 1536, P_NSQ = 2048, P_KC = 2560, P_VC = 2688, P_KS = 2816, P_VS = 2944, P_KW = 3072, P_VW = 3200, P_XAQ = 3328, PW = 3840;
constexpr size_t MiB = 1u << 20;
constexpr size_t WS_U = 40 * MiB;
constexpr size_t WS_P = 72 * MiB;
constexpr size_t WS_Y = 192 * MiB;
constexpr size_t WS_AFFN = 200 * MiB;
constexpr size_t WS_S32 = 240 * MiB;
constexpr size_t WS_MEMN = 242 * MiB;
constexpr size_t WS_MEMKV = 244 * MiB;
constexpr size_t WS_KC = 246 * MiB;
constexpr size_t WS_VC = 246 * MiB + 512 * 1024;
constexpr size_t WS_NA = 247 * MiB;
constexpr size_t WS_G = 248 * MiB;
constexpr size_t WS_MLOC = 248 * MiB + 4096;
constexpr size_t WS_MPREV = 248 * MiB + 8192;

__device__ __forceinline__ float wave_sum(float v) {
#pragma unroll
    for (int o = 1; o < 64; o <<= 1) v += __shfl_xor(v, o);
    return v;
}
__device__ __forceinline__ float wave_max(float v) {
#pragma unroll
    for (int o = 1; o < 64; o <<= 1) v = fmaxf(v, __shfl_xor(v, o));
    return v;
}

template <bool OUT_BF16>
__device__ __forceinline__ void rms_rows(VB vb, const float* x, const float* g, void* out) {
    float* red = (float*)vb.sm;
    const int row = vb.id, tid = vb.tid;
    const float4 v = ((const float4*)(x + (size_t)row * D))[tid];
    float s = v.x * v.x + v.y * v.y + v.z * v.z + v.w * v.w;
    s = wave_sum(s);
    if ((tid & 63) == 0) red[tid >> 6] = s;
    __syncthreads();
    const float tot = red[0] + red[1] + red[2] + red[3];
    const float r = rsqrtf(tot * (1.0f / D) + EPS);
    const float4 gg = ((const float4*)g)[tid];
    float4 o; o.x = v.x * r * gg.x; o.y = v.y * r * gg.y; o.z = v.z * r * gg.z; o.w = v.w * r * gg.w;
    if (OUT_BF16) { bf16_t* ob = (bf16_t*)out + (size_t)row * D + tid * 4; ob[0] = f2bf(o.x); ob[1] = f2bf(o.y); ob[2] = f2bf(o.z); ob[3] = f2bf(o.w); }
    else ((float4*)((float*)out + (size_t)row * D))[tid] = o;
}

struct GArgs { const bf16_t* A; const float* W; int lda, ldw, N, K; };
template <class Epi>
__device__ __forceinline__ void ngemm(VB vb, GArgs ga, Epi epi) {
    const bf16_t* A = ga.A; const float* W = ga.W; const int lda = ga.lda, ldw = ga.ldw, N = ga.N, K = ga.K;
    float (*As)[65] = (float (*)[65])vb.sm; float (*Bs)[65] = (float (*)[65])(vb.sm + 16 * 65 * 4);
    const int tid = vb.tid, tx = tid & 15, ty = tid >> 4;
    const int nx = (N + 63) / 64; const int m0 = (vb.id / nx) * 64, n0 = (vb.id % nx) * 64;
    float acc[4][4];
#pragma unroll
    for (int i = 0; i < 4; ++i)
#pragma unroll
        for (int j = 0; j < 4; ++j) acc[i][j] = 0.f;
    for (int k0 = 0; k0 < K; k0 += 16) {
#pragma unroll
        for (int i = 0; i < 4; ++i) { const int idx = tid + i * 256, r = idx >> 4, kk = idx & 15; As[kk][r] = bf2f(A[(size_t)(m0 + r) * lda + k0 + kk]); }
#pragma unroll
        for (int i = 0; i < 4; ++i) { const int idx = tid + i * 256, kk = idx >> 6, n = idx & 63; Bs[kk][n] = (n0 + n < N) ? W[(size_t)(k0 + kk) * ldw + n0 + n] : 0.f; }
        __syncthreads();
#pragma unroll
        for (int kk = 0; kk < 16; ++kk) {
            float a[4], b[4];
#pragma unroll
            for (int i = 0; i < 4; ++i) { a[i] = As[kk][ty * 4 + i]; b[i] = Bs[kk][tx * 4 + i]; }
#pragma unroll
            for (int i = 0; i < 4; ++i)
#pragma unroll
                for (int j = 0; j < 4; ++j) acc[i][j] += a[i] * b[j];
        }
        __syncthreads();
    }
#pragma unroll
    for (int i = 0; i < 4; ++i)
#pragma unroll
        for (int j = 0; j < 4; ++j) { const int n = n0 + tx * 4 + j; if (n < N) epi(m0 + ty * 4 + i, n, acc[i][j]); }
}
struct EpiBiasBf16 { bf16_t* O; const float* bias; int ldo, pad; __device__ void operator()(int m, int n, float a) const { O[(size_t)m * ldo + n] = f2bf(a + (bias ? bias[n] : 0.f)); } };
struct EpiBiasF32 { float* O; const float* bias; int ldo, pad; __device__ void operator()(int m, int n, float a) const { O[(size_t)m * ldo + n] = a + bias[n]; } };
struct EpiSigBf16 { bf16_t* O; const float* bias; int ldo, pad; __device__ void operator()(int m, int n, float a) const { const float v = a + bias[n]; O[(size_t)m * ldo + n] = f2bf(1.f / (1.f + __expf(-v))); } };
struct EpiMerge { const bf16_t* G; float* Mf; bf16_t* Mb; int j, pad; __device__ void operator()(int m, int n, float a) const {
    const float g = bf2f(G[(size_t)m * 3072 + j * 1024 + n]); float v = g * a; if (j > 0) v += Mf[(size_t)m * D + n];
    if (j < 2) Mf[(size_t)m * D + n] = v; else Mb[(size_t)m * D + n] = f2bf(v); } };
struct EpiResid { const float* X; float* O; __device__ void operator()(int m, int n, float a) const { O[(size_t)m * D + n] = X[(size_t)m * D + n] + a; } };
struct EpiRelu2 { bf16_t* O; __device__ void operator()(int m, int n, float a) const { const float r = fmaxf(a, 0.f); O[(size_t)m * FF + n] = f2bf(r * r); } };

__device__ __forceinline__ float convqk(const bf16_t* P, const float* w  , int m, int t, int ch) {
    float y = 0.f;
#pragma unroll
    for (int j = 0; j < 4; ++j) if (t - j >= 0) y += w[j * 1024 + ch] * bf2f(P[(size_t)(m - j) * PW + ch]);
    return bf2f(f2bf(y / (1.f + __expf(-y))));
}
__device__ __forceinline__ float logsig(float x) { return fminf(x, 0.f) - log1pf(__expf(-fabsf(x))); }
__device__ __forceinline__ void m1_naive(VB vb, const bf16_t* P, const float* cw, const float* S32, float* Abuf, float* NA, float* Gc, float* Mloc) {
    float (*kk)[128] = (float (*)[128])vb.sm; float* e = (float*)(vb.sm + 32768); float* bc = e + 64;
    const int ci = vb.id, c = ci & 63, bh = ci >> 6, h = bh & 3, b = bh >> 2, tid = vb.tid;
    const int m0 = b * T + c * 64;
    if (tid == 0) {
        float run = 0.f;
        for (int s = 0; s < 64; ++s) { run += logsig(S32[(size_t)(m0 + s) * 32 + 4 + h]); bc[s] = run; }
        const float g = run; float mx = -INFINITY;
        for (int s = 0; s < 64; ++s) { const float w = g - bc[s] + S32[(size_t)(m0 + s) * 32 + h]; e[s] = w; mx = fmaxf(mx, w); }
        for (int s = 0; s < 64; ++s) e[s] = __expf(e[s] - mx);
        Gc[ci] = g; Mloc[ci] = mx;
    }
    for (int i = tid; i < 64 * 128; i += 256) { const int s = i >> 7, k = i & 127; kk[s][k] = convqk(P, cw, m0 + s, c * 64 + s, 512 + h * 128 + k) * 0.08838834764831845f; }
    __syncthreads();
    const int v = tid & 127, kh = tid >> 7;
    float acc[64];
#pragma unroll
    for (int i = 0; i < 64; ++i) acc[i] = 0.f;
    for (int s = 0; s < 64; ++s) {
        const float ev = e[s] * bf2f(P[(size_t)(m0 + s) * PW + P_MLV + h * 128 + v]);
#pragma unroll
        for (int i = 0; i < 64; ++i) acc[i] += kk[s][kh * 64 + i] * ev;
    }
#pragma unroll
    for (int i = 0; i < 64; ++i) Abuf[((size_t)ci * 128 + kh * 64 + i) * 128 + v] = acc[i];
    if (tid < 128) { float n = 0.f; for (int s = 0; s < 64; ++s) n += e[s] * kk[s][tid]; NA[(size_t)ci * 128 + tid] = n; }
}
__device__ __forceinline__ void m2_naive(VB vb, float* Abuf, float* NA, const float* Gc, const float* Mloc, float* Mprev) {
    const int i = vb.id * 256 + vb.tid;
    const int bh = i >> 14, kv = i & 16383, k = kv >> 7, v = kv & 127;
    float C = 0.f, n = 0.f, m = 0.f;
    for (int c = 0; c < 64; ++c) {
        const int ci = bh * 64 + c;
        const float g = Gc[ci], ml = Mloc[ci];
        const float mn = fmaxf(g + m, ml), a = __expf(g + m - mn), bb = __expf(ml - mn);
        const size_t idx = ((size_t)ci * 128 + k) * 128 + v;
        const float A = Abuf[idx]; Abuf[idx] = C; C = a * C + bb * A;
        if (v == 0) { const float nA = NA[(size_t)ci * 128 + k]; NA[(size_t)ci * 128 + k] = n; n = a * n + bb * nA; }
        if (kv == 0) Mprev[ci] = m;
        m = mn;
    }
}
__device__ __forceinline__ void m3_naive(VB vb, const bf16_t* P, const float* cw, const float* S32, const float* Cprev, const float* Nprev, const float* Mprev,
                                                const float* normg, bf16_t* Yml) {
    float* q = (float*)vb.sm; float* Srow = q + 128; float* bc = Srow + 64; float* li = bc + 64; float* sh = li + 64;
    const int ci = vb.id >> 6, tt = vb.id & 63, c = ci & 63, bh = ci >> 6, h = bh & 3, b = bh >> 2, tid = vb.tid;
    const int m0 = b * T + c * 64, m = m0 + tt;
    q[tid] = convqk(P, cw, m, c * 64 + tt, h * 128 + tid);
    if (tid == 0) { float run = 0.f; for (int s = 0; s <= tt; ++s) { run += logsig(S32[(size_t)(m0 + s) * 32 + 4 + h]); bc[s] = run; li[s] = S32[(size_t)(m0 + s) * 32 + h]; } }
    __syncthreads();
    const float mprev = Mprev[ci], inter = bc[tt] + mprev;
    float mt = inter;
    for (int s = 0; s <= tt; ++s) mt = fmaxf(mt, bc[tt] - bc[s] + li[s]);
    if (tid < 64) {
        float sv = 0.f;
        if (tid <= tt) { float dot = 0.f; for (int k = 0; k < 128; ++k) dot += q[k] * convqk(P, cw, m0 + tid, c * 64 + tid, 512 + h * 128 + k);
            sv = dot * 0.08838834764831845f * __expf(bc[tt] - bc[tid] + li[tid] - mt); }
        Srow[tid] = sv;
    }
    __syncthreads();
    const float sc = __expf(inter - mt);
    float num = 0.f, den = 0.f;
    for (int s = 0; s <= tt; ++s) { num += Srow[s] * bf2f(P[(size_t)(m0 + s) * PW + P_MLV + h * 128 + tid]); den += Srow[s]; }
    float qc = 0.f, qn = 0.f;
    for (int k = 0; k < 128; ++k) { qc += q[k] * Cprev[((size_t)ci * 128 + k) * 128 + tid]; qn += q[k] * Nprev[(size_t)ci * 128 + k]; }
    num += sc * qc; den += sc * qn;
    const float hv = num / fmaxf(fabsf(den), __expf(-mt));
    float ss = wave_sum(hv * hv);
    if ((tid & 63) == 0) sh[tid >> 6] = ss;
    __syncthreads();
    const float r = rsqrtf((sh[0] + sh[1]) * (1.f / 128.f) + EPS);
    const float o = bf2f(P[(size_t)m * PW + P_MLO + h * 128 + tid]);
    Yml[(size_t)m * 512 + h * 128 + tid] = f2bf(1.f / (1.f + __expf(-o)) * hv * r * normg[h * 128 + tid]);
}

__device__ __forceinline__ float gelu_tanh(float x) { const float u = 0.7978845608028654f * (x + 0.044715f * x * x * x); return 0.5f * x * (1.f + tanhf(u)); }
__device__ __forceinline__ void n1_naive(VB vb, const bf16_t* P, const float* pe  , const float* w1  , const float* w2  , bf16_t* KC, bf16_t* VC) {
    float* xin = (float*)vb.sm; float* hid = xin + 2048;
    int idx = vb.id; const int g = idx & 1; idx >>= 1; const int n = idx % 255; idx /= 255; const int b = idx & 3, kv = idx >> 2, tid = vb.tid;
    const int pcol = (kv ? P_VC : P_KC) + g * 64;
    for (int i = tid; i < 2048; i += 256) { const int l = i >> 6, d = i & 63; xin[i] = bf2f(P[(size_t)(b * T + n * 16 + l) * PW + pcol + d]) + pe[kv * 2048 + i]; }
    __syncthreads();
    float a = 0.f; const float* w = w1 + (size_t)kv * 2048 * 256 + tid;
    for (int i = 0; i < 2048; ++i) a += xin[i] * w[(size_t)i * 256];
    hid[tid] = gelu_tanh(a);
    __syncthreads();
    if (tid < 64) { float o = 0.f; const float* ww = w2 + (size_t)kv * 256 * 64 + tid; for (int j = 0; j < 256; ++j) o += hid[j] * ww[j * 64];
        (kv ? VC : KC)[((size_t)(b * 256 + n) * 2 + g) * 64 + tid] = f2bf(o); }
}
__device__ __forceinline__ void n2_naive(VB vb, const bf16_t* P, const float* S32, const bf16_t* KC, const bf16_t* VC, bf16_t* Ynsa) {
    float (*q_s)[64] = (float (*)[64])vb.sm; float (*sc)[1024] = (float (*)[1024])(vb.sm + 1024); float (*pc)[256] = (float (*)[256])(vb.sm + 1024 + 16384); float* imp_s = (float*)(vb.sm + 1024 + 16384 + 4096);
    unsigned long long& selmask = *(unsigned long long*)(vb.sm + 1024 + 16384 + 4096 + 256);
    const int g = vb.id & 1, m = vb.id >> 1, b = m / T, t = m % T, tid = vb.tid, r = tid >> 6, lane = tid & 63, h = g * 4 + r;
    const float slope = exp2f(-(float)(h + 1));
    q_s[r][lane] = bf2f(P[(size_t)m * PW + P_NSQ + h * 64 + lane]) * 0.125f;
    __syncthreads();
    float sv[4]; float mx = -INFINITY;
#pragma unroll
    for (int i = 0; i < 4; ++i) { const int n = lane + 64 * i; sv[i] = -INFINITY;
        if (n < 255) { const int dist = t - (16 * n + 31); if (dist >= 0) { const bf16_t* kr = KC + ((size_t)(b * 256 + n) * 2 + g) * 64; float dot = 0.f; for (int d = 0; d < 64; ++d) dot += q_s[r][d] * bf2f(kr[d]);
            sv[i] = dot - slope * (float)dist; mx = fmaxf(mx, sv[i]); } } }
    mx = wave_max(mx);
    float sum = 0.f;
#pragma unroll
    for (int i = 0; i < 4; ++i) { sv[i] = (sv[i] == -INFINITY) ? 0.f : __expf(sv[i] - mx); sum += sv[i]; }
    sum = wave_sum(sum);
    const float inv = sum > 0.f ? 1.f / sum : 0.f;
#pragma unroll
    for (int i = 0; i < 4; ++i) pc[r][lane + 64 * i] = sv[i] * inv;
    __syncthreads();
    float oc = 0.f;
    { const int nmax = (t >= 31) ? ((t - 31) / 16) : -1; for (int n = 0; n <= nmax && n < 255; ++n) oc += pc[r][n] * bf2f(VC[((size_t)(b * 256 + n) * 2 + g) * 64 + lane]); }
    if (tid < 64) { const int j = tid; float im = 0.f;
        for (int n = 4 * j - 1; n <= 4 * j + 3; ++n) if (n >= 0 && n < 255) im += (pc[0][n] + pc[1][n]) + (pc[2][n] + pc[3][n]);
        const int cur = t >> 6; const bool valid = j <= cur, forced = (j == 0) || (j == cur) || (j == cur - 1);
        const float s = valid ? im + (forced ? 1000.f : 0.f) : -1e30f;
        imp_s[j] = s; }
    __syncthreads();
    if (tid < 64) { const int j = tid; const float s = imp_s[j]; int rank = 0;
        for (int jj = 0; jj < 64; ++jj) { const float o = imp_s[jj]; rank += (o > s || (o == s && jj < j)) ? 1 : 0; }
        const unsigned long long mk = __ballot(rank < 16 && j <= (t >> 6)); if (tid == 0) selmask = mk; }
    __syncthreads();
    float osel = 0.f;
    { unsigned long long mk = selmask; int slot = 0; float mxs = -INFINITY;
      while (mk) { const int jb = __ffsll((long long)mk) - 1; mk &= mk - 1; const int pos = jb * 64 + lane; float s = -INFINITY;
          if (pos <= t) { const bf16_t* kr = P + (size_t)(b * T + pos) * PW + P_KS + g * 64; float dot = 0.f; for (int d = 0; d < 64; ++d) dot += q_s[r][d] * bf2f(kr[d]); s = dot - slope * (float)(t - pos); }
          sc[r][slot * 64 + lane] = s; mxs = fmaxf(mxs, s); ++slot; }
      mxs = wave_max(mxs); float sm = 0.f;
      for (int i = 0; i < slot; ++i) { const float s = sc[r][i * 64 + lane]; const float p = (s == -INFINITY) ? 0.f : __expf(s - mxs); sc[r][i * 64 + lane] = p; sm += p; }
      sm = wave_sum(sm);
      mk = selmask; slot = 0;
      while (mk) { const int jb = __ffsll((long long)mk) - 1; mk &= mk - 1;
          for (int i = 0; i < 64; ++i) { const int pos = jb * 64 + i; if (pos > t) break; osel += sc[r][slot * 64 + i] * bf2f(P[(size_t)(b * T + pos) * PW + P_VS + g * 64 + lane]); }
          ++slot; }
      osel /= sm; }
    __syncthreads();
    float owin = 0.f;
    { float mxs = -INFINITY;
      for (int i = 0; i < 8; ++i) { const int pos = t - 511 + i * 64 + lane; float s = -INFINITY;
          if (pos >= 0) { const bf16_t* kr = P + (size_t)(b * T + pos) * PW + P_KW + g * 64; float dot = 0.f; for (int d = 0; d < 64; ++d) dot += q_s[r][d] * bf2f(kr[d]); s = dot - slope * (float)(t - pos); }
          sc[r][i * 64 + lane] = s; mxs = fmaxf(mxs, s); }
      mxs = wave_max(mxs); float sm = 0.f;
      for (int i = 0; i < 8; ++i) { const float s = sc[r][i * 64 + lane]; const float p = (s == -INFINITY) ? 0.f : __expf(s - mxs); sc[r][i * 64 + lane] = p; sm += p; }
      sm = wave_sum(sm);
      for (int i = 0; i < 512; ++i) { const int pos = t - 511 + i; if (pos < 0) continue; owin += sc[r][i] * bf2f(P[(size_t)(b * T + pos) * PW + P_VW + g * 64 + lane]); }
      owin /= sm; }
    const float* gp = S32 + (size_t)m * 32 + 8 + h * 3;
    const float g0 = 1.f / (1.f + __expf(-gp[0])), g1 = 1.f / (1.f + __expf(-gp[1])), g2 = 1.f / (1.f + __expf(-gp[2]));
    Ynsa[(size_t)m * 512 + h * 64 + lane] = f2bf(g0 * oc + g1 * osel + g2 * owin);
}
__device__ __forceinline__ void x1_naive(VB vb, const bf16_t* P, const bf16_t* MEMKV, bf16_t* Yxa) {
    float (*q_s)[128] = (float (*)[128])vb.sm; float (*p_s)[256] = (float (*)[256])(vb.sm + 2048);
    const int m = vb.id, b = m / T, tid = vb.tid, h = tid >> 6, lane = tid & 63;
    q_s[h][lane] = bf2f(P[(size_t)m * PW + P_XAQ + h * 128 + lane]) * 0.08838834764831845f;
    q_s[h][lane + 64] = bf2f(P[(size_t)m * PW + P_XAQ + h * 128 + lane + 64]) * 0.08838834764831845f;
    __syncthreads();
    float sv[4]; float mx = -INFINITY;
#pragma unroll
    for (int i = 0; i < 4; ++i) { const int j = lane + 64 * i; const bf16_t* kr = MEMKV + (size_t)(b * 256 + j) * 1024 + h * 128; float dot = 0.f; for (int d = 0; d < 128; ++d) dot += q_s[h][d] * bf2f(kr[d]); sv[i] = dot; mx = fmaxf(mx, dot); }
    mx = wave_max(mx); float sm = 0.f;
#pragma unroll
    for (int i = 0; i < 4; ++i) { sv[i] = __expf(sv[i] - mx); sm += sv[i]; }
    sm = wave_sum(sm);
#pragma unroll
    for (int i = 0; i < 4; ++i) p_s[h][lane + 64 * i] = sv[i] / sm;
    __syncthreads();
    float o0 = 0.f, o1 = 0.f;
    for (int j = 0; j < 256; ++j) { const bf16_t* vr = MEMKV + (size_t)(b * 256 + j) * 1024 + 512 + h * 128; const float p = p_s[h][j]; o0 += p * bf2f(vr[lane]); o1 += p * bf2f(vr[lane + 64]); }
    Yxa[(size_t)m * 512 + h * 128 + lane] = f2bf(o0); Yxa[(size_t)m * 512 + h * 128 + lane + 64] = f2bf(o1);
}


namespace pg8 {
#define PG8_LAS __attribute__((address_space(3)))
typedef unsigned short bf16_t;
typedef short bf16x8 __attribute__((ext_vector_type(8)));
typedef float f32x4 __attribute__((ext_vector_type(4)));
typedef unsigned u32x4 __attribute__((ext_vector_type(4)));
constexpr int BM = 256, BK = 64, HALF = 128, HTB = HALF * BK * 2  , STAGE_BYTES = 8 * HTB, NXCD = 8, WGM = 8;

__host__ __device__ __forceinline__ int lds_byte(int r, int c) { const int st = (r >> 4) * 2 + (c >> 5), rr = r & 15, cc = c & 31, ob = rr * 64 + cc * 2; return st * 1024 + (ob ^ (((ob >> 9) & 1) << 5)); }
__host__ __device__ __forceinline__ void stage_rc(int b, int& R, int& C) { const int st = b / 1024, sb = b % 1024, swz = sb ^ (((sb >> 9) & 1) << 5); R = (st >> 1) * 16 + swz / 64; C = (st & 1) * 32 + (swz % 64) / 2; }
__host__ __device__ __forceinline__ int perm32(int rho) { const int n = rho >> 4, i = rho & 15; return 8 * (i >> 2) + 4 * n + (i & 3); }

struct Unit { int pm, pn, j; };
struct Gemm { const bf16_t* A; const bf16_t* Bt; int M, N, K; };

struct StaticOrder {
    int nM, nN, nwg, G, c;
    __host__ __device__ void init(int M, int N, int G_, int c_) { nM = M / BM; nN = N / BM; nwg = nM * nN; G = G_; c = c_; }
    __host__ __device__ bool next(int i, Unit& u) const {
        const long L = (long)i * G + c; if (L >= nwg) return false;
        int wgid = (int)L; { const int q = nwg / NXCD, r = nwg % NXCD, xcd = wgid % NXCD, off = wgid / NXCD; wgid = (xcd < r ? xcd * (q + 1) : r * (q + 1) + (xcd - r) * q) + off; }
        const int nig = WGM * nN, gid = wgid / nig, fm = gid * WGM, gsz = (nM - fm) < WGM ? (nM - fm) : WGM;
        u.pm = fm + ((wgid % nig) % gsz); u.pn = (wgid % nig) / gsz; u.j = 0; return true;
    }
    __device__ __forceinline__ const char* pa(const Gemm& g, const Unit& u, size_t tstep) const { return (const char*)g.A + (size_t)u.pm * tstep; }
    __device__ __forceinline__ const char* pb(const Gemm& g, const Unit& u, size_t tstep) const { return (const char*)g.Bt + (size_t)u.pn * tstep; }
    __device__ __forceinline__ void a_ready(const Unit&) const {}
    __device__ __forceinline__ void done(const Unit&) const {}
};

struct MergeOrder {
    StaticOrder so; size_t sa, sb;
    __device__ __forceinline__ bool next(int i, Unit& u) const { if (i >= 3) return false; const bool ok = so.next(0, u); u.j = i; return ok; }
    __device__ __forceinline__ const char* pa(const Gemm& g, const Unit& u, size_t tstep) const { return (const char*)g.A + (size_t)u.j * sa + (size_t)u.pm * tstep; }
    __device__ __forceinline__ const char* pb(const Gemm& g, const Unit& u, size_t tstep) const { return (const char*)g.Bt + (size_t)u.j * sb + (size_t)u.pn * tstep; }
    __device__ __forceinline__ void a_ready(const Unit&) const {}
    __device__ __forceinline__ void done(const Unit&) const {}
};
typedef float f32x2_t __attribute__((ext_vector_type(2))); typedef __bf16 bf16x2_t __attribute__((ext_vector_type(2)));
__device__ __forceinline__ unsigned cvt_pk_bf16(float lo, float hi) { f32x2_t v = {lo, hi}; bf16x2_t b = __builtin_convertvector(v, bf16x2_t); return __builtin_bit_cast(unsigned, b); }
typedef float f32x2 __attribute__((ext_vector_type(2)));

typedef unsigned u32x2 __attribute__((ext_vector_type(2)));
__device__ __forceinline__ float bflo(unsigned w) { return __uint_as_float(w << 16); }
__device__ __forceinline__ float bfhi(unsigned w) { return __uint_as_float(w & 0xffff0000u); }
template <int ACT> __device__ __forceinline__ f32x4 act4(f32x4 v) {
    if (ACT == 1) { f32x4 o; for (int e = 0; e < 4; ++e) o[e] = __builtin_amdgcn_rcpf(1.f + __expf(-v[e])); return o; }
    if (ACT == 2) { f32x4 o; for (int e = 0; e < 4; ++e) { const float r = fmaxf(v[e], 0.f); o[e] = r * r; } return o; }
    return v;
}
template <int ACT> struct EpiStore {
    static constexpr bool PERM = true, AFTER_DRAIN = false;
    bf16_t* O; const float* bias; float* S32; int ldc, small_pn;
    __device__ __forceinline__ void operator()(const f32x4 (&acc)[2][2][4][2], const Unit& u, int wr, int wc, int fr, int fq) const {
        asm volatile("s_waitcnt vmcnt(0)" ::: "memory");
        const int row0 = u.pm * BM + wr * 64 + fr, col0 = u.pn * BM + wc * 32 + 8 * fq;
        if (u.pn == small_pn) {
            if (wc == 0) {
                const f32x4 b0 = *(const f32x4*)(bias + col0), b1 = *(const f32x4*)(bias + col0 + 4);
#pragma unroll
                for (int ai = 0; ai < 2; ++ai)
#pragma unroll
                    for (int m = 0; m < 4; ++m) { float* rp = S32 + (size_t)(row0 + ai * HALF + m * 16) * 32 + 8 * fq;
                        *(f32x4*)rp = acc[ai][0][m][0] + acc[ai][1][m][0] + b0; *(f32x4*)(rp + 4) = acc[ai][0][m][1] + acc[ai][1][m][1] + b1; }
            }
            return;
        }
        f32x4 bv[2][2];
#pragma unroll
        for (int bj = 0; bj < 2; ++bj)
#pragma unroll
            for (int n = 0; n < 2; ++n) bv[bj][n] = bias ? *(const f32x4*)(bias + col0 + bj * HALF + 4 * n) : (f32x4){0.f, 0.f, 0.f, 0.f};
#pragma unroll
        for (int ai = 0; ai < 2; ++ai)
#pragma unroll
            for (int m = 0; m < 4; ++m) { bf16_t* rowp = O + (size_t)(row0 + ai * HALF + m * 16) * ldc + col0;
#pragma unroll
                for (int bj = 0; bj < 2; ++bj) { const f32x4 v0 = act4<ACT>(acc[ai][bj][m][0] + bv[bj][0]), v1 = act4<ACT>(acc[ai][bj][m][1] + bv[bj][1]);
                    u32x4 w; w.x = cvt_pk_bf16(v0[0], v0[1]); w.y = cvt_pk_bf16(v0[2], v0[3]); w.z = cvt_pk_bf16(v1[0], v1[1]); w.w = cvt_pk_bf16(v1[2], v1[3]);
                    *(u32x4*)(rowp + bj * HALF) = w; } }
    }
};
struct EpiMergeG {
    static constexpr bool PERM = true, AFTER_DRAIN = false;
    const bf16_t* G; bf16_t* Mp; bf16_t* Mb;
    __device__ __forceinline__ void operator()(const f32x4 (&acc)[2][2][4][2], const Unit& u, int wr, int wc, int fr, int fq) const {
        const int j = u.j;
        asm volatile("s_waitcnt vmcnt(0)" ::: "memory");
        const int row0 = u.pm * BM + wr * 64 + fr, col0 = u.pn * BM + wc * 32 + 8 * fq;
        bf16_t* dst = (j < 2) ? Mp : Mb;
#pragma unroll
        for (int ai = 0; ai < 2; ++ai)
#pragma unroll
            for (int m = 0; m < 4; ++m) { const size_t row = (size_t)(row0 + ai * HALF + m * 16);
#pragma unroll
                for (int bj = 0; bj < 2; ++bj) { const int col = col0 + bj * HALF;
                    const u32x4 gw = *(const u32x4*)(G + row * 3072 + j * 1024 + col);
                    f32x4 v0 = (f32x4){bflo(gw.x), bfhi(gw.x), bflo(gw.y), bfhi(gw.y)} * acc[ai][bj][m][0], v1 = (f32x4){bflo(gw.z), bfhi(gw.z), bflo(gw.w), bfhi(gw.w)} * acc[ai][bj][m][1];
                    if (j > 0) { const u32x4 pw = *(const u32x4*)(Mp + row * 1024 + col); v0 += (f32x4){bflo(pw.x), bfhi(pw.x), bflo(pw.y), bfhi(pw.y)}; v1 += (f32x4){bflo(pw.z), bfhi(pw.z), bflo(pw.w), bfhi(pw.w)}; }
                    u32x4 w; w.x = cvt_pk_bf16(v0[0], v0[1]); w.y = cvt_pk_bf16(v0[2], v0[3]); w.z = cvt_pk_bf16(v1[0], v1[1]); w.w = cvt_pk_bf16(v1[2], v1[3]); *(u32x4*)(dst + row * 1024 + col) = w; } }
    }
};
struct EpiResidF {
    static constexpr bool PERM = true, AFTER_DRAIN = false;
    const float* X; float* O;
    __device__ __forceinline__ void operator()(const f32x4 (&acc)[2][2][4][2], const Unit& u, int wr, int wc, int fr, int fq) const {
        asm volatile("s_waitcnt vmcnt(0)" ::: "memory");
        const int row0 = u.pm * BM + wr * 64 + fr, col0 = u.pn * BM + wc * 32 + 8 * fq;
#pragma unroll
        for (int ai = 0; ai < 2; ++ai)
#pragma unroll
            for (int m = 0; m < 4; ++m) { const size_t off = (size_t)(row0 + ai * HALF + m * 16) * 1024 + col0;
#pragma unroll
                for (int bj = 0; bj < 2; ++bj) { const f32x4 x0 = *(const f32x4*)(X + off + bj * HALF), x1 = *(const f32x4*)(X + off + bj * HALF + 4);
                    *(f32x4*)(O + off + bj * HALF) = x0 + acc[ai][bj][m][0]; *(f32x4*)(O + off + bj * HALF + 4) = x1 + acc[ai][bj][m][1]; } }
    }
};
struct EpiResRms {
    static constexpr bool PERM = false, AFTER_DRAIN = true;
    const float* R; float* Hout; float* Nf; bf16_t* Nb; const float* gain; float* xbuf; unsigned* cnt;
    __device__ __forceinline__ void fused(f32x4 (&acc)[2][2][4][2], const Unit& u, int wr, int wc, int fr, int fq, PG8_LAS unsigned char* lds, int wid, int lane) const {
        PG8_LAS float* Pp = (PG8_LAS float*)lds; PG8_LAS float* S = (PG8_LAS float*)(lds + 4096);
        const int col0 = u.pn * BM + wc * 32 + 4 * fq;
#pragma unroll
        for (int ai = 0; ai < 2; ++ai)
#pragma unroll
            for (int m = 0; m < 4; ++m) { const size_t off = (size_t)(u.pm * BM + ai * HALF + wr * 64 + m * 16 + fr) * 1024 + col0; float sq = 0.f;
#pragma unroll
                for (int bj = 0; bj < 2; ++bj)
#pragma unroll
                    for (int n = 0; n < 2; ++n) { const f32x4 v = acc[ai][bj][m][n] + *(const f32x4*)(R + off + bj * HALF + n * 16); acc[ai][bj][m][n] = v; sq += (v[0] * v[0] + v[1] * v[1]) + (v[2] * v[2] + v[3] * v[3]); }
                sq += __shfl_xor(sq, 16); sq += __shfl_xor(sq, 32);
                if (fq == 0) Pp[(ai * HALF + wr * 64 + m * 16 + fr) * 4 + wc] = sq; }
        asm volatile("s_waitcnt lgkmcnt(0)" ::: "memory"); __builtin_amdgcn_s_barrier(); asm volatile("" ::: "memory");
        const int row = wid * 32 + (lane & 31);
        if (lane < 32) { const float tot = (Pp[row * 4 + 0] + Pp[row * 4 + 1]) + (Pp[row * 4 + 2] + Pp[row * 4 + 3]);
            __hip_atomic_store(xbuf + ((size_t)(u.pm * BM + row) * 4 + u.pn), tot, __ATOMIC_RELAXED, __HIP_MEMORY_SCOPE_AGENT); }
        asm volatile("s_waitcnt vmcnt(0)" ::: "memory");
        if (lane == 0) __hip_atomic_fetch_add(cnt + 64 * u.pm, 1u, __ATOMIC_RELAXED, __HIP_MEMORY_SCOPE_AGENT);
        if (wid == 0) { unsigned sp = 0;
            while ((unsigned)__builtin_amdgcn_readfirstlane(__hip_atomic_load(cnt + 64 * u.pm, __ATOMIC_RELAXED, __HIP_MEMORY_SCOPE_AGENT)) < 32u) { __builtin_amdgcn_s_sleep(2); if (++sp > (1u << 22)) break; }
            __builtin_amdgcn_fence(__ATOMIC_ACQUIRE, "agent"); }
        asm volatile("s_waitcnt vmcnt(0) lgkmcnt(0)" ::: "memory"); __builtin_amdgcn_s_barrier(); asm volatile("" ::: "memory");
        if (lane < 32) { const float* slot = xbuf + (size_t)(u.pm * BM + row) * 4; float t = 0.f;
#pragma unroll
            for (int q = 0; q < 4; ++q) t += __hip_atomic_load(slot + q, __ATOMIC_RELAXED, __HIP_MEMORY_SCOPE_AGENT);
            S[row] = rsqrtf(t * (1.0f / 1024.0f) + 1e-6f); }
        asm volatile("s_waitcnt lgkmcnt(0)" ::: "memory"); __builtin_amdgcn_s_barrier(); asm volatile("" ::: "memory");
        f32x4 gv[2][2];
#pragma unroll
        for (int bj = 0; bj < 2; ++bj)
#pragma unroll
            for (int n = 0; n < 2; ++n) gv[bj][n] = *(const f32x4*)(gain + col0 + bj * HALF + n * 16);
#pragma unroll
        for (int ai = 0; ai < 2; ++ai)
#pragma unroll
            for (int m = 0; m < 4; ++m) { const int r = ai * HALF + wr * 64 + m * 16 + fr; const float rs = S[r]; const size_t off = (size_t)(u.pm * BM + r) * 1024 + col0;
#pragma unroll
                for (int bj = 0; bj < 2; ++bj)
#pragma unroll
                    for (int n = 0; n < 2; ++n) { const f32x4 v = acc[ai][bj][m][n]; const f32x4 o = v * rs * gv[bj][n];
                        if (Hout) *(f32x4*)(Hout + off + bj * HALF + n * 16) = v;
                        if (Nf) *(f32x4*)(Nf + off + bj * HALF + n * 16) = o;
                        if (Nb) { u32x2 w; w.x = cvt_pk_bf16(o[0], o[1]); w.y = cvt_pk_bf16(o[2], o[3]); *(u32x2*)(Nb + off + bj * HALF + n * 16) = w; } } }
    }
};

template <class Epi, class Sched, bool ALIGN_EPI = false, bool SP2 = false>
__device__ __forceinline__ void gemm_phase(PG8_LAS unsigned char* lds, const Gemm g, const Sched& S, const Epi& E) {
    const int tid = threadIdx.x, wid = __builtin_amdgcn_readfirstlane(tid >> 6), lane = tid & 63, wr = wid >> 2, wc = wid & 3, fr = lane & 15, fq = lane >> 4;
    const int K = g.K, nt = K / BK;
    unsigned voffA[2], voffB[2];
#pragma unroll
    for (int i = 0; i < 2; ++i) { int R, C; stage_rc(tid * 16 + i * 8192, R, C); const int Rb = Epi::PERM ? ((R & ~31) + perm32(R & 31)) : R;
        voffA[i] = (unsigned)(R * K + C) * 2u; voffB[i] = (unsigned)(Rb * K + C) * 2u; }
    const size_t kstep = (size_t)(BK * 2);
    const size_t hstep = (size_t)HALF * K * 2;
    const size_t tstep = 2 * hstep;
    const unsigned ldsw = (unsigned)wid * 1024u;
    const int aoff = lds_byte(wr * 64 + fr, fq * 8), boff = lds_byte(wc * 32 + fr, fq * 8);
#define PG8_SA(b, h) (((b) * 2 + (h)) * HTB)
#define PG8_SB(b, h) ((4 + (b) * 2 + (h)) * HTB)
#define PG8_STAGE(bufoff, gbase, voff) do { _Pragma("unroll") for (int _i = 0; _i < 2; ++_i) \
        __builtin_amdgcn_global_load_lds((const unsigned*)((const char*)(gbase) + (voff)[_i]), (PG8_LAS unsigned*)(lds + (bufoff) + ldsw + _i * 8192), 16, 0, 0); } while (0)
#define PG8_LDA(dst, b, h) do { _Pragma("unroll") for (int m = 0; m < 4; ++m) _Pragma("unroll") for (int k = 0; k < 2; ++k) dst[m][k] = *(const PG8_LAS bf16x8*)(lds + PG8_SA(b, h) + aoff + m * 2048 + k * 1024); } while (0)
#define PG8_LDB(dst, b, h) do { _Pragma("unroll") for (int n = 0; n < 2; ++n) _Pragma("unroll") for (int k = 0; k < 2; ++k) dst[n][k] = *(const PG8_LAS bf16x8*)(lds + PG8_SB(b, h) + boff + n * 2048 + k * 1024); } while (0)
#define PG8_MMA(ai, bj, At, Bt) do { __builtin_amdgcn_s_setprio(1); _Pragma("unroll") for (int m = 0; m < 4; ++m) _Pragma("unroll") for (int n = 0; n < 2; ++n) _Pragma("unroll") for (int k = 0; k < 2; ++k) \
        acc[ai][bj][m][n] = __builtin_amdgcn_mfma_f32_16x16x32_bf16(Bt[n][k], At[m][k], acc[ai][bj][m][n], 0, 0, 0); __builtin_amdgcn_s_setprio(0); } while (0)
#define PG8_WAIT_V(n) asm volatile("s_waitcnt vmcnt(" #n ")" ::: "memory")
#define PG8_WAIT_L(n) asm volatile("s_waitcnt lgkmcnt(" #n ")" ::: "memory")
#define PG8_BAR __builtin_amdgcn_s_barrier()
#define PG8_SCHED __builtin_amdgcn_sched_barrier(0)
    Unit cur, nxt; int ui = 0;
    if (!S.next(0, cur)) return;
    f32x4 acc[2][2][4][2];
#pragma unroll
    for (int a = 0; a < 2; ++a)
#pragma unroll
        for (int b = 0; b < 2; ++b)
#pragma unroll
            for (int m = 0; m < 4; ++m)
#pragma unroll
                for (int n = 0; n < 2; ++n) acc[a][b][m][n] = (f32x4){0.f, 0.f, 0.f, 0.f};
    bf16x8 At[4][2], B0[2][2], B1[2][2];
    const char* cA = S.pa(g, cur, tstep); const char* cB = S.pb(g, cur, tstep);
    S.a_ready(cur);
    if constexpr (SP2) {
        PG8_STAGE(PG8_SB(0, 0), cB, voffB); PG8_STAGE(PG8_SB(0, 1), cB + hstep, voffB); PG8_STAGE(PG8_SA(0, 0), cA, voffA); PG8_STAGE(PG8_SA(0, 1), cA + hstep, voffA);
        if (wr == 1) PG8_BAR;
        PG8_WAIT_V(2); PG8_BAR;
        PG8_STAGE(PG8_SB(1, 0), cB + kstep, voffB); PG8_STAGE(PG8_SA(1, 0), cA + kstep, voffA); PG8_STAGE(PG8_SB(1, 1), cB + hstep + kstep, voffB);
        PG8_WAIT_V(6); PG8_BAR;
    } else {
        PG8_STAGE(PG8_SB(0, 0), cB, voffB); PG8_STAGE(PG8_SA(0, 0), cA, voffA); PG8_STAGE(PG8_SB(0, 1), cB + hstep, voffB); PG8_STAGE(PG8_SA(0, 1), cA + hstep, voffA);
        if (wr == 1) PG8_BAR;
        PG8_WAIT_V(4); PG8_BAR;
        PG8_STAGE(PG8_SB(1, 0), cB + kstep, voffB); PG8_STAGE(PG8_SA(1, 0), cA + kstep, voffA); PG8_STAGE(PG8_SB(1, 1), cB + hstep + kstep, voffB);
        PG8_WAIT_V(6); PG8_BAR;
    }
    for (;;) {
        const bool has_next = S.next(ui + 1, nxt);
        const char* nA = has_next ? S.pa(g, nxt, tstep) : cA; const char* nB = has_next ? S.pb(g, nxt, tstep) : cB;
        for (int t = 0; t < nt; t += 2) {
            const bool last = (t == nt - 2);
            const char* a1 = cA + (size_t)(t + 1) * kstep;
            const char* a2 = last ? nA : cA + (size_t)(t + 2) * kstep; const char* b2 = last ? nB : cB + (size_t)(t + 2) * kstep;
            const char* a3 = a2 + kstep; const char* b3 = b2 + kstep;
            if (last && has_next) S.a_ready(nxt);
            if constexpr (SP2) {
            PG8_LDB(B0, 0, 0); PG8_LDB(B1, 0, 1); PG8_SCHED; PG8_LDA(At, 0, 0); PG8_STAGE(PG8_SA(1, 1), a1 + hstep, voffA);
            PG8_WAIT_V(8); PG8_WAIT_L(0); PG8_BAR; PG8_MMA(0, 0, At, B0); PG8_MMA(0, 1, At, B1); PG8_BAR; PG8_SCHED;
            PG8_LDA(At, 0, 1); PG8_STAGE(PG8_SB(0, 0), b2, voffB); PG8_STAGE(PG8_SB(0, 1), b2 + hstep, voffB); PG8_STAGE(PG8_SA(0, 0), a2, voffA);
            PG8_WAIT_V(8); PG8_WAIT_L(0); PG8_BAR; PG8_MMA(1, 0, At, B0); PG8_MMA(1, 1, At, B1); PG8_BAR; PG8_SCHED;
            PG8_LDB(B0, 1, 0); PG8_LDB(B1, 1, 1); PG8_SCHED; PG8_LDA(At, 1, 0); PG8_STAGE(PG8_SA(0, 1), a2 + hstep, voffA);
            PG8_WAIT_V(8); PG8_WAIT_L(0); PG8_BAR; PG8_MMA(0, 0, At, B0); PG8_MMA(0, 1, At, B1); PG8_BAR; PG8_SCHED;
            PG8_LDA(At, 1, 1); PG8_STAGE(PG8_SB(1, 0), b3, voffB); PG8_STAGE(PG8_SB(1, 1), b3 + hstep, voffB); PG8_STAGE(PG8_SA(1, 0), a3, voffA);
            PG8_WAIT_V(8); PG8_WAIT_L(0); PG8_BAR; PG8_MMA(1, 0, At, B0); PG8_MMA(1, 1, At, B1); PG8_BAR; PG8_SCHED;
            } else {
            PG8_LDB(B0, 0, 0); PG8_SCHED; PG8_LDA(At, 0, 0); PG8_STAGE(PG8_SA(1, 1), a1 + hstep, voffA);
            PG8_WAIT_L(8); PG8_BAR; PG8_WAIT_L(0); PG8_MMA(0, 0, At, B0); PG8_BAR; PG8_SCHED;
            PG8_LDB(B1, 0, 1); PG8_STAGE(PG8_SB(0, 0), b2, voffB);
            PG8_BAR; PG8_WAIT_L(0); PG8_MMA(0, 1, At, B1); PG8_BAR;
            PG8_LDA(At, 0, 1); PG8_STAGE(PG8_SA(0, 0), a2, voffA);
            PG8_BAR; PG8_WAIT_L(0); PG8_MMA(1, 0, At, B0); PG8_BAR; PG8_SCHED;
            PG8_STAGE(PG8_SB(0, 1), b2 + hstep, voffB);
            PG8_WAIT_V(6); PG8_BAR; PG8_MMA(1, 1, At, B1); PG8_BAR;
            PG8_LDB(B0, 1, 0); PG8_SCHED; PG8_LDA(At, 1, 0); PG8_STAGE(PG8_SA(0, 1), a2 + hstep, voffA);
            PG8_WAIT_L(8); PG8_BAR; PG8_WAIT_L(0); PG8_MMA(0, 0, At, B0); PG8_BAR; PG8_SCHED;
            PG8_LDB(B1, 1, 1); PG8_STAGE(PG8_SB(1, 0), b3, voffB);
            PG8_BAR; PG8_WAIT_L(0); PG8_MMA(0, 1, At, B1); PG8_BAR;
            PG8_LDA(At, 1, 1); PG8_STAGE(PG8_SA(1, 0), a3, voffA);
            PG8_BAR; PG8_WAIT_L(0); PG8_MMA(1, 0, At, B0); PG8_BAR; PG8_SCHED;
            PG8_STAGE(PG8_SB(1, 1), b3 + hstep, voffB);
            PG8_WAIT_V(6); PG8_BAR; PG8_MMA(1, 1, At, B1); PG8_BAR;
            }
        }
        if constexpr (ALIGN_EPI) { if (wr == 0) PG8_BAR; }
        if constexpr (!Epi::AFTER_DRAIN) { E(acc, cur, wr, wc, fr, fq); S.done(cur); }
        if (!has_next) break;
#pragma unroll
        for (int a = 0; a < 2; ++a)
#pragma unroll
            for (int b = 0; b < 2; ++b)
#pragma unroll
                for (int m = 0; m < 4; ++m)
#pragma unroll
                    for (int n = 0; n < 2; ++n) acc[a][b][m][n] = (f32x4){0.f, 0.f, 0.f, 0.f};
        cur = nxt; cA = nA; cB = nB; ++ui;
        if constexpr (ALIGN_EPI) { if (wr == 1) PG8_BAR; }
    }
    PG8_WAIT_V(0);
    if constexpr (!ALIGN_EPI) { if (wr == 0) PG8_BAR; }
    PG8_BAR;
    if constexpr (Epi::AFTER_DRAIN) { E.fused(acc, cur, wr, wc, fr, fq, lds, wid, lane); S.done(cur); }
#undef PG8_SA
#undef PG8_SB
#undef PG8_STAGE
#undef PG8_LDA
#undef PG8_LDB
#undef PG8_MMA
#undef PG8_WAIT_V
#undef PG8_WAIT_L
#undef PG8_BAR
#undef PG8_SCHED
}
}

namespace nsa {
#define NLAS __attribute__((address_space(3)))
typedef short bf16x8 __attribute__((ext_vector_type(8)));
typedef short s16x4 __attribute__((ext_vector_type(4)));
typedef short v4i16_t __attribute__((ext_vector_type(4)));
typedef float f32x4 __attribute__((ext_vector_type(4)));
typedef unsigned u32x4 __attribute__((ext_vector_type(4)));
typedef unsigned u32x2 __attribute__((ext_vector_type(2)));
typedef unsigned long long u64;
constexpr int RS = 144, TILE_B = 64 * RS;
constexpr float LOG2E = 1.4426950408889634f;
constexpr int L_KB0 = 0, L_VB0 = TILE_B, L_KB1 = 2 * TILE_B, L_VB1 = 3 * TILE_B, L_CK = 4 * TILE_B, L_CV = 8 * TILE_B, L_IMP = 12 * TILE_B, L_MSK = L_IMP + 8192, L_WU = L_MSK + 256, L_END = L_WU + 64;
static_assert(L_END <= 131072, "nsa LDS map");
__device__ __forceinline__ s16x4 vtr(const NLAS char* p) { return __builtin_bit_cast(s16x4, __builtin_amdgcn_ds_read_tr16_b64_v4i16((NLAS v4i16_t*)p)); }
__device__ __forceinline__ f32x4 mfma16(bf16x8 a, bf16x8 b, f32x4 c) { return __builtin_amdgcn_mfma_f32_16x16x32_bf16(a, b, c, 0, 0, 0); }
__device__ __forceinline__ unsigned pkbf(float lo, float hi) { return pg8::cvt_pk_bf16(lo, hi); }
__device__ __forceinline__ void qk_tile(f32x4 (&s)[4], const NLAS char* Kb, const bf16x8 (&qf)[2], int i, int g, float kslope, float bt) {
    bf16x8 a[4][2]; const NLAS char* kp = Kb + i * RS + 16 * g;
#pragma unroll
    for (int kb = 0; kb < 4; ++kb) { a[kb][0] = *(const NLAS bf16x8*)(kp + kb * 16 * RS); a[kb][1] = *(const NLAS bf16x8*)(kp + kb * 16 * RS + 64); }
#pragma unroll
    for (int kb = 0; kb < 4; ++kb) { f32x4 ci; ci[0] = fmaf(kslope, (float)(kb * 16 + 0), bt); ci[1] = fmaf(kslope, (float)(kb * 16 + 1), bt); ci[2] = fmaf(kslope, (float)(kb * 16 + 2), bt); ci[3] = fmaf(kslope, (float)(kb * 16 + 3), bt);
        s[kb] = mfma16(a[kb][0], qf[0], ci); }
#pragma unroll
    for (int kb = 0; kb < 4; ++kb) s[kb] = mfma16(a[kb][1], qf[1], s[kb]);
}
__device__ __forceinline__ void pv_tile(f32x4 (&o)[4], const NLAS char* Vb, const f32x4 (&p)[4], int i, int g) {
    const NLAS char* vb = Vb + (4 * g + (i >> 2)) * RS + (i & 3) * 8;
    s16x4 lo[2][4], hi[2][4];
#pragma unroll
    for (int kk = 0; kk < 2; ++kk)
#pragma unroll
        for (int db = 0; db < 4; ++db) { const NLAS char* vp = vb + (2 * kk) * 16 * RS + db * 32; lo[kk][db] = vtr(vp); hi[kk][db] = vtr(vp + 16 * RS); }
    bf16x8 pf[2];
#pragma unroll
    for (int kk = 0; kk < 2; ++kk) { u32x4 pw; pw.x = pkbf(p[2 * kk][0], p[2 * kk][1]); pw.y = pkbf(p[2 * kk][2], p[2 * kk][3]); pw.z = pkbf(p[2 * kk + 1][0], p[2 * kk + 1][1]); pw.w = pkbf(p[2 * kk + 1][2], p[2 * kk + 1][3]);
        pf[kk] = __builtin_bit_cast(bf16x8, pw); }
#pragma unroll
    for (int kk = 0; kk < 2; ++kk)
#pragma unroll
        for (int db = 0; db < 4; ++db) o[db] = mfma16((bf16x8){lo[kk][db][0], lo[kk][db][1], lo[kk][db][2], lo[kk][db][3], hi[kk][db][0], hi[kk][db][1], hi[kk][db][2], hi[kk][db][3]}, pf[kk], o[db]);
}
constexpr float THR = 6.0f;
template <bool FIRST>
__device__ __forceinline__ void online_tile(f32x4 (&s)[4], float& m, float& l, f32x4 (&o)[4], bool needmask, int base, int lo, int hi) {
    if (needmask) {
#pragma unroll
        for (int kb = 0; kb < 4; ++kb)
#pragma unroll
            for (int r = 0; r < 4; ++r) { const int pos = base + kb * 16 + r; s[kb][r] = (pos >= lo && pos <= hi) ? s[kb][r] : -INFINITY; } }
    float mt = fmaxf(fmaxf(fmaxf(s[0][0], s[0][1]), fmaxf(s[0][2], s[0][3])), fmaxf(fmaxf(s[1][0], s[1][1]), fmaxf(s[1][2], s[1][3])));
    mt = fmaxf(mt, fmaxf(fmaxf(fmaxf(s[2][0], s[2][1]), fmaxf(s[2][2], s[2][3])), fmaxf(fmaxf(s[3][0], s[3][1]), fmaxf(s[3][2], s[3][3]))));
    if (FIRST || __any(mt > THR)) {
        mt = fmaxf(mt, __shfl_xor(mt, 16)); mt = fmaxf(mt, __shfl_xor(mt, 32));
        const float d = FIRST ? mt : fmaxf(mt, 0.f), f = __builtin_amdgcn_exp2f(-d); m += d; l *= f;
#pragma unroll
        for (int db = 0; db < 4; ++db) o[db] = o[db] * f;
#pragma unroll
        for (int kb = 0; kb < 4; ++kb) s[kb] = s[kb] - d; }
    float sum = 0.f;
#pragma unroll
    for (int kb = 0; kb < 4; ++kb)
#pragma unroll
        for (int r = 0; r < 4; ++r) { const float p = __builtin_amdgcn_exp2f(s[kb][r]); s[kb][r] = p; sum += p; }
    l += sum;
}
struct Stg { u32x4 k, v; };
__device__ __forceinline__ void stg_load(Stg& r, const bf16_t* kb, const bf16_t* vb, size_t pitch, int tid) { const size_t off = (size_t)(tid >> 3) * pitch + (tid & 7) * 8; r.k = *(const u32x4*)(kb + off); r.v = *(const u32x4*)(vb + off); }
__device__ __forceinline__ void stg_store(NLAS char* lds, int ko, int vo, const Stg& r, int tid) { const int off = (tid >> 3) * RS + (tid & 7) * 16; *(NLAS u32x4*)(lds + ko + off) = r.k; *(NLAS u32x4*)(lds + vo + off) = r.v; }
__device__ __forceinline__ float sigm(float v) { return __builtin_amdgcn_rcpf(1.f + __expf(-v)); }

__device__ __forceinline__ void unit(NLAS char* lds, const bf16_t* P, const float* S32, const bf16_t* KC, const bf16_t* VC, bf16_t* Ynsa, int b, int gq, int ti) {
    const int tid = threadIdx.x, lane = tid & 63, w = __builtin_amdgcn_readfirstlane(tid >> 6), i = lane & 15, g = lane >> 4;
    const int t0 = ti * 32, tl_mine = i >> 2, r = i & 3, h = gq * 4 + r, t = t0 + 4 * w + tl_mine; const size_t m = (size_t)b * T + t;
    const float slope2 = __builtin_amdgcn_exp2f(-(float)(h + 1)) * LOG2E;
    bf16x8 qf[2]; constexpr float QS = 0.125f * LOG2E;
    { const bf16_t* qp = P + m * PW + P_NSQ + h * 64 + 8 * g;
#pragma unroll
      for (int ks = 0; ks < 2; ++ks) { const u32x4 raw = *(const u32x4*)(qp + 32 * ks); u32x4 sc;
          sc.x = pkbf(pg8::bflo(raw.x) * QS, pg8::bfhi(raw.x) * QS); sc.y = pkbf(pg8::bflo(raw.y) * QS, pg8::bfhi(raw.y) * QS);
          sc.z = pkbf(pg8::bflo(raw.z) * QS, pg8::bfhi(raw.z) * QS); sc.w = pkbf(pg8::bflo(raw.w) * QS, pg8::bfhi(raw.w) * QS);
          qf[ks] = __builtin_bit_cast(bf16x8, sc); } }
    const float* gp = S32 + m * 32 + 8 + h * 3;
    const float gate0 = sigm(gp[0]), gate1 = sigm(gp[1]), gate2 = sigm(gp[2]);
    f32x4 outacc[4];
#pragma unroll
    for (int db = 0; db < 4; ++db) outacc[db] = (f32x4){0.f, 0.f, 0.f, 0.f};
    const int ntc = (ti >> 5) + 1;
    for (int tile = 0; tile < ntc; ++tile) { Stg sr; const size_t row0 = ((size_t)(b * 256 + tile * 64) * 2 + gq) * 64; stg_load(sr, KC + row0, VC + row0, 128, tid); stg_store(lds, L_CK + tile * TILE_B, L_CV + tile * TILE_B, sr, tid); }
    __syncthreads();
    { const int nmax = (t - 31) >> 4; const float kslope = 16.f * slope2, c = -slope2 * (float)(t - 31);
      float mc = -INFINITY, lc = 0.f;
#pragma unroll 1
      for (int tile = 0; tile < ntc; ++tile) { f32x4 s[4]; qk_tile(s, lds + L_CK + tile * TILE_B, qf, i, g, kslope, fmaf(kslope, (float)(tile * 64 + 4 * g), c));
          float mt = -INFINITY;
#pragma unroll
          for (int kb = 0; kb < 4; ++kb)
#pragma unroll
              for (int rr = 0; rr < 4; ++rr) { const int n = tile * 64 + kb * 16 + 4 * g + rr; const float v = (n <= nmax) ? s[kb][rr] : -INFINITY; s[kb][rr] = v; mt = fmaxf(mt, v); }
          mt = fmaxf(mt, __shfl_xor(mt, 16)); mt = fmaxf(mt, __shfl_xor(mt, 32));
          const float mn = fmaxf(mc, mt), ms = (mn == -INFINITY) ? 0.f : mn; float sum = 0.f;
#pragma unroll
          for (int kb = 0; kb < 4; ++kb)
#pragma unroll
              for (int rr = 0; rr < 4; ++rr) sum += __builtin_amdgcn_exp2f(s[kb][rr] - ms);
          lc = lc * __builtin_amdgcn_exp2f(mc - ms) + sum; mc = mn; }
      lc += __shfl_xor(lc, 16); lc += __shfl_xor(lc, 32);
      const float ms = (mc == -INFINITY) ? 0.f : mc, inv = lc > 0.f ? 1.f / lc : 0.f;
      f32x4 oc[4];
#pragma unroll
      for (int db = 0; db < 4; ++db) oc[db] = (f32x4){0.f, 0.f, 0.f, 0.f};
      NLAS float* imp_s = (NLAS float*)(lds + L_IMP) + (w * 4 + tl_mine) * 64;
      float cprev = 0.f;
#pragma unroll 1
      for (int tile = 0; tile < 4; ++tile) {
          if (tile < ntc) { f32x4 s[4]; qk_tile(s, lds + L_CK + tile * TILE_B, qf, i, g, kslope, fmaf(kslope, (float)(tile * 64 + 4 * g), c));
#pragma unroll
              for (int kb = 0; kb < 4; ++kb)
#pragma unroll
                  for (int rr = 0; rr < 4; ++rr) { const int n = tile * 64 + kb * 16 + 4 * g + rr; const float v = (n <= nmax) ? s[kb][rr] : -INFINITY; s[kb][rr] = __builtin_amdgcn_exp2f(v - ms) * inv; }
              pv_tile(oc, lds + L_CV + tile * TILE_B, s, i, g);
#pragma unroll
              for (int kb = 0; kb < 4; ++kb) { const f32x4 pv = s[kb];
                  float a = (pv[0] + pv[1]) + (pv[2] + pv[3]), cc = pv[3];
                  a += __shfl_xor(a, 1); a += __shfl_xor(a, 2); cc += __shfl_xor(cc, 1); cc += __shfl_xor(cc, 2);
                  const float up = __shfl(cc, (lane + 48) & 63);
                  const float im = a + (g > 0 ? up : cprev); cprev = up;
                  if (r == 0) imp_s[4 * (tile * 4 + kb) + g] = im; }
          } else { if (r == 0) {
#pragma unroll
              for (int kb = 0; kb < 4; ++kb) imp_s[4 * (tile * 4 + kb) + g] = 0.f; } }
      }
#pragma unroll
      for (int db = 0; db < 4; ++db) outacc[db] = outacc[db] + oc[db] * gate0;
    }
    __syncthreads();
    NLAS float* impw = (NLAS float*)(lds + L_IMP) + w * 256;
    float myscore[4];
#pragma unroll
    for (int tl = 0; tl < 4; ++tl) { const int tt = t0 + 4 * w + tl, cur = tt >> 6, j = lane; const bool valid = j <= cur, forced = (j == 0) || (j == cur) || (j == cur - 1);
        const float s = valid ? impw[tl * 64 + j] + (forced ? 1000.f : 0.f) : -1e30f; myscore[tl] = s; }
    __syncthreads();
#pragma unroll
    for (int tl = 0; tl < 4; ++tl) impw[tl * 64 + lane] = myscore[tl];
    __syncthreads();
    u64 wmask[4], wun = 0ull;
#pragma unroll
    for (int tl = 0; tl < 4; ++tl) { const int tt = t0 + 4 * w + tl, cur = tt >> 6; const float s = myscore[tl]; int rank = 0;
        for (int jj = 0; jj < 64; ++jj) { const float o = impw[tl * 64 + jj]; rank += (o > s || (o == s && jj < lane)) ? 1 : 0; }
        wmask[tl] = __ballot(rank < 16 && lane <= cur); wun |= wmask[tl]; }
    if (lane == 0) { NLAS u64* mk = (NLAS u64*)(lds + L_MSK) + w * 4; mk[0] = wmask[0]; mk[1] = wmask[1]; mk[2] = wmask[2]; mk[3] = wmask[3]; ((NLAS u64*)(lds + L_WU))[w] = wun; }
    __syncthreads();
    const u64 mymask = ((const NLAS u64*)(lds + L_MSK))[w * 4 + tl_mine];
    u64 uall = 0ull;
#pragma unroll
    for (int ww = 0; ww < 8; ++ww) uall |= ((const NLAS u64*)(lds + L_WU))[ww];
    uall = ((u64)__builtin_amdgcn_readfirstlane((unsigned)(uall >> 32)) << 32) | (u64)__builtin_amdgcn_readfirstlane((unsigned)uall);
    const size_t rowb = (size_t)b * T;
    {
        float ms_ = 0.f, ls = 0.f; f32x4 os[4];
#pragma unroll
        for (int db = 0; db < 4; ++db) os[db] = (f32x4){0.f, 0.f, 0.f, 0.f};
        const bf16_t* kcol = P + rowb * PW + P_KS + gq * 64; const bf16_t* vcol = P + rowb * PW + P_VS + gq * 64;
        const float c = -slope2 * (float)t;
        const int jcur = t0 >> 6;
        const u64 wall = ((const NLAS u64*)(lds + L_MSK))[w * 4 + 0] & ((const NLAS u64*)(lds + L_MSK))[w * 4 + 1] & ((const NLAS u64*)(lds + L_MSK))[w * 4 + 2] & ((const NLAS u64*)(lds + L_MSK))[w * 4 + 3];
        const u64 wallu = ((u64)__builtin_amdgcn_readfirstlane((unsigned)(wall >> 32)) << 32) | (u64)__builtin_amdgcn_readfirstlane((unsigned)wall);
        u64 rem = uall & ((1ull << jcur) - 1ull); int j = jcur; int cur = 0; bool first = true;
        Stg sr; stg_load(sr, kcol + (size_t)j * 64 * PW, vcol + (size_t)j * 64 * PW, PW, tid); stg_store(lds, L_KB0, L_VB0, sr, tid);
        int jn = rem ? 63 - __builtin_clzll(rem) : -1; if (jn >= 0) rem &= ~(1ull << jn);
        if (jn >= 0) stg_load(sr, kcol + (size_t)jn * 64 * PW, vcol + (size_t)jn * 64 * PW, PW, tid);
        __syncthreads();
        for (;;) {
            const int jnn = (jn >= 0 && rem) ? 63 - __builtin_clzll(rem) : -1; if (jnn >= 0) rem &= ~(1ull << jnn);
            if (jn >= 0) stg_store(lds, cur ? L_KB0 : L_KB1, cur ? L_VB0 : L_VB1, sr, tid);
            if (jnn >= 0) stg_load(sr, kcol + (size_t)jnn * 64 * PW, vcol + (size_t)jnn * 64 * PW, PW, tid);
            if ((wun >> j) & 1ull) { f32x4 s[4];
                const float bt = fmaf(slope2, (float)(j * 64 + 4 * g), c) - ms_ + (((mymask >> j) & 1ull) ? 0.f : -1e30f);
                qk_tile(s, lds + (cur ? L_KB1 : L_KB0), qf, i, g, slope2, bt);
                if (first) online_tile<true>(s, ms_, ls, os, true, j * 64 + 4 * g, 0, t); else online_tile<false>(s, ms_, ls, os, false, 0, 0, 0);
                pv_tile(os, lds + (cur ? L_VB1 : L_VB0), s, i, g); }
            first = false;
            __syncthreads();
            if (jn < 0) break;
            j = jn; jn = jnn; cur ^= 1;
        }
        ls += __shfl_xor(ls, 16); ls += __shfl_xor(ls, 32);
        const float sc1 = gate1 / ls;
#pragma unroll
        for (int db = 0; db < 4; ++db) outacc[db] = outacc[db] + os[db] * sc1;
    }
    {
        float mw = 0.f, lw = 0.f; f32x4 ow[4];
#pragma unroll
        for (int db = 0; db < 4; ++db) ow[db] = (f32x4){0.f, 0.f, 0.f, 0.f};
        const bf16_t* kcol = P + rowb * PW + P_KW + gq * 64; const bf16_t* vcol = P + rowb * PW + P_VW + gq * 64;
        const float c = -slope2 * (float)t;
        const int j0 = (t0 - 511) > 0 ? ((t0 - 511) >> 6) : 0, j1 = t0 >> 6, tw0 = t0 + 4 * w;
        int j = j1, cur = 0; bool first = true;
        Stg sr; stg_load(sr, kcol + (size_t)j * 64 * PW, vcol + (size_t)j * 64 * PW, PW, tid); stg_store(lds, L_KB0, L_VB0, sr, tid);
        if (j > j0) stg_load(sr, kcol + (size_t)(j - 1) * 64 * PW, vcol + (size_t)(j - 1) * 64 * PW, PW, tid);
        __syncthreads();
        for (;;) {
            if (j > j0) stg_store(lds, cur ? L_KB0 : L_KB1, cur ? L_VB0 : L_VB1, sr, tid);
            if (j - 1 > j0) stg_load(sr, kcol + (size_t)(j - 2) * 64 * PW, vcol + (size_t)(j - 2) * 64 * PW, PW, tid);
            if (64 * j <= tw0 + 3 && 64 * j + 63 >= tw0 - 511) { f32x4 s[4];
                qk_tile(s, lds + (cur ? L_KB1 : L_KB0), qf, i, g, slope2, fmaf(slope2, (float)(j * 64 + 4 * g), c) - mw);
                const bool needmask = first || (64 * j < tw0 + 3 - 511);
                if (first) online_tile<true>(s, mw, lw, ow, true, j * 64 + 4 * g, t - 511, t); else online_tile<false>(s, mw, lw, ow, needmask, j * 64 + 4 * g, t - 511, t);
                pv_tile(ow, lds + (cur ? L_VB1 : L_VB0), s, i, g); }
            first = false;
            __syncthreads();
            if (j <= j0) break;
            --j; cur ^= 1;
        }
        lw += __shfl_xor(lw, 16); lw += __shfl_xor(lw, 32);
        const float sc2 = gate2 / lw;
#pragma unroll
        for (int db = 0; db < 4; ++db) outacc[db] = outacc[db] + ow[db] * sc2;
    }
    bf16_t* yo = Ynsa + m * 512 + h * 64 + 4 * g;
#pragma unroll
    for (int db = 0; db < 4; ++db) { u32x2 v; v.x = pkbf(outacc[db][0], outacc[db][1]); v.y = pkbf(outacc[db][2], outacc[db][3]); *(u32x2*)(yo + db * 16) = v; }
}
__device__ __forceinline__ void phase(NLAS char* lds, const bf16_t* P, const float* S32, const bf16_t* KC, const bf16_t* VC, bf16_t* Ynsa) {
    const int G = gridDim.x, bid = blockIdx.x;
    if (G == 256) { const int base = bid >> 3, bg = bid & 7;
#pragma unroll 1
        for (int k = 0; k < 4; ++k) { const int ti = (k == 0) ? 127 - base : (k == 1) ? 64 + base : (k == 2) ? 63 - base : base; unit(lds, P, S32, KC, VC, Ynsa, bg >> 1, bg & 1, ti); } }
    else {
#pragma unroll 1
        for (int u = bid; u < 1024; u += G) unit(lds, P, S32, KC, VC, Ynsa, (u & 7) >> 1, u & 1, 127 - (u >> 3)); }
}
}

namespace xa {
using nsa::bf16x8; using nsa::s16x4; using nsa::f32x4; using nsa::u32x4; using nsa::u32x2; using nsa::vtr; using nsa::mfma16; using nsa::pkbf;
constexpr int RS = 272, TILE_B = 64 * RS;
__device__ __forceinline__ int l_k(int tile) { return tile * 2 * TILE_B; }
__device__ __forceinline__ int l_v(int tile) { return tile * 2 * TILE_B + TILE_B; }
__device__ __forceinline__ void unit(NLAS char* lds, const bf16_t* P, const bf16_t* MEMKV, bf16_t* Yxa, int b, int h, int tt) {
    const int tid = threadIdx.x, lane = tid & 63, w = __builtin_amdgcn_readfirstlane(tid >> 6), i = lane & 15, g = lane >> 4;
    const size_t m = (size_t)b * T + tt * 128 + 16 * w + i;
    const bf16_t* kbase = MEMKV + (size_t)b * 256 * 1024 + h * 128;
    { u32x4 st[4][4]; const bf16_t* p0 = kbase + (size_t)(tid >> 3) * 1024 + (tid & 7) * 8;
#pragma unroll
      for (int tile = 0; tile < 4; ++tile) { const bf16_t* p = p0 + (size_t)tile * 64 * 1024; st[tile][0] = *(const u32x4*)p; st[tile][1] = *(const u32x4*)(p + 64); st[tile][2] = *(const u32x4*)(p + 512); st[tile][3] = *(const u32x4*)(p + 576); }
      const int off = (tid >> 3) * RS + (tid & 7) * 16;
#pragma unroll
      for (int tile = 0; tile < 4; ++tile) { *(NLAS u32x4*)(lds + l_k(tile) + off) = st[tile][0]; *(NLAS u32x4*)(lds + l_k(tile) + off + 128) = st[tile][1]; *(NLAS u32x4*)(lds + l_v(tile) + off) = st[tile][2]; *(NLAS u32x4*)(lds + l_v(tile) + off + 128) = st[tile][3]; } }
    bf16x8 qf[4];
    { const bf16_t* qp = P + m * PW + P_XAQ + h * 128 + 8 * g;
#pragma unroll
      for (int ks = 0; ks < 4; ++ks) qf[ks] = *(const bf16x8*)(qp + 32 * ks); }
    const float scale2 = 0.08838834764831845f * nsa::LOG2E;
    float mx = -INFINITY, l = 0.f; f32x4 o[8];
#pragma unroll
    for (int db = 0; db < 8; ++db) o[db] = (f32x4){0.f, 0.f, 0.f, 0.f};
    __syncthreads();
#pragma unroll 1
    for (int tile = 0; tile < 4; ++tile) {
        const NLAS char* Kb = lds + l_k(tile); const NLAS char* Vb = lds + l_v(tile);
        f32x4 s[4];
        { bf16x8 a[4][4];
#pragma unroll
          for (int kb = 0; kb < 4; ++kb)
#pragma unroll
              for (int ks = 0; ks < 4; ++ks) a[kb][ks] = *(const NLAS bf16x8*)(Kb + (kb * 16 + i) * RS + 16 * g + 64 * ks);
#pragma unroll
          for (int kb = 0; kb < 4; ++kb) s[kb] = mfma16(a[kb][0], qf[0], (f32x4){0.f, 0.f, 0.f, 0.f});
#pragma unroll
          for (int ks = 1; ks < 4; ++ks)
#pragma unroll
              for (int kb = 0; kb < 4; ++kb) s[kb] = mfma16(a[kb][ks], qf[ks], s[kb]); }
        float mt = -INFINITY;
#pragma unroll
        for (int kb = 0; kb < 4; ++kb)
#pragma unroll
            for (int r = 0; r < 4; ++r) { const float v = s[kb][r] * scale2; s[kb][r] = v; mt = fmaxf(mt, v); }
        mt = fmaxf(mt, __shfl_xor(mt, 16)); mt = fmaxf(mt, __shfl_xor(mt, 32));
        const float mn = fmaxf(mx, mt), alpha = __builtin_amdgcn_exp2f(mx - mn); float sum = 0.f;
#pragma unroll
        for (int kb = 0; kb < 4; ++kb)
#pragma unroll
            for (int r = 0; r < 4; ++r) { const float p = __builtin_amdgcn_exp2f(s[kb][r] - mn); s[kb][r] = p; sum += p; }
        l = l * alpha + sum; mx = mn;
#pragma unroll
        for (int db = 0; db < 8; ++db) o[db] = o[db] * alpha;
        const NLAS char* vb = Vb + (4 * g + (i >> 2)) * RS + (i & 3) * 8;
#pragma unroll
        for (int kk = 0; kk < 2; ++kk) {
            u32x4 pw; pw.x = pkbf(s[2 * kk][0], s[2 * kk][1]); pw.y = pkbf(s[2 * kk][2], s[2 * kk][3]); pw.z = pkbf(s[2 * kk + 1][0], s[2 * kk + 1][1]); pw.w = pkbf(s[2 * kk + 1][2], s[2 * kk + 1][3]);
            const bf16x8 pf = __builtin_bit_cast(bf16x8, pw);
            s16x4 lo[8], hi[8];
#pragma unroll
            for (int db = 0; db < 8; ++db) { const NLAS char* vp = vb + (2 * kk) * 16 * RS + db * 32; lo[db] = vtr(vp); hi[db] = vtr(vp + 16 * RS); }
#pragma unroll
            for (int db = 0; db < 8; ++db) o[db] = mfma16((bf16x8){lo[db][0], lo[db][1], lo[db][2], lo[db][3], hi[db][0], hi[db][1], hi[db][2], hi[db][3]}, pf, o[db]);
        }
    }
    l += __shfl_xor(l, 16); l += __shfl_xor(l, 32);
    const float inv = 1.f / l;
    bf16_t* yo = Yxa + m * 512 + h * 128 + 4 * g;
#pragma unroll
    for (int db = 0; db < 8; ++db) { u32x2 v; v.x = pkbf(o[db][0] * inv, o[db][1] * inv); v.y = pkbf(o[db][2] * inv, o[db][3] * inv); *(u32x2*)(yo + db * 16) = v; }
    __syncthreads();
}
__device__ __forceinline__ void memkv_tile(const bf16_t* MEMN, const bf16_t* Wmkv, bf16_t* MEMKV, int tile) {
    const int tid = threadIdx.x, lane = tid & 63, w = __builtin_amdgcn_readfirstlane(tid >> 6), i = lane & 15, g = lane >> 4;
    const int r0 = (tile >> 4) * 64 + (w >> 1) * 16, c0 = (tile & 15) * 64 + (w & 1) * 32;
    const bf16_t* ap = MEMN + (size_t)(r0 + i) * 1024 + 8 * g; const bf16_t* bp = Wmkv + (size_t)(c0 + i) * 1024 + 8 * g;
    f32x4 acc0 = (f32x4){0.f, 0.f, 0.f, 0.f}, acc1 = acc0;
#pragma unroll 1
    for (int k0 = 0; k0 < 32; k0 += 8) { bf16x8 a[8], b0[8], b1[8];
#pragma unroll
        for (int kk = 0; kk < 8; ++kk) { a[kk] = *(const bf16x8*)(ap + 32 * (k0 + kk)); b0[kk] = *(const bf16x8*)(bp + 32 * (k0 + kk)); b1[kk] = *(const bf16x8*)(bp + 16 * 1024 + 32 * (k0 + kk)); }
#pragma unroll
        for (int kk = 0; kk < 8; ++kk) { acc0 = mfma16(a[kk], b0[kk], acc0); acc1 = mfma16(a[kk], b1[kk], acc1); } }
#pragma unroll
    for (int r = 0; r < 4; ++r) { bf16_t* o = MEMKV + (size_t)(r0 + 4 * g + r) * 1024 + c0 + i; o[0] = f2bf(acc0[r]); o[16] = f2bf(acc1[r]); }
}
__device__ __forceinline__ void phase(NLAS char* lds, const bf16_t* P, const bf16_t* MEMKV, bf16_t* Yxa) {
#pragma unroll 1
    for (int u = blockIdx.x; u < 512; u += gridDim.x) unit(lds, P, MEMKV, Yxa, u >> 7, (u >> 5) & 3, u & 31);
}
}

namespace ml {
using nsa::bf16x8; using nsa::s16x4; using nsa::f32x4; using nsa::u32x4; using nsa::u32x2; using nsa::vtr; using nsa::mfma16; using nsa::pkbf;
constexpr int RS = 272, TB = 64 * RS, RSS = 144;
constexpr float KSCALE = 0.08838834764831845f;
__device__ __forceinline__ float scan_add(float v, int lane) {
#pragma unroll
    for (int o = 1; o < 64; o <<= 1) { const float u = __shfl_up(v, o); if (lane >= o) v += u; }
    return v; }
__device__ __forceinline__ float scan_max(float v, int lane) {
#pragma unroll
    for (int o = 1; o < 64; o <<= 1) { const float u = __shfl_up(v, o); if (lane >= o) v = fmaxf(v, u); }
    return v; }
__device__ __forceinline__ bf16x8 trpair(const NLAS char* p, int hi_off) { const s16x4 lo = vtr(p), hi = vtr(p + hi_off); return (bf16x8){lo[0], lo[1], lo[2], lo[3], hi[0], hi[1], hi[2], hi[3]}; }
__device__ __forceinline__ void load_conv(NLAS char* dst, const bf16_t* P, const float* cw, int colP, int cwc, size_t m0, int tseq0, int tid) {
    const int s = tid >> 3, c16 = (tid & 7) * 16;
#pragma unroll
    for (int half = 0; half < 2; ++half) { const int c = c16 + half * 8; float acc[8];
#pragma unroll
        for (int e = 0; e < 8; ++e) acc[e] = 0.f;
#pragma unroll
        for (int j = 0; j < 4; ++j) { if (tseq0 + s - j >= 0) { const u32x4 raw = *(const u32x4*)(P + (m0 + s - j) * PW + colP + c);
            const f32x4 w0 = *(const f32x4*)(cw + j * 1024 + cwc + c), w1 = *(const f32x4*)(cw + j * 1024 + cwc + c + 4);
            acc[0] += w0[0] * pg8::bflo(raw.x); acc[1] += w0[1] * pg8::bfhi(raw.x); acc[2] += w0[2] * pg8::bflo(raw.y); acc[3] += w0[3] * pg8::bfhi(raw.y);
            acc[4] += w1[0] * pg8::bflo(raw.z); acc[5] += w1[1] * pg8::bfhi(raw.z); acc[6] += w1[2] * pg8::bflo(raw.w); acc[7] += w1[3] * pg8::bfhi(raw.w); } }
#pragma unroll
        for (int e = 0; e < 8; ++e) acc[e] = acc[e] * __builtin_amdgcn_rcpf(1.f + __expf(-acc[e]));
        u32x4 o; o.x = pkbf(acc[0], acc[1]); o.y = pkbf(acc[2], acc[3]); o.z = pkbf(acc[4], acc[5]); o.w = pkbf(acc[6], acc[7]);
        *(NLAS u32x4*)(dst + s * RS + c * 2) = o; }
}
__device__ __forceinline__ void m1_unit(NLAS char* lds, const bf16_t* P, const float* cw, const float* S32, bf16_t* Abuf, float* NA, float* Gc, float* Mloc, int ci) {
    constexpr int L_K = 0, L_EV = TB, L_E = 2 * TB;
    const int tid = threadIdx.x, lane = tid & 63, w = __builtin_amdgcn_readfirstlane(tid >> 6), i = lane & 15, g = lane >> 4;
    const int c = ci & 63, bh = ci >> 6, h = bh & 3, b = bh >> 2; const size_t m0 = (size_t)b * T + c * 64;
    NLAS float* eS = (NLAS float*)(lds + L_E);
    if (w == 0) { const float fpre = S32[(m0 + lane) * 32 + 4 + h], ipre = S32[(m0 + lane) * 32 + h];
        const float bcs = scan_add(logsig(fpre), lane), gtot = __shfl(bcs, 63), wend = gtot - bcs + ipre, mloc = wave_max(wend);
        eS[lane] = __expf(wend - mloc) * KSCALE; if (lane == 0) { Gc[ci] = gtot; Mloc[ci] = mloc; } }
    load_conv(lds + L_K, P, cw, P_MLK + h * 128, 512 + h * 128, m0, c * 64, tid);
    __syncthreads();
    { const int s = tid >> 3, c16 = (tid & 7) * 16; const float es = eS[s]; const bf16_t* vp = P + (m0 + s) * PW + P_MLV + h * 128 + c16;
#pragma unroll
      for (int half = 0; half < 2; ++half) { const u32x4 raw = *(const u32x4*)(vp + half * 8); u32x4 o;
          o.x = pkbf(pg8::bflo(raw.x) * es, pg8::bfhi(raw.x) * es); o.y = pkbf(pg8::bflo(raw.y) * es, pg8::bfhi(raw.y) * es);
          o.z = pkbf(pg8::bflo(raw.z) * es, pg8::bfhi(raw.z) * es); o.w = pkbf(pg8::bflo(raw.w) * es, pg8::bfhi(raw.w) * es);
          *(NLAS u32x4*)(lds + L_EV + s * RS + (c16 + half * 8) * 2) = o; } }
    __syncthreads();
    f32x4 acc[8];
#pragma unroll
    for (int vb = 0; vb < 8; ++vb) acc[vb] = (f32x4){0.f, 0.f, 0.f, 0.f};
    const int rowoff = (4 * g + (i >> 2)) * RS + (i & 3) * 8;
#pragma unroll
    for (int kk = 0; kk < 2; ++kk) { const bf16x8 kf = trpair(lds + L_K + kk * 32 * RS + rowoff + w * 32, 16 * RS);
#pragma unroll
        for (int vb = 0; vb < 8; ++vb) acc[vb] = mfma16(trpair(lds + L_EV + kk * 32 * RS + rowoff + vb * 32, 16 * RS), kf, acc[vb]); }
    bf16_t* ap = Abuf + ((size_t)ci * 128 + w * 16 + i) * 128 + 4 * g;
#pragma unroll
    for (int vb = 0; vb < 8; ++vb) { u32x2 pk; pk.x = pkbf(acc[vb][0], acc[vb][1]); pk.y = pkbf(acc[vb][2], acc[vb][3]); *(u32x2*)(ap + vb * 16) = pk; }
    { const int k = tid >> 2, part = tid & 3; float n = 0.f;
#pragma unroll
      for (int s = 0; s < 16; ++s) n += eS[part * 16 + s] * bf2f(*(const NLAS bf16_t*)(lds + L_K + (part * 16 + s) * RS + k * 2));
      n += __shfl_xor(n, 1); n += __shfl_xor(n, 2); if (part == 0) NA[(size_t)ci * 128 + k] = n; }
    __syncthreads();
}
__device__ __forceinline__ void m2_items(bf16_t* Abuf, float* NA, const float* Gc, const float* Mloc, float* Mprev) {
    for (int it = blockIdx.x * blockDim.x + threadIdx.x; it < 16 * 128 * 64; it += gridDim.x * blockDim.x) {
        const int bh = it >> 13, kv2 = it & 8191, k = kv2 >> 6, v2 = kv2 & 63;
        float C0 = 0.f, C1 = 0.f, n = 0.f, m = 0.f;
        unsigned* base = (unsigned*)(Abuf + ((size_t)(bh * 64) * 128 + k) * 128 + v2 * 2);
#pragma unroll 1
        for (int c0 = 0; c0 < 64; c0 += 16) { unsigned A[16];
#pragma unroll
            for (int u = 0; u < 16; ++u) A[u] = base[(size_t)(c0 + u) * 8192];
#pragma unroll
            for (int u = 0; u < 16; ++u) { const int ci = bh * 64 + c0 + u; const float gg = Gc[ci], ml = Mloc[ci];
                const float mn = fmaxf(gg + m, ml), a = __expf(gg + m - mn), bb = __expf(ml - mn);
                base[(size_t)(c0 + u) * 8192] = pkbf(C0, C1); C0 = C0 * a + pg8::bflo(A[u]) * bb; C1 = C1 * a + pg8::bfhi(A[u]) * bb;
                if (v2 == 0) { const float nA = NA[(size_t)ci * 128 + k]; NA[(size_t)ci * 128 + k] = n; n = a * n + bb * nA; }
                if (kv2 == 0) Mprev[ci] = m;
                m = mn; } }
    }
}
__device__ __forceinline__ void m3_unit(NLAS char* lds, const bf16_t* P, const float* cw, const float* S32, const bf16_t* Cprev, const float* Nprev, const float* Mprev, const float* normg, bf16_t* Yml, int ci) {
    constexpr int L_Q = 0, L_K = TB, L_V = 2 * TB, L_C = 3 * TB, L_S = 5 * TB, L_F = L_S + 64 * RSS;
    const int tid = threadIdx.x, lane = tid & 63, w = __builtin_amdgcn_readfirstlane(tid >> 6), i = lane & 15, g = lane >> 4;
    const int c = ci & 63, bh = ci >> 6, h = bh & 3, b = bh >> 2; const size_t m0 = (size_t)b * T + c * 64;
    bf16_t ov[4][4]; float ng[4];
    { const int tb_ = w >> 1, vb0_ = (w & 1) * 4;
#pragma unroll
      for (int vb = 0; vb < 4; ++vb) { ng[vb] = normg[h * 128 + (vb0_ + vb) * 16 + i];
#pragma unroll
          for (int r = 0; r < 4; ++r) ov[vb][r] = P[(m0 + tb_ * 16 + 4 * g + r) * PW + P_MLO + h * 128 + (vb0_ + vb) * 16 + i]; } }
    NLAS float* F = (NLAS float*)(lds + L_F);
    NLAS float* rowf = F; NLAS float* colf = F + 64; NLAS float* scv = F + 128; NLAS float* emt = F + 192; NLAS float* qn = F + 256; NLAS float* nprev = F + 320; NLAS float* denp = F + 448; NLAS float* ssq = F + 576;
    if (w == 0) { const float fpre = S32[(m0 + lane) * 32 + 4 + h], ipre = S32[(m0 + lane) * 32 + h], mprev = Mprev[ci];
        const float bcs = scan_add(logsig(fpre), lane), u = ipre - bcs, pm = scan_max(u, lane), mt = bcs + fmaxf(mprev, pm);
        rowf[lane] = bcs - mt; colf[lane] = u; scv[lane] = __expf(bcs + mprev - mt); emt[lane] = __expf(-mt); }
    else if (w <= 2) nprev[tid - 64] = Nprev[(size_t)ci * 128 + tid - 64];
    load_conv(lds + L_Q, P, cw, P_MLQ + h * 128, h * 128, m0, c * 64, tid);
    load_conv(lds + L_K, P, cw, P_MLK + h * 128, 512 + h * 128, m0, c * 64, tid);
    { const int s = tid >> 3, c16 = (tid & 7) * 16; const bf16_t* vp = P + (m0 + s) * PW + P_MLV + h * 128 + c16;
      *(NLAS u32x4*)(lds + L_V + s * RS + c16 * 2) = *(const u32x4*)vp; *(NLAS u32x4*)(lds + L_V + s * RS + c16 * 2 + 16) = *(const u32x4*)(vp + 8); }
    { const int k = tid >> 2, v0 = (tid & 3) * 32; const bf16_t* cp = Cprev + ((size_t)ci * 128 + k) * 128 + v0;
#pragma unroll
      for (int q8 = 0; q8 < 4; ++q8) *(NLAS u32x4*)(lds + L_C + k * RS + (v0 + q8 * 8) * 2) = *(const u32x4*)(cp + q8 * 8); }
    __syncthreads();
    { const int tq = tid >> 3, part = tid & 7; const u32x4 q0 = *(const NLAS u32x4*)(lds + L_Q + tq * RS + part * 32), q1 = *(const NLAS u32x4*)(lds + L_Q + tq * RS + part * 32 + 16);
      const NLAS f32x4* np = (const NLAS f32x4*)(nprev + part * 16); const f32x4 n0 = np[0], n1 = np[1], n2 = np[2], n3 = np[3];
      float a = pg8::bflo(q0.x) * n0[0] + pg8::bfhi(q0.x) * n0[1] + pg8::bflo(q0.y) * n0[2] + pg8::bfhi(q0.y) * n0[3] + pg8::bflo(q0.z) * n1[0] + pg8::bfhi(q0.z) * n1[1] + pg8::bflo(q0.w) * n1[2] + pg8::bfhi(q0.w) * n1[3]
              + pg8::bflo(q1.x) * n2[0] + pg8::bfhi(q1.x) * n2[1] + pg8::bflo(q1.y) * n2[2] + pg8::bfhi(q1.y) * n2[3] + pg8::bflo(q1.z) * n3[0] + pg8::bfhi(q1.z) * n3[1] + pg8::bflo(q1.w) * n3[2] + pg8::bfhi(q1.w) * n3[3];
      a += __shfl_xor(a, 1); a += __shfl_xor(a, 2); a += __shfl_xor(a, 4); if (part == 0) qn[tq] = a; }
    const int tb = w >> 1;
    {
        float rs[4] = {0.f, 0.f, 0.f, 0.f};
#pragma unroll
        for (int sbi = 0; sbi < 2; ++sbi) { const int sb = 2 * (w & 1) + sbi; f32x4 acc = (f32x4){0.f, 0.f, 0.f, 0.f};
            if (sb <= tb) {
#pragma unroll
                for (int ks = 0; ks < 4; ++ks) acc = mfma16(*(const NLAS bf16x8*)(lds + L_Q + (tb * 16 + i) * RS + (32 * ks + 8 * g) * 2), *(const NLAS bf16x8*)(lds + L_K + (sb * 16 + i) * RS + (32 * ks + 8 * g) * 2), acc); }
            const int s = sb * 16 + i; const float cf = colf[s];
#pragma unroll
            for (int r = 0; r < 4; ++r) { const int t = tb * 16 + 4 * g + r; const float v = (s <= t) ? acc[r] * KSCALE * __expf(rowf[t] + cf) : 0.f; rs[r] += v;
                *(NLAS bf16_t*)(lds + L_S + t * RSS + s * 2) = f2bf(v); } }
#pragma unroll
        for (int r = 0; r < 4; ++r) { float x = rs[r]; x += __shfl_xor(x, 1); x += __shfl_xor(x, 2); x += __shfl_xor(x, 4); x += __shfl_xor(x, 8); if (i == 0) denp[(w & 1) * 64 + tb * 16 + 4 * g + r] = x; }
    }
    __syncthreads();
    f32x4 a1[4], a2[4];
#pragma unroll
    for (int vb = 0; vb < 4; ++vb) { a1[vb] = (f32x4){0.f, 0.f, 0.f, 0.f}; a2[vb] = (f32x4){0.f, 0.f, 0.f, 0.f}; }
    const int vb0 = (w & 1) * 4, troff = (8 * g + (i >> 2)) * RS + (i & 3) * 8;
#pragma unroll
    for (int kk = 0; kk < 2; ++kk) { if (32 * kk <= tb * 16 + 15) { const bf16x8 sf = *(const NLAS bf16x8*)(lds + L_S + (tb * 16 + i) * RSS + (32 * kk + 8 * g) * 2);
#pragma unroll
        for (int vb = 0; vb < 4; ++vb) a1[vb] = mfma16(sf, trpair(lds + L_V + kk * 32 * RS + troff + (vb0 + vb) * 32, 4 * RS), a1[vb]); } }
#pragma unroll
    for (int ks = 0; ks < 4; ++ks) { const bf16x8 qf = *(const NLAS bf16x8*)(lds + L_Q + (tb * 16 + i) * RS + (32 * ks + 8 * g) * 2);
#pragma unroll
        for (int vb = 0; vb < 4; ++vb) a2[vb] = mfma16(qf, trpair(lds + L_C + ks * 32 * RS + troff + (vb0 + vb) * 32, 4 * RS), a2[vb]); }
    float hv[4][4], sq[4] = {0.f, 0.f, 0.f, 0.f};
#pragma unroll
    for (int r = 0; r < 4; ++r) { const int t = tb * 16 + 4 * g + r; const float sc = scv[t]; const float den = denp[t] + denp[64 + t] + sc * qn[t]; const float hd = 1.f / fmaxf(fabsf(den), emt[t]);
#pragma unroll
        for (int vb = 0; vb < 4; ++vb) { const float x = (a1[vb][r] + sc * a2[vb][r]) * hd; hv[vb][r] = x; sq[r] += x * x; } }
#pragma unroll
    for (int r = 0; r < 4; ++r) { float x = sq[r]; x += __shfl_xor(x, 1); x += __shfl_xor(x, 2); x += __shfl_xor(x, 4); x += __shfl_xor(x, 8); if (i == 0) ssq[(w & 1) * 64 + tb * 16 + 4 * g + r] = x; }
    __syncthreads();
#pragma unroll
    for (int r = 0; r < 4; ++r) { const int t = tb * 16 + 4 * g + r; const float rinv = rsqrtf((ssq[t] + ssq[64 + t]) * (1.f / 128.f) + EPS);
#pragma unroll
        for (int vb = 0; vb < 4; ++vb) { const int v = (vb0 + vb) * 16 + i; const float o = bf2f(ov[vb][r]);
            Yml[(m0 + t) * 512 + h * 128 + v] = f2bf(__builtin_amdgcn_rcpf(1.f + __expf(-o)) * hv[vb][r] * rinv * ng[vb]); } }
    __syncthreads();
}
}

namespace cmpr {
using nsa::bf16x8; using nsa::f32x4; using nsa::u32x4; using nsa::mfma16; using nsa::pkbf;
constexpr int RSX = 144, L_X = 0, L_PE = 272 * RSX  , L_H = L_PE + 8192, RSH = 528;
__device__ __forceinline__ void unit(NLAS char* lds, const bf16_t* P, const float* pe, const bf16_t* W1t, const bf16_t* W2t, bf16_t* KC, bf16_t* VC, int u) {
    const int tid = threadIdx.x, lane = tid & 63, w = __builtin_amdgcn_readfirstlane(tid >> 6), i = lane & 15, g = lane >> 4;
    const int nt = u & 15, gq = (u >> 4) & 1, b = (u >> 5) & 3, kv = u >> 7;
    const int pcol = (kv ? P_VC : P_KC) + gq * 64, tok0 = 256 * nt;
    for (int ch = tid; ch < 272 * 8; ch += 512) { const int row = ch >> 3, c8 = (ch & 7) * 8, tok = tok0 + row;
        u32x4 v = (u32x4){0u, 0u, 0u, 0u}; if (tok < T) v = *(const u32x4*)(P + ((size_t)b * T + tok) * PW + pcol + c8);
        *(NLAS u32x4*)(lds + L_X + row * RSX + c8 * 2) = v; }
    for (int e = tid; e < 2048; e += 512) ((NLAS float*)(lds + L_PE))[e] = pe[kv * 2048 + e];
    __syncthreads();
    f32x4 acc[2]; acc[0] = (f32x4){0.f, 0.f, 0.f, 0.f}; acc[1] = acc[0];
    const bf16_t* wb = W1t + ((size_t)kv * 256 + 32 * w + i) * 2048 + 8 * g;
#define CMPR_LOAD(dst, k0_) { _Pragma("unroll") for (int kk = 0; kk < 8; ++kk) { dst[kk][0] = *(const bf16x8*)(wb + 32 * ((k0_) + kk)); dst[kk][1] = *(const bf16x8*)(wb + 16 * 2048 + 32 * ((k0_) + kk)); } }
#define CMPR_COMP(src, k0_) { _Pragma("unroll") for (int kk = 0; kk < 8; ++kk) { const int ks = (k0_) + kk, l = ks >> 1, dh = ks & 1; \
            const u32x4 raw = *(const NLAS u32x4*)(lds + L_X + (16 * i + l) * RSX + dh * 64 + 16 * g); \
            const NLAS float* pp = (const NLAS float*)(lds + L_PE) + l * 64 + dh * 32 + 8 * g; const f32x4 p0 = *(const NLAS f32x4*)pp, p1 = *(const NLAS f32x4*)(pp + 4); \
            u32x4 a; a.x = pkbf(pg8::bflo(raw.x) + p0[0], pg8::bfhi(raw.x) + p0[1]); a.y = pkbf(pg8::bflo(raw.y) + p0[2], pg8::bfhi(raw.y) + p0[3]); \
            a.z = pkbf(pg8::bflo(raw.z) + p1[0], pg8::bfhi(raw.z) + p1[1]); a.w = pkbf(pg8::bflo(raw.w) + p1[2], pg8::bfhi(raw.w) + p1[3]); \
            const bf16x8 af = __builtin_bit_cast(bf16x8, a); \
            acc[0] = mfma16(af, src[kk][0], acc[0]); acc[1] = mfma16(af, src[kk][1], acc[1]); } }
    { bf16x8 bA[8][2], bB[8][2];
      CMPR_LOAD(bA, 0)
#pragma unroll 1
      for (int k0 = 0; k0 < 64; k0 += 16) { CMPR_LOAD(bB, k0 + 8) CMPR_COMP(bA, k0) if (k0 + 16 < 64) CMPR_LOAD(bA, k0 + 16) CMPR_COMP(bB, k0 + 8) } }
#undef CMPR_LOAD
#undef CMPR_COMP
#pragma unroll
    for (int cb = 0; cb < 2; ++cb)
#pragma unroll
        for (int r = 0; r < 4; ++r) { const float x = acc[cb][r], uu = 0.7978845608028654f * (x + 0.044715f * x * x * x); const float gl = x * __builtin_amdgcn_rcpf(1.f + __expf(-2.f * uu));
            *(NLAS bf16_t*)(lds + L_H + (4 * g + r) * RSH + (32 * w + cb * 16 + i) * 2) = f2bf(gl); }
    __syncthreads();
    if (w < 4) { f32x4 o = (f32x4){0.f, 0.f, 0.f, 0.f}; const bf16_t* w2 = W2t + ((size_t)kv * 64 + 16 * w + i) * 256 + 8 * g;
#pragma unroll
        for (int ks = 0; ks < 8; ++ks) o = mfma16(*(const NLAS bf16x8*)(lds + L_H + i * RSH + (32 * ks + 8 * g) * 2), *(const bf16x8*)(w2 + 32 * ks), o);
        bf16_t* dst = (kv ? VC : KC);
#pragma unroll
        for (int r = 0; r < 4; ++r) dst[((size_t)(b * 256 + 16 * nt + 4 * g + r) * 2 + gq) * 64 + 16 * w + i] = f2bf(o[r]); }
    __syncthreads();
}
}

#define LAS __attribute__((address_space(3)))
constexpr int NTHREADS = 512, LDS_BYTES = 147456;
constexpr size_t WS_WIN = 1 * MiB, WS_WG = 9 * MiB, WS_WBR = 15 * MiB, WS_WOUT = 18 * MiB, WS_WFF1 = 20 * MiB, WS_WFF2 = 28 * MiB, WS_WMKV = 36 * MiB, WS_WC1 = 38 * MiB;
constexpr size_t WS_BIASP = 249 * MiB, WS_XCH = 250 * MiB;
#define XB_TMO      128
#define XB_XCNT(j)  (256  + 64 * (j))
#define XB_XSUB(j)  (1280 + 64 * (j))
#define XB_XGEN(j)  (2304 + 64 * (j))
#define XB_TOP      3328
#define XB_TOPGEN   3392
#define XCD_BAR_WORDS 3456
#define XB_SPIN_CAP (1u << 18)

__device__ __forceinline__ unsigned xb_ld(unsigned* p)              { return __hip_atomic_load(p, __ATOMIC_RELAXED, __HIP_MEMORY_SCOPE_AGENT); }
__device__ __forceinline__ unsigned xb_add(unsigned* p, unsigned v) { return __hip_atomic_fetch_add(p, v, __ATOMIC_RELAXED, __HIP_MEMORY_SCOPE_AGENT); }
__device__ __forceinline__ unsigned xb_xcc_id() { return (unsigned)__builtin_amdgcn_s_getreg((3 << 11) | 20) & 0xFu; }
#define XB_SPIN(cond, bar) do { unsigned _sp = 0; while (cond) { __builtin_amdgcn_s_sleep(1); \
    if ((++_sp & 255u) == 0u) { if (xb_ld(&(bar)[XB_TMO])) break; if (_sp > XB_SPIN_CAP) { atomicAdd(&(bar)[XB_TMO], 1u); break; } } } } while (0)

struct XcdBarrier {
    unsigned* bar; unsigned x;
    volatile LAS unsigned* st;
};

__device__ __forceinline__ XcdBarrier xcd_barrier_post(unsigned* bar, volatile LAS unsigned* st) {
    XcdBarrier b; b.bar = bar; b.x = xb_xcc_id(); b.st = st;
    if (threadIdx.x == 0) (void)xb_add(&bar[XB_XCNT(b.x)], 1u);
    return b;
}
__device__ __forceinline__ void xcd_barrier_complete(unsigned* bar, unsigned x, unsigned& nloc, unsigned& nx) {
    const unsigned G = gridDim.x * gridDim.y * gridDim.z;
    unsigned sum, cnt, mine, sp = 0u;
    for (;;) {
        sum = 0u; cnt = 0u; mine = 0u;
#pragma unroll
        for (unsigned j = 0; j < 16; ++j) { const unsigned c = xb_ld(&bar[XB_XCNT(j)]); sum += c; cnt += (c > 0u) ? 1u : 0u; mine = (j == x) ? c : mine; }
        if (sum == G) break;
        __builtin_amdgcn_s_sleep(1);
        if ((++sp & 255u) == 0u) { if (xb_ld(&bar[XB_TMO])) break; if (sp > XB_SPIN_CAP) { atomicAdd(&bar[XB_TMO], 1u); break; } }
    }
    nloc = mine > 0u ? mine : 1u; nx = cnt > 0u ? cnt : 1u;
}

__device__ __forceinline__ void xcd_barrier(const XcdBarrier& b) {
    asm volatile("s_waitcnt vmcnt(0)" ::: "memory");
    __syncthreads();
    if (threadIdx.x == 0) {
        unsigned* bar = b.bar;
        __builtin_amdgcn_s_waitcnt(0);
        unsigned nloc = b.st[0], nx = b.st[1];
        if (nloc == 0u) { xcd_barrier_complete(bar, b.x, nloc, nx); b.st[0] = nloc; b.st[1] = nx; }
        const unsigned old = xb_add(&bar[XB_XSUB(b.x)], 1u);
        const unsigned gen = old / nloc;
        if (old + 1u == (gen + 1u) * nloc) {
            __builtin_amdgcn_fence(__ATOMIC_RELEASE, "agent");
            asm volatile("s_waitcnt vmcnt(0)" ::: "memory");
            const unsigned og = xb_add(&bar[XB_TOP], 1u);
            const unsigned tg = og / nx;
            if (og + 1u == (tg + 1u) * nx) xb_add(&bar[XB_TOPGEN], 1u);
            else XB_SPIN(xb_ld(&bar[XB_TOPGEN]) == tg, bar);
            __builtin_amdgcn_fence(__ATOMIC_ACQUIRE, "agent");
            xb_add(&bar[XB_XGEN(b.x)], 1u);
            asm volatile("s_waitcnt vmcnt(0)" ::: "memory");
        } else {
            XB_SPIN(xb_ld(&bar[XB_XGEN(b.x)]) == gen, bar);
            __builtin_amdgcn_fence(__ATOMIC_ACQUIRE, "agent");
            asm volatile("s_waitcnt vmcnt(0)" ::: "memory");
        }
    }
    __syncthreads();
}

struct Args { const float* in[18]; float* out; unsigned char* ws; int ph_lo, ph_hi; };
template <int VT, class F> __device__ __forceinline__ void run_vb(int nvb, char* lds, F f) {
    constexpr int PER = NTHREADS / VT; const int sub = threadIdx.x / VT, tid = threadIdx.x % VT;
    for (int it = blockIdx.x; it * PER < nvb; it += gridDim.x) { VB vb{it * PER + sub, tid, lds + sub * (LDS_BYTES / PER)}; f(vb); __syncthreads(); }
}
__device__ __forceinline__ unsigned pk2(float lo, float hi) { return (unsigned)f2bf(lo) | ((unsigned)f2bf(hi) << 16); }
typedef unsigned v4u __attribute__((ext_vector_type(4)));
typedef float f32x4 __attribute__((ext_vector_type(4)));
__device__ __forceinline__ void tr_item(const float* W, int ld, int ncols, int K, bf16_t* WT, int row_off, LAS float* scr, int item, int lane) {
    const int nblk = ncols / 32, kb = item / nblk, nb = item % nblk, k0 = 64 * kb, n0 = 32 * nb;
#pragma unroll 8
    for (int i = 0; i < 32; ++i) { const int kk = 2 * i + (lane >> 5); scr[kk * 33 + (lane & 31)] = W[(size_t)(k0 + kk) * ld + n0 + (lane & 31)]; }
    asm volatile("s_waitcnt lgkmcnt(0)" ::: "memory");
    const int c = lane & 7;
#pragma unroll
    for (int j = 0; j < 4; ++j) { const int n = (lane >> 3) + 8 * j; const LAS float* s = scr + (8 * c) * 33 + n;
        v4u o; o.x = pk2(s[0 * 33], s[1 * 33]); o.y = pk2(s[2 * 33], s[3 * 33]); o.z = pk2(s[4 * 33], s[5 * 33]); o.w = pk2(s[6 * 33], s[7 * 33]);
        *(v4u*)(WT + (size_t)(row_off + n0 + n) * K + k0 + 8 * c) = o; }
    asm volatile("s_waitcnt lgkmcnt(0)" ::: "memory");
}
__device__ __forceinline__ void rms_row_wave(const float* xrow, const float* g, bf16_t* orow, int lane) {
    const f32x4* xr = (const f32x4*)xrow + lane; const f32x4* gr = (const f32x4*)g + lane;
    f32x4 v[4]; float s = 0.f;
#pragma unroll
    for (int j = 0; j < 4; ++j) { v[j] = xr[64 * j]; s += (v[j].x * v[j].x + v[j].y * v[j].y) + (v[j].z * v[j].z + v[j].w * v[j].w); }
    const float r = rsqrtf(wave_sum(s) * (1.f / D) + EPS);
    unsigned long long* o8 = (unsigned long long*)orow + lane;
#pragma unroll
    for (int j = 0; j < 4; ++j) { const f32x4 gg = gr[64 * j]; o8[64 * j] = (unsigned long long)pk2(v[j].x * r * gg.x, v[j].y * r * gg.y) | ((unsigned long long)pk2(v[j].z * r * gg.z, v[j].w * r * gg.w) << 32); }
}
__device__ __forceinline__ int small_src_col(int c) { return c < 8 ? C_MLI + c : C_NSG + (c - 8); }
__global__ void __launch_bounds__(NTHREADS, 2) mega(Args a) {
    extern __shared__ __attribute__((aligned(16))) unsigned char lds_raw[];
    char* lds = (char*)lds_raw;
    LAS unsigned char* lds3 = (LAS unsigned char*)lds_raw;
    const float* x = a.in[0]; const float* mem = a.in[1]; const float* g_mix = a.in[2]; const float* w_in = a.in[3];
    const float* b_in = a.in[4]; const float* ml_conv = a.in[5]; const float* ml_norm_g = a.in[6]; const float* cmp_pe = a.in[7];
    const float* cmp_w1 = a.in[8]; const float* cmp_w2 = a.in[9]; const float* g_mem = a.in[10]; const float* w_mem_kv = a.in[11];
    const float* w_branch = a.in[12]; const float* w_out = a.in[13]; const float* g_ffn = a.in[14]; const float* w_ff1 = a.in[15];
    const float* w_ff2 = a.in[16]; const float* g_final = a.in[17];
    char* ws = (char*)a.ws; float* out = a.out;
    bf16_t* U = (bf16_t*)(ws + WS_U); bf16_t* P = (bf16_t*)(ws + WS_P);
    bf16_t* Yml = (bf16_t*)(ws + WS_Y); bf16_t* Ynsa = Yml + (size_t)M * 512; bf16_t* Yxa = Ynsa + (size_t)M * 512;
    float* S32 = (float*)(ws + WS_S32); bf16_t* MEMN = (bf16_t*)(ws + WS_MEMN); bf16_t* MEMKV = (bf16_t*)(ws + WS_MEMKV);
    bf16_t* KC = (bf16_t*)(ws + WS_KC); bf16_t* VC = (bf16_t*)(ws + WS_VC);
    float* NA = (float*)(ws + WS_NA); float* Gc = (float*)(ws + WS_G); float* Mloc = (float*)(ws + WS_MLOC); float* Mprev = (float*)(ws + WS_MPREV);
    bf16_t* Abuf = (bf16_t*)out;
    bf16_t* GATES = P; bf16_t* MERGED = U; bf16_t* AFFN = (bf16_t*)(ws + WS_AFFN); bf16_t* HBUF = P;
    bf16_t* Wi = (bf16_t*)(ws + WS_WIN); bf16_t* Wg = (bf16_t*)(ws + WS_WG); bf16_t* Wbr = (bf16_t*)(ws + WS_WBR); bf16_t* Wo = (bf16_t*)(ws + WS_WOUT);
    bf16_t* Wf1 = (bf16_t*)(ws + WS_WFF1); bf16_t* Wf2 = (bf16_t*)(ws + WS_WFF2); bf16_t* Wmkv = (bf16_t*)(ws + WS_WMKV);
    float* biasP = (float*)(ws + WS_BIASP); bf16_t* Wc1 = (bf16_t*)(ws + WS_WC1); bf16_t* Wc2 = (bf16_t*)(ws + WS_BIASP + 65536);
    const int tid = threadIdx.x, lane = tid & 63, wave = __builtin_amdgcn_readfirstlane(tid >> 6);
    const int G = gridDim.x, bid = blockIdx.x;
    const int lo = a.ph_lo, hi = a.ph_hi;
    volatile LAS unsigned* xbst = (volatile LAS unsigned*)(lds3 + LDS_BYTES - 64);
    if (tid < 2) xbst[tid] = 0u;
    __syncthreads();
    const XcdBarrier bar = xcd_barrier_post((unsigned*)ws, xbst);
#define PHASE(k) if (lo <= (k) && (k) < hi)
#define SEAM(k) if (lo <= (k) && (k) + 1 < hi) xcd_barrier(bar)
    PHASE(0) {
        LAS float* scr = (LAS float*)(lds3 + wave * 16384);
        const int gw = bid * 8 + wave, NGW = G * 8;
        constexpr int I0 = 16 * 64, I1 = 16 * 40, I2 = 16 * 16, I3 = 16 * 96, I4 = 8 * 32, I5 = 16 * 32, I6 = 16 * 128, I7 = 64 * 32, I8 = 16 * 32;
        constexpr int I9 = 32 * 8, I10 = 4 * 2;
        constexpr int NITEMS = I0 + I1 + I2 + I3 + 3 * I4 + I5 + I6 + I7 + I8 + 2 * I9 + 2 * I10;
        for (int it = gw; it < NITEMS; it += NGW) {
            int r = it;
            if (r < I0) { tr_item(w_in, DIN, 2048, 1024, Wi, 0, scr, r, lane); continue; } r -= I0;
            if (r < I1) { tr_item(w_in + 2056, DIN, 1280, 1024, Wi, 2048, scr, r, lane); continue; } r -= I1;
            if (r < I2) { tr_item(w_in + 3360, DIN, 512, 1024, Wi, 3328, scr, r, lane); continue; } r -= I2;
            if (r < I3) { tr_item(w_in + C_MG, DIN, 3072, 1024, Wg, 0, scr, r, lane); continue; } r -= I3;
            if (r < 3 * I4) { const int j = r / I4; tr_item(w_branch + (size_t)j * 512 * 1024, 1024, 1024, 512, Wbr + (size_t)j * 1024 * 512, 0, scr, r % I4, lane); continue; } r -= 3 * I4;
            if (r < I5) { tr_item(w_out, 1024, 1024, 1024, Wo, 0, scr, r, lane); continue; } r -= I5;
            if (r < I6) { tr_item(w_ff1, FF, FF, 1024, Wf1, 0, scr, r, lane); continue; } r -= I6;
            if (r < I7) { tr_item(w_ff2, 1024, 1024, FF, Wf2, 0, scr, r, lane); continue; } r -= I7;
            if (r < I8) { tr_item(w_mem_kv, 1024, 1024, 1024, Wmkv, 0, scr, r, lane); continue; } r -= I8;
            if (r < 2 * I9) { const int kv = r / I9; tr_item(cmp_w1 + (size_t)kv * 2048 * 256, 256, 256, 2048, Wc1 + (size_t)kv * 256 * 2048, 0, scr, r % I9, lane); continue; } r -= 2 * I9;
            { const int kv = r / I10; tr_item(cmp_w2 + (size_t)kv * 256 * 64, 64, 64, 256, Wc2 + (size_t)kv * 64 * 256, 0, scr, r % I10, lane); }
        }
        for (int i = bid * NTHREADS + tid; i < 256 * 1024; i += G * NTHREADS) { const int r = i >> 10, k = i & 1023; bf16_t v = 0;
            if (r < 32) v = f2bf(w_in[(size_t)k * DIN + small_src_col(r)]);
            else if (r >= 128 && r < 160) { const float w = w_in[(size_t)k * DIN + small_src_col(r - 128)]; v = f2bf(w - bf2f(f2bf(w))); }
            Wi[(size_t)(3840 + r) * 1024 + k] = v; }
        for (int c = bid * NTHREADS + tid; c < 4096; c += G * NTHREADS) { float v = 0.f;
            if (c < 2048) v = b_in[c]; else if (c < 3328) v = b_in[c + 8]; else if (c < 3840) v = b_in[c + 32]; else if (c < 3872) v = b_in[small_src_col(c - 3840)];
            biasP[c] = v; }
        for (int m = gw; m < M; m += NGW) rms_row_wave(x + (size_t)m * D, g_mix, U + (size_t)m * D, lane);
        for (int m = gw; m < 1024; m += NGW) rms_row_wave(mem + (size_t)m * D, g_mem, MEMN + (size_t)m * D, lane);
    }
    SEAM(0);
    PHASE(1) {
        { pg8::Gemm g{U, Wi, M, 4096, D}; pg8::StaticOrder S; S.init(M, 4096, G, bid);
          pg8::EpiStore<0> E{P, biasP, S32, PW, 15};
          pg8::gemm_phase<pg8::EpiStore<0>, pg8::StaticOrder, true, true>(lds3, g, S, E); }
    }
    SEAM(1);
    PHASE(2) { for (int tl_ = bid; tl_ < 256; tl_ += G) xa::memkv_tile(MEMN, Wmkv, MEMKV, tl_);
               for (int ci = bid; ci < 1024; ci += G) ml::m1_unit((NLAS char*)lds_raw, P, ml_conv, S32, Abuf, NA, Gc, Mloc, ci);
               for (int u = bid; u < 256; u += G) cmpr::unit((NLAS char*)lds_raw, P, cmp_pe, Wc1, Wc2, KC, VC, u);
    }
    SEAM(2);
    PHASE(3) { unsigned* m2cnt = (unsigned*)ws + 12288;
               ml::m2_items(Abuf, NA, Gc, Mloc, Mprev);
               asm volatile("s_waitcnt vmcnt(0)" ::: "memory"); __syncthreads();
               if (tid == 0) { __builtin_amdgcn_fence(__ATOMIC_RELEASE, "agent"); asm volatile("s_waitcnt vmcnt(0)" ::: "memory"); __hip_atomic_fetch_add(m2cnt, 1u, __ATOMIC_RELAXED, __HIP_MEMORY_SCOPE_AGENT); }
               nsa::phase((NLAS char*)lds_raw, P, S32, KC, VC, Ynsa);
               xa::phase((NLAS char*)lds_raw, P, MEMKV, Yxa);
               if (tid == 0) { unsigned sp = 0; while (__hip_atomic_load(m2cnt, __ATOMIC_RELAXED, __HIP_MEMORY_SCOPE_AGENT) < (unsigned)G) { __builtin_amdgcn_s_sleep(2); if (++sp > (1u << 22)) break; }
                               __builtin_amdgcn_fence(__ATOMIC_ACQUIRE, "agent"); asm volatile("s_waitcnt vmcnt(0)" ::: "memory"); }
               __syncthreads();
               for (int ci = bid; ci < 1024; ci += G) ml::m3_unit((NLAS char*)lds_raw, P, ml_conv, S32, Abuf, NA, Mprev, ml_norm_g, Yml, ci); }
    SEAM(4);
    PHASE(5) { pg8::Gemm g{U, Wg, M, 3072, D}; pg8::StaticOrder S; S.init(M, 3072, G, bid);
               pg8::EpiStore<1> E{GATES, b_in + C_MG, nullptr, 3072, -1};
               pg8::gemm_phase<pg8::EpiStore<1>, pg8::StaticOrder, true, true>(lds3, g, S, E); }
    SEAM(5);
    PHASE(6) { pg8::Gemm g{Yml, Wbr, M, 1024, 512}; pg8::MergeOrder S; S.so.init(M, 1024, G, bid); S.sa = (size_t)M * 512 * 2; S.sb = (size_t)1024 * 512 * 2;
               pg8::EpiMergeG E{GATES, (bf16_t*)out, MERGED};
               pg8::gemm_phase<pg8::EpiMergeG, pg8::MergeOrder, true, true>(lds3, g, S, E); }
    SEAM(6);
    PHASE(7) { pg8::Gemm g{MERGED, Wo, M, 1024, D}; pg8::StaticOrder S; S.init(M, 1024, G, bid);
               pg8::EpiResRms E{x, out, nullptr, AFFN, g_ffn, (float*)(ws + WS_XCH), (unsigned*)ws + 4096};
               pg8::gemm_phase<pg8::EpiResRms, pg8::StaticOrder, false, true>(lds3, g, S, E); }
    SEAM(7);
    PHASE(9) { pg8::Gemm g{AFFN, Wf1, M, FF, D}; pg8::StaticOrder S; S.init(M, FF, G, bid);
               pg8::EpiStore<2> E{HBUF, nullptr, nullptr, FF, -1};
               pg8::gemm_phase<pg8::EpiStore<2>, pg8::StaticOrder, true, true>(lds3, g, S, E); }
    SEAM(9);
    PHASE(10) { pg8::Gemm g{HBUF, Wf2, M, 1024, FF}; pg8::StaticOrder S; S.init(M, 1024, G, bid);
                pg8::EpiResRms E{out, nullptr, out, nullptr, g_final, (float*)(ws + WS_XCH + 262144), (unsigned*)ws + 4096 + 4096};
                pg8::gemm_phase<pg8::EpiResRms, pg8::StaticOrder, false, true>(lds3, g, S, E); }
}
constexpr int N_PHASES = 12;
#ifndef MK_PER_PHASE
#define MK_PER_PHASE 0
#endif
extern "C" void kernel_launch(void* const* d_in, const int* in_sizes, int n_in, void* d_out, int out_size, void* d_ws, size_t ws_size, hipStream_t stream) {
    static int grid = 0;
    if (grid == 0) {
        int dev = 0, cus = 0, per_cu = 0;
        (void)hipGetDevice(&dev); (void)hipDeviceGetAttribute(&cus, hipDeviceAttributeMultiprocessorCount, dev);
        (void)hipFuncSetAttribute((const void*)mega, hipFuncAttributeMaxDynamicSharedMemorySize, LDS_BYTES);
        (void)hipOccupancyMaxActiveBlocksPerMultiprocessor(&per_cu, (const void*)mega, NTHREADS, LDS_BYTES);
        if (per_cu < 1) { fprintf(stderr, "occupancy query says %d blocks/CU\n", per_cu); per_cu = 1; }
        grid = cus * 1;
        (void)hipGetLastError();
    }
    (void)hipMemsetAsync(d_ws, 0, 65536, stream);
    Args a{};
    for (int i = 0; i < 18; ++i) a.in[i] = (const float*)d_in[i];
    a.out = (float*)d_out; a.ws = (unsigned char*)d_ws;
#if MK_PER_PHASE
    for (int p = 0; p < N_PHASES; ++p) { a.ph_lo = p; a.ph_hi = p + 1; void* args[] = {&a};
        (void)hipLaunchCooperativeKernel((const void*)mega, dim3(grid), dim3(NTHREADS), args, LDS_BYTES, stream); }
#else
    a.ph_lo = 0; a.ph_hi = N_PHASES; void* args[] = {&a};
    hipError_t e = hipLaunchCooperativeKernel((const void*)mega, dim3(grid), dim3(NTHREADS), args, LDS_BYTES, stream);
    if (e != hipSuccess) fprintf(stderr, "cooperative launch failed: %s (grid %d)\n", hipGetErrorString(e), grid);
#endif
}
```

```cpp
#include <hip/hip_runtime.h>
#include <hip/hip_cooperative_groups.h>
#include <cstdio>
namespace cg = cooperative_groups;
#include <stdint.h>

typedef unsigned short bf16_t;
__device__ __forceinline__ float bf2f(bf16_t v) { return __uint_as_float(((unsigned)v) << 16); }
__device__ __forceinline__ bf16_t f2bf(float f) { unsigned u = __float_as_uint(f); return (bf16_t)((u + 0x7fffu + ((u >> 16) & 1u)) >> 16); }

constexpr int NB = 4, T = 4096, M = NB * T, D = 1024, DIN = 6944, FF = 4096;
constexpr float EPS = 1e-6f;
constexpr int C_MLI = 2048, C_NSG = 3336, C_MG = 3872;
constexpr int P_MLQ = 0, P_MLK = 512, P_MLV = 1024, P_MLO = 1536, P_NSQ = 2048, P_KC = 2560, P_VC = 2688, P_KS = 2816, P_VS = 2944, P_KW = 3072, P_VW = 3200, P_XAQ = 3328, PW = 3840;
constexpr size_t MiB = 1u << 20;
constexpr size_t WS_U = 40 * MiB;
constexpr size_t WS_P = 72 * MiB;
constexpr size_t WS_Y = 192 * MiB;
constexpr size_t WS_AFFN = 200 * MiB;
constexpr size_t WS_S32 = 240 * MiB;
constexpr size_t WS_MEMN = 242 * MiB;
constexpr size_t WS_MEMKV = 244 * MiB;
constexpr size_t WS_KC = 246 * MiB;
constexpr size_t WS_VC = 246 * MiB + 512 * 1024;
constexpr size_t WS_NA = 247 * MiB;
constexpr size_t WS_G = 248 * MiB;
constexpr size_t WS_MLOC = 248 * MiB + 4096;
constexpr size_t WS_MPREV = 248 * MiB + 8192;

__device__ __forceinline__ float wave_sum(float v) {
#pragma unroll
    for (int o = 1; o < 64; o <<= 1) v += __shfl_xor(v, o);
    return v;
}
__device__ __forceinline__ float wave_max(float v) {
#pragma unroll
    for (int o = 1; o < 64; o <<= 1) v = fmaxf(v, __shfl_xor(v, o));
    return v;
}

__device__ __forceinline__ float logsig(float x) { return fminf(x, 0.f) - log1pf(__expf(-fabsf(x))); }
namespace pg8 {
#define PG8_LAS __attribute__((address_space(3)))
typedef unsigned short bf16_t;
typedef short bf16x8 __attribute__((ext_vector_type(8)));
typedef float f32x4 __attribute__((ext_vector_type(4)));
typedef unsigned u32x4 __attribute__((ext_vector_type(4)));
constexpr int BM = 256, BK = 64, HALF = 128, HTB = HALF * BK * 2  , STAGE_BYTES = 8 * HTB, NXCD = 8, WGM = 8;

__host__ __device__ __forceinline__ int lds_byte(int r, int c) { const int st = (r >> 4) * 2 + (c >> 5), rr = r & 15, cc = c & 31, ob = rr * 64 + cc * 2; return st * 1024 + (ob ^ (((ob >> 9) & 1) << 5)); }
__host__ __device__ __forceinline__ void stage_rc(int b, int& R, int& C) { const int st = b / 1024, sb = b % 1024, swz = sb ^ (((sb >> 9) & 1) << 5); R = (st >> 1) * 16 + swz / 64; C = (st & 1) * 32 + (swz % 64) / 2; }
__host__ __device__ __forceinline__ int perm32(int rho) { const int n = rho >> 4, i = rho & 15; return 8 * (i >> 2) + 4 * n + (i & 3); }

struct Unit { int pm, pn, j; };
struct Gemm { const bf16_t* A; const bf16_t* Bt; int M, N, K; };

struct StaticOrder {
    int nM, nN, nwg, G, c;
    __host__ __device__ void init(int M, int N, int G_, int c_) { nM = M / BM; nN = N / BM; nwg = nM * nN; G = G_; c = c_; }
    __host__ __device__ bool next(int i, Unit& u) const {
        const long L = (long)i * G + c; if (L >= nwg) return false;
        int wgid = (int)L; { const int q = nwg / NXCD, r = nwg % NXCD, xcd = wgid % NXCD, off = wgid / NXCD; wgid = (xcd < r ? xcd * (q + 1) : r * (q + 1) + (xcd - r) * q) + off; }
        const int nig = WGM * nN, gid = wgid / nig, fm = gid * WGM, gsz = (nM - fm) < WGM ? (nM - fm) : WGM;
        u.pm = fm + ((wgid % nig) % gsz); u.pn = (wgid % nig) / gsz; u.j = 0; return true;
    }
    __device__ __forceinline__ const char* pa(const Gemm& g, const Unit& u, size_t tstep) const { return (const char*)g.A + (size_t)u.pm * tstep; }
    __device__ __forceinline__ const char* pb(const Gemm& g, const Unit& u, size_t tstep) const { return (const char*)g.Bt + (size_t)u.pn * tstep; }
    __device__ __forceinline__ void a_ready(const Unit&) const {}
    __device__ __forceinline__ void done(const Unit&) const {}
};

struct MergeOrder {
    StaticOrder so; size_t sa, sb;
    __device__ __forceinline__ bool next(int i, Unit& u) const { if (i >= 3) return false; const bool ok = so.next(0, u); u.j = i; return ok; }
    __device__ __forceinline__ const char* pa(const Gemm& g, const Unit& u, size_t tstep) const { return (const char*)g.A + (size_t)u.j * sa + (size_t)u.pm * tstep; }
    __device__ __forceinline__ const char* pb(const Gemm& g, const Unit& u, size_t tstep) const { return (const char*)g.Bt + (size_t)u.j * sb + (size_t)u.pn * tstep; }
    __device__ __forceinline__ void a_ready(const Unit&) const {}
    __device__ __forceinline__ void done(const Unit&) const {}
};
typedef float f32x2_t __attribute__((ext_vector_type(2))); typedef __bf16 bf16x2_t __attribute__((ext_vector_type(2)));
__device__ __forceinline__ unsigned cvt_pk_bf16(float lo, float hi) { f32x2_t v = {lo, hi}; bf16x2_t b = __builtin_convertvector(v, bf16x2_t); return __builtin_bit_cast(unsigned, b); }
typedef float f32x2 __attribute__((ext_vector_type(2)));

typedef unsigned u32x2 __attribute__((ext_vector_type(2)));
__device__ __forceinline__ float bflo(unsigned w) { return __uint_as_float(w << 16); }
__device__ __forceinline__ float bfhi(unsigned w) { return __uint_as_float(w & 0xffff0000u); }
template <int ACT> __device__ __forceinline__ f32x4 act4(f32x4 v) {
    if (ACT == 1) { f32x4 o; for (int e = 0; e < 4; ++e) o[e] = __builtin_amdgcn_rcpf(1.f + __expf(-v[e])); return o; }
    if (ACT == 2) { f32x4 o; for (int e = 0; e < 4; ++e) { const float r = fmaxf(v[e], 0.f); o[e] = r * r; } return o; }
    return v;
}
template <int ACT> struct EpiStore {
    static constexpr bool PERM = true, AFTER_DRAIN = false;
    bf16_t* O; const float* bias; float* S32; int ldc, small_pn;
    __device__ __forceinline__ void operator()(const f32x4 (&acc)[2][2][4][2], const Unit& u, int wr, int wc, int fr, int fq) const {
        asm volatile("s_waitcnt vmcnt(0)" ::: "memory");
        const int row0 = u.pm * BM + wr * 64 + fr, col0 = u.pn * BM + wc * 32 + 8 * fq;
        if (u.pn == small_pn) {
            if (wc == 0) {
                const f32x4 b0 = *(const f32x4*)(bias + col0), b1 = *(const f32x4*)(bias + col0 + 4);
#pragma unroll
                for (int ai = 0; ai < 2; ++ai)
#pragma unroll
                    for (int m = 0; m < 4; ++m) { float* rp = S32 + (size_t)(row0 + ai * HALF + m * 16) * 32 + 8 * fq;
                        *(f32x4*)rp = acc[ai][0][m][0] + acc[ai][1][m][0] + b0; *(f32x4*)(rp + 4) = acc[ai][0][m][1] + acc[ai][1][m][1] + b1; }
            }
            return;
        }
        f32x4 bv[2][2];
#pragma unroll
        for (int bj = 0; bj < 2; ++bj)
#pragma unroll
            for (int n = 0; n < 2; ++n) bv[bj][n] = bias ? *(const f32x4*)(bias + col0 + bj * HALF + 4 * n) : (f32x4){0.f, 0.f, 0.f, 0.f};
#pragma unroll
        for (int ai = 0; ai < 2; ++ai)
#pragma unroll
            for (int m = 0; m < 4; ++m) { bf16_t* rowp = O + (size_t)(row0 + ai * HALF + m * 16) * ldc + col0;
#pragma unroll
                for (int bj = 0; bj < 2; ++bj) { const f32x4 v0 = act4<ACT>(acc[ai][bj][m][0] + bv[bj][0]), v1 = act4<ACT>(acc[ai][bj][m][1] + bv[bj][1]);
                    u32x4 w; w.x = cvt_pk_bf16(v0[0], v0[1]); w.y = cvt_pk_bf16(v0[2], v0[3]); w.z = cvt_pk_bf16(v1[0], v1[1]); w.w = cvt_pk_bf16(v1[2], v1[3]);
                    *(u32x4*)(rowp + bj * HALF) = w; } }
    }
};
struct EpiMergeG {
    static constexpr bool PERM = true, AFTER_DRAIN = false;
    const bf16_t* G; bf16_t* Mp; bf16_t* Mb;
    __device__ __forceinline__ void operator()(const f32x4 (&acc)[2][2][4][2], const Unit& u, int wr, int wc, int fr, int fq) const {
        const int j = u.j;
        asm volatile("s_waitcnt vmcnt(0)" ::: "memory");
        const int row0 = u.pm * BM + wr * 64 + fr, col0 = u.pn * BM + wc * 32 + 8 * fq;
        bf16_t* dst = (j < 2) ? Mp : Mb;
#pragma unroll
        for (int ai = 0; ai < 2; ++ai)
#pragma unroll
            for (int m = 0; m < 4; ++m) { const size_t row = (size_t)(row0 + ai * HALF + m * 16);
#pragma unroll
                for (int bj = 0; bj < 2; ++bj) { const int col = col0 + bj * HALF;
                    const u32x4 gw = *(const u32x4*)(G + row * 3072 + j * 1024 + col);
                    f32x4 v0 = (f32x4){bflo(gw.x), bfhi(gw.x), bflo(gw.y), bfhi(gw.y)} * acc[ai][bj][m][0], v1 = (f32x4){bflo(gw.z), bfhi(gw.z), bflo(gw.w), bfhi(gw.w)} * acc[ai][bj][m][1];
                    if (j > 0) { const u32x4 pw = *(const u32x4*)(Mp + row * 1024 + col); v0 += (f32x4){bflo(pw.x), bfhi(pw.x), bflo(pw.y), bfhi(pw.y)}; v1 += (f32x4){bflo(pw.z), bfhi(pw.z), bflo(pw.w), bfhi(pw.w)}; }
                    u32x4 w; w.x = cvt_pk_bf16(v0[0], v0[1]); w.y = cvt_pk_bf16(v0[2], v0[3]); w.z = cvt_pk_bf16(v1[0], v1[1]); w.w = cvt_pk_bf16(v1[2], v1[3]); *(u32x4*)(dst + row * 1024 + col) = w; } }
    }
};
struct EpiResidF {
    static constexpr bool PERM = true, AFTER_DRAIN = false;
    const float* X; float* O;
    __device__ __forceinline__ void operator()(const f32x4 (&acc)[2][2][4][2], const Unit& u, int wr, int wc, int fr, int fq) const {
        asm volatile("s_waitcnt vmcnt(0)" ::: "memory");
        const int row0 = u.pm * BM + wr * 64 + fr, col0 = u.pn * BM + wc * 32 + 8 * fq;
#pragma unroll
        for (int ai = 0; ai < 2; ++ai)
#pragma unroll
            for (int m = 0; m < 4; ++m) { const size_t off = (size_t)(row0 + ai * HALF + m * 16) * 1024 + col0;
#pragma unroll
                for (int bj = 0; bj < 2; ++bj) { const f32x4 x0 = *(const f32x4*)(X + off + bj * HALF), x1 = *(const f32x4*)(X + off + bj * HALF + 4);
                    *(f32x4*)(O + off + bj * HALF) = x0 + acc[ai][bj][m][0]; *(f32x4*)(O + off + bj * HALF + 4) = x1 + acc[ai][bj][m][1]; } }
    }
};
struct EpiResRms {
    static constexpr bool PERM = false, AFTER_DRAIN = true;
    const float* R; float* Hout; float* Nf; bf16_t* Nb; const float* gain; float* xbuf; unsigned* cnt;
    __device__ __forceinline__ void fused(f32x4 (&acc)[2][2][4][2], const Unit& u, int wr, int wc, int fr, int fq, PG8_LAS unsigned char* lds, int wid, int lane) const {
        PG8_LAS float* Pp = (PG8_LAS float*)lds; PG8_LAS float* S = (PG8_LAS float*)(lds + 4096);
        const int col0 = u.pn * BM + wc * 32 + 4 * fq;
#pragma unroll
        for (int ai = 0; ai < 2; ++ai)
#pragma unroll
            for (int m = 0; m < 4; ++m) { const size_t off = (size_t)(u.pm * BM + ai * HALF + wr * 64 + m * 16 + fr) * 1024 + col0; float sq = 0.f;
#pragma unroll
                for (int bj = 0; bj < 2; ++bj)
#pragma unroll
                    for (int n = 0; n < 2; ++n) { const f32x4 v = acc[ai][bj][m][n] + *(const f32x4*)(R + off + bj * HALF + n * 16); acc[ai][bj][m][n] = v; sq += (v[0] * v[0] + v[1] * v[1]) + (v[2] * v[2] + v[3] * v[3]); }
                sq += __shfl_xor(sq, 16); sq += __shfl_xor(sq, 32);
                if (fq == 0) Pp[(ai * HALF + wr * 64 + m * 16 + fr) * 4 + wc] = sq; }
        asm volatile("s_waitcnt lgkmcnt(0)" ::: "memory"); __builtin_amdgcn_s_barrier(); asm volatile("" ::: "memory");
        const int row = wid * 32 + (lane & 31);
        if (lane < 32) { const float tot = (Pp[row * 4 + 0] + Pp[row * 4 + 1]) + (Pp[row * 4 + 2] + Pp[row * 4 + 3]);
            __hip_atomic_store(xbuf + ((size_t)(u.pm * BM + row) * 4 + u.pn), tot, __ATOMIC_RELAXED, __HIP_MEMORY_SCOPE_AGENT); }
        asm volatile("s_waitcnt vmcnt(0)" ::: "memory");
        if (lane == 0) __hip_atomic_fetch_add(cnt + 64 * u.pm, 1u, __ATOMIC_RELAXED, __HIP_MEMORY_SCOPE_AGENT);
        if (wid == 0) { unsigned sp = 0;
            while ((unsigned)__builtin_amdgcn_readfirstlane(__hip_atomic_load(cnt + 64 * u.pm, __ATOMIC_RELAXED, __HIP_MEMORY_SCOPE_AGENT)) < 32u) { __builtin_amdgcn_s_sleep(2); if (++sp > (1u << 22)) break; }
            __builtin_amdgcn_fence(__ATOMIC_ACQUIRE, "agent"); }
        asm volatile("s_waitcnt vmcnt(0) lgkmcnt(0)" ::: "memory"); __builtin_amdgcn_s_barrier(); asm volatile("" ::: "memory");
        if (lane < 32) { const float* slot = xbuf + (size_t)(u.pm * BM + row) * 4; float t = 0.f;
#pragma unroll
            for (int q = 0; q < 4; ++q) t += __hip_atomic_load(slot + q, __ATOMIC_RELAXED, __HIP_MEMORY_SCOPE_AGENT);
            S[row] = rsqrtf(t * (1.0f / 1024.0f) + 1e-6f); }
        asm volatile("s_waitcnt lgkmcnt(0)" ::: "memory"); __builtin_amdgcn_s_barrier(); asm volatile("" ::: "memory");
        f32x4 gv[2][2];
#pragma unroll
        for (int bj = 0; bj < 2; ++bj)
#pragma unroll
            for (int n = 0; n < 2; ++n) gv[bj][n] = *(const f32x4*)(gain + col0 + bj * HALF + n * 16);
#pragma unroll
        for (int ai = 0; ai < 2; ++ai)
#pragma unroll
            for (int m = 0; m < 4; ++m) { const int r = ai * HALF + wr * 64 + m * 16 + fr; const float rs = S[r]; const size_t off = (size_t)(u.pm * BM + r) * 1024 + col0;
#pragma unroll
                for (int bj = 0; bj < 2; ++bj)
#pragma unroll
                    for (int n = 0; n < 2; ++n) { const f32x4 v = acc[ai][bj][m][n]; const f32x4 o = v * rs * gv[bj][n];
                        if (Hout) *(f32x4*)(Hout + off + bj * HALF + n * 16) = v;
                        if (Nf) *(f32x4*)(Nf + off + bj * HALF + n * 16) = o;
                        if (Nb) { u32x2 w; w.x = cvt_pk_bf16(o[0], o[1]); w.y = cvt_pk_bf16(o[2], o[3]); *(u32x2*)(Nb + off + bj * HALF + n * 16) = w; } } }
    }
};

template <class Epi, class Sched, bool ALIGN_EPI = false, bool SP2 = false>
__device__ __forceinline__ void gemm_phase(PG8_LAS unsigned char* lds, const Gemm g, const Sched& S, const Epi& E) {
    const int tid = threadIdx.x, wid = __builtin_amdgcn_readfirstlane(tid >> 6), lane = tid & 63, wr = wid >> 2, wc = wid & 3, fr = lane & 15, fq = lane >> 4;
    const int K = g.K, nt = K / BK;
    unsigned voffA[2], voffB[2];
#pragma unroll
    for (int i = 0; i < 2; ++i) { int R, C; stage_rc(tid * 16 + i * 8192, R, C); const int Rb = Epi::PERM ? ((R & ~31) + perm32(R & 31)) : R;
        voffA[i] = (unsigned)(R * K + C) * 2u; voffB[i] = (unsigned)(Rb * K + C) * 2u; }
    const size_t kstep = (size_t)(BK * 2);
    const size_t hstep = (size_t)HALF * K * 2;
    const size_t tstep = 2 * hstep;
    const unsigned ldsw = (unsigned)wid * 1024u;
    const int aoff = lds_byte(wr * 64 + fr, fq * 8), boff = lds_byte(wc * 32 + fr, fq * 8);
#define PG8_SA(b, h) (((b) * 2 + (h)) * HTB)
#define PG8_SB(b, h) ((4 + (b) * 2 + (h)) * HTB)
#define PG8_STAGE(bufoff, gbase, voff) do { _Pragma("unroll") for (int _i = 0; _i < 2; ++_i) \
        __builtin_amdgcn_global_load_lds((const unsigned*)((const char*)(gbase) + (voff)[_i]), (PG8_LAS unsigned*)(lds + (bufoff) + ldsw + _i * 8192), 16, 0, 0); } while (0)
#define PG8_LDA(dst, b, h) do { _Pragma("unroll") for (int m = 0; m < 4; ++m) _Pragma("unroll") for (int k = 0; k < 2; ++k) dst[m][k] = *(const PG8_LAS bf16x8*)(lds + PG8_SA(b, h) + aoff + m * 2048 + k * 1024); } while (0)
#define PG8_LDB(dst, b, h) do { _Pragma("unroll") for (int n = 0; n < 2; ++n) _Pragma("unroll") for (int k = 0; k < 2; ++k) dst[n][k] = *(const PG8_LAS bf16x8*)(lds + PG8_SB(b, h) + boff + n * 2048 + k * 1024); } while (0)
#define PG8_MMA(ai, bj, At, Bt) do { __builtin_amdgcn_s_setprio(1); _Pragma("unroll") for (int m = 0; m < 4; ++m) _Pragma("unroll") for (int n = 0; n < 2; ++n) _Pragma("unroll") for (int k = 0; k < 2; ++k) \
        acc[ai][bj][m][n] = __builtin_amdgcn_mfma_f32_16x16x32_bf16(Bt[n][k], At[m][k], acc[ai][bj][m][n], 0, 0, 0); __builtin_amdgcn_s_setprio(0); } while (0)
#define PG8_WAIT_V(n) asm volatile("s_waitcnt vmcnt(" #n ")" ::: "memory")
#define PG8_WAIT_L(n) asm volatile("s_waitcnt lgkmcnt(" #n ")" ::: "memory")
#define PG8_BAR __builtin_amdgcn_s_barrier()
#define PG8_SCHED __builtin_amdgcn_sched_barrier(0)
    Unit cur, nxt; int ui = 0;
    if (!S.next(0, cur)) return;
    f32x4 acc[2][2][4][2];
#pragma unroll
    for (int a = 0; a < 2; ++a)
#pragma unroll
        for (int b = 0; b < 2; ++b)
#pragma unroll
            for (int m = 0; m < 4; ++m)
#pragma unroll
                for (int n = 0; n < 2; ++n) acc[a][b][m][n] = (f32x4){0.f, 0.f, 0.f, 0.f};
    bf16x8 At[4][2], B0[2][2], B1[2][2];
    const char* cA = S.pa(g, cur, tstep); const char* cB = S.pb(g, cur, tstep);
    S.a_ready(cur);
    if constexpr (SP2) {
        PG8_STAGE(PG8_SB(0, 0), cB, voffB); PG8_STAGE(PG8_SB(0, 1), cB + hstep, voffB); PG8_STAGE(PG8_SA(0, 0), cA, voffA); PG8_STAGE(PG8_SA(0, 1), cA + hstep, voffA);
        if (wr == 1) PG8_BAR;
        PG8_WAIT_V(2); PG8_BAR;
        PG8_STAGE(PG8_SB(1, 0), cB + kstep, voffB); PG8_STAGE(PG8_SA(1, 0), cA + kstep, voffA); PG8_STAGE(PG8_SB(1, 1), cB + hstep + kstep, voffB);
        PG8_WAIT_V(6); PG8_BAR;
    } else {
        PG8_STAGE(PG8_SB(0, 0), cB, voffB); PG8_STAGE(PG8_SA(0, 0), cA, voffA); PG8_STAGE(PG8_SB(0, 1), cB + hstep, voffB); PG8_STAGE(PG8_SA(0, 1), cA + hstep, voffA);
        if (wr == 1) PG8_BAR;
        PG8_WAIT_V(4); PG8_BAR;
        PG8_STAGE(PG8_SB(1, 0), cB + kstep, voffB); PG8_STAGE(PG8_SA(1, 0), cA + kstep, voffA); PG8_STAGE(PG8_SB(1, 1), cB + hstep + kstep, voffB);
        PG8_WAIT_V(6); PG8_BAR;
    }
    for (;;) {
        const bool has_next = S.next(ui + 1, nxt);
        const char* nA = has_next ? S.pa(g, nxt, tstep) : cA; const char* nB = has_next ? S.pb(g, nxt, tstep) : cB;
        for (int t = 0; t < nt; t += 2) {
            const bool last = (t == nt - 2);
            const char* a1 = cA + (size_t)(t + 1) * kstep;
            const char* a2 = last ? nA : cA + (size_t)(t + 2) * kstep; const char* b2 = last ? nB : cB + (size_t)(t + 2) * kstep;
            const char* a3 = a2 + kstep; const char* b3 = b2 + kstep;
            if (last && has_next) S.a_ready(nxt);
            if constexpr (SP2) {
            PG8_LDB(B0, 0, 0); PG8_LDB(B1, 0, 1); PG8_SCHED; PG8_LDA(At, 0, 0); PG8_STAGE(PG8_SA(1, 1), a1 + hstep, voffA);
            PG8_WAIT_V(8); PG8_WAIT_L(0); PG8_BAR; PG8_MMA(0, 0, At, B0); PG8_MMA(0, 1, At, B1); PG8_BAR; PG8_SCHED;
            PG8_LDA(At, 0, 1); PG8_STAGE(PG8_SB(0, 0), b2, voffB); PG8_STAGE(PG8_SB(0, 1), b2 + hstep, voffB); PG8_STAGE(PG8_SA(0, 0), a2, voffA);
            PG8_WAIT_V(8); PG8_WAIT_L(0); PG8_BAR; PG8_MMA(1, 0, At, B0); PG8_MMA(1, 1, At, B1); PG8_BAR; PG8_SCHED;
            PG8_LDB(B0, 1, 0); PG8_LDB(B1, 1, 1); PG8_SCHED; PG8_LDA(At, 1, 0); PG8_STAGE(PG8_SA(0, 1), a2 + hstep, voffA);
            PG8_WAIT_V(8); PG8_WAIT_L(0); PG8_BAR; PG8_MMA(0, 0, At, B0); PG8_MMA(0, 1, At, B1); PG8_BAR; PG8_SCHED;
            PG8_LDA(At, 1, 1); PG8_STAGE(PG8_SB(1, 0), b3, voffB); PG8_STAGE(PG8_SB(1, 1), b3 + hstep, voffB); PG8_STAGE(PG8_SA(1, 0), a3, voffA);
            PG8_WAIT_V(8); PG8_WAIT_L(0); PG8_BAR; PG8_MMA(1, 0, At, B0); PG8_MMA(1, 1, At, B1); PG8_BAR; PG8_SCHED;
            } else {
            PG8_LDB(B0, 0, 0); PG8_SCHED; PG8_LDA(At, 0, 0); PG8_STAGE(PG8_SA(1, 1), a1 + hstep, voffA);
            PG8_WAIT_L(8); PG8_BAR; PG8_WAIT_L(0); PG8_MMA(0, 0, At, B0); PG8_BAR; PG8_SCHED;
            PG8_LDB(B1, 0, 1); PG8_STAGE(PG8_SB(0, 0), b2, voffB);
            PG8_BAR; PG8_WAIT_L(0); PG8_MMA(0, 1, At, B1); PG8_BAR;
            PG8_LDA(At, 0, 1); PG8_STAGE(PG8_SA(0, 0), a2, voffA);
            PG8_BAR; PG8_WAIT_L(0); PG8_MMA(1, 0, At, B0); PG8_BAR; PG8_SCHED;
            PG8_STAGE(PG8_SB(0, 1), b2 + hstep, voffB);
            PG8_WAIT_V(6); PG8_BAR; PG8_MMA(1, 1, At, B1); PG8_BAR;
            PG8_LDB(B0, 1, 0); PG8_SCHED; PG8_LDA(At, 1, 0); PG8_STAGE(PG8_SA(0, 1), a2 + hstep, voffA);
            PG8_WAIT_L(8); PG8_BAR; PG8_WAIT_L(0); PG8_MMA(0, 0, At, B0); PG8_BAR; PG8_SCHED;
            PG8_LDB(B1, 1, 1); PG8_STAGE(PG8_SB(1, 0), b3, voffB);
            PG8_BAR; PG8_WAIT_L(0); PG8_MMA(0, 1, At, B1); PG8_BAR;
            PG8_LDA(At, 1, 1); PG8_STAGE(PG8_SA(1, 0), a3, voffA);
            PG8_BAR; PG8_WAIT_L(0); PG8_MMA(1, 0, At, B0); PG8_BAR; PG8_SCHED;
            PG8_STAGE(PG8_SB(1, 1), b3 + hstep, voffB);
            PG8_WAIT_V(6); PG8_BAR; PG8_MMA(1, 1, At, B1); PG8_BAR;
            }
        }
        if constexpr (ALIGN_EPI) { if (wr == 0) PG8_BAR; }
        if constexpr (!Epi::AFTER_DRAIN) { E(acc, cur, wr, wc, fr, fq); S.done(cur); }
        if (!has_next) break;
#pragma unroll
        for (int a = 0; a < 2; ++a)
#pragma unroll
            for (int b = 0; b < 2; ++b)
#pragma unroll
                for (int m = 0; m < 4; ++m)
#pragma unroll
                    for (int n = 0; n < 2; ++n) acc[a][b][m][n] = (f32x4){0.f, 0.f, 0.f, 0.f};
        cur = nxt; cA = nA; cB = nB; ++ui;
        if constexpr (ALIGN_EPI) { if (wr == 1) PG8_BAR; }
    }
    PG8_WAIT_V(0);
    if constexpr (!ALIGN_EPI) { if (wr == 0) PG8_BAR; }
    PG8_BAR;
    if constexpr (Epi::AFTER_DRAIN) { E.fused(acc, cur, wr, wc, fr, fq, lds, wid, lane); S.done(cur); }
#undef PG8_SA
#undef PG8_SB
#undef PG8_STAGE
#undef PG8_LDA
#undef PG8_LDB
#undef PG8_MMA
#undef PG8_WAIT_V
#undef PG8_WAIT_L
#undef PG8_BAR
#undef PG8_SCHED
}
}

namespace nsa {
#define NLAS __attribute__((address_space(3)))
typedef short bf16x8 __attribute__((ext_vector_type(8)));
typedef short s16x4 __attribute__((ext_vector_type(4)));
typedef short v4i16_t __attribute__((ext_vector_type(4)));
typedef float f32x4 __attribute__((ext_vector_type(4)));
typedef unsigned u32x4 __attribute__((ext_vector_type(4)));
typedef unsigned u32x2 __attribute__((ext_vector_type(2)));
typedef unsigned long long u64;
constexpr int RS = 144, TILE_B = 64 * RS;
constexpr float LOG2E = 1.4426950408889634f;
constexpr int L_KB0 = 0, L_VB0 = TILE_B, L_KB1 = 2 * TILE_B, L_VB1 = 3 * TILE_B, L_CK = 4 * TILE_B, L_CV = 8 * TILE_B, L_IMP = 12 * TILE_B, L_MSK = L_IMP + 8192, L_WU = L_MSK + 256, L_END = L_WU + 64;
static_assert(L_END <= 131072, "nsa LDS map");
__device__ __forceinline__ s16x4 vtr(const NLAS char* p) { return __builtin_bit_cast(s16x4, __builtin_amdgcn_ds_read_tr16_b64_v4i16((NLAS v4i16_t*)p)); }
__device__ __forceinline__ f32x4 mfma16(bf16x8 a, bf16x8 b, f32x4 c) { return __builtin_amdgcn_mfma_f32_16x16x32_bf16(a, b, c, 0, 0, 0); }
__device__ __forceinline__ unsigned pkbf(float lo, float hi) { return pg8::cvt_pk_bf16(lo, hi); }
__device__ __forceinline__ void qk_tile(f32x4 (&s)[4], const NLAS char* Kb, const bf16x8 (&qf)[2], int i, int g, float kslope, float bt) {
    bf16x8 a[4][2]; const NLAS char* kp = Kb + i * RS + 16 * g;
#pragma unroll
    for (int kb = 0; kb < 4; ++kb) { a[kb][0] = *(const NLAS bf16x8*)(kp + kb * 16 * RS); a[kb][1] = *(const NLAS bf16x8*)(kp + kb * 16 * RS + 64); }
#pragma unroll
    for (int kb = 0; kb < 4; ++kb) { f32x4 ci; ci[0] = fmaf(kslope, (float)(kb * 16 + 0), bt); ci[1] = fmaf(kslope, (float)(kb * 16 + 1), bt); ci[2] = fmaf(kslope, (float)(kb * 16 + 2), bt); ci[3] = fmaf(kslope, (float)(kb * 16 + 3), bt);
        s[kb] = mfma16(a[kb][0], qf[0], ci); }
#pragma unroll
    for (int kb = 0; kb < 4; ++kb) s[kb] = mfma16(a[kb][1], qf[1], s[kb]);
}
__device__ __forceinline__ void pv_tile(f32x4 (&o)[4], const NLAS char* Vb, const f32x4 (&p)[4], int i, int g) {
    const NLAS char* vb = Vb + (4 * g + (i >> 2)) * RS + (i & 3) * 8;
    s16x4 lo[2][4], hi[2][4];
#pragma unroll
    for (int kk = 0; kk < 2; ++kk)
#pragma unroll
        for (int db = 0; db < 4; ++db) { const NLAS char* vp = vb + (2 * kk) * 16 * RS + db * 32; lo[kk][db] = vtr(vp); hi[kk][db] = vtr(vp + 16 * RS); }
    bf16x8 pf[2];
#pragma unroll
    for (int kk = 0; kk < 2; ++kk) { u32x4 pw; pw.x = pkbf(p[2 * kk][0], p[2 * kk][1]); pw.y = pkbf(p[2 * kk][2], p[2 * kk][3]); pw.z = pkbf(p[2 * kk + 1][0], p[2 * kk + 1][1]); pw.w = pkbf(p[2 * kk + 1][2], p[2 * kk + 1][3]);
        pf[kk] = __builtin_bit_cast(bf16x8, pw); }
#pragma unroll
    for (int kk = 0; kk < 2; ++kk)
#pragma unroll
        for (int db = 0; db < 4; ++db) o[db] = mfma16((bf16x8){lo[kk][db][0], lo[kk][db][1], lo[kk][db][2], lo[kk][db][3], hi[kk][db][0], hi[kk][db][1], hi[kk][db][2], hi[kk][db][3]}, pf[kk], o[db]);
}
constexpr float THR = 6.0f;
template <bool FIRST>
__device__ __forceinline__ void online_tile(f32x4 (&s)[4], float& m, float& l, f32x4 (&o)[4], bool needmask, int base, int lo, int hi) {
    if (needmask) {
#pragma unroll
        for (int kb = 0; kb < 4; ++kb)
#pragma unroll
            for (int r = 0; r < 4; ++r) { const int pos = base + kb * 16 + r; s[kb][r] = (pos >= lo && pos <= hi) ? s[kb][r] : -INFINITY; } }
    float mt = fmaxf(fmaxf(fmaxf(s[0][0], s[0][1]), fmaxf(s[0][2], s[0][3])), fmaxf(fmaxf(s[1][0], s[1][1]), fmaxf(s[1][2], s[1][3])));
    mt = fmaxf(mt, fmaxf(fmaxf(fmaxf(s[2][0], s[2][1]), fmaxf(s[2][2], s[2][3])), fmaxf(fmaxf(s[3][0], s[3][1]), fmaxf(s[3][2], s[3][3]))));
    if (FIRST || __any(mt > THR)) {
        mt = fmaxf(mt, __shfl_xor(mt, 16)); mt = fmaxf(mt, __shfl_xor(mt, 32));
        const float d = FIRST ? mt : fmaxf(mt, 0.f), f = __builtin_amdgcn_exp2f(-d); m += d; l *= f;
#pragma unroll
        for (int db = 0; db < 4; ++db) o[db] = o[db] * f;
#pragma unroll
        for (int kb = 0; kb < 4; ++kb) s[kb] = s[kb] - d; }
    float sum = 0.f;
#pragma unroll
    for (int kb = 0; kb < 4; ++kb)
#pragma unroll
        for (int r = 0; r < 4; ++r) { const float p = __builtin_amdgcn_exp2f(s[kb][r]); s[kb][r] = p; sum += p; }
    l += sum;
}
struct Stg { u32x4 k, v; };
__device__ __forceinline__ void stg_load(Stg& r, const bf16_t* kb, const bf16_t* vb, size_t pitch, int tid) { const size_t off = (size_t)(tid >> 3) * pitch + (tid & 7) * 8; r.k = *(const u32x4*)(kb + off); r.v = *(const u32x4*)(vb + off); }
__device__ __forceinline__ void stg_store(NLAS char* lds, int ko, int vo, const Stg& r, int tid) { const int off = (tid >> 3) * RS + (tid & 7) * 16; *(NLAS u32x4*)(lds + ko + off) = r.k; *(NLAS u32x4*)(lds + vo + off) = r.v; }
__device__ __forceinline__ float sigm(float v) { return __builtin_amdgcn_rcpf(1.f + __expf(-v)); }

__device__ __forceinline__ void unit(NLAS char* lds, const bf16_t* P, const float* S32, const bf16_t* KC, const bf16_t* VC, bf16_t* Ynsa, int b, int gq, int ti) {
    const int tid = threadIdx.x, lane = tid & 63, w = __builtin_amdgcn_readfirstlane(tid >> 6), i = lane & 15, g = lane >> 4;
    const int t0 = ti * 32, tl_mine = i >> 2, r = i & 3, h = gq * 4 + r, t = t0 + 4 * w + tl_mine; const size_t m = (size_t)b * T + t;
    const float slope2 = __builtin_amdgcn_exp2f(-(float)(h + 1)) * LOG2E;
    bf16x8 qf[2]; constexpr float QS = 0.125f * LOG2E;
    { const bf16_t* qp = P + m * PW + P_NSQ + h * 64 + 8 * g;
#pragma unroll
      for (int ks = 0; ks < 2; ++ks) { const u32x4 raw = *(const u32x4*)(qp + 32 * ks); u32x4 sc;
          sc.x = pkbf(pg8::bflo(raw.x) * QS, pg8::bfhi(raw.x) * QS); sc.y = pkbf(pg8::bflo(raw.y) * QS, pg8::bfhi(raw.y) * QS);
          sc.z = pkbf(pg8::bflo(raw.z) * QS, pg8::bfhi(raw.z) * QS); sc.w = pkbf(pg8::bflo(raw.w) * QS, pg8::bfhi(raw.w) * QS);
          qf[ks] = __builtin_bit_cast(bf16x8, sc); } }
    const float* gp = S32 + m * 32 + 8 + h * 3;
    const float gate0 = sigm(gp[0]), gate1 = sigm(gp[1]), gate2 = sigm(gp[2]);
    f32x4 outacc[4];
#pragma unroll
    for (int db = 0; db < 4; ++db) outacc[db] = (f32x4){0.f, 0.f, 0.f, 0.f};
    const int ntc = (ti >> 5) + 1;
    for (int tile = 0; tile < ntc; ++tile) { Stg sr; const size_t row0 = ((size_t)(b * 256 + tile * 64) * 2 + gq) * 64; stg_load(sr, KC + row0, VC + row0, 128, tid); stg_store(lds, L_CK + tile * TILE_B, L_CV + tile * TILE_B, sr, tid); }
    __syncthreads();
    { const int nmax = (t - 31) >> 4; const float kslope = 16.f * slope2, c = -slope2 * (float)(t - 31);
      float mc = -INFINITY, lc = 0.f;
#pragma unroll 1
      for (int tile = 0; tile < ntc; ++tile) { f32x4 s[4]; qk_tile(s, lds + L_CK + tile * TILE_B, qf, i, g, kslope, fmaf(kslope, (float)(tile * 64 + 4 * g), c));
          float mt = -INFINITY;
#pragma unroll
          for (int kb = 0; kb < 4; ++kb)
#pragma unroll
              for (int rr = 0; rr < 4; ++rr) { const int n = tile * 64 + kb * 16 + 4 * g + rr; const float v = (n <= nmax) ? s[kb][rr] : -INFINITY; s[kb][rr] = v; mt = fmaxf(mt, v); }
          mt = fmaxf(mt, __shfl_xor(mt, 16)); mt = fmaxf(mt, __shfl_xor(mt, 32));
          const float mn = fmaxf(mc, mt), ms = (mn == -INFINITY) ? 0.f : mn; float sum = 0.f;
#pragma unroll
          for (int kb = 0; kb < 4; ++kb)
#pragma unroll
              for (int rr = 0; rr < 4; ++rr) sum += __builtin_amdgcn_exp2f(s[kb][rr] - ms);
          lc = lc * __builtin_amdgcn_exp2f(mc - ms) + sum; mc = mn; }
      lc += __shfl_xor(lc, 16); lc += __shfl_xor(lc, 32);
      const float ms = (mc == -INFINITY) ? 0.f : mc, inv = lc > 0.f ? 1.f / lc : 0.f;
      f32x4 oc[4];
#pragma unroll
      for (int db = 0; db < 4; ++db) oc[db] = (f32x4){0.f, 0.f, 0.f, 0.f};
      NLAS float* imp_s = (NLAS float*)(lds + L_IMP) + (w * 4 + tl_mine) * 64;
      float cprev = 0.f;
#pragma unroll 1
      for (int tile = 0; tile < 4; ++tile) {
          if (tile < ntc) { f32x4 s[4]; qk_tile(s, lds + L_CK + tile * TILE_B, qf, i, g, kslope, fmaf(kslope, (float)(tile * 64 + 4 * g), c));
#pragma unroll
              for (int kb = 0; kb < 4; ++kb)
#pragma unroll
                  for (int rr = 0; rr < 4; ++rr) { const int n = tile * 64 + kb * 16 + 4 * g + rr; const float v = (n <= nmax) ? s[kb][rr] : -INFINITY; s[kb][rr] = __builtin_amdgcn_exp2f(v - ms) * inv; }
              pv_tile(oc, lds + L_CV + tile * TILE_B, s, i, g);
#pragma unroll
              for (int kb = 0; kb < 4; ++kb) { const f32x4 pv = s[kb];
                  float a = (pv[0] + pv[1]) + (pv[2] + pv[3]), cc = pv[3];
                  a += __shfl_xor(a, 1); a += __shfl_xor(a, 2); cc += __shfl_xor(cc, 1); cc += __shfl_xor(cc, 2);
                  const float up = __shfl(cc, (lane + 48) & 63);
                  const float im = a + (g > 0 ? up : cprev); cprev = up;
                  if (r == 0) imp_s[4 * (tile * 4 + kb) + g] = im; }
          } else { if (r == 0) {
#pragma unroll
              for (int kb = 0; kb < 4; ++kb) imp_s[4 * (tile * 4 + kb) + g] = 0.f; } }
      }
#pragma unroll
      for (int db = 0; db < 4; ++db) outacc[db] = outacc[db] + oc[db] * gate0;
    }
    __syncthreads();
    NLAS float* impw = (NLAS float*)(lds + L_IMP) + w * 256;
    float myscore[4];
#pragma unroll
    for (int tl = 0; tl < 4; ++tl) { const int tt = t0 + 4 * w + tl, cur = tt >> 6, j = lane; const bool valid = j <= cur, forced = (j == 0) || (j == cur) || (j == cur - 1);
        const float s = valid ? impw[tl * 64 + j] + (forced ? 1000.f : 0.f) : -1e30f; myscore[tl] = s; }
    __syncthreads();
#pragma unroll
    for (int tl = 0; tl < 4; ++tl) impw[tl * 64 + lane] = myscore[tl];
    __syncthreads();
    u64 wmask[4], wun = 0ull;
#pragma unroll
    for (int tl = 0; tl < 4; ++tl) { const int tt = t0 + 4 * w + tl, cur = tt >> 6; const float s = myscore[tl]; int rank = 0;
        for (int jj = 0; jj < 64; ++jj) { const float o = impw[tl * 64 + jj]; rank += (o > s || (o == s && jj < lane)) ? 1 : 0; }
        wmask[tl] = __ballot(rank < 16 && lane <= cur); wun |= wmask[tl]; }
    if (lane == 0) { NLAS u64* mk = (NLAS u64*)(lds + L_MSK) + w * 4; mk[0] = wmask[0]; mk[1] = wmask[1]; mk[2] = wmask[2]; mk[3] = wmask[3]; ((NLAS u64*)(lds + L_WU))[w] = wun; }
    __syncthreads();
    const u64 mymask = ((const NLAS u64*)(lds + L_MSK))[w * 4 + tl_mine];
    u64 uall = 0ull;
#pragma unroll
    for (int ww = 0; ww < 8; ++ww) uall |= ((const NLAS u64*)(lds + L_WU))[ww];
    uall = ((u64)__builtin_amdgcn_readfirstlane((unsigned)(uall >> 32)) << 32) | (u64)__builtin_amdgcn_readfirstlane((unsigned)uall);
    const size_t rowb = (size_t)b * T;
    {
        float ms_ = 0.f, ls = 0.f; f32x4 os[4];
#pragma unroll
        for (int db = 0; db < 4; ++db) os[db] = (f32x4){0.f, 0.f, 0.f, 0.f};
        const bf16_t* kcol = P + rowb * PW + P_KS + gq * 64; const bf16_t* vcol = P + rowb * PW + P_VS + gq * 64;
        const float c = -slope2 * (float)t;
        const int jcur = t0 >> 6;
        const u64 wall = ((const NLAS u64*)(lds + L_MSK))[w * 4 + 0] & ((const NLAS u64*)(lds + L_MSK))[w * 4 + 1] & ((const NLAS u64*)(lds + L_MSK))[w * 4 + 2] & ((const NLAS u64*)(lds + L_MSK))[w * 4 + 3];
        const u64 wallu = ((u64)__builtin_amdgcn_readfirstlane((unsigned)(wall >> 32)) << 32) | (u64)__builtin_amdgcn_readfirstlane((unsigned)wall);
        u64 rem = uall & ((1ull << jcur) - 1ull); int j = jcur; int cur = 0; bool first = true;
        Stg sr; stg_load(sr, kcol + (size_t)j * 64 * PW, vcol + (size_t)j * 64 * PW, PW, tid); stg_store(lds, L_KB0, L_VB0, sr, tid);
        int jn = rem ? 63 - __builtin_clzll(rem) : -1; if (jn >= 0) rem &= ~(1ull << jn);
        if (jn >= 0) stg_load(sr, kcol + (size_t)jn * 64 * PW, vcol + (size_t)jn * 64 * PW, PW, tid);
        __syncthreads();
        for (;;) {
            const int jnn = (jn >= 0 && rem) ? 63 - __builtin_clzll(rem) : -1; if (jnn >= 0) rem &= ~(1ull << jnn);
            if (jn >= 0) stg_store(lds, cur ? L_KB0 : L_KB1, cur ? L_VB0 : L_VB1, sr, tid);
            if (jnn >= 0) stg_load(sr, kcol + (size_t)jnn * 64 * PW, vcol + (size_t)jnn * 64 * PW, PW, tid);
            if ((wun >> j) & 1ull) { f32x4 s[4];
                const float bt = fmaf(slope2, (float)(j * 64 + 4 * g), c) - ms_ + (((mymask >> j) & 1ull) ? 0.f : -1e30f);
                qk_tile(s, lds + (cur ? L_KB1 : L_KB0), qf, i, g, slope2, bt);
                if (first) online_tile<true>(s, ms_, ls, os, true, j * 64 + 4 * g, 0, t); else online_tile<false>(s, ms_, ls, os, false, 0, 0, 0);
                pv_tile(os, lds + (cur ? L_VB1 : L_VB0), s, i, g); }
            first = false;
            __syncthreads();
            if (jn < 0) break;
            j = jn; jn = jnn; cur ^= 1;
        }
        ls += __shfl_xor(ls, 16); ls += __shfl_xor(ls, 32);
        const float sc1 = gate1 / ls;
#pragma unroll
        for (int db = 0; db < 4; ++db) outacc[db] = outacc[db] + os[db] * sc1;
    }
    {
        float mw = 0.f, lw = 0.f; f32x4 ow[4];
#pragma unroll
        for (int db = 0; db < 4; ++db) ow[db] = (f32x4){0.f, 0.f, 0.f, 0.f};
        const bf16_t* kcol = P + rowb * PW + P_KW + gq * 64; const bf16_t* vcol = P + rowb * PW + P_VW + gq * 64;
        const float c = -slope2 * (float)t;
        const int j0 = (t0 - 511) > 0 ? ((t0 - 511) >> 6) : 0, j1 = t0 >> 6, tw0 = t0 + 4 * w;
        int j = j1, cur = 0; bool first = true;
        Stg sr; stg_load(sr, kcol + (size_t)j * 64 * PW, vcol + (size_t)j * 64 * PW, PW, tid); stg_store(lds, L_KB0, L_VB0, sr, tid);
        if (j > j0) stg_load(sr, kcol + (size_t)(j - 1) * 64 * PW, vcol + (size_t)(j - 1) * 64 * PW, PW, tid);
        __syncthreads();
        for (;;) {
            if (j > j0) stg_store(lds, cur ? L_KB0 : L_KB1, cur ? L_VB0 : L_VB1, sr, tid);
            if (j - 1 > j0) stg_load(sr, kcol + (size_t)(j - 2) * 64 * PW, vcol + (size_t)(j - 2) * 64 * PW, PW, tid);
            if (64 * j <= tw0 + 3 && 64 * j + 63 >= tw0 - 511) { f32x4 s[4];
                qk_tile(s, lds + (cur ? L_KB1 : L_KB0), qf, i, g, slope2, fmaf(slope2, (float)(j * 64 + 4 * g), c) - mw);
                const bool needmask = first || (64 * j < tw0 + 3 - 511);
                if (first) online_tile<true>(s, mw, lw, ow, true, j * 64 + 4 * g, t - 511, t); else online_tile<false>(s, mw, lw, ow, needmask, j * 64 + 4 * g, t - 511, t);
                pv_tile(ow, lds + (cur ? L_VB1 : L_VB0), s, i, g); }
            first = false;
            __syncthreads();
            if (j <= j0) break;
            --j; cur ^= 1;
        }
        lw += __shfl_xor(lw, 16); lw += __shfl_xor(lw, 32);
        const float sc2 = gate2 / lw;
#pragma unroll
        for (int db = 0; db < 4; ++db) outacc[db] = outacc[db] + ow[db] * sc2;
    }
    bf16_t* yo = Ynsa + m * 512 + h * 64 + 4 * g;
#pragma unroll
    for (int db = 0; db < 4; ++db) { u32x2 v; v.x = pkbf(outacc[db][0], outacc[db][1]); v.y = pkbf(outacc[db][2], outacc[db][3]); *(u32x2*)(yo + db * 16) = v; }
}
__device__ __forceinline__ void phase(NLAS char* lds, const bf16_t* P, const float* S32, const bf16_t* KC, const bf16_t* VC, bf16_t* Ynsa) {
    const int G = gridDim.x, bid = blockIdx.x;
    if (G == 256) { const int base = bid >> 3, bg = bid & 7;
#pragma unroll 1
        for (int k = 0; k < 4; ++k) { const int ti = (k == 0) ? 127 - base : (k == 1) ? 64 + base : (k == 2) ? 63 - base : base; unit(lds, P, S32, KC, VC, Ynsa, bg >> 1, bg & 1, ti); } }
    else {
#pragma unroll 1
        for (int u = bid; u < 1024; u += G) unit(lds, P, S32, KC, VC, Ynsa, (u & 7) >> 1, u & 1, 127 - (u >> 3)); }
}
}

namespace xa {
using nsa::bf16x8; using nsa::s16x4; using nsa::f32x4; using nsa::u32x4; using nsa::u32x2; using nsa::vtr; using nsa::mfma16; using nsa::pkbf;
constexpr int RS = 272, TILE_B = 64 * RS;
__device__ __forceinline__ int l_k(int tile) { return tile * 2 * TILE_B; }
__device__ __forceinline__ int l_v(int tile) { return tile * 2 * TILE_B + TILE_B; }
__device__ __forceinline__ void unit(NLAS char* lds, const bf16_t* P, const bf16_t* MEMKV, bf16_t* Yxa, int b, int h, int tt) {
    const int tid = threadIdx.x, lane = tid & 63, w = __builtin_amdgcn_readfirstlane(tid >> 6), i = lane & 15, g = lane >> 4;
    const size_t m = (size_t)b * T + tt * 128 + 16 * w + i;
    const bf16_t* kbase = MEMKV + (size_t)b * 256 * 1024 + h * 128;
    { u32x4 st[4][4]; const bf16_t* p0 = kbase + (size_t)(tid >> 3) * 1024 + (tid & 7) * 8;
#pragma unroll
      for (int tile = 0; tile < 4; ++tile) { const bf16_t* p = p0 + (size_t)tile * 64 * 1024; st[tile][0] = *(const u32x4*)p; st[tile][1] = *(const u32x4*)(p + 64); st[tile][2] = *(const u32x4*)(p + 512); st[tile][3] = *(const u32x4*)(p + 576); }
      const int off = (tid >> 3) * RS + (tid & 7) * 16;
#pragma unroll
      for (int tile = 0; tile < 4; ++tile) { *(NLAS u32x4*)(lds + l_k(tile) + off) = st[tile][0]; *(NLAS u32x4*)(lds + l_k(tile) + off + 128) = st[tile][1]; *(NLAS u32x4*)(lds + l_v(tile) + off) = st[tile][2]; *(NLAS u32x4*)(lds + l_v(tile) + off + 128) = st[tile][3]; } }
    bf16x8 qf[4];
    { const bf16_t* qp = P + m * PW + P_XAQ + h * 128 + 8 * g;
#pragma unroll
      for (int ks = 0; ks < 4; ++ks) qf[ks] = *(const bf16x8*)(qp + 32 * ks); }
    const float scale2 = 0.08838834764831845f * nsa::LOG2E;
    float mx = -INFINITY, l = 0.f; f32x4 o[8];
#pragma unroll
    for (int db = 0; db < 8; ++db) o[db] = (f32x4){0.f, 0.f, 0.f, 0.f};
    __syncthreads();
#pragma unroll 1
    for (int tile = 0; tile < 4; ++tile) {
        const NLAS char* Kb = lds + l_k(tile); const NLAS char* Vb = lds + l_v(tile);
        f32x4 s[4];
        { bf16x8 a[4][4];
#pragma unroll
          for (int kb = 0; kb < 4; ++kb)
#pragma unroll
              for (int ks = 0; ks < 4; ++ks) a[kb][ks] = *(const NLAS bf16x8*)(Kb + (kb * 16 + i) * RS + 16 * g + 64 * ks);
#pragma unroll
          for (int kb = 0; kb < 4; ++kb) s[kb] = mfma16(a[kb][0], qf[0], (f32x4){0.f, 0.f, 0.f, 0.f});
#pragma unroll
          for (int ks = 1; ks < 4; ++ks)
#pragma unroll
              for (int kb = 0; kb < 4; ++kb) s[kb] = mfma16(a[kb][ks], qf[ks], s[kb]); }
        float mt = -INFINITY;
#pragma unroll
        for (int kb = 0; kb < 4; ++kb)
#pragma unroll
            for (int r = 0; r < 4; ++r) { const float v = s[kb][r] * scale2; s[kb][r] = v; mt = fmaxf(mt, v); }
        mt = fmaxf(mt, __shfl_xor(mt, 16)); mt = fmaxf(mt, __shfl_xor(mt, 32));
        const float mn = fmaxf(mx, mt), alpha = __builtin_amdgcn_exp2f(mx - mn); float sum = 0.f;
#pragma unroll
        for (int kb = 0; kb < 4; ++kb)
#pragma unroll
            for (int r = 0; r < 4; ++r) { const float p = __builtin_amdgcn_exp2f(s[kb][r] - mn); s[kb][r] = p; sum += p; }
        l = l * alpha + sum; mx = mn;
#pragma unroll
        for (int db = 0; db < 8; ++db) o[db] = o[db] * alpha;
        const NLAS char* vb = Vb + (4 * g + (i >> 2)) * RS + (i & 3) * 8;
#pragma unroll
        for (int kk = 0; kk < 2; ++kk) {
            u32x4 pw; pw.x = pkbf(s[2 * kk][0], s[2 * kk][1]); pw.y = pkbf(s[2 * kk][2], s[2 * kk][3]); pw.z = pkbf(s[2 * kk + 1][0], s[2 * kk + 1][1]); pw.w = pkbf(s[2 * kk + 1][2], s[2 * kk + 1][3]);
            const bf16x8 pf = __builtin_bit_cast(bf16x8, pw);
            s16x4 lo[8], hi[8];
#pragma unroll
            for (int db = 0; db < 8; ++db) { const NLAS char* vp = vb + (2 * kk) * 16 * RS + db * 32; lo[db] = vtr(vp); hi[db] = vtr(vp + 16 * RS); }
#pragma unroll
            for (int db = 0; db < 8; ++db) o[db] = mfma16((bf16x8){lo[db][0], lo[db][1], lo[db][2], lo[db][3], hi[db][0], hi[db][1], hi[db][2], hi[db][3]}, pf, o[db]);
        }
    }
    l += __shfl_xor(l, 16); l += __shfl_xor(l, 32);
    const float inv = 1.f / l;
    bf16_t* yo = Yxa + m * 512 + h * 128 + 4 * g;
#pragma unroll
    for (int db = 0; db < 8; ++db) { u32x2 v; v.x = pkbf(o[db][0] * inv, o[db][1] * inv); v.y = pkbf(o[db][2] * inv, o[db][3] * inv); *(u32x2*)(yo + db * 16) = v; }
    __syncthreads();
}
__device__ __forceinline__ void memkv_tile(const bf16_t* MEMN, const bf16_t* Wmkv, bf16_t* MEMKV, int tile) {
    const int tid = threadIdx.x, lane = tid & 63, w = __builtin_amdgcn_readfirstlane(tid >> 6), i = lane & 15, g = lane >> 4;
    const int r0 = (tile >> 4) * 64 + (w >> 1) * 16, c0 = (tile & 15) * 64 + (w & 1) * 32;
    const bf16_t* ap = MEMN + (size_t)(r0 + i) * 1024 + 8 * g; const bf16_t* bp = Wmkv + (size_t)(c0 + i) * 1024 + 8 * g;
    f32x4 acc0 = (f32x4){0.f, 0.f, 0.f, 0.f}, acc1 = acc0;
#pragma unroll 1
    for (int k0 = 0; k0 < 32; k0 += 8) { bf16x8 a[8], b0[8], b1[8];
#pragma unroll
        for (int kk = 0; kk < 8; ++kk) { a[kk] = *(const bf16x8*)(ap + 32 * (k0 + kk)); b0[kk] = *(const bf16x8*)(bp + 32 * (k0 + kk)); b1[kk] = *(const bf16x8*)(bp + 16 * 1024 + 32 * (k0 + kk)); }
#pragma unroll
        for (int kk = 0; kk < 8; ++kk) { acc0 = mfma16(a[kk], b0[kk], acc0); acc1 = mfma16(a[kk], b1[kk], acc1); } }
#pragma unroll
    for (int r = 0; r < 4; ++r) { bf16_t* o = MEMKV + (size_t)(r0 + 4 * g + r) * 1024 + c0 + i; o[0] = f2bf(acc0[r]); o[16] = f2bf(acc1[r]); }
}
__device__ __forceinline__ void phase(NLAS char* lds, const bf16_t* P, const bf16_t* MEMKV, bf16_t* Yxa) {
#pragma unroll 1
    for (int u = blockIdx.x; u < 512; u += gridDim.x) unit(lds, P, MEMKV, Yxa, u >> 7, (u >> 5) & 3, u & 31);
}
}

namespace ml {
using nsa::bf16x8; using nsa::s16x4; using nsa::f32x4; using nsa::u32x4; using nsa::u32x2; using nsa::vtr; using nsa::mfma16; using nsa::pkbf;
constexpr int RS = 272, TB = 64 * RS, RSS = 144;
constexpr float KSCALE = 0.08838834764831845f;
__device__ __forceinline__ float scan_add(float v, int lane) {
#pragma unroll
    for (int o = 1; o < 64; o <<= 1) { const float u = __shfl_up(v, o); if (lane >= o) v += u; }
    return v; }
__device__ __forceinline__ float scan_max(float v, int lane) {
#pragma unroll
    for (int o = 1; o < 64; o <<= 1) { const float u = __shfl_up(v, o); if (lane >= o) v = fmaxf(v, u); }
    return v; }
__device__ __forceinline__ bf16x8 trpair(const NLAS char* p, int hi_off) { const s16x4 lo = vtr(p), hi = vtr(p + hi_off); return (bf16x8){lo[0], lo[1], lo[2], lo[3], hi[0], hi[1], hi[2], hi[3]}; }
__device__ __forceinline__ void load_conv(NLAS char* dst, const bf16_t* P, const float* cw, int colP, int cwc, size_t m0, int tseq0, int tid) {
    const int s = tid >> 3, c16 = (tid & 7) * 16;
#pragma unroll
    for (int half = 0; half < 2; ++half) { const int c = c16 + half * 8; float acc[8];
#pragma unroll
        for (int e = 0; e < 8; ++e) acc[e] = 0.f;
#pragma unroll
        for (int j = 0; j < 4; ++j) { if (tseq0 + s - j >= 0) { const u32x4 raw = *(const u32x4*)(P + (m0 + s - j) * PW + colP + c);
            const f32x4 w0 = *(const f32x4*)(cw + j * 1024 + cwc + c), w1 = *(const f32x4*)(cw + j * 1024 + cwc + c + 4);
            acc[0] += w0[0] * pg8::bflo(raw.x); acc[1] += w0[1] * pg8::bfhi(raw.x); acc[2] += w0[2] * pg8::bflo(raw.y); acc[3] += w0[3] * pg8::bfhi(raw.y);
            acc[4] += w1[0] * pg8::bflo(raw.z); acc[5] += w1[1] * pg8::bfhi(raw.z); acc[6] += w1[2] * pg8::bflo(raw.w); acc[7] += w1[3] * pg8::bfhi(raw.w); } }
#pragma unroll
        for (int e = 0; e < 8; ++e) acc[e] = acc[e] * __builtin_amdgcn_rcpf(1.f + __expf(-acc[e]));
        u32x4 o; o.x = pkbf(acc[0], acc[1]); o.y = pkbf(acc[2], acc[3]); o.z = pkbf(acc[4], acc[5]); o.w = pkbf(acc[6], acc[7]);
        *(NLAS u32x4*)(dst + s * RS + c * 2) = o; }
}
__device__ __forceinline__ void m1_unit(NLAS char* lds, const bf16_t* P, const float* cw, const float* S32, bf16_t* Abuf, float* NA, float* Gc, float* Mloc, int ci) {
    constexpr int L_K = 0, L_EV = TB, L_E = 2 * TB;
    const int tid = threadIdx.x, lane = tid & 63, w = __builtin_amdgcn_readfirstlane(tid >> 6), i = lane & 15, g = lane >> 4;
    const int c = ci & 63, bh = ci >> 6, h = bh & 3, b = bh >> 2; const size_t m0 = (size_t)b * T + c * 64;
    NLAS float* eS = (NLAS float*)(lds + L_E);
    if (w == 0) { const float fpre = S32[(m0 + lane) * 32 + 4 + h], ipre = S32[(m0 + lane) * 32 + h];
        const float bcs = scan_add(logsig(fpre), lane), gtot = __shfl(bcs, 63), wend = gtot - bcs + ipre, mloc = wave_max(wend);
        eS[lane] = __expf(wend - mloc) * KSCALE; if (lane == 0) { Gc[ci] = gtot; Mloc[ci] = mloc; } }
    load_conv(lds + L_K, P, cw, P_MLK + h * 128, 512 + h * 128, m0, c * 64, tid);
    __syncthreads();
    { const int s = tid >> 3, c16 = (tid & 7) * 16; const float es = eS[s]; const bf16_t* vp = P + (m0 + s) * PW + P_MLV + h * 128 + c16;
#pragma unroll
      for (int half = 0; half < 2; ++half) { const u32x4 raw = *(const u32x4*)(vp + half * 8); u32x4 o;
          o.x = pkbf(pg8::bflo(raw.x) * es, pg8::bfhi(raw.x) * es); o.y = pkbf(pg8::bflo(raw.y) * es, pg8::bfhi(raw.y) * es);
          o.z = pkbf(pg8::bflo(raw.z) * es, pg8::bfhi(raw.z) * es); o.w = pkbf(pg8::bflo(raw.w) * es, pg8::bfhi(raw.w) * es);
          *(NLAS u32x4*)(lds + L_EV + s * RS + (c16 + half * 8) * 2) = o; } }
    __syncthreads();
    f32x4 acc[8];
#pragma unroll
    for (int vb = 0; vb < 8; ++vb) acc[vb] = (f32x4){0.f, 0.f, 0.f, 0.f};
    const int rowoff = (4 * g + (i >> 2)) * RS + (i & 3) * 8;
#pragma unroll
    for (int kk = 0; kk < 2; ++kk) { const bf16x8 kf = trpair(lds + L_K + kk * 32 * RS + rowoff + w * 32, 16 * RS);
#pragma unroll
        for (int vb = 0; vb < 8; ++vb) acc[vb] = mfma16(trpair(lds + L_EV + kk * 32 * RS + rowoff + vb * 32, 16 * RS), kf, acc[vb]); }
    bf16_t* ap = Abuf + ((size_t)ci * 128 + w * 16 + i) * 128 + 4 * g;
#pragma unroll
    for (int vb = 0; vb < 8; ++vb) { u32x2 pk; pk.x = pkbf(acc[vb][0], acc[vb][1]); pk.y = pkbf(acc[vb][2], acc[vb][3]); *(u32x2*)(ap + vb * 16) = pk; }
    { const int k = tid >> 2, part = tid & 3; float n = 0.f;
#pragma unroll
      for (int s = 0; s < 16; ++s) n += eS[part * 16 + s] * bf2f(*(const NLAS bf16_t*)(lds + L_K + (part * 16 + s) * RS + k * 2));
      n += __shfl_xor(n, 1); n += __shfl_xor(n, 2); if (part == 0) NA[(size_t)ci * 128 + k] = n; }
    __syncthreads();
}
__device__ __forceinline__ void m2_items(bf16_t* Abuf, float* NA, const float* Gc, const float* Mloc, float* Mprev) {
    for (int it = blockIdx.x * blockDim.x + threadIdx.x; it < 16 * 128 * 64; it += gridDim.x * blockDim.x) {
        const int bh = it >> 13, kv2 = it & 8191, k = kv2 >> 6, v2 = kv2 & 63;
        float C0 = 0.f, C1 = 0.f, n = 0.f, m = 0.f;
        unsigned* base = (unsigned*)(Abuf + ((size_t)(bh * 64) * 128 + k) * 128 + v2 * 2);
#pragma unroll 1
        for (int c0 = 0; c0 < 64; c0 += 16) { unsigned A[16];
#pragma unroll
            for (int u = 0; u < 16; ++u) A[u] = base[(size_t)(c0 + u) * 8192];
#pragma unroll
            for (int u = 0; u < 16; ++u) { const int ci = bh * 64 + c0 + u; const float gg = Gc[ci], ml = Mloc[ci];
                const float mn = fmaxf(gg + m, ml), a = __expf(gg + m - mn), bb = __expf(ml - mn);
                base[(size_t)(c0 + u) * 8192] = pkbf(C0, C1); C0 = C0 * a + pg8::bflo(A[u]) * bb; C1 = C1 * a + pg8::bfhi(A[u]) * bb;
                if (v2 == 0) { const float nA = NA[(size_t)ci * 128 + k]; NA[(size_t)ci * 128 + k] = n; n = a * n + bb * nA; }
                if (kv2 == 0) Mprev[ci] = m;
                m = mn; } }
    }
}
__device__ __forceinline__ void m3_unit(NLAS char* lds, const bf16_t* P, const float* cw, const float* S32, const bf16_t* Cprev, const float* Nprev, const float* Mprev, const float* normg, bf16_t* Yml, int ci) {
    constexpr int L_Q = 0, L_K = TB, L_V = 2 * TB, L_C = 3 * TB, L_S = 5 * TB, L_F = L_S + 64 * RSS;
    const int tid = threadIdx.x, lane = tid & 63, w = __builtin_amdgcn_readfirstlane(tid >> 6), i = lane & 15, g = lane >> 4;
    const int c = ci & 63, bh = ci >> 6, h = bh & 3, b = bh >> 2; const size_t m0 = (size_t)b * T + c * 64;
    bf16_t ov[4][4]; float ng[4];
    { const int tb_ = w >> 1, vb0_ = (w & 1) * 4;
#pragma unroll
      for (int vb = 0; vb < 4; ++vb) { ng[vb] = normg[h * 128 + (vb0_ + vb) * 16 + i];
#pragma unroll
          for (int r = 0; r < 4; ++r) ov[vb][r] = P[(m0 + tb_ * 16 + 4 * g + r) * PW + P_MLO + h * 128 + (vb0_ + vb) * 16 + i]; } }
    NLAS float* F = (NLAS float*)(lds + L_F);
    NLAS float* rowf = F; NLAS float* colf = F + 64; NLAS float* scv = F + 128; NLAS float* emt = F + 192; NLAS float* qn = F + 256; NLAS float* nprev = F + 320; NLAS float* denp = F + 448; NLAS float* ssq = F + 576;
    if (w == 0) { const float fpre = S32[(m0 + lane) * 32 + 4 + h], ipre = S32[(m0 + lane) * 32 + h], mprev = Mprev[ci];
        const float bcs = scan_add(logsig(fpre), lane), u = ipre - bcs, pm = scan_max(u, lane), mt = bcs + fmaxf(mprev, pm);
        rowf[lane] = bcs - mt; colf[lane] = u; scv[lane] = __expf(bcs + mprev - mt); emt[lane] = __expf(-mt); }
    else if (w <= 2) nprev[tid - 64] = Nprev[(size_t)ci * 128 + tid - 64];
    load_conv(lds + L_Q, P, cw, P_MLQ + h * 128, h * 128, m0, c * 64, tid);
    load_conv(lds + L_K, P, cw, P_MLK + h * 128, 512 + h * 128, m0, c * 64, tid);
    { const int s = tid >> 3, c16 = (tid & 7) * 16; const bf16_t* vp = P + (m0 + s) * PW + P_MLV + h * 128 + c16;
      *(NLAS u32x4*)(lds + L_V + s * RS + c16 * 2) = *(const u32x4*)vp; *(NLAS u32x4*)(lds + L_V + s * RS + c16 * 2 + 16) = *(const u32x4*)(vp + 8); }
    { const int k = tid >> 2, v0 = (tid & 3) * 32; const bf16_t* cp = Cprev + ((size_t)ci * 128 + k) * 128 + v0;
#pragma unroll
      for (int q8 = 0; q8 < 4; ++q8) *(NLAS u32x4*)(lds + L_C + k * RS + (v0 + q8 * 8) * 2) = *(const u32x4*)(cp + q8 * 8); }
    __syncthreads();
    { const int tq = tid >> 3, part = tid & 7; const u32x4 q0 = *(const NLAS u32x4*)(lds + L_Q + tq * RS + part * 32), q1 = *(const NLAS u32x4*)(lds + L_Q + tq * RS + part * 32 + 16);
      const NLAS f32x4* np = (const NLAS f32x4*)(nprev + part * 16); const f32x4 n0 = np[0], n1 = np[1], n2 = np[2], n3 = np[3];
      float a = pg8::bflo(q0.x) * n0[0] + pg8::bfhi(q0.x) * n0[1] + pg8::bflo(q0.y) * n0[2] + pg8::bfhi(q0.y) * n0[3] + pg8::bflo(q0.z) * n1[0] + pg8::bfhi(q0.z) * n1[1] + pg8::bflo(q0.w) * n1[2] + pg8::bfhi(q0.w) * n1[3]
              + pg8::bflo(q1.x) * n2[0] + pg8::bfhi(q1.x) * n2[1] + pg8::bflo(q1.y) * n2[2] + pg8::bfhi(q1.y) * n2[3] + pg8::bflo(q1.z) * n3[0] + pg8::bfhi(q1.z) * n3[1] + pg8::bflo(q1.w) * n3[2] + pg8::bfhi(q1.w) * n3[3];
      a += __shfl_xor(a, 1); a += __shfl_xor(a, 2); a += __shfl_xor(a, 4); if (part == 0) qn[tq] = a; }
    const int tb = w >> 1;
    {
        float rs[4] = {0.f, 0.f, 0.f, 0.f};
#pragma unroll
        for (int sbi = 0; sbi < 2; ++sbi) { const int sb = 2 * (w & 1) + sbi; f32x4 acc = (f32x4){0.f, 0.f, 0.f, 0.f};
            if (sb <= tb) {
#pragma unroll
                for (int ks = 0; ks < 4; ++ks) acc = mfma16(*(const NLAS bf16x8*)(lds + L_Q + (tb * 16 + i) * RS + (32 * ks + 8 * g) * 2), *(const NLAS bf16x8*)(lds + L_K + (sb * 16 + i) * RS + (32 * ks + 8 * g) * 2), acc); }
            const int s = sb * 16 + i; const float cf = colf[s];
#pragma unroll
            for (int r = 0; r < 4; ++r) { const int t = tb * 16 + 4 * g + r; const float v = (s <= t) ? acc[r] * KSCALE * __expf(rowf[t] + cf) : 0.f; rs[r] += v;
                *(NLAS bf16_t*)(lds + L_S + t * RSS + s * 2) = f2bf(v); } }
#pragma unroll
        for (int r = 0; r < 4; ++r) { float x = rs[r]; x += __shfl_xor(x, 1); x += __shfl_xor(x, 2); x += __shfl_xor(x, 4); x += __shfl_xor(x, 8); if (i == 0) denp[(w & 1) * 64 + tb * 16 + 4 * g + r] = x; }
    }
    __syncthreads();
    f32x4 a1[4], a2[4];
#pragma unroll
    for (int vb = 0; vb < 4; ++vb) { a1[vb] = (f32x4){0.f, 0.f, 0.f, 0.f}; a2[vb] = (f32x4){0.f, 0.f, 0.f, 0.f}; }
    const int vb0 = (w & 1) * 4, troff = (8 * g + (i >> 2)) * RS + (i & 3) * 8;
#pragma unroll
    for (int kk = 0; kk < 2; ++kk) { if (32 * kk <= tb * 16 + 15) { const bf16x8 sf = *(const NLAS bf16x8*)(lds + L_S + (tb * 16 + i) * RSS + (32 * kk + 8 * g) * 2);
#pragma unroll
        for (int vb = 0; vb < 4; ++vb) a1[vb] = mfma16(sf, trpair(lds + L_V + kk * 32 * RS + troff + (vb0 + vb) * 32, 4 * RS), a1[vb]); } }
#pragma unroll
    for (int ks = 0; ks < 4; ++ks) { const bf16x8 qf = *(const NLAS bf16x8*)(lds + L_Q + (tb * 16 + i) * RS + (32 * ks + 8 * g) * 2);
#pragma unroll
        for (int vb = 0; vb < 4; ++vb) a2[vb] = mfma16(qf, trpair(lds + L_C + ks * 32 * RS + troff + (vb0 + vb) * 32, 4 * RS), a2[vb]); }
    float hv[4][4], sq[4] = {0.f, 0.f, 0.f, 0.f};
#pragma unroll
    for (int r = 0; r < 4; ++r) { const int t = tb * 16 + 4 * g + r; const float sc = scv[t]; const float den = denp[t] + denp[64 + t] + sc * qn[t]; const float hd = 1.f / fmaxf(fabsf(den), emt[t]);
#pragma unroll
        for (int vb = 0; vb < 4; ++vb) { const float x = (a1[vb][r] + sc * a2[vb][r]) * hd; hv[vb][r] = x; sq[r] += x * x; } }
#pragma unroll
    for (int r = 0; r < 4; ++r) { float x = sq[r]; x += __shfl_xor(x, 1); x += __shfl_xor(x, 2); x += __shfl_xor(x, 4); x += __shfl_xor(x, 8); if (i == 0) ssq[(w & 1) * 64 + tb * 16 + 4 * g + r] = x; }
    __syncthreads();
#pragma unroll
    for (int r = 0; r < 4; ++r) { const int t = tb * 16 + 4 * g + r; const float rinv = rsqrtf((ssq[t] + ssq[64 + t]) * (1.f / 128.f) + EPS);
#pragma unroll
        for (int vb = 0; vb < 4; ++vb) { const int v = (vb0 + vb) * 16 + i; const float o = bf2f(ov[vb][r]);
            Yml[(m0 + t) * 512 + h * 128 + v] = f2bf(__builtin_amdgcn_rcpf(1.f + __expf(-o)) * hv[vb][r] * rinv * ng[vb]); } }
    __syncthreads();
}
}

namespace cmpr {
using nsa::bf16x8; using nsa::f32x4; using nsa::u32x4; using nsa::mfma16; using nsa::pkbf;
constexpr int RSX = 144, L_X = 0, L_PE = 272 * RSX  , L_H = L_PE + 8192, RSH = 528;
__device__ __forceinline__ void unit(NLAS char* lds, const bf16_t* P, const float* pe, const bf16_t* W1t, const bf16_t* W2t, bf16_t* KC, bf16_t* VC, int u) {
    const int tid = threadIdx.x, lane = tid & 63, w = __builtin_amdgcn_readfirstlane(tid >> 6), i = lane & 15, g = lane >> 4;
    const int nt = u & 15, gq = (u >> 4) & 1, b = (u >> 5) & 3, kv = u >> 7;
    const int pcol = (kv ? P_VC : P_KC) + gq * 64, tok0 = 256 * nt;
    for (int ch = tid; ch < 272 * 8; ch += 512) { const int row = ch >> 3, c8 = (ch & 7) * 8, tok = tok0 + row;
        u32x4 v = (u32x4){0u, 0u, 0u, 0u}; if (tok < T) v = *(const u32x4*)(P + ((size_t)b * T + tok) * PW + pcol + c8);
        *(NLAS u32x4*)(lds + L_X + row * RSX + c8 * 2) = v; }
    for (int e = tid; e < 2048; e += 512) ((NLAS float*)(lds + L_PE))[e] = pe[kv * 2048 + e];
    __syncthreads();
    f32x4 acc[2]; acc[0] = (f32x4){0.f, 0.f, 0.f, 0.f}; acc[1] = acc[0];
    const bf16_t* wb = W1t + ((size_t)kv * 256 + 32 * w + i) * 2048 + 8 * g;
#define CMPR_LOAD(dst, k0_) { _Pragma("unroll") for (int kk = 0; kk < 8; ++kk) { dst[kk][0] = *(const bf16x8*)(wb + 32 * ((k0_) + kk)); dst[kk][1] = *(const bf16x8*)(wb + 16 * 2048 + 32 * ((k0_) + kk)); } }
#define CMPR_COMP(src, k0_) { _Pragma("unroll") for (int kk = 0; kk < 8; ++kk) { const int ks = (k0_) + kk, l = ks >> 1, dh = ks & 1; \
            const u32x4 raw = *(const NLAS u32x4*)(lds + L_X + (16 * i + l) * RSX + dh * 64 + 16 * g); \
            const NLAS float* pp = (const NLAS float*)(lds + L_PE) + l * 64 + dh * 32 + 8 * g; const f32x4 p0 = *(const NLAS f32x4*)pp, p1 = *(const NLAS f32x4*)(pp + 4); \
            u32x4 a; a.x = pkbf(pg8::bflo(raw.x) + p0[0], pg8::bfhi(raw.x) + p0[1]); a.y = pkbf(pg8::bflo(raw.y) + p0[2], pg8::bfhi(raw.y) + p0[3]); \
            a.z = pkbf(pg8::bflo(raw.z) + p1[0], pg8::bfhi(raw.z) + p1[1]); a.w = pkbf(pg8::bflo(raw.w) + p1[2], pg8::bfhi(raw.w) + p1[3]); \
            const bf16x8 af = __builtin_bit_cast(bf16x8, a); \
            acc[0] = mfma16(af, src[kk][0], acc[0]); acc[1] = mfma16(af, src[kk][1], acc[1]); } }
    { bf16x8 bA[8][2], bB[8][2];
      CMPR_LOAD(bA, 0)
#pragma unroll 1
      for (int k0 = 0; k0 < 64; k0 += 16) { CMPR_LOAD(bB, k0 + 8) CMPR_COMP(bA, k0) if (k0 + 16 < 64) CMPR_LOAD(bA, k0 + 16) CMPR_COMP(bB, k0 + 8) } }
#undef CMPR_LOAD
#undef CMPR_COMP
#pragma unroll
    for (int cb = 0; cb < 2; ++cb)
#pragma unroll
        for (int r = 0; r < 4; ++r) { const float x = acc[cb][r], uu = 0.7978845608028654f * (x + 0.044715f * x * x * x); const float gl = x * __builtin_amdgcn_rcpf(1.f + __expf(-2.f * uu));
            *(NLAS bf16_t*)(lds + L_H + (4 * g + r) * RSH + (32 * w + cb * 16 + i) * 2) = f2bf(gl); }
    __syncthreads();
    if (w < 4) { f32x4 o = (f32x4){0.f, 0.f, 0.f, 0.f}; const bf16_t* w2 = W2t + ((size_t)kv * 64 + 16 * w + i) * 256 + 8 * g;
#pragma unroll
        for (int ks = 0; ks < 8; ++ks) o = mfma16(*(const NLAS bf16x8*)(lds + L_H + i * RSH + (32 * ks + 8 * g) * 2), *(const bf16x8*)(w2 + 32 * ks), o);
        bf16_t* dst = (kv ? VC : KC);
#pragma unroll
        for (int r = 0; r < 4; ++r) dst[((size_t)(b * 256 + 16 * nt + 4 * g + r) * 2 + gq) * 64 + 16 * w + i] = f2bf(o[r]); }
    __syncthreads();
}
}

#define LAS __attribute__((address_space(3)))
constexpr int NTHREADS = 512, LDS_BYTES = 147456;
constexpr size_t WS_WIN = 1 * MiB, WS_WG = 9 * MiB, WS_WBR = 15 * MiB, WS_WOUT = 18 * MiB, WS_WFF1 = 20 * MiB, WS_WFF2 = 28 * MiB, WS_WMKV = 36 * MiB, WS_WC1 = 38 * MiB;
constexpr size_t WS_BIASP = 249 * MiB, WS_XCH = 250 * MiB;
#define XB_TMO      128
#define XB_XCNT(j)  (256  + 64 * (j))
#define XB_XSUB(j)  (1280 + 64 * (j))
#define XB_XGEN(j)  (2304 + 64 * (j))
#define XB_TOP      3328
#define XB_TOPGEN   3392
#define XCD_BAR_WORDS 3456
#define XB_SPIN_CAP (1u << 18)

__device__ __forceinline__ unsigned xb_ld(unsigned* p)              { return __hip_atomic_load(p, __ATOMIC_RELAXED, __HIP_MEMORY_SCOPE_AGENT); }
__device__ __forceinline__ unsigned xb_add(unsigned* p, unsigned v) { return __hip_atomic_fetch_add(p, v, __ATOMIC_RELAXED, __HIP_MEMORY_SCOPE_AGENT); }
__device__ __forceinline__ unsigned xb_xcc_id() { return (unsigned)__builtin_amdgcn_s_getreg((3 << 11) | 20) & 0xFu; }
#define XB_SPIN(cond, bar) do { unsigned _sp = 0; while (cond) { __builtin_amdgcn_s_sleep(1); \
    if ((++_sp & 255u) == 0u) { if (xb_ld(&(bar)[XB_TMO])) break; if (_sp > XB_SPIN_CAP) { atomicAdd(&(bar)[XB_TMO], 1u); break; } } } } while (0)

struct XcdBarrier {
    unsigned* bar; unsigned x;
    volatile LAS unsigned* st;
};

__device__ __forceinline__ XcdBarrier xcd_barrier_post(unsigned* bar, volatile LAS unsigned* st) {
    XcdBarrier b; b.bar = bar; b.x = xb_xcc_id(); b.st = st;
    if (threadIdx.x == 0) (void)xb_add(&bar[XB_XCNT(b.x)], 1u);
    return b;
}
__device__ __forceinline__ void xcd_barrier_complete(unsigned* bar, unsigned x, unsigned& nloc, unsigned& nx) {
    const unsigned G = gridDim.x * gridDim.y * gridDim.z;
    unsigned sum, cnt, mine, sp = 0u;
    for (;;) {
        sum = 0u; cnt = 0u; mine = 0u;
#pragma unroll
        for (unsigned j = 0; j < 16; ++j) { const unsigned c = xb_ld(&bar[XB_XCNT(j)]); sum += c; cnt += (c > 0u) ? 1u : 0u; mine = (j == x) ? c : mine; }
        if (sum == G) break;
        __builtin_amdgcn_s_sleep(1);
        if ((++sp & 255u) == 0u) { if (xb_ld(&bar[XB_TMO])) break; if (sp > XB_SPIN_CAP) { atomicAdd(&bar[XB_TMO], 1u); break; } }
    }
    nloc = mine > 0u ? mine : 1u; nx = cnt > 0u ? cnt : 1u;
}

__device__ __forceinline__ void xcd_barrier(const XcdBarrier& b) {
    asm volatile("s_waitcnt vmcnt(0)" ::: "memory");
    __syncthreads();
    if (threadIdx.x == 0) {
        unsigned* bar = b.bar;
        __builtin_amdgcn_s_waitcnt(0);
        unsigned nloc = b.st[0], nx = b.st[1];
        if (nloc == 0u) { xcd_barrier_complete(bar, b.x, nloc, nx); b.st[0] = nloc; b.st[1] = nx; }
        const unsigned old = xb_add(&bar[XB_XSUB(b.x)], 1u);
        const unsigned gen = old / nloc;
        if (old + 1u == (gen + 1u) * nloc) {
            __builtin_amdgcn_fence(__ATOMIC_RELEASE, "agent");
            asm volatile("s_waitcnt vmcnt(0)" ::: "memory");
            const unsigned og = xb_add(&bar[XB_TOP], 1u);
            const unsigned tg = og / nx;
            if (og + 1u == (tg + 1u) * nx) xb_add(&bar[XB_TOPGEN], 1u);
            else XB_SPIN(xb_ld(&bar[XB_TOPGEN]) == tg, bar);
            __builtin_amdgcn_fence(__ATOMIC_ACQUIRE, "agent");
            xb_add(&bar[XB_XGEN(b.x)], 1u);
            asm volatile("s_waitcnt vmcnt(0)" ::: "memory");
        } else {
            XB_SPIN(xb_ld(&bar[XB_XGEN(b.x)]) == gen, bar);
            __builtin_amdgcn_fence(__ATOMIC_ACQUIRE, "agent");
            asm volatile("s_waitcnt vmcnt(0)" ::: "memory");
        }
    }
    __syncthreads();
}

struct Args { const float* in[18]; float* out; unsigned char* ws; int ph_lo, ph_hi; };
__device__ __forceinline__ unsigned pk2(float lo, float hi) { return (unsigned)f2bf(lo) | ((unsigned)f2bf(hi) << 16); }
typedef unsigned v4u __attribute__((ext_vector_type(4)));
typedef float f32x4 __attribute__((ext_vector_type(4)));
__device__ __forceinline__ void tr_item(const float* W, int ld, int ncols, int K, bf16_t* WT, int row_off, LAS float* scr, int item, int lane) {
    const int nblk = ncols / 32, kb = item / nblk, nb = item % nblk, k0 = 64 * kb, n0 = 32 * nb;
#pragma unroll 8
    for (int i = 0; i < 32; ++i) { const int kk = 2 * i + (lane >> 5); scr[kk * 33 + (lane & 31)] = W[(size_t)(k0 + kk) * ld + n0 + (lane & 31)]; }
    asm volatile("s_waitcnt lgkmcnt(0)" ::: "memory");
    const int c = lane & 7;
#pragma unroll
    for (int j = 0; j < 4; ++j) { const int n = (lane >> 3) + 8 * j; const LAS float* s = scr + (8 * c) * 33 + n;
        v4u o; o.x = pk2(s[0 * 33], s[1 * 33]); o.y = pk2(s[2 * 33], s[3 * 33]); o.z = pk2(s[4 * 33], s[5 * 33]); o.w = pk2(s[6 * 33], s[7 * 33]);
        *(v4u*)(WT + (size_t)(row_off + n0 + n) * K + k0 + 8 * c) = o; }
    asm volatile("s_waitcnt lgkmcnt(0)" ::: "memory");
}
__device__ __forceinline__ void rms_row_wave(const float* xrow, const float* g, bf16_t* orow, int lane) {
    const f32x4* xr = (const f32x4*)xrow + lane; const f32x4* gr = (const f32x4*)g + lane;
    f32x4 v[4]; float s = 0.f;
#pragma unroll
    for (int j = 0; j < 4; ++j) { v[j] = xr[64 * j]; s += (v[j].x * v[j].x + v[j].y * v[j].y) + (v[j].z * v[j].z + v[j].w * v[j].w); }
    const float r = rsqrtf(wave_sum(s) * (1.f / D) + EPS);
    unsigned long long* o8 = (unsigned long long*)orow + lane;
#pragma unroll
    for (int j = 0; j < 4; ++j) { const f32x4 gg = gr[64 * j]; o8[64 * j] = (unsigned long long)pk2(v[j].x * r * gg.x, v[j].y * r * gg.y) | ((unsigned long long)pk2(v[j].z * r * gg.z, v[j].w * r * gg.w) << 32); }
}
__device__ __forceinline__ int small_src_col(int c) { return c < 8 ? C_MLI + c : C_NSG + (c - 8); }
__global__ void __launch_bounds__(NTHREADS, 2) mega(Args a) {
    extern __shared__ __attribute__((aligned(16))) unsigned char lds_raw[];
    char* lds = (char*)lds_raw;
    LAS unsigned char* lds3 = (LAS unsigned char*)lds_raw;
    const float* x = a.in[0]; const float* mem = a.in[1]; const float* g_mix = a.in[2]; const float* w_in = a.in[3];
    const float* b_in = a.in[4]; const float* ml_conv = a.in[5]; const float* ml_norm_g = a.in[6]; const float* cmp_pe = a.in[7];
    const float* cmp_w1 = a.in[8]; const float* cmp_w2 = a.in[9]; const float* g_mem = a.in[10]; const float* w_mem_kv = a.in[11];
    const float* w_branch = a.in[12]; const float* w_out = a.in[13]; const float* g_ffn = a.in[14]; const float* w_ff1 = a.in[15];
    const float* w_ff2 = a.in[16]; const float* g_final = a.in[17];
    char* ws = (char*)a.ws; float* out = a.out;
    bf16_t* U = (bf16_t*)(ws + WS_U); bf16_t* P = (bf16_t*)(ws + WS_P);
    bf16_t* Yml = (bf16_t*)(ws + WS_Y); bf16_t* Ynsa = Yml + (size_t)M * 512; bf16_t* Yxa = Ynsa + (size_t)M * 512;
    float* S32 = (float*)(ws + WS_S32); bf16_t* MEMN = (bf16_t*)(ws + WS_MEMN); bf16_t* MEMKV = (bf16_t*)(ws + WS_MEMKV);
    bf16_t* KC = (bf16_t*)(ws + WS_KC); bf16_t* VC = (bf16_t*)(ws + WS_VC);
    float* NA = (float*)(ws + WS_NA); float* Gc = (float*)(ws + WS_G); float* Mloc = (float*)(ws + WS_MLOC); float* Mprev = (float*)(ws + WS_MPREV);
    bf16_t* Abuf = (bf16_t*)out;
    bf16_t* GATES = P; bf16_t* MERGED = U; bf16_t* AFFN = (bf16_t*)(ws + WS_AFFN); bf16_t* HBUF = P;
    bf16_t* Wi = (bf16_t*)(ws + WS_WIN); bf16_t* Wg = (bf16_t*)(ws + WS_WG); bf16_t* Wbr = (bf16_t*)(ws + WS_WBR); bf16_t* Wo = (bf16_t*)(ws + WS_WOUT);
    bf16_t* Wf1 = (bf16_t*)(ws + WS_WFF1); bf16_t* Wf2 = (bf16_t*)(ws + WS_WFF2); bf16_t* Wmkv = (bf16_t*)(ws + WS_WMKV);
    float* biasP = (float*)(ws + WS_BIASP); bf16_t* Wc1 = (bf16_t*)(ws + WS_WC1); bf16_t* Wc2 = (bf16_t*)(ws + WS_BIASP + 65536);
    const int tid = threadIdx.x, lane = tid & 63, wave = __builtin_amdgcn_readfirstlane(tid >> 6);
    const int G = gridDim.x, bid = blockIdx.x;
    const int lo = a.ph_lo, hi = a.ph_hi;
    volatile LAS unsigned* xbst = (volatile LAS unsigned*)(lds3 + LDS_BYTES - 64);
    if (tid < 2) xbst[tid] = 0u;
    __syncthreads();
    const XcdBarrier bar = xcd_barrier_post((unsigned*)ws, xbst);
#define PHASE(k) if (lo <= (k) && (k) < hi)
#define SEAM(k) if (lo <= (k) && (k) + 1 < hi) xcd_barrier(bar)
    PHASE(0) {
        LAS float* scr = (LAS float*)(lds3 + wave * 16384);
        const int gw = bid * 8 + wave, NGW = G * 8;
        constexpr int I0 = 16 * 64, I1 = 16 * 40, I2 = 16 * 16, I3 = 16 * 96, I4 = 8 * 32, I5 = 16 * 32, I6 = 16 * 128, I7 = 64 * 32, I8 = 16 * 32;
        constexpr int I9 = 32 * 8, I10 = 4 * 2;
        constexpr int NITEMS = I0 + I1 + I2 + I3 + 3 * I4 + I5 + I6 + I7 + I8 + 2 * I9 + 2 * I10;
        for (int it = gw; it < NITEMS; it += NGW) {
            int r = it;
            if (r < I0) { tr_item(w_in, DIN, 2048, 1024, Wi, 0, scr, r, lane); continue; } r -= I0;
            if (r < I1) { tr_item(w_in + 2056, DIN, 1280, 1024, Wi, 2048, scr, r, lane); continue; } r -= I1;
            if (r < I2) { tr_item(w_in + 3360, DIN, 512, 1024, Wi, 3328, scr, r, lane); continue; } r -= I2;
            if (r < I3) { tr_item(w_in + C_MG, DIN, 3072, 1024, Wg, 0, scr, r, lane); continue; } r -= I3;
            if (r < 3 * I4) { const int j = r / I4; tr_item(w_branch + (size_t)j * 512 * 1024, 1024, 1024, 512, Wbr + (size_t)j * 1024 * 512, 0, scr, r % I4, lane); continue; } r -= 3 * I4;
            if (r < I5) { tr_item(w_out, 1024, 1024, 1024, Wo, 0, scr, r, lane); continue; } r -= I5;
            if (r < I6) { tr_item(w_ff1, FF, FF, 1024, Wf1, 0, scr, r, lane); continue; } r -= I6;
            if (r < I7) { tr_item(w_ff2, 1024, 1024, FF, Wf2, 0, scr, r, lane); continue; } r -= I7;
            if (r < I8) { tr_item(w_mem_kv, 1024, 1024, 1024, Wmkv, 0, scr, r, lane); continue; } r -= I8;
            if (r < 2 * I9) { const int kv = r / I9; tr_item(cmp_w1 + (size_t)kv * 2048 * 256, 256, 256, 2048, Wc1 + (size_t)kv * 256 * 2048, 0, scr, r % I9, lane); continue; } r -= 2 * I9;
            { const int kv = r / I10; tr_item(cmp_w2 + (size_t)kv * 256 * 64, 64, 64, 256, Wc2 + (size_t)kv * 64 * 256, 0, scr, r % I10, lane); }
        }
        for (int i = bid * NTHREADS + tid; i < 256 * 1024; i += G * NTHREADS) { const int r = i >> 10, k = i & 1023; bf16_t v = 0;
            if (r < 32) v = f2bf(w_in[(size_t)k * DIN + small_src_col(r)]);
            else if (r >= 128 && r < 160) { const float w = w_in[(size_t)k * DIN + small_src_col(r - 128)]; v = f2bf(w - bf2f(f2bf(w))); }
            Wi[(size_t)(3840 + r) * 1024 + k] = v; }
        for (int c = bid * NTHREADS + tid; c < 4096; c += G * NTHREADS) { float v = 0.f;
            if (c < 2048) v = b_in[c]; else if (c < 3328) v = b_in[c + 8]; else if (c < 3840) v = b_in[c + 32]; else if (c < 3872) v = b_in[small_src_col(c - 3840)];
            biasP[c] = v; }
        for (int m = gw; m < M; m += NGW) rms_row_wave(x + (size_t)m * D, g_mix, U + (size_t)m * D, lane);
        for (int m = gw; m < 1024; m += NGW) rms_row_wave(mem + (size_t)m * D, g_mem, MEMN + (size_t)m * D, lane);
    }
    SEAM(0);
    PHASE(1) {
        { pg8::Gemm g{U, Wi, M, 4096, D}; pg8::StaticOrder S; S.init(M, 4096, G, bid);
          pg8::EpiStore<0> E{P, biasP, S32, PW, 15};
          pg8::gemm_phase<pg8::EpiStore<0>, pg8::StaticOrder, true, true>(lds3, g, S, E); }
    }
    SEAM(1);
    PHASE(2) { for (int tl_ = bid; tl_ < 256; tl_ += G) xa::memkv_tile(MEMN, Wmkv, MEMKV, tl_);
               for (int ci = bid; ci < 1024; ci += G) ml::m1_unit((NLAS char*)lds_raw, P, ml_conv, S32, Abuf, NA, Gc, Mloc, ci);
               for (int u = bid; u < 256; u += G) cmpr::unit((NLAS char*)lds_raw, P, cmp_pe, Wc1, Wc2, KC, VC, u);
    }
    SEAM(2);
    PHASE(3) { unsigned* m2cnt = (unsigned*)ws + 12288;
               ml::m2_items(Abuf, NA, Gc, Mloc, Mprev);
               asm volatile("s_waitcnt vmcnt(0)" ::: "memory"); __syncthreads();
               if (tid == 0) { __builtin_amdgcn_fence(__ATOMIC_RELEASE, "agent"); asm volatile("s_waitcnt vmcnt(0)" ::: "memory"); __hip_atomic_fetch_add(m2cnt, 1u, __ATOMIC_RELAXED, __HIP_MEMORY_SCOPE_AGENT); }
               nsa::phase((NLAS char*)lds_raw, P, S32, KC, VC, Ynsa);
               xa::phase((NLAS char*)lds_raw, P, MEMKV, Yxa);
               if (tid == 0) { unsigned sp = 0; while (__hip_atomic_load(m2cnt, __ATOMIC_RELAXED, __HIP_MEMORY_SCOPE_AGENT) < (unsigned)G) { __builtin_amdgcn_s_sleep(2); if (++sp > (1u << 22)) break; }
                               __builtin_amdgcn_fence(__ATOMIC_ACQUIRE, "agent"); asm volatile("s_waitcnt vmcnt(0)" ::: "memory"); }
               __syncthreads();
               for (int ci = bid; ci < 1024; ci += G) ml::m3_unit((NLAS char*)lds_raw, P, ml_conv, S32, Abuf, NA, Mprev, ml_norm_g, Yml, ci); }
    SEAM(4);
    PHASE(5) { pg8::Gemm g{U, Wg, M, 3072, D}; pg8::StaticOrder S; S.init(M, 3072, G, bid);
               pg8::EpiStore<1> E{GATES, b_in + C_MG, nullptr, 3072, -1};
               pg8::gemm_phase<pg8::EpiStore<1>, pg8::StaticOrder, true, true>(lds3, g, S, E); }
    SEAM(5);
    PHASE(6) { pg8::Gemm g{Yml, Wbr, M, 1024, 512}; pg8::MergeOrder S; S.so.init(M, 1024, G, bid); S.sa = (size_t)M * 512 * 2; S.sb = (size_t)1024 * 512 * 2;
               pg8::EpiMergeG E{GATES, (bf16_t*)out, MERGED};
               pg8::gemm_phase<pg8::EpiMergeG, pg8::MergeOrder, true, true>(lds3, g, S, E); }
    SEAM(6);
    PHASE(7) { pg8::Gemm g{MERGED, Wo, M, 1024, D}; pg8::StaticOrder S; S.init(M, 1024, G, bid);
               pg8::EpiResRms E{x, out, nullptr, AFFN, g_ffn, (float*)(ws + WS_XCH), (unsigned*)ws + 4096};
               pg8::gemm_phase<pg8::EpiResRms, pg8::StaticOrder, false, true>(lds3, g, S, E); }
    SEAM(7);
    PHASE(9) { pg8::Gemm g{AFFN, Wf1, M, FF, D}; pg8::StaticOrder S; S.init(M, FF, G, bid);
               pg8::EpiStore<2> E{HBUF, nullptr, nullptr, FF, -1};
               pg8::gemm_phase<pg8::EpiStore<2>, pg8::StaticOrder, true, true>(lds3, g, S, E); }
    SEAM(9);
    PHASE(10) { pg8::Gemm g{HBUF, Wf2, M, 1024, FF}; pg8::StaticOrder S; S.init(M, 1024, G, bid);
                pg8::EpiResRms E{out, nullptr, out, nullptr, g_final, (float*)(ws + WS_XCH + 262144), (unsigned*)ws + 4096 + 4096};
                pg8::gemm_phase<pg8::EpiResRms, pg8::StaticOrder, false, true>(lds3, g, S, E); }
}
constexpr int N_PHASES = 12;
#ifndef MK_PER_PHASE
#define MK_PER_PHASE 0
#endif
extern "C" void kernel_launch(void* const* d_in, const int* in_sizes, int n_in, void* d_out, int out_size, void* d_ws, size_t ws_size, hipStream_t stream) {
    static int grid = 0;
    if (grid == 0) {
        int dev = 0, cus = 0, per_cu = 0;
        (void)hipGetDevice(&dev); (void)hipDeviceGetAttribute(&cus, hipDeviceAttributeMultiprocessorCount, dev);
        (void)hipFuncSetAttribute((const void*)mega, hipFuncAttributeMaxDynamicSharedMemorySize, LDS_BYTES);
        (void)hipOccupancyMaxActiveBlocksPerMultiprocessor(&per_cu, (const void*)mega, NTHREADS, LDS_BYTES);
        if (per_cu < 1) { fprintf(stderr, "occupancy query says %d blocks/CU\n", per_cu); per_cu = 1; }
        grid = cus * 1;
        (void)hipGetLastError();
    }
    (void)hipMemsetAsync(d_ws, 0, 65536, stream);
    Args a{};
    for (int i = 0; i < 18; ++i) a.in[i] = (const float*)d_in[i];
    a.out = (float*)d_out; a.ws = (unsigned char*)d_ws;
#if MK_PER_PHASE
    for (int p = 0; p < N_PHASES; ++p) { a.ph_lo = p; a.ph_hi = p + 1; void* args[] = {&a};
        (void)hipLaunchCooperativeKernel((const void*)mega, dim3(grid), dim3(NTHREADS), args, LDS_BYTES, stream); }
#else
    a.ph_lo = 0; a.ph_hi = N_PHASES; void* args[] = {&a};
    hipError_t e = hipLaunchCooperativeKernel((const void*)mega, dim3(grid), dim3(NTHREADS), args, LDS_BYTES, stream);
    if (e != hipSuccess) fprintf(stderr, "cooperative launch failed: %s (grid %d)\n", hipGetErrorString(e), grid);
#endif
}
```

```cpp
#include <hip/hip_runtime.h>
#include <hip/hip_cooperative_groups.h>
#include <cstdio>
namespace cg = cooperative_groups;
#include <stdint.h>

typedef unsigned short bf16_t;
__device__ __forceinline__ float bf2f(bf16_t v) { return __uint_as_float(((unsigned)v) << 16); }
__device__ __forceinline__ bf16_t f2bf(float f) { unsigned u = __float_as_uint(f); return (bf16_t)((u + 0x7fffu + ((u >> 16) & 1u)) >> 16); }

constexpr int NB = 4, T = 4096, M = NB * T, D = 1024, DIN = 6944, FF = 4096;
constexpr float EPS = 1e-6f;
constexpr int C_MLI = 2048, C_NSG = 3336, C_MG = 3872;
constexpr int P_MLQ = 0, P_MLK = 512, P_MLV = 1024, P_MLO = 1536, P_NSQ = 2048, P_KC = 2560, P_VC = 2688, P_KS = 2816, P_VS = 2944, P_KW = 3072, P_VW = 3200, P_XAQ = 3328, PW = 3840;
constexpr size_t MiB = 1u << 20;
constexpr size_t WS_U = 40 * MiB;
constexpr size_t WS_P = 72 * MiB;
constexpr size_t WS_Y = 192 * MiB;
constexpr size_t WS_AFFN = 200 * MiB;
constexpr size_t WS_S32 = 240 * MiB;
constexpr size_t WS_MEMN = 242 * MiB;
constexpr size_t WS_MEMKV = 244 * MiB;
constexpr size_t WS_KC = 246 * MiB;
constexpr size_t WS_VC = 246 * MiB + 512 * 1024;
constexpr size_t WS_NA = 247 * MiB;
constexpr size_t WS_G = 248 * MiB;
constexpr size_t WS_MLOC = 248 * MiB + 4096;
constexpr size_t WS_MPREV = 248 * MiB + 8192;

__device__ __forceinline__ float wave_sum(float v) {
#pragma unroll
    for (int o = 1; o < 64; o <<= 1) v += __shfl_xor(v, o);
    return v;
}
__device__ __forceinline__ float wave_max(float v) {
#pragma unroll
    for (int o = 1; o < 64; o <<= 1) v = fmaxf(v, __shfl_xor(v, o));
    return v;
}

__device__ __forceinline__ float logsig(float x) { return fminf(x, 0.f) - log1pf(__expf(-fabsf(x))); }
namespace pg8 {
#define PG8_LAS __attribute__((address_space(3)))
typedef unsigned short bf16_t;
typedef short bf16x8 __attribute__((ext_vector_type(8)));
typedef float f32x4 __attribute__((ext_vector_type(4)));
typedef unsigned u32x4 __attribute__((ext_vector_type(4)));
constexpr int BM = 256, BK = 64, HALF = 128, HTB = HALF * BK * 2  , STAGE_BYTES = 8 * HTB, NXCD = 8, WGM = 8;

__host__ __device__ __forceinline__ int lds_byte(int r, int c) { const int st = (r >> 4) * 2 + (c >> 5), rr = r & 15, cc = c & 31, ob = rr * 64 + cc * 2; return st * 1024 + (ob ^ (((ob >> 9) & 1) << 5)); }
__host__ __device__ __forceinline__ void stage_rc(int b, int& R, int& C) { const int st = b / 1024, sb = b % 1024, swz = sb ^ (((sb >> 9) & 1) << 5); R = (st >> 1) * 16 + swz / 64; C = (st & 1) * 32 + (swz % 64) / 2; }
__host__ __device__ __forceinline__ int perm32(int rho) { const int n = rho >> 4, i = rho & 15; return 8 * (i >> 2) + 4 * n + (i & 3); }

struct Unit { int pm, pn, j; };
struct Gemm { const bf16_t* A; const bf16_t* Bt; int M, N, K; };

struct StaticOrder {
    int nM, nN, nwg, G, c;
    __host__ __device__ void init(int M, int N, int G_, int c_) { nM = M / BM; nN = N / BM; nwg = nM * nN; G = G_; c = c_; }
    __host__ __device__ bool next(int i, Unit& u) const {
        const long L = (long)i * G + c; if (L >= nwg) return false;
        int wgid = (int)L; { const int q = nwg / NXCD, r = nwg % NXCD, xcd = wgid % NXCD, off = wgid / NXCD; wgid = (xcd < r ? xcd * (q + 1) : r * (q + 1) + (xcd - r) * q) + off; }
        const int nig = WGM * nN, gid = wgid / nig, fm = gid * WGM, gsz = (nM - fm) < WGM ? (nM - fm) : WGM;
        u.pm = fm + ((wgid % nig) % gsz); u.pn = (wgid % nig) / gsz; u.j = 0; return true;
    }
    __device__ __forceinline__ const char* pa(const Gemm& g, const Unit& u, size_t tstep) const { return (const char*)g.A + (size_t)u.pm * tstep; }
    __device__ __forceinline__ const char* pb(const Gemm& g, const Unit& u, size_t tstep) const { return (const char*)g.Bt + (size_t)u.pn * tstep; }
    __device__ __forceinline__ void a_ready(const Unit&) const {}
    __device__ __forceinline__ void done(const Unit&) const {}
};

struct MergeOrder {
    StaticOrder so; size_t sa, sb;
    __device__ __forceinline__ bool next(int i, Unit& u) const { if (i >= 3) return false; const bool ok = so.next(0, u); u.j = i; return ok; }
    __device__ __forceinline__ const char* pa(const Gemm& g, const Unit& u, size_t tstep) const { return (const char*)g.A + (size_t)u.j * sa + (size_t)u.pm * tstep; }
    __device__ __forceinline__ const char* pb(const Gemm& g, const Unit& u, size_t tstep) const { return (const char*)g.Bt + (size_t)u.j * sb + (size_t)u.pn * tstep; }
    __device__ __forceinline__ void a_ready(const Unit&) const {}
    __device__ __forceinline__ void done(const Unit&) const {}
};
typedef float f32x2_t __attribute__((ext_vector_type(2))); typedef __bf16 bf16x2_t __attribute__((ext_vector_type(2)));
__device__ __forceinline__ unsigned cvt_pk_bf16(float lo, float hi) { f32x2_t v = {lo, hi}; bf16x2_t b = __builtin_convertvector(v, bf16x2_t); return __builtin_bit_cast(unsigned, b); }
typedef float f32x2 __attribute__((ext_vector_type(2)));

typedef unsigned u32x2 __attribute__((ext_vector_type(2)));
__device__ __forceinline__ float bflo(unsigned w) { return __uint_as_float(w << 16); }
__device__ __forceinline__ float bfhi(unsigned w) { return __uint_as_float(w & 0xffff0000u); }
template <int ACT> __device__ __forceinline__ f32x4 act4(f32x4 v) {
    if (ACT == 1) { f32x4 o; for (int e = 0; e < 4; ++e) o[e] = __builtin_amdgcn_rcpf(1.f + __expf(-v[e])); return o; }
    if (ACT == 2) { f32x4 o; for (int e = 0; e < 4; ++e) { const float r = fmaxf(v[e], 0.f); o[e] = r * r; } return o; }
    return v;
}
template <int ACT> struct EpiStore {
    static constexpr bool PERM = true, AFTER_DRAIN = false;
    bf16_t* O; const float* bias; float* S32; int ldc, small_pn;
    __device__ __forceinline__ void operator()(const f32x4 (&acc)[2][2][4][2], const Unit& u, int wr, int wc, int fr, int fq) const {
        asm volatile("s_waitcnt vmcnt(0)" ::: "memory");
        const int row0 = u.pm * BM + wr * 64 + fr, col0 = u.pn * BM + wc * 32 + 8 * fq;
        if (u.pn == small_pn) {
            if (wc == 0) {
                const f32x4 b0 = *(const f32x4*)(bias + col0), b1 = *(const f32x4*)(bias + col0 + 4);
#pragma unroll
                for (int ai = 0; ai < 2; ++ai)
#pragma unroll
                    for (int m = 0; m < 4; ++m) { float* rp = S32 + (size_t)(row0 + ai * HALF + m * 16) * 32 + 8 * fq;
                        *(f32x4*)rp = acc[ai][0][m][0] + acc[ai][1][m][0] + b0; *(f32x4*)(rp + 4) = acc[ai][0][m][1] + acc[ai][1][m][1] + b1; }
            }
            return;
        }
        f32x4 bv[2][2];
#pragma unroll
        for (int bj = 0; bj < 2; ++bj)
#pragma unroll
            for (int n = 0; n < 2; ++n) bv[bj][n] = bias ? *(const f32x4*)(bias + col0 + bj * HALF + 4 * n) : (f32x4){0.f, 0.f, 0.f, 0.f};
#pragma unroll
        for (int ai = 0; ai < 2; ++ai)
#pragma unroll
            for (int m = 0; m < 4; ++m) { bf16_t* rowp = O + (size_t)(row0 + ai * HALF + m * 16) * ldc + col0;
#pragma unroll
                for (int bj = 0; bj < 2; ++bj) { const f32x4 v0 = act4<ACT>(acc[ai][bj][m][0] + bv[bj][0]), v1 = act4<ACT>(acc[ai][bj][m][1] + bv[bj][1]);
                    u32x4 w; w.x = cvt_pk_bf16(v0[0], v0[1]); w.y = cvt_pk_bf16(v0[2], v0[3]); w.z = cvt_pk_bf16(v1[0], v1[1]); w.w = cvt_pk_bf16(v1[2], v1[3]);
                    *(u32x4*)(rowp + bj * HALF) = w; } }
    }
};
struct EpiMergeG {
    static constexpr bool PERM = true, AFTER_DRAIN = false;
    const bf16_t* G; bf16_t* Mp; bf16_t* Mb;
    __device__ __forceinline__ void operator()(const f32x4 (&acc)[2][2][4][2], const Unit& u, int wr, int wc, int fr, int fq) const {
        const int j = u.j;
        asm volatile("s_waitcnt vmcnt(0)" ::: "memory");
        const int row0 = u.pm * BM + wr * 64 + fr, col0 = u.pn * BM + wc * 32 + 8 * fq;
        bf16_t* dst = (j < 2) ? Mp : Mb;
#pragma unroll
        for (int ai = 0; ai < 2; ++ai)
#pragma unroll
            for (int m = 0; m < 4; ++m) { const size_t row = (size_t)(row0 + ai * HALF + m * 16);
#pragma unroll
                for (int bj = 0; bj < 2; ++bj) { const int col = col0 + bj * HALF;
                    const u32x4 gw = *(const u32x4*)(G + row * 3072 + j * 1024 + col);
                    f32x4 v0 = (f32x4){bflo(gw.x), bfhi(gw.x), bflo(gw.y), bfhi(gw.y)} * acc[ai][bj][m][0], v1 = (f32x4){bflo(gw.z), bfhi(gw.z), bflo(gw.w), bfhi(gw.w)} * acc[ai][bj][m][1];
                    if (j > 0) { const u32x4 pw = *(const u32x4*)(Mp + row * 1024 + col); v0 += (f32x4){bflo(pw.x), bfhi(pw.x), bflo(pw.y), bfhi(pw.y)}; v1 += (f32x4){bflo(pw.z), bfhi(pw.z), bflo(pw.w), bfhi(pw.w)}; }
                    u32x4 w; w.x = cvt_pk_bf16(v0[0], v0[1]); w.y = cvt_pk_bf16(v0[2], v0[3]); w.z = cvt_pk_bf16(v1[0], v1[1]); w.w = cvt_pk_bf16(v1[2], v1[3]); *(u32x4*)(dst + row * 1024 + col) = w; } }
    }
};
struct EpiResidF {
    static constexpr bool PERM = true, AFTER_DRAIN = false;
    const float* X; float* O;
    __device__ __forceinline__ void operator()(const f32x4 (&acc)[2][2][4][2], const Unit& u, int wr, int wc, int fr, int fq) const {
        asm volatile("s_waitcnt vmcnt(0)" ::: "memory");
        const int row0 = u.pm * BM + wr * 64 + fr, col0 = u.pn * BM + wc * 32 + 8 * fq;
#pragma unroll
        for (int ai = 0; ai < 2; ++ai)
#pragma unroll
            for (int m = 0; m < 4; ++m) { const size_t off = (size_t)(row0 + ai * HALF + m * 16) * 1024 + col0;
#pragma unroll
                for (int bj = 0; bj < 2; ++bj) { const f32x4 x0 = *(const f32x4*)(X + off + bj * HALF), x1 = *(const f32x4*)(X + off + bj * HALF + 4);
                    *(f32x4*)(O + off + bj * HALF) = x0 + acc[ai][bj][m][0]; *(f32x4*)(O + off + bj * HALF + 4) = x1 + acc[ai][bj][m][1]; } }
    }
};
struct EpiResRms {
    static constexpr bool PERM = false, AFTER_DRAIN = true;
    const float* R; float* Hout; float* Nf; bf16_t* Nb; const float* gain; float* xbuf; unsigned* cnt;
    __device__ __forceinline__ void fused(f32x4 (&acc)[2][2][4][2], const Unit& u, int wr, int wc, int fr, int fq, PG8_LAS unsigned char* lds, int wid, int lane) const {
        PG8_LAS float* Pp = (PG8_LAS float*)lds; PG8_LAS float* S = (PG8_LAS float*)(lds + 4096);
        const int col0 = u.pn * BM + wc * 32 + 4 * fq;
#pragma unroll
        for (int ai = 0; ai < 2; ++ai)
#pragma unroll
            for (int m = 0; m < 4; ++m) { const size_t off = (size_t)(u.pm * BM + ai * HALF + wr * 64 + m * 16 + fr) * 1024 + col0; float sq = 0.f;
#pragma unroll
                for (int bj = 0; bj < 2; ++bj)
#pragma unroll
                    for (int n = 0; n < 2; ++n) { const f32x4 v = acc[ai][bj][m][n] + *(const f32x4*)(R + off + bj * HALF + n * 16); acc[ai][bj][m][n] = v; sq += (v[0] * v[0] + v[1] * v[1]) + (v[2] * v[2] + v[3] * v[3]); }
                sq += __shfl_xor(sq, 16); sq += __shfl_xor(sq, 32);
                if (fq == 0) Pp[(ai * HALF + wr * 64 + m * 16 + fr) * 4 + wc] = sq; }
        asm volatile("s_waitcnt lgkmcnt(0)" ::: "memory"); __builtin_amdgcn_s_barrier(); asm volatile("" ::: "memory");
        const int row = wid * 32 + (lane & 31);
        if (lane < 32) { const float tot = (Pp[row * 4 + 0] + Pp[row * 4 + 1]) + (Pp[row * 4 + 2] + Pp[row * 4 + 3]);
            __hip_atomic_store(xbuf + ((size_t)(u.pm * BM + row) * 4 + u.pn), tot, __ATOMIC_RELAXED, __HIP_MEMORY_SCOPE_AGENT); }
        asm volatile("s_waitcnt vmcnt(0)" ::: "memory");
        if (lane == 0) __hip_atomic_fetch_add(cnt + 64 * u.pm, 1u, __ATOMIC_RELAXED, __HIP_MEMORY_SCOPE_AGENT);
        if (wid == 0) { unsigned sp = 0;
            while ((unsigned)__builtin_amdgcn_readfirstlane(__hip_atomic_load(cnt + 64 * u.pm, __ATOMIC_RELAXED, __HIP_MEMORY_SCOPE_AGENT)) < 32u) { __builtin_amdgcn_s_sleep(2); if (++sp > (1u << 22)) break; }
            __builtin_amdgcn_fence(__ATOMIC_ACQUIRE, "agent"); }
        asm volatile("s_waitcnt vmcnt(0) lgkmcnt(0)" ::: "memory"); __builtin_amdgcn_s_barrier(); asm volatile("" ::: "memory");
        if (lane < 32) { const float* slot = xbuf + (size_t)(u.pm * BM + row) * 4; float t = 0.f;
#pragma unroll
            for (int q = 0; q < 4; ++q) t += __hip_atomic_load(slot + q, __ATOMIC_RELAXED, __HIP_MEMORY_SCOPE_AGENT);
            S[row] = rsqrtf(t * (1.0f / 1024.0f) + 1e-6f); }
        asm volatile("s_waitcnt lgkmcnt(0)" ::: "memory"); __builtin_amdgcn_s_barrier(); asm volatile("" ::: "memory");
        f32x4 gv[2][2];
#pragma unroll
        for (int bj = 0; bj < 2; ++bj)
#pragma unroll
            for (int n = 0; n < 2; ++n) gv[bj][n] = *(const f32x4*)(gain + col0 + bj * HALF + n * 16);
#pragma unroll
        for (int ai = 0; ai < 2; ++ai)
#pragma unroll
            for (int m = 0; m < 4; ++m) { const int r = ai * HALF + wr * 64 + m * 16 + fr; const float rs = S[r]; const size_t off = (size_t)(u.pm * BM + r) * 1024 + col0;
#pragma unroll
                for (int bj = 0; bj < 2; ++bj)
#pragma unroll
                    for (int n = 0; n < 2; ++n) { const f32x4 v = acc[ai][bj][m][n]; const f32x4 o = v * rs * gv[bj][n];
                        if (Hout) *(f32x4*)(Hout + off + bj * HALF + n * 16) = v;
                        if (Nf) *(f32x4*)(Nf + off + bj * HALF + n * 16) = o;
                        if (Nb) { u32x2 w; w.x = cvt_pk_bf16(o[0], o[1]); w.y = cvt_pk_bf16(o[2], o[3]); *(u32x2*)(Nb + off + bj * HALF + n * 16) = w; } } }
    }
};

template <class Epi, class Sched, bool ALIGN_EPI = false, bool SP2 = false>
__device__ __forceinline__ void gemm_phase(PG8_LAS unsigned char* lds, const Gemm g, const Sched& S, const Epi& E) {
    const int tid = threadIdx.x, wid = __builtin_amdgcn_readfirstlane(tid >> 6), lane = tid & 63, wr = wid >> 2, wc = wid & 3, fr = lane & 15, fq = lane >> 4;
    const int K = g.K, nt = K / BK;
    unsigned voffA[2], voffB[2];
#pragma unroll
    for (int i = 0; i < 2; ++i) { int R, C; stage_rc(tid * 16 + i * 8192, R, C); const int Rb = Epi::PERM ? ((R & ~31) + perm32(R & 31)) : R;
        voffA[i] = (unsigned)(R * K + C) * 2u; voffB[i] = (unsigned)(Rb * K + C) * 2u; }
    const size_t kstep = (size_t)(BK * 2);
    const size_t hstep = (size_t)HALF * K * 2;
    const size_t tstep = 2 * hstep;
    const unsigned ldsw = (unsigned)wid * 1024u;
    const int aoff = lds_byte(wr * 64 + fr, fq * 8), boff = lds_byte(wc * 32 + fr, fq * 8);
#define PG8_SA(b, h) (((b) * 2 + (h)) * HTB)
#define PG8_SB(b, h) ((4 + (b) * 2 + (h)) * HTB)
#define PG8_STAGE(bufoff, gbase, voff) do { _Pragma("unroll") for (int _i = 0; _i < 2; ++_i) \
        __builtin_amdgcn_global_load_lds((const unsigned*)((const char*)(gbase) + (voff)[_i]), (PG8_LAS unsigned*)(lds + (bufoff) + ldsw + _i * 8192), 16, 0, 0); } while (0)
#define PG8_LDA(dst, b, h) do { _Pragma("unroll") for (int m = 0; m < 4; ++m) _Pragma("unroll") for (int k = 0; k < 2; ++k) dst[m][k] = *(const PG8_LAS bf16x8*)(lds + PG8_SA(b, h) + aoff + m * 2048 + k * 1024); } while (0)
#define PG8_LDB(dst, b, h) do { _Pragma("unroll") for (int n = 0; n < 2; ++n) _Pragma("unroll") for (int k = 0; k < 2; ++k) dst[n][k] = *(const PG8_LAS bf16x8*)(lds + PG8_SB(b, h) + boff + n * 2048 + k * 1024); } while (0)
#define PG8_MMA(ai, bj, At, Bt) do { __builtin_amdgcn_s_setprio(1); _Pragma("unroll") for (int m = 0; m < 4; ++m) _Pragma("unroll") for (int n = 0; n < 2; ++n) _Pragma("unroll") for (int k = 0; k < 2; ++k) \
        acc[ai][bj][m][n] = __builtin_amdgcn_mfma_f32_16x16x32_bf16(Bt[n][k], At[m][k], acc[ai][bj][m][n], 0, 0, 0); __builtin_amdgcn_s_setprio(0); } while (0)
#define PG8_WAIT_V(n) asm volatile("s_waitcnt vmcnt(" #n ")" ::: "memory")
#define PG8_WAIT_L(n) asm volatile("s_waitcnt lgkmcnt(" #n ")" ::: "memory")
#define PG8_BAR __builtin_amdgcn_s_barrier()
#define PG8_SCHED __builtin_amdgcn_sched_barrier(0)
    Unit cur, nxt; int ui = 0;
    if (!S.next(0, cur)) return;
    f32x4 acc[2][2][4][2];
#pragma unroll
    for (int a = 0; a < 2; ++a)
#pragma unroll
        for (int b = 0; b < 2; ++b)
#pragma unroll
            for (int m = 0; m < 4; ++m)
#pragma unroll
                for (int n = 0; n < 2; ++n) acc[a][b][m][n] = (f32x4){0.f, 0.f, 0.f, 0.f};
    bf16x8 At[4][2], B0[2][2], B1[2][2];
    const char* cA = S.pa(g, cur, tstep); const char* cB = S.pb(g, cur, tstep);
    S.a_ready(cur);
    if constexpr (SP2) {
        PG8_STAGE(PG8_SB(0, 0), cB, voffB); PG8_STAGE(PG8_SB(0, 1), cB + hstep, voffB); PG8_STAGE(PG8_SA(0, 0), cA, voffA); PG8_STAGE(PG8_SA(0, 1), cA + hstep, voffA);
        if (wr == 1) PG8_BAR;
        PG8_WAIT_V(2); PG8_BAR;
        PG8_STAGE(PG8_SB(1, 0), cB + kstep, voffB); PG8_STAGE(PG8_SA(1, 0), cA + kstep, voffA); PG8_STAGE(PG8_SB(1, 1), cB + hstep + kstep, voffB);
        PG8_WAIT_V(6); PG8_BAR;
    } else {
        PG8_STAGE(PG8_SB(0, 0), cB, voffB); PG8_STAGE(PG8_SA(0, 0), cA, voffA); PG8_STAGE(PG8_SB(0, 1), cB + hstep, voffB); PG8_STAGE(PG8_SA(0, 1), cA + hstep, voffA);
        if (wr == 1) PG8_BAR;
        PG8_WAIT_V(4); PG8_BAR;
        PG8_STAGE(PG8_SB(1, 0), cB + kstep, voffB); PG8_STAGE(PG8_SA(1, 0), cA + kstep, voffA); PG8_STAGE(PG8_SB(1, 1), cB + hstep + kstep, voffB);
        PG8_WAIT_V(6); PG8_BAR;
    }
    for (;;) {
        const bool has_next = S.next(ui + 1, nxt);
        const char* nA = has_next ? S.pa(g, nxt, tstep) : cA; const char* nB = has_next ? S.pb(g, nxt, tstep) : cB;
        for (int t = 0; t < nt; t += 2) {
            const bool last = (t == nt - 2);
            const char* a1 = cA + (size_t)(t + 1) * kstep;
            const char* a2 = last ? nA : cA + (size_t)(t + 2) * kstep; const char* b2 = last ? nB : cB + (size_t)(t + 2) * kstep;
            const char* a3 = a2 + kstep; const char* b3 = b2 + kstep;
            if (last && has_next) S.a_ready(nxt);
            if constexpr (SP2) {
            PG8_LDB(B0, 0, 0); PG8_LDB(B1, 0, 1); PG8_SCHED; PG8_LDA(At, 0, 0); PG8_STAGE(PG8_SA(1, 1), a1 + hstep, voffA);
            PG8_WAIT_V(8); PG8_WAIT_L(0); PG8_BAR; PG8_MMA(0, 0, At, B0); PG8_MMA(0, 1, At, B1); PG8_BAR; PG8_SCHED;
            PG8_LDA(At, 0, 1); PG8_STAGE(PG8_SB(0, 0), b2, voffB); PG8_STAGE(PG8_SB(0, 1), b2 + hstep, voffB); PG8_STAGE(PG8_SA(0, 0), a2, voffA);
            PG8_WAIT_V(8); PG8_WAIT_L(0); PG8_BAR; PG8_MMA(1, 0, At, B0); PG8_MMA(1, 1, At, B1); PG8_BAR; PG8_SCHED;
            PG8_LDB(B0, 1, 0); PG8_LDB(B1, 1, 1); PG8_SCHED; PG8_LDA(At, 1, 0); PG8_STAGE(PG8_SA(0, 1), a2 + hstep, voffA);
            PG8_WAIT_V(8); PG8_WAIT_L(0); PG8_BAR; PG8_MMA(0, 0, At, B0); PG8_MMA(0, 1, At, B1); PG8_BAR; PG8_SCHED;
            PG8_LDA(At, 1, 1); PG8_STAGE(PG8_SB(1, 0), b3, voffB); PG8_STAGE(PG8_SB(1, 1), b3 + hstep, voffB); PG8_STAGE(PG8_SA(1, 0), a3, voffA);
            PG8_WAIT_V(8); PG8_WAIT_L(0); PG8_BAR; PG8_MMA(1, 0, At, B0); PG8_MMA(1, 1, At, B1); PG8_BAR; PG8_SCHED;
            } else {
            PG8_LDB(B0, 0, 0); PG8_SCHED; PG8_LDA(At, 0, 0); PG8_STAGE(PG8_SA(1, 1), a1 + hstep, voffA);
            PG8_WAIT_L(8); PG8_BAR; PG8_WAIT_L(0); PG8_MMA(0, 0, At, B0); PG8_BAR; PG8_SCHED;
            PG8_LDB(B1, 0, 1); PG8_STAGE(PG8_SB(0, 0), b2, voffB);
            PG8_BAR; PG8_WAIT_L(0); PG8_MMA(0, 1, At, B1); PG8_BAR;
            PG8_LDA(At, 0, 1); PG8_STAGE(PG8_SA(0, 0), a2, voffA);
            PG8_BAR; PG8_WAIT_L(0); PG8_MMA(1, 0, At, B0); PG8_BAR; PG8_SCHED;
            PG8_STAGE(PG8_SB(0, 1), b2 + hstep, voffB);
            PG8_WAIT_V(6); PG8_BAR; PG8_MMA(1, 1, At, B1); PG8_BAR;
            PG8_LDB(B0, 1, 0); PG8_SCHED; PG8_LDA(At, 1, 0); PG8_STAGE(PG8_SA(0, 1), a2 + hstep, voffA);
            PG8_WAIT_L(8); PG8_BAR; PG8_WAIT_L(0); PG8_MMA(0, 0, At, B0); PG8_BAR; PG8_SCHED;
            PG8_LDB(B1, 1, 1); PG8_STAGE(PG8_SB(1, 0), b3, voffB);
            PG8_BAR; PG8_WAIT_L(0); PG8_MMA(0, 1, At, B1); PG8_BAR;
            PG8_LDA(At, 1, 1); PG8_STAGE(PG8_SA(1, 0), a3, voffA);
            PG8_BAR; PG8_WAIT_L(0); PG8_MMA(1, 0, At, B0); PG8_BAR; PG8_SCHED;
            PG8_STAGE(PG8_SB(1, 1), b3 + hstep, voffB);
            PG8_WAIT_V(6); PG8_BAR; PG8_MMA(1, 1, At, B1); PG8_BAR;
            }
        }
        if constexpr (ALIGN_EPI) { if (wr == 0) PG8_BAR; }
        if constexpr (!Epi::AFTER_DRAIN) { E(acc, cur, wr, wc, fr, fq); S.done(cur); }
        if (!has_next) break;
#pragma unroll
        for (int a = 0; a < 2; ++a)
#pragma unroll
            for (int b = 0; b < 2; ++b)
#pragma unroll
                for (int m = 0; m < 4; ++m)
#pragma unroll
                    for (int n = 0; n < 2; ++n) acc[a][b][m][n] = (f32x4){0.f, 0.f, 0.f, 0.f};
        cur = nxt; cA = nA; cB = nB; ++ui;
        if constexpr (ALIGN_EPI) { if (wr == 1) PG8_BAR; }
    }
    PG8_WAIT_V(0);
    if constexpr (!ALIGN_EPI) { if (wr == 0) PG8_BAR; }
    PG8_BAR;
    if constexpr (Epi::AFTER_DRAIN) { E.fused(acc, cur, wr, wc, fr, fq, lds, wid, lane); S.done(cur); }
#undef PG8_SA
#undef PG8_SB
#undef PG8_STAGE
#undef PG8_LDA
#undef PG8_LDB
#undef PG8_MMA
#undef PG8_WAIT_V
#undef PG8_WAIT_L
#undef PG8_BAR
#undef PG8_SCHED
}
}

namespace nsa {
#define NLAS __attribute__((address_space(3)))
typedef short bf16x8 __attribute__((ext_vector_type(8)));
typedef short s16x4 __attribute__((ext_vector_type(4)));
typedef short v4i16_t __attribute__((ext_vector_type(4)));
typedef float f32x4 __attribute__((ext_vector_type(4)));
typedef unsigned u32x4 __attribute__((ext_vector_type(4)));
typedef unsigned u32x2 __attribute__((ext_vector_type(2)));
typedef unsigned long long u64;
constexpr int RS = 144, TILE_B = 64 * RS;
constexpr float LOG2E = 1.4426950408889634f;
constexpr int L_KB0 = 0, L_VB0 = TILE_B, L_KB1 = 2 * TILE_B, L_VB1 = 3 * TILE_B, L_CK = 4 * TILE_B, L_CV = 8 * TILE_B, L_IMP = 12 * TILE_B, L_MSK = L_IMP + 8192, L_WU = L_MSK + 256, L_END = L_WU + 64;
static_assert(L_END <= 131072, "nsa LDS map");
__device__ __forceinline__ s16x4 vtr(const NLAS char* p) { return __builtin_bit_cast(s16x4, __builtin_amdgcn_ds_read_tr16_b64_v4i16((NLAS v4i16_t*)p)); }
__device__ __forceinline__ f32x4 mfma16(bf16x8 a, bf16x8 b, f32x4 c) { return __builtin_amdgcn_mfma_f32_16x16x32_bf16(a, b, c, 0, 0, 0); }
__device__ __forceinline__ unsigned pkbf(float lo, float hi) { return pg8::cvt_pk_bf16(lo, hi); }
__device__ __forceinline__ void qk_tile(f32x4 (&s)[4], const NLAS char* Kb, const bf16x8 (&qf)[2], int i, int g, float kslope, float bt) {
    bf16x8 a[4][2]; const NLAS char* kp = Kb + i * RS + 16 * g;
#pragma unroll
    for (int kb = 0; kb < 4; ++kb) { a[kb][0] = *(const NLAS bf16x8*)(kp + kb * 16 * RS); a[kb][1] = *(const NLAS bf16x8*)(kp + kb * 16 * RS + 64); }
#pragma unroll
    for (int kb = 0; kb < 4; ++kb) { f32x4 ci; ci[0] = fmaf(kslope, (float)(kb * 16 + 0), bt); ci[1] = fmaf(kslope, (float)(kb * 16 + 1), bt); ci[2] = fmaf(kslope, (float)(kb * 16 + 2), bt); ci[3] = fmaf(kslope, (float)(kb * 16 + 3), bt);
        s[kb] = mfma16(a[kb][0], qf[0], ci); }
#pragma unroll
    for (int kb = 0; kb < 4; ++kb) s[kb] = mfma16(a[kb][1], qf[1], s[kb]);
}
__device__ __forceinline__ void pv_tile(f32x4 (&o)[4], const NLAS char* Vb, const f32x4 (&p)[4], int i, int g) {
    const NLAS char* vb = Vb + (4 * g + (i >> 2)) * RS + (i & 3) * 8;
    s16x4 lo[2][4], hi[2][4];
#pragma unroll
    for (int kk = 0; kk < 2; ++kk)
#pragma unroll
        for (int db = 0; db < 4; ++db) { const NLAS char* vp = vb + (2 * kk) * 16 * RS + db * 32; lo[kk][db] = vtr(vp); hi[kk][db] = vtr(vp + 16 * RS); }
    bf16x8 pf[2];
#pragma unroll
    for (int kk = 0; kk < 2; ++kk) { u32x4 pw; pw.x = pkbf(p[2 * kk][0], p[2 * kk][1]); pw.y = pkbf(p[2 * kk][2], p[2 * kk][3]); pw.z = pkbf(p[2 * kk + 1][0], p[2 * kk + 1][1]); pw.w = pkbf(p[2 * kk + 1][2], p[2 * kk + 1][3]);
        pf[kk] = __builtin_bit_cast(bf16x8, pw); }
#pragma unroll
    for (int kk = 0; kk < 2; ++kk)
#pragma unroll
        for (int db = 0; db < 4; ++db) o[db] = mfma16((bf16x8){lo[kk][db][0], lo[kk][db][1], lo[kk][db][2], lo[kk][db][3], hi[kk][db][0], hi[kk][db][1], hi[kk][db][2], hi[kk][db][3]}, pf[kk], o[db]);
}
constexpr float THR = 6.0f;
template <bool FIRST>
__device__ __forceinline__ float online_tile(f32x4 (&s)[4], float& m, float& l, f32x4 (&o)[4], bool needmask, int base, int lo, int hi) {
    float fret = 1.f;
    if (needmask) {
#pragma unroll
        for (int kb = 0; kb < 4; ++kb)
#pragma unroll
            for (int r = 0; r < 4; ++r) { const int pos = base + kb * 16 + r; s[kb][r] = (pos >= lo && pos <= hi) ? s[kb][r] : -INFINITY; } }
    float mt = fmaxf(fmaxf(fmaxf(s[0][0], s[0][1]), fmaxf(s[0][2], s[0][3])), fmaxf(fmaxf(s[1][0], s[1][1]), fmaxf(s[1][2], s[1][3])));
    mt = fmaxf(mt, fmaxf(fmaxf(fmaxf(s[2][0], s[2][1]), fmaxf(s[2][2], s[2][3])), fmaxf(fmaxf(s[3][0], s[3][1]), fmaxf(s[3][2], s[3][3]))));
    if (FIRST || __any(mt > THR)) {
        mt = fmaxf(mt, __shfl_xor(mt, 16)); mt = fmaxf(mt, __shfl_xor(mt, 32));
        const float d = FIRST ? ((mt == -INFINITY) ? 0.f : mt) : fmaxf(mt, 0.f), f = __builtin_amdgcn_exp2f(-d); m += d; l *= f; fret = f;
#pragma unroll
        for (int db = 0; db < 4; ++db) o[db] = o[db] * f;
#pragma unroll
        for (int kb = 0; kb < 4; ++kb) s[kb] = s[kb] - d; }
    float sum = 0.f;
#pragma unroll
    for (int kb = 0; kb < 4; ++kb)
#pragma unroll
        for (int r = 0; r < 4; ++r) { const float p = __builtin_amdgcn_exp2f(s[kb][r]); s[kb][r] = p; sum += p; }
    l += sum;
    return fret;
}
struct Stg { u32x4 k, v; };
__device__ __forceinline__ void stg_load(Stg& r, const bf16_t* kb, const bf16_t* vb, size_t pitch, int tid) { const size_t off = (size_t)(tid >> 3) * pitch + (tid & 7) * 8; r.k = *(const u32x4*)(kb + off); r.v = *(const u32x4*)(vb + off); }
__device__ __forceinline__ void stg_store(NLAS char* lds, int ko, int vo, const Stg& r, int tid) { const int off = (tid >> 3) * RS + (tid & 7) * 16; *(NLAS u32x4*)(lds + ko + off) = r.k; *(NLAS u32x4*)(lds + vo + off) = r.v; }
template <bool FIRST>
__device__ __forceinline__ void pair_tiles(const NLAS char* lds, int koA, int voA, int koB, int voB, bool na, bool nb, const bf16x8 (&qf)[2], int i, int g, float slope2,
                                           float btA, float btB, bool maskA, bool maskB, int baseA, int baseB, int lo, int hi, float& m, float& l, f32x4 (&o)[4]) {
    f32x4 sa[4], sb[4];
    if (na) qk_tile(sa, lds + koA, qf, i, g, slope2, btA - m);
    if (nb) qk_tile(sb, lds + koB, qf, i, g, slope2, btB - m);
    float da = 0.f;
    if (na) { const float m0 = m; online_tile<FIRST>(sa, m, l, o, FIRST || maskA, baseA, lo, hi); da = m - m0; pv_tile(o, lds + voA, sa, i, g); }
    if (nb) { if (__any(da != 0.f)) {
#pragma unroll
            for (int kb = 0; kb < 4; ++kb) sb[kb] = sb[kb] - da; }
        online_tile<false>(sb, m, l, o, maskB, baseB, lo, hi); pv_tile(o, lds + voB, sb, i, g); }
}
__device__ __forceinline__ float sigm(float v) { return __builtin_amdgcn_rcpf(1.f + __expf(-v)); }

__device__ __forceinline__ void unit(NLAS char* lds, const bf16_t* P, const float* S32, const bf16_t* KC, const bf16_t* VC, bf16_t* Ynsa, int b, int gq, int ti) {
    const int tid = threadIdx.x, lane = tid & 63, w = __builtin_amdgcn_readfirstlane(tid >> 6), i = lane & 15, g = lane >> 4;
    const int t0 = ti * 32, tl_mine = i >> 2, r = i & 3, h = gq * 4 + r, t = t0 + 4 * w + tl_mine; const size_t m = (size_t)b * T + t;
    const float slope2 = __builtin_amdgcn_exp2f(-(float)(h + 1)) * LOG2E;
    bf16x8 qf[2]; constexpr float QS = 0.125f * LOG2E;
    { const bf16_t* qp = P + m * PW + P_NSQ + h * 64 + 8 * g;
#pragma unroll
      for (int ks = 0; ks < 2; ++ks) { const u32x4 raw = *(const u32x4*)(qp + 32 * ks); u32x4 sc;
          sc.x = pkbf(pg8::bflo(raw.x) * QS, pg8::bfhi(raw.x) * QS); sc.y = pkbf(pg8::bflo(raw.y) * QS, pg8::bfhi(raw.y) * QS);
          sc.z = pkbf(pg8::bflo(raw.z) * QS, pg8::bfhi(raw.z) * QS); sc.w = pkbf(pg8::bflo(raw.w) * QS, pg8::bfhi(raw.w) * QS);
          qf[ks] = __builtin_bit_cast(bf16x8, sc); } }
    const float* gp = S32 + m * 32 + 8 + h * 3;
    const float gate0 = sigm(gp[0]), gate1 = sigm(gp[1]), gate2 = sigm(gp[2]);
    f32x4 outacc[4];
#pragma unroll
    for (int db = 0; db < 4; ++db) outacc[db] = (f32x4){0.f, 0.f, 0.f, 0.f};
    const int ntc = (ti >> 5) + 1;
    { Stg sc_[4];
#pragma unroll
      for (int tile = 0; tile < 4; ++tile) if (tile < ntc) { const size_t row0 = ((size_t)(b * 256 + tile * 64) * 2 + gq) * 64; stg_load(sc_[tile], KC + row0, VC + row0, 128, tid); }
#pragma unroll
      for (int tile = 0; tile < 4; ++tile) if (tile < ntc) stg_store(lds, L_CK + tile * TILE_B, L_CV + tile * TILE_B, sc_[tile], tid); }
    __syncthreads();
    { const int nmax = (t - 31) >> 4, nmax_w = ((t0 + 4 * w) - 31) >> 4; const float kslope = 16.f * slope2, c = -slope2 * (float)(t - 31);
      float mc = 0.f, lc = 0.f; f32x4 oc[4]; float av[16], cv[16];
#pragma unroll
      for (int db = 0; db < 4; ++db) oc[db] = (f32x4){0.f, 0.f, 0.f, 0.f};
#pragma unroll
      for (int q = 0; q < 16; ++q) { av[q] = 0.f; cv[q] = 0.f; }
      bool firstc = true;
#pragma unroll
      for (int tile = 3; tile >= 0; --tile) {
          if (tile < ntc) { f32x4 s[4]; qk_tile(s, lds + L_CK + tile * TILE_B, qf, i, g, kslope, fmaf(kslope, (float)(tile * 64 + 4 * g), c) - mc);
              const bool needmask = (tile * 64 + 63 > nmax_w);
              const float f = firstc ? online_tile<true>(s, mc, lc, oc, needmask, tile * 64 + 4 * g, -0x40000000, nmax) : online_tile<false>(s, mc, lc, oc, needmask, tile * 64 + 4 * g, -0x40000000, nmax);
              if (!firstc && __any(f != 1.f)) {
#pragma unroll
                  for (int q = 0; q < 16; ++q) { av[q] *= f; cv[q] *= f; } }
              firstc = false;
              pv_tile(oc, lds + L_CV + tile * TILE_B, s, i, g);
#pragma unroll
              for (int kb = 0; kb < 4; ++kb) { const f32x4 pv = s[kb];
                  float a = (pv[0] + pv[1]) + (pv[2] + pv[3]), cc = pv[3];
                  a += __shfl_xor(a, 1); a += __shfl_xor(a, 2); cc += __shfl_xor(cc, 1); cc += __shfl_xor(cc, 2);
                  av[tile * 4 + kb] = a; cv[tile * 4 + kb] = cc; } }
      }
      lc += __shfl_xor(lc, 16); lc += __shfl_xor(lc, 32);
      const float inv = lc > 0.f ? 1.f / lc : 0.f, g0i = gate0 * inv;
#pragma unroll
      for (int db = 0; db < 4; ++db) outacc[db] = outacc[db] + oc[db] * g0i;
      NLAS float* imp_s = (NLAS float*)(lds + L_IMP) + (w * 4 + tl_mine) * 64;
      float cprev = 0.f;
#pragma unroll
      for (int q = 0; q < 16; ++q) { const float up = __shfl(cv[q], (lane + 48) & 63); const float im = (av[q] + (g > 0 ? up : cprev)) * inv; cprev = up; if (r == 0) imp_s[4 * q + g] = im; }
    }
    NLAS float* impw = (NLAS float*)(lds + L_IMP) + w * 256;
    float myscore[4];
    asm volatile("s_waitcnt lgkmcnt(0)" ::: "memory");
#pragma unroll
    for (int tl = 0; tl < 4; ++tl) { const int tt = t0 + 4 * w + tl, cur = tt >> 6, j = lane; const bool valid = j <= cur, forced = (j == 0) || (j == cur) || (j == cur - 1);
        const float s = valid ? impw[tl * 64 + j] + (forced ? 1000.f : 0.f) : -1e30f; myscore[tl] = s; }
    asm volatile("s_waitcnt lgkmcnt(0)" ::: "memory");
#pragma unroll
    for (int tl = 0; tl < 4; ++tl) impw[tl * 64 + lane] = myscore[tl];
    asm volatile("s_waitcnt lgkmcnt(0)" ::: "memory");
    u64 wmask[4], wun = 0ull;
#pragma unroll
    for (int tl = 0; tl < 4; ++tl) { const int tt = t0 + 4 * w + tl, cur = tt >> 6; const float s = myscore[tl]; int rank = 0;
        for (int jj = 0; jj < 64; ++jj) { const float o = impw[tl * 64 + jj]; rank += (o > s || (o == s && jj < lane)) ? 1 : 0; }
        wmask[tl] = __ballot(rank < 16 && lane <= cur); wun |= wmask[tl]; }
    if (lane == 0) { NLAS u64* mk = (NLAS u64*)(lds + L_MSK) + w * 4; mk[0] = wmask[0]; mk[1] = wmask[1]; mk[2] = wmask[2]; mk[3] = wmask[3]; ((NLAS u64*)(lds + L_WU))[w] = wun; }
    __syncthreads();
    const u64 mymask = ((const NLAS u64*)(lds + L_MSK))[w * 4 + tl_mine];
    u64 uall = 0ull;
#pragma unroll
    for (int ww = 0; ww < 8; ++ww) uall |= ((const NLAS u64*)(lds + L_WU))[ww];
    uall = ((u64)__builtin_amdgcn_readfirstlane((unsigned)(uall >> 32)) << 32) | (u64)__builtin_amdgcn_readfirstlane((unsigned)uall);
    const size_t rowb = (size_t)b * T;
    {
        float ms_ = 0.f, ls = 0.f; f32x4 os[4];
#pragma unroll
        for (int db = 0; db < 4; ++db) os[db] = (f32x4){0.f, 0.f, 0.f, 0.f};
        const bf16_t* kcol = P + rowb * PW + P_KS + gq * 64; const bf16_t* vcol = P + rowb * PW + P_VS + gq * 64;
        const float c = -slope2 * (float)t;
        const int jcur = t0 >> 6;
        u64 rem = uall & ((1ull << jcur) - 1ull);
#define NSA_NEXT(dst) { dst = rem ? 63 - __builtin_clzll(rem) : -1; if (dst >= 0) rem &= ~(1ull << dst); }
#define NSA_KO(p, h) ((p) ? L_CK + (h) * TILE_B : ((h) ? L_KB1 : L_KB0))
#define NSA_VO(p, h) ((p) ? L_CV + (h) * TILE_B : ((h) ? L_VB1 : L_VB0))
        int ja = jcur, jb, na_, nb_, cur = 0; bool first = true;
        NSA_NEXT(jb)
        Stg sr0, sr1;
        stg_load(sr0, kcol + (size_t)ja * 64 * PW, vcol + (size_t)ja * 64 * PW, PW, tid); stg_store(lds, L_KB0, L_VB0, sr0, tid);
        if (jb >= 0) { stg_load(sr1, kcol + (size_t)jb * 64 * PW, vcol + (size_t)jb * 64 * PW, PW, tid); stg_store(lds, L_KB1, L_VB1, sr1, tid); }
        NSA_NEXT(na_) NSA_NEXT(nb_)
        if (na_ >= 0) stg_load(sr0, kcol + (size_t)na_ * 64 * PW, vcol + (size_t)na_ * 64 * PW, PW, tid);
        if (nb_ >= 0) stg_load(sr1, kcol + (size_t)nb_ * 64 * PW, vcol + (size_t)nb_ * 64 * PW, PW, tid);
        __syncthreads();
        for (;;) {
            if (na_ >= 0) stg_store(lds, NSA_KO(cur ^ 1, 0), NSA_VO(cur ^ 1, 0), sr0, tid);
            if (nb_ >= 0) stg_store(lds, NSA_KO(cur ^ 1, 1), NSA_VO(cur ^ 1, 1), sr1, tid);
            int nna, nnb; NSA_NEXT(nna) NSA_NEXT(nnb)
            if (nna >= 0) stg_load(sr0, kcol + (size_t)nna * 64 * PW, vcol + (size_t)nna * 64 * PW, PW, tid);
            if (nnb >= 0) stg_load(sr1, kcol + (size_t)nnb * 64 * PW, vcol + (size_t)nnb * 64 * PW, PW, tid);
            const bool na = (wun >> ja) & 1ull, nb = (jb >= 0) && ((wun >> jb) & 1ull);
            if (na || nb) {
                const float btA = fmaf(slope2, (float)(ja * 64 + 4 * g), c) + (((mymask >> ja) & 1ull) ? 0.f : -1e30f);
                const float btB = fmaf(slope2, (float)((jb < 0 ? 0 : jb) * 64 + 4 * g), c) + ((jb >= 0 && ((mymask >> jb) & 1ull)) ? 0.f : -1e30f);
                if (first) pair_tiles<true>(lds, NSA_KO(cur, 0), NSA_VO(cur, 0), NSA_KO(cur, 1), NSA_VO(cur, 1), na, nb, qf, i, g, slope2, btA, btB, true, false, ja * 64 + 4 * g, 0, 0, t, ms_, ls, os);
                else pair_tiles<false>(lds, NSA_KO(cur, 0), NSA_VO(cur, 0), NSA_KO(cur, 1), NSA_VO(cur, 1), na, nb, qf, i, g, slope2, btA, btB, false, false, 0, 0, 0, t, ms_, ls, os); }
            first = false;
            __syncthreads();
            if (na_ < 0) break;
            ja = na_; jb = nb_; na_ = nna; nb_ = nnb; cur ^= 1;
        }
        ls += __shfl_xor(ls, 16); ls += __shfl_xor(ls, 32);
        const float sc1 = gate1 / ls;
#pragma unroll
        for (int db = 0; db < 4; ++db) outacc[db] = outacc[db] + os[db] * sc1;
    }
    {
        float mw = 0.f, lw = 0.f; f32x4 ow[4];
#pragma unroll
        for (int db = 0; db < 4; ++db) ow[db] = (f32x4){0.f, 0.f, 0.f, 0.f};
        const bf16_t* kcol = P + rowb * PW + P_KW + gq * 64; const bf16_t* vcol = P + rowb * PW + P_VW + gq * 64;
        const float c = -slope2 * (float)t;
        const int j0 = (t0 - 511) > 0 ? ((t0 - 511) >> 6) : 0, j1 = t0 >> 6, tw0 = t0 + 4 * w;
        int ja = j1, cur = 0; bool first = true;
        Stg sr0, sr1;
        stg_load(sr0, kcol + (size_t)ja * 64 * PW, vcol + (size_t)ja * 64 * PW, PW, tid); stg_store(lds, L_KB0, L_VB0, sr0, tid);
        if (ja - 1 >= j0) { stg_load(sr1, kcol + (size_t)(ja - 1) * 64 * PW, vcol + (size_t)(ja - 1) * 64 * PW, PW, tid); stg_store(lds, L_KB1, L_VB1, sr1, tid); }
        if (ja - 2 >= j0) stg_load(sr0, kcol + (size_t)(ja - 2) * 64 * PW, vcol + (size_t)(ja - 2) * 64 * PW, PW, tid);
        if (ja - 3 >= j0) stg_load(sr1, kcol + (size_t)(ja - 3) * 64 * PW, vcol + (size_t)(ja - 3) * 64 * PW, PW, tid);
        __syncthreads();
        for (;;) {
            if (ja - 2 >= j0) stg_store(lds, NSA_KO(cur ^ 1, 0), NSA_VO(cur ^ 1, 0), sr0, tid);
            if (ja - 3 >= j0) stg_store(lds, NSA_KO(cur ^ 1, 1), NSA_VO(cur ^ 1, 1), sr1, tid);
            if (ja - 4 >= j0) stg_load(sr0, kcol + (size_t)(ja - 4) * 64 * PW, vcol + (size_t)(ja - 4) * 64 * PW, PW, tid);
            if (ja - 5 >= j0) stg_load(sr1, kcol + (size_t)(ja - 5) * 64 * PW, vcol + (size_t)(ja - 5) * 64 * PW, PW, tid);
            const int jb = ja - 1;
            const bool na = (64 * ja <= tw0 + 3) && (64 * ja + 63 >= tw0 - 511), nb = (jb >= j0) && (64 * jb <= tw0 + 3) && (64 * jb + 63 >= tw0 - 511);
            if (na || nb) {
                const float btA = fmaf(slope2, (float)(ja * 64 + 4 * g), c), btB = fmaf(slope2, (float)(jb * 64 + 4 * g), c);
                const bool maskA = (64 * ja < tw0 + 3 - 511), maskB = (64 * jb < tw0 + 3 - 511);
                if (first) pair_tiles<true>(lds, NSA_KO(cur, 0), NSA_VO(cur, 0), NSA_KO(cur, 1), NSA_VO(cur, 1), na, nb, qf, i, g, slope2, btA, btB, true, maskB, ja * 64 + 4 * g, jb * 64 + 4 * g, t - 511, t, mw, lw, ow);
                else pair_tiles<false>(lds, NSA_KO(cur, 0), NSA_VO(cur, 0), NSA_KO(cur, 1), NSA_VO(cur, 1), na, nb, qf, i, g, slope2, btA, btB, maskA, maskB, ja * 64 + 4 * g, jb * 64 + 4 * g, t - 511, t, mw, lw, ow); }
            first = false;
            __syncthreads();
            if (ja - 2 < j0) break;
            ja -= 2; cur ^= 1;
        }
        lw += __shfl_xor(lw, 16); lw += __shfl_xor(lw, 32);
        const float sc2 = gate2 / lw;
#pragma unroll
        for (int db = 0; db < 4; ++db) outacc[db] = outacc[db] + ow[db] * sc2;
    }
    bf16_t* yo = Ynsa + m * 512 + h * 64 + 4 * g;
#pragma unroll
    for (int db = 0; db < 4; ++db) { u32x2 v; v.x = pkbf(outacc[db][0], outacc[db][1]); v.y = pkbf(outacc[db][2], outacc[db][3]); *(u32x2*)(yo + db * 16) = v; }
}
__device__ __forceinline__ void phase(NLAS char* lds, const bf16_t* P, const float* S32, const bf16_t* KC, const bf16_t* VC, bf16_t* Ynsa) {
    const int G = gridDim.x, bid = blockIdx.x;
    if (G == 256) { const int base = bid >> 3, bg = bid & 7;
#pragma unroll 1
        for (int k = 0; k < 4; ++k) { const int ti = (k == 0) ? 127 - base : (k == 1) ? 64 + base : (k == 2) ? 63 - base : base; unit(lds, P, S32, KC, VC, Ynsa, bg >> 1, bg & 1, ti); } }
    else {
#pragma unroll 1
        for (int u = bid; u < 1024; u += G) unit(lds, P, S32, KC, VC, Ynsa, (u & 7) >> 1, u & 1, 127 - (u >> 3)); }
}
}

namespace xa {
using nsa::bf16x8; using nsa::s16x4; using nsa::f32x4; using nsa::u32x4; using nsa::u32x2; using nsa::vtr; using nsa::mfma16; using nsa::pkbf;
constexpr int RS = 272, TILE_B = 64 * RS;
__device__ __forceinline__ int l_k(int tile) { return tile * 2 * TILE_B; }
__device__ __forceinline__ int l_v(int tile) { return tile * 2 * TILE_B + TILE_B; }
__device__ __forceinline__ void unit(NLAS char* lds, const bf16_t* P, const bf16_t* MEMKV, bf16_t* Yxa, int b, int h, int tt) {
    const int tid = threadIdx.x, lane = tid & 63, w = __builtin_amdgcn_readfirstlane(tid >> 6), i = lane & 15, g = lane >> 4;
    const size_t m = (size_t)b * T + tt * 128 + 16 * w + i;
    const bf16_t* kbase = MEMKV + (size_t)b * 256 * 1024 + h * 128;
    { u32x4 st[4][4]; const bf16_t* p0 = kbase + (size_t)(tid >> 3) * 1024 + (tid & 7) * 8;
#pragma unroll
      for (int tile = 0; tile < 4; ++tile) { const bf16_t* p = p0 + (size_t)tile * 64 * 1024; st[tile][0] = *(const u32x4*)p; st[tile][1] = *(const u32x4*)(p + 64); st[tile][2] = *(const u32x4*)(p + 512); st[tile][3] = *(const u32x4*)(p + 576); }
      const int off = (tid >> 3) * RS + (tid & 7) * 16;
#pragma unroll
      for (int tile = 0; tile < 4; ++tile) { *(NLAS u32x4*)(lds + l_k(tile) + off) = st[tile][0]; *(NLAS u32x4*)(lds + l_k(tile) + off + 128) = st[tile][1]; *(NLAS u32x4*)(lds + l_v(tile) + off) = st[tile][2]; *(NLAS u32x4*)(lds + l_v(tile) + off + 128) = st[tile][3]; } }
    bf16x8 qf[4];
    { const bf16_t* qp = P + m * PW + P_XAQ + h * 128 + 8 * g;
#pragma unroll
      for (int ks = 0; ks < 4; ++ks) qf[ks] = *(const bf16x8*)(qp + 32 * ks); }
    const float scale2 = 0.08838834764831845f * nsa::LOG2E;
    float mx = -INFINITY, l = 0.f; f32x4 o[8];
#pragma unroll
    for (int db = 0; db < 8; ++db) o[db] = (f32x4){0.f, 0.f, 0.f, 0.f};
    __syncthreads();
#pragma unroll 1
    for (int tile = 0; tile < 4; ++tile) {
        const NLAS char* Kb = lds + l_k(tile); const NLAS char* Vb = lds + l_v(tile);
        f32x4 s[4];
        { bf16x8 a[4][4];
#pragma unroll
          for (int kb = 0; kb < 4; ++kb)
#pragma unroll
              for (int ks = 0; ks < 4; ++ks) a[kb][ks] = *(const NLAS bf16x8*)(Kb + (kb * 16 + i) * RS + 16 * g + 64 * ks);
#pragma unroll
          for (int kb = 0; kb < 4; ++kb) s[kb] = mfma16(a[kb][0], qf[0], (f32x4){0.f, 0.f, 0.f, 0.f});
#pragma unroll
          for (int ks = 1; ks < 4; ++ks)
#pragma unroll
              for (int kb = 0; kb < 4; ++kb) s[kb] = mfma16(a[kb][ks], qf[ks], s[kb]); }
        float mt = -INFINITY;
#pragma unroll
        for (int kb = 0; kb < 4; ++kb)
#pragma unroll
            for (int r = 0; r < 4; ++r) { const float v = s[kb][r] * scale2; s[kb][r] = v; mt = fmaxf(mt, v); }
        mt = fmaxf(mt, __shfl_xor(mt, 16)); mt = fmaxf(mt, __shfl_xor(mt, 32));
        const float mn = fmaxf(mx, mt), alpha = __builtin_amdgcn_exp2f(mx - mn); float sum = 0.f;
#pragma unroll
        for (int kb = 0; kb < 4; ++kb)
#pragma unroll
            for (int r = 0; r < 4; ++r) { const float p = __builtin_amdgcn_exp2f(s[kb][r] - mn); s[kb][r] = p; sum += p; }
        l = l * alpha + sum; mx = mn;
#pragma unroll
        for (int db = 0; db < 8; ++db) o[db] = o[db] * alpha;
        const NLAS char* vb = Vb + (4 * g + (i >> 2)) * RS + (i & 3) * 8;
#pragma unroll
        for (int kk = 0; kk < 2; ++kk) {
            u32x4 pw; pw.x = pkbf(s[2 * kk][0], s[2 * kk][1]); pw.y = pkbf(s[2 * kk][2], s[2 * kk][3]); pw.z = pkbf(s[2 * kk + 1][0], s[2 * kk + 1][1]); pw.w = pkbf(s[2 * kk + 1][2], s[2 * kk + 1][3]);
            const bf16x8 pf = __builtin_bit_cast(bf16x8, pw);
            s16x4 lo[8], hi[8];
#pragma unroll
            for (int db = 0; db < 8; ++db) { const NLAS char* vp = vb + (2 * kk) * 16 * RS + db * 32; lo[db] = vtr(vp); hi[db] = vtr(vp + 16 * RS); }
#pragma unroll
            for (int db = 0; db < 8; ++db) o[db] = mfma16((bf16x8){lo[db][0], lo[db][1], lo[db][2], lo[db][3], hi[db][0], hi[db][1], hi[db][2], hi[db][3]}, pf, o[db]);
        }
    }
    l += __shfl_xor(l, 16); l += __shfl_xor(l, 32);
    const float inv = 1.f / l;
    bf16_t* yo = Yxa + m * 512 + h * 128 + 4 * g;
#pragma unroll
    for (int db = 0; db < 8; ++db) { u32x2 v; v.x = pkbf(o[db][0] * inv, o[db][1] * inv); v.y = pkbf(o[db][2] * inv, o[db][3] * inv); *(u32x2*)(yo + db * 16) = v; }
    __syncthreads();
}
__device__ __forceinline__ void memkv_tile(const bf16_t* MEMN, const bf16_t* Wmkv, bf16_t* MEMKV, int tile) {
    const int tid = threadIdx.x, lane = tid & 63, w = __builtin_amdgcn_readfirstlane(tid >> 6), i = lane & 15, g = lane >> 4;
    const int r0 = (tile >> 4) * 64 + (w >> 1) * 16, c0 = (tile & 15) * 64 + (w & 1) * 32;
    const bf16_t* ap = MEMN + (size_t)(r0 + i) * 1024 + 8 * g; const bf16_t* bp = Wmkv + (size_t)(c0 + i) * 1024 + 8 * g;
    f32x4 acc0 = (f32x4){0.f, 0.f, 0.f, 0.f}, acc1 = acc0;
#pragma unroll 1
    for (int k0 = 0; k0 < 32; k0 += 8) { bf16x8 a[8], b0[8], b1[8];
#pragma unroll
        for (int kk = 0; kk < 8; ++kk) { a[kk] = *(const bf16x8*)(ap + 32 * (k0 + kk)); b0[kk] = *(const bf16x8*)(bp + 32 * (k0 + kk)); b1[kk] = *(const bf16x8*)(bp + 16 * 1024 + 32 * (k0 + kk)); }
#pragma unroll
        for (int kk = 0; kk < 8; ++kk) { acc0 = mfma16(a[kk], b0[kk], acc0); acc1 = mfma16(a[kk], b1[kk], acc1); } }
#pragma unroll
    for (int r = 0; r < 4; ++r) { bf16_t* o = MEMKV + (size_t)(r0 + 4 * g + r) * 1024 + c0 + i; o[0] = f2bf(acc0[r]); o[16] = f2bf(acc1[r]); }
}
__device__ __forceinline__ void phase(NLAS char* lds, const bf16_t* P, const bf16_t* MEMKV, bf16_t* Yxa) {
#pragma unroll 1
    for (int u = blockIdx.x; u < 512; u += gridDim.x) unit(lds, P, MEMKV, Yxa, u >> 7, (u >> 5) & 3, u & 31);
}
}

namespace ml {
using nsa::bf16x8; using nsa::s16x4; using nsa::f32x4; using nsa::u32x4; using nsa::u32x2; using nsa::vtr; using nsa::mfma16; using nsa::pkbf;
constexpr int RS = 272, TB = 64 * RS, RSS = 144;
constexpr float KSCALE = 0.08838834764831845f;
__device__ __forceinline__ float scan_add(float v, int lane) {
#pragma unroll
    for (int o = 1; o < 64; o <<= 1) { const float u = __shfl_up(v, o); if (lane >= o) v += u; }
    return v; }
__device__ __forceinline__ float scan_max(float v, int lane) {
#pragma unroll
    for (int o = 1; o < 64; o <<= 1) { const float u = __shfl_up(v, o); if (lane >= o) v = fmaxf(v, u); }
    return v; }
__device__ __forceinline__ bf16x8 trpair(const NLAS char* p, int hi_off) { const s16x4 lo = vtr(p), hi = vtr(p + hi_off); return (bf16x8){lo[0], lo[1], lo[2], lo[3], hi[0], hi[1], hi[2], hi[3]}; }
__device__ __forceinline__ void load_conv(NLAS char* dst, const bf16_t* P, const float* cw, int colP, int cwc, size_t m0, int tseq0, int tid) {
    const int s = tid >> 3, c16 = (tid & 7) * 16;
#pragma unroll
    for (int half = 0; half < 2; ++half) { const int c = c16 + half * 8; float acc[8];
#pragma unroll
        for (int e = 0; e < 8; ++e) acc[e] = 0.f;
#pragma unroll
        for (int j = 0; j < 4; ++j) { if (tseq0 + s - j >= 0) { const u32x4 raw = *(const u32x4*)(P + (m0 + s - j) * PW + colP + c);
            const f32x4 w0 = *(const f32x4*)(cw + j * 1024 + cwc + c), w1 = *(const f32x4*)(cw + j * 1024 + cwc + c + 4);
            acc[0] += w0[0] * pg8::bflo(raw.x); acc[1] += w0[1] * pg8::bfhi(raw.x); acc[2] += w0[2] * pg8::bflo(raw.y); acc[3] += w0[3] * pg8::bfhi(raw.y);
            acc[4] += w1[0] * pg8::bflo(raw.z); acc[5] += w1[1] * pg8::bfhi(raw.z); acc[6] += w1[2] * pg8::bflo(raw.w); acc[7] += w1[3] * pg8::bfhi(raw.w); } }
#pragma unroll
        for (int e = 0; e < 8; ++e) acc[e] = acc[e] * __builtin_amdgcn_rcpf(1.f + __expf(-acc[e]));
        u32x4 o; o.x = pkbf(acc[0], acc[1]); o.y = pkbf(acc[2], acc[3]); o.z = pkbf(acc[4], acc[5]); o.w = pkbf(acc[6], acc[7]);
        *(NLAS u32x4*)(dst + s * RS + c * 2) = o; }
}
__device__ __forceinline__ void m1_unit(NLAS char* lds, const bf16_t* P, const float* cw, const float* S32, bf16_t* Abuf, float* NA, float* Gc, float* Mloc, int ci) {
    constexpr int L_K = 0, L_EV = TB, L_E = 2 * TB;
    const int tid = threadIdx.x, lane = tid & 63, w = __builtin_amdgcn_readfirstlane(tid >> 6), i = lane & 15, g = lane >> 4;
    const int c = ci & 63, bh = ci >> 6, h = bh & 3, b = bh >> 2; const size_t m0 = (size_t)b * T + c * 64;
    NLAS float* eS = (NLAS float*)(lds + L_E);
    if (w == 0) { const float fpre = S32[(m0 + lane) * 32 + 4 + h], ipre = S32[(m0 + lane) * 32 + h];
        const float bcs = scan_add(logsig(fpre), lane), gtot = __shfl(bcs, 63), wend = gtot - bcs + ipre, mloc = wave_max(wend);
        eS[lane] = __expf(wend - mloc) * KSCALE; if (lane == 0) { Gc[ci] = gtot; Mloc[ci] = mloc; } }
    load_conv(lds + L_K, P, cw, P_MLK + h * 128, 512 + h * 128, m0, c * 64, tid);
    __syncthreads();
    { const int s = tid >> 3, c16 = (tid & 7) * 16; const float es = eS[s]; const bf16_t* vp = P + (m0 + s) * PW + P_MLV + h * 128 + c16;
#pragma unroll
      for (int half = 0; half < 2; ++half) { const u32x4 raw = *(const u32x4*)(vp + half * 8); u32x4 o;
          o.x = pkbf(pg8::bflo(raw.x) * es, pg8::bfhi(raw.x) * es); o.y = pkbf(pg8::bflo(raw.y) * es, pg8::bfhi(raw.y) * es);
          o.z = pkbf(pg8::bflo(raw.z) * es, pg8::bfhi(raw.z) * es); o.w = pkbf(pg8::bflo(raw.w) * es, pg8::bfhi(raw.w) * es);
          *(NLAS u32x4*)(lds + L_EV + s * RS + (c16 + half * 8) * 2) = o; } }
    __syncthreads();
    f32x4 acc[8];
#pragma unroll
    for (int vb = 0; vb < 8; ++vb) acc[vb] = (f32x4){0.f, 0.f, 0.f, 0.f};
    const int rowoff = (4 * g + (i >> 2)) * RS + (i & 3) * 8;
#pragma unroll
    for (int kk = 0; kk < 2; ++kk) { const bf16x8 kf = trpair(lds + L_K + kk * 32 * RS + rowoff + w * 32, 16 * RS);
#pragma unroll
        for (int vb = 0; vb < 8; ++vb) acc[vb] = mfma16(trpair(lds + L_EV + kk * 32 * RS + rowoff + vb * 32, 16 * RS), kf, acc[vb]); }
    bf16_t* ap = Abuf + ((size_t)ci * 128 + w * 16 + i) * 128 + 4 * g;
#pragma unroll
    for (int vb = 0; vb < 8; ++vb) { u32x2 pk; pk.x = pkbf(acc[vb][0], acc[vb][1]); pk.y = pkbf(acc[vb][2], acc[vb][3]); *(u32x2*)(ap + vb * 16) = pk; }
    { const int k = tid >> 2, part = tid & 3; float n = 0.f;
#pragma unroll
      for (int s = 0; s < 16; ++s) n += eS[part * 16 + s] * bf2f(*(const NLAS bf16_t*)(lds + L_K + (part * 16 + s) * RS + k * 2));
      n += __shfl_xor(n, 1); n += __shfl_xor(n, 2); if (part == 0) NA[(size_t)ci * 128 + k] = n; }
    __syncthreads();
}
__device__ __forceinline__ void m2_items(bf16_t* Abuf, float* NA, const float* Gc, const float* Mloc, float* Mprev) {
    for (int it = blockIdx.x * blockDim.x + threadIdx.x; it < 16 * 128 * 64; it += gridDim.x * blockDim.x) {
        const int bh = it >> 13, kv2 = it & 8191, k = kv2 >> 6, v2 = kv2 & 63;
        float C0 = 0.f, C1 = 0.f, n = 0.f, m = 0.f;
        unsigned* base = (unsigned*)(Abuf + ((size_t)(bh * 64) * 128 + k) * 128 + v2 * 2);
#pragma unroll 1
        for (int c0 = 0; c0 < 64; c0 += 16) { unsigned A[16];
#pragma unroll
            for (int u = 0; u < 16; ++u) A[u] = base[(size_t)(c0 + u) * 8192];
#pragma unroll
            for (int u = 0; u < 16; ++u) { const int ci = bh * 64 + c0 + u; const float gg = Gc[ci], ml = Mloc[ci];
                const float mn = fmaxf(gg + m, ml), a = __expf(gg + m - mn), bb = __expf(ml - mn);
                base[(size_t)(c0 + u) * 8192] = pkbf(C0, C1); C0 = C0 * a + pg8::bflo(A[u]) * bb; C1 = C1 * a + pg8::bfhi(A[u]) * bb;
                if (v2 == 0) { const float nA = NA[(size_t)ci * 128 + k]; NA[(size_t)ci * 128 + k] = n; n = a * n + bb * nA; }
                if (kv2 == 0) Mprev[ci] = m;
                m = mn; } }
    }
}
__device__ __forceinline__ void m3_unit(NLAS char* lds, const bf16_t* P, const float* cw, const float* S32, const bf16_t* Cprev, const float* Nprev, const float* Mprev, const float* normg, bf16_t* Yml, int ci) {
    constexpr int L_Q = 0, L_K = TB, L_V = 2 * TB, L_C = 3 * TB, L_S = 5 * TB, L_F = L_S + 64 * RSS;
    const int tid = threadIdx.x, lane = tid & 63, w = __builtin_amdgcn_readfirstlane(tid >> 6), i = lane & 15, g = lane >> 4;
    const int c = ci & 63, bh = ci >> 6, h = bh & 3, b = bh >> 2; const size_t m0 = (size_t)b * T + c * 64;
    bf16_t ov[4][4]; float ng[4];
    { const int tb_ = w >> 1, vb0_ = (w & 1) * 4;
#pragma unroll
      for (int vb = 0; vb < 4; ++vb) { ng[vb] = normg[h * 128 + (vb0_ + vb) * 16 + i];
#pragma unroll
          for (int r = 0; r < 4; ++r) ov[vb][r] = P[(m0 + tb_ * 16 + 4 * g + r) * PW + P_MLO + h * 128 + (vb0_ + vb) * 16 + i]; } }
    NLAS float* F = (NLAS float*)(lds + L_F);
    NLAS float* rowf = F; NLAS float* colf = F + 64; NLAS float* scv = F + 128; NLAS float* emt = F + 192; NLAS float* qn = F + 256; NLAS float* nprev = F + 320; NLAS float* denp = F + 448; NLAS float* ssq = F + 576;
    if (w == 0) { const float fpre = S32[(m0 + lane) * 32 + 4 + h], ipre = S32[(m0 + lane) * 32 + h], mprev = Mprev[ci];
        const float bcs = scan_add(logsig(fpre), lane), u = ipre - bcs, pm = scan_max(u, lane), mt = bcs + fmaxf(mprev, pm);
        rowf[lane] = bcs - mt; colf[lane] = u; scv[lane] = __expf(bcs + mprev - mt); emt[lane] = __expf(-mt); }
    else if (w <= 2) nprev[tid - 64] = Nprev[(size_t)ci * 128 + tid - 64];
    load_conv(lds + L_Q, P, cw, P_MLQ + h * 128, h * 128, m0, c * 64, tid);
    load_conv(lds + L_K, P, cw, P_MLK + h * 128, 512 + h * 128, m0, c * 64, tid);
    { const int s = tid >> 3, c16 = (tid & 7) * 16; const bf16_t* vp = P + (m0 + s) * PW + P_MLV + h * 128 + c16;
      *(NLAS u32x4*)(lds + L_V + s * RS + c16 * 2) = *(const u32x4*)vp; *(NLAS u32x4*)(lds + L_V + s * RS + c16 * 2 + 16) = *(const u32x4*)(vp + 8); }
    { const int k = tid >> 2, v0 = (tid & 3) * 32; const bf16_t* cp = Cprev + ((size_t)ci * 128 + k) * 128 + v0;
#pragma unroll
      for (int q8 = 0; q8 < 4; ++q8) *(NLAS u32x4*)(lds + L_C + k * RS + (v0 + q8 * 8) * 2) = *(const u32x4*)(cp + q8 * 8); }
    __syncthreads();
    { const int tq = tid >> 3, part = tid & 7; const u32x4 q0 = *(const NLAS u32x4*)(lds + L_Q + tq * RS + part * 32), q1 = *(const NLAS u32x4*)(lds + L_Q + tq * RS + part * 32 + 16);
      const NLAS f32x4* np = (const NLAS f32x4*)(nprev + part * 16); const f32x4 n0 = np[0], n1 = np[1], n2 = np[2], n3 = np[3];
      float a = pg8::bflo(q0.x) * n0[0] + pg8::bfhi(q0.x) * n0[1] + pg8::bflo(q0.y) * n0[2] + pg8::bfhi(q0.y) * n0[3] + pg8::bflo(q0.z) * n1[0] + pg8::bfhi(q0.z) * n1[1] + pg8::bflo(q0.w) * n1[2] + pg8::bfhi(q0.w) * n1[3]
              + pg8::bflo(q1.x) * n2[0] + pg8::bfhi(q1.x) * n2[1] + pg8::bflo(q1.y) * n2[2] + pg8::bfhi(q1.y) * n2[3] + pg8::bflo(q1.z) * n3[0] + pg8::bfhi(q1.z) * n3[1] + pg8::bflo(q1.w) * n3[2] + pg8::bfhi(q1.w) * n3[3];
      a += __shfl_xor(a, 1); a += __shfl_xor(a, 2); a += __shfl_xor(a, 4); if (part == 0) qn[tq] = a; }
    const int tb = w >> 1;
    {
        float rs[4] = {0.f, 0.f, 0.f, 0.f};
#pragma unroll
        for (int sbi = 0; sbi < 2; ++sbi) { const int sb = 2 * (w & 1) + sbi; f32x4 acc = (f32x4){0.f, 0.f, 0.f, 0.f};
            if (sb <= tb) {
#pragma unroll
                for (int ks = 0; ks < 4; ++ks) acc = mfma16(*(const NLAS bf16x8*)(lds + L_Q + (tb * 16 + i) * RS + (32 * ks + 8 * g) * 2), *(const NLAS bf16x8*)(lds + L_K + (sb * 16 + i) * RS + (32 * ks + 8 * g) * 2), acc); }
            const int s = sb * 16 + i; const float cf = colf[s];
#pragma unroll
            for (int r = 0; r < 4; ++r) { const int t = tb * 16 + 4 * g + r; const float v = (s <= t) ? acc[r] * KSCALE * __expf(rowf[t] + cf) : 0.f; rs[r] += v;
                *(NLAS bf16_t*)(lds + L_S + t * RSS + s * 2) = f2bf(v); } }
#pragma unroll
        for (int r = 0; r < 4; ++r) { float x = rs[r]; x += __shfl_xor(x, 1); x += __shfl_xor(x, 2); x += __shfl_xor(x, 4); x += __shfl_xor(x, 8); if (i == 0) denp[(w & 1) * 64 + tb * 16 + 4 * g + r] = x; }
    }
    __syncthreads();
    f32x4 a1[4], a2[4];
#pragma unroll
    for (int vb = 0; vb < 4; ++vb) { a1[vb] = (f32x4){0.f, 0.f, 0.f, 0.f}; a2[vb] = (f32x4){0.f, 0.f, 0.f, 0.f}; }
    const int vb0 = (w & 1) * 4, troff = (8 * g + (i >> 2)) * RS + (i & 3) * 8;
#pragma unroll
    for (int kk = 0; kk < 2; ++kk) { if (32 * kk <= tb * 16 + 15) { const bf16x8 sf = *(const NLAS bf16x8*)(lds + L_S + (tb * 16 + i) * RSS + (32 * kk + 8 * g) * 2);
#pragma unroll
        for (int vb = 0; vb < 4; ++vb) a1[vb] = mfma16(sf, trpair(lds + L_V + kk * 32 * RS + troff + (vb0 + vb) * 32, 4 * RS), a1[vb]); } }
#pragma unroll
    for (int ks = 0; ks < 4; ++ks) { const bf16x8 qf = *(const NLAS bf16x8*)(lds + L_Q + (tb * 16 + i) * RS + (32 * ks + 8 * g) * 2);
#pragma unroll
        for (int vb = 0; vb < 4; ++vb) a2[vb] = mfma16(qf, trpair(lds + L_C + ks * 32 * RS + troff + (vb0 + vb) * 32, 4 * RS), a2[vb]); }
    float hv[4][4], sq[4] = {0.f, 0.f, 0.f, 0.f};
#pragma unroll
    for (int r = 0; r < 4; ++r) { const int t = tb * 16 + 4 * g + r; const float sc = scv[t]; const float den = denp[t] + denp[64 + t] + sc * qn[t]; const float hd = 1.f / fmaxf(fabsf(den), emt[t]);
#pragma unroll
        for (int vb = 0; vb < 4; ++vb) { const float x = (a1[vb][r] + sc * a2[vb][r]) * hd; hv[vb][r] = x; sq[r] += x * x; } }
#pragma unroll
    for (int r = 0; r < 4; ++r) { float x = sq[r]; x += __shfl_xor(x, 1); x += __shfl_xor(x, 2); x += __shfl_xor(x, 4); x += __shfl_xor(x, 8); if (i == 0) ssq[(w & 1) * 64 + tb * 16 + 4 * g + r] = x; }
    __syncthreads();
#pragma unroll
    for (int r = 0; r < 4; ++r) { const int t = tb * 16 + 4 * g + r; const float rinv = rsqrtf((ssq[t] + ssq[64 + t]) * (1.f / 128.f) + EPS);
#pragma unroll
        for (int vb = 0; vb < 4; ++vb) { const int v = (vb0 + vb) * 16 + i; const float o = bf2f(ov[vb][r]);
            Yml[(m0 + t) * 512 + h * 128 + v] = f2bf(__builtin_amdgcn_rcpf(1.f + __expf(-o)) * hv[vb][r] * rinv * ng[vb]); } }
    __syncthreads();
}
}

namespace cmpr {
using nsa::bf16x8; using nsa::f32x4; using nsa::u32x4; using nsa::mfma16; using nsa::pkbf;
constexpr int RSX = 144, L_X = 0, L_PE = 272 * RSX  , L_H = L_PE + 8192, RSH = 528;
__device__ __forceinline__ void unit(NLAS char* lds, const bf16_t* P, const float* pe, const bf16_t* W1t, const bf16_t* W2t, bf16_t* KC, bf16_t* VC, int u) {
    const int tid = threadIdx.x, lane = tid & 63, w = __builtin_amdgcn_readfirstlane(tid >> 6), i = lane & 15, g = lane >> 4;
    const int nt = u & 15, gq = (u >> 4) & 1, b = (u >> 5) & 3, kv = u >> 7;
    const int pcol = (kv ? P_VC : P_KC) + gq * 64, tok0 = 256 * nt;
    for (int ch = tid; ch < 272 * 8; ch += 512) { const int row = ch >> 3, c8 = (ch & 7) * 8, tok = tok0 + row;
        u32x4 v = (u32x4){0u, 0u, 0u, 0u}; if (tok < T) v = *(const u32x4*)(P + ((size_t)b * T + tok) * PW + pcol + c8);
        *(NLAS u32x4*)(lds + L_X + row * RSX + c8 * 2) = v; }
    for (int e = tid; e < 2048; e += 512) ((NLAS float*)(lds + L_PE))[e] = pe[kv * 2048 + e];
    __syncthreads();
    f32x4 acc[2]; acc[0] = (f32x4){0.f, 0.f, 0.f, 0.f}; acc[1] = acc[0];
    const bf16_t* wb = W1t + ((size_t)kv * 256 + 32 * w + i) * 2048 + 8 * g;
#define CMPR_LOAD(dst, k0_) { _Pragma("unroll") for (int kk = 0; kk < 8; ++kk) { dst[kk][0] = *(const bf16x8*)(wb + 32 * ((k0_) + kk)); dst[kk][1] = *(const bf16x8*)(wb + 16 * 2048 + 32 * ((k0_) + kk)); } }
#define CMPR_COMP(src, k0_) { _Pragma("unroll") for (int kk = 0; kk < 8; ++kk) { const int ks = (k0_) + kk, l = ks >> 1, dh = ks & 1; \
            const u32x4 raw = *(const NLAS u32x4*)(lds + L_X + (16 * i + l) * RSX + dh * 64 + 16 * g); \
            const NLAS float* pp = (const NLAS float*)(lds + L_PE) + l * 64 + dh * 32 + 8 * g; const f32x4 p0 = *(const NLAS f32x4*)pp, p1 = *(const NLAS f32x4*)(pp + 4); \
            u32x4 a; a.x = pkbf(pg8::bflo(raw.x) + p0[0], pg8::bfhi(raw.x) + p0[1]); a.y = pkbf(pg8::bflo(raw.y) + p0[2], pg8::bfhi(raw.y) + p0[3]); \
            a.z = pkbf(pg8::bflo(raw.z) + p1[0], pg8::bfhi(raw.z) + p1[1]); a.w = pkbf(pg8::bflo(raw.w) + p1[2], pg8::bfhi(raw.w) + p1[3]); \
            const bf16x8 af = __builtin_bit_cast(bf16x8, a); \
            acc[0] = mfma16(af, src[kk][0], acc[0]); acc[1] = mfma16(af, src[kk][1], acc[1]); } }
    { bf16x8 bA[8][2], bB[8][2];
      CMPR_LOAD(bA, 0)
#pragma unroll 1
      for (int k0 = 0; k0 < 64; k0 += 16) { CMPR_LOAD(bB, k0 + 8) CMPR_COMP(bA, k0) if (k0 + 16 < 64) CMPR_LOAD(bA, k0 + 16) CMPR_COMP(bB, k0 + 8) } }
#undef CMPR_LOAD
#undef CMPR_COMP
#pragma unroll
    for (int cb = 0; cb < 2; ++cb)
#pragma unroll
        for (int r = 0; r < 4; ++r) { const float x = acc[cb][r], uu = 0.7978845608028654f * (x + 0.044715f * x * x * x); const float gl = x * __builtin_amdgcn_rcpf(1.f + __expf(-2.f * uu));
            *(NLAS bf16_t*)(lds + L_H + (4 * g + r) * RSH + (32 * w + cb * 16 + i) * 2) = f2bf(gl); }
    __syncthreads();
    if (w < 4) { f32x4 o = (f32x4){0.f, 0.f, 0.f, 0.f}; const bf16_t* w2 = W2t + ((size_t)kv * 64 + 16 * w + i) * 256 + 8 * g;
#pragma unroll
        for (int ks = 0; ks < 8; ++ks) o = mfma16(*(const NLAS bf16x8*)(lds + L_H + i * RSH + (32 * ks + 8 * g) * 2), *(const bf16x8*)(w2 + 32 * ks), o);
        bf16_t* dst = (kv ? VC : KC);
#pragma unroll
        for (int r = 0; r < 4; ++r) dst[((size_t)(b * 256 + 16 * nt + 4 * g + r) * 2 + gq) * 64 + 16 * w + i] = f2bf(o[r]); }
    __syncthreads();
}
}

#define LAS __attribute__((address_space(3)))
constexpr int NTHREADS = 512, LDS_BYTES = 147456;
constexpr size_t WS_WIN = 1 * MiB, WS_WG = 9 * MiB, WS_WBR = 15 * MiB, WS_WOUT = 18 * MiB, WS_WFF1 = 20 * MiB, WS_WFF2 = 28 * MiB, WS_WMKV = 36 * MiB, WS_WC1 = 38 * MiB;
constexpr size_t WS_BIASP = 249 * MiB, WS_XCH = 250 * MiB;
#define XB_TMO      128
#define XB_XCNT(j)  (256  + 64 * (j))
#define XB_XSUB(j)  (1280 + 64 * (j))
#define XB_XGEN(j)  (2304 + 64 * (j))
#define XB_TOP      3328
#define XB_TOPGEN   3392
#define XCD_BAR_WORDS 3456
#define XB_SPIN_CAP (1u << 18)

__device__ __forceinline__ unsigned xb_ld(unsigned* p)              { return __hip_atomic_load(p, __ATOMIC_RELAXED, __HIP_MEMORY_SCOPE_AGENT); }
__device__ __forceinline__ unsigned xb_add(unsigned* p, unsigned v) { return __hip_atomic_fetch_add(p, v, __ATOMIC_RELAXED, __HIP_MEMORY_SCOPE_AGENT); }
__device__ __forceinline__ unsigned xb_xcc_id() { return (unsigned)__builtin_amdgcn_s_getreg((3 << 11) | 20) & 0xFu; }
#define XB_SPIN(cond, bar) do { unsigned _sp = 0; while (cond) { __builtin_amdgcn_s_sleep(1); \
    if ((++_sp & 255u) == 0u) { if (xb_ld(&(bar)[XB_TMO])) break; if (_sp > XB_SPIN_CAP) { atomicAdd(&(bar)[XB_TMO], 1u); break; } } } } while (0)

struct XcdBarrier {
    unsigned* bar; unsigned x;
    volatile LAS unsigned* st;
};

__device__ __forceinline__ XcdBarrier xcd_barrier_post(unsigned* bar, volatile LAS unsigned* st) {
    XcdBarrier b; b.bar = bar; b.x = xb_xcc_id(); b.st = st;
    if (threadIdx.x == 0) (void)xb_add(&bar[XB_XCNT(b.x)], 1u);
    return b;
}
__device__ __forceinline__ void xcd_barrier_complete(unsigned* bar, unsigned x, unsigned& nloc, unsigned& nx) {
    const unsigned G = gridDim.x * gridDim.y * gridDim.z;
    unsigned sum, cnt, mine, sp = 0u;
    for (;;) {
        sum = 0u; cnt = 0u; mine = 0u;
#pragma unroll
        for (unsigned j = 0; j < 16; ++j) { const unsigned c = xb_ld(&bar[XB_XCNT(j)]); sum += c; cnt += (c > 0u) ? 1u : 0u; mine = (j == x) ? c : mine; }
        if (sum == G) break;
        __builtin_amdgcn_s_sleep(1);
        if ((++sp & 255u) == 0u) { if (xb_ld(&bar[XB_TMO])) break; if (sp > XB_SPIN_CAP) { atomicAdd(&bar[XB_TMO], 1u); break; } }
    }
    nloc = mine > 0u ? mine : 1u; nx = cnt > 0u ? cnt : 1u;
}

__device__ __forceinline__ void xcd_barrier(const XcdBarrier& b) {
    asm volatile("s_waitcnt vmcnt(0)" ::: "memory");
    __syncthreads();
    if (threadIdx.x == 0) {
        unsigned* bar = b.bar;
        __builtin_amdgcn_s_waitcnt(0);
        unsigned nloc = b.st[0], nx = b.st[1];
        if (nloc == 0u) { xcd_barrier_complete(bar, b.x, nloc, nx); b.st[0] = nloc; b.st[1] = nx; }
        const unsigned old = xb_add(&bar[XB_XSUB(b.x)], 1u);
        const unsigned gen = old / nloc;
        if (old + 1u == (gen + 1u) * nloc) {
            __builtin_amdgcn_fence(__ATOMIC_RELEASE, "agent");
            asm volatile("s_waitcnt vmcnt(0)" ::: "memory");
            const unsigned og = xb_add(&bar[XB_TOP], 1u);
            const unsigned tg = og / nx;
            if (og + 1u == (tg + 1u) * nx) xb_add(&bar[XB_TOPGEN], 1u);
            else XB_SPIN(xb_ld(&bar[XB_TOPGEN]) == tg, bar);
            __builtin_amdgcn_fence(__ATOMIC_ACQUIRE, "agent");
            xb_add(&bar[XB_XGEN(b.x)], 1u);
            asm volatile("s_waitcnt vmcnt(0)" ::: "memory");
        } else {
            XB_SPIN(xb_ld(&bar[XB_XGEN(b.x)]) == gen, bar);
            __builtin_amdgcn_fence(__ATOMIC_ACQUIRE, "agent");
            asm volatile("s_waitcnt vmcnt(0)" ::: "memory");
        }
    }
    __syncthreads();
}

struct Args { const float* in[18]; float* out; unsigned char* ws; int ph_lo, ph_hi; };
__device__ __forceinline__ unsigned pk2(float lo, float hi) { return (unsigned)f2bf(lo) | ((unsigned)f2bf(hi) << 16); }
typedef unsigned v4u __attribute__((ext_vector_type(4)));
typedef float f32x4 __attribute__((ext_vector_type(4)));
__device__ __forceinline__ void tr_item(const float* W, int ld, int ncols, int K, bf16_t* WT, int row_off, LAS float* scr, int item, int lane) {
    const int nblk = ncols / 32, kb = item / nblk, nb = item % nblk, k0 = 64 * kb, n0 = 32 * nb;
#pragma unroll 8
    for (int i = 0; i < 32; ++i) { const int kk = 2 * i + (lane >> 5); scr[kk * 33 + (lane & 31)] = W[(size_t)(k0 + kk) * ld + n0 + (lane & 31)]; }
    asm volatile("s_waitcnt lgkmcnt(0)" ::: "memory");
    const int c = lane & 7;
#pragma unroll
    for (int j = 0; j < 4; ++j) { const int n = (lane >> 3) + 8 * j; const LAS float* s = scr + (8 * c) * 33 + n;
        v4u o; o.x = pk2(s[0 * 33], s[1 * 33]); o.y = pk2(s[2 * 33], s[3 * 33]); o.z = pk2(s[4 * 33], s[5 * 33]); o.w = pk2(s[6 * 33], s[7 * 33]);
        *(v4u*)(WT + (size_t)(row_off + n0 + n) * K + k0 + 8 * c) = o; }
    asm volatile("s_waitcnt lgkmcnt(0)" ::: "memory");
}
__device__ __forceinline__ void rms_row_wave(const float* xrow, const float* g, bf16_t* orow, int lane) {
    const f32x4* xr = (const f32x4*)xrow + lane; const f32x4* gr = (const f32x4*)g + lane;
    f32x4 v[4]; float s = 0.f;
#pragma unroll
    for (int j = 0; j < 4; ++j) { v[j] = xr[64 * j]; s += (v[j].x * v[j].x + v[j].y * v[j].y) + (v[j].z * v[j].z + v[j].w * v[j].w); }
    const float r = rsqrtf(wave_sum(s) * (1.f / D) + EPS);
    unsigned long long* o8 = (unsigned long long*)orow + lane;
#pragma unroll
    for (int j = 0; j < 4; ++j) { const f32x4 gg = gr[64 * j]; o8[64 * j] = (unsigned long long)pk2(v[j].x * r * gg.x, v[j].y * r * gg.y) | ((unsigned long long)pk2(v[j].z * r * gg.z, v[j].w * r * gg.w) << 32); }
}
__device__ __forceinline__ int small_src_col(int c) { return c < 8 ? C_MLI + c : C_NSG + (c - 8); }
__global__ void __launch_bounds__(NTHREADS, 2) mega(Args a) {
    extern __shared__ __attribute__((aligned(16))) unsigned char lds_raw[];
    char* lds = (char*)lds_raw;
    LAS unsigned char* lds3 = (LAS unsigned char*)lds_raw;
    const float* x = a.in[0]; const float* mem = a.in[1]; const float* g_mix = a.in[2]; const float* w_in = a.in[3];
    const float* b_in = a.in[4]; const float* ml_conv = a.in[5]; const float* ml_norm_g = a.in[6]; const float* cmp_pe = a.in[7];
    const float* cmp_w1 = a.in[8]; const float* cmp_w2 = a.in[9]; const float* g_mem = a.in[10]; const float* w_mem_kv = a.in[11];
    const float* w_branch = a.in[12]; const float* w_out = a.in[13]; const float* g_ffn = a.in[14]; const float* w_ff1 = a.in[15];
    const float* w_ff2 = a.in[16]; const float* g_final = a.in[17];
    char* ws = (char*)a.ws; float* out = a.out;
    bf16_t* U = (bf16_t*)(ws + WS_U); bf16_t* P = (bf16_t*)(ws + WS_P);
    bf16_t* Yml = (bf16_t*)(ws + WS_Y); bf16_t* Ynsa = Yml + (size_t)M * 512; bf16_t* Yxa = Ynsa + (size_t)M * 512;
    float* S32 = (float*)(ws + WS_S32); bf16_t* MEMN = (bf16_t*)(ws + WS_MEMN); bf16_t* MEMKV = (bf16_t*)(ws + WS_MEMKV);
    bf16_t* KC = (bf16_t*)(ws + WS_KC); bf16_t* VC = (bf16_t*)(ws + WS_VC);
    float* NA = (float*)(ws + WS_NA); float* Gc = (float*)(ws + WS_G); float* Mloc = (float*)(ws + WS_MLOC); float* Mprev = (float*)(ws + WS_MPREV);
    bf16_t* Abuf = (bf16_t*)out;
    bf16_t* GATES = P; bf16_t* MERGED = U; bf16_t* AFFN = (bf16_t*)(ws + WS_AFFN); bf16_t* HBUF = P;
    bf16_t* Wi = (bf16_t*)(ws + WS_WIN); bf16_t* Wg = (bf16_t*)(ws + WS_WG); bf16_t* Wbr = (bf16_t*)(ws + WS_WBR); bf16_t* Wo = (bf16_t*)(ws + WS_WOUT);
    bf16_t* Wf1 = (bf16_t*)(ws + WS_WFF1); bf16_t* Wf2 = (bf16_t*)(ws + WS_WFF2); bf16_t* Wmkv = (bf16_t*)(ws + WS_WMKV);
    float* biasP = (float*)(ws + WS_BIASP); bf16_t* Wc1 = (bf16_t*)(ws + WS_WC1); bf16_t* Wc2 = (bf16_t*)(ws + WS_BIASP + 65536);
    const int tid = threadIdx.x, lane = tid & 63, wave = __builtin_amdgcn_readfirstlane(tid >> 6);
    const int G = gridDim.x, bid = blockIdx.x;
    const int lo = a.ph_lo, hi = a.ph_hi;
    volatile LAS unsigned* xbst = (volatile LAS unsigned*)(lds3 + LDS_BYTES - 64);
    if (tid < 2) xbst[tid] = 0u;
    __syncthreads();
    const XcdBarrier bar = xcd_barrier_post((unsigned*)ws, xbst);
#define PHASE(k) if (lo <= (k) && (k) < hi)
#define SEAM(k) if (lo <= (k) && (k) + 1 < hi) xcd_barrier(bar)
    PHASE(0) {
        LAS float* scr = (LAS float*)(lds3 + wave * 16384);
        const int gw = bid * 8 + wave, NGW = G * 8;
        constexpr int I0 = 16 * 64, I1 = 16 * 40, I2 = 16 * 16, I3 = 16 * 96, I4 = 8 * 32, I5 = 16 * 32, I6 = 16 * 128, I7 = 64 * 32, I8 = 16 * 32;
        constexpr int I9 = 32 * 8, I10 = 4 * 2;
        constexpr int NITEMS = I0 + I1 + I2 + I3 + 3 * I4 + I5 + I6 + I7 + I8 + 2 * I9 + 2 * I10;
        for (int it = gw; it < NITEMS; it += NGW) {
            int r = it;
            if (r < I0) { tr_item(w_in, DIN, 2048, 1024, Wi, 0, scr, r, lane); continue; } r -= I0;
            if (r < I1) { tr_item(w_in + 2056, DIN, 1280, 1024, Wi, 2048, scr, r, lane); continue; } r -= I1;
            if (r < I2) { tr_item(w_in + 3360, DIN, 512, 1024, Wi, 3328, scr, r, lane); continue; } r -= I2;
            if (r < I3) { tr_item(w_in + C_MG, DIN, 3072, 1024, Wg, 0, scr, r, lane); continue; } r -= I3;
            if (r < 3 * I4) { const int j = r / I4; tr_item(w_branch + (size_t)j * 512 * 1024, 1024, 1024, 512, Wbr + (size_t)j * 1024 * 512, 0, scr, r % I4, lane); continue; } r -= 3 * I4;
            if (r < I5) { tr_item(w_out, 1024, 1024, 1024, Wo, 0, scr, r, lane); continue; } r -= I5;
            if (r < I6) { tr_item(w_ff1, FF, FF, 1024, Wf1, 0, scr, r, lane); continue; } r -= I6;
            if (r < I7) { tr_item(w_ff2, 1024, 1024, FF, Wf2, 0, scr, r, lane); continue; } r -= I7;
            if (r < I8) { tr_item(w_mem_kv, 1024, 1024, 1024, Wmkv, 0, scr, r, lane); continue; } r -= I8;
            if (r < 2 * I9) { const int kv = r / I9; tr_item(cmp_w1 + (size_t)kv * 2048 * 256, 256, 256, 2048, Wc1 + (size_t)kv * 256 * 2048, 0, scr, r % I9, lane); continue; } r -= 2 * I9;
            { const int kv = r / I10; tr_item(cmp_w2 + (size_t)kv * 256 * 64, 64, 64, 256, Wc2 + (size_t)kv * 64 * 256, 0, scr, r % I10, lane); }
        }
        for (int i = bid * NTHREADS + tid; i < 256 * 1024; i += G * NTHREADS) { const int r = i >> 10, k = i & 1023; bf16_t v = 0;
            if (r < 32) v = f2bf(w_in[(size_t)k * DIN + small_src_col(r)]);
            else if (r >= 128 && r < 160) { const float w = w_in[(size_t)k * DIN + small_src_col(r - 128)]; v = f2bf(w - bf2f(f2bf(w))); }
            Wi[(size_t)(3840 + r) * 1024 + k] = v; }
        for (int c = bid * NTHREADS + tid; c < 4096; c += G * NTHREADS) { float v = 0.f;
            if (c < 2048) v = b_in[c]; else if (c < 3328) v = b_in[c + 8]; else if (c < 3840) v = b_in[c + 32]; else if (c < 3872) v = b_in[small_src_col(c - 3840)];
            biasP[c] = v; }
        for (int m = gw; m < M; m += NGW) rms_row_wave(x + (size_t)m * D, g_mix, U + (size_t)m * D, lane);
        for (int m = gw; m < 1024; m += NGW) rms_row_wave(mem + (size_t)m * D, g_mem, MEMN + (size_t)m * D, lane);
    }
    SEAM(0);
    PHASE(1) {
        { pg8::Gemm g{U, Wi, M, 4096, D}; pg8::StaticOrder S; S.init(M, 4096, G, bid);
          pg8::EpiStore<0> E{P, biasP, S32, PW, 15};
          pg8::gemm_phase<pg8::EpiStore<0>, pg8::StaticOrder, true, true>(lds3, g, S, E); }
    }
    SEAM(1);
    PHASE(2) { for (int tl_ = bid; tl_ < 256; tl_ += G) xa::memkv_tile(MEMN, Wmkv, MEMKV, tl_);
               for (int ci = bid; ci < 1024; ci += G) ml::m1_unit((NLAS char*)lds_raw, P, ml_conv, S32, Abuf, NA, Gc, Mloc, ci);
               for (int u = bid; u < 256; u += G) cmpr::unit((NLAS char*)lds_raw, P, cmp_pe, Wc1, Wc2, KC, VC, u);
    }
    SEAM(2);
    PHASE(3) { unsigned* m2cnt = (unsigned*)ws + 12288;
               ml::m2_items(Abuf, NA, Gc, Mloc, Mprev);
               asm volatile("s_waitcnt vmcnt(0)" ::: "memory"); __syncthreads();
               if (tid == 0) { __builtin_amdgcn_fence(__ATOMIC_RELEASE, "agent"); asm volatile("s_waitcnt vmcnt(0)" ::: "memory"); __hip_atomic_fetch_add(m2cnt, 1u, __ATOMIC_RELAXED, __HIP_MEMORY_SCOPE_AGENT); }
               nsa::phase((NLAS char*)lds_raw, P, S32, KC, VC, Ynsa);
               xa::phase((NLAS char*)lds_raw, P, MEMKV, Yxa);
               if (tid == 0) { unsigned sp = 0; while (__hip_atomic_load(m2cnt, __ATOMIC_RELAXED, __HIP_MEMORY_SCOPE_AGENT) < (unsigned)G) { __builtin_amdgcn_s_sleep(2); if (++sp > (1u << 22)) break; }
                               __builtin_amdgcn_fence(__ATOMIC_ACQUIRE, "agent"); asm volatile("s_waitcnt vmcnt(0)" ::: "memory"); }
               __syncthreads();
               for (int ci = bid; ci < 1024; ci += G) ml::m3_unit((NLAS char*)lds_raw, P, ml_conv, S32, Abuf, NA, Mprev, ml_norm_g, Yml, ci); }
    SEAM(4);
    PHASE(5) { pg8::Gemm g{U, Wg, M, 3072, D}; pg8::StaticOrder S; S.init(M, 3072, G, bid);
               pg8::EpiStore<1> E{GATES, b_in + C_MG, nullptr, 3072, -1};
               pg8::gemm_phase<pg8::EpiStore<1>, pg8::StaticOrder, true, true>(lds3, g, S, E); }
    SEAM(5);
    PHASE(6) { pg8::Gemm g{Yml, Wbr, M, 1024, 512}; pg8::MergeOrder S; S.so.init(M, 1024, G, bid); S.sa = (size_t)M * 512 * 2; S.sb = (size_t)1024 * 512 * 2;
               pg8::EpiMergeG E{GATES, (bf16_t*)out, MERGED};
               pg8::gemm_phase<pg8::EpiMergeG, pg8::MergeOrder, true, true>(lds3, g, S, E); }
    SEAM(6);
    PHASE(7) { pg8::Gemm g{MERGED, Wo, M, 1024, D}; pg8::StaticOrder S; S.init(M, 1024, G, bid);
               pg8::EpiResRms E{x, out, nullptr, AFFN, g_ffn, (float*)(ws + WS_XCH), (unsigned*)ws + 4096};
               pg8::gemm_phase<pg8::EpiResRms, pg8::StaticOrder, false, true>(lds3, g, S, E); }
    SEAM(7);
    PHASE(9) { pg8::Gemm g{AFFN, Wf1, M, FF, D}; pg8::StaticOrder S; S.init(M, FF, G, bid);
               pg8::EpiStore<2> E{HBUF, nullptr, nullptr, FF, -1};
               pg8::gemm_phase<pg8::EpiStore<2>, pg8::StaticOrder, true, true>(lds3, g, S, E); }
    SEAM(9);
    PHASE(10) { pg8::Gemm g{HBUF, Wf2, M, 1024, FF}; pg8::StaticOrder S; S.init(M, 1024, G, bid);
                pg8::EpiResRms E{out, nullptr, out, nullptr, g_final, (float*)(ws + WS_XCH + 262144), (unsigned*)ws + 4096 + 4096};
                pg8::gemm_phase<pg8::EpiResRms, pg8::StaticOrder, false, true>(lds3, g, S, E); }
}
constexpr int N_PHASES = 12;
#ifndef MK_PER_PHASE
#define MK_PER_PHASE 0
#endif
extern "C" void kernel_launch(void* const* d_in, const int* in_sizes, int n_in, void* d_out, int out_size, void* d_ws, size_t ws_size, hipStream_t stream) {
    static int grid = 0;
    if (grid == 0) {
        int dev = 0, cus = 0, per_cu = 0;
        (void)hipGetDevice(&dev); (void)hipDeviceGetAttribute(&cus, hipDeviceAttributeMultiprocessorCount, dev);
        (void)hipFuncSetAttribute((const void*)mega, hipFuncAttributeMaxDynamicSharedMemorySize, LDS_BYTES);
        (void)hipOccupancyMaxActiveBlocksPerMultiprocessor(&per_cu, (const void*)mega, NTHREADS, LDS_BYTES);
        if (per_cu < 1) { fprintf(stderr, "occupancy query says %d blocks/CU\n", per_cu); per_cu = 1; }
        grid = cus * 1;
        (void)hipGetLastError();
    }
    (void)hipMemsetAsync(d_ws, 0, 65536, stream);
    Args a{};
    for (int i = 0; i < 18; ++i) a.in[i] = (const float*)d_in[i];
    a.out = (float*)d_out; a.ws = (unsigned char*)d_ws;
#if MK_PER_PHASE
    for (int p = 0; p < N_PHASES; ++p) { a.ph_lo = p; a.ph_hi = p + 1; void* args[] = {&a};
        (void)hipLaunchCooperativeKernel((const void*)mega, dim3(grid), dim3(NTHREADS), args, LDS_BYTES, stream); }
#else
    a.ph_lo = 0; a.ph_hi = N_PHASES; void* args[] = {&a};
    hipError_t e = hipLaunchCooperativeKernel((const void*)mega, dim3(grid), dim3(NTHREADS), args, LDS_BYTES, stream);
    if (e != hipSuccess) fprintf(stderr, "cooperative launch failed: %s (grid %d)\n", hipGetErrorString(e), grid);
#endif
}
```

```cpp
#include <hip/hip_runtime.h>
#include <hip/hip_cooperative_groups.h>
#include <cstdio>
namespace cg = cooperative_groups;
#include <stdint.h>

typedef unsigned short bf16_t;
__device__ __forceinline__ float bf2f(bf16_t v) { return __uint_as_float(((unsigned)v) << 16); }
__device__ __forceinline__ bf16_t f2bf(float f) { unsigned u = __float_as_uint(f); return (bf16_t)((u + 0x7fffu + ((u >> 16) & 1u)) >> 16); }

constexpr int NB = 4, T = 4096, M = NB * T, D = 1024, DIN = 6944, FF = 4096;
constexpr float EPS = 1e-6f;
constexpr int C_MLI = 2048, C_NSG = 3336, C_MG = 3872;
constexpr int P_MLQ = 0, P_MLK = 512, P_MLV = 1024, P_MLO = 1536, P_NSQ = 2048, P_KC = 2560, P_VC = 2688, P_KS = 2816, P_VS = 2944, P_KW = 3072, P_VW = 3200, P_XAQ = 3328, PW = 3840;
constexpr size_t MiB = 1u << 20;
constexpr size_t WS_U = 40 * MiB;
constexpr size_t WS_P = 72 * MiB;
constexpr size_t WS_Y = 200 * MiB;
constexpr size_t WS_S32 = 248 * MiB;
constexpr size_t WS_MEMKV = 250 * MiB;
constexpr size_t WS_KC = 252 * MiB;
constexpr size_t WS_VC = 252 * MiB + 512 * 1024;
constexpr size_t WS_NA = 253 * MiB;
constexpr size_t WS_G = 253 * MiB + 512 * 1024;
constexpr size_t WS_MLOC = 253 * MiB + 512 * 1024 + 4096;
constexpr size_t WS_MPREV = 253 * MiB + 512 * 1024 + 8192;

__device__ __forceinline__ float wave_sum(float v) {
#pragma unroll
    for (int o = 1; o < 64; o <<= 1) v += __shfl_xor(v, o);
    return v;
}
__device__ __forceinline__ float wave_max(float v) {
#pragma unroll
    for (int o = 1; o < 64; o <<= 1) v = fmaxf(v, __shfl_xor(v, o));
    return v;
}

__device__ __forceinline__ float logsig(float x) { return fminf(x, 0.f) - log1pf(__expf(-fabsf(x))); }
namespace pg8 {
#define PG8_LAS __attribute__((address_space(3)))
typedef unsigned short bf16_t;
typedef short bf16x8 __attribute__((ext_vector_type(8)));
typedef float f32x4 __attribute__((ext_vector_type(4)));
typedef unsigned u32x4 __attribute__((ext_vector_type(4)));
constexpr int BM = 256, BK = 64, HALF = 128, HTB = HALF * BK * 2  , STAGE_BYTES = 8 * HTB, NXCD = 8, WGM = 8;

__host__ __device__ __forceinline__ int lds_byte(int r, int c) { const int st = (r >> 4) * 2 + (c >> 5), rr = r & 15, cc = c & 31, ob = rr * 64 + cc * 2; return st * 1024 + (ob ^ (((ob >> 9) & 1) << 5)); }
__host__ __device__ __forceinline__ void stage_rc(int b, int& R, int& C) { const int st = b / 1024, sb = b % 1024, swz = sb ^ (((sb >> 9) & 1) << 5); R = (st >> 1) * 16 + swz / 64; C = (st & 1) * 32 + (swz % 64) / 2; }
__host__ __device__ __forceinline__ int perm32(int rho) { const int n = rho >> 4, i = rho & 15; return 8 * (i >> 2) + 4 * n + (i & 3); }

struct Unit { int pm, pn, j; };
struct Gemm { const bf16_t* A; const bf16_t* Bt; int M, N, K; };

struct StaticOrder {
    int nM, nN, nwg, G, c;
    __host__ __device__ void init(int M, int N, int G_, int c_) { nM = M / BM; nN = N / BM; nwg = nM * nN; G = G_; c = c_; }
    __host__ __device__ bool next(int i, Unit& u) const {
        const long L = (long)i * G + c; if (L >= nwg) return false;
        int wgid = (int)L; { const int q = nwg / NXCD, r = nwg % NXCD, xcd = wgid % NXCD, off = wgid / NXCD; wgid = (xcd < r ? xcd * (q + 1) : r * (q + 1) + (xcd - r) * q) + off; }
        const int nig = WGM * nN, gid = wgid / nig, fm = gid * WGM, gsz = (nM - fm) < WGM ? (nM - fm) : WGM;
        u.pm = fm + ((wgid % nig) % gsz); u.pn = (wgid % nig) / gsz; u.j = 0; return true;
    }
    __device__ __forceinline__ const char* pa(const Gemm& g, const Unit& u, size_t tstep) const { return (const char*)g.A + (size_t)u.pm * tstep; }
    __device__ __forceinline__ const char* pb(const Gemm& g, const Unit& u, size_t tstep) const { return (const char*)g.Bt + (size_t)u.pn * tstep; }
    __device__ __forceinline__ void a_ready(const Unit&) const {}
    __device__ __forceinline__ void done(const Unit&) const {}
};

struct MergeOrder {
    StaticOrder so; size_t sa, sb;
    __device__ __forceinline__ bool next(int i, Unit& u) const { if (i >= 3) return false; const bool ok = so.next(0, u); u.j = i; return ok; }
    __device__ __forceinline__ const char* pa(const Gemm& g, const Unit& u, size_t tstep) const { return (const char*)g.A + (size_t)u.j * sa + (size_t)u.pm * tstep; }
    __device__ __forceinline__ const char* pb(const Gemm& g, const Unit& u, size_t tstep) const { return (const char*)g.Bt + (size_t)u.j * sb + (size_t)u.pn * tstep; }
    __device__ __forceinline__ void a_ready(const Unit&) const {}
    __device__ __forceinline__ void done(const Unit&) const {}
};
typedef float f32x2_t __attribute__((ext_vector_type(2))); typedef __bf16 bf16x2_t __attribute__((ext_vector_type(2)));
__device__ __forceinline__ unsigned cvt_pk_bf16(float lo, float hi) { f32x2_t v = {lo, hi}; bf16x2_t b = __builtin_convertvector(v, bf16x2_t); return __builtin_bit_cast(unsigned, b); }
typedef float f32x2 __attribute__((ext_vector_type(2)));

typedef unsigned u32x2 __attribute__((ext_vector_type(2)));
__device__ __forceinline__ float bflo(unsigned w) { return __uint_as_float(w << 16); }
__device__ __forceinline__ float bfhi(unsigned w) { return __uint_as_float(w & 0xffff0000u); }
template <int ACT> __device__ __forceinline__ f32x4 act4(f32x4 v) {
    if (ACT == 1) { f32x4 o; for (int e = 0; e < 4; ++e) o[e] = __builtin_amdgcn_rcpf(1.f + __expf(-v[e])); return o; }
    if (ACT == 2) { f32x4 o; for (int e = 0; e < 4; ++e) { const float r = fmaxf(v[e], 0.f); o[e] = r * r; } return o; }
    return v;
}
template <int ACT> struct EpiStore {
    static constexpr bool PERM = true, AFTER_DRAIN = false;
    bf16_t* O; const float* bias; float* S32; int ldc, small_pn;
    __device__ __forceinline__ void operator()(const f32x4 (&acc)[2][2][4][2], const Unit& u, int wr, int wc, int fr, int fq) const {
        asm volatile("s_waitcnt vmcnt(0)" ::: "memory");
        const int row0 = u.pm * BM + wr * 64 + fr, col0 = u.pn * BM + wc * 32 + 8 * fq;
        if (u.pn == small_pn) {
            if (wc == 0) {
                const f32x4 b0 = *(const f32x4*)(bias + col0), b1 = *(const f32x4*)(bias + col0 + 4);
#pragma unroll
                for (int ai = 0; ai < 2; ++ai)
#pragma unroll
                    for (int m = 0; m < 4; ++m) { float* rp = S32 + (size_t)(row0 + ai * HALF + m * 16) * 32 + 8 * fq;
                        *(f32x4*)rp = acc[ai][0][m][0] + acc[ai][1][m][0] + b0; *(f32x4*)(rp + 4) = acc[ai][0][m][1] + acc[ai][1][m][1] + b1; }
            }
            return;
        }
        f32x4 bv[2][2];
#pragma unroll
        for (int bj = 0; bj < 2; ++bj)
#pragma unroll
            for (int n = 0; n < 2; ++n) bv[bj][n] = bias ? *(const f32x4*)(bias + col0 + bj * HALF + 4 * n) : (f32x4){0.f, 0.f, 0.f, 0.f};
#pragma unroll
        for (int ai = 0; ai < 2; ++ai)
#pragma unroll
            for (int m = 0; m < 4; ++m) { bf16_t* rowp = O + (size_t)(row0 + ai * HALF + m * 16) * ldc + col0;
#pragma unroll
                for (int bj = 0; bj < 2; ++bj) { const f32x4 v0 = act4<ACT>(acc[ai][bj][m][0] + bv[bj][0]), v1 = act4<ACT>(acc[ai][bj][m][1] + bv[bj][1]);
                    u32x4 w; w.x = cvt_pk_bf16(v0[0], v0[1]); w.y = cvt_pk_bf16(v0[2], v0[3]); w.z = cvt_pk_bf16(v1[0], v1[1]); w.w = cvt_pk_bf16(v1[2], v1[3]);
                    *(u32x4*)(rowp + bj * HALF) = w; } }
    }
};
struct EpiMergeG {
    static constexpr bool PERM = true, AFTER_DRAIN = false;
    const bf16_t* G; bf16_t* Mp; bf16_t* Mb;
    __device__ __forceinline__ void operator()(const f32x4 (&acc)[2][2][4][2], const Unit& u, int wr, int wc, int fr, int fq) const {
        const int j = u.j;
        asm volatile("s_waitcnt vmcnt(0)" ::: "memory");
        const int row0 = u.pm * BM + wr * 64 + fr, col0 = u.pn * BM + wc * 32 + 8 * fq;
        bf16_t* dst = (j < 2) ? Mp : Mb; constexpr size_t mpitch = 2048;
#pragma unroll
        for (int ai = 0; ai < 2; ++ai)
#pragma unroll
            for (int m = 0; m < 4; ++m) { const size_t row = (size_t)(row0 + ai * HALF + m * 16);
#pragma unroll
                for (int bj = 0; bj < 2; ++bj) { const int col = col0 + bj * HALF;
                    const u32x4 gw = *(const u32x4*)(G + row * 4096 + j * 1024 + col);
                    f32x4 v0 = (f32x4){bflo(gw.x), bfhi(gw.x), bflo(gw.y), bfhi(gw.y)} * acc[ai][bj][m][0], v1 = (f32x4){bflo(gw.z), bfhi(gw.z), bflo(gw.w), bfhi(gw.w)} * acc[ai][bj][m][1];
                    if (j > 0) { const u32x4 pw = *(const u32x4*)(Mp + row * mpitch + col); v0 += (f32x4){bflo(pw.x), bfhi(pw.x), bflo(pw.y), bfhi(pw.y)}; v1 += (f32x4){bflo(pw.z), bfhi(pw.z), bflo(pw.w), bfhi(pw.w)}; }
                    u32x4 w; w.x = cvt_pk_bf16(v0[0], v0[1]); w.y = cvt_pk_bf16(v0[2], v0[3]); w.z = cvt_pk_bf16(v1[0], v1[1]); w.w = cvt_pk_bf16(v1[2], v1[3]); *(u32x4*)(dst + row * ((j < 2) ? mpitch : (size_t)1024) + col) = w; } }
    }
};
struct EpiResidF {
    static constexpr bool PERM = true, AFTER_DRAIN = false;
    const float* X; float* O;
    __device__ __forceinline__ void operator()(const f32x4 (&acc)[2][2][4][2], const Unit& u, int wr, int wc, int fr, int fq) const {
        asm volatile("s_waitcnt vmcnt(0)" ::: "memory");
        const int row0 = u.pm * BM + wr * 64 + fr, col0 = u.pn * BM + wc * 32 + 8 * fq;
#pragma unroll
        for (int ai = 0; ai < 2; ++ai)
#pragma unroll
            for (int m = 0; m < 4; ++m) { const size_t off = (size_t)(row0 + ai * HALF + m * 16) * 1024 + col0;
#pragma unroll
                for (int bj = 0; bj < 2; ++bj) { const f32x4 x0 = *(const f32x4*)(X + off + bj * HALF), x1 = *(const f32x4*)(X + off + bj * HALF + 4);
                    *(f32x4*)(O + off + bj * HALF) = x0 + acc[ai][bj][m][0]; *(f32x4*)(O + off + bj * HALF + 4) = x1 + acc[ai][bj][m][1]; } }
    }
};
struct EpiResRms {
    static constexpr bool PERM = false, AFTER_DRAIN = true;
    const float* R; float* Hout; float* Nf; bf16_t* Nb; const float* gain; float* xbuf; unsigned* cnt;
    __device__ __forceinline__ void fused(f32x4 (&acc)[2][2][4][2], const Unit& u, int wr, int wc, int fr, int fq, PG8_LAS unsigned char* lds, int wid, int lane) const {
        PG8_LAS float* Pp = (PG8_LAS float*)lds; PG8_LAS float* S = (PG8_LAS float*)(lds + 4096);
        const int col0 = u.pn * BM + wc * 32 + 4 * fq;
#pragma unroll
        for (int ai = 0; ai < 2; ++ai)
#pragma unroll
            for (int m = 0; m < 4; ++m) { const size_t off = (size_t)(u.pm * BM + ai * HALF + wr * 64 + m * 16 + fr) * 1024 + col0; float sq = 0.f;
#pragma unroll
                for (int bj = 0; bj < 2; ++bj)
#pragma unroll
                    for (int n = 0; n < 2; ++n) { const f32x4 v = acc[ai][bj][m][n] + *(const f32x4*)(R + off + bj * HALF + n * 16); acc[ai][bj][m][n] = v; sq += (v[0] * v[0] + v[1] * v[1]) + (v[2] * v[2] + v[3] * v[3]); }
                sq += __shfl_xor(sq, 16); sq += __shfl_xor(sq, 32);
                if (fq == 0) Pp[(ai * HALF + wr * 64 + m * 16 + fr) * 4 + wc] = sq; }
        asm volatile("s_waitcnt lgkmcnt(0)" ::: "memory"); __builtin_amdgcn_s_barrier(); asm volatile("" ::: "memory");
        const int row = wid * 32 + (lane & 31);
        if (lane < 32) { const float tot = (Pp[row * 4 + 0] + Pp[row * 4 + 1]) + (Pp[row * 4 + 2] + Pp[row * 4 + 3]);
            __hip_atomic_store(xbuf + ((size_t)(u.pm * BM + row) * 4 + u.pn), tot, __ATOMIC_RELAXED, __HIP_MEMORY_SCOPE_AGENT); }
        asm volatile("s_waitcnt vmcnt(0)" ::: "memory");
        if (lane == 0) __hip_atomic_fetch_add(cnt + 64 * u.pm, 1u, __ATOMIC_RELAXED, __HIP_MEMORY_SCOPE_AGENT);
        if (wid == 0) { unsigned sp = 0;
            while ((unsigned)__builtin_amdgcn_readfirstlane(__hip_atomic_load(cnt + 64 * u.pm, __ATOMIC_RELAXED, __HIP_MEMORY_SCOPE_AGENT)) < 32u) { __builtin_amdgcn_s_sleep(2); if (++sp > (1u << 22)) break; }
            __builtin_amdgcn_fence(__ATOMIC_ACQUIRE, "agent"); }
        asm volatile("s_waitcnt vmcnt(0) lgkmcnt(0)" ::: "memory"); __builtin_amdgcn_s_barrier(); asm volatile("" ::: "memory");
        if (lane < 32) { const float* slot = xbuf + (size_t)(u.pm * BM + row) * 4; float t = 0.f;
#pragma unroll
            for (int q = 0; q < 4; ++q) t += __hip_atomic_load(slot + q, __ATOMIC_RELAXED, __HIP_MEMORY_SCOPE_AGENT);
            S[row] = rsqrtf(t * (1.0f / 1024.0f) + 1e-6f); }
        asm volatile("s_waitcnt lgkmcnt(0)" ::: "memory"); __builtin_amdgcn_s_barrier(); asm volatile("" ::: "memory");
        f32x4 gv[2][2];
#pragma unroll
        for (int bj = 0; bj < 2; ++bj)
#pragma unroll
            for (int n = 0; n < 2; ++n) gv[bj][n] = *(const f32x4*)(gain + col0 + bj * HALF + n * 16);
#pragma unroll
        for (int ai = 0; ai < 2; ++ai)
#pragma unroll
            for (int m = 0; m < 4; ++m) { const int r = ai * HALF + wr * 64 + m * 16 + fr; const float rs = S[r]; const size_t off = (size_t)(u.pm * BM + r) * 1024 + col0;
#pragma unroll
                for (int bj = 0; bj < 2; ++bj)
#pragma unroll
                    for (int n = 0; n < 2; ++n) { const f32x4 v = acc[ai][bj][m][n]; const f32x4 o = v * rs * gv[bj][n];
                        if (Hout) *(f32x4*)(Hout + off + bj * HALF + n * 16) = v;
                        if (Nf) *(f32x4*)(Nf + off + bj * HALF + n * 16) = o;
                        if (Nb) { u32x2 w; w.x = cvt_pk_bf16(o[0], o[1]); w.y = cvt_pk_bf16(o[2], o[3]); *(u32x2*)(Nb + off + bj * HALF + n * 16) = w; } } }
    }
};

template <class Epi, class Sched, bool ALIGN_EPI = false, bool SP2 = false>
__device__ __forceinline__ void gemm_phase(PG8_LAS unsigned char* lds, const Gemm g, const Sched& S, const Epi& E) {
    const int tid = threadIdx.x, wid = __builtin_amdgcn_readfirstlane(tid >> 6), lane = tid & 63, wr = wid >> 2, wc = wid & 3, fr = lane & 15, fq = lane >> 4;
    const int K = g.K, nt = K / BK;
    unsigned voffA[2], voffB[2];
#pragma unroll
    for (int i = 0; i < 2; ++i) { int R, C; stage_rc(tid * 16 + i * 8192, R, C); const int Rb = Epi::PERM ? ((R & ~31) + perm32(R & 31)) : R;
        voffA[i] = (unsigned)(R * K + C) * 2u; voffB[i] = (unsigned)(Rb * K + C) * 2u; }
    const size_t kstep = (size_t)(BK * 2);
    const size_t hstep = (size_t)HALF * K * 2;
    const size_t tstep = 2 * hstep;
    const unsigned ldsw = (unsigned)wid * 1024u;
    const int aoff = lds_byte(wr * 64 + fr, fq * 8), boff = lds_byte(wc * 32 + fr, fq * 8);
#define PG8_SA(b, h) (((b) * 2 + (h)) * HTB)
#define PG8_SB(b, h) ((4 + (b) * 2 + (h)) * HTB)
#define PG8_STAGE(bufoff, gbase, voff) do { _Pragma("unroll") for (int _i = 0; _i < 2; ++_i) \
        __builtin_amdgcn_global_load_lds((const unsigned*)((const char*)(gbase) + (voff)[_i]), (PG8_LAS unsigned*)(lds + (bufoff) + ldsw + _i * 8192), 16, 0, 0); } while (0)
#define PG8_LDA(dst, b, h) do { _Pragma("unroll") for (int m = 0; m < 4; ++m) _Pragma("unroll") for (int k = 0; k < 2; ++k) dst[m][k] = *(const PG8_LAS bf16x8*)(lds + PG8_SA(b, h) + aoff + m * 2048 + k * 1024); } while (0)
#define PG8_LDB(dst, b, h) do { _Pragma("unroll") for (int n = 0; n < 2; ++n) _Pragma("unroll") for (int k = 0; k < 2; ++k) dst[n][k] = *(const PG8_LAS bf16x8*)(lds + PG8_SB(b, h) + boff + n * 2048 + k * 1024); } while (0)
#define PG8_MMA(ai, bj, At, Bt) do { __builtin_amdgcn_s_setprio(1); _Pragma("unroll") for (int m = 0; m < 4; ++m) _Pragma("unroll") for (int n = 0; n < 2; ++n) _Pragma("unroll") for (int k = 0; k < 2; ++k) \
        acc[ai][bj][m][n] = __builtin_amdgcn_mfma_f32_16x16x32_bf16(Bt[n][k], At[m][k], acc[ai][bj][m][n], 0, 0, 0); __builtin_amdgcn_s_setprio(0); } while (0)
#define PG8_WAIT_V(n) asm volatile("s_waitcnt vmcnt(" #n ")" ::: "memory")
#define PG8_WAIT_L(n) asm volatile("s_waitcnt lgkmcnt(" #n ")" ::: "memory")
#define PG8_BAR __builtin_amdgcn_s_barrier()
#define PG8_SCHED __builtin_amdgcn_sched_barrier(0)
    Unit cur, nxt; int ui = 0;
    if (!S.next(0, cur)) return;
    f32x4 acc[2][2][4][2];
#pragma unroll
    for (int a = 0; a < 2; ++a)
#pragma unroll
        for (int b = 0; b < 2; ++b)
#pragma unroll
            for (int m = 0; m < 4; ++m)
#pragma unroll
                for (int n = 0; n < 2; ++n) acc[a][b][m][n] = (f32x4){0.f, 0.f, 0.f, 0.f};
    bf16x8 At[4][2], B0[2][2], B1[2][2];
    const char* cA = S.pa(g, cur, tstep); const char* cB = S.pb(g, cur, tstep);
    S.a_ready(cur);
    if constexpr (SP2) {
        PG8_STAGE(PG8_SB(0, 0), cB, voffB); PG8_STAGE(PG8_SB(0, 1), cB + hstep, voffB); PG8_STAGE(PG8_SA(0, 0), cA, voffA); PG8_STAGE(PG8_SA(0, 1), cA + hstep, voffA);
        if (wr == 1) PG8_BAR;
        PG8_WAIT_V(2); PG8_BAR;
        PG8_STAGE(PG8_SB(1, 0), cB + kstep, voffB); PG8_STAGE(PG8_SA(1, 0), cA + kstep, voffA); PG8_STAGE(PG8_SB(1, 1), cB + hstep + kstep, voffB);
        PG8_WAIT_V(6); PG8_BAR;
    } else {
        PG8_STAGE(PG8_SB(0, 0), cB, voffB); PG8_STAGE(PG8_SA(0, 0), cA, voffA); PG8_STAGE(PG8_SB(0, 1), cB + hstep, voffB); PG8_STAGE(PG8_SA(0, 1), cA + hstep, voffA);
        if (wr == 1) PG8_BAR;
        PG8_WAIT_V(4); PG8_BAR;
        PG8_STAGE(PG8_SB(1, 0), cB + kstep, voffB); PG8_STAGE(PG8_SA(1, 0), cA + kstep, voffA); PG8_STAGE(PG8_SB(1, 1), cB + hstep + kstep, voffB);
        PG8_WAIT_V(6); PG8_BAR;
    }
    for (;;) {
        const bool has_next = S.next(ui + 1, nxt);
        const char* nA = has_next ? S.pa(g, nxt, tstep) : cA; const char* nB = has_next ? S.pb(g, nxt, tstep) : cB;
        for (int t = 0; t < nt; t += 2) {
            const bool last = (t == nt - 2);
            const char* a1 = cA + (size_t)(t + 1) * kstep;
            const char* a2 = last ? nA : cA + (size_t)(t + 2) * kstep; const char* b2 = last ? nB : cB + (size_t)(t + 2) * kstep;
            const char* a3 = a2 + kstep; const char* b3 = b2 + kstep;
            if (last && has_next) S.a_ready(nxt);
            if constexpr (SP2) {
            PG8_LDB(B0, 0, 0); PG8_LDB(B1, 0, 1); PG8_SCHED; PG8_LDA(At, 0, 0); PG8_STAGE(PG8_SA(1, 1), a1 + hstep, voffA);
            PG8_WAIT_V(8); PG8_WAIT_L(0); PG8_BAR; PG8_MMA(0, 0, At, B0); PG8_MMA(0, 1, At, B1); PG8_BAR; PG8_SCHED;
            PG8_LDA(At, 0, 1); PG8_STAGE(PG8_SB(0, 0), b2, voffB); PG8_STAGE(PG8_SB(0, 1), b2 + hstep, voffB); PG8_STAGE(PG8_SA(0, 0), a2, voffA);
            PG8_WAIT_V(8); PG8_WAIT_L(0); PG8_BAR; PG8_MMA(1, 0, At, B0); PG8_MMA(1, 1, At, B1); PG8_BAR; PG8_SCHED;
            PG8_LDB(B0, 1, 0); PG8_LDB(B1, 1, 1); PG8_SCHED; PG8_LDA(At, 1, 0); PG8_STAGE(PG8_SA(0, 1), a2 + hstep, voffA);
            PG8_WAIT_V(8); PG8_WAIT_L(0); PG8_BAR; PG8_MMA(0, 0, At, B0); PG8_MMA(0, 1, At, B1); PG8_BAR; PG8_SCHED;
            PG8_LDA(At, 1, 1); PG8_STAGE(PG8_SB(1, 0), b3, voffB); PG8_STAGE(PG8_SB(1, 1), b3 + hstep, voffB); PG8_STAGE(PG8_SA(1, 0), a3, voffA);
            PG8_WAIT_V(8); PG8_WAIT_L(0); PG8_BAR; PG8_MMA(1, 0, At, B0); PG8_MMA(1, 1, At, B1); PG8_BAR; PG8_SCHED;
            } else {
            PG8_LDB(B0, 0, 0); PG8_SCHED; PG8_LDA(At, 0, 0); PG8_STAGE(PG8_SA(1, 1), a1 + hstep, voffA);
            PG8_WAIT_L(8); PG8_BAR; PG8_WAIT_L(0); PG8_MMA(0, 0, At, B0); PG8_BAR; PG8_SCHED;
            PG8_LDB(B1, 0, 1); PG8_STAGE(PG8_SB(0, 0), b2, voffB);
            PG8_BAR; PG8_WAIT_L(0); PG8_MMA(0, 1, At, B1); PG8_BAR;
            PG8_LDA(At, 0, 1); PG8_STAGE(PG8_SA(0, 0), a2, voffA);
            PG8_BAR; PG8_WAIT_L(0); PG8_MMA(1, 0, At, B0); PG8_BAR; PG8_SCHED;
            PG8_STAGE(PG8_SB(0, 1), b2 + hstep, voffB);
            PG8_WAIT_V(6); PG8_BAR; PG8_MMA(1, 1, At, B1); PG8_BAR;
            PG8_LDB(B0, 1, 0); PG8_SCHED; PG8_LDA(At, 1, 0); PG8_STAGE(PG8_SA(0, 1), a2 + hstep, voffA);
            PG8_WAIT_L(8); PG8_BAR; PG8_WAIT_L(0); PG8_MMA(0, 0, At, B0); PG8_BAR; PG8_SCHED;
            PG8_LDB(B1, 1, 1); PG8_STAGE(PG8_SB(1, 0), b3, voffB);
            PG8_BAR; PG8_WAIT_L(0); PG8_MMA(0, 1, At, B1); PG8_BAR;
            PG8_LDA(At, 1, 1); PG8_STAGE(PG8_SA(1, 0), a3, voffA);
            PG8_BAR; PG8_WAIT_L(0); PG8_MMA(1, 0, At, B0); PG8_BAR; PG8_SCHED;
            PG8_STAGE(PG8_SB(1, 1), b3 + hstep, voffB);
            PG8_WAIT_V(6); PG8_BAR; PG8_MMA(1, 1, At, B1); PG8_BAR;
            }
        }
        if constexpr (ALIGN_EPI) { if (wr == 0) PG8_BAR; }
        if constexpr (!Epi::AFTER_DRAIN) { E(acc, cur, wr, wc, fr, fq); S.done(cur); }
        if (!has_next) break;
#pragma unroll
        for (int a = 0; a < 2; ++a)
#pragma unroll
            for (int b = 0; b < 2; ++b)
#pragma unroll
                for (int m = 0; m < 4; ++m)
#pragma unroll
                    for (int n = 0; n < 2; ++n) acc[a][b][m][n] = (f32x4){0.f, 0.f, 0.f, 0.f};
        cur = nxt; cA = nA; cB = nB; ++ui;
        if constexpr (ALIGN_EPI) { if (wr == 1) PG8_BAR; }
    }
    PG8_WAIT_V(0);
    if constexpr (!ALIGN_EPI) { if (wr == 0) PG8_BAR; }
    PG8_BAR;
    if constexpr (Epi::AFTER_DRAIN) { E.fused(acc, cur, wr, wc, fr, fq, lds, wid, lane); S.done(cur); }
#undef PG8_SA
#undef PG8_SB
#undef PG8_STAGE
#undef PG8_LDA
#undef PG8_LDB
#undef PG8_MMA
#undef PG8_WAIT_V
#undef PG8_WAIT_L
#undef PG8_BAR
#undef PG8_SCHED
}
}

namespace nsa {
#define NLAS __attribute__((address_space(3)))
typedef short bf16x8 __attribute__((ext_vector_type(8)));
typedef short s16x4 __attribute__((ext_vector_type(4)));
typedef short v4i16_t __attribute__((ext_vector_type(4)));
typedef float f32x4 __attribute__((ext_vector_type(4)));
typedef unsigned u32x4 __attribute__((ext_vector_type(4)));
typedef unsigned u32x2 __attribute__((ext_vector_type(2)));
typedef unsigned long long u64;
constexpr int RS = 144, TILE_B = 64 * RS;
constexpr float LOG2E = 1.4426950408889634f;
constexpr int L_KB0 = 0, L_VB0 = TILE_B, L_KB1 = 2 * TILE_B, L_VB1 = 3 * TILE_B, L_CK = 4 * TILE_B, L_CV = 8 * TILE_B, L_IMP = 12 * TILE_B, L_MSK = L_IMP + 8192, L_WU = L_MSK + 256, L_END = L_WU + 64;
static_assert(L_END <= 131072, "nsa LDS map");
__device__ __forceinline__ s16x4 vtr(const NLAS char* p) { return __builtin_bit_cast(s16x4, __builtin_amdgcn_ds_read_tr16_b64_v4i16((NLAS v4i16_t*)p)); }
__device__ __forceinline__ f32x4 mfma16(bf16x8 a, bf16x8 b, f32x4 c) { return __builtin_amdgcn_mfma_f32_16x16x32_bf16(a, b, c, 0, 0, 0); }
__device__ __forceinline__ unsigned pkbf(float lo, float hi) { return pg8::cvt_pk_bf16(lo, hi); }
__device__ __forceinline__ void qk_tile(f32x4 (&s)[4], const NLAS char* Kb, const bf16x8 (&qf)[2], int i, int g, float kslope, float bt) {
    bf16x8 a[4][2]; const NLAS char* kp = Kb + i * RS + 16 * g;
#pragma unroll
    for (int kb = 0; kb < 4; ++kb) { a[kb][0] = *(const NLAS bf16x8*)(kp + kb * 16 * RS); a[kb][1] = *(const NLAS bf16x8*)(kp + kb * 16 * RS + 64); }
#pragma unroll
    for (int kb = 0; kb < 4; ++kb) { f32x4 ci; ci[0] = fmaf(kslope, (float)(kb * 16 + 0), bt); ci[1] = fmaf(kslope, (float)(kb * 16 + 1), bt); ci[2] = fmaf(kslope, (float)(kb * 16 + 2), bt); ci[3] = fmaf(kslope, (float)(kb * 16 + 3), bt);
        s[kb] = mfma16(a[kb][0], qf[0], ci); }
#pragma unroll
    for (int kb = 0; kb < 4; ++kb) s[kb] = mfma16(a[kb][1], qf[1], s[kb]);
}
__device__ __forceinline__ void pv_tile(f32x4 (&o)[4], const NLAS char* Vb, const f32x4 (&p)[4], int i, int g) {
    const NLAS char* vb = Vb + (4 * g + (i >> 2)) * RS + (i & 3) * 8;
    s16x4 lo[2][4], hi[2][4];
#pragma unroll
    for (int kk = 0; kk < 2; ++kk)
#pragma unroll
        for (int db = 0; db < 4; ++db) { const NLAS char* vp = vb + (2 * kk) * 16 * RS + db * 32; lo[kk][db] = vtr(vp); hi[kk][db] = vtr(vp + 16 * RS); }
    bf16x8 pf[2];
#pragma unroll
    for (int kk = 0; kk < 2; ++kk) { u32x4 pw; pw.x = pkbf(p[2 * kk][0], p[2 * kk][1]); pw.y = pkbf(p[2 * kk][2], p[2 * kk][3]); pw.z = pkbf(p[2 * kk + 1][0], p[2 * kk + 1][1]); pw.w = pkbf(p[2 * kk + 1][2], p[2 * kk + 1][3]);
        pf[kk] = __builtin_bit_cast(bf16x8, pw); }
#pragma unroll
    for (int kk = 0; kk < 2; ++kk)
#pragma unroll
        for (int db = 0; db < 4; ++db) o[db] = mfma16((bf16x8){lo[kk][db][0], lo[kk][db][1], lo[kk][db][2], lo[kk][db][3], hi[kk][db][0], hi[kk][db][1], hi[kk][db][2], hi[kk][db][3]}, pf[kk], o[db]);
}
constexpr float THR = 6.0f;
template <bool FIRST>
__device__ __forceinline__ float online_tile(f32x4 (&s)[4], float& m, float& l, f32x4 (&o)[4], bool needmask, int base, int lo, int hi) {
    float fret = 1.f;
    if (needmask) {
#pragma unroll
        for (int kb = 0; kb < 4; ++kb)
#pragma unroll
            for (int r = 0; r < 4; ++r) { const int pos = base + kb * 16 + r; s[kb][r] = (pos >= lo && pos <= hi) ? s[kb][r] : -INFINITY; } }
    float mt = fmaxf(fmaxf(fmaxf(s[0][0], s[0][1]), fmaxf(s[0][2], s[0][3])), fmaxf(fmaxf(s[1][0], s[1][1]), fmaxf(s[1][2], s[1][3])));
    mt = fmaxf(mt, fmaxf(fmaxf(fmaxf(s[2][0], s[2][1]), fmaxf(s[2][2], s[2][3])), fmaxf(fmaxf(s[3][0], s[3][1]), fmaxf(s[3][2], s[3][3]))));
    if (FIRST || __any(mt > THR)) {
        mt = fmaxf(mt, __shfl_xor(mt, 16)); mt = fmaxf(mt, __shfl_xor(mt, 32));
        const float d = FIRST ? ((mt == -INFINITY) ? 0.f : mt) : fmaxf(mt, 0.f), f = __builtin_amdgcn_exp2f(-d); m += d; l *= f; fret = f;
#pragma unroll
        for (int db = 0; db < 4; ++db) o[db] = o[db] * f;
#pragma unroll
        for (int kb = 0; kb < 4; ++kb) s[kb] = s[kb] - d; }
    float sum = 0.f;
#pragma unroll
    for (int kb = 0; kb < 4; ++kb)
#pragma unroll
        for (int r = 0; r < 4; ++r) { const float p = __builtin_amdgcn_exp2f(s[kb][r]); s[kb][r] = p; sum += p; }
    l += sum;
    return fret;
}
struct Stg { u32x4 k, v; };
__device__ __forceinline__ void stg_load(Stg& r, const bf16_t* kb, const bf16_t* vb, size_t pitch, int tid) { const size_t off = (size_t)(tid >> 3) * pitch + (tid & 7) * 8; r.k = *(const u32x4*)(kb + off); r.v = *(const u32x4*)(vb + off); }
__device__ __forceinline__ void stg_store(NLAS char* lds, int ko, int vo, const Stg& r, int tid) { const int off = (tid >> 3) * RS + (tid & 7) * 16; *(NLAS u32x4*)(lds + ko + off) = r.k; *(NLAS u32x4*)(lds + vo + off) = r.v; }
template <bool FIRST>
__device__ __forceinline__ void pair_tiles(const NLAS char* lds, int koA, int voA, int koB, int voB, bool na, bool nb, const bf16x8 (&qf)[2], int i, int g, float slope2,
                                           float btA, float btB, bool maskA, bool maskB, int baseA, int baseB, int lo, int hi, float& m, float& l, f32x4 (&o)[4]) {
    f32x4 sa[4], sb[4];
    if (na) qk_tile(sa, lds + koA, qf, i, g, slope2, btA - m);
    if (nb) qk_tile(sb, lds + koB, qf, i, g, slope2, btB - m);
    float da = 0.f;
    if (na) { const float m0 = m; online_tile<FIRST>(sa, m, l, o, FIRST || maskA, baseA, lo, hi); da = m - m0; pv_tile(o, lds + voA, sa, i, g); }
    if (nb) { if (__any(da != 0.f)) {
#pragma unroll
            for (int kb = 0; kb < 4; ++kb) sb[kb] = sb[kb] - da; }
        online_tile<false>(sb, m, l, o, maskB, baseB, lo, hi); pv_tile(o, lds + voB, sb, i, g); }
}
__device__ __forceinline__ float sigm(float v) { return __builtin_amdgcn_rcpf(1.f + __expf(-v)); }

__device__ __forceinline__ void unit(NLAS char* lds, const bf16_t* P, const float* S32, const bf16_t* KC, const bf16_t* VC, bf16_t* Ynsa, int b, int gq, int ti) {
    const int tid = threadIdx.x, lane = tid & 63, w = __builtin_amdgcn_readfirstlane(tid >> 6), i = lane & 15, g = lane >> 4;
    const int t0 = ti * 32, tl_mine = i >> 2, r = i & 3, h = gq * 4 + r, t = t0 + 4 * w + tl_mine; const size_t m = (size_t)b * T + t;
    const float slope2 = __builtin_amdgcn_exp2f(-(float)(h + 1)) * LOG2E;
    bf16x8 qf[2]; constexpr float QS = 0.125f * LOG2E;
    { const bf16_t* qp = P + m * PW + P_NSQ + h * 64 + 8 * g;
#pragma unroll
      for (int ks = 0; ks < 2; ++ks) { const u32x4 raw = *(const u32x4*)(qp + 32 * ks); u32x4 sc;
          sc.x = pkbf(pg8::bflo(raw.x) * QS, pg8::bfhi(raw.x) * QS); sc.y = pkbf(pg8::bflo(raw.y) * QS, pg8::bfhi(raw.y) * QS);
          sc.z = pkbf(pg8::bflo(raw.z) * QS, pg8::bfhi(raw.z) * QS); sc.w = pkbf(pg8::bflo(raw.w) * QS, pg8::bfhi(raw.w) * QS);
          qf[ks] = __builtin_bit_cast(bf16x8, sc); } }
    const float* gp = S32 + m * 32 + 8 + h * 3;
    const float gate0 = sigm(gp[0]), gate1 = sigm(gp[1]), gate2 = sigm(gp[2]);
    f32x4 outacc[4];
#pragma unroll
    for (int db = 0; db < 4; ++db) outacc[db] = (f32x4){0.f, 0.f, 0.f, 0.f};
    const int ntc = (ti >> 5) + 1;
    { Stg sc_[4];
#pragma unroll
      for (int tile = 0; tile < 4; ++tile) if (tile < ntc) { const size_t row0 = ((size_t)(b * 256 + tile * 64) * 2 + gq) * 64; stg_load(sc_[tile], KC + row0, VC + row0, 128, tid); }
#pragma unroll
      for (int tile = 0; tile < 4; ++tile) if (tile < ntc) stg_store(lds, L_CK + tile * TILE_B, L_CV + tile * TILE_B, sc_[tile], tid); }
    __syncthreads();
    { const int nmax = (t - 31) >> 4, nmax_w = ((t0 + 4 * w) - 31) >> 4; const float kslope = 16.f * slope2, c = -slope2 * (float)(t - 31);
      float mc = 0.f, lc = 0.f; f32x4 oc[4]; float av[16], cv[16];
#pragma unroll
      for (int db = 0; db < 4; ++db) oc[db] = (f32x4){0.f, 0.f, 0.f, 0.f};
#pragma unroll
      for (int q = 0; q < 16; ++q) { av[q] = 0.f; cv[q] = 0.f; }
      bool firstc = true;
#pragma unroll
      for (int tile = 3; tile >= 0; --tile) {
          if (tile < ntc) { f32x4 s[4]; qk_tile(s, lds + L_CK + tile * TILE_B, qf, i, g, kslope, fmaf(kslope, (float)(tile * 64 + 4 * g), c) - mc);
              const bool needmask = (tile * 64 + 63 > nmax_w);
              const float f = firstc ? online_tile<true>(s, mc, lc, oc, needmask, tile * 64 + 4 * g, -0x40000000, nmax) : online_tile<false>(s, mc, lc, oc, needmask, tile * 64 + 4 * g, -0x40000000, nmax);
              if (!firstc && __any(f != 1.f)) {
#pragma unroll
                  for (int q = 0; q < 16; ++q) { av[q] *= f; cv[q] *= f; } }
              firstc = false;
              pv_tile(oc, lds + L_CV + tile * TILE_B, s, i, g);
#pragma unroll
              for (int kb = 0; kb < 4; ++kb) { const f32x4 pv = s[kb];
                  float a = (pv[0] + pv[1]) + (pv[2] + pv[3]), cc = pv[3];
                  a += __shfl_xor(a, 1); a += __shfl_xor(a, 2); cc += __shfl_xor(cc, 1); cc += __shfl_xor(cc, 2);
                  av[tile * 4 + kb] = a; cv[tile * 4 + kb] = cc; } }
      }
      lc += __shfl_xor(lc, 16); lc += __shfl_xor(lc, 32);
      const float inv = lc > 0.f ? 1.f / lc : 0.f, g0i = gate0 * inv;
#pragma unroll
      for (int db = 0; db < 4; ++db) outacc[db] = outacc[db] + oc[db] * g0i;
      NLAS float* imp_s = (NLAS float*)(lds + L_IMP) + (w * 4 + tl_mine) * 64;
      float cprev = 0.f;
#pragma unroll
      for (int q = 0; q < 16; ++q) { const float up = __shfl(cv[q], (lane + 48) & 63); const float im = (av[q] + (g > 0 ? up : cprev)) * inv; cprev = up; if (r == 0) imp_s[4 * q + g] = im; }
    }
    NLAS float* impw = (NLAS float*)(lds + L_IMP) + w * 256;
    float myscore[4];
    asm volatile("s_waitcnt lgkmcnt(0)" ::: "memory");
#pragma unroll
    for (int tl = 0; tl < 4; ++tl) { const int tt = t0 + 4 * w + tl, cur = tt >> 6, j = lane; const bool valid = j <= cur, forced = (j == 0) || (j == cur) || (j == cur - 1);
        const float s = valid ? impw[tl * 64 + j] + (forced ? 1000.f : 0.f) : -1e30f; myscore[tl] = s; }
    asm volatile("s_waitcnt lgkmcnt(0)" ::: "memory");
#pragma unroll
    for (int tl = 0; tl < 4; ++tl) impw[tl * 64 + lane] = myscore[tl];
    asm volatile("s_waitcnt lgkmcnt(0)" ::: "memory");
    u64 wmask[4], wun = 0ull;
#pragma unroll
    for (int tl = 0; tl < 4; ++tl) { const int tt = t0 + 4 * w + tl, cur = tt >> 6; const float s = myscore[tl]; int rank = 0;
        for (int jj = 0; jj < 64; ++jj) { const float o = impw[tl * 64 + jj]; rank += (o > s || (o == s && jj < lane)) ? 1 : 0; }
        wmask[tl] = __ballot(rank < 16 && lane <= cur); wun |= wmask[tl]; }
    if (lane == 0) { NLAS u64* mk = (NLAS u64*)(lds + L_MSK) + w * 4; mk[0] = wmask[0]; mk[1] = wmask[1]; mk[2] = wmask[2]; mk[3] = wmask[3]; ((NLAS u64*)(lds + L_WU))[w] = wun; }
    __syncthreads();
    const u64 mymask = ((const NLAS u64*)(lds + L_MSK))[w * 4 + tl_mine];
    u64 uall = 0ull;
#pragma unroll
    for (int ww = 0; ww < 8; ++ww) uall |= ((const NLAS u64*)(lds + L_WU))[ww];
    uall = ((u64)__builtin_amdgcn_readfirstlane((unsigned)(uall >> 32)) << 32) | (u64)__builtin_amdgcn_readfirstlane((unsigned)uall);
    const size_t rowb = (size_t)b * T;
    {
        float ms_ = 0.f, ls = 0.f; f32x4 os[4];
#pragma unroll
        for (int db = 0; db < 4; ++db) os[db] = (f32x4){0.f, 0.f, 0.f, 0.f};
        const bf16_t* kcol = P + rowb * PW + P_KS + gq * 64; const bf16_t* vcol = P + rowb * PW + P_VS + gq * 64;
        const float c = -slope2 * (float)t;
        const int jcur = t0 >> 6;
        u64 rem = uall & ((1ull << jcur) - 1ull);
#define NSA_NEXT(dst) { dst = rem ? 63 - __builtin_clzll(rem) : -1; if (dst >= 0) rem &= ~(1ull << dst); }
#define NSA_KO(p, h) ((p) ? L_CK + (h) * TILE_B : ((h) ? L_KB1 : L_KB0))
#define NSA_VO(p, h) ((p) ? L_CV + (h) * TILE_B : ((h) ? L_VB1 : L_VB0))
        int ja = jcur, jb, na_, nb_, cur = 0; bool first = true;
        NSA_NEXT(jb)
        Stg sr0, sr1;
        stg_load(sr0, kcol + (size_t)ja * 64 * PW, vcol + (size_t)ja * 64 * PW, PW, tid); stg_store(lds, L_KB0, L_VB0, sr0, tid);
        if (jb >= 0) { stg_load(sr1, kcol + (size_t)jb * 64 * PW, vcol + (size_t)jb * 64 * PW, PW, tid); stg_store(lds, L_KB1, L_VB1, sr1, tid); }
        NSA_NEXT(na_) NSA_NEXT(nb_)
        if (na_ >= 0) stg_load(sr0, kcol + (size_t)na_ * 64 * PW, vcol + (size_t)na_ * 64 * PW, PW, tid);
        if (nb_ >= 0) stg_load(sr1, kcol + (size_t)nb_ * 64 * PW, vcol + (size_t)nb_ * 64 * PW, PW, tid);
        __syncthreads();
        for (;;) {
            if (na_ >= 0) stg_store(lds, NSA_KO(cur ^ 1, 0), NSA_VO(cur ^ 1, 0), sr0, tid);
            if (nb_ >= 0) stg_store(lds, NSA_KO(cur ^ 1, 1), NSA_VO(cur ^ 1, 1), sr1, tid);
            int nna, nnb; NSA_NEXT(nna) NSA_NEXT(nnb)
            if (nna >= 0) stg_load(sr0, kcol + (size_t)nna * 64 * PW, vcol + (size_t)nna * 64 * PW, PW, tid);
            if (nnb >= 0) stg_load(sr1, kcol + (size_t)nnb * 64 * PW, vcol + (size_t)nnb * 64 * PW, PW, tid);
            const bool na = (wun >> ja) & 1ull, nb = (jb >= 0) && ((wun >> jb) & 1ull);
            if (na || nb) {
                const float btA = fmaf(slope2, (float)(ja * 64 + 4 * g), c) + (((mymask >> ja) & 1ull) ? 0.f : -1e30f);
                const float btB = fmaf(slope2, (float)((jb < 0 ? 0 : jb) * 64 + 4 * g), c) + ((jb >= 0 && ((mymask >> jb) & 1ull)) ? 0.f : -1e30f);
                if (first) pair_tiles<true>(lds, NSA_KO(cur, 0), NSA_VO(cur, 0), NSA_KO(cur, 1), NSA_VO(cur, 1), na, nb, qf, i, g, slope2, btA, btB, true, false, ja * 64 + 4 * g, 0, 0, t, ms_, ls, os);
                else pair_tiles<false>(lds, NSA_KO(cur, 0), NSA_VO(cur, 0), NSA_KO(cur, 1), NSA_VO(cur, 1), na, nb, qf, i, g, slope2, btA, btB, false, false, 0, 0, 0, t, ms_, ls, os); }
            first = false;
            __syncthreads();
            if (na_ < 0) break;
            ja = na_; jb = nb_; na_ = nna; nb_ = nnb; cur ^= 1;
        }
        ls += __shfl_xor(ls, 16); ls += __shfl_xor(ls, 32);
        const float sc1 = gate1 / ls;
#pragma unroll
        for (int db = 0; db < 4; ++db) outacc[db] = outacc[db] + os[db] * sc1;
    }
    {
        float mw = 0.f, lw = 0.f; f32x4 ow[4];
#pragma unroll
        for (int db = 0; db < 4; ++db) ow[db] = (f32x4){0.f, 0.f, 0.f, 0.f};
        const bf16_t* kcol = P + rowb * PW + P_KW + gq * 64; const bf16_t* vcol = P + rowb * PW + P_VW + gq * 64;
        const float c = -slope2 * (float)t;
        const int j0 = (t0 - 511) > 0 ? ((t0 - 511) >> 6) : 0, j1 = t0 >> 6, tw0 = t0 + 4 * w;
        int ja = j1, cur = 0; bool first = true;
        Stg sr0, sr1;
        stg_load(sr0, kcol + (size_t)ja * 64 * PW, vcol + (size_t)ja * 64 * PW, PW, tid); stg_store(lds, L_KB0, L_VB0, sr0, tid);
        if (ja - 1 >= j0) { stg_load(sr1, kcol + (size_t)(ja - 1) * 64 * PW, vcol + (size_t)(ja - 1) * 64 * PW, PW, tid); stg_store(lds, L_KB1, L_VB1, sr1, tid); }
        if (ja - 2 >= j0) stg_load(sr0, kcol + (size_t)(ja - 2) * 64 * PW, vcol + (size_t)(ja - 2) * 64 * PW, PW, tid);
        if (ja - 3 >= j0) stg_load(sr1, kcol + (size_t)(ja - 3) * 64 * PW, vcol + (size_t)(ja - 3) * 64 * PW, PW, tid);
        __syncthreads();
        for (;;) {
            if (ja - 2 >= j0) stg_store(lds, NSA_KO(cur ^ 1, 0), NSA_VO(cur ^ 1, 0), sr0, tid);
            if (ja - 3 >= j0) stg_store(lds, NSA_KO(cur ^ 1, 1), NSA_VO(cur ^ 1, 1), sr1, tid);
            if (ja - 4 >= j0) stg_load(sr0, kcol + (size_t)(ja - 4) * 64 * PW, vcol + (size_t)(ja - 4) * 64 * PW, PW, tid);
            if (ja - 5 >= j0) stg_load(sr1, kcol + (size_t)(ja - 5) * 64 * PW, vcol + (size_t)(ja - 5) * 64 * PW, PW, tid);
            const int jb = ja - 1;
            const bool na = (64 * ja <= tw0 + 3) && (64 * ja + 63 >= tw0 - 511), nb = (jb >= j0) && (64 * jb <= tw0 + 3) && (64 * jb + 63 >= tw0 - 511);
            if (na || nb) {
                const float btA = fmaf(slope2, (float)(ja * 64 + 4 * g), c), btB = fmaf(slope2, (float)(jb * 64 + 4 * g), c);
                const bool maskA = (64 * ja < tw0 + 3 - 511), maskB = (64 * jb < tw0 + 3 - 511);
                if (first) pair_tiles<true>(lds, NSA_KO(cur, 0), NSA_VO(cur, 0), NSA_KO(cur, 1), NSA_VO(cur, 1), na, nb, qf, i, g, slope2, btA, btB, true, maskB, ja * 64 + 4 * g, jb * 64 + 4 * g, t - 511, t, mw, lw, ow);
                else pair_tiles<false>(lds, NSA_KO(cur, 0), NSA_VO(cur, 0), NSA_KO(cur, 1), NSA_VO(cur, 1), na, nb, qf, i, g, slope2, btA, btB, maskA, maskB, ja * 64 + 4 * g, jb * 64 + 4 * g, t - 511, t, mw, lw, ow); }
            first = false;
            __syncthreads();
            if (ja - 2 < j0) break;
            ja -= 2; cur ^= 1;
        }
        lw += __shfl_xor(lw, 16); lw += __shfl_xor(lw, 32);
        const float sc2 = gate2 / lw;
#pragma unroll
        for (int db = 0; db < 4; ++db) outacc[db] = outacc[db] + ow[db] * sc2;
    }
    bf16_t* yo = Ynsa + m * 512 + h * 64 + 4 * g;
#pragma unroll
    for (int db = 0; db < 4; ++db) { u32x2 v; v.x = pkbf(outacc[db][0], outacc[db][1]); v.y = pkbf(outacc[db][2], outacc[db][3]); *(u32x2*)(yo + db * 16) = v; }
}
__device__ __forceinline__ void phase(NLAS char* lds, const bf16_t* P, const float* S32, const bf16_t* KC, const bf16_t* VC, bf16_t* Ynsa) {
    const int G = gridDim.x, bid = blockIdx.x;
    if (G == 256) { const int base = bid >> 3, bg = bid & 7;
#pragma unroll 1
        for (int k = 0; k < 4; ++k) { const int ti = (k == 0) ? 127 - base : (k == 1) ? 64 + base : (k == 2) ? 63 - base : base; unit(lds, P, S32, KC, VC, Ynsa, bg >> 1, bg & 1, ti); } }
    else {
#pragma unroll 1
        for (int u = bid; u < 1024; u += G) unit(lds, P, S32, KC, VC, Ynsa, (u & 7) >> 1, u & 1, 127 - (u >> 3)); }
}
}

namespace xa {
using nsa::bf16x8; using nsa::s16x4; using nsa::f32x4; using nsa::u32x4; using nsa::u32x2; using nsa::vtr; using nsa::mfma16; using nsa::pkbf;
constexpr int RS = 272, TILE_B = 64 * RS;
__device__ __forceinline__ int l_k(int tile) { return tile * 2 * TILE_B; }
__device__ __forceinline__ int l_v(int tile) { return tile * 2 * TILE_B + TILE_B; }
__device__ __forceinline__ void unit(NLAS char* lds, const bf16_t* P, const bf16_t* MEMKV, bf16_t* Yxa, int b, int h, int tt) {
    const int tid = threadIdx.x, lane = tid & 63, w = __builtin_amdgcn_readfirstlane(tid >> 6), i = lane & 15, g = lane >> 4;
    const size_t m = (size_t)b * T + tt * 128 + 16 * w + i;
    const bf16_t* kbase = MEMKV + (size_t)b * 256 * 1024 + h * 128;
    { u32x4 st[4][4]; const bf16_t* p0 = kbase + (size_t)(tid >> 3) * 1024 + (tid & 7) * 8;
#pragma unroll
      for (int tile = 0; tile < 4; ++tile) { const bf16_t* p = p0 + (size_t)tile * 64 * 1024; st[tile][0] = *(const u32x4*)p; st[tile][1] = *(const u32x4*)(p + 64); st[tile][2] = *(const u32x4*)(p + 512); st[tile][3] = *(const u32x4*)(p + 576); }
      const int off = (tid >> 3) * RS + (tid & 7) * 16;
#pragma unroll
      for (int tile = 0; tile < 4; ++tile) { *(NLAS u32x4*)(lds + l_k(tile) + off) = st[tile][0]; *(NLAS u32x4*)(lds + l_k(tile) + off + 128) = st[tile][1]; *(NLAS u32x4*)(lds + l_v(tile) + off) = st[tile][2]; *(NLAS u32x4*)(lds + l_v(tile) + off + 128) = st[tile][3]; } }
    bf16x8 qf[4];
    { const bf16_t* qp = P + m * PW + P_XAQ + h * 128 + 8 * g;
#pragma unroll
      for (int ks = 0; ks < 4; ++ks) qf[ks] = *(const bf16x8*)(qp + 32 * ks); }
    const float scale2 = 0.08838834764831845f * nsa::LOG2E;
    float mx = -INFINITY, l = 0.f; f32x4 o[8];
#pragma unroll
    for (int db = 0; db < 8; ++db) o[db] = (f32x4){0.f, 0.f, 0.f, 0.f};
    __syncthreads();
#pragma unroll 1
    for (int tile = 0; tile < 4; ++tile) {
        const NLAS char* Kb = lds + l_k(tile); const NLAS char* Vb = lds + l_v(tile);
        f32x4 s[4];
        { bf16x8 a[4][4];
#pragma unroll
          for (int kb = 0; kb < 4; ++kb)
#pragma unroll
              for (int ks = 0; ks < 4; ++ks) a[kb][ks] = *(const NLAS bf16x8*)(Kb + (kb * 16 + i) * RS + 16 * g + 64 * ks);
#pragma unroll
          for (int kb = 0; kb < 4; ++kb) s[kb] = mfma16(a[kb][0], qf[0], (f32x4){0.f, 0.f, 0.f, 0.f});
#pragma unroll
          for (int ks = 1; ks < 4; ++ks)
#pragma unroll
              for (int kb = 0; kb < 4; ++kb) s[kb] = mfma16(a[kb][ks], qf[ks], s[kb]); }
        float mt = -INFINITY;
#pragma unroll
        for (int kb = 0; kb < 4; ++kb)
#pragma unroll
            for (int r = 0; r < 4; ++r) { const float v = s[kb][r] * scale2; s[kb][r] = v; mt = fmaxf(mt, v); }
        mt = fmaxf(mt, __shfl_xor(mt, 16)); mt = fmaxf(mt, __shfl_xor(mt, 32));
        const float mn = fmaxf(mx, mt), alpha = __builtin_amdgcn_exp2f(mx - mn); float sum = 0.f;
#pragma unroll
        for (int kb = 0; kb < 4; ++kb)
#pragma unroll
            for (int r = 0; r < 4; ++r) { const float p = __builtin_amdgcn_exp2f(s[kb][r] - mn); s[kb][r] = p; sum += p; }
        l = l * alpha + sum; mx = mn;
#pragma unroll
        for (int db = 0; db < 8; ++db) o[db] = o[db] * alpha;
        const NLAS char* vb = Vb + (4 * g + (i >> 2)) * RS + (i & 3) * 8;
#pragma unroll
        for (int kk = 0; kk < 2; ++kk) {
            u32x4 pw; pw.x = pkbf(s[2 * kk][0], s[2 * kk][1]); pw.y = pkbf(s[2 * kk][2], s[2 * kk][3]); pw.z = pkbf(s[2 * kk + 1][0], s[2 * kk + 1][1]); pw.w = pkbf(s[2 * kk + 1][2], s[2 * kk + 1][3]);
            const bf16x8 pf = __builtin_bit_cast(bf16x8, pw);
            s16x4 lo[8], hi[8];
#pragma unroll
            for (int db = 0; db < 8; ++db) { const NLAS char* vp = vb + (2 * kk) * 16 * RS + db * 32; lo[db] = vtr(vp); hi[db] = vtr(vp + 16 * RS); }
#pragma unroll
            for (int db = 0; db < 8; ++db) o[db] = mfma16((bf16x8){lo[db][0], lo[db][1], lo[db][2], lo[db][3], hi[db][0], hi[db][1], hi[db][2], hi[db][3]}, pf, o[db]);
        }
    }
    l += __shfl_xor(l, 16); l += __shfl_xor(l, 32);
    const float inv = 1.f / l;
    bf16_t* yo = Yxa + m * 512 + h * 128 + 4 * g;
#pragma unroll
    for (int db = 0; db < 8; ++db) { u32x2 v; v.x = pkbf(o[db][0] * inv, o[db][1] * inv); v.y = pkbf(o[db][2] * inv, o[db][3] * inv); *(u32x2*)(yo + db * 16) = v; }
    __syncthreads();
}
__device__ __forceinline__ void memkv_tile(const bf16_t* MEMN, const bf16_t* Wmkv, bf16_t* MEMKV, int tile) {
    const int tid = threadIdx.x, lane = tid & 63, w = __builtin_amdgcn_readfirstlane(tid >> 6), i = lane & 15, g = lane >> 4;
    const int r0 = (tile >> 4) * 64 + (w >> 1) * 16, c0 = (tile & 15) * 64 + (w & 1) * 32;
    const bf16_t* ap = MEMN + (size_t)(r0 + i) * 1024 + 8 * g; const bf16_t* bp = Wmkv + (size_t)(c0 + i) * 1024 + 8 * g;
    f32x4 acc0 = (f32x4){0.f, 0.f, 0.f, 0.f}, acc1 = acc0;
#pragma unroll 1
    for (int k0 = 0; k0 < 32; k0 += 8) { bf16x8 a[8], b0[8], b1[8];
#pragma unroll
        for (int kk = 0; kk < 8; ++kk) { a[kk] = *(const bf16x8*)(ap + 32 * (k0 + kk)); b0[kk] = *(const bf16x8*)(bp + 32 * (k0 + kk)); b1[kk] = *(const bf16x8*)(bp + 16 * 1024 + 32 * (k0 + kk)); }
#pragma unroll
        for (int kk = 0; kk < 8; ++kk) { acc0 = mfma16(a[kk], b0[kk], acc0); acc1 = mfma16(a[kk], b1[kk], acc1); } }
#pragma unroll
    for (int r = 0; r < 4; ++r) { bf16_t* o = MEMKV + (size_t)(r0 + 4 * g + r) * 1024 + c0 + i; o[0] = f2bf(acc0[r]); o[16] = f2bf(acc1[r]); }
}
__device__ __forceinline__ void phase(NLAS char* lds, const bf16_t* P, const bf16_t* MEMKV, bf16_t* Yxa) {
#pragma unroll 1
    for (int u = blockIdx.x; u < 512; u += gridDim.x) unit(lds, P, MEMKV, Yxa, u >> 7, (u >> 5) & 3, u & 31);
}
}

namespace ml {
using nsa::bf16x8; using nsa::s16x4; using nsa::f32x4; using nsa::u32x4; using nsa::u32x2; using nsa::vtr; using nsa::mfma16; using nsa::pkbf;
constexpr int RS = 272, TB = 64 * RS, RSS = 144;
constexpr float KSCALE = 0.08838834764831845f;
__device__ __forceinline__ float scan_add(float v, int lane) {
#pragma unroll
    for (int o = 1; o < 64; o <<= 1) { const float u = __shfl_up(v, o); if (lane >= o) v += u; }
    return v; }
__device__ __forceinline__ float scan_max(float v, int lane) {
#pragma unroll
    for (int o = 1; o < 64; o <<= 1) { const float u = __shfl_up(v, o); if (lane >= o) v = fmaxf(v, u); }
    return v; }
__device__ __forceinline__ bf16x8 trpair(const NLAS char* p, int hi_off) { const s16x4 lo = vtr(p), hi = vtr(p + hi_off); return (bf16x8){lo[0], lo[1], lo[2], lo[3], hi[0], hi[1], hi[2], hi[3]}; }
__device__ __forceinline__ void load_conv(NLAS char* dst, const bf16_t* P, const float* cw, int colP, int cwc, size_t m0, int tseq0, int tid) {
    const int s = tid >> 3, c16 = (tid & 7) * 16;
#pragma unroll
    for (int half = 0; half < 2; ++half) { const int c = c16 + half * 8; float acc[8];
#pragma unroll
        for (int e = 0; e < 8; ++e) acc[e] = 0.f;
#pragma unroll
        for (int j = 0; j < 4; ++j) { if (tseq0 + s - j >= 0) { const u32x4 raw = *(const u32x4*)(P + (m0 + s - j) * PW + colP + c);
            const f32x4 w0 = *(const f32x4*)(cw + j * 1024 + cwc + c), w1 = *(const f32x4*)(cw + j * 1024 + cwc + c + 4);
            acc[0] += w0[0] * pg8::bflo(raw.x); acc[1] += w0[1] * pg8::bfhi(raw.x); acc[2] += w0[2] * pg8::bflo(raw.y); acc[3] += w0[3] * pg8::bfhi(raw.y);
            acc[4] += w1[0] * pg8::bflo(raw.z); acc[5] += w1[1] * pg8::bfhi(raw.z); acc[6] += w1[2] * pg8::bflo(raw.w); acc[7] += w1[3] * pg8::bfhi(raw.w); } }
#pragma unroll
        for (int e = 0; e < 8; ++e) acc[e] = acc[e] * __builtin_amdgcn_rcpf(1.f + __expf(-acc[e]));
        u32x4 o; o.x = pkbf(acc[0], acc[1]); o.y = pkbf(acc[2], acc[3]); o.z = pkbf(acc[4], acc[5]); o.w = pkbf(acc[6], acc[7]);
        *(NLAS u32x4*)(dst + s * RS + c * 2) = o; }
}
__device__ __forceinline__ void m1_unit(NLAS char* lds, const bf16_t* P, const float* cw, const float* S32, bf16_t* Abuf, float* NA, float* Gc, float* Mloc, int ci) {
    constexpr int L_K = 0, L_EV = TB, L_E = 2 * TB;
    const int tid = threadIdx.x, lane = tid & 63, w = __builtin_amdgcn_readfirstlane(tid >> 6), i = lane & 15, g = lane >> 4;
    const int c = ci & 63, bh = ci >> 6, h = bh & 3, b = bh >> 2; const size_t m0 = (size_t)b * T + c * 64;
    NLAS float* eS = (NLAS float*)(lds + L_E);
    if (w == 0) { const float fpre = S32[(m0 + lane) * 32 + 4 + h], ipre = S32[(m0 + lane) * 32 + h];
        const float bcs = scan_add(logsig(fpre), lane), gtot = __shfl(bcs, 63), wend = gtot - bcs + ipre, mloc = wave_max(wend);
        eS[lane] = __expf(wend - mloc) * KSCALE; if (lane == 0) { Gc[ci] = gtot; Mloc[ci] = mloc; } }
    load_conv(lds + L_K, P, cw, P_MLK + h * 128, 512 + h * 128, m0, c * 64, tid);
    __syncthreads();
    { const int s = tid >> 3, c16 = (tid & 7) * 16; const float es = eS[s]; const bf16_t* vp = P + (m0 + s) * PW + P_MLV + h * 128 + c16;
#pragma unroll
      for (int half = 0; half < 2; ++half) { const u32x4 raw = *(const u32x4*)(vp + half * 8); u32x4 o;
          o.x = pkbf(pg8::bflo(raw.x) * es, pg8::bfhi(raw.x) * es); o.y = pkbf(pg8::bflo(raw.y) * es, pg8::bfhi(raw.y) * es);
          o.z = pkbf(pg8::bflo(raw.z) * es, pg8::bfhi(raw.z) * es); o.w = pkbf(pg8::bflo(raw.w) * es, pg8::bfhi(raw.w) * es);
          *(NLAS u32x4*)(lds + L_EV + s * RS + (c16 + half * 8) * 2) = o; } }
    __syncthreads();
    f32x4 acc[8];
#pragma unroll
    for (int vb = 0; vb < 8; ++vb) acc[vb] = (f32x4){0.f, 0.f, 0.f, 0.f};
    const int rowoff = (4 * g + (i >> 2)) * RS + (i & 3) * 8;
#pragma unroll
    for (int kk = 0; kk < 2; ++kk) { const bf16x8 kf = trpair(lds + L_K + kk * 32 * RS + rowoff + w * 32, 16 * RS);
#pragma unroll
        for (int vb = 0; vb < 8; ++vb) acc[vb] = mfma16(trpair(lds + L_EV + kk * 32 * RS + rowoff + vb * 32, 16 * RS), kf, acc[vb]); }
    bf16_t* ap = Abuf + ((size_t)ci * 128 + w * 16 + i) * 128 + 4 * g;
#pragma unroll
    for (int vb = 0; vb < 8; ++vb) { u32x2 pk; pk.x = pkbf(acc[vb][0], acc[vb][1]); pk.y = pkbf(acc[vb][2], acc[vb][3]); *(u32x2*)(ap + vb * 16) = pk; }
    { const int k = tid >> 2, part = tid & 3; float n = 0.f;
#pragma unroll
      for (int s = 0; s < 16; ++s) n += eS[part * 16 + s] * bf2f(*(const NLAS bf16_t*)(lds + L_K + (part * 16 + s) * RS + k * 2));
      n += __shfl_xor(n, 1); n += __shfl_xor(n, 2); if (part == 0) NA[(size_t)ci * 128 + k] = n; }
    __syncthreads();
}
__device__ __forceinline__ void m2_items(bf16_t* Abuf, float* NA, const float* Gc, const float* Mloc, float* Mprev) {
    for (int it = blockIdx.x * blockDim.x + threadIdx.x; it < 16 * 128 * 64; it += gridDim.x * blockDim.x) {
        const int bh = it >> 13, kv2 = it & 8191, k = kv2 >> 6, v2 = kv2 & 63;
        float C0 = 0.f, C1 = 0.f, n = 0.f, m = 0.f;
        unsigned* base = (unsigned*)(Abuf + ((size_t)(bh * 64) * 128 + k) * 128 + v2 * 2);
#pragma unroll 1
        for (int c0 = 0; c0 < 64; c0 += 16) { unsigned A[16];
#pragma unroll
            for (int u = 0; u < 16; ++u) A[u] = base[(size_t)(c0 + u) * 8192];
#pragma unroll
            for (int u = 0; u < 16; ++u) { const int ci = bh * 64 + c0 + u; const float gg = Gc[ci], ml = Mloc[ci];
                const float mn = fmaxf(gg + m, ml), a = __expf(gg + m - mn), bb = __expf(ml - mn);
                base[(size_t)(c0 + u) * 8192] = pkbf(C0, C1); C0 = C0 * a + pg8::bflo(A[u]) * bb; C1 = C1 * a + pg8::bfhi(A[u]) * bb;
                if (v2 == 0) { const float nA = NA[(size_t)ci * 128 + k]; NA[(size_t)ci * 128 + k] = n; n = a * n + bb * nA; }
                if (kv2 == 0) Mprev[ci] = m;
                m = mn; } }
    }
}
__device__ __forceinline__ void m3_unit(NLAS char* lds, const bf16_t* P, const float* cw, const float* S32, const bf16_t* Cprev, const float* Nprev, const float* Mprev, const float* normg, bf16_t* Yml, int ci) {
    constexpr int L_Q = 0, L_K = TB, L_V = 2 * TB, L_C = 3 * TB, L_S = 5 * TB, L_F = L_S + 64 * RSS;
    const int tid = threadIdx.x, lane = tid & 63, w = __builtin_amdgcn_readfirstlane(tid >> 6), i = lane & 15, g = lane >> 4;
    const int c = ci & 63, bh = ci >> 6, h = bh & 3, b = bh >> 2; const size_t m0 = (size_t)b * T + c * 64;
    bf16_t ov[4][4]; float ng[4];
    { const int tb_ = w >> 1, vb0_ = (w & 1) * 4;
#pragma unroll
      for (int vb = 0; vb < 4; ++vb) { ng[vb] = normg[h * 128 + (vb0_ + vb) * 16 + i];
#pragma unroll
          for (int r = 0; r < 4; ++r) ov[vb][r] = P[(m0 + tb_ * 16 + 4 * g + r) * PW + P_MLO + h * 128 + (vb0_ + vb) * 16 + i]; } }
    NLAS float* F = (NLAS float*)(lds + L_F);
    NLAS float* rowf = F; NLAS float* colf = F + 64; NLAS float* scv = F + 128; NLAS float* emt = F + 192; NLAS float* qn = F + 256; NLAS float* nprev = F + 320; NLAS float* denp = F + 448; NLAS float* ssq = F + 576;
    if (w == 0) { const float fpre = S32[(m0 + lane) * 32 + 4 + h], ipre = S32[(m0 + lane) * 32 + h], mprev = Mprev[ci];
        const float bcs = scan_add(logsig(fpre), lane), u = ipre - bcs, pm = scan_max(u, lane), mt = bcs + fmaxf(mprev, pm);
        rowf[lane] = bcs - mt; colf[lane] = u; scv[lane] = __expf(bcs + mprev - mt); emt[lane] = __expf(-mt); }
    else if (w <= 2) nprev[tid - 64] = Nprev[(size_t)ci * 128 + tid - 64];
    load_conv(lds + L_Q, P, cw, P_MLQ + h * 128, h * 128, m0, c * 64, tid);
    load_conv(lds + L_K, P, cw, P_MLK + h * 128, 512 + h * 128, m0, c * 64, tid);
    { const int s = tid >> 3, c16 = (tid & 7) * 16; const bf16_t* vp = P + (m0 + s) * PW + P_MLV + h * 128 + c16;
      *(NLAS u32x4*)(lds + L_V + s * RS + c16 * 2) = *(const u32x4*)vp; *(NLAS u32x4*)(lds + L_V + s * RS + c16 * 2 + 16) = *(const u32x4*)(vp + 8); }
    { const int k = tid >> 2, v0 = (tid & 3) * 32; const bf16_t* cp = Cprev + ((size_t)ci * 128 + k) * 128 + v0;
#pragma unroll
      for (int q8 = 0; q8 < 4; ++q8) *(NLAS u32x4*)(lds + L_C + k * RS + (v0 + q8 * 8) * 2) = *(const u32x4*)(cp + q8 * 8); }
    __syncthreads();
    { const int tq = tid >> 3, part = tid & 7; const u32x4 q0 = *(const NLAS u32x4*)(lds + L_Q + tq * RS + part * 32), q1 = *(const NLAS u32x4*)(lds + L_Q + tq * RS + part * 32 + 16);
      const NLAS f32x4* np = (const NLAS f32x4*)(nprev + part * 16); const f32x4 n0 = np[0], n1 = np[1], n2 = np[2], n3 = np[3];
      float a = pg8::bflo(q0.x) * n0[0] + pg8::bfhi(q0.x) * n0[1] + pg8::bflo(q0.y) * n0[2] + pg8::bfhi(q0.y) * n0[3] + pg8::bflo(q0.z) * n1[0] + pg8::bfhi(q0.z) * n1[1] + pg8::bflo(q0.w) * n1[2] + pg8::bfhi(q0.w) * n1[3]
              + pg8::bflo(q1.x) * n2[0] + pg8::bfhi(q1.x) * n2[1] + pg8::bflo(q1.y) * n2[2] + pg8::bfhi(q1.y) * n2[3] + pg8::bflo(q1.z) * n3[0] + pg8::bfhi(q1.z) * n3[1] + pg8::bflo(q1.w) * n3[2] + pg8::bfhi(q1.w) * n3[3];
      a += __shfl_xor(a, 1); a += __shfl_xor(a, 2); a += __shfl_xor(a, 4); if (part == 0) qn[tq] = a; }
    const int tb = w >> 1;
    {
        float rs[4] = {0.f, 0.f, 0.f, 0.f};
#pragma unroll
        for (int sbi = 0; sbi < 2; ++sbi) { const int sb = 2 * (w & 1) + sbi; f32x4 acc = (f32x4){0.f, 0.f, 0.f, 0.f};
            if (sb <= tb) {
#pragma unroll
                for (int ks = 0; ks < 4; ++ks) acc = mfma16(*(const NLAS bf16x8*)(lds + L_Q + (tb * 16 + i) * RS + (32 * ks + 8 * g) * 2), *(const NLAS bf16x8*)(lds + L_K + (sb * 16 + i) * RS + (32 * ks + 8 * g) * 2), acc); }
            const int s = sb * 16 + i; const float cf = colf[s];
#pragma unroll
            for (int r = 0; r < 4; ++r) { const int t = tb * 16 + 4 * g + r; const float v = (s <= t) ? acc[r] * KSCALE * __expf(rowf[t] + cf) : 0.f; rs[r] += v;
                *(NLAS bf16_t*)(lds + L_S + t * RSS + s * 2) = f2bf(v); } }
#pragma unroll
        for (int r = 0; r < 4; ++r) { float x = rs[r]; x += __shfl_xor(x, 1); x += __shfl_xor(x, 2); x += __shfl_xor(x, 4); x += __shfl_xor(x, 8); if (i == 0) denp[(w & 1) * 64 + tb * 16 + 4 * g + r] = x; }
    }
    __syncthreads();
    f32x4 a1[4], a2[4];
#pragma unroll
    for (int vb = 0; vb < 4; ++vb) { a1[vb] = (f32x4){0.f, 0.f, 0.f, 0.f}; a2[vb] = (f32x4){0.f, 0.f, 0.f, 0.f}; }
    const int vb0 = (w & 1) * 4, troff = (8 * g + (i >> 2)) * RS + (i & 3) * 8;
#pragma unroll
    for (int kk = 0; kk < 2; ++kk) { if (32 * kk <= tb * 16 + 15) { const bf16x8 sf = *(const NLAS bf16x8*)(lds + L_S + (tb * 16 + i) * RSS + (32 * kk + 8 * g) * 2);
#pragma unroll
        for (int vb = 0; vb < 4; ++vb) a1[vb] = mfma16(sf, trpair(lds + L_V + kk * 32 * RS + troff + (vb0 + vb) * 32, 4 * RS), a1[vb]); } }
#pragma unroll
    for (int ks = 0; ks < 4; ++ks) { const bf16x8 qf = *(const NLAS bf16x8*)(lds + L_Q + (tb * 16 + i) * RS + (32 * ks + 8 * g) * 2);
#pragma unroll
        for (int vb = 0; vb < 4; ++vb) a2[vb] = mfma16(qf, trpair(lds + L_C + ks * 32 * RS + troff + (vb0 + vb) * 32, 4 * RS), a2[vb]); }
    float hv[4][4], sq[4] = {0.f, 0.f, 0.f, 0.f};
#pragma unroll
    for (int r = 0; r < 4; ++r) { const int t = tb * 16 + 4 * g + r; const float sc = scv[t]; const float den = denp[t] + denp[64 + t] + sc * qn[t]; const float hd = 1.f / fmaxf(fabsf(den), emt[t]);
#pragma unroll
        for (int vb = 0; vb < 4; ++vb) { const float x = (a1[vb][r] + sc * a2[vb][r]) * hd; hv[vb][r] = x; sq[r] += x * x; } }
#pragma unroll
    for (int r = 0; r < 4; ++r) { float x = sq[r]; x += __shfl_xor(x, 1); x += __shfl_xor(x, 2); x += __shfl_xor(x, 4); x += __shfl_xor(x, 8); if (i == 0) ssq[(w & 1) * 64 + tb * 16 + 4 * g + r] = x; }
    __syncthreads();
#pragma unroll
    for (int r = 0; r < 4; ++r) { const int t = tb * 16 + 4 * g + r; const float rinv = rsqrtf((ssq[t] + ssq[64 + t]) * (1.f / 128.f) + EPS);
#pragma unroll
        for (int vb = 0; vb < 4; ++vb) { const int v = (vb0 + vb) * 16 + i; const float o = bf2f(ov[vb][r]);
            Yml[(m0 + t) * 512 + h * 128 + v] = f2bf(__builtin_amdgcn_rcpf(1.f + __expf(-o)) * hv[vb][r] * rinv * ng[vb]); } }
    __syncthreads();
}
}

namespace cmpr {
using nsa::bf16x8; using nsa::f32x4; using nsa::u32x4; using nsa::mfma16; using nsa::pkbf;
constexpr int RSX = 144, L_X = 0, L_PE = 272 * RSX  , L_H = L_PE + 8192, RSH = 528;
__device__ __forceinline__ void unit(NLAS char* lds, const bf16_t* P, const float* pe, const bf16_t* W1t, const bf16_t* W2t, bf16_t* KC, bf16_t* VC, int u) {
    const int tid = threadIdx.x, lane = tid & 63, w = __builtin_amdgcn_readfirstlane(tid >> 6), i = lane & 15, g = lane >> 4;
    const int nt = u & 15, gq = (u >> 4) & 1, b = (u >> 5) & 3, kv = u >> 7;
    const int pcol = (kv ? P_VC : P_KC) + gq * 64, tok0 = 256 * nt;
    for (int ch = tid; ch < 272 * 8; ch += 512) { const int row = ch >> 3, c8 = (ch & 7) * 8, tok = tok0 + row;
        u32x4 v = (u32x4){0u, 0u, 0u, 0u}; if (tok < T) v = *(const u32x4*)(P + ((size_t)b * T + tok) * PW + pcol + c8);
        *(NLAS u32x4*)(lds + L_X + row * RSX + c8 * 2) = v; }
    for (int e = tid; e < 2048; e += 512) ((NLAS float*)(lds + L_PE))[e] = pe[kv * 2048 + e];
    __syncthreads();
    f32x4 acc[2]; acc[0] = (f32x4){0.f, 0.f, 0.f, 0.f}; acc[1] = acc[0];
    const bf16_t* wb = W1t + ((size_t)kv * 256 + 32 * w + i) * 2048 + 8 * g;
#define CMPR_LOAD(dst, k0_) { _Pragma("unroll") for (int kk = 0; kk < 8; ++kk) { dst[kk][0] = *(const bf16x8*)(wb + 32 * ((k0_) + kk)); dst[kk][1] = *(const bf16x8*)(wb + 16 * 2048 + 32 * ((k0_) + kk)); } }
#define CMPR_COMP(src, k0_) { _Pragma("unroll") for (int kk = 0; kk < 8; ++kk) { const int ks = (k0_) + kk, l = ks >> 1, dh = ks & 1; \
            const u32x4 raw = *(const NLAS u32x4*)(lds + L_X + (16 * i + l) * RSX + dh * 64 + 16 * g); \
            const NLAS float* pp = (const NLAS float*)(lds + L_PE) + l * 64 + dh * 32 + 8 * g; const f32x4 p0 = *(const NLAS f32x4*)pp, p1 = *(const NLAS f32x4*)(pp + 4); \
            u32x4 a; a.x = pkbf(pg8::bflo(raw.x) + p0[0], pg8::bfhi(raw.x) + p0[1]); a.y = pkbf(pg8::bflo(raw.y) + p0[2], pg8::bfhi(raw.y) + p0[3]); \
            a.z = pkbf(pg8::bflo(raw.z) + p1[0], pg8::bfhi(raw.z) + p1[1]); a.w = pkbf(pg8::bflo(raw.w) + p1[2], pg8::bfhi(raw.w) + p1[3]); \
            const bf16x8 af = __builtin_bit_cast(bf16x8, a); \
            acc[0] = mfma16(af, src[kk][0], acc[0]); acc[1] = mfma16(af, src[kk][1], acc[1]); } }
    { bf16x8 bA[8][2], bB[8][2];
      CMPR_LOAD(bA, 0)
#pragma unroll 1
      for (int k0 = 0; k0 < 64; k0 += 16) { CMPR_LOAD(bB, k0 + 8) CMPR_COMP(bA, k0) if (k0 + 16 < 64) CMPR_LOAD(bA, k0 + 16) CMPR_COMP(bB, k0 + 8) } }
#undef CMPR_LOAD
#undef CMPR_COMP
#pragma unroll
    for (int cb = 0; cb < 2; ++cb)
#pragma unroll
        for (int r = 0; r < 4; ++r) { const float x = acc[cb][r], uu = 0.7978845608028654f * (x + 0.044715f * x * x * x); const float gl = x * __builtin_amdgcn_rcpf(1.f + __expf(-2.f * uu));
            *(NLAS bf16_t*)(lds + L_H + (4 * g + r) * RSH + (32 * w + cb * 16 + i) * 2) = f2bf(gl); }
    __syncthreads();
    if (w < 4) { f32x4 o = (f32x4){0.f, 0.f, 0.f, 0.f}; const bf16_t* w2 = W2t + ((size_t)kv * 64 + 16 * w + i) * 256 + 8 * g;
#pragma unroll
        for (int ks = 0; ks < 8; ++ks) o = mfma16(*(const NLAS bf16x8*)(lds + L_H + i * RSH + (32 * ks + 8 * g) * 2), *(const bf16x8*)(w2 + 32 * ks), o);
        bf16_t* dst = (kv ? VC : KC);
#pragma unroll
        for (int r = 0; r < 4; ++r) dst[((size_t)(b * 256 + 16 * nt + 4 * g + r) * 2 + gq) * 64 + 16 * w + i] = f2bf(o[r]); }
    __syncthreads();
}
}

#define LAS __attribute__((address_space(3)))
constexpr int NTHREADS = 512, LDS_BYTES = 147456;
constexpr size_t WS_WIN = 1 * MiB, WS_WG = 9 * MiB, WS_WBR = 15 * MiB, WS_WOUT = 18 * MiB, WS_WFF1 = 20 * MiB, WS_WFF2 = 28 * MiB, WS_WMKV = 36 * MiB, WS_WC1 = 38 * MiB;
constexpr size_t WS_BIASP = 253 * MiB + 768 * 1024, WS_XCH = 254 * MiB;
#define XB_TMO      128
#define XB_XCNT(j)  (256  + 64 * (j))
#define XB_XSUB(j)  (1280 + 64 * (j))
#define XB_XGEN(j)  (2304 + 64 * (j))
#define XB_TOP      3328
#define XB_TOPGEN   3392
#define XCD_BAR_WORDS 3456
#define XB_SPIN_CAP (1u << 18)

__device__ __forceinline__ unsigned xb_ld(unsigned* p)              { return __hip_atomic_load(p, __ATOMIC_RELAXED, __HIP_MEMORY_SCOPE_AGENT); }
__device__ __forceinline__ unsigned xb_add(unsigned* p, unsigned v) { return __hip_atomic_fetch_add(p, v, __ATOMIC_RELAXED, __HIP_MEMORY_SCOPE_AGENT); }
__device__ __forceinline__ unsigned xb_xcc_id() { return (unsigned)__builtin_amdgcn_s_getreg((3 << 11) | 20) & 0xFu; }
#define XB_SPIN(cond, bar) do { unsigned _sp = 0; while (cond) { __builtin_amdgcn_s_sleep(1); \
    if ((++_sp & 255u) == 0u) { if (xb_ld(&(bar)[XB_TMO])) break; if (_sp > XB_SPIN_CAP) { atomicAdd(&(bar)[XB_TMO], 1u); break; } } } } while (0)

struct XcdBarrier {
    unsigned* bar; unsigned x;
    volatile LAS unsigned* st;
};

__device__ __forceinline__ XcdBarrier xcd_barrier_post(unsigned* bar, volatile LAS unsigned* st) {
    XcdBarrier b; b.bar = bar; b.x = xb_xcc_id(); b.st = st;
    if (threadIdx.x == 0) (void)xb_add(&bar[XB_XCNT(b.x)], 1u);
    return b;
}
__device__ __forceinline__ void xcd_barrier_complete(unsigned* bar, unsigned x, unsigned& nloc, unsigned& nx) {
    const unsigned G = gridDim.x * gridDim.y * gridDim.z;
    unsigned sum, cnt, mine, sp = 0u;
    for (;;) {
        sum = 0u; cnt = 0u; mine = 0u;
#pragma unroll
        for (unsigned j = 0; j < 16; ++j) { const unsigned c = xb_ld(&bar[XB_XCNT(j)]); sum += c; cnt += (c > 0u) ? 1u : 0u; mine = (j == x) ? c : mine; }
        if (sum == G) break;
        __builtin_amdgcn_s_sleep(1);
        if ((++sp & 255u) == 0u) { if (xb_ld(&bar[XB_TMO])) break; if (sp > XB_SPIN_CAP) { atomicAdd(&bar[XB_TMO], 1u); break; } }
    }
    nloc = mine > 0u ? mine : 1u; nx = cnt > 0u ? cnt : 1u;
}

__device__ __forceinline__ void xcd_barrier(const XcdBarrier& b) {
    asm volatile("s_waitcnt vmcnt(0)" ::: "memory");
    __syncthreads();
    if (threadIdx.x == 0) {
        unsigned* bar = b.bar;
        __builtin_amdgcn_s_waitcnt(0);
        unsigned nloc = b.st[0], nx = b.st[1];
        if (nloc == 0u) { xcd_barrier_complete(bar, b.x, nloc, nx); b.st[0] = nloc; b.st[1] = nx; }
        const unsigned old = xb_add(&bar[XB_XSUB(b.x)], 1u);
        const unsigned gen = old / nloc;
        if (old + 1u == (gen + 1u) * nloc) {
            __builtin_amdgcn_fence(__ATOMIC_RELEASE, "agent");
            asm volatile("s_waitcnt vmcnt(0)" ::: "memory");
            const unsigned og = xb_add(&bar[XB_TOP], 1u);
            const unsigned tg = og / nx;
            if (og + 1u == (tg + 1u) * nx) xb_add(&bar[XB_TOPGEN], 1u);
            else XB_SPIN(xb_ld(&bar[XB_TOPGEN]) == tg, bar);
            __builtin_amdgcn_fence(__ATOMIC_ACQUIRE, "agent");
            xb_add(&bar[XB_XGEN(b.x)], 1u);
            asm volatile("s_waitcnt vmcnt(0)" ::: "memory");
        } else {
            XB_SPIN(xb_ld(&bar[XB_XGEN(b.x)]) == gen, bar);
            __builtin_amdgcn_fence(__ATOMIC_ACQUIRE, "agent");
            asm volatile("s_waitcnt vmcnt(0)" ::: "memory");
        }
    }
    __syncthreads();
}

__device__ __forceinline__ void group_barrier(unsigned* gc, unsigned target, bool light) {
    asm volatile("s_waitcnt vmcnt(0)" ::: "memory"); __syncthreads();
    if (threadIdx.x == 0) {
        if (!light) { __builtin_amdgcn_fence(__ATOMIC_RELEASE, "agent"); asm volatile("s_waitcnt vmcnt(0)" ::: "memory"); }
        __hip_atomic_fetch_add(gc, 1u, __ATOMIC_RELAXED, __HIP_MEMORY_SCOPE_AGENT);
        unsigned sp = 0; while (__hip_atomic_load(gc, __ATOMIC_RELAXED, __HIP_MEMORY_SCOPE_AGENT) < target) { __builtin_amdgcn_s_sleep(1); if (++sp > (1u << 22)) break; }
        __builtin_amdgcn_fence(__ATOMIC_ACQUIRE, "agent"); asm volatile("s_waitcnt vmcnt(0)" ::: "memory");
    }
    __syncthreads();
}
struct Args { const float* in[18]; float* out; unsigned char* ws; int ph_lo, ph_hi; };
__device__ __forceinline__ unsigned pk2(float lo, float hi) { return (unsigned)f2bf(lo) | ((unsigned)f2bf(hi) << 16); }
typedef unsigned v4u __attribute__((ext_vector_type(4)));
typedef float f32x4 __attribute__((ext_vector_type(4)));
__device__ __forceinline__ void tr_item(const float* W, int ld, int ncols, int K, bf16_t* WT, int row_off, LAS float* scr, int item, int lane) {
    const int nblk = ncols / 32, kb = item / nblk, nb = item % nblk, k0 = 64 * kb, n0 = 32 * nb;
#pragma unroll 8
    for (int i = 0; i < 32; ++i) { const int kk = 2 * i + (lane >> 5); scr[kk * 33 + (lane & 31)] = W[(size_t)(k0 + kk) * ld + n0 + (lane & 31)]; }
    asm volatile("s_waitcnt lgkmcnt(0)" ::: "memory");
    const int c = lane & 7;
#pragma unroll
    for (int j = 0; j < 4; ++j) { const int n = (lane >> 3) + 8 * j; const LAS float* s = scr + (8 * c) * 33 + n;
        v4u o; o.x = pk2(s[0 * 33], s[1 * 33]); o.y = pk2(s[2 * 33], s[3 * 33]); o.z = pk2(s[4 * 33], s[5 * 33]); o.w = pk2(s[6 * 33], s[7 * 33]);
        *(v4u*)(WT + (size_t)(row_off + n0 + n) * K + k0 + 8 * c) = o; }
    asm volatile("s_waitcnt lgkmcnt(0)" ::: "memory");
}
__device__ __forceinline__ void rms_row_wave(const float* xrow, const float* g, bf16_t* orow, int lane) {
    const f32x4* xr = (const f32x4*)xrow + lane; const f32x4* gr = (const f32x4*)g + lane;
    f32x4 v[4]; float s = 0.f;
#pragma unroll
    for (int j = 0; j < 4; ++j) { v[j] = xr[64 * j]; s += (v[j].x * v[j].x + v[j].y * v[j].y) + (v[j].z * v[j].z + v[j].w * v[j].w); }
    const float r = rsqrtf(wave_sum(s) * (1.f / D) + EPS);
    unsigned long long* o8 = (unsigned long long*)orow + lane;
#pragma unroll
    for (int j = 0; j < 4; ++j) { const f32x4 gg = gr[64 * j]; o8[64 * j] = (unsigned long long)pk2(v[j].x * r * gg.x, v[j].y * r * gg.y) | ((unsigned long long)pk2(v[j].z * r * gg.z, v[j].w * r * gg.w) << 32); }
}
__device__ __forceinline__ int small_src_col(int c) { return c < 8 ? C_MLI + c : C_NSG + (c - 8); }
__global__ void __launch_bounds__(NTHREADS, 2) mega(Args a) {
    extern __shared__ __attribute__((aligned(16))) unsigned char lds_raw[];
    char* lds = (char*)lds_raw;
    LAS unsigned char* lds3 = (LAS unsigned char*)lds_raw;
    const float* x = a.in[0]; const float* mem = a.in[1]; const float* g_mix = a.in[2]; const float* w_in = a.in[3];
    const float* b_in = a.in[4]; const float* ml_conv = a.in[5]; const float* ml_norm_g = a.in[6]; const float* cmp_pe = a.in[7];
    const float* cmp_w1 = a.in[8]; const float* cmp_w2 = a.in[9]; const float* g_mem = a.in[10]; const float* w_mem_kv = a.in[11];
    const float* w_branch = a.in[12]; const float* w_out = a.in[13]; const float* g_ffn = a.in[14]; const float* w_ff1 = a.in[15];
    const float* w_ff2 = a.in[16]; const float* g_final = a.in[17];
    char* ws = (char*)a.ws; float* out = a.out;
    bf16_t* U = (bf16_t*)(ws + WS_U); bf16_t* P = (bf16_t*)(ws + WS_P);
    bf16_t* Yml = (bf16_t*)(ws + WS_Y); bf16_t* Ynsa = Yml + (size_t)M * 512; bf16_t* Yxa = Ynsa + (size_t)M * 512;
    float* S32 = (float*)(ws + WS_S32); bf16_t* MEMN = (bf16_t*)out + (size_t)16 * 1024 * 1024;     bf16_t* MEMKV = (bf16_t*)(ws + WS_MEMKV);
    bf16_t* KC = (bf16_t*)(ws + WS_KC); bf16_t* VC = (bf16_t*)(ws + WS_VC);
    float* NA = (float*)(ws + WS_NA); float* Gc = (float*)(ws + WS_G); float* Mloc = (float*)(ws + WS_MLOC); float* Mprev = (float*)(ws + WS_MPREV);
    bf16_t* Abuf = (bf16_t*)out;
    bf16_t* GATES = P; bf16_t* MERGED = U; bf16_t* AFFN = U; bf16_t* HBUF = P;
    bf16_t* Wi = (bf16_t*)(ws + WS_WIN); bf16_t* Wg = (bf16_t*)(ws + WS_WG); bf16_t* Wbr = (bf16_t*)(ws + WS_WBR); bf16_t* Wo = (bf16_t*)(ws + WS_WOUT);
    bf16_t* Wf1 = (bf16_t*)(ws + WS_WFF1); bf16_t* Wf2 = (bf16_t*)(ws + WS_WFF2); bf16_t* Wmkv = (bf16_t*)(ws + WS_WMKV);
    float* biasP = (float*)(ws + WS_BIASP); bf16_t* Wc1 = (bf16_t*)(ws + WS_WC1); bf16_t* Wc2 = (bf16_t*)(ws + WS_BIASP + 65536);
    const int tid = threadIdx.x, lane = tid & 63, wave = __builtin_amdgcn_readfirstlane(tid >> 6);
    const int G = gridDim.x, bid = blockIdx.x;
    const int lo = a.ph_lo, hi = a.ph_hi;
    volatile LAS unsigned* xbst = (volatile LAS unsigned*)(lds3 + LDS_BYTES - 64);
    if (tid < 2) xbst[tid] = 0u;
    __syncthreads();
    const XcdBarrier bar = xcd_barrier_post((unsigned*)ws, xbst);
    if (tid == 0) __hip_atomic_store((unsigned*)ws + 12544 + bid, xb_xcc_id() + 1u, __ATOMIC_RELAXED, __HIP_MEMORY_SCOPE_AGENT);
#define PHASE(k) if (lo <= (k) && (k) < hi)
#define SEAM(k) if (lo <= (k) && (k) + 1 < hi) xcd_barrier(bar)
    PHASE(0) {
        LAS float* scr = (LAS float*)(lds3 + wave * 16384);
        const int gw = bid * 8 + wave, NGW = G * 8;
        constexpr int I0 = 16 * 64, I1 = 16 * 40, I2 = 16 * 16, I3 = 16 * 96, I4 = 8 * 32, I5 = 16 * 32, I6 = 16 * 128, I7 = 64 * 32, I8 = 16 * 32;
        constexpr int I9 = 32 * 8, I10 = 4 * 2;
        constexpr int NITEMS = I0 + I1 + I2 + I3 + 3 * I4 + I5 + I6 + I7 + I8 + 2 * I9 + 2 * I10;
        for (int it = gw; it < NITEMS; it += NGW) {
            int r = it;
            if (r < I0) { tr_item(w_in, DIN, 2048, 1024, Wi, 0, scr, r, lane); continue; } r -= I0;
            if (r < I1) { tr_item(w_in + 2056, DIN, 1280, 1024, Wi, 2048, scr, r, lane); continue; } r -= I1;
            if (r < I2) { tr_item(w_in + 3360, DIN, 512, 1024, Wi, 3328, scr, r, lane); continue; } r -= I2;
            if (r < I3) { tr_item(w_in + C_MG, DIN, 3072, 1024, Wg, 0, scr, r, lane); continue; } r -= I3;
            if (r < 3 * I4) { const int j = r / I4; tr_item(w_branch + (size_t)j * 512 * 1024, 1024, 1024, 512, Wbr + (size_t)j * 1024 * 512, 0, scr, r % I4, lane); continue; } r -= 3 * I4;
            if (r < I5) { tr_item(w_out, 1024, 1024, 1024, Wo, 0, scr, r, lane); continue; } r -= I5;
            if (r < I6) { tr_item(w_ff1, FF, FF, 1024, Wf1, 0, scr, r, lane); continue; } r -= I6;
            if (r < I7) { tr_item(w_ff2, 1024, 1024, FF, Wf2, 0, scr, r, lane); continue; } r -= I7;
            if (r < I8) { tr_item(w_mem_kv, 1024, 1024, 1024, Wmkv, 0, scr, r, lane); continue; } r -= I8;
            if (r < 2 * I9) { const int kv = r / I9; tr_item(cmp_w1 + (size_t)kv * 2048 * 256, 256, 256, 2048, Wc1 + (size_t)kv * 256 * 2048, 0, scr, r % I9, lane); continue; } r -= 2 * I9;
            { const int kv = r / I10; tr_item(cmp_w2 + (size_t)kv * 256 * 64, 64, 64, 256, Wc2 + (size_t)kv * 64 * 256, 0, scr, r % I10, lane); }
        }
        for (int i = bid * NTHREADS + tid; i < 256 * 1024; i += G * NTHREADS) { const int r = i >> 10, k = i & 1023; bf16_t v = 0;
            if (r < 32) v = f2bf(w_in[(size_t)k * DIN + small_src_col(r)]);
            else if (r >= 128 && r < 160) { const float w = w_in[(size_t)k * DIN + small_src_col(r - 128)]; v = f2bf(w - bf2f(f2bf(w))); }
            Wi[(size_t)(3840 + r) * 1024 + k] = v; }
        for (int c = bid * NTHREADS + tid; c < 4096; c += G * NTHREADS) { float v = 0.f;
            if (c < 2048) v = b_in[c]; else if (c < 3328) v = b_in[c + 8]; else if (c < 3840) v = b_in[c + 32]; else if (c < 3872) v = b_in[small_src_col(c - 3840)];
            biasP[c] = v; }
        for (int m = gw; m < M; m += NGW) rms_row_wave(x + (size_t)m * D, g_mix, U + (size_t)m * D, lane);
        for (int m = gw; m < 1024; m += NGW) rms_row_wave(mem + (size_t)m * D, g_mem, MEMN + (size_t)m * D, lane);
    }
    SEAM(0);
    PHASE(1) {
        { pg8::Gemm g{U, Wi, M, 4096, D}; pg8::StaticOrder S; S.init(M, 4096, G, bid);
          pg8::EpiStore<0> E{P, biasP, S32, PW, 15};
          pg8::gemm_phase<pg8::EpiStore<0>, pg8::StaticOrder, true, true>(lds3, g, S, E); }
    }
    SEAM(1);
    PHASE(2) { for (int tl_ = bid; tl_ < 256; tl_ += G) xa::memkv_tile(MEMN, Wmkv, MEMKV, tl_);
               for (int ci = bid; ci < 1024; ci += G) ml::m1_unit((NLAS char*)lds_raw, P, ml_conv, S32, Abuf, NA, Gc, Mloc, ci);
               for (int u = bid; u < 256; u += G) cmpr::unit((NLAS char*)lds_raw, P, cmp_pe, Wc1, Wc2, KC, VC, u);
    }
    SEAM(2);
    PHASE(3) { unsigned* m2cnt = (unsigned*)ws + 12288;
               ml::m2_items(Abuf, NA, Gc, Mloc, Mprev);
               asm volatile("s_waitcnt vmcnt(0)" ::: "memory"); __syncthreads();
               if (tid == 0) { __builtin_amdgcn_fence(__ATOMIC_RELEASE, "agent"); asm volatile("s_waitcnt vmcnt(0)" ::: "memory"); __hip_atomic_fetch_add(m2cnt, 1u, __ATOMIC_RELAXED, __HIP_MEMORY_SCOPE_AGENT); }
               nsa::phase((NLAS char*)lds_raw, P, S32, KC, VC, Ynsa);
               xa::phase((NLAS char*)lds_raw, P, MEMKV, Yxa);
               if (tid == 0) { unsigned sp = 0; while (__hip_atomic_load(m2cnt, __ATOMIC_RELAXED, __HIP_MEMORY_SCOPE_AGENT) < (unsigned)G) { __builtin_amdgcn_s_sleep(2); if (++sp > (1u << 22)) break; }
                               __builtin_amdgcn_fence(__ATOMIC_ACQUIRE, "agent"); asm volatile("s_waitcnt vmcnt(0)" ::: "memory"); }
               __syncthreads();
               for (int ci = bid; ci < 1024; ci += G) ml::m3_unit((NLAS char*)lds_raw, P, ml_conv, S32, Abuf, NA, Mprev, ml_norm_g, Yml, ci); }
    SEAM(4);
    const bool panel_sync = (G == 256);
    unsigned* gcnt = (unsigned*)ws + 13312 + 16 * (bid & 63);
    bool light = false;
    if (panel_sync) { unsigned x0 = 0, same = 1;
        for (int k = 0; k < 4; ++k) { const unsigned xv = __hip_atomic_load((unsigned*)ws + 12544 + (bid & 63) + 64 * k, __ATOMIC_RELAXED, __HIP_MEMORY_SCOPE_AGENT); if (k == 0) x0 = xv; same &= (xv == x0 && xv != 0u) ? 1u : 0u; }
        light = __builtin_amdgcn_readfirstlane(same) != 0; }
#define PSEAM(k, n) if (lo <= (k) && (k) + 1 < hi) { if (panel_sync) group_barrier(gcnt, 4u * (n), light); else xcd_barrier(bar); }
    PHASE(5) { pg8::Gemm g{U, Wg, M, 3072, D}; pg8::StaticOrder S; S.init(M, 3072, G, bid);
               pg8::EpiStore<1> E{GATES, b_in + C_MG, nullptr, 4096, -1};
               pg8::gemm_phase<pg8::EpiStore<1>, pg8::StaticOrder, true, true>(lds3, g, S, E); }
    PSEAM(5, 1);
    PHASE(6) { pg8::Gemm g{Yml, Wbr, M, 1024, 512}; pg8::MergeOrder S; S.so.init(M, 1024, G, bid); S.sa = (size_t)M * 512 * 2; S.sb = (size_t)1024 * 512 * 2;
               pg8::EpiMergeG E{GATES, (bf16_t*)out, MERGED};
               pg8::gemm_phase<pg8::EpiMergeG, pg8::MergeOrder, true, true>(lds3, g, S, E); }
    PSEAM(6, 2);
    PHASE(7) { pg8::Gemm g{MERGED, Wo, M, 1024, D}; pg8::StaticOrder S; S.init(M, 1024, G, bid);
               pg8::EpiResRms E{x, out, nullptr, AFFN, g_ffn, (float*)(ws + WS_XCH), (unsigned*)ws + 4096};
               pg8::gemm_phase<pg8::EpiResRms, pg8::StaticOrder, false, true>(lds3, g, S, E); }
    PSEAM(7, 3);
    PHASE(9) { pg8::Gemm g{AFFN, Wf1, M, FF, D}; pg8::StaticOrder S; S.init(M, FF, G, bid);
               pg8::EpiStore<2> E{HBUF, nullptr, nullptr, FF, -1};
               pg8::gemm_phase<pg8::EpiStore<2>, pg8::StaticOrder, true, true>(lds3, g, S, E); }
    PSEAM(9, 4);
    PHASE(10) { pg8::Gemm g{HBUF, Wf2, M, 1024, FF}; pg8::StaticOrder S; S.init(M, 1024, G, bid);
                pg8::EpiResRms E{out, nullptr, out, nullptr, g_final, (float*)(ws + WS_XCH + 262144), (unsigned*)ws + 4096 + 4096};
                pg8::gemm_phase<pg8::EpiResRms, pg8::StaticOrder, false, true>(lds3, g, S, E); }
}
constexpr int N_PHASES = 12;
#ifndef MK_PER_PHASE
#define MK_PER_PHASE 0
#endif
extern "C" void kernel_launch(void* const* d_in, const int* in_sizes, int n_in, void* d_out, int out_size, void* d_ws, size_t ws_size, hipStream_t stream) {
    static int grid = 0;
    if (grid == 0) {
        int dev = 0, cus = 0, per_cu = 0;
        (void)hipGetDevice(&dev); (void)hipDeviceGetAttribute(&cus, hipDeviceAttributeMultiprocessorCount, dev);
        (void)hipFuncSetAttribute((const void*)mega, hipFuncAttributeMaxDynamicSharedMemorySize, LDS_BYTES);
        (void)hipOccupancyMaxActiveBlocksPerMultiprocessor(&per_cu, (const void*)mega, NTHREADS, LDS_BYTES);
        if (per_cu < 1) { fprintf(stderr, "occupancy query says %d blocks/CU\n", per_cu); per_cu = 1; }
        grid = cus * 1;
        (void)hipGetLastError();
    }
    (void)hipMemsetAsync(d_ws, 0, 65536, stream);
    Args a{};
    for (int i = 0; i < 18; ++i) a.in[i] = (const float*)d_in[i];
    a.out = (float*)d_out; a.ws = (unsigned char*)d_ws;
#if MK_PER_PHASE
    for (int p = 0; p < N_PHASES; ++p) { a.ph_lo = p; a.ph_hi = p + 1; void* args[] = {&a};
        (void)hipLaunchCooperativeKernel((const void*)mega, dim3(grid), dim3(NTHREADS), args, LDS_BYTES, stream); }
#else
    a.ph_lo = 0; a.ph_hi = N_PHASES; void* args[] = {&a};
    hipError_t e = hipLaunchCooperativeKernel((const void*)mega, dim3(grid), dim3(NTHREADS), args, LDS_BYTES, stream);
    if (e != hipSuccess) fprintf(stderr, "cooperative launch failed: %s (grid %d)\n", hipGetErrorString(e), grid);
#endif
}
```

```cpp
#include <hip/hip_runtime.h>
#include <hip/hip_cooperative_groups.h>
#include <cstdio>
namespace cg = cooperative_groups;
#include <stdint.h>

typedef unsigned short bf16_t;
__device__ __forceinline__ float bf2f(bf16_t v) { return __uint_as_float(((unsigned)v) << 16); }
__device__ __forceinline__ bf16_t f2bf(float f) { unsigned u = __float_as_uint(f); return (bf16_t)((u + 0x7fffu + ((u >> 16) & 1u)) >> 16); }

constexpr int NB = 4, T = 4096, M = NB * T, D = 1024, DIN = 6944, FF = 4096;
constexpr float EPS = 1e-6f;
constexpr int C_MLI = 2048, C_NSG = 3336, C_MG = 3872;
constexpr int P_MLQ = 0, P_MLK = 512, P_MLV = 1024, P_MLO = 1536, P_NSQ = 2048, P_KC = 2560, P_VC = 2688, P_KS = 2816, P_VS = 2944, P_KW = 3072, P_VW = 3200, P_XAQ = 3328, PW = 3840;
constexpr size_t MiB = 1u << 20;
constexpr size_t WS_U = 40 * MiB;
constexpr size_t WS_P = 72 * MiB;
constexpr size_t WS_Y = 200 * MiB;
constexpr size_t WS_S32 = 248 * MiB;
constexpr size_t WS_MEMKV = 250 * MiB;
constexpr size_t WS_KC = 252 * MiB;
constexpr size_t WS_VC = 252 * MiB + 512 * 1024;
constexpr size_t WS_NA = 253 * MiB;
constexpr size_t WS_G = 253 * MiB + 512 * 1024;
constexpr size_t WS_MLOC = 253 * MiB + 512 * 1024 + 4096;
constexpr size_t WS_MPREV = 253 * MiB + 512 * 1024 + 8192;

__device__ __forceinline__ float wave_sum(float v) {
#pragma unroll
    for (int o = 1; o < 64; o <<= 1) v += __shfl_xor(v, o);
    return v;
}
__device__ __forceinline__ float wave_max(float v) {
#pragma unroll
    for (int o = 1; o < 64; o <<= 1) v = fmaxf(v, __shfl_xor(v, o));
    return v;
}

__device__ __forceinline__ float logsig(float x) { return fminf(x, 0.f) - log1pf(__expf(-fabsf(x))); }
namespace pg8 {
#define PG8_LAS __attribute__((address_space(3)))
typedef unsigned short bf16_t;
typedef short bf16x8 __attribute__((ext_vector_type(8)));
typedef float f32x4 __attribute__((ext_vector_type(4)));
typedef unsigned u32x4 __attribute__((ext_vector_type(4)));
constexpr int BM = 256, BK = 64, HALF = 128, HTB = HALF * BK * 2  , STAGE_BYTES = 8 * HTB, NXCD = 8, WGM = 8;

__host__ __device__ __forceinline__ int lds_byte(int r, int c) { const int st = (r >> 4) * 2 + (c >> 5), rr = r & 15, cc = c & 31, ob = rr * 64 + cc * 2; return st * 1024 + (ob ^ (((ob >> 9) & 1) << 5)); }
__host__ __device__ __forceinline__ void stage_rc(int b, int& R, int& C) { const int st = b / 1024, sb = b % 1024, swz = sb ^ (((sb >> 9) & 1) << 5); R = (st >> 1) * 16 + swz / 64; C = (st & 1) * 32 + (swz % 64) / 2; }
__host__ __device__ __forceinline__ int perm32(int rho) { const int n = rho >> 4, i = rho & 15; return 8 * (i >> 2) + 4 * n + (i & 3); }

struct Unit { int pm, pn, j; };
struct Gemm { const bf16_t* A; const bf16_t* Bt; int M, N, K; };

struct StaticOrder {
    int nM, nN, nwg, G, c;
    __host__ __device__ void init(int M, int N, int G_, int c_) { nM = M / BM; nN = N / BM; nwg = nM * nN; G = G_; c = c_; }
    __host__ __device__ bool next(int i, Unit& u) const {
        const long L = (long)i * G + c; if (L >= nwg) return false;
        int wgid = (int)L; { const int q = nwg / NXCD, r = nwg % NXCD, xcd = wgid % NXCD, off = wgid / NXCD; wgid = (xcd < r ? xcd * (q + 1) : r * (q + 1) + (xcd - r) * q) + off; }
        const int nig = WGM * nN, gid = wgid / nig, fm = gid * WGM, gsz = (nM - fm) < WGM ? (nM - fm) : WGM;
        u.pm = fm + ((wgid % nig) % gsz); u.pn = (wgid % nig) / gsz; u.j = 0; return true;
    }
    __device__ __forceinline__ const char* pa(const Gemm& g, const Unit& u, size_t tstep) const { return (const char*)g.A + (size_t)u.pm * tstep; }
    __device__ __forceinline__ const char* pb(const Gemm& g, const Unit& u, size_t tstep) const { return (const char*)g.Bt + (size_t)u.pn * tstep; }
    __device__ __forceinline__ void a_ready(const Unit&) const {}
    __device__ __forceinline__ void done(const Unit&) const {}
};

struct MergeOrder {
    StaticOrder so; size_t sa, sb;
    __device__ __forceinline__ bool next(int i, Unit& u) const { if (i >= 3) return false; const bool ok = so.next(0, u); u.j = i; return ok; }
    __device__ __forceinline__ const char* pa(const Gemm& g, const Unit& u, size_t tstep) const { return (const char*)g.A + (size_t)u.j * sa + (size_t)u.pm * tstep; }
    __device__ __forceinline__ const char* pb(const Gemm& g, const Unit& u, size_t tstep) const { return (const char*)g.Bt + (size_t)u.j * sb + (size_t)u.pn * tstep; }
    __device__ __forceinline__ void a_ready(const Unit&) const {}
    __device__ __forceinline__ void done(const Unit&) const {}
};
typedef float f32x2_t __attribute__((ext_vector_type(2))); typedef __bf16 bf16x2_t __attribute__((ext_vector_type(2)));
__device__ __forceinline__ unsigned cvt_pk_bf16(float lo, float hi) { f32x2_t v = {lo, hi}; bf16x2_t b = __builtin_convertvector(v, bf16x2_t); return __builtin_bit_cast(unsigned, b); }
typedef float f32x2 __attribute__((ext_vector_type(2)));

typedef unsigned u32x2 __attribute__((ext_vector_type(2)));
__device__ __forceinline__ float bflo(unsigned w) { return __uint_as_float(w << 16); }
__device__ __forceinline__ float bfhi(unsigned w) { return __uint_as_float(w & 0xffff0000u); }
template <int ACT> __device__ __forceinline__ f32x4 act4(f32x4 v) {
    if (ACT == 1) { f32x4 o; for (int e = 0; e < 4; ++e) o[e] = __builtin_amdgcn_rcpf(1.f + __expf(-v[e])); return o; }
    if (ACT == 2) { f32x4 o; for (int e = 0; e < 4; ++e) { const float r = fmaxf(v[e], 0.f); o[e] = r * r; } return o; }
    return v;
}
template <int ACT> struct EpiStore {
    static constexpr bool PERM = true, AFTER_DRAIN = false;
    bf16_t* O; const float* bias; float* S32; int ldc, small_pn;
    __device__ __forceinline__ void operator()(const f32x4 (&acc)[2][2][4][2], const Unit& u, int wr, int wc, int fr, int fq) const {
        asm volatile("s_waitcnt vmcnt(0)" ::: "memory");
        const int row0 = u.pm * BM + wr * 64 + fr, col0 = u.pn * BM + wc * 32 + 8 * fq;
        if (u.pn == small_pn) {
            if (wc == 0) {
                const f32x4 b0 = *(const f32x4*)(bias + col0), b1 = *(const f32x4*)(bias + col0 + 4);
#pragma unroll
                for (int ai = 0; ai < 2; ++ai)
#pragma unroll
                    for (int m = 0; m < 4; ++m) { float* rp = S32 + (size_t)(row0 + ai * HALF + m * 16) * 32 + 8 * fq;
                        *(f32x4*)rp = acc[ai][0][m][0] + acc[ai][1][m][0] + b0; *(f32x4*)(rp + 4) = acc[ai][0][m][1] + acc[ai][1][m][1] + b1; }
            }
            return;
        }
        f32x4 bv[2][2];
#pragma unroll
        for (int bj = 0; bj < 2; ++bj)
#pragma unroll
            for (int n = 0; n < 2; ++n) bv[bj][n] = bias ? *(const f32x4*)(bias + col0 + bj * HALF + 4 * n) : (f32x4){0.f, 0.f, 0.f, 0.f};
#pragma unroll
        for (int ai = 0; ai < 2; ++ai)
#pragma unroll
            for (int m = 0; m < 4; ++m) { bf16_t* rowp = O + (size_t)(row0 + ai * HALF + m * 16) * ldc + col0;
#pragma unroll
                for (int bj = 0; bj < 2; ++bj) { const f32x4 v0 = act4<ACT>(acc[ai][bj][m][0] + bv[bj][0]), v1 = act4<ACT>(acc[ai][bj][m][1] + bv[bj][1]);
                    u32x4 w; w.x = cvt_pk_bf16(v0[0], v0[1]); w.y = cvt_pk_bf16(v0[2], v0[3]); w.z = cvt_pk_bf16(v1[0], v1[1]); w.w = cvt_pk_bf16(v1[2], v1[3]);
                    *(u32x4*)(rowp + bj * HALF) = w; } }
    }
};
struct EpiMergeG {
    static constexpr bool PERM = true, AFTER_DRAIN = false;
    const bf16_t* G; bf16_t* Mp; bf16_t* Mb;
    __device__ __forceinline__ void operator()(const f32x4 (&acc)[2][2][4][2], const Unit& u, int wr, int wc, int fr, int fq) const {
        const int j = u.j;
        asm volatile("s_waitcnt vmcnt(0)" ::: "memory");
        const int row0 = u.pm * BM + wr * 64 + fr, col0 = u.pn * BM + wc * 32 + 8 * fq;
        bf16_t* dst = (j < 2) ? Mp : Mb; constexpr size_t mpitch = 2048;
#pragma unroll
        for (int ai = 0; ai < 2; ++ai)
#pragma unroll
            for (int m = 0; m < 4; ++m) { const size_t row = (size_t)(row0 + ai * HALF + m * 16);
#pragma unroll
                for (int bj = 0; bj < 2; ++bj) { const int col = col0 + bj * HALF;
                    const u32x4 gw = *(const u32x4*)(G + row * 4096 + j * 1024 + col);
                    f32x4 v0 = (f32x4){bflo(gw.x), bfhi(gw.x), bflo(gw.y), bfhi(gw.y)} * acc[ai][bj][m][0], v1 = (f32x4){bflo(gw.z), bfhi(gw.z), bflo(gw.w), bfhi(gw.w)} * acc[ai][bj][m][1];
                    if (j > 0) { const u32x4 pw = *(const u32x4*)(Mp + row * mpitch + col); v0 += (f32x4){bflo(pw.x), bfhi(pw.x), bflo(pw.y), bfhi(pw.y)}; v1 += (f32x4){bflo(pw.z), bfhi(pw.z), bflo(pw.w), bfhi(pw.w)}; }
                    u32x4 w; w.x = cvt_pk_bf16(v0[0], v0[1]); w.y = cvt_pk_bf16(v0[2], v0[3]); w.z = cvt_pk_bf16(v1[0], v1[1]); w.w = cvt_pk_bf16(v1[2], v1[3]); *(u32x4*)(dst + row * ((j < 2) ? mpitch : (size_t)1024) + col) = w; } }
    }
};
struct EpiResidF {
    static constexpr bool PERM = true, AFTER_DRAIN = false;
    const float* X; float* O;
    __device__ __forceinline__ void operator()(const f32x4 (&acc)[2][2][4][2], const Unit& u, int wr, int wc, int fr, int fq) const {
        asm volatile("s_waitcnt vmcnt(0)" ::: "memory");
        const int row0 = u.pm * BM + wr * 64 + fr, col0 = u.pn * BM + wc * 32 + 8 * fq;
#pragma unroll
        for (int ai = 0; ai < 2; ++ai)
#pragma unroll
            for (int m = 0; m < 4; ++m) { const size_t off = (size_t)(row0 + ai * HALF + m * 16) * 1024 + col0;
#pragma unroll
                for (int bj = 0; bj < 2; ++bj) { const f32x4 x0 = *(const f32x4*)(X + off + bj * HALF), x1 = *(const f32x4*)(X + off + bj * HALF + 4);
                    *(f32x4*)(O + off + bj * HALF) = x0 + acc[ai][bj][m][0]; *(f32x4*)(O + off + bj * HALF + 4) = x1 + acc[ai][bj][m][1]; } }
    }
};
struct EpiResRms {
    static constexpr bool PERM = false, AFTER_DRAIN = true;
    const float* R; float* Hout; float* Nf; bf16_t* Nb; const float* gain; float* xbuf; unsigned* cnt;
    __device__ __forceinline__ void fused(f32x4 (&acc)[2][2][4][2], const Unit& u, int wr, int wc, int fr, int fq, PG8_LAS unsigned char* lds, int wid, int lane) const {
        PG8_LAS float* Pp = (PG8_LAS float*)lds; PG8_LAS float* S = (PG8_LAS float*)(lds + 4096);
        const int col0 = u.pn * BM + wc * 32 + 4 * fq;
#pragma unroll
        for (int ai = 0; ai < 2; ++ai)
#pragma unroll
            for (int m = 0; m < 4; ++m) { const size_t off = (size_t)(u.pm * BM + ai * HALF + wr * 64 + m * 16 + fr) * 1024 + col0; float sq = 0.f;
#pragma unroll
                for (int bj = 0; bj < 2; ++bj)
#pragma unroll
                    for (int n = 0; n < 2; ++n) { const f32x4 v = acc[ai][bj][m][n] + *(const f32x4*)(R + off + bj * HALF + n * 16); acc[ai][bj][m][n] = v; sq += (v[0] * v[0] + v[1] * v[1]) + (v[2] * v[2] + v[3] * v[3]); }
                sq += __shfl_xor(sq, 16); sq += __shfl_xor(sq, 32);
                if (fq == 0) Pp[(ai * HALF + wr * 64 + m * 16 + fr) * 4 + wc] = sq; }
        asm volatile("s_waitcnt lgkmcnt(0)" ::: "memory"); __builtin_amdgcn_s_barrier(); asm volatile("" ::: "memory");
        const int row = wid * 32 + (lane & 31);
        if (lane < 32) { const float tot = (Pp[row * 4 + 0] + Pp[row * 4 + 1]) + (Pp[row * 4 + 2] + Pp[row * 4 + 3]);
            __hip_atomic_store(xbuf + ((size_t)(u.pm * BM + row) * 4 + u.pn), tot, __ATOMIC_RELAXED, __HIP_MEMORY_SCOPE_AGENT); }
        asm volatile("s_waitcnt vmcnt(0)" ::: "memory");
        if (lane == 0) __hip_atomic_fetch_add(cnt + 64 * u.pm, 1u, __ATOMIC_RELAXED, __HIP_MEMORY_SCOPE_AGENT);
        if (wid == 0) { unsigned sp = 0;
            while ((unsigned)__builtin_amdgcn_readfirstlane(__hip_atomic_load(cnt + 64 * u.pm, __ATOMIC_RELAXED, __HIP_MEMORY_SCOPE_AGENT)) < 32u) { __builtin_amdgcn_s_sleep(2); if (++sp > (1u << 22)) break; }
            __builtin_amdgcn_fence(__ATOMIC_ACQUIRE, "agent"); }
        asm volatile("s_waitcnt vmcnt(0) lgkmcnt(0)" ::: "memory"); __builtin_amdgcn_s_barrier(); asm volatile("" ::: "memory");
        if (lane < 32) { const float* slot = xbuf + (size_t)(u.pm * BM + row) * 4; float t = 0.f;
#pragma unroll
            for (int q = 0; q < 4; ++q) t += __hip_atomic_load(slot + q, __ATOMIC_RELAXED, __HIP_MEMORY_SCOPE_AGENT);
            S[row] = rsqrtf(t * (1.0f / 1024.0f) + 1e-6f); }
        asm volatile("s_waitcnt lgkmcnt(0)" ::: "memory"); __builtin_amdgcn_s_barrier(); asm volatile("" ::: "memory");
        f32x4 gv[2][2];
#pragma unroll
        for (int bj = 0; bj < 2; ++bj)
#pragma unroll
            for (int n = 0; n < 2; ++n) gv[bj][n] = *(const f32x4*)(gain + col0 + bj * HALF + n * 16);
#pragma unroll
        for (int ai = 0; ai < 2; ++ai)
#pragma unroll
            for (int m = 0; m < 4; ++m) { const int r = ai * HALF + wr * 64 + m * 16 + fr; const float rs = S[r]; const size_t off = (size_t)(u.pm * BM + r) * 1024 + col0;
#pragma unroll
                for (int bj = 0; bj < 2; ++bj)
#pragma unroll
                    for (int n = 0; n < 2; ++n) { const f32x4 v = acc[ai][bj][m][n]; const f32x4 o = v * rs * gv[bj][n];
                        if (Hout) *(f32x4*)(Hout + off + bj * HALF + n * 16) = v;
                        if (Nf) *(f32x4*)(Nf + off + bj * HALF + n * 16) = o;
                        if (Nb) { u32x2 w; w.x = cvt_pk_bf16(o[0], o[1]); w.y = cvt_pk_bf16(o[2], o[3]); *(u32x2*)(Nb + off + bj * HALF + n * 16) = w; } } }
    }
};

template <class Epi, class Sched, bool ALIGN_EPI = false, bool SP2 = false>
__device__ __forceinline__ void gemm_phase(PG8_LAS unsigned char* lds, const Gemm g, const Sched& S, const Epi& E) {
    const int tid = threadIdx.x, wid = __builtin_amdgcn_readfirstlane(tid >> 6), lane = tid & 63, wr = wid >> 2, wc = wid & 3, fr = lane & 15, fq = lane >> 4;
    const int K = g.K, nt = K / BK;
    unsigned voffA[2], voffB[2];
#pragma unroll
    for (int i = 0; i < 2; ++i) { int R, C; stage_rc(tid * 16 + i * 8192, R, C); const int Rb = Epi::PERM ? ((R & ~31) + perm32(R & 31)) : R;
        voffA[i] = (unsigned)(R * K + C) * 2u; voffB[i] = (unsigned)(Rb * K + C) * 2u; }
    const size_t kstep = (size_t)(BK * 2);
    const size_t hstep = (size_t)HALF * K * 2;
    const size_t tstep = 2 * hstep;
    const unsigned ldsw = (unsigned)wid * 1024u;
    const int aoff = lds_byte(wr * 64 + fr, fq * 8), boff = lds_byte(wc * 32 + fr, fq * 8);
#define PG8_SA(b, h) (((b) * 2 + (h)) * HTB)
#define PG8_SB(b, h) ((4 + (b) * 2 + (h)) * HTB)
#define PG8_STAGE(bufoff, gbase, voff) do { _Pragma("unroll") for (int _i = 0; _i < 2; ++_i) \
        __builtin_amdgcn_global_load_lds((const unsigned*)((const char*)(gbase) + (voff)[_i]), (PG8_LAS unsigned*)(lds + (bufoff) + ldsw + _i * 8192), 16, 0, 0); } while (0)
#define PG8_LDA(dst, b, h) do { _Pragma("unroll") for (int m = 0; m < 4; ++m) _Pragma("unroll") for (int k = 0; k < 2; ++k) dst[m][k] = *(const PG8_LAS bf16x8*)(lds + PG8_SA(b, h) + aoff + m * 2048 + k * 1024); } while (0)
#define PG8_LDB(dst, b, h) do { _Pragma("unroll") for (int n = 0; n < 2; ++n) _Pragma("unroll") for (int k = 0; k < 2; ++k) dst[n][k] = *(const PG8_LAS bf16x8*)(lds + PG8_SB(b, h) + boff + n * 2048 + k * 1024); } while (0)
#define PG8_MMA(ai, bj, At, Bt) do { __builtin_amdgcn_s_setprio(1); _Pragma("unroll") for (int m = 0; m < 4; ++m) _Pragma("unroll") for (int n = 0; n < 2; ++n) _Pragma("unroll") for (int k = 0; k < 2; ++k) \
        acc[ai][bj][m][n] = __builtin_amdgcn_mfma_f32_16x16x32_bf16(Bt[n][k], At[m][k], acc[ai][bj][m][n], 0, 0, 0); __builtin_amdgcn_s_setprio(0); } while (0)
#define PG8_WAIT_V(n) asm volatile("s_waitcnt vmcnt(" #n ")" ::: "memory")
#define PG8_WAIT_L(n) asm volatile("s_waitcnt lgkmcnt(" #n ")" ::: "memory")
#define PG8_BAR __builtin_amdgcn_s_barrier()
#define PG8_SCHED __builtin_amdgcn_sched_barrier(0)
    Unit cur, nxt; int ui = 0;
    if (!S.next(0, cur)) return;
    f32x4 acc[2][2][4][2];
#pragma unroll
    for (int a = 0; a < 2; ++a)
#pragma unroll
        for (int b = 0; b < 2; ++b)
#pragma unroll
            for (int m = 0; m < 4; ++m)
#pragma unroll
                for (int n = 0; n < 2; ++n) acc[a][b][m][n] = (f32x4){0.f, 0.f, 0.f, 0.f};
    bf16x8 At[4][2], B0[2][2], B1[2][2];
    const char* cA = S.pa(g, cur, tstep); const char* cB = S.pb(g, cur, tstep);
    S.a_ready(cur);
    if constexpr (SP2) {
        PG8_STAGE(PG8_SB(0, 0), cB, voffB); PG8_STAGE(PG8_SB(0, 1), cB + hstep, voffB); PG8_STAGE(PG8_SA(0, 0), cA, voffA); PG8_STAGE(PG8_SA(0, 1), cA + hstep, voffA);
        if (wr == 1) PG8_BAR;
        PG8_WAIT_V(2); PG8_BAR;
        PG8_STAGE(PG8_SB(1, 0), cB + kstep, voffB); PG8_STAGE(PG8_SA(1, 0), cA + kstep, voffA); PG8_STAGE(PG8_SB(1, 1), cB + hstep + kstep, voffB);
        PG8_WAIT_V(6); PG8_BAR;
    } else {
        PG8_STAGE(PG8_SB(0, 0), cB, voffB); PG8_STAGE(PG8_SA(0, 0), cA, voffA); PG8_STAGE(PG8_SB(0, 1), cB + hstep, voffB); PG8_STAGE(PG8_SA(0, 1), cA + hstep, voffA);
        if (wr == 1) PG8_BAR;
        PG8_WAIT_V(4); PG8_BAR;
        PG8_STAGE(PG8_SB(1, 0), cB + kstep, voffB); PG8_STAGE(PG8_SA(1, 0), cA + kstep, voffA); PG8_STAGE(PG8_SB(1, 1), cB + hstep + kstep, voffB);
        PG8_WAIT_V(6); PG8_BAR;
    }
    for (;;) {
        const bool has_next = S.next(ui + 1, nxt);
        const char* nA = has_next ? S.pa(g, nxt, tstep) : cA; const char* nB = has_next ? S.pb(g, nxt, tstep) : cB;
        for (int t = 0; t < nt; t += 2) {
            const bool last = (t == nt - 2);
            const char* a1 = cA + (size_t)(t + 1) * kstep;
            const char* a2 = last ? nA : cA + (size_t)(t + 2) * kstep; const char* b2 = last ? nB : cB + (size_t)(t + 2) * kstep;
            const char* a3 = a2 + kstep; const char* b3 = b2 + kstep;
            if (last && has_next) S.a_ready(nxt);
            if constexpr (SP2) {
            PG8_LDB(B0, 0, 0); PG8_LDB(B1, 0, 1); PG8_SCHED; PG8_LDA(At, 0, 0); PG8_STAGE(PG8_SA(1, 1), a1 + hstep, voffA);
            PG8_WAIT_V(8); PG8_WAIT_L(0); PG8_BAR; PG8_MMA(0, 0, At, B0); PG8_MMA(0, 1, At, B1); PG8_BAR; PG8_SCHED;
            PG8_LDA(At, 0, 1); PG8_STAGE(PG8_SB(0, 0), b2, voffB); PG8_STAGE(PG8_SB(0, 1), b2 + hstep, voffB); PG8_STAGE(PG8_SA(0, 0), a2, voffA);
            PG8_WAIT_V(8); PG8_WAIT_L(0); PG8_BAR; PG8_MMA(1, 0, At, B0); PG8_MMA(1, 1, At, B1); PG8_BAR; PG8_SCHED;
            PG8_LDB(B0, 1, 0); PG8_LDB(B1, 1, 1); PG8_SCHED; PG8_LDA(At, 1, 0); PG8_STAGE(PG8_SA(0, 1), a2 + hstep, voffA);
            PG8_WAIT_V(8); PG8_WAIT_L(0); PG8_BAR; PG8_MMA(0, 0, At, B0); PG8_MMA(0, 1, At, B1); PG8_BAR; PG8_SCHED;
            PG8_LDA(At, 1, 1); PG8_STAGE(PG8_SB(1, 0), b3, voffB); PG8_STAGE(PG8_SB(1, 1), b3 + hstep, voffB); PG8_STAGE(PG8_SA(1, 0), a3, voffA);
            PG8_WAIT_V(8); PG8_WAIT_L(0); PG8_BAR; PG8_MMA(1, 0, At, B0); PG8_MMA(1, 1, At, B1); PG8_BAR; PG8_SCHED;
            } else {
            PG8_LDB(B0, 0, 0); PG8_SCHED; PG8_LDA(At, 0, 0); PG8_STAGE(PG8_SA(1, 1), a1 + hstep, voffA);
            PG8_WAIT_L(8); PG8_BAR; PG8_WAIT_L(0); PG8_MMA(0, 0, At, B0); PG8_BAR; PG8_SCHED;
            PG8_LDB(B1, 0, 1); PG8_STAGE(PG8_SB(0, 0), b2, voffB);
            PG8_BAR; PG8_WAIT_L(0); PG8_MMA(0, 1, At, B1); PG8_BAR;
            PG8_LDA(At, 0, 1); PG8_STAGE(PG8_SA(0, 0), a2, voffA);
            PG8_BAR; PG8_WAIT_L(0); PG8_MMA(1, 0, At, B0); PG8_BAR; PG8_SCHED;
            PG8_STAGE(PG8_SB(0, 1), b2 + hstep, voffB);
            PG8_WAIT_V(6); PG8_BAR; PG8_MMA(1, 1, At, B1); PG8_BAR;
            PG8_LDB(B0, 1, 0); PG8_SCHED; PG8_LDA(At, 1, 0); PG8_STAGE(PG8_SA(0, 1), a2 + hstep, voffA);
            PG8_WAIT_L(8); PG8_BAR; PG8_WAIT_L(0); PG8_MMA(0, 0, At, B0); PG8_BAR; PG8_SCHED;
            PG8_LDB(B1, 1, 1); PG8_STAGE(PG8_SB(1, 0), b3, voffB);
            PG8_BAR; PG8_WAIT_L(0); PG8_MMA(0, 1, At, B1); PG8_BAR;
            PG8_LDA(At, 1, 1); PG8_STAGE(PG8_SA(1, 0), a3, voffA);
            PG8_BAR; PG8_WAIT_L(0); PG8_MMA(1, 0, At, B0); PG8_BAR; PG8_SCHED;
            PG8_STAGE(PG8_SB(1, 1), b3 + hstep, voffB);
            PG8_WAIT_V(6); PG8_BAR; PG8_MMA(1, 1, At, B1); PG8_BAR;
            }
        }
        if constexpr (ALIGN_EPI) { if (wr == 0) PG8_BAR; }
        if constexpr (!Epi::AFTER_DRAIN) { E(acc, cur, wr, wc, fr, fq); S.done(cur); }
        if (!has_next) break;
#pragma unroll
        for (int a = 0; a < 2; ++a)
#pragma unroll
            for (int b = 0; b < 2; ++b)
#pragma unroll
                for (int m = 0; m < 4; ++m)
#pragma unroll
                    for (int n = 0; n < 2; ++n) acc[a][b][m][n] = (f32x4){0.f, 0.f, 0.f, 0.f};
        cur = nxt; cA = nA; cB = nB; ++ui;
        if constexpr (ALIGN_EPI) { if (wr == 1) PG8_BAR; }
    }
    PG8_WAIT_V(0);
    if constexpr (!ALIGN_EPI) { if (wr == 0) PG8_BAR; }
    PG8_BAR;
    if constexpr (Epi::AFTER_DRAIN) { E.fused(acc, cur, wr, wc, fr, fq, lds, wid, lane); S.done(cur); }
#undef PG8_SA
#undef PG8_SB
#undef PG8_STAGE
#undef PG8_LDA
#undef PG8_LDB
#undef PG8_MMA
#undef PG8_WAIT_V
#undef PG8_WAIT_L
#undef PG8_BAR
#undef PG8_SCHED
}
}

namespace nsa {
#define NLAS __attribute__((address_space(3)))
typedef short bf16x8 __attribute__((ext_vector_type(8)));
typedef short s16x4 __attribute__((ext_vector_type(4)));
typedef short v4i16_t __attribute__((ext_vector_type(4)));
typedef float f32x4 __attribute__((ext_vector_type(4)));
typedef unsigned u32x4 __attribute__((ext_vector_type(4)));
typedef unsigned u32x2 __attribute__((ext_vector_type(2)));
typedef unsigned long long u64;
constexpr int RS = 144, TILE_B = 64 * RS;
constexpr float LOG2E = 1.4426950408889634f;
constexpr int L_KB0 = 0, L_VB0 = TILE_B, L_KB1 = 2 * TILE_B, L_VB1 = 3 * TILE_B, L_CK = 4 * TILE_B, L_CV = 8 * TILE_B, L_IMP = 12 * TILE_B, L_MSK = L_IMP + 8192, L_WU = L_MSK + 256, L_END = L_WU + 64;
static_assert(L_END <= 131072, "nsa LDS map");
__device__ __forceinline__ s16x4 vtr(const NLAS char* p) { return __builtin_bit_cast(s16x4, __builtin_amdgcn_ds_read_tr16_b64_v4i16((NLAS v4i16_t*)p)); }
__device__ __forceinline__ f32x4 mfma16(bf16x8 a, bf16x8 b, f32x4 c) { return __builtin_amdgcn_mfma_f32_16x16x32_bf16(a, b, c, 0, 0, 0); }
__device__ __forceinline__ unsigned pkbf(float lo, float hi) { return pg8::cvt_pk_bf16(lo, hi); }
__device__ __forceinline__ void qk_tile(f32x4 (&s)[4], const NLAS char* Kb, const bf16x8 (&qf)[2], int i, int g, float kslope, float bt) {
    bf16x8 a[4][2]; const NLAS char* kp = Kb + i * RS + 16 * g;
#pragma unroll
    for (int kb = 0; kb < 4; ++kb) { a[kb][0] = *(const NLAS bf16x8*)(kp + kb * 16 * RS); a[kb][1] = *(const NLAS bf16x8*)(kp + kb * 16 * RS + 64); }
#pragma unroll
    for (int kb = 0; kb < 4; ++kb) { f32x4 ci; ci[0] = fmaf(kslope, (float)(kb * 16 + 0), bt); ci[1] = fmaf(kslope, (float)(kb * 16 + 1), bt); ci[2] = fmaf(kslope, (float)(kb * 16 + 2), bt); ci[3] = fmaf(kslope, (float)(kb * 16 + 3), bt);
        s[kb] = mfma16(a[kb][0], qf[0], ci); }
#pragma unroll
    for (int kb = 0; kb < 4; ++kb) s[kb] = mfma16(a[kb][1], qf[1], s[kb]);
}
__device__ __forceinline__ void pv_tile(f32x4 (&o)[4], const NLAS char* Vb, const f32x4 (&p)[4], int i, int g) {
    const NLAS char* vb = Vb + (4 * g + (i >> 2)) * RS + (i & 3) * 8;
    s16x4 lo[2][4], hi[2][4];
#pragma unroll
    for (int kk = 0; kk < 2; ++kk)
#pragma unroll
        for (int db = 0; db < 4; ++db) { const NLAS char* vp = vb + (2 * kk) * 16 * RS + db * 32; lo[kk][db] = vtr(vp); hi[kk][db] = vtr(vp + 16 * RS); }
    bf16x8 pf[2];
#pragma unroll
    for (int kk = 0; kk < 2; ++kk) { u32x4 pw; pw.x = pkbf(p[2 * kk][0], p[2 * kk][1]); pw.y = pkbf(p[2 * kk][2], p[2 * kk][3]); pw.z = pkbf(p[2 * kk + 1][0], p[2 * kk + 1][1]); pw.w = pkbf(p[2 * kk + 1][2], p[2 * kk + 1][3]);
        pf[kk] = __builtin_bit_cast(bf16x8, pw); }
#pragma unroll
    for (int kk = 0; kk < 2; ++kk)
#pragma unroll
        for (int db = 0; db < 4; ++db) o[db] = mfma16((bf16x8){lo[kk][db][0], lo[kk][db][1], lo[kk][db][2], lo[kk][db][3], hi[kk][db][0], hi[kk][db][1], hi[kk][db][2], hi[kk][db][3]}, pf[kk], o[db]);
}
constexpr float THR = 6.0f;
template <bool FIRST>
__device__ __forceinline__ float online_tile(f32x4 (&s)[4], float& m, float& l, f32x4 (&o)[4], bool needmask, int base, int lo, int hi) {
    float fret = 1.f;
    if (needmask) {
#pragma unroll
        for (int kb = 0; kb < 4; ++kb)
#pragma unroll
            for (int r = 0; r < 4; ++r) { const int pos = base + kb * 16 + r; s[kb][r] = (pos >= lo && pos <= hi) ? s[kb][r] : -INFINITY; } }
    float mt = fmaxf(fmaxf(fmaxf(s[0][0], s[0][1]), fmaxf(s[0][2], s[0][3])), fmaxf(fmaxf(s[1][0], s[1][1]), fmaxf(s[1][2], s[1][3])));
    mt = fmaxf(mt, fmaxf(fmaxf(fmaxf(s[2][0], s[2][1]), fmaxf(s[2][2], s[2][3])), fmaxf(fmaxf(s[3][0], s[3][1]), fmaxf(s[3][2], s[3][3]))));
    if (FIRST || __any(mt > THR)) {
        mt = fmaxf(mt, __shfl_xor(mt, 16)); mt = fmaxf(mt, __shfl_xor(mt, 32));
        const float d = FIRST ? ((mt == -INFINITY) ? 0.f : mt) : fmaxf(mt, 0.f), f = __builtin_amdgcn_exp2f(-d); m += d; l *= f; fret = f;
#pragma unroll
        for (int db = 0; db < 4; ++db) o[db] = o[db] * f;
#pragma unroll
        for (int kb = 0; kb < 4; ++kb) s[kb] = s[kb] - d; }
    float sum = 0.f;
#pragma unroll
    for (int kb = 0; kb < 4; ++kb)
#pragma unroll
        for (int r = 0; r < 4; ++r) { const float p = __builtin_amdgcn_exp2f(s[kb][r]); s[kb][r] = p; sum += p; }
    l += sum;
    return fret;
}
struct Stg { u32x4 k, v; };
__device__ __forceinline__ void stg_load(Stg& r, const bf16_t* kb, const bf16_t* vb, size_t pitch, int tid) { const size_t off = (size_t)(tid >> 3) * pitch + (tid & 7) * 8; r.k = *(const u32x4*)(kb + off); r.v = *(const u32x4*)(vb + off); }
__device__ __forceinline__ void stg_store(NLAS char* lds, int ko, int vo, const Stg& r, int tid) { const int off = (tid >> 3) * RS + (tid & 7) * 16; *(NLAS u32x4*)(lds + ko + off) = r.k; *(NLAS u32x4*)(lds + vo + off) = r.v; }
template <bool FIRST>
__device__ __forceinline__ void pair_tiles(const NLAS char* lds, int koA, int voA, int koB, int voB, bool na, bool nb, const bf16x8 (&qf)[2], int i, int g, float slope2,
                                           float btA, float btB, bool maskA, bool maskB, int baseA, int baseB, int lo, int hi, float& m, float& l, f32x4 (&o)[4]) {
    f32x4 sa[4], sb[4];
    if (na) qk_tile(sa, lds + koA, qf, i, g, slope2, btA - m);
    if (nb) qk_tile(sb, lds + koB, qf, i, g, slope2, btB - m);
    float da = 0.f;
    if (na) { const float m0 = m; online_tile<FIRST>(sa, m, l, o, FIRST || maskA, baseA, lo, hi); da = m - m0; pv_tile(o, lds + voA, sa, i, g); }
    if (nb) { if (__any(da != 0.f)) {
#pragma unroll
            for (int kb = 0; kb < 4; ++kb) sb[kb] = sb[kb] - da; }
        online_tile<false>(sb, m, l, o, maskB, baseB, lo, hi); pv_tile(o, lds + voB, sb, i, g); }
}
__device__ __forceinline__ float sigm(float v) { return __builtin_amdgcn_rcpf(1.f + __expf(-v)); }

__device__ __forceinline__ void unit(NLAS char* lds, const bf16_t* P, const float* S32, const bf16_t* KC, const bf16_t* VC, bf16_t* Ynsa, int b, int gq, int ti) {
    const int tid = threadIdx.x, lane = tid & 63, w = __builtin_amdgcn_readfirstlane(tid >> 6), i = lane & 15, g = lane >> 4;
    const int t0 = ti * 32, tl_mine = i >> 2, r = i & 3, h = gq * 4 + r, t = t0 + 4 * w + tl_mine; const size_t m = (size_t)b * T + t;
    const float slope2 = __builtin_amdgcn_exp2f(-(float)(h + 1)) * LOG2E;
    bf16x8 qf[2]; constexpr float QS = 0.125f * LOG2E;
    { const bf16_t* qp = P + m * PW + P_NSQ + h * 64 + 8 * g;
#pragma unroll
      for (int ks = 0; ks < 2; ++ks) { const u32x4 raw = *(const u32x4*)(qp + 32 * ks); u32x4 sc;
          sc.x = pkbf(pg8::bflo(raw.x) * QS, pg8::bfhi(raw.x) * QS); sc.y = pkbf(pg8::bflo(raw.y) * QS, pg8::bfhi(raw.y) * QS);
          sc.z = pkbf(pg8::bflo(raw.z) * QS, pg8::bfhi(raw.z) * QS); sc.w = pkbf(pg8::bflo(raw.w) * QS, pg8::bfhi(raw.w) * QS);
          qf[ks] = __builtin_bit_cast(bf16x8, sc); } }
    const float* gp = S32 + m * 32 + 8 + h * 3;
    const float gate0 = sigm(gp[0]), gate1 = sigm(gp[1]), gate2 = sigm(gp[2]);
    f32x4 outacc[4];
#pragma unroll
    for (int db = 0; db < 4; ++db) outacc[db] = (f32x4){0.f, 0.f, 0.f, 0.f};
    const int ntc = (ti >> 5) + 1;
    { Stg sc_[4];
#pragma unroll
      for (int tile = 0; tile < 4; ++tile) if (tile < ntc) { const size_t row0 = ((size_t)(b * 256 + tile * 64) * 2 + gq) * 64; stg_load(sc_[tile], KC + row0, VC + row0, 128, tid); }
#pragma unroll
      for (int tile = 0; tile < 4; ++tile) if (tile < ntc) stg_store(lds, L_CK + tile * TILE_B, L_CV + tile * TILE_B, sc_[tile], tid); }
    __syncthreads();
    { const int nmax = (t - 31) >> 4, nmax_w = ((t0 + 4 * w) - 31) >> 4; const float kslope = 16.f * slope2, c = -slope2 * (float)(t - 31);
      float mc = 0.f, lc = 0.f; f32x4 oc[4]; float av[16], cv[16];
#pragma unroll
      for (int db = 0; db < 4; ++db) oc[db] = (f32x4){0.f, 0.f, 0.f, 0.f};
#pragma unroll
      for (int q = 0; q < 16; ++q) { av[q] = 0.f; cv[q] = 0.f; }
      bool firstc = true;
#pragma unroll
      for (int tile = 3; tile >= 0; --tile) {
          if (tile < ntc) { f32x4 s[4]; qk_tile(s, lds + L_CK + tile * TILE_B, qf, i, g, kslope, fmaf(kslope, (float)(tile * 64 + 4 * g), c) - mc);
              const bool needmask = (tile * 64 + 63 > nmax_w);
              const float f = firstc ? online_tile<true>(s, mc, lc, oc, needmask, tile * 64 + 4 * g, -0x40000000, nmax) : online_tile<false>(s, mc, lc, oc, needmask, tile * 64 + 4 * g, -0x40000000, nmax);
              if (!firstc && __any(f != 1.f)) {
#pragma unroll
                  for (int q = 0; q < 16; ++q) { av[q] *= f; cv[q] *= f; } }
              firstc = false;
              pv_tile(oc, lds + L_CV + tile * TILE_B, s, i, g);
#pragma unroll
              for (int kb = 0; kb < 4; ++kb) { const f32x4 pv = s[kb];
                  float a = (pv[0] + pv[1]) + (pv[2] + pv[3]), cc = pv[3];
                  a += __shfl_xor(a, 1); a += __shfl_xor(a, 2); cc += __shfl_xor(cc, 1); cc += __shfl_xor(cc, 2);
                  av[tile * 4 + kb] = a; cv[tile * 4 + kb] = cc; } }
      }
      lc += __shfl_xor(lc, 16); lc += __shfl_xor(lc, 32);
      const float inv = lc > 0.f ? 1.f / lc : 0.f, g0i = gate0 * inv;
#pragma unroll
      for (int db = 0; db < 4; ++db) outacc[db] = outacc[db] + oc[db] * g0i;
      NLAS float* imp_s = (NLAS float*)(lds + L_IMP) + (w * 4 + tl_mine) * 64;
      float cprev = 0.f;
#pragma unroll
      for (int q = 0; q < 16; ++q) { const float up = __shfl(cv[q], (lane + 48) & 63); const float im = (av[q] + (g > 0 ? up : cprev)) * inv; cprev = up; if (r == 0) imp_s[4 * q + g] = im; }
    }
    NLAS float* impw = (NLAS float*)(lds + L_IMP) + w * 256;
    float myscore[4];
    asm volatile("s_waitcnt lgkmcnt(0)" ::: "memory");
#pragma unroll
    for (int tl = 0; tl < 4; ++tl) { const int tt = t0 + 4 * w + tl, cur = tt >> 6, j = lane; const bool valid = j <= cur, forced = (j == 0) || (j == cur) || (j == cur - 1);
        const float s = valid ? impw[tl * 64 + j] + (forced ? 1000.f : 0.f) : -1e30f; myscore[tl] = s; }
    asm volatile("s_waitcnt lgkmcnt(0)" ::: "memory");
#pragma unroll
    for (int tl = 0; tl < 4; ++tl) impw[tl * 64 + lane] = myscore[tl];
    asm volatile("s_waitcnt lgkmcnt(0)" ::: "memory");
    u64 wmask[4], wun = 0ull;
#pragma unroll
    for (int tl = 0; tl < 4; ++tl) { const int tt = t0 + 4 * w + tl, cur = tt >> 6; const float s = myscore[tl]; int rank = 0;
        for (int jj = 0; jj < 64; ++jj) { const float o = impw[tl * 64 + jj]; rank += (o > s || (o == s && jj < lane)) ? 1 : 0; }
        wmask[tl] = __ballot(rank < 16 && lane <= cur); wun |= wmask[tl]; }
    if (lane == 0) { NLAS u64* mk = (NLAS u64*)(lds + L_MSK) + w * 4; mk[0] = wmask[0]; mk[1] = wmask[1]; mk[2] = wmask[2]; mk[3] = wmask[3]; ((NLAS u64*)(lds + L_WU))[w] = wun; }
    __syncthreads();
    const u64 mymask = ((const NLAS u64*)(lds + L_MSK))[w * 4 + tl_mine];
    u64 uall = 0ull;
#pragma unroll
    for (int ww = 0; ww < 8; ++ww) uall |= ((const NLAS u64*)(lds + L_WU))[ww];
    uall = ((u64)__builtin_amdgcn_readfirstlane((unsigned)(uall >> 32)) << 32) | (u64)__builtin_amdgcn_readfirstlane((unsigned)uall);
    const size_t rowb = (size_t)b * T;
    {
        float ms_ = 0.f, ls = 0.f; f32x4 os[4];
#pragma unroll
        for (int db = 0; db < 4; ++db) os[db] = (f32x4){0.f, 0.f, 0.f, 0.f};
        const bf16_t* kcol = P + rowb * PW + P_KS + gq * 64; const bf16_t* vcol = P + rowb * PW + P_VS + gq * 64;
        const float c = -slope2 * (float)t;
        const int jcur = t0 >> 6;
        u64 rem = uall & ((1ull << jcur) - 1ull);
#define NSA_NEXT(dst) { dst = rem ? 63 - __builtin_clzll(rem) : -1; if (dst >= 0) rem &= ~(1ull << dst); }
#define NSA_KO(p, h) ((p) ? L_CK + (h) * TILE_B : ((h) ? L_KB1 : L_KB0))
#define NSA_VO(p, h) ((p) ? L_CV + (h) * TILE_B : ((h) ? L_VB1 : L_VB0))
        int ja = jcur, jb, na_, nb_, cur = 0; bool first = true;
        NSA_NEXT(jb)
        Stg sr0, sr1;
        stg_load(sr0, kcol + (size_t)ja * 64 * PW, vcol + (size_t)ja * 64 * PW, PW, tid); stg_store(lds, L_KB0, L_VB0, sr0, tid);
        if (jb >= 0) { stg_load(sr1, kcol + (size_t)jb * 64 * PW, vcol + (size_t)jb * 64 * PW, PW, tid); stg_store(lds, L_KB1, L_VB1, sr1, tid); }
        NSA_NEXT(na_) NSA_NEXT(nb_)
        if (na_ >= 0) stg_load(sr0, kcol + (size_t)na_ * 64 * PW, vcol + (size_t)na_ * 64 * PW, PW, tid);
        if (nb_ >= 0) stg_load(sr1, kcol + (size_t)nb_ * 64 * PW, vcol + (size_t)nb_ * 64 * PW, PW, tid);
        __syncthreads();
        for (;;) {
            if (na_ >= 0) stg_store(lds, NSA_KO(cur ^ 1, 0), NSA_VO(cur ^ 1, 0), sr0, tid);
            if (nb_ >= 0) stg_store(lds, NSA_KO(cur ^ 1, 1), NSA_VO(cur ^ 1, 1), sr1, tid);
            int nna, nnb; NSA_NEXT(nna) NSA_NEXT(nnb)
            if (nna >= 0) stg_load(sr0, kcol + (size_t)nna * 64 * PW, vcol + (size_t)nna * 64 * PW, PW, tid);
            if (nnb >= 0) stg_load(sr1, kcol + (size_t)nnb * 64 * PW, vcol + (size_t)nnb * 64 * PW, PW, tid);
            const bool na = (wun >> ja) & 1ull, nb = (jb >= 0) && ((wun >> jb) & 1ull);
            if (na || nb) {
                const float btA = fmaf(slope2, (float)(ja * 64 + 4 * g), c) + (((mymask >> ja) & 1ull) ? 0.f : -1e30f);
                const float btB = fmaf(slope2, (float)((jb < 0 ? 0 : jb) * 64 + 4 * g), c) + ((jb >= 0 && ((mymask >> jb) & 1ull)) ? 0.f : -1e30f);
                if (first) pair_tiles<true>(lds, NSA_KO(cur, 0), NSA_VO(cur, 0), NSA_KO(cur, 1), NSA_VO(cur, 1), na, nb, qf, i, g, slope2, btA, btB, true, false, ja * 64 + 4 * g, 0, 0, t, ms_, ls, os);
                else pair_tiles<false>(lds, NSA_KO(cur, 0), NSA_VO(cur, 0), NSA_KO(cur, 1), NSA_VO(cur, 1), na, nb, qf, i, g, slope2, btA, btB, false, false, 0, 0, 0, t, ms_, ls, os); }
            first = false;
            __syncthreads();
            if (na_ < 0) break;
            ja = na_; jb = nb_; na_ = nna; nb_ = nnb; cur ^= 1;
        }
        ls += __shfl_xor(ls, 16); ls += __shfl_xor(ls, 32);
        const float sc1 = gate1 / ls;
#pragma unroll
        for (int db = 0; db < 4; ++db) outacc[db] = outacc[db] + os[db] * sc1;
    }
    {
        float mw = 0.f, lw = 0.f; f32x4 ow[4];
#pragma unroll
        for (int db = 0; db < 4; ++db) ow[db] = (f32x4){0.f, 0.f, 0.f, 0.f};
        const bf16_t* kcol = P + rowb * PW + P_KW + gq * 64; const bf16_t* vcol = P + rowb * PW + P_VW + gq * 64;
        const float c = -slope2 * (float)t;
        const int j0 = (t0 - 511) > 0 ? ((t0 - 511) >> 6) : 0, j1 = t0 >> 6, tw0 = t0 + 4 * w;
        int ja = j1, cur = 0; bool first = true;
        Stg sr0, sr1;
        stg_load(sr0, kcol + (size_t)ja * 64 * PW, vcol + (size_t)ja * 64 * PW, PW, tid); stg_store(lds, L_KB0, L_VB0, sr0, tid);
        if (ja - 1 >= j0) { stg_load(sr1, kcol + (size_t)(ja - 1) * 64 * PW, vcol + (size_t)(ja - 1) * 64 * PW, PW, tid); stg_store(lds, L_KB1, L_VB1, sr1, tid); }
        if (ja - 2 >= j0) stg_load(sr0, kcol + (size_t)(ja - 2) * 64 * PW, vcol + (size_t)(ja - 2) * 64 * PW, PW, tid);
        if (ja - 3 >= j0) stg_load(sr1, kcol + (size_t)(ja - 3) * 64 * PW, vcol + (size_t)(ja - 3) * 64 * PW, PW, tid);
        __syncthreads();
        for (;;) {
            if (ja - 2 >= j0) stg_store(lds, NSA_KO(cur ^ 1, 0), NSA_VO(cur ^ 1, 0), sr0, tid);
            if (ja - 3 >= j0) stg_store(lds, NSA_KO(cur ^ 1, 1), NSA_VO(cur ^ 1, 1), sr1, tid);
            if (ja - 4 >= j0) stg_load(sr0, kcol + (size_t)(ja - 4) * 64 * PW, vcol + (size_t)(ja - 4) * 64 * PW, PW, tid);
            if (ja - 5 >= j0) stg_load(sr1, kcol + (size_t)(ja - 5) * 64 * PW, vcol + (size_t)(ja - 5) * 64 * PW, PW, tid);
            const int jb = ja - 1;
            const bool na = (64 * ja <= tw0 + 3) && (64 * ja + 63 >= tw0 - 511), nb = (jb >= j0) && (64 * jb <= tw0 + 3) && (64 * jb + 63 >= tw0 - 511);
            if (na || nb) {
                const float btA = fmaf(slope2, (float)(ja * 64 + 4 * g), c), btB = fmaf(slope2, (float)(jb * 64 + 4 * g), c);
                const bool maskA = (64 * ja < tw0 + 3 - 511), maskB = (64 * jb < tw0 + 3 - 511);
                if (first) pair_tiles<true>(lds, NSA_KO(cur, 0), NSA_VO(cur, 0), NSA_KO(cur, 1), NSA_VO(cur, 1), na, nb, qf, i, g, slope2, btA, btB, true, maskB, ja * 64 + 4 * g, jb * 64 + 4 * g, t - 511, t, mw, lw, ow);
                else pair_tiles<false>(lds, NSA_KO(cur, 0), NSA_VO(cur, 0), NSA_KO(cur, 1), NSA_VO(cur, 1), na, nb, qf, i, g, slope2, btA, btB, maskA, maskB, ja * 64 + 4 * g, jb * 64 + 4 * g, t - 511, t, mw, lw, ow); }
            first = false;
            __syncthreads();
            if (ja - 2 < j0) break;
            ja -= 2; cur ^= 1;
        }
        lw += __shfl_xor(lw, 16); lw += __shfl_xor(lw, 32);
        const float sc2 = gate2 / lw;
#pragma unroll
        for (int db = 0; db < 4; ++db) outacc[db] = outacc[db] + ow[db] * sc2;
    }
    bf16_t* yo = Ynsa + m * 512 + h * 64 + 4 * g;
#pragma unroll
    for (int db = 0; db < 4; ++db) { u32x2 v; v.x = pkbf(outacc[db][0], outacc[db][1]); v.y = pkbf(outacc[db][2], outacc[db][3]); *(u32x2*)(yo + db * 16) = v; }
}
__device__ __forceinline__ void phase(NLAS char* lds, const bf16_t* P, const float* S32, const bf16_t* KC, const bf16_t* VC, bf16_t* Ynsa) {
    const int G = gridDim.x, bid = blockIdx.x;
    if (G == 256) { const int base = bid >> 3, bg = bid & 7;
#pragma unroll 1
        for (int k = 0; k < 4; ++k) { const int ti = (k == 0) ? 127 - base : (k == 1) ? 64 + base : (k == 2) ? 63 - base : base; unit(lds, P, S32, KC, VC, Ynsa, bg >> 1, bg & 1, ti); } }
    else {
#pragma unroll 1
        for (int u = bid; u < 1024; u += G) unit(lds, P, S32, KC, VC, Ynsa, (u & 7) >> 1, u & 1, 127 - (u >> 3)); }
}
}

namespace xa {
using nsa::bf16x8; using nsa::s16x4; using nsa::f32x4; using nsa::u32x4; using nsa::u32x2; using nsa::vtr; using nsa::mfma16; using nsa::pkbf;
constexpr int RS = 272, TILE_B = 64 * RS;
__device__ __forceinline__ int l_k(int tile) { return tile * 2 * TILE_B; }
__device__ __forceinline__ int l_v(int tile) { return tile * 2 * TILE_B + TILE_B; }
__device__ __forceinline__ void unit(NLAS char* lds, const bf16_t* P, const bf16_t* MEMKV, bf16_t* Yxa, int b, int h, int tt) {
    const int tid = threadIdx.x, lane = tid & 63, w = __builtin_amdgcn_readfirstlane(tid >> 6), i = lane & 15, g = lane >> 4;
    const size_t m = (size_t)b * T + tt * 128 + 16 * w + i;
    const bf16_t* kbase = MEMKV + (size_t)b * 256 * 1024 + h * 128;
    { u32x4 st[4][4]; const bf16_t* p0 = kbase + (size_t)(tid >> 3) * 1024 + (tid & 7) * 8;
#pragma unroll
      for (int tile = 0; tile < 4; ++tile) { const bf16_t* p = p0 + (size_t)tile * 64 * 1024; st[tile][0] = *(const u32x4*)p; st[tile][1] = *(const u32x4*)(p + 64); st[tile][2] = *(const u32x4*)(p + 512); st[tile][3] = *(const u32x4*)(p + 576); }
      const int off = (tid >> 3) * RS + (tid & 7) * 16;
#pragma unroll
      for (int tile = 0; tile < 4; ++tile) { *(NLAS u32x4*)(lds + l_k(tile) + off) = st[tile][0]; *(NLAS u32x4*)(lds + l_k(tile) + off + 128) = st[tile][1]; *(NLAS u32x4*)(lds + l_v(tile) + off) = st[tile][2]; *(NLAS u32x4*)(lds + l_v(tile) + off + 128) = st[tile][3]; } }
    bf16x8 qf[4];
    { const bf16_t* qp = P + m * PW + P_XAQ + h * 128 + 8 * g;
#pragma unroll
      for (int ks = 0; ks < 4; ++ks) qf[ks] = *(const bf16x8*)(qp + 32 * ks); }
    const float scale2 = 0.08838834764831845f * nsa::LOG2E;
    float mx = -INFINITY, l = 0.f; f32x4 o[8];
#pragma unroll
    for (int db = 0; db < 8; ++db) o[db] = (f32x4){0.f, 0.f, 0.f, 0.f};
    __syncthreads();
#pragma unroll 1
    for (int tile = 0; tile < 4; ++tile) {
        const NLAS char* Kb = lds + l_k(tile); const NLAS char* Vb = lds + l_v(tile);
        f32x4 s[4];
        { bf16x8 a[4][4];
#pragma unroll
          for (int kb = 0; kb < 4; ++kb)
#pragma unroll
              for (int ks = 0; ks < 4; ++ks) a[kb][ks] = *(const NLAS bf16x8*)(Kb + (kb * 16 + i) * RS + 16 * g + 64 * ks);
#pragma unroll
          for (int kb = 0; kb < 4; ++kb) s[kb] = mfma16(a[kb][0], qf[0], (f32x4){0.f, 0.f, 0.f, 0.f});
#pragma unroll
          for (int ks = 1; ks < 4; ++ks)
#pragma unroll
              for (int kb = 0; kb < 4; ++kb) s[kb] = mfma16(a[kb][ks], qf[ks], s[kb]); }
        float mt = -INFINITY;
#pragma unroll
        for (int kb = 0; kb < 4; ++kb)
#pragma unroll
            for (int r = 0; r < 4; ++r) { const float v = s[kb][r] * scale2; s[kb][r] = v; mt = fmaxf(mt, v); }
        mt = fmaxf(mt, __shfl_xor(mt, 16)); mt = fmaxf(mt, __shfl_xor(mt, 32));
        const float mn = fmaxf(mx, mt), alpha = __builtin_amdgcn_exp2f(mx - mn); float sum = 0.f;
#pragma unroll
        for (int kb = 0; kb < 4; ++kb)
#pragma unroll
            for (int r = 0; r < 4; ++r) { const float p = __builtin_amdgcn_exp2f(s[kb][r] - mn); s[kb][r] = p; sum += p; }
        l = l * alpha + sum; mx = mn;
#pragma unroll
        for (int db = 0; db < 8; ++db) o[db] = o[db] * alpha;
        const NLAS char* vb = Vb + (4 * g + (i >> 2)) * RS + (i & 3) * 8;
#pragma unroll
        for (int kk = 0; kk < 2; ++kk) {
            u32x4 pw; pw.x = pkbf(s[2 * kk][0], s[2 * kk][1]); pw.y = pkbf(s[2 * kk][2], s[2 * kk][3]); pw.z = pkbf(s[2 * kk + 1][0], s[2 * kk + 1][1]); pw.w = pkbf(s[2 * kk + 1][2], s[2 * kk + 1][3]);
            const bf16x8 pf = __builtin_bit_cast(bf16x8, pw);
            s16x4 lo[8], hi[8];
#pragma unroll
            for (int db = 0; db < 8; ++db) { const NLAS char* vp = vb + (2 * kk) * 16 * RS + db * 32; lo[db] = vtr(vp); hi[db] = vtr(vp + 16 * RS); }
#pragma unroll
            for (int db = 0; db < 8; ++db) o[db] = mfma16((bf16x8){lo[db][0], lo[db][1], lo[db][2], lo[db][3], hi[db][0], hi[db][1], hi[db][2], hi[db][3]}, pf, o[db]);
        }
    }
    l += __shfl_xor(l, 16); l += __shfl_xor(l, 32);
    const float inv = 1.f / l;
    bf16_t* yo = Yxa + m * 512 + h * 128 + 4 * g;
#pragma unroll
    for (int db = 0; db < 8; ++db) { u32x2 v; v.x = pkbf(o[db][0] * inv, o[db][1] * inv); v.y = pkbf(o[db][2] * inv, o[db][3] * inv); *(u32x2*)(yo + db * 16) = v; }
    __syncthreads();
}
__device__ __forceinline__ void memkv_tile(const bf16_t* MEMN, const bf16_t* Wmkv, bf16_t* MEMKV, int tile) {
    const int tid = threadIdx.x, lane = tid & 63, w = __builtin_amdgcn_readfirstlane(tid >> 6), i = lane & 15, g = lane >> 4;
    const int r0 = (tile >> 4) * 64 + (w >> 1) * 16, c0 = (tile & 15) * 64 + (w & 1) * 32;
    const bf16_t* ap = MEMN + (size_t)(r0 + i) * 1024 + 8 * g; const bf16_t* bp = Wmkv + (size_t)(c0 + i) * 1024 + 8 * g;
    f32x4 acc0 = (f32x4){0.f, 0.f, 0.f, 0.f}, acc1 = acc0;
#pragma unroll 1
    for (int k0 = 0; k0 < 32; k0 += 8) { bf16x8 a[8], b0[8], b1[8];
#pragma unroll
        for (int kk = 0; kk < 8; ++kk) { a[kk] = *(const bf16x8*)(ap + 32 * (k0 + kk)); b0[kk] = *(const bf16x8*)(bp + 32 * (k0 + kk)); b1[kk] = *(const bf16x8*)(bp + 16 * 1024 + 32 * (k0 + kk)); }
#pragma unroll
        for (int kk = 0; kk < 8; ++kk) { acc0 = mfma16(a[kk], b0[kk], acc0); acc1 = mfma16(a[kk], b1[kk], acc1); } }
#pragma unroll
    for (int r = 0; r < 4; ++r) { bf16_t* o = MEMKV + (size_t)(r0 + 4 * g + r) * 1024 + c0 + i; o[0] = f2bf(acc0[r]); o[16] = f2bf(acc1[r]); }
}
__device__ __forceinline__ void phase(NLAS char* lds, const bf16_t* P, const bf16_t* MEMKV, bf16_t* Yxa) {
#pragma unroll 1
    for (int u = blockIdx.x; u < 512; u += gridDim.x) unit(lds, P, MEMKV, Yxa, u >> 7, (u >> 5) & 3, u & 31);
}
}

namespace ml {
using nsa::bf16x8; using nsa::s16x4; using nsa::f32x4; using nsa::u32x4; using nsa::u32x2; using nsa::vtr; using nsa::mfma16; using nsa::pkbf;
constexpr int RS = 272, TB = 64 * RS, RSS = 144;
constexpr float KSCALE = 0.08838834764831845f;
__device__ __forceinline__ float scan_add(float v, int lane) {
#pragma unroll
    for (int o = 1; o < 64; o <<= 1) { const float u = __shfl_up(v, o); if (lane >= o) v += u; }
    return v; }
__device__ __forceinline__ float scan_max(float v, int lane) {
#pragma unroll
    for (int o = 1; o < 64; o <<= 1) { const float u = __shfl_up(v, o); if (lane >= o) v = fmaxf(v, u); }
    return v; }
__device__ __forceinline__ bf16x8 trpair(const NLAS char* p, int hi_off) { const s16x4 lo = vtr(p), hi = vtr(p + hi_off); return (bf16x8){lo[0], lo[1], lo[2], lo[3], hi[0], hi[1], hi[2], hi[3]}; }
__device__ __forceinline__ void load_conv(NLAS char* dst, const bf16_t* P, const float* cw, int colP, int cwc, size_t m0, int tseq0, int tid) {
    const int s = tid >> 3, c16 = (tid & 7) * 16;
#pragma unroll
    for (int half = 0; half < 2; ++half) { const int c = c16 + half * 8; float acc[8];
#pragma unroll
        for (int e = 0; e < 8; ++e) acc[e] = 0.f;
#pragma unroll
        for (int j = 0; j < 4; ++j) { if (tseq0 + s - j >= 0) { const u32x4 raw = *(const u32x4*)(P + (m0 + s - j) * PW + colP + c);
            const f32x4 w0 = *(const f32x4*)(cw + j * 1024 + cwc + c), w1 = *(const f32x4*)(cw + j * 1024 + cwc + c + 4);
            acc[0] += w0[0] * pg8::bflo(raw.x); acc[1] += w0[1] * pg8::bfhi(raw.x); acc[2] += w0[2] * pg8::bflo(raw.y); acc[3] += w0[3] * pg8::bfhi(raw.y);
            acc[4] += w1[0] * pg8::bflo(raw.z); acc[5] += w1[1] * pg8::bfhi(raw.z); acc[6] += w1[2] * pg8::bflo(raw.w); acc[7] += w1[3] * pg8::bfhi(raw.w); } }
#pragma unroll
        for (int e = 0; e < 8; ++e) acc[e] = acc[e] * __builtin_amdgcn_rcpf(1.f + __expf(-acc[e]));
        u32x4 o; o.x = pkbf(acc[0], acc[1]); o.y = pkbf(acc[2], acc[3]); o.z = pkbf(acc[4], acc[5]); o.w = pkbf(acc[6], acc[7]);
        *(NLAS u32x4*)(dst + s * RS + c * 2) = o; }
}
__device__ __forceinline__ void m1_unit(NLAS char* lds, const bf16_t* P, const float* cw, const float* S32, bf16_t* Abuf, float* NA, float* Gc, float* Mloc, int ci) {
    constexpr int L_K = 0, L_EV = TB, L_E = 2 * TB;
    const int tid = threadIdx.x, lane = tid & 63, w = __builtin_amdgcn_readfirstlane(tid >> 6), i = lane & 15, g = lane >> 4;
    const int c = ci & 63, bh = ci >> 6, h = bh & 3, b = bh >> 2; const size_t m0 = (size_t)b * T + c * 64;
    NLAS float* eS = (NLAS float*)(lds + L_E);
    if (w == 0) { const float fpre = S32[(m0 + lane) * 32 + 4 + h], ipre = S32[(m0 + lane) * 32 + h];
        const float bcs = scan_add(logsig(fpre), lane), gtot = __shfl(bcs, 63), wend = gtot - bcs + ipre, mloc = wave_max(wend);
        eS[lane] = __expf(wend - mloc) * KSCALE; if (lane == 0) { Gc[ci] = gtot; Mloc[ci] = mloc; } }
    load_conv(lds + L_K, P, cw, P_MLK + h * 128, 512 + h * 128, m0, c * 64, tid);
    __syncthreads();
    { const int s = tid >> 3, c16 = (tid & 7) * 16; const float es = eS[s]; const bf16_t* vp = P + (m0 + s) * PW + P_MLV + h * 128 + c16;
#pragma unroll
      for (int half = 0; half < 2; ++half) { const u32x4 raw = *(const u32x4*)(vp + half * 8); u32x4 o;
          o.x = pkbf(pg8::bflo(raw.x) * es, pg8::bfhi(raw.x) * es); o.y = pkbf(pg8::bflo(raw.y) * es, pg8::bfhi(raw.y) * es);
          o.z = pkbf(pg8::bflo(raw.z) * es, pg8::bfhi(raw.z) * es); o.w = pkbf(pg8::bflo(raw.w) * es, pg8::bfhi(raw.w) * es);
          *(NLAS u32x4*)(lds + L_EV + s * RS + (c16 + half * 8) * 2) = o; } }
    __syncthreads();
    f32x4 acc[8];
#pragma unroll
    for (int vb = 0; vb < 8; ++vb) acc[vb] = (f32x4){0.f, 0.f, 0.f, 0.f};
    const int rowoff = (4 * g + (i >> 2)) * RS + (i & 3) * 8;
#pragma unroll
    for (int kk = 0; kk < 2; ++kk) { const bf16x8 kf = trpair(lds + L_K + kk * 32 * RS + rowoff + w * 32, 16 * RS);
#pragma unroll
        for (int vb = 0; vb < 8; ++vb) acc[vb] = mfma16(trpair(lds + L_EV + kk * 32 * RS + rowoff + vb * 32, 16 * RS), kf, acc[vb]); }
    bf16_t* ap = Abuf + ((size_t)ci * 128 + w * 16 + i) * 128 + 4 * g;
#pragma unroll
    for (int vb = 0; vb < 8; ++vb) { u32x2 pk; pk.x = pkbf(acc[vb][0], acc[vb][1]); pk.y = pkbf(acc[vb][2], acc[vb][3]); *(u32x2*)(ap + vb * 16) = pk; }
    { const int k = tid >> 2, part = tid & 3; float n = 0.f;
#pragma unroll
      for (int s = 0; s < 16; ++s) n += eS[part * 16 + s] * bf2f(*(const NLAS bf16_t*)(lds + L_K + (part * 16 + s) * RS + k * 2));
      n += __shfl_xor(n, 1); n += __shfl_xor(n, 2); if (part == 0) NA[(size_t)ci * 128 + k] = n; }
    __syncthreads();
}
__device__ __forceinline__ void m2_items(bf16_t* Abuf, float* NA, const float* Gc, const float* Mloc, float* Mprev) {
    for (int it = blockIdx.x * blockDim.x + threadIdx.x; it < 16 * 128 * 64; it += gridDim.x * blockDim.x) {
        const int bh = it >> 13, kv2 = it & 8191, k = kv2 >> 6, v2 = kv2 & 63;
        float C0 = 0.f, C1 = 0.f, n = 0.f, m = 0.f;
        unsigned* base = (unsigned*)(Abuf + ((size_t)(bh * 64) * 128 + k) * 128 + v2 * 2);
#pragma unroll 1
        for (int c0 = 0; c0 < 64; c0 += 16) { unsigned A[16];
#pragma unroll
            for (int u = 0; u < 16; ++u) A[u] = base[(size_t)(c0 + u) * 8192];
#pragma unroll
            for (int u = 0; u < 16; ++u) { const int ci = bh * 64 + c0 + u; const float gg = Gc[ci], ml = Mloc[ci];
                const float mn = fmaxf(gg + m, ml), a = __expf(gg + m - mn), bb = __expf(ml - mn);
                base[(size_t)(c0 + u) * 8192] = pkbf(C0, C1); C0 = C0 * a + pg8::bflo(A[u]) * bb; C1 = C1 * a + pg8::bfhi(A[u]) * bb;
                if (v2 == 0) { const float nA = NA[(size_t)ci * 128 + k]; NA[(size_t)ci * 128 + k] = n; n = a * n + bb * nA; }
                if (kv2 == 0) Mprev[ci] = m;
                m = mn; } }
    }
}
__device__ __forceinline__ void m3_unit(NLAS char* lds, const bf16_t* P, const float* cw, const float* S32, const bf16_t* Cprev, const float* Nprev, const float* Mprev, const float* normg, bf16_t* Yml, int ci) {
    constexpr int L_Q = 0, L_K = TB, L_V = 2 * TB, L_C = 3 * TB, L_S = 5 * TB, L_F = L_S + 64 * RSS;
    const int tid = threadIdx.x, lane = tid & 63, w = __builtin_amdgcn_readfirstlane(tid >> 6), i = lane & 15, g = lane >> 4;
    const int c = ci & 63, bh = ci >> 6, h = bh & 3, b = bh >> 2; const size_t m0 = (size_t)b * T + c * 64;
    bf16_t ov[4][4]; float ng[4];
    { const int tb_ = w >> 1, vb0_ = (w & 1) * 4;
#pragma unroll
      for (int vb = 0; vb < 4; ++vb) { ng[vb] = normg[h * 128 + (vb0_ + vb) * 16 + i];
#pragma unroll
          for (int r = 0; r < 4; ++r) ov[vb][r] = P[(m0 + tb_ * 16 + 4 * g + r) * PW + P_MLO + h * 128 + (vb0_ + vb) * 16 + i]; } }
    NLAS float* F = (NLAS float*)(lds + L_F);
    NLAS float* rowf = F; NLAS float* colf = F + 64; NLAS float* scv = F + 128; NLAS float* emt = F + 192; NLAS float* qn = F + 256; NLAS float* nprev = F + 320; NLAS float* denp = F + 448; NLAS float* ssq = F + 576;
    if (w == 0) { const float fpre = S32[(m0 + lane) * 32 + 4 + h], ipre = S32[(m0 + lane) * 32 + h], mprev = Mprev[ci];
        const float bcs = scan_add(logsig(fpre), lane), u = ipre - bcs, pm = scan_max(u, lane), mt = bcs + fmaxf(mprev, pm);
        rowf[lane] = bcs - mt; colf[lane] = u; scv[lane] = __expf(bcs + mprev - mt); emt[lane] = __expf(-mt); }
    else if (w <= 2) nprev[tid - 64] = Nprev[(size_t)ci * 128 + tid - 64];
    load_conv(lds + L_Q, P, cw, P_MLQ + h * 128, h * 128, m0, c * 64, tid);
    load_conv(lds + L_K, P, cw, P_MLK + h * 128, 512 + h * 128, m0, c * 64, tid);
    { const int s = tid >> 3, c16 = (tid & 7) * 16; const bf16_t* vp = P + (m0 + s) * PW + P_MLV + h * 128 + c16;
      *(NLAS u32x4*)(lds + L_V + s * RS + c16 * 2) = *(const u32x4*)vp; *(NLAS u32x4*)(lds + L_V + s * RS + c16 * 2 + 16) = *(const u32x4*)(vp + 8); }
    { const int k = tid >> 2, v0 = (tid & 3) * 32; const bf16_t* cp = Cprev + ((size_t)ci * 128 + k) * 128 + v0;
#pragma unroll
      for (int q8 = 0; q8 < 4; ++q8) *(NLAS u32x4*)(lds + L_C + k * RS + (v0 + q8 * 8) * 2) = *(const u32x4*)(cp + q8 * 8); }
    __syncthreads();
    { const int tq = tid >> 3, part = tid & 7; const u32x4 q0 = *(const NLAS u32x4*)(lds + L_Q + tq * RS + part * 32), q1 = *(const NLAS u32x4*)(lds + L_Q + tq * RS + part * 32 + 16);
      const NLAS f32x4* np = (const NLAS f32x4*)(nprev + part * 16); const f32x4 n0 = np[0], n1 = np[1], n2 = np[2], n3 = np[3];
      float a = pg8::bflo(q0.x) * n0[0] + pg8::bfhi(q0.x) * n0[1] + pg8::bflo(q0.y) * n0[2] + pg8::bfhi(q0.y) * n0[3] + pg8::bflo(q0.z) * n1[0] + pg8::bfhi(q0.z) * n1[1] + pg8::bflo(q0.w) * n1[2] + pg8::bfhi(q0.w) * n1[3]
              + pg8::bflo(q1.x) * n2[0] + pg8::bfhi(q1.x) * n2[1] + pg8::bflo(q1.y) * n2[2] + pg8::bfhi(q1.y) * n2[3] + pg8::bflo(q1.z) * n3[0] + pg8::bfhi(q1.z) * n3[1] + pg8::bflo(q1.w) * n3[2] + pg8::bfhi(q1.w) * n3[3];
      a += __shfl_xor(a, 1); a += __shfl_xor(a, 2); a += __shfl_xor(a, 4); if (part == 0) qn[tq] = a; }
    const int tb = w >> 1;
    {
        float rs[4] = {0.f, 0.f, 0.f, 0.f};
#pragma unroll
        for (int sbi = 0; sbi < 2; ++sbi) { const int sb = 2 * (w & 1) + sbi; f32x4 acc = (f32x4){0.f, 0.f, 0.f, 0.f};
            if (sb <= tb) {
#pragma unroll
                for (int ks = 0; ks < 4; ++ks) acc = mfma16(*(const NLAS bf16x8*)(lds + L_Q + (tb * 16 + i) * RS + (32 * ks + 8 * g) * 2), *(const NLAS bf16x8*)(lds + L_K + (sb * 16 + i) * RS + (32 * ks + 8 * g) * 2), acc); }
            const int s = sb * 16 + i; const float cf = colf[s];
#pragma unroll
            for (int r = 0; r < 4; ++r) { const int t = tb * 16 + 4 * g + r; const float v = (s <= t) ? acc[r] * KSCALE * __expf(rowf[t] + cf) : 0.f; rs[r] += v;
                *(NLAS bf16_t*)(lds + L_S + t * RSS + s * 2) = f2bf(v); } }
#pragma unroll
        for (int r = 0; r < 4; ++r) { float x = rs[r]; x += __shfl_xor(x, 1); x += __shfl_xor(x, 2); x += __shfl_xor(x, 4); x += __shfl_xor(x, 8); if (i == 0) denp[(w & 1) * 64 + tb * 16 + 4 * g + r] = x; }
    }
    __syncthreads();
    f32x4 a1[4], a2[4];
#pragma unroll
    for (int vb = 0; vb < 4; ++vb) { a1[vb] = (f32x4){0.f, 0.f, 0.f, 0.f}; a2[vb] = (f32x4){0.f, 0.f, 0.f, 0.f}; }
    const int vb0 = (w & 1) * 4, troff = (8 * g + (i >> 2)) * RS + (i & 3) * 8;
#pragma unroll
    for (int kk = 0; kk < 2; ++kk) { if (32 * kk <= tb * 16 + 15) { const bf16x8 sf = *(const NLAS bf16x8*)(lds + L_S + (tb * 16 + i) * RSS + (32 * kk + 8 * g) * 2);
#pragma unroll
        for (int vb = 0; vb < 4; ++vb) a1[vb] = mfma16(sf, trpair(lds + L_V + kk * 32 * RS + troff + (vb0 + vb) * 32, 4 * RS), a1[vb]); } }
#pragma unroll
    for (int ks = 0; ks < 4; ++ks) { const bf16x8 qf = *(const NLAS bf16x8*)(lds + L_Q + (tb * 16 + i) * RS + (32 * ks + 8 * g) * 2);
#pragma unroll
        for (int vb = 0; vb < 4; ++vb) a2[vb] = mfma16(qf, trpair(lds + L_C + ks * 32 * RS + troff + (vb0 + vb) * 32, 4 * RS), a2[vb]); }
    float hv[4][4], sq[4] = {0.f, 0.f, 0.f, 0.f};
#pragma unroll
    for (int r = 0; r < 4; ++r) { const int t = tb * 16 + 4 * g + r; const float sc = scv[t]; const float den = denp[t] + denp[64 + t] + sc * qn[t]; const float hd = 1.f / fmaxf(fabsf(den), emt[t]);
#pragma unroll
        for (int vb = 0; vb < 4; ++vb) { const float x = (a1[vb][r] + sc * a2[vb][r]) * hd; hv[vb][r] = x; sq[r] += x * x; } }
#pragma unroll
    for (int r = 0; r < 4; ++r) { float x = sq[r]; x += __shfl_xor(x, 1); x += __shfl_xor(x, 2); x += __shfl_xor(x, 4); x += __shfl_xor(x, 8); if (i == 0) ssq[(w & 1) * 64 + tb * 16 + 4 * g + r] = x; }
    __syncthreads();
#pragma unroll
    for (int r = 0; r < 4; ++r) { const int t = tb * 16 + 4 * g + r; const float rinv = rsqrtf((ssq[t] + ssq[64 + t]) * (1.f / 128.f) + EPS);
#pragma unroll
        for (int vb = 0; vb < 4; ++vb) { const int v = (vb0 + vb) * 16 + i; const float o = bf2f(ov[vb][r]);
            Yml[(m0 + t) * 512 + h * 128 + v] = f2bf(__builtin_amdgcn_rcpf(1.f + __expf(-o)) * hv[vb][r] * rinv * ng[vb]); } }
    __syncthreads();
}
}

namespace cmpr {
using nsa::bf16x8; using nsa::f32x4; using nsa::u32x4; using nsa::mfma16; using nsa::pkbf;
constexpr int RSX = 144, L_X = 0, L_PE = 272 * RSX  , L_H = L_PE + 8192, RSH = 528;
__device__ __forceinline__ void unit(NLAS char* lds, const bf16_t* P, const float* pe, const bf16_t* W1t, const bf16_t* W2t, bf16_t* KC, bf16_t* VC, int u) {
    const int tid = threadIdx.x, lane = tid & 63, w = __builtin_amdgcn_readfirstlane(tid >> 6), i = lane & 15, g = lane >> 4;
    const int nt = u & 15, gq = (u >> 4) & 1, b = (u >> 5) & 3, kv = u >> 7;
    const int pcol = (kv ? P_VC : P_KC) + gq * 64, tok0 = 256 * nt;
    for (int ch = tid; ch < 272 * 8; ch += 512) { const int row = ch >> 3, c8 = (ch & 7) * 8, tok = tok0 + row;
        u32x4 v = (u32x4){0u, 0u, 0u, 0u}; if (tok < T) v = *(const u32x4*)(P + ((size_t)b * T + tok) * PW + pcol + c8);
        *(NLAS u32x4*)(lds + L_X + row * RSX + c8 * 2) = v; }
    for (int e = tid; e < 2048; e += 512) ((NLAS float*)(lds + L_PE))[e] = pe[kv * 2048 + e];
    __syncthreads();
    f32x4 acc[2]; acc[0] = (f32x4){0.f, 0.f, 0.f, 0.f}; acc[1] = acc[0];
    const bf16_t* wb = W1t + ((size_t)kv * 256 + 32 * w + i) * 2048 + 8 * g;
#define CMPR_LOAD(dst, k0_) { _Pragma("unroll") for (int kk = 0; kk < 8; ++kk) { dst[kk][0] = *(const bf16x8*)(wb + 32 * ((k0_) + kk)); dst[kk][1] = *(const bf16x8*)(wb + 16 * 2048 + 32 * ((k0_) + kk)); } }
#define CMPR_COMP(src, k0_) { _Pragma("unroll") for (int kk = 0; kk < 8; ++kk) { const int ks = (k0_) + kk, l = ks >> 1, dh = ks & 1; \
            const u32x4 raw = *(const NLAS u32x4*)(lds + L_X + (16 * i + l) * RSX + dh * 64 + 16 * g); \
            const NLAS float* pp = (const NLAS float*)(lds + L_PE) + l * 64 + dh * 32 + 8 * g; const f32x4 p0 = *(const NLAS f32x4*)pp, p1 = *(const NLAS f32x4*)(pp + 4); \
            u32x4 a; a.x = pkbf(pg8::bflo(raw.x) + p0[0], pg8::bfhi(raw.x) + p0[1]); a.y = pkbf(pg8::bflo(raw.y) + p0[2], pg8::bfhi(raw.y) + p0[3]); \
            a.z = pkbf(pg8::bflo(raw.z) + p1[0], pg8::bfhi(raw.z) + p1[1]); a.w = pkbf(pg8::bflo(raw.w) + p1[2], pg8::bfhi(raw.w) + p1[3]); \
            const bf16x8 af = __builtin_bit_cast(bf16x8, a); \
            acc[0] = mfma16(af, src[kk][0], acc[0]); acc[1] = mfma16(af, src[kk][1], acc[1]); } }
    { bf16x8 bA[8][2], bB[8][2];
      CMPR_LOAD(bA, 0)
#pragma unroll 1
      for (int k0 = 0; k0 < 64; k0 += 16) { CMPR_LOAD(bB, k0 + 8) CMPR_COMP(bA, k0) if (k0 + 16 < 64) CMPR_LOAD(bA, k0 + 16) CMPR_COMP(bB, k0 + 8) } }
#undef CMPR_LOAD
#undef CMPR_COMP
#pragma unroll
    for (int cb = 0; cb < 2; ++cb)
#pragma unroll
        for (int r = 0; r < 4; ++r) { const float x = acc[cb][r], uu = 0.7978845608028654f * (x + 0.044715f * x * x * x); const float gl = x * __builtin_amdgcn_rcpf(1.f + __expf(-2.f * uu));
            *(NLAS bf16_t*)(lds + L_H + (4 * g + r) * RSH + (32 * w + cb * 16 + i) * 2) = f2bf(gl); }
    __syncthreads();
    if (w < 4) { f32x4 o = (f32x4){0.f, 0.f, 0.f, 0.f}; const bf16_t* w2 = W2t + ((size_t)kv * 64 + 16 * w + i) * 256 + 8 * g;
#pragma unroll
        for (int ks = 0; ks < 8; ++ks) o = mfma16(*(const NLAS bf16x8*)(lds + L_H + i * RSH + (32 * ks + 8 * g) * 2), *(const bf16x8*)(w2 + 32 * ks), o);
        bf16_t* dst = (kv ? VC : KC);
#pragma unroll
        for (int r = 0; r < 4; ++r) dst[((size_t)(b * 256 + 16 * nt + 4 * g + r) * 2 + gq) * 64 + 16 * w + i] = f2bf(o[r]); }
    __syncthreads();
}
}

#define LAS __attribute__((address_space(3)))
constexpr int NTHREADS = 512, LDS_BYTES = 147456;
constexpr size_t WS_WIN = 1 * MiB, WS_WG = 9 * MiB, WS_WBR = 15 * MiB, WS_WOUT = 18 * MiB, WS_WFF1 = 20 * MiB, WS_WFF2 = 28 * MiB, WS_WMKV = 36 * MiB, WS_WC1 = 38 * MiB;
constexpr size_t WS_BIASP = 253 * MiB + 768 * 1024, WS_XCH = 254 * MiB;
#define XB_TMO      128
#define XB_XCNT(j)  (256  + 64 * (j))
#define XB_XSUB(j)  (1280 + 64 * (j))
#define XB_XGEN(j)  (2304 + 64 * (j))
#define XB_TOP      3328
#define XB_TOPGEN   3392
#define XCD_BAR_WORDS 3456
#define XB_SPIN_CAP (1u << 18)

__device__ __forceinline__ unsigned xb_ld(unsigned* p)              { return __hip_atomic_load(p, __ATOMIC_RELAXED, __HIP_MEMORY_SCOPE_AGENT); }
__device__ __forceinline__ unsigned xb_add(unsigned* p, unsigned v) { return __hip_atomic_fetch_add(p, v, __ATOMIC_RELAXED, __HIP_MEMORY_SCOPE_AGENT); }
__device__ __forceinline__ unsigned xb_xcc_id() { return (unsigned)__builtin_amdgcn_s_getreg((3 << 11) | 20) & 0xFu; }
#define XB_SPIN(cond, bar) do { unsigned _sp = 0; while (cond) { __builtin_amdgcn_s_sleep(1); \
    if ((++_sp & 255u) == 0u) { if (xb_ld(&(bar)[XB_TMO])) break; if (_sp > XB_SPIN_CAP) { atomicAdd(&(bar)[XB_TMO], 1u); break; } } } } while (0)

struct XcdBarrier {
    unsigned* bar; unsigned x;
    volatile LAS unsigned* st;
};

__device__ __forceinline__ XcdBarrier xcd_barrier_post(unsigned* bar, volatile LAS unsigned* st) {
    XcdBarrier b; b.bar = bar; b.x = xb_xcc_id(); b.st = st;
    if (threadIdx.x == 0) (void)xb_add(&bar[XB_XCNT(b.x)], 1u);
    return b;
}
__device__ __forceinline__ void xcd_barrier_complete(unsigned* bar, unsigned x, unsigned& nloc, unsigned& nx) {
    const unsigned G = gridDim.x * gridDim.y * gridDim.z;
    unsigned sum, cnt, mine, sp = 0u;
    for (;;) {
        sum = 0u; cnt = 0u; mine = 0u;
#pragma unroll
        for (unsigned j = 0; j < 16; ++j) { const unsigned c = xb_ld(&bar[XB_XCNT(j)]); sum += c; cnt += (c > 0u) ? 1u : 0u; mine = (j == x) ? c : mine; }
        if (sum == G) break;
        __builtin_amdgcn_s_sleep(1);
        if ((++sp & 255u) == 0u) { if (xb_ld(&bar[XB_TMO])) break; if (sp > XB_SPIN_CAP) { atomicAdd(&bar[XB_TMO], 1u); break; } }
    }
    nloc = mine > 0u ? mine : 1u; nx = cnt > 0u ? cnt : 1u;
}

__device__ __forceinline__ void xcd_barrier(const XcdBarrier& b) {
    asm volatile("s_waitcnt vmcnt(0)" ::: "memory");
    __syncthreads();
    if (threadIdx.x == 0) {
        unsigned* bar = b.bar;
        __builtin_amdgcn_s_waitcnt(0);
        unsigned nloc = b.st[0], nx = b.st[1];
        if (nloc == 0u) { xcd_barrier_complete(bar, b.x, nloc, nx); b.st[0] = nloc; b.st[1] = nx; }
        const unsigned old = xb_add(&bar[XB_XSUB(b.x)], 1u);
        const unsigned gen = old / nloc;
        if (old + 1u == (gen + 1u) * nloc) {
            __builtin_amdgcn_fence(__ATOMIC_RELEASE, "agent");
            asm volatile("s_waitcnt vmcnt(0)" ::: "memory");
            const unsigned og = xb_add(&bar[XB_TOP], 1u);
            const unsigned tg = og / nx;
            if (og + 1u == (tg + 1u) * nx) xb_add(&bar[XB_TOPGEN], 1u);
            else XB_SPIN(xb_ld(&bar[XB_TOPGEN]) == tg, bar);
            __builtin_amdgcn_fence(__ATOMIC_ACQUIRE, "agent");
            xb_add(&bar[XB_XGEN(b.x)], 1u);
            asm volatile("s_waitcnt vmcnt(0)" ::: "memory");
        } else {
            XB_SPIN(xb_ld(&bar[XB_XGEN(b.x)]) == gen, bar);
            __builtin_amdgcn_fence(__ATOMIC_ACQUIRE, "agent");
            asm volatile("s_waitcnt vmcnt(0)" ::: "memory");
        }
    }
    __syncthreads();
}

__device__ __forceinline__ void group_barrier(unsigned* gc, unsigned target, bool light) {
    asm volatile("s_waitcnt vmcnt(0)" ::: "memory"); __syncthreads();
    if (threadIdx.x == 0) {
        if (!light) { __builtin_amdgcn_fence(__ATOMIC_RELEASE, "agent"); asm volatile("s_waitcnt vmcnt(0)" ::: "memory"); }
        __hip_atomic_fetch_add(gc, 1u, __ATOMIC_RELAXED, __HIP_MEMORY_SCOPE_AGENT);
        unsigned sp = 0; while (__hip_atomic_load(gc, __ATOMIC_RELAXED, __HIP_MEMORY_SCOPE_AGENT) < target) { __builtin_amdgcn_s_sleep(1); if (++sp > (1u << 22)) break; }
        __builtin_amdgcn_fence(__ATOMIC_ACQUIRE, "agent"); asm volatile("s_waitcnt vmcnt(0)" ::: "memory");
    }
    __syncthreads();
}
struct Args { const float* in[18]; float* out; unsigned char* ws; int ph_lo, ph_hi; };
__device__ __forceinline__ unsigned pk2(float lo, float hi) { return (unsigned)f2bf(lo) | ((unsigned)f2bf(hi) << 16); }
typedef unsigned v4u __attribute__((ext_vector_type(4)));
typedef float f32x4 __attribute__((ext_vector_type(4)));
__device__ __forceinline__ void tr_item(const float* W, int ld, int ncols, int K, bf16_t* WT, int row_off, LAS float* scr, int item, int lane) {
    const int nblk = ncols / 32, kb = item / nblk, nb = item % nblk, k0 = 64 * kb, n0 = 32 * nb;
#pragma unroll 8
    for (int i = 0; i < 32; ++i) { const int kk = 2 * i + (lane >> 5); scr[kk * 33 + (lane & 31)] = W[(size_t)(k0 + kk) * ld + n0 + (lane & 31)]; }
    asm volatile("s_waitcnt lgkmcnt(0)" ::: "memory");
    const int c = lane & 7;
#pragma unroll
    for (int j = 0; j < 4; ++j) { const int n = (lane >> 3) + 8 * j; const LAS float* s = scr + (8 * c) * 33 + n;
        v4u o; o.x = pk2(s[0 * 33], s[1 * 33]); o.y = pk2(s[2 * 33], s[3 * 33]); o.z = pk2(s[4 * 33], s[5 * 33]); o.w = pk2(s[6 * 33], s[7 * 33]);
        *(v4u*)(WT + (size_t)(row_off + n0 + n) * K + k0 + 8 * c) = o; }
    asm volatile("s_waitcnt lgkmcnt(0)" ::: "memory");
}
__device__ __forceinline__ void rms_row_wave(const float* xrow, const float* g, bf16_t* orow, int lane) {
    const f32x4* xr = (const f32x4*)xrow + lane; const f32x4* gr = (const f32x4*)g + lane;
    f32x4 v[4]; float s = 0.f;
#pragma unroll
    for (int j = 0; j < 4; ++j) { v[j] = xr[64 * j]; s += (v[j].x * v[j].x + v[j].y * v[j].y) + (v[j].z * v[j].z + v[j].w * v[j].w); }
    const float r = rsqrtf(wave_sum(s) * (1.f / D) + EPS);
    unsigned long long* o8 = (unsigned long long*)orow + lane;
#pragma unroll
    for (int j = 0; j < 4; ++j) { const f32x4 gg = gr[64 * j]; o8[64 * j] = (unsigned long long)pk2(v[j].x * r * gg.x, v[j].y * r * gg.y) | ((unsigned long long)pk2(v[j].z * r * gg.z, v[j].w * r * gg.w) << 32); }
}
__device__ __forceinline__ int small_src_col(int c) { return c < 8 ? C_MLI + c : C_NSG + (c - 8); }
__global__ void __launch_bounds__(NTHREADS, 2) mega(Args a) {
    extern __shared__ __attribute__((aligned(16))) unsigned char lds_raw[];
    char* lds = (char*)lds_raw;
    LAS unsigned char* lds3 = (LAS unsigned char*)lds_raw;
    const float* x = a.in[0]; const float* mem = a.in[1]; const float* g_mix = a.in[2]; const float* w_in = a.in[3];
    const float* b_in = a.in[4]; const float* ml_conv = a.in[5]; const float* ml_norm_g = a.in[6]; const float* cmp_pe = a.in[7];
    const float* cmp_w1 = a.in[8]; const float* cmp_w2 = a.in[9]; const float* g_mem = a.in[10]; const float* w_mem_kv = a.in[11];
    const float* w_branch = a.in[12]; const float* w_out = a.in[13]; const float* g_ffn = a.in[14]; const float* w_ff1 = a.in[15];
    const float* w_ff2 = a.in[16]; const float* g_final = a.in[17];
    char* ws = (char*)a.ws; float* out = a.out;
    bf16_t* U = (bf16_t*)(ws + WS_U); bf16_t* P = (bf16_t*)(ws + WS_P);
    bf16_t* Yml = (bf16_t*)(ws + WS_Y); bf16_t* Ynsa = Yml + (size_t)M * 512; bf16_t* Yxa = Ynsa + (size_t)M * 512;
    float* S32 = (float*)(ws + WS_S32); bf16_t* MEMN = (bf16_t*)out + (size_t)16 * 1024 * 1024;     bf16_t* MEMKV = (bf16_t*)(ws + WS_MEMKV);
    bf16_t* KC = (bf16_t*)(ws + WS_KC); bf16_t* VC = (bf16_t*)(ws + WS_VC);
    float* NA = (float*)(ws + WS_NA); float* Gc = (float*)(ws + WS_G); float* Mloc = (float*)(ws + WS_MLOC); float* Mprev = (float*)(ws + WS_MPREV);
    bf16_t* Abuf = (bf16_t*)out;
    bf16_t* GATES = P; bf16_t* MERGED = U; bf16_t* AFFN = U; bf16_t* HBUF = P;
    bf16_t* Wi = (bf16_t*)(ws + WS_WIN); bf16_t* Wg = (bf16_t*)(ws + WS_WG); bf16_t* Wbr = (bf16_t*)(ws + WS_WBR); bf16_t* Wo = (bf16_t*)(ws + WS_WOUT);
    bf16_t* Wf1 = (bf16_t*)(ws + WS_WFF1); bf16_t* Wf2 = (bf16_t*)(ws + WS_WFF2); bf16_t* Wmkv = (bf16_t*)(ws + WS_WMKV);
    float* biasP = (float*)(ws + WS_BIASP); bf16_t* Wc1 = (bf16_t*)(ws + WS_WC1); bf16_t* Wc2 = (bf16_t*)(ws + WS_BIASP + 65536);
    const int tid = threadIdx.x, lane = tid & 63, wave = __builtin_amdgcn_readfirstlane(tid >> 6);
    const int G = gridDim.x, bid = blockIdx.x;
    const int lo = a.ph_lo, hi = a.ph_hi;
    volatile LAS unsigned* xbst = (volatile LAS unsigned*)(lds3 + LDS_BYTES - 64);
    if (tid < 2) xbst[tid] = 0u;
    __syncthreads();
    const XcdBarrier bar = xcd_barrier_post((unsigned*)ws, xbst);
    if (tid == 0) __hip_atomic_store((unsigned*)ws + 12544 + bid, xb_xcc_id() + 1u, __ATOMIC_RELAXED, __HIP_MEMORY_SCOPE_AGENT);
#define PHASE(k) if (lo <= (k) && (k) < hi)
#define SEAM(k) if (lo <= (k) && (k) + 1 < hi) xcd_barrier(bar)
    PHASE(0) {
        LAS float* scr = (LAS float*)(lds3 + wave * 16384);
        const int gw = bid * 8 + wave, NGW = G * 8;
        constexpr int I0 = 16 * 64, I1 = 16 * 40, I2 = 16 * 16, I3 = 16 * 96, I4 = 8 * 32, I5 = 16 * 32, I6 = 16 * 128, I7 = 64 * 32, I8 = 16 * 32;
        constexpr int I9 = 32 * 8, I10 = 4 * 2;
        constexpr int NITEMS = I0 + I1 + I2 + I3 + 3 * I4 + I5 + I6 + I7 + I8 + 2 * I9 + 2 * I10;
        for (int it = gw; it < NITEMS; it += NGW) {
            int r = it;
            if (r < I0) { tr_item(w_in, DIN, 2048, 1024, Wi, 0, scr, r, lane); continue; } r -= I0;
            if (r < I1) { tr_item(w_in + 2056, DIN, 1280, 1024, Wi, 2048, scr, r, lane); continue; } r -= I1;
            if (r < I2) { tr_item(w_in + 3360, DIN, 512, 1024, Wi, 3328, scr, r, lane); continue; } r -= I2;
            if (r < I3) { tr_item(w_in + C_MG, DIN, 3072, 1024, Wg, 0, scr, r, lane); continue; } r -= I3;
            if (r < 3 * I4) { const int j = r / I4; tr_item(w_branch + (size_t)j * 512 * 1024, 1024, 1024, 512, Wbr + (size_t)j * 1024 * 512, 0, scr, r % I4, lane); continue; } r -= 3 * I4;
            if (r < I5) { tr_item(w_out, 1024, 1024, 1024, Wo, 0, scr, r, lane); continue; } r -= I5;
            if (r < I6) { tr_item(w_ff1, FF, FF, 1024, Wf1, 0, scr, r, lane); continue; } r -= I6;
            if (r < I7) { tr_item(w_ff2, 1024, 1024, FF, Wf2, 0, scr, r, lane); continue; } r -= I7;
            if (r < I8) { tr_item(w_mem_kv, 1024, 1024, 1024, Wmkv, 0, scr, r, lane); continue; } r -= I8;
            if (r < 2 * I9) { const int kv = r / I9; tr_item(cmp_w1 + (size_t)kv * 2048 * 256, 256, 256, 2048, Wc1 + (size_t)kv * 256 * 2048, 0, scr, r % I9, lane); continue; } r -= 2 * I9;
            { const int kv = r / I10; tr_item(cmp_w2 + (size_t)kv * 256 * 64, 64, 64, 256, Wc2 + (size_t)kv * 64 * 256, 0, scr, r % I10, lane); }
        }
        for (int i = bid * NTHREADS + tid; i < 256 * 1024; i += G * NTHREADS) { const int r = i >> 10, k = i & 1023; bf16_t v = 0;
            if (r < 32) v = f2bf(w_in[(size_t)k * DIN + small_src_col(r)]);
            else if (r >= 128 && r < 160) { const float w = w_in[(size_t)k * DIN + small_src_col(r - 128)]; v = f2bf(w - bf2f(f2bf(w))); }
            Wi[(size_t)(3840 + r) * 1024 + k] = v; }
        for (int c = bid * NTHREADS + tid; c < 4096; c += G * NTHREADS) { float v = 0.f;
            if (c < 2048) v = b_in[c]; else if (c < 3328) v = b_in[c + 8]; else if (c < 3840) v = b_in[c + 32]; else if (c < 3872) v = b_in[small_src_col(c - 3840)];
            biasP[c] = v; }
        for (int m = gw; m < M; m += NGW) rms_row_wave(x + (size_t)m * D, g_mix, U + (size_t)m * D, lane);
        for (int m = gw; m < 1024; m += NGW) rms_row_wave(mem + (size_t)m * D, g_mem, MEMN + (size_t)m * D, lane);
    }
    SEAM(0);
    PHASE(1) {
        { pg8::Gemm g{U, Wi, M, 4096, D}; pg8::StaticOrder S; S.init(M, 4096, G, bid);
          pg8::EpiStore<0> E{P, biasP, S32, PW, 15};
          pg8::gemm_phase<pg8::EpiStore<0>, pg8::StaticOrder, true, true>(lds3, g, S, E); }
    }
    SEAM(1);
    PHASE(2) { for (int tl_ = bid; tl_ < 256; tl_ += G) xa::memkv_tile(MEMN, Wmkv, MEMKV, tl_);
               for (int ci = bid; ci < 1024; ci += G) ml::m1_unit((NLAS char*)lds_raw, P, ml_conv, S32, Abuf, NA, Gc, Mloc, ci);
               for (int u = bid; u < 256; u += G) cmpr::unit((NLAS char*)lds_raw, P, cmp_pe, Wc1, Wc2, KC, VC, u);
    }
    SEAM(2);
    PHASE(3) { unsigned* m2cnt = (unsigned*)ws + 12288;
               ml::m2_items(Abuf, NA, Gc, Mloc, Mprev);
               asm volatile("s_waitcnt vmcnt(0)" ::: "memory"); __syncthreads();
               if (tid == 0) { __builtin_amdgcn_fence(__ATOMIC_RELEASE, "agent"); asm volatile("s_waitcnt vmcnt(0)" ::: "memory"); __hip_atomic_fetch_add(m2cnt, 1u, __ATOMIC_RELAXED, __HIP_MEMORY_SCOPE_AGENT); }
               nsa::phase((NLAS char*)lds_raw, P, S32, KC, VC, Ynsa);
               xa::phase((NLAS char*)lds_raw, P, MEMKV, Yxa);
               if (tid == 0) { unsigned sp = 0; while (__hip_atomic_load(m2cnt, __ATOMIC_RELAXED, __HIP_MEMORY_SCOPE_AGENT) < (unsigned)G) { __builtin_amdgcn_s_sleep(2); if (++sp > (1u << 22)) break; }
                               __builtin_amdgcn_fence(__ATOMIC_ACQUIRE, "agent"); asm volatile("s_waitcnt vmcnt(0)" ::: "memory"); }
               __syncthreads();
               for (int ci = bid; ci < 1024; ci += G) ml::m3_unit((NLAS char*)lds_raw, P, ml_conv, S32, Abuf, NA, Mprev, ml_norm_g, Yml, ci); }
    SEAM(4);
    unsigned* gcnt = (unsigned*)ws + 13312 + 16 * (bid & 63);
    bool panel_sync = false;
    if (G == 256) { volatile LAS unsigned* flag = (volatile LAS unsigned*)(lds3 + LDS_BYTES - 48);
        if (wave == 0) { const unsigned* xt = (const unsigned*)ws + 12544; unsigned x0 = 0, same = 1;
            for (int k = 0; k < 4; ++k) { const unsigned xv = __hip_atomic_load(xt + lane + 64 * k, __ATOMIC_RELAXED, __HIP_MEMORY_SCOPE_AGENT); if (k == 0) x0 = xv; same &= (xv == x0 && xv != 0u) ? 1u : 0u; }
            const unsigned long long all = __ballot(same != 0u); if (lane == 0) flag[0] = (all == ~0ull) ? 1u : 0u; }
        __syncthreads();
        panel_sync = flag[0] != 0u; }
    const bool light = true;
#define PSEAM(k, n) if (lo <= (k) && (k) + 1 < hi) { if (panel_sync) group_barrier(gcnt, 4u * (n), light); else xcd_barrier(bar); }
    PHASE(5) { pg8::Gemm g{U, Wg, M, 3072, D}; pg8::StaticOrder S; S.init(M, 3072, G, bid);
               pg8::EpiStore<1> E{GATES, b_in + C_MG, nullptr, 4096, -1};
               pg8::gemm_phase<pg8::EpiStore<1>, pg8::StaticOrder, true, true>(lds3, g, S, E); }
    PSEAM(5, 1);
    PHASE(6) { pg8::Gemm g{Yml, Wbr, M, 1024, 512}; pg8::MergeOrder S; S.so.init(M, 1024, G, bid); S.sa = (size_t)M * 512 * 2; S.sb = (size_t)1024 * 512 * 2;
               pg8::EpiMergeG E{GATES, (bf16_t*)out, MERGED};
               pg8::gemm_phase<pg8::EpiMergeG, pg8::MergeOrder, true, true>(lds3, g, S, E); }
    PSEAM(6, 2);
    PHASE(7) { pg8::Gemm g{MERGED, Wo, M, 1024, D}; pg8::StaticOrder S; S.init(M, 1024, G, bid);
               pg8::EpiResRms E{x, out, nullptr, AFFN, g_ffn, (float*)(ws + WS_XCH), (unsigned*)ws + 4096};
               pg8::gemm_phase<pg8::EpiResRms, pg8::StaticOrder, false, true>(lds3, g, S, E); }
    PSEAM(7, 3);
    PHASE(9) { pg8::Gemm g{AFFN, Wf1, M, FF, D}; pg8::StaticOrder S; S.init(M, FF, G, bid);
               pg8::EpiStore<2> E{HBUF, nullptr, nullptr, FF, -1};
               pg8::gemm_phase<pg8::EpiStore<2>, pg8::StaticOrder, true, true>(lds3, g, S, E); }
    PSEAM(9, 4);
    PHASE(10) { pg8::Gemm g{HBUF, Wf2, M, 1024, FF}; pg8::StaticOrder S; S.init(M, 1024, G, bid);
                pg8::EpiResRms E{out, nullptr, out, nullptr, g_final, (float*)(ws + WS_XCH + 262144), (unsigned*)ws + 4096 + 4096};
                pg8::gemm_phase<pg8::EpiResRms, pg8::StaticOrder, false, true>(lds3, g, S, E); }
}
constexpr int N_PHASES = 12;
extern "C" void kernel_launch(void* const* d_in, const int* in_sizes, int n_in, void* d_out, int out_size, void* d_ws, size_t ws_size, hipStream_t stream) {
    static int grid = 0;
    if (grid == 0) {
        int dev = 0, cus = 0, per_cu = 0;
        (void)hipGetDevice(&dev); (void)hipDeviceGetAttribute(&cus, hipDeviceAttributeMultiprocessorCount, dev);
        (void)hipFuncSetAttribute((const void*)mega, hipFuncAttributeMaxDynamicSharedMemorySize, LDS_BYTES);
        (void)hipOccupancyMaxActiveBlocksPerMultiprocessor(&per_cu, (const void*)mega, NTHREADS, LDS_BYTES);
        if (per_cu < 1) { fprintf(stderr, "occupancy query says %d blocks/CU\n", per_cu); per_cu = 1; }
        grid = cus * 1;
        (void)hipGetLastError();
    }
    (void)hipMemsetAsync(d_ws, 0, 65536, stream);
    Args a{};
    for (int i = 0; i < 18; ++i) a.in[i] = (const float*)d_in[i];
    a.out = (float*)d_out; a.ws = (unsigned char*)d_ws;
    a.ph_lo = 0; a.ph_hi = N_PHASES; void* args[] = {&a};
    hipError_t e = hipLaunchCooperativeKernel((const void*)mega, dim3(grid), dim3(NTHREADS), args, LDS_BYTES, stream);
    if (e != hipSuccess) {
        (void)hipGetLastError();
        hipLaunchKernelGGL(mega, dim3(grid), dim3(NTHREADS), LDS_BYTES, stream, a);
    }
}
```

```cpp
#include <hip/hip_runtime.h>
#include <hip/hip_cooperative_groups.h>
#include <cstdio>
namespace cg = cooperative_groups;
#include <stdint.h>

typedef unsigned short bf16_t;
__device__ __forceinline__ float bf2f(bf16_t v) { return __uint_as_float(((unsigned)v) << 16); }
__device__ __forceinline__ bf16_t f2bf(float f) { unsigned u = __float_as_uint(f); return (bf16_t)((u + 0x7fffu + ((u >> 16) & 1u)) >> 16); }

constexpr int NB = 4, T = 4096, M = NB * T, D = 1024, DIN = 6944, FF = 4096;
constexpr float EPS = 1e-6f;
constexpr int C_MLI = 2048, C_NSG = 3336, C_MG = 3872;
constexpr int P_MLQ = 0, P_MLK = 512, P_MLV = 1024, P_MLO = 1536, P_NSQ = 2048, P_KC = 2560, P_VC = 2688, P_KS = 2816, P_VS = 2944, P_KW = 3072, P_VW = 3200, P_XAQ = 3328, PW = 3840;
constexpr size_t MiB = 1u << 20;
constexpr size_t WS_U = 40 * MiB;
constexpr size_t WS_P = 72 * MiB;
constexpr size_t WS_Y = 200 * MiB;
constexpr size_t WS_S32 = 248 * MiB;
constexpr size_t WS_MEMKV = 250 * MiB;
constexpr size_t WS_KC = 252 * MiB;
constexpr size_t WS_VC = 252 * MiB + 512 * 1024;
constexpr size_t WS_NA = 253 * MiB;
constexpr size_t WS_G = 253 * MiB + 512 * 1024;
constexpr size_t WS_MLOC = 253 * MiB + 512 * 1024 + 4096;
constexpr size_t WS_MPREV = 253 * MiB + 512 * 1024 + 8192;

__device__ __forceinline__ float wave_sum(float v) {
#pragma unroll
    for (int o = 1; o < 64; o <<= 1) v += __shfl_xor(v, o);
    return v;
}
__device__ __forceinline__ float wave_max(float v) {
#pragma unroll
    for (int o = 1; o < 64; o <<= 1) v = fmaxf(v, __shfl_xor(v, o));
    return v;
}

__device__ __forceinline__ float logsig(float x) { return fminf(x, 0.f) - log1pf(__expf(-fabsf(x))); }
namespace pg8 {
#define PG8_LAS __attribute__((address_space(3)))
typedef unsigned short bf16_t;
typedef short bf16x8 __attribute__((ext_vector_type(8)));
typedef float f32x4 __attribute__((ext_vector_type(4)));
typedef unsigned u32x4 __attribute__((ext_vector_type(4)));
constexpr int BM = 256, BK = 64, HALF = 128, HTB = HALF * BK * 2  , STAGE_BYTES = 8 * HTB, NXCD = 8, WGM = 8;

__host__ __device__ __forceinline__ int lds_byte(int r, int c) { const int st = (r >> 4) * 2 + (c >> 5), rr = r & 15, cc = c & 31, ob = rr * 64 + cc * 2; return st * 1024 + (ob ^ (((ob >> 9) & 1) << 5)); }
__host__ __device__ __forceinline__ void stage_rc(int b, int& R, int& C) { const int st = b / 1024, sb = b % 1024, swz = sb ^ (((sb >> 9) & 1) << 5); R = (st >> 1) * 16 + swz / 64; C = (st & 1) * 32 + (swz % 64) / 2; }
__host__ __device__ __forceinline__ int perm32(int rho) { const int n = rho >> 4, i = rho & 15; return 8 * (i >> 2) + 4 * n + (i & 3); }

struct Unit { int pm, pn, j; };
struct Gemm { const bf16_t* A; const bf16_t* Bt; int M, N, K; };

struct StaticOrder {
    int nM, nN, nwg, G, c;
    __host__ __device__ void init(int M, int N, int G_, int c_) { nM = M / BM; nN = N / BM; nwg = nM * nN; G = G_; c = c_; }
    __host__ __device__ bool next(int i, Unit& u) const {
        const long L = (long)i * G + c; if (L >= nwg) return false;
        int wgid = (int)L; { const int q = nwg / NXCD, r = nwg % NXCD, xcd = wgid % NXCD, off = wgid / NXCD; wgid = (xcd < r ? xcd * (q + 1) : r * (q + 1) + (xcd - r) * q) + off; }
        const int nig = WGM * nN, gid = wgid / nig, fm = gid * WGM, gsz = (nM - fm) < WGM ? (nM - fm) : WGM;
        u.pm = fm + ((wgid % nig) % gsz); u.pn = (wgid % nig) / gsz; u.j = 0; return true;
    }
    __device__ __forceinline__ const char* pa(const Gemm& g, const Unit& u, size_t tstep) const { return (const char*)g.A + (size_t)u.pm * tstep; }
    __device__ __forceinline__ const char* pb(const Gemm& g, const Unit& u, size_t tstep) const { return (const char*)g.Bt + (size_t)u.pn * tstep; }
    __device__ __forceinline__ void a_ready(const Unit&) const {}
    __device__ __forceinline__ void done(const Unit&) const {}
};

struct MergeOrder {
    StaticOrder so; size_t sa, sb;
    __device__ __forceinline__ bool next(int i, Unit& u) const { if (i >= 3) return false; const bool ok = so.next(0, u); u.j = i; return ok; }
    __device__ __forceinline__ const char* pa(const Gemm& g, const Unit& u, size_t tstep) const { return (const char*)g.A + (size_t)u.j * sa + (size_t)u.pm * tstep; }
    __device__ __forceinline__ const char* pb(const Gemm& g, const Unit& u, size_t tstep) const { return (const char*)g.Bt + (size_t)u.j * sb + (size_t)u.pn * tstep; }
    __device__ __forceinline__ void a_ready(const Unit&) const {}
    __device__ __forceinline__ void done(const Unit&) const {}
};
typedef float f32x2_t __attribute__((ext_vector_type(2))); typedef __bf16 bf16x2_t __attribute__((ext_vector_type(2)));
__device__ __forceinline__ unsigned cvt_pk_bf16(float lo, float hi) { f32x2_t v = {lo, hi}; bf16x2_t b = __builtin_convertvector(v, bf16x2_t); return __builtin_bit_cast(unsigned, b); }
typedef float f32x2 __attribute__((ext_vector_type(2)));

typedef unsigned u32x2 __attribute__((ext_vector_type(2)));
__device__ __forceinline__ float bflo(unsigned w) { return __uint_as_float(w << 16); }
__device__ __forceinline__ float bfhi(unsigned w) { return __uint_as_float(w & 0xffff0000u); }
template <int ACT> __device__ __forceinline__ f32x4 act4(f32x4 v) {
    if (ACT == 1) { f32x4 o; for (int e = 0; e < 4; ++e) o[e] = __builtin_amdgcn_rcpf(1.f + __expf(-v[e])); return o; }
    if (ACT == 2) { f32x4 o; for (int e = 0; e < 4; ++e) { const float r = fmaxf(v[e], 0.f); o[e] = r * r; } return o; }
    return v;
}
template <int ACT> struct EpiStore {
    static constexpr bool PERM = true, AFTER_DRAIN = false;
    bf16_t* O; const float* bias; float* S32; int ldc, small_pn;
    __device__ __forceinline__ void operator()(const f32x4 (&acc)[2][2][4][2], const Unit& u, int wr, int wc, int fr, int fq) const {
        asm volatile("s_waitcnt vmcnt(0)" ::: "memory");
        const int row0 = u.pm * BM + wr * 64 + fr, col0 = u.pn * BM + wc * 32 + 8 * fq;
        if (u.pn == small_pn) {
            if (wc == 0) {
                const f32x4 b0 = *(const f32x4*)(bias + col0), b1 = *(const f32x4*)(bias + col0 + 4);
#pragma unroll
                for (int ai = 0; ai < 2; ++ai)
#pragma unroll
                    for (int m = 0; m < 4; ++m) { float* rp = S32 + (size_t)(row0 + ai * HALF + m * 16) * 32 + 8 * fq;
                        *(f32x4*)rp = acc[ai][0][m][0] + acc[ai][1][m][0] + b0; *(f32x4*)(rp + 4) = acc[ai][0][m][1] + acc[ai][1][m][1] + b1; }
            }
            return;
        }
        f32x4 bv[2][2];
#pragma unroll
        for (int bj = 0; bj < 2; ++bj)
#pragma unroll
            for (int n = 0; n < 2; ++n) bv[bj][n] = bias ? *(const f32x4*)(bias + col0 + bj * HALF + 4 * n) : (f32x4){0.f, 0.f, 0.f, 0.f};
#pragma unroll
        for (int ai = 0; ai < 2; ++ai)
#pragma unroll
            for (int m = 0; m < 4; ++m) { bf16_t* rowp = O + (size_t)(row0 + ai * HALF + m * 16) * ldc + col0;
#pragma unroll
                for (int bj = 0; bj < 2; ++bj) { const f32x4 v0 = act4<ACT>(acc[ai][bj][m][0] + bv[bj][0]), v1 = act4<ACT>(acc[ai][bj][m][1] + bv[bj][1]);
                    u32x4 w; w.x = cvt_pk_bf16(v0[0], v0[1]); w.y = cvt_pk_bf16(v0[2], v0[3]); w.z = cvt_pk_bf16(v1[0], v1[1]); w.w = cvt_pk_bf16(v1[2], v1[3]);
                    *(u32x4*)(rowp + bj * HALF) = w; } }
    }
};
struct EpiMergeG {
    static constexpr bool PERM = true, AFTER_DRAIN = false;
    const bf16_t* G; bf16_t* Mp; bf16_t* Mb;
    template <bool HASP>
    __device__ __forceinline__ void body(const f32x4 (&acc)[2][2][4][2], int j, bf16_t* dst, size_t dpitch, int row0, int col0) const {
        constexpr size_t mpitch = 2048;
#pragma unroll
        for (int ai = 0; ai < 2; ++ai) { u32x4 gw[4][2], pw[4][2];
#pragma unroll
            for (int m = 0; m < 4; ++m)
#pragma unroll
                for (int bj = 0; bj < 2; ++bj) { const size_t row = (size_t)(row0 + ai * HALF + m * 16); const int col = col0 + bj * HALF;
                    gw[m][bj] = *(const u32x4*)(G + row * 4096 + j * 1024 + col); if (HASP) pw[m][bj] = *(const u32x4*)(Mp + row * mpitch + col); }
#pragma unroll
            for (int m = 0; m < 4; ++m)
#pragma unroll
                for (int bj = 0; bj < 2; ++bj) { const size_t row = (size_t)(row0 + ai * HALF + m * 16); const int col = col0 + bj * HALF; const u32x4 g4 = gw[m][bj];
                    f32x4 v0 = (f32x4){bflo(g4.x), bfhi(g4.x), bflo(g4.y), bfhi(g4.y)} * acc[ai][bj][m][0], v1 = (f32x4){bflo(g4.z), bfhi(g4.z), bflo(g4.w), bfhi(g4.w)} * acc[ai][bj][m][1];
                    if (HASP) { const u32x4 p4 = pw[m][bj]; v0 += (f32x4){bflo(p4.x), bfhi(p4.x), bflo(p4.y), bfhi(p4.y)}; v1 += (f32x4){bflo(p4.z), bfhi(p4.z), bflo(p4.w), bfhi(p4.w)}; }
                    u32x4 w; w.x = cvt_pk_bf16(v0[0], v0[1]); w.y = cvt_pk_bf16(v0[2], v0[3]); w.z = cvt_pk_bf16(v1[0], v1[1]); w.w = cvt_pk_bf16(v1[2], v1[3]); *(u32x4*)(dst + row * dpitch + col) = w; } }
    }
    __device__ __forceinline__ void operator()(const f32x4 (&acc)[2][2][4][2], const Unit& u, int wr, int wc, int fr, int fq) const {
        const int j = u.j;
        asm volatile("s_waitcnt vmcnt(0)" ::: "memory");
        const int row0 = u.pm * BM + wr * 64 + fr, col0 = u.pn * BM + wc * 32 + 8 * fq;
        if (j == 0) body<false>(acc, 0, Mp, 2048, row0, col0);
        else if (j == 1) body<true>(acc, 1, Mp, 2048, row0, col0);
        else body<true>(acc, 2, Mb, 1024, row0, col0);
    }
};
struct EpiResidF {
    static constexpr bool PERM = true, AFTER_DRAIN = false;
    const float* X; float* O;
    __device__ __forceinline__ void operator()(const f32x4 (&acc)[2][2][4][2], const Unit& u, int wr, int wc, int fr, int fq) const {
        asm volatile("s_waitcnt vmcnt(0)" ::: "memory");
        const int row0 = u.pm * BM + wr * 64 + fr, col0 = u.pn * BM + wc * 32 + 8 * fq;
#pragma unroll
        for (int ai = 0; ai < 2; ++ai)
#pragma unroll
            for (int m = 0; m < 4; ++m) { const size_t off = (size_t)(row0 + ai * HALF + m * 16) * 1024 + col0;
#pragma unroll
                for (int bj = 0; bj < 2; ++bj) { const f32x4 x0 = *(const f32x4*)(X + off + bj * HALF), x1 = *(const f32x4*)(X + off + bj * HALF + 4);
                    *(f32x4*)(O + off + bj * HALF) = x0 + acc[ai][bj][m][0]; *(f32x4*)(O + off + bj * HALF + 4) = x1 + acc[ai][bj][m][1]; } }
    }
};
struct EpiResRms {
    static constexpr bool PERM = false, AFTER_DRAIN = true;
    const float* R; float* Hout; float* Nf; bf16_t* Nb; const float* gain; float* xbuf; unsigned* cnt;
    __device__ __forceinline__ void fused(f32x4 (&acc)[2][2][4][2], const Unit& u, int wr, int wc, int fr, int fq, PG8_LAS unsigned char* lds, int wid, int lane) const {
        PG8_LAS float* Pp = (PG8_LAS float*)lds; PG8_LAS float* S = (PG8_LAS float*)(lds + 4096);
        const int col0 = u.pn * BM + wc * 32 + 4 * fq;
#pragma unroll
        for (int ai = 0; ai < 2; ++ai) { f32x4 pre[4][2][2];
#pragma unroll
            for (int m = 0; m < 4; ++m) { const size_t off = (size_t)(u.pm * BM + ai * HALF + wr * 64 + m * 16 + fr) * 1024 + col0;
#pragma unroll
                for (int bj = 0; bj < 2; ++bj)
#pragma unroll
                    for (int n = 0; n < 2; ++n) pre[m][bj][n] = *(const f32x4*)(R + off + bj * HALF + n * 16); }
#pragma unroll
            for (int m = 0; m < 4; ++m) { float sq = 0.f;
#pragma unroll
                for (int bj = 0; bj < 2; ++bj)
#pragma unroll
                    for (int n = 0; n < 2; ++n) { const f32x4 v = acc[ai][bj][m][n] + pre[m][bj][n]; acc[ai][bj][m][n] = v; sq += (v[0] * v[0] + v[1] * v[1]) + (v[2] * v[2] + v[3] * v[3]); }
                sq += __shfl_xor(sq, 16); sq += __shfl_xor(sq, 32);
                if (fq == 0) Pp[(ai * HALF + wr * 64 + m * 16 + fr) * 4 + wc] = sq; } }
        asm volatile("s_waitcnt lgkmcnt(0)" ::: "memory"); __builtin_amdgcn_s_barrier(); asm volatile("" ::: "memory");
        const int row = wid * 32 + (lane & 31);
        if (lane < 32) { const float tot = (Pp[row * 4 + 0] + Pp[row * 4 + 1]) + (Pp[row * 4 + 2] + Pp[row * 4 + 3]);
            __hip_atomic_store(xbuf + ((size_t)(u.pm * BM + row) * 4 + u.pn), tot, __ATOMIC_RELAXED, __HIP_MEMORY_SCOPE_AGENT); }
        asm volatile("s_waitcnt vmcnt(0)" ::: "memory");
        if (lane == 0) __hip_atomic_fetch_add(cnt + 64 * u.pm, 1u, __ATOMIC_RELAXED, __HIP_MEMORY_SCOPE_AGENT);
        if (wid == 0) { unsigned sp = 0;
            while ((unsigned)__builtin_amdgcn_readfirstlane(__hip_atomic_load(cnt + 64 * u.pm, __ATOMIC_RELAXED, __HIP_MEMORY_SCOPE_AGENT)) < 32u) { __builtin_amdgcn_s_sleep(2); if (++sp > (1u << 22)) break; }
            __builtin_amdgcn_fence(__ATOMIC_ACQUIRE, "agent"); }
        asm volatile("s_waitcnt vmcnt(0) lgkmcnt(0)" ::: "memory"); __builtin_amdgcn_s_barrier(); asm volatile("" ::: "memory");
        if (lane < 32) { const float* slot = xbuf + (size_t)(u.pm * BM + row) * 4; float t = 0.f;
#pragma unroll
            for (int q = 0; q < 4; ++q) t += __hip_atomic_load(slot + q, __ATOMIC_RELAXED, __HIP_MEMORY_SCOPE_AGENT);
            S[row] = rsqrtf(t * (1.0f / 1024.0f) + 1e-6f); }
        asm volatile("s_waitcnt lgkmcnt(0)" ::: "memory"); __builtin_amdgcn_s_barrier(); asm volatile("" ::: "memory");
        f32x4 gv[2][2];
#pragma unroll
        for (int bj = 0; bj < 2; ++bj)
#pragma unroll
            for (int n = 0; n < 2; ++n) gv[bj][n] = *(const f32x4*)(gain + col0 + bj * HALF + n * 16);
#pragma unroll
        for (int ai = 0; ai < 2; ++ai)
#pragma unroll
            for (int m = 0; m < 4; ++m) { const int r = ai * HALF + wr * 64 + m * 16 + fr; const float rs = S[r]; const size_t off = (size_t)(u.pm * BM + r) * 1024 + col0;
#pragma unroll
                for (int bj = 0; bj < 2; ++bj)
#pragma unroll
                    for (int n = 0; n < 2; ++n) { const f32x4 v = acc[ai][bj][m][n]; const f32x4 o = v * rs * gv[bj][n];
                        if (Hout) *(f32x4*)(Hout + off + bj * HALF + n * 16) = v;
                        if (Nf) *(f32x4*)(Nf + off + bj * HALF + n * 16) = o;
                        if (Nb) { u32x2 w; w.x = cvt_pk_bf16(o[0], o[1]); w.y = cvt_pk_bf16(o[2], o[3]); *(u32x2*)(Nb + off + bj * HALF + n * 16) = w; } } }
    }
};

template <class Epi, class Sched, bool ALIGN_EPI = false, bool SP2 = false>
__device__ __forceinline__ void gemm_phase(PG8_LAS unsigned char* lds, const Gemm g, const Sched& S, const Epi& E) {
    const int tid = threadIdx.x, wid = __builtin_amdgcn_readfirstlane(tid >> 6), lane = tid & 63, wr = wid >> 2, wc = wid & 3, fr = lane & 15, fq = lane >> 4;
    const int K = g.K, nt = K / BK;
    unsigned voffA[2], voffB[2];
#pragma unroll
    for (int i = 0; i < 2; ++i) { int R, C; stage_rc(tid * 16 + i * 8192, R, C); const int Rb = Epi::PERM ? ((R & ~31) + perm32(R & 31)) : R;
        voffA[i] = (unsigned)(R * K + C) * 2u; voffB[i] = (unsigned)(Rb * K + C) * 2u; }
    const size_t kstep = (size_t)(BK * 2);
    const size_t hstep = (size_t)HALF * K * 2;
    const size_t tstep = 2 * hstep;
    const unsigned ldsw = (unsigned)wid * 1024u;
    const int aoff = lds_byte(wr * 64 + fr, fq * 8), boff = lds_byte(wc * 32 + fr, fq * 8);
#define PG8_SA(b, h) (((b) * 2 + (h)) * HTB)
#define PG8_SB(b, h) ((4 + (b) * 2 + (h)) * HTB)
#define PG8_STAGE(bufoff, gbase, voff) do { _Pragma("unroll") for (int _i = 0; _i < 2; ++_i) \
        __builtin_amdgcn_global_load_lds((const unsigned*)((const char*)(gbase) + (voff)[_i]), (PG8_LAS unsigned*)(lds + (bufoff) + ldsw + _i * 8192), 16, 0, 0); } while (0)
#define PG8_LDA(dst, b, h) do { _Pragma("unroll") for (int m = 0; m < 4; ++m) _Pragma("unroll") for (int k = 0; k < 2; ++k) dst[m][k] = *(const PG8_LAS bf16x8*)(lds + PG8_SA(b, h) + aoff + m * 2048 + k * 1024); } while (0)
#define PG8_LDB(dst, b, h) do { _Pragma("unroll") for (int n = 0; n < 2; ++n) _Pragma("unroll") for (int k = 0; k < 2; ++k) dst[n][k] = *(const PG8_LAS bf16x8*)(lds + PG8_SB(b, h) + boff + n * 2048 + k * 1024); } while (0)
#define PG8_MMA(ai, bj, At, Bt) do { __builtin_amdgcn_s_setprio(1); _Pragma("unroll") for (int m = 0; m < 4; ++m) _Pragma("unroll") for (int n = 0; n < 2; ++n) _Pragma("unroll") for (int k = 0; k < 2; ++k) \
        acc[ai][bj][m][n] = __builtin_amdgcn_mfma_f32_16x16x32_bf16(Bt[n][k], At[m][k], acc[ai][bj][m][n], 0, 0, 0); __builtin_amdgcn_s_setprio(0); } while (0)
#define PG8_WAIT_V(n) asm volatile("s_waitcnt vmcnt(" #n ")" ::: "memory")
#define PG8_WAIT_L(n) asm volatile("s_waitcnt lgkmcnt(" #n ")" ::: "memory")
#define PG8_BAR __builtin_amdgcn_s_barrier()
#define PG8_SCHED __builtin_amdgcn_sched_barrier(0)
    Unit cur, nxt; int ui = 0;
    if (!S.next(0, cur)) return;
    f32x4 acc[2][2][4][2];
#pragma unroll
    for (int a = 0; a < 2; ++a)
#pragma unroll
        for (int b = 0; b < 2; ++b)
#pragma unroll
            for (int m = 0; m < 4; ++m)
#pragma unroll
                for (int n = 0; n < 2; ++n) acc[a][b][m][n] = (f32x4){0.f, 0.f, 0.f, 0.f};
    bf16x8 At[4][2], B0[2][2], B1[2][2];
    const char* cA = S.pa(g, cur, tstep); const char* cB = S.pb(g, cur, tstep);
    S.a_ready(cur);
    if constexpr (SP2) {
        PG8_STAGE(PG8_SB(0, 0), cB, voffB); PG8_STAGE(PG8_SB(0, 1), cB + hstep, voffB); PG8_STAGE(PG8_SA(0, 0), cA, voffA); PG8_STAGE(PG8_SA(0, 1), cA + hstep, voffA);
        if (wr == 1) PG8_BAR;
        PG8_WAIT_V(2); PG8_BAR;
        PG8_STAGE(PG8_SB(1, 0), cB + kstep, voffB); PG8_STAGE(PG8_SA(1, 0), cA + kstep, voffA); PG8_STAGE(PG8_SB(1, 1), cB + hstep + kstep, voffB);
        PG8_WAIT_V(6); PG8_BAR;
    } else {
        PG8_STAGE(PG8_SB(0, 0), cB, voffB); PG8_STAGE(PG8_SA(0, 0), cA, voffA); PG8_STAGE(PG8_SB(0, 1), cB + hstep, voffB); PG8_STAGE(PG8_SA(0, 1), cA + hstep, voffA);
        if (wr == 1) PG8_BAR;
        PG8_WAIT_V(4); PG8_BAR;
        PG8_STAGE(PG8_SB(1, 0), cB + kstep, voffB); PG8_STAGE(PG8_SA(1, 0), cA + kstep, voffA); PG8_STAGE(PG8_SB(1, 1), cB + hstep + kstep, voffB);
        PG8_WAIT_V(6); PG8_BAR;
    }
    for (;;) {
        const bool has_next = S.next(ui + 1, nxt);
        const char* nA = has_next ? S.pa(g, nxt, tstep) : cA; const char* nB = has_next ? S.pb(g, nxt, tstep) : cB;
        for (int t = 0; t < nt; t += 2) {
            const bool last = (t == nt - 2);
            const char* a1 = cA + (size_t)(t + 1) * kstep;
            const char* a2 = last ? nA : cA + (size_t)(t + 2) * kstep; const char* b2 = last ? nB : cB + (size_t)(t + 2) * kstep;
            const char* a3 = a2 + kstep; const char* b3 = b2 + kstep;
            if (last && has_next) S.a_ready(nxt);
            if constexpr (SP2) {
            PG8_LDB(B0, 0, 0); PG8_LDB(B1, 0, 1); PG8_SCHED; PG8_LDA(At, 0, 0); PG8_STAGE(PG8_SA(1, 1), a1 + hstep, voffA);
            PG8_WAIT_V(8); PG8_WAIT_L(0); PG8_BAR; PG8_MMA(0, 0, At, B0); PG8_MMA(0, 1, At, B1); PG8_BAR; PG8_SCHED;
            PG8_LDA(At, 0, 1); PG8_STAGE(PG8_SB(0, 0), b2, voffB); PG8_STAGE(PG8_SB(0, 1), b2 + hstep, voffB); PG8_STAGE(PG8_SA(0, 0), a2, voffA);
            PG8_WAIT_V(8); PG8_WAIT_L(0); PG8_BAR; PG8_MMA(1, 0, At, B0); PG8_MMA(1, 1, At, B1); PG8_BAR; PG8_SCHED;
            PG8_LDB(B0, 1, 0); PG8_LDB(B1, 1, 1); PG8_SCHED; PG8_LDA(At, 1, 0); PG8_STAGE(PG8_SA(0, 1), a2 + hstep, voffA);
            PG8_WAIT_V(8); PG8_WAIT_L(0); PG8_BAR; PG8_MMA(0, 0, At, B0); PG8_MMA(0, 1, At, B1); PG8_BAR; PG8_SCHED;
            PG8_LDA(At, 1, 1); PG8_STAGE(PG8_SB(1, 0), b3, voffB); PG8_STAGE(PG8_SB(1, 1), b3 + hstep, voffB); PG8_STAGE(PG8_SA(1, 0), a3, voffA);
            PG8_WAIT_V(8); PG8_WAIT_L(0); PG8_BAR; PG8_MMA(1, 0, At, B0); PG8_MMA(1, 1, At, B1); PG8_BAR; PG8_SCHED;
            } else {
            PG8_LDB(B0, 0, 0); PG8_SCHED; PG8_LDA(At, 0, 0); PG8_STAGE(PG8_SA(1, 1), a1 + hstep, voffA);
            PG8_WAIT_L(8); PG8_BAR; PG8_WAIT_L(0); PG8_MMA(0, 0, At, B0); PG8_BAR; PG8_SCHED;
            PG8_LDB(B1, 0, 1); PG8_STAGE(PG8_SB(0, 0), b2, voffB);
            PG8_BAR; PG8_WAIT_L(0); PG8_MMA(0, 1, At, B1); PG8_BAR;
            PG8_LDA(At, 0, 1); PG8_STAGE(PG8_SA(0, 0), a2, voffA);
            PG8_BAR; PG8_WAIT_L(0); PG8_MMA(1, 0, At, B0); PG8_BAR; PG8_SCHED;
            PG8_STAGE(PG8_SB(0, 1), b2 + hstep, voffB);
            PG8_WAIT_V(6); PG8_BAR; PG8_MMA(1, 1, At, B1); PG8_BAR;
            PG8_LDB(B0, 1, 0); PG8_SCHED; PG8_LDA(At, 1, 0); PG8_STAGE(PG8_SA(0, 1), a2 + hstep, voffA);
            PG8_WAIT_L(8); PG8_BAR; PG8_WAIT_L(0); PG8_MMA(0, 0, At, B0); PG8_BAR; PG8_SCHED;
            PG8_LDB(B1, 1, 1); PG8_STAGE(PG8_SB(1, 0), b3, voffB);
            PG8_BAR; PG8_WAIT_L(0); PG8_MMA(0, 1, At, B1); PG8_BAR;
            PG8_LDA(At, 1, 1); PG8_STAGE(PG8_SA(1, 0), a3, voffA);
            PG8_BAR; PG8_WAIT_L(0); PG8_MMA(1, 0, At, B0); PG8_BAR; PG8_SCHED;
            PG8_STAGE(PG8_SB(1, 1), b3 + hstep, voffB);
            PG8_WAIT_V(6); PG8_BAR; PG8_MMA(1, 1, At, B1); PG8_BAR;
            }
        }
        if constexpr (ALIGN_EPI) { if (wr == 0) PG8_BAR; }
        if constexpr (!Epi::AFTER_DRAIN) { E(acc, cur, wr, wc, fr, fq); S.done(cur); }
        if (!has_next) break;
#pragma unroll
        for (int a = 0; a < 2; ++a)
#pragma unroll
            for (int b = 0; b < 2; ++b)
#pragma unroll
                for (int m = 0; m < 4; ++m)
#pragma unroll
                    for (int n = 0; n < 2; ++n) acc[a][b][m][n] = (f32x4){0.f, 0.f, 0.f, 0.f};
        cur = nxt; cA = nA; cB = nB; ++ui;
        if constexpr (ALIGN_EPI) { if (wr == 1) PG8_BAR; }
    }
    PG8_WAIT_V(0);
    if constexpr (!ALIGN_EPI) { if (wr == 0) PG8_BAR; }
    PG8_BAR;
    if constexpr (Epi::AFTER_DRAIN) { E.fused(acc, cur, wr, wc, fr, fq, lds, wid, lane); S.done(cur); }
#undef PG8_SA
#undef PG8_SB
#undef PG8_STAGE
#undef PG8_LDA
#undef PG8_LDB
#undef PG8_MMA
#undef PG8_WAIT_V
#undef PG8_WAIT_L
#undef PG8_BAR
#undef PG8_SCHED
}
}

namespace nsa {
#define NLAS __attribute__((address_space(3)))
typedef short bf16x8 __attribute__((ext_vector_type(8)));
typedef short s16x4 __attribute__((ext_vector_type(4)));
typedef short v4i16_t __attribute__((ext_vector_type(4)));
typedef float f32x4 __attribute__((ext_vector_type(4)));
typedef unsigned u32x4 __attribute__((ext_vector_type(4)));
typedef unsigned u32x2 __attribute__((ext_vector_type(2)));
typedef unsigned long long u64;
constexpr int RS = 144, TILE_B = 64 * RS;
constexpr float LOG2E = 1.4426950408889634f;
constexpr int L_KB0 = 0, L_VB0 = TILE_B, L_KB1 = 2 * TILE_B, L_VB1 = 3 * TILE_B, L_CK = 4 * TILE_B, L_CV = 8 * TILE_B, L_IMP = 12 * TILE_B, L_MSK = L_IMP + 8192, L_WU = L_MSK + 256, L_END = L_WU + 64;
static_assert(L_END <= 131072, "nsa LDS map");
__device__ __forceinline__ s16x4 vtr(const NLAS char* p) { return __builtin_bit_cast(s16x4, __builtin_amdgcn_ds_read_tr16_b64_v4i16((NLAS v4i16_t*)p)); }
__device__ __forceinline__ f32x4 mfma16(bf16x8 a, bf16x8 b, f32x4 c) { return __builtin_amdgcn_mfma_f32_16x16x32_bf16(a, b, c, 0, 0, 0); }
__device__ __forceinline__ unsigned pkbf(float lo, float hi) { return pg8::cvt_pk_bf16(lo, hi); }
__device__ __forceinline__ void qk_tile(f32x4 (&s)[4], const NLAS char* Kb, const bf16x8 (&qf)[2], int i, int g, float kslope, float bt) {
    bf16x8 a[4][2]; const NLAS char* kp = Kb + i * RS + 16 * g;
#pragma unroll
    for (int kb = 0; kb < 4; ++kb) { a[kb][0] = *(const NLAS bf16x8*)(kp + kb * 16 * RS); a[kb][1] = *(const NLAS bf16x8*)(kp + kb * 16 * RS + 64); }
#pragma unroll
    for (int kb = 0; kb < 4; ++kb) { f32x4 ci; ci[0] = fmaf(kslope, (float)(kb * 16 + 0), bt); ci[1] = fmaf(kslope, (float)(kb * 16 + 1), bt); ci[2] = fmaf(kslope, (float)(kb * 16 + 2), bt); ci[3] = fmaf(kslope, (float)(kb * 16 + 3), bt);
        s[kb] = mfma16(a[kb][0], qf[0], ci); }
#pragma unroll
    for (int kb = 0; kb < 4; ++kb) s[kb] = mfma16(a[kb][1], qf[1], s[kb]);
}
__device__ __forceinline__ void pv_tile(f32x4 (&o)[4], const NLAS char* Vb, const f32x4 (&p)[4], int i, int g) {
    const NLAS char* vb = Vb + (4 * g + (i >> 2)) * RS + (i & 3) * 8;
    s16x4 lo[2][4], hi[2][4];
#pragma unroll
    for (int kk = 0; kk < 2; ++kk)
#pragma unroll
        for (int db = 0; db < 4; ++db) { const NLAS char* vp = vb + (2 * kk) * 16 * RS + db * 32; lo[kk][db] = vtr(vp); hi[kk][db] = vtr(vp + 16 * RS); }
    bf16x8 pf[2];
#pragma unroll
    for (int kk = 0; kk < 2; ++kk) { u32x4 pw; pw.x = pkbf(p[2 * kk][0], p[2 * kk][1]); pw.y = pkbf(p[2 * kk][2], p[2 * kk][3]); pw.z = pkbf(p[2 * kk + 1][0], p[2 * kk + 1][1]); pw.w = pkbf(p[2 * kk + 1][2], p[2 * kk + 1][3]);
        pf[kk] = __builtin_bit_cast(bf16x8, pw); }
#pragma unroll
    for (int kk = 0; kk < 2; ++kk)
#pragma unroll
        for (int db = 0; db < 4; ++db) o[db] = mfma16((bf16x8){lo[kk][db][0], lo[kk][db][1], lo[kk][db][2], lo[kk][db][3], hi[kk][db][0], hi[kk][db][1], hi[kk][db][2], hi[kk][db][3]}, pf[kk], o[db]);
}
constexpr float THR = 6.0f;
template <bool FIRST>
__device__ __forceinline__ float online_tile(f32x4 (&s)[4], float& m, float& l, f32x4 (&o)[4], bool needmask, int base, int lo, int hi) {
    float fret = 1.f;
    if (needmask) {
#pragma unroll
        for (int kb = 0; kb < 4; ++kb)
#pragma unroll
            for (int r = 0; r < 4; ++r) { const int pos = base + kb * 16 + r; s[kb][r] = (pos >= lo && pos <= hi) ? s[kb][r] : -INFINITY; } }
    float mt = fmaxf(fmaxf(fmaxf(s[0][0], s[0][1]), fmaxf(s[0][2], s[0][3])), fmaxf(fmaxf(s[1][0], s[1][1]), fmaxf(s[1][2], s[1][3])));
    mt = fmaxf(mt, fmaxf(fmaxf(fmaxf(s[2][0], s[2][1]), fmaxf(s[2][2], s[2][3])), fmaxf(fmaxf(s[3][0], s[3][1]), fmaxf(s[3][2], s[3][3]))));
    if (FIRST || __any(mt > THR)) {
        mt = fmaxf(mt, __shfl_xor(mt, 16)); mt = fmaxf(mt, __shfl_xor(mt, 32));
        const float d = FIRST ? ((mt == -INFINITY) ? 0.f : mt) : fmaxf(mt, 0.f), f = __builtin_amdgcn_exp2f(-d); m += d; l *= f; fret = f;
#pragma unroll
        for (int db = 0; db < 4; ++db) o[db] = o[db] * f;
#pragma unroll
        for (int kb = 0; kb < 4; ++kb) s[kb] = s[kb] - d; }
    float sum = 0.f;
#pragma unroll
    for (int kb = 0; kb < 4; ++kb)
#pragma unroll
        for (int r = 0; r < 4; ++r) { const float p = __builtin_amdgcn_exp2f(s[kb][r]); s[kb][r] = p; sum += p; }
    l += sum;
    return fret;
}
struct Stg { u32x4 k, v; };
__device__ __forceinline__ void stg_load(Stg& r, const bf16_t* kb, const bf16_t* vb, size_t pitch, int tid) { const size_t off = (size_t)(tid >> 3) * pitch + (tid & 7) * 8; r.k = *(const u32x4*)(kb + off); r.v = *(const u32x4*)(vb + off); }
__device__ __forceinline__ void stg_store(NLAS char* lds, int ko, int vo, const Stg& r, int tid) { const int off = (tid >> 3) * RS + (tid & 7) * 16; *(NLAS u32x4*)(lds + ko + off) = r.k; *(NLAS u32x4*)(lds + vo + off) = r.v; }
template <bool FIRST>
__device__ __forceinline__ void pair_tiles(const NLAS char* lds, int koA, int voA, int koB, int voB, bool na, bool nb, const bf16x8 (&qf)[2], int i, int g, float slope2,
                                           float btA, float btB, bool maskA, bool maskB, int baseA, int baseB, int lo, int hi, float& m, float& l, f32x4 (&o)[4]) {
    f32x4 sa[4], sb[4];
    if (na) qk_tile(sa, lds + koA, qf, i, g, slope2, btA - m);
    if (nb) qk_tile(sb, lds + koB, qf, i, g, slope2, btB - m);
    float da = 0.f;
    if (na) { const float m0 = m; online_tile<FIRST>(sa, m, l, o, FIRST || maskA, baseA, lo, hi); da = m - m0; pv_tile(o, lds + voA, sa, i, g); }
    if (nb) { if (__any(da != 0.f)) {
#pragma unroll
            for (int kb = 0; kb < 4; ++kb) sb[kb] = sb[kb] - da; }
        online_tile<false>(sb, m, l, o, maskB, baseB, lo, hi); pv_tile(o, lds + voB, sb, i, g); }
}
__device__ __forceinline__ float sigm(float v) { return __builtin_amdgcn_rcpf(1.f + __expf(-v)); }

__device__ __forceinline__ void unit(NLAS char* lds, const bf16_t* P, const float* S32, const bf16_t* KC, const bf16_t* VC, bf16_t* Ynsa, int b, int gq, int ti) {
    const int tid = threadIdx.x, lane = tid & 63, w = __builtin_amdgcn_readfirstlane(tid >> 6), i = lane & 15, g = lane >> 4;
    const int t0 = ti * 32, tl_mine = i >> 2, r = i & 3, h = gq * 4 + r, t = t0 + 4 * w + tl_mine; const size_t m = (size_t)b * T + t;
    const float slope2 = __builtin_amdgcn_exp2f(-(float)(h + 1)) * LOG2E;
    bf16x8 qf[2]; constexpr float QS = 0.125f * LOG2E;
    { const bf16_t* qp = P + m * PW + P_NSQ + h * 64 + 8 * g;
#pragma unroll
      for (int ks = 0; ks < 2; ++ks) { const u32x4 raw = *(const u32x4*)(qp + 32 * ks); u32x4 sc;
          sc.x = pkbf(pg8::bflo(raw.x) * QS, pg8::bfhi(raw.x) * QS); sc.y = pkbf(pg8::bflo(raw.y) * QS, pg8::bfhi(raw.y) * QS);
          sc.z = pkbf(pg8::bflo(raw.z) * QS, pg8::bfhi(raw.z) * QS); sc.w = pkbf(pg8::bflo(raw.w) * QS, pg8::bfhi(raw.w) * QS);
          qf[ks] = __builtin_bit_cast(bf16x8, sc); } }
    const float* gp = S32 + m * 32 + 8 + h * 3;
    const float gate0 = sigm(gp[0]), gate1 = sigm(gp[1]), gate2 = sigm(gp[2]);
    f32x4 outacc[4];
#pragma unroll
    for (int db = 0; db < 4; ++db) outacc[db] = (f32x4){0.f, 0.f, 0.f, 0.f};
    const int ntc = (ti >> 5) + 1;
    { Stg sc_[4];
#pragma unroll
      for (int tile = 0; tile < 4; ++tile) if (tile < ntc) { const size_t row0 = ((size_t)(b * 256 + tile * 64) * 2 + gq) * 64; stg_load(sc_[tile], KC + row0, VC + row0, 128, tid); }
#pragma unroll
      for (int tile = 0; tile < 4; ++tile) if (tile < ntc) stg_store(lds, L_CK + tile * TILE_B, L_CV + tile * TILE_B, sc_[tile], tid); }
    __syncthreads();
    { const int nmax = (t - 31) >> 4, nmax_w = ((t0 + 4 * w) - 31) >> 4; const float kslope = 16.f * slope2, c = -slope2 * (float)(t - 31);
      float mc = 0.f, lc = 0.f; f32x4 oc[4]; float av[16], cv[16];
#pragma unroll
      for (int db = 0; db < 4; ++db) oc[db] = (f32x4){0.f, 0.f, 0.f, 0.f};
#pragma unroll
      for (int q = 0; q < 16; ++q) { av[q] = 0.f; cv[q] = 0.f; }
      bool firstc = true;
#pragma unroll
      for (int tile = 3; tile >= 0; --tile) {
          if (tile < ntc) { f32x4 s[4]; qk_tile(s, lds + L_CK + tile * TILE_B, qf, i, g, kslope, fmaf(kslope, (float)(tile * 64 + 4 * g), c) - mc);
              const bool needmask = (tile * 64 + 63 > nmax_w);
              const float f = firstc ? online_tile<true>(s, mc, lc, oc, needmask, tile * 64 + 4 * g, -0x40000000, nmax) : online_tile<false>(s, mc, lc, oc, needmask, tile * 64 + 4 * g, -0x40000000, nmax);
              if (!firstc && __any(f != 1.f)) {
#pragma unroll
                  for (int q = 0; q < 16; ++q) { av[q] *= f; cv[q] *= f; } }
              firstc = false;
              pv_tile(oc, lds + L_CV + tile * TILE_B, s, i, g);
#pragma unroll
              for (int kb = 0; kb < 4; ++kb) { const f32x4 pv = s[kb];
                  float a = (pv[0] + pv[1]) + (pv[2] + pv[3]), cc = pv[3];
                  a += __shfl_xor(a, 1); a += __shfl_xor(a, 2); cc += __shfl_xor(cc, 1); cc += __shfl_xor(cc, 2);
                  av[tile * 4 + kb] = a; cv[tile * 4 + kb] = cc; } }
      }
      lc += __shfl_xor(lc, 16); lc += __shfl_xor(lc, 32);
      const float inv = lc > 0.f ? 1.f / lc : 0.f, g0i = gate0 * inv;
#pragma unroll
      for (int db = 0; db < 4; ++db) outacc[db] = outacc[db] + oc[db] * g0i;
      NLAS float* imp_s = (NLAS float*)(lds + L_IMP) + (w * 4 + tl_mine) * 64;
      float cprev = 0.f;
#pragma unroll
      for (int q = 0; q < 16; ++q) { const float up = __shfl(cv[q], (lane + 48) & 63); const float im = (av[q] + (g > 0 ? up : cprev)) * inv; cprev = up; if (r == 0) imp_s[4 * q + g] = im; }
    }
    NLAS float* impw = (NLAS float*)(lds + L_IMP) + w * 256;
    float myscore[4];
    asm volatile("s_waitcnt lgkmcnt(0)" ::: "memory");
#pragma unroll
    for (int tl = 0; tl < 4; ++tl) { const int tt = t0 + 4 * w + tl, cur = tt >> 6, j = lane; const bool valid = j <= cur, forced = (j == 0) || (j == cur) || (j == cur - 1);
        const float s = valid ? impw[tl * 64 + j] + (forced ? 1000.f : 0.f) : -1e30f; myscore[tl] = s; }
    asm volatile("s_waitcnt lgkmcnt(0)" ::: "memory");
#pragma unroll
    for (int tl = 0; tl < 4; ++tl) impw[tl * 64 + lane] = myscore[tl];
    asm volatile("s_waitcnt lgkmcnt(0)" ::: "memory");
    u64 wmask[4], wun = 0ull;
#pragma unroll
    for (int tl = 0; tl < 4; ++tl) { const int tt = t0 + 4 * w + tl, cur = tt >> 6; const float s = myscore[tl]; int rank = 0;
        for (int jj = 0; jj < 64; ++jj) { const float o = impw[tl * 64 + jj]; rank += (o > s || (o == s && jj < lane)) ? 1 : 0; }
        wmask[tl] = __ballot(rank < 16 && lane <= cur); wun |= wmask[tl]; }
    if (lane == 0) { NLAS u64* mk = (NLAS u64*)(lds + L_MSK) + w * 4; mk[0] = wmask[0]; mk[1] = wmask[1]; mk[2] = wmask[2]; mk[3] = wmask[3]; ((NLAS u64*)(lds + L_WU))[w] = wun; }
    __syncthreads();
    const u64 mymask = ((const NLAS u64*)(lds + L_MSK))[w * 4 + tl_mine];
    u64 uall = 0ull;
#pragma unroll
    for (int ww = 0; ww < 8; ++ww) uall |= ((const NLAS u64*)(lds + L_WU))[ww];
    uall = ((u64)__builtin_amdgcn_readfirstlane((unsigned)(uall >> 32)) << 32) | (u64)__builtin_amdgcn_readfirstlane((unsigned)uall);
    const size_t rowb = (size_t)b * T;
    {
        float ms_ = 0.f, ls = 0.f; f32x4 os[4];
#pragma unroll
        for (int db = 0; db < 4; ++db) os[db] = (f32x4){0.f, 0.f, 0.f, 0.f};
        const bf16_t* kcol = P + rowb * PW + P_KS + gq * 64; const bf16_t* vcol = P + rowb * PW + P_VS + gq * 64;
        const float c = -slope2 * (float)t;
        const int jcur = t0 >> 6;
        u64 rem = uall & ((1ull << jcur) - 1ull);
#define NSA_NEXT(dst) { dst = rem ? 63 - __builtin_clzll(rem) : -1; if (dst >= 0) rem &= ~(1ull << dst); }
#define NSA_KO(p, h) ((p) ? L_CK + (h) * TILE_B : ((h) ? L_KB1 : L_KB0))
#define NSA_VO(p, h) ((p) ? L_CV + (h) * TILE_B : ((h) ? L_VB1 : L_VB0))
        int ja = jcur, jb, na_, nb_, cur = 0; bool first = true;
        NSA_NEXT(jb)
        Stg sr0, sr1;
        stg_load(sr0, kcol + (size_t)ja * 64 * PW, vcol + (size_t)ja * 64 * PW, PW, tid); stg_store(lds, L_KB0, L_VB0, sr0, tid);
        if (jb >= 0) { stg_load(sr1, kcol + (size_t)jb * 64 * PW, vcol + (size_t)jb * 64 * PW, PW, tid); stg_store(lds, L_KB1, L_VB1, sr1, tid); }
        NSA_NEXT(na_) NSA_NEXT(nb_)
        if (na_ >= 0) stg_load(sr0, kcol + (size_t)na_ * 64 * PW, vcol + (size_t)na_ * 64 * PW, PW, tid);
        if (nb_ >= 0) stg_load(sr1, kcol + (size_t)nb_ * 64 * PW, vcol + (size_t)nb_ * 64 * PW, PW, tid);
        __syncthreads();
        for (;;) {
            if (na_ >= 0) stg_store(lds, NSA_KO(cur ^ 1, 0), NSA_VO(cur ^ 1, 0), sr0, tid);
            if (nb_ >= 0) stg_store(lds, NSA_KO(cur ^ 1, 1), NSA_VO(cur ^ 1, 1), sr1, tid);
            int nna, nnb; NSA_NEXT(nna) NSA_NEXT(nnb)
            if (nna >= 0) stg_load(sr0, kcol + (size_t)nna * 64 * PW, vcol + (size_t)nna * 64 * PW, PW, tid);
            if (nnb >= 0) stg_load(sr1, kcol + (size_t)nnb * 64 * PW, vcol + (size_t)nnb * 64 * PW, PW, tid);
            const bool na = (wun >> ja) & 1ull, nb = (jb >= 0) && ((wun >> jb) & 1ull);
            if (na || nb) {
                const float btA = fmaf(slope2, (float)(ja * 64 + 4 * g), c) + (((mymask >> ja) & 1ull) ? 0.f : -1e30f);
                const float btB = fmaf(slope2, (float)((jb < 0 ? 0 : jb) * 64 + 4 * g), c) + ((jb >= 0 && ((mymask >> jb) & 1ull)) ? 0.f : -1e30f);
                if (first) pair_tiles<true>(lds, NSA_KO(cur, 0), NSA_VO(cur, 0), NSA_KO(cur, 1), NSA_VO(cur, 1), na, nb, qf, i, g, slope2, btA, btB, true, false, ja * 64 + 4 * g, 0, 0, t, ms_, ls, os);
                else pair_tiles<false>(lds, NSA_KO(cur, 0), NSA_VO(cur, 0), NSA_KO(cur, 1), NSA_VO(cur, 1), na, nb, qf, i, g, slope2, btA, btB, false, false, 0, 0, 0, t, ms_, ls, os); }
            first = false;
            __syncthreads();
            if (na_ < 0) break;
            ja = na_; jb = nb_; na_ = nna; nb_ = nnb; cur ^= 1;
        }
        ls += __shfl_xor(ls, 16); ls += __shfl_xor(ls, 32);
        const float sc1 = gate1 / ls;
#pragma unroll
        for (int db = 0; db < 4; ++db) outacc[db] = outacc[db] + os[db] * sc1;
    }
    {
        float mw = 0.f, lw = 0.f; f32x4 ow[4];
#pragma unroll
        for (int db = 0; db < 4; ++db) ow[db] = (f32x4){0.f, 0.f, 0.f, 0.f};
        const bf16_t* kcol = P + rowb * PW + P_KW + gq * 64; const bf16_t* vcol = P + rowb * PW + P_VW + gq * 64;
        const float c = -slope2 * (float)t;
        const int j0 = (t0 - 511) > 0 ? ((t0 - 511) >> 6) : 0, j1 = t0 >> 6, tw0 = t0 + 4 * w;
        int ja = j1, cur = 0; bool first = true;
        Stg sr0, sr1;
        stg_load(sr0, kcol + (size_t)ja * 64 * PW, vcol + (size_t)ja * 64 * PW, PW, tid); stg_store(lds, L_KB0, L_VB0, sr0, tid);
        if (ja - 1 >= j0) { stg_load(sr1, kcol + (size_t)(ja - 1) * 64 * PW, vcol + (size_t)(ja - 1) * 64 * PW, PW, tid); stg_store(lds, L_KB1, L_VB1, sr1, tid); }
        if (ja - 2 >= j0) stg_load(sr0, kcol + (size_t)(ja - 2) * 64 * PW, vcol + (size_t)(ja - 2) * 64 * PW, PW, tid);
        if (ja - 3 >= j0) stg_load(sr1, kcol + (size_t)(ja - 3) * 64 * PW, vcol + (size_t)(ja - 3) * 64 * PW, PW, tid);
        __syncthreads();
        for (;;) {
            if (ja - 2 >= j0) stg_store(lds, NSA_KO(cur ^ 1, 0), NSA_VO(cur ^ 1, 0), sr0, tid);
            if (ja - 3 >= j0) stg_store(lds, NSA_KO(cur ^ 1, 1), NSA_VO(cur ^ 1, 1), sr1, tid);
            if (ja - 4 >= j0) stg_load(sr0, kcol + (size_t)(ja - 4) * 64 * PW, vcol + (size_t)(ja - 4) * 64 * PW, PW, tid);
            if (ja - 5 >= j0) stg_load(sr1, kcol + (size_t)(ja - 5) * 64 * PW, vcol + (size_t)(ja - 5) * 64 * PW, PW, tid);
            const int jb = ja - 1;
            const bool na = (64 * ja <= tw0 + 3) && (64 * ja + 63 >= tw0 - 511), nb = (jb >= j0) && (64 * jb <= tw0 + 3) && (64 * jb + 63 >= tw0 - 511);
            if (na || nb) {
                const float btA = fmaf(slope2, (float)(ja * 64 + 4 * g), c), btB = fmaf(slope2, (float)(jb * 64 + 4 * g), c);
                const bool maskA = (64 * ja < tw0 + 3 - 511), maskB = (64 * jb < tw0 + 3 - 511);
                if (first) pair_tiles<true>(lds, NSA_KO(cur, 0), NSA_VO(cur, 0), NSA_KO(cur, 1), NSA_VO(cur, 1), na, nb, qf, i, g, slope2, btA, btB, true, maskB, ja * 64 + 4 * g, jb * 64 + 4 * g, t - 511, t, mw, lw, ow);
                else pair_tiles<false>(lds, NSA_KO(cur, 0), NSA_VO(cur, 0), NSA_KO(cur, 1), NSA_VO(cur, 1), na, nb, qf, i, g, slope2, btA, btB, maskA, maskB, ja * 64 + 4 * g, jb * 64 + 4 * g, t - 511, t, mw, lw, ow); }
            first = false;
            __syncthreads();
            if (ja - 2 < j0) break;
            ja -= 2; cur ^= 1;
        }
        lw += __shfl_xor(lw, 16); lw += __shfl_xor(lw, 32);
        const float sc2 = gate2 / lw;
#pragma unroll
        for (int db = 0; db < 4; ++db) outacc[db] = outacc[db] + ow[db] * sc2;
    }
    bf16_t* yo = Ynsa + m * 512 + h * 64 + 4 * g;
#pragma unroll
    for (int db = 0; db < 4; ++db) { u32x2 v; v.x = pkbf(outacc[db][0], outacc[db][1]); v.y = pkbf(outacc[db][2], outacc[db][3]); *(u32x2*)(yo + db * 16) = v; }
}
__device__ __forceinline__ void phase(NLAS char* lds, const bf16_t* P, const float* S32, const bf16_t* KC, const bf16_t* VC, bf16_t* Ynsa) {
    const int G = gridDim.x, bid = blockIdx.x;
    if (G == 256) { const int base = bid >> 3, bg = bid & 7;
#pragma unroll 1
        for (int k = 0; k < 4; ++k) { const int ti = (k == 0) ? 127 - base : (k == 1) ? 64 + base : (k == 2) ? 63 - base : base; unit(lds, P, S32, KC, VC, Ynsa, bg >> 1, bg & 1, ti); } }
    else {
#pragma unroll 1
        for (int u = bid; u < 1024; u += G) unit(lds, P, S32, KC, VC, Ynsa, (u & 7) >> 1, u & 1, 127 - (u >> 3)); }
}
}

namespace xa {
using nsa::bf16x8; using nsa::s16x4; using nsa::f32x4; using nsa::u32x4; using nsa::u32x2; using nsa::vtr; using nsa::mfma16; using nsa::pkbf;
constexpr int RS = 272, TILE_B = 64 * RS;
__device__ __forceinline__ int l_k(int tile) { return tile * 2 * TILE_B; }
__device__ __forceinline__ int l_v(int tile) { return tile * 2 * TILE_B + TILE_B; }
__device__ __forceinline__ void unit(NLAS char* lds, const bf16_t* P, const bf16_t* MEMKV, bf16_t* Yxa, int b, int h, int tt) {
    const int tid = threadIdx.x, lane = tid & 63, w = __builtin_amdgcn_readfirstlane(tid >> 6), i = lane & 15, g = lane >> 4;
    const size_t m = (size_t)b * T + tt * 128 + 16 * w + i;
    const bf16_t* kbase = MEMKV + (size_t)b * 256 * 1024 + h * 128;
    { u32x4 st[4][4]; const bf16_t* p0 = kbase + (size_t)(tid >> 3) * 1024 + (tid & 7) * 8;
#pragma unroll
      for (int tile = 0; tile < 4; ++tile) { const bf16_t* p = p0 + (size_t)tile * 64 * 1024; st[tile][0] = *(const u32x4*)p; st[tile][1] = *(const u32x4*)(p + 64); st[tile][2] = *(const u32x4*)(p + 512); st[tile][3] = *(const u32x4*)(p + 576); }
      const int off = (tid >> 3) * RS + (tid & 7) * 16;
#pragma unroll
      for (int tile = 0; tile < 4; ++tile) { *(NLAS u32x4*)(lds + l_k(tile) + off) = st[tile][0]; *(NLAS u32x4*)(lds + l_k(tile) + off + 128) = st[tile][1]; *(NLAS u32x4*)(lds + l_v(tile) + off) = st[tile][2]; *(NLAS u32x4*)(lds + l_v(tile) + off + 128) = st[tile][3]; } }
    bf16x8 qf[4];
    { const bf16_t* qp = P + m * PW + P_XAQ + h * 128 + 8 * g;
#pragma unroll
      for (int ks = 0; ks < 4; ++ks) qf[ks] = *(const bf16x8*)(qp + 32 * ks); }
    const float scale2 = 0.08838834764831845f * nsa::LOG2E;
    float mx = -INFINITY, l = 0.f; f32x4 o[8];
#pragma unroll
    for (int db = 0; db < 8; ++db) o[db] = (f32x4){0.f, 0.f, 0.f, 0.f};
    __syncthreads();
#pragma unroll 1
    for (int tile = 0; tile < 4; ++tile) {
        const NLAS char* Kb = lds + l_k(tile); const NLAS char* Vb = lds + l_v(tile);
        f32x4 s[4];
        { bf16x8 a[4][4];
#pragma unroll
          for (int kb = 0; kb < 4; ++kb)
#pragma unroll
              for (int ks = 0; ks < 4; ++ks) a[kb][ks] = *(const NLAS bf16x8*)(Kb + (kb * 16 + i) * RS + 16 * g + 64 * ks);
#pragma unroll
          for (int kb = 0; kb < 4; ++kb) s[kb] = mfma16(a[kb][0], qf[0], (f32x4){0.f, 0.f, 0.f, 0.f});
#pragma unroll
          for (int ks = 1; ks < 4; ++ks)
#pragma unroll
              for (int kb = 0; kb < 4; ++kb) s[kb] = mfma16(a[kb][ks], qf[ks], s[kb]); }
        float mt = -INFINITY;
#pragma unroll
        for (int kb = 0; kb < 4; ++kb)
#pragma unroll
            for (int r = 0; r < 4; ++r) { const float v = s[kb][r] * scale2; s[kb][r] = v; mt = fmaxf(mt, v); }
        mt = fmaxf(mt, __shfl_xor(mt, 16)); mt = fmaxf(mt, __shfl_xor(mt, 32));
        const float mn = fmaxf(mx, mt), alpha = __builtin_amdgcn_exp2f(mx - mn); float sum = 0.f;
#pragma unroll
        for (int kb = 0; kb < 4; ++kb)
#pragma unroll
            for (int r = 0; r < 4; ++r) { const float p = __builtin_amdgcn_exp2f(s[kb][r] - mn); s[kb][r] = p; sum += p; }
        l = l * alpha + sum; mx = mn;
#pragma unroll
        for (int db = 0; db < 8; ++db) o[db] = o[db] * alpha;
        const NLAS char* vb = Vb + (4 * g + (i >> 2)) * RS + (i & 3) * 8;
#pragma unroll
        for (int kk = 0; kk < 2; ++kk) {
            u32x4 pw; pw.x = pkbf(s[2 * kk][0], s[2 * kk][1]); pw.y = pkbf(s[2 * kk][2], s[2 * kk][3]); pw.z = pkbf(s[2 * kk + 1][0], s[2 * kk + 1][1]); pw.w = pkbf(s[2 * kk + 1][2], s[2 * kk + 1][3]);
            const bf16x8 pf = __builtin_bit_cast(bf16x8, pw);
            s16x4 lo[8], hi[8];
#pragma unroll
            for (int db = 0; db < 8; ++db) { const NLAS char* vp = vb + (2 * kk) * 16 * RS + db * 32; lo[db] = vtr(vp); hi[db] = vtr(vp + 16 * RS); }
#pragma unroll
            for (int db = 0; db < 8; ++db) o[db] = mfma16((bf16x8){lo[db][0], lo[db][1], lo[db][2], lo[db][3], hi[db][0], hi[db][1], hi[db][2], hi[db][3]}, pf, o[db]);
        }
    }
    l += __shfl_xor(l, 16); l += __shfl_xor(l, 32);
    const float inv = 1.f / l;
    bf16_t* yo = Yxa + m * 512 + h * 128 + 4 * g;
#pragma unroll
    for (int db = 0; db < 8; ++db) { u32x2 v; v.x = pkbf(o[db][0] * inv, o[db][1] * inv); v.y = pkbf(o[db][2] * inv, o[db][3] * inv); *(u32x2*)(yo + db * 16) = v; }
    __syncthreads();
}
__device__ __forceinline__ void memkv_tile(const bf16_t* MEMN, const bf16_t* Wmkv, bf16_t* MEMKV, int tile) {
    const int tid = threadIdx.x, lane = tid & 63, w = __builtin_amdgcn_readfirstlane(tid >> 6), i = lane & 15, g = lane >> 4;
    const int r0 = (tile >> 4) * 64 + (w >> 1) * 16, c0 = (tile & 15) * 64 + (w & 1) * 32;
    const bf16_t* ap = MEMN + (size_t)(r0 + i) * 1024 + 8 * g; const bf16_t* bp = Wmkv + (size_t)(c0 + i) * 1024 + 8 * g;
    f32x4 acc0 = (f32x4){0.f, 0.f, 0.f, 0.f}, acc1 = acc0;
#pragma unroll 1
    for (int k0 = 0; k0 < 32; k0 += 8) { bf16x8 a[8], b0[8], b1[8];
#pragma unroll
        for (int kk = 0; kk < 8; ++kk) { a[kk] = *(const bf16x8*)(ap + 32 * (k0 + kk)); b0[kk] = *(const bf16x8*)(bp + 32 * (k0 + kk)); b1[kk] = *(const bf16x8*)(bp + 16 * 1024 + 32 * (k0 + kk)); }
#pragma unroll
        for (int kk = 0; kk < 8; ++kk) { acc0 = mfma16(a[kk], b0[kk], acc0); acc1 = mfma16(a[kk], b1[kk], acc1); } }
#pragma unroll
    for (int r = 0; r < 4; ++r) { bf16_t* o = MEMKV + (size_t)(r0 + 4 * g + r) * 1024 + c0 + i; o[0] = f2bf(acc0[r]); o[16] = f2bf(acc1[r]); }
}
__device__ __forceinline__ void phase(NLAS char* lds, const bf16_t* P, const bf16_t* MEMKV, bf16_t* Yxa) {
#pragma unroll 1
    for (int u = blockIdx.x; u < 512; u += gridDim.x) unit(lds, P, MEMKV, Yxa, u >> 7, (u >> 5) & 3, u & 31);
}
}

namespace ml {
using nsa::bf16x8; using nsa::s16x4; using nsa::f32x4; using nsa::u32x4; using nsa::u32x2; using nsa::vtr; using nsa::mfma16; using nsa::pkbf;
constexpr int RS = 272, TB = 64 * RS, RSS = 144;
constexpr float KSCALE = 0.08838834764831845f;
__device__ __forceinline__ float scan_add(float v, int lane) {
#pragma unroll
    for (int o = 1; o < 64; o <<= 1) { const float u = __shfl_up(v, o); if (lane >= o) v += u; }
    return v; }
__device__ __forceinline__ float scan_max(float v, int lane) {
#pragma unroll
    for (int o = 1; o < 64; o <<= 1) { const float u = __shfl_up(v, o); if (lane >= o) v = fmaxf(v, u); }
    return v; }
__device__ __forceinline__ bf16x8 trpair(const NLAS char* p, int hi_off) { const s16x4 lo = vtr(p), hi = vtr(p + hi_off); return (bf16x8){lo[0], lo[1], lo[2], lo[3], hi[0], hi[1], hi[2], hi[3]}; }
__device__ __forceinline__ void load_conv(NLAS char* dst, const bf16_t* P, const float* cw, int colP, int cwc, size_t m0, int tseq0, int tid) {
    const int s = tid >> 3, c16 = (tid & 7) * 16;
#pragma unroll
    for (int half = 0; half < 2; ++half) { const int c = c16 + half * 8; float acc[8];
#pragma unroll
        for (int e = 0; e < 8; ++e) acc[e] = 0.f;
#pragma unroll
        for (int j = 0; j < 4; ++j) { if (tseq0 + s - j >= 0) { const u32x4 raw = *(const u32x4*)(P + (m0 + s - j) * PW + colP + c);
            const f32x4 w0 = *(const f32x4*)(cw + j * 1024 + cwc + c), w1 = *(const f32x4*)(cw + j * 1024 + cwc + c + 4);
            acc[0] += w0[0] * pg8::bflo(raw.x); acc[1] += w0[1] * pg8::bfhi(raw.x); acc[2] += w0[2] * pg8::bflo(raw.y); acc[3] += w0[3] * pg8::bfhi(raw.y);
            acc[4] += w1[0] * pg8::bflo(raw.z); acc[5] += w1[1] * pg8::bfhi(raw.z); acc[6] += w1[2] * pg8::bflo(raw.w); acc[7] += w1[3] * pg8::bfhi(raw.w); } }
#pragma unroll
        for (int e = 0; e < 8; ++e) acc[e] = acc[e] * __builtin_amdgcn_rcpf(1.f + __expf(-acc[e]));
        u32x4 o; o.x = pkbf(acc[0], acc[1]); o.y = pkbf(acc[2], acc[3]); o.z = pkbf(acc[4], acc[5]); o.w = pkbf(acc[6], acc[7]);
        *(NLAS u32x4*)(dst + s * RS + c * 2) = o; }
}
__device__ __forceinline__ void m1_unit(NLAS char* lds, const bf16_t* P, const float* cw, const float* S32, bf16_t* Abuf, float* NA, float* Gc, float* Mloc, int ci) {
    constexpr int L_K = 0, L_EV = TB, L_E = 2 * TB;
    const int tid = threadIdx.x, lane = tid & 63, w = __builtin_amdgcn_readfirstlane(tid >> 6), i = lane & 15, g = lane >> 4;
    const int c = ci & 63, bh = ci >> 6, h = bh & 3, b = bh >> 2; const size_t m0 = (size_t)b * T + c * 64;
    NLAS float* eS = (NLAS float*)(lds + L_E);
    if (w == 0) { const float fpre = S32[(m0 + lane) * 32 + 4 + h], ipre = S32[(m0 + lane) * 32 + h];
        const float bcs = scan_add(logsig(fpre), lane), gtot = __shfl(bcs, 63), wend = gtot - bcs + ipre, mloc = wave_max(wend);
        eS[lane] = __expf(wend - mloc) * KSCALE; if (lane == 0) { Gc[ci] = gtot; Mloc[ci] = mloc; } }
    load_conv(lds + L_K, P, cw, P_MLK + h * 128, 512 + h * 128, m0, c * 64, tid);
    __syncthreads();
    { const int s = tid >> 3, c16 = (tid & 7) * 16; const float es = eS[s]; const bf16_t* vp = P + (m0 + s) * PW + P_MLV + h * 128 + c16;
#pragma unroll
      for (int half = 0; half < 2; ++half) { const u32x4 raw = *(const u32x4*)(vp + half * 8); u32x4 o;
          o.x = pkbf(pg8::bflo(raw.x) * es, pg8::bfhi(raw.x) * es); o.y = pkbf(pg8::bflo(raw.y) * es, pg8::bfhi(raw.y) * es);
          o.z = pkbf(pg8::bflo(raw.z) * es, pg8::bfhi(raw.z) * es); o.w = pkbf(pg8::bflo(raw.w) * es, pg8::bfhi(raw.w) * es);
          *(NLAS u32x4*)(lds + L_EV + s * RS + (c16 + half * 8) * 2) = o; } }
    __syncthreads();
    f32x4 acc[8];
#pragma unroll
    for (int vb = 0; vb < 8; ++vb) acc[vb] = (f32x4){0.f, 0.f, 0.f, 0.f};
    const int rowoff = (4 * g + (i >> 2)) * RS + (i & 3) * 8;
#pragma unroll
    for (int kk = 0; kk < 2; ++kk) { const bf16x8 kf = trpair(lds + L_K + kk * 32 * RS + rowoff + w * 32, 16 * RS);
#pragma unroll
        for (int vb = 0; vb < 8; ++vb) acc[vb] = mfma16(trpair(lds + L_EV + kk * 32 * RS + rowoff + vb * 32, 16 * RS), kf, acc[vb]); }
    bf16_t* ap = Abuf + ((size_t)ci * 128 + w * 16 + i) * 128 + 4 * g;
#pragma unroll
    for (int vb = 0; vb < 8; ++vb) { u32x2 pk; pk.x = pkbf(acc[vb][0], acc[vb][1]); pk.y = pkbf(acc[vb][2], acc[vb][3]); *(u32x2*)(ap + vb * 16) = pk; }
    { const int k = tid >> 2, part = tid & 3; float n = 0.f;
#pragma unroll
      for (int s = 0; s < 16; ++s) n += eS[part * 16 + s] * bf2f(*(const NLAS bf16_t*)(lds + L_K + (part * 16 + s) * RS + k * 2));
      n += __shfl_xor(n, 1); n += __shfl_xor(n, 2); if (part == 0) NA[(size_t)ci * 128 + k] = n; }
    __syncthreads();
}
__device__ __forceinline__ void m2_items(bf16_t* Abuf, float* NA, const float* Gc, const float* Mloc, float* Mprev) {
    for (int it = blockIdx.x * blockDim.x + threadIdx.x; it < 16 * 128 * 64; it += gridDim.x * blockDim.x) {
        const int bh = it >> 13, kv2 = it & 8191, k = kv2 >> 6, v2 = kv2 & 63;
        float C0 = 0.f, C1 = 0.f, n = 0.f, m = 0.f;
        unsigned* base = (unsigned*)(Abuf + ((size_t)(bh * 64) * 128 + k) * 128 + v2 * 2);
#pragma unroll 1
        for (int c0 = 0; c0 < 64; c0 += 16) { unsigned A[16];
#pragma unroll
            for (int u = 0; u < 16; ++u) A[u] = base[(size_t)(c0 + u) * 8192];
#pragma unroll
            for (int u = 0; u < 16; ++u) { const int ci = bh * 64 + c0 + u; const float gg = Gc[ci], ml = Mloc[ci];
                const float mn = fmaxf(gg + m, ml), a = __expf(gg + m - mn), bb = __expf(ml - mn);
                base[(size_t)(c0 + u) * 8192] = pkbf(C0, C1); C0 = C0 * a + pg8::bflo(A[u]) * bb; C1 = C1 * a + pg8::bfhi(A[u]) * bb;
                if (v2 == 0) { const float nA = NA[(size_t)ci * 128 + k]; NA[(size_t)ci * 128 + k] = n; n = a * n + bb * nA; }
                if (kv2 == 0) Mprev[ci] = m;
                m = mn; } }
    }
}
__device__ __forceinline__ void m3_unit(NLAS char* lds, const bf16_t* P, const float* cw, const float* S32, const bf16_t* Cprev, const float* Nprev, const float* Mprev, const float* normg, bf16_t* Yml, int ci) {
    constexpr int L_Q = 0, L_K = TB, L_V = 2 * TB, L_C = 3 * TB, L_S = 5 * TB, L_F = L_S + 64 * RSS;
    const int tid = threadIdx.x, lane = tid & 63, w = __builtin_amdgcn_readfirstlane(tid >> 6), i = lane & 15, g = lane >> 4;
    const int c = ci & 63, bh = ci >> 6, h = bh & 3, b = bh >> 2; const size_t m0 = (size_t)b * T + c * 64;
    bf16_t ov[4][4]; float ng[4];
    { const int tb_ = w >> 1, vb0_ = (w & 1) * 4;
#pragma unroll
      for (int vb = 0; vb < 4; ++vb) { ng[vb] = normg[h * 128 + (vb0_ + vb) * 16 + i];
#pragma unroll
          for (int r = 0; r < 4; ++r) ov[vb][r] = P[(m0 + tb_ * 16 + 4 * g + r) * PW + P_MLO + h * 128 + (vb0_ + vb) * 16 + i]; } }
    NLAS float* F = (NLAS float*)(lds + L_F);
    NLAS float* rowf = F; NLAS float* colf = F + 64; NLAS float* scv = F + 128; NLAS float* emt = F + 192; NLAS float* qn = F + 256; NLAS float* nprev = F + 320; NLAS float* denp = F + 448; NLAS float* ssq = F + 576;
    if (w == 0) { const float fpre = S32[(m0 + lane) * 32 + 4 + h], ipre = S32[(m0 + lane) * 32 + h], mprev = Mprev[ci];
        const float bcs = scan_add(logsig(fpre), lane), u = ipre - bcs, pm = scan_max(u, lane), mt = bcs + fmaxf(mprev, pm);
        rowf[lane] = bcs - mt; colf[lane] = u; scv[lane] = __expf(bcs + mprev - mt); emt[lane] = __expf(-mt); }
    else if (w <= 2) nprev[tid - 64] = Nprev[(size_t)ci * 128 + tid - 64];
    load_conv(lds + L_Q, P, cw, P_MLQ + h * 128, h * 128, m0, c * 64, tid);
    load_conv(lds + L_K, P, cw, P_MLK + h * 128, 512 + h * 128, m0, c * 64, tid);
    { const int s = tid >> 3, c16 = (tid & 7) * 16; const bf16_t* vp = P + (m0 + s) * PW + P_MLV + h * 128 + c16;
      *(NLAS u32x4*)(lds + L_V + s * RS + c16 * 2) = *(const u32x4*)vp; *(NLAS u32x4*)(lds + L_V + s * RS + c16 * 2 + 16) = *(const u32x4*)(vp + 8); }
    { const int k = tid >> 2, v0 = (tid & 3) * 32; const bf16_t* cp = Cprev + ((size_t)ci * 128 + k) * 128 + v0;
#pragma unroll
      for (int q8 = 0; q8 < 4; ++q8) *(NLAS u32x4*)(lds + L_C + k * RS + (v0 + q8 * 8) * 2) = *(const u32x4*)(cp + q8 * 8); }
    __syncthreads();
    { const int tq = tid >> 3, part = tid & 7; const u32x4 q0 = *(const NLAS u32x4*)(lds + L_Q + tq * RS + part * 32), q1 = *(const NLAS u32x4*)(lds + L_Q + tq * RS + part * 32 + 16);
      const NLAS f32x4* np = (const NLAS f32x4*)(nprev + part * 16); const f32x4 n0 = np[0], n1 = np[1], n2 = np[2], n3 = np[3];
      float a = pg8::bflo(q0.x) * n0[0] + pg8::bfhi(q0.x) * n0[1] + pg8::bflo(q0.y) * n0[2] + pg8::bfhi(q0.y) * n0[3] + pg8::bflo(q0.z) * n1[0] + pg8::bfhi(q0.z) * n1[1] + pg8::bflo(q0.w) * n1[2] + pg8::bfhi(q0.w) * n1[3]
              + pg8::bflo(q1.x) * n2[0] + pg8::bfhi(q1.x) * n2[1] + pg8::bflo(q1.y) * n2[2] + pg8::bfhi(q1.y) * n2[3] + pg8::bflo(q1.z) * n3[0] + pg8::bfhi(q1.z) * n3[1] + pg8::bflo(q1.w) * n3[2] + pg8::bfhi(q1.w) * n3[3];
      a += __shfl_xor(a, 1); a += __shfl_xor(a, 2); a += __shfl_xor(a, 4); if (part == 0) qn[tq] = a; }
    const int tb = w >> 1;
    {
        float rs[4] = {0.f, 0.f, 0.f, 0.f};
#pragma unroll
        for (int sbi = 0; sbi < 2; ++sbi) { const int sb = 2 * (w & 1) + sbi; f32x4 acc = (f32x4){0.f, 0.f, 0.f, 0.f};
            if (sb <= tb) {
#pragma unroll
                for (int ks = 0; ks < 4; ++ks) acc = mfma16(*(const NLAS bf16x8*)(lds + L_Q + (tb * 16 + i) * RS + (32 * ks + 8 * g) * 2), *(const NLAS bf16x8*)(lds + L_K + (sb * 16 + i) * RS + (32 * ks + 8 * g) * 2), acc); }
            const int s = sb * 16 + i; const float cf = colf[s];
#pragma unroll
            for (int r = 0; r < 4; ++r) { const int t = tb * 16 + 4 * g + r; const float v = (s <= t) ? acc[r] * KSCALE * __expf(rowf[t] + cf) : 0.f; rs[r] += v;
                *(NLAS bf16_t*)(lds + L_S + t * RSS + s * 2) = f2bf(v); } }
#pragma unroll
        for (int r = 0; r < 4; ++r) { float x = rs[r]; x += __shfl_xor(x, 1); x += __shfl_xor(x, 2); x += __shfl_xor(x, 4); x += __shfl_xor(x, 8); if (i == 0) denp[(w & 1) * 64 + tb * 16 + 4 * g + r] = x; }
    }
    __syncthreads();
    f32x4 a1[4], a2[4];
#pragma unroll
    for (int vb = 0; vb < 4; ++vb) { a1[vb] = (f32x4){0.f, 0.f, 0.f, 0.f}; a2[vb] = (f32x4){0.f, 0.f, 0.f, 0.f}; }
    const int vb0 = (w & 1) * 4, troff = (8 * g + (i >> 2)) * RS + (i & 3) * 8;
#pragma unroll
    for (int kk = 0; kk < 2; ++kk) { if (32 * kk <= tb * 16 + 15) { const bf16x8 sf = *(const NLAS bf16x8*)(lds + L_S + (tb * 16 + i) * RSS + (32 * kk + 8 * g) * 2);
#pragma unroll
        for (int vb = 0; vb < 4; ++vb) a1[vb] = mfma16(sf, trpair(lds + L_V + kk * 32 * RS + troff + (vb0 + vb) * 32, 4 * RS), a1[vb]); } }
#pragma unroll
    for (int ks = 0; ks < 4; ++ks) { const bf16x8 qf = *(const NLAS bf16x8*)(lds + L_Q + (tb * 16 + i) * RS + (32 * ks + 8 * g) * 2);
#pragma unroll
        for (int vb = 0; vb < 4; ++vb) a2[vb] = mfma16(qf, trpair(lds + L_C + ks * 32 * RS + troff + (vb0 + vb) * 32, 4 * RS), a2[vb]); }
    float hv[4][4], sq[4] = {0.f, 0.f, 0.f, 0.f};
#pragma unroll
    for (int r = 0; r < 4; ++r) { const int t = tb * 16 + 4 * g + r; const float sc = scv[t]; const float den = denp[t] + denp[64 + t] + sc * qn[t]; const float hd = 1.f / fmaxf(fabsf(den), emt[t]);
#pragma unroll
        for (int vb = 0; vb < 4; ++vb) { const float x = (a1[vb][r] + sc * a2[vb][r]) * hd; hv[vb][r] = x; sq[r] += x * x; } }
#pragma unroll
    for (int r = 0; r < 4; ++r) { float x = sq[r]; x += __shfl_xor(x, 1); x += __shfl_xor(x, 2); x += __shfl_xor(x, 4); x += __shfl_xor(x, 8); if (i == 0) ssq[(w & 1) * 64 + tb * 16 + 4 * g + r] = x; }
    __syncthreads();
#pragma unroll
    for (int r = 0; r < 4; ++r) { const int t = tb * 16 + 4 * g + r; const float rinv = rsqrtf((ssq[t] + ssq[64 + t]) * (1.f / 128.f) + EPS);
#pragma unroll
        for (int vb = 0; vb < 4; ++vb) { const int v = (vb0 + vb) * 16 + i; const float o = bf2f(ov[vb][r]);
            Yml[(m0 + t) * 512 + h * 128 + v] = f2bf(__builtin_amdgcn_rcpf(1.f + __expf(-o)) * hv[vb][r] * rinv * ng[vb]); } }
    __syncthreads();
}
}

namespace cmpr {
using nsa::bf16x8; using nsa::f32x4; using nsa::u32x4; using nsa::mfma16; using nsa::pkbf;
constexpr int RSX = 144, L_X = 0, L_PE = 272 * RSX  , L_H = L_PE + 8192, RSH = 528;
__device__ __forceinline__ void unit(NLAS char* lds, const bf16_t* P, const float* pe, const bf16_t* W1t, const bf16_t* W2t, bf16_t* KC, bf16_t* VC, int u) {
    const int tid = threadIdx.x, lane = tid & 63, w = __builtin_amdgcn_readfirstlane(tid >> 6), i = lane & 15, g = lane >> 4;
    const int nt = u & 15, gq = (u >> 4) & 1, b = (u >> 5) & 3, kv = u >> 7;
    const int pcol = (kv ? P_VC : P_KC) + gq * 64, tok0 = 256 * nt;
    for (int ch = tid; ch < 272 * 8; ch += 512) { const int row = ch >> 3, c8 = (ch & 7) * 8, tok = tok0 + row;
        u32x4 v = (u32x4){0u, 0u, 0u, 0u}; if (tok < T) v = *(const u32x4*)(P + ((size_t)b * T + tok) * PW + pcol + c8);
        *(NLAS u32x4*)(lds + L_X + row * RSX + c8 * 2) = v; }
    for (int e = tid; e < 2048; e += 512) ((NLAS float*)(lds + L_PE))[e] = pe[kv * 2048 + e];
    __syncthreads();
    f32x4 acc[2]; acc[0] = (f32x4){0.f, 0.f, 0.f, 0.f}; acc[1] = acc[0];
    const bf16_t* wb = W1t + ((size_t)kv * 256 + 32 * w + i) * 2048 + 8 * g;
#define CMPR_LOAD(dst, k0_) { _Pragma("unroll") for (int kk = 0; kk < 8; ++kk) { dst[kk][0] = *(const bf16x8*)(wb + 32 * ((k0_) + kk)); dst[kk][1] = *(const bf16x8*)(wb + 16 * 2048 + 32 * ((k0_) + kk)); } }
#define CMPR_COMP(src, k0_) { _Pragma("unroll") for (int kk = 0; kk < 8; ++kk) { const int ks = (k0_) + kk, l = ks >> 1, dh = ks & 1; \
            const u32x4 raw = *(const NLAS u32x4*)(lds + L_X + (16 * i + l) * RSX + dh * 64 + 16 * g); \
            const NLAS float* pp = (const NLAS float*)(lds + L_PE) + l * 64 + dh * 32 + 8 * g; const f32x4 p0 = *(const NLAS f32x4*)pp, p1 = *(const NLAS f32x4*)(pp + 4); \
            u32x4 a; a.x = pkbf(pg8::bflo(raw.x) + p0[0], pg8::bfhi(raw.x) + p0[1]); a.y = pkbf(pg8::bflo(raw.y) + p0[2], pg8::bfhi(raw.y) + p0[3]); \
            a.z = pkbf(pg8::bflo(raw.z) + p1[0], pg8::bfhi(raw.z) + p1[1]); a.w = pkbf(pg8::bflo(raw.w) + p1[2], pg8::bfhi(raw.w) + p1[3]); \
            const bf16x8 af = __builtin_bit_cast(bf16x8, a); \
            acc[0] = mfma16(af, src[kk][0], acc[0]); acc[1] = mfma16(af, src[kk][1], acc[1]); } }
    { bf16x8 bA[8][2], bB[8][2];
      CMPR_LOAD(bA, 0)
#pragma unroll 1
      for (int k0 = 0; k0 < 64; k0 += 16) { CMPR_LOAD(bB, k0 + 8) CMPR_COMP(bA, k0) if (k0 + 16 < 64) CMPR_LOAD(bA, k0 + 16) CMPR_COMP(bB, k0 + 8) } }
#undef CMPR_LOAD
#undef CMPR_COMP
#pragma unroll
    for (int cb = 0; cb < 2; ++cb)
#pragma unroll
        for (int r = 0; r < 4; ++r) { const float x = acc[cb][r], uu = 0.7978845608028654f * (x + 0.044715f * x * x * x); const float gl = x * __builtin_amdgcn_rcpf(1.f + __expf(-2.f * uu));
            *(NLAS bf16_t*)(lds + L_H + (4 * g + r) * RSH + (32 * w + cb * 16 + i) * 2) = f2bf(gl); }
    __syncthreads();
    if (w < 4) { f32x4 o = (f32x4){0.f, 0.f, 0.f, 0.f}; const bf16_t* w2 = W2t + ((size_t)kv * 64 + 16 * w + i) * 256 + 8 * g;
#pragma unroll
        for (int ks = 0; ks < 8; ++ks) o = mfma16(*(const NLAS bf16x8*)(lds + L_H + i * RSH + (32 * ks + 8 * g) * 2), *(const bf16x8*)(w2 + 32 * ks), o);
        bf16_t* dst = (kv ? VC : KC);
#pragma unroll
        for (int r = 0; r < 4; ++r) dst[((size_t)(b * 256 + 16 * nt + 4 * g + r) * 2 + gq) * 64 + 16 * w + i] = f2bf(o[r]); }
    __syncthreads();
}
}

#define LAS __attribute__((address_space(3)))
constexpr int NTHREADS = 512, LDS_BYTES = 147456;
constexpr size_t WS_WIN = 1 * MiB, WS_WG = 9 * MiB, WS_WBR = 15 * MiB, WS_WOUT = 18 * MiB, WS_WFF1 = 20 * MiB, WS_WFF2 = 28 * MiB, WS_WMKV = 36 * MiB, WS_WC1 = 38 * MiB;
constexpr size_t WS_BIASP = 253 * MiB + 768 * 1024, WS_XCH = 254 * MiB;
#define XB_TMO      128
#define XB_XCNT(j)  (256  + 64 * (j))
#define XB_XSUB(j)  (1280 + 64 * (j))
#define XB_XGEN(j)  (2304 + 64 * (j))
#define XB_TOP      3328
#define XB_TOPGEN   3392
#define XCD_BAR_WORDS 3456
#define XB_SPIN_CAP (1u << 18)

__device__ __forceinline__ unsigned xb_ld(unsigned* p)              { return __hip_atomic_load(p, __ATOMIC_RELAXED, __HIP_MEMORY_SCOPE_AGENT); }
__device__ __forceinline__ unsigned xb_add(unsigned* p, unsigned v) { return __hip_atomic_fetch_add(p, v, __ATOMIC_RELAXED, __HIP_MEMORY_SCOPE_AGENT); }
__device__ __forceinline__ unsigned xb_xcc_id() { return (unsigned)__builtin_amdgcn_s_getreg((3 << 11) | 20) & 0xFu; }
#define XB_SPIN(cond, bar) do { unsigned _sp = 0; while (cond) { __builtin_amdgcn_s_sleep(1); \
    if ((++_sp & 255u) == 0u) { if (xb_ld(&(bar)[XB_TMO])) break; if (_sp > XB_SPIN_CAP) { atomicAdd(&(bar)[XB_TMO], 1u); break; } } } } while (0)

struct XcdBarrier {
    unsigned* bar; unsigned x;
    volatile LAS unsigned* st;
};

__device__ __forceinline__ XcdBarrier xcd_barrier_post(unsigned* bar, volatile LAS unsigned* st) {
    XcdBarrier b; b.bar = bar; b.x = xb_xcc_id(); b.st = st;
    if (threadIdx.x == 0) (void)xb_add(&bar[XB_XCNT(b.x)], 1u);
    return b;
}
__device__ __forceinline__ void xcd_barrier_complete(unsigned* bar, unsigned x, unsigned& nloc, unsigned& nx) {
    const unsigned G = gridDim.x * gridDim.y * gridDim.z;
    unsigned sum, cnt, mine, sp = 0u;
    for (;;) {
        sum = 0u; cnt = 0u; mine = 0u;
#pragma unroll
        for (unsigned j = 0; j < 16; ++j) { const unsigned c = xb_ld(&bar[XB_XCNT(j)]); sum += c; cnt += (c > 0u) ? 1u : 0u; mine = (j == x) ? c : mine; }
        if (sum == G) break;
        __builtin_amdgcn_s_sleep(1);
        if ((++sp & 255u) == 0u) { if (xb_ld(&bar[XB_TMO])) break; if (sp > XB_SPIN_CAP) { atomicAdd(&bar[XB_TMO], 1u); break; } }
    }
    nloc = mine > 0u ? mine : 1u; nx = cnt > 0u ? cnt : 1u;
}

__device__ __forceinline__ void xcd_barrier(const XcdBarrier& b) {
    asm volatile("s_waitcnt vmcnt(0)" ::: "memory");
    __syncthreads();
    if (threadIdx.x == 0) {
        unsigned* bar = b.bar;
        __builtin_amdgcn_s_waitcnt(0);
        unsigned nloc = b.st[0], nx = b.st[1];
        if (nloc == 0u) { xcd_barrier_complete(bar, b.x, nloc, nx); b.st[0] = nloc; b.st[1] = nx; }
        const unsigned old = xb_add(&bar[XB_XSUB(b.x)], 1u);
        const unsigned gen = old / nloc;
        if (old + 1u == (gen + 1u) * nloc) {
            __builtin_amdgcn_fence(__ATOMIC_RELEASE, "agent");
            asm volatile("s_waitcnt vmcnt(0)" ::: "memory");
            const unsigned og = xb_add(&bar[XB_TOP], 1u);
            const unsigned tg = og / nx;
            if (og + 1u == (tg + 1u) * nx) xb_add(&bar[XB_TOPGEN], 1u);
            else XB_SPIN(xb_ld(&bar[XB_TOPGEN]) == tg, bar);
            __builtin_amdgcn_fence(__ATOMIC_ACQUIRE, "agent");
            xb_add(&bar[XB_XGEN(b.x)], 1u);
            asm volatile("s_waitcnt vmcnt(0)" ::: "memory");
        } else {
            XB_SPIN(xb_ld(&bar[XB_XGEN(b.x)]) == gen, bar);
            __builtin_amdgcn_fence(__ATOMIC_ACQUIRE, "agent");
            asm volatile("s_waitcnt vmcnt(0)" ::: "memory");
        }
    }
    __syncthreads();
}

__device__ __forceinline__ void group_barrier(unsigned* gc, unsigned target, bool light) {
    asm volatile("s_waitcnt vmcnt(0)" ::: "memory"); __syncthreads();
    if (threadIdx.x == 0) {
        if (!light) { __builtin_amdgcn_fence(__ATOMIC_RELEASE, "agent"); asm volatile("s_waitcnt vmcnt(0)" ::: "memory"); }
        __hip_atomic_fetch_add(gc, 1u, __ATOMIC_RELAXED, __HIP_MEMORY_SCOPE_AGENT);
        unsigned sp = 0; while (__hip_atomic_load(gc, __ATOMIC_RELAXED, __HIP_MEMORY_SCOPE_AGENT) < target) { __builtin_amdgcn_s_sleep(1); if (++sp > (1u << 22)) break; }
        __builtin_amdgcn_fence(__ATOMIC_ACQUIRE, "agent"); asm volatile("s_waitcnt vmcnt(0)" ::: "memory");
    }
    __syncthreads();
}
struct Args { const float* in[18]; float* out; unsigned char* ws; int ph_lo, ph_hi; };
__device__ __forceinline__ unsigned pk2(float lo, float hi) { return (unsigned)f2bf(lo) | ((unsigned)f2bf(hi) << 16); }
typedef unsigned v4u __attribute__((ext_vector_type(4)));
typedef float f32x4 __attribute__((ext_vector_type(4)));
__device__ __forceinline__ void tr_item(const float* W, int ld, int ncols, int K, bf16_t* WT, int row_off, LAS float* scr, int item, int lane) {
    const int nblk = ncols / 32, kb = item / nblk, nb = item % nblk, k0 = 64 * kb, n0 = 32 * nb;
#pragma unroll 8
    for (int i = 0; i < 32; ++i) { const int kk = 2 * i + (lane >> 5); scr[kk * 33 + (lane & 31)] = W[(size_t)(k0 + kk) * ld + n0 + (lane & 31)]; }
    asm volatile("s_waitcnt lgkmcnt(0)" ::: "memory");
    const int c = lane & 7;
#pragma unroll
    for (int j = 0; j < 4; ++j) { const int n = (lane >> 3) + 8 * j; const LAS float* s = scr + (8 * c) * 33 + n;
        v4u o; o.x = pk2(s[0 * 33], s[1 * 33]); o.y = pk2(s[2 * 33], s[3 * 33]); o.z = pk2(s[4 * 33], s[5 * 33]); o.w = pk2(s[6 * 33], s[7 * 33]);
        *(v4u*)(WT + (size_t)(row_off + n0 + n) * K + k0 + 8 * c) = o; }
    asm volatile("s_waitcnt lgkmcnt(0)" ::: "memory");
}
__device__ __forceinline__ void rms_row_wave(const float* xrow, const float* g, bf16_t* orow, int lane) {
    const f32x4* xr = (const f32x4*)xrow + lane; const f32x4* gr = (const f32x4*)g + lane;
    f32x4 v[4]; float s = 0.f;
#pragma unroll
    for (int j = 0; j < 4; ++j) { v[j] = xr[64 * j]; s += (v[j].x * v[j].x + v[j].y * v[j].y) + (v[j].z * v[j].z + v[j].w * v[j].w); }
    const float r = rsqrtf(wave_sum(s) * (1.f / D) + EPS);
    unsigned long long* o8 = (unsigned long long*)orow + lane;
#pragma unroll
    for (int j = 0; j < 4; ++j) { const f32x4 gg = gr[64 * j]; o8[64 * j] = (unsigned long long)pk2(v[j].x * r * gg.x, v[j].y * r * gg.y) | ((unsigned long long)pk2(v[j].z * r * gg.z, v[j].w * r * gg.w) << 32); }
}
__device__ __forceinline__ int small_src_col(int c) { return c < 8 ? C_MLI + c : C_NSG + (c - 8); }
__global__ void __launch_bounds__(NTHREADS, 2) mega(Args a) {
    extern __shared__ __attribute__((aligned(16))) unsigned char lds_raw[];
    char* lds = (char*)lds_raw;
    LAS unsigned char* lds3 = (LAS unsigned char*)lds_raw;
    const float* x = a.in[0]; const float* mem = a.in[1]; const float* g_mix = a.in[2]; const float* w_in = a.in[3];
    const float* b_in = a.in[4]; const float* ml_conv = a.in[5]; const float* ml_norm_g = a.in[6]; const float* cmp_pe = a.in[7];
    const float* cmp_w1 = a.in[8]; const float* cmp_w2 = a.in[9]; const float* g_mem = a.in[10]; const float* w_mem_kv = a.in[11];
    const float* w_branch = a.in[12]; const float* w_out = a.in[13]; const float* g_ffn = a.in[14]; const float* w_ff1 = a.in[15];
    const float* w_ff2 = a.in[16]; const float* g_final = a.in[17];
    char* ws = (char*)a.ws; float* out = a.out;
    bf16_t* U = (bf16_t*)(ws + WS_U); bf16_t* P = (bf16_t*)(ws + WS_P);
    bf16_t* Yml = (bf16_t*)(ws + WS_Y); bf16_t* Ynsa = Yml + (size_t)M * 512; bf16_t* Yxa = Ynsa + (size_t)M * 512;
    float* S32 = (float*)(ws + WS_S32); bf16_t* MEMN = (bf16_t*)out + (size_t)16 * 1024 * 1024;     bf16_t* MEMKV = (bf16_t*)(ws + WS_MEMKV);
    bf16_t* KC = (bf16_t*)(ws + WS_KC); bf16_t* VC = (bf16_t*)(ws + WS_VC);
    float* NA = (float*)(ws + WS_NA); float* Gc = (float*)(ws + WS_G); float* Mloc = (float*)(ws + WS_MLOC); float* Mprev = (float*)(ws + WS_MPREV);
    bf16_t* Abuf = (bf16_t*)out;
    bf16_t* GATES = P; bf16_t* MERGED = U; bf16_t* AFFN = U; bf16_t* HBUF = P;
    bf16_t* Wi = (bf16_t*)(ws + WS_WIN); bf16_t* Wg = (bf16_t*)(ws + WS_WG); bf16_t* Wbr = (bf16_t*)(ws + WS_WBR); bf16_t* Wo = (bf16_t*)(ws + WS_WOUT);
    bf16_t* Wf1 = (bf16_t*)(ws + WS_WFF1); bf16_t* Wf2 = (bf16_t*)(ws + WS_WFF2); bf16_t* Wmkv = (bf16_t*)(ws + WS_WMKV);
    float* biasP = (float*)(ws + WS_BIASP); bf16_t* Wc1 = (bf16_t*)(ws + WS_WC1); bf16_t* Wc2 = (bf16_t*)(ws + WS_BIASP + 65536);
    const int tid = threadIdx.x, lane = tid & 63, wave = __builtin_amdgcn_readfirstlane(tid >> 6);
    const int G = gridDim.x, bid = blockIdx.x;
    const int lo = a.ph_lo, hi = a.ph_hi;
    volatile LAS unsigned* xbst = (volatile LAS unsigned*)(lds3 + LDS_BYTES - 64);
    if (tid < 2) xbst[tid] = 0u;
    __syncthreads();
    const XcdBarrier bar = xcd_barrier_post((unsigned*)ws, xbst);
    if (tid == 0) __hip_atomic_store((unsigned*)ws + 12544 + bid, xb_xcc_id() + 1u, __ATOMIC_RELAXED, __HIP_MEMORY_SCOPE_AGENT);
#define PHASE(k) if (lo <= (k) && (k) < hi)
#define SEAM(k) if (lo <= (k) && (k) + 1 < hi) xcd_barrier(bar)
    PHASE(0) {
        LAS float* scr = (LAS float*)(lds3 + wave * 16384);
        const int gw = bid * 8 + wave, NGW = G * 8;
        constexpr int I0 = 16 * 64, I1 = 16 * 40, I2 = 16 * 16, I3 = 16 * 96, I4 = 8 * 32, I5 = 16 * 32, I6 = 16 * 128, I7 = 64 * 32, I8 = 16 * 32;
        constexpr int I9 = 32 * 8, I10 = 4 * 2;
        constexpr int NITEMS = I0 + I1 + I2 + I3 + 3 * I4 + I5 + I6 + I7 + I8 + 2 * I9 + 2 * I10;
        for (int it = gw; it < NITEMS; it += NGW) {
            int r = it;
            if (r < I0) { tr_item(w_in, DIN, 2048, 1024, Wi, 0, scr, r, lane); continue; } r -= I0;
            if (r < I1) { tr_item(w_in + 2056, DIN, 1280, 1024, Wi, 2048, scr, r, lane); continue; } r -= I1;
            if (r < I2) { tr_item(w_in + 3360, DIN, 512, 1024, Wi, 3328, scr, r, lane); continue; } r -= I2;
            if (r < I3) { tr_item(w_in + C_MG, DIN, 3072, 1024, Wg, 0, scr, r, lane); continue; } r -= I3;
            if (r < 3 * I4) { const int j = r / I4; tr_item(w_branch + (size_t)j * 512 * 1024, 1024, 1024, 512, Wbr + (size_t)j * 1024 * 512, 0, scr, r % I4, lane); continue; } r -= 3 * I4;
            if (r < I5) { tr_item(w_out, 1024, 1024, 1024, Wo, 0, scr, r, lane); continue; } r -= I5;
            if (r < I6) { tr_item(w_ff1, FF, FF, 1024, Wf1, 0, scr, r, lane); continue; } r -= I6;
            if (r < I7) { tr_item(w_ff2, 1024, 1024, FF, Wf2, 0, scr, r, lane); continue; } r -= I7;
            if (r < I8) { tr_item(w_mem_kv, 1024, 1024, 1024, Wmkv, 0, scr, r, lane); continue; } r -= I8;
            if (r < 2 * I9) { const int kv = r / I9; tr_item(cmp_w1 + (size_t)kv * 2048 * 256, 256, 256, 2048, Wc1 + (size_t)kv * 256 * 2048, 0, scr, r % I9, lane); continue; } r -= 2 * I9;
            { const int kv = r / I10; tr_item(cmp_w2 + (size_t)kv * 256 * 64, 64, 64, 256, Wc2 + (size_t)kv * 64 * 256, 0, scr, r % I10, lane); }
        }
        for (int i = bid * NTHREADS + tid; i < 256 * 1024; i += G * NTHREADS) { const int r = i >> 10, k = i & 1023; bf16_t v = 0;
            if (r < 32) v = f2bf(w_in[(size_t)k * DIN + small_src_col(r)]);
            else if (r >= 128 && r < 160) { const float w = w_in[(size_t)k * DIN + small_src_col(r - 128)]; v = f2bf(w - bf2f(f2bf(w))); }
            Wi[(size_t)(3840 + r) * 1024 + k] = v; }
        for (int c = bid * NTHREADS + tid; c < 4096; c += G * NTHREADS) { float v = 0.f;
            if (c < 2048) v = b_in[c]; else if (c < 3328) v = b_in[c + 8]; else if (c < 3840) v = b_in[c + 32]; else if (c < 3872) v = b_in[small_src_col(c - 3840)];
            biasP[c] = v; }
        for (int m = gw; m < M; m += NGW) rms_row_wave(x + (size_t)m * D, g_mix, U + (size_t)m * D, lane);
        for (int m = gw; m < 1024; m += NGW) rms_row_wave(mem + (size_t)m * D, g_mem, MEMN + (size_t)m * D, lane);
    }
    SEAM(0);
    PHASE(1) {
        { pg8::Gemm g{U, Wi, M, 4096, D}; pg8::StaticOrder S; S.init(M, 4096, G, bid);
          pg8::EpiStore<0> E{P, biasP, S32, PW, 15};
          pg8::gemm_phase<pg8::EpiStore<0>, pg8::StaticOrder, true, true>(lds3, g, S, E); }
    }
    SEAM(1);
    PHASE(2) { for (int tl_ = bid; tl_ < 256; tl_ += G) xa::memkv_tile(MEMN, Wmkv, MEMKV, tl_);
               for (int ci = bid; ci < 1024; ci += G) ml::m1_unit((NLAS char*)lds_raw, P, ml_conv, S32, Abuf, NA, Gc, Mloc, ci);
               for (int u = bid; u < 256; u += G) cmpr::unit((NLAS char*)lds_raw, P, cmp_pe, Wc1, Wc2, KC, VC, u);
    }
    SEAM(2);
    PHASE(3) { unsigned* m2cnt = (unsigned*)ws + 12288;
               ml::m2_items(Abuf, NA, Gc, Mloc, Mprev);
               asm volatile("s_waitcnt vmcnt(0)" ::: "memory"); __syncthreads();
               if (tid == 0) { __builtin_amdgcn_fence(__ATOMIC_RELEASE, "agent"); asm volatile("s_waitcnt vmcnt(0)" ::: "memory"); __hip_atomic_fetch_add(m2cnt, 1u, __ATOMIC_RELAXED, __HIP_MEMORY_SCOPE_AGENT); }
               nsa::phase((NLAS char*)lds_raw, P, S32, KC, VC, Ynsa);
               xa::phase((NLAS char*)lds_raw, P, MEMKV, Yxa);
               if (tid == 0) { unsigned sp = 0; while (__hip_atomic_load(m2cnt, __ATOMIC_RELAXED, __HIP_MEMORY_SCOPE_AGENT) < (unsigned)G) { __builtin_amdgcn_s_sleep(2); if (++sp > (1u << 22)) break; }
                               __builtin_amdgcn_fence(__ATOMIC_ACQUIRE, "agent"); asm volatile("s_waitcnt vmcnt(0)" ::: "memory"); }
               __syncthreads();
               for (int ci = bid; ci < 1024; ci += G) ml::m3_unit((NLAS char*)lds_raw, P, ml_conv, S32, Abuf, NA, Mprev, ml_norm_g, Yml, ci); }
    SEAM(4);
    unsigned* gcnt = (unsigned*)ws + 13312 + 16 * (bid & 63);
    bool panel_sync = false;
    if (G == 256) { volatile LAS unsigned* flag = (volatile LAS unsigned*)(lds3 + LDS_BYTES - 48);
        if (wave == 0) { const unsigned* xt = (const unsigned*)ws + 12544; unsigned x0 = 0, same = 1;
            for (int k = 0; k < 4; ++k) { const unsigned xv = __hip_atomic_load(xt + lane + 64 * k, __ATOMIC_RELAXED, __HIP_MEMORY_SCOPE_AGENT); if (k == 0) x0 = xv; same &= (xv == x0 && xv != 0u) ? 1u : 0u; }
            const unsigned long long all = __ballot(same != 0u); if (lane == 0) flag[0] = (all == ~0ull) ? 1u : 0u; }
        __syncthreads();
        panel_sync = flag[0] != 0u; }
    const bool light = true;
#define PSEAM(k, n) if (lo <= (k) && (k) + 1 < hi) { if (panel_sync) group_barrier(gcnt, 4u * (n), light); else xcd_barrier(bar); }
    PHASE(5) { pg8::Gemm g{U, Wg, M, 3072, D}; pg8::StaticOrder S; S.init(M, 3072, G, bid);
               pg8::EpiStore<1> E{GATES, b_in + C_MG, nullptr, 4096, -1};
               pg8::gemm_phase<pg8::EpiStore<1>, pg8::StaticOrder, true, true>(lds3, g, S, E); }
    PSEAM(5, 1);
    PHASE(6) { pg8::Gemm g{Yml, Wbr, M, 1024, 512}; pg8::MergeOrder S; S.so.init(M, 1024, G, bid); S.sa = (size_t)M * 512 * 2; S.sb = (size_t)1024 * 512 * 2;
               pg8::EpiMergeG E{GATES, (bf16_t*)out, MERGED};
               pg8::gemm_phase<pg8::EpiMergeG, pg8::MergeOrder, true, true>(lds3, g, S, E); }
    PSEAM(6, 2);
    PHASE(7) { pg8::Gemm g{MERGED, Wo, M, 1024, D}; pg8::StaticOrder S; S.init(M, 1024, G, bid);
               pg8::EpiResRms E{x, out, nullptr, AFFN, g_ffn, (float*)(ws + WS_XCH), (unsigned*)ws + 4096};
               pg8::gemm_phase<pg8::EpiResRms, pg8::StaticOrder, false, true>(lds3, g, S, E); }
    PSEAM(7, 3);
    PHASE(9) { pg8::Gemm g{AFFN, Wf1, M, FF, D}; pg8::StaticOrder S; S.init(M, FF, G, bid);
               pg8::EpiStore<2> E{HBUF, nullptr, nullptr, FF, -1};
               pg8::gemm_phase<pg8::EpiStore<2>, pg8::StaticOrder, true, true>(lds3, g, S, E); }
    PSEAM(9, 4);
    PHASE(10) { pg8::Gemm g{HBUF, Wf2, M, 1024, FF}; pg8::StaticOrder S; S.init(M, 1024, G, bid);
                pg8::EpiResRms E{out, nullptr, out, nullptr, g_final, (float*)(ws + WS_XCH + 262144), (unsigned*)ws + 4096 + 4096};
                pg8::gemm_phase<pg8::EpiResRms, pg8::StaticOrder, false, true>(lds3, g, S, E); }
}
constexpr int N_PHASES = 12;
extern "C" void kernel_launch(void* const* d_in, const int* in_sizes, int n_in, void* d_out, int out_size, void* d_ws, size_t ws_size, hipStream_t stream) {
    static int grid = 0;
    if (grid == 0) {
        int dev = 0, cus = 0, per_cu = 0;
        (void)hipGetDevice(&dev); (void)hipDeviceGetAttribute(&cus, hipDeviceAttributeMultiprocessorCount, dev);
        (void)hipFuncSetAttribute((const void*)mega, hipFuncAttributeMaxDynamicSharedMemorySize, LDS_BYTES);
        (void)hipOccupancyMaxActiveBlocksPerMultiprocessor(&per_cu, (const void*)mega, NTHREADS, LDS_BYTES);
        if (per_cu < 1) { fprintf(stderr, "occupancy query says %d blocks/CU\n", per_cu); per_cu = 1; }
        grid = cus * 1;
        (void)hipGetLastError();
    }
    (void)hipMemsetAsync(d_ws, 0, 65536, stream);
    Args a{};
    for (int i = 0; i < 18; ++i) a.in[i] = (const float*)d_in[i];
    a.out = (float*)d_out; a.ws = (unsigned char*)d_ws;
    a.ph_lo = 0; a.ph_hi = N_PHASES; void* args[] = {&a};
    hipError_t e = hipLaunchCooperativeKernel((const void*)mega, dim3(grid), dim3(NTHREADS), args, LDS_BYTES, stream);
    if (e != hipSuccess) {
        (void)hipGetLastError();
        hipLaunchKernelGGL(mega, dim3(grid), dim3(NTHREADS), LDS_BYTES, stream, a);
    }
}
```

```cpp
#include <hip/hip_runtime.h>
#include <hip/hip_cooperative_groups.h>
#include <cstdio>
namespace cg = cooperative_groups;
#include <stdint.h>

typedef unsigned short bf16_t;
__device__ __forceinline__ float bf2f(bf16_t v) { return __uint_as_float(((unsigned)v) << 16); }
__device__ __forceinline__ bf16_t f2bf(float f) { unsigned u = __float_as_uint(f); return (bf16_t)((u + 0x7fffu + ((u >> 16) & 1u)) >> 16); }

constexpr int NB = 4, T = 4096, M = NB * T, D = 1024, DIN = 6944, FF = 4096;
constexpr float EPS = 1e-6f;
constexpr int C_MLI = 2048, C_NSG = 3336, C_MG = 3872;
constexpr int P_MLQ = 0, P_MLK = 512, P_MLV = 1024, P_MLO = 1536, P_NSQ = 2048, P_KC = 2560, P_VC = 2688, P_KS = 2816, P_VS = 2944, P_KW = 3072, P_VW = 3200, P_XAQ = 3328, PW = 3840;
constexpr size_t MiB = 1u << 20;
constexpr size_t WS_U = 40 * MiB;
constexpr size_t WS_P = 72 * MiB;
constexpr size_t WS_Y = 200 * MiB;
constexpr size_t WS_S32 = 248 * MiB;
constexpr size_t WS_MEMKV = 250 * MiB;
constexpr size_t WS_KC = 252 * MiB;
constexpr size_t WS_VC = 252 * MiB + 512 * 1024;
constexpr size_t WS_NA = 253 * MiB;
constexpr size_t WS_G = 253 * MiB + 512 * 1024;
constexpr size_t WS_MLOC = 253 * MiB + 512 * 1024 + 4096;
constexpr size_t WS_MPREV = 253 * MiB + 512 * 1024 + 8192;

__device__ __forceinline__ float wave_sum(float v) {
#pragma unroll
    for (int o = 1; o < 64; o <<= 1) v += __shfl_xor(v, o);
    return v;
}
__device__ __forceinline__ float wave_max(float v) {
#pragma unroll
    for (int o = 1; o < 64; o <<= 1) v = fmaxf(v, __shfl_xor(v, o));
    return v;
}

__device__ __forceinline__ float logsig(float x) { return fminf(x, 0.f) - log1pf(__expf(-fabsf(x))); }
namespace pg8 {
#define PG8_LAS __attribute__((address_space(3)))
typedef unsigned short bf16_t;
typedef short bf16x8 __attribute__((ext_vector_type(8)));
typedef float f32x4 __attribute__((ext_vector_type(4)));
typedef unsigned u32x4 __attribute__((ext_vector_type(4)));
constexpr int BM = 256, BK = 64, HALF = 128, HTB = HALF * BK * 2  , STAGE_BYTES = 8 * HTB, NXCD = 8, WGM = 8;

__host__ __device__ __forceinline__ int lds_byte(int r, int c) { const int st = (r >> 4) * 2 + (c >> 5), rr = r & 15, cc = c & 31, ob = rr * 64 + cc * 2; return st * 1024 + (ob ^ (((ob >> 9) & 1) << 5)); }
__host__ __device__ __forceinline__ void stage_rc(int b, int& R, int& C) { const int st = b / 1024, sb = b % 1024, swz = sb ^ (((sb >> 9) & 1) << 5); R = (st >> 1) * 16 + swz / 64; C = (st & 1) * 32 + (swz % 64) / 2; }
__host__ __device__ __forceinline__ int perm32(int rho) { const int n = rho >> 4, i = rho & 15; return 8 * (i >> 2) + 4 * n + (i & 3); }

struct Unit { int pm, pn, j; };
struct Gemm { const bf16_t* A; const bf16_t* Bt; int M, N, K; };

struct StaticOrder {
    int nM, nN, nwg, G, c;
    __host__ __device__ void init(int M, int N, int G_, int c_) { nM = M / BM; nN = N / BM; nwg = nM * nN; G = G_; c = c_; }
    __host__ __device__ bool next(int i, Unit& u) const {
        const long L = (long)i * G + c; if (L >= nwg) return false;
        int wgid = (int)L; { const int q = nwg / NXCD, r = nwg % NXCD, xcd = wgid % NXCD, off = wgid / NXCD; wgid = (xcd < r ? xcd * (q + 1) : r * (q + 1) + (xcd - r) * q) + off; }
        const int nig = WGM * nN, gid = wgid / nig, fm = gid * WGM, gsz = (nM - fm) < WGM ? (nM - fm) : WGM;
        u.pm = fm + ((wgid % nig) % gsz); u.pn = (wgid % nig) / gsz; u.j = 0; return true;
    }
    __device__ __forceinline__ const char* pa(const Gemm& g, const Unit& u, size_t tstep) const { return (const char*)g.A + (size_t)u.pm * tstep; }
    __device__ __forceinline__ const char* pb(const Gemm& g, const Unit& u, size_t tstep) const { return (const char*)g.Bt + (size_t)u.pn * tstep; }
    __device__ __forceinline__ void a_ready(const Unit&) const {}
    __device__ __forceinline__ void done(const Unit&) const {}
};

struct MergeOrder {
    StaticOrder so; size_t sa, sb;
    __device__ __forceinline__ bool next(int i, Unit& u) const { if (i >= 3) return false; const bool ok = so.next(0, u); u.j = i; return ok; }
    __device__ __forceinline__ const char* pa(const Gemm& g, const Unit& u, size_t tstep) const { return (const char*)g.A + (size_t)u.j * sa + (size_t)u.pm * tstep; }
    __device__ __forceinline__ const char* pb(const Gemm& g, const Unit& u, size_t tstep) const { return (const char*)g.Bt + (size_t)u.j * sb + (size_t)u.pn * tstep; }
    __device__ __forceinline__ void a_ready(const Unit&) const {}
    __device__ __forceinline__ void done(const Unit&) const {}
};
typedef float f32x2_t __attribute__((ext_vector_type(2))); typedef __bf16 bf16x2_t __attribute__((ext_vector_type(2)));
__device__ __forceinline__ unsigned cvt_pk_bf16(float lo, float hi) { f32x2_t v = {lo, hi}; bf16x2_t b = __builtin_convertvector(v, bf16x2_t); return __builtin_bit_cast(unsigned, b); }
typedef float f32x2 __attribute__((ext_vector_type(2)));

typedef unsigned u32x2 __attribute__((ext_vector_type(2)));
__device__ __forceinline__ float bflo(unsigned w) { return __uint_as_float(w << 16); }
__device__ __forceinline__ float bfhi(unsigned w) { return __uint_as_float(w & 0xffff0000u); }
template <int ACT> __device__ __forceinline__ f32x4 act4(f32x4 v) {
    if (ACT == 1) { f32x4 o; for (int e = 0; e < 4; ++e) o[e] = __builtin_amdgcn_rcpf(1.f + __expf(-v[e])); return o; }
    if (ACT == 2) { f32x4 o; for (int e = 0; e < 4; ++e) { const float r = fmaxf(v[e], 0.f); o[e] = r * r; } return o; }
    return v;
}
template <int ACT> struct EpiStore {
    static constexpr bool PERM = true, AFTER_DRAIN = false;
    bf16_t* O; const float* bias; float* S32; int ldc, small_pn;
    __device__ __forceinline__ void operator()(const f32x4 (&acc)[2][2][4][2], const Unit& u, int wr, int wc, int fr, int fq) const {
        asm volatile("s_waitcnt vmcnt(0)" ::: "memory");
        const int row0 = u.pm * BM + wr * 64 + fr, col0 = u.pn * BM + wc * 32 + 8 * fq;
        if (u.pn == small_pn) {
            if (wc == 0) {
                const f32x4 b0 = *(const f32x4*)(bias + col0), b1 = *(const f32x4*)(bias + col0 + 4);
#pragma unroll
                for (int ai = 0; ai < 2; ++ai)
#pragma unroll
                    for (int m = 0; m < 4; ++m) { float* rp = S32 + (size_t)(row0 + ai * HALF + m * 16) * 32 + 8 * fq;
                        *(f32x4*)rp = acc[ai][0][m][0] + acc[ai][1][m][0] + b0; *(f32x4*)(rp + 4) = acc[ai][0][m][1] + acc[ai][1][m][1] + b1; }
            }
            return;
        }
        f32x4 bv[2][2];
#pragma unroll
        for (int bj = 0; bj < 2; ++bj)
#pragma unroll
            for (int n = 0; n < 2; ++n) bv[bj][n] = bias ? *(const f32x4*)(bias + col0 + bj * HALF + 4 * n) : (f32x4){0.f, 0.f, 0.f, 0.f};
#pragma unroll
        for (int ai = 0; ai < 2; ++ai)
#pragma unroll
            for (int m = 0; m < 4; ++m) { bf16_t* rowp = O + (size_t)(row0 + ai * HALF + m * 16) * ldc + col0;
#pragma unroll
                for (int bj = 0; bj < 2; ++bj) { const f32x4 v0 = act4<ACT>(acc[ai][bj][m][0] + bv[bj][0]), v1 = act4<ACT>(acc[ai][bj][m][1] + bv[bj][1]);
                    u32x4 w; w.x = cvt_pk_bf16(v0[0], v0[1]); w.y = cvt_pk_bf16(v0[2], v0[3]); w.z = cvt_pk_bf16(v1[0], v1[1]); w.w = cvt_pk_bf16(v1[2], v1[3]);
                    *(u32x4*)(rowp + bj * HALF) = w; } }
    }
};
struct EpiMergeG {
    static constexpr bool PERM = true, AFTER_DRAIN = false;
    const bf16_t* G; bf16_t* Mp; bf16_t* Mb;
    template <bool HASP>
    __device__ __forceinline__ void body(const f32x4 (&acc)[2][2][4][2], int j, bf16_t* dst, size_t dpitch, int row0, int col0) const {
        constexpr size_t mpitch = 2048;
#pragma unroll
        for (int ai = 0; ai < 2; ++ai) { u32x4 gw[4][2], pw[4][2];
#pragma unroll
            for (int m = 0; m < 4; ++m)
#pragma unroll
                for (int bj = 0; bj < 2; ++bj) { const size_t row = (size_t)(row0 + ai * HALF + m * 16); const int col = col0 + bj * HALF;
                    gw[m][bj] = *(const u32x4*)(G + row * 4096 + j * 1024 + col); if (HASP) pw[m][bj] = *(const u32x4*)(Mp + row * mpitch + col); }
#pragma unroll
            for (int m = 0; m < 4; ++m)
#pragma unroll
                for (int bj = 0; bj < 2; ++bj) { const size_t row = (size_t)(row0 + ai * HALF + m * 16); const int col = col0 + bj * HALF; const u32x4 g4 = gw[m][bj];
                    f32x4 v0 = (f32x4){bflo(g4.x), bfhi(g4.x), bflo(g4.y), bfhi(g4.y)} * acc[ai][bj][m][0], v1 = (f32x4){bflo(g4.z), bfhi(g4.z), bflo(g4.w), bfhi(g4.w)} * acc[ai][bj][m][1];
                    if (HASP) { const u32x4 p4 = pw[m][bj]; v0 += (f32x4){bflo(p4.x), bfhi(p4.x), bflo(p4.y), bfhi(p4.y)}; v1 += (f32x4){bflo(p4.z), bfhi(p4.z), bflo(p4.w), bfhi(p4.w)}; }
                    u32x4 w; w.x = cvt_pk_bf16(v0[0], v0[1]); w.y = cvt_pk_bf16(v0[2], v0[3]); w.z = cvt_pk_bf16(v1[0], v1[1]); w.w = cvt_pk_bf16(v1[2], v1[3]); *(u32x4*)(dst + row * dpitch + col) = w; } }
    }
    __device__ __forceinline__ void operator()(const f32x4 (&acc)[2][2][4][2], const Unit& u, int wr, int wc, int fr, int fq) const {
        const int j = u.j;
        asm volatile("s_waitcnt vmcnt(0)" ::: "memory");
        const int row0 = u.pm * BM + wr * 64 + fr, col0 = u.pn * BM + wc * 32 + 8 * fq;
        if (j == 0) body<false>(acc, 0, Mp, 2048, row0, col0);
        else if (j == 1) body<true>(acc, 1, Mp, 2048, row0, col0);
        else body<true>(acc, 2, Mb, 1024, row0, col0);
    }
};
struct EpiResidF {
    static constexpr bool PERM = true, AFTER_DRAIN = false;
    const float* X; float* O;
    __device__ __forceinline__ void operator()(const f32x4 (&acc)[2][2][4][2], const Unit& u, int wr, int wc, int fr, int fq) const {
        asm volatile("s_waitcnt vmcnt(0)" ::: "memory");
        const int row0 = u.pm * BM + wr * 64 + fr, col0 = u.pn * BM + wc * 32 + 8 * fq;
#pragma unroll
        for (int ai = 0; ai < 2; ++ai)
#pragma unroll
            for (int m = 0; m < 4; ++m) { const size_t off = (size_t)(row0 + ai * HALF + m * 16) * 1024 + col0;
#pragma unroll
                for (int bj = 0; bj < 2; ++bj) { const f32x4 x0 = *(const f32x4*)(X + off + bj * HALF), x1 = *(const f32x4*)(X + off + bj * HALF + 4);
                    *(f32x4*)(O + off + bj * HALF) = x0 + acc[ai][bj][m][0]; *(f32x4*)(O + off + bj * HALF + 4) = x1 + acc[ai][bj][m][1]; } }
    }
};
struct EpiResRms {
    static constexpr bool PERM = false, AFTER_DRAIN = true;
    const float* R; float* Hout; float* Nf; bf16_t* Nb; const float* gain; float* xbuf; unsigned* cnt;
    __device__ __forceinline__ void fused(f32x4 (&acc)[2][2][4][2], const Unit& u, int wr, int wc, int fr, int fq, PG8_LAS unsigned char* lds, int wid, int lane) const {
        PG8_LAS float* Pp = (PG8_LAS float*)lds; PG8_LAS float* S = (PG8_LAS float*)(lds + 4096);
        const int col0 = u.pn * BM + wc * 32 + 4 * fq;
#pragma unroll
        for (int ai = 0; ai < 2; ++ai) { f32x4 pre[4][2][2];
#pragma unroll
            for (int m = 0; m < 4; ++m) { const size_t off = (size_t)(u.pm * BM + ai * HALF + wr * 64 + m * 16 + fr) * 1024 + col0;
#pragma unroll
                for (int bj = 0; bj < 2; ++bj)
#pragma unroll
                    for (int n = 0; n < 2; ++n) pre[m][bj][n] = *(const f32x4*)(R + off + bj * HALF + n * 16); }
#pragma unroll
            for (int m = 0; m < 4; ++m) { float sq = 0.f;
#pragma unroll
                for (int bj = 0; bj < 2; ++bj)
#pragma unroll
                    for (int n = 0; n < 2; ++n) { const f32x4 v = acc[ai][bj][m][n] + pre[m][bj][n]; acc[ai][bj][m][n] = v; sq += (v[0] * v[0] + v[1] * v[1]) + (v[2] * v[2] + v[3] * v[3]); }
                sq += __shfl_xor(sq, 16); sq += __shfl_xor(sq, 32);
                if (fq == 0) Pp[(ai * HALF + wr * 64 + m * 16 + fr) * 4 + wc] = sq; } }
        asm volatile("s_waitcnt lgkmcnt(0)" ::: "memory"); __builtin_amdgcn_s_barrier(); asm volatile("" ::: "memory");
        const int row = wid * 32 + (lane & 31);
        if (lane < 32) { const float tot = (Pp[row * 4 + 0] + Pp[row * 4 + 1]) + (Pp[row * 4 + 2] + Pp[row * 4 + 3]);
            __hip_atomic_store(xbuf + ((size_t)(u.pm * BM + row) * 4 + u.pn), tot, __ATOMIC_RELAXED, __HIP_MEMORY_SCOPE_AGENT); }
        asm volatile("s_waitcnt vmcnt(0)" ::: "memory");
        if (lane == 0) __hip_atomic_fetch_add(cnt + 64 * u.pm, 1u, __ATOMIC_RELAXED, __HIP_MEMORY_SCOPE_AGENT);
        if (wid == 0) { unsigned sp = 0;
            while ((unsigned)__builtin_amdgcn_readfirstlane(__hip_atomic_load(cnt + 64 * u.pm, __ATOMIC_RELAXED, __HIP_MEMORY_SCOPE_AGENT)) < 32u) { __builtin_amdgcn_s_sleep(2); if (++sp > (1u << 22)) break; }
            __builtin_amdgcn_fence(__ATOMIC_ACQUIRE, "agent"); }
        asm volatile("s_waitcnt vmcnt(0) lgkmcnt(0)" ::: "memory"); __builtin_amdgcn_s_barrier(); asm volatile("" ::: "memory");
        if (lane < 32) { const float* slot = xbuf + (size_t)(u.pm * BM + row) * 4; float t = 0.f;
#pragma unroll
            for (int q = 0; q < 4; ++q) t += __hip_atomic_load(slot + q, __ATOMIC_RELAXED, __HIP_MEMORY_SCOPE_AGENT);
            S[row] = rsqrtf(t * (1.0f / 1024.0f) + 1e-6f); }
        asm volatile("s_waitcnt lgkmcnt(0)" ::: "memory"); __builtin_amdgcn_s_barrier(); asm volatile("" ::: "memory");
        f32x4 gv[2][2];
#pragma unroll
        for (int bj = 0; bj < 2; ++bj)
#pragma unroll
            for (int n = 0; n < 2; ++n) gv[bj][n] = *(const f32x4*)(gain + col0 + bj * HALF + n * 16);
#pragma unroll
        for (int ai = 0; ai < 2; ++ai)
#pragma unroll
            for (int m = 0; m < 4; ++m) { const int r = ai * HALF + wr * 64 + m * 16 + fr; const float rs = S[r]; const size_t off = (size_t)(u.pm * BM + r) * 1024 + col0;
#pragma unroll
                for (int bj = 0; bj < 2; ++bj)
#pragma unroll
                    for (int n = 0; n < 2; ++n) { const f32x4 v = acc[ai][bj][m][n]; const f32x4 o = v * rs * gv[bj][n];
                        if (Hout) *(f32x4*)(Hout + off + bj * HALF + n * 16) = v;
                        if (Nf) *(f32x4*)(Nf + off + bj * HALF + n * 16) = o;
                        if (Nb) { u32x2 w; w.x = cvt_pk_bf16(o[0], o[1]); w.y = cvt_pk_bf16(o[2], o[3]); *(u32x2*)(Nb + off + bj * HALF + n * 16) = w; } } }
    }
};

template <class Epi, class Sched, bool ALIGN_EPI = false, bool SP2 = false>
__device__ __forceinline__ void gemm_phase(PG8_LAS unsigned char* lds, const Gemm g, const Sched& S, const Epi& E) {
    const int tid = threadIdx.x, wid = __builtin_amdgcn_readfirstlane(tid >> 6), lane = tid & 63, wr = wid >> 2, wc = wid & 3, fr = lane & 15, fq = lane >> 4;
    const int K = g.K, nt = K / BK;
    unsigned voffA[2], voffB[2];
#pragma unroll
    for (int i = 0; i < 2; ++i) { int R, C; stage_rc(tid * 16 + i * 8192, R, C); const int Rb = Epi::PERM ? ((R & ~31) + perm32(R & 31)) : R;
        voffA[i] = (unsigned)(R * K + C) * 2u; voffB[i] = (unsigned)(Rb * K + C) * 2u; }
    const size_t kstep = (size_t)(BK * 2);
    const size_t hstep = (size_t)HALF * K * 2;
    const size_t tstep = 2 * hstep;
    const unsigned ldsw = (unsigned)wid * 1024u;
    const int aoff = lds_byte(wr * 64 + fr, fq * 8), boff = lds_byte(wc * 32 + fr, fq * 8);
#define PG8_SA(b, h) (((b) * 2 + (h)) * HTB)
#define PG8_SB(b, h) ((4 + (b) * 2 + (h)) * HTB)
#define PG8_STAGE(bufoff, gbase, voff) do { _Pragma("unroll") for (int _i = 0; _i < 2; ++_i) \
        __builtin_amdgcn_global_load_lds((const unsigned*)((const char*)(gbase) + (voff)[_i]), (PG8_LAS unsigned*)(lds + (bufoff) + ldsw + _i * 8192), 16, 0, 0); } while (0)
#define PG8_LDA(dst, b, h) do { _Pragma("unroll") for (int m = 0; m < 4; ++m) _Pragma("unroll") for (int k = 0; k < 2; ++k) dst[m][k] = *(const PG8_LAS bf16x8*)(lds + PG8_SA(b, h) + aoff + m * 2048 + k * 1024); } while (0)
#define PG8_LDB(dst, b, h) do { _Pragma("unroll") for (int n = 0; n < 2; ++n) _Pragma("unroll") for (int k = 0; k < 2; ++k) dst[n][k] = *(const PG8_LAS bf16x8*)(lds + PG8_SB(b, h) + boff + n * 2048 + k * 1024); } while (0)
#define PG8_MMA(ai, bj, At, Bt) do { __builtin_amdgcn_s_setprio(1); _Pragma("unroll") for (int m = 0; m < 4; ++m) _Pragma("unroll") for (int n = 0; n < 2; ++n) _Pragma("unroll") for (int k = 0; k < 2; ++k) \
        acc[ai][bj][m][n] = __builtin_amdgcn_mfma_f32_16x16x32_bf16(Bt[n][k], At[m][k], acc[ai][bj][m][n], 0, 0, 0); __builtin_amdgcn_s_setprio(0); } while (0)
#define PG8_WAIT_V(n) asm volatile("s_waitcnt vmcnt(" #n ")" ::: "memory")
#define PG8_WAIT_L(n) asm volatile("s_waitcnt lgkmcnt(" #n ")" ::: "memory")
#define PG8_BAR __builtin_amdgcn_s_barrier()
#define PG8_SCHED __builtin_amdgcn_sched_barrier(0)
    Unit cur, nxt; int ui = 0;
    if (!S.next(0, cur)) return;
    f32x4 acc[2][2][4][2];
#pragma unroll
    for (int a = 0; a < 2; ++a)
#pragma unroll
        for (int b = 0; b < 2; ++b)
#pragma unroll
            for (int m = 0; m < 4; ++m)
#pragma unroll
                for (int n = 0; n < 2; ++n) acc[a][b][m][n] = (f32x4){0.f, 0.f, 0.f, 0.f};
    bf16x8 At[4][2], B0[2][2], B1[2][2];
    const char* cA = S.pa(g, cur, tstep); const char* cB = S.pb(g, cur, tstep);
    S.a_ready(cur);
    if constexpr (SP2) {
        PG8_STAGE(PG8_SB(0, 0), cB, voffB); PG8_STAGE(PG8_SB(0, 1), cB + hstep, voffB); PG8_STAGE(PG8_SA(0, 0), cA, voffA); PG8_STAGE(PG8_SA(0, 1), cA + hstep, voffA);
        if (wr == 1) PG8_BAR;
        PG8_WAIT_V(2); PG8_BAR;
        PG8_STAGE(PG8_SB(1, 0), cB + kstep, voffB); PG8_STAGE(PG8_SA(1, 0), cA + kstep, voffA); PG8_STAGE(PG8_SB(1, 1), cB + hstep + kstep, voffB);
        PG8_WAIT_V(6); PG8_BAR;
    } else {
        PG8_STAGE(PG8_SB(0, 0), cB, voffB); PG8_STAGE(PG8_SA(0, 0), cA, voffA); PG8_STAGE(PG8_SB(0, 1), cB + hstep, voffB); PG8_STAGE(PG8_SA(0, 1), cA + hstep, voffA);
        if (wr == 1) PG8_BAR;
        PG8_WAIT_V(4); PG8_BAR;
        PG8_STAGE(PG8_SB(1, 0), cB + kstep, voffB); PG8_STAGE(PG8_SA(1, 0), cA + kstep, voffA); PG8_STAGE(PG8_SB(1, 1), cB + hstep + kstep, voffB);
        PG8_WAIT_V(6); PG8_BAR;
    }
    for (;;) {
        const bool has_next = S.next(ui + 1, nxt);
        const char* nA = has_next ? S.pa(g, nxt, tstep) : cA; const char* nB = has_next ? S.pb(g, nxt, tstep) : cB;
        for (int t = 0; t < nt; t += 2) {
            const bool last = (t == nt - 2);
            const char* a1 = cA + (size_t)(t + 1) * kstep;
            const char* a2 = last ? nA : cA + (size_t)(t + 2) * kstep; const char* b2 = last ? nB : cB + (size_t)(t + 2) * kstep;
            const char* a3 = a2 + kstep; const char* b3 = b2 + kstep;
            if (last && has_next) S.a_ready(nxt);
            if constexpr (SP2) {
            PG8_LDB(B0, 0, 0); PG8_LDB(B1, 0, 1); PG8_SCHED; PG8_LDA(At, 0, 0); PG8_STAGE(PG8_SA(1, 1), a1 + hstep, voffA);
            PG8_WAIT_V(8); PG8_WAIT_L(0); PG8_BAR; PG8_MMA(0, 0, At, B0); PG8_MMA(0, 1, At, B1); PG8_BAR; PG8_SCHED;
            PG8_LDA(At, 0, 1); PG8_STAGE(PG8_SB(0, 0), b2, voffB); PG8_STAGE(PG8_SB(0, 1), b2 + hstep, voffB); PG8_STAGE(PG8_SA(0, 0), a2, voffA);
            PG8_WAIT_V(8); PG8_WAIT_L(0); PG8_BAR; PG8_MMA(1, 0, At, B0); PG8_MMA(1, 1, At, B1); PG8_BAR; PG8_SCHED;
            PG8_LDB(B0, 1, 0); PG8_LDB(B1, 1, 1); PG8_SCHED; PG8_LDA(At, 1, 0); PG8_STAGE(PG8_SA(0, 1), a2 + hstep, voffA);
            PG8_WAIT_V(8); PG8_WAIT_L(0); PG8_BAR; PG8_MMA(0, 0, At, B0); PG8_MMA(0, 1, At, B1); PG8_BAR; PG8_SCHED;
            PG8_LDA(At, 1, 1); PG8_STAGE(PG8_SB(1, 0), b3, voffB); PG8_STAGE(PG8_SB(1, 1), b3 + hstep, voffB); PG8_STAGE(PG8_SA(1, 0), a3, voffA);
            PG8_WAIT_V(8); PG8_WAIT_L(0); PG8_BAR; PG8_MMA(1, 0, At, B0); PG8_MMA(1, 1, At, B1); PG8_BAR; PG8_SCHED;
            } else {
            PG8_LDB(B0, 0, 0); PG8_SCHED; PG8_LDA(At, 0, 0); PG8_STAGE(PG8_SA(1, 1), a1 + hstep, voffA);
            PG8_WAIT_L(8); PG8_BAR; PG8_WAIT_L(0); PG8_MMA(0, 0, At, B0); PG8_BAR; PG8_SCHED;
            PG8_LDB(B1, 0, 1); PG8_STAGE(PG8_SB(0, 0), b2, voffB);
            PG8_BAR; PG8_WAIT_L(0); PG8_MMA(0, 1, At, B1); PG8_BAR;
            PG8_LDA(At, 0, 1); PG8_STAGE(PG8_SA(0, 0), a2, voffA);
            PG8_BAR; PG8_WAIT_L(0); PG8_MMA(1, 0, At, B0); PG8_BAR; PG8_SCHED;
            PG8_STAGE(PG8_SB(0, 1), b2 + hstep, voffB);
            PG8_WAIT_V(6); PG8_BAR; PG8_MMA(1, 1, At, B1); PG8_BAR;
            PG8_LDB(B0, 1, 0); PG8_SCHED; PG8_LDA(At, 1, 0); PG8_STAGE(PG8_SA(0, 1), a2 + hstep, voffA);
            PG8_WAIT_L(8); PG8_BAR; PG8_WAIT_L(0); PG8_MMA(0, 0, At, B0); PG8_BAR; PG8_SCHED;
            PG8_LDB(B1, 1, 1); PG8_STAGE(PG8_SB(1, 0), b3, voffB);
            PG8_BAR; PG8_WAIT_L(0); PG8_MMA(0, 1, At, B1); PG8_BAR;
            PG8_LDA(At, 1, 1); PG8_STAGE(PG8_SA(1, 0), a3, voffA);
            PG8_BAR; PG8_WAIT_L(0); PG8_MMA(1, 0, At, B0); PG8_BAR; PG8_SCHED;
            PG8_STAGE(PG8_SB(1, 1), b3 + hstep, voffB);
            PG8_WAIT_V(6); PG8_BAR; PG8_MMA(1, 1, At, B1); PG8_BAR;
            }
        }
        if constexpr (ALIGN_EPI) { if (wr == 0) PG8_BAR; }
        if constexpr (!Epi::AFTER_DRAIN) { E(acc, cur, wr, wc, fr, fq); S.done(cur); }
        if (!has_next) break;
#pragma unroll
        for (int a = 0; a < 2; ++a)
#pragma unroll
            for (int b = 0; b < 2; ++b)
#pragma unroll
                for (int m = 0; m < 4; ++m)
#pragma unroll
                    for (int n = 0; n < 2; ++n) acc[a][b][m][n] = (f32x4){0.f, 0.f, 0.f, 0.f};
        cur = nxt; cA = nA; cB = nB; ++ui;
        if constexpr (ALIGN_EPI) { if (wr == 1) PG8_BAR; }
    }
    PG8_WAIT_V(0);
    if constexpr (!ALIGN_EPI) { if (wr == 0) PG8_BAR; }
    PG8_BAR;
    if constexpr (Epi::AFTER_DRAIN) { E.fused(acc, cur, wr, wc, fr, fq, lds, wid, lane); S.done(cur); }
#undef PG8_SA
#undef PG8_SB
#undef PG8_STAGE
#undef PG8_LDA
#undef PG8_LDB
#undef PG8_MMA
#undef PG8_WAIT_V
#undef PG8_WAIT_L
#undef PG8_BAR
#undef PG8_SCHED
}
}

namespace nsa {
#define NLAS __attribute__((address_space(3)))
typedef short bf16x8 __attribute__((ext_vector_type(8)));
typedef short s16x4 __attribute__((ext_vector_type(4)));
typedef short v4i16_t __attribute__((ext_vector_type(4)));
typedef float f32x4 __attribute__((ext_vector_type(4)));
typedef unsigned u32x4 __attribute__((ext_vector_type(4)));
typedef unsigned u32x2 __attribute__((ext_vector_type(2)));
typedef unsigned long long u64;
constexpr int RS = 144, TILE_B = 64 * RS;
constexpr float LOG2E = 1.4426950408889634f;
constexpr int L_KB0 = 0, L_VB0 = TILE_B, L_KB1 = 2 * TILE_B, L_VB1 = 3 * TILE_B, L_CK = 4 * TILE_B, L_CV = 8 * TILE_B, L_IMP = 12 * TILE_B, L_MSK = L_IMP + 8192, L_WU = L_MSK + 256, L_END = L_WU + 64;
static_assert(L_END <= 131072, "nsa LDS map");
__device__ __forceinline__ s16x4 vtr(const NLAS char* p) { return __builtin_bit_cast(s16x4, __builtin_amdgcn_ds_read_tr16_b64_v4i16((NLAS v4i16_t*)p)); }
__device__ __forceinline__ f32x4 mfma16(bf16x8 a, bf16x8 b, f32x4 c) { return __builtin_amdgcn_mfma_f32_16x16x32_bf16(a, b, c, 0, 0, 0); }
__device__ __forceinline__ unsigned pkbf(float lo, float hi) { return pg8::cvt_pk_bf16(lo, hi); }
__device__ __forceinline__ void qk_tile(f32x4 (&s)[4], const NLAS char* Kb, const bf16x8 (&qf)[2], int i, int g, float kslope, float bt) {
    bf16x8 a[4][2]; const NLAS char* kp = Kb + i * RS + 16 * g;
#pragma unroll
    for (int kb = 0; kb < 4; ++kb) { a[kb][0] = *(const NLAS bf16x8*)(kp + kb * 16 * RS); a[kb][1] = *(const NLAS bf16x8*)(kp + kb * 16 * RS + 64); }
#pragma unroll
    for (int kb = 0; kb < 4; ++kb) { f32x4 ci; ci[0] = fmaf(kslope, (float)(kb * 16 + 0), bt); ci[1] = fmaf(kslope, (float)(kb * 16 + 1), bt); ci[2] = fmaf(kslope, (float)(kb * 16 + 2), bt); ci[3] = fmaf(kslope, (float)(kb * 16 + 3), bt);
        s[kb] = mfma16(a[kb][0], qf[0], ci); }
#pragma unroll
    for (int kb = 0; kb < 4; ++kb) s[kb] = mfma16(a[kb][1], qf[1], s[kb]);
}
__device__ __forceinline__ void pv_tile(f32x4 (&o)[4], const NLAS char* Vb, const f32x4 (&p)[4], int i, int g) {
    const NLAS char* vb = Vb + (4 * g + (i >> 2)) * RS + (i & 3) * 8;
    s16x4 lo[2][4], hi[2][4];
#pragma unroll
    for (int kk = 0; kk < 2; ++kk)
#pragma unroll
        for (int db = 0; db < 4; ++db) { const NLAS char* vp = vb + (2 * kk) * 16 * RS + db * 32; lo[kk][db] = vtr(vp); hi[kk][db] = vtr(vp + 16 * RS); }
    bf16x8 pf[2];
#pragma unroll
    for (int kk = 0; kk < 2; ++kk) { u32x4 pw; pw.x = pkbf(p[2 * kk][0], p[2 * kk][1]); pw.y = pkbf(p[2 * kk][2], p[2 * kk][3]); pw.z = pkbf(p[2 * kk + 1][0], p[2 * kk + 1][1]); pw.w = pkbf(p[2 * kk + 1][2], p[2 * kk + 1][3]);
        pf[kk] = __builtin_bit_cast(bf16x8, pw); }
#pragma unroll
    for (int kk = 0; kk < 2; ++kk)
#pragma unroll
        for (int db = 0; db < 4; ++db) o[db] = mfma16((bf16x8){lo[kk][db][0], lo[kk][db][1], lo[kk][db][2], lo[kk][db][3], hi[kk][db][0], hi[kk][db][1], hi[kk][db][2], hi[kk][db][3]}, pf[kk], o[db]);
}
constexpr float THR = 6.0f;
template <bool FIRST>
__device__ __forceinline__ float online_tile(f32x4 (&s)[4], float& m, float& l, f32x4 (&o)[4], bool needmask, int base, int lo, int hi) {
    float fret = 1.f;
    if (needmask) {
#pragma unroll
        for (int kb = 0; kb < 4; ++kb)
#pragma unroll
            for (int r = 0; r < 4; ++r) { const int pos = base + kb * 16 + r; s[kb][r] = (pos >= lo && pos <= hi) ? s[kb][r] : -INFINITY; } }
    float mt = fmaxf(fmaxf(fmaxf(s[0][0], s[0][1]), fmaxf(s[0][2], s[0][3])), fmaxf(fmaxf(s[1][0], s[1][1]), fmaxf(s[1][2], s[1][3])));
    mt = fmaxf(mt, fmaxf(fmaxf(fmaxf(s[2][0], s[2][1]), fmaxf(s[2][2], s[2][3])), fmaxf(fmaxf(s[3][0], s[3][1]), fmaxf(s[3][2], s[3][3]))));
    if (FIRST || __any(mt > THR)) {
        mt = fmaxf(mt, __shfl_xor(mt, 16)); mt = fmaxf(mt, __shfl_xor(mt, 32));
        const float d = FIRST ? ((mt == -INFINITY) ? 0.f : mt) : fmaxf(mt, 0.f), f = __builtin_amdgcn_exp2f(-d); m += d; l *= f; fret = f;
#pragma unroll
        for (int db = 0; db < 4; ++db) o[db] = o[db] * f;
#pragma unroll
        for (int kb = 0; kb < 4; ++kb) s[kb] = s[kb] - d; }
    float sum = 0.f;
#pragma unroll
    for (int kb = 0; kb < 4; ++kb)
#pragma unroll
        for (int r = 0; r < 4; ++r) { const float p = __builtin_amdgcn_exp2f(s[kb][r]); s[kb][r] = p; sum += p; }
    l += sum;
    return fret;
}
struct Stg { u32x4 k, v; };
__device__ __forceinline__ void stg_load(Stg& r, const bf16_t* kb, const bf16_t* vb, size_t pitch, int tid) { const size_t off = (size_t)(tid >> 3) * pitch + (tid & 7) * 8; r.k = *(const u32x4*)(kb + off); r.v = *(const u32x4*)(vb + off); }
__device__ __forceinline__ void stg_store(NLAS char* lds, int ko, int vo, const Stg& r, int tid) { const int off = (tid >> 3) * RS + (tid & 7) * 16; *(NLAS u32x4*)(lds + ko + off) = r.k; *(NLAS u32x4*)(lds + vo + off) = r.v; }
template <bool FIRST>
__device__ __forceinline__ void pair_tiles(const NLAS char* lds, int koA, int voA, int koB, int voB, bool na, bool nb, const bf16x8 (&qf)[2], int i, int g, float slope2,
                                           float btA, float btB, bool maskA, bool maskB, int baseA, int baseB, int lo, int hi, float& m, float& l, f32x4 (&o)[4]) {
    f32x4 sa[4], sb[4];
    if (na) qk_tile(sa, lds + koA, qf, i, g, slope2, btA - m);
    if (nb) qk_tile(sb, lds + koB, qf, i, g, slope2, btB - m);
    float da = 0.f;
    if (na) { const float m0 = m; online_tile<FIRST>(sa, m, l, o, FIRST || maskA, baseA, lo, hi); da = m - m0; pv_tile(o, lds + voA, sa, i, g); }
    if (nb) { if (__any(da != 0.f)) {
#pragma unroll
            for (int kb = 0; kb < 4; ++kb) sb[kb] = sb[kb] - da; }
        online_tile<false>(sb, m, l, o, maskB, baseB, lo, hi); pv_tile(o, lds + voB, sb, i, g); }
}
__device__ __forceinline__ float sigm(float v) { return __builtin_amdgcn_rcpf(1.f + __expf(-v)); }

__device__ __forceinline__ void unit(NLAS char* lds, const bf16_t* P, const float* S32, const bf16_t* KC, const bf16_t* VC, bf16_t* Ynsa, int b, int gq, int ti) {
    const int tid = threadIdx.x, lane = tid & 63, w = __builtin_amdgcn_readfirstlane(tid >> 6), i = lane & 15, g = lane >> 4;
    const int t0 = ti * 32, tl_mine = i >> 2, r = i & 3, h = gq * 4 + r, t = t0 + 4 * w + tl_mine; const size_t m = (size_t)b * T + t;
    const float slope2 = __builtin_amdgcn_exp2f(-(float)(h + 1)) * LOG2E;
    bf16x8 qf[2]; constexpr float QS = 0.125f * LOG2E;
    { const bf16_t* qp = P + m * PW + P_NSQ + h * 64 + 8 * g;
#pragma unroll
      for (int ks = 0; ks < 2; ++ks) { const u32x4 raw = *(const u32x4*)(qp + 32 * ks); u32x4 sc;
          sc.x = pkbf(pg8::bflo(raw.x) * QS, pg8::bfhi(raw.x) * QS); sc.y = pkbf(pg8::bflo(raw.y) * QS, pg8::bfhi(raw.y) * QS);
          sc.z = pkbf(pg8::bflo(raw.z) * QS, pg8::bfhi(raw.z) * QS); sc.w = pkbf(pg8::bflo(raw.w) * QS, pg8::bfhi(raw.w) * QS);
          qf[ks] = __builtin_bit_cast(bf16x8, sc); } }
    const float* gp = S32 + m * 32 + 8 + h * 3;
    const float gate0 = sigm(gp[0]), gate1 = sigm(gp[1]), gate2 = sigm(gp[2]);
    f32x4 outacc[4];
#pragma unroll
    for (int db = 0; db < 4; ++db) outacc[db] = (f32x4){0.f, 0.f, 0.f, 0.f};
    const int ntc = (ti >> 5) + 1;
    { Stg sc_[4];
#pragma unroll
      for (int tile = 0; tile < 4; ++tile) if (tile < ntc) { const size_t row0 = ((size_t)(b * 256 + tile * 64) * 2 + gq) * 64; stg_load(sc_[tile], KC + row0, VC + row0, 128, tid); }
#pragma unroll
      for (int tile = 0; tile < 4; ++tile) if (tile < ntc) stg_store(lds, L_CK + tile * TILE_B, L_CV + tile * TILE_B, sc_[tile], tid); }
    __syncthreads();
    { const int nmax = (t - 31) >> 4, nmax_w = ((t0 + 4 * w) - 31) >> 4; const float kslope = 16.f * slope2, c = -slope2 * (float)(t - 31);
      float mc = 0.f, lc = 0.f; f32x4 oc[4]; float av[16], cv[16];
#pragma unroll
      for (int db = 0; db < 4; ++db) oc[db] = (f32x4){0.f, 0.f, 0.f, 0.f};
#pragma unroll
      for (int q = 0; q < 16; ++q) { av[q] = 0.f; cv[q] = 0.f; }
      bool firstc = true;
#pragma unroll
      for (int tile = 3; tile >= 0; --tile) {
          if (tile < ntc) { f32x4 s[4]; qk_tile(s, lds + L_CK + tile * TILE_B, qf, i, g, kslope, fmaf(kslope, (float)(tile * 64 + 4 * g), c) - mc);
              const bool needmask = (tile * 64 + 63 > nmax_w);
              const float f = firstc ? online_tile<true>(s, mc, lc, oc, needmask, tile * 64 + 4 * g, -0x40000000, nmax) : online_tile<false>(s, mc, lc, oc, needmask, tile * 64 + 4 * g, -0x40000000, nmax);
              if (!firstc && __any(f != 1.f)) {
#pragma unroll
                  for (int q = 0; q < 16; ++q) { av[q] *= f; cv[q] *= f; } }
              firstc = false;
              pv_tile(oc, lds + L_CV + tile * TILE_B, s, i, g);
#pragma unroll
              for (int kb = 0; kb < 4; ++kb) { const f32x4 pv = s[kb];
                  float a = (pv[0] + pv[1]) + (pv[2] + pv[3]), cc = pv[3];
                  a += __shfl_xor(a, 1); a += __shfl_xor(a, 2); cc += __shfl_xor(cc, 1); cc += __shfl_xor(cc, 2);
                  av[tile * 4 + kb] = a; cv[tile * 4 + kb] = cc; } }
      }
      lc += __shfl_xor(lc, 16); lc += __shfl_xor(lc, 32);
      const float inv = lc > 0.f ? 1.f / lc : 0.f, g0i = gate0 * inv;
#pragma unroll
      for (int db = 0; db < 4; ++db) outacc[db] = outacc[db] + oc[db] * g0i;
      NLAS float* imp_s = (NLAS float*)(lds + L_IMP) + (w * 4 + tl_mine) * 64;
      float cprev = 0.f;
#pragma unroll
      for (int q = 0; q < 16; ++q) { const float up = __shfl(cv[q], (lane + 48) & 63); const float im = (av[q] + (g > 0 ? up : cprev)) * inv; cprev = up; if (r == 0) imp_s[4 * q + g] = im; }
    }
    NLAS float* impw = (NLAS float*)(lds + L_IMP) + w * 256;
    float myscore[4];
    asm volatile("s_waitcnt lgkmcnt(0)" ::: "memory");
#pragma unroll
    for (int tl = 0; tl < 4; ++tl) { const int tt = t0 + 4 * w + tl, cur = tt >> 6, j = lane; const bool valid = j <= cur, forced = (j == 0) || (j == cur) || (j == cur - 1);
        const float s = valid ? impw[tl * 64 + j] + (forced ? 1000.f : 0.f) : -1e30f; myscore[tl] = s; }
    u64 wmask[4], wun = 0ull;
#pragma unroll
    for (int tl = 0; tl < 4; ++tl) { const int tt = t0 + 4 * w + tl, cur = tt >> 6; const bool valid = lane <= cur;
        const unsigned key = valid ? ((__builtin_bit_cast(unsigned, myscore[tl]) & ~63u) | (unsigned)(63 - lane)) : 0u; unsigned rank = 0;
#pragma unroll
        for (int jj = 0; jj < 64; ++jj) { const unsigned o = (unsigned)__builtin_amdgcn_readlane((int)key, jj); rank += (o > key) ? 1u : 0u; }
        wmask[tl] = __ballot(rank < 16u && valid); wun |= wmask[tl]; }
    if (lane == 0) { NLAS u64* mk = (NLAS u64*)(lds + L_MSK) + w * 4; mk[0] = wmask[0]; mk[1] = wmask[1]; mk[2] = wmask[2]; mk[3] = wmask[3]; ((NLAS u64*)(lds + L_WU))[w] = wun; }
    __syncthreads();
    const u64 mymask = ((const NLAS u64*)(lds + L_MSK))[w * 4 + tl_mine];
    u64 uall = 0ull;
#pragma unroll
    for (int ww = 0; ww < 8; ++ww) uall |= ((const NLAS u64*)(lds + L_WU))[ww];
    uall = ((u64)__builtin_amdgcn_readfirstlane((unsigned)(uall >> 32)) << 32) | (u64)__builtin_amdgcn_readfirstlane((unsigned)uall);
    const size_t rowb = (size_t)b * T;
    {
        float ms_ = 0.f, ls = 0.f; f32x4 os[4];
#pragma unroll
        for (int db = 0; db < 4; ++db) os[db] = (f32x4){0.f, 0.f, 0.f, 0.f};
        const bf16_t* kcol = P + rowb * PW + P_KS + gq * 64; const bf16_t* vcol = P + rowb * PW + P_VS + gq * 64;
        const float c = -slope2 * (float)t;
        const int jcur = t0 >> 6;
        u64 rem = uall & ((1ull << jcur) - 1ull);
#define NSA_NEXT(dst) { dst = rem ? 63 - __builtin_clzll(rem) : -1; if (dst >= 0) rem &= ~(1ull << dst); }
#define NSA_KO(p, h) ((p) ? L_CK + (h) * TILE_B : ((h) ? L_KB1 : L_KB0))
#define NSA_VO(p, h) ((p) ? L_CV + (h) * TILE_B : ((h) ? L_VB1 : L_VB0))
        int ja = jcur, jb, na_, nb_, cur = 0; bool first = true;
        NSA_NEXT(jb)
        Stg sr0, sr1;
        stg_load(sr0, kcol + (size_t)ja * 64 * PW, vcol + (size_t)ja * 64 * PW, PW, tid); stg_store(lds, L_KB0, L_VB0, sr0, tid);
        if (jb >= 0) { stg_load(sr1, kcol + (size_t)jb * 64 * PW, vcol + (size_t)jb * 64 * PW, PW, tid); stg_store(lds, L_KB1, L_VB1, sr1, tid); }
        NSA_NEXT(na_) NSA_NEXT(nb_)
        if (na_ >= 0) stg_load(sr0, kcol + (size_t)na_ * 64 * PW, vcol + (size_t)na_ * 64 * PW, PW, tid);
        if (nb_ >= 0) stg_load(sr1, kcol + (size_t)nb_ * 64 * PW, vcol + (size_t)nb_ * 64 * PW, PW, tid);
        __syncthreads();
        for (;;) {
            if (na_ >= 0) stg_store(lds, NSA_KO(cur ^ 1, 0), NSA_VO(cur ^ 1, 0), sr0, tid);
            if (nb_ >= 0) stg_store(lds, NSA_KO(cur ^ 1, 1), NSA_VO(cur ^ 1, 1), sr1, tid);
            int nna, nnb; NSA_NEXT(nna) NSA_NEXT(nnb)
            if (nna >= 0) stg_load(sr0, kcol + (size_t)nna * 64 * PW, vcol + (size_t)nna * 64 * PW, PW, tid);
            if (nnb >= 0) stg_load(sr1, kcol + (size_t)nnb * 64 * PW, vcol + (size_t)nnb * 64 * PW, PW, tid);
            const bool na = (wun >> ja) & 1ull, nb = (jb >= 0) && ((wun >> jb) & 1ull);
            if (na || nb) {
                const float btA = fmaf(slope2, (float)(ja * 64 + 4 * g), c) + (((mymask >> ja) & 1ull) ? 0.f : -1e30f);
                const float btB = fmaf(slope2, (float)((jb < 0 ? 0 : jb) * 64 + 4 * g), c) + ((jb >= 0 && ((mymask >> jb) & 1ull)) ? 0.f : -1e30f);
                if (first) pair_tiles<true>(lds, NSA_KO(cur, 0), NSA_VO(cur, 0), NSA_KO(cur, 1), NSA_VO(cur, 1), na, nb, qf, i, g, slope2, btA, btB, true, false, ja * 64 + 4 * g, 0, 0, t, ms_, ls, os);
                else pair_tiles<false>(lds, NSA_KO(cur, 0), NSA_VO(cur, 0), NSA_KO(cur, 1), NSA_VO(cur, 1), na, nb, qf, i, g, slope2, btA, btB, false, false, 0, 0, 0, t, ms_, ls, os); }
            first = false;
            __syncthreads();
            if (na_ < 0) break;
            ja = na_; jb = nb_; na_ = nna; nb_ = nnb; cur ^= 1;
        }
        ls += __shfl_xor(ls, 16); ls += __shfl_xor(ls, 32);
        const float sc1 = gate1 / ls;
#pragma unroll
        for (int db = 0; db < 4; ++db) outacc[db] = outacc[db] + os[db] * sc1;
    }
    {
        float mw = 0.f, lw = 0.f; f32x4 ow[4];
#pragma unroll
        for (int db = 0; db < 4; ++db) ow[db] = (f32x4){0.f, 0.f, 0.f, 0.f};
        const bf16_t* kcol = P + rowb * PW + P_KW + gq * 64; const bf16_t* vcol = P + rowb * PW + P_VW + gq * 64;
        const float c = -slope2 * (float)t;
        const int j0 = (t0 - 511) > 0 ? ((t0 - 511) >> 6) : 0, j1 = t0 >> 6, tw0 = t0 + 4 * w;
        int ja = j1, cur = 0; bool first = true;
        Stg sr0, sr1;
        stg_load(sr0, kcol + (size_t)ja * 64 * PW, vcol + (size_t)ja * 64 * PW, PW, tid); stg_store(lds, L_KB0, L_VB0, sr0, tid);
        if (ja - 1 >= j0) { stg_load(sr1, kcol + (size_t)(ja - 1) * 64 * PW, vcol + (size_t)(ja - 1) * 64 * PW, PW, tid); stg_store(lds, L_KB1, L_VB1, sr1, tid); }
        if (ja - 2 >= j0) stg_load(sr0, kcol + (size_t)(ja - 2) * 64 * PW, vcol + (size_t)(ja - 2) * 64 * PW, PW, tid);
        if (ja - 3 >= j0) stg_load(sr1, kcol + (size_t)(ja - 3) * 64 * PW, vcol + (size_t)(ja - 3) * 64 * PW, PW, tid);
        __syncthreads();
        for (;;) {
            if (ja - 2 >= j0) stg_store(lds, NSA_KO(cur ^ 1, 0), NSA_VO(cur ^ 1, 0), sr0, tid);
            if (ja - 3 >= j0) stg_store(lds, NSA_KO(cur ^ 1, 1), NSA_VO(cur ^ 1, 1), sr1, tid);
            if (ja - 4 >= j0) stg_load(sr0, kcol + (size_t)(ja - 4) * 64 * PW, vcol + (size_t)(ja - 4) * 64 * PW, PW, tid);
            if (ja - 5 >= j0) stg_load(sr1, kcol + (size_t)(ja - 5) * 64 * PW, vcol + (size_t)(ja - 5) * 64 * PW, PW, tid);
            const int jb = ja - 1;
            const bool na = (64 * ja <= tw0 + 3) && (64 * ja + 63 >= tw0 - 511), nb = (jb >= j0) && (64 * jb <= tw0 + 3) && (64 * jb + 63 >= tw0 - 511);
            if (na || nb) {
                const float btA = fmaf(slope2, (float)(ja * 64 + 4 * g), c), btB = fmaf(slope2, (float)(jb * 64 + 4 * g), c);
                const bool maskA = (64 * ja < tw0 + 3 - 511), maskB = (64 * jb < tw0 + 3 - 511);
                if (first) pair_tiles<true>(lds, NSA_KO(cur, 0), NSA_VO(cur, 0), NSA_KO(cur, 1), NSA_VO(cur, 1), na, nb, qf, i, g, slope2, btA, btB, true, maskB, ja * 64 + 4 * g, jb * 64 + 4 * g, t - 511, t, mw, lw, ow);
                else pair_tiles<false>(lds, NSA_KO(cur, 0), NSA_VO(cur, 0), NSA_KO(cur, 1), NSA_VO(cur, 1), na, nb, qf, i, g, slope2, btA, btB, maskA, maskB, ja * 64 + 4 * g, jb * 64 + 4 * g, t - 511, t, mw, lw, ow); }
            first = false;
            __syncthreads();
            if (ja - 2 < j0) break;
            ja -= 2; cur ^= 1;
        }
        lw += __shfl_xor(lw, 16); lw += __shfl_xor(lw, 32);
        const float sc2 = gate2 / lw;
#pragma unroll
        for (int db = 0; db < 4; ++db) outacc[db] = outacc[db] + ow[db] * sc2;
    }
    bf16_t* yo = Ynsa + m * 512 + h * 64 + 4 * g;
#pragma unroll
    for (int db = 0; db < 4; ++db) { u32x2 v; v.x = pkbf(outacc[db][0], outacc[db][1]); v.y = pkbf(outacc[db][2], outacc[db][3]); *(u32x2*)(yo + db * 16) = v; }
}
__device__ __forceinline__ void phase(NLAS char* lds, const bf16_t* P, const float* S32, const bf16_t* KC, const bf16_t* VC, bf16_t* Ynsa) {
    const int G = gridDim.x, bid = blockIdx.x;
    if (G == 256) { const int base = bid >> 3, bg = bid & 7;
#pragma unroll 1
        for (int k = 0; k < 4; ++k) { const int ti = (k == 0) ? 127 - base : (k == 1) ? 64 + base : (k == 2) ? 63 - base : base; unit(lds, P, S32, KC, VC, Ynsa, bg >> 1, bg & 1, ti); } }
    else {
#pragma unroll 1
        for (int u = bid; u < 1024; u += G) unit(lds, P, S32, KC, VC, Ynsa, (u & 7) >> 1, u & 1, 127 - (u >> 3)); }
}
}

namespace xa {
using nsa::bf16x8; using nsa::s16x4; using nsa::f32x4; using nsa::u32x4; using nsa::u32x2; using nsa::vtr; using nsa::mfma16; using nsa::pkbf;
constexpr int RS = 272, TILE_B = 64 * RS;
__device__ __forceinline__ int l_k(int tile) { return tile * 2 * TILE_B; }
__device__ __forceinline__ int l_v(int tile) { return tile * 2 * TILE_B + TILE_B; }
__device__ __forceinline__ void unit(NLAS char* lds, const bf16_t* P, const bf16_t* MEMKV, bf16_t* Yxa, int b, int h, int tt) {
    const int tid = threadIdx.x, lane = tid & 63, w = __builtin_amdgcn_readfirstlane(tid >> 6), i = lane & 15, g = lane >> 4;
    const size_t m = (size_t)b * T + tt * 128 + 16 * w + i;
    const bf16_t* kbase = MEMKV + (size_t)b * 256 * 1024 + h * 128;
    { u32x4 st[4][4]; const bf16_t* p0 = kbase + (size_t)(tid >> 3) * 1024 + (tid & 7) * 8;
#pragma unroll
      for (int tile = 0; tile < 4; ++tile) { const bf16_t* p = p0 + (size_t)tile * 64 * 1024; st[tile][0] = *(const u32x4*)p; st[tile][1] = *(const u32x4*)(p + 64); st[tile][2] = *(const u32x4*)(p + 512); st[tile][3] = *(const u32x4*)(p + 576); }
      const int off = (tid >> 3) * RS + (tid & 7) * 16;
#pragma unroll
      for (int tile = 0; tile < 4; ++tile) { *(NLAS u32x4*)(lds + l_k(tile) + off) = st[tile][0]; *(NLAS u32x4*)(lds + l_k(tile) + off + 128) = st[tile][1]; *(NLAS u32x4*)(lds + l_v(tile) + off) = st[tile][2]; *(NLAS u32x4*)(lds + l_v(tile) + off + 128) = st[tile][3]; } }
    bf16x8 qf[4];
    { const bf16_t* qp = P + m * PW + P_XAQ + h * 128 + 8 * g;
#pragma unroll
      for (int ks = 0; ks < 4; ++ks) qf[ks] = *(const bf16x8*)(qp + 32 * ks); }
    const float scale2 = 0.08838834764831845f * nsa::LOG2E;
    float mx = -INFINITY, l = 0.f; f32x4 o[8];
#pragma unroll
    for (int db = 0; db < 8; ++db) o[db] = (f32x4){0.f, 0.f, 0.f, 0.f};
    __syncthreads();
#pragma unroll 1
    for (int tile = 0; tile < 4; ++tile) {
        const NLAS char* Kb = lds + l_k(tile); const NLAS char* Vb = lds + l_v(tile);
        f32x4 s[4];
        { bf16x8 a[4][4];
#pragma unroll
          for (int kb = 0; kb < 4; ++kb)
#pragma unroll
              for (int ks = 0; ks < 4; ++ks) a[kb][ks] = *(const NLAS bf16x8*)(Kb + (kb * 16 + i) * RS + 16 * g + 64 * ks);
#pragma unroll
          for (int kb = 0; kb < 4; ++kb) s[kb] = mfma16(a[kb][0], qf[0], (f32x4){0.f, 0.f, 0.f, 0.f});
#pragma unroll
          for (int ks = 1; ks < 4; ++ks)
#pragma unroll
              for (int kb = 0; kb < 4; ++kb) s[kb] = mfma16(a[kb][ks], qf[ks], s[kb]); }
        float mt = -INFINITY;
#pragma unroll
        for (int kb = 0; kb < 4; ++kb)
#pragma unroll
            for (int r = 0; r < 4; ++r) { const float v = s[kb][r] * scale2; s[kb][r] = v; mt = fmaxf(mt, v); }
        mt = fmaxf(mt, __shfl_xor(mt, 16)); mt = fmaxf(mt, __shfl_xor(mt, 32));
        const float mn = fmaxf(mx, mt), alpha = __builtin_amdgcn_exp2f(mx - mn); float sum = 0.f;
#pragma unroll
        for (int kb = 0; kb < 4; ++kb)
#pragma unroll
            for (int r = 0; r < 4; ++r) { const float p = __builtin_amdgcn_exp2f(s[kb][r] - mn); s[kb][r] = p; sum += p; }
        l = l * alpha + sum; mx = mn;
#pragma unroll
        for (int db = 0; db < 8; ++db) o[db] = o[db] * alpha;
        const NLAS char* vb = Vb + (4 * g + (i >> 2)) * RS + (i & 3) * 8;
#pragma unroll
        for (int kk = 0; kk < 2; ++kk) {
            u32x4 pw; pw.x = pkbf(s[2 * kk][0], s[2 * kk][1]); pw.y = pkbf(s[2 * kk][2], s[2 * kk][3]); pw.z = pkbf(s[2 * kk + 1][0], s[2 * kk + 1][1]); pw.w = pkbf(s[2 * kk + 1][2], s[2 * kk + 1][3]);
            const bf16x8 pf = __builtin_bit_cast(bf16x8, pw);
            s16x4 lo[8], hi[8];
#pragma unroll
            for (int db = 0; db < 8; ++db) { const NLAS char* vp = vb + (2 * kk) * 16 * RS + db * 32; lo[db] = vtr(vp); hi[db] = vtr(vp + 16 * RS); }
#pragma unroll
            for (int db = 0; db < 8; ++db) o[db] = mfma16((bf16x8){lo[db][0], lo[db][1], lo[db][2], lo[db][3], hi[db][0], hi[db][1], hi[db][2], hi[db][3]}, pf, o[db]);
        }
    }
    l += __shfl_xor(l, 16); l += __shfl_xor(l, 32);
    const float inv = 1.f / l;
    bf16_t* yo = Yxa + m * 512 + h * 128 + 4 * g;
#pragma unroll
    for (int db = 0; db < 8; ++db) { u32x2 v; v.x = pkbf(o[db][0] * inv, o[db][1] * inv); v.y = pkbf(o[db][2] * inv, o[db][3] * inv); *(u32x2*)(yo + db * 16) = v; }
    __syncthreads();
}
__device__ __forceinline__ void memkv_tile(const bf16_t* MEMN, const bf16_t* Wmkv, bf16_t* MEMKV, int tile) {
    const int tid = threadIdx.x, lane = tid & 63, w = __builtin_amdgcn_readfirstlane(tid >> 6), i = lane & 15, g = lane >> 4;
    const int r0 = (tile >> 4) * 64 + (w >> 1) * 16, c0 = (tile & 15) * 64 + (w & 1) * 32;
    const bf16_t* ap = MEMN + (size_t)(r0 + i) * 1024 + 8 * g; const bf16_t* bp = Wmkv + (size_t)(c0 + i) * 1024 + 8 * g;
    f32x4 acc0 = (f32x4){0.f, 0.f, 0.f, 0.f}, acc1 = acc0;
#pragma unroll 1
    for (int k0 = 0; k0 < 32; k0 += 8) { bf16x8 a[8], b0[8], b1[8];
#pragma unroll
        for (int kk = 0; kk < 8; ++kk) { a[kk] = *(const bf16x8*)(ap + 32 * (k0 + kk)); b0[kk] = *(const bf16x8*)(bp + 32 * (k0 + kk)); b1[kk] = *(const bf16x8*)(bp + 16 * 1024 + 32 * (k0 + kk)); }
#pragma unroll
        for (int kk = 0; kk < 8; ++kk) { acc0 = mfma16(a[kk], b0[kk], acc0); acc1 = mfma16(a[kk], b1[kk], acc1); } }
#pragma unroll
    for (int r = 0; r < 4; ++r) { bf16_t* o = MEMKV + (size_t)(r0 + 4 * g + r) * 1024 + c0 + i; o[0] = f2bf(acc0[r]); o[16] = f2bf(acc1[r]); }
}
__device__ __forceinline__ void phase(NLAS char* lds, const bf16_t* P, const bf16_t* MEMKV, bf16_t* Yxa) {
#pragma unroll 1
    for (int u = blockIdx.x; u < 512; u += gridDim.x) unit(lds, P, MEMKV, Yxa, u >> 7, (u >> 5) & 3, u & 31);
}
}

namespace ml {
using nsa::bf16x8; using nsa::s16x4; using nsa::f32x4; using nsa::u32x4; using nsa::u32x2; using nsa::vtr; using nsa::mfma16; using nsa::pkbf;
constexpr int RS = 272, TB = 64 * RS, RSS = 144;
constexpr float KSCALE = 0.08838834764831845f;
__device__ __forceinline__ float scan_add(float v, int lane) {
#pragma unroll
    for (int o = 1; o < 64; o <<= 1) { const float u = __shfl_up(v, o); if (lane >= o) v += u; }
    return v; }
__device__ __forceinline__ float scan_max(float v, int lane) {
#pragma unroll
    for (int o = 1; o < 64; o <<= 1) { const float u = __shfl_up(v, o); if (lane >= o) v = fmaxf(v, u); }
    return v; }
__device__ __forceinline__ bf16x8 trpair(const NLAS char* p, int hi_off) { const s16x4 lo = vtr(p), hi = vtr(p + hi_off); return (bf16x8){lo[0], lo[1], lo[2], lo[3], hi[0], hi[1], hi[2], hi[3]}; }
__device__ __forceinline__ void load_conv(NLAS char* dst, const bf16_t* P, const float* cw, int colP, int cwc, size_t m0, int tseq0, int tid) {
    const int s = tid >> 3, c16 = (tid & 7) * 16;
#pragma unroll
    for (int half = 0; half < 2; ++half) { const int c = c16 + half * 8; float acc[8];
#pragma unroll
        for (int e = 0; e < 8; ++e) acc[e] = 0.f;
#pragma unroll
        for (int j = 0; j < 4; ++j) { if (tseq0 + s - j >= 0) { const u32x4 raw = *(const u32x4*)(P + (m0 + s - j) * PW + colP + c);
            const f32x4 w0 = *(const f32x4*)(cw + j * 1024 + cwc + c), w1 = *(const f32x4*)(cw + j * 1024 + cwc + c + 4);
            acc[0] += w0[0] * pg8::bflo(raw.x); acc[1] += w0[1] * pg8::bfhi(raw.x); acc[2] += w0[2] * pg8::bflo(raw.y); acc[3] += w0[3] * pg8::bfhi(raw.y);
            acc[4] += w1[0] * pg8::bflo(raw.z); acc[5] += w1[1] * pg8::bfhi(raw.z); acc[6] += w1[2] * pg8::bflo(raw.w); acc[7] += w1[3] * pg8::bfhi(raw.w); } }
#pragma unroll
        for (int e = 0; e < 8; ++e) acc[e] = acc[e] * __builtin_amdgcn_rcpf(1.f + __expf(-acc[e]));
        u32x4 o; o.x = pkbf(acc[0], acc[1]); o.y = pkbf(acc[2], acc[3]); o.z = pkbf(acc[4], acc[5]); o.w = pkbf(acc[6], acc[7]);
        *(NLAS u32x4*)(dst + s * RS + c * 2) = o; }
}
__device__ __forceinline__ void m1_unit(NLAS char* lds, const bf16_t* P, const float* cw, const float* S32, bf16_t* Abuf, float* NA, float* Gc, float* Mloc, int ci) {
    constexpr int L_K = 0, L_EV = TB, L_E = 2 * TB;
    const int tid = threadIdx.x, lane = tid & 63, w = __builtin_amdgcn_readfirstlane(tid >> 6), i = lane & 15, g = lane >> 4;
    const int c = ci & 63, bh = ci >> 6, h = bh & 3, b = bh >> 2; const size_t m0 = (size_t)b * T + c * 64;
    NLAS float* eS = (NLAS float*)(lds + L_E);
    if (w == 0) { const float fpre = S32[(m0 + lane) * 32 + 4 + h], ipre = S32[(m0 + lane) * 32 + h];
        const float bcs = scan_add(logsig(fpre), lane), gtot = __shfl(bcs, 63), wend = gtot - bcs + ipre, mloc = wave_max(wend);
        eS[lane] = __expf(wend - mloc) * KSCALE; if (lane == 0) { Gc[ci] = gtot; Mloc[ci] = mloc; } }
    load_conv(lds + L_K, P, cw, P_MLK + h * 128, 512 + h * 128, m0, c * 64, tid);
    __syncthreads();
    { const int s = tid >> 3, c16 = (tid & 7) * 16; const float es = eS[s]; const bf16_t* vp = P + (m0 + s) * PW + P_MLV + h * 128 + c16;
#pragma unroll
      for (int half = 0; half < 2; ++half) { const u32x4 raw = *(const u32x4*)(vp + half * 8); u32x4 o;
          o.x = pkbf(pg8::bflo(raw.x) * es, pg8::bfhi(raw.x) * es); o.y = pkbf(pg8::bflo(raw.y) * es, pg8::bfhi(raw.y) * es);
          o.z = pkbf(pg8::bflo(raw.z) * es, pg8::bfhi(raw.z) * es); o.w = pkbf(pg8::bflo(raw.w) * es, pg8::bfhi(raw.w) * es);
          *(NLAS u32x4*)(lds + L_EV + s * RS + (c16 + half * 8) * 2) = o; } }
    __syncthreads();
    f32x4 acc[8];
#pragma unroll
    for (int vb = 0; vb < 8; ++vb) acc[vb] = (f32x4){0.f, 0.f, 0.f, 0.f};
    const int rowoff = (4 * g + (i >> 2)) * RS + (i & 3) * 8;
#pragma unroll
    for (int kk = 0; kk < 2; ++kk) { const bf16x8 kf = trpair(lds + L_K + kk * 32 * RS + rowoff + w * 32, 16 * RS);
#pragma unroll
        for (int vb = 0; vb < 8; ++vb) acc[vb] = mfma16(trpair(lds + L_EV + kk * 32 * RS + rowoff + vb * 32, 16 * RS), kf, acc[vb]); }
    bf16_t* ap = Abuf + ((size_t)ci * 128 + w * 16 + i) * 128 + 4 * g;
#pragma unroll
    for (int vb = 0; vb < 8; ++vb) { u32x2 pk; pk.x = pkbf(acc[vb][0], acc[vb][1]); pk.y = pkbf(acc[vb][2], acc[vb][3]); *(u32x2*)(ap + vb * 16) = pk; }
    { const int k = tid >> 2, part = tid & 3; float n = 0.f;
#pragma unroll
      for (int s = 0; s < 16; ++s) n += eS[part * 16 + s] * bf2f(*(const NLAS bf16_t*)(lds + L_K + (part * 16 + s) * RS + k * 2));
      n += __shfl_xor(n, 1); n += __shfl_xor(n, 2); if (part == 0) NA[(size_t)ci * 128 + k] = n; }
    __syncthreads();
}
__device__ __forceinline__ void m2_items(bf16_t* Abuf, float* NA, const float* Gc, const float* Mloc, float* Mprev) {
    for (int it = blockIdx.x * blockDim.x + threadIdx.x; it < 16 * 128 * 64; it += gridDim.x * blockDim.x) {
        const int bh = it >> 13, kv2 = it & 8191, k = kv2 >> 6, v2 = kv2 & 63;
        float C0 = 0.f, C1 = 0.f, n = 0.f, m = 0.f;
        unsigned* base = (unsigned*)(Abuf + ((size_t)(bh * 64) * 128 + k) * 128 + v2 * 2);
#pragma unroll 1
        for (int c0 = 0; c0 < 64; c0 += 16) { unsigned A[16];
#pragma unroll
            for (int u = 0; u < 16; ++u) A[u] = base[(size_t)(c0 + u) * 8192];
#pragma unroll
            for (int u = 0; u < 16; ++u) { const int ci = bh * 64 + c0 + u; const float gg = Gc[ci], ml = Mloc[ci];
                const float mn = fmaxf(gg + m, ml), a = __expf(gg + m - mn), bb = __expf(ml - mn);
                base[(size_t)(c0 + u) * 8192] = pkbf(C0, C1); C0 = C0 * a + pg8::bflo(A[u]) * bb; C1 = C1 * a + pg8::bfhi(A[u]) * bb;
                if (v2 == 0) { const float nA = NA[(size_t)ci * 128 + k]; NA[(size_t)ci * 128 + k] = n; n = a * n + bb * nA; }
                if (kv2 == 0) Mprev[ci] = m;
                m = mn; } }
    }
}
__device__ __forceinline__ void m3_unit(NLAS char* lds, const bf16_t* P, const float* cw, const float* S32, const bf16_t* Cprev, const float* Nprev, const float* Mprev, const float* normg, bf16_t* Yml, int ci) {
    constexpr int L_Q = 0, L_K = TB, L_V = 2 * TB, L_C = 3 * TB, L_S = 5 * TB, L_F = L_S + 64 * RSS;
    const int tid = threadIdx.x, lane = tid & 63, w = __builtin_amdgcn_readfirstlane(tid >> 6), i = lane & 15, g = lane >> 4;
    const int c = ci & 63, bh = ci >> 6, h = bh & 3, b = bh >> 2; const size_t m0 = (size_t)b * T + c * 64;
    bf16_t ov[4][4]; float ng[4];
    { const int tb_ = w >> 1, vb0_ = (w & 1) * 4;
#pragma unroll
      for (int vb = 0; vb < 4; ++vb) { ng[vb] = normg[h * 128 + (vb0_ + vb) * 16 + i];
#pragma unroll
          for (int r = 0; r < 4; ++r) ov[vb][r] = P[(m0 + tb_ * 16 + 4 * g + r) * PW + P_MLO + h * 128 + (vb0_ + vb) * 16 + i]; } }
    NLAS float* F = (NLAS float*)(lds + L_F);
    NLAS float* rowf = F; NLAS float* colf = F + 64; NLAS float* scv = F + 128; NLAS float* emt = F + 192; NLAS float* qn = F + 256; NLAS float* nprev = F + 320; NLAS float* denp = F + 448; NLAS float* ssq = F + 576;
    if (w == 0) { const float fpre = S32[(m0 + lane) * 32 + 4 + h], ipre = S32[(m0 + lane) * 32 + h], mprev = Mprev[ci];
        const float bcs = scan_add(logsig(fpre), lane), u = ipre - bcs, pm = scan_max(u, lane), mt = bcs + fmaxf(mprev, pm);
        rowf[lane] = bcs - mt; colf[lane] = u; scv[lane] = __expf(bcs + mprev - mt); emt[lane] = __expf(-mt); }
    else if (w <= 2) nprev[tid - 64] = Nprev[(size_t)ci * 128 + tid - 64];
    load_conv(lds + L_Q, P, cw, P_MLQ + h * 128, h * 128, m0, c * 64, tid);
    load_conv(lds + L_K, P, cw, P_MLK + h * 128, 512 + h * 128, m0, c * 64, tid);
    { const int s = tid >> 3, c16 = (tid & 7) * 16; const bf16_t* vp = P + (m0 + s) * PW + P_MLV + h * 128 + c16;
      *(NLAS u32x4*)(lds + L_V + s * RS + c16 * 2) = *(const u32x4*)vp; *(NLAS u32x4*)(lds + L_V + s * RS + c16 * 2 + 16) = *(const u32x4*)(vp + 8); }
    { const int k = tid >> 2, v0 = (tid & 3) * 32; const bf16_t* cp = Cprev + ((size_t)ci * 128 + k) * 128 + v0;
#pragma unroll
      for (int q8 = 0; q8 < 4; ++q8) *(NLAS u32x4*)(lds + L_C + k * RS + (v0 + q8 * 8) * 2) = *(const u32x4*)(cp + q8 * 8); }
    __syncthreads();
    { const int tq = tid >> 3, part = tid & 7; const u32x4 q0 = *(const NLAS u32x4*)(lds + L_Q + tq * RS + part * 32), q1 = *(const NLAS u32x4*)(lds + L_Q + tq * RS + part * 32 + 16);
      const NLAS f32x4* np = (const NLAS f32x4*)(nprev + part * 16); const f32x4 n0 = np[0], n1 = np[1], n2 = np[2], n3 = np[3];
      float a = pg8::bflo(q0.x) * n0[0] + pg8::bfhi(q0.x) * n0[1] + pg8::bflo(q0.y) * n0[2] + pg8::bfhi(q0.y) * n0[3] + pg8::bflo(q0.z) * n1[0] + pg8::bfhi(q0.z) * n1[1] + pg8::bflo(q0.w) * n1[2] + pg8::bfhi(q0.w) * n1[3]
              + pg8::bflo(q1.x) * n2[0] + pg8::bfhi(q1.x) * n2[1] + pg8::bflo(q1.y) * n2[2] + pg8::bfhi(q1.y) * n2[3] + pg8::bflo(q1.z) * n3[0] + pg8::bfhi(q1.z) * n3[1] + pg8::bflo(q1.w) * n3[2] + pg8::bfhi(q1.w) * n3[3];
      a += __shfl_xor(a, 1); a += __shfl_xor(a, 2); a += __shfl_xor(a, 4); if (part == 0) qn[tq] = a; }
    const int tb = w >> 1;
    {
        float rs[4] = {0.f, 0.f, 0.f, 0.f};
#pragma unroll
        for (int sbi = 0; sbi < 2; ++sbi) { const int sb = 2 * (w & 1) + sbi; f32x4 acc = (f32x4){0.f, 0.f, 0.f, 0.f};
            if (sb <= tb) {
#pragma unroll
                for (int ks = 0; ks < 4; ++ks) acc = mfma16(*(const NLAS bf16x8*)(lds + L_Q + (tb * 16 + i) * RS + (32 * ks + 8 * g) * 2), *(const NLAS bf16x8*)(lds + L_K + (sb * 16 + i) * RS + (32 * ks + 8 * g) * 2), acc); }
            const int s = sb * 16 + i; const float cf = colf[s];
#pragma unroll
            for (int r = 0; r < 4; ++r) { const int t = tb * 16 + 4 * g + r; const float v = (s <= t) ? acc[r] * KSCALE * __expf(rowf[t] + cf) : 0.f; rs[r] += v;
                *(NLAS bf16_t*)(lds + L_S + t * RSS + s * 2) = f2bf(v); } }
#pragma unroll
        for (int r = 0; r < 4; ++r) { float x = rs[r]; x += __shfl_xor(x, 1); x += __shfl_xor(x, 2); x += __shfl_xor(x, 4); x += __shfl_xor(x, 8); if (i == 0) denp[(w & 1) * 64 + tb * 16 + 4 * g + r] = x; }
    }
    __syncthreads();
    f32x4 a1[4], a2[4];
#pragma unroll
    for (int vb = 0; vb < 4; ++vb) { a1[vb] = (f32x4){0.f, 0.f, 0.f, 0.f}; a2[vb] = (f32x4){0.f, 0.f, 0.f, 0.f}; }
    const int vb0 = (w & 1) * 4, troff = (8 * g + (i >> 2)) * RS + (i & 3) * 8;
#pragma unroll
    for (int kk = 0; kk < 2; ++kk) { if (32 * kk <= tb * 16 + 15) { const bf16x8 sf = *(const NLAS bf16x8*)(lds + L_S + (tb * 16 + i) * RSS + (32 * kk + 8 * g) * 2);
#pragma unroll
        for (int vb = 0; vb < 4; ++vb) a1[vb] = mfma16(sf, trpair(lds + L_V + kk * 32 * RS + troff + (vb0 + vb) * 32, 4 * RS), a1[vb]); } }
#pragma unroll
    for (int ks = 0; ks < 4; ++ks) { const bf16x8 qf = *(const NLAS bf16x8*)(lds + L_Q + (tb * 16 + i) * RS + (32 * ks + 8 * g) * 2);
#pragma unroll
        for (int vb = 0; vb < 4; ++vb) a2[vb] = mfma16(qf, trpair(lds + L_C + ks * 32 * RS + troff + (vb0 + vb) * 32, 4 * RS), a2[vb]); }
    float hv[4][4], sq[4] = {0.f, 0.f, 0.f, 0.f};
#pragma unroll
    for (int r = 0; r < 4; ++r) { const int t = tb * 16 + 4 * g + r; const float sc = scv[t]; const float den = denp[t] + denp[64 + t] + sc * qn[t]; const float hd = 1.f / fmaxf(fabsf(den), emt[t]);
#pragma unroll
        for (int vb = 0; vb < 4; ++vb) { const float x = (a1[vb][r] + sc * a2[vb][r]) * hd; hv[vb][r] = x; sq[r] += x * x; } }
#pragma unroll
    for (int r = 0; r < 4; ++r) { float x = sq[r]; x += __shfl_xor(x, 1); x += __shfl_xor(x, 2); x += __shfl_xor(x, 4); x += __shfl_xor(x, 8); if (i == 0) ssq[(w & 1) * 64 + tb * 16 + 4 * g + r] = x; }
    __syncthreads();
#pragma unroll
    for (int r = 0; r < 4; ++r) { const int t = tb * 16 + 4 * g + r; const float rinv = rsqrtf((ssq[t] + ssq[64 + t]) * (1.f / 128.f) + EPS);
#pragma unroll
        for (int vb = 0; vb < 4; ++vb) { const int v = (vb0 + vb) * 16 + i; const float o = bf2f(ov[vb][r]);
            Yml[(m0 + t) * 512 + h * 128 + v] = f2bf(__builtin_amdgcn_rcpf(1.f + __expf(-o)) * hv[vb][r] * rinv * ng[vb]); } }
    __syncthreads();
}
}

namespace cmpr {
using nsa::bf16x8; using nsa::f32x4; using nsa::u32x4; using nsa::mfma16; using nsa::pkbf;
constexpr int RSX = 144, L_X = 0, L_PE = 272 * RSX  , L_H = L_PE + 8192, RSH = 528;
__device__ __forceinline__ void unit(NLAS char* lds, const bf16_t* P, const float* pe, const bf16_t* W1t, const bf16_t* W2t, bf16_t* KC, bf16_t* VC, int u) {
    const int tid = threadIdx.x, lane = tid & 63, w = __builtin_amdgcn_readfirstlane(tid >> 6), i = lane & 15, g = lane >> 4;
    const int nt = u & 15, gq = (u >> 4) & 1, b = (u >> 5) & 3, kv = u >> 7;
    const int pcol = (kv ? P_VC : P_KC) + gq * 64, tok0 = 256 * nt;
    for (int ch = tid; ch < 272 * 8; ch += 512) { const int row = ch >> 3, c8 = (ch & 7) * 8, tok = tok0 + row;
        u32x4 v = (u32x4){0u, 0u, 0u, 0u}; if (tok < T) v = *(const u32x4*)(P + ((size_t)b * T + tok) * PW + pcol + c8);
        *(NLAS u32x4*)(lds + L_X + row * RSX + c8 * 2) = v; }
    for (int e = tid; e < 2048; e += 512) ((NLAS float*)(lds + L_PE))[e] = pe[kv * 2048 + e];
    __syncthreads();
    f32x4 acc[2]; acc[0] = (f32x4){0.f, 0.f, 0.f, 0.f}; acc[1] = acc[0];
    const bf16_t* wb = W1t + ((size_t)kv * 256 + 32 * w + i) * 2048 + 8 * g;
#define CMPR_LOAD(dst, k0_) { _Pragma("unroll") for (int kk = 0; kk < 8; ++kk) { dst[kk][0] = *(const bf16x8*)(wb + 32 * ((k0_) + kk)); dst[kk][1] = *(const bf16x8*)(wb + 16 * 2048 + 32 * ((k0_) + kk)); } }
#define CMPR_COMP(src, k0_) { _Pragma("unroll") for (int kk = 0; kk < 8; ++kk) { const int ks = (k0_) + kk, l = ks >> 1, dh = ks & 1; \
            const u32x4 raw = *(const NLAS u32x4*)(lds + L_X + (16 * i + l) * RSX + dh * 64 + 16 * g); \
            const NLAS float* pp = (const NLAS float*)(lds + L_PE) + l * 64 + dh * 32 + 8 * g; const f32x4 p0 = *(const NLAS f32x4*)pp, p1 = *(const NLAS f32x4*)(pp + 4); \
            u32x4 a; a.x = pkbf(pg8::bflo(raw.x) + p0[0], pg8::bfhi(raw.x) + p0[1]); a.y = pkbf(pg8::bflo(raw.y) + p0[2], pg8::bfhi(raw.y) + p0[3]); \
            a.z = pkbf(pg8::bflo(raw.z) + p1[0], pg8::bfhi(raw.z) + p1[1]); a.w = pkbf(pg8::bflo(raw.w) + p1[2], pg8::bfhi(raw.w) + p1[3]); \
            const bf16x8 af = __builtin_bit_cast(bf16x8, a); \
            acc[0] = mfma16(af, src[kk][0], acc[0]); acc[1] = mfma16(af, src[kk][1], acc[1]); } }
    { bf16x8 bA[8][2], bB[8][2];
      CMPR_LOAD(bA, 0)
#pragma unroll 1
      for (int k0 = 0; k0 < 64; k0 += 16) { CMPR_LOAD(bB, k0 + 8) CMPR_COMP(bA, k0) if (k0 + 16 < 64) CMPR_LOAD(bA, k0 + 16) CMPR_COMP(bB, k0 + 8) } }
#undef CMPR_LOAD
#undef CMPR_COMP
#pragma unroll
    for (int cb = 0; cb < 2; ++cb)
#pragma unroll
        for (int r = 0; r < 4; ++r) { const float x = acc[cb][r], uu = 0.7978845608028654f * (x + 0.044715f * x * x * x); const float gl = x * __builtin_amdgcn_rcpf(1.f + __expf(-2.f * uu));
            *(NLAS bf16_t*)(lds + L_H + (4 * g + r) * RSH + (32 * w + cb * 16 + i) * 2) = f2bf(gl); }
    __syncthreads();
    if (w < 4) { f32x4 o = (f32x4){0.f, 0.f, 0.f, 0.f}; const bf16_t* w2 = W2t + ((size_t)kv * 64 + 16 * w + i) * 256 + 8 * g;
#pragma unroll
        for (int ks = 0; ks < 8; ++ks) o = mfma16(*(const NLAS bf16x8*)(lds + L_H + i * RSH + (32 * ks + 8 * g) * 2), *(const bf16x8*)(w2 + 32 * ks), o);
        bf16_t* dst = (kv ? VC : KC);
#pragma unroll
        for (int r = 0; r < 4; ++r) dst[((size_t)(b * 256 + 16 * nt + 4 * g + r) * 2 + gq) * 64 + 16 * w + i] = f2bf(o[r]); }
    __syncthreads();
}
}

#define LAS __attribute__((address_space(3)))
constexpr int NTHREADS = 512, LDS_BYTES = 147456;
constexpr size_t WS_WIN = 1 * MiB, WS_WG = 9 * MiB, WS_WBR = 15 * MiB, WS_WOUT = 18 * MiB, WS_WFF1 = 20 * MiB, WS_WFF2 = 28 * MiB, WS_WMKV = 36 * MiB, WS_WC1 = 38 * MiB;
constexpr size_t WS_BIASP = 253 * MiB + 768 * 1024, WS_XCH = 254 * MiB;
#define XB_TMO      128
#define XB_XCNT(j)  (256  + 64 * (j))
#define XB_XSUB(j)  (1280 + 64 * (j))
#define XB_XGEN(j)  (2304 + 64 * (j))
#define XB_TOP      3328
#define XB_TOPGEN   3392
#define XCD_BAR_WORDS 3456
#define XB_SPIN_CAP (1u << 18)

__device__ __forceinline__ unsigned xb_ld(unsigned* p)              { return __hip_atomic_load(p, __ATOMIC_RELAXED, __HIP_MEMORY_SCOPE_AGENT); }
__device__ __forceinline__ unsigned xb_add(unsigned* p, unsigned v) { return __hip_atomic_fetch_add(p, v, __ATOMIC_RELAXED, __HIP_MEMORY_SCOPE_AGENT); }
__device__ __forceinline__ unsigned xb_xcc_id() { return (unsigned)__builtin_amdgcn_s_getreg((3 << 11) | 20) & 0xFu; }
#define XB_SPIN(cond, bar) do { unsigned _sp = 0; while (cond) { __builtin_amdgcn_s_sleep(1); \
    if ((++_sp & 255u) == 0u) { if (xb_ld(&(bar)[XB_TMO])) break; if (_sp > XB_SPIN_CAP) { atomicAdd(&(bar)[XB_TMO], 1u); break; } } } } while (0)

struct XcdBarrier {
    unsigned* bar; unsigned x;
    volatile LAS unsigned* st;
};

__device__ __forceinline__ XcdBarrier xcd_barrier_post(unsigned* bar, volatile LAS unsigned* st) {
    XcdBarrier b; b.bar = bar; b.x = xb_xcc_id(); b.st = st;
    if (threadIdx.x == 0) (void)xb_add(&bar[XB_XCNT(b.x)], 1u);
    return b;
}
__device__ __forceinline__ void xcd_barrier_complete(unsigned* bar, unsigned x, unsigned& nloc, unsigned& nx) {
    const unsigned G = gridDim.x * gridDim.y * gridDim.z;
    unsigned sum, cnt, mine, sp = 0u;
    for (;;) {
        sum = 0u; cnt = 0u; mine = 0u;
#pragma unroll
        for (unsigned j = 0; j < 16; ++j) { const unsigned c = xb_ld(&bar[XB_XCNT(j)]); sum += c; cnt += (c > 0u) ? 1u : 0u; mine = (j == x) ? c : mine; }
        if (sum == G) break;
        __builtin_amdgcn_s_sleep(1);
        if ((++sp & 255u) == 0u) { if (xb_ld(&bar[XB_TMO])) break; if (sp > XB_SPIN_CAP) { atomicAdd(&bar[XB_TMO], 1u); break; } }
    }
    nloc = mine > 0u ? mine : 1u; nx = cnt > 0u ? cnt : 1u;
}

__device__ __forceinline__ void xcd_barrier(const XcdBarrier& b) {
    asm volatile("s_waitcnt vmcnt(0)" ::: "memory");
    __syncthreads();
    if (threadIdx.x == 0) {
        unsigned* bar = b.bar;
        __builtin_amdgcn_s_waitcnt(0);
        unsigned nloc = b.st[0], nx = b.st[1];
        if (nloc == 0u) { xcd_barrier_complete(bar, b.x, nloc, nx); b.st[0] = nloc; b.st[1] = nx; }
        const unsigned old = xb_add(&bar[XB_XSUB(b.x)], 1u);
        const unsigned gen = old / nloc;
        if (old + 1u == (gen + 1u) * nloc) {
            __builtin_amdgcn_fence(__ATOMIC_RELEASE, "agent");
            asm volatile("s_waitcnt vmcnt(0)" ::: "memory");
            const unsigned og = xb_add(&bar[XB_TOP], 1u);
            const unsigned tg = og / nx;
            if (og + 1u == (tg + 1u) * nx) xb_add(&bar[XB_TOPGEN], 1u);
            else XB_SPIN(xb_ld(&bar[XB_TOPGEN]) == tg, bar);
            __builtin_amdgcn_fence(__ATOMIC_ACQUIRE, "agent");
            xb_add(&bar[XB_XGEN(b.x)], 1u);
            asm volatile("s_waitcnt vmcnt(0)" ::: "memory");
        } else {
            XB_SPIN(xb_ld(&bar[XB_XGEN(b.x)]) == gen, bar);
            __builtin_amdgcn_fence(__ATOMIC_ACQUIRE, "agent");
            asm volatile("s_waitcnt vmcnt(0)" ::: "memory");
        }
    }
    __syncthreads();
}

__device__ __forceinline__ void group_barrier(unsigned* gc, unsigned target, bool light) {
    asm volatile("s_waitcnt vmcnt(0)" ::: "memory"); __syncthreads();
    if (threadIdx.x == 0) {
        if (!light) { __builtin_amdgcn_fence(__ATOMIC_RELEASE, "agent"); asm volatile("s_waitcnt vmcnt(0)" ::: "memory"); }
        __hip_atomic_fetch_add(gc, 1u, __ATOMIC_RELAXED, __HIP_MEMORY_SCOPE_AGENT);
        unsigned sp = 0; while (__hip_atomic_load(gc, __ATOMIC_RELAXED, __HIP_MEMORY_SCOPE_AGENT) < target) { __builtin_amdgcn_s_sleep(1); if (++sp > (1u << 22)) break; }
        __builtin_amdgcn_fence(__ATOMIC_ACQUIRE, "agent"); asm volatile("s_waitcnt vmcnt(0)" ::: "memory");
    }
    __syncthreads();
}
struct Args { const float* in[18]; float* out; unsigned char* ws; int ph_lo, ph_hi; };
__device__ __forceinline__ unsigned pk2(float lo, float hi) { return (unsigned)f2bf(lo) | ((unsigned)f2bf(hi) << 16); }
typedef unsigned v4u __attribute__((ext_vector_type(4)));
typedef float f32x4 __attribute__((ext_vector_type(4)));
__device__ __forceinline__ void tr_item(const float* W, int ld, int ncols, int K, bf16_t* WT, int row_off, LAS float* scr, int item, int lane) {
    const int nblk = ncols / 32, kb = item / nblk, nb = item % nblk, k0 = 64 * kb, n0 = 32 * nb;
#pragma unroll 8
    for (int i = 0; i < 32; ++i) { const int kk = 2 * i + (lane >> 5); scr[kk * 33 + (lane & 31)] = W[(size_t)(k0 + kk) * ld + n0 + (lane & 31)]; }
    asm volatile("s_waitcnt lgkmcnt(0)" ::: "memory");
    const int c = lane & 7;
#pragma unroll
    for (int j = 0; j < 4; ++j) { const int n = (lane >> 3) + 8 * j; const LAS float* s = scr + (8 * c) * 33 + n;
        v4u o; o.x = pk2(s[0 * 33], s[1 * 33]); o.y = pk2(s[2 * 33], s[3 * 33]); o.z = pk2(s[4 * 33], s[5 * 33]); o.w = pk2(s[6 * 33], s[7 * 33]);
        *(v4u*)(WT + (size_t)(row_off + n0 + n) * K + k0 + 8 * c) = o; }
    asm volatile("s_waitcnt lgkmcnt(0)" ::: "memory");
}
__device__ __forceinline__ void rms_row_wave(const float* xrow, const float* g, bf16_t* orow, int lane) {
    const f32x4* xr = (const f32x4*)xrow + lane; const f32x4* gr = (const f32x4*)g + lane;
    f32x4 v[4]; float s = 0.f;
#pragma unroll
    for (int j = 0; j < 4; ++j) { v[j] = xr[64 * j]; s += (v[j].x * v[j].x + v[j].y * v[j].y) + (v[j].z * v[j].z + v[j].w * v[j].w); }
    const float r = rsqrtf(wave_sum(s) * (1.f / D) + EPS);
    unsigned long long* o8 = (unsigned long long*)orow + lane;
#pragma unroll
    for (int j = 0; j < 4; ++j) { const f32x4 gg = gr[64 * j]; o8[64 * j] = (unsigned long long)pk2(v[j].x * r * gg.x, v[j].y * r * gg.y) | ((unsigned long long)pk2(v[j].z * r * gg.z, v[j].w * r * gg.w) << 32); }
}
__device__ __forceinline__ int small_src_col(int c) { return c < 8 ? C_MLI + c : C_NSG + (c - 8); }
__global__ void __launch_bounds__(NTHREADS, 2) mega(Args a) {
    extern __shared__ __attribute__((aligned(16))) unsigned char lds_raw[];
    char* lds = (char*)lds_raw;
    LAS unsigned char* lds3 = (LAS unsigned char*)lds_raw;
    const float* x = a.in[0]; const float* mem = a.in[1]; const float* g_mix = a.in[2]; const float* w_in = a.in[3];
    const float* b_in = a.in[4]; const float* ml_conv = a.in[5]; const float* ml_norm_g = a.in[6]; const float* cmp_pe = a.in[7];
    const float* cmp_w1 = a.in[8]; const float* cmp_w2 = a.in[9]; const float* g_mem = a.in[10]; const float* w_mem_kv = a.in[11];
    const float* w_branch = a.in[12]; const float* w_out = a.in[13]; const float* g_ffn = a.in[14]; const float* w_ff1 = a.in[15];
    const float* w_ff2 = a.in[16]; const float* g_final = a.in[17];
    char* ws = (char*)a.ws; float* out = a.out;
    bf16_t* U = (bf16_t*)(ws + WS_U); bf16_t* P = (bf16_t*)(ws + WS_P);
    bf16_t* Yml = (bf16_t*)(ws + WS_Y); bf16_t* Ynsa = Yml + (size_t)M * 512; bf16_t* Yxa = Ynsa + (size_t)M * 512;
    float* S32 = (float*)(ws + WS_S32); bf16_t* MEMN = (bf16_t*)out + (size_t)16 * 1024 * 1024;     bf16_t* MEMKV = (bf16_t*)(ws + WS_MEMKV);
    bf16_t* KC = (bf16_t*)(ws + WS_KC); bf16_t* VC = (bf16_t*)(ws + WS_VC);
    float* NA = (float*)(ws + WS_NA); float* Gc = (float*)(ws + WS_G); float* Mloc = (float*)(ws + WS_MLOC); float* Mprev = (float*)(ws + WS_MPREV);
    bf16_t* Abuf = (bf16_t*)out;
    bf16_t* GATES = P; bf16_t* MERGED = U; bf16_t* AFFN = U; bf16_t* HBUF = P;
    bf16_t* Wi = (bf16_t*)(ws + WS_WIN); bf16_t* Wg = (bf16_t*)(ws + WS_WG); bf16_t* Wbr = (bf16_t*)(ws + WS_WBR); bf16_t* Wo = (bf16_t*)(ws + WS_WOUT);
    bf16_t* Wf1 = (bf16_t*)(ws + WS_WFF1); bf16_t* Wf2 = (bf16_t*)(ws + WS_WFF2); bf16_t* Wmkv = (bf16_t*)(ws + WS_WMKV);
    float* biasP = (float*)(ws + WS_BIASP); bf16_t* Wc1 = (bf16_t*)(ws + WS_WC1); bf16_t* Wc2 = (bf16_t*)(ws + WS_BIASP + 65536);
    const int tid = threadIdx.x, lane = tid & 63, wave = __builtin_amdgcn_readfirstlane(tid >> 6);
    const int G = gridDim.x, bid = blockIdx.x;
    const int lo = a.ph_lo, hi = a.ph_hi;
    volatile LAS unsigned* xbst = (volatile LAS unsigned*)(lds3 + LDS_BYTES - 64);
    if (tid < 2) xbst[tid] = 0u;
    __syncthreads();
    const XcdBarrier bar = xcd_barrier_post((unsigned*)ws, xbst);
    if (tid == 0) __hip_atomic_store((unsigned*)ws + 12544 + bid, xb_xcc_id() + 1u, __ATOMIC_RELAXED, __HIP_MEMORY_SCOPE_AGENT);
#define PHASE(k) if (lo <= (k) && (k) < hi)
#define SEAM(k) if (lo <= (k) && (k) + 1 < hi) xcd_barrier(bar)
    PHASE(0) {
        LAS float* scr = (LAS float*)(lds3 + wave * 16384);
        const int gw = bid * 8 + wave, NGW = G * 8;
        constexpr int I0 = 16 * 64, I1 = 16 * 40, I2 = 16 * 16, I3 = 16 * 96, I4 = 8 * 32, I5 = 16 * 32, I6 = 16 * 128, I7 = 64 * 32, I8 = 16 * 32;
        constexpr int I9 = 32 * 8, I10 = 4 * 2;
        constexpr int NITEMS = I0 + I1 + I2 + I3 + 3 * I4 + I5 + I6 + I7 + I8 + 2 * I9 + 2 * I10;
        for (int it = gw; it < NITEMS; it += NGW) {
            int r = it;
            if (r < I0) { tr_item(w_in, DIN, 2048, 1024, Wi, 0, scr, r, lane); continue; } r -= I0;
            if (r < I1) { tr_item(w_in + 2056, DIN, 1280, 1024, Wi, 2048, scr, r, lane); continue; } r -= I1;
            if (r < I2) { tr_item(w_in + 3360, DIN, 512, 1024, Wi, 3328, scr, r, lane); continue; } r -= I2;
            if (r < I3) { tr_item(w_in + C_MG, DIN, 3072, 1024, Wg, 0, scr, r, lane); continue; } r -= I3;
            if (r < 3 * I4) { const int j = r / I4; tr_item(w_branch + (size_t)j * 512 * 1024, 1024, 1024, 512, Wbr + (size_t)j * 1024 * 512, 0, scr, r % I4, lane); continue; } r -= 3 * I4;
            if (r < I5) { tr_item(w_out, 1024, 1024, 1024, Wo, 0, scr, r, lane); continue; } r -= I5;
            if (r < I6) { tr_item(w_ff1, FF, FF, 1024, Wf1, 0, scr, r, lane); continue; } r -= I6;
            if (r < I7) { tr_item(w_ff2, 1024, 1024, FF, Wf2, 0, scr, r, lane); continue; } r -= I7;
            if (r < I8) { tr_item(w_mem_kv, 1024, 1024, 1024, Wmkv, 0, scr, r, lane); continue; } r -= I8;
            if (r < 2 * I9) { const int kv = r / I9; tr_item(cmp_w1 + (size_t)kv * 2048 * 256, 256, 256, 2048, Wc1 + (size_t)kv * 256 * 2048, 0, scr, r % I9, lane); continue; } r -= 2 * I9;
            { const int kv = r / I10; tr_item(cmp_w2 + (size_t)kv * 256 * 64, 64, 64, 256, Wc2 + (size_t)kv * 64 * 256, 0, scr, r % I10, lane); }
        }
        for (int i = bid * NTHREADS + tid; i < 256 * 1024; i += G * NTHREADS) { const int r = i >> 10, k = i & 1023; bf16_t v = 0;
            if (r < 32) v = f2bf(w_in[(size_t)k * DIN + small_src_col(r)]);
            else if (r >= 128 && r < 160) { const float w = w_in[(size_t)k * DIN + small_src_col(r - 128)]; v = f2bf(w - bf2f(f2bf(w))); }
            Wi[(size_t)(3840 + r) * 1024 + k] = v; }
        for (int c = bid * NTHREADS + tid; c < 4096; c += G * NTHREADS) { float v = 0.f;
            if (c < 2048) v = b_in[c]; else if (c < 3328) v = b_in[c + 8]; else if (c < 3840) v = b_in[c + 32]; else if (c < 3872) v = b_in[small_src_col(c - 3840)];
            biasP[c] = v; }
        for (int m = gw; m < M; m += NGW) rms_row_wave(x + (size_t)m * D, g_mix, U + (size_t)m * D, lane);
        for (int m = gw; m < 1024; m += NGW) rms_row_wave(mem + (size_t)m * D, g_mem, MEMN + (size_t)m * D, lane);
    }
    SEAM(0);
    PHASE(1) {
        { pg8::Gemm g{U, Wi, M, 4096, D}; pg8::StaticOrder S; S.init(M, 4096, G, bid);
          pg8::EpiStore<0> E{P, biasP, S32, PW, 15};
          pg8::gemm_phase<pg8::EpiStore<0>, pg8::StaticOrder, true, true>(lds3, g, S, E); }
    }
    SEAM(1);
    PHASE(2) { for (int tl_ = bid; tl_ < 256; tl_ += G) xa::memkv_tile(MEMN, Wmkv, MEMKV, tl_);
               for (int ci = bid; ci < 1024; ci += G) ml::m1_unit((NLAS char*)lds_raw, P, ml_conv, S32, Abuf, NA, Gc, Mloc, ci);
               for (int u = bid; u < 256; u += G) cmpr::unit((NLAS char*)lds_raw, P, cmp_pe, Wc1, Wc2, KC, VC, u);
    }
    SEAM(2);
    PHASE(3) { unsigned* m2cnt = (unsigned*)ws + 12288;
               ml::m2_items(Abuf, NA, Gc, Mloc, Mprev);
               asm volatile("s_waitcnt vmcnt(0)" ::: "memory"); __syncthreads();
               if (tid == 0) { __builtin_amdgcn_fence(__ATOMIC_RELEASE, "agent"); asm volatile("s_waitcnt vmcnt(0)" ::: "memory"); __hip_atomic_fetch_add(m2cnt, 1u, __ATOMIC_RELAXED, __HIP_MEMORY_SCOPE_AGENT); }
               nsa::phase((NLAS char*)lds_raw, P, S32, KC, VC, Ynsa);
               xa::phase((NLAS char*)lds_raw, P, MEMKV, Yxa);
               if (tid == 0) { unsigned sp = 0; while (__hip_atomic_load(m2cnt, __ATOMIC_RELAXED, __HIP_MEMORY_SCOPE_AGENT) < (unsigned)G) { __builtin_amdgcn_s_sleep(2); if (++sp > (1u << 22)) break; }
                               __builtin_amdgcn_fence(__ATOMIC_ACQUIRE, "agent"); asm volatile("s_waitcnt vmcnt(0)" ::: "memory"); }
               __syncthreads();
               for (int ci = bid; ci < 1024; ci += G) ml::m3_unit((NLAS char*)lds_raw, P, ml_conv, S32, Abuf, NA, Mprev, ml_norm_g, Yml, ci); }
    SEAM(4);
    unsigned* gcnt = (unsigned*)ws + 13312 + 16 * (bid & 63);
    bool panel_sync = false;
    if (G == 256) { volatile LAS unsigned* flag = (volatile LAS unsigned*)(lds3 + LDS_BYTES - 48);
        if (wave == 0) { const unsigned* xt = (const unsigned*)ws + 12544; unsigned x0 = 0, same = 1;
            for (int k = 0; k < 4; ++k) { const unsigned xv = __hip_atomic_load(xt + lane + 64 * k, __ATOMIC_RELAXED, __HIP_MEMORY_SCOPE_AGENT); if (k == 0) x0 = xv; same &= (xv == x0 && xv != 0u) ? 1u : 0u; }
            const unsigned long long all = __ballot(same != 0u); if (lane == 0) flag[0] = (all == ~0ull) ? 1u : 0u; }
        __syncthreads();
        panel_sync = flag[0] != 0u; }
    const bool light = true;
#define PSEAM(k, n) if (lo <= (k) && (k) + 1 < hi) { if (panel_sync) group_barrier(gcnt, 4u * (n), light); else xcd_barrier(bar); }
    PHASE(5) { pg8::Gemm g{U, Wg, M, 3072, D}; pg8::StaticOrder S; S.init(M, 3072, G, bid);
               pg8::EpiStore<1> E{GATES, b_in + C_MG, nullptr, 4096, -1};
               pg8::gemm_phase<pg8::EpiStore<1>, pg8::StaticOrder, true, true>(lds3, g, S, E); }
    PSEAM(5, 1);
    PHASE(6) { pg8::Gemm g{Yml, Wbr, M, 1024, 512}; pg8::MergeOrder S; S.so.init(M, 1024, G, bid); S.sa = (size_t)M * 512 * 2; S.sb = (size_t)1024 * 512 * 2;
               pg8::EpiMergeG E{GATES, (bf16_t*)out, MERGED};
               pg8::gemm_phase<pg8::EpiMergeG, pg8::MergeOrder, true, true>(lds3, g, S, E); }
    PSEAM(6, 2);
    PHASE(7) { pg8::Gemm g{MERGED, Wo, M, 1024, D}; pg8::StaticOrder S; S.init(M, 1024, G, bid);
               pg8::EpiResRms E{x, out, nullptr, AFFN, g_ffn, (float*)(ws + WS_XCH), (unsigned*)ws + 4096};
               pg8::gemm_phase<pg8::EpiResRms, pg8::StaticOrder, false, true>(lds3, g, S, E); }
    PSEAM(7, 3);
    PHASE(9) { pg8::Gemm g{AFFN, Wf1, M, FF, D}; pg8::StaticOrder S; S.init(M, FF, G, bid);
               pg8::EpiStore<2> E{HBUF, nullptr, nullptr, FF, -1};
               pg8::gemm_phase<pg8::EpiStore<2>, pg8::StaticOrder, true, true>(lds3, g, S, E); }
    PSEAM(9, 4);
    PHASE(10) { pg8::Gemm g{HBUF, Wf2, M, 1024, FF}; pg8::StaticOrder S; S.init(M, 1024, G, bid);
                pg8::EpiResRms E{out, nullptr, out, nullptr, g_final, (float*)(ws + WS_XCH + 262144), (unsigned*)ws + 4096 + 4096};
                pg8::gemm_phase<pg8::EpiResRms, pg8::StaticOrder, false, true>(lds3, g, S, E); }
}
constexpr int N_PHASES = 12;
extern "C" void kernel_launch(void* const* d_in, const int* in_sizes, int n_in, void* d_out, int out_size, void* d_ws, size_t ws_size, hipStream_t stream) {
    static int grid = 0;
    if (grid == 0) {
        int dev = 0, cus = 0, per_cu = 0;
        (void)hipGetDevice(&dev); (void)hipDeviceGetAttribute(&cus, hipDeviceAttributeMultiprocessorCount, dev);
        (void)hipFuncSetAttribute((const void*)mega, hipFuncAttributeMaxDynamicSharedMemorySize, LDS_BYTES);
        (void)hipOccupancyMaxActiveBlocksPerMultiprocessor(&per_cu, (const void*)mega, NTHREADS, LDS_BYTES);
        if (per_cu < 1) { fprintf(stderr, "occupancy query says %d blocks/CU\n", per_cu); per_cu = 1; }
        grid = cus * 1;
        (void)hipGetLastError();
    }
    (void)hipMemsetAsync(d_ws, 0, 65536, stream);
    Args a{};
    for (int i = 0; i < 18; ++i) a.in[i] = (const float*)d_in[i];
    a.out = (float*)d_out; a.ws = (unsigned char*)d_ws;
    a.ph_lo = 0; a.ph_hi = N_PHASES; void* args[] = {&a};
    hipError_t e = hipLaunchCooperativeKernel((const void*)mega, dim3(grid), dim3(NTHREADS), args, LDS_BYTES, stream);
    if (e != hipSuccess) {
        (void)hipGetLastError();
        hipLaunchKernelGGL(mega, dim3(grid), dim3(NTHREADS), LDS_BYTES, stream, a);
    }
}
```

```cpp
#include <hip/hip_runtime.h>
#include <hip/hip_cooperative_groups.h>
#include <cstdio>
namespace cg = cooperative_groups;
#include <stdint.h>

typedef unsigned short bf16_t;
__device__ __forceinline__ float bf2f(bf16_t v) { return __uint_as_float(((unsigned)v) << 16); }
__device__ __forceinline__ bf16_t f2bf(float f) { unsigned u = __float_as_uint(f); return (bf16_t)((u + 0x7fffu + ((u >> 16) & 1u)) >> 16); }

constexpr int NB = 4, T = 4096, M = NB * T, D = 1024, DIN = 6944, FF = 4096;
constexpr float EPS = 1e-6f;
constexpr int C_MLI = 2048, C_NSG = 3336, C_MG = 3872;
constexpr int P_MLQ = 0, P_MLK = 512, P_MLV = 1024, P_MLO = 1536, P_NSQ = 2048, P_KC = 2560, P_VC = 2688, P_KS = 2816, P_VS = 2944, P_KW = 3072, P_VW = 3200, P_XAQ = 3328, PW = 3840;
constexpr size_t MiB = 1u << 20;
constexpr size_t WS_U = 40 * MiB;
constexpr size_t WS_P = 72 * MiB;
constexpr size_t WS_Y = 200 * MiB;
constexpr size_t WS_S32 = 248 * MiB;
constexpr size_t WS_MEMKV = 250 * MiB;
constexpr size_t WS_KC = 252 * MiB;
constexpr size_t WS_VC = 252 * MiB + 512 * 1024;
constexpr size_t WS_NA = 253 * MiB;
constexpr size_t WS_G = 253 * MiB + 512 * 1024;
constexpr size_t WS_MLOC = 253 * MiB + 512 * 1024 + 4096;
constexpr size_t WS_MPREV = 253 * MiB + 512 * 1024 + 8192;

__device__ __forceinline__ float wave_sum(float v) {
#pragma unroll
    for (int o = 1; o < 64; o <<= 1) v += __shfl_xor(v, o);
    return v;
}
__device__ __forceinline__ float wave_max(float v) {
#pragma unroll
    for (int o = 1; o < 64; o <<= 1) v = fmaxf(v, __shfl_xor(v, o));
    return v;
}

__device__ __forceinline__ float logsig(float x) { return fminf(x, 0.f) - log1pf(__expf(-fabsf(x))); }
namespace pg8 {
#define PG8_LAS __attribute__((address_space(3)))
typedef unsigned short bf16_t;
typedef short bf16x8 __attribute__((ext_vector_type(8)));
typedef float f32x4 __attribute__((ext_vector_type(4)));
typedef unsigned u32x4 __attribute__((ext_vector_type(4)));
constexpr int BM = 256, BK = 64, HALF = 128, HTB = HALF * BK * 2  , STAGE_BYTES = 8 * HTB, NXCD = 8, WGM = 8;

__host__ __device__ __forceinline__ int lds_byte(int r, int c) { const int st = (r >> 4) * 2 + (c >> 5), rr = r & 15, cc = c & 31, ob = rr * 64 + cc * 2; return st * 1024 + (ob ^ (((ob >> 9) & 1) << 5)); }
__host__ __device__ __forceinline__ void stage_rc(int b, int& R, int& C) { const int st = b / 1024, sb = b % 1024, swz = sb ^ (((sb >> 9) & 1) << 5); R = (st >> 1) * 16 + swz / 64; C = (st & 1) * 32 + (swz % 64) / 2; }
__host__ __device__ __forceinline__ int perm32(int rho) { const int n = rho >> 4, i = rho & 15; return 8 * (i >> 2) + 4 * n + (i & 3); }

struct Unit { int pm, pn, j; };
struct Gemm { const bf16_t* A; const bf16_t* Bt; int M, N, K; };

struct StaticOrder {
    int nM, nN, nwg, G, c;
    __host__ __device__ void init(int M, int N, int G_, int c_) { nM = M / BM; nN = N / BM; nwg = nM * nN; G = G_; c = c_; }
    __host__ __device__ bool next(int i, Unit& u) const {
        const long L = (long)i * G + c; if (L >= nwg) return false;
        int wgid = (int)L; { const int q = nwg / NXCD, r = nwg % NXCD, xcd = wgid % NXCD, off = wgid / NXCD; wgid = (xcd < r ? xcd * (q + 1) : r * (q + 1) + (xcd - r) * q) + off; }
        const int nig = WGM * nN, gid = wgid / nig, fm = gid * WGM, gsz = (nM - fm) < WGM ? (nM - fm) : WGM;
        u.pm = fm + ((wgid % nig) % gsz); u.pn = (wgid % nig) / gsz; u.j = 0; return true;
    }
    __device__ __forceinline__ const char* pa(const Gemm& g, const Unit& u, size_t tstep) const { return (const char*)g.A + (size_t)u.pm * tstep; }
    __device__ __forceinline__ const char* pb(const Gemm& g, const Unit& u, size_t tstep) const { return (const char*)g.Bt + (size_t)u.pn * tstep; }
    __device__ __forceinline__ void a_ready(const Unit&) const {}
    __device__ __forceinline__ void done(const Unit&) const {}
};

struct MergeOrder {
    StaticOrder so; size_t sa, sb;
    __device__ __forceinline__ bool next(int i, Unit& u) const { if (i >= 3) return false; const bool ok = so.next(0, u); u.j = i; return ok; }
    __device__ __forceinline__ const char* pa(const Gemm& g, const Unit& u, size_t tstep) const { return (const char*)g.A + (size_t)u.j * sa + (size_t)u.pm * tstep; }
    __device__ __forceinline__ const char* pb(const Gemm& g, const Unit& u, size_t tstep) const { return (const char*)g.Bt + (size_t)u.j * sb + (size_t)u.pn * tstep; }
    __device__ __forceinline__ void a_ready(const Unit&) const {}
    __device__ __forceinline__ void done(const Unit&) const {}
};
typedef float f32x2_t __attribute__((ext_vector_type(2))); typedef __bf16 bf16x2_t __attribute__((ext_vector_type(2)));
__device__ __forceinline__ unsigned cvt_pk_bf16(float lo, float hi) { f32x2_t v = {lo, hi}; bf16x2_t b = __builtin_convertvector(v, bf16x2_t); return __builtin_bit_cast(unsigned, b); }
typedef float f32x2 __attribute__((ext_vector_type(2)));

typedef unsigned u32x2 __attribute__((ext_vector_type(2)));
__device__ __forceinline__ float bflo(unsigned w) { return __uint_as_float(w << 16); }
__device__ __forceinline__ float bfhi(unsigned w) { return __uint_as_float(w & 0xffff0000u); }
template <int ACT> __device__ __forceinline__ f32x4 act4(f32x4 v) {
    if (ACT == 1) { f32x4 o; for (int e = 0; e < 4; ++e) o[e] = __builtin_amdgcn_rcpf(1.f + __expf(-v[e])); return o; }
    if (ACT == 2) { f32x4 o; for (int e = 0; e < 4; ++e) { const float r = fmaxf(v[e], 0.f); o[e] = r * r; } return o; }
    return v;
}
template <int ACT> struct EpiStore {
    static constexpr bool PERM = true, AFTER_DRAIN = false;
    bf16_t* O; const float* bias; float* S32; int ldc, small_pn;
    __device__ __forceinline__ void operator()(const f32x4 (&acc)[2][2][4][2], const Unit& u, int wr, int wc, int fr, int fq) const {
        asm volatile("s_waitcnt vmcnt(0)" ::: "memory");
        const int row0 = u.pm * BM + wr * 64 + fr, col0 = u.pn * BM + wc * 32 + 8 * fq;
        if (u.pn == small_pn) {
            if (wc == 0) {
                const f32x4 b0 = *(const f32x4*)(bias + col0), b1 = *(const f32x4*)(bias + col0 + 4);
#pragma unroll
                for (int ai = 0; ai < 2; ++ai)
#pragma unroll
                    for (int m = 0; m < 4; ++m) { float* rp = S32 + (size_t)(row0 + ai * HALF + m * 16) * 32 + 8 * fq;
                        *(f32x4*)rp = acc[ai][0][m][0] + acc[ai][1][m][0] + b0; *(f32x4*)(rp + 4) = acc[ai][0][m][1] + acc[ai][1][m][1] + b1; }
            }
            return;
        }
        f32x4 bv[2][2];
#pragma unroll
        for (int bj = 0; bj < 2; ++bj)
#pragma unroll
            for (int n = 0; n < 2; ++n) bv[bj][n] = bias ? *(const f32x4*)(bias + col0 + bj * HALF + 4 * n) : (f32x4){0.f, 0.f, 0.f, 0.f};
#pragma unroll
        for (int ai = 0; ai < 2; ++ai)
#pragma unroll
            for (int m = 0; m < 4; ++m) { bf16_t* rowp = O + (size_t)(row0 + ai * HALF + m * 16) * ldc + col0;
#pragma unroll
                for (int bj = 0; bj < 2; ++bj) { const f32x4 v0 = act4<ACT>(acc[ai][bj][m][0] + bv[bj][0]), v1 = act4<ACT>(acc[ai][bj][m][1] + bv[bj][1]);
                    u32x4 w; w.x = cvt_pk_bf16(v0[0], v0[1]); w.y = cvt_pk_bf16(v0[2], v0[3]); w.z = cvt_pk_bf16(v1[0], v1[1]); w.w = cvt_pk_bf16(v1[2], v1[3]);
                    *(u32x4*)(rowp + bj * HALF) = w; } }
    }
};
struct EpiMergeG {
    static constexpr bool PERM = true, AFTER_DRAIN = false;
    const bf16_t* G; bf16_t* Mp; bf16_t* Mb;
    template <bool HASP>
    __device__ __forceinline__ void body(const f32x4 (&acc)[2][2][4][2], int j, bf16_t* dst, size_t dpitch, int row0, int col0) const {
        constexpr size_t mpitch = 2048;
#pragma unroll
        for (int ai = 0; ai < 2; ++ai) { u32x4 gw[4][2], pw[4][2];
#pragma unroll
            for (int m = 0; m < 4; ++m)
#pragma unroll
                for (int bj = 0; bj < 2; ++bj) { const size_t row = (size_t)(row0 + ai * HALF + m * 16); const int col = col0 + bj * HALF;
                    gw[m][bj] = *(const u32x4*)(G + row * 4096 + j * 1024 + col); if (HASP) pw[m][bj] = *(const u32x4*)(Mp + row * mpitch + col); }
#pragma unroll
            for (int m = 0; m < 4; ++m)
#pragma unroll
                for (int bj = 0; bj < 2; ++bj) { const size_t row = (size_t)(row0 + ai * HALF + m * 16); const int col = col0 + bj * HALF; const u32x4 g4 = gw[m][bj];
                    f32x4 v0 = (f32x4){bflo(g4.x), bfhi(g4.x), bflo(g4.y), bfhi(g4.y)} * acc[ai][bj][m][0], v1 = (f32x4){bflo(g4.z), bfhi(g4.z), bflo(g4.w), bfhi(g4.w)} * acc[ai][bj][m][1];
                    if (HASP) { const u32x4 p4 = pw[m][bj]; v0 += (f32x4){bflo(p4.x), bfhi(p4.x), bflo(p4.y), bfhi(p4.y)}; v1 += (f32x4){bflo(p4.z), bfhi(p4.z), bflo(p4.w), bfhi(p4.w)}; }
                    u32x4 w; w.x = cvt_pk_bf16(v0[0], v0[1]); w.y = cvt_pk_bf16(v0[2], v0[3]); w.z = cvt_pk_bf16(v1[0], v1[1]); w.w = cvt_pk_bf16(v1[2], v1[3]); *(u32x4*)(dst + row * dpitch + col) = w; } }
    }
    __device__ __forceinline__ void operator()(const f32x4 (&acc)[2][2][4][2], const Unit& u, int wr, int wc, int fr, int fq) const {
        const int j = u.j;
        asm volatile("s_waitcnt vmcnt(0)" ::: "memory");
        const int row0 = u.pm * BM + wr * 64 + fr, col0 = u.pn * BM + wc * 32 + 8 * fq;
        if (j == 0) body<false>(acc, 0, Mp, 2048, row0, col0);
        else if (j == 1) body<true>(acc, 1, Mp, 2048, row0, col0);
        else body<true>(acc, 2, Mb, 1024, row0, col0);
    }
};
struct EpiResidF {
    static constexpr bool PERM = true, AFTER_DRAIN = false;
    const float* X; float* O;
    __device__ __forceinline__ void operator()(const f32x4 (&acc)[2][2][4][2], const Unit& u, int wr, int wc, int fr, int fq) const {
        asm volatile("s_waitcnt vmcnt(0)" ::: "memory");
        const int row0 = u.pm * BM + wr * 64 + fr, col0 = u.pn * BM + wc * 32 + 8 * fq;
#pragma unroll
        for (int ai = 0; ai < 2; ++ai)
#pragma unroll
            for (int m = 0; m < 4; ++m) { const size_t off = (size_t)(row0 + ai * HALF + m * 16) * 1024 + col0;
#pragma unroll
                for (int bj = 0; bj < 2; ++bj) { const f32x4 x0 = *(const f32x4*)(X + off + bj * HALF), x1 = *(const f32x4*)(X + off + bj * HALF + 4);
                    *(f32x4*)(O + off + bj * HALF) = x0 + acc[ai][bj][m][0]; *(f32x4*)(O + off + bj * HALF + 4) = x1 + acc[ai][bj][m][1]; } }
    }
};
struct EpiResRms {
    static constexpr bool PERM = false, AFTER_DRAIN = true;
    const float* R; float* Hout; float* Nf; bf16_t* Nb; const float* gain; float* xbuf; unsigned* cnt;
    __device__ __forceinline__ void fused(f32x4 (&acc)[2][2][4][2], const Unit& u, int wr, int wc, int fr, int fq, PG8_LAS unsigned char* lds, int wid, int lane) const {
        PG8_LAS float* Pp = (PG8_LAS float*)lds; PG8_LAS float* S = (PG8_LAS float*)(lds + 4096);
        const int col0 = u.pn * BM + wc * 32 + 4 * fq;
#pragma unroll
        for (int ai = 0; ai < 2; ++ai) { f32x4 pre[4][2][2];
#pragma unroll
            for (int m = 0; m < 4; ++m) { const size_t off = (size_t)(u.pm * BM + ai * HALF + wr * 64 + m * 16 + fr) * 1024 + col0;
#pragma unroll
                for (int bj = 0; bj < 2; ++bj)
#pragma unroll
                    for (int n = 0; n < 2; ++n) pre[m][bj][n] = *(const f32x4*)(R + off + bj * HALF + n * 16); }
#pragma unroll
            for (int m = 0; m < 4; ++m) { float sq = 0.f;
#pragma unroll
                for (int bj = 0; bj < 2; ++bj)
#pragma unroll
                    for (int n = 0; n < 2; ++n) { const f32x4 v = acc[ai][bj][m][n] + pre[m][bj][n]; acc[ai][bj][m][n] = v; sq += (v[0] * v[0] + v[1] * v[1]) + (v[2] * v[2] + v[3] * v[3]); }
                sq += __shfl_xor(sq, 16); sq += __shfl_xor(sq, 32);
                if (fq == 0) Pp[(ai * HALF + wr * 64 + m * 16 + fr) * 4 + wc] = sq; } }
        asm volatile("s_waitcnt lgkmcnt(0)" ::: "memory"); __builtin_amdgcn_s_barrier(); asm volatile("" ::: "memory");
        const int row = wid * 32 + (lane & 31);
        if (lane < 32) { const float tot = (Pp[row * 4 + 0] + Pp[row * 4 + 1]) + (Pp[row * 4 + 2] + Pp[row * 4 + 3]);
            __hip_atomic_store(xbuf + ((size_t)(u.pm * BM + row) * 4 + u.pn), tot, __ATOMIC_RELAXED, __HIP_MEMORY_SCOPE_AGENT); }
        asm volatile("s_waitcnt vmcnt(0)" ::: "memory");
        if (lane == 0) __hip_atomic_fetch_add(cnt + 64 * u.pm, 1u, __ATOMIC_RELAXED, __HIP_MEMORY_SCOPE_AGENT);
        if (wid == 0) { unsigned sp = 0;
            while ((unsigned)__builtin_amdgcn_readfirstlane(__hip_atomic_load(cnt + 64 * u.pm, __ATOMIC_RELAXED, __HIP_MEMORY_SCOPE_AGENT)) < 32u) { __builtin_amdgcn_s_sleep(2); if (++sp > (1u << 22)) break; }
            __builtin_amdgcn_fence(__ATOMIC_ACQUIRE, "agent"); }
        asm volatile("s_waitcnt vmcnt(0) lgkmcnt(0)" ::: "memory"); __builtin_amdgcn_s_barrier(); asm volatile("" ::: "memory");
        if (lane < 32) { const float* slot = xbuf + (size_t)(u.pm * BM + row) * 4; float t = 0.f;
#pragma unroll
            for (int q = 0; q < 4; ++q) t += __hip_atomic_load(slot + q, __ATOMIC_RELAXED, __HIP_MEMORY_SCOPE_AGENT);
            S[row] = rsqrtf(t * (1.0f / 1024.0f) + 1e-6f); }
        asm volatile("s_waitcnt lgkmcnt(0)" ::: "memory"); __builtin_amdgcn_s_barrier(); asm volatile("" ::: "memory");
        f32x4 gv[2][2];
#pragma unroll
        for (int bj = 0; bj < 2; ++bj)
#pragma unroll
            for (int n = 0; n < 2; ++n) gv[bj][n] = *(const f32x4*)(gain + col0 + bj * HALF + n * 16);
#pragma unroll
        for (int ai = 0; ai < 2; ++ai)
#pragma unroll
            for (int m = 0; m < 4; ++m) { const int r = ai * HALF + wr * 64 + m * 16 + fr; const float rs = S[r]; const size_t off = (size_t)(u.pm * BM + r) * 1024 + col0;
#pragma unroll
                for (int bj = 0; bj < 2; ++bj)
#pragma unroll
                    for (int n = 0; n < 2; ++n) { const f32x4 v = acc[ai][bj][m][n]; const f32x4 o = v * rs * gv[bj][n];
                        if (Hout) *(f32x4*)(Hout + off + bj * HALF + n * 16) = v;
                        if (Nf) *(f32x4*)(Nf + off + bj * HALF + n * 16) = o;
                        if (Nb) { u32x2 w; w.x = cvt_pk_bf16(o[0], o[1]); w.y = cvt_pk_bf16(o[2], o[3]); *(u32x2*)(Nb + off + bj * HALF + n * 16) = w; } } }
    }
};

template <class Epi, class Sched, bool ALIGN_EPI = false, bool SP2 = false>
__device__ __forceinline__ void gemm_phase(PG8_LAS unsigned char* lds, const Gemm g, const Sched& S, const Epi& E) {
    const int tid = threadIdx.x, wid = __builtin_amdgcn_readfirstlane(tid >> 6), lane = tid & 63, wr = wid >> 2, wc = wid & 3, fr = lane & 15, fq = lane >> 4;
    const int K = g.K, nt = K / BK;
    unsigned voffA[2], voffB[2];
#pragma unroll
    for (int i = 0; i < 2; ++i) { int R, C; stage_rc(tid * 16 + i * 8192, R, C); const int Rb = Epi::PERM ? ((R & ~31) + perm32(R & 31)) : R;
        voffA[i] = (unsigned)(R * K + C) * 2u; voffB[i] = (unsigned)(Rb * K + C) * 2u; }
    const size_t kstep = (size_t)(BK * 2);
    const size_t hstep = (size_t)HALF * K * 2;
    const size_t tstep = 2 * hstep;
    const unsigned ldsw = (unsigned)wid * 1024u;
    const int aoff = lds_byte(wr * 64 + fr, fq * 8), boff = lds_byte(wc * 32 + fr, fq * 8);
#define PG8_SA(b, h) (((b) * 2 + (h)) * HTB)
#define PG8_SB(b, h) ((4 + (b) * 2 + (h)) * HTB)
#define PG8_STAGE(bufoff, gbase, voff) do { _Pragma("unroll") for (int _i = 0; _i < 2; ++_i) \
        __builtin_amdgcn_global_load_lds((const unsigned*)((const char*)(gbase) + (voff)[_i]), (PG8_LAS unsigned*)(lds + (bufoff) + ldsw + _i * 8192), 16, 0, 0); } while (0)
#define PG8_LDA(dst, b, h) do { _Pragma("unroll") for (int m = 0; m < 4; ++m) _Pragma("unroll") for (int k = 0; k < 2; ++k) dst[m][k] = *(const PG8_LAS bf16x8*)(lds + PG8_SA(b, h) + aoff + m * 2048 + k * 1024); } while (0)
#define PG8_LDB(dst, b, h) do { _Pragma("unroll") for (int n = 0; n < 2; ++n) _Pragma("unroll") for (int k = 0; k < 2; ++k) dst[n][k] = *(const PG8_LAS bf16x8*)(lds + PG8_SB(b, h) + boff + n * 2048 + k * 1024); } while (0)
#define PG8_MMA(ai, bj, At, Bt) do { __builtin_amdgcn_s_setprio(1); _Pragma("unroll") for (int m = 0; m < 4; ++m) _Pragma("unroll") for (int n = 0; n < 2; ++n) _Pragma("unroll") for (int k = 0; k < 2; ++k) \
        acc[ai][bj][m][n] = __builtin_amdgcn_mfma_f32_16x16x32_bf16(Bt[n][k], At[m][k], acc[ai][bj][m][n], 0, 0, 0); __builtin_amdgcn_s_setprio(0); } while (0)
#define PG8_WAIT_V(n) asm volatile("s_waitcnt vmcnt(" #n ")" ::: "memory")
#define PG8_WAIT_L(n) asm volatile("s_waitcnt lgkmcnt(" #n ")" ::: "memory")
#define PG8_BAR __builtin_amdgcn_s_barrier()
#define PG8_SCHED __builtin_amdgcn_sched_barrier(0)
    Unit cur, nxt; int ui = 0;
    if (!S.next(0, cur)) return;
    f32x4 acc[2][2][4][2];
#pragma unroll
    for (int a = 0; a < 2; ++a)
#pragma unroll
        for (int b = 0; b < 2; ++b)
#pragma unroll
            for (int m = 0; m < 4; ++m)
#pragma unroll
                for (int n = 0; n < 2; ++n) acc[a][b][m][n] = (f32x4){0.f, 0.f, 0.f, 0.f};
    bf16x8 At[4][2], B0[2][2], B1[2][2];
    const char* cA = S.pa(g, cur, tstep); const char* cB = S.pb(g, cur, tstep);
    S.a_ready(cur);
    if constexpr (SP2) {
        PG8_STAGE(PG8_SB(0, 0), cB, voffB); PG8_STAGE(PG8_SB(0, 1), cB + hstep, voffB); PG8_STAGE(PG8_SA(0, 0), cA, voffA); PG8_STAGE(PG8_SA(0, 1), cA + hstep, voffA);
        if (wr == 1) PG8_BAR;
        PG8_WAIT_V(2); PG8_BAR;
        PG8_STAGE(PG8_SB(1, 0), cB + kstep, voffB); PG8_STAGE(PG8_SA(1, 0), cA + kstep, voffA); PG8_STAGE(PG8_SB(1, 1), cB + hstep + kstep, voffB);
        PG8_WAIT_V(6); PG8_BAR;
    } else {
        PG8_STAGE(PG8_SB(0, 0), cB, voffB); PG8_STAGE(PG8_SA(0, 0), cA, voffA); PG8_STAGE(PG8_SB(0, 1), cB + hstep, voffB); PG8_STAGE(PG8_SA(0, 1), cA + hstep, voffA);
        if (wr == 1) PG8_BAR;
        PG8_WAIT_V(4); PG8_BAR;
        PG8_STAGE(PG8_SB(1, 0), cB + kstep, voffB); PG8_STAGE(PG8_SA(1, 0), cA + kstep, voffA); PG8_STAGE(PG8_SB(1, 1), cB + hstep + kstep, voffB);
        PG8_WAIT_V(6); PG8_BAR;
    }
    for (;;) {
        const bool has_next = S.next(ui + 1, nxt);
        const char* nA = has_next ? S.pa(g, nxt, tstep) : cA; const char* nB = has_next ? S.pb(g, nxt, tstep) : cB;
        for (int t = 0; t < nt; t += 2) {
            const bool last = (t == nt - 2);
            const char* a1 = cA + (size_t)(t + 1) * kstep;
            const char* a2 = last ? nA : cA + (size_t)(t + 2) * kstep; const char* b2 = last ? nB : cB + (size_t)(t + 2) * kstep;
            const char* a3 = a2 + kstep; const char* b3 = b2 + kstep;
            if (last && has_next) S.a_ready(nxt);
            if constexpr (SP2) {
            PG8_LDB(B0, 0, 0); PG8_LDB(B1, 0, 1); PG8_SCHED; PG8_LDA(At, 0, 0); PG8_STAGE(PG8_SA(1, 1), a1 + hstep, voffA);
            PG8_WAIT_V(8); PG8_WAIT_L(0); PG8_BAR; PG8_MMA(0, 0, At, B0); PG8_MMA(0, 1, At, B1); PG8_BAR; PG8_SCHED;
            PG8_LDA(At, 0, 1); PG8_STAGE(PG8_SB(0, 0), b2, voffB); PG8_STAGE(PG8_SB(0, 1), b2 + hstep, voffB); PG8_STAGE(PG8_SA(0, 0), a2, voffA);
            PG8_WAIT_V(8); PG8_WAIT_L(0); PG8_BAR; PG8_MMA(1, 0, At, B0); PG8_MMA(1, 1, At, B1); PG8_BAR; PG8_SCHED;
            PG8_LDB(B0, 1, 0); PG8_LDB(B1, 1, 1); PG8_SCHED; PG8_LDA(At, 1, 0); PG8_STAGE(PG8_SA(0, 1), a2 + hstep, voffA);
            PG8_WAIT_V(8); PG8_WAIT_L(0); PG8_BAR; PG8_MMA(0, 0, At, B0); PG8_MMA(0, 1, At, B1); PG8_BAR; PG8_SCHED;
            PG8_LDA(At, 1, 1); PG8_STAGE(PG8_SB(1, 0), b3, voffB); PG8_STAGE(PG8_SB(1, 1), b3 + hstep, voffB); PG8_STAGE(PG8_SA(1, 0), a3, voffA);
            PG8_WAIT_V(8); PG8_WAIT_L(0); PG8_BAR; PG8_MMA(1, 0, At, B0); PG8_MMA(1, 1, At, B1); PG8_BAR; PG8_SCHED;
            } else {
            PG8_LDB(B0, 0, 0); PG8_SCHED; PG8_LDA(At, 0, 0); PG8_STAGE(PG8_SA(1, 1), a1 + hstep, voffA);
            PG8_WAIT_L(8); PG8_BAR; PG8_WAIT_L(0); PG8_MMA(0, 0, At, B0); PG8_BAR; PG8_SCHED;
            PG8_LDB(B1, 0, 1); PG8_STAGE(PG8_SB(0, 0), b2, voffB);
            PG8_BAR; PG8_WAIT_L(0); PG8_MMA(0, 1, At, B1); PG8_BAR;
            PG8_LDA(At, 0, 1); PG8_STAGE(PG8_SA(0, 0), a2, voffA);
            PG8_BAR; PG8_WAIT_L(0); PG8_MMA(1, 0, At, B0); PG8_BAR; PG8_SCHED;
            PG8_STAGE(PG8_SB(0, 1), b2 + hstep, voffB);
            PG8_WAIT_V(6); PG8_BAR; PG8_MMA(1, 1, At, B1); PG8_BAR;
            PG8_LDB(B0, 1, 0); PG8_SCHED; PG8_LDA(At, 1, 0); PG8_STAGE(PG8_SA(0, 1), a2 + hstep, voffA);
            PG8_WAIT_L(8); PG8_BAR; PG8_WAIT_L(0); PG8_MMA(0, 0, At, B0); PG8_BAR; PG8_SCHED;
            PG8_LDB(B1, 1, 1); PG8_STAGE(PG8_SB(1, 0), b3, voffB);
            PG8_BAR; PG8_WAIT_L(0); PG8_MMA(0, 1, At, B1); PG8_BAR;
            PG8_LDA(At, 1, 1); PG8_STAGE(PG8_SA(1, 0), a3, voffA);
            PG8_BAR; PG8_WAIT_L(0); PG8_MMA(1, 0, At, B0); PG8_BAR; PG8_SCHED;
            PG8_STAGE(PG8_SB(1, 1), b3 + hstep, voffB);
            PG8_WAIT_V(6); PG8_BAR; PG8_MMA(1, 1, At, B1); PG8_BAR;
            }
        }
        if constexpr (ALIGN_EPI) { if (wr == 0) PG8_BAR; }
        if constexpr (!Epi::AFTER_DRAIN) { E(acc, cur, wr, wc, fr, fq); S.done(cur); }
        if (!has_next) break;
#pragma unroll
        for (int a = 0; a < 2; ++a)
#pragma unroll
            for (int b = 0; b < 2; ++b)
#pragma unroll
                for (int m = 0; m < 4; ++m)
#pragma unroll
                    for (int n = 0; n < 2; ++n) acc[a][b][m][n] = (f32x4){0.f, 0.f, 0.f, 0.f};
        cur = nxt; cA = nA; cB = nB; ++ui;
        if constexpr (ALIGN_EPI) { if (wr == 1) PG8_BAR; }
    }
    PG8_WAIT_V(0);
    if constexpr (!ALIGN_EPI) { if (wr == 0) PG8_BAR; }
    PG8_BAR;
    if constexpr (Epi::AFTER_DRAIN) { E.fused(acc, cur, wr, wc, fr, fq, lds, wid, lane); S.done(cur); }
#undef PG8_SA
#undef PG8_SB
#undef PG8_STAGE
#undef PG8_LDA
#undef PG8_LDB
#undef PG8_MMA
#undef PG8_WAIT_V
#undef PG8_WAIT_L
#undef PG8_BAR
#undef PG8_SCHED
}
}

namespace nsa {
#define NLAS __attribute__((address_space(3)))
typedef short bf16x8 __attribute__((ext_vector_type(8)));
typedef short s16x4 __attribute__((ext_vector_type(4)));
typedef short v4i16_t __attribute__((ext_vector_type(4)));
typedef float f32x4 __attribute__((ext_vector_type(4)));
typedef unsigned u32x4 __attribute__((ext_vector_type(4)));
typedef unsigned u32x2 __attribute__((ext_vector_type(2)));
typedef unsigned long long u64;
constexpr int RS = 144, TILE_B = 64 * RS;
constexpr float LOG2E = 1.4426950408889634f;
constexpr int L_KB0 = 0, L_VB0 = TILE_B, L_KB1 = 2 * TILE_B, L_VB1 = 3 * TILE_B, L_CK = 4 * TILE_B, L_CV = 8 * TILE_B, L_IMP = 12 * TILE_B, L_MSK = L_IMP + 8192, L_WU = L_MSK + 256, L_END = L_WU + 64;
static_assert(L_END <= 131072, "nsa LDS map");
__device__ __forceinline__ s16x4 vtr(const NLAS char* p) { return __builtin_bit_cast(s16x4, __builtin_amdgcn_ds_read_tr16_b64_v4i16((NLAS v4i16_t*)p)); }
__device__ __forceinline__ f32x4 mfma16(bf16x8 a, bf16x8 b, f32x4 c) { return __builtin_amdgcn_mfma_f32_16x16x32_bf16(a, b, c, 0, 0, 0); }
__device__ __forceinline__ unsigned pkbf(float lo, float hi) { return pg8::cvt_pk_bf16(lo, hi); }
__device__ __forceinline__ void qk_tile(f32x4 (&s)[4], const NLAS char* Kb, const bf16x8 (&qf)[2], int i, int g, float kslope, float bt) {
    bf16x8 a[4][2]; const NLAS char* kp = Kb + i * RS + 16 * g;
#pragma unroll
    for (int kb = 0; kb < 4; ++kb) { a[kb][0] = *(const NLAS bf16x8*)(kp + kb * 16 * RS); a[kb][1] = *(const NLAS bf16x8*)(kp + kb * 16 * RS + 64); }
#pragma unroll
    for (int kb = 0; kb < 4; ++kb) { f32x4 ci; ci[0] = fmaf(kslope, (float)(kb * 16 + 0), bt); ci[1] = fmaf(kslope, (float)(kb * 16 + 1), bt); ci[2] = fmaf(kslope, (float)(kb * 16 + 2), bt); ci[3] = fmaf(kslope, (float)(kb * 16 + 3), bt);
        s[kb] = mfma16(a[kb][0], qf[0], ci); }
#pragma unroll
    for (int kb = 0; kb < 4; ++kb) s[kb] = mfma16(a[kb][1], qf[1], s[kb]);
}
__device__ __forceinline__ void pv_tile(f32x4 (&o)[4], const NLAS char* Vb, const f32x4 (&p)[4], int i, int g) {
    const NLAS char* vb = Vb + (4 * g + (i >> 2)) * RS + (i & 3) * 8;
    s16x4 lo[2][4], hi[2][4];
#pragma unroll
    for (int kk = 0; kk < 2; ++kk)
#pragma unroll
        for (int db = 0; db < 4; ++db) { const NLAS char* vp = vb + (2 * kk) * 16 * RS + db * 32; lo[kk][db] = vtr(vp); hi[kk][db] = vtr(vp + 16 * RS); }
    bf16x8 pf[2];
#pragma unroll
    for (int kk = 0; kk < 2; ++kk) { u32x4 pw; pw.x = pkbf(p[2 * kk][0], p[2 * kk][1]); pw.y = pkbf(p[2 * kk][2], p[2 * kk][3]); pw.z = pkbf(p[2 * kk + 1][0], p[2 * kk + 1][1]); pw.w = pkbf(p[2 * kk + 1][2], p[2 * kk + 1][3]);
        pf[kk] = __builtin_bit_cast(bf16x8, pw); }
#pragma unroll
    for (int kk = 0; kk < 2; ++kk)
#pragma unroll
        for (int db = 0; db < 4; ++db) o[db] = mfma16((bf16x8){lo[kk][db][0], lo[kk][db][1], lo[kk][db][2], lo[kk][db][3], hi[kk][db][0], hi[kk][db][1], hi[kk][db][2], hi[kk][db][3]}, pf[kk], o[db]);
}
constexpr float THR = 6.0f;
template <bool FIRST>
__device__ __forceinline__ float online_tile(f32x4 (&s)[4], float& m, float& l, f32x4 (&o)[4], bool needmask, int base, int lo, int hi) {
    float fret = 1.f;
    if (needmask) {
#pragma unroll
        for (int kb = 0; kb < 4; ++kb)
#pragma unroll
            for (int r = 0; r < 4; ++r) { const int pos = base + kb * 16 + r; s[kb][r] = (pos >= lo && pos <= hi) ? s[kb][r] : -INFINITY; } }
    float mt = fmaxf(fmaxf(fmaxf(s[0][0], s[0][1]), fmaxf(s[0][2], s[0][3])), fmaxf(fmaxf(s[1][0], s[1][1]), fmaxf(s[1][2], s[1][3])));
    mt = fmaxf(mt, fmaxf(fmaxf(fmaxf(s[2][0], s[2][1]), fmaxf(s[2][2], s[2][3])), fmaxf(fmaxf(s[3][0], s[3][1]), fmaxf(s[3][2], s[3][3]))));
    if (FIRST || __any(mt > THR)) {
        mt = fmaxf(mt, __shfl_xor(mt, 16)); mt = fmaxf(mt, __shfl_xor(mt, 32));
        const float d = FIRST ? ((mt == -INFINITY) ? 0.f : mt) : fmaxf(mt, 0.f), f = __builtin_amdgcn_exp2f(-d); m += d; l *= f; fret = f;
#pragma unroll
        for (int db = 0; db < 4; ++db) o[db] = o[db] * f;
#pragma unroll
        for (int kb = 0; kb < 4; ++kb) s[kb] = s[kb] - d; }
    float sum = 0.f;
#pragma unroll
    for (int kb = 0; kb < 4; ++kb)
#pragma unroll
        for (int r = 0; r < 4; ++r) { const float p = __builtin_amdgcn_exp2f(s[kb][r]); s[kb][r] = p; sum += p; }
    l += sum;
    return fret;
}
struct Stg { u32x4 k, v; };
__device__ __forceinline__ void stg_load(Stg& r, const bf16_t* kb, const bf16_t* vb, size_t pitch, int tid) { const size_t off = (size_t)(tid >> 3) * pitch + (tid & 7) * 8; r.k = *(const u32x4*)(kb + off); r.v = *(const u32x4*)(vb + off); }
__device__ __forceinline__ void stg_store(NLAS char* lds, int ko, int vo, const Stg& r, int tid) { const int off = (tid >> 3) * RS + (tid & 7) * 16; *(NLAS u32x4*)(lds + ko + off) = r.k; *(NLAS u32x4*)(lds + vo + off) = r.v; }
template <bool FIRST>
__device__ __forceinline__ void pair_tiles(const NLAS char* lds, int koA, int voA, int koB, int voB, bool na, bool nb, const bf16x8 (&qf)[2], int i, int g, float slope2,
                                           float btA, float btB, bool maskA, bool maskB, int baseA, int baseB, int lo, int hi, float& m, float& l, f32x4 (&o)[4]) {
    f32x4 sa[4], sb[4];
    if (na) qk_tile(sa, lds + koA, qf, i, g, slope2, btA - m);
    if (nb) qk_tile(sb, lds + koB, qf, i, g, slope2, btB - m);
    float da = 0.f;
    if (na) { const float m0 = m; online_tile<FIRST>(sa, m, l, o, FIRST || maskA, baseA, lo, hi); da = m - m0; pv_tile(o, lds + voA, sa, i, g); }
    if (nb) { if (__any(da != 0.f)) {
#pragma unroll
            for (int kb = 0; kb < 4; ++kb) sb[kb] = sb[kb] - da; }
        online_tile<false>(sb, m, l, o, maskB, baseB, lo, hi); pv_tile(o, lds + voB, sb, i, g); }
}
__device__ __forceinline__ float sigm(float v) { return __builtin_amdgcn_rcpf(1.f + __expf(-v)); }

__device__ __forceinline__ void unit(NLAS char* lds, const bf16_t* P, const float* S32, const bf16_t* KC, const bf16_t* VC, bf16_t* Ynsa, int b, int gq, int ti) {
    const int tid = threadIdx.x, lane = tid & 63, w = __builtin_amdgcn_readfirstlane(tid >> 6), i = lane & 15, g = lane >> 4;
    const int t0 = ti * 32, tl_mine = i >> 2, r = i & 3, h = gq * 4 + r, t = t0 + 4 * w + tl_mine; const size_t m = (size_t)b * T + t;
    const float slope2 = __builtin_amdgcn_exp2f(-(float)(h + 1)) * LOG2E;
    bf16x8 qf[2]; constexpr float QS = 0.125f * LOG2E;
    { const bf16_t* qp = P + m * PW + P_NSQ + h * 64 + 8 * g;
#pragma unroll
      for (int ks = 0; ks < 2; ++ks) { const u32x4 raw = *(const u32x4*)(qp + 32 * ks); u32x4 sc;
          sc.x = pkbf(pg8::bflo(raw.x) * QS, pg8::bfhi(raw.x) * QS); sc.y = pkbf(pg8::bflo(raw.y) * QS, pg8::bfhi(raw.y) * QS);
          sc.z = pkbf(pg8::bflo(raw.z) * QS, pg8::bfhi(raw.z) * QS); sc.w = pkbf(pg8::bflo(raw.w) * QS, pg8::bfhi(raw.w) * QS);
          qf[ks] = __builtin_bit_cast(bf16x8, sc); } }
    const float* gp = S32 + m * 32 + 8 + h * 3;
    const float gate0 = sigm(gp[0]), gate1 = sigm(gp[1]), gate2 = sigm(gp[2]);
    f32x4 outacc[4];
#pragma unroll
    for (int db = 0; db < 4; ++db) outacc[db] = (f32x4){0.f, 0.f, 0.f, 0.f};
    const int ntc = (ti >> 5) + 1;
    { Stg sc_[4];
#pragma unroll
      for (int tile = 0; tile < 4; ++tile) if (tile < ntc) { const size_t row0 = ((size_t)(b * 256 + tile * 64) * 2 + gq) * 64; stg_load(sc_[tile], KC + row0, VC + row0, 128, tid); }
#pragma unroll
      for (int tile = 0; tile < 4; ++tile) if (tile < ntc) stg_store(lds, L_CK + tile * TILE_B, L_CV + tile * TILE_B, sc_[tile], tid); }
    __syncthreads();
    { const int nmax = (t - 31) >> 4, nmax_w = ((t0 + 4 * w) - 31) >> 4; const float kslope = 16.f * slope2, c = -slope2 * (float)(t - 31);
      float mc = 0.f, lc = 0.f; f32x4 oc[4]; float av[16], cv[16];
#pragma unroll
      for (int db = 0; db < 4; ++db) oc[db] = (f32x4){0.f, 0.f, 0.f, 0.f};
#pragma unroll
      for (int q = 0; q < 16; ++q) { av[q] = 0.f; cv[q] = 0.f; }
      bool firstc = true;
#pragma unroll
      for (int tile = 3; tile >= 0; --tile) {
          if (tile < ntc) { f32x4 s[4]; qk_tile(s, lds + L_CK + tile * TILE_B, qf, i, g, kslope, fmaf(kslope, (float)(tile * 64 + 4 * g), c) - mc);
              const bool needmask = (tile * 64 + 63 > nmax_w);
              const float f = firstc ? online_tile<true>(s, mc, lc, oc, needmask, tile * 64 + 4 * g, -0x40000000, nmax) : online_tile<false>(s, mc, lc, oc, needmask, tile * 64 + 4 * g, -0x40000000, nmax);
              if (!firstc && __any(f != 1.f)) {
#pragma unroll
                  for (int q = 0; q < 16; ++q) { av[q] *= f; cv[q] *= f; } }
              firstc = false;
              pv_tile(oc, lds + L_CV + tile * TILE_B, s, i, g);
#pragma unroll
              for (int kb = 0; kb < 4; ++kb) { const f32x4 pv = s[kb];
                  float a = (pv[0] + pv[1]) + (pv[2] + pv[3]), cc = pv[3];
                  a += __shfl_xor(a, 1); a += __shfl_xor(a, 2); cc += __shfl_xor(cc, 1); cc += __shfl_xor(cc, 2);
                  av[tile * 4 + kb] = a; cv[tile * 4 + kb] = cc; } }
      }
      lc += __shfl_xor(lc, 16); lc += __shfl_xor(lc, 32);
      const float inv = lc > 0.f ? 1.f / lc : 0.f, g0i = gate0 * inv;
#pragma unroll
      for (int db = 0; db < 4; ++db) outacc[db] = outacc[db] + oc[db] * g0i;
      NLAS float* imp_s = (NLAS float*)(lds + L_IMP) + (w * 4 + tl_mine) * 64;
      float cprev = 0.f;
#pragma unroll
      for (int q = 0; q < 16; ++q) { const float up = __shfl(cv[q], (lane + 48) & 63); const float im = (av[q] + (g > 0 ? up : cprev)) * inv; cprev = up; if (r == 0) imp_s[4 * q + g] = im; }
    }
    NLAS float* impw = (NLAS float*)(lds + L_IMP) + w * 256;
    float myscore[4];
    asm volatile("s_waitcnt lgkmcnt(0)" ::: "memory");
#pragma unroll
    for (int tl = 0; tl < 4; ++tl) { const int tt = t0 + 4 * w + tl, cur = tt >> 6, j = lane; const bool valid = j <= cur, forced = (j == 0) || (j == cur) || (j == cur - 1);
        const float s = valid ? impw[tl * 64 + j] + (forced ? 1000.f : 0.f) : -1e30f; myscore[tl] = s; }
    u64 wmask[4], wun = 0ull;
#pragma unroll
    for (int tl = 0; tl < 4; ++tl) { const int tt = t0 + 4 * w + tl, cur = tt >> 6; const bool valid = lane <= cur;
        const unsigned key = valid ? ((__builtin_bit_cast(unsigned, myscore[tl]) & ~63u) | (unsigned)(63 - lane)) : 0u; unsigned rank = 0;
#pragma unroll
        for (int jj = 0; jj < 64; ++jj) { const unsigned o = (unsigned)__builtin_amdgcn_readlane((int)key, jj); rank += (o > key) ? 1u : 0u; }
        wmask[tl] = __ballot(rank < 16u && valid); wun |= wmask[tl]; }
    if (lane == 0) { NLAS u64* mk = (NLAS u64*)(lds + L_MSK) + w * 4; mk[0] = wmask[0]; mk[1] = wmask[1]; mk[2] = wmask[2]; mk[3] = wmask[3]; ((NLAS u64*)(lds + L_WU))[w] = wun; }
    __syncthreads();
    const u64 mymask = ((const NLAS u64*)(lds + L_MSK))[w * 4 + tl_mine];
    u64 uall = 0ull;
#pragma unroll
    for (int ww = 0; ww < 8; ++ww) uall |= ((const NLAS u64*)(lds + L_WU))[ww];
    uall = ((u64)__builtin_amdgcn_readfirstlane((unsigned)(uall >> 32)) << 32) | (u64)__builtin_amdgcn_readfirstlane((unsigned)uall);
    const size_t rowb = (size_t)b * T;
    {
        float ms_ = 0.f, ls = 0.f; f32x4 os[4];
#pragma unroll
        for (int db = 0; db < 4; ++db) os[db] = (f32x4){0.f, 0.f, 0.f, 0.f};
        const bf16_t* kcol = P + rowb * PW + P_KS + gq * 64; const bf16_t* vcol = P + rowb * PW + P_VS + gq * 64;
        const float c = -slope2 * (float)t;
        const int jcur = t0 >> 6;
        u64 rem = uall & ((1ull << jcur) - 1ull);
#define NSA_NEXT(dst) { dst = rem ? 63 - __builtin_clzll(rem) : -1; if (dst >= 0) rem &= ~(1ull << dst); }
#define NSA_KO(p, h) ((p) ? L_CK + (h) * TILE_B : ((h) ? L_KB1 : L_KB0))
#define NSA_VO(p, h) ((p) ? L_CV + (h) * TILE_B : ((h) ? L_VB1 : L_VB0))
        int ja = jcur, jb, na_, nb_, cur = 0; bool first = true;
        NSA_NEXT(jb)
        Stg sr0, sr1;
        stg_load(sr0, kcol + (size_t)ja * 64 * PW, vcol + (size_t)ja * 64 * PW, PW, tid); stg_store(lds, L_KB0, L_VB0, sr0, tid);
        if (jb >= 0) { stg_load(sr1, kcol + (size_t)jb * 64 * PW, vcol + (size_t)jb * 64 * PW, PW, tid); stg_store(lds, L_KB1, L_VB1, sr1, tid); }
        NSA_NEXT(na_) NSA_NEXT(nb_)
        if (na_ >= 0) stg_load(sr0, kcol + (size_t)na_ * 64 * PW, vcol + (size_t)na_ * 64 * PW, PW, tid);
        if (nb_ >= 0) stg_load(sr1, kcol + (size_t)nb_ * 64 * PW, vcol + (size_t)nb_ * 64 * PW, PW, tid);
        __syncthreads();
        for (;;) {
            if (na_ >= 0) stg_store(lds, NSA_KO(cur ^ 1, 0), NSA_VO(cur ^ 1, 0), sr0, tid);
            if (nb_ >= 0) stg_store(lds, NSA_KO(cur ^ 1, 1), NSA_VO(cur ^ 1, 1), sr1, tid);
            int nna, nnb; NSA_NEXT(nna) NSA_NEXT(nnb)
            if (nna >= 0) stg_load(sr0, kcol + (size_t)nna * 64 * PW, vcol + (size_t)nna * 64 * PW, PW, tid);
            if (nnb >= 0) stg_load(sr1, kcol + (size_t)nnb * 64 * PW, vcol + (size_t)nnb * 64 * PW, PW, tid);
            const bool na = (wun >> ja) & 1ull, nb = (jb >= 0) && ((wun >> jb) & 1ull);
            if (na || nb) {
                const float btA = fmaf(slope2, (float)(ja * 64 + 4 * g), c) + (((mymask >> ja) & 1ull) ? 0.f : -1e30f);
                const float btB = fmaf(slope2, (float)((jb < 0 ? 0 : jb) * 64 + 4 * g), c) + ((jb >= 0 && ((mymask >> jb) & 1ull)) ? 0.f : -1e30f);
                if (first) pair_tiles<true>(lds, NSA_KO(cur, 0), NSA_VO(cur, 0), NSA_KO(cur, 1), NSA_VO(cur, 1), na, nb, qf, i, g, slope2, btA, btB, true, false, ja * 64 + 4 * g, 0, 0, t, ms_, ls, os);
                else pair_tiles<false>(lds, NSA_KO(cur, 0), NSA_VO(cur, 0), NSA_KO(cur, 1), NSA_VO(cur, 1), na, nb, qf, i, g, slope2, btA, btB, false, false, 0, 0, 0, t, ms_, ls, os); }
            first = false;
            __syncthreads();
            if (na_ < 0) break;
            ja = na_; jb = nb_; na_ = nna; nb_ = nnb; cur ^= 1;
        }
        ls += __shfl_xor(ls, 16); ls += __shfl_xor(ls, 32);
        const float sc1 = gate1 / ls;
#pragma unroll
        for (int db = 0; db < 4; ++db) outacc[db] = outacc[db] + os[db] * sc1;
    }
    {
        float mw = 0.f, lw = 0.f; f32x4 ow[4];
#pragma unroll
        for (int db = 0; db < 4; ++db) ow[db] = (f32x4){0.f, 0.f, 0.f, 0.f};
        const bf16_t* kcol = P + rowb * PW + P_KW + gq * 64; const bf16_t* vcol = P + rowb * PW + P_VW + gq * 64;
        const float c = -slope2 * (float)t;
        const int j0 = (t0 - 511) > 0 ? ((t0 - 511) >> 6) : 0, j1 = t0 >> 6, tw0 = t0 + 4 * w;
        int ja = j1, cur = 0; bool first = true;
        Stg sr0, sr1;
        stg_load(sr0, kcol + (size_t)ja * 64 * PW, vcol + (size_t)ja * 64 * PW, PW, tid); stg_store(lds, L_KB0, L_VB0, sr0, tid);
        if (ja - 1 >= j0) { stg_load(sr1, kcol + (size_t)(ja - 1) * 64 * PW, vcol + (size_t)(ja - 1) * 64 * PW, PW, tid); stg_store(lds, L_KB1, L_VB1, sr1, tid); }
        if (ja - 2 >= j0) stg_load(sr0, kcol + (size_t)(ja - 2) * 64 * PW, vcol + (size_t)(ja - 2) * 64 * PW, PW, tid);
        if (ja - 3 >= j0) stg_load(sr1, kcol + (size_t)(ja - 3) * 64 * PW, vcol + (size_t)(ja - 3) * 64 * PW, PW, tid);
        __syncthreads();
        for (;;) {
            if (ja - 2 >= j0) stg_store(lds, NSA_KO(cur ^ 1, 0), NSA_VO(cur ^ 1, 0), sr0, tid);
            if (ja - 3 >= j0) stg_store(lds, NSA_KO(cur ^ 1, 1), NSA_VO(cur ^ 1, 1), sr1, tid);
            if (ja - 4 >= j0) stg_load(sr0, kcol + (size_t)(ja - 4) * 64 * PW, vcol + (size_t)(ja - 4) * 64 * PW, PW, tid);
            if (ja - 5 >= j0) stg_load(sr1, kcol + (size_t)(ja - 5) * 64 * PW, vcol + (size_t)(ja - 5) * 64 * PW, PW, tid);
            const int jb = ja - 1;
            const bool na = (64 * ja <= tw0 + 3) && (64 * ja + 63 >= tw0 - 511), nb = (jb >= j0) && (64 * jb <= tw0 + 3) && (64 * jb + 63 >= tw0 - 511);
            if (na || nb) {
                const float btA = fmaf(slope2, (float)(ja * 64 + 4 * g), c), btB = fmaf(slope2, (float)(jb * 64 + 4 * g), c);
                const bool maskA = (64 * ja < tw0 + 3 - 511), maskB = (64 * jb < tw0 + 3 - 511);
                if (first) pair_tiles<true>(lds, NSA_KO(cur, 0), NSA_VO(cur, 0), NSA_KO(cur, 1), NSA_VO(cur, 1), na, nb, qf, i, g, slope2, btA, btB, true, maskB, ja * 64 + 4 * g, jb * 64 + 4 * g, t - 511, t, mw, lw, ow);
                else pair_tiles<false>(lds, NSA_KO(cur, 0), NSA_VO(cur, 0), NSA_KO(cur, 1), NSA_VO(cur, 1), na, nb, qf, i, g, slope2, btA, btB, maskA, maskB, ja * 64 + 4 * g, jb * 64 + 4 * g, t - 511, t, mw, lw, ow); }
            first = false;
            __syncthreads();
            if (ja - 2 < j0) break;
            ja -= 2; cur ^= 1;
        }
        lw += __shfl_xor(lw, 16); lw += __shfl_xor(lw, 32);
        const float sc2 = gate2 / lw;
#pragma unroll
        for (int db = 0; db < 4; ++db) outacc[db] = outacc[db] + ow[db] * sc2;
    }
    bf16_t* yo = Ynsa + m * 512 + h * 64 + 4 * g;
#pragma unroll
    for (int db = 0; db < 4; ++db) { u32x2 v; v.x = pkbf(outacc[db][0], outacc[db][1]); v.y = pkbf(outacc[db][2], outacc[db][3]); *(u32x2*)(yo + db * 16) = v; }
}
__device__ __forceinline__ void phase(NLAS char* lds, const bf16_t* P, const float* S32, const bf16_t* KC, const bf16_t* VC, bf16_t* Ynsa) {
    const int G = gridDim.x, bid = blockIdx.x;
    if (G == 256) { const int base = bid >> 3, bg = bid & 7;
#pragma unroll 1
        for (int k = 0; k < 4; ++k) { const int ti = (k == 0) ? 127 - base : (k == 1) ? 64 + base : (k == 2) ? 63 - base : base; unit(lds, P, S32, KC, VC, Ynsa, bg >> 1, bg & 1, ti); } }
    else {
#pragma unroll 1
        for (int u = bid; u < 1024; u += G) unit(lds, P, S32, KC, VC, Ynsa, (u & 7) >> 1, u & 1, 127 - (u >> 3)); }
}
}

namespace xa {
using nsa::bf16x8; using nsa::s16x4; using nsa::f32x4; using nsa::u32x4; using nsa::u32x2; using nsa::vtr; using nsa::mfma16; using nsa::pkbf;
constexpr int RS = 272, TILE_B = 64 * RS;
__device__ __forceinline__ int l_k(int tile) { return tile * 2 * TILE_B; }
__device__ __forceinline__ int l_v(int tile) { return tile * 2 * TILE_B + TILE_B; }
__device__ __forceinline__ void unit(NLAS char* lds, const bf16_t* P, const bf16_t* MEMKV, bf16_t* Yxa, int b, int h, int tt) {
    const int tid = threadIdx.x, lane = tid & 63, w = __builtin_amdgcn_readfirstlane(tid >> 6), i = lane & 15, g = lane >> 4;
    const size_t m = (size_t)b * T + tt * 128 + 16 * w + i;
    const bf16_t* kbase = MEMKV + (size_t)b * 256 * 1024 + h * 128;
    { u32x4 st[4][4]; const bf16_t* p0 = kbase + (size_t)(tid >> 3) * 1024 + (tid & 7) * 8;
#pragma unroll
      for (int tile = 0; tile < 4; ++tile) { const bf16_t* p = p0 + (size_t)tile * 64 * 1024; st[tile][0] = *(const u32x4*)p; st[tile][1] = *(const u32x4*)(p + 64); st[tile][2] = *(const u32x4*)(p + 512); st[tile][3] = *(const u32x4*)(p + 576); }
      const int off = (tid >> 3) * RS + (tid & 7) * 16;
#pragma unroll
      for (int tile = 0; tile < 4; ++tile) { *(NLAS u32x4*)(lds + l_k(tile) + off) = st[tile][0]; *(NLAS u32x4*)(lds + l_k(tile) + off + 128) = st[tile][1]; *(NLAS u32x4*)(lds + l_v(tile) + off) = st[tile][2]; *(NLAS u32x4*)(lds + l_v(tile) + off + 128) = st[tile][3]; } }
    bf16x8 qf[4];
    { const bf16_t* qp = P + m * PW + P_XAQ + h * 128 + 8 * g;
#pragma unroll
      for (int ks = 0; ks < 4; ++ks) qf[ks] = *(const bf16x8*)(qp + 32 * ks); }
    const float scale2 = 0.08838834764831845f * nsa::LOG2E;
    float mx = -INFINITY, l = 0.f; f32x4 o[8];
#pragma unroll
    for (int db = 0; db < 8; ++db) o[db] = (f32x4){0.f, 0.f, 0.f, 0.f};
    __syncthreads();
#pragma unroll 1
    for (int tile = 0; tile < 4; ++tile) {
        const NLAS char* Kb = lds + l_k(tile); const NLAS char* Vb = lds + l_v(tile);
        f32x4 s[4];
        { bf16x8 a[4][4];
#pragma unroll
          for (int kb = 0; kb < 4; ++kb)
#pragma unroll
              for (int ks = 0; ks < 4; ++ks) a[kb][ks] = *(const NLAS bf16x8*)(Kb + (kb * 16 + i) * RS + 16 * g + 64 * ks);
#pragma unroll
          for (int kb = 0; kb < 4; ++kb) s[kb] = mfma16(a[kb][0], qf[0], (f32x4){0.f, 0.f, 0.f, 0.f});
#pragma unroll
          for (int ks = 1; ks < 4; ++ks)
#pragma unroll
              for (int kb = 0; kb < 4; ++kb) s[kb] = mfma16(a[kb][ks], qf[ks], s[kb]); }
        float mt = -INFINITY;
#pragma unroll
        for (int kb = 0; kb < 4; ++kb)
#pragma unroll
            for (int r = 0; r < 4; ++r) { const float v = s[kb][r] * scale2; s[kb][r] = v; mt = fmaxf(mt, v); }
        mt = fmaxf(mt, __shfl_xor(mt, 16)); mt = fmaxf(mt, __shfl_xor(mt, 32));
        const float mn = fmaxf(mx, mt), alpha = __builtin_amdgcn_exp2f(mx - mn); float sum = 0.f;
#pragma unroll
        for (int kb = 0; kb < 4; ++kb)
#pragma unroll
            for (int r = 0; r < 4; ++r) { const float p = __builtin_amdgcn_exp2f(s[kb][r] - mn); s[kb][r] = p; sum += p; }
        l = l * alpha + sum; mx = mn;
#pragma unroll
        for (int db = 0; db < 8; ++db) o[db] = o[db] * alpha;
        const NLAS char* vb = Vb + (4 * g + (i >> 2)) * RS + (i & 3) * 8;
#pragma unroll
        for (int kk = 0; kk < 2; ++kk) {
            u32x4 pw; pw.x = pkbf(s[2 * kk][0], s[2 * kk][1]); pw.y = pkbf(s[2 * kk][2], s[2 * kk][3]); pw.z = pkbf(s[2 * kk + 1][0], s[2 * kk + 1][1]); pw.w = pkbf(s[2 * kk + 1][2], s[2 * kk + 1][3]);
            const bf16x8 pf = __builtin_bit_cast(bf16x8, pw);
            s16x4 lo[8], hi[8];
#pragma unroll
            for (int db = 0; db < 8; ++db) { const NLAS char* vp = vb + (2 * kk) * 16 * RS + db * 32; lo[db] = vtr(vp); hi[db] = vtr(vp + 16 * RS); }
#pragma unroll
            for (int db = 0; db < 8; ++db) o[db] = mfma16((bf16x8){lo[db][0], lo[db][1], lo[db][2], lo[db][3], hi[db][0], hi[db][1], hi[db][2], hi[db][3]}, pf, o[db]);
        }
    }
    l += __shfl_xor(l, 16); l += __shfl_xor(l, 32);
    const float inv = 1.f / l;
    bf16_t* yo = Yxa + m * 512 + h * 128 + 4 * g;
#pragma unroll
    for (int db = 0; db < 8; ++db) { u32x2 v; v.x = pkbf(o[db][0] * inv, o[db][1] * inv); v.y = pkbf(o[db][2] * inv, o[db][3] * inv); *(u32x2*)(yo + db * 16) = v; }
    __syncthreads();
}
__device__ __forceinline__ void memkv_tile(const bf16_t* MEMN, const bf16_t* Wmkv, bf16_t* MEMKV, int tile) {
    const int tid = threadIdx.x, lane = tid & 63, w = __builtin_amdgcn_readfirstlane(tid >> 6), i = lane & 15, g = lane >> 4;
    const int r0 = (tile >> 4) * 64 + (w >> 1) * 16, c0 = (tile & 15) * 64 + (w & 1) * 32;
    const bf16_t* ap = MEMN + (size_t)(r0 + i) * 1024 + 8 * g; const bf16_t* bp = Wmkv + (size_t)(c0 + i) * 1024 + 8 * g;
    f32x4 acc0 = (f32x4){0.f, 0.f, 0.f, 0.f}, acc1 = acc0;
#pragma unroll 1
    for (int k0 = 0; k0 < 32; k0 += 8) { bf16x8 a[8], b0[8], b1[8];
#pragma unroll
        for (int kk = 0; kk < 8; ++kk) { a[kk] = *(const bf16x8*)(ap + 32 * (k0 + kk)); b0[kk] = *(const bf16x8*)(bp + 32 * (k0 + kk)); b1[kk] = *(const bf16x8*)(bp + 16 * 1024 + 32 * (k0 + kk)); }
#pragma unroll
        for (int kk = 0; kk < 8; ++kk) { acc0 = mfma16(a[kk], b0[kk], acc0); acc1 = mfma16(a[kk], b1[kk], acc1); } }
#pragma unroll
    for (int r = 0; r < 4; ++r) { bf16_t* o = MEMKV + (size_t)(r0 + 4 * g + r) * 1024 + c0 + i; o[0] = f2bf(acc0[r]); o[16] = f2bf(acc1[r]); }
}
__device__ __forceinline__ void phase(NLAS char* lds, const bf16_t* P, const bf16_t* MEMKV, bf16_t* Yxa) {
#pragma unroll 1
    for (int u = blockIdx.x; u < 512; u += gridDim.x) unit(lds, P, MEMKV, Yxa, u >> 7, (u >> 5) & 3, u & 31);
}
}

namespace ml {
using nsa::bf16x8; using nsa::s16x4; using nsa::f32x4; using nsa::u32x4; using nsa::u32x2; using nsa::vtr; using nsa::mfma16; using nsa::pkbf;
constexpr int RS = 272, TB = 64 * RS, RSS = 144;
constexpr float KSCALE = 0.08838834764831845f;
__device__ __forceinline__ float scan_add(float v, int lane) {
#pragma unroll
    for (int o = 1; o < 64; o <<= 1) { const float u = __shfl_up(v, o); if (lane >= o) v += u; }
    return v; }
__device__ __forceinline__ float scan_max(float v, int lane) {
#pragma unroll
    for (int o = 1; o < 64; o <<= 1) { const float u = __shfl_up(v, o); if (lane >= o) v = fmaxf(v, u); }
    return v; }
__device__ __forceinline__ bf16x8 trpair(const NLAS char* p, int hi_off) { const s16x4 lo = vtr(p), hi = vtr(p + hi_off); return (bf16x8){lo[0], lo[1], lo[2], lo[3], hi[0], hi[1], hi[2], hi[3]}; }
__device__ __forceinline__ void load_conv(NLAS char* dst, const bf16_t* P, const float* cw, int colP, int cwc, size_t m0, int tseq0, int tid) {
    const int s = tid >> 3, c16 = (tid & 7) * 16;
    u32x4 raw[2][4]; f32x4 wv[2][4][2];
#pragma unroll
    for (int half = 0; half < 2; ++half) { const int c = c16 + half * 8;
#pragma unroll
        for (int j = 0; j < 4; ++j) { const bool ok = (tseq0 + s - j >= 0); const size_t row = m0 + s - (ok ? j : 0);
            raw[half][j] = *(const u32x4*)(P + row * PW + colP + c);
            const f32x4 w0 = *(const f32x4*)(cw + j * 1024 + cwc + c), w1 = *(const f32x4*)(cw + j * 1024 + cwc + c + 4); const f32x4 z = (f32x4){0.f, 0.f, 0.f, 0.f};
            wv[half][j][0] = ok ? w0 : z; wv[half][j][1] = ok ? w1 : z; } }
#pragma unroll
    for (int half = 0; half < 2; ++half) { const int c = c16 + half * 8; float acc[8];
#pragma unroll
        for (int e = 0; e < 8; ++e) acc[e] = 0.f;
#pragma unroll
        for (int j = 0; j < 4; ++j) { const u32x4 r4 = raw[half][j]; const f32x4 w0 = wv[half][j][0], w1 = wv[half][j][1];
            acc[0] += w0[0] * pg8::bflo(r4.x); acc[1] += w0[1] * pg8::bfhi(r4.x); acc[2] += w0[2] * pg8::bflo(r4.y); acc[3] += w0[3] * pg8::bfhi(r4.y);
            acc[4] += w1[0] * pg8::bflo(r4.z); acc[5] += w1[1] * pg8::bfhi(r4.z); acc[6] += w1[2] * pg8::bflo(r4.w); acc[7] += w1[3] * pg8::bfhi(r4.w); }
#pragma unroll
        for (int e = 0; e < 8; ++e) acc[e] = acc[e] * __builtin_amdgcn_rcpf(1.f + __expf(-acc[e]));
        u32x4 o; o.x = pkbf(acc[0], acc[1]); o.y = pkbf(acc[2], acc[3]); o.z = pkbf(acc[4], acc[5]); o.w = pkbf(acc[6], acc[7]);
        *(NLAS u32x4*)(dst + s * RS + c * 2) = o; }
}
struct RawT { u32x4 v[3]; };
__device__ __forceinline__ void raw_issue(RawT& r, const bf16_t* P, int colP, size_t m0, int tseq0, int tid) {
#pragma unroll
    for (int it = 0; it < 3; ++it) { int idx = tid + 512 * it; idx = idx < 1072 ? idx : 1071; const int row = idx >> 4, c = (idx & 15) * 8; const bool ok = (tseq0 + row - 3 >= 0);
        const u32x4 v = *(const u32x4*)(P + (ok ? m0 + row - 3 : m0) * PW + colP + c); r.v[it] = ok ? v : (u32x4){0u, 0u, 0u, 0u}; }
}
__device__ __forceinline__ void raw_store(NLAS char* dst, const RawT& r, int tid) {
#pragma unroll
    for (int it = 0; it < 3; ++it) { int idx = tid + 512 * it; idx = idx < 1072 ? idx : 1071; *(NLAS u32x4*)(dst + (idx >> 4) * RS + (idx & 15) * 16) = r.v[it]; }
}
__device__ __forceinline__ void conv_from_lds(NLAS char* dst, const NLAS char* raw, const NLAS float* wl, int tid) {
    const int s = tid >> 3, c16 = (tid & 7) * 16;
#pragma unroll
    for (int half = 0; half < 2; ++half) { const int c = c16 + half * 8; float acc[8];
#pragma unroll
        for (int e = 0; e < 8; ++e) acc[e] = 0.f;
#pragma unroll
        for (int j = 0; j < 4; ++j) { const u32x4 r4 = *(const NLAS u32x4*)(raw + (s + 3 - j) * RS + c * 2); const f32x4 w0 = *(const NLAS f32x4*)(wl + j * 128 + c), w1 = *(const NLAS f32x4*)(wl + j * 128 + c + 4);
            acc[0] += w0[0] * pg8::bflo(r4.x); acc[1] += w0[1] * pg8::bfhi(r4.x); acc[2] += w0[2] * pg8::bflo(r4.y); acc[3] += w0[3] * pg8::bfhi(r4.y);
            acc[4] += w1[0] * pg8::bflo(r4.z); acc[5] += w1[1] * pg8::bfhi(r4.z); acc[6] += w1[2] * pg8::bflo(r4.w); acc[7] += w1[3] * pg8::bfhi(r4.w); }
#pragma unroll
        for (int e = 0; e < 8; ++e) acc[e] = acc[e] * __builtin_amdgcn_rcpf(1.f + __expf(-acc[e]));
        u32x4 o; o.x = pkbf(acc[0], acc[1]); o.y = pkbf(acc[2], acc[3]); o.z = pkbf(acc[4], acc[5]); o.w = pkbf(acc[6], acc[7]);
        *(NLAS u32x4*)(dst + s * RS + c * 2) = o; }
}
__device__ __forceinline__ void m1_unit(NLAS char* lds, const bf16_t* P, const float* cw, const float* S32, bf16_t* Abuf, float* NA, float* Gc, float* Mloc, int ci) {
    constexpr int L_K = 0, L_EV = TB, L_E = 2 * TB, L_RK = 2 * TB + 1024, L_W = L_RK + 67 * RS;
    const int tid = threadIdx.x, lane = tid & 63, w = __builtin_amdgcn_readfirstlane(tid >> 6), i = lane & 15, g = lane >> 4;
    const int c = ci & 63, bh = ci >> 6, h = bh & 3, b = bh >> 2; const size_t m0 = (size_t)b * T + c * 64;
    NLAS float* eS = (NLAS float*)(lds + L_E);
    RawT rk; raw_issue(rk, P, P_MLK + h * 128, m0, c * 64, tid);
    u32x4 vraw[2]; { const bf16_t* vp = P + (m0 + (tid >> 3)) * PW + P_MLV + h * 128 + (tid & 7) * 16; vraw[0] = *(const u32x4*)vp; vraw[1] = *(const u32x4*)(vp + 8); }
    f32x4 wreg = (f32x4){0.f, 0.f, 0.f, 0.f}; if (tid < 128) wreg = *(const f32x4*)(cw + (tid >> 5) * 1024 + 512 + h * 128 + (tid & 31) * 4);
    if (w == 0) { const float fpre = S32[(m0 + lane) * 32 + 4 + h], ipre = S32[(m0 + lane) * 32 + h];
        const float bcs = scan_add(logsig(fpre), lane), gtot = __shfl(bcs, 63), wend = gtot - bcs + ipre, mloc = wave_max(wend);
        eS[lane] = __expf(wend - mloc) * KSCALE; if (lane == 0) { Gc[ci] = gtot; Mloc[ci] = mloc; } }
    raw_store(lds + L_RK, rk, tid); if (tid < 128) *(NLAS f32x4*)(lds + L_W + ((tid >> 5) * 128 + (tid & 31) * 4) * 4) = wreg;
    __syncthreads();
    conv_from_lds(lds + L_K, lds + L_RK, (const NLAS float*)(lds + L_W), tid);
    { const int s = tid >> 3, c16 = (tid & 7) * 16; const float es = eS[s];
#pragma unroll
      for (int half = 0; half < 2; ++half) { const u32x4 raw = vraw[half]; u32x4 o;
          o.x = pkbf(pg8::bflo(raw.x) * es, pg8::bfhi(raw.x) * es); o.y = pkbf(pg8::bflo(raw.y) * es, pg8::bfhi(raw.y) * es);
          o.z = pkbf(pg8::bflo(raw.z) * es, pg8::bfhi(raw.z) * es); o.w = pkbf(pg8::bflo(raw.w) * es, pg8::bfhi(raw.w) * es);
          *(NLAS u32x4*)(lds + L_EV + s * RS + (c16 + half * 8) * 2) = o; } }
    __syncthreads();
    f32x4 acc[8];
#pragma unroll
    for (int vb = 0; vb < 8; ++vb) acc[vb] = (f32x4){0.f, 0.f, 0.f, 0.f};
    const int rowoff = (4 * g + (i >> 2)) * RS + (i & 3) * 8;
#pragma unroll
    for (int kk = 0; kk < 2; ++kk) { const bf16x8 kf = trpair(lds + L_K + kk * 32 * RS + rowoff + w * 32, 16 * RS);
#pragma unroll
        for (int vb = 0; vb < 8; ++vb) acc[vb] = mfma16(trpair(lds + L_EV + kk * 32 * RS + rowoff + vb * 32, 16 * RS), kf, acc[vb]); }
    bf16_t* ap = Abuf + ((size_t)ci * 128 + w * 16 + i) * 128 + 4 * g;
#pragma unroll
    for (int vb = 0; vb < 8; ++vb) { u32x2 pk; pk.x = pkbf(acc[vb][0], acc[vb][1]); pk.y = pkbf(acc[vb][2], acc[vb][3]); *(u32x2*)(ap + vb * 16) = pk; }
    { const int k = tid >> 2, part = tid & 3; float n = 0.f;
#pragma unroll
      for (int s = 0; s < 16; ++s) n += eS[part * 16 + s] * bf2f(*(const NLAS bf16_t*)(lds + L_K + (part * 16 + s) * RS + k * 2));
      n += __shfl_xor(n, 1); n += __shfl_xor(n, 2); if (part == 0) NA[(size_t)ci * 128 + k] = n; }
    __syncthreads();
}
__device__ __forceinline__ void m2_items(bf16_t* Abuf, float* NA, const float* Gc, const float* Mloc, float* Mprev) {
    for (int it = blockIdx.x * blockDim.x + threadIdx.x; it < 16 * 128 * 64; it += gridDim.x * blockDim.x) {
        const int bh = it >> 13, kv2 = it & 8191, k = kv2 >> 6, v2 = kv2 & 63;
        float C0 = 0.f, C1 = 0.f, n = 0.f, m = 0.f;
        unsigned* base = (unsigned*)(Abuf + ((size_t)(bh * 64) * 128 + k) * 128 + v2 * 2);
#pragma unroll 1
        for (int c0 = 0; c0 < 64; c0 += 16) { unsigned A[16];
#pragma unroll
            for (int u = 0; u < 16; ++u) A[u] = base[(size_t)(c0 + u) * 8192];
#pragma unroll
            for (int u = 0; u < 16; ++u) { const int ci = bh * 64 + c0 + u; const float gg = Gc[ci], ml = Mloc[ci];
                const float mn = fmaxf(gg + m, ml), a = __expf(gg + m - mn), bb = __expf(ml - mn);
                base[(size_t)(c0 + u) * 8192] = pkbf(C0, C1); C0 = C0 * a + pg8::bflo(A[u]) * bb; C1 = C1 * a + pg8::bfhi(A[u]) * bb;
                if (v2 == 0) { const float nA = NA[(size_t)ci * 128 + k]; NA[(size_t)ci * 128 + k] = n; n = a * n + bb * nA; }
                if (kv2 == 0) Mprev[ci] = m;
                m = mn; } }
    }
}
__device__ __forceinline__ void m3_unit(NLAS char* lds, const bf16_t* P, const float* cw, const float* S32, const bf16_t* Cprev, const float* Nprev, const float* Mprev, const float* normg, bf16_t* Yml, int ci) {
    constexpr int L_Q = 0, L_K = TB, L_V = 2 * TB, L_C = 3 * TB, L_S = 5 * TB, L_F = L_S + 64 * RSS, L_RQ = L_F + 4096, L_RK = L_RQ + 67 * RS, L_W = L_RK + 67 * RS;
    static_assert(L_W + 4096 <= 147392 - 64, "m3 LDS map");
    const int tid = threadIdx.x, lane = tid & 63, w = __builtin_amdgcn_readfirstlane(tid >> 6), i = lane & 15, g = lane >> 4;
    const int c = ci & 63, bh = ci >> 6, h = bh & 3, b = bh >> 2; const size_t m0 = (size_t)b * T + c * 64;
    const int srow = tid >> 3, c16 = (tid & 7) * 16;
    RawT rq, rk; raw_issue(rq, P, P_MLQ + h * 128, m0, c * 64, tid); raw_issue(rk, P, P_MLK + h * 128, m0, c * 64, tid);
    u32x4 vr[2], orw[2], cr[4];
    { const bf16_t* vp = P + (m0 + srow) * PW + P_MLV + h * 128 + c16; vr[0] = *(const u32x4*)vp; vr[1] = *(const u32x4*)(vp + 8);
      const bf16_t* op = P + (m0 + srow) * PW + P_MLO + h * 128 + c16; orw[0] = *(const u32x4*)op; orw[1] = *(const u32x4*)(op + 8);
      const bf16_t* cp = Cprev + ((size_t)ci * 128 + (tid >> 2)) * 128 + (tid & 3) * 32;
#pragma unroll
      for (int q8 = 0; q8 < 4; ++q8) cr[q8] = *(const u32x4*)(cp + q8 * 8); }
    f32x4 wreg = (f32x4){0.f, 0.f, 0.f, 0.f}; if (tid < 256) wreg = *(const f32x4*)(cw + ((tid & 127) >> 5) * 1024 + (tid >> 7) * 512 + h * 128 + (tid & 31) * 4);
    float ng[4];
#pragma unroll
    for (int vb = 0; vb < 4; ++vb) ng[vb] = normg[h * 128 + ((w & 1) * 4 + vb) * 16 + i];
    NLAS float* F = (NLAS float*)(lds + L_F);
    NLAS float* rowf = F; NLAS float* colf = F + 64; NLAS float* scv = F + 128; NLAS float* emt = F + 192; NLAS float* qn = F + 256; NLAS float* nprev = F + 320; NLAS float* denp = F + 448; NLAS float* ssq = F + 576;
    if (w == 0) { const float fpre = S32[(m0 + lane) * 32 + 4 + h], ipre = S32[(m0 + lane) * 32 + h], mprev = Mprev[ci];
        const float bcs = scan_add(logsig(fpre), lane), u = ipre - bcs, pm = scan_max(u, lane), mt = bcs + fmaxf(mprev, pm);
        rowf[lane] = bcs - mt; colf[lane] = u; scv[lane] = __expf(bcs + mprev - mt); emt[lane] = __expf(-mt); }
    else if (w <= 2) nprev[tid - 64] = Nprev[(size_t)ci * 128 + tid - 64];
    raw_store(lds + L_RQ, rq, tid); raw_store(lds + L_RK, rk, tid);
    if (tid < 256) *(NLAS f32x4*)(lds + L_W + ((tid >> 7) * 512 + ((tid & 127) >> 5) * 128 + (tid & 31) * 4) * 4) = wreg;
    *(NLAS u32x4*)(lds + L_V + srow * RS + c16 * 2) = vr[0]; *(NLAS u32x4*)(lds + L_V + srow * RS + c16 * 2 + 16) = vr[1];
#pragma unroll
    for (int q8 = 0; q8 < 4; ++q8) *(NLAS u32x4*)(lds + L_C + (tid >> 2) * RS + ((tid & 3) * 32 + q8 * 8) * 2) = cr[q8];
    __syncthreads();
    conv_from_lds(lds + L_Q, lds + L_RQ, (const NLAS float*)(lds + L_W), tid);
    conv_from_lds(lds + L_K, lds + L_RK, (const NLAS float*)(lds + L_W) + 512, tid);
    __syncthreads();
    *(NLAS u32x4*)(lds + L_RQ + srow * RS + c16 * 2) = orw[0]; *(NLAS u32x4*)(lds + L_RQ + srow * RS + c16 * 2 + 16) = orw[1];
    { const int tq = tid >> 3, part = tid & 7; const u32x4 q0 = *(const NLAS u32x4*)(lds + L_Q + tq * RS + part * 32), q1 = *(const NLAS u32x4*)(lds + L_Q + tq * RS + part * 32 + 16);
      const NLAS f32x4* np = (const NLAS f32x4*)(nprev + part * 16); const f32x4 n0 = np[0], n1 = np[1], n2 = np[2], n3 = np[3];
      float a = pg8::bflo(q0.x) * n0[0] + pg8::bfhi(q0.x) * n0[1] + pg8::bflo(q0.y) * n0[2] + pg8::bfhi(q0.y) * n0[3] + pg8::bflo(q0.z) * n1[0] + pg8::bfhi(q0.z) * n1[1] + pg8::bflo(q0.w) * n1[2] + pg8::bfhi(q0.w) * n1[3]
              + pg8::bflo(q1.x) * n2[0] + pg8::bfhi(q1.x) * n2[1] + pg8::bflo(q1.y) * n2[2] + pg8::bfhi(q1.y) * n2[3] + pg8::bflo(q1.z) * n3[0] + pg8::bfhi(q1.z) * n3[1] + pg8::bflo(q1.w) * n3[2] + pg8::bfhi(q1.w) * n3[3];
      a += __shfl_xor(a, 1); a += __shfl_xor(a, 2); a += __shfl_xor(a, 4); if (part == 0) qn[tq] = a; }
    const int tb = w >> 1;
    {
        float rs[4] = {0.f, 0.f, 0.f, 0.f};
#pragma unroll
        for (int sbi = 0; sbi < 2; ++sbi) { const int sb = 2 * (w & 1) + sbi; f32x4 acc = (f32x4){0.f, 0.f, 0.f, 0.f};
            if (sb <= tb) {
#pragma unroll
                for (int ks = 0; ks < 4; ++ks) acc = mfma16(*(const NLAS bf16x8*)(lds + L_Q + (tb * 16 + i) * RS + (32 * ks + 8 * g) * 2), *(const NLAS bf16x8*)(lds + L_K + (sb * 16 + i) * RS + (32 * ks + 8 * g) * 2), acc); }
            const int sx = sb * 16 + i; const float cf = colf[sx];
#pragma unroll
            for (int r = 0; r < 4; ++r) { const int t = tb * 16 + 4 * g + r; const float v = (sx <= t) ? acc[r] * KSCALE * __expf(rowf[t] + cf) : 0.f; rs[r] += v;
                *(NLAS bf16_t*)(lds + L_S + t * RSS + sx * 2) = f2bf(v); } }
#pragma unroll
        for (int r = 0; r < 4; ++r) { float x = rs[r]; x += __shfl_xor(x, 1); x += __shfl_xor(x, 2); x += __shfl_xor(x, 4); x += __shfl_xor(x, 8); if (i == 0) denp[(w & 1) * 64 + tb * 16 + 4 * g + r] = x; }
    }
    __syncthreads();
    f32x4 a1[4], a2[4];
#pragma unroll
    for (int vb = 0; vb < 4; ++vb) { a1[vb] = (f32x4){0.f, 0.f, 0.f, 0.f}; a2[vb] = (f32x4){0.f, 0.f, 0.f, 0.f}; }
    const int vb0 = (w & 1) * 4, troff = (8 * g + (i >> 2)) * RS + (i & 3) * 8;
#pragma unroll
    for (int kk = 0; kk < 2; ++kk) { if (32 * kk <= tb * 16 + 15) { const bf16x8 sf = *(const NLAS bf16x8*)(lds + L_S + (tb * 16 + i) * RSS + (32 * kk + 8 * g) * 2);
#pragma unroll
        for (int vb = 0; vb < 4; ++vb) a1[vb] = mfma16(sf, trpair(lds + L_V + kk * 32 * RS + troff + (vb0 + vb) * 32, 4 * RS), a1[vb]); } }
#pragma unroll
    for (int ks = 0; ks < 4; ++ks) { const bf16x8 qf = *(const NLAS bf16x8*)(lds + L_Q + (tb * 16 + i) * RS + (32 * ks + 8 * g) * 2);
#pragma unroll
        for (int vb = 0; vb < 4; ++vb) a2[vb] = mfma16(qf, trpair(lds + L_C + ks * 32 * RS + troff + (vb0 + vb) * 32, 4 * RS), a2[vb]); }
    float hv[4][4], sq[4] = {0.f, 0.f, 0.f, 0.f};
#pragma unroll
    for (int r = 0; r < 4; ++r) { const int t = tb * 16 + 4 * g + r; const float sc = scv[t]; const float den = denp[t] + denp[64 + t] + sc * qn[t]; const float hd = 1.f / fmaxf(fabsf(den), emt[t]);
#pragma unroll
        for (int vb = 0; vb < 4; ++vb) { const float x = (a1[vb][r] + sc * a2[vb][r]) * hd; hv[vb][r] = x; sq[r] += x * x; } }
#pragma unroll
    for (int r = 0; r < 4; ++r) { float x = sq[r]; x += __shfl_xor(x, 1); x += __shfl_xor(x, 2); x += __shfl_xor(x, 4); x += __shfl_xor(x, 8); if (i == 0) ssq[(w & 1) * 64 + tb * 16 + 4 * g + r] = x; }
    __syncthreads();
#pragma unroll
    for (int r = 0; r < 4; ++r) { const int t = tb * 16 + 4 * g + r; const float rinv = rsqrtf((ssq[t] + ssq[64 + t]) * (1.f / 128.f) + EPS);
#pragma unroll
        for (int vb = 0; vb < 4; ++vb) { const int v = (vb0 + vb) * 16 + i; const float o = bf2f(*(const NLAS bf16_t*)(lds + L_RQ + t * RS + v * 2));
            *(NLAS bf16_t*)(lds + L_RK + t * RS + v * 2) = f2bf(__builtin_amdgcn_rcpf(1.f + __expf(-o)) * hv[vb][r] * rinv * ng[vb]); } }
    __syncthreads();
    { bf16_t* yp = Yml + (m0 + srow) * 512 + h * 128 + c16; *(u32x4*)yp = *(const NLAS u32x4*)(lds + L_RK + srow * RS + c16 * 2); *(u32x4*)(yp + 8) = *(const NLAS u32x4*)(lds + L_RK + srow * RS + c16 * 2 + 16); }
    __syncthreads();
}
}

namespace cmpr {
using nsa::bf16x8; using nsa::f32x4; using nsa::u32x4; using nsa::mfma16; using nsa::pkbf;
constexpr int RSX = 144, L_X = 0, L_PE = 272 * RSX  , L_H = L_PE + 8192, RSH = 528;
__device__ __forceinline__ void unit(NLAS char* lds, const bf16_t* P, const float* pe, const bf16_t* W1t, const bf16_t* W2t, bf16_t* KC, bf16_t* VC, int u) {
    const int tid = threadIdx.x, lane = tid & 63, w = __builtin_amdgcn_readfirstlane(tid >> 6), i = lane & 15, g = lane >> 4;
    const int nt = u & 15, gq = (u >> 4) & 1, b = (u >> 5) & 3, kv = u >> 7;
    const int pcol = (kv ? P_VC : P_KC) + gq * 64, tok0 = 256 * nt;
    for (int ch = tid; ch < 272 * 8; ch += 512) { const int row = ch >> 3, c8 = (ch & 7) * 8, tok = tok0 + row;
        u32x4 v = (u32x4){0u, 0u, 0u, 0u}; if (tok < T) v = *(const u32x4*)(P + ((size_t)b * T + tok) * PW + pcol + c8);
        *(NLAS u32x4*)(lds + L_X + row * RSX + c8 * 2) = v; }
    for (int e = tid; e < 2048; e += 512) ((NLAS float*)(lds + L_PE))[e] = pe[kv * 2048 + e];
    __syncthreads();
    f32x4 acc[2]; acc[0] = (f32x4){0.f, 0.f, 0.f, 0.f}; acc[1] = acc[0];
    const bf16_t* wb = W1t + ((size_t)kv * 256 + 32 * w + i) * 2048 + 8 * g;
#define CMPR_LOAD(dst, k0_) { _Pragma("unroll") for (int kk = 0; kk < 8; ++kk) { dst[kk][0] = *(const bf16x8*)(wb + 32 * ((k0_) + kk)); dst[kk][1] = *(const bf16x8*)(wb + 16 * 2048 + 32 * ((k0_) + kk)); } }
#define CMPR_COMP(src, k0_) { _Pragma("unroll") for (int kk = 0; kk < 8; ++kk) { const int ks = (k0_) + kk, l = ks >> 1, dh = ks & 1; \
            const u32x4 raw = *(const NLAS u32x4*)(lds + L_X + (16 * i + l) * RSX + dh * 64 + 16 * g); \
            const NLAS float* pp = (const NLAS float*)(lds + L_PE) + l * 64 + dh * 32 + 8 * g; const f32x4 p0 = *(const NLAS f32x4*)pp, p1 = *(const NLAS f32x4*)(pp + 4); \
            u32x4 a; a.x = pkbf(pg8::bflo(raw.x) + p0[0], pg8::bfhi(raw.x) + p0[1]); a.y = pkbf(pg8::bflo(raw.y) + p0[2], pg8::bfhi(raw.y) + p0[3]); \
            a.z = pkbf(pg8::bflo(raw.z) + p1[0], pg8::bfhi(raw.z) + p1[1]); a.w = pkbf(pg8::bflo(raw.w) + p1[2], pg8::bfhi(raw.w) + p1[3]); \
            const bf16x8 af = __builtin_bit_cast(bf16x8, a); \
            acc[0] = mfma16(af, src[kk][0], acc[0]); acc[1] = mfma16(af, src[kk][1], acc[1]); } }
    { bf16x8 bA[8][2], bB[8][2];
      CMPR_LOAD(bA, 0)
#pragma unroll 1
      for (int k0 = 0; k0 < 64; k0 += 16) { CMPR_LOAD(bB, k0 + 8) CMPR_COMP(bA, k0) if (k0 + 16 < 64) CMPR_LOAD(bA, k0 + 16) CMPR_COMP(bB, k0 + 8) } }
#undef CMPR_LOAD
#undef CMPR_COMP
#pragma unroll
    for (int cb = 0; cb < 2; ++cb)
#pragma unroll
        for (int r = 0; r < 4; ++r) { const float x = acc[cb][r], uu = 0.7978845608028654f * (x + 0.044715f * x * x * x); const float gl = x * __builtin_amdgcn_rcpf(1.f + __expf(-2.f * uu));
            *(NLAS bf16_t*)(lds + L_H + (4 * g + r) * RSH + (32 * w + cb * 16 + i) * 2) = f2bf(gl); }
    __syncthreads();
    if (w < 4) { f32x4 o = (f32x4){0.f, 0.f, 0.f, 0.f}; const bf16_t* w2 = W2t + ((size_t)kv * 64 + 16 * w + i) * 256 + 8 * g;
#pragma unroll
        for (int ks = 0; ks < 8; ++ks) o = mfma16(*(const NLAS bf16x8*)(lds + L_H + i * RSH + (32 * ks + 8 * g) * 2), *(const bf16x8*)(w2 + 32 * ks), o);
        bf16_t* dst = (kv ? VC : KC);
#pragma unroll
        for (int r = 0; r < 4; ++r) dst[((size_t)(b * 256 + 16 * nt + 4 * g + r) * 2 + gq) * 64 + 16 * w + i] = f2bf(o[r]); }
    __syncthreads();
}
}

#define LAS __attribute__((address_space(3)))
constexpr int NTHREADS = 512, LDS_BYTES = 147456;
constexpr size_t WS_WIN = 1 * MiB, WS_WG = 9 * MiB, WS_WBR = 15 * MiB, WS_WOUT = 18 * MiB, WS_WFF1 = 20 * MiB, WS_WFF2 = 28 * MiB, WS_WMKV = 36 * MiB, WS_WC1 = 38 * MiB;
constexpr size_t WS_BIASP = 253 * MiB + 768 * 1024, WS_XCH = 254 * MiB;
#define XB_TMO      128
#define XB_XCNT(j)  (256  + 64 * (j))
#define XB_XSUB(j)  (1280 + 64 * (j))
#define XB_XGEN(j)  (2304 + 64 * (j))
#define XB_TOP      3328
#define XB_TOPGEN   3392
#define XCD_BAR_WORDS 3456
#define XB_SPIN_CAP (1u << 18)

__device__ __forceinline__ unsigned xb_ld(unsigned* p)              { return __hip_atomic_load(p, __ATOMIC_RELAXED, __HIP_MEMORY_SCOPE_AGENT); }
__device__ __forceinline__ unsigned xb_add(unsigned* p, unsigned v) { return __hip_atomic_fetch_add(p, v, __ATOMIC_RELAXED, __HIP_MEMORY_SCOPE_AGENT); }
__device__ __forceinline__ unsigned xb_xcc_id() { return (unsigned)__builtin_amdgcn_s_getreg((3 << 11) | 20) & 0xFu; }
#define XB_SPIN(cond, bar) do { unsigned _sp = 0; while (cond) { __builtin_amdgcn_s_sleep(1); \
    if ((++_sp & 255u) == 0u) { if (xb_ld(&(bar)[XB_TMO])) break; if (_sp > XB_SPIN_CAP) { atomicAdd(&(bar)[XB_TMO], 1u); break; } } } } while (0)

struct XcdBarrier {
    unsigned* bar; unsigned x;
    volatile LAS unsigned* st;
};

__device__ __forceinline__ XcdBarrier xcd_barrier_post(unsigned* bar, volatile LAS unsigned* st) {
    XcdBarrier b; b.bar = bar; b.x = xb_xcc_id(); b.st = st;
    if (threadIdx.x == 0) (void)xb_add(&bar[XB_XCNT(b.x)], 1u);
    return b;
}
__device__ __forceinline__ void xcd_barrier_complete(unsigned* bar, unsigned x, unsigned& nloc, unsigned& nx) {
    const unsigned G = gridDim.x * gridDim.y * gridDim.z;
    unsigned sum, cnt, mine, sp = 0u;
    for (;;) {
        sum = 0u; cnt = 0u; mine = 0u;
#pragma unroll
        for (unsigned j = 0; j < 16; ++j) { const unsigned c = xb_ld(&bar[XB_XCNT(j)]); sum += c; cnt += (c > 0u) ? 1u : 0u; mine = (j == x) ? c : mine; }
        if (sum == G) break;
        __builtin_amdgcn_s_sleep(1);
        if ((++sp & 255u) == 0u) { if (xb_ld(&bar[XB_TMO])) break; if (sp > XB_SPIN_CAP) { atomicAdd(&bar[XB_TMO], 1u); break; } }
    }
    nloc = mine > 0u ? mine : 1u; nx = cnt > 0u ? cnt : 1u;
}

__device__ __forceinline__ void xcd_barrier(const XcdBarrier& b) {
    asm volatile("s_waitcnt vmcnt(0)" ::: "memory");
    __syncthreads();
    if (threadIdx.x == 0) {
        unsigned* bar = b.bar;
        __builtin_amdgcn_s_waitcnt(0);
        unsigned nloc = b.st[0], nx = b.st[1];
        if (nloc == 0u) { xcd_barrier_complete(bar, b.x, nloc, nx); b.st[0] = nloc; b.st[1] = nx; }
        const unsigned old = xb_add(&bar[XB_XSUB(b.x)], 1u);
        const unsigned gen = old / nloc;
        if (old + 1u == (gen + 1u) * nloc) {
            __builtin_amdgcn_fence(__ATOMIC_RELEASE, "agent");
            asm volatile("s_waitcnt vmcnt(0)" ::: "memory");
            const unsigned og = xb_add(&bar[XB_TOP], 1u);
            const unsigned tg = og / nx;
            if (og + 1u == (tg + 1u) * nx) xb_add(&bar[XB_TOPGEN], 1u);
            else XB_SPIN(xb_ld(&bar[XB_TOPGEN]) == tg, bar);
            __builtin_amdgcn_fence(__ATOMIC_ACQUIRE, "agent");
            xb_add(&bar[XB_XGEN(b.x)], 1u);
            asm volatile("s_waitcnt vmcnt(0)" ::: "memory");
        } else {
            XB_SPIN(xb_ld(&bar[XB_XGEN(b.x)]) == gen, bar);
            __builtin_amdgcn_fence(__ATOMIC_ACQUIRE, "agent");
            asm volatile("s_waitcnt vmcnt(0)" ::: "memory");
        }
    }
    __syncthreads();
}

__device__ __forceinline__ void group_barrier(unsigned* gc, unsigned target, bool light) {
    asm volatile("s_waitcnt vmcnt(0)" ::: "memory"); __syncthreads();
    if (threadIdx.x == 0) {
        if (!light) { __builtin_amdgcn_fence(__ATOMIC_RELEASE, "agent"); asm volatile("s_waitcnt vmcnt(0)" ::: "memory"); }
        __hip_atomic_fetch_add(gc, 1u, __ATOMIC_RELAXED, __HIP_MEMORY_SCOPE_AGENT);
        unsigned sp = 0; while (__hip_atomic_load(gc, __ATOMIC_RELAXED, __HIP_MEMORY_SCOPE_AGENT) < target) { __builtin_amdgcn_s_sleep(1); if (++sp > (1u << 22)) break; }
        __builtin_amdgcn_fence(__ATOMIC_ACQUIRE, "agent"); asm volatile("s_waitcnt vmcnt(0)" ::: "memory");
    }
    __syncthreads();
}
struct Args { const float* in[18]; float* out; unsigned char* ws; int ph_lo, ph_hi; };
__device__ __forceinline__ unsigned pk2(float lo, float hi) { return (unsigned)f2bf(lo) | ((unsigned)f2bf(hi) << 16); }
typedef unsigned v4u __attribute__((ext_vector_type(4)));
typedef float f32x4 __attribute__((ext_vector_type(4)));
__device__ __forceinline__ void tr_item(const float* W, int ld, int ncols, int K, bf16_t* WT, int row_off, LAS float* scr, int item, int lane) {
    const int nblk = ncols / 32, kb = item / nblk, nb = item % nblk, k0 = 64 * kb, n0 = 32 * nb;
#pragma unroll 8
    for (int i = 0; i < 32; ++i) { const int kk = 2 * i + (lane >> 5); scr[kk * 33 + (lane & 31)] = W[(size_t)(k0 + kk) * ld + n0 + (lane & 31)]; }
    asm volatile("s_waitcnt lgkmcnt(0)" ::: "memory");
    const int c = lane & 7;
#pragma unroll
    for (int j = 0; j < 4; ++j) { const int n = (lane >> 3) + 8 * j; const LAS float* s = scr + (8 * c) * 33 + n;
        v4u o; o.x = pk2(s[0 * 33], s[1 * 33]); o.y = pk2(s[2 * 33], s[3 * 33]); o.z = pk2(s[4 * 33], s[5 * 33]); o.w = pk2(s[6 * 33], s[7 * 33]);
        *(v4u*)(WT + (size_t)(row_off + n0 + n) * K + k0 + 8 * c) = o; }
    asm volatile("s_waitcnt lgkmcnt(0)" ::: "memory");
}
__device__ __forceinline__ void rms_row_wave(const float* xrow, const float* g, bf16_t* orow, int lane) {
    const f32x4* xr = (const f32x4*)xrow + lane; const f32x4* gr = (const f32x4*)g + lane;
    f32x4 v[4]; float s = 0.f;
#pragma unroll
    for (int j = 0; j < 4; ++j) { v[j] = xr[64 * j]; s += (v[j].x * v[j].x + v[j].y * v[j].y) + (v[j].z * v[j].z + v[j].w * v[j].w); }
    const float r = rsqrtf(wave_sum(s) * (1.f / D) + EPS);
    unsigned long long* o8 = (unsigned long long*)orow + lane;
#pragma unroll
    for (int j = 0; j < 4; ++j) { const f32x4 gg = gr[64 * j]; o8[64 * j] = (unsigned long long)pk2(v[j].x * r * gg.x, v[j].y * r * gg.y) | ((unsigned long long)pk2(v[j].z * r * gg.z, v[j].w * r * gg.w) << 32); }
}
__device__ __forceinline__ int small_src_col(int c) { return c < 8 ? C_MLI + c : C_NSG + (c - 8); }
__global__ void __launch_bounds__(NTHREADS, 2) mega(Args a) {
    extern __shared__ __attribute__((aligned(16))) unsigned char lds_raw[];
    char* lds = (char*)lds_raw;
    LAS unsigned char* lds3 = (LAS unsigned char*)lds_raw;
    const float* x = a.in[0]; const float* mem = a.in[1]; const float* g_mix = a.in[2]; const float* w_in = a.in[3];
    const float* b_in = a.in[4]; const float* ml_conv = a.in[5]; const float* ml_norm_g = a.in[6]; const float* cmp_pe = a.in[7];
    const float* cmp_w1 = a.in[8]; const float* cmp_w2 = a.in[9]; const float* g_mem = a.in[10]; const float* w_mem_kv = a.in[11];
    const float* w_branch = a.in[12]; const float* w_out = a.in[13]; const float* g_ffn = a.in[14]; const float* w_ff1 = a.in[15];
    const float* w_ff2 = a.in[16]; const float* g_final = a.in[17];
    char* ws = (char*)a.ws; float* out = a.out;
    bf16_t* U = (bf16_t*)(ws + WS_U); bf16_t* P = (bf16_t*)(ws + WS_P);
    bf16_t* Yml = (bf16_t*)(ws + WS_Y); bf16_t* Ynsa = Yml + (size_t)M * 512; bf16_t* Yxa = Ynsa + (size_t)M * 512;
    float* S32 = (float*)(ws + WS_S32); bf16_t* MEMN = (bf16_t*)out + (size_t)16 * 1024 * 1024;     bf16_t* MEMKV = (bf16_t*)(ws + WS_MEMKV);
    bf16_t* KC = (bf16_t*)(ws + WS_KC); bf16_t* VC = (bf16_t*)(ws + WS_VC);
    float* NA = (float*)(ws + WS_NA); float* Gc = (float*)(ws + WS_G); float* Mloc = (float*)(ws + WS_MLOC); float* Mprev = (float*)(ws + WS_MPREV);
    bf16_t* Abuf = (bf16_t*)out;
    bf16_t* GATES = P; bf16_t* MERGED = U; bf16_t* AFFN = U; bf16_t* HBUF = P;
    bf16_t* Wi = (bf16_t*)(ws + WS_WIN); bf16_t* Wg = (bf16_t*)(ws + WS_WG); bf16_t* Wbr = (bf16_t*)(ws + WS_WBR); bf16_t* Wo = (bf16_t*)(ws + WS_WOUT);
    bf16_t* Wf1 = (bf16_t*)(ws + WS_WFF1); bf16_t* Wf2 = (bf16_t*)(ws + WS_WFF2); bf16_t* Wmkv = (bf16_t*)(ws + WS_WMKV);
    float* biasP = (float*)(ws + WS_BIASP); bf16_t* Wc1 = (bf16_t*)(ws + WS_WC1); bf16_t* Wc2 = (bf16_t*)(ws + WS_BIASP + 65536);
    const int tid = threadIdx.x, lane = tid & 63, wave = __builtin_amdgcn_readfirstlane(tid >> 6);
    const int G = gridDim.x, bid = blockIdx.x;
    const int lo = a.ph_lo, hi = a.ph_hi;
    volatile LAS unsigned* xbst = (volatile LAS unsigned*)(lds3 + LDS_BYTES - 64);
    if (tid < 2) xbst[tid] = 0u;
    __syncthreads();
    const XcdBarrier bar = xcd_barrier_post((unsigned*)ws, xbst);
    if (tid == 0) __hip_atomic_store((unsigned*)ws + 12544 + bid, xb_xcc_id() + 1u, __ATOMIC_RELAXED, __HIP_MEMORY_SCOPE_AGENT);
#define PHASE(k) if (lo <= (k) && (k) < hi)
#define SEAM(k) if (lo <= (k) && (k) + 1 < hi) xcd_barrier(bar)
    PHASE(0) {
        LAS float* scr = (LAS float*)(lds3 + wave * 16384);
        const int gw = bid * 8 + wave, NGW = G * 8;
        constexpr int I0 = 16 * 64, I1 = 16 * 40, I2 = 16 * 16, I3 = 16 * 96, I4 = 8 * 32, I5 = 16 * 32, I6 = 16 * 128, I7 = 64 * 32, I8 = 16 * 32;
        constexpr int I9 = 32 * 8, I10 = 4 * 2;
        constexpr int NITEMS = I0 + I1 + I2 + I3 + 3 * I4 + I5 + I6 + I7 + I8 + 2 * I9 + 2 * I10;
        for (int it = gw; it < NITEMS; it += NGW) {
            int r = it;
            if (r < I0) { tr_item(w_in, DIN, 2048, 1024, Wi, 0, scr, r, lane); continue; } r -= I0;
            if (r < I1) { tr_item(w_in + 2056, DIN, 1280, 1024, Wi, 2048, scr, r, lane); continue; } r -= I1;
            if (r < I2) { tr_item(w_in + 3360, DIN, 512, 1024, Wi, 3328, scr, r, lane); continue; } r -= I2;
            if (r < I3) { tr_item(w_in + C_MG, DIN, 3072, 1024, Wg, 0, scr, r, lane); continue; } r -= I3;
            if (r < 3 * I4) { const int j = r / I4; tr_item(w_branch + (size_t)j * 512 * 1024, 1024, 1024, 512, Wbr + (size_t)j * 1024 * 512, 0, scr, r % I4, lane); continue; } r -= 3 * I4;
            if (r < I5) { tr_item(w_out, 1024, 1024, 1024, Wo, 0, scr, r, lane); continue; } r -= I5;
            if (r < I6) { tr_item(w_ff1, FF, FF, 1024, Wf1, 0, scr, r, lane); continue; } r -= I6;
            if (r < I7) { tr_item(w_ff2, 1024, 1024, FF, Wf2, 0, scr, r, lane); continue; } r -= I7;
            if (r < I8) { tr_item(w_mem_kv, 1024, 1024, 1024, Wmkv, 0, scr, r, lane); continue; } r -= I8;
            if (r < 2 * I9) { const int kv = r / I9; tr_item(cmp_w1 + (size_t)kv * 2048 * 256, 256, 256, 2048, Wc1 + (size_t)kv * 256 * 2048, 0, scr, r % I9, lane); continue; } r -= 2 * I9;
            { const int kv = r / I10; tr_item(cmp_w2 + (size_t)kv * 256 * 64, 64, 64, 256, Wc2 + (size_t)kv * 64 * 256, 0, scr, r % I10, lane); }
        }
        for (int i = bid * NTHREADS + tid; i < 256 * 1024; i += G * NTHREADS) { const int r = i >> 10, k = i & 1023; bf16_t v = 0;
            if (r < 32) v = f2bf(w_in[(size_t)k * DIN + small_src_col(r)]);
            else if (r >= 128 && r < 160) { const float w = w_in[(size_t)k * DIN + small_src_col(r - 128)]; v = f2bf(w - bf2f(f2bf(w))); }
            Wi[(size_t)(3840 + r) * 1024 + k] = v; }
        for (int c = bid * NTHREADS + tid; c < 4096; c += G * NTHREADS) { float v = 0.f;
            if (c < 2048) v = b_in[c]; else if (c < 3328) v = b_in[c + 8]; else if (c < 3840) v = b_in[c + 32]; else if (c < 3872) v = b_in[small_src_col(c - 3840)];
            biasP[c] = v; }
        for (int m = gw; m < M; m += NGW) rms_row_wave(x + (size_t)m * D, g_mix, U + (size_t)m * D, lane);
        for (int m = gw; m < 1024; m += NGW) rms_row_wave(mem + (size_t)m * D, g_mem, MEMN + (size_t)m * D, lane);
    }
    SEAM(0);
    PHASE(1) {
        { pg8::Gemm g{U, Wi, M, 4096, D}; pg8::StaticOrder S; S.init(M, 4096, G, bid);
          pg8::EpiStore<0> E{P, biasP, S32, PW, 15};
          pg8::gemm_phase<pg8::EpiStore<0>, pg8::StaticOrder, true, true>(lds3, g, S, E); }
    }
    SEAM(1);
    PHASE(2) { for (int tl_ = bid; tl_ < 256; tl_ += G) xa::memkv_tile(MEMN, Wmkv, MEMKV, tl_);
               for (int ci = bid; ci < 1024; ci += G) ml::m1_unit((NLAS char*)lds_raw, P, ml_conv, S32, Abuf, NA, Gc, Mloc, ci);
               for (int u = bid; u < 256; u += G) cmpr::unit((NLAS char*)lds_raw, P, cmp_pe, Wc1, Wc2, KC, VC, u);
    }
    SEAM(2);
    PHASE(3) { unsigned* m2cnt = (unsigned*)ws + 12288;
               ml::m2_items(Abuf, NA, Gc, Mloc, Mprev);
               asm volatile("s_waitcnt vmcnt(0)" ::: "memory"); __syncthreads();
               if (tid == 0) { __builtin_amdgcn_fence(__ATOMIC_RELEASE, "agent"); asm volatile("s_waitcnt vmcnt(0)" ::: "memory"); __hip_atomic_fetch_add(m2cnt, 1u, __ATOMIC_RELAXED, __HIP_MEMORY_SCOPE_AGENT); }
               nsa::phase((NLAS char*)lds_raw, P, S32, KC, VC, Ynsa);
               xa::phase((NLAS char*)lds_raw, P, MEMKV, Yxa);
               if (tid == 0) { unsigned sp = 0; while (__hip_atomic_load(m2cnt, __ATOMIC_RELAXED, __HIP_MEMORY_SCOPE_AGENT) < (unsigned)G) { __builtin_amdgcn_s_sleep(2); if (++sp > (1u << 22)) break; }
                               __builtin_amdgcn_fence(__ATOMIC_ACQUIRE, "agent"); asm volatile("s_waitcnt vmcnt(0)" ::: "memory"); }
               __syncthreads();
               for (int ci = bid; ci < 1024; ci += G) ml::m3_unit((NLAS char*)lds_raw, P, ml_conv, S32, Abuf, NA, Mprev, ml_norm_g, Yml, ci); }
    SEAM(4);
    unsigned* gcnt = (unsigned*)ws + 13312 + 16 * (bid & 63);
    bool panel_sync = false;
    if (G == 256) { volatile LAS unsigned* flag = (volatile LAS unsigned*)(lds3 + LDS_BYTES - 48);
        if (wave == 0) { const unsigned* xt = (const unsigned*)ws + 12544; unsigned x0 = 0, same = 1;
            for (int k = 0; k < 4; ++k) { const unsigned xv = __hip_atomic_load(xt + lane + 64 * k, __ATOMIC_RELAXED, __HIP_MEMORY_SCOPE_AGENT); if (k == 0) x0 = xv; same &= (xv == x0 && xv != 0u) ? 1u : 0u; }
            const unsigned long long all = __ballot(same != 0u); if (lane == 0) flag[0] = (all == ~0ull) ? 1u : 0u; }
        __syncthreads();
        panel_sync = flag[0] != 0u; }
    const bool light = true;
#define PSEAM(k, n) if (lo <= (k) && (k) + 1 < hi) { if (panel_sync) group_barrier(gcnt, 4u * (n), light); else xcd_barrier(bar); }
    PHASE(5) { pg8::Gemm g{U, Wg, M, 3072, D}; pg8::StaticOrder S; S.init(M, 3072, G, bid);
               pg8::EpiStore<1> E{GATES, b_in + C_MG, nullptr, 4096, -1};
               pg8::gemm_phase<pg8::EpiStore<1>, pg8::StaticOrder, true, true>(lds3, g, S, E); }
    PSEAM(5, 1);
    PHASE(6) { pg8::Gemm g{Yml, Wbr, M, 1024, 512}; pg8::MergeOrder S; S.so.init(M, 1024, G, bid); S.sa = (size_t)M * 512 * 2; S.sb = (size_t)1024 * 512 * 2;
               pg8::EpiMergeG E{GATES, (bf16_t*)out, MERGED};
               pg8::gemm_phase<pg8::EpiMergeG, pg8::MergeOrder, true, true>(lds3, g, S, E); }
    PSEAM(6, 2);
    PHASE(7) { pg8::Gemm g{MERGED, Wo, M, 1024, D}; pg8::StaticOrder S; S.init(M, 1024, G, bid);
               pg8::EpiResRms E{x, out, nullptr, AFFN, g_ffn, (float*)(ws + WS_XCH), (unsigned*)ws + 4096};
               pg8::gemm_phase<pg8::EpiResRms, pg8::StaticOrder, false, true>(lds3, g, S, E); }
    PSEAM(7, 3);
    PHASE(9) { pg8::Gemm g{AFFN, Wf1, M, FF, D}; pg8::StaticOrder S; S.init(M, FF, G, bid);
               pg8::EpiStore<2> E{HBUF, nullptr, nullptr, FF, -1};
               pg8::gemm_phase<pg8::EpiStore<2>, pg8::StaticOrder, true, true>(lds3, g, S, E); }
    PSEAM(9, 4);
    PHASE(10) { pg8::Gemm g{HBUF, Wf2, M, 1024, FF}; pg8::StaticOrder S; S.init(M, 1024, G, bid);
                pg8::EpiResRms E{out, nullptr, out, nullptr, g_final, (float*)(ws + WS_XCH + 262144), (unsigned*)ws + 4096 + 4096};
                pg8::gemm_phase<pg8::EpiResRms, pg8::StaticOrder, false, true>(lds3, g, S, E); }
}
constexpr int N_PHASES = 12;
extern "C" void kernel_launch(void* const* d_in, const int* in_sizes, int n_in, void* d_out, int out_size, void* d_ws, size_t ws_size, hipStream_t stream) {
    static int grid = 0;
    if (grid == 0) {
        int dev = 0, cus = 0, per_cu = 0;
        (void)hipGetDevice(&dev); (void)hipDeviceGetAttribute(&cus, hipDeviceAttributeMultiprocessorCount, dev);
        (void)hipFuncSetAttribute((const void*)mega, hipFuncAttributeMaxDynamicSharedMemorySize, LDS_BYTES);
        (void)hipOccupancyMaxActiveBlocksPerMultiprocessor(&per_cu, (const void*)mega, NTHREADS, LDS_BYTES);
        if (per_cu < 1) { fprintf(stderr, "occupancy query says %d blocks/CU\n", per_cu); per_cu = 1; }
        grid = cus * 1;
        (void)hipGetLastError();
    }
    (void)hipMemsetAsync(d_ws, 0, 65536, stream);
    Args a{};
    for (int i = 0; i < 18; ++i) a.in[i] = (const float*)d_in[i];
    a.out = (float*)d_out; a.ws = (unsigned char*)d_ws;
    a.ph_lo = 0; a.ph_hi = N_PHASES; void* args[] = {&a};
    hipError_t e = hipLaunchCooperativeKernel((const void*)mega, dim3(grid), dim3(NTHREADS), args, LDS_BYTES, stream);
    if (e != hipSuccess) {
        (void)hipGetLastError();
        hipLaunchKernelGGL(mega, dim3(grid), dim3(NTHREADS), LDS_BYTES, stream, a);
    }
}
```

```cpp
#include <hip/hip_runtime.h>
#include <hip/hip_cooperative_groups.h>
#include <cstdio>
namespace cg = cooperative_groups;
#include <stdint.h>

typedef unsigned short bf16_t;
__device__ __forceinline__ float bf2f(bf16_t v) { return __uint_as_float(((unsigned)v) << 16); }
__device__ __forceinline__ bf16_t f2bf(float f) { unsigned u = __float_as_uint(f); return (bf16_t)((u + 0x7fffu + ((u >> 16) & 1u)) >> 16); }

constexpr int NB = 4, T = 4096, M = NB * T, D = 1024, DIN = 6944, FF = 4096;
constexpr float EPS = 1e-6f;
constexpr int C_MLI = 2048, C_NSG = 3336, C_MG = 3872;
constexpr int P_MLQ = 0, P_MLK = 512, P_MLV = 1024, P_MLO = 1536, P_NSQ = 2048, P_KC = 2560, P_VC = 2688, P_KS = 2816, P_VS = 2944, P_KW = 3072, P_VW = 3200, P_XAQ = 3328, PW = 3840;
constexpr size_t MiB = 1u << 20;
constexpr size_t WS_U = 40 * MiB;
constexpr size_t WS_P = 72 * MiB;
constexpr size_t WS_Y = 200 * MiB;
constexpr size_t WS_S32 = 248 * MiB;
constexpr size_t WS_MEMKV = 250 * MiB;
constexpr size_t WS_KC = 252 * MiB;
constexpr size_t WS_VC = 252 * MiB + 512 * 1024;
constexpr size_t WS_NA = 253 * MiB;
constexpr size_t WS_G = 253 * MiB + 512 * 1024;
constexpr size_t WS_MLOC = 253 * MiB + 512 * 1024 + 4096;
constexpr size_t WS_MPREV = 253 * MiB + 512 * 1024 + 8192;

__device__ __forceinline__ float wave_sum(float v) {
#pragma unroll
    for (int o = 1; o < 64; o <<= 1) v += __shfl_xor(v, o);
    return v;
}
__device__ __forceinline__ float wave_max(float v) {
#pragma unroll
    for (int o = 1; o < 64; o <<= 1) v = fmaxf(v, __shfl_xor(v, o));
    return v;
}

__device__ __forceinline__ float logsig(float x) { return fminf(x, 0.f) - log1pf(__expf(-fabsf(x))); }
namespace pg8 {
#define PG8_LAS __attribute__((address_space(3)))
typedef unsigned short bf16_t;
typedef short bf16x8 __attribute__((ext_vector_type(8)));
typedef float f32x4 __attribute__((ext_vector_type(4)));
typedef unsigned u32x4 __attribute__((ext_vector_type(4)));
constexpr int BM = 256, BK = 64, HALF = 128, HTB = HALF * BK * 2  , STAGE_BYTES = 8 * HTB, NXCD = 8, WGM = 8;

__host__ __device__ __forceinline__ int lds_byte(int r, int c) { const int st = (r >> 4) * 2 + (c >> 5), rr = r & 15, cc = c & 31, ob = rr * 64 + cc * 2; return st * 1024 + (ob ^ (((ob >> 9) & 1) << 5)); }
__host__ __device__ __forceinline__ void stage_rc(int b, int& R, int& C) { const int st = b / 1024, sb = b % 1024, swz = sb ^ (((sb >> 9) & 1) << 5); R = (st >> 1) * 16 + swz / 64; C = (st & 1) * 32 + (swz % 64) / 2; }
__host__ __device__ __forceinline__ int perm32(int rho) { const int n = rho >> 4, i = rho & 15; return 8 * (i >> 2) + 4 * n + (i & 3); }

struct Unit { int pm, pn, j; };
struct Gemm { const bf16_t* A; const bf16_t* Bt; int M, N, K; };

struct StaticOrder {
    int nM, nN, nwg, G, c;
    __host__ __device__ void init(int M, int N, int G_, int c_) { nM = M / BM; nN = N / BM; nwg = nM * nN; G = G_; c = c_; }
    __host__ __device__ bool next(int i, Unit& u) const {
        const long L = (long)i * G + c; if (L >= nwg) return false;
        int wgid = (int)L; { const int q = nwg / NXCD, r = nwg % NXCD, xcd = wgid % NXCD, off = wgid / NXCD; wgid = (xcd < r ? xcd * (q + 1) : r * (q + 1) + (xcd - r) * q) + off; }
        const int nig = WGM * nN, gid = wgid / nig, fm = gid * WGM, gsz = (nM - fm) < WGM ? (nM - fm) : WGM;
        u.pm = fm + ((wgid % nig) % gsz); u.pn = (wgid % nig) / gsz; u.j = 0; return true;
    }
    __device__ __forceinline__ const char* pa(const Gemm& g, const Unit& u, size_t tstep) const { return (const char*)g.A + (size_t)u.pm * tstep; }
    __device__ __forceinline__ const char* pb(const Gemm& g, const Unit& u, size_t tstep) const { return (const char*)g.Bt + (size_t)u.pn * tstep; }
    __device__ __forceinline__ void a_ready(const Unit&) const {}
    __device__ __forceinline__ void done(const Unit&) const {}
};

struct MergeOrder {
    StaticOrder so; size_t sa, sb;
    __device__ __forceinline__ bool next(int i, Unit& u) const { if (i >= 3) return false; const bool ok = so.next(0, u); u.j = i; return ok; }
    __device__ __forceinline__ const char* pa(const Gemm& g, const Unit& u, size_t tstep) const { return (const char*)g.A + (size_t)u.j * sa + (size_t)u.pm * tstep; }
    __device__ __forceinline__ const char* pb(const Gemm& g, const Unit& u, size_t tstep) const { return (const char*)g.Bt + (size_t)u.j * sb + (size_t)u.pn * tstep; }
    __device__ __forceinline__ void a_ready(const Unit&) const {}
    __device__ __forceinline__ void done(const Unit&) const {}
};
typedef float f32x2_t __attribute__((ext_vector_type(2))); typedef __bf16 bf16x2_t __attribute__((ext_vector_type(2)));
__device__ __forceinline__ unsigned cvt_pk_bf16(float lo, float hi) { f32x2_t v = {lo, hi}; bf16x2_t b = __builtin_convertvector(v, bf16x2_t); return __builtin_bit_cast(unsigned, b); }
typedef float f32x2 __attribute__((ext_vector_type(2)));

typedef unsigned u32x2 __attribute__((ext_vector_type(2)));
__device__ __forceinline__ float bflo(unsigned w) { return __uint_as_float(w << 16); }
__device__ __forceinline__ float bfhi(unsigned w) { return __uint_as_float(w & 0xffff0000u); }
template <int ACT> __device__ __forceinline__ f32x4 act4(f32x4 v) {
    if (ACT == 1) { f32x4 o; for (int e = 0; e < 4; ++e) o[e] = __builtin_amdgcn_rcpf(1.f + __expf(-v[e])); return o; }
    if (ACT == 2) { f32x4 o; for (int e = 0; e < 4; ++e) { const float r = fmaxf(v[e], 0.f); o[e] = r * r; } return o; }
    return v;
}
template <int ACT> struct EpiStore {
    static constexpr bool PERM = true, AFTER_DRAIN = false;
    bf16_t* O; const float* bias; float* S32; int ldc, small_pn;
    __device__ __forceinline__ void operator()(const f32x4 (&acc)[2][2][4][2], const Unit& u, int wr, int wc, int fr, int fq) const {
        asm volatile("s_waitcnt vmcnt(0)" ::: "memory");
        const int row0 = u.pm * BM + wr * 64 + fr, col0 = u.pn * BM + wc * 32 + 8 * fq;
        if (u.pn == small_pn) {
            if (wc == 0) {
                const f32x4 b0 = *(const f32x4*)(bias + col0), b1 = *(const f32x4*)(bias + col0 + 4);
#pragma unroll
                for (int ai = 0; ai < 2; ++ai)
#pragma unroll
                    for (int m = 0; m < 4; ++m) { float* rp = S32 + (size_t)(row0 + ai * HALF + m * 16) * 32 + 8 * fq;
                        *(f32x4*)rp = acc[ai][0][m][0] + acc[ai][1][m][0] + b0; *(f32x4*)(rp + 4) = acc[ai][0][m][1] + acc[ai][1][m][1] + b1; }
            }
            return;
        }
        f32x4 bv[2][2];
#pragma unroll
        for (int bj = 0; bj < 2; ++bj)
#pragma unroll
            for (int n = 0; n < 2; ++n) bv[bj][n] = bias ? *(const f32x4*)(bias + col0 + bj * HALF + 4 * n) : (f32x4){0.f, 0.f, 0.f, 0.f};
#pragma unroll
        for (int ai = 0; ai < 2; ++ai)
#pragma unroll
            for (int m = 0; m < 4; ++m) { bf16_t* rowp = O + (size_t)(row0 + ai * HALF + m * 16) * ldc + col0;
#pragma unroll
                for (int bj = 0; bj < 2; ++bj) { const f32x4 v0 = act4<ACT>(acc[ai][bj][m][0] + bv[bj][0]), v1 = act4<ACT>(acc[ai][bj][m][1] + bv[bj][1]);
                    u32x4 w; w.x = cvt_pk_bf16(v0[0], v0[1]); w.y = cvt_pk_bf16(v0[2], v0[3]); w.z = cvt_pk_bf16(v1[0], v1[1]); w.w = cvt_pk_bf16(v1[2], v1[3]);
                    *(u32x4*)(rowp + bj * HALF) = w; } }
    }
};
struct EpiMergeG {
    static constexpr bool PERM = true, AFTER_DRAIN = false;
    const bf16_t* G; bf16_t* Mp; bf16_t* Mb;
    template <bool HASP>
    __device__ __forceinline__ void body(const f32x4 (&acc)[2][2][4][2], int j, bf16_t* dst, size_t dpitch, int row0, int col0) const {
        constexpr size_t mpitch = 2048;
#pragma unroll
        for (int ai = 0; ai < 2; ++ai) { u32x4 gw[4][2], pw[4][2];
#pragma unroll
            for (int m = 0; m < 4; ++m)
#pragma unroll
                for (int bj = 0; bj < 2; ++bj) { const size_t row = (size_t)(row0 + ai * HALF + m * 16); const int col = col0 + bj * HALF;
                    gw[m][bj] = *(const u32x4*)(G + row * 4096 + j * 1024 + col); if (HASP) pw[m][bj] = *(const u32x4*)(Mp + row * mpitch + col); }
#pragma unroll
            for (int m = 0; m < 4; ++m)
#pragma unroll
                for (int bj = 0; bj < 2; ++bj) { const size_t row = (size_t)(row0 + ai * HALF + m * 16); const int col = col0 + bj * HALF; const u32x4 g4 = gw[m][bj];
                    f32x4 v0 = (f32x4){bflo(g4.x), bfhi(g4.x), bflo(g4.y), bfhi(g4.y)} * acc[ai][bj][m][0], v1 = (f32x4){bflo(g4.z), bfhi(g4.z), bflo(g4.w), bfhi(g4.w)} * acc[ai][bj][m][1];
                    if (HASP) { const u32x4 p4 = pw[m][bj]; v0 += (f32x4){bflo(p4.x), bfhi(p4.x), bflo(p4.y), bfhi(p4.y)}; v1 += (f32x4){bflo(p4.z), bfhi(p4.z), bflo(p4.w), bfhi(p4.w)}; }
                    u32x4 w; w.x = cvt_pk_bf16(v0[0], v0[1]); w.y = cvt_pk_bf16(v0[2], v0[3]); w.z = cvt_pk_bf16(v1[0], v1[1]); w.w = cvt_pk_bf16(v1[2], v1[3]); *(u32x4*)(dst + row * dpitch + col) = w; } }
    }
    __device__ __forceinline__ void operator()(const f32x4 (&acc)[2][2][4][2], const Unit& u, int wr, int wc, int fr, int fq) const {
        const int j = u.j;
        asm volatile("s_waitcnt vmcnt(0)" ::: "memory");
        const int row0 = u.pm * BM + wr * 64 + fr, col0 = u.pn * BM + wc * 32 + 8 * fq;
        if (j == 0) body<false>(acc, 0, Mp, 2048, row0, col0);
        else if (j == 1) body<true>(acc, 1, Mp, 2048, row0, col0);
        else body<true>(acc, 2, Mb, 1024, row0, col0);
    }
};
struct EpiResidF {
    static constexpr bool PERM = true, AFTER_DRAIN = false;
    const float* X; float* O;
    __device__ __forceinline__ void operator()(const f32x4 (&acc)[2][2][4][2], const Unit& u, int wr, int wc, int fr, int fq) const {
        asm volatile("s_waitcnt vmcnt(0)" ::: "memory");
        const int row0 = u.pm * BM + wr * 64 + fr, col0 = u.pn * BM + wc * 32 + 8 * fq;
#pragma unroll
        for (int ai = 0; ai < 2; ++ai)
#pragma unroll
            for (int m = 0; m < 4; ++m) { const size_t off = (size_t)(row0 + ai * HALF + m * 16) * 1024 + col0;
#pragma unroll
                for (int bj = 0; bj < 2; ++bj) { const f32x4 x0 = *(const f32x4*)(X + off + bj * HALF), x1 = *(const f32x4*)(X + off + bj * HALF + 4);
                    *(f32x4*)(O + off + bj * HALF) = x0 + acc[ai][bj][m][0]; *(f32x4*)(O + off + bj * HALF + 4) = x1 + acc[ai][bj][m][1]; } }
    }
};
struct EpiResRms {
    static constexpr bool PERM = false, AFTER_DRAIN = true;
    const float* R; float* Hout; float* Nf; bf16_t* Nb; const float* gain; float* xbuf; unsigned* cnt;
    __device__ __forceinline__ void fused(f32x4 (&acc)[2][2][4][2], const Unit& u, int wr, int wc, int fr, int fq, PG8_LAS unsigned char* lds, int wid, int lane) const {
        PG8_LAS float* Pp = (PG8_LAS float*)lds; PG8_LAS float* S = (PG8_LAS float*)(lds + 4096);
        const int col0 = u.pn * BM + wc * 32 + 4 * fq;
#pragma unroll
        for (int ai = 0; ai < 2; ++ai) { f32x4 pre[4][2][2];
#pragma unroll
            for (int m = 0; m < 4; ++m) { const size_t off = (size_t)(u.pm * BM + ai * HALF + wr * 64 + m * 16 + fr) * 1024 + col0;
#pragma unroll
                for (int bj = 0; bj < 2; ++bj)
#pragma unroll
                    for (int n = 0; n < 2; ++n) pre[m][bj][n] = *(const f32x4*)(R + off + bj * HALF + n * 16); }
#pragma unroll
            for (int m = 0; m < 4; ++m) { float sq = 0.f;
#pragma unroll
                for (int bj = 0; bj < 2; ++bj)
#pragma unroll
                    for (int n = 0; n < 2; ++n) { const f32x4 v = acc[ai][bj][m][n] + pre[m][bj][n]; acc[ai][bj][m][n] = v; sq += (v[0] * v[0] + v[1] * v[1]) + (v[2] * v[2] + v[3] * v[3]); }
                sq += __shfl_xor(sq, 16); sq += __shfl_xor(sq, 32);
                if (fq == 0) Pp[(ai * HALF + wr * 64 + m * 16 + fr) * 4 + wc] = sq; } }
        asm volatile("s_waitcnt lgkmcnt(0)" ::: "memory"); __builtin_amdgcn_s_barrier(); asm volatile("" ::: "memory");
        const int row = wid * 32 + (lane & 31);
        if (lane < 32) { const float tot = (Pp[row * 4 + 0] + Pp[row * 4 + 1]) + (Pp[row * 4 + 2] + Pp[row * 4 + 3]);
            __hip_atomic_store(xbuf + ((size_t)(u.pm * BM + row) * 4 + u.pn), tot, __ATOMIC_RELAXED, __HIP_MEMORY_SCOPE_AGENT); }
        asm volatile("s_waitcnt vmcnt(0)" ::: "memory");
        if (lane == 0) __hip_atomic_fetch_add(cnt + 64 * u.pm, 1u, __ATOMIC_RELAXED, __HIP_MEMORY_SCOPE_AGENT);
        if (wid == 0) { unsigned sp = 0;
            while ((unsigned)__builtin_amdgcn_readfirstlane(__hip_atomic_load(cnt + 64 * u.pm, __ATOMIC_RELAXED, __HIP_MEMORY_SCOPE_AGENT)) < 32u) { __builtin_amdgcn_s_sleep(2); if (++sp > (1u << 22)) break; }
            __builtin_amdgcn_fence(__ATOMIC_ACQUIRE, "agent"); }
        asm volatile("s_waitcnt vmcnt(0) lgkmcnt(0)" ::: "memory"); __builtin_amdgcn_s_barrier(); asm volatile("" ::: "memory");
        if (lane < 32) { const float* slot = xbuf + (size_t)(u.pm * BM + row) * 4; float t = 0.f;
#pragma unroll
            for (int q = 0; q < 4; ++q) t += __hip_atomic_load(slot + q, __ATOMIC_RELAXED, __HIP_MEMORY_SCOPE_AGENT);
            S[row] = rsqrtf(t * (1.0f / 1024.0f) + 1e-6f); }
        asm volatile("s_waitcnt lgkmcnt(0)" ::: "memory"); __builtin_amdgcn_s_barrier(); asm volatile("" ::: "memory");
        f32x4 gv[2][2];
#pragma unroll
        for (int bj = 0; bj < 2; ++bj)
#pragma unroll
            for (int n = 0; n < 2; ++n) gv[bj][n] = *(const f32x4*)(gain + col0 + bj * HALF + n * 16);
#pragma unroll
        for (int ai = 0; ai < 2; ++ai)
#pragma unroll
            for (int m = 0; m < 4; ++m) { const int r = ai * HALF + wr * 64 + m * 16 + fr; const float rs = S[r]; const size_t off = (size_t)(u.pm * BM + r) * 1024 + col0;
#pragma unroll
                for (int bj = 0; bj < 2; ++bj)
#pragma unroll
                    for (int n = 0; n < 2; ++n) { const f32x4 v = acc[ai][bj][m][n]; const f32x4 o = v * rs * gv[bj][n];
                        if (Hout) *(f32x4*)(Hout + off + bj * HALF + n * 16) = v;
                        if (Nf) *(f32x4*)(Nf + off + bj * HALF + n * 16) = o;
                        if (Nb) { u32x2 w; w.x = cvt_pk_bf16(o[0], o[1]); w.y = cvt_pk_bf16(o[2], o[3]); *(u32x2*)(Nb + off + bj * HALF + n * 16) = w; } } }
    }
};

template <class Epi, class Sched, bool ALIGN_EPI = false, bool SP2 = false>
__device__ __forceinline__ void gemm_phase(PG8_LAS unsigned char* lds, const Gemm g, const Sched& S, const Epi& E) {
    const int tid = threadIdx.x, wid = __builtin_amdgcn_readfirstlane(tid >> 6), lane = tid & 63, wr = wid >> 2, wc = wid & 3, fr = lane & 15, fq = lane >> 4;
    const int K = g.K, nt = K / BK;
    unsigned voffA[2], voffB[2];
#pragma unroll
    for (int i = 0; i < 2; ++i) { int R, C; stage_rc(tid * 16 + i * 8192, R, C); const int Rb = Epi::PERM ? ((R & ~31) + perm32(R & 31)) : R;
        voffA[i] = (unsigned)(R * K + C) * 2u; voffB[i] = (unsigned)(Rb * K + C) * 2u; }
    const size_t kstep = (size_t)(BK * 2);
    const size_t hstep = (size_t)HALF * K * 2;
    const size_t tstep = 2 * hstep;
    const unsigned ldsw = (unsigned)wid * 1024u;
    const int aoff = lds_byte(wr * 64 + fr, fq * 8), boff = lds_byte(wc * 32 + fr, fq * 8);
#define PG8_SA(b, h) (((b) * 2 + (h)) * HTB)
#define PG8_SB(b, h) ((4 + (b) * 2 + (h)) * HTB)
#define PG8_STAGE(bufoff, gbase, voff) do { _Pragma("unroll") for (int _i = 0; _i < 2; ++_i) \
        __builtin_amdgcn_global_load_lds((const unsigned*)((const char*)(gbase) + (voff)[_i]), (PG8_LAS unsigned*)(lds + (bufoff) + ldsw + _i * 8192), 16, 0, 0); } while (0)
#define PG8_LDA(dst, b, h) do { _Pragma("unroll") for (int m = 0; m < 4; ++m) _Pragma("unroll") for (int k = 0; k < 2; ++k) dst[m][k] = *(const PG8_LAS bf16x8*)(lds + PG8_SA(b, h) + aoff + m * 2048 + k * 1024); } while (0)
#define PG8_LDB(dst, b, h) do { _Pragma("unroll") for (int n = 0; n < 2; ++n) _Pragma("unroll") for (int k = 0; k < 2; ++k) dst[n][k] = *(const PG8_LAS bf16x8*)(lds + PG8_SB(b, h) + boff + n * 2048 + k * 1024); } while (0)
#define PG8_MMA(ai, bj, At, Bt) do { __builtin_amdgcn_s_setprio(1); _Pragma("unroll") for (int m = 0; m < 4; ++m) _Pragma("unroll") for (int n = 0; n < 2; ++n) _Pragma("unroll") for (int k = 0; k < 2; ++k) \
        acc[ai][bj][m][n] = __builtin_amdgcn_mfma_f32_16x16x32_bf16(Bt[n][k], At[m][k], acc[ai][bj][m][n], 0, 0, 0); __builtin_amdgcn_s_setprio(0); } while (0)
#define PG8_WAIT_V(n) asm volatile("s_waitcnt vmcnt(" #n ")" ::: "memory")
#define PG8_WAIT_L(n) asm volatile("s_waitcnt lgkmcnt(" #n ")" ::: "memory")
#define PG8_BAR __builtin_amdgcn_s_barrier()
#define PG8_SCHED __builtin_amdgcn_sched_barrier(0)
    Unit cur, nxt; int ui = 0;
    if (!S.next(0, cur)) return;
    f32x4 acc[2][2][4][2];
#pragma unroll
    for (int a = 0; a < 2; ++a)
#pragma unroll
        for (int b = 0; b < 2; ++b)
#pragma unroll
            for (int m = 0; m < 4; ++m)
#pragma unroll
                for (int n = 0; n < 2; ++n) acc[a][b][m][n] = (f32x4){0.f, 0.f, 0.f, 0.f};
    bf16x8 At[4][2], B0[2][2], B1[2][2];
    const char* cA = S.pa(g, cur, tstep); const char* cB = S.pb(g, cur, tstep);
    S.a_ready(cur);
    if constexpr (SP2) {
        PG8_STAGE(PG8_SB(0, 0), cB, voffB); PG8_STAGE(PG8_SB(0, 1), cB + hstep, voffB); PG8_STAGE(PG8_SA(0, 0), cA, voffA); PG8_STAGE(PG8_SA(0, 1), cA + hstep, voffA);
        if (wr == 1) PG8_BAR;
        PG8_WAIT_V(2); PG8_BAR;
        PG8_STAGE(PG8_SB(1, 0), cB + kstep, voffB); PG8_STAGE(PG8_SA(1, 0), cA + kstep, voffA); PG8_STAGE(PG8_SB(1, 1), cB + hstep + kstep, voffB);
        PG8_WAIT_V(6); PG8_BAR;
    } else {
        PG8_STAGE(PG8_SB(0, 0), cB, voffB); PG8_STAGE(PG8_SA(0, 0), cA, voffA); PG8_STAGE(PG8_SB(0, 1), cB + hstep, voffB); PG8_STAGE(PG8_SA(0, 1), cA + hstep, voffA);
        if (wr == 1) PG8_BAR;
        PG8_WAIT_V(4); PG8_BAR;
        PG8_STAGE(PG8_SB(1, 0), cB + kstep, voffB); PG8_STAGE(PG8_SA(1, 0), cA + kstep, voffA); PG8_STAGE(PG8_SB(1, 1), cB + hstep + kstep, voffB);
        PG8_WAIT_V(6); PG8_BAR;
    }
    for (;;) {
        const bool has_next = S.next(ui + 1, nxt);
        const char* nA = has_next ? S.pa(g, nxt, tstep) : cA; const char* nB = has_next ? S.pb(g, nxt, tstep) : cB;
        for (int t = 0; t < nt; t += 2) {
            const bool last = (t == nt - 2);
            const char* a1 = cA + (size_t)(t + 1) * kstep;
            const char* a2 = last ? nA : cA + (size_t)(t + 2) * kstep; const char* b2 = last ? nB : cB + (size_t)(t + 2) * kstep;
            const char* a3 = a2 + kstep; const char* b3 = b2 + kstep;
            if (last && has_next) S.a_ready(nxt);
            if constexpr (SP2) {
            PG8_LDB(B0, 0, 0); PG8_LDB(B1, 0, 1); PG8_SCHED; PG8_LDA(At, 0, 0); PG8_STAGE(PG8_SA(1, 1), a1 + hstep, voffA);
            PG8_WAIT_V(8); PG8_WAIT_L(0); PG8_BAR; PG8_MMA(0, 0, At, B0); PG8_MMA(0, 1, At, B1); PG8_BAR; PG8_SCHED;
            PG8_LDA(At, 0, 1); PG8_STAGE(PG8_SB(0, 0), b2, voffB); PG8_STAGE(PG8_SB(0, 1), b2 + hstep, voffB); PG8_STAGE(PG8_SA(0, 0), a2, voffA);
            PG8_WAIT_V(8); PG8_WAIT_L(0); PG8_BAR; PG8_MMA(1, 0, At, B0); PG8_MMA(1, 1, At, B1); PG8_BAR; PG8_SCHED;
            PG8_LDB(B0, 1, 0); PG8_LDB(B1, 1, 1); PG8_SCHED; PG8_LDA(At, 1, 0); PG8_STAGE(PG8_SA(0, 1), a2 + hstep, voffA);
            PG8_WAIT_V(8); PG8_WAIT_L(0); PG8_BAR; PG8_MMA(0, 0, At, B0); PG8_MMA(0, 1, At, B1); PG8_BAR; PG8_SCHED;
            PG8_LDA(At, 1, 1); PG8_STAGE(PG8_SB(1, 0), b3, voffB); PG8_STAGE(PG8_SB(1, 1), b3 + hstep, voffB); PG8_STAGE(PG8_SA(1, 0), a3, voffA);
            PG8_WAIT_V(8); PG8_WAIT_L(0); PG8_BAR; PG8_MMA(1, 0, At, B0); PG8_MMA(1, 1, At, B1); PG8_BAR; PG8_SCHED;
            } else {
            PG8_LDB(B0, 0, 0); PG8_SCHED; PG8_LDA(At, 0, 0); PG8_STAGE(PG8_SA(1, 1), a1 + hstep, voffA);
            PG8_WAIT_L(8); PG8_BAR; PG8_WAIT_L(0); PG8_MMA(0, 0, At, B0); PG8_BAR; PG8_SCHED;
            PG8_LDB(B1, 0, 1); PG8_STAGE(PG8_SB(0, 0), b2, voffB);
            PG8_BAR; PG8_WAIT_L(0); PG8_MMA(0, 1, At, B1); PG8_BAR;
            PG8_LDA(At, 0, 1); PG8_STAGE(PG8_SA(0, 0), a2, voffA);
            PG8_BAR; PG8_WAIT_L(0); PG8_MMA(1, 0, At, B0); PG8_BAR; PG8_SCHED;
            PG8_STAGE(PG8_SB(0, 1), b2 + hstep, voffB);
            PG8_WAIT_V(6); PG8_BAR; PG8_MMA(1, 1, At, B1); PG8_BAR;
            PG8_LDB(B0, 1, 0); PG8_SCHED; PG8_LDA(At, 1, 0); PG8_STAGE(PG8_SA(0, 1), a2 + hstep, voffA);
            PG8_WAIT_L(8); PG8_BAR; PG8_WAIT_L(0); PG8_MMA(0, 0, At, B0); PG8_BAR; PG8_SCHED;
            PG8_LDB(B1, 1, 1); PG8_STAGE(PG8_SB(1, 0), b3, voffB);
            PG8_BAR; PG8_WAIT_L(0); PG8_MMA(0, 1, At, B1); PG8_BAR;
            PG8_LDA(At, 1, 1); PG8_STAGE(PG8_SA(1, 0), a3, voffA);
            PG8_BAR; PG8_WAIT_L(0); PG8_MMA(1, 0, At, B0); PG8_BAR; PG8_SCHED;
            PG8_STAGE(PG8_SB(1, 1), b3 + hstep, voffB);
            PG8_WAIT_V(6); PG8_BAR; PG8_MMA(1, 1, At, B1); PG8_BAR;
            }
        }
        if constexpr (ALIGN_EPI) { if (wr == 0) PG8_BAR; }
        if constexpr (!Epi::AFTER_DRAIN) { E(acc, cur, wr, wc, fr, fq); S.done(cur); }
        if (!has_next) break;
#pragma unroll
        for (int a = 0; a < 2; ++a)
#pragma unroll
            for (int b = 0; b < 2; ++b)
#pragma unroll
                for (int m = 0; m < 4; ++m)
#pragma unroll
                    for (int n = 0; n < 2; ++n) acc[a][b][m][n] = (f32x4){0.f, 0.f, 0.f, 0.f};
        cur = nxt; cA = nA; cB = nB; ++ui;
        if constexpr (ALIGN_EPI) { if (wr == 1) PG8_BAR; }
    }
    PG8_WAIT_V(0);
    if constexpr (!ALIGN_EPI) { if (wr == 0) PG8_BAR; }
    PG8_BAR;
    if constexpr (Epi::AFTER_DRAIN) { E.fused(acc, cur, wr, wc, fr, fq, lds, wid, lane); S.done(cur); }
#undef PG8_SA
#undef PG8_SB
#undef PG8_STAGE
#undef PG8_LDA
#undef PG8_LDB
#undef PG8_MMA
#undef PG8_WAIT_V
#undef PG8_WAIT_L
#undef PG8_BAR
#undef PG8_SCHED
}
}

namespace nsa {
#define NLAS __attribute__((address_space(3)))
typedef short bf16x8 __attribute__((ext_vector_type(8)));
typedef short s16x4 __attribute__((ext_vector_type(4)));
typedef short v4i16_t __attribute__((ext_vector_type(4)));
typedef float f32x4 __attribute__((ext_vector_type(4)));
typedef unsigned u32x4 __attribute__((ext_vector_type(4)));
typedef unsigned u32x2 __attribute__((ext_vector_type(2)));
typedef unsigned long long u64;
constexpr int RS = 144, TILE_B = 64 * RS;
constexpr float LOG2E = 1.4426950408889634f;
constexpr int L_KB0 = 0, L_VB0 = TILE_B, L_KB1 = 2 * TILE_B, L_VB1 = 3 * TILE_B, L_CK = 4 * TILE_B, L_CV = 8 * TILE_B, L_IMP = 12 * TILE_B, L_MSK = L_IMP + 8192, L_WU = L_MSK + 256, L_END = L_WU + 64;
static_assert(L_END <= 131072, "nsa LDS map");
__device__ __forceinline__ s16x4 vtr(const NLAS char* p) { return __builtin_bit_cast(s16x4, __builtin_amdgcn_ds_read_tr16_b64_v4i16((NLAS v4i16_t*)p)); }
__device__ __forceinline__ f32x4 mfma16(bf16x8 a, bf16x8 b, f32x4 c) { return __builtin_amdgcn_mfma_f32_16x16x32_bf16(a, b, c, 0, 0, 0); }
__device__ __forceinline__ unsigned pkbf(float lo, float hi) { return pg8::cvt_pk_bf16(lo, hi); }
__device__ __forceinline__ void qk_tile(f32x4 (&s)[4], const NLAS char* Kb, const bf16x8 (&qf)[2], int i, int g, float kslope, float bt) {
    bf16x8 a[4][2]; const NLAS char* kp = Kb + i * RS + 16 * g;
#pragma unroll
    for (int kb = 0; kb < 4; ++kb) { a[kb][0] = *(const NLAS bf16x8*)(kp + kb * 16 * RS); a[kb][1] = *(const NLAS bf16x8*)(kp + kb * 16 * RS + 64); }
#pragma unroll
    for (int kb = 0; kb < 4; ++kb) { f32x4 ci; ci[0] = fmaf(kslope, (float)(kb * 16 + 0), bt); ci[1] = fmaf(kslope, (float)(kb * 16 + 1), bt); ci[2] = fmaf(kslope, (float)(kb * 16 + 2), bt); ci[3] = fmaf(kslope, (float)(kb * 16 + 3), bt);
        s[kb] = mfma16(a[kb][0], qf[0], ci); }
#pragma unroll
    for (int kb = 0; kb < 4; ++kb) s[kb] = mfma16(a[kb][1], qf[1], s[kb]);
}
__device__ __forceinline__ void pv_tile(f32x4 (&o)[4], const NLAS char* Vb, const f32x4 (&p)[4], int i, int g) {
    const NLAS char* vb = Vb + (4 * g + (i >> 2)) * RS + (i & 3) * 8;
    s16x4 lo[2][4], hi[2][4];
#pragma unroll
    for (int kk = 0; kk < 2; ++kk)
#pragma unroll
        for (int db = 0; db < 4; ++db) { const NLAS char* vp = vb + (2 * kk) * 16 * RS + db * 32; lo[kk][db] = vtr(vp); hi[kk][db] = vtr(vp + 16 * RS); }
    bf16x8 pf[2];
#pragma unroll
    for (int kk = 0; kk < 2; ++kk) { u32x4 pw; pw.x = pkbf(p[2 * kk][0], p[2 * kk][1]); pw.y = pkbf(p[2 * kk][2], p[2 * kk][3]); pw.z = pkbf(p[2 * kk + 1][0], p[2 * kk + 1][1]); pw.w = pkbf(p[2 * kk + 1][2], p[2 * kk + 1][3]);
        pf[kk] = __builtin_bit_cast(bf16x8, pw); }
#pragma unroll
    for (int kk = 0; kk < 2; ++kk)
#pragma unroll
        for (int db = 0; db < 4; ++db) o[db] = mfma16((bf16x8){lo[kk][db][0], lo[kk][db][1], lo[kk][db][2], lo[kk][db][3], hi[kk][db][0], hi[kk][db][1], hi[kk][db][2], hi[kk][db][3]}, pf[kk], o[db]);
}
constexpr float THR = 6.0f;
template <bool FIRST>
__device__ __forceinline__ float online_tile(f32x4 (&s)[4], float& m, float& l, f32x4 (&o)[4], bool needmask, int base, int lo, int hi) {
    float fret = 1.f;
    if (needmask) {
#pragma unroll
        for (int kb = 0; kb < 4; ++kb)
#pragma unroll
            for (int r = 0; r < 4; ++r) { const int pos = base + kb * 16 + r; s[kb][r] = (pos >= lo && pos <= hi) ? s[kb][r] : -INFINITY; } }
    float mt = fmaxf(fmaxf(fmaxf(s[0][0], s[0][1]), fmaxf(s[0][2], s[0][3])), fmaxf(fmaxf(s[1][0], s[1][1]), fmaxf(s[1][2], s[1][3])));
    mt = fmaxf(mt, fmaxf(fmaxf(fmaxf(s[2][0], s[2][1]), fmaxf(s[2][2], s[2][3])), fmaxf(fmaxf(s[3][0], s[3][1]), fmaxf(s[3][2], s[3][3]))));
    if (FIRST || __any(mt > THR)) {
        mt = fmaxf(mt, __shfl_xor(mt, 16)); mt = fmaxf(mt, __shfl_xor(mt, 32));
        const float d = FIRST ? ((mt == -INFINITY) ? 0.f : mt) : fmaxf(mt, 0.f), f = __builtin_amdgcn_exp2f(-d); m += d; l *= f; fret = f;
#pragma unroll
        for (int db = 0; db < 4; ++db) o[db] = o[db] * f;
#pragma unroll
        for (int kb = 0; kb < 4; ++kb) s[kb] = s[kb] - d; }
    float sum = 0.f;
#pragma unroll
    for (int kb = 0; kb < 4; ++kb)
#pragma unroll
        for (int r = 0; r < 4; ++r) { const float p = __builtin_amdgcn_exp2f(s[kb][r]); s[kb][r] = p; sum += p; }
    l += sum;
    return fret;
}
struct Stg { u32x4 k, v; };
__device__ __forceinline__ void stg_load(Stg& r, const bf16_t* kb, const bf16_t* vb, size_t pitch, int tid) { const size_t off = (size_t)(tid >> 3) * pitch + (tid & 7) * 8; r.k = *(const u32x4*)(kb + off); r.v = *(const u32x4*)(vb + off); }
__device__ __forceinline__ void stg_store(NLAS char* lds, int ko, int vo, const Stg& r, int tid) { const int off = (tid >> 3) * RS + (tid & 7) * 16; *(NLAS u32x4*)(lds + ko + off) = r.k; *(NLAS u32x4*)(lds + vo + off) = r.v; }
template <bool FIRST>
__device__ __forceinline__ void pair_tiles(const NLAS char* lds, int koA, int voA, int koB, int voB, bool na, bool nb, const bf16x8 (&qf)[2], int i, int g, float slope2,
                                           float btA, float btB, bool maskA, bool maskB, int baseA, int baseB, int lo, int hi, float& m, float& l, f32x4 (&o)[4]) {
    f32x4 sa[4], sb[4];
    if (na) qk_tile(sa, lds + koA, qf, i, g, slope2, btA - m);
    if (nb) qk_tile(sb, lds + koB, qf, i, g, slope2, btB - m);
    float da = 0.f;
    if (na) { const float m0 = m; online_tile<FIRST>(sa, m, l, o, FIRST || maskA, baseA, lo, hi); da = m - m0; pv_tile(o, lds + voA, sa, i, g); }
    if (nb) { if (__any(da != 0.f)) {
#pragma unroll
            for (int kb = 0; kb < 4; ++kb) sb[kb] = sb[kb] - da; }
        online_tile<false>(sb, m, l, o, maskB, baseB, lo, hi); pv_tile(o, lds + voB, sb, i, g); }
}
__device__ __forceinline__ float sigm(float v) { return __builtin_amdgcn_rcpf(1.f + __expf(-v)); }

__device__ __forceinline__ void unit(NLAS char* lds, const bf16_t* P, const float* S32, const bf16_t* KC, const bf16_t* VC, bf16_t* Ynsa, int b, int gq, int ti) {
    const int tid = threadIdx.x, lane = tid & 63, w = __builtin_amdgcn_readfirstlane(tid >> 6), i = lane & 15, g = lane >> 4;
    const int t0 = ti * 32, tl_mine = i >> 2, r = i & 3, h = gq * 4 + r, t = t0 + 4 * w + tl_mine; const size_t m = (size_t)b * T + t;
    const float slope2 = __builtin_amdgcn_exp2f(-(float)(h + 1)) * LOG2E;
    bf16x8 qf[2]; constexpr float QS = 0.125f * LOG2E;
    { const bf16_t* qp = P + m * PW + P_NSQ + h * 64 + 8 * g;
#pragma unroll
      for (int ks = 0; ks < 2; ++ks) { const u32x4 raw = *(const u32x4*)(qp + 32 * ks); u32x4 sc;
          sc.x = pkbf(pg8::bflo(raw.x) * QS, pg8::bfhi(raw.x) * QS); sc.y = pkbf(pg8::bflo(raw.y) * QS, pg8::bfhi(raw.y) * QS);
          sc.z = pkbf(pg8::bflo(raw.z) * QS, pg8::bfhi(raw.z) * QS); sc.w = pkbf(pg8::bflo(raw.w) * QS, pg8::bfhi(raw.w) * QS);
          qf[ks] = __builtin_bit_cast(bf16x8, sc); } }
    const float* gp = S32 + m * 32 + 8 + h * 3;
    const float gate0 = sigm(gp[0]), gate1 = sigm(gp[1]), gate2 = sigm(gp[2]);
    f32x4 outacc[4];
#pragma unroll
    for (int db = 0; db < 4; ++db) outacc[db] = (f32x4){0.f, 0.f, 0.f, 0.f};
    const int ntc = (ti >> 5) + 1;
    { Stg sc_[4];
#pragma unroll
      for (int tile = 0; tile < 4; ++tile) if (tile < ntc) { const size_t row0 = ((size_t)(b * 256 + tile * 64) * 2 + gq) * 64; stg_load(sc_[tile], KC + row0, VC + row0, 128, tid); }
#pragma unroll
      for (int tile = 0; tile < 4; ++tile) if (tile < ntc) stg_store(lds, L_CK + tile * TILE_B, L_CV + tile * TILE_B, sc_[tile], tid); }
    __syncthreads();
    { const int nmax = (t - 31) >> 4, nmax_w = ((t0 + 4 * w) - 31) >> 4; const float kslope = 16.f * slope2, c = -slope2 * (float)(t - 31);
      float mc = 0.f, lc = 0.f; f32x4 oc[4]; float av[16], cv[16];
#pragma unroll
      for (int db = 0; db < 4; ++db) oc[db] = (f32x4){0.f, 0.f, 0.f, 0.f};
#pragma unroll
      for (int q = 0; q < 16; ++q) { av[q] = 0.f; cv[q] = 0.f; }
      bool firstc = true;
#pragma unroll
      for (int tile = 3; tile >= 0; --tile) {
          if (tile < ntc) { f32x4 s[4]; qk_tile(s, lds + L_CK + tile * TILE_B, qf, i, g, kslope, fmaf(kslope, (float)(tile * 64 + 4 * g), c) - mc);
              const bool needmask = (tile * 64 + 63 > nmax_w);
              const float f = firstc ? online_tile<true>(s, mc, lc, oc, needmask, tile * 64 + 4 * g, -0x40000000, nmax) : online_tile<false>(s, mc, lc, oc, needmask, tile * 64 + 4 * g, -0x40000000, nmax);
              if (!firstc && __any(f != 1.f)) {
#pragma unroll
                  for (int q = 0; q < 16; ++q) { av[q] *= f; cv[q] *= f; } }
              firstc = false;
              pv_tile(oc, lds + L_CV + tile * TILE_B, s, i, g);
#pragma unroll
              for (int kb = 0; kb < 4; ++kb) { const f32x4 pv = s[kb];
                  float a = (pv[0] + pv[1]) + (pv[2] + pv[3]), cc = pv[3];
                  a += __shfl_xor(a, 1); a += __shfl_xor(a, 2); cc += __shfl_xor(cc, 1); cc += __shfl_xor(cc, 2);
                  av[tile * 4 + kb] = a; cv[tile * 4 + kb] = cc; } }
      }
      lc += __shfl_xor(lc, 16); lc += __shfl_xor(lc, 32);
      const float inv = lc > 0.f ? 1.f / lc : 0.f, g0i = gate0 * inv;
#pragma unroll
      for (int db = 0; db < 4; ++db) outacc[db] = outacc[db] + oc[db] * g0i;
      NLAS float* imp_s = (NLAS float*)(lds + L_IMP) + (w * 4 + tl_mine) * 64;
      float cprev = 0.f;
#pragma unroll
      for (int q = 0; q < 16; ++q) { const float up = __shfl(cv[q], (lane + 48) & 63); const float im = (av[q] + (g > 0 ? up : cprev)) * inv; cprev = up; if (r == 0) imp_s[4 * q + g] = im; }
    }
    NLAS float* impw = (NLAS float*)(lds + L_IMP) + w * 256;
    float myscore[4];
    asm volatile("s_waitcnt lgkmcnt(0)" ::: "memory");
#pragma unroll
    for (int tl = 0; tl < 4; ++tl) { const int tt = t0 + 4 * w + tl, cur = tt >> 6, j = lane; const bool valid = j <= cur, forced = (j == 0) || (j == cur) || (j == cur - 1);
        const float s = valid ? impw[tl * 64 + j] + (forced ? 1000.f : 0.f) : -1e30f; myscore[tl] = s; }
    u64 wmask[4], wun = 0ull;
#pragma unroll
    for (int tl = 0; tl < 4; ++tl) { const int tt = t0 + 4 * w + tl, cur = tt >> 6; const bool valid = lane <= cur;
        const unsigned key = valid ? ((__builtin_bit_cast(unsigned, myscore[tl]) & ~63u) | (unsigned)(63 - lane)) : 0u; unsigned rank = 0;
#pragma unroll
        for (int jj = 0; jj < 64; ++jj) { const unsigned o = (unsigned)__builtin_amdgcn_readlane((int)key, jj); rank += (o > key) ? 1u : 0u; }
        wmask[tl] = __ballot(rank < 16u && valid); wun |= wmask[tl]; }
    if (lane == 0) { NLAS u64* mk = (NLAS u64*)(lds + L_MSK) + w * 4; mk[0] = wmask[0]; mk[1] = wmask[1]; mk[2] = wmask[2]; mk[3] = wmask[3]; ((NLAS u64*)(lds + L_WU))[w] = wun; }
    __syncthreads();
    const u64 mymask = ((const NLAS u64*)(lds + L_MSK))[w * 4 + tl_mine];
    u64 uall = 0ull;
#pragma unroll
    for (int ww = 0; ww < 8; ++ww) uall |= ((const NLAS u64*)(lds + L_WU))[ww];
    uall = ((u64)__builtin_amdgcn_readfirstlane((unsigned)(uall >> 32)) << 32) | (u64)__builtin_amdgcn_readfirstlane((unsigned)uall);
    const size_t rowb = (size_t)b * T;
    {
        float ms_ = 0.f, ls = 0.f; f32x4 os[4];
#pragma unroll
        for (int db = 0; db < 4; ++db) os[db] = (f32x4){0.f, 0.f, 0.f, 0.f};
        const bf16_t* kcol = P + rowb * PW + P_KS + gq * 64; const bf16_t* vcol = P + rowb * PW + P_VS + gq * 64;
        const float c = -slope2 * (float)t;
        const int jcur = t0 >> 6;
        u64 rem = uall & ((1ull << jcur) - 1ull);
#define NSA_NEXT(dst) { dst = rem ? 63 - __builtin_clzll(rem) : -1; if (dst >= 0) rem &= ~(1ull << dst); }
#define NSA_KO(p, h) ((p) ? L_CK + (h) * TILE_B : ((h) ? L_KB1 : L_KB0))
#define NSA_VO(p, h) ((p) ? L_CV + (h) * TILE_B : ((h) ? L_VB1 : L_VB0))
        int ja = jcur, jb, na_, nb_, cur = 0; bool first = true;
        NSA_NEXT(jb)
        Stg sr0, sr1;
        stg_load(sr0, kcol + (size_t)ja * 64 * PW, vcol + (size_t)ja * 64 * PW, PW, tid); stg_store(lds, L_KB0, L_VB0, sr0, tid);
        if (jb >= 0) { stg_load(sr1, kcol + (size_t)jb * 64 * PW, vcol + (size_t)jb * 64 * PW, PW, tid); stg_store(lds, L_KB1, L_VB1, sr1, tid); }
        NSA_NEXT(na_) NSA_NEXT(nb_)
        if (na_ >= 0) stg_load(sr0, kcol + (size_t)na_ * 64 * PW, vcol + (size_t)na_ * 64 * PW, PW, tid);
        if (nb_ >= 0) stg_load(sr1, kcol + (size_t)nb_ * 64 * PW, vcol + (size_t)nb_ * 64 * PW, PW, tid);
        __syncthreads();
        for (;;) {
            if (na_ >= 0) stg_store(lds, NSA_KO(cur ^ 1, 0), NSA_VO(cur ^ 1, 0), sr0, tid);
            if (nb_ >= 0) stg_store(lds, NSA_KO(cur ^ 1, 1), NSA_VO(cur ^ 1, 1), sr1, tid);
            int nna, nnb; NSA_NEXT(nna) NSA_NEXT(nnb)
            if (nna >= 0) stg_load(sr0, kcol + (size_t)nna * 64 * PW, vcol + (size_t)nna * 64 * PW, PW, tid);
            if (nnb >= 0) stg_load(sr1, kcol + (size_t)nnb * 64 * PW, vcol + (size_t)nnb * 64 * PW, PW, tid);
            const bool na = (wun >> ja) & 1ull, nb = (jb >= 0) && ((wun >> jb) & 1ull);
            if (na || nb) {
                const float btA = fmaf(slope2, (float)(ja * 64 + 4 * g), c) + (((mymask >> ja) & 1ull) ? 0.f : -1e30f);
                const float btB = fmaf(slope2, (float)((jb < 0 ? 0 : jb) * 64 + 4 * g), c) + ((jb >= 0 && ((mymask >> jb) & 1ull)) ? 0.f : -1e30f);
                if (first) pair_tiles<true>(lds, NSA_KO(cur, 0), NSA_VO(cur, 0), NSA_KO(cur, 1), NSA_VO(cur, 1), na, nb, qf, i, g, slope2, btA, btB, true, false, ja * 64 + 4 * g, 0, 0, t, ms_, ls, os);
                else pair_tiles<false>(lds, NSA_KO(cur, 0), NSA_VO(cur, 0), NSA_KO(cur, 1), NSA_VO(cur, 1), na, nb, qf, i, g, slope2, btA, btB, false, false, 0, 0, 0, t, ms_, ls, os); }
            first = false;
            __syncthreads();
            if (na_ < 0) break;
            ja = na_; jb = nb_; na_ = nna; nb_ = nnb; cur ^= 1;
        }
        ls += __shfl_xor(ls, 16); ls += __shfl_xor(ls, 32);
        const float sc1 = gate1 / ls;
#pragma unroll
        for (int db = 0; db < 4; ++db) outacc[db] = outacc[db] + os[db] * sc1;
    }
    {
        float mw = 0.f, lw = 0.f; f32x4 ow[4];
#pragma unroll
        for (int db = 0; db < 4; ++db) ow[db] = (f32x4){0.f, 0.f, 0.f, 0.f};
        const bf16_t* kcol = P + rowb * PW + P_KW + gq * 64; const bf16_t* vcol = P + rowb * PW + P_VW + gq * 64;
        const float c = -slope2 * (float)t;
        const int j0 = (t0 - 511) > 0 ? ((t0 - 511) >> 6) : 0, j1 = t0 >> 6, tw0 = t0 + 4 * w;
        int ja = j1, cur = 0; bool first = true;
        Stg sr0, sr1;
        stg_load(sr0, kcol + (size_t)ja * 64 * PW, vcol + (size_t)ja * 64 * PW, PW, tid); stg_store(lds, L_KB0, L_VB0, sr0, tid);
        if (ja - 1 >= j0) { stg_load(sr1, kcol + (size_t)(ja - 1) * 64 * PW, vcol + (size_t)(ja - 1) * 64 * PW, PW, tid); stg_store(lds, L_KB1, L_VB1, sr1, tid); }
        if (ja - 2 >= j0) stg_load(sr0, kcol + (size_t)(ja - 2) * 64 * PW, vcol + (size_t)(ja - 2) * 64 * PW, PW, tid);
        if (ja - 3 >= j0) stg_load(sr1, kcol + (size_t)(ja - 3) * 64 * PW, vcol + (size_t)(ja - 3) * 64 * PW, PW, tid);
        __syncthreads();
        for (;;) {
            if (ja - 2 >= j0) stg_store(lds, NSA_KO(cur ^ 1, 0), NSA_VO(cur ^ 1, 0), sr0, tid);
            if (ja - 3 >= j0) stg_store(lds, NSA_KO(cur ^ 1, 1), NSA_VO(cur ^ 1, 1), sr1, tid);
            if (ja - 4 >= j0) stg_load(sr0, kcol + (size_t)(ja - 4) * 64 * PW, vcol + (size_t)(ja - 4) * 64 * PW, PW, tid);
            if (ja - 5 >= j0) stg_load(sr1, kcol + (size_t)(ja - 5) * 64 * PW, vcol + (size_t)(ja - 5) * 64 * PW, PW, tid);
            const int jb = ja - 1;
            const bool na = (64 * ja <= tw0 + 3) && (64 * ja + 63 >= tw0 - 511), nb = (jb >= j0) && (64 * jb <= tw0 + 3) && (64 * jb + 63 >= tw0 - 511);
            if (na || nb) {
                const float btA = fmaf(slope2, (float)(ja * 64 + 4 * g), c), btB = fmaf(slope2, (float)(jb * 64 + 4 * g), c);
                const bool maskA = (64 * ja < tw0 + 3 - 511), maskB = (64 * jb < tw0 + 3 - 511);
                if (first) pair_tiles<true>(lds, NSA_KO(cur, 0), NSA_VO(cur, 0), NSA_KO(cur, 1), NSA_VO(cur, 1), na, nb, qf, i, g, slope2, btA, btB, true, maskB, ja * 64 + 4 * g, jb * 64 + 4 * g, t - 511, t, mw, lw, ow);
                else pair_tiles<false>(lds, NSA_KO(cur, 0), NSA_VO(cur, 0), NSA_KO(cur, 1), NSA_VO(cur, 1), na, nb, qf, i, g, slope2, btA, btB, maskA, maskB, ja * 64 + 4 * g, jb * 64 + 4 * g, t - 511, t, mw, lw, ow); }
            first = false;
            __syncthreads();
            if (ja - 2 < j0) break;
            ja -= 2; cur ^= 1;
        }
        lw += __shfl_xor(lw, 16); lw += __shfl_xor(lw, 32);
        const float sc2 = gate2 / lw;
#pragma unroll
        for (int db = 0; db < 4; ++db) outacc[db] = outacc[db] + ow[db] * sc2;
    }
    bf16_t* yo = Ynsa + m * 512 + h * 64 + 4 * g;
#pragma unroll
    for (int db = 0; db < 4; ++db) { u32x2 v; v.x = pkbf(outacc[db][0], outacc[db][1]); v.y = pkbf(outacc[db][2], outacc[db][3]); *(u32x2*)(yo + db * 16) = v; }
}
__device__ __forceinline__ void phase(NLAS char* lds, const bf16_t* P, const float* S32, const bf16_t* KC, const bf16_t* VC, bf16_t* Ynsa) {
    const int G = gridDim.x, bid = blockIdx.x;
    if (G == 256) { const int base = bid >> 3, bg = bid & 7;
#pragma unroll 1
        for (int k = 0; k < 4; ++k) { const int ti = (k == 0) ? 127 - base : (k == 1) ? 64 + base : (k == 2) ? 63 - base : base; unit(lds, P, S32, KC, VC, Ynsa, bg >> 1, bg & 1, ti); } }
    else {
#pragma unroll 1
        for (int u = bid; u < 1024; u += G) unit(lds, P, S32, KC, VC, Ynsa, (u & 7) >> 1, u & 1, 127 - (u >> 3)); }
}
}

namespace xa {
using nsa::bf16x8; using nsa::s16x4; using nsa::f32x4; using nsa::u32x4; using nsa::u32x2; using nsa::vtr; using nsa::mfma16; using nsa::pkbf;
constexpr int RS = 272, TILE_B = 64 * RS;
__device__ __forceinline__ int l_k(int tile) { return tile * 2 * TILE_B; }
__device__ __forceinline__ int l_v(int tile) { return tile * 2 * TILE_B + TILE_B; }
__device__ __forceinline__ void unit(NLAS char* lds, const bf16_t* P, const bf16_t* MEMKV, bf16_t* Yxa, int b, int h, int tt) {
    const int tid = threadIdx.x, lane = tid & 63, w = __builtin_amdgcn_readfirstlane(tid >> 6), i = lane & 15, g = lane >> 4;
    const size_t m = (size_t)b * T + tt * 128 + 16 * w + i;
    const bf16_t* kbase = MEMKV + (size_t)b * 256 * 1024 + h * 128;
    { u32x4 st[4][4]; const bf16_t* p0 = kbase + (size_t)(tid >> 3) * 1024 + (tid & 7) * 8;
#pragma unroll
      for (int tile = 0; tile < 4; ++tile) { const bf16_t* p = p0 + (size_t)tile * 64 * 1024; st[tile][0] = *(const u32x4*)p; st[tile][1] = *(const u32x4*)(p + 64); st[tile][2] = *(const u32x4*)(p + 512); st[tile][3] = *(const u32x4*)(p + 576); }
      const int off = (tid >> 3) * RS + (tid & 7) * 16;
#pragma unroll
      for (int tile = 0; tile < 4; ++tile) { *(NLAS u32x4*)(lds + l_k(tile) + off) = st[tile][0]; *(NLAS u32x4*)(lds + l_k(tile) + off + 128) = st[tile][1]; *(NLAS u32x4*)(lds + l_v(tile) + off) = st[tile][2]; *(NLAS u32x4*)(lds + l_v(tile) + off + 128) = st[tile][3]; } }
    bf16x8 qf[4];
    { const bf16_t* qp = P + m * PW + P_XAQ + h * 128 + 8 * g;
#pragma unroll
      for (int ks = 0; ks < 4; ++ks) qf[ks] = *(const bf16x8*)(qp + 32 * ks); }
    const float scale2 = 0.08838834764831845f * nsa::LOG2E;
    float mx = -INFINITY, l = 0.f; f32x4 o[8];
#pragma unroll
    for (int db = 0; db < 8; ++db) o[db] = (f32x4){0.f, 0.f, 0.f, 0.f};
    __syncthreads();
#pragma unroll 1
    for (int tile = 0; tile < 4; ++tile) {
        const NLAS char* Kb = lds + l_k(tile); const NLAS char* Vb = lds + l_v(tile);
        f32x4 s[4];
        { bf16x8 a[4][4];
#pragma unroll
          for (int kb = 0; kb < 4; ++kb)
#pragma unroll
              for (int ks = 0; ks < 4; ++ks) a[kb][ks] = *(const NLAS bf16x8*)(Kb + (kb * 16 + i) * RS + 16 * g + 64 * ks);
#pragma unroll
          for (int kb = 0; kb < 4; ++kb) s[kb] = mfma16(a[kb][0], qf[0], (f32x4){0.f, 0.f, 0.f, 0.f});
#pragma unroll
          for (int ks = 1; ks < 4; ++ks)
#pragma unroll
              for (int kb = 0; kb < 4; ++kb) s[kb] = mfma16(a[kb][ks], qf[ks], s[kb]); }
        float mt = -INFINITY;
#pragma unroll
        for (int kb = 0; kb < 4; ++kb)
#pragma unroll
            for (int r = 0; r < 4; ++r) { const float v = s[kb][r] * scale2; s[kb][r] = v; mt = fmaxf(mt, v); }
        mt = fmaxf(mt, __shfl_xor(mt, 16)); mt = fmaxf(mt, __shfl_xor(mt, 32));
        const float mn = fmaxf(mx, mt), alpha = __builtin_amdgcn_exp2f(mx - mn); float sum = 0.f;
#pragma unroll
        for (int kb = 0; kb < 4; ++kb)
#pragma unroll
            for (int r = 0; r < 4; ++r) { const float p = __builtin_amdgcn_exp2f(s[kb][r] - mn); s[kb][r] = p; sum += p; }
        l = l * alpha + sum; mx = mn;
#pragma unroll
        for (int db = 0; db < 8; ++db) o[db] = o[db] * alpha;
        const NLAS char* vb = Vb + (4 * g + (i >> 2)) * RS + (i & 3) * 8;
#pragma unroll
        for (int kk = 0; kk < 2; ++kk) {
            u32x4 pw; pw.x = pkbf(s[2 * kk][0], s[2 * kk][1]); pw.y = pkbf(s[2 * kk][2], s[2 * kk][3]); pw.z = pkbf(s[2 * kk + 1][0], s[2 * kk + 1][1]); pw.w = pkbf(s[2 * kk + 1][2], s[2 * kk + 1][3]);
            const bf16x8 pf = __builtin_bit_cast(bf16x8, pw);
            s16x4 lo[8], hi[8];
#pragma unroll
            for (int db = 0; db < 8; ++db) { const NLAS char* vp = vb + (2 * kk) * 16 * RS + db * 32; lo[db] = vtr(vp); hi[db] = vtr(vp + 16 * RS); }
#pragma unroll
            for (int db = 0; db < 8; ++db) o[db] = mfma16((bf16x8){lo[db][0], lo[db][1], lo[db][2], lo[db][3], hi[db][0], hi[db][1], hi[db][2], hi[db][3]}, pf, o[db]);
        }
    }
    l += __shfl_xor(l, 16); l += __shfl_xor(l, 32);
    const float inv = 1.f / l;
    bf16_t* yo = Yxa + m * 512 + h * 128 + 4 * g;
#pragma unroll
    for (int db = 0; db < 8; ++db) { u32x2 v; v.x = pkbf(o[db][0] * inv, o[db][1] * inv); v.y = pkbf(o[db][2] * inv, o[db][3] * inv); *(u32x2*)(yo + db * 16) = v; }
    __syncthreads();
}
__device__ __forceinline__ void memkv_tile(NLAS char* lds, const bf16_t* MEMN, const bf16_t* Wmkv, bf16_t* MEMKV, int tile) {
    constexpr int RSK = 528, TBK = 64 * RSK;
    const int tid = threadIdx.x, lane = tid & 63, w = __builtin_amdgcn_readfirstlane(tid >> 6), i = lane & 15, g = lane >> 4;
    const int r0 = (tile >> 4) * 64, c0 = (tile & 15) * 64;
    const bf16_t* ap = MEMN + (size_t)(r0 + (tid >> 5)) * 1024 + (tid & 31) * 8; const bf16_t* bp = Wmkv + (size_t)(c0 + (tid >> 5)) * 1024 + (tid & 31) * 8;
    const int soff = (tid >> 5) * RSK + (tid & 31) * 16;
    u32x4 ra[4], rb[4];
#define MKV_LOAD(kc) { _Pragma("unroll") for (int q = 0; q < 4; ++q) { ra[q] = *(const u32x4*)(ap + (size_t)q * 16 * 1024 + (kc) * 256); rb[q] = *(const u32x4*)(bp + (size_t)q * 16 * 1024 + (kc) * 256); } }
#define MKV_STORE(buf) { _Pragma("unroll") for (int q = 0; q < 4; ++q) { *(NLAS u32x4*)(lds + (buf) * 2 * TBK + soff + q * 16 * RSK) = ra[q]; *(NLAS u32x4*)(lds + (buf) * 2 * TBK + TBK + soff + q * 16 * RSK) = rb[q]; } }
    f32x4 acc0 = (f32x4){0.f, 0.f, 0.f, 0.f}, acc1 = acc0;
    MKV_LOAD(0) MKV_STORE(0) MKV_LOAD(1)
    __syncthreads();
    const int arow = ((w >> 1) * 16 + i) * RSK + 16 * g, brow = ((w & 1) * 32 + i) * RSK + 16 * g;
#pragma unroll
    for (int kc = 0; kc < 4; ++kc) { const int buf = kc & 1;
        if (kc < 3) MKV_STORE(buf ^ 1)
        if (kc < 2) MKV_LOAD(kc + 2)
        const NLAS char* A = lds + buf * 2 * TBK; const NLAS char* B = A + TBK;
        bf16x8 af[8], b0[8], b1[8];
#pragma unroll
        for (int ks = 0; ks < 8; ++ks) { af[ks] = *(const NLAS bf16x8*)(A + arow + ks * 64); b0[ks] = *(const NLAS bf16x8*)(B + brow + ks * 64); b1[ks] = *(const NLAS bf16x8*)(B + brow + 16 * RSK + ks * 64); }
#pragma unroll
        for (int ks = 0; ks < 8; ++ks) { acc0 = mfma16(af[ks], b0[ks], acc0); acc1 = mfma16(af[ks], b1[ks], acc1); }
        __syncthreads(); }
#undef MKV_LOAD
#undef MKV_STORE
#pragma unroll
    for (int r = 0; r < 4; ++r) { bf16_t* o = MEMKV + (size_t)(r0 + (w >> 1) * 16 + 4 * g + r) * 1024 + c0 + (w & 1) * 32 + i; o[0] = f2bf(acc0[r]); o[16] = f2bf(acc1[r]); }
}
__device__ __forceinline__ void phase(NLAS char* lds, const bf16_t* P, const bf16_t* MEMKV, bf16_t* Yxa) {
#pragma unroll 1
    for (int u = blockIdx.x; u < 512; u += gridDim.x) unit(lds, P, MEMKV, Yxa, u >> 7, (u >> 5) & 3, u & 31);
}
}

namespace ml {
using nsa::bf16x8; using nsa::s16x4; using nsa::f32x4; using nsa::u32x4; using nsa::u32x2; using nsa::vtr; using nsa::mfma16; using nsa::pkbf;
constexpr int RS = 272, TB = 64 * RS, RSS = 144;
constexpr float KSCALE = 0.08838834764831845f;
__device__ __forceinline__ float scan_add(float v, int lane) {
#pragma unroll
    for (int o = 1; o < 64; o <<= 1) { const float u = __shfl_up(v, o); if (lane >= o) v += u; }
    return v; }
__device__ __forceinline__ float scan_max(float v, int lane) {
#pragma unroll
    for (int o = 1; o < 64; o <<= 1) { const float u = __shfl_up(v, o); if (lane >= o) v = fmaxf(v, u); }
    return v; }
__device__ __forceinline__ bf16x8 trpair(const NLAS char* p, int hi_off) { const s16x4 lo = vtr(p), hi = vtr(p + hi_off); return (bf16x8){lo[0], lo[1], lo[2], lo[3], hi[0], hi[1], hi[2], hi[3]}; }
__device__ __forceinline__ void load_conv(NLAS char* dst, const bf16_t* P, const float* cw, int colP, int cwc, size_t m0, int tseq0, int tid) {
    const int s = tid >> 3, c16 = (tid & 7) * 16;
    u32x4 raw[2][4]; f32x4 wv[2][4][2];
#pragma unroll
    for (int half = 0; half < 2; ++half) { const int c = c16 + half * 8;
#pragma unroll
        for (int j = 0; j < 4; ++j) { const bool ok = (tseq0 + s - j >= 0); const size_t row = m0 + s - (ok ? j : 0);
            raw[half][j] = *(const u32x4*)(P + row * PW + colP + c);
            const f32x4 w0 = *(const f32x4*)(cw + j * 1024 + cwc + c), w1 = *(const f32x4*)(cw + j * 1024 + cwc + c + 4); const f32x4 z = (f32x4){0.f, 0.f, 0.f, 0.f};
            wv[half][j][0] = ok ? w0 : z; wv[half][j][1] = ok ? w1 : z; } }
#pragma unroll
    for (int half = 0; half < 2; ++half) { const int c = c16 + half * 8; float acc[8];
#pragma unroll
        for (int e = 0; e < 8; ++e) acc[e] = 0.f;
#pragma unroll
        for (int j = 0; j < 4; ++j) { const u32x4 r4 = raw[half][j]; const f32x4 w0 = wv[half][j][0], w1 = wv[half][j][1];
            acc[0] += w0[0] * pg8::bflo(r4.x); acc[1] += w0[1] * pg8::bfhi(r4.x); acc[2] += w0[2] * pg8::bflo(r4.y); acc[3] += w0[3] * pg8::bfhi(r4.y);
            acc[4] += w1[0] * pg8::bflo(r4.z); acc[5] += w1[1] * pg8::bfhi(r4.z); acc[6] += w1[2] * pg8::bflo(r4.w); acc[7] += w1[3] * pg8::bfhi(r4.w); }
#pragma unroll
        for (int e = 0; e < 8; ++e) acc[e] = acc[e] * __builtin_amdgcn_rcpf(1.f + __expf(-acc[e]));
        u32x4 o; o.x = pkbf(acc[0], acc[1]); o.y = pkbf(acc[2], acc[3]); o.z = pkbf(acc[4], acc[5]); o.w = pkbf(acc[6], acc[7]);
        *(NLAS u32x4*)(dst + s * RS + c * 2) = o; }
}
struct RawT { u32x4 v[3]; };
__device__ __forceinline__ void raw_issue(RawT& r, const bf16_t* P, int colP, size_t m0, int tseq0, int tid) {
#pragma unroll
    for (int it = 0; it < 3; ++it) { int idx = tid + 512 * it; idx = idx < 1072 ? idx : 1071; const int row = idx >> 4, c = (idx & 15) * 8; const bool ok = (tseq0 + row - 3 >= 0);
        const u32x4 v = *(const u32x4*)(P + (ok ? m0 + row - 3 : m0) * PW + colP + c); r.v[it] = ok ? v : (u32x4){0u, 0u, 0u, 0u}; }
}
__device__ __forceinline__ void raw_store(NLAS char* dst, const RawT& r, int tid) {
#pragma unroll
    for (int it = 0; it < 3; ++it) { int idx = tid + 512 * it; idx = idx < 1072 ? idx : 1071; *(NLAS u32x4*)(dst + (idx >> 4) * RS + (idx & 15) * 16) = r.v[it]; }
}
__device__ __forceinline__ void conv_from_lds(NLAS char* dst, const NLAS char* raw, const NLAS float* wl, int tid) {
    const int s = tid >> 3, c16 = (tid & 7) * 16;
#pragma unroll
    for (int half = 0; half < 2; ++half) { const int c = c16 + half * 8; float acc[8];
#pragma unroll
        for (int e = 0; e < 8; ++e) acc[e] = 0.f;
#pragma unroll
        for (int j = 0; j < 4; ++j) { const u32x4 r4 = *(const NLAS u32x4*)(raw + (s + 3 - j) * RS + c * 2); const f32x4 w0 = *(const NLAS f32x4*)(wl + j * 128 + c), w1 = *(const NLAS f32x4*)(wl + j * 128 + c + 4);
            acc[0] += w0[0] * pg8::bflo(r4.x); acc[1] += w0[1] * pg8::bfhi(r4.x); acc[2] += w0[2] * pg8::bflo(r4.y); acc[3] += w0[3] * pg8::bfhi(r4.y);
            acc[4] += w1[0] * pg8::bflo(r4.z); acc[5] += w1[1] * pg8::bfhi(r4.z); acc[6] += w1[2] * pg8::bflo(r4.w); acc[7] += w1[3] * pg8::bfhi(r4.w); }
#pragma unroll
        for (int e = 0; e < 8; ++e) acc[e] = acc[e] * __builtin_amdgcn_rcpf(1.f + __expf(-acc[e]));
        u32x4 o; o.x = pkbf(acc[0], acc[1]); o.y = pkbf(acc[2], acc[3]); o.z = pkbf(acc[4], acc[5]); o.w = pkbf(acc[6], acc[7]);
        *(NLAS u32x4*)(dst + s * RS + c * 2) = o; }
}
__device__ __forceinline__ void m1_unit(NLAS char* lds, const bf16_t* P, const float* cw, const float* S32, bf16_t* Abuf, float* NA, float* Gc, float* Mloc, int ci) {
    constexpr int L_K = 0, L_EV = TB, L_E = 2 * TB, L_RK = 2 * TB + 1024, L_W = L_RK + 67 * RS;
    const int tid = threadIdx.x, lane = tid & 63, w = __builtin_amdgcn_readfirstlane(tid >> 6), i = lane & 15, g = lane >> 4;
    const int c = ci & 63, bh = ci >> 6, h = bh & 3, b = bh >> 2; const size_t m0 = (size_t)b * T + c * 64;
    NLAS float* eS = (NLAS float*)(lds + L_E);
    RawT rk; raw_issue(rk, P, P_MLK + h * 128, m0, c * 64, tid);
    u32x4 vraw[2]; { const bf16_t* vp = P + (m0 + (tid >> 3)) * PW + P_MLV + h * 128 + (tid & 7) * 16; vraw[0] = *(const u32x4*)vp; vraw[1] = *(const u32x4*)(vp + 8); }
    f32x4 wreg = (f32x4){0.f, 0.f, 0.f, 0.f}; if (tid < 128) wreg = *(const f32x4*)(cw + (tid >> 5) * 1024 + 512 + h * 128 + (tid & 31) * 4);
    if (w == 0) { const float fpre = S32[(m0 + lane) * 32 + 4 + h], ipre = S32[(m0 + lane) * 32 + h];
        const float bcs = scan_add(logsig(fpre), lane), gtot = __shfl(bcs, 63), wend = gtot - bcs + ipre, mloc = wave_max(wend);
        eS[lane] = __expf(wend - mloc) * KSCALE; if (lane == 0) { Gc[ci] = gtot; Mloc[ci] = mloc; } }
    raw_store(lds + L_RK, rk, tid); if (tid < 128) *(NLAS f32x4*)(lds + L_W + ((tid >> 5) * 128 + (tid & 31) * 4) * 4) = wreg;
    __syncthreads();
    conv_from_lds(lds + L_K, lds + L_RK, (const NLAS float*)(lds + L_W), tid);
    { const int s = tid >> 3, c16 = (tid & 7) * 16; const float es = eS[s];
#pragma unroll
      for (int half = 0; half < 2; ++half) { const u32x4 raw = vraw[half]; u32x4 o;
          o.x = pkbf(pg8::bflo(raw.x) * es, pg8::bfhi(raw.x) * es); o.y = pkbf(pg8::bflo(raw.y) * es, pg8::bfhi(raw.y) * es);
          o.z = pkbf(pg8::bflo(raw.z) * es, pg8::bfhi(raw.z) * es); o.w = pkbf(pg8::bflo(raw.w) * es, pg8::bfhi(raw.w) * es);
          *(NLAS u32x4*)(lds + L_EV + s * RS + (c16 + half * 8) * 2) = o; } }
    __syncthreads();
    f32x4 acc[8];
#pragma unroll
    for (int vb = 0; vb < 8; ++vb) acc[vb] = (f32x4){0.f, 0.f, 0.f, 0.f};
    const int rowoff = (4 * g + (i >> 2)) * RS + (i & 3) * 8;
#pragma unroll
    for (int kk = 0; kk < 2; ++kk) { const bf16x8 kf = trpair(lds + L_K + kk * 32 * RS + rowoff + w * 32, 16 * RS);
#pragma unroll
        for (int vb = 0; vb < 8; ++vb) acc[vb] = mfma16(trpair(lds + L_EV + kk * 32 * RS + rowoff + vb * 32, 16 * RS), kf, acc[vb]); }
    bf16_t* ap = Abuf + ((size_t)ci * 128 + w * 16 + i) * 128 + 4 * g;
#pragma unroll
    for (int vb = 0; vb < 8; ++vb) { u32x2 pk; pk.x = pkbf(acc[vb][0], acc[vb][1]); pk.y = pkbf(acc[vb][2], acc[vb][3]); *(u32x2*)(ap + vb * 16) = pk; }
    { const int k = tid >> 2, part = tid & 3; float n = 0.f;
#pragma unroll
      for (int s = 0; s < 16; ++s) n += eS[part * 16 + s] * bf2f(*(const NLAS bf16_t*)(lds + L_K + (part * 16 + s) * RS + k * 2));
      n += __shfl_xor(n, 1); n += __shfl_xor(n, 2); if (part == 0) NA[(size_t)ci * 128 + k] = n; }
    __syncthreads();
}
__device__ __forceinline__ void m2_items(bf16_t* Abuf, float* NA, const float* Gc, const float* Mloc, float* Mprev) {
    for (int it = blockIdx.x * blockDim.x + threadIdx.x; it < 16 * 128 * 64; it += gridDim.x * blockDim.x) {
        const int bh = it >> 13, kv2 = it & 8191, k = kv2 >> 6, v2 = kv2 & 63;
        float C0 = 0.f, C1 = 0.f, n = 0.f, m = 0.f;
        unsigned* base = (unsigned*)(Abuf + ((size_t)(bh * 64) * 128 + k) * 128 + v2 * 2);
#pragma unroll 1
        for (int c0 = 0; c0 < 64; c0 += 16) { unsigned A[16];
#pragma unroll
            for (int u = 0; u < 16; ++u) A[u] = base[(size_t)(c0 + u) * 8192];
#pragma unroll
            for (int u = 0; u < 16; ++u) { const int ci = bh * 64 + c0 + u; const float gg = Gc[ci], ml = Mloc[ci];
                const float mn = fmaxf(gg + m, ml), a = __expf(gg + m - mn), bb = __expf(ml - mn);
                base[(size_t)(c0 + u) * 8192] = pkbf(C0, C1); C0 = C0 * a + pg8::bflo(A[u]) * bb; C1 = C1 * a + pg8::bfhi(A[u]) * bb;
                if (v2 == 0) { const float nA = NA[(size_t)ci * 128 + k]; NA[(size_t)ci * 128 + k] = n; n = a * n + bb * nA; }
                if (kv2 == 0) Mprev[ci] = m;
                m = mn; } }
    }
}
__device__ __forceinline__ void m3_unit(NLAS char* lds, const bf16_t* P, const float* cw, const float* S32, const bf16_t* Cprev, const float* Nprev, const float* Mprev, const float* normg, bf16_t* Yml, int ci) {
    constexpr int L_Q = 0, L_K = TB, L_V = 2 * TB, L_C = 3 * TB, L_S = 5 * TB, L_F = L_S + 64 * RSS, L_RQ = L_F + 4096, L_RK = L_RQ + 67 * RS, L_W = L_RK + 67 * RS;
    static_assert(L_W + 4096 <= 147392 - 64, "m3 LDS map");
    const int tid = threadIdx.x, lane = tid & 63, w = __builtin_amdgcn_readfirstlane(tid >> 6), i = lane & 15, g = lane >> 4;
    const int c = ci & 63, bh = ci >> 6, h = bh & 3, b = bh >> 2; const size_t m0 = (size_t)b * T + c * 64;
    const int srow = tid >> 3, c16 = (tid & 7) * 16;
    RawT rq, rk; raw_issue(rq, P, P_MLQ + h * 128, m0, c * 64, tid); raw_issue(rk, P, P_MLK + h * 128, m0, c * 64, tid);
    u32x4 vr[2], orw[2], cr[4];
    { const bf16_t* vp = P + (m0 + srow) * PW + P_MLV + h * 128 + c16; vr[0] = *(const u32x4*)vp; vr[1] = *(const u32x4*)(vp + 8);
      const bf16_t* op = P + (m0 + srow) * PW + P_MLO + h * 128 + c16; orw[0] = *(const u32x4*)op; orw[1] = *(const u32x4*)(op + 8);
      const bf16_t* cp = Cprev + ((size_t)ci * 128 + (tid >> 2)) * 128 + (tid & 3) * 32;
#pragma unroll
      for (int q8 = 0; q8 < 4; ++q8) cr[q8] = *(const u32x4*)(cp + q8 * 8); }
    f32x4 wreg = (f32x4){0.f, 0.f, 0.f, 0.f}; if (tid < 256) wreg = *(const f32x4*)(cw + ((tid & 127) >> 5) * 1024 + (tid >> 7) * 512 + h * 128 + (tid & 31) * 4);
    float ng[4];
#pragma unroll
    for (int vb = 0; vb < 4; ++vb) ng[vb] = normg[h * 128 + ((w & 1) * 4 + vb) * 16 + i];
    NLAS float* F = (NLAS float*)(lds + L_F);
    NLAS float* rowf = F; NLAS float* colf = F + 64; NLAS float* scv = F + 128; NLAS float* emt = F + 192; NLAS float* qn = F + 256; NLAS float* nprev = F + 320; NLAS float* denp = F + 448; NLAS float* ssq = F + 576;
    if (w == 0) { const float fpre = S32[(m0 + lane) * 32 + 4 + h], ipre = S32[(m0 + lane) * 32 + h], mprev = Mprev[ci];
        const float bcs = scan_add(logsig(fpre), lane), u = ipre - bcs, pm = scan_max(u, lane), mt = bcs + fmaxf(mprev, pm);
        rowf[lane] = bcs - mt; colf[lane] = u; scv[lane] = __expf(bcs + mprev - mt); emt[lane] = __expf(-mt); }
    else if (w <= 2) nprev[tid - 64] = Nprev[(size_t)ci * 128 + tid - 64];
    raw_store(lds + L_RQ, rq, tid); raw_store(lds + L_RK, rk, tid);
    if (tid < 256) *(NLAS f32x4*)(lds + L_W + ((tid >> 7) * 512 + ((tid & 127) >> 5) * 128 + (tid & 31) * 4) * 4) = wreg;
    *(NLAS u32x4*)(lds + L_V + srow * RS + c16 * 2) = vr[0]; *(NLAS u32x4*)(lds + L_V + srow * RS + c16 * 2 + 16) = vr[1];
#pragma unroll
    for (int q8 = 0; q8 < 4; ++q8) *(NLAS u32x4*)(lds + L_C + (tid >> 2) * RS + ((tid & 3) * 32 + q8 * 8) * 2) = cr[q8];
    __syncthreads();
    conv_from_lds(lds + L_Q, lds + L_RQ, (const NLAS float*)(lds + L_W), tid);
    conv_from_lds(lds + L_K, lds + L_RK, (const NLAS float*)(lds + L_W) + 512, tid);
    __syncthreads();
    *(NLAS u32x4*)(lds + L_RQ + srow * RS + c16 * 2) = orw[0]; *(NLAS u32x4*)(lds + L_RQ + srow * RS + c16 * 2 + 16) = orw[1];
    { const int tq = tid >> 3, part = tid & 7; const u32x4 q0 = *(const NLAS u32x4*)(lds + L_Q + tq * RS + part * 32), q1 = *(const NLAS u32x4*)(lds + L_Q + tq * RS + part * 32 + 16);
      const NLAS f32x4* np = (const NLAS f32x4*)(nprev + part * 16); const f32x4 n0 = np[0], n1 = np[1], n2 = np[2], n3 = np[3];
      float a = pg8::bflo(q0.x) * n0[0] + pg8::bfhi(q0.x) * n0[1] + pg8::bflo(q0.y) * n0[2] + pg8::bfhi(q0.y) * n0[3] + pg8::bflo(q0.z) * n1[0] + pg8::bfhi(q0.z) * n1[1] + pg8::bflo(q0.w) * n1[2] + pg8::bfhi(q0.w) * n1[3]
              + pg8::bflo(q1.x) * n2[0] + pg8::bfhi(q1.x) * n2[1] + pg8::bflo(q1.y) * n2[2] + pg8::bfhi(q1.y) * n2[3] + pg8::bflo(q1.z) * n3[0] + pg8::bfhi(q1.z) * n3[1] + pg8::bflo(q1.w) * n3[2] + pg8::bfhi(q1.w) * n3[3];
      a += __shfl_xor(a, 1); a += __shfl_xor(a, 2); a += __shfl_xor(a, 4); if (part == 0) qn[tq] = a; }
    const int tb = w >> 1;
    {
        float rs[4] = {0.f, 0.f, 0.f, 0.f};
#pragma unroll
        for (int sbi = 0; sbi < 2; ++sbi) { const int sb = 2 * (w & 1) + sbi; f32x4 acc = (f32x4){0.f, 0.f, 0.f, 0.f};
            if (sb <= tb) {
#pragma unroll
                for (int ks = 0; ks < 4; ++ks) acc = mfma16(*(const NLAS bf16x8*)(lds + L_Q + (tb * 16 + i) * RS + (32 * ks + 8 * g) * 2), *(const NLAS bf16x8*)(lds + L_K + (sb * 16 + i) * RS + (32 * ks + 8 * g) * 2), acc); }
            const int sx = sb * 16 + i; const float cf = colf[sx];
#pragma unroll
            for (int r = 0; r < 4; ++r) { const int t = tb * 16 + 4 * g + r; const float v = (sx <= t) ? acc[r] * KSCALE * __expf(rowf[t] + cf) : 0.f; rs[r] += v;
                *(NLAS bf16_t*)(lds + L_S + t * RSS + sx * 2) = f2bf(v); } }
#pragma unroll
        for (int r = 0; r < 4; ++r) { float x = rs[r]; x += __shfl_xor(x, 1); x += __shfl_xor(x, 2); x += __shfl_xor(x, 4); x += __shfl_xor(x, 8); if (i == 0) denp[(w & 1) * 64 + tb * 16 + 4 * g + r] = x; }
    }
    __syncthreads();
    f32x4 a1[4], a2[4];
#pragma unroll
    for (int vb = 0; vb < 4; ++vb) { a1[vb] = (f32x4){0.f, 0.f, 0.f, 0.f}; a2[vb] = (f32x4){0.f, 0.f, 0.f, 0.f}; }
    const int vb0 = (w & 1) * 4, troff = (8 * g + (i >> 2)) * RS + (i & 3) * 8;
#pragma unroll
    for (int kk = 0; kk < 2; ++kk) { if (32 * kk <= tb * 16 + 15) { const bf16x8 sf = *(const NLAS bf16x8*)(lds + L_S + (tb * 16 + i) * RSS + (32 * kk + 8 * g) * 2);
#pragma unroll
        for (int vb = 0; vb < 4; ++vb) a1[vb] = mfma16(sf, trpair(lds + L_V + kk * 32 * RS + troff + (vb0 + vb) * 32, 4 * RS), a1[vb]); } }
#pragma unroll
    for (int ks = 0; ks < 4; ++ks) { const bf16x8 qf = *(const NLAS bf16x8*)(lds + L_Q + (tb * 16 + i) * RS + (32 * ks + 8 * g) * 2);
#pragma unroll
        for (int vb = 0; vb < 4; ++vb) a2[vb] = mfma16(qf, trpair(lds + L_C + ks * 32 * RS + troff + (vb0 + vb) * 32, 4 * RS), a2[vb]); }
    float hv[4][4], sq[4] = {0.f, 0.f, 0.f, 0.f};
#pragma unroll
    for (int r = 0; r < 4; ++r) { const int t = tb * 16 + 4 * g + r; const float sc = scv[t]; const float den = denp[t] + denp[64 + t] + sc * qn[t]; const float hd = 1.f / fmaxf(fabsf(den), emt[t]);
#pragma unroll
        for (int vb = 0; vb < 4; ++vb) { const float x = (a1[vb][r] + sc * a2[vb][r]) * hd; hv[vb][r] = x; sq[r] += x * x; } }
#pragma unroll
    for (int r = 0; r < 4; ++r) { float x = sq[r]; x += __shfl_xor(x, 1); x += __shfl_xor(x, 2); x += __shfl_xor(x, 4); x += __shfl_xor(x, 8); if (i == 0) ssq[(w & 1) * 64 + tb * 16 + 4 * g + r] = x; }
    __syncthreads();
#pragma unroll
    for (int r = 0; r < 4; ++r) { const int t = tb * 16 + 4 * g + r; const float rinv = rsqrtf((ssq[t] + ssq[64 + t]) * (1.f / 128.f) + EPS);
#pragma unroll
        for (int vb = 0; vb < 4; ++vb) { const int v = (vb0 + vb) * 16 + i; const float o = bf2f(*(const NLAS bf16_t*)(lds + L_RQ + t * RS + v * 2));
            *(NLAS bf16_t*)(lds + L_RK + t * RS + v * 2) = f2bf(__builtin_amdgcn_rcpf(1.f + __expf(-o)) * hv[vb][r] * rinv * ng[vb]); } }
    __syncthreads();
    { bf16_t* yp = Yml + (m0 + srow) * 512 + h * 128 + c16; *(u32x4*)yp = *(const NLAS u32x4*)(lds + L_RK + srow * RS + c16 * 2); *(u32x4*)(yp + 8) = *(const NLAS u32x4*)(lds + L_RK + srow * RS + c16 * 2 + 16); }
    __syncthreads();
}
}

namespace cmpr {
using nsa::bf16x8; using nsa::f32x4; using nsa::u32x4; using nsa::mfma16; using nsa::pkbf;
constexpr int RSA = 4112, L_A = 0, RSB = 144, TBB = 256 * RSB, L_B = 16 * RSA, L_H = L_B, RSH = 528;
static_assert(L_B + 2 * TBB <= 147392 - 64, "cmpr LDS map");
__device__ __forceinline__ void unit(NLAS char* lds, const bf16_t* P, const float* pe, const bf16_t* W1t, const bf16_t* W2t, bf16_t* KC, bf16_t* VC, int u) {
    const int tid = threadIdx.x, lane = tid & 63, w = __builtin_amdgcn_readfirstlane(tid >> 6), i = lane & 15, g = lane >> 4;
    const int nt = u & 15, gq = (u >> 4) & 1, b = (u >> 5) & 3, kv = u >> 7;
    const int pcol = (kv ? P_VC : P_KC) + gq * 64, tok0 = 256 * nt;
    const bf16_t* bp = W1t + ((size_t)kv * 256 + (tid >> 3)) * 2048 + (tid & 7) * 8; const int bso = (tid >> 3) * RSB + (tid & 7) * 16;
    u32x4 r0[4], r1[4], r2[4], r3[4];
#define CMPR_LOAD(dst, kc) { _Pragma("unroll") for (int q = 0; q < 4; ++q) dst[q] = *(const u32x4*)(bp + (size_t)q * 64 * 2048 + (kc) * 64); }
#define CMPR_STORE(src, buf) { _Pragma("unroll") for (int q = 0; q < 4; ++q) *(NLAS u32x4*)(lds + L_B + (buf) * TBB + bso + q * 64 * RSB) = src[q]; }
    CMPR_LOAD(r0, 0) CMPR_LOAD(r1, 1) CMPR_LOAD(r2, 2) CMPR_LOAD(r3, 3)
#pragma unroll
    for (int q = 0; q < 8; ++q) { const int p = tid + 512 * q, n = p >> 8, l = (p >> 3) & 31, c8 = (p & 7) * 8, tok = tok0 + 16 * n + l;
        u32x4 v = *(const u32x4*)(P + ((size_t)b * T + (tok < T ? tok : T - 1)) * PW + pcol + c8); if (tok >= T) v = (u32x4){0u, 0u, 0u, 0u};
        const float* pa = pe + kv * 2048 + l * 64 + c8; const f32x4 a0 = *(const f32x4*)pa, a1 = *(const f32x4*)(pa + 4);
        u32x4 o; o.x = pkbf(pg8::bflo(v.x) + a0[0], pg8::bfhi(v.x) + a0[1]); o.y = pkbf(pg8::bflo(v.y) + a0[2], pg8::bfhi(v.y) + a0[3]); o.z = pkbf(pg8::bflo(v.z) + a1[0], pg8::bfhi(v.z) + a1[1]); o.w = pkbf(pg8::bflo(v.w) + a1[2], pg8::bfhi(v.w) + a1[3]);
        *(NLAS u32x4*)(lds + L_A + n * RSA + (l * 64 + c8) * 2) = o; }
    CMPR_STORE(r0, 0)
    __syncthreads();
    f32x4 acc[2]; acc[0] = (f32x4){0.f, 0.f, 0.f, 0.f}; acc[1] = acc[0];
    const int aro = i * RSA + 16 * g, bro = (32 * w + i) * RSB + 16 * g;
#define CMPR_STEP(kc, cur, nxt) { if ((kc) + 1 < 32) CMPR_STORE(nxt, ((kc) + 1) & 1) if ((kc) + 4 < 32) CMPR_LOAD(cur, (kc) + 4) \
        { const NLAS char* B = lds + L_B + ((kc) & 1) * TBB + bro; const NLAS char* A = lds + L_A + aro + (kc) * 128; \
          const bf16x8 a0 = *(const NLAS bf16x8*)A, a1 = *(const NLAS bf16x8*)(A + 64); \
          acc[0] = mfma16(a0, *(const NLAS bf16x8*)B, acc[0]); acc[1] = mfma16(a0, *(const NLAS bf16x8*)(B + 16 * RSB), acc[1]); \
          acc[0] = mfma16(a1, *(const NLAS bf16x8*)(B + 64), acc[0]); acc[1] = mfma16(a1, *(const NLAS bf16x8*)(B + 16 * RSB + 64), acc[1]); } \
        __syncthreads(); }
#pragma unroll 1
    for (int k4 = 0; k4 < 32; k4 += 4) { CMPR_STEP(k4, r0, r1) CMPR_STEP(k4 + 1, r1, r2) CMPR_STEP(k4 + 2, r2, r3) CMPR_STEP(k4 + 3, r3, r0) }
#undef CMPR_LOAD
#undef CMPR_STORE
#undef CMPR_STEP
#pragma unroll
    for (int cb = 0; cb < 2; ++cb)
#pragma unroll
        for (int r = 0; r < 4; ++r) { const float x = acc[cb][r], uu = 0.7978845608028654f * (x + 0.044715f * x * x * x); const float gl = x * __builtin_amdgcn_rcpf(1.f + __expf(-2.f * uu));
            *(NLAS bf16_t*)(lds + L_H + (4 * g + r) * RSH + (32 * w + cb * 16 + i) * 2) = f2bf(gl); }
    __syncthreads();
    if (w < 4) { f32x4 o = (f32x4){0.f, 0.f, 0.f, 0.f}; const bf16_t* w2 = W2t + ((size_t)kv * 64 + 16 * w + i) * 256 + 8 * g;
#pragma unroll
        for (int ks = 0; ks < 8; ++ks) o = mfma16(*(const NLAS bf16x8*)(lds + L_H + i * RSH + (32 * ks + 8 * g) * 2), *(const bf16x8*)(w2 + 32 * ks), o);
        bf16_t* dst = (kv ? VC : KC);
#pragma unroll
        for (int r = 0; r < 4; ++r) dst[((size_t)(b * 256 + 16 * nt + 4 * g + r) * 2 + gq) * 64 + 16 * w + i] = f2bf(o[r]); }
    __syncthreads();
}
}

#define LAS __attribute__((address_space(3)))
constexpr int NTHREADS = 512, LDS_BYTES = 147456;
constexpr size_t WS_WIN = 1 * MiB, WS_WG = 9 * MiB, WS_WBR = 15 * MiB, WS_WOUT = 18 * MiB, WS_WFF1 = 20 * MiB, WS_WFF2 = 28 * MiB, WS_WMKV = 36 * MiB, WS_WC1 = 38 * MiB;
constexpr size_t WS_BIASP = 253 * MiB + 768 * 1024, WS_XCH = 254 * MiB;
#define XB_TMO      128
#define XB_XCNT(j)  (256  + 64 * (j))
#define XB_XSUB(j)  (1280 + 64 * (j))
#define XB_XGEN(j)  (2304 + 64 * (j))
#define XB_TOP      3328
#define XB_TOPGEN   3392
#define XCD_BAR_WORDS 3456
#define XB_SPIN_CAP (1u << 18)

__device__ __forceinline__ unsigned xb_ld(unsigned* p)              { return __hip_atomic_load(p, __ATOMIC_RELAXED, __HIP_MEMORY_SCOPE_AGENT); }
__device__ __forceinline__ unsigned xb_add(unsigned* p, unsigned v) { return __hip_atomic_fetch_add(p, v, __ATOMIC_RELAXED, __HIP_MEMORY_SCOPE_AGENT); }
__device__ __forceinline__ unsigned xb_xcc_id() { return (unsigned)__builtin_amdgcn_s_getreg((3 << 11) | 20) & 0xFu; }
#define XB_SPIN(cond, bar) do { unsigned _sp = 0; while (cond) { __builtin_amdgcn_s_sleep(1); \
    if ((++_sp & 255u) == 0u) { if (xb_ld(&(bar)[XB_TMO])) break; if (_sp > XB_SPIN_CAP) { atomicAdd(&(bar)[XB_TMO], 1u); break; } } } } while (0)

struct XcdBarrier {
    unsigned* bar; unsigned x;
    volatile LAS unsigned* st;
};

__device__ __forceinline__ XcdBarrier xcd_barrier_post(unsigned* bar, volatile LAS unsigned* st) {
    XcdBarrier b; b.bar = bar; b.x = xb_xcc_id(); b.st = st;
    if (threadIdx.x == 0) (void)xb_add(&bar[XB_XCNT(b.x)], 1u);
    return b;
}
__device__ __forceinline__ void xcd_barrier_complete(unsigned* bar, unsigned x, unsigned& nloc, unsigned& nx) {
    const unsigned G = gridDim.x * gridDim.y * gridDim.z;
    unsigned sum, cnt, mine, sp = 0u;
    for (;;) {
        sum = 0u; cnt = 0u; mine = 0u;
#pragma unroll
        for (unsigned j = 0; j < 16; ++j) { const unsigned c = xb_ld(&bar[XB_XCNT(j)]); sum += c; cnt += (c > 0u) ? 1u : 0u; mine = (j == x) ? c : mine; }
        if (sum == G) break;
        __builtin_amdgcn_s_sleep(1);
        if ((++sp & 255u) == 0u) { if (xb_ld(&bar[XB_TMO])) break; if (sp > XB_SPIN_CAP) { atomicAdd(&bar[XB_TMO], 1u); break; } }
    }
    nloc = mine > 0u ? mine : 1u; nx = cnt > 0u ? cnt : 1u;
}

__device__ __forceinline__ void xcd_barrier(const XcdBarrier& b) {
    asm volatile("s_waitcnt vmcnt(0)" ::: "memory");
    __syncthreads();
    if (threadIdx.x == 0) {
        unsigned* bar = b.bar;
        __builtin_amdgcn_s_waitcnt(0);
        unsigned nloc = b.st[0], nx = b.st[1];
        if (nloc == 0u) { xcd_barrier_complete(bar, b.x, nloc, nx); b.st[0] = nloc; b.st[1] = nx; }
        const unsigned old = xb_add(&bar[XB_XSUB(b.x)], 1u);
        const unsigned gen = old / nloc;
        if (old + 1u == (gen + 1u) * nloc) {
            __builtin_amdgcn_fence(__ATOMIC_RELEASE, "agent");
            asm volatile("s_waitcnt vmcnt(0)" ::: "memory");
            const unsigned og = xb_add(&bar[XB_TOP], 1u);
            const unsigned tg = og / nx;
            if (og + 1u == (tg + 1u) * nx) xb_add(&bar[XB_TOPGEN], 1u);
            else XB_SPIN(xb_ld(&bar[XB_TOPGEN]) == tg, bar);
            __builtin_amdgcn_fence(__ATOMIC_ACQUIRE, "agent");
            xb_add(&bar[XB_XGEN(b.x)], 1u);
            asm volatile("s_waitcnt vmcnt(0)" ::: "memory");
        } else {
            XB_SPIN(xb_ld(&bar[XB_XGEN(b.x)]) == gen, bar);
            __builtin_amdgcn_fence(__ATOMIC_ACQUIRE, "agent");
            asm volatile("s_waitcnt vmcnt(0)" ::: "memory");
        }
    }
    __syncthreads();
}

__device__ __forceinline__ void group_barrier(unsigned* gc, unsigned target, bool light) {
    asm volatile("s_waitcnt vmcnt(0)" ::: "memory"); __syncthreads();
    if (threadIdx.x == 0) {
        if (!light) { __builtin_amdgcn_fence(__ATOMIC_RELEASE, "agent"); asm volatile("s_waitcnt vmcnt(0)" ::: "memory"); }
        __hip_atomic_fetch_add(gc, 1u, __ATOMIC_RELAXED, __HIP_MEMORY_SCOPE_AGENT);
        unsigned sp = 0; while (__hip_atomic_load(gc, __ATOMIC_RELAXED, __HIP_MEMORY_SCOPE_AGENT) < target) { __builtin_amdgcn_s_sleep(1); if (++sp > (1u << 22)) break; }
        __builtin_amdgcn_fence(__ATOMIC_ACQUIRE, "agent"); asm volatile("s_waitcnt vmcnt(0)" ::: "memory");
    }
    __syncthreads();
}
struct Args { const float* in[18]; float* out; unsigned char* ws; int ph_lo, ph_hi; };
__device__ __forceinline__ unsigned pk2(float lo, float hi) { return (unsigned)f2bf(lo) | ((unsigned)f2bf(hi) << 16); }
typedef unsigned v4u __attribute__((ext_vector_type(4)));
typedef float f32x4 __attribute__((ext_vector_type(4)));
__device__ __forceinline__ void tr_item(const float* W, int ld, int ncols, int K, bf16_t* WT, int row_off, LAS float* scr, int item, int lane) {
    const int nblk = ncols / 32, kb = item / nblk, nb = item % nblk, k0 = 64 * kb, n0 = 32 * nb;
#pragma unroll 8
    for (int i = 0; i < 32; ++i) { const int kk = 2 * i + (lane >> 5); scr[kk * 33 + (lane & 31)] = W[(size_t)(k0 + kk) * ld + n0 + (lane & 31)]; }
    asm volatile("s_waitcnt lgkmcnt(0)" ::: "memory");
    const int c = lane & 7;
#pragma unroll
    for (int j = 0; j < 4; ++j) { const int n = (lane >> 3) + 8 * j; const LAS float* s = scr + (8 * c) * 33 + n;
        v4u o; o.x = pk2(s[0 * 33], s[1 * 33]); o.y = pk2(s[2 * 33], s[3 * 33]); o.z = pk2(s[4 * 33], s[5 * 33]); o.w = pk2(s[6 * 33], s[7 * 33]);
        *(v4u*)(WT + (size_t)(row_off + n0 + n) * K + k0 + 8 * c) = o; }
    asm volatile("s_waitcnt lgkmcnt(0)" ::: "memory");
}
__device__ __forceinline__ void rms_row_wave(const float* xrow, const float* g, bf16_t* orow, int lane) {
    const f32x4* xr = (const f32x4*)xrow + lane; const f32x4* gr = (const f32x4*)g + lane;
    f32x4 v[4]; float s = 0.f;
#pragma unroll
    for (int j = 0; j < 4; ++j) { v[j] = xr[64 * j]; s += (v[j].x * v[j].x + v[j].y * v[j].y) + (v[j].z * v[j].z + v[j].w * v[j].w); }
    const float r = rsqrtf(wave_sum(s) * (1.f / D) + EPS);
    unsigned long long* o8 = (unsigned long long*)orow + lane;
#pragma unroll
    for (int j = 0; j < 4; ++j) { const f32x4 gg = gr[64 * j]; o8[64 * j] = (unsigned long long)pk2(v[j].x * r * gg.x, v[j].y * r * gg.y) | ((unsigned long long)pk2(v[j].z * r * gg.z, v[j].w * r * gg.w) << 32); }
}
__device__ __forceinline__ int small_src_col(int c) { return c < 8 ? C_MLI + c : C_NSG + (c - 8); }
__global__ void __launch_bounds__(NTHREADS, 2) mega(Args a) {
    extern __shared__ __attribute__((aligned(16))) unsigned char lds_raw[];
    char* lds = (char*)lds_raw;
    LAS unsigned char* lds3 = (LAS unsigned char*)lds_raw;
    const float* x = a.in[0]; const float* mem = a.in[1]; const float* g_mix = a.in[2]; const float* w_in = a.in[3];
    const float* b_in = a.in[4]; const float* ml_conv = a.in[5]; const float* ml_norm_g = a.in[6]; const float* cmp_pe = a.in[7];
    const float* cmp_w1 = a.in[8]; const float* cmp_w2 = a.in[9]; const float* g_mem = a.in[10]; const float* w_mem_kv = a.in[11];
    const float* w_branch = a.in[12]; const float* w_out = a.in[13]; const float* g_ffn = a.in[14]; const float* w_ff1 = a.in[15];
    const float* w_ff2 = a.in[16]; const float* g_final = a.in[17];
    char* ws = (char*)a.ws; float* out = a.out;
    bf16_t* U = (bf16_t*)(ws + WS_U); bf16_t* P = (bf16_t*)(ws + WS_P);
    bf16_t* Yml = (bf16_t*)(ws + WS_Y); bf16_t* Ynsa = Yml + (size_t)M * 512; bf16_t* Yxa = Ynsa + (size_t)M * 512;
    float* S32 = (float*)(ws + WS_S32); bf16_t* MEMN = (bf16_t*)out + (size_t)16 * 1024 * 1024;     bf16_t* MEMKV = (bf16_t*)(ws + WS_MEMKV);
    bf16_t* KC = (bf16_t*)(ws + WS_KC); bf16_t* VC = (bf16_t*)(ws + WS_VC);
    float* NA = (float*)(ws + WS_NA); float* Gc = (float*)(ws + WS_G); float* Mloc = (float*)(ws + WS_MLOC); float* Mprev = (float*)(ws + WS_MPREV);
    bf16_t* Abuf = (bf16_t*)out;
    bf16_t* GATES = P; bf16_t* MERGED = U; bf16_t* AFFN = U; bf16_t* HBUF = P;
    bf16_t* Wi = (bf16_t*)(ws + WS_WIN); bf16_t* Wg = (bf16_t*)(ws + WS_WG); bf16_t* Wbr = (bf16_t*)(ws + WS_WBR); bf16_t* Wo = (bf16_t*)(ws + WS_WOUT);
    bf16_t* Wf1 = (bf16_t*)(ws + WS_WFF1); bf16_t* Wf2 = (bf16_t*)(ws + WS_WFF2); bf16_t* Wmkv = (bf16_t*)(ws + WS_WMKV);
    float* biasP = (float*)(ws + WS_BIASP); bf16_t* Wc1 = (bf16_t*)(ws + WS_WC1); bf16_t* Wc2 = (bf16_t*)(ws + WS_BIASP + 65536);
    const int tid = threadIdx.x, lane = tid & 63, wave = __builtin_amdgcn_readfirstlane(tid >> 6);
    const int G = gridDim.x, bid = blockIdx.x;
    const int lo = a.ph_lo, hi = a.ph_hi;
    volatile LAS unsigned* xbst = (volatile LAS unsigned*)(lds3 + LDS_BYTES - 64);
    if (tid < 2) xbst[tid] = 0u;
    __syncthreads();
    const XcdBarrier bar = xcd_barrier_post((unsigned*)ws, xbst);
    if (tid == 0) __hip_atomic_store((unsigned*)ws + 12544 + bid, xb_xcc_id() + 1u, __ATOMIC_RELAXED, __HIP_MEMORY_SCOPE_AGENT);
#define PHASE(k) if (lo <= (k) && (k) < hi)
#define SEAM(k) if (lo <= (k) && (k) + 1 < hi) xcd_barrier(bar)
    PHASE(0) {
        LAS float* scr = (LAS float*)(lds3 + wave * 16384);
        const int gw = bid * 8 + wave, NGW = G * 8;
        constexpr int I0 = 16 * 64, I1 = 16 * 40, I2 = 16 * 16, I3 = 16 * 96, I4 = 8 * 32, I5 = 16 * 32, I6 = 16 * 128, I7 = 64 * 32, I8 = 16 * 32;
        constexpr int I9 = 32 * 8, I10 = 4 * 2;
        constexpr int NITEMS = I0 + I1 + I2 + I3 + 3 * I4 + I5 + I6 + I7 + I8 + 2 * I9 + 2 * I10;
        for (int it = gw; it < NITEMS; it += NGW) {
            int r = it;
            if (r < I0) { tr_item(w_in, DIN, 2048, 1024, Wi, 0, scr, r, lane); continue; } r -= I0;
            if (r < I1) { tr_item(w_in + 2056, DIN, 1280, 1024, Wi, 2048, scr, r, lane); continue; } r -= I1;
            if (r < I2) { tr_item(w_in + 3360, DIN, 512, 1024, Wi, 3328, scr, r, lane); continue; } r -= I2;
            if (r < I3) { tr_item(w_in + C_MG, DIN, 3072, 1024, Wg, 0, scr, r, lane); continue; } r -= I3;
            if (r < 3 * I4) { const int j = r / I4; tr_item(w_branch + (size_t)j * 512 * 1024, 1024, 1024, 512, Wbr + (size_t)j * 1024 * 512, 0, scr, r % I4, lane); continue; } r -= 3 * I4;
            if (r < I5) { tr_item(w_out, 1024, 1024, 1024, Wo, 0, scr, r, lane); continue; } r -= I5;
            if (r < I6) { tr_item(w_ff1, FF, FF, 1024, Wf1, 0, scr, r, lane); continue; } r -= I6;
            if (r < I7) { tr_item(w_ff2, 1024, 1024, FF, Wf2, 0, scr, r, lane); continue; } r -= I7;
            if (r < I8) { tr_item(w_mem_kv, 1024, 1024, 1024, Wmkv, 0, scr, r, lane); continue; } r -= I8;
            if (r < 2 * I9) { const int kv = r / I9; tr_item(cmp_w1 + (size_t)kv * 2048 * 256, 256, 256, 2048, Wc1 + (size_t)kv * 256 * 2048, 0, scr, r % I9, lane); continue; } r -= 2 * I9;
            { const int kv = r / I10; tr_item(cmp_w2 + (size_t)kv * 256 * 64, 64, 64, 256, Wc2 + (size_t)kv * 64 * 256, 0, scr, r % I10, lane); }
        }
        for (int i = bid * NTHREADS + tid; i < 256 * 1024; i += G * NTHREADS) { const int r = i >> 10, k = i & 1023; bf16_t v = 0;
            if (r < 32) v = f2bf(w_in[(size_t)k * DIN + small_src_col(r)]);
            else if (r >= 128 && r < 160) { const float w = w_in[(size_t)k * DIN + small_src_col(r - 128)]; v = f2bf(w - bf2f(f2bf(w))); }
            Wi[(size_t)(3840 + r) * 1024 + k] = v; }
        for (int c = bid * NTHREADS + tid; c < 4096; c += G * NTHREADS) { float v = 0.f;
            if (c < 2048) v = b_in[c]; else if (c < 3328) v = b_in[c + 8]; else if (c < 3840) v = b_in[c + 32]; else if (c < 3872) v = b_in[small_src_col(c - 3840)];
            biasP[c] = v; }
        for (int m = gw; m < M; m += NGW) rms_row_wave(x + (size_t)m * D, g_mix, U + (size_t)m * D, lane);
        for (int m = gw; m < 1024; m += NGW) rms_row_wave(mem + (size_t)m * D, g_mem, MEMN + (size_t)m * D, lane);
    }
    SEAM(0);
    PHASE(1) {
        { pg8::Gemm g{U, Wi, M, 4096, D}; pg8::StaticOrder S; S.init(M, 4096, G, bid);
          pg8::EpiStore<0> E{P, biasP, S32, PW, 15};
          pg8::gemm_phase<pg8::EpiStore<0>, pg8::StaticOrder, true, true>(lds3, g, S, E); }
    }
    SEAM(1);
    PHASE(2) { for (int tl_ = bid; tl_ < 256; tl_ += G) xa::memkv_tile((NLAS char*)lds_raw, MEMN, Wmkv, MEMKV, tl_);
               for (int ci = bid; ci < 1024; ci += G) ml::m1_unit((NLAS char*)lds_raw, P, ml_conv, S32, Abuf, NA, Gc, Mloc, ci);
               for (int u = bid; u < 256; u += G) cmpr::unit((NLAS char*)lds_raw, P, cmp_pe, Wc1, Wc2, KC, VC, u);
    }
    SEAM(2);
    PHASE(3) { unsigned* m2cnt = (unsigned*)ws + 12288;
               ml::m2_items(Abuf, NA, Gc, Mloc, Mprev);
               asm volatile("s_waitcnt vmcnt(0)" ::: "memory"); __syncthreads();
               if (tid == 0) { __builtin_amdgcn_fence(__ATOMIC_RELEASE, "agent"); asm volatile("s_waitcnt vmcnt(0)" ::: "memory"); __hip_atomic_fetch_add(m2cnt, 1u, __ATOMIC_RELAXED, __HIP_MEMORY_SCOPE_AGENT); }
               nsa::phase((NLAS char*)lds_raw, P, S32, KC, VC, Ynsa);
               xa::phase((NLAS char*)lds_raw, P, MEMKV, Yxa);
               if (tid == 0) { unsigned sp = 0; while (__hip_atomic_load(m2cnt, __ATOMIC_RELAXED, __HIP_MEMORY_SCOPE_AGENT) < (unsigned)G) { __builtin_amdgcn_s_sleep(2); if (++sp > (1u << 22)) break; }
                               __builtin_amdgcn_fence(__ATOMIC_ACQUIRE, "agent"); asm volatile("s_waitcnt vmcnt(0)" ::: "memory"); }
               __syncthreads();
               for (int ci = bid; ci < 1024; ci += G) ml::m3_unit((NLAS char*)lds_raw, P, ml_conv, S32, Abuf, NA, Mprev, ml_norm_g, Yml, ci); }
    SEAM(4);
    unsigned* gcnt = (unsigned*)ws + 13312 + 16 * (bid & 63);
    bool panel_sync = false;
    if (G == 256) { volatile LAS unsigned* flag = (volatile LAS unsigned*)(lds3 + LDS_BYTES - 48);
        if (wave == 0) { const unsigned* xt = (const unsigned*)ws + 12544; unsigned x0 = 0, same = 1;
            for (int k = 0; k < 4; ++k) { const unsigned xv = __hip_atomic_load(xt + lane + 64 * k, __ATOMIC_RELAXED, __HIP_MEMORY_SCOPE_AGENT); if (k == 0) x0 = xv; same &= (xv == x0 && xv != 0u) ? 1u : 0u; }
            const unsigned long long all = __ballot(same != 0u); if (lane == 0) flag[0] = (all == ~0ull) ? 1u : 0u; }
        __syncthreads();
        panel_sync = flag[0] != 0u; }
    const bool light = true;
#define PSEAM(k, n) if (lo <= (k) && (k) + 1 < hi) { if (panel_sync) group_barrier(gcnt, 4u * (n), light); else xcd_barrier(bar); }
    PHASE(5) { pg8::Gemm g{U, Wg, M, 3072, D}; pg8::StaticOrder S; S.init(M, 3072, G, bid);
               pg8::EpiStore<1> E{GATES, b_in + C_MG, nullptr, 4096, -1};
               pg8::gemm_phase<pg8::EpiStore<1>, pg8::StaticOrder, true, true>(lds3, g, S, E); }
    PSEAM(5, 1);
    PHASE(6) { pg8::Gemm g{Yml, Wbr, M, 1024, 512}; pg8::MergeOrder S; S.so.init(M, 1024, G, bid); S.sa = (size_t)M * 512 * 2; S.sb = (size_t)1024 * 512 * 2;
               pg8::EpiMergeG E{GATES, (bf16_t*)out, MERGED};
               pg8::gemm_phase<pg8::EpiMergeG, pg8::MergeOrder, true, true>(lds3, g, S, E); }
    PSEAM(6, 2);
    PHASE(7) { pg8::Gemm g{MERGED, Wo, M, 1024, D}; pg8::StaticOrder S; S.init(M, 1024, G, bid);
               pg8::EpiResRms E{x, out, nullptr, AFFN, g_ffn, (float*)(ws + WS_XCH), (unsigned*)ws + 4096};
               pg8::gemm_phase<pg8::EpiResRms, pg8::StaticOrder, false, true>(lds3, g, S, E); }
    PSEAM(7, 3);
    PHASE(9) { pg8::Gemm g{AFFN, Wf1, M, FF, D}; pg8::StaticOrder S; S.init(M, FF, G, bid);
               pg8::EpiStore<2> E{HBUF, nullptr, nullptr, FF, -1};
               pg8::gemm_phase<pg8::EpiStore<2>, pg8::StaticOrder, true, true>(lds3, g, S, E); }
    PSEAM(9, 4);
    PHASE(10) { pg8::Gemm g{HBUF, Wf2, M, 1024, FF}; pg8::StaticOrder S; S.init(M, 1024, G, bid);
                pg8::EpiResRms E{out, nullptr, out, nullptr, g_final, (float*)(ws + WS_XCH + 262144), (unsigned*)ws + 4096 + 4096};
                pg8::gemm_phase<pg8::EpiResRms, pg8::StaticOrder, false, true>(lds3, g, S, E); }
}
constexpr int N_PHASES = 12;
extern "C" void kernel_launch(void* const* d_in, const int* in_sizes, int n_in, void* d_out, int out_size, void* d_ws, size_t ws_size, hipStream_t stream) {
    static int grid = 0;
    if (grid == 0) {
        int dev = 0, cus = 0, per_cu = 0;
        (void)hipGetDevice(&dev); (void)hipDeviceGetAttribute(&cus, hipDeviceAttributeMultiprocessorCount, dev);
        (void)hipFuncSetAttribute((const void*)mega, hipFuncAttributeMaxDynamicSharedMemorySize, LDS_BYTES);
        (void)hipOccupancyMaxActiveBlocksPerMultiprocessor(&per_cu, (const void*)mega, NTHREADS, LDS_BYTES);
        if (per_cu < 1) { fprintf(stderr, "occupancy query says %d blocks/CU\n", per_cu); per_cu = 1; }
        grid = cus * 1;
        (void)hipGetLastError();
    }
    (void)hipMemsetAsync(d_ws, 0, 65536, stream);
    Args a{};
    for (int i = 0; i < 18; ++i) a.in[i] = (const float*)d_in[i];
    a.out = (float*)d_out; a.ws = (unsigned char*)d_ws;
    a.ph_lo = 0; a.ph_hi = N_PHASES; void* args[] = {&a};
    hipError_t e = hipLaunchCooperativeKernel((const void*)mega, dim3(grid), dim3(NTHREADS), args, LDS_BYTES, stream);
    if (e != hipSuccess) {
        (void)hipGetLastError();
        hipLaunchKernelGGL(mega, dim3(grid), dim3(NTHREADS), LDS_BYTES, stream, a);
    }
}
```

```cpp
#include <hip/hip_runtime.h>
#include <hip/hip_cooperative_groups.h>
#include <cstdio>
namespace cg = cooperative_groups;
#include <stdint.h>

typedef unsigned short bf16_t;
__device__ __forceinline__ float bf2f(bf16_t v) { return __uint_as_float(((unsigned)v) << 16); }
__device__ __forceinline__ bf16_t f2bf(float f) { unsigned u = __float_as_uint(f); return (bf16_t)((u + 0x7fffu + ((u >> 16) & 1u)) >> 16); }

constexpr int NB = 4, T = 4096, M = NB * T, D = 1024, DIN = 6944, FF = 4096;
constexpr float EPS = 1e-6f;
constexpr int C_MLI = 2048, C_NSG = 3336, C_MG = 3872;
constexpr int P_MLQ = 0, P_MLK = 512, P_MLV = 1024, P_MLO = 1536, P_NSQ = 2048, P_KC = 2560, P_VC = 2688, P_KS = 2816, P_VS = 2944, P_KW = 3072, P_VW = 3200, P_XAQ = 3328, PW = 3840;
constexpr size_t MiB = 1u << 20;
constexpr size_t WS_U = 40 * MiB;
constexpr size_t WS_P = 72 * MiB;
constexpr size_t WS_Y = 200 * MiB;
constexpr size_t WS_S32 = 248 * MiB;
constexpr size_t WS_MEMKV = 250 * MiB;
constexpr size_t WS_KC = 252 * MiB;
constexpr size_t WS_VC = 252 * MiB + 512 * 1024;
constexpr size_t WS_NA = 253 * MiB;
constexpr size_t WS_G = 253 * MiB + 512 * 1024;
constexpr size_t WS_MLOC = 253 * MiB + 512 * 1024 + 4096;
constexpr size_t WS_MPREV = 253 * MiB + 512 * 1024 + 8192;

__device__ __forceinline__ float wave_sum(float v) {
#pragma unroll
    for (int o = 1; o < 64; o <<= 1) v += __shfl_xor(v, o);
    return v;
}
__device__ __forceinline__ float wave_max(float v) {
#pragma unroll
    for (int o = 1; o < 64; o <<= 1) v = fmaxf(v, __shfl_xor(v, o));
    return v;
}

__device__ __forceinline__ float logsig(float x) { return fminf(x, 0.f) - log1pf(__expf(-fabsf(x))); }
namespace pg8 {
#define PG8_LAS __attribute__((address_space(3)))
typedef unsigned short bf16_t;
typedef short bf16x8 __attribute__((ext_vector_type(8)));
typedef float f32x4 __attribute__((ext_vector_type(4)));
typedef unsigned u32x4 __attribute__((ext_vector_type(4)));
constexpr int BM = 256, BK = 64, HALF = 128, HTB = HALF * BK * 2  , STAGE_BYTES = 8 * HTB, NXCD = 8, WGM = 8;

__host__ __device__ __forceinline__ int lds_byte(int r, int c) { const int st = (r >> 4) * 2 + (c >> 5), rr = r & 15, cc = c & 31, ob = rr * 64 + cc * 2; return st * 1024 + (ob ^ (((ob >> 9) & 1) << 5)); }
__host__ __device__ __forceinline__ void stage_rc(int b, int& R, int& C) { const int st = b / 1024, sb = b % 1024, swz = sb ^ (((sb >> 9) & 1) << 5); R = (st >> 1) * 16 + swz / 64; C = (st & 1) * 32 + (swz % 64) / 2; }
__host__ __device__ __forceinline__ int perm32(int rho) { const int n = rho >> 4, i = rho & 15; return 8 * (i >> 2) + 4 * n + (i & 3); }

struct Unit { int pm, pn, j; };
struct Gemm { const bf16_t* A; const bf16_t* Bt; int M, N, K; };

struct StaticOrder {
    int nM, nN, nwg, G, c;
    __host__ __device__ void init(int M, int N, int G_, int c_) { nM = M / BM; nN = N / BM; nwg = nM * nN; G = G_; c = c_; }
    __host__ __device__ bool next(int i, Unit& u) const {
        const long L = (long)i * G + c; if (L >= nwg) return false;
        int wgid = (int)L; { const int q = nwg / NXCD, r = nwg % NXCD, xcd = wgid % NXCD, off = wgid / NXCD; wgid = (xcd < r ? xcd * (q + 1) : r * (q + 1) + (xcd - r) * q) + off; }
        const int nig = WGM * nN, gid = wgid / nig, fm = gid * WGM, gsz = (nM - fm) < WGM ? (nM - fm) : WGM;
        u.pm = fm + ((wgid % nig) % gsz); u.pn = (wgid % nig) / gsz; u.j = 0; return true;
    }
    __device__ __forceinline__ const char* pa(const Gemm& g, const Unit& u, size_t tstep) const { return (const char*)g.A + (size_t)u.pm * tstep; }
    __device__ __forceinline__ const char* pb(const Gemm& g, const Unit& u, size_t tstep) const { return (const char*)g.Bt + (size_t)u.pn * tstep; }
    __device__ __forceinline__ void a_ready(const Unit&) const {}
    __device__ __forceinline__ void done(const Unit&) const {}
};

struct MergeOrder {
    StaticOrder so; size_t sa, sb;
    __device__ __forceinline__ bool next(int i, Unit& u) const { if (i >= 3) return false; const bool ok = so.next(0, u); u.j = i; return ok; }
    __device__ __forceinline__ const char* pa(const Gemm& g, const Unit& u, size_t tstep) const { return (const char*)g.A + (size_t)u.j * sa + (size_t)u.pm * tstep; }
    __device__ __forceinline__ const char* pb(const Gemm& g, const Unit& u, size_t tstep) const { return (const char*)g.Bt + (size_t)u.j * sb + (size_t)u.pn * tstep; }
    __device__ __forceinline__ void a_ready(const Unit&) const {}
    __device__ __forceinline__ void done(const Unit&) const {}
};
typedef float f32x2_t __attribute__((ext_vector_type(2))); typedef __bf16 bf16x2_t __attribute__((ext_vector_type(2)));
__device__ __forceinline__ unsigned cvt_pk_bf16(float lo, float hi) { f32x2_t v = {lo, hi}; bf16x2_t b = __builtin_convertvector(v, bf16x2_t); return __builtin_bit_cast(unsigned, b); }
typedef float f32x2 __attribute__((ext_vector_type(2)));

typedef unsigned u32x2 __attribute__((ext_vector_type(2)));
__device__ __forceinline__ float bflo(unsigned w) { return __uint_as_float(w << 16); }
__device__ __forceinline__ float bfhi(unsigned w) { return __uint_as_float(w & 0xffff0000u); }
template <int ACT> __device__ __forceinline__ f32x4 act4(f32x4 v) {
    if (ACT == 1) { f32x4 o; for (int e = 0; e < 4; ++e) o[e] = __builtin_amdgcn_rcpf(1.f + __expf(-v[e])); return o; }
    if (ACT == 2) { f32x4 o; for (int e = 0; e < 4; ++e) { const float r = fmaxf(v[e], 0.f); o[e] = r * r; } return o; }
    return v;
}
template <int ACT> struct EpiStore {
    static constexpr bool PERM = true, AFTER_DRAIN = false;
    bf16_t* O; const float* bias; float* S32; int ldc, small_pn;
    __device__ __forceinline__ void operator()(const f32x4 (&acc)[2][2][4][2], const Unit& u, int wr, int wc, int fr, int fq) const {
        asm volatile("s_waitcnt vmcnt(0)" ::: "memory");
        const int row0 = u.pm * BM + wr * 64 + fr, col0 = u.pn * BM + wc * 32 + 8 * fq;
        if (u.pn == small_pn) {
            if (wc == 0) {
                const f32x4 b0 = *(const f32x4*)(bias + col0), b1 = *(const f32x4*)(bias + col0 + 4);
#pragma unroll
                for (int ai = 0; ai < 2; ++ai)
#pragma unroll
                    for (int m = 0; m < 4; ++m) { float* rp = S32 + (size_t)(row0 + ai * HALF + m * 16) * 32 + 8 * fq;
                        *(f32x4*)rp = acc[ai][0][m][0] + acc[ai][1][m][0] + b0; *(f32x4*)(rp + 4) = acc[ai][0][m][1] + acc[ai][1][m][1] + b1; }
            }
            return;
        }
        f32x4 bv[2][2];
#pragma unroll
        for (int bj = 0; bj < 2; ++bj)
#pragma unroll
            for (int n = 0; n < 2; ++n) bv[bj][n] = bias ? *(const f32x4*)(bias + col0 + bj * HALF + 4 * n) : (f32x4){0.f, 0.f, 0.f, 0.f};
#pragma unroll
        for (int ai = 0; ai < 2; ++ai)
#pragma unroll
            for (int m = 0; m < 4; ++m) { bf16_t* rowp = O + (size_t)(row0 + ai * HALF + m * 16) * ldc + col0;
#pragma unroll
                for (int bj = 0; bj < 2; ++bj) { const f32x4 v0 = act4<ACT>(acc[ai][bj][m][0] + bv[bj][0]), v1 = act4<ACT>(acc[ai][bj][m][1] + bv[bj][1]);
                    u32x4 w; w.x = cvt_pk_bf16(v0[0], v0[1]); w.y = cvt_pk_bf16(v0[2], v0[3]); w.z = cvt_pk_bf16(v1[0], v1[1]); w.w = cvt_pk_bf16(v1[2], v1[3]);
                    *(u32x4*)(rowp + bj * HALF) = w; } }
    }
};
struct EpiMergeG {
    static constexpr bool PERM = true, AFTER_DRAIN = false;
    const bf16_t* G; bf16_t* Mp; bf16_t* Mb;
    template <bool HASP>
    __device__ __forceinline__ void body(const f32x4 (&acc)[2][2][4][2], int j, bf16_t* dst, size_t dpitch, int row0, int col0) const {
        constexpr size_t mpitch = 2048;
#pragma unroll
        for (int ai = 0; ai < 2; ++ai) { u32x4 gw[4][2], pw[4][2];
#pragma unroll
            for (int m = 0; m < 4; ++m)
#pragma unroll
                for (int bj = 0; bj < 2; ++bj) { const size_t row = (size_t)(row0 + ai * HALF + m * 16); const int col = col0 + bj * HALF;
                    gw[m][bj] = *(const u32x4*)(G + row * 4096 + j * 1024 + col); if (HASP) pw[m][bj] = *(const u32x4*)(Mp + row * mpitch + col); }
#pragma unroll
            for (int m = 0; m < 4; ++m)
#pragma unroll
                for (int bj = 0; bj < 2; ++bj) { const size_t row = (size_t)(row0 + ai * HALF + m * 16); const int col = col0 + bj * HALF; const u32x4 g4 = gw[m][bj];
                    f32x4 v0 = (f32x4){bflo(g4.x), bfhi(g4.x), bflo(g4.y), bfhi(g4.y)} * acc[ai][bj][m][0], v1 = (f32x4){bflo(g4.z), bfhi(g4.z), bflo(g4.w), bfhi(g4.w)} * acc[ai][bj][m][1];
                    if (HASP) { const u32x4 p4 = pw[m][bj]; v0 += (f32x4){bflo(p4.x), bfhi(p4.x), bflo(p4.y), bfhi(p4.y)}; v1 += (f32x4){bflo(p4.z), bfhi(p4.z), bflo(p4.w), bfhi(p4.w)}; }
                    u32x4 w; w.x = cvt_pk_bf16(v0[0], v0[1]); w.y = cvt_pk_bf16(v0[2], v0[3]); w.z = cvt_pk_bf16(v1[0], v1[1]); w.w = cvt_pk_bf16(v1[2], v1[3]); *(u32x4*)(dst + row * dpitch + col) = w; } }
    }
    __device__ __forceinline__ void operator()(const f32x4 (&acc)[2][2][4][2], const Unit& u, int wr, int wc, int fr, int fq) const {
        const int j = u.j;
        asm volatile("s_waitcnt vmcnt(0)" ::: "memory");
        const int row0 = u.pm * BM + wr * 64 + fr, col0 = u.pn * BM + wc * 32 + 8 * fq;
        if (j == 0) body<false>(acc, 0, Mp, 2048, row0, col0);
        else if (j == 1) body<true>(acc, 1, Mp, 2048, row0, col0);
        else body<true>(acc, 2, Mb, 1024, row0, col0);
    }
};
struct EpiResidF {
    static constexpr bool PERM = true, AFTER_DRAIN = false;
    const float* X; float* O;
    __device__ __forceinline__ void operator()(const f32x4 (&acc)[2][2][4][2], const Unit& u, int wr, int wc, int fr, int fq) const {
        asm volatile("s_waitcnt vmcnt(0)" ::: "memory");
        const int row0 = u.pm * BM + wr * 64 + fr, col0 = u.pn * BM + wc * 32 + 8 * fq;
#pragma unroll
        for (int ai = 0; ai < 2; ++ai)
#pragma unroll
            for (int m = 0; m < 4; ++m) { const size_t off = (size_t)(row0 + ai * HALF + m * 16) * 1024 + col0;
#pragma unroll
                for (int bj = 0; bj < 2; ++bj) { const f32x4 x0 = *(const f32x4*)(X + off + bj * HALF), x1 = *(const f32x4*)(X + off + bj * HALF + 4);
                    *(f32x4*)(O + off + bj * HALF) = x0 + acc[ai][bj][m][0]; *(f32x4*)(O + off + bj * HALF + 4) = x1 + acc[ai][bj][m][1]; } }
    }
};
struct EpiResRms {
    static constexpr bool PERM = false, AFTER_DRAIN = true;
    const float* R; float* Hout; float* Nf; bf16_t* Nb; const float* gain; float* xbuf; unsigned* cnt;
    __device__ __forceinline__ void fused(f32x4 (&acc)[2][2][4][2], const Unit& u, int wr, int wc, int fr, int fq, PG8_LAS unsigned char* lds, int wid, int lane) const {
        PG8_LAS float* Pp = (PG8_LAS float*)lds; PG8_LAS float* S = (PG8_LAS float*)(lds + 4096);
        const int col0 = u.pn * BM + wc * 32 + 4 * fq;
#pragma unroll
        for (int ai = 0; ai < 2; ++ai) { f32x4 pre[4][2][2];
#pragma unroll
            for (int m = 0; m < 4; ++m) { const size_t off = (size_t)(u.pm * BM + ai * HALF + wr * 64 + m * 16 + fr) * 1024 + col0;
#pragma unroll
                for (int bj = 0; bj < 2; ++bj)
#pragma unroll
                    for (int n = 0; n < 2; ++n) pre[m][bj][n] = *(const f32x4*)(R + off + bj * HALF + n * 16); }
#pragma unroll
            for (int m = 0; m < 4; ++m) { float sq = 0.f;
#pragma unroll
                for (int bj = 0; bj < 2; ++bj)
#pragma unroll
                    for (int n = 0; n < 2; ++n) { const f32x4 v = acc[ai][bj][m][n] + pre[m][bj][n]; acc[ai][bj][m][n] = v; sq += (v[0] * v[0] + v[1] * v[1]) + (v[2] * v[2] + v[3] * v[3]); }
                sq += __shfl_xor(sq, 16); sq += __shfl_xor(sq, 32);
                if (fq == 0) Pp[(ai * HALF + wr * 64 + m * 16 + fr) * 4 + wc] = sq; } }
        asm volatile("s_waitcnt lgkmcnt(0)" ::: "memory"); __builtin_amdgcn_s_barrier(); asm volatile("" ::: "memory");
        const int row = wid * 32 + (lane & 31);
        if (lane < 32) { const float tot = (Pp[row * 4 + 0] + Pp[row * 4 + 1]) + (Pp[row * 4 + 2] + Pp[row * 4 + 3]);
            __hip_atomic_store(xbuf + ((size_t)(u.pm * BM + row) * 4 + u.pn), tot, __ATOMIC_RELAXED, __HIP_MEMORY_SCOPE_AGENT); }
        asm volatile("s_waitcnt vmcnt(0)" ::: "memory");
        if (lane == 0) __hip_atomic_fetch_add(cnt + 64 * u.pm, 1u, __ATOMIC_RELAXED, __HIP_MEMORY_SCOPE_AGENT);
        if (wid == 0) { unsigned sp = 0;
            while ((unsigned)__builtin_amdgcn_readfirstlane(__hip_atomic_load(cnt + 64 * u.pm, __ATOMIC_RELAXED, __HIP_MEMORY_SCOPE_AGENT)) < 32u) { __builtin_amdgcn_s_sleep(2); if (++sp > (1u << 22)) break; }
            __builtin_amdgcn_fence(__ATOMIC_ACQUIRE, "agent"); }
        asm volatile("s_waitcnt vmcnt(0) lgkmcnt(0)" ::: "memory"); __builtin_amdgcn_s_barrier(); asm volatile("" ::: "memory");
        if (lane < 32) { const float* slot = xbuf + (size_t)(u.pm * BM + row) * 4; float t = 0.f;
#pragma unroll
            for (int q = 0; q < 4; ++q) t += __hip_atomic_load(slot + q, __ATOMIC_RELAXED, __HIP_MEMORY_SCOPE_AGENT);
            S[row] = rsqrtf(t * (1.0f / 1024.0f) + 1e-6f); }
        asm volatile("s_waitcnt lgkmcnt(0)" ::: "memory"); __builtin_amdgcn_s_barrier(); asm volatile("" ::: "memory");
        f32x4 gv[2][2];
#pragma unroll
        for (int bj = 0; bj < 2; ++bj)
#pragma unroll
            for (int n = 0; n < 2; ++n) gv[bj][n] = *(const f32x4*)(gain + col0 + bj * HALF + n * 16);
#pragma unroll
        for (int ai = 0; ai < 2; ++ai)
#pragma unroll
            for (int m = 0; m < 4; ++m) { const int r = ai * HALF + wr * 64 + m * 16 + fr; const float rs = S[r]; const size_t off = (size_t)(u.pm * BM + r) * 1024 + col0;
#pragma unroll
                for (int bj = 0; bj < 2; ++bj)
#pragma unroll
                    for (int n = 0; n < 2; ++n) { const f32x4 v = acc[ai][bj][m][n]; const f32x4 o = v * rs * gv[bj][n];
                        if (Hout) *(f32x4*)(Hout + off + bj * HALF + n * 16) = v;
                        if (Nf) *(f32x4*)(Nf + off + bj * HALF + n * 16) = o;
                        if (Nb) { u32x2 w; w.x = cvt_pk_bf16(o[0], o[1]); w.y = cvt_pk_bf16(o[2], o[3]); *(u32x2*)(Nb + off + bj * HALF + n * 16) = w; } } }
    }
};

template <class Epi, class Sched, bool ALIGN_EPI = false, bool SP2 = false>
__device__ __forceinline__ void gemm_phase(PG8_LAS unsigned char* lds, const Gemm g, const Sched& S, const Epi& E) {
    const int tid = threadIdx.x, wid = __builtin_amdgcn_readfirstlane(tid >> 6), lane = tid & 63, wr = wid >> 2, wc = wid & 3, fr = lane & 15, fq = lane >> 4;
    const int K = g.K, nt = K / BK;
    unsigned voffA[2], voffB[2];
#pragma unroll
    for (int i = 0; i < 2; ++i) { int R, C; stage_rc(tid * 16 + i * 8192, R, C); const int Rb = Epi::PERM ? ((R & ~31) + perm32(R & 31)) : R;
        voffA[i] = (unsigned)(R * K + C) * 2u; voffB[i] = (unsigned)(Rb * K + C) * 2u; }
    const size_t kstep = (size_t)(BK * 2);
    const size_t hstep = (size_t)HALF * K * 2;
    const size_t tstep = 2 * hstep;
    const unsigned ldsw = (unsigned)wid * 1024u;
    const int aoff = lds_byte(wr * 64 + fr, fq * 8), boff = lds_byte(wc * 32 + fr, fq * 8);
#define PG8_SA(b, h) (((b) * 2 + (h)) * HTB)
#define PG8_SB(b, h) ((4 + (b) * 2 + (h)) * HTB)
#define PG8_STAGE(bufoff, gbase, voff) do { _Pragma("unroll") for (int _i = 0; _i < 2; ++_i) \
        __builtin_amdgcn_global_load_lds((const unsigned*)((const char*)(gbase) + (voff)[_i]), (PG8_LAS unsigned*)(lds + (bufoff) + ldsw + _i * 8192), 16, 0, 0); } while (0)
#define PG8_LDA(dst, b, h) do { _Pragma("unroll") for (int m = 0; m < 4; ++m) _Pragma("unroll") for (int k = 0; k < 2; ++k) dst[m][k] = *(const PG8_LAS bf16x8*)(lds + PG8_SA(b, h) + aoff + m * 2048 + k * 1024); } while (0)
#define PG8_LDB(dst, b, h) do { _Pragma("unroll") for (int n = 0; n < 2; ++n) _Pragma("unroll") for (int k = 0; k < 2; ++k) dst[n][k] = *(const PG8_LAS bf16x8*)(lds + PG8_SB(b, h) + boff + n * 2048 + k * 1024); } while (0)
#define PG8_MMA(ai, bj, At, Bt) do { __builtin_amdgcn_s_setprio(1); _Pragma("unroll") for (int m = 0; m < 4; ++m) _Pragma("unroll") for (int n = 0; n < 2; ++n) _Pragma("unroll") for (int k = 0; k < 2; ++k) \
        acc[ai][bj][m][n] = __builtin_amdgcn_mfma_f32_16x16x32_bf16(Bt[n][k], At[m][k], acc[ai][bj][m][n], 0, 0, 0); __builtin_amdgcn_s_setprio(0); } while (0)
#define PG8_WAIT_V(n) asm volatile("s_waitcnt vmcnt(" #n ")" ::: "memory")
#define PG8_WAIT_L(n) asm volatile("s_waitcnt lgkmcnt(" #n ")" ::: "memory")
#define PG8_BAR __builtin_amdgcn_s_barrier()
#define PG8_SCHED __builtin_amdgcn_sched_barrier(0)
    Unit cur, nxt; int ui = 0;
    if (!S.next(0, cur)) return;
    f32x4 acc[2][2][4][2];
#pragma unroll
    for (int a = 0; a < 2; ++a)
#pragma unroll
        for (int b = 0; b < 2; ++b)
#pragma unroll
            for (int m = 0; m < 4; ++m)
#pragma unroll
                for (int n = 0; n < 2; ++n) acc[a][b][m][n] = (f32x4){0.f, 0.f, 0.f, 0.f};
    bf16x8 At[4][2], B0[2][2], B1[2][2];
    const char* cA = S.pa(g, cur, tstep); const char* cB = S.pb(g, cur, tstep);
    S.a_ready(cur);
    if constexpr (SP2) {
        PG8_STAGE(PG8_SB(0, 0), cB, voffB); PG8_STAGE(PG8_SB(0, 1), cB + hstep, voffB); PG8_STAGE(PG8_SA(0, 0), cA, voffA); PG8_STAGE(PG8_SA(0, 1), cA + hstep, voffA);
        if (wr == 1) PG8_BAR;
        PG8_WAIT_V(2); PG8_BAR;
        PG8_STAGE(PG8_SB(1, 0), cB + kstep, voffB); PG8_STAGE(PG8_SA(1, 0), cA + kstep, voffA); PG8_STAGE(PG8_SB(1, 1), cB + hstep + kstep, voffB);
        PG8_WAIT_V(6); PG8_BAR;
    } else {
        PG8_STAGE(PG8_SB(0, 0), cB, voffB); PG8_STAGE(PG8_SA(0, 0), cA, voffA); PG8_STAGE(PG8_SB(0, 1), cB + hstep, voffB); PG8_STAGE(PG8_SA(0, 1), cA + hstep, voffA);
        if (wr == 1) PG8_BAR;
        PG8_WAIT_V(4); PG8_BAR;
        PG8_STAGE(PG8_SB(1, 0), cB + kstep, voffB); PG8_STAGE(PG8_SA(1, 0), cA + kstep, voffA); PG8_STAGE(PG8_SB(1, 1), cB + hstep + kstep, voffB);
        PG8_WAIT_V(6); PG8_BAR;
    }
    for (;;) {
        const bool has_next = S.next(ui + 1, nxt);
        const char* nA = has_next ? S.pa(g, nxt, tstep) : cA; const char* nB = has_next ? S.pb(g, nxt, tstep) : cB;
        for (int t = 0; t < nt; t += 2) {
            const bool last = (t == nt - 2);
            const char* a1 = cA + (size_t)(t + 1) * kstep;
            const char* a2 = last ? nA : cA + (size_t)(t + 2) * kstep; const char* b2 = last ? nB : cB + (size_t)(t + 2) * kstep;
            const char* a3 = a2 + kstep; const char* b3 = b2 + kstep;
            if (last && has_next) S.a_ready(nxt);
            if constexpr (SP2) {
            PG8_LDB(B0, 0, 0); PG8_LDB(B1, 0, 1); PG8_SCHED; PG8_LDA(At, 0, 0); PG8_STAGE(PG8_SA(1, 1), a1 + hstep, voffA);
            PG8_WAIT_V(8); PG8_WAIT_L(0); PG8_BAR; PG8_MMA(0, 0, At, B0); PG8_MMA(0, 1, At, B1); PG8_BAR; PG8_SCHED;
            PG8_LDA(At, 0, 1); PG8_STAGE(PG8_SB(0, 0), b2, voffB); PG8_STAGE(PG8_SB(0, 1), b2 + hstep, voffB); PG8_STAGE(PG8_SA(0, 0), a2, voffA);
            PG8_WAIT_V(8); PG8_WAIT_L(0); PG8_BAR; PG8_MMA(1, 0, At, B0); PG8_MMA(1, 1, At, B1); PG8_BAR; PG8_SCHED;
            PG8_LDB(B0, 1, 0); PG8_LDB(B1, 1, 1); PG8_SCHED; PG8_LDA(At, 1, 0); PG8_STAGE(PG8_SA(0, 1), a2 + hstep, voffA);
            PG8_WAIT_V(8); PG8_WAIT_L(0); PG8_BAR; PG8_MMA(0, 0, At, B0); PG8_MMA(0, 1, At, B1); PG8_BAR; PG8_SCHED;
            PG8_LDA(At, 1, 1); PG8_STAGE(PG8_SB(1, 0), b3, voffB); PG8_STAGE(PG8_SB(1, 1), b3 + hstep, voffB); PG8_STAGE(PG8_SA(1, 0), a3, voffA);
            PG8_WAIT_V(8); PG8_WAIT_L(0); PG8_BAR; PG8_MMA(1, 0, At, B0); PG8_MMA(1, 1, At, B1); PG8_BAR; PG8_SCHED;
            } else {
            PG8_LDB(B0, 0, 0); PG8_SCHED; PG8_LDA(At, 0, 0); PG8_STAGE(PG8_SA(1, 1), a1 + hstep, voffA);
            PG8_WAIT_L(8); PG8_BAR; PG8_WAIT_L(0); PG8_MMA(0, 0, At, B0); PG8_BAR; PG8_SCHED;
            PG8_LDB(B1, 0, 1); PG8_STAGE(PG8_SB(0, 0), b2, voffB);
            PG8_BAR; PG8_WAIT_L(0); PG8_MMA(0, 1, At, B1); PG8_BAR;
            PG8_LDA(At, 0, 1); PG8_STAGE(PG8_SA(0, 0), a2, voffA);
            PG8_BAR; PG8_WAIT_L(0); PG8_MMA(1, 0, At, B0); PG8_BAR; PG8_SCHED;
            PG8_STAGE(PG8_SB(0, 1), b2 + hstep, voffB);
            PG8_WAIT_V(6); PG8_BAR; PG8_MMA(1, 1, At, B1); PG8_BAR;
            PG8_LDB(B0, 1, 0); PG8_SCHED; PG8_LDA(At, 1, 0); PG8_STAGE(PG8_SA(0, 1), a2 + hstep, voffA);
            PG8_WAIT_L(8); PG8_BAR; PG8_WAIT_L(0); PG8_MMA(0, 0, At, B0); PG8_BAR; PG8_SCHED;
            PG8_LDB(B1, 1, 1); PG8_STAGE(PG8_SB(1, 0), b3, voffB);
            PG8_BAR; PG8_WAIT_L(0); PG8_MMA(0, 1, At, B1); PG8_BAR;
            PG8_LDA(At, 1, 1); PG8_STAGE(PG8_SA(1, 0), a3, voffA);
            PG8_BAR; PG8_WAIT_L(0); PG8_MMA(1, 0, At, B0); PG8_BAR; PG8_SCHED;
            PG8_STAGE(PG8_SB(1, 1), b3 + hstep, voffB);
            PG8_WAIT_V(6); PG8_BAR; PG8_MMA(1, 1, At, B1); PG8_BAR;
            }
        }
        if constexpr (ALIGN_EPI) { if (wr == 0) PG8_BAR; }
        if constexpr (!Epi::AFTER_DRAIN) { E(acc, cur, wr, wc, fr, fq); S.done(cur); }
        if (!has_next) break;
#pragma unroll
        for (int a = 0; a < 2; ++a)
#pragma unroll
            for (int b = 0; b < 2; ++b)
#pragma unroll
                for (int m = 0; m < 4; ++m)
#pragma unroll
                    for (int n = 0; n < 2; ++n) acc[a][b][m][n] = (f32x4){0.f, 0.f, 0.f, 0.f};
        cur = nxt; cA = nA; cB = nB; ++ui;
        if constexpr (ALIGN_EPI) { if (wr == 1) PG8_BAR; }
    }
    PG8_WAIT_V(0);
    if constexpr (!ALIGN_EPI) { if (wr == 0) PG8_BAR; }
    PG8_BAR;
    if constexpr (Epi::AFTER_DRAIN) { E.fused(acc, cur, wr, wc, fr, fq, lds, wid, lane); S.done(cur); }
#undef PG8_SA
#undef PG8_SB
#undef PG8_STAGE
#undef PG8_LDA
#undef PG8_LDB
#undef PG8_MMA
#undef PG8_WAIT_V
#undef PG8_WAIT_L
#undef PG8_BAR
#undef PG8_SCHED
}
}

namespace nsa {
#define NLAS __attribute__((address_space(3)))
typedef short bf16x8 __attribute__((ext_vector_type(8)));
typedef short s16x4 __attribute__((ext_vector_type(4)));
typedef short v4i16_t __attribute__((ext_vector_type(4)));
typedef float f32x4 __attribute__((ext_vector_type(4)));
typedef unsigned u32x4 __attribute__((ext_vector_type(4)));
typedef unsigned u32x2 __attribute__((ext_vector_type(2)));
typedef unsigned long long u64;
constexpr int RS = 144, TILE_B = 64 * RS;
constexpr float LOG2E = 1.4426950408889634f;
constexpr int L_KB0 = 0, L_VB0 = TILE_B, L_KB1 = 2 * TILE_B, L_VB1 = 3 * TILE_B, L_CK = 4 * TILE_B, L_CV = 8 * TILE_B, L_IMP = 12 * TILE_B, L_MSK = L_IMP + 8192, L_WU = L_MSK + 256, L_END = L_WU + 64;
static_assert(L_END <= 131072, "nsa LDS map");
__device__ __forceinline__ s16x4 vtr(const NLAS char* p) { return __builtin_bit_cast(s16x4, __builtin_amdgcn_ds_read_tr16_b64_v4i16((NLAS v4i16_t*)p)); }
__device__ __forceinline__ f32x4 mfma16(bf16x8 a, bf16x8 b, f32x4 c) { return __builtin_amdgcn_mfma_f32_16x16x32_bf16(a, b, c, 0, 0, 0); }
__device__ __forceinline__ unsigned pkbf(float lo, float hi) { return pg8::cvt_pk_bf16(lo, hi); }
__device__ __forceinline__ void qk_tile(f32x4 (&s)[4], const NLAS char* Kb, const bf16x8 (&qf)[2], int i, int g, float kslope, float bt) {
    bf16x8 a[4][2]; const NLAS char* kp = Kb + i * RS + 16 * g;
#pragma unroll
    for (int kb = 0; kb < 4; ++kb) { a[kb][0] = *(const NLAS bf16x8*)(kp + kb * 16 * RS); a[kb][1] = *(const NLAS bf16x8*)(kp + kb * 16 * RS + 64); }
    __builtin_amdgcn_sched_barrier(0);
#pragma unroll
    for (int kb = 0; kb < 4; ++kb) { f32x4 ci; ci[0] = fmaf(kslope, (float)(kb * 16 + 0), bt); ci[1] = fmaf(kslope, (float)(kb * 16 + 1), bt); ci[2] = fmaf(kslope, (float)(kb * 16 + 2), bt); ci[3] = fmaf(kslope, (float)(kb * 16 + 3), bt);
        s[kb] = mfma16(a[kb][0], qf[0], ci); }
#pragma unroll
    for (int kb = 0; kb < 4; ++kb) s[kb] = mfma16(a[kb][1], qf[1], s[kb]);
}
__device__ __forceinline__ void pv_tile(f32x4 (&o)[4], const NLAS char* Vb, const f32x4 (&p)[4], int i, int g) {
    const NLAS char* vb = Vb + (4 * g + (i >> 2)) * RS + (i & 3) * 8;
    s16x4 lo[2][4], hi[2][4];
#pragma unroll
    for (int kk = 0; kk < 2; ++kk)
#pragma unroll
        for (int db = 0; db < 4; ++db) { const NLAS char* vp = vb + (2 * kk) * 16 * RS + db * 32; lo[kk][db] = vtr(vp); hi[kk][db] = vtr(vp + 16 * RS); }
    bf16x8 pf[2];
#pragma unroll
    for (int kk = 0; kk < 2; ++kk) { u32x4 pw; pw.x = pkbf(p[2 * kk][0], p[2 * kk][1]); pw.y = pkbf(p[2 * kk][2], p[2 * kk][3]); pw.z = pkbf(p[2 * kk + 1][0], p[2 * kk + 1][1]); pw.w = pkbf(p[2 * kk + 1][2], p[2 * kk + 1][3]);
        pf[kk] = __builtin_bit_cast(bf16x8, pw); }
#pragma unroll
    for (int kk = 0; kk < 2; ++kk)
#pragma unroll
        for (int db = 0; db < 4; ++db) o[db] = mfma16((bf16x8){lo[kk][db][0], lo[kk][db][1], lo[kk][db][2], lo[kk][db][3], hi[kk][db][0], hi[kk][db][1], hi[kk][db][2], hi[kk][db][3]}, pf[kk], o[db]);
}
constexpr float THR = 6.0f;
template <bool FIRST>
__device__ __forceinline__ float online_tile(f32x4 (&s)[4], float& m, float& l, f32x4 (&o)[4], bool needmask, int base, int lo, int hi) {
    float fret = 1.f;
    if (needmask) {
#pragma unroll
        for (int kb = 0; kb < 4; ++kb)
#pragma unroll
            for (int r = 0; r < 4; ++r) { const int pos = base + kb * 16 + r; s[kb][r] = (pos >= lo && pos <= hi) ? s[kb][r] : -INFINITY; } }
    float mt = fmaxf(fmaxf(fmaxf(s[0][0], s[0][1]), fmaxf(s[0][2], s[0][3])), fmaxf(fmaxf(s[1][0], s[1][1]), fmaxf(s[1][2], s[1][3])));
    mt = fmaxf(mt, fmaxf(fmaxf(fmaxf(s[2][0], s[2][1]), fmaxf(s[2][2], s[2][3])), fmaxf(fmaxf(s[3][0], s[3][1]), fmaxf(s[3][2], s[3][3]))));
    if (FIRST || __any(mt > THR)) {
        mt = fmaxf(mt, __shfl_xor(mt, 16)); mt = fmaxf(mt, __shfl_xor(mt, 32));
        const float d = FIRST ? ((mt == -INFINITY) ? 0.f : mt) : fmaxf(mt, 0.f), f = __builtin_amdgcn_exp2f(-d); m += d; l *= f; fret = f;
#pragma unroll
        for (int db = 0; db < 4; ++db) o[db] = o[db] * f;
#pragma unroll
        for (int kb = 0; kb < 4; ++kb) s[kb] = s[kb] - d; }
    float sum = 0.f;
#pragma unroll
    for (int kb = 0; kb < 4; ++kb)
#pragma unroll
        for (int r = 0; r < 4; ++r) { const float p = __builtin_amdgcn_exp2f(s[kb][r]); s[kb][r] = p; sum += p; }
    l += sum;
    return fret;
}
struct Stg { u32x4 k, v; };
__device__ __forceinline__ void stg_load(Stg& r, const bf16_t* kb, const bf16_t* vb, size_t pitch, int tid) { const size_t off = (size_t)(tid >> 3) * pitch + (tid & 7) * 8; r.k = *(const u32x4*)(kb + off); r.v = *(const u32x4*)(vb + off); }
__device__ __forceinline__ void stg_store(NLAS char* lds, int ko, int vo, const Stg& r, int tid) { const int off = (tid >> 3) * RS + (tid & 7) * 16; *(NLAS u32x4*)(lds + ko + off) = r.k; *(NLAS u32x4*)(lds + vo + off) = r.v; }
template <bool FIRST>
__device__ __forceinline__ void pair_tiles(const NLAS char* lds, int koA, int voA, int koB, int voB, bool na, bool nb, const bf16x8 (&qf)[2], int i, int g, float slope2,
                                           float btA, float btB, bool maskA, bool maskB, int baseA, int baseB, int lo, int hi, float& m, float& l, f32x4 (&o)[4]) {
    f32x4 sa[4], sb[4];
    if (na) qk_tile(sa, lds + koA, qf, i, g, slope2, btA - m);
    if (nb) qk_tile(sb, lds + koB, qf, i, g, slope2, btB - m);
    float da = 0.f;
    if (na) { const float m0 = m; online_tile<FIRST>(sa, m, l, o, FIRST || maskA, baseA, lo, hi); da = m - m0; pv_tile(o, lds + voA, sa, i, g); }
    if (nb) { if (__any(da != 0.f)) {
#pragma unroll
            for (int kb = 0; kb < 4; ++kb) sb[kb] = sb[kb] - da; }
        online_tile<false>(sb, m, l, o, maskB, baseB, lo, hi); pv_tile(o, lds + voB, sb, i, g); }
}
__device__ __forceinline__ float sigm(float v) { return __builtin_amdgcn_rcpf(1.f + __expf(-v)); }

__device__ __forceinline__ void unit(NLAS char* lds, const bf16_t* P, const float* S32, const bf16_t* KC, const bf16_t* VC, bf16_t* Ynsa, int b, int gq, int ti) {
    const int tid = threadIdx.x, lane = tid & 63, w = __builtin_amdgcn_readfirstlane(tid >> 6), i = lane & 15, g = lane >> 4;
    const int t0 = ti * 32, tl_mine = i >> 2, r = i & 3, h = gq * 4 + r, t = t0 + 4 * w + tl_mine; const size_t m = (size_t)b * T + t;
    const float slope2 = __builtin_amdgcn_exp2f(-(float)(h + 1)) * LOG2E;
    bf16x8 qf[2]; constexpr float QS = 0.125f * LOG2E;
    { const bf16_t* qp = P + m * PW + P_NSQ + h * 64 + 8 * g;
#pragma unroll
      for (int ks = 0; ks < 2; ++ks) { const u32x4 raw = *(const u32x4*)(qp + 32 * ks); u32x4 sc;
          sc.x = pkbf(pg8::bflo(raw.x) * QS, pg8::bfhi(raw.x) * QS); sc.y = pkbf(pg8::bflo(raw.y) * QS, pg8::bfhi(raw.y) * QS);
          sc.z = pkbf(pg8::bflo(raw.z) * QS, pg8::bfhi(raw.z) * QS); sc.w = pkbf(pg8::bflo(raw.w) * QS, pg8::bfhi(raw.w) * QS);
          qf[ks] = __builtin_bit_cast(bf16x8, sc); } }
    const float* gp = S32 + m * 32 + 8 + h * 3;
    const float gate0 = sigm(gp[0]), gate1 = sigm(gp[1]), gate2 = sigm(gp[2]);
    f32x4 outacc[4];
#pragma unroll
    for (int db = 0; db < 4; ++db) outacc[db] = (f32x4){0.f, 0.f, 0.f, 0.f};
    const int ntc = (ti >> 5) + 1;
    { Stg sc_[4];
#pragma unroll
      for (int tile = 0; tile < 4; ++tile) if (tile < ntc) { const size_t row0 = ((size_t)(b * 256 + tile * 64) * 2 + gq) * 64; stg_load(sc_[tile], KC + row0, VC + row0, 128, tid); }
#pragma unroll
      for (int tile = 0; tile < 4; ++tile) if (tile < ntc) stg_store(lds, L_CK + tile * TILE_B, L_CV + tile * TILE_B, sc_[tile], tid); }
    __syncthreads();
    { const int nmax = (t - 31) >> 4, nmax_w = ((t0 + 4 * w) - 31) >> 4; const float kslope = 16.f * slope2, c = -slope2 * (float)(t - 31);
      float mc = 0.f, lc = 0.f; f32x4 oc[4]; float av[16], cv[16];
#pragma unroll
      for (int db = 0; db < 4; ++db) oc[db] = (f32x4){0.f, 0.f, 0.f, 0.f};
#pragma unroll
      for (int q = 0; q < 16; ++q) { av[q] = 0.f; cv[q] = 0.f; }
      bool firstc = true;
#pragma unroll
      for (int tile = 3; tile >= 0; --tile) {
          if (tile < ntc) { f32x4 s[4]; qk_tile(s, lds + L_CK + tile * TILE_B, qf, i, g, kslope, fmaf(kslope, (float)(tile * 64 + 4 * g), c) - mc);
              const bool needmask = (tile * 64 + 63 > nmax_w);
              const float f = firstc ? online_tile<true>(s, mc, lc, oc, needmask, tile * 64 + 4 * g, -0x40000000, nmax) : online_tile<false>(s, mc, lc, oc, needmask, tile * 64 + 4 * g, -0x40000000, nmax);
              if (!firstc && __any(f != 1.f)) {
#pragma unroll
                  for (int q = 0; q < 16; ++q) { av[q] *= f; cv[q] *= f; } }
              firstc = false;
              pv_tile(oc, lds + L_CV + tile * TILE_B, s, i, g);
#pragma unroll
              for (int kb = 0; kb < 4; ++kb) { const f32x4 pv = s[kb];
                  float a = (pv[0] + pv[1]) + (pv[2] + pv[3]), cc = pv[3];
                  a += __shfl_xor(a, 1); a += __shfl_xor(a, 2); cc += __shfl_xor(cc, 1); cc += __shfl_xor(cc, 2);
                  av[tile * 4 + kb] = a; cv[tile * 4 + kb] = cc; } }
      }
      lc += __shfl_xor(lc, 16); lc += __shfl_xor(lc, 32);
      const float inv = lc > 0.f ? 1.f / lc : 0.f, g0i = gate0 * inv;
#pragma unroll
      for (int db = 0; db < 4; ++db) outacc[db] = outacc[db] + oc[db] * g0i;
      NLAS float* imp_s = (NLAS float*)(lds + L_IMP) + (w * 4 + tl_mine) * 64;
      float cprev = 0.f;
#pragma unroll
      for (int q = 0; q < 16; ++q) { const float up = __shfl(cv[q], (lane + 48) & 63); const float im = (av[q] + (g > 0 ? up : cprev)) * inv; cprev = up; if (r == 0) imp_s[4 * q + g] = im; }
    }
    NLAS float* impw = (NLAS float*)(lds + L_IMP) + w * 256;
    float myscore[4];
    asm volatile("s_waitcnt lgkmcnt(0)" ::: "memory");
#pragma unroll
    for (int tl = 0; tl < 4; ++tl) { const int tt = t0 + 4 * w + tl, cur = tt >> 6, j = lane; const bool valid = j <= cur, forced = (j == 0) || (j == cur) || (j == cur - 1);
        const float s = valid ? impw[tl * 64 + j] + (forced ? 1000.f : 0.f) : -1e30f; myscore[tl] = s; }
    u64 wmask[4], wun = 0ull;
#pragma unroll
    for (int tl = 0; tl < 4; ++tl) { const int tt = t0 + 4 * w + tl, cur = tt >> 6; const bool valid = lane <= cur;
        const unsigned key = valid ? ((__builtin_bit_cast(unsigned, myscore[tl]) & ~63u) | (unsigned)(63 - lane)) : 0u; unsigned rank = 0;
#pragma unroll
        for (int jj = 0; jj < 64; ++jj) { const unsigned o = (unsigned)__builtin_amdgcn_readlane((int)key, jj); rank += (o > key) ? 1u : 0u; }
        wmask[tl] = __ballot(rank < 16u && valid); wun |= wmask[tl]; }
    if (lane == 0) { NLAS u64* mk = (NLAS u64*)(lds + L_MSK) + w * 4; mk[0] = wmask[0]; mk[1] = wmask[1]; mk[2] = wmask[2]; mk[3] = wmask[3]; ((NLAS u64*)(lds + L_WU))[w] = wun; }
    __syncthreads();
    const u64 mymask = ((const NLAS u64*)(lds + L_MSK))[w * 4 + tl_mine];
    u64 uall = 0ull;
#pragma unroll
    for (int ww = 0; ww < 8; ++ww) uall |= ((const NLAS u64*)(lds + L_WU))[ww];
    uall = ((u64)__builtin_amdgcn_readfirstlane((unsigned)(uall >> 32)) << 32) | (u64)__builtin_amdgcn_readfirstlane((unsigned)uall);
    const size_t rowb = (size_t)b * T;
    {
        float ms_ = 0.f, ls = 0.f; f32x4 os[4];
#pragma unroll
        for (int db = 0; db < 4; ++db) os[db] = (f32x4){0.f, 0.f, 0.f, 0.f};
        const bf16_t* kcol = P + rowb * PW + P_KS + gq * 64; const bf16_t* vcol = P + rowb * PW + P_VS + gq * 64;
        const float c = -slope2 * (float)t;
        const int jcur = t0 >> 6;
        u64 rem = uall & ((1ull << jcur) - 1ull);
#define NSA_NEXT(dst) { dst = rem ? 63 - __builtin_clzll(rem) : -1; if (dst >= 0) rem &= ~(1ull << dst); }
#define NSA_KO(p, h) ((p) ? L_CK + (h) * TILE_B : ((h) ? L_KB1 : L_KB0))
#define NSA_VO(p, h) ((p) ? L_CV + (h) * TILE_B : ((h) ? L_VB1 : L_VB0))
        int ja = jcur, jb, na_, nb_, cur = 0; bool first = true;
        NSA_NEXT(jb)
        Stg sr0, sr1;
        stg_load(sr0, kcol + (size_t)ja * 64 * PW, vcol + (size_t)ja * 64 * PW, PW, tid); stg_store(lds, L_KB0, L_VB0, sr0, tid);
        if (jb >= 0) { stg_load(sr1, kcol + (size_t)jb * 64 * PW, vcol + (size_t)jb * 64 * PW, PW, tid); stg_store(lds, L_KB1, L_VB1, sr1, tid); }
        NSA_NEXT(na_) NSA_NEXT(nb_)
        if (na_ >= 0) stg_load(sr0, kcol + (size_t)na_ * 64 * PW, vcol + (size_t)na_ * 64 * PW, PW, tid);
        if (nb_ >= 0) stg_load(sr1, kcol + (size_t)nb_ * 64 * PW, vcol + (size_t)nb_ * 64 * PW, PW, tid);
        __syncthreads();
        for (;;) {
            if (na_ >= 0) stg_store(lds, NSA_KO(cur ^ 1, 0), NSA_VO(cur ^ 1, 0), sr0, tid);
            if (nb_ >= 0) stg_store(lds, NSA_KO(cur ^ 1, 1), NSA_VO(cur ^ 1, 1), sr1, tid);
            int nna, nnb; NSA_NEXT(nna) NSA_NEXT(nnb)
            if (nna >= 0) stg_load(sr0, kcol + (size_t)nna * 64 * PW, vcol + (size_t)nna * 64 * PW, PW, tid);
            if (nnb >= 0) stg_load(sr1, kcol + (size_t)nnb * 64 * PW, vcol + (size_t)nnb * 64 * PW, PW, tid);
            const bool na = (wun >> ja) & 1ull, nb = (jb >= 0) && ((wun >> jb) & 1ull);
            if (na || nb) {
                const float btA = fmaf(slope2, (float)(ja * 64 + 4 * g), c) + (((mymask >> ja) & 1ull) ? 0.f : -1e30f);
                const float btB = fmaf(slope2, (float)((jb < 0 ? 0 : jb) * 64 + 4 * g), c) + ((jb >= 0 && ((mymask >> jb) & 1ull)) ? 0.f : -1e30f);
                if (first) pair_tiles<true>(lds, NSA_KO(cur, 0), NSA_VO(cur, 0), NSA_KO(cur, 1), NSA_VO(cur, 1), na, nb, qf, i, g, slope2, btA, btB, true, false, ja * 64 + 4 * g, 0, 0, t, ms_, ls, os);
                else pair_tiles<false>(lds, NSA_KO(cur, 0), NSA_VO(cur, 0), NSA_KO(cur, 1), NSA_VO(cur, 1), na, nb, qf, i, g, slope2, btA, btB, false, false, 0, 0, 0, t, ms_, ls, os); }
            first = false;
            __syncthreads();
            if (na_ < 0) break;
            ja = na_; jb = nb_; na_ = nna; nb_ = nnb; cur ^= 1;
        }
        ls += __shfl_xor(ls, 16); ls += __shfl_xor(ls, 32);
        const float sc1 = gate1 / ls;
#pragma unroll
        for (int db = 0; db < 4; ++db) outacc[db] = outacc[db] + os[db] * sc1;
    }
    {
        float mw = 0.f, lw = 0.f; f32x4 ow[4];
#pragma unroll
        for (int db = 0; db < 4; ++db) ow[db] = (f32x4){0.f, 0.f, 0.f, 0.f};
        const bf16_t* kcol = P + rowb * PW + P_KW + gq * 64; const bf16_t* vcol = P + rowb * PW + P_VW + gq * 64;
        const float c = -slope2 * (float)t;
        const int j0 = (t0 - 511) > 0 ? ((t0 - 511) >> 6) : 0, j1 = t0 >> 6, tw0 = t0 + 4 * w;
        int ja = j1, cur = 0; bool first = true;
        Stg sr0, sr1;
        stg_load(sr0, kcol + (size_t)ja * 64 * PW, vcol + (size_t)ja * 64 * PW, PW, tid); stg_store(lds, L_KB0, L_VB0, sr0, tid);
        if (ja - 1 >= j0) { stg_load(sr1, kcol + (size_t)(ja - 1) * 64 * PW, vcol + (size_t)(ja - 1) * 64 * PW, PW, tid); stg_store(lds, L_KB1, L_VB1, sr1, tid); }
        if (ja - 2 >= j0) stg_load(sr0, kcol + (size_t)(ja - 2) * 64 * PW, vcol + (size_t)(ja - 2) * 64 * PW, PW, tid);
        if (ja - 3 >= j0) stg_load(sr1, kcol + (size_t)(ja - 3) * 64 * PW, vcol + (size_t)(ja - 3) * 64 * PW, PW, tid);
        __syncthreads();
        for (;;) {
            if (ja - 2 >= j0) stg_store(lds, NSA_KO(cur ^ 1, 0), NSA_VO(cur ^ 1, 0), sr0, tid);
            if (ja - 3 >= j0) stg_store(lds, NSA_KO(cur ^ 1, 1), NSA_VO(cur ^ 1, 1), sr1, tid);
            if (ja - 4 >= j0) stg_load(sr0, kcol + (size_t)(ja - 4) * 64 * PW, vcol + (size_t)(ja - 4) * 64 * PW, PW, tid);
            if (ja - 5 >= j0) stg_load(sr1, kcol + (size_t)(ja - 5) * 64 * PW, vcol + (size_t)(ja - 5) * 64 * PW, PW, tid);
            const int jb = ja - 1;
            const bool na = (64 * ja <= tw0 + 3) && (64 * ja + 63 >= tw0 - 511), nb = (jb >= j0) && (64 * jb <= tw0 + 3) && (64 * jb + 63 >= tw0 - 511);
            if (na || nb) {
                const float btA = fmaf(slope2, (float)(ja * 64 + 4 * g), c), btB = fmaf(slope2, (float)(jb * 64 + 4 * g), c);
                const bool maskA = (64 * ja < tw0 + 3 - 511), maskB = (64 * jb < tw0 + 3 - 511);
                if (first) pair_tiles<true>(lds, NSA_KO(cur, 0), NSA_VO(cur, 0), NSA_KO(cur, 1), NSA_VO(cur, 1), na, nb, qf, i, g, slope2, btA, btB, true, maskB, ja * 64 + 4 * g, jb * 64 + 4 * g, t - 511, t, mw, lw, ow);
                else pair_tiles<false>(lds, NSA_KO(cur, 0), NSA_VO(cur, 0), NSA_KO(cur, 1), NSA_VO(cur, 1), na, nb, qf, i, g, slope2, btA, btB, maskA, maskB, ja * 64 + 4 * g, jb * 64 + 4 * g, t - 511, t, mw, lw, ow); }
            first = false;
            __syncthreads();
            if (ja - 2 < j0) break;
            ja -= 2; cur ^= 1;
        }
        lw += __shfl_xor(lw, 16); lw += __shfl_xor(lw, 32);
        const float sc2 = gate2 / lw;
#pragma unroll
        for (int db = 0; db < 4; ++db) outacc[db] = outacc[db] + ow[db] * sc2;
    }
    bf16_t* yo = Ynsa + m * 512 + h * 64 + 4 * g;
#pragma unroll
    for (int db = 0; db < 4; ++db) { u32x2 v; v.x = pkbf(outacc[db][0], outacc[db][1]); v.y = pkbf(outacc[db][2], outacc[db][3]); *(u32x2*)(yo + db * 16) = v; }
}
__device__ __forceinline__ void phase(NLAS char* lds, const bf16_t* P, const float* S32, const bf16_t* KC, const bf16_t* VC, bf16_t* Ynsa) {
    const int G = gridDim.x, bid = blockIdx.x;
    if (G == 256) { const int base = bid >> 3, bg = bid & 7;
#pragma unroll 1
        for (int k = 0; k < 4; ++k) { const int ti = (k == 0) ? 127 - base : (k == 1) ? 64 + base : (k == 2) ? 63 - base : base; unit(lds, P, S32, KC, VC, Ynsa, bg >> 1, bg & 1, ti); } }
    else {
#pragma unroll 1
        for (int u = bid; u < 1024; u += G) unit(lds, P, S32, KC, VC, Ynsa, (u & 7) >> 1, u & 1, 127 - (u >> 3)); }
}
}

namespace xa {
using nsa::bf16x8; using nsa::s16x4; using nsa::f32x4; using nsa::u32x4; using nsa::u32x2; using nsa::vtr; using nsa::mfma16; using nsa::pkbf;
constexpr int RS = 272, TILE_B = 64 * RS;
__device__ __forceinline__ int l_k(int tile) { return tile * 2 * TILE_B; }
__device__ __forceinline__ int l_v(int tile) { return tile * 2 * TILE_B + TILE_B; }
__device__ __forceinline__ void unit(NLAS char* lds, const bf16_t* P, const bf16_t* MEMKV, bf16_t* Yxa, int b, int h, int tt) {
    const int tid = threadIdx.x, lane = tid & 63, w = __builtin_amdgcn_readfirstlane(tid >> 6), i = lane & 15, g = lane >> 4;
    const size_t m = (size_t)b * T + tt * 128 + 16 * w + i;
    const bf16_t* kbase = MEMKV + (size_t)b * 256 * 1024 + h * 128;
    { u32x4 st[4][4]; const bf16_t* p0 = kbase + (size_t)(tid >> 3) * 1024 + (tid & 7) * 8;
#pragma unroll
      for (int tile = 0; tile < 4; ++tile) { const bf16_t* p = p0 + (size_t)tile * 64 * 1024; st[tile][0] = *(const u32x4*)p; st[tile][1] = *(const u32x4*)(p + 64); st[tile][2] = *(const u32x4*)(p + 512); st[tile][3] = *(const u32x4*)(p + 576); }
      const int off = (tid >> 3) * RS + (tid & 7) * 16;
#pragma unroll
      for (int tile = 0; tile < 4; ++tile) { *(NLAS u32x4*)(lds + l_k(tile) + off) = st[tile][0]; *(NLAS u32x4*)(lds + l_k(tile) + off + 128) = st[tile][1]; *(NLAS u32x4*)(lds + l_v(tile) + off) = st[tile][2]; *(NLAS u32x4*)(lds + l_v(tile) + off + 128) = st[tile][3]; } }
    bf16x8 qf[4];
    { const bf16_t* qp = P + m * PW + P_XAQ + h * 128 + 8 * g;
#pragma unroll
      for (int ks = 0; ks < 4; ++ks) qf[ks] = *(const bf16x8*)(qp + 32 * ks); }
    const float scale2 = 0.08838834764831845f * nsa::LOG2E;
    float mx = -INFINITY, l = 0.f; f32x4 o[8];
#pragma unroll
    for (int db = 0; db < 8; ++db) o[db] = (f32x4){0.f, 0.f, 0.f, 0.f};
    __syncthreads();
#pragma unroll 1
    for (int tile = 0; tile < 4; ++tile) {
        const NLAS char* Kb = lds + l_k(tile); const NLAS char* Vb = lds + l_v(tile);
        f32x4 s[4];
        { bf16x8 a[4][4];
#pragma unroll
          for (int kb = 0; kb < 4; ++kb)
#pragma unroll
              for (int ks = 0; ks < 4; ++ks) a[kb][ks] = *(const NLAS bf16x8*)(Kb + (kb * 16 + i) * RS + 16 * g + 64 * ks);
#pragma unroll
          for (int kb = 0; kb < 4; ++kb) s[kb] = mfma16(a[kb][0], qf[0], (f32x4){0.f, 0.f, 0.f, 0.f});
#pragma unroll
          for (int ks = 1; ks < 4; ++ks)
#pragma unroll
              for (int kb = 0; kb < 4; ++kb) s[kb] = mfma16(a[kb][ks], qf[ks], s[kb]); }
        float mt = -INFINITY;
#pragma unroll
        for (int kb = 0; kb < 4; ++kb)
#pragma unroll
            for (int r = 0; r < 4; ++r) { const float v = s[kb][r] * scale2; s[kb][r] = v; mt = fmaxf(mt, v); }
        mt = fmaxf(mt, __shfl_xor(mt, 16)); mt = fmaxf(mt, __shfl_xor(mt, 32));
        const float mn = fmaxf(mx, mt), alpha = __builtin_amdgcn_exp2f(mx - mn); float sum = 0.f;
#pragma unroll
        for (int kb = 0; kb < 4; ++kb)
#pragma unroll
            for (int r = 0; r < 4; ++r) { const float p = __builtin_amdgcn_exp2f(s[kb][r] - mn); s[kb][r] = p; sum += p; }
        l = l * alpha + sum; mx = mn;
#pragma unroll
        for (int db = 0; db < 8; ++db) o[db] = o[db] * alpha;
        const NLAS char* vb = Vb + (4 * g + (i >> 2)) * RS + (i & 3) * 8;
#pragma unroll
        for (int kk = 0; kk < 2; ++kk) {
            u32x4 pw; pw.x = pkbf(s[2 * kk][0], s[2 * kk][1]); pw.y = pkbf(s[2 * kk][2], s[2 * kk][3]); pw.z = pkbf(s[2 * kk + 1][0], s[2 * kk + 1][1]); pw.w = pkbf(s[2 * kk + 1][2], s[2 * kk + 1][3]);
            const bf16x8 pf = __builtin_bit_cast(bf16x8, pw);
            s16x4 lo[8], hi[8];
#pragma unroll
            for (int db = 0; db < 8; ++db) { const NLAS char* vp = vb + (2 * kk) * 16 * RS + db * 32; lo[db] = vtr(vp); hi[db] = vtr(vp + 16 * RS); }
#pragma unroll
            for (int db = 0; db < 8; ++db) o[db] = mfma16((bf16x8){lo[db][0], lo[db][1], lo[db][2], lo[db][3], hi[db][0], hi[db][1], hi[db][2], hi[db][3]}, pf, o[db]);
        }
    }
    l += __shfl_xor(l, 16); l += __shfl_xor(l, 32);
    const float inv = 1.f / l;
    bf16_t* yo = Yxa + m * 512 + h * 128 + 4 * g;
#pragma unroll
    for (int db = 0; db < 8; ++db) { u32x2 v; v.x = pkbf(o[db][0] * inv, o[db][1] * inv); v.y = pkbf(o[db][2] * inv, o[db][3] * inv); *(u32x2*)(yo + db * 16) = v; }
    __syncthreads();
}
__device__ __forceinline__ void memkv_tile(NLAS char* lds, const bf16_t* MEMN, const bf16_t* Wmkv, bf16_t* MEMKV, int tile) {
    constexpr int RSK = 528, TBK = 64 * RSK;
    const int tid = threadIdx.x, lane = tid & 63, w = __builtin_amdgcn_readfirstlane(tid >> 6), i = lane & 15, g = lane >> 4;
    const int r0 = (tile >> 4) * 64, c0 = (tile & 15) * 64;
    const bf16_t* ap = MEMN + (size_t)(r0 + (tid >> 5)) * 1024 + (tid & 31) * 8; const bf16_t* bp = Wmkv + (size_t)(c0 + (tid >> 5)) * 1024 + (tid & 31) * 8;
    const int soff = (tid >> 5) * RSK + (tid & 31) * 16;
    u32x4 ra[4], rb[4];
#define MKV_LOAD(kc) { _Pragma("unroll") for (int q = 0; q < 4; ++q) { ra[q] = *(const u32x4*)(ap + (size_t)q * 16 * 1024 + (kc) * 256); rb[q] = *(const u32x4*)(bp + (size_t)q * 16 * 1024 + (kc) * 256); } }
#define MKV_STORE(buf) { _Pragma("unroll") for (int q = 0; q < 4; ++q) { *(NLAS u32x4*)(lds + (buf) * 2 * TBK + soff + q * 16 * RSK) = ra[q]; *(NLAS u32x4*)(lds + (buf) * 2 * TBK + TBK + soff + q * 16 * RSK) = rb[q]; } }
    f32x4 acc0 = (f32x4){0.f, 0.f, 0.f, 0.f}, acc1 = acc0;
    MKV_LOAD(0) MKV_STORE(0) MKV_LOAD(1)
    __syncthreads();
    const int arow = ((w >> 1) * 16 + i) * RSK + 16 * g, brow = ((w & 1) * 32 + i) * RSK + 16 * g;
#pragma unroll
    for (int kc = 0; kc < 4; ++kc) { const int buf = kc & 1;
        if (kc < 3) MKV_STORE(buf ^ 1)
        if (kc < 2) MKV_LOAD(kc + 2)
        const NLAS char* A = lds + buf * 2 * TBK; const NLAS char* B = A + TBK;
        bf16x8 af[8], b0[8], b1[8];
#pragma unroll
        for (int ks = 0; ks < 8; ++ks) { af[ks] = *(const NLAS bf16x8*)(A + arow + ks * 64); b0[ks] = *(const NLAS bf16x8*)(B + brow + ks * 64); b1[ks] = *(const NLAS bf16x8*)(B + brow + 16 * RSK + ks * 64); }
#pragma unroll
        for (int ks = 0; ks < 8; ++ks) { acc0 = mfma16(af[ks], b0[ks], acc0); acc1 = mfma16(af[ks], b1[ks], acc1); }
        __syncthreads(); }
#undef MKV_LOAD
#undef MKV_STORE
#pragma unroll
    for (int r = 0; r < 4; ++r) { bf16_t* o = MEMKV + (size_t)(r0 + (w >> 1) * 16 + 4 * g + r) * 1024 + c0 + (w & 1) * 32 + i; o[0] = f2bf(acc0[r]); o[16] = f2bf(acc1[r]); }
}
__device__ __forceinline__ void phase(NLAS char* lds, const bf16_t* P, const bf16_t* MEMKV, bf16_t* Yxa) {
#pragma unroll 1
    for (int u = blockIdx.x; u < 512; u += gridDim.x) unit(lds, P, MEMKV, Yxa, u >> 7, (u >> 5) & 3, u & 31);
}
}

namespace ml {
using nsa::bf16x8; using nsa::s16x4; using nsa::f32x4; using nsa::u32x4; using nsa::u32x2; using nsa::vtr; using nsa::mfma16; using nsa::pkbf;
constexpr int RS = 272, TB = 64 * RS, RSS = 144;
constexpr float KSCALE = 0.08838834764831845f;
__device__ __forceinline__ float scan_add(float v, int lane) {
#pragma unroll
    for (int o = 1; o < 64; o <<= 1) { const float u = __shfl_up(v, o); if (lane >= o) v += u; }
    return v; }
__device__ __forceinline__ float scan_max(float v, int lane) {
#pragma unroll
    for (int o = 1; o < 64; o <<= 1) { const float u = __shfl_up(v, o); if (lane >= o) v = fmaxf(v, u); }
    return v; }
__device__ __forceinline__ bf16x8 trpair(const NLAS char* p, int hi_off) { const s16x4 lo = vtr(p), hi = vtr(p + hi_off); return (bf16x8){lo[0], lo[1], lo[2], lo[3], hi[0], hi[1], hi[2], hi[3]}; }
__device__ __forceinline__ void load_conv(NLAS char* dst, const bf16_t* P, const float* cw, int colP, int cwc, size_t m0, int tseq0, int tid) {
    const int s = tid >> 3, c16 = (tid & 7) * 16;
    u32x4 raw[2][4]; f32x4 wv[2][4][2];
#pragma unroll
    for (int half = 0; half < 2; ++half) { const int c = c16 + half * 8;
#pragma unroll
        for (int j = 0; j < 4; ++j) { const bool ok = (tseq0 + s - j >= 0); const size_t row = m0 + s - (ok ? j : 0);
            raw[half][j] = *(const u32x4*)(P + row * PW + colP + c);
            const f32x4 w0 = *(const f32x4*)(cw + j * 1024 + cwc + c), w1 = *(const f32x4*)(cw + j * 1024 + cwc + c + 4); const f32x4 z = (f32x4){0.f, 0.f, 0.f, 0.f};
            wv[half][j][0] = ok ? w0 : z; wv[half][j][1] = ok ? w1 : z; } }
#pragma unroll
    for (int half = 0; half < 2; ++half) { const int c = c16 + half * 8; float acc[8];
#pragma unroll
        for (int e = 0; e < 8; ++e) acc[e] = 0.f;
#pragma unroll
        for (int j = 0; j < 4; ++j) { const u32x4 r4 = raw[half][j]; const f32x4 w0 = wv[half][j][0], w1 = wv[half][j][1];
            acc[0] += w0[0] * pg8::bflo(r4.x); acc[1] += w0[1] * pg8::bfhi(r4.x); acc[2] += w0[2] * pg8::bflo(r4.y); acc[3] += w0[3] * pg8::bfhi(r4.y);
            acc[4] += w1[0] * pg8::bflo(r4.z); acc[5] += w1[1] * pg8::bfhi(r4.z); acc[6] += w1[2] * pg8::bflo(r4.w); acc[7] += w1[3] * pg8::bfhi(r4.w); }
#pragma unroll
        for (int e = 0; e < 8; ++e) acc[e] = acc[e] * __builtin_amdgcn_rcpf(1.f + __expf(-acc[e]));
        u32x4 o; o.x = pkbf(acc[0], acc[1]); o.y = pkbf(acc[2], acc[3]); o.z = pkbf(acc[4], acc[5]); o.w = pkbf(acc[6], acc[7]);
        *(NLAS u32x4*)(dst + s * RS + c * 2) = o; }
}
struct RawT { u32x4 v[3]; };
__device__ __forceinline__ void raw_issue(RawT& r, const bf16_t* P, int colP, size_t m0, int tseq0, int tid) {
#pragma unroll
    for (int it = 0; it < 3; ++it) { int idx = tid + 512 * it; idx = idx < 1072 ? idx : 1071; const int row = idx >> 4, c = (idx & 15) * 8; const bool ok = (tseq0 + row - 3 >= 0);
        const u32x4 v = *(const u32x4*)(P + (ok ? m0 + row - 3 : m0) * PW + colP + c); r.v[it] = ok ? v : (u32x4){0u, 0u, 0u, 0u}; }
}
__device__ __forceinline__ void raw_store(NLAS char* dst, const RawT& r, int tid) {
#pragma unroll
    for (int it = 0; it < 3; ++it) { int idx = tid + 512 * it; idx = idx < 1072 ? idx : 1071; *(NLAS u32x4*)(dst + (idx >> 4) * RS + (idx & 15) * 16) = r.v[it]; }
}
__device__ __forceinline__ void conv_from_lds(NLAS char* dst, const NLAS char* raw, const NLAS float* wl, int tid) {
    const int s = tid >> 3, c16 = (tid & 7) * 16;
#pragma unroll
    for (int half = 0; half < 2; ++half) { const int c = c16 + half * 8; float acc[8];
#pragma unroll
        for (int e = 0; e < 8; ++e) acc[e] = 0.f;
#pragma unroll
        for (int j = 0; j < 4; ++j) { const u32x4 r4 = *(const NLAS u32x4*)(raw + (s + 3 - j) * RS + c * 2); const f32x4 w0 = *(const NLAS f32x4*)(wl + j * 128 + c), w1 = *(const NLAS f32x4*)(wl + j * 128 + c + 4);
            acc[0] += w0[0] * pg8::bflo(r4.x); acc[1] += w0[1] * pg8::bfhi(r4.x); acc[2] += w0[2] * pg8::bflo(r4.y); acc[3] += w0[3] * pg8::bfhi(r4.y);
            acc[4] += w1[0] * pg8::bflo(r4.z); acc[5] += w1[1] * pg8::bfhi(r4.z); acc[6] += w1[2] * pg8::bflo(r4.w); acc[7] += w1[3] * pg8::bfhi(r4.w); }
#pragma unroll
        for (int e = 0; e < 8; ++e) acc[e] = acc[e] * __builtin_amdgcn_rcpf(1.f + __expf(-acc[e]));
        u32x4 o; o.x = pkbf(acc[0], acc[1]); o.y = pkbf(acc[2], acc[3]); o.z = pkbf(acc[4], acc[5]); o.w = pkbf(acc[6], acc[7]);
        *(NLAS u32x4*)(dst + s * RS + c * 2) = o; }
}
__device__ __forceinline__ void m1_unit(NLAS char* lds, const bf16_t* P, const float* cw, const float* S32, bf16_t* Abuf, float* NA, float* Gc, float* Mloc, int ci) {
    constexpr int L_K = 0, L_EV = TB, L_E = 2 * TB, L_RK = 2 * TB + 1024, L_W = L_RK + 67 * RS;
    const int tid = threadIdx.x, lane = tid & 63, w = __builtin_amdgcn_readfirstlane(tid >> 6), i = lane & 15, g = lane >> 4;
    const int c = ci & 63, bh = ci >> 6, h = bh & 3, b = bh >> 2; const size_t m0 = (size_t)b * T + c * 64;
    NLAS float* eS = (NLAS float*)(lds + L_E);
    RawT rk; raw_issue(rk, P, P_MLK + h * 128, m0, c * 64, tid);
    u32x4 vraw[2]; { const bf16_t* vp = P + (m0 + (tid >> 3)) * PW + P_MLV + h * 128 + (tid & 7) * 16; vraw[0] = *(const u32x4*)vp; vraw[1] = *(const u32x4*)(vp + 8); }
    f32x4 wreg = (f32x4){0.f, 0.f, 0.f, 0.f}; if (tid < 128) wreg = *(const f32x4*)(cw + (tid >> 5) * 1024 + 512 + h * 128 + (tid & 31) * 4);
    if (w == 0) { const float fpre = S32[(m0 + lane) * 32 + 4 + h], ipre = S32[(m0 + lane) * 32 + h];
        const float bcs = scan_add(logsig(fpre), lane), gtot = __shfl(bcs, 63), wend = gtot - bcs + ipre, mloc = wave_max(wend);
        eS[lane] = __expf(wend - mloc) * KSCALE; if (lane == 0) { Gc[ci] = gtot; Mloc[ci] = mloc; } }
    raw_store(lds + L_RK, rk, tid); if (tid < 128) *(NLAS f32x4*)(lds + L_W + ((tid >> 5) * 128 + (tid & 31) * 4) * 4) = wreg;
    __syncthreads();
    conv_from_lds(lds + L_K, lds + L_RK, (const NLAS float*)(lds + L_W), tid);
    { const int s = tid >> 3, c16 = (tid & 7) * 16; const float es = eS[s];
#pragma unroll
      for (int half = 0; half < 2; ++half) { const u32x4 raw = vraw[half]; u32x4 o;
          o.x = pkbf(pg8::bflo(raw.x) * es, pg8::bfhi(raw.x) * es); o.y = pkbf(pg8::bflo(raw.y) * es, pg8::bfhi(raw.y) * es);
          o.z = pkbf(pg8::bflo(raw.z) * es, pg8::bfhi(raw.z) * es); o.w = pkbf(pg8::bflo(raw.w) * es, pg8::bfhi(raw.w) * es);
          *(NLAS u32x4*)(lds + L_EV + s * RS + (c16 + half * 8) * 2) = o; } }
    __syncthreads();
    f32x4 acc[8];
#pragma unroll
    for (int vb = 0; vb < 8; ++vb) acc[vb] = (f32x4){0.f, 0.f, 0.f, 0.f};
    const int rowoff = (4 * g + (i >> 2)) * RS + (i & 3) * 8;
#pragma unroll
    for (int kk = 0; kk < 2; ++kk) { const bf16x8 kf = trpair(lds + L_K + kk * 32 * RS + rowoff + w * 32, 16 * RS);
#pragma unroll
        for (int vb = 0; vb < 8; ++vb) acc[vb] = mfma16(trpair(lds + L_EV + kk * 32 * RS + rowoff + vb * 32, 16 * RS), kf, acc[vb]); }
    bf16_t* ap = Abuf + ((size_t)ci * 128 + w * 16 + i) * 128 + 4 * g;
#pragma unroll
    for (int vb = 0; vb < 8; ++vb) { u32x2 pk; pk.x = pkbf(acc[vb][0], acc[vb][1]); pk.y = pkbf(acc[vb][2], acc[vb][3]); *(u32x2*)(ap + vb * 16) = pk; }
    { const int k = tid >> 2, part = tid & 3; float n = 0.f;
#pragma unroll
      for (int s = 0; s < 16; ++s) n += eS[part * 16 + s] * bf2f(*(const NLAS bf16_t*)(lds + L_K + (part * 16 + s) * RS + k * 2));
      n += __shfl_xor(n, 1); n += __shfl_xor(n, 2); if (part == 0) NA[(size_t)ci * 128 + k] = n; }
    __syncthreads();
}
__device__ __forceinline__ void m2_items(bf16_t* Abuf, float* NA, const float* Gc, const float* Mloc, float* Mprev) {
    for (int it = blockIdx.x * blockDim.x + threadIdx.x; it < 16 * 128 * 64; it += gridDim.x * blockDim.x) {
        const int bh = it >> 13, kv2 = it & 8191, k = kv2 >> 6, v2 = kv2 & 63;
        float C0 = 0.f, C1 = 0.f, n = 0.f, m = 0.f;
        unsigned* base = (unsigned*)(Abuf + ((size_t)(bh * 64) * 128 + k) * 128 + v2 * 2);
#pragma unroll 1
        for (int c0 = 0; c0 < 64; c0 += 16) { unsigned A[16];
#pragma unroll
            for (int u = 0; u < 16; ++u) A[u] = base[(size_t)(c0 + u) * 8192];
#pragma unroll
            for (int u = 0; u < 16; ++u) { const int ci = bh * 64 + c0 + u; const float gg = Gc[ci], ml = Mloc[ci];
                const float mn = fmaxf(gg + m, ml), a = __expf(gg + m - mn), bb = __expf(ml - mn);
                base[(size_t)(c0 + u) * 8192] = pkbf(C0, C1); C0 = C0 * a + pg8::bflo(A[u]) * bb; C1 = C1 * a + pg8::bfhi(A[u]) * bb;
                if (v2 == 0) { const float nA = NA[(size_t)ci * 128 + k]; NA[(size_t)ci * 128 + k] = n; n = a * n + bb * nA; }
                if (kv2 == 0) Mprev[ci] = m;
                m = mn; } }
    }
}
__device__ __forceinline__ void m3_unit(NLAS char* lds, const bf16_t* P, const float* cw, const float* S32, const bf16_t* Cprev, const float* Nprev, const float* Mprev, const float* normg, bf16_t* Yml, int ci) {
    constexpr int L_Q = 0, L_K = TB, L_V = 2 * TB, L_C = 3 * TB, L_S = 5 * TB, L_F = L_S + 64 * RSS, L_RQ = L_F + 4096, L_RK = L_RQ + 67 * RS, L_W = L_RK + 67 * RS;
    static_assert(L_W + 4096 <= 147392 - 64, "m3 LDS map");
    const int tid = threadIdx.x, lane = tid & 63, w = __builtin_amdgcn_readfirstlane(tid >> 6), i = lane & 15, g = lane >> 4;
    const int c = ci & 63, bh = ci >> 6, h = bh & 3, b = bh >> 2; const size_t m0 = (size_t)b * T + c * 64;
    const int srow = tid >> 3, c16 = (tid & 7) * 16;
    RawT rq, rk; raw_issue(rq, P, P_MLQ + h * 128, m0, c * 64, tid); raw_issue(rk, P, P_MLK + h * 128, m0, c * 64, tid);
    u32x4 vr[2], orw[2], cr[4];
    { const bf16_t* vp = P + (m0 + srow) * PW + P_MLV + h * 128 + c16; vr[0] = *(const u32x4*)vp; vr[1] = *(const u32x4*)(vp + 8);
      const bf16_t* op = P + (m0 + srow) * PW + P_MLO + h * 128 + c16; orw[0] = *(const u32x4*)op; orw[1] = *(const u32x4*)(op + 8);
      const bf16_t* cp = Cprev + ((size_t)ci * 128 + (tid >> 2)) * 128 + (tid & 3) * 32;
#pragma unroll
      for (int q8 = 0; q8 < 4; ++q8) cr[q8] = *(const u32x4*)(cp + q8 * 8); }
    f32x4 wreg = (f32x4){0.f, 0.f, 0.f, 0.f}; if (tid < 256) wreg = *(const f32x4*)(cw + ((tid & 127) >> 5) * 1024 + (tid >> 7) * 512 + h * 128 + (tid & 31) * 4);
    float ng[4];
#pragma unroll
    for (int vb = 0; vb < 4; ++vb) ng[vb] = normg[h * 128 + ((w & 1) * 4 + vb) * 16 + i];
    NLAS float* F = (NLAS float*)(lds + L_F);
    NLAS float* rowf = F; NLAS float* colf = F + 64; NLAS float* scv = F + 128; NLAS float* emt = F + 192; NLAS float* qn = F + 256; NLAS float* nprev = F + 320; NLAS float* denp = F + 448; NLAS float* ssq = F + 576;
    if (w == 0) { const float fpre = S32[(m0 + lane) * 32 + 4 + h], ipre = S32[(m0 + lane) * 32 + h], mprev = Mprev[ci];
        const float bcs = scan_add(logsig(fpre), lane), u = ipre - bcs, pm = scan_max(u, lane), mt = bcs + fmaxf(mprev, pm);
        rowf[lane] = bcs - mt; colf[lane] = u; scv[lane] = __expf(bcs + mprev - mt); emt[lane] = __expf(-mt); }
    else if (w <= 2) nprev[tid - 64] = Nprev[(size_t)ci * 128 + tid - 64];
    raw_store(lds + L_RQ, rq, tid); raw_store(lds + L_RK, rk, tid);
    if (tid < 256) *(NLAS f32x4*)(lds + L_W + ((tid >> 7) * 512 + ((tid & 127) >> 5) * 128 + (tid & 31) * 4) * 4) = wreg;
    *(NLAS u32x4*)(lds + L_V + srow * RS + c16 * 2) = vr[0]; *(NLAS u32x4*)(lds + L_V + srow * RS + c16 * 2 + 16) = vr[1];
#pragma unroll
    for (int q8 = 0; q8 < 4; ++q8) *(NLAS u32x4*)(lds + L_C + (tid >> 2) * RS + ((tid & 3) * 32 + q8 * 8) * 2) = cr[q8];
    __syncthreads();
    conv_from_lds(lds + L_Q, lds + L_RQ, (const NLAS float*)(lds + L_W), tid);
    conv_from_lds(lds + L_K, lds + L_RK, (const NLAS float*)(lds + L_W) + 512, tid);
    __syncthreads();
    *(NLAS u32x4*)(lds + L_RQ + srow * RS + c16 * 2) = orw[0]; *(NLAS u32x4*)(lds + L_RQ + srow * RS + c16 * 2 + 16) = orw[1];
    { const int tq = tid >> 3, part = tid & 7; const u32x4 q0 = *(const NLAS u32x4*)(lds + L_Q + tq * RS + part * 32), q1 = *(const NLAS u32x4*)(lds + L_Q + tq * RS + part * 32 + 16);
      const NLAS f32x4* np = (const NLAS f32x4*)(nprev + part * 16); const f32x4 n0 = np[0], n1 = np[1], n2 = np[2], n3 = np[3];
      float a = pg8::bflo(q0.x) * n0[0] + pg8::bfhi(q0.x) * n0[1] + pg8::bflo(q0.y) * n0[2] + pg8::bfhi(q0.y) * n0[3] + pg8::bflo(q0.z) * n1[0] + pg8::bfhi(q0.z) * n1[1] + pg8::bflo(q0.w) * n1[2] + pg8::bfhi(q0.w) * n1[3]
              + pg8::bflo(q1.x) * n2[0] + pg8::bfhi(q1.x) * n2[1] + pg8::bflo(q1.y) * n2[2] + pg8::bfhi(q1.y) * n2[3] + pg8::bflo(q1.z) * n3[0] + pg8::bfhi(q1.z) * n3[1] + pg8::bflo(q1.w) * n3[2] + pg8::bfhi(q1.w) * n3[3];
      a += __shfl_xor(a, 1); a += __shfl_xor(a, 2); a += __shfl_xor(a, 4); if (part == 0) qn[tq] = a; }
    const int tb = w >> 1;
    {
        float rs[4] = {0.f, 0.f, 0.f, 0.f};
#pragma unroll
        for (int sbi = 0; sbi < 2; ++sbi) { const int sb = 2 * (w & 1) + sbi; f32x4 acc = (f32x4){0.f, 0.f, 0.f, 0.f};
            if (sb <= tb) {
#pragma unroll
                for (int ks = 0; ks < 4; ++ks) acc = mfma16(*(const NLAS bf16x8*)(lds + L_Q + (tb * 16 + i) * RS + (32 * ks + 8 * g) * 2), *(const NLAS bf16x8*)(lds + L_K + (sb * 16 + i) * RS + (32 * ks + 8 * g) * 2), acc); }
            const int sx = sb * 16 + i; const float cf = colf[sx];
#pragma unroll
            for (int r = 0; r < 4; ++r) { const int t = tb * 16 + 4 * g + r; const float v = (sx <= t) ? acc[r] * KSCALE * __expf(rowf[t] + cf) : 0.f; rs[r] += v;
                *(NLAS bf16_t*)(lds + L_S + t * RSS + sx * 2) = f2bf(v); } }
#pragma unroll
        for (int r = 0; r < 4; ++r) { float x = rs[r]; x += __shfl_xor(x, 1); x += __shfl_xor(x, 2); x += __shfl_xor(x, 4); x += __shfl_xor(x, 8); if (i == 0) denp[(w & 1) * 64 + tb * 16 + 4 * g + r] = x; }
    }
    __syncthreads();
    f32x4 a1[4], a2[4];
#pragma unroll
    for (int vb = 0; vb < 4; ++vb) { a1[vb] = (f32x4){0.f, 0.f, 0.f, 0.f}; a2[vb] = (f32x4){0.f, 0.f, 0.f, 0.f}; }
    const int vb0 = (w & 1) * 4, troff = (8 * g + (i >> 2)) * RS + (i & 3) * 8;
#pragma unroll
    for (int kk = 0; kk < 2; ++kk) { if (32 * kk <= tb * 16 + 15) { const bf16x8 sf = *(const NLAS bf16x8*)(lds + L_S + (tb * 16 + i) * RSS + (32 * kk + 8 * g) * 2);
#pragma unroll
        for (int vb = 0; vb < 4; ++vb) a1[vb] = mfma16(sf, trpair(lds + L_V + kk * 32 * RS + troff + (vb0 + vb) * 32, 4 * RS), a1[vb]); } }
#pragma unroll
    for (int ks = 0; ks < 4; ++ks) { const bf16x8 qf = *(const NLAS bf16x8*)(lds + L_Q + (tb * 16 + i) * RS + (32 * ks + 8 * g) * 2);
#pragma unroll
        for (int vb = 0; vb < 4; ++vb) a2[vb] = mfma16(qf, trpair(lds + L_C + ks * 32 * RS + troff + (vb0 + vb) * 32, 4 * RS), a2[vb]); }
    float hv[4][4], sq[4] = {0.f, 0.f, 0.f, 0.f};
#pragma unroll
    for (int r = 0; r < 4; ++r) { const int t = tb * 16 + 4 * g + r; const float sc = scv[t]; const float den = denp[t] + denp[64 + t] + sc * qn[t]; const float hd = 1.f / fmaxf(fabsf(den), emt[t]);
#pragma unroll
        for (int vb = 0; vb < 4; ++vb) { const float x = (a1[vb][r] + sc * a2[vb][r]) * hd; hv[vb][r] = x; sq[r] += x * x; } }
#pragma unroll
    for (int r = 0; r < 4; ++r) { float x = sq[r]; x += __shfl_xor(x, 1); x += __shfl_xor(x, 2); x += __shfl_xor(x, 4); x += __shfl_xor(x, 8); if (i == 0) ssq[(w & 1) * 64 + tb * 16 + 4 * g + r] = x; }
    __syncthreads();
#pragma unroll
    for (int r = 0; r < 4; ++r) { const int t = tb * 16 + 4 * g + r; const float rinv = rsqrtf((ssq[t] + ssq[64 + t]) * (1.f / 128.f) + EPS);
#pragma unroll
        for (int vb = 0; vb < 4; ++vb) { const int v = (vb0 + vb) * 16 + i; const float o = bf2f(*(const NLAS bf16_t*)(lds + L_RQ + t * RS + v * 2));
            *(NLAS bf16_t*)(lds + L_RK + t * RS + v * 2) = f2bf(__builtin_amdgcn_rcpf(1.f + __expf(-o)) * hv[vb][r] * rinv * ng[vb]); } }
    __syncthreads();
    { bf16_t* yp = Yml + (m0 + srow) * 512 + h * 128 + c16; *(u32x4*)yp = *(const NLAS u32x4*)(lds + L_RK + srow * RS + c16 * 2); *(u32x4*)(yp + 8) = *(const NLAS u32x4*)(lds + L_RK + srow * RS + c16 * 2 + 16); }
    __syncthreads();
}
}

namespace cmpr {
using nsa::bf16x8; using nsa::f32x4; using nsa::u32x4; using nsa::mfma16; using nsa::pkbf;
constexpr int RSA = 4112, L_A = 0, RSB = 144, TBB = 256 * RSB, L_B = 16 * RSA, L_H = L_B, RSH = 528;
static_assert(L_B + 2 * TBB <= 147392 - 64, "cmpr LDS map");
__device__ __forceinline__ void unit(NLAS char* lds, const bf16_t* P, const float* pe, const bf16_t* W1t, const bf16_t* W2t, bf16_t* KC, bf16_t* VC, int u) {
    const int tid = threadIdx.x, lane = tid & 63, w = __builtin_amdgcn_readfirstlane(tid >> 6), i = lane & 15, g = lane >> 4;
    const int nt = u & 15, gq = (u >> 4) & 1, b = (u >> 5) & 3, kv = u >> 7;
    const int pcol = (kv ? P_VC : P_KC) + gq * 64, tok0 = 256 * nt;
    const bf16_t* bp = W1t + ((size_t)kv * 256 + (tid >> 3)) * 2048 + (tid & 7) * 8; const int bso = (tid >> 3) * RSB + (tid & 7) * 16;
    u32x4 r0[4], r1[4], r2[4], r3[4];
#define CMPR_LOAD(dst, kc) { _Pragma("unroll") for (int q = 0; q < 4; ++q) dst[q] = *(const u32x4*)(bp + (size_t)q * 64 * 2048 + (kc) * 64); }
#define CMPR_STORE(src, buf) { _Pragma("unroll") for (int q = 0; q < 4; ++q) *(NLAS u32x4*)(lds + L_B + (buf) * TBB + bso + q * 64 * RSB) = src[q]; }
    CMPR_LOAD(r0, 0) CMPR_LOAD(r1, 1) CMPR_LOAD(r2, 2) CMPR_LOAD(r3, 3)
#pragma unroll
    for (int q = 0; q < 8; ++q) { const int p = tid + 512 * q, n = p >> 8, l = (p >> 3) & 31, c8 = (p & 7) * 8, tok = tok0 + 16 * n + l;
        u32x4 v = *(const u32x4*)(P + ((size_t)b * T + (tok < T ? tok : T - 1)) * PW + pcol + c8); if (tok >= T) v = (u32x4){0u, 0u, 0u, 0u};
        const float* pa = pe + kv * 2048 + l * 64 + c8; const f32x4 a0 = *(const f32x4*)pa, a1 = *(const f32x4*)(pa + 4);
        u32x4 o; o.x = pkbf(pg8::bflo(v.x) + a0[0], pg8::bfhi(v.x) + a0[1]); o.y = pkbf(pg8::bflo(v.y) + a0[2], pg8::bfhi(v.y) + a0[3]); o.z = pkbf(pg8::bflo(v.z) + a1[0], pg8::bfhi(v.z) + a1[1]); o.w = pkbf(pg8::bflo(v.w) + a1[2], pg8::bfhi(v.w) + a1[3]);
        *(NLAS u32x4*)(lds + L_A + n * RSA + (l * 64 + c8) * 2) = o; }
    CMPR_STORE(r0, 0)
    __syncthreads();
    f32x4 acc[2]; acc[0] = (f32x4){0.f, 0.f, 0.f, 0.f}; acc[1] = acc[0];
    const int aro = i * RSA + 16 * g, bro = (32 * w + i) * RSB + 16 * g;
#define CMPR_STEP(kc, cur, nxt) { if ((kc) + 1 < 32) CMPR_STORE(nxt, ((kc) + 1) & 1) if ((kc) + 4 < 32) CMPR_LOAD(cur, (kc) + 4) \
        { const NLAS char* B = lds + L_B + ((kc) & 1) * TBB + bro; const NLAS char* A = lds + L_A + aro + (kc) * 128; \
          const bf16x8 a0 = *(const NLAS bf16x8*)A, a1 = *(const NLAS bf16x8*)(A + 64); \
          acc[0] = mfma16(a0, *(const NLAS bf16x8*)B, acc[0]); acc[1] = mfma16(a0, *(const NLAS bf16x8*)(B + 16 * RSB), acc[1]); \
          acc[0] = mfma16(a1, *(const NLAS bf16x8*)(B + 64), acc[0]); acc[1] = mfma16(a1, *(const NLAS bf16x8*)(B + 16 * RSB + 64), acc[1]); } \
        __syncthreads(); }
#pragma unroll 1
    for (int k4 = 0; k4 < 32; k4 += 4) { CMPR_STEP(k4, r0, r1) CMPR_STEP(k4 + 1, r1, r2) CMPR_STEP(k4 + 2, r2, r3) CMPR_STEP(k4 + 3, r3, r0) }
#undef CMPR_LOAD
#undef CMPR_STORE
#undef CMPR_STEP
#pragma unroll
    for (int cb = 0; cb < 2; ++cb)
#pragma unroll
        for (int r = 0; r < 4; ++r) { const float x = acc[cb][r], uu = 0.7978845608028654f * (x + 0.044715f * x * x * x); const float gl = x * __builtin_amdgcn_rcpf(1.f + __expf(-2.f * uu));
            *(NLAS bf16_t*)(lds + L_H + (4 * g + r) * RSH + (32 * w + cb * 16 + i) * 2) = f2bf(gl); }
    __syncthreads();
    if (w < 4) { f32x4 o = (f32x4){0.f, 0.f, 0.f, 0.f}; const bf16_t* w2 = W2t + ((size_t)kv * 64 + 16 * w + i) * 256 + 8 * g;
#pragma unroll
        for (int ks = 0; ks < 8; ++ks) o = mfma16(*(const NLAS bf16x8*)(lds + L_H + i * RSH + (32 * ks + 8 * g) * 2), *(const bf16x8*)(w2 + 32 * ks), o);
        bf16_t* dst = (kv ? VC : KC);
#pragma unroll
        for (int r = 0; r < 4; ++r) dst[((size_t)(b * 256 + 16 * nt + 4 * g + r) * 2 + gq) * 64 + 16 * w + i] = f2bf(o[r]); }
    __syncthreads();
}
}

#define LAS __attribute__((address_space(3)))
constexpr int NTHREADS = 512, LDS_BYTES = 147456;
constexpr size_t WS_WIN = 1 * MiB, WS_WG = 9 * MiB, WS_WBR = 15 * MiB, WS_WOUT = 18 * MiB, WS_WFF1 = 20 * MiB, WS_WFF2 = 28 * MiB, WS_WMKV = 36 * MiB, WS_WC1 = 38 * MiB;
constexpr size_t WS_BIASP = 253 * MiB + 768 * 1024, WS_XCH = 254 * MiB;
#define XB_TMO      128
#define XB_XCNT(j)  (256  + 64 * (j))
#define XB_XSUB(j)  (1280 + 64 * (j))
#define XB_XGEN(j)  (2304 + 64 * (j))
#define XB_TOP      3328
#define XB_TOPGEN   3392
#define XCD_BAR_WORDS 3456
#define XB_SPIN_CAP (1u << 18)

__device__ __forceinline__ unsigned xb_ld(unsigned* p)              { return __hip_atomic_load(p, __ATOMIC_RELAXED, __HIP_MEMORY_SCOPE_AGENT); }
__device__ __forceinline__ unsigned xb_add(unsigned* p, unsigned v) { return __hip_atomic_fetch_add(p, v, __ATOMIC_RELAXED, __HIP_MEMORY_SCOPE_AGENT); }
__device__ __forceinline__ unsigned xb_xcc_id() { return (unsigned)__builtin_amdgcn_s_getreg((3 << 11) | 20) & 0xFu; }
#define XB_SPIN(cond, bar) do { unsigned _sp = 0; while (cond) { __builtin_amdgcn_s_sleep(1); \
    if ((++_sp & 255u) == 0u) { if (xb_ld(&(bar)[XB_TMO])) break; if (_sp > XB_SPIN_CAP) { atomicAdd(&(bar)[XB_TMO], 1u); break; } } } } while (0)

struct XcdBarrier {
    unsigned* bar; unsigned x;
    volatile LAS unsigned* st;
};

__device__ __forceinline__ XcdBarrier xcd_barrier_post(unsigned* bar, volatile LAS unsigned* st) {
    XcdBarrier b; b.bar = bar; b.x = xb_xcc_id(); b.st = st;
    if (threadIdx.x == 0) (void)xb_add(&bar[XB_XCNT(b.x)], 1u);
    return b;
}
__device__ __forceinline__ void xcd_barrier_complete(unsigned* bar, unsigned x, unsigned& nloc, unsigned& nx) {
    const unsigned G = gridDim.x * gridDim.y * gridDim.z;
    unsigned sum, cnt, mine, sp = 0u;
    for (;;) {
        sum = 0u; cnt = 0u; mine = 0u;
#pragma unroll
        for (unsigned j = 0; j < 16; ++j) { const unsigned c = xb_ld(&bar[XB_XCNT(j)]); sum += c; cnt += (c > 0u) ? 1u : 0u; mine = (j == x) ? c : mine; }
        if (sum == G) break;
        __builtin_amdgcn_s_sleep(1);
        if ((++sp & 255u) == 0u) { if (xb_ld(&bar[XB_TMO])) break; if (sp > XB_SPIN_CAP) { atomicAdd(&bar[XB_TMO], 1u); break; } }
    }
    nloc = mine > 0u ? mine : 1u; nx = cnt > 0u ? cnt : 1u;
}

__device__ __forceinline__ void xcd_barrier(const XcdBarrier& b) {
    asm volatile("s_waitcnt vmcnt(0)" ::: "memory");
    __syncthreads();
    if (threadIdx.x == 0) {
        unsigned* bar = b.bar;
        __builtin_amdgcn_s_waitcnt(0);
        unsigned nloc = b.st[0], nx = b.st[1];
        if (nloc == 0u) { xcd_barrier_complete(bar, b.x, nloc, nx); b.st[0] = nloc; b.st[1] = nx; }
        const unsigned old = xb_add(&bar[XB_XSUB(b.x)], 1u);
        const unsigned gen = old / nloc;
        if (old + 1u == (gen + 1u) * nloc) {
            __builtin_amdgcn_fence(__ATOMIC_RELEASE, "agent");
            asm volatile("s_waitcnt vmcnt(0)" ::: "memory");
            const unsigned og = xb_add(&bar[XB_TOP], 1u);
            const unsigned tg = og / nx;
            if (og + 1u == (tg + 1u) * nx) xb_add(&bar[XB_TOPGEN], 1u);
            else XB_SPIN(xb_ld(&bar[XB_TOPGEN]) == tg, bar);
            __builtin_amdgcn_fence(__ATOMIC_ACQUIRE, "agent");
            xb_add(&bar[XB_XGEN(b.x)], 1u);
            asm volatile("s_waitcnt vmcnt(0)" ::: "memory");
        } else {
            XB_SPIN(xb_ld(&bar[XB_XGEN(b.x)]) == gen, bar);
            __builtin_amdgcn_fence(__ATOMIC_ACQUIRE, "agent");
            asm volatile("s_waitcnt vmcnt(0)" ::: "memory");
        }
    }
    __syncthreads();
}

__device__ __forceinline__ void group_barrier(unsigned* gc, unsigned target, bool light) {
    asm volatile("s_waitcnt vmcnt(0)" ::: "memory"); __syncthreads();
    if (threadIdx.x == 0) {
        if (!light) { __builtin_amdgcn_fence(__ATOMIC_RELEASE, "agent"); asm volatile("s_waitcnt vmcnt(0)" ::: "memory"); }
        __hip_atomic_fetch_add(gc, 1u, __ATOMIC_RELAXED, __HIP_MEMORY_SCOPE_AGENT);
        unsigned sp = 0; while (__hip_atomic_load(gc, __ATOMIC_RELAXED, __HIP_MEMORY_SCOPE_AGENT) < target) { __builtin_amdgcn_s_sleep(1); if (++sp > (1u << 22)) break; }
        __builtin_amdgcn_fence(__ATOMIC_ACQUIRE, "agent"); asm volatile("s_waitcnt vmcnt(0)" ::: "memory");
    }
    __syncthreads();
}
struct Args { const float* in[18]; float* out; unsigned char* ws; int ph_lo, ph_hi; };
__device__ __forceinline__ unsigned pk2(float lo, float hi) { return (unsigned)f2bf(lo) | ((unsigned)f2bf(hi) << 16); }
typedef unsigned v4u __attribute__((ext_vector_type(4)));
typedef float f32x4 __attribute__((ext_vector_type(4)));
__device__ __forceinline__ void tr_item(const float* W, int ld, int ncols, int K, bf16_t* WT, int row_off, LAS float* scr, int item, int lane) {
    const int nblk = ncols / 32, kb = item / nblk, nb = item % nblk, k0 = 64 * kb, n0 = 32 * nb;
#pragma unroll 8
    for (int i = 0; i < 32; ++i) { const int kk = 2 * i + (lane >> 5); scr[kk * 33 + (lane & 31)] = W[(size_t)(k0 + kk) * ld + n0 + (lane & 31)]; }
    asm volatile("s_waitcnt lgkmcnt(0)" ::: "memory");
    const int c = lane & 7;
#pragma unroll
    for (int j = 0; j < 4; ++j) { const int n = (lane >> 3) + 8 * j; const LAS float* s = scr + (8 * c) * 33 + n;
        v4u o; o.x = pk2(s[0 * 33], s[1 * 33]); o.y = pk2(s[2 * 33], s[3 * 33]); o.z = pk2(s[4 * 33], s[5 * 33]); o.w = pk2(s[6 * 33], s[7 * 33]);
        *(v4u*)(WT + (size_t)(row_off + n0 + n) * K + k0 + 8 * c) = o; }
    asm volatile("s_waitcnt lgkmcnt(0)" ::: "memory");
}
__device__ __forceinline__ void rms_row_wave(const float* xrow, const float* g, bf16_t* orow, int lane) {
    const f32x4* xr = (const f32x4*)xrow + lane; const f32x4* gr = (const f32x4*)g + lane;
    f32x4 v[4]; float s = 0.f;
#pragma unroll
    for (int j = 0; j < 4; ++j) { v[j] = xr[64 * j]; s += (v[j].x * v[j].x + v[j].y * v[j].y) + (v[j].z * v[j].z + v[j].w * v[j].w); }
    const float r = rsqrtf(wave_sum(s) * (1.f / D) + EPS);
    unsigned long long* o8 = (unsigned long long*)orow + lane;
#pragma unroll
    for (int j = 0; j < 4; ++j) { const f32x4 gg = gr[64 * j]; o8[64 * j] = (unsigned long long)pk2(v[j].x * r * gg.x, v[j].y * r * gg.y) | ((unsigned long long)pk2(v[j].z * r * gg.z, v[j].w * r * gg.w) << 32); }
}
__device__ __forceinline__ int small_src_col(int c) { return c < 8 ? C_MLI + c : C_NSG + (c - 8); }
__global__ void __launch_bounds__(NTHREADS, 2) mega(Args a) {
    extern __shared__ __attribute__((aligned(16))) unsigned char lds_raw[];
    char* lds = (char*)lds_raw;
    LAS unsigned char* lds3 = (LAS unsigned char*)lds_raw;
    const float* x = a.in[0]; const float* mem = a.in[1]; const float* g_mix = a.in[2]; const float* w_in = a.in[3];
    const float* b_in = a.in[4]; const float* ml_conv = a.in[5]; const float* ml_norm_g = a.in[6]; const float* cmp_pe = a.in[7];
    const float* cmp_w1 = a.in[8]; const float* cmp_w2 = a.in[9]; const float* g_mem = a.in[10]; const float* w_mem_kv = a.in[11];
    const float* w_branch = a.in[12]; const float* w_out = a.in[13]; const float* g_ffn = a.in[14]; const float* w_ff1 = a.in[15];
    const float* w_ff2 = a.in[16]; const float* g_final = a.in[17];
    char* ws = (char*)a.ws; float* out = a.out;
    bf16_t* U = (bf16_t*)(ws + WS_U); bf16_t* P = (bf16_t*)(ws + WS_P);
    bf16_t* Yml = (bf16_t*)(ws + WS_Y); bf16_t* Ynsa = Yml + (size_t)M * 512; bf16_t* Yxa = Ynsa + (size_t)M * 512;
    float* S32 = (float*)(ws + WS_S32); bf16_t* MEMN = (bf16_t*)out + (size_t)16 * 1024 * 1024;     bf16_t* MEMKV = (bf16_t*)(ws + WS_MEMKV);
    bf16_t* KC = (bf16_t*)(ws + WS_KC); bf16_t* VC = (bf16_t*)(ws + WS_VC);
    float* NA = (float*)(ws + WS_NA); float* Gc = (float*)(ws + WS_G); float* Mloc = (float*)(ws + WS_MLOC); float* Mprev = (float*)(ws + WS_MPREV);
    bf16_t* Abuf = (bf16_t*)out;
    bf16_t* GATES = P; bf16_t* MERGED = U; bf16_t* AFFN = U; bf16_t* HBUF = P;
    bf16_t* Wi = (bf16_t*)(ws + WS_WIN); bf16_t* Wg = (bf16_t*)(ws + WS_WG); bf16_t* Wbr = (bf16_t*)(ws + WS_WBR); bf16_t* Wo = (bf16_t*)(ws + WS_WOUT);
    bf16_t* Wf1 = (bf16_t*)(ws + WS_WFF1); bf16_t* Wf2 = (bf16_t*)(ws + WS_WFF2); bf16_t* Wmkv = (bf16_t*)(ws + WS_WMKV);
    float* biasP = (float*)(ws + WS_BIASP); bf16_t* Wc1 = (bf16_t*)(ws + WS_WC1); bf16_t* Wc2 = (bf16_t*)(ws + WS_BIASP + 65536);
    const int tid = threadIdx.x, lane = tid & 63, wave = __builtin_amdgcn_readfirstlane(tid >> 6);
    const int G = gridDim.x, bid = blockIdx.x;
    const int lo = a.ph_lo, hi = a.ph_hi;
    volatile LAS unsigned* xbst = (volatile LAS unsigned*)(lds3 + LDS_BYTES - 64);
    if (tid < 2) xbst[tid] = 0u;
    __syncthreads();
    const XcdBarrier bar = xcd_barrier_post((unsigned*)ws, xbst);
    if (tid == 0) __hip_atomic_store((unsigned*)ws + 12544 + bid, xb_xcc_id() + 1u, __ATOMIC_RELAXED, __HIP_MEMORY_SCOPE_AGENT);
#define PHASE(k) if (lo <= (k) && (k) < hi)
#define SEAM(k) if (lo <= (k) && (k) + 1 < hi) xcd_barrier(bar)
    PHASE(0) {
        LAS float* scr = (LAS float*)(lds3 + wave * 16384);
        const int gw = bid * 8 + wave, NGW = G * 8;
        constexpr int I0 = 16 * 64, I1 = 16 * 40, I2 = 16 * 16, I3 = 16 * 96, I4 = 8 * 32, I5 = 16 * 32, I6 = 16 * 128, I7 = 64 * 32, I8 = 16 * 32;
        constexpr int I9 = 32 * 8, I10 = 4 * 2;
        constexpr int NITEMS = I0 + I1 + I2 + I3 + 3 * I4 + I5 + I6 + I7 + I8 + 2 * I9 + 2 * I10;
        for (int it = gw; it < NITEMS; it += NGW) {
            int r = it;
            if (r < I0) { tr_item(w_in, DIN, 2048, 1024, Wi, 0, scr, r, lane); continue; } r -= I0;
            if (r < I1) { tr_item(w_in + 2056, DIN, 1280, 1024, Wi, 2048, scr, r, lane); continue; } r -= I1;
            if (r < I2) { tr_item(w_in + 3360, DIN, 512, 1024, Wi, 3328, scr, r, lane); continue; } r -= I2;
            if (r < I3) { tr_item(w_in + C_MG, DIN, 3072, 1024, Wg, 0, scr, r, lane); continue; } r -= I3;
            if (r < 3 * I4) { const int j = r / I4; tr_item(w_branch + (size_t)j * 512 * 1024, 1024, 1024, 512, Wbr + (size_t)j * 1024 * 512, 0, scr, r % I4, lane); continue; } r -= 3 * I4;
            if (r < I5) { tr_item(w_out, 1024, 1024, 1024, Wo, 0, scr, r, lane); continue; } r -= I5;
            if (r < I6) { tr_item(w_ff1, FF, FF, 1024, Wf1, 0, scr, r, lane); continue; } r -= I6;
            if (r < I7) { tr_item(w_ff2, 1024, 1024, FF, Wf2, 0, scr, r, lane); continue; } r -= I7;
            if (r < I8) { tr_item(w_mem_kv, 1024, 1024, 1024, Wmkv, 0, scr, r, lane); continue; } r -= I8;
            if (r < 2 * I9) { const int kv = r / I9; tr_item(cmp_w1 + (size_t)kv * 2048 * 256, 256, 256, 2048, Wc1 + (size_t)kv * 256 * 2048, 0, scr, r % I9, lane); continue; } r -= 2 * I9;
            { const int kv = r / I10; tr_item(cmp_w2 + (size_t)kv * 256 * 64, 64, 64, 256, Wc2 + (size_t)kv * 64 * 256, 0, scr, r % I10, lane); }
        }
        for (int i = bid * NTHREADS + tid; i < 256 * 1024; i += G * NTHREADS) { const int r = i >> 10, k = i & 1023; bf16_t v = 0;
            if (r < 32) v = f2bf(w_in[(size_t)k * DIN + small_src_col(r)]);
            else if (r >= 128 && r < 160) { const float w = w_in[(size_t)k * DIN + small_src_col(r - 128)]; v = f2bf(w - bf2f(f2bf(w))); }
            Wi[(size_t)(3840 + r) * 1024 + k] = v; }
        for (int c = bid * NTHREADS + tid; c < 4096; c += G * NTHREADS) { float v = 0.f;
            if (c < 2048) v = b_in[c]; else if (c < 3328) v = b_in[c + 8]; else if (c < 3840) v = b_in[c + 32]; else if (c < 3872) v = b_in[small_src_col(c - 3840)];
            biasP[c] = v; }
        for (int m = gw; m < M; m += NGW) rms_row_wave(x + (size_t)m * D, g_mix, U + (size_t)m * D, lane);
        for (int m = gw; m < 1024; m += NGW) rms_row_wave(mem + (size_t)m * D, g_mem, MEMN + (size_t)m * D, lane);
    }
    SEAM(0);
    PHASE(1) {
        { pg8::Gemm g{U, Wi, M, 4096, D}; pg8::StaticOrder S; S.init(M, 4096, G, bid);
          pg8::EpiStore<0> E{P, biasP, S32, PW, 15};
          pg8::gemm_phase<pg8::EpiStore<0>, pg8::StaticOrder, true, true>(lds3, g, S, E); }
    }
    SEAM(1);
    PHASE(2) { for (int tl_ = bid; tl_ < 256; tl_ += G) xa::memkv_tile((NLAS char*)lds_raw, MEMN, Wmkv, MEMKV, tl_);
               for (int ci = bid; ci < 1024; ci += G) ml::m1_unit((NLAS char*)lds_raw, P, ml_conv, S32, Abuf, NA, Gc, Mloc, ci);
               for (int u = bid; u < 256; u += G) cmpr::unit((NLAS char*)lds_raw, P, cmp_pe, Wc1, Wc2, KC, VC, u);
    }
    SEAM(2);
    PHASE(3) { unsigned* m2cnt = (unsigned*)ws + 12288;
               ml::m2_items(Abuf, NA, Gc, Mloc, Mprev);
               asm volatile("s_waitcnt vmcnt(0)" ::: "memory"); __syncthreads();
               if (tid == 0) { __builtin_amdgcn_fence(__ATOMIC_RELEASE, "agent"); asm volatile("s_waitcnt vmcnt(0)" ::: "memory"); __hip_atomic_fetch_add(m2cnt, 1u, __ATOMIC_RELAXED, __HIP_MEMORY_SCOPE_AGENT); }
               nsa::phase((NLAS char*)lds_raw, P, S32, KC, VC, Ynsa);
               xa::phase((NLAS char*)lds_raw, P, MEMKV, Yxa);
               if (tid == 0) { unsigned sp = 0; while (__hip_atomic_load(m2cnt, __ATOMIC_RELAXED, __HIP_MEMORY_SCOPE_AGENT) < (unsigned)G) { __builtin_amdgcn_s_sleep(2); if (++sp > (1u << 22)) break; }
                               __builtin_amdgcn_fence(__ATOMIC_ACQUIRE, "agent"); asm volatile("s_waitcnt vmcnt(0)" ::: "memory"); }
               __syncthreads();
               for (int ci = bid; ci < 1024; ci += G) ml::m3_unit((NLAS char*)lds_raw, P, ml_conv, S32, Abuf, NA, Mprev, ml_norm_g, Yml, ci); }
    SEAM(4);
    unsigned* gcnt = (unsigned*)ws + 13312 + 16 * (bid & 63);
    bool panel_sync = false;
    if (G == 256) { volatile LAS unsigned* flag = (volatile LAS unsigned*)(lds3 + LDS_BYTES - 48);
        if (wave == 0) { const unsigned* xt = (const unsigned*)ws + 12544; unsigned x0 = 0, same = 1;
            for (int k = 0; k < 4; ++k) { const unsigned xv = __hip_atomic_load(xt + lane + 64 * k, __ATOMIC_RELAXED, __HIP_MEMORY_SCOPE_AGENT); if (k == 0) x0 = xv; same &= (xv == x0 && xv != 0u) ? 1u : 0u; }
            const unsigned long long all = __ballot(same != 0u); if (lane == 0) flag[0] = (all == ~0ull) ? 1u : 0u; }
        __syncthreads();
        panel_sync = flag[0] != 0u; }
    const bool light = true;
#define PSEAM(k, n) if (lo <= (k) && (k) + 1 < hi) { if (panel_sync) group_barrier(gcnt, 4u * (n), light); else xcd_barrier(bar); }
    PHASE(5) { pg8::Gemm g{U, Wg, M, 3072, D}; pg8::StaticOrder S; S.init(M, 3072, G, bid);
               pg8::EpiStore<1> E{GATES, b_in + C_MG, nullptr, 4096, -1};
               pg8::gemm_phase<pg8::EpiStore<1>, pg8::StaticOrder, true, true>(lds3, g, S, E); }
    PSEAM(5, 1);
    PHASE(6) { pg8::Gemm g{Yml, Wbr, M, 1024, 512}; pg8::MergeOrder S; S.so.init(M, 1024, G, bid); S.sa = (size_t)M * 512 * 2; S.sb = (size_t)1024 * 512 * 2;
               pg8::EpiMergeG E{GATES, (bf16_t*)out, MERGED};
               pg8::gemm_phase<pg8::EpiMergeG, pg8::MergeOrder, true, true>(lds3, g, S, E); }
    PSEAM(6, 2);
    PHASE(7) { pg8::Gemm g{MERGED, Wo, M, 1024, D}; pg8::StaticOrder S; S.init(M, 1024, G, bid);
               pg8::EpiResRms E{x, out, nullptr, AFFN, g_ffn, (float*)(ws + WS_XCH), (unsigned*)ws + 4096};
               pg8::gemm_phase<pg8::EpiResRms, pg8::StaticOrder, false, true>(lds3, g, S, E); }
    PSEAM(7, 3);
    PHASE(9) { pg8::Gemm g{AFFN, Wf1, M, FF, D}; pg8::StaticOrder S; S.init(M, FF, G, bid);
               pg8::EpiStore<2> E{HBUF, nullptr, nullptr, FF, -1};
               pg8::gemm_phase<pg8::EpiStore<2>, pg8::StaticOrder, true, true>(lds3, g, S, E); }
    PSEAM(9, 4);
    PHASE(10) { pg8::Gemm g{HBUF, Wf2, M, 1024, FF}; pg8::StaticOrder S; S.init(M, 1024, G, bid);
                pg8::EpiResRms E{out, nullptr, out, nullptr, g_final, (float*)(ws + WS_XCH + 262144), (unsigned*)ws + 4096 + 4096};
                pg8::gemm_phase<pg8::EpiResRms, pg8::StaticOrder, false, true>(lds3, g, S, E); }
}
constexpr int N_PHASES = 12;
extern "C" void kernel_launch(void* const* d_in, const int* in_sizes, int n_in, void* d_out, int out_size, void* d_ws, size_t ws_size, hipStream_t stream) {
    static int grid = 0;
    if (grid == 0) {
        int dev = 0, cus = 0, per_cu = 0;
        (void)hipGetDevice(&dev); (void)hipDeviceGetAttribute(&cus, hipDeviceAttributeMultiprocessorCount, dev);
        (void)hipFuncSetAttribute((const void*)mega, hipFuncAttributeMaxDynamicSharedMemorySize, LDS_BYTES);
        (void)hipOccupancyMaxActiveBlocksPerMultiprocessor(&per_cu, (const void*)mega, NTHREADS, LDS_BYTES);
        if (per_cu < 1) { fprintf(stderr, "occupancy query says %d blocks/CU\n", per_cu); per_cu = 1; }
        grid = cus * 1;
        (void)hipGetLastError();
    }
    (void)hipMemsetAsync(d_ws, 0, 65536, stream);
    Args a{};
    for (int i = 0; i < 18; ++i) a.in[i] = (const float*)d_in[i];
    a.out = (float*)d_out; a.ws = (unsigned char*)d_ws;
    a.ph_lo = 0; a.ph_hi = N_PHASES; void* args[] = {&a};
    hipError_t e = hipLaunchCooperativeKernel((const void*)mega, dim3(grid), dim3(NTHREADS), args, LDS_BYTES, stream);
    if (e != hipSuccess) {
        (void)hipGetLastError();
        hipLaunchKernelGGL(mega, dim3(grid), dim3(NTHREADS), LDS_BYTES, stream, a);
    }
}
```

```cpp
#include <hip/hip_runtime.h>
#include <hip/hip_cooperative_groups.h>
#include <cstdio>
namespace cg = cooperative_groups;
#include <stdint.h>

typedef unsigned short bf16_t;
__device__ __forceinline__ float bf2f(bf16_t v) { return __uint_as_float(((unsigned)v) << 16); }
__device__ __forceinline__ bf16_t f2bf(float f) { unsigned u = __float_as_uint(f); return (bf16_t)((u + 0x7fffu + ((u >> 16) & 1u)) >> 16); }

constexpr int NB = 4, T = 4096, M = NB * T, D = 1024, DIN = 6944, FF = 4096;
constexpr float EPS = 1e-6f;
constexpr int C_MLI = 2048, C_NSG = 3336, C_MG = 3872;
constexpr int P_MLQ = 0, P_MLK = 512, P_MLV = 1024, P_MLO = 1536, P_NSQ = 2048, P_KC = 2560, P_VC = 2688, P_KS = 2816, P_VS = 2944, P_KW = 3072, P_VW = 3200, P_XAQ = 3328, PW = 3840;
constexpr size_t MiB = 1u << 20;
constexpr size_t WS_U = 40 * MiB;
constexpr size_t WS_P = 72 * MiB;
constexpr size_t WS_Y = 200 * MiB;
constexpr size_t WS_S32 = 248 * MiB;
constexpr size_t WS_MEMKV = 250 * MiB;
constexpr size_t WS_KC = 252 * MiB;
constexpr size_t WS_VC = 252 * MiB + 512 * 1024;
constexpr size_t WS_NA = 253 * MiB;
constexpr size_t WS_G = 253 * MiB + 512 * 1024;
constexpr size_t WS_MLOC = 253 * MiB + 512 * 1024 + 4096;
constexpr size_t WS_MPREV = 253 * MiB + 512 * 1024 + 8192;

template <bool MAX> __device__ __forceinline__ float wave_scan_dpp(float v) {
    constexpr int IDN = MAX ? (int)0xFF800000 : 0;
#define WSC_STEP(ctrl, rm) { const float t = __builtin_bit_cast(float, __builtin_amdgcn_update_dpp(IDN, __builtin_bit_cast(int, v), ctrl, rm, 0xF, false)); v = MAX ? fmaxf(v, t) : v + t; }
    WSC_STEP(0x111, 0xF) WSC_STEP(0x112, 0xF) WSC_STEP(0x114, 0xF) WSC_STEP(0x118, 0xF) WSC_STEP(0x142, 0xA) WSC_STEP(0x143, 0xC)
#undef WSC_STEP
    return v;
}
__device__ __forceinline__ void xrow_swap16(float v, float& a, float& b) { a = v; b = v; asm volatile("s_nop 1\n\tv_permlane16_swap_b32 %0, %1" : "+v"(a), "+v"(b)); }
__device__ __forceinline__ void xrow_swap32(float v, float& a, float& b) { a = v; b = v; asm volatile("s_nop 1\n\tv_permlane32_swap_b32 %0, %1" : "+v"(a), "+v"(b)); }
__device__ __forceinline__ float xrow_sum(float v) { float a, b; xrow_swap16(v, a, b); v = a + b; xrow_swap32(v, a, b); return a + b; }
__device__ __forceinline__ float xrow_max(float v) { float a, b; xrow_swap16(v, a, b); v = fmaxf(a, b); xrow_swap32(v, a, b); return fmaxf(a, b); }
__device__ __forceinline__ float wave_sum(float v) { return __builtin_bit_cast(float, __builtin_amdgcn_readlane(__builtin_bit_cast(int, wave_scan_dpp<false>(v)), 63)); }
__device__ __forceinline__ float wave_max(float v) { return __builtin_bit_cast(float, __builtin_amdgcn_readlane(__builtin_bit_cast(int, wave_scan_dpp<true>(v)), 63)); }

__device__ __forceinline__ float logsig(float x) { return fminf(x, 0.f) - log1pf(__expf(-fabsf(x))); }
namespace pg8 {
#define PG8_LAS __attribute__((address_space(3)))
typedef unsigned short bf16_t;
typedef short bf16x8 __attribute__((ext_vector_type(8)));
typedef float f32x4 __attribute__((ext_vector_type(4)));
typedef unsigned u32x4 __attribute__((ext_vector_type(4)));
constexpr int BM = 256, BK = 64, HALF = 128, HTB = HALF * BK * 2  , STAGE_BYTES = 8 * HTB, NXCD = 8, WGM = 8;

__host__ __device__ __forceinline__ int lds_byte(int r, int c) { const int st = (r >> 4) * 2 + (c >> 5), rr = r & 15, cc = c & 31, ob = rr * 64 + cc * 2; return st * 1024 + (ob ^ (((ob >> 9) & 1) << 5)); }
__host__ __device__ __forceinline__ void stage_rc(int b, int& R, int& C) { const int st = b / 1024, sb = b % 1024, swz = sb ^ (((sb >> 9) & 1) << 5); R = (st >> 1) * 16 + swz / 64; C = (st & 1) * 32 + (swz % 64) / 2; }
__host__ __device__ __forceinline__ int perm32(int rho) { const int n = rho >> 4, i = rho & 15; return 8 * (i >> 2) + 4 * n + (i & 3); }

struct Unit { int pm, pn, j; };
struct Gemm { const bf16_t* A; const bf16_t* Bt; int M, N, K; };

struct StaticOrder {
    int nM, nN, nwg, G, c; size_t astep;
    __host__ __device__ void init(int M, int N, int G_, int c_) { nM = M / BM; nN = N / BM; nwg = nM * nN; G = G_; c = c_; astep = 0; }
    __host__ __device__ bool next(int i, Unit& u) const {
        const long L = (long)i * G + c; if (L >= nwg) return false;
        int wgid = (int)L; { const int q = nwg / NXCD, r = nwg % NXCD, xcd = wgid % NXCD, off = wgid / NXCD; wgid = (xcd < r ? xcd * (q + 1) : r * (q + 1) + (xcd - r) * q) + off; }
        const int nig = WGM * nN, gid = wgid / nig, fm = gid * WGM, gsz = (nM - fm) < WGM ? (nM - fm) : WGM;
        u.pm = fm + ((wgid % nig) % gsz); u.pn = (wgid % nig) / gsz; u.j = 0; return true;
    }
    __device__ __forceinline__ const char* pa(const Gemm& g, const Unit& u, size_t tstep) const { return (const char*)g.A + (size_t)u.pm * (astep ? astep : tstep); }
    __device__ __forceinline__ const char* pb(const Gemm& g, const Unit& u, size_t tstep) const { return (const char*)g.Bt + (size_t)u.pn * tstep; }
    __device__ __forceinline__ void a_ready(const Unit&) const {}
    __device__ __forceinline__ void done(const Unit&) const {}
};

struct MergeOrder {
    StaticOrder so; size_t sa, sb;
    __device__ __forceinline__ bool next(int i, Unit& u) const { if (i >= 3) return false; const bool ok = so.next(0, u); u.j = i; return ok; }
    __device__ __forceinline__ const char* pa(const Gemm& g, const Unit& u, size_t tstep) const { return (const char*)g.A + (size_t)u.j * sa + (size_t)u.pm * tstep; }
    __device__ __forceinline__ const char* pb(const Gemm& g, const Unit& u, size_t tstep) const { return (const char*)g.Bt + (size_t)u.j * sb + (size_t)u.pn * tstep; }
    __device__ __forceinline__ void a_ready(const Unit&) const {}
    __device__ __forceinline__ void done(const Unit&) const {}
};
typedef float f32x2_t __attribute__((ext_vector_type(2))); typedef __bf16 bf16x2_t __attribute__((ext_vector_type(2)));
__device__ __forceinline__ unsigned cvt_pk_bf16(float lo, float hi) { f32x2_t v = {lo, hi}; bf16x2_t b = __builtin_convertvector(v, bf16x2_t); return __builtin_bit_cast(unsigned, b); }
typedef float f32x2 __attribute__((ext_vector_type(2)));

typedef unsigned u32x2 __attribute__((ext_vector_type(2)));
__device__ __forceinline__ float bflo(unsigned w) { return __uint_as_float(w << 16); }
__device__ __forceinline__ float bfhi(unsigned w) { return __uint_as_float(w & 0xffff0000u); }
template <int ACT> __device__ __forceinline__ f32x4 act4(f32x4 v) {
    if (ACT == 1) { f32x4 o; for (int e = 0; e < 4; ++e) o[e] = __builtin_amdgcn_rcpf(1.f + __expf(-fmaxf(v[e], -30.f))); return o; }
    if (ACT == 2) { f32x4 o; for (int e = 0; e < 4; ++e) { const float r = fmaxf(v[e], 0.f); o[e] = r * r; } return o; }
    return v;
}
template <int ACT> struct EpiStore {
    static constexpr bool PERM = true, AFTER_DRAIN = false;
    bf16_t* O; const float* bias; float* S32; int ldc, small_pn;
    __device__ __forceinline__ void operator()(const f32x4 (&acc)[2][2][4][2], const Unit& u, int wr, int wc, int fr, int fq) const {
        asm volatile("s_waitcnt vmcnt(0)" ::: "memory");
        const int row0 = u.pm * BM + wr * 64 + fr, col0 = u.pn * BM + wc * 32 + 8 * fq;
        if (u.pn == small_pn) {
            if (wc == 0) {
                const f32x4 b0 = *(const f32x4*)(bias + col0), b1 = *(const f32x4*)(bias + col0 + 4);
#pragma unroll
                for (int ai = 0; ai < 2; ++ai)
#pragma unroll
                    for (int m = 0; m < 4; ++m) { float* rp = S32 + (size_t)(row0 + ai * HALF + m * 16) * 32 + 8 * fq;
                        *(f32x4*)rp = acc[ai][0][m][0] + acc[ai][1][m][0] + b0; *(f32x4*)(rp + 4) = acc[ai][0][m][1] + acc[ai][1][m][1] + b1; }
            }
            return;
        }
        f32x4 bv[2][2];
#pragma unroll
        for (int bj = 0; bj < 2; ++bj)
#pragma unroll
            for (int n = 0; n < 2; ++n) bv[bj][n] = bias ? *(const f32x4*)(bias + col0 + bj * HALF + 4 * n) : (f32x4){0.f, 0.f, 0.f, 0.f};
#pragma unroll
        for (int ai = 0; ai < 2; ++ai)
#pragma unroll
            for (int m = 0; m < 4; ++m) { bf16_t* rowp = O + (size_t)(row0 + ai * HALF + m * 16) * ldc + col0;
#pragma unroll
                for (int bj = 0; bj < 2; ++bj) { const f32x4 v0 = act4<ACT>(acc[ai][bj][m][0] + bv[bj][0]), v1 = act4<ACT>(acc[ai][bj][m][1] + bv[bj][1]);
                    u32x4 w; w.x = cvt_pk_bf16(v0[0], v0[1]); w.y = cvt_pk_bf16(v0[2], v0[3]); w.z = cvt_pk_bf16(v1[0], v1[1]); w.w = cvt_pk_bf16(v1[2], v1[3]);
                    *(u32x4*)(rowp + bj * HALF) = w; } }
    }
};
struct EpiMergeG {
    static constexpr bool PERM = true, AFTER_DRAIN = false;
    const bf16_t* G; bf16_t* Mp; bf16_t* Mb;
    template <bool HASP>
    __device__ __forceinline__ void body(const f32x4 (&acc)[2][2][4][2], int j, bf16_t* dst, size_t dpitch, int row0, int col0) const {
        constexpr size_t mpitch = 2048;
#pragma unroll
        for (int ai = 0; ai < 2; ++ai) { u32x4 gw[4][2], pw[4][2];
#pragma unroll
            for (int m = 0; m < 4; ++m)
#pragma unroll
                for (int bj = 0; bj < 2; ++bj) { const size_t row = (size_t)(row0 + ai * HALF + m * 16); const int col = col0 + bj * HALF;
                    gw[m][bj] = *(const u32x4*)(G + row * 4096 + j * 1024 + col); if (HASP) pw[m][bj] = *(const u32x4*)(Mp + row * mpitch + col); }
#pragma unroll
            for (int m = 0; m < 4; ++m)
#pragma unroll
                for (int bj = 0; bj < 2; ++bj) { const size_t row = (size_t)(row0 + ai * HALF + m * 16); const int col = col0 + bj * HALF; const u32x4 g4 = gw[m][bj];
                    f32x4 v0 = (f32x4){bflo(g4.x), bfhi(g4.x), bflo(g4.y), bfhi(g4.y)} * acc[ai][bj][m][0], v1 = (f32x4){bflo(g4.z), bfhi(g4.z), bflo(g4.w), bfhi(g4.w)} * acc[ai][bj][m][1];
                    if (HASP) { const u32x4 p4 = pw[m][bj]; v0 += (f32x4){bflo(p4.x), bfhi(p4.x), bflo(p4.y), bfhi(p4.y)}; v1 += (f32x4){bflo(p4.z), bfhi(p4.z), bflo(p4.w), bfhi(p4.w)}; }
                    u32x4 w; w.x = cvt_pk_bf16(v0[0], v0[1]); w.y = cvt_pk_bf16(v0[2], v0[3]); w.z = cvt_pk_bf16(v1[0], v1[1]); w.w = cvt_pk_bf16(v1[2], v1[3]); *(u32x4*)(dst + row * dpitch + col) = w; } }
    }
    __device__ __forceinline__ void operator()(const f32x4 (&acc)[2][2][4][2], const Unit& u, int wr, int wc, int fr, int fq) const {
        const int j = u.j;
        asm volatile("s_waitcnt vmcnt(0)" ::: "memory");
        const int row0 = u.pm * BM + wr * 64 + fr, col0 = u.pn * BM + wc * 32 + 8 * fq;
        if (j == 0) body<false>(acc, 0, Mp, 2048, row0, col0);
        else if (j == 1) body<true>(acc, 1, Mp, 2048, row0, col0);
        else body<true>(acc, 2, Mb, 1024, row0, col0);
    }
};
struct EpiMergeR {
    static constexpr bool PERM = true, AFTER_DRAIN = false;
    const bf16_t* G; bf16_t* Mb;
    __device__ __forceinline__ void operator()(f32x4 (&acc)[2][2][4][2], const Unit& u, int wr, int wc, int fr, int fq) const {
        const int j = u.j;
        const int row0 = u.pm * BM + wr * 64 + fr, col0 = u.pn * BM + wc * 32 + 8 * fq;
        if (j < 2) {
#pragma unroll
            for (int ai = 0; ai < 2; ++ai) { u32x4 ga[4][2], gb[4][2];
#pragma unroll
                for (int m = 0; m < 4; ++m)
#pragma unroll
                    for (int bj = 0; bj < 2; ++bj) { const bf16_t* gp = G + (size_t)(row0 + ai * HALF + m * 16) * 4096 + j * 1024 + col0 + bj * HALF;
                        ga[m][bj] = *(const u32x4*)gp; gb[m][bj] = *(const u32x4*)(gp + 1024); }
#pragma unroll
                for (int m = 0; m < 4; ++m)
#pragma unroll
                    for (int bj = 0; bj < 2; ++bj) { const u32x4 a4 = ga[m][bj], b4 = gb[m][bj];
                        const f32x4 r0 = (f32x4){bflo(a4.x) * __builtin_amdgcn_rcpf(bflo(b4.x)), bfhi(a4.x) * __builtin_amdgcn_rcpf(bfhi(b4.x)), bflo(a4.y) * __builtin_amdgcn_rcpf(bflo(b4.y)), bfhi(a4.y) * __builtin_amdgcn_rcpf(bfhi(b4.y))};
                        const f32x4 r1 = (f32x4){bflo(a4.z) * __builtin_amdgcn_rcpf(bflo(b4.z)), bfhi(a4.z) * __builtin_amdgcn_rcpf(bfhi(b4.z)), bflo(a4.w) * __builtin_amdgcn_rcpf(bflo(b4.w)), bfhi(a4.w) * __builtin_amdgcn_rcpf(bfhi(b4.w))};
                        acc[ai][bj][m][0] = acc[ai][bj][m][0] * r0; acc[ai][bj][m][1] = acc[ai][bj][m][1] * r1; } }
        } else {
            asm volatile("s_waitcnt vmcnt(0)" ::: "memory");
#pragma unroll
            for (int ai = 0; ai < 2; ++ai) { u32x4 gw[4][2];
#pragma unroll
                for (int m = 0; m < 4; ++m)
#pragma unroll
                    for (int bj = 0; bj < 2; ++bj) gw[m][bj] = *(const u32x4*)(G + (size_t)(row0 + ai * HALF + m * 16) * 4096 + 2 * 1024 + col0 + bj * HALF);
#pragma unroll
                for (int m = 0; m < 4; ++m)
#pragma unroll
                    for (int bj = 0; bj < 2; ++bj) { const size_t row = (size_t)(row0 + ai * HALF + m * 16); const int col = col0 + bj * HALF; const u32x4 g4 = gw[m][bj];
                        const f32x4 v0 = (f32x4){bflo(g4.x), bfhi(g4.x), bflo(g4.y), bfhi(g4.y)} * acc[ai][bj][m][0], v1 = (f32x4){bflo(g4.z), bfhi(g4.z), bflo(g4.w), bfhi(g4.w)} * acc[ai][bj][m][1];
                        u32x4 w; w.x = cvt_pk_bf16(v0[0], v0[1]); w.y = cvt_pk_bf16(v0[2], v0[3]); w.z = cvt_pk_bf16(v1[0], v1[1]); w.w = cvt_pk_bf16(v1[2], v1[3]); *(u32x4*)(Mb + row * 1024 + col) = w; } }
        }
    }
};
struct EpiResidF {
    static constexpr bool PERM = true, AFTER_DRAIN = false;
    const float* X; float* O;
    __device__ __forceinline__ void operator()(const f32x4 (&acc)[2][2][4][2], const Unit& u, int wr, int wc, int fr, int fq) const {
        asm volatile("s_waitcnt vmcnt(0)" ::: "memory");
        const int row0 = u.pm * BM + wr * 64 + fr, col0 = u.pn * BM + wc * 32 + 8 * fq;
#pragma unroll
        for (int ai = 0; ai < 2; ++ai)
#pragma unroll
            for (int m = 0; m < 4; ++m) { const size_t off = (size_t)(row0 + ai * HALF + m * 16) * 1024 + col0;
#pragma unroll
                for (int bj = 0; bj < 2; ++bj) { const f32x4 x0 = *(const f32x4*)(X + off + bj * HALF), x1 = *(const f32x4*)(X + off + bj * HALF + 4);
                    *(f32x4*)(O + off + bj * HALF) = x0 + acc[ai][bj][m][0]; *(f32x4*)(O + off + bj * HALF + 4) = x1 + acc[ai][bj][m][1]; } }
    }
};
constexpr size_t HB_PANEL = 524288;
struct EpiResH {
    static constexpr bool PERM = false, AFTER_DRAIN = true;
    const float* R; bf16_t* Hb; float* SS;
    __device__ __forceinline__ void fused(f32x4 (&acc)[2][2][4][2], const Unit& u, int wr, int wc, int fr, int fq, PG8_LAS unsigned char* lds, int wid, int lane) const {
        PG8_LAS float* Pp = (PG8_LAS float*)lds;
        const int col0 = u.pn * BM + wc * 32 + 4 * fq; bf16_t* hb = Hb + (size_t)u.pm * HB_PANEL;
#pragma unroll
        for (int ai = 0; ai < 2; ++ai) { f32x4 pre[4][2][2];
#pragma unroll
            for (int m = 0; m < 4; ++m) { const size_t off = (size_t)(u.pm * BM + ai * HALF + wr * 64 + m * 16 + fr) * 1024 + col0;
#pragma unroll
                for (int bj = 0; bj < 2; ++bj)
#pragma unroll
                    for (int n = 0; n < 2; ++n) pre[m][bj][n] = __builtin_nontemporal_load((const f32x4*)(R + off + bj * HALF + n * 16)); }
#pragma unroll
            for (int m = 0; m < 4; ++m) { float sq = 0.f; const int r = ai * HALF + wr * 64 + m * 16 + fr;
#pragma unroll
                for (int bj = 0; bj < 2; ++bj)
#pragma unroll
                    for (int n = 0; n < 2; ++n) { const f32x4 v = acc[ai][bj][m][n] + pre[m][bj][n]; sq += (v[0] * v[0] + v[1] * v[1]) + (v[2] * v[2] + v[3] * v[3]);
                        u32x2 w; w.x = cvt_pk_bf16(v[0], v[1]); w.y = cvt_pk_bf16(v[2], v[3]); *(u32x2*)(hb + (size_t)r * 1024 + col0 + bj * HALF + n * 16) = w; }
                sq = xrow_sum(sq);
                if (fq == 0) Pp[r * 4 + wc] = sq; } }
        asm volatile("s_waitcnt lgkmcnt(0)" ::: "memory"); __builtin_amdgcn_s_barrier(); asm volatile("" ::: "memory");
        const int row = wid * 32 + (lane & 31);
        if (lane < 32) SS[(size_t)(u.pm * BM + row) * 4 + u.pn] = (Pp[row * 4 + 0] + Pp[row * 4 + 1]) + (Pp[row * 4 + 2] + Pp[row * 4 + 3]);
    }
};
template <int ACT> struct EpiStoreRs {
    static constexpr bool PERM = true, AFTER_DRAIN = false;
    bf16_t* O; const float* SS; int ldc;
    __device__ __forceinline__ void operator()(const f32x4 (&acc)[2][2][4][2], const Unit& u, int wr, int wc, int fr, int fq) const {
        asm volatile("s_waitcnt vmcnt(0)" ::: "memory");
        const int row0 = u.pm * BM + wr * 64 + fr, col0 = u.pn * BM + wc * 32 + 8 * fq;
        float rs[2][4];
#pragma unroll
        for (int ai = 0; ai < 2; ++ai)
#pragma unroll
            for (int m = 0; m < 4; ++m) { const f32x4 t = *(const f32x4*)(SS + (size_t)(row0 + ai * HALF + m * 16) * 4); rs[ai][m] = rsqrtf(((t[0] + t[1]) + (t[2] + t[3])) * (1.0f / 1024.0f) + 1e-6f); }
#pragma unroll
        for (int ai = 0; ai < 2; ++ai)
#pragma unroll
            for (int m = 0; m < 4; ++m) { bf16_t* rowp = O + (size_t)(row0 + ai * HALF + m * 16) * ldc + col0; const float r = rs[ai][m];
#pragma unroll
                for (int bj = 0; bj < 2; ++bj) { const f32x4 v0 = act4<ACT>(acc[ai][bj][m][0] * r), v1 = act4<ACT>(acc[ai][bj][m][1] * r);
                    u32x4 w; w.x = cvt_pk_bf16(v0[0], v0[1]); w.y = cvt_pk_bf16(v0[2], v0[3]); w.z = cvt_pk_bf16(v1[0], v1[1]); w.w = cvt_pk_bf16(v1[2], v1[3]);
                    *(u32x4*)(rowp + bj * HALF) = w; } }
    }
};
struct EpiResRms {
    static constexpr bool PERM = false, AFTER_DRAIN = true;
    const bf16_t* R; float* Hout; float* Nf; bf16_t* Nb; const float* gain; float* xbuf; unsigned* cnt;
    __device__ __forceinline__ void fused(f32x4 (&acc)[2][2][4][2], const Unit& u, int wr, int wc, int fr, int fq, PG8_LAS unsigned char* lds, int wid, int lane) const {
        PG8_LAS float* Pp = (PG8_LAS float*)lds; PG8_LAS float* S = (PG8_LAS float*)(lds + 4096);
        const int col0 = u.pn * BM + wc * 32 + 4 * fq;
#pragma unroll
        for (int ai = 0; ai < 2; ++ai) { u32x2 pre[4][2][2];
#pragma unroll
            for (int m = 0; m < 4; ++m) { const size_t off = (size_t)u.pm * HB_PANEL + (size_t)(ai * HALF + wr * 64 + m * 16 + fr) * 1024 + col0;
#pragma unroll
                for (int bj = 0; bj < 2; ++bj)
#pragma unroll
                    for (int n = 0; n < 2; ++n) pre[m][bj][n] = *(const u32x2*)(R + off + bj * HALF + n * 16); }
#pragma unroll
            for (int m = 0; m < 4; ++m) { float sq = 0.f;
#pragma unroll
                for (int bj = 0; bj < 2; ++bj)
#pragma unroll
                    for (int n = 0; n < 2; ++n) { const u32x2 pw = pre[m][bj][n]; const f32x4 v = acc[ai][bj][m][n] + (f32x4){bflo(pw.x), bfhi(pw.x), bflo(pw.y), bfhi(pw.y)}; acc[ai][bj][m][n] = v; sq += (v[0] * v[0] + v[1] * v[1]) + (v[2] * v[2] + v[3] * v[3]); }
                sq = xrow_sum(sq);
                if (fq == 0) Pp[(ai * HALF + wr * 64 + m * 16 + fr) * 4 + wc] = sq; } }
        asm volatile("s_waitcnt lgkmcnt(0)" ::: "memory"); __builtin_amdgcn_s_barrier(); asm volatile("" ::: "memory");
        const int row = wid * 32 + (lane & 31);
        if (lane < 32) { const float tot = (Pp[row * 4 + 0] + Pp[row * 4 + 1]) + (Pp[row * 4 + 2] + Pp[row * 4 + 3]);
            __hip_atomic_store(xbuf + ((size_t)(u.pm * BM + row) * 4 + u.pn), tot, __ATOMIC_RELAXED, __HIP_MEMORY_SCOPE_AGENT); }
        asm volatile("s_waitcnt vmcnt(0)" ::: "memory");
        if (lane == 0) __hip_atomic_fetch_add(cnt + 64 * u.pm, 1u, __ATOMIC_RELAXED, __HIP_MEMORY_SCOPE_AGENT);
        if (wid == 0) { unsigned sp = 0;
            while ((unsigned)__builtin_amdgcn_readfirstlane(__hip_atomic_load(cnt + 64 * u.pm, __ATOMIC_RELAXED, __HIP_MEMORY_SCOPE_AGENT)) < 32u) { __builtin_amdgcn_s_sleep(2); if (++sp > (1u << 22)) break; }
            __builtin_amdgcn_fence(__ATOMIC_ACQUIRE, "agent"); }
        asm volatile("s_waitcnt vmcnt(0) lgkmcnt(0)" ::: "memory"); __builtin_amdgcn_s_barrier(); asm volatile("" ::: "memory");
        if (lane < 32) { const float* slot = xbuf + (size_t)(u.pm * BM + row) * 4; float t = 0.f;
#pragma unroll
            for (int q = 0; q < 4; ++q) t += __hip_atomic_load(slot + q, __ATOMIC_RELAXED, __HIP_MEMORY_SCOPE_AGENT);
            S[row] = rsqrtf(t * (1.0f / 1024.0f) + 1e-6f); }
        asm volatile("s_waitcnt lgkmcnt(0)" ::: "memory"); __builtin_amdgcn_s_barrier(); asm volatile("" ::: "memory");
        f32x4 gv[2][2];
#pragma unroll
        for (int bj = 0; bj < 2; ++bj)
#pragma unroll
            for (int n = 0; n < 2; ++n) gv[bj][n] = *(const f32x4*)(gain + col0 + bj * HALF + n * 16);
#pragma unroll
        for (int ai = 0; ai < 2; ++ai)
#pragma unroll
            for (int m = 0; m < 4; ++m) { const int r = ai * HALF + wr * 64 + m * 16 + fr; const float rs = S[r]; const size_t off = (size_t)(u.pm * BM + r) * 1024 + col0;
#pragma unroll
                for (int bj = 0; bj < 2; ++bj)
#pragma unroll
                    for (int n = 0; n < 2; ++n) { const f32x4 v = acc[ai][bj][m][n]; const f32x4 o = v * rs * gv[bj][n];
                        if (Hout) *(f32x4*)(Hout + off + bj * HALF + n * 16) = v;
                        if (Nf) *(f32x4*)(Nf + off + bj * HALF + n * 16) = o;
                        if (Nb) { u32x2 w; w.x = cvt_pk_bf16(o[0], o[1]); w.y = cvt_pk_bf16(o[2], o[3]); *(u32x2*)(Nb + off + bj * HALF + n * 16) = w; } } }
    }
};

template <class Epi, class Sched, bool ALIGN_EPI = false, bool SP2 = false, bool CARRY = false>
__device__ __forceinline__ void gemm_phase(PG8_LAS unsigned char* lds, const Gemm g, const Sched& S, const Epi& E) {
    const int tid = threadIdx.x, wid = __builtin_amdgcn_readfirstlane(tid >> 6), lane = tid & 63, wr = wid >> 2, wc = wid & 3, fr = lane & 15, fq = lane >> 4;
    const int K = g.K, nt = K / BK;
    unsigned voffA[2], voffB[2];
#pragma unroll
    for (int i = 0; i < 2; ++i) { int R, C; stage_rc(tid * 16 + i * 8192, R, C); const int Rb = Epi::PERM ? ((R & ~31) + perm32(R & 31)) : R;
        voffA[i] = (unsigned)(R * K + C) * 2u; voffB[i] = (unsigned)(Rb * K + C) * 2u; }
    const size_t kstep = (size_t)(BK * 2);
    const size_t hstep = (size_t)HALF * K * 2;
    const size_t tstep = 2 * hstep;
    const unsigned ldsw = (unsigned)wid * 1024u;
    const int aoff = lds_byte(wr * 64 + fr, fq * 8), boff = lds_byte(wc * 32 + fr, fq * 8);
#define PG8_SA(b, h) (((b) * 2 + (h)) * HTB)
#define PG8_SB(b, h) ((4 + (b) * 2 + (h)) * HTB)
#define PG8_STAGE(bufoff, gbase, voff) do { _Pragma("unroll") for (int _i = 0; _i < 2; ++_i) \
        __builtin_amdgcn_global_load_lds((const unsigned*)((const char*)(gbase) + (voff)[_i]), (PG8_LAS unsigned*)(lds + (bufoff) + ldsw + _i * 8192), 16, 0, 0); } while (0)
#define PG8_LDA(dst, b, h) do { _Pragma("unroll") for (int m = 0; m < 4; ++m) _Pragma("unroll") for (int k = 0; k < 2; ++k) dst[m][k] = *(const PG8_LAS bf16x8*)(lds + PG8_SA(b, h) + aoff + m * 2048 + k * 1024); } while (0)
#define PG8_LDB(dst, b, h) do { _Pragma("unroll") for (int n = 0; n < 2; ++n) _Pragma("unroll") for (int k = 0; k < 2; ++k) dst[n][k] = *(const PG8_LAS bf16x8*)(lds + PG8_SB(b, h) + boff + n * 2048 + k * 1024); } while (0)
#define PG8_MMA(ai, bj, At, Bt) do { __builtin_amdgcn_s_setprio(1); _Pragma("unroll") for (int m = 0; m < 4; ++m) _Pragma("unroll") for (int n = 0; n < 2; ++n) _Pragma("unroll") for (int k = 0; k < 2; ++k) \
        acc[ai][bj][m][n] = __builtin_amdgcn_mfma_f32_16x16x32_bf16(Bt[n][k], At[m][k], acc[ai][bj][m][n], 0, 0, 0); __builtin_amdgcn_s_setprio(0); } while (0)
#define PG8_WAIT_V(n) asm volatile("s_waitcnt vmcnt(" #n ")" ::: "memory")
#define PG8_WAIT_L(n) asm volatile("s_waitcnt lgkmcnt(" #n ")" ::: "memory")
#define PG8_BAR __builtin_amdgcn_s_barrier()
#define PG8_SCHED __builtin_amdgcn_sched_barrier(0)
    Unit cur, nxt; int ui = 0;
    if (!S.next(0, cur)) return;
    f32x4 acc[2][2][4][2];
#pragma unroll
    for (int a = 0; a < 2; ++a)
#pragma unroll
        for (int b = 0; b < 2; ++b)
#pragma unroll
            for (int m = 0; m < 4; ++m)
#pragma unroll
                for (int n = 0; n < 2; ++n) acc[a][b][m][n] = (f32x4){0.f, 0.f, 0.f, 0.f};
    bf16x8 At[4][2], B0[2][2], B1[2][2];
    const char* cA = S.pa(g, cur, tstep); const char* cB = S.pb(g, cur, tstep);
    S.a_ready(cur);
    if constexpr (SP2) {
        PG8_STAGE(PG8_SB(0, 0), cB, voffB); PG8_STAGE(PG8_SB(0, 1), cB + hstep, voffB); PG8_STAGE(PG8_SA(0, 0), cA, voffA); PG8_STAGE(PG8_SA(0, 1), cA + hstep, voffA);
        if (wr == 1) PG8_BAR;
        PG8_WAIT_V(2); PG8_BAR;
        PG8_STAGE(PG8_SB(1, 0), cB + kstep, voffB); PG8_STAGE(PG8_SA(1, 0), cA + kstep, voffA); PG8_STAGE(PG8_SB(1, 1), cB + hstep + kstep, voffB);
        PG8_WAIT_V(6); PG8_BAR;
    } else {
        PG8_STAGE(PG8_SB(0, 0), cB, voffB); PG8_STAGE(PG8_SA(0, 0), cA, voffA); PG8_STAGE(PG8_SB(0, 1), cB + hstep, voffB); PG8_STAGE(PG8_SA(0, 1), cA + hstep, voffA);
        if (wr == 1) PG8_BAR;
        PG8_WAIT_V(4); PG8_BAR;
        PG8_STAGE(PG8_SB(1, 0), cB + kstep, voffB); PG8_STAGE(PG8_SA(1, 0), cA + kstep, voffA); PG8_STAGE(PG8_SB(1, 1), cB + hstep + kstep, voffB);
        PG8_WAIT_V(6); PG8_BAR;
    }
    for (;;) {
        const bool has_next = S.next(ui + 1, nxt);
        const char* nA = has_next ? S.pa(g, nxt, tstep) : cA; const char* nB = has_next ? S.pb(g, nxt, tstep) : cB;
        for (int t = 0; t < nt; t += 2) {
            const bool last = (t == nt - 2);
            const char* a1 = cA + (size_t)(t + 1) * kstep;
            const char* a2 = last ? nA : cA + (size_t)(t + 2) * kstep; const char* b2 = last ? nB : cB + (size_t)(t + 2) * kstep;
            const char* a3 = a2 + kstep; const char* b3 = b2 + kstep;
            if (last && has_next) S.a_ready(nxt);
            if constexpr (SP2) {
            PG8_LDB(B0, 0, 0); PG8_LDB(B1, 0, 1); PG8_SCHED; PG8_LDA(At, 0, 0); PG8_STAGE(PG8_SA(1, 1), a1 + hstep, voffA);
            PG8_WAIT_V(8); PG8_WAIT_L(0); PG8_BAR; PG8_MMA(0, 0, At, B0); PG8_MMA(0, 1, At, B1); PG8_BAR; PG8_SCHED;
            PG8_LDA(At, 0, 1); PG8_STAGE(PG8_SB(0, 0), b2, voffB); PG8_STAGE(PG8_SB(0, 1), b2 + hstep, voffB); PG8_STAGE(PG8_SA(0, 0), a2, voffA);
            PG8_WAIT_V(8); PG8_WAIT_L(0); PG8_BAR; PG8_MMA(1, 0, At, B0); PG8_MMA(1, 1, At, B1); PG8_BAR; PG8_SCHED;
            PG8_LDB(B0, 1, 0); PG8_LDB(B1, 1, 1); PG8_SCHED; PG8_LDA(At, 1, 0); PG8_STAGE(PG8_SA(0, 1), a2 + hstep, voffA);
            PG8_WAIT_V(8); PG8_WAIT_L(0); PG8_BAR; PG8_MMA(0, 0, At, B0); PG8_MMA(0, 1, At, B1); PG8_BAR; PG8_SCHED;
            PG8_LDA(At, 1, 1); PG8_STAGE(PG8_SB(1, 0), b3, voffB); PG8_STAGE(PG8_SB(1, 1), b3 + hstep, voffB); PG8_STAGE(PG8_SA(1, 0), a3, voffA);
            PG8_WAIT_V(8); PG8_WAIT_L(0); PG8_BAR; PG8_MMA(1, 0, At, B0); PG8_MMA(1, 1, At, B1); PG8_BAR; PG8_SCHED;
            } else {
            PG8_LDB(B0, 0, 0); PG8_SCHED; PG8_LDA(At, 0, 0); PG8_STAGE(PG8_SA(1, 1), a1 + hstep, voffA);
            PG8_WAIT_L(8); PG8_BAR; PG8_WAIT_L(0); PG8_MMA(0, 0, At, B0); PG8_BAR; PG8_SCHED;
            PG8_LDB(B1, 0, 1); PG8_STAGE(PG8_SB(0, 0), b2, voffB);
            PG8_BAR; PG8_WAIT_L(0); PG8_MMA(0, 1, At, B1); PG8_BAR;
            PG8_LDA(At, 0, 1); PG8_STAGE(PG8_SA(0, 0), a2, voffA);
            PG8_BAR; PG8_WAIT_L(0); PG8_MMA(1, 0, At, B0); PG8_BAR; PG8_SCHED;
            PG8_STAGE(PG8_SB(0, 1), b2 + hstep, voffB);
            PG8_WAIT_V(6); PG8_BAR; PG8_MMA(1, 1, At, B1); PG8_BAR;
            PG8_LDB(B0, 1, 0); PG8_SCHED; PG8_LDA(At, 1, 0); PG8_STAGE(PG8_SA(0, 1), a2 + hstep, voffA);
            PG8_WAIT_L(8); PG8_BAR; PG8_WAIT_L(0); PG8_MMA(0, 0, At, B0); PG8_BAR; PG8_SCHED;
            PG8_LDB(B1, 1, 1); PG8_STAGE(PG8_SB(1, 0), b3, voffB);
            PG8_BAR; PG8_WAIT_L(0); PG8_MMA(0, 1, At, B1); PG8_BAR;
            PG8_LDA(At, 1, 1); PG8_STAGE(PG8_SA(1, 0), a3, voffA);
            PG8_BAR; PG8_WAIT_L(0); PG8_MMA(1, 0, At, B0); PG8_BAR; PG8_SCHED;
            PG8_STAGE(PG8_SB(1, 1), b3 + hstep, voffB);
            PG8_WAIT_V(6); PG8_BAR; PG8_MMA(1, 1, At, B1); PG8_BAR;
            }
        }
        if constexpr (ALIGN_EPI) { if (wr == 0) PG8_BAR; }
        if constexpr (!Epi::AFTER_DRAIN) { E(acc, cur, wr, wc, fr, fq); S.done(cur); }
        if (!has_next) break;
        if constexpr (!CARRY) {
#pragma unroll
        for (int a = 0; a < 2; ++a)
#pragma unroll
            for (int b = 0; b < 2; ++b)
#pragma unroll
                for (int m = 0; m < 4; ++m)
#pragma unroll
                    for (int n = 0; n < 2; ++n) acc[a][b][m][n] = (f32x4){0.f, 0.f, 0.f, 0.f};
        }
        cur = nxt; cA = nA; cB = nB; ++ui;
        if constexpr (ALIGN_EPI) { if (wr == 1) PG8_BAR; }
    }
    PG8_WAIT_V(0);
    if constexpr (!ALIGN_EPI) { if (wr == 0) PG8_BAR; }
    PG8_BAR;
    if constexpr (Epi::AFTER_DRAIN) { E.fused(acc, cur, wr, wc, fr, fq, lds, wid, lane); S.done(cur); }
#undef PG8_SA
#undef PG8_SB
#undef PG8_STAGE
#undef PG8_LDA
#undef PG8_LDB
#undef PG8_MMA
#undef PG8_WAIT_V
#undef PG8_WAIT_L
#undef PG8_BAR
#undef PG8_SCHED
}
}

namespace nsa {
#define NLAS __attribute__((address_space(3)))
typedef short bf16x8 __attribute__((ext_vector_type(8)));
typedef short s16x4 __attribute__((ext_vector_type(4)));
typedef short v4i16_t __attribute__((ext_vector_type(4)));
typedef float f32x4 __attribute__((ext_vector_type(4)));
typedef unsigned u32x4 __attribute__((ext_vector_type(4)));
typedef unsigned u32x2 __attribute__((ext_vector_type(2)));
typedef unsigned long long u64;
constexpr int RS = 144, TILE_B = 64 * RS;
constexpr float LOG2E = 1.4426950408889634f;
constexpr int L_KB0 = 0, L_VB0 = TILE_B, L_KB1 = 2 * TILE_B, L_VB1 = 3 * TILE_B, L_CK = 4 * TILE_B, L_CV = 8 * TILE_B, L_IMP = 12 * TILE_B, L_WU = L_IMP + 16384, L_GT = L_WU + 64, L_END = L_GT + 2048;
static_assert(L_END <= 131072, "nsa LDS map");
__device__ __forceinline__ s16x4 vtr(const NLAS char* p) { return __builtin_bit_cast(s16x4, __builtin_amdgcn_ds_read_tr16_b64_v4i16((NLAS v4i16_t*)p)); }
__device__ __forceinline__ f32x4 mfma16(bf16x8 a, bf16x8 b, f32x4 c) { return __builtin_amdgcn_mfma_f32_16x16x32_bf16(a, b, c, 0, 0, 0); }
__device__ __forceinline__ unsigned pkbf(float lo, float hi) { return pg8::cvt_pk_bf16(lo, hi); }
__device__ __forceinline__ float qx1(float v) { return __builtin_bit_cast(float, __builtin_amdgcn_update_dpp(0, __builtin_bit_cast(int, v), 0xB1, 0xF, 0xF, true)); }
__device__ __forceinline__ float qx2(float v) { return __builtin_bit_cast(float, __builtin_amdgcn_update_dpp(0, __builtin_bit_cast(int, v), 0x4E, 0xF, 0xF, true)); }
template <int N> __device__ __forceinline__ float rror(float v) { return __builtin_bit_cast(float, __builtin_amdgcn_update_dpp(0, __builtin_bit_cast(int, v), 0x120 + N, 0xF, 0xF, true)); }
__device__ __forceinline__ void qk_tile(f32x4 (&s)[4], const NLAS char* Kb, const bf16x8 (&qf)[2], int i, int g, float kslope, float bt) {
    bf16x8 a[4][2]; const NLAS char* kp = Kb + i * RS + 16 * g;
#pragma unroll
    for (int kb = 0; kb < 4; ++kb) { a[kb][0] = *(const NLAS bf16x8*)(kp + kb * 16 * RS); a[kb][1] = *(const NLAS bf16x8*)(kp + kb * 16 * RS + 64); }
    __builtin_amdgcn_sched_barrier(0);
#pragma unroll
    for (int kb = 0; kb < 4; ++kb) { f32x4 ci; ci[0] = fmaf(kslope, (float)(kb * 16 + 0), bt); ci[1] = fmaf(kslope, (float)(kb * 16 + 1), bt); ci[2] = fmaf(kslope, (float)(kb * 16 + 2), bt); ci[3] = fmaf(kslope, (float)(kb * 16 + 3), bt);
        s[kb] = mfma16(a[kb][0], qf[0], ci); }
#pragma unroll
    for (int kb = 0; kb < 4; ++kb) s[kb] = mfma16(a[kb][1], qf[1], s[kb]);
}
__device__ __forceinline__ void pv_tile(f32x4 (&o)[4], f32x4& ol, const NLAS char* Vb, const f32x4 (&p)[4], int i, int g) {
    const NLAS char* vb = Vb + (4 * g + (i >> 2)) * RS + (i & 3) * 8;
    s16x4 lo[2][4], hi[2][4];
#pragma unroll
    for (int kk = 0; kk < 2; ++kk)
#pragma unroll
        for (int db = 0; db < 4; ++db) { const NLAS char* vp = vb + (2 * kk) * 16 * RS + db * 32; lo[kk][db] = vtr(vp); hi[kk][db] = vtr(vp + 16 * RS); }
    bf16x8 pf[2];
#pragma unroll
    for (int kk = 0; kk < 2; ++kk) { u32x4 pw; pw.x = pkbf(p[2 * kk][0], p[2 * kk][1]); pw.y = pkbf(p[2 * kk][2], p[2 * kk][3]); pw.z = pkbf(p[2 * kk + 1][0], p[2 * kk + 1][1]); pw.w = pkbf(p[2 * kk + 1][2], p[2 * kk + 1][3]);
        pf[kk] = __builtin_bit_cast(bf16x8, pw); }
#pragma unroll
    for (int kk = 0; kk < 2; ++kk)
#pragma unroll
        for (int db = 0; db < 4; ++db) o[db] = mfma16((bf16x8){lo[kk][db][0], lo[kk][db][1], lo[kk][db][2], lo[kk][db][3], hi[kk][db][0], hi[kk][db][1], hi[kk][db][2], hi[kk][db][3]}, pf[kk], o[db]);
    const bf16x8 ones = (bf16x8){0x3F80, 0x3F80, 0x3F80, 0x3F80, 0x3F80, 0x3F80, 0x3F80, 0x3F80};
    ol = mfma16(ones, pf[0], ol); ol = mfma16(ones, pf[1], ol);
}
constexpr float THR = 6.0f;
template <bool FIRST>
__device__ __forceinline__ float online_tile(f32x4 (&s)[4], float& m, f32x4& l, f32x4 (&o)[4], bool needmask, int base, int lo, int hi) {
    float fret = 1.f;
    if (needmask) {
#pragma unroll
        for (int kb = 0; kb < 4; ++kb)
#pragma unroll
            for (int r = 0; r < 4; ++r) { const int pos = base + kb * 16 + r; s[kb][r] = (pos >= lo && pos <= hi) ? s[kb][r] : -INFINITY; } }
    float mt;
    if (FIRST) {
        mt = fmaxf(fmaxf(fmaxf(s[0][0], s[0][1]), fmaxf(s[0][2], s[0][3])), fmaxf(fmaxf(s[1][0], s[1][1]), fmaxf(s[1][2], s[1][3])));
        mt = fmaxf(mt, fmaxf(fmaxf(fmaxf(s[2][0], s[2][1]), fmaxf(s[2][2], s[2][3])), fmaxf(fmaxf(s[3][0], s[3][1]), fmaxf(s[3][2], s[3][3]))));
    } else {
#define NSA_B(kb, r) __float_as_int(s[kb][r])
#define NSA_MX3(a, b, c) max(max(a, b), c)
        const int m0 = NSA_MX3(NSA_B(0, 0), NSA_B(0, 1), NSA_B(0, 2)), m1 = NSA_MX3(NSA_B(0, 3), NSA_B(1, 0), NSA_B(1, 1)), m2 = NSA_MX3(NSA_B(1, 2), NSA_B(1, 3), NSA_B(2, 0));
        const int m3 = NSA_MX3(NSA_B(2, 1), NSA_B(2, 2), NSA_B(2, 3)), m4 = NSA_MX3(NSA_B(3, 0), NSA_B(3, 1), NSA_B(3, 2));
        const int mi = max(NSA_MX3(m0, m1, m2), NSA_MX3(m3, m4, NSA_B(3, 3)));
#undef NSA_B
#undef NSA_MX3
        mt = __int_as_float(mi > 0 ? mi : 0);
    }
    if (FIRST || __any(mt > THR)) {
        mt = xrow_max(mt);
        const float d = FIRST ? ((mt == -INFINITY) ? 0.f : mt) : fmaxf(mt, 0.f), f = __builtin_amdgcn_exp2f(-d); m += d; l = l * f; fret = f;
#pragma unroll
        for (int db = 0; db < 4; ++db) o[db] = o[db] * f;
#pragma unroll
        for (int kb = 0; kb < 4; ++kb) s[kb] = s[kb] - d; }
#pragma unroll
    for (int kb = 0; kb < 4; ++kb)
#pragma unroll
        for (int r = 0; r < 4; ++r) s[kb][r] = __builtin_amdgcn_exp2f(s[kb][r]);
    return fret;
}
struct Stg { u32x4 k, v; };
__device__ __forceinline__ void stg_load(Stg& r, const bf16_t* kb, const bf16_t* vb, size_t pitch, int tid) { const size_t off = (size_t)(tid >> 3) * pitch + (tid & 7) * 8; r.k = *(const u32x4*)(kb + off); r.v = *(const u32x4*)(vb + off); }
__device__ __forceinline__ void stg_store(NLAS char* lds, int ko, int vo, const Stg& r, int tid) { const int off = (tid >> 3) * RS + (tid & 7) * 16; *(NLAS u32x4*)(lds + ko + off) = r.k; *(NLAS u32x4*)(lds + vo + off) = r.v; }
template <bool FIRST>
__device__ __forceinline__ void pair_tiles(const NLAS char* lds, int koA, int voA, int koB, int voB, bool na, bool nb, const bf16x8 (&qf)[2], int i, int g, float slope2,
                                           float btA, float btB, bool maskA, bool maskB, int baseA, int baseB, int lo, int hi, float& m, f32x4& l, f32x4 (&o)[4]) {
    f32x4 sa[4], sb[4];
    if (na) qk_tile(sa, lds + koA, qf, i, g, slope2, btA - m);
    if (nb) qk_tile(sb, lds + koB, qf, i, g, slope2, btB - m);
    float da = 0.f;
    if (na) { const float m0 = m; online_tile<FIRST>(sa, m, l, o, FIRST || maskA, baseA, lo, hi); da = m - m0; pv_tile(o, l, lds + voA, sa, i, g); }
    if (nb) { if (__any(da != 0.f)) {
#pragma unroll
            for (int kb = 0; kb < 4; ++kb) sb[kb] = sb[kb] - da; }
        online_tile<false>(sb, m, l, o, maskB, baseB, lo, hi); pv_tile(o, l, lds + voB, sb, i, g); }
}
__device__ __forceinline__ float sigm(float v) { return __builtin_amdgcn_rcpf(1.f + __expf(-v)); }

struct KFrag { bf16x8 a[4][2]; };
struct VFrag { s16x4 lo[2][4], hi[2][4]; };
__device__ __forceinline__ void k_load(KFrag& k, const NLAS char* Kb, int i, int g) { const NLAS char* kp = Kb + i * RS + 16 * g;
#pragma unroll
    for (int kb = 0; kb < 4; ++kb) { k.a[kb][0] = *(const NLAS bf16x8*)(kp + kb * 16 * RS); k.a[kb][1] = *(const NLAS bf16x8*)(kp + kb * 16 * RS + 64); } }
__device__ __forceinline__ void qk_mma(f32x4 (&s)[4], const KFrag& k, const bf16x8 (&qf)[2], float kslope, float bt) {
#pragma unroll
    for (int kb = 0; kb < 4; ++kb) { f32x4 ci; ci[0] = fmaf(kslope, (float)(kb * 16 + 0), bt); ci[1] = fmaf(kslope, (float)(kb * 16 + 1), bt); ci[2] = fmaf(kslope, (float)(kb * 16 + 2), bt); ci[3] = fmaf(kslope, (float)(kb * 16 + 3), bt);
        s[kb] = mfma16(k.a[kb][0], qf[0], ci); }
#pragma unroll
    for (int kb = 0; kb < 4; ++kb) s[kb] = mfma16(k.a[kb][1], qf[1], s[kb]);
}
__device__ __forceinline__ void v_load(VFrag& v, const NLAS char* Vb, int i, int g) { const NLAS char* vb = Vb + (4 * g + (i >> 2)) * RS + (i & 3) * 8;
#pragma unroll
    for (int kk = 0; kk < 2; ++kk)
#pragma unroll
        for (int db = 0; db < 4; ++db) { const NLAS char* vp = vb + (2 * kk) * 16 * RS + db * 32; v.lo[kk][db] = vtr(vp); v.hi[kk][db] = vtr(vp + 16 * RS); } }
__device__ __forceinline__ void pv_mma(f32x4 (&o)[4], f32x4& ol, const VFrag& v, const f32x4 (&p)[4]) {
    bf16x8 pf[2];
#pragma unroll
    for (int kk = 0; kk < 2; ++kk) { u32x4 pw; pw.x = pkbf(p[2 * kk][0], p[2 * kk][1]); pw.y = pkbf(p[2 * kk][2], p[2 * kk][3]); pw.z = pkbf(p[2 * kk + 1][0], p[2 * kk + 1][1]); pw.w = pkbf(p[2 * kk + 1][2], p[2 * kk + 1][3]);
        pf[kk] = __builtin_bit_cast(bf16x8, pw); }
#pragma unroll
    for (int kk = 0; kk < 2; ++kk)
#pragma unroll
        for (int db = 0; db < 4; ++db) o[db] = mfma16((bf16x8){v.lo[kk][db][0], v.lo[kk][db][1], v.lo[kk][db][2], v.lo[kk][db][3], v.hi[kk][db][0], v.hi[kk][db][1], v.hi[kk][db][2], v.hi[kk][db][3]}, pf[kk], o[db]);
    const bf16x8 ones = (bf16x8){0x3F80, 0x3F80, 0x3F80, 0x3F80, 0x3F80, 0x3F80, 0x3F80, 0x3F80};
    ol = mfma16(ones, pf[0], ol); ol = mfma16(ones, pf[1], ol);
}
struct Blk { float m; f32x4 l; f32x4 o[4]; };
__device__ __forceinline__ void pack_p(bf16x8 (&pf)[2], const f32x4 (&p)[4]) {
#pragma unroll
    for (int kk = 0; kk < 2; ++kk) { u32x4 pw; pw.x = pkbf(p[2 * kk][0], p[2 * kk][1]); pw.y = pkbf(p[2 * kk][2], p[2 * kk][3]); pw.z = pkbf(p[2 * kk + 1][0], p[2 * kk + 1][1]); pw.w = pkbf(p[2 * kk + 1][2], p[2 * kk + 1][3]);
        pf[kk] = __builtin_bit_cast(bf16x8, pw); } }
template <bool FIRST>
__device__ __forceinline__ void tile2(const NLAS char* Kb, const NLAS char* Vb, const bf16x8 (&qf0)[2], const bf16x8 (&qf1)[2], int i, int g, float kslope, float bt0, float bt1, bool needmask, int base, int lo0, int lo1, int hi0, int hi1, Blk& b0, Blk& b1) {
    const NLAS char* kp = Kb + i * RS + 16 * g; const float ba = bt0 - b0.m, bb = bt1 - b1.m;
    f32x4 s0[4], s1[4];
#pragma unroll
    for (int hf = 0; hf < 2; ++hf) { bf16x8 a[2][2];
#pragma unroll
        for (int q = 0; q < 2; ++q) { const int kb = 2 * hf + q; a[q][0] = *(const NLAS bf16x8*)(kp + kb * 16 * RS); a[q][1] = *(const NLAS bf16x8*)(kp + kb * 16 * RS + 64); }
        __builtin_amdgcn_sched_barrier(0);
        __builtin_amdgcn_s_setprio(1);
#pragma unroll
        for (int q = 0; q < 2; ++q) { const int kb = 2 * hf + q; f32x4 ca, cb;
            ca[0] = fmaf(kslope, (float)(kb * 16 + 0), ba); ca[1] = fmaf(kslope, (float)(kb * 16 + 1), ba); ca[2] = fmaf(kslope, (float)(kb * 16 + 2), ba); ca[3] = fmaf(kslope, (float)(kb * 16 + 3), ba);
            cb[0] = fmaf(kslope, (float)(kb * 16 + 0), bb); cb[1] = fmaf(kslope, (float)(kb * 16 + 1), bb); cb[2] = fmaf(kslope, (float)(kb * 16 + 2), bb); cb[3] = fmaf(kslope, (float)(kb * 16 + 3), bb);
            s0[kb] = mfma16(a[q][0], qf0[0], ca); s1[kb] = mfma16(a[q][0], qf1[0], cb); }
#pragma unroll
        for (int q = 0; q < 2; ++q) { const int kb = 2 * hf + q; s0[kb] = mfma16(a[q][1], qf0[1], s0[kb]); s1[kb] = mfma16(a[q][1], qf1[1], s1[kb]); }
        __builtin_amdgcn_s_setprio(0);
        __builtin_amdgcn_sched_barrier(0); }
    const NLAS char* vb = Vb + (4 * g + (i >> 2)) * RS + (i & 3) * 8;
    s16x4 vlo[4], vhi[4];
#pragma unroll
    for (int db = 0; db < 4; ++db) { vlo[db] = vtr(vb + db * 32); vhi[db] = vtr(vb + db * 32 + 16 * RS); }
    __builtin_amdgcn_sched_barrier(0);
    bf16x8 pf0[2], pf1[2];
    online_tile<FIRST>(s0, b0.m, b0.l, b0.o, needmask, base, lo0, hi0); pack_p(pf0, s0);
    online_tile<FIRST>(s1, b1.m, b1.l, b1.o, needmask, base, lo1, hi1); pack_p(pf1, s1);
    const bf16x8 ones = (bf16x8){0x3F80, 0x3F80, 0x3F80, 0x3F80, 0x3F80, 0x3F80, 0x3F80, 0x3F80};
#pragma unroll
    for (int kk = 0; kk < 2; ++kk) {
        if (kk == 1) {
#pragma unroll
            for (int db = 0; db < 4; ++db) { vlo[db] = vtr(vb + 32 * RS + db * 32); vhi[db] = vtr(vb + 32 * RS + db * 32 + 16 * RS); } }
        __builtin_amdgcn_s_setprio(1);
#pragma unroll
        for (int db = 0; db < 4; ++db) { const bf16x8 vf = (bf16x8){vlo[db][0], vlo[db][1], vlo[db][2], vlo[db][3], vhi[db][0], vhi[db][1], vhi[db][2], vhi[db][3]};
            b0.o[db] = mfma16(vf, pf0[kk], b0.o[db]); b1.o[db] = mfma16(vf, pf1[kk], b1.o[db]); }
        b0.l = mfma16(ones, pf0[kk], b0.l); b1.l = mfma16(ones, pf1[kk], b1.l);
        __builtin_amdgcn_s_setprio(0);
        __builtin_amdgcn_sched_barrier(0); }
}
__device__ __forceinline__ int oscr_off(int w) { return w < 2 ? L_CK + 2 * TILE_B + w * 8192 : w < 4 ? L_CV + 2 * TILE_B + (w - 2) * 8192 : w < 6 ? L_IMP + (w - 4) * 8192 : L_END + (w - 6) * 8192; }
static_assert(L_END + 2 * 8192 <= 147392 - 64 && 2 * 8192 <= 2 * TILE_B && L_IMP + 2 * 8192 <= L_WU, "nsa output scratch");
__device__ __forceinline__ void cmp_block(const NLAS char* lds, const bf16x8 (&qf)[2], int i, int g, int lane, int t, int tw_min, int ntc, float slope2, float gate0, f32x4 (&res)[4], NLAS float* imp_s) {
    const int r = i & 3;
    const int nmax = (t - 31) >> 4, nmax_w = (tw_min - 31) >> 4; const float kslope = 16.f * slope2, c = -slope2 * (float)(t - 31);
    float mc = 0.f; f32x4 lcv = (f32x4){0.f, 0.f, 0.f, 0.f}; f32x4 oc[4]; float av[16], cv[16];
#pragma unroll
    for (int db = 0; db < 4; ++db) oc[db] = (f32x4){0.f, 0.f, 0.f, 0.f};
#pragma unroll
    for (int q = 0; q < 16; ++q) { av[q] = 0.f; cv[q] = 0.f; }
    bool firstc = true;
#pragma unroll
    for (int tile = 3; tile >= 0; --tile) {
        if (tile < ntc) { f32x4 s[4]; qk_tile(s, lds + L_CK + tile * TILE_B, qf, i, g, kslope, fmaf(kslope, (float)(tile * 64 + 4 * g), c) - mc);
            const bool needmask = (tile * 64 + 63 > nmax_w);
            const float f = firstc ? online_tile<true>(s, mc, lcv, oc, needmask, tile * 64 + 4 * g, -0x40000000, nmax) : online_tile<false>(s, mc, lcv, oc, needmask, tile * 64 + 4 * g, -0x40000000, nmax);
            if (!firstc && __any(f != 1.f)) {
#pragma unroll
                for (int q = 0; q < 16; ++q) { av[q] *= f; cv[q] *= f; } }
            firstc = false;
            pv_tile(oc, lcv, lds + L_CV + tile * TILE_B, s, i, g);
#pragma unroll
            for (int kb = 0; kb < 4; ++kb) { const f32x4 pv = s[kb];
                float a = (pv[0] + pv[1]) + (pv[2] + pv[3]), cc = pv[3];
                a += qx1(a); a += qx2(a); cc += qx1(cc); cc += qx2(cc);
                av[tile * 4 + kb] = a; cv[tile * 4 + kb] = cc; } }
    }
    const float lc = lcv[0];
    const float inv = lc > 0.f ? 1.f / lc : 0.f, g0i = gate0 * inv;
#pragma unroll
    for (int db = 0; db < 4; ++db) res[db] = oc[db] * g0i;
    float cprev = 0.f;
#pragma unroll
    for (int q = 0; q < 16; ++q) { const float up = __shfl(cv[q], (lane + 48) & 63); const float im = (av[q] + (g > 0 ? up : cprev)) * inv; cprev = up; if (r == 0) imp_s[4 * q + g] = im; }
}
__device__ __forceinline__ void unit64(NLAS char* lds, const bf16_t* P, const float* S32, const bf16_t* KC, const bf16_t* VC, bf16_t* Ynsa, int b, int gq, int tj) {
    int tid = threadIdx.x; asm volatile("" : "+v"(tid));
    const int lane = tid & 63, w = __builtin_amdgcn_readfirstlane(tid >> 6), i = lane & 15, g = lane >> 4;
    const int t0 = tj * 64, r = i & 3, h = gq * 4 + r, tw0 = t0 + 8 * w;
    const int tl0 = i >> 2, tl1 = 4 + (i >> 2), tk0 = tw0 + tl0, tk1 = tw0 + tl1; const size_t mr0 = (size_t)b * T + tk0, mr1 = (size_t)b * T + tk1;
    const float slope2 = __builtin_amdgcn_exp2f(-(float)(h + 1)) * LOG2E;
    bf16x8 qf0[2], qf1[2]; constexpr float QS = 0.125f * LOG2E;
#pragma unroll
    for (int ks = 0; ks < 2; ++ks) { const u32x4 ra = *(const u32x4*)(P + mr0 * PW + P_NSQ + h * 64 + 8 * g + 32 * ks), rb = *(const u32x4*)(P + mr1 * PW + P_NSQ + h * 64 + 8 * g + 32 * ks); u32x4 sa, sb;
        sa.x = pkbf(pg8::bflo(ra.x) * QS, pg8::bfhi(ra.x) * QS); sa.y = pkbf(pg8::bflo(ra.y) * QS, pg8::bfhi(ra.y) * QS); sa.z = pkbf(pg8::bflo(ra.z) * QS, pg8::bfhi(ra.z) * QS); sa.w = pkbf(pg8::bflo(ra.w) * QS, pg8::bfhi(ra.w) * QS);
        sb.x = pkbf(pg8::bflo(rb.x) * QS, pg8::bfhi(rb.x) * QS); sb.y = pkbf(pg8::bflo(rb.y) * QS, pg8::bfhi(rb.y) * QS); sb.z = pkbf(pg8::bflo(rb.z) * QS, pg8::bfhi(rb.z) * QS); sb.w = pkbf(pg8::bflo(rb.w) * QS, pg8::bfhi(rb.w) * QS);
        qf0[ks] = __builtin_bit_cast(bf16x8, sa); qf1[ks] = __builtin_bit_cast(bf16x8, sb); }
    const float* gp0 = S32 + mr0 * 32 + 8 + h * 3; const float* gp1 = S32 + mr1 * 32 + 8 + h * 3;
    const float ga0 = sigm(gp0[0]), gb0 = sigm(gp1[0]);
    NLAS f32x4* gtab = (NLAS f32x4*)(lds + L_GT) + w * 16 + i;
    if (g == 0) *gtab = (f32x4){sigm(gp0[1]), sigm(gp1[1]), sigm(gp0[2]), sigm(gp1[2])};
    const int ntc = (tj >> 4) + 1;
    const size_t rowb = (size_t)b * T; const int jcur = tj;
    { Stg sc_[4];
#pragma unroll
      for (int tile = 0; tile < 4; ++tile) if (tile < ntc) { const size_t row0 = ((size_t)(b * 256 + tile * 64) * 2 + gq) * 64; stg_load(sc_[tile], KC + row0, VC + row0, 128, tid); }
#pragma unroll
      for (int tile = 0; tile < 4; ++tile) if (tile < ntc) stg_store(lds, L_CK + tile * TILE_B, L_CV + tile * TILE_B, sc_[tile], tid); }
    { Stg sf0, sf1; const bf16_t* kcol = P + rowb * PW + P_KS + gq * 64; const bf16_t* vcol = P + rowb * PW + P_VS + gq * 64;
      stg_load(sf0, kcol + (size_t)jcur * 64 * PW, vcol + (size_t)jcur * 64 * PW, PW, tid);
      if (jcur >= 1) stg_load(sf1, kcol + (size_t)(jcur - 1) * 64 * PW, vcol + (size_t)(jcur - 1) * 64 * PW, PW, tid);
      stg_store(lds, L_KB0, L_VB0, sf0, tid); if (jcur >= 1) stg_store(lds, L_KB1, L_VB1, sf1, tid); }
    __syncthreads();
    f32x4 res0[4], res1[4];
    cmp_block(lds, qf0, i, g, lane, tk0, tw0, ntc, slope2, ga0, res0, (NLAS float*)(lds + L_IMP) + (w * 8 + tl0) * 64);
    cmp_block(lds, qf1, i, g, lane, tk1, tw0, ntc, slope2, gb0, res1, (NLAS float*)(lds + L_IMP) + (w * 8 + tl1) * 64);
    NLAS float* impw = (NLAS float*)(lds + L_IMP) + w * 512;
    asm volatile("s_waitcnt lgkmcnt(0)" ::: "memory");
    u64 wun = 0ull, mym0 = 0ull, mym1 = 0ull;
    { const bool valid = lane <= tj, forced = (lane == 0) || (lane == tj) || (lane == tj - 1);
#pragma unroll 1
      for (int tl = 0; tl < 8; ++tl) { const float sc = valid ? impw[tl * 64 + lane] + (forced ? 1000.f : 0.f) : -1e30f;
        const unsigned key = valid ? ((__float_as_uint(sc) & ~63u) | (unsigned)(63 - lane)) : 0u; unsigned rank = 0;
        NLAS unsigned* krow = (NLAS unsigned*)impw + tl * 64; krow[lane] = key;
#pragma unroll 1
        for (int j8 = 0; j8 <= tj; j8 += 8) {
            const u32x4 ka = *(const NLAS u32x4*)(krow + j8), kb = *(const NLAS u32x4*)(krow + j8 + 4);
            rank += (ka.x > key) ? 1u : 0u; rank += (ka.y > key) ? 1u : 0u; rank += (ka.z > key) ? 1u : 0u; rank += (ka.w > key) ? 1u : 0u;
            rank += (kb.x > key) ? 1u : 0u; rank += (kb.y > key) ? 1u : 0u; rank += (kb.z > key) ? 1u : 0u; rank += (kb.w > key) ? 1u : 0u; }
        const u64 wm = __ballot(rank < 16u && valid); wun |= wm; if (tl == tl0) mym0 = wm; if (tl == tl1) mym1 = wm; } }
    if (lane == 0) ((NLAS u64*)(lds + L_WU))[w] = wun;
    __syncthreads();
    u64 uall = 0ull;
#pragma unroll
    for (int ww = 0; ww < 8; ++ww) uall |= ((const NLAS u64*)(lds + L_WU))[ww];
    uall = ((u64)__builtin_amdgcn_readfirstlane((unsigned)(uall >> 32)) << 32) | (u64)__builtin_amdgcn_readfirstlane((unsigned)uall);
    NLAS f32x4* oscr = (NLAS f32x4*)(lds + oscr_off(w)) + lane;
#pragma unroll
    for (int db = 0; db < 4; ++db) { oscr[db * 64] = res0[db]; oscr[(4 + db) * 64] = res1[db]; }
#define NSA_NEXT(dst) { dst = rem ? 63 - __builtin_clzll(rem) : -1; if (dst >= 0) rem &= ~(1ull << dst); }
#define NSA_KO(p, h) ((p) ? L_CK + (h) * TILE_B : ((h) ? L_KB1 : L_KB0))
#define NSA_VO(p, h) ((p) ? L_CV + (h) * TILE_B : ((h) ? L_VB1 : L_VB0))
    Stg sr0, sr1;
    {
        Blk b0, b1; b0.m = 0.f; b1.m = 0.f; b0.l = (f32x4){0.f, 0.f, 0.f, 0.f}; b1.l = b0.l;
#pragma unroll
        for (int db = 0; db < 4; ++db) { b0.o[db] = (f32x4){0.f, 0.f, 0.f, 0.f}; b1.o[db] = b0.o[db]; }
        const bf16_t* kcol = P + rowb * PW + P_KS + gq * 64; const bf16_t* vcol = P + rowb * PW + P_VS + gq * 64;
        const float c0 = -slope2 * (float)tk0, c1 = -slope2 * (float)tk1;
        u64 rem = uall & ((1ull << jcur) - 1ull);
        int ja = jcur, jb, na_, nb_, cur = 0; bool first = true;
        NSA_NEXT(jb)
        NSA_NEXT(na_) NSA_NEXT(nb_)
        if (na_ >= 0) stg_load(sr0, kcol + (size_t)na_ * 64 * PW, vcol + (size_t)na_ * 64 * PW, PW, tid);
        if (nb_ >= 0) stg_load(sr1, kcol + (size_t)nb_ * 64 * PW, vcol + (size_t)nb_ * 64 * PW, PW, tid);
        unsigned pfw0, pfw1, pfw2;
        { const int wrow0 = t0 >= 512 ? t0 - 512 : 0, nrow = t0 + 64 - wrow0;
          const int x0 = tid, x1 = tid + 512, x2 = tid + 1024; const int r0_ = (x0 >> 1) < nrow ? (x0 >> 1) : nrow - 1, r1_ = (x1 >> 1) < nrow ? (x1 >> 1) : nrow - 1, r2_ = (x2 >> 1) < nrow ? (x2 >> 1) : nrow - 1;
          const bf16_t* wb = P + (rowb + wrow0) * PW + gq * 64;
          pfw0 = *(const unsigned*)(wb + (size_t)r0_ * PW + ((x0 & 1) ? P_VW : P_KW)); pfw1 = *(const unsigned*)(wb + (size_t)r1_ * PW + ((x1 & 1) ? P_VW : P_KW)); pfw2 = *(const unsigned*)(wb + (size_t)r2_ * PW + ((x2 & 1) ? P_VW : P_KW)); }
        __syncthreads();
        for (;;) {
            __builtin_amdgcn_s_waitcnt(0x0F70);
            asm volatile("" : "+v"(pfw0), "+v"(pfw1), "+v"(pfw2));
            if (na_ >= 0) stg_store(lds, NSA_KO(cur ^ 1, 0), NSA_VO(cur ^ 1, 0), sr0, tid);
            if (nb_ >= 0) stg_store(lds, NSA_KO(cur ^ 1, 1), NSA_VO(cur ^ 1, 1), sr1, tid);
            int nna, nnb; NSA_NEXT(nna) NSA_NEXT(nnb)
            if (nna >= 0) stg_load(sr0, kcol + (size_t)nna * 64 * PW, vcol + (size_t)nna * 64 * PW, PW, tid);
            if (nnb >= 0) stg_load(sr1, kcol + (size_t)nnb * 64 * PW, vcol + (size_t)nnb * 64 * PW, PW, tid);
            if (na_ < 0) { const bf16_t* kw = P + rowb * PW + P_KW + gq * 64; const bf16_t* vw = P + rowb * PW + P_VW + gq * 64;
                stg_load(sr0, kw + (size_t)jcur * 64 * PW, vw + (size_t)jcur * 64 * PW, PW, tid);
                if (jcur >= 1) stg_load(sr1, kw + (size_t)(jcur - 1) * 64 * PW, vw + (size_t)(jcur - 1) * 64 * PW, PW, tid); }
            const bool na = (wun >> ja) & 1ull, nb = (jb >= 0) && ((wun >> jb) & 1ull);
            if (na) { const float pb = slope2 * (float)(ja * 64 + 4 * g);
                const float bt0 = pb + c0 + (((mym0 >> ja) & 1ull) ? 0.f : -1e30f), bt1 = pb + c1 + (((mym1 >> ja) & 1ull) ? 0.f : -1e30f);
                if (first) tile2<true>(lds + NSA_KO(cur, 0), lds + NSA_VO(cur, 0), qf0, qf1, i, g, slope2, bt0, bt1, true, ja * 64 + 4 * g, 0, 0, tk0, tk1, b0, b1);
                else tile2<false>(lds + NSA_KO(cur, 0), lds + NSA_VO(cur, 0), qf0, qf1, i, g, slope2, bt0, bt1, false, 0, 0, 0, 0, 0, b0, b1); }
            if (nb) { const float pb = slope2 * (float)(jb * 64 + 4 * g);
                const float bt0 = pb + c0 + (((mym0 >> jb) & 1ull) ? 0.f : -1e30f), bt1 = pb + c1 + (((mym1 >> jb) & 1ull) ? 0.f : -1e30f);
                tile2<false>(lds + NSA_KO(cur, 1), lds + NSA_VO(cur, 1), qf0, qf1, i, g, slope2, bt0, bt1, false, 0, 0, 0, 0, 0, b0, b1); }
            first = false;
            __syncthreads();
            if (na_ < 0) break;
            ja = na_; jb = nb_; na_ = nna; nb_ = nnb; cur ^= 1;
        }
        if ((pfw0 ^ pfw1 ^ pfw2) == 0x9E3779B9u && tj > 4096) Ynsa[0] = 0;
        const f32x4 gt = *gtab; const float sa = gt[0] / b0.l[0], sb = gt[1] / b1.l[0];
#pragma unroll
        for (int db = 0; db < 4; ++db) { oscr[db * 64] = oscr[db * 64] + b0.o[db] * sa; oscr[(4 + db) * 64] = oscr[(4 + db) * 64] + b1.o[db] * sb; }
    }
    {
        Blk b0, b1; b0.m = 0.f; b1.m = 0.f; b0.l = (f32x4){0.f, 0.f, 0.f, 0.f}; b1.l = b0.l;
#pragma unroll
        for (int db = 0; db < 4; ++db) { b0.o[db] = (f32x4){0.f, 0.f, 0.f, 0.f}; b1.o[db] = b0.o[db]; }
        const bf16_t* kcol = P + rowb * PW + P_KW + gq * 64; const bf16_t* vcol = P + rowb * PW + P_VW + gq * 64;
        const float c0 = -slope2 * (float)tk0, c1 = -slope2 * (float)tk1;
        const int j0 = tj >= 8 ? tj - 8 : 0, j1 = tj;
        int ja = j1, cur = 0; bool first = true;
        stg_store(lds, L_KB0, L_VB0, sr0, tid);
        if (ja - 1 >= j0) stg_store(lds, L_KB1, L_VB1, sr1, tid);
        if (ja - 2 >= j0) stg_load(sr0, kcol + (size_t)(ja - 2) * 64 * PW, vcol + (size_t)(ja - 2) * 64 * PW, PW, tid);
        if (ja - 3 >= j0) stg_load(sr1, kcol + (size_t)(ja - 3) * 64 * PW, vcol + (size_t)(ja - 3) * 64 * PW, PW, tid);
        __syncthreads();
        for (;;) {
            __builtin_amdgcn_s_waitcnt(0x0F70);
            if (ja - 2 >= j0) stg_store(lds, NSA_KO(cur ^ 1, 0), NSA_VO(cur ^ 1, 0), sr0, tid);
            if (ja - 3 >= j0) stg_store(lds, NSA_KO(cur ^ 1, 1), NSA_VO(cur ^ 1, 1), sr1, tid);
            if (ja - 4 >= j0) stg_load(sr0, kcol + (size_t)(ja - 4) * 64 * PW, vcol + (size_t)(ja - 4) * 64 * PW, PW, tid);
            if (ja - 5 >= j0) stg_load(sr1, kcol + (size_t)(ja - 5) * 64 * PW, vcol + (size_t)(ja - 5) * 64 * PW, PW, tid);
            const int jb = ja - 1;
            { const float pb = slope2 * (float)(ja * 64 + 4 * g); const bool mask = (64 * ja < tw0 + 7 - 511);
              if (first) tile2<true>(lds + NSA_KO(cur, 0), lds + NSA_VO(cur, 0), qf0, qf1, i, g, slope2, pb + c0, pb + c1, true, ja * 64 + 4 * g, tk0 - 511, tk1 - 511, tk0, tk1, b0, b1);
              else tile2<false>(lds + NSA_KO(cur, 0), lds + NSA_VO(cur, 0), qf0, qf1, i, g, slope2, pb + c0, pb + c1, mask, ja * 64 + 4 * g, tk0 - 511, tk1 - 511, tk0, tk1, b0, b1); }
            if (jb >= j0) { const float pb = slope2 * (float)(jb * 64 + 4 * g); const bool mask = (64 * jb < tw0 + 7 - 511);
              tile2<false>(lds + NSA_KO(cur, 1), lds + NSA_VO(cur, 1), qf0, qf1, i, g, slope2, pb + c0, pb + c1, mask, jb * 64 + 4 * g, tk0 - 511, tk1 - 511, tk0, tk1, b0, b1); }
            first = false;
            __syncthreads();
            if (ja - 2 < j0) break;
            ja -= 2; cur ^= 1;
        }
        const f32x4 gt = *gtab; const float sa = gt[2] / b0.l[0], sb = gt[3] / b1.l[0];
        int tq = threadIdx.x; asm volatile("" : "+v"(tq));
        const int i2 = tq & 15, g2 = (tq >> 4) & 3, h2 = gq * 4 + (i2 & 3); const size_t mq0 = (size_t)b * T + t0 + 8 * w + (i2 >> 2);
        bf16_t* yo0 = Ynsa + mq0 * 512 + h2 * 64 + 4 * g2; bf16_t* yo1 = yo0 + 4 * 512;
#pragma unroll
        for (int db = 0; db < 4; ++db) { const f32x4 v0 = oscr[db * 64] + b0.o[db] * sa, v1 = oscr[(4 + db) * 64] + b1.o[db] * sb;
            u32x2 p0, p1; p0.x = pkbf(v0[0], v0[1]); p0.y = pkbf(v0[2], v0[3]); p1.x = pkbf(v1[0], v1[1]); p1.y = pkbf(v1[2], v1[3]); *(u32x2*)(yo0 + db * 16) = p0; *(u32x2*)(yo1 + db * 16) = p1; }
    }
#undef NSA_NEXT
#undef NSA_KO
#undef NSA_VO
    __syncthreads();
}
__device__ __forceinline__ void phase(NLAS char* lds, const bf16_t* P, const float* S32, const bf16_t* KC, const bf16_t* VC, bf16_t* Ynsa) {
    const int G = gridDim.x, bid = blockIdx.x;
    if (G == 256) { const int base = bid >> 3, bg = bid & 7;
#pragma unroll 1
        for (int k = 0; k < 2; ++k) unit64(lds, P, S32, KC, VC, Ynsa, bg >> 1, bg & 1, k ? base : 63 - base); }
    else {
#pragma unroll 1
        for (int u = bid; u < 512; u += G) unit64(lds, P, S32, KC, VC, Ynsa, (u & 7) >> 1, u & 1, 63 - (u >> 3)); }
}
}

namespace xa {
using nsa::bf16x8; using nsa::s16x4; using nsa::f32x4; using nsa::u32x4; using nsa::u32x2; using nsa::vtr; using nsa::mfma16; using nsa::pkbf;
constexpr int RS = 272, TILE_B = 64 * RS;
__device__ __forceinline__ int l_k(int tile) { return tile * 2 * TILE_B; }
__device__ __forceinline__ int l_v(int tile) { return tile * 2 * TILE_B + TILE_B; }
__device__ __forceinline__ void unit(NLAS char* lds, const bf16_t* P, const bf16_t* MEMKV, bf16_t* Yxa, int b, int h, int tt, bool load) {
    const int tid = threadIdx.x, lane = tid & 63, w = __builtin_amdgcn_readfirstlane(tid >> 6), i = lane & 15, g = lane >> 4;
    const size_t m = (size_t)b * T + tt * 128 + 16 * w + i;
    const bf16_t* kbase = MEMKV + (size_t)b * 256 * 1024 + h * 128;
    bf16x8 qf[4];
    { const bf16_t* qp = P + m * PW + P_XAQ + h * 128 + 8 * g;
#pragma unroll
      for (int ks = 0; ks < 4; ++ks) qf[ks] = *(const bf16x8*)(qp + 32 * ks); }
    if (load) { u32x4 st[4][4]; const bf16_t* p0 = kbase + (size_t)(tid >> 3) * 1024 + (tid & 7) * 8;
#pragma unroll
      for (int tile = 0; tile < 4; ++tile) { const bf16_t* p = p0 + (size_t)tile * 64 * 1024; st[tile][0] = *(const u32x4*)p; st[tile][1] = *(const u32x4*)(p + 64); st[tile][2] = *(const u32x4*)(p + 512); st[tile][3] = *(const u32x4*)(p + 576); }
      const int off = (tid >> 3) * RS + (tid & 7) * 16;
#pragma unroll
      for (int tile = 0; tile < 4; ++tile) { *(NLAS u32x4*)(lds + l_k(tile) + off) = st[tile][0]; *(NLAS u32x4*)(lds + l_k(tile) + off + 128) = st[tile][1]; *(NLAS u32x4*)(lds + l_v(tile) + off) = st[tile][2]; *(NLAS u32x4*)(lds + l_v(tile) + off + 128) = st[tile][3]; } }
    const float scale2 = 0.08838834764831845f * nsa::LOG2E;
    float mx = -INFINITY, l = 0.f; f32x4 o[8];
#pragma unroll
    for (int db = 0; db < 8; ++db) o[db] = (f32x4){0.f, 0.f, 0.f, 0.f};
    __syncthreads();
#pragma unroll 1
    for (int tile = 0; tile < 4; ++tile) {
        const NLAS char* Kb = lds + l_k(tile); const NLAS char* Vb = lds + l_v(tile);
        f32x4 s[4];
        { bf16x8 a[4][4];
#pragma unroll
          for (int kb = 0; kb < 4; ++kb)
#pragma unroll
              for (int ks = 0; ks < 4; ++ks) a[kb][ks] = *(const NLAS bf16x8*)(Kb + (kb * 16 + i) * RS + 16 * g + 64 * ks);
#pragma unroll
          for (int kb = 0; kb < 4; ++kb) s[kb] = mfma16(a[kb][0], qf[0], (f32x4){0.f, 0.f, 0.f, 0.f});
#pragma unroll
          for (int ks = 1; ks < 4; ++ks)
#pragma unroll
              for (int kb = 0; kb < 4; ++kb) s[kb] = mfma16(a[kb][ks], qf[ks], s[kb]); }
        float mt = -INFINITY;
#pragma unroll
        for (int kb = 0; kb < 4; ++kb)
#pragma unroll
            for (int r = 0; r < 4; ++r) { const float v = s[kb][r] * scale2; s[kb][r] = v; mt = fmaxf(mt, v); }
        mt = xrow_max(mt);
        const float mn = fmaxf(mx, mt), alpha = __builtin_amdgcn_exp2f(mx - mn); float sum = 0.f;
#pragma unroll
        for (int kb = 0; kb < 4; ++kb)
#pragma unroll
            for (int r = 0; r < 4; ++r) { const float p = __builtin_amdgcn_exp2f(s[kb][r] - mn); s[kb][r] = p; sum += p; }
        l = l * alpha + sum; mx = mn;
#pragma unroll
        for (int db = 0; db < 8; ++db) o[db] = o[db] * alpha;
        const NLAS char* vb = Vb + (4 * g + (i >> 2)) * RS + (i & 3) * 8;
#pragma unroll
        for (int kk = 0; kk < 2; ++kk) {
            u32x4 pw; pw.x = pkbf(s[2 * kk][0], s[2 * kk][1]); pw.y = pkbf(s[2 * kk][2], s[2 * kk][3]); pw.z = pkbf(s[2 * kk + 1][0], s[2 * kk + 1][1]); pw.w = pkbf(s[2 * kk + 1][2], s[2 * kk + 1][3]);
            const bf16x8 pf = __builtin_bit_cast(bf16x8, pw);
            s16x4 lo[8], hi[8];
#pragma unroll
            for (int db = 0; db < 8; ++db) { const NLAS char* vp = vb + (2 * kk) * 16 * RS + db * 32; lo[db] = vtr(vp); hi[db] = vtr(vp + 16 * RS); }
#pragma unroll
            for (int db = 0; db < 8; ++db) o[db] = mfma16((bf16x8){lo[db][0], lo[db][1], lo[db][2], lo[db][3], hi[db][0], hi[db][1], hi[db][2], hi[db][3]}, pf, o[db]);
        }
    }
    l = xrow_sum(l);
    const float inv = 1.f / l;
    bf16_t* yo = Yxa + m * 512 + h * 128 + 4 * g;
#pragma unroll
    for (int db = 0; db < 8; ++db) { u32x2 v; v.x = pkbf(o[db][0] * inv, o[db][1] * inv); v.y = pkbf(o[db][2] * inv, o[db][3] * inv); *(u32x2*)(yo + db * 16) = v; }
    __syncthreads();
}
__device__ __forceinline__ void memkv_tile(NLAS char* lds, const bf16_t* MEMN, const bf16_t* Wmkv, bf16_t* MEMKV, int tile) {
    constexpr int RSK = 528, TBK = 64 * RSK;
    const int tid = threadIdx.x, lane = tid & 63, w = __builtin_amdgcn_readfirstlane(tid >> 6), i = lane & 15, g = lane >> 4;
    const int r0 = (tile >> 4) * 64, c0 = (tile & 15) * 64;
    const bf16_t* ap = MEMN + (size_t)(r0 + (tid >> 5)) * 1024 + (tid & 31) * 8; const bf16_t* bp = Wmkv + (size_t)(c0 + (tid >> 5)) * 1024 + (tid & 31) * 8;
    const int soff = (tid >> 5) * RSK + (tid & 31) * 16;
    u32x4 ra[4], rb[4];
#define MKV_LOAD(kc) { _Pragma("unroll") for (int q = 0; q < 4; ++q) { ra[q] = *(const u32x4*)(ap + (size_t)q * 16 * 1024 + (kc) * 256); rb[q] = *(const u32x4*)(bp + (size_t)q * 16 * 1024 + (kc) * 256); } }
#define MKV_STORE(buf) { _Pragma("unroll") for (int q = 0; q < 4; ++q) { *(NLAS u32x4*)(lds + (buf) * 2 * TBK + soff + q * 16 * RSK) = ra[q]; *(NLAS u32x4*)(lds + (buf) * 2 * TBK + TBK + soff + q * 16 * RSK) = rb[q]; } }
    f32x4 acc0 = (f32x4){0.f, 0.f, 0.f, 0.f}, acc1 = acc0;
    MKV_LOAD(0) MKV_STORE(0) MKV_LOAD(1)
    __syncthreads();
    const int arow = ((w >> 1) * 16 + i) * RSK + 16 * g, brow = ((w & 1) * 32 + i) * RSK + 16 * g;
#pragma unroll
    for (int kc = 0; kc < 4; ++kc) { const int buf = kc & 1;
        if (kc < 3) MKV_STORE(buf ^ 1)
        if (kc < 2) MKV_LOAD(kc + 2)
        const NLAS char* A = lds + buf * 2 * TBK; const NLAS char* B = A + TBK;
        bf16x8 af[8], b0[8], b1[8];
#pragma unroll
        for (int ks = 0; ks < 8; ++ks) { af[ks] = *(const NLAS bf16x8*)(A + arow + ks * 64); b0[ks] = *(const NLAS bf16x8*)(B + brow + ks * 64); b1[ks] = *(const NLAS bf16x8*)(B + brow + 16 * RSK + ks * 64); }
#pragma unroll
        for (int ks = 0; ks < 8; ++ks) { acc0 = mfma16(af[ks], b0[ks], acc0); acc1 = mfma16(af[ks], b1[ks], acc1); }
        __syncthreads(); }
#undef MKV_LOAD
#undef MKV_STORE
#pragma unroll
    for (int r = 0; r < 4; ++r) { bf16_t* o = MEMKV + (size_t)(r0 + (w >> 1) * 16 + 4 * g + r) * 1024 + c0 + (w & 1) * 32 + i; o[0] = f2bf(acc0[r]); o[16] = f2bf(acc1[r]); }
}
__device__ __forceinline__ void phase(NLAS char* lds, const bf16_t* P, const bf16_t* MEMKV, bf16_t* Yxa) {
#pragma unroll 1
    for (int pr = blockIdx.x; pr < 256; pr += gridDim.x) {
        unit(lds, P, MEMKV, Yxa, pr >> 6, (pr >> 4) & 3, 2 * (pr & 15), true); unit(lds, P, MEMKV, Yxa, pr >> 6, (pr >> 4) & 3, 2 * (pr & 15) + 1, false); }
}
}

namespace ml {
using nsa::bf16x8; using nsa::s16x4; using nsa::f32x4; using nsa::u32x4; using nsa::u32x2; using nsa::vtr; using nsa::mfma16; using nsa::pkbf;
constexpr int RS = 272, TB = 64 * RS, RSS = 144;
constexpr float KSCALE = 0.08838834764831845f;
__device__ __forceinline__ float scan_add(float v, int) { return wave_scan_dpp<false>(v); }
__device__ __forceinline__ float scan_max(float v, int) { return wave_scan_dpp<true>(v); }
__device__ __forceinline__ bf16x8 trpair(const NLAS char* p, int hi_off) { const s16x4 lo = vtr(p), hi = vtr(p + hi_off); return (bf16x8){lo[0], lo[1], lo[2], lo[3], hi[0], hi[1], hi[2], hi[3]}; }
__device__ __forceinline__ void load_conv(NLAS char* dst, const bf16_t* P, const float* cw, int colP, int cwc, size_t m0, int tseq0, int tid) {
    const int s = tid >> 3, c16 = (tid & 7) * 16;
    u32x4 raw[2][4]; f32x4 wv[2][4][2];
#pragma unroll
    for (int half = 0; half < 2; ++half) { const int c = c16 + half * 8;
#pragma unroll
        for (int j = 0; j < 4; ++j) { const bool ok = (tseq0 + s - j >= 0); const size_t row = m0 + s - (ok ? j : 0);
            raw[half][j] = *(const u32x4*)(P + row * PW + colP + c);
            const f32x4 w0 = *(const f32x4*)(cw + j * 1024 + cwc + c), w1 = *(const f32x4*)(cw + j * 1024 + cwc + c + 4); const f32x4 z = (f32x4){0.f, 0.f, 0.f, 0.f};
            wv[half][j][0] = ok ? w0 : z; wv[half][j][1] = ok ? w1 : z; } }
#pragma unroll
    for (int half = 0; half < 2; ++half) { const int c = c16 + half * 8; float acc[8];
#pragma unroll
        for (int e = 0; e < 8; ++e) acc[e] = 0.f;
#pragma unroll
        for (int j = 0; j < 4; ++j) { const u32x4 r4 = raw[half][j]; const f32x4 w0 = wv[half][j][0], w1 = wv[half][j][1];
            acc[0] += w0[0] * pg8::bflo(r4.x); acc[1] += w0[1] * pg8::bfhi(r4.x); acc[2] += w0[2] * pg8::bflo(r4.y); acc[3] += w0[3] * pg8::bfhi(r4.y);
            acc[4] += w1[0] * pg8::bflo(r4.z); acc[5] += w1[1] * pg8::bfhi(r4.z); acc[6] += w1[2] * pg8::bflo(r4.w); acc[7] += w1[3] * pg8::bfhi(r4.w); }
#pragma unroll
        for (int e = 0; e < 8; ++e) acc[e] = acc[e] * __builtin_amdgcn_rcpf(1.f + __expf(-acc[e]));
        u32x4 o; o.x = pkbf(acc[0], acc[1]); o.y = pkbf(acc[2], acc[3]); o.z = pkbf(acc[4], acc[5]); o.w = pkbf(acc[6], acc[7]);
        *(NLAS u32x4*)(dst + s * RS + c * 2) = o; }
}
struct RawT { u32x4 v[3]; };
__device__ __forceinline__ void raw_issue(RawT& r, const bf16_t* P, int colP, size_t m0, int tseq0, int tid) {
#pragma unroll
    for (int it = 0; it < 3; ++it) { int idx = tid + 512 * it; idx = idx < 1072 ? idx : 1071; const int row = idx >> 4, c = (idx & 15) * 8; const bool ok = (tseq0 + row - 3 >= 0);
        const u32x4 v = *(const u32x4*)(P + (ok ? m0 + row - 3 : m0) * PW + colP + c); r.v[it] = ok ? v : (u32x4){0u, 0u, 0u, 0u}; }
}
__device__ __forceinline__ void raw_store(NLAS char* dst, const RawT& r, int tid) {
#pragma unroll
    for (int it = 0; it < 3; ++it) { int idx = tid + 512 * it; idx = idx < 1072 ? idx : 1071; *(NLAS u32x4*)(dst + (idx >> 4) * RS + (idx & 15) * 16) = r.v[it]; }
}
__device__ __forceinline__ void raw_issue_nz(RawT& r, const bf16_t* P, int colP, size_t m0, int tseq0, int tid) {
#pragma unroll
    for (int it = 0; it < 3; ++it) { int idx = tid + 512 * it; idx = idx < 1072 ? idx : 1071; const int row = idx >> 4, c = (idx & 15) * 8; const bool ok = (tseq0 + row - 3 >= 0);
        r.v[it] = *(const u32x4*)(P + (ok ? m0 + row - 3 : m0) * PW + colP + c); }
}
__device__ __forceinline__ void raw_store_z(NLAS char* dst, const RawT& r, int tseq0, int tid) {
#pragma unroll
    for (int it = 0; it < 3; ++it) { int idx = tid + 512 * it; idx = idx < 1072 ? idx : 1071; const bool ok = (tseq0 + (idx >> 4) - 3 >= 0); *(NLAS u32x4*)(dst + (idx >> 4) * RS + (idx & 15) * 16) = ok ? r.v[it] : (u32x4){0u, 0u, 0u, 0u}; }
}
__device__ __forceinline__ void conv_from_lds(NLAS char* dst, const NLAS char* raw, const NLAS float* wl, int tid) {
    const int s = tid >> 3, c16 = (tid & 7) * 16;
#pragma unroll
    for (int half = 0; half < 2; ++half) { const int c = c16 + half * 8; float acc[8];
#pragma unroll
        for (int e = 0; e < 8; ++e) acc[e] = 0.f;
#pragma unroll
        for (int j = 0; j < 4; ++j) { const u32x4 r4 = *(const NLAS u32x4*)(raw + (s + 3 - j) * RS + c * 2); const f32x4 w0 = *(const NLAS f32x4*)(wl + j * 128 + c), w1 = *(const NLAS f32x4*)(wl + j * 128 + c + 4);
            acc[0] += w0[0] * pg8::bflo(r4.x); acc[1] += w0[1] * pg8::bfhi(r4.x); acc[2] += w0[2] * pg8::bflo(r4.y); acc[3] += w0[3] * pg8::bfhi(r4.y);
            acc[4] += w1[0] * pg8::bflo(r4.z); acc[5] += w1[1] * pg8::bfhi(r4.z); acc[6] += w1[2] * pg8::bflo(r4.w); acc[7] += w1[3] * pg8::bfhi(r4.w); }
#pragma unroll
        for (int e = 0; e < 8; ++e) acc[e] = acc[e] * __builtin_amdgcn_rcpf(1.f + __expf(-acc[e]));
        u32x4 o; o.x = pkbf(acc[0], acc[1]); o.y = pkbf(acc[2], acc[3]); o.z = pkbf(acc[4], acc[5]); o.w = pkbf(acc[6], acc[7]);
        *(NLAS u32x4*)(dst + s * RS + c * 2) = o; }
}
struct M1Pre { RawT rk; u32x4 vraw[2]; f32x4 wreg; float fpre, ipre; };
__device__ __forceinline__ void m1_issue(M1Pre& p, const bf16_t* P, const float* cw, const float* S32, int ci) {
    const int tid = threadIdx.x, lane = tid & 63;
    const int c = ci & 63, bh = ci >> 6, h = bh & 3, b = bh >> 2; const size_t m0 = (size_t)b * T + c * 64;
    raw_issue_nz(p.rk, P, P_MLK + h * 128, m0, c * 64, tid);
    { const bf16_t* vp = P + (m0 + (tid >> 3)) * PW + P_MLV + h * 128 + (tid & 7) * 16; p.vraw[0] = *(const u32x4*)vp; p.vraw[1] = *(const u32x4*)(vp + 8); }
    { const int t2 = tid & 127; p.wreg = *(const f32x4*)(cw + (t2 >> 5) * 1024 + 512 + h * 128 + (t2 & 31) * 4); }
    p.fpre = S32[(m0 + lane) * 32 + 4 + h]; p.ipre = S32[(m0 + lane) * 32 + h];
}
__device__ __forceinline__ void m1_unit(NLAS char* lds, M1Pre& p, const bf16_t* P, const float* cw, const float* S32, bf16_t* Abuf, float* NA, float* Gc, float* Mloc, int ci, int ci_next) {
    constexpr int L_K = 0, L_EV = TB, L_E = 2 * TB, L_RK = 2 * TB + 1024, L_W = L_RK + 67 * RS;
    const int tid = threadIdx.x, lane = tid & 63, w = __builtin_amdgcn_readfirstlane(tid >> 6), i = lane & 15, g = lane >> 4;
    const int c = ci & 63;
    NLAS float* eS = (NLAS float*)(lds + L_E);
    u32x4 vraw[2] = {p.vraw[0], p.vraw[1]};
    if (w == 0) { const float fpre = p.fpre, ipre = p.ipre;
        const float bcs = scan_add(logsig(fpre), lane), gtot = __builtin_bit_cast(float, __builtin_amdgcn_readlane(__builtin_bit_cast(int, bcs), 63)), wend = gtot - bcs + ipre, mloc = wave_max(wend);
        eS[lane] = __expf(wend - mloc) * KSCALE; if (lane == 0) { Gc[ci] = gtot; Mloc[ci] = mloc; } }
    raw_store_z(lds + L_RK, p.rk, c * 64, tid); if (tid < 128) *(NLAS f32x4*)(lds + L_W + ((tid >> 5) * 128 + (tid & 31) * 4) * 4) = p.wreg;
    __syncthreads();
    m1_issue(p, P, cw, S32, ci_next);
    conv_from_lds(lds + L_K, lds + L_RK, (const NLAS float*)(lds + L_W), tid);
    { const int s = tid >> 3, c16 = (tid & 7) * 16; const float es = eS[s];
#pragma unroll
      for (int half = 0; half < 2; ++half) { const u32x4 raw = vraw[half]; u32x4 o;
          o.x = pkbf(pg8::bflo(raw.x) * es, pg8::bfhi(raw.x) * es); o.y = pkbf(pg8::bflo(raw.y) * es, pg8::bfhi(raw.y) * es);
          o.z = pkbf(pg8::bflo(raw.z) * es, pg8::bfhi(raw.z) * es); o.w = pkbf(pg8::bflo(raw.w) * es, pg8::bfhi(raw.w) * es);
          *(NLAS u32x4*)(lds + L_EV + s * RS + (c16 + half * 8) * 2) = o; } }
    __syncthreads();
    f32x4 acc[8];
#pragma unroll
    for (int vb = 0; vb < 8; ++vb) acc[vb] = (f32x4){0.f, 0.f, 0.f, 0.f};
    const int rowoff = (4 * g + (i >> 2)) * RS + (i & 3) * 8;
#pragma unroll
    for (int kk = 0; kk < 2; ++kk) { const bf16x8 kf = trpair(lds + L_K + kk * 32 * RS + rowoff + w * 32, 16 * RS);
#pragma unroll
        for (int vb = 0; vb < 8; ++vb) acc[vb] = mfma16(trpair(lds + L_EV + kk * 32 * RS + rowoff + vb * 32, 16 * RS), kf, acc[vb]); }
    bf16_t* ap = Abuf + ((size_t)ci * 128 + w * 16 + i) * 128 + 4 * g;
#pragma unroll
    for (int vb = 0; vb < 8; ++vb) { u32x2 pk; pk.x = pkbf(acc[vb][0], acc[vb][1]); pk.y = pkbf(acc[vb][2], acc[vb][3]); *(u32x2*)(ap + vb * 16) = pk; }
    { const int k = tid >> 2, part = tid & 3; float n = 0.f;
#pragma unroll
      for (int s = 0; s < 16; ++s) n += eS[part * 16 + s] * bf2f(*(const NLAS bf16_t*)(lds + L_K + (part * 16 + s) * RS + k * 2));
      n += nsa::qx1(n); n += nsa::qx2(n); if (part == 0) NA[(size_t)ci * 128 + k] = n; }
    __syncthreads();
}
__device__ __forceinline__ void m2_items(bf16_t* Abuf, float* NA, const float* Gc, const float* Mloc, float* Mprev) {
    for (int it = blockIdx.x * blockDim.x + threadIdx.x; it < 16 * 128 * 64; it += gridDim.x * blockDim.x) {
        const int bh = it >> 13, kv2 = it & 8191, k = kv2 >> 6, lane = kv2 & 63;
        unsigned* base = (unsigned*)(Abuf + ((size_t)(bh * 64) * 128 + k) * 128 + lane * 2);
        const float gl = Gc[bh * 64 + lane], mll = Mloc[bh * 64 + lane], nal = NA[(size_t)(bh * 64 + lane) * 128 + k];
        unsigned A[64];
#pragma unroll
        for (int c = 0; c < 64; ++c) A[c] = base[(size_t)c * 8192];
        float C0 = 0.f, C1 = 0.f, n = 0.f, m = 0.f, nout = 0.f, mout = 0.f;
#pragma unroll
        for (int c = 0; c < 64; ++c) {
            const float gg = __builtin_bit_cast(float, __builtin_amdgcn_readlane(__builtin_bit_cast(int, gl), c)), ml = __builtin_bit_cast(float, __builtin_amdgcn_readlane(__builtin_bit_cast(int, mll), c));
            const float nA = __builtin_bit_cast(float, __builtin_amdgcn_readlane(__builtin_bit_cast(int, nal), c));
            const float mn = fmaxf(gg + m, ml), a = __expf(gg + m - mn), bb = __expf(ml - mn);
            base[(size_t)c * 8192] = pkbf(C0, C1); C0 = C0 * a + pg8::bflo(A[c]) * bb; C1 = C1 * a + pg8::bfhi(A[c]) * bb;
            nout = (lane == c) ? n : nout; mout = (lane == c) ? m : mout;
            n = a * n + bb * nA; m = mn; }
        NA[(size_t)(bh * 64 + lane) * 128 + k] = nout;
        if (k == 0) Mprev[bh * 64 + lane] = mout;
    }
}
struct M3Pre { RawT rq, rk; u32x4 vr[2], orw[2], cr[4]; f32x4 wreg; float ng[4]; float fpre, ipre, mprev, nprev; };
__device__ __forceinline__ void m3_issue(M3Pre& p, const bf16_t* P, const float* cw, const float* S32, const bf16_t* Cprev, const float* Nprev, const float* Mprev, const float* normg, int ci) {
    const int tid = threadIdx.x, lane = tid & 63, w = __builtin_amdgcn_readfirstlane(tid >> 6), i = lane & 15;
    const int c = ci & 63, bh = ci >> 6, h = bh & 3, b = bh >> 2; const size_t m0 = (size_t)b * T + c * 64;
    const int srow = tid >> 3, c16 = (tid & 7) * 16;
    raw_issue_nz(p.rq, P, P_MLQ + h * 128, m0, c * 64, tid); raw_issue_nz(p.rk, P, P_MLK + h * 128, m0, c * 64, tid);
    { const bf16_t* vp = P + (m0 + srow) * PW + P_MLV + h * 128 + c16; p.vr[0] = *(const u32x4*)vp; p.vr[1] = *(const u32x4*)(vp + 8);
      const bf16_t* op = P + (m0 + srow) * PW + P_MLO + h * 128 + c16; p.orw[0] = *(const u32x4*)op; p.orw[1] = *(const u32x4*)(op + 8);
      const bf16_t* cp = Cprev + ((size_t)ci * 128 + (tid >> 2)) * 128 + (tid & 3) * 32;
#pragma unroll
      for (int q8 = 0; q8 < 4; ++q8) p.cr[q8] = __builtin_nontemporal_load((const u32x4*)(cp + q8 * 8)); }
    { const int t2 = tid & 255; p.wreg = *(const f32x4*)(cw + ((t2 & 127) >> 5) * 1024 + (t2 >> 7) * 512 + h * 128 + (t2 & 31) * 4); }
#pragma unroll
    for (int vb = 0; vb < 4; ++vb) p.ng[vb] = normg[h * 128 + ((w & 1) * 4 + vb) * 16 + i];
    p.fpre = S32[(m0 + lane) * 32 + 4 + h]; p.ipre = S32[(m0 + lane) * 32 + h]; p.mprev = Mprev[ci]; p.nprev = Nprev[(size_t)ci * 128 + (tid & 127)];
}
__device__ __forceinline__ void m3_unit(NLAS char* lds, M3Pre& p, const bf16_t* P, const float* cw, const float* S32, const bf16_t* Cprev, const float* Nprev, const float* Mprev, const float* normg, bf16_t* Yml, int ci, int ci_next) {
    constexpr int L_Q = 0, L_K = TB, L_V = 2 * TB, L_C = 3 * TB, L_S = 5 * TB, L_F = L_S + 64 * RSS, L_RQ = L_F + 4096, L_RK = L_RQ + 67 * RS, L_W = L_RK + 67 * RS;
    static_assert(L_W + 4096 <= 147392 - 64, "m3 LDS map");
    const int tid = threadIdx.x, lane = tid & 63, w = __builtin_amdgcn_readfirstlane(tid >> 6), i = lane & 15, g = lane >> 4;
    const int c = ci & 63, bh = ci >> 6, h = bh & 3, b = bh >> 2; const size_t m0 = (size_t)b * T + c * 64;
    const int srow = tid >> 3, c16 = (tid & 7) * 16;
    float ng[4];
#pragma unroll
    for (int vb = 0; vb < 4; ++vb) ng[vb] = p.ng[vb];
    const u32x4 orw0 = p.orw[0], orw1 = p.orw[1];
    NLAS float* F = (NLAS float*)(lds + L_F);
    NLAS float* rowf = F; NLAS float* colf = F + 64; NLAS float* scv = F + 128; NLAS float* emt = F + 192; NLAS float* qn = F + 256; NLAS float* nprev = F + 320; NLAS float* denp = F + 448; NLAS float* ssq = F + 576;
    if (w == 0) { const float fpre = p.fpre, ipre = p.ipre, mprev = p.mprev;
        const float bcs = scan_add(logsig(fpre), lane), u = ipre - bcs, pm = scan_max(u, lane), mt = bcs + fmaxf(mprev, pm);
        rowf[lane] = bcs - mt; colf[lane] = u; scv[lane] = __expf(bcs + mprev - mt); emt[lane] = __expf(-mt); }
    else if (w <= 2) nprev[tid - 64] = p.nprev;
    raw_store_z(lds + L_RQ, p.rq, c * 64, tid); raw_store_z(lds + L_RK, p.rk, c * 64, tid);
    if (tid < 256) *(NLAS f32x4*)(lds + L_W + ((tid >> 7) * 512 + ((tid & 127) >> 5) * 128 + (tid & 31) * 4) * 4) = p.wreg;
    *(NLAS u32x4*)(lds + L_V + srow * RS + c16 * 2) = p.vr[0]; *(NLAS u32x4*)(lds + L_V + srow * RS + c16 * 2 + 16) = p.vr[1];
#pragma unroll
    for (int q8 = 0; q8 < 4; ++q8) *(NLAS u32x4*)(lds + L_C + (tid >> 2) * RS + ((tid & 3) * 32 + q8 * 8) * 2) = p.cr[q8];
    __syncthreads();
    m3_issue(p, P, cw, S32, Cprev, Nprev, Mprev, normg, ci_next);
    conv_from_lds(lds + L_Q, lds + L_RQ, (const NLAS float*)(lds + L_W), tid);
    conv_from_lds(lds + L_K, lds + L_RK, (const NLAS float*)(lds + L_W) + 512, tid);
    __syncthreads();
    *(NLAS u32x4*)(lds + L_RQ + srow * RS + c16 * 2) = orw0; *(NLAS u32x4*)(lds + L_RQ + srow * RS + c16 * 2 + 16) = orw1;
    { const int tq = tid >> 3, part = tid & 7; const u32x4 q0 = *(const NLAS u32x4*)(lds + L_Q + tq * RS + part * 32), q1 = *(const NLAS u32x4*)(lds + L_Q + tq * RS + part * 32 + 16);
      const NLAS f32x4* np = (const NLAS f32x4*)(nprev + part * 16); const f32x4 n0 = np[0], n1 = np[1], n2 = np[2], n3 = np[3];
      float a = pg8::bflo(q0.x) * n0[0] + pg8::bfhi(q0.x) * n0[1] + pg8::bflo(q0.y) * n0[2] + pg8::bfhi(q0.y) * n0[3] + pg8::bflo(q0.z) * n1[0] + pg8::bfhi(q0.z) * n1[1] + pg8::bflo(q0.w) * n1[2] + pg8::bfhi(q0.w) * n1[3]
              + pg8::bflo(q1.x) * n2[0] + pg8::bfhi(q1.x) * n2[1] + pg8::bflo(q1.y) * n2[2] + pg8::bfhi(q1.y) * n2[3] + pg8::bflo(q1.z) * n3[0] + pg8::bfhi(q1.z) * n3[1] + pg8::bflo(q1.w) * n3[2] + pg8::bfhi(q1.w) * n3[3];
      a += nsa::qx1(a); a += nsa::qx2(a); a += nsa::rror<12>(a); if (part == 0) qn[tq] = a; }
    const int tb = w >> 1;
    {
        float rs[4] = {0.f, 0.f, 0.f, 0.f};
#pragma unroll
        for (int sbi = 0; sbi < 2; ++sbi) { const int sb = 2 * (w & 1) + sbi; f32x4 acc = (f32x4){0.f, 0.f, 0.f, 0.f};
            if (sb <= tb) {
#pragma unroll
                for (int ks = 0; ks < 4; ++ks) acc = mfma16(*(const NLAS bf16x8*)(lds + L_Q + (tb * 16 + i) * RS + (32 * ks + 8 * g) * 2), *(const NLAS bf16x8*)(lds + L_K + (sb * 16 + i) * RS + (32 * ks + 8 * g) * 2), acc); }
            const int sx = sb * 16 + i; const float cf = colf[sx];
#pragma unroll
            for (int r = 0; r < 4; ++r) { const int t = tb * 16 + 4 * g + r; const float v = (sx <= t) ? acc[r] * KSCALE * __expf(rowf[t] + cf) : 0.f; rs[r] += v;
                *(NLAS bf16_t*)(lds + L_S + t * RSS + sx * 2) = f2bf(v); } }
#pragma unroll
        for (int r = 0; r < 4; ++r) { float x = rs[r]; x += nsa::qx1(x); x += nsa::qx2(x); x += nsa::rror<4>(x); x += nsa::rror<8>(x); if (i == 0) denp[(w & 1) * 64 + tb * 16 + 4 * g + r] = x; }
    }
    __syncthreads();
    f32x4 a1[4], a2[4];
#pragma unroll
    for (int vb = 0; vb < 4; ++vb) { a1[vb] = (f32x4){0.f, 0.f, 0.f, 0.f}; a2[vb] = (f32x4){0.f, 0.f, 0.f, 0.f}; }
    const int vb0 = (w & 1) * 4, troff = (8 * g + (i >> 2)) * RS + (i & 3) * 8;
#pragma unroll
    for (int kk = 0; kk < 2; ++kk) { if (32 * kk <= tb * 16 + 15) { const bf16x8 sf = *(const NLAS bf16x8*)(lds + L_S + (tb * 16 + i) * RSS + (32 * kk + 8 * g) * 2);
#pragma unroll
        for (int vb = 0; vb < 4; ++vb) a1[vb] = mfma16(sf, trpair(lds + L_V + kk * 32 * RS + troff + (vb0 + vb) * 32, 4 * RS), a1[vb]); } }
#pragma unroll
    for (int ks = 0; ks < 4; ++ks) { const bf16x8 qf = *(const NLAS bf16x8*)(lds + L_Q + (tb * 16 + i) * RS + (32 * ks + 8 * g) * 2);
#pragma unroll
        for (int vb = 0; vb < 4; ++vb) a2[vb] = mfma16(qf, trpair(lds + L_C + ks * 32 * RS + troff + (vb0 + vb) * 32, 4 * RS), a2[vb]); }
    float hv[4][4], sq[4] = {0.f, 0.f, 0.f, 0.f};
#pragma unroll
    for (int r = 0; r < 4; ++r) { const int t = tb * 16 + 4 * g + r; const float sc = scv[t]; const float den = denp[t] + denp[64 + t] + sc * qn[t]; const float hd = 1.f / fmaxf(fabsf(den), emt[t]);
#pragma unroll
        for (int vb = 0; vb < 4; ++vb) { const float x = (a1[vb][r] + sc * a2[vb][r]) * hd; hv[vb][r] = x; sq[r] += x * x; } }
#pragma unroll
    for (int r = 0; r < 4; ++r) { float x = sq[r]; x += nsa::qx1(x); x += nsa::qx2(x); x += nsa::rror<4>(x); x += nsa::rror<8>(x); if (i == 0) ssq[(w & 1) * 64 + tb * 16 + 4 * g + r] = x; }
    __syncthreads();
#pragma unroll
    for (int r = 0; r < 4; ++r) { const int t = tb * 16 + 4 * g + r; const float rinv = rsqrtf((ssq[t] + ssq[64 + t]) * (1.f / 128.f) + EPS);
#pragma unroll
        for (int vb = 0; vb < 4; ++vb) { const int v = (vb0 + vb) * 16 + i; const float o = bf2f(*(const NLAS bf16_t*)(lds + L_RQ + t * RS + v * 2));
            *(NLAS bf16_t*)(lds + L_RK + t * RS + v * 2) = f2bf(__builtin_amdgcn_rcpf(1.f + __expf(-o)) * hv[vb][r] * rinv * ng[vb]); } }
    __syncthreads();
    { bf16_t* yp = Yml + (m0 + srow) * 512 + h * 128 + c16; *(u32x4*)yp = *(const NLAS u32x4*)(lds + L_RK + srow * RS + c16 * 2); *(u32x4*)(yp + 8) = *(const NLAS u32x4*)(lds + L_RK + srow * RS + c16 * 2 + 16); }
    __syncthreads();
}
}

namespace cmpr {
using nsa::bf16x8; using nsa::f32x4; using nsa::u32x4; using nsa::mfma16; using nsa::pkbf;
constexpr int RSA = 4112, L_A = 0, RSB = 144, TBB = 256 * RSB, L_B = 16 * RSA, L_H = L_B, RSH = 528;
static_assert(L_B + 2 * TBB <= 147392 - 64, "cmpr LDS map");
__device__ __forceinline__ void unit(NLAS char* lds, const bf16_t* P, const float* pe, const bf16_t* W1t, const bf16_t* W2t, bf16_t* KC, bf16_t* VC, int u) {
    const int tid = threadIdx.x, lane = tid & 63, w = __builtin_amdgcn_readfirstlane(tid >> 6), i = lane & 15, g = lane >> 4;
    const int nt = u & 15, gq = (u >> 4) & 1, b = (u >> 5) & 3, kv = u >> 7;
    const int pcol = (kv ? P_VC : P_KC) + gq * 64, tok0 = 256 * nt;
    const bf16_t* bp = W1t + ((size_t)kv * 256 + (tid >> 3)) * 2048 + (tid & 7) * 8; const int bso = (tid >> 3) * RSB + (tid & 7) * 16;
    u32x4 r0[4], r1[4], r2[4], r3[4], r4[4], r5[4], r6[4], r7[4];
    const int rot = (blockIdx.x >> 3) & 31;
#define CMPR_KC(kc) (((kc) + rot) & 31)
#define CMPR_LOAD(dst, kc) { _Pragma("unroll") for (int q = 0; q < 4; ++q) dst[q] = *(const u32x4*)(bp + (size_t)q * 64 * 2048 + CMPR_KC(kc) * 64); }
#define CMPR_STORE(src, buf) { _Pragma("unroll") for (int q = 0; q < 4; ++q) *(NLAS u32x4*)(lds + L_B + (buf) * TBB + bso + q * 64 * RSB) = src[q]; }
    CMPR_LOAD(r0, 0) CMPR_LOAD(r1, 1) CMPR_LOAD(r2, 2) CMPR_LOAD(r3, 3) CMPR_LOAD(r4, 4) CMPR_LOAD(r5, 5) CMPR_LOAD(r6, 6) CMPR_LOAD(r7, 7)
#pragma unroll
    for (int q = 0; q < 8; ++q) { const int p = tid + 512 * q, n = p >> 8, l = (p >> 3) & 31, c8 = (p & 7) * 8, tok = tok0 + 16 * n + l;
        u32x4 v = *(const u32x4*)(P + ((size_t)b * T + (tok < T ? tok : T - 1)) * PW + pcol + c8); if (tok >= T) v = (u32x4){0u, 0u, 0u, 0u};
        const float* pa = pe + kv * 2048 + l * 64 + c8; const f32x4 a0 = *(const f32x4*)pa, a1 = *(const f32x4*)(pa + 4);
        u32x4 o; o.x = pkbf(pg8::bflo(v.x) + a0[0], pg8::bfhi(v.x) + a0[1]); o.y = pkbf(pg8::bflo(v.y) + a0[2], pg8::bfhi(v.y) + a0[3]); o.z = pkbf(pg8::bflo(v.z) + a1[0], pg8::bfhi(v.z) + a1[1]); o.w = pkbf(pg8::bflo(v.w) + a1[2], pg8::bfhi(v.w) + a1[3]);
        *(NLAS u32x4*)(lds + L_A + n * RSA + (l * 64 + c8) * 2) = o; }
    CMPR_STORE(r0, 0)
    __syncthreads();
    f32x4 acc[2]; acc[0] = (f32x4){0.f, 0.f, 0.f, 0.f}; acc[1] = acc[0];
    const int aro = i * RSA + 16 * g, bro = (32 * w + i) * RSB + 16 * g;
#define CMPR_STEP(kc, cur, nxt) { if ((kc) + 1 < 32) CMPR_STORE(nxt, ((kc) + 1) & 1) if ((kc) + 8 < 32) CMPR_LOAD(cur, (kc) + 8) \
        { const NLAS char* B = lds + L_B + ((kc) & 1) * TBB + bro; const NLAS char* A = lds + L_A + aro + CMPR_KC(kc) * 128; \
          const bf16x8 a0 = *(const NLAS bf16x8*)A, a1 = *(const NLAS bf16x8*)(A + 64); \
          acc[0] = mfma16(a0, *(const NLAS bf16x8*)B, acc[0]); acc[1] = mfma16(a0, *(const NLAS bf16x8*)(B + 16 * RSB), acc[1]); \
          acc[0] = mfma16(a1, *(const NLAS bf16x8*)(B + 64), acc[0]); acc[1] = mfma16(a1, *(const NLAS bf16x8*)(B + 16 * RSB + 64), acc[1]); } \
        __syncthreads(); }
#pragma unroll 1
    for (int k4 = 0; k4 < 32; k4 += 8) { CMPR_STEP(k4, r0, r1) CMPR_STEP(k4 + 1, r1, r2) CMPR_STEP(k4 + 2, r2, r3) CMPR_STEP(k4 + 3, r3, r4) CMPR_STEP(k4 + 4, r4, r5) CMPR_STEP(k4 + 5, r5, r6) CMPR_STEP(k4 + 6, r6, r7) CMPR_STEP(k4 + 7, r7, r0) }
#undef CMPR_LOAD
#undef CMPR_KC
#undef CMPR_STORE
#undef CMPR_STEP
#pragma unroll
    for (int cb = 0; cb < 2; ++cb)
#pragma unroll
        for (int r = 0; r < 4; ++r) { const float x = acc[cb][r], uu = 0.7978845608028654f * (x + 0.044715f * x * x * x); const float gl = x * __builtin_amdgcn_rcpf(1.f + __expf(-2.f * uu));
            *(NLAS bf16_t*)(lds + L_H + (4 * g + r) * RSH + (32 * w + cb * 16 + i) * 2) = f2bf(gl); }
    __syncthreads();
    if (w < 4) { f32x4 o = (f32x4){0.f, 0.f, 0.f, 0.f}; const bf16_t* w2 = W2t + ((size_t)kv * 64 + 16 * w + i) * 256 + 8 * g;
#pragma unroll
        for (int ks = 0; ks < 8; ++ks) o = mfma16(*(const NLAS bf16x8*)(lds + L_H + i * RSH + (32 * ks + 8 * g) * 2), *(const bf16x8*)(w2 + 32 * ks), o);
        bf16_t* dst = (kv ? VC : KC);
#pragma unroll
        for (int r = 0; r < 4; ++r) dst[((size_t)(b * 256 + 16 * nt + 4 * g + r) * 2 + gq) * 64 + 16 * w + i] = f2bf(o[r]); }
    __syncthreads();
}
}

#define LAS __attribute__((address_space(3)))
constexpr int NTHREADS = 512, LDS_BYTES = 147456;
constexpr size_t WS_WIN = 1 * MiB, WS_WG = 9 * MiB, WS_WBR = 15 * MiB, WS_WOUT = 18 * MiB, WS_WFF1 = 20 * MiB, WS_WFF2 = 28 * MiB, WS_WMKV = 36 * MiB, WS_WC1 = 38 * MiB;
constexpr size_t WS_BIASP = 253 * MiB + 768 * 1024, WS_XCH = 254 * MiB;
#define XB_TMO      128
#define XB_XCNT(j)  (256  + 64 * (j))
#define XB_XSUB(j)  (1280 + 64 * (j))
#define XB_XGEN(j)  (2304 + 64 * (j))
#define XB_TOP      3328
#define XB_TOPGEN   3392
#define XCD_BAR_WORDS 3456
#define XB_SPIN_CAP (1u << 18)

__device__ __forceinline__ unsigned xb_ld(unsigned* p)              { return __hip_atomic_load(p, __ATOMIC_RELAXED, __HIP_MEMORY_SCOPE_AGENT); }
__device__ __forceinline__ unsigned xb_add(unsigned* p, unsigned v) { return __hip_atomic_fetch_add(p, v, __ATOMIC_RELAXED, __HIP_MEMORY_SCOPE_AGENT); }
__device__ __forceinline__ unsigned xb_xcc_id() { return (unsigned)__builtin_amdgcn_s_getreg((3 << 11) | 20) & 0xFu; }
#define XB_SPIN(cond, bar) do { unsigned _sp = 0; while (cond) { __builtin_amdgcn_s_sleep(1); \
    if ((++_sp & 255u) == 0u) { if (xb_ld(&(bar)[XB_TMO])) break; if (_sp > XB_SPIN_CAP) { atomicAdd(&(bar)[XB_TMO], 1u); break; } } } } while (0)

struct XcdBarrier {
    unsigned* bar; unsigned x;
    volatile LAS unsigned* st;
};

__device__ __forceinline__ XcdBarrier xcd_barrier_post(unsigned* bar, volatile LAS unsigned* st) {
    XcdBarrier b; b.bar = bar; b.x = xb_xcc_id(); b.st = st;
    if (threadIdx.x == 0) (void)xb_add(&bar[XB_XCNT(b.x)], 1u);
    return b;
}
__device__ __forceinline__ void xcd_barrier_complete(unsigned* bar, unsigned x, unsigned& nloc, unsigned& nx) {
    const unsigned G = gridDim.x * gridDim.y * gridDim.z;
    unsigned sum, cnt, mine, sp = 0u;
    for (;;) {
        sum = 0u; cnt = 0u; mine = 0u;
#pragma unroll
        for (unsigned j = 0; j < 16; ++j) { const unsigned c = xb_ld(&bar[XB_XCNT(j)]); sum += c; cnt += (c > 0u) ? 1u : 0u; mine = (j == x) ? c : mine; }
        if (sum == G) break;
        __builtin_amdgcn_s_sleep(1);
        if ((++sp & 255u) == 0u) { if (xb_ld(&bar[XB_TMO])) break; if (sp > XB_SPIN_CAP) { atomicAdd(&bar[XB_TMO], 1u); break; } }
    }
    nloc = mine > 0u ? mine : 1u; nx = cnt > 0u ? cnt : 1u;
}

__device__ __forceinline__ void xcd_barrier(const XcdBarrier& b) {
    asm volatile("s_waitcnt vmcnt(0)" ::: "memory");
    __syncthreads();
    if (threadIdx.x == 0) {
        unsigned* bar = b.bar;
        __builtin_amdgcn_s_waitcnt(0);
        unsigned nloc = b.st[0], nx = b.st[1];
        if (nloc == 0u) { xcd_barrier_complete(bar, b.x, nloc, nx); b.st[0] = nloc; b.st[1] = nx; }
        const unsigned old = xb_add(&bar[XB_XSUB(b.x)], 1u);
        const unsigned gen = old / nloc;
        if (old + 1u == (gen + 1u) * nloc) {
            __builtin_amdgcn_fence(__ATOMIC_RELEASE, "agent");
            asm volatile("s_waitcnt vmcnt(0)" ::: "memory");
            const unsigned og = xb_add(&bar[XB_TOP], 1u);
            const unsigned tg = og / nx;
            if (og + 1u == (tg + 1u) * nx) xb_add(&bar[XB_TOPGEN], 1u);
            else XB_SPIN(xb_ld(&bar[XB_TOPGEN]) == tg, bar);
            __builtin_amdgcn_fence(__ATOMIC_ACQUIRE, "agent");
            xb_add(&bar[XB_XGEN(b.x)], 1u);
            asm volatile("s_waitcnt vmcnt(0)" ::: "memory");
        } else {
            XB_SPIN(xb_ld(&bar[XB_XGEN(b.x)]) == gen, bar);
            __builtin_amdgcn_fence(__ATOMIC_ACQUIRE, "agent");
            asm volatile("s_waitcnt vmcnt(0)" ::: "memory");
        }
    }
    __syncthreads();
}

__device__ __forceinline__ void group_barrier(unsigned* gc, unsigned target, bool light) {
    asm volatile("s_waitcnt vmcnt(0)" ::: "memory"); __syncthreads();
    if (threadIdx.x == 0) {
        if (!light) { __builtin_amdgcn_fence(__ATOMIC_RELEASE, "agent"); asm volatile("s_waitcnt vmcnt(0)" ::: "memory"); }
        __hip_atomic_fetch_add(gc, 1u, __ATOMIC_RELAXED, __HIP_MEMORY_SCOPE_AGENT);
        unsigned sp = 0; while (__hip_atomic_load(gc, __ATOMIC_RELAXED, __HIP_MEMORY_SCOPE_AGENT) < target) { __builtin_amdgcn_s_sleep(1); if (++sp > (1u << 22)) break; }
        __builtin_amdgcn_fence(__ATOMIC_ACQUIRE, "agent"); asm volatile("s_waitcnt vmcnt(0)" ::: "memory");
    }
    __syncthreads();
}
struct Args { const float* in[18]; float* out; unsigned char* ws; int ph_lo, ph_hi; };
__device__ __forceinline__ unsigned pk2(float lo, float hi) { return (unsigned)f2bf(lo) | ((unsigned)f2bf(hi) << 16); }
typedef unsigned v4u __attribute__((ext_vector_type(4)));
typedef float f32x4 __attribute__((ext_vector_type(4)));
__device__ __forceinline__ void tr_item(const float* W, int ld, int ncols, int K, bf16_t* WT, int row_off, LAS float* scr, int item, int lane, const float* ks = nullptr) {
    const int nblk = ncols / 32, kb = item / nblk, nb = item % nblk, k0 = 64 * kb, n0 = 32 * nb;
#pragma unroll 8
    for (int i = 0; i < 32; ++i) { const int kk = 2 * i + (lane >> 5); scr[kk * 33 + (lane & 31)] = W[(size_t)(k0 + kk) * ld + n0 + (lane & 31)] * (ks ? ks[k0 + kk] : 1.f); }
    asm volatile("s_waitcnt lgkmcnt(0)" ::: "memory");
    const int c = lane & 7;
#pragma unroll
    for (int j = 0; j < 4; ++j) { const int n = (lane >> 3) + 8 * j; const LAS float* s = scr + (8 * c) * 33 + n;
        v4u o; o.x = pk2(s[0 * 33], s[1 * 33]); o.y = pk2(s[2 * 33], s[3 * 33]); o.z = pk2(s[4 * 33], s[5 * 33]); o.w = pk2(s[6 * 33], s[7 * 33]);
        *(v4u*)(WT + (size_t)(row_off + n0 + n) * K + k0 + 8 * c) = o; }
    asm volatile("s_waitcnt lgkmcnt(0)" ::: "memory");
}
struct TrD { const float* src; bf16_t* dst; const float* ks; int ld, K; };
__device__ __forceinline__ TrD tr_desc(const float* W, int ld, int ncols, int K, bf16_t* WT, int row_off, int item, const float* ks = nullptr) {
    const int nblk = ncols / 32, kb = item / nblk, nb = item % nblk, k0 = 64 * kb, n0 = 32 * nb;
    TrD d; d.src = W + (size_t)k0 * ld + n0; d.dst = WT + (size_t)(row_off + n0) * K + k0; d.ks = ks ? ks + k0 : nullptr; d.ld = ld; d.K = K; return d; }
__device__ __forceinline__ void tr_load(float (&v)[32], const TrD& d, int lane) { const float* p = d.src + (size_t)(lane >> 5) * d.ld + (lane & 31);
#pragma unroll
    for (int i = 0; i < 32; ++i) v[i] = __builtin_nontemporal_load(p + (size_t)(2 * i) * d.ld); }
__device__ __forceinline__ void tr_finish(const float (&v)[32], const TrD& d, LAS float* scr, int lane) {
#pragma unroll
    for (int i = 0; i < 32; ++i) scr[(2 * i + (lane >> 5)) * 33 + (lane & 31)] = v[i];
    asm volatile("s_waitcnt lgkmcnt(0)" ::: "memory");
    const int c = lane & 7; f32x4 k0v = (f32x4){1.f, 1.f, 1.f, 1.f}, k1v = k0v;
    if (d.ks) { k0v = *(const f32x4*)(d.ks + 8 * c); k1v = *(const f32x4*)(d.ks + 8 * c + 4); }
#pragma unroll
    for (int j = 0; j < 4; ++j) { const int n = (lane >> 3) + 8 * j; const LAS float* t = scr + (8 * c) * 33 + n;
        v4u o; o.x = pk2(t[0 * 33] * k0v[0], t[1 * 33] * k0v[1]); o.y = pk2(t[2 * 33] * k0v[2], t[3 * 33] * k0v[3]); o.z = pk2(t[4 * 33] * k1v[0], t[5 * 33] * k1v[1]); o.w = pk2(t[6 * 33] * k1v[2], t[7 * 33] * k1v[3]);
        *(v4u*)(d.dst + (size_t)n * d.K + 8 * c) = o; }
    asm volatile("s_waitcnt lgkmcnt(0)" ::: "memory");
}
__device__ __forceinline__ void rms_row_wave(const float* xrow, const float* g, bf16_t* orow, int lane) {
    const f32x4* xr = (const f32x4*)xrow + lane; const f32x4* gr = (const f32x4*)g + lane;
    f32x4 v[4]; float s = 0.f;
#pragma unroll
    for (int j = 0; j < 4; ++j) { v[j] = xr[64 * j]; s += (v[j].x * v[j].x + v[j].y * v[j].y) + (v[j].z * v[j].z + v[j].w * v[j].w); }
    const float r = rsqrtf(wave_sum(s) * (1.f / D) + EPS);
    unsigned long long* o8 = (unsigned long long*)orow + lane;
#pragma unroll
    for (int j = 0; j < 4; ++j) { const f32x4 gg = gr[64 * j]; o8[64 * j] = (unsigned long long)pk2(v[j].x * r * gg.x, v[j].y * r * gg.y) | ((unsigned long long)pk2(v[j].z * r * gg.z, v[j].w * r * gg.w) << 32); }
}
__device__ __forceinline__ void rms_row_load(f32x4 (&v)[4], const float* xrow, int lane) { const f32x4* xr = (const f32x4*)xrow + lane;
#pragma unroll
    for (int j = 0; j < 4; ++j) v[j] = __builtin_nontemporal_load(xr + 64 * j); }
__device__ __forceinline__ void rms_row_finish(const f32x4 (&v)[4], const float* g, bf16_t* orow, int lane) { const f32x4* gr = (const f32x4*)g + lane; float s = 0.f;
#pragma unroll
    for (int j = 0; j < 4; ++j) s += (v[j].x * v[j].x + v[j].y * v[j].y) + (v[j].z * v[j].z + v[j].w * v[j].w);
    const float r = rsqrtf(wave_sum(s) * (1.f / D) + EPS);
    unsigned long long* o8 = (unsigned long long*)orow + lane;
#pragma unroll
    for (int j = 0; j < 4; ++j) { const f32x4 gg = gr[64 * j]; o8[64 * j] = (unsigned long long)pk2(v[j].x * r * gg.x, v[j].y * r * gg.y) | ((unsigned long long)pk2(v[j].z * r * gg.z, v[j].w * r * gg.w) << 32); } }
__device__ __forceinline__ int small_src_col(int c) { return c < 8 ? C_MLI + c : C_NSG + (c - 8); }
__global__ void __launch_bounds__(NTHREADS, 2) mega(Args a) {
    extern __shared__ __attribute__((aligned(16))) unsigned char lds_raw[];
    char* lds = (char*)lds_raw;
    LAS unsigned char* lds3 = (LAS unsigned char*)lds_raw;
    const float* x = a.in[0]; const float* mem = a.in[1]; const float* g_mix = a.in[2]; const float* w_in = a.in[3];
    const float* b_in = a.in[4]; const float* ml_conv = a.in[5]; const float* ml_norm_g = a.in[6]; const float* cmp_pe = a.in[7];
    const float* cmp_w1 = a.in[8]; const float* cmp_w2 = a.in[9]; const float* g_mem = a.in[10]; const float* w_mem_kv = a.in[11];
    const float* w_branch = a.in[12]; const float* w_out = a.in[13]; const float* g_ffn = a.in[14]; const float* w_ff1 = a.in[15];
    const float* w_ff2 = a.in[16]; const float* g_final = a.in[17];
    char* ws = (char*)a.ws; float* out = a.out;
    bf16_t* U = (bf16_t*)(ws + WS_U); bf16_t* P = (bf16_t*)(ws + WS_P);
    bf16_t* Yml = (bf16_t*)(ws + WS_Y); bf16_t* Ynsa = Yml + (size_t)M * 512; bf16_t* Yxa = Ynsa + (size_t)M * 512;
    float* S32 = (float*)(ws + WS_S32); bf16_t* MEMN = (bf16_t*)out + (size_t)16 * 1024 * 1024;     bf16_t* MEMKV = (bf16_t*)(ws + WS_MEMKV);
    bf16_t* KC = (bf16_t*)(ws + WS_KC); bf16_t* VC = (bf16_t*)(ws + WS_VC);
    float* NA = (float*)(ws + WS_NA); float* Gc = (float*)(ws + WS_G); float* Mloc = (float*)(ws + WS_MLOC); float* Mprev = (float*)(ws + WS_MPREV);
    bf16_t* Abuf = (bf16_t*)out;
    bf16_t* GATES = P; bf16_t* MERGED = U; bf16_t* H1B = (bf16_t*)out; bf16_t* HBUF = P;
    bf16_t* Wi = (bf16_t*)(ws + WS_WIN); bf16_t* Wg = (bf16_t*)(ws + WS_WG); bf16_t* Wbr = (bf16_t*)(ws + WS_WBR); bf16_t* Wo = (bf16_t*)(ws + WS_WOUT);
    bf16_t* Wf1 = (bf16_t*)(ws + WS_WFF1); bf16_t* Wf2 = (bf16_t*)(ws + WS_WFF2); bf16_t* Wmkv = (bf16_t*)(ws + WS_WMKV);
    float* biasP = (float*)(ws + WS_BIASP); bf16_t* Wc1 = (bf16_t*)(ws + WS_WC1); bf16_t* Wc2 = (bf16_t*)(ws + WS_BIASP + 65536);
    const int tid = threadIdx.x, lane = tid & 63, wave = __builtin_amdgcn_readfirstlane(tid >> 6);
    const int G = gridDim.x, bid = blockIdx.x;
    const int lo = a.ph_lo, hi = a.ph_hi;
    volatile LAS unsigned* xbst = (volatile LAS unsigned*)(lds3 + LDS_BYTES - 64);
    if (tid < 2) xbst[tid] = 0u;
    __syncthreads();
    const XcdBarrier bar = xcd_barrier_post((unsigned*)ws, xbst);
    if (tid == 0) __hip_atomic_store((unsigned*)ws + 12544 + bid, xb_xcc_id() + 1u, __ATOMIC_RELAXED, __HIP_MEMORY_SCOPE_AGENT);
#define PHASE(k) if (lo <= (k) && (k) < hi)
#define SEAM(k) if (lo <= (k) && (k) + 1 < hi) xcd_barrier(bar)
    const int gw = bid * 8 + wave, NGW = G * 8;
    constexpr int I0 = 16 * 64, I1 = 16 * 40, I2 = 16 * 16, I3 = 16 * 96, I4 = 8 * 32, I5 = 16 * 32, I6 = 16 * 128, I7 = 64 * 32, I8 = 16 * 32;
    constexpr int I9 = 32 * 8, I10 = 4 * 2;
    constexpr int NITEMS = I0 + I1 + I2 + I3 + 3 * I4 + I5 + I6 + I7 + I8 + 2 * I9 + 2 * I10;
    auto desc = [&](int it) -> TrD { int r = it;
        if (r < I0) return tr_desc(w_in, DIN, 2048, 1024, Wi, 0, r); r -= I0;
        if (r < I1) return tr_desc(w_in + 2056, DIN, 1280, 1024, Wi, 2048, r); r -= I1;
        if (r < I2) return tr_desc(w_in + 3360, DIN, 512, 1024, Wi, 3328, r); r -= I2;
        if (r < I3) return tr_desc(w_in + C_MG, DIN, 3072, 1024, Wg, 0, r); r -= I3;
        if (r < 3 * I4) { const int j = r / I4; return tr_desc(w_branch + (size_t)j * 512 * 1024, 1024, 1024, 512, Wbr + (size_t)j * 1024 * 512, 0, r % I4); } r -= 3 * I4;
        if (r < I5) return tr_desc(w_out, 1024, 1024, 1024, Wo, 0, r); r -= I5;
        if (r < I6) return tr_desc(w_ff1, FF, FF, 1024, Wf1, 0, r, g_ffn); r -= I6;
        if (r < I7) return tr_desc(w_ff2, 1024, 1024, FF, Wf2, 0, r); r -= I7;
        if (r < I8) return tr_desc(w_mem_kv, 1024, 1024, 1024, Wmkv, 0, r); r -= I8;
        if (r < 2 * I9) { const int kv = r / I9; return tr_desc(cmp_w1 + (size_t)kv * 2048 * 256, 256, 256, 2048, Wc1 + (size_t)kv * 256 * 2048, 0, r % I9); } r -= 2 * I9;
        { const int kv = r / I10; return tr_desc(cmp_w2 + (size_t)kv * 256 * 64, 64, 64, 256, Wc2 + (size_t)kv * 64 * 256, 0, r % I10); } };
    constexpr int NE = I0 + I1 + I2;
    auto tr_run = [&](int first, int step, int end) { LAS float* scr = (LAS float*)(lds3 + wave * 16384);
          int it = first; float va[32], vb[32]; TrD da, db;
          if (it < end) { da = desc(it); tr_load(va, da, lane); }
          while (it < end) {
              const int n1 = it + step; if (n1 < end) { db = desc(n1); tr_load(vb, db, lane); }
              tr_finish(va, da, scr, lane);
              if (n1 >= end) break;
              const int n2 = n1 + step; if (n2 < end) { da = desc(n2); tr_load(va, da, lane); }
              tr_finish(vb, db, scr, lane);
              it = n2; } };
    const bool late_split = (G == 256);
    PHASE(0) {
        tr_run(gw, NGW, late_split ? NE : NITEMS);
        {
          const int i0 = bid * NTHREADS + tid, st = G * NTHREADS;
          for (int i = i0; i < 256 * 1024; i += 2 * st) { const int ia = i, ib = i + st; const bool hb = ib < 256 * 1024;
              const int ra = ia >> 10, ka = ia & 1023, rb = (hb ? ib : ia) >> 10, kb = (hb ? ib : ia) & 1023;
              const bool la = ra < 32 || (ra >= 128 && ra < 160), lb = rb < 32 || (rb >= 128 && rb < 160);
              const float wa = la ? w_in[(size_t)ka * DIN + small_src_col(ra < 32 ? ra : ra - 128)] : 0.f, wb = lb ? w_in[(size_t)kb * DIN + small_src_col(rb < 32 ? rb : rb - 128)] : 0.f;
              const bf16_t va = !la ? (bf16_t)0 : (ra < 32 ? f2bf(wa) : f2bf(wa - bf2f(f2bf(wa)))), vb = !lb ? (bf16_t)0 : (rb < 32 ? f2bf(wb) : f2bf(wb - bf2f(f2bf(wb))));
              Wi[(size_t)(3840 + ra) * 1024 + ka] = va; if (hb) Wi[(size_t)(3840 + rb) * 1024 + kb] = vb; } }
        for (int c = bid * NTHREADS + tid; c < 4096; c += G * NTHREADS) { float v = 0.f;
            if (c < 2048) v = b_in[c]; else if (c < 3328) v = b_in[c + 8]; else if (c < 3840) v = b_in[c + 32]; else if (c < 3872) v = b_in[small_src_col(c - 3840)];
            biasP[c] = v; }
        { int m = gw; f32x4 ra[4], rb[4];
          if (m < M) rms_row_load(ra, x + (size_t)m * D, lane);
          while (m < M) {
              const int m1 = m + NGW; if (m1 < M) rms_row_load(rb, x + (size_t)m1 * D, lane);
              rms_row_finish(ra, g_mix, U + (size_t)m * D, lane);
              if (m1 >= M) break;
              const int m2 = m1 + NGW; if (m2 < M) rms_row_load(ra, x + (size_t)m2 * D, lane);
              rms_row_finish(rb, g_mix, U + (size_t)m1 * D, lane);
              m = m2; } }
        for (int m = gw; m < 1024; m += NGW) rms_row_wave(mem + (size_t)m * D, g_mem, MEMN + (size_t)m * D, lane);
    }
    SEAM(0);
    PHASE(1) {
        const int lhalf = (bid >> 6) & 1, lworker = (((bid >> 7) << 6) | (bid & 63)) * 8 + wave;
        if (late_split && lhalf == 0) { tr_run(NE + 2 * lworker, 2048, NITEMS); asm volatile("s_waitcnt vmcnt(0)" ::: "memory"); __syncthreads(); }
        { pg8::Gemm g{U, Wi, M, 4096, D}; pg8::StaticOrder S; S.init(M, 4096, G, bid);
          pg8::EpiStore<0> E{P, biasP, S32, PW, 15};
          pg8::gemm_phase<pg8::EpiStore<0>, pg8::StaticOrder, true, true>(lds3, g, S, E); }
        if (late_split && lhalf == 1) { __syncthreads(); tr_run(NE + 1 + 2 * lworker, 2048, NITEMS); }
    }
    SEAM(1);
    PHASE(2) { for (int tl_ = bid; tl_ < 256; tl_ += G) xa::memkv_tile((NLAS char*)lds_raw, MEMN, Wmkv, MEMKV, tl_);
               if (bid < 1024) { ml::M1Pre pre1; ml::m1_issue(pre1, P, ml_conv, S32, bid);
                   for (int ci = bid; ci < 1024; ci += G) ml::m1_unit((NLAS char*)lds_raw, pre1, P, ml_conv, S32, Abuf, NA, Gc, Mloc, ci, ci + G < 1024 ? ci + G : ci); }
               for (int u = bid; u < 256; u += G) cmpr::unit((NLAS char*)lds_raw, P, cmp_pe, Wc1, Wc2, KC, VC, u);
    }
    SEAM(2);
    PHASE(3) { unsigned* m2cnt = (unsigned*)ws + 12288;
               ml::m2_items(Abuf, NA, Gc, Mloc, Mprev);
               asm volatile("s_waitcnt vmcnt(0)" ::: "memory"); __syncthreads();
               if (tid == 0) { __builtin_amdgcn_fence(__ATOMIC_RELEASE, "agent"); asm volatile("s_waitcnt vmcnt(0)" ::: "memory"); __hip_atomic_fetch_add(m2cnt, 1u, __ATOMIC_RELAXED, __HIP_MEMORY_SCOPE_AGENT); }
               nsa::phase((NLAS char*)lds_raw, P, S32, KC, VC, Ynsa);
               xa::phase((NLAS char*)lds_raw, P, MEMKV, Yxa);
               if (tid == 0) { unsigned sp = 0; while (__hip_atomic_load(m2cnt, __ATOMIC_RELAXED, __HIP_MEMORY_SCOPE_AGENT) < (unsigned)G) { __builtin_amdgcn_s_sleep(2); if (++sp > (1u << 22)) break; }
                               __builtin_amdgcn_fence(__ATOMIC_ACQUIRE, "agent"); asm volatile("s_waitcnt vmcnt(0)" ::: "memory"); }
               __syncthreads();
               if (G == 256) {
                   unsigned* m3q = (unsigned*)ws + 12448; volatile LAS unsigned* qslot = (volatile LAS unsigned*)(lds3 + LDS_BYTES - 40);
                   int cur = bid, nxt = bid + 256; ml::M3Pre pre; ml::m3_issue(pre, P, ml_conv, S32, Abuf, NA, Mprev, ml_norm_g, cur);
                   while (cur < 1024) { unsigned got = 0u; if (tid == 0) got = __hip_atomic_fetch_add(m3q, 1u, __ATOMIC_RELAXED, __HIP_MEMORY_SCOPE_AGENT);
                       ml::m3_unit((NLAS char*)lds_raw, pre, P, ml_conv, S32, Abuf, NA, Mprev, ml_norm_g, Yml, cur, nxt < 1024 ? nxt : cur);
                       if (tid == 0) qslot[0] = 512u + got;
                       __syncthreads(); const int n2 = (int)qslot[0]; cur = nxt; nxt = n2; } }
               else if (bid < 1024) { ml::M3Pre pre; ml::m3_issue(pre, P, ml_conv, S32, Abuf, NA, Mprev, ml_norm_g, bid);
                   for (int ci = bid; ci < 1024; ci += G) ml::m3_unit((NLAS char*)lds_raw, pre, P, ml_conv, S32, Abuf, NA, Mprev, ml_norm_g, Yml, ci, ci + G < 1024 ? ci + G : ci); } }
    SEAM(4);
    unsigned* gcnt = (unsigned*)ws + 13312 + 16 * (bid & 63);
    bool panel_sync = false;
    if (G == 256) { volatile LAS unsigned* flag = (volatile LAS unsigned*)(lds3 + LDS_BYTES - 48);
        if (wave == 0) { const unsigned* xt = (const unsigned*)ws + 12544; unsigned x0 = 0, same = 1;
            for (int k = 0; k < 4; ++k) { const unsigned xv = __hip_atomic_load(xt + lane + 64 * k, __ATOMIC_RELAXED, __HIP_MEMORY_SCOPE_AGENT); if (k == 0) x0 = xv; same &= (xv == x0 && xv != 0u) ? 1u : 0u; }
            const unsigned long long all = __ballot(same != 0u); if (lane == 0) flag[0] = (all == ~0ull) ? 1u : 0u; }
        __syncthreads();
        panel_sync = flag[0] != 0u; }
    const bool light = true;
#define PSEAM(k, n) if (lo <= (k) && (k) + 1 < hi) { if (panel_sync) group_barrier(gcnt, 4u * (n), light); else xcd_barrier(bar); }
    PHASE(5) { pg8::Gemm g{U, Wg, M, 3072, D}; pg8::StaticOrder S; S.init(M, 3072, G, bid);
               pg8::EpiStore<1> E{GATES, b_in + C_MG, nullptr, 4096, -1};
               pg8::gemm_phase<pg8::EpiStore<1>, pg8::StaticOrder, true, true>(lds3, g, S, E); }
    PSEAM(5, 1);
    PHASE(6) { pg8::Gemm g{Yml, Wbr, M, 1024, 512}; pg8::MergeOrder S; S.so.init(M, 1024, G, bid); S.sa = (size_t)M * 512 * 2; S.sb = (size_t)1024 * 512 * 2;
               pg8::EpiMergeR E{GATES, MERGED};
               pg8::gemm_phase<pg8::EpiMergeR, pg8::MergeOrder, true, true, true>(lds3, g, S, E); }
    PSEAM(6, 2);
    PHASE(7) { pg8::Gemm g{MERGED, Wo, M, 1024, D}; pg8::StaticOrder S; S.init(M, 1024, G, bid);
               pg8::EpiResH E{x, H1B, (float*)(ws + WS_XCH)};
               pg8::gemm_phase<pg8::EpiResH, pg8::StaticOrder, false, true>(lds3, g, S, E); }
    PSEAM(7, 3);
    PHASE(9) { pg8::Gemm g{H1B, Wf1, M, FF, D}; pg8::StaticOrder S; S.init(M, FF, G, bid); S.astep = pg8::HB_PANEL * 2;
               pg8::EpiStoreRs<2> E{HBUF, (const float*)(ws + WS_XCH), FF};
               pg8::gemm_phase<pg8::EpiStoreRs<2>, pg8::StaticOrder, true, true>(lds3, g, S, E); }
    PSEAM(9, 4);
    PHASE(10) { pg8::Gemm g{HBUF, Wf2, M, 1024, FF}; pg8::StaticOrder S; S.init(M, 1024, G, bid);
                pg8::EpiResRms E{H1B, nullptr, out, nullptr, g_final, (float*)(ws + WS_XCH + 262144), (unsigned*)ws + 4096 + 4096};
                pg8::gemm_phase<pg8::EpiResRms, pg8::StaticOrder, false, true>(lds3, g, S, E); }
}
constexpr int N_PHASES = 12;
extern "C" void kernel_launch(void* const* d_in, const int* in_sizes, int n_in, void* d_out, int out_size, void* d_ws, size_t ws_size, hipStream_t stream) {
    static int grid = 0;
    if (grid == 0) {
        int dev = 0, cus = 0, per_cu = 0;
        (void)hipGetDevice(&dev); (void)hipDeviceGetAttribute(&cus, hipDeviceAttributeMultiprocessorCount, dev);
        (void)hipFuncSetAttribute((const void*)mega, hipFuncAttributeMaxDynamicSharedMemorySize, LDS_BYTES);
        (void)hipOccupancyMaxActiveBlocksPerMultiprocessor(&per_cu, (const void*)mega, NTHREADS, LDS_BYTES);
        if (per_cu < 1) { fprintf(stderr, "occupancy query says %d blocks/CU\n", per_cu); per_cu = 1; }
        grid = cus * 1;
        (void)hipGetLastError();
    }
    (void)hipMemsetAsync(d_ws, 0, 65536, stream);
    Args a{};
    for (int i = 0; i < 18; ++i) a.in[i] = (const float*)d_in[i];
    a.out = (float*)d_out; a.ws = (unsigned char*)d_ws;
    a.ph_lo = 0; a.ph_hi = N_PHASES; void* args[] = {&a};
    hipError_t e = hipLaunchCooperativeKernel((const void*)mega, dim3(grid), dim3(NTHREADS), args, LDS_BYTES, stream);
    if (e != hipSuccess) {
        (void)hipGetLastError();
        hipLaunchKernelGGL(mega, dim3(grid), dim3(NTHREADS), LDS_BYTES, stream, a);
    }
}
```
